# Optimizing an MI355X kernel written in HIP

```python
import math
import jax
import jax.numpy as jnp
from jax import lax
import numpy as np

D_MODEL = 4096
BATCH = 4
SEQ = 4096
DEPTH = 1

CTX_LEN = 256
GRID_W = 64

RMS_EPS = 1e-6
N_MOD = 6

RWKV_WIDTH = D_MODEL // 2
RWKV_HEAD = 64
RWKV_HEADS = RWKV_WIDTH // RWKV_HEAD
DECAY_RANK = 96
ICL_RANK = 96
GATE_RANK = 256
RWKV_GN_EPS = 64e-5
RWKV_COLS = 3 * RWKV_WIDTH + 2 * DECAY_RANK + 2 * ICL_RANK + GATE_RANK
RWKV_SPLITS = (RWKV_WIDTH, 2 * RWKV_WIDTH, 3 * RWKV_WIDTH,
               3 * RWKV_WIDTH + 2 * DECAY_RANK,
               3 * RWKV_WIDTH + 2 * DECAY_RANK + 2 * ICL_RANK)

SSM_WIDTH = D_MODEL - RWKV_WIDTH
SSM_HEAD = 64
SSM_HEADS = SSM_WIDTH // SSM_HEAD
SSM_GROUPS = 8
SSM_STATE = 128
SSM_CONV = 3
SSM_CHUNK = 128
SSM_XBC = SSM_WIDTH + 2 * SSM_GROUPS * SSM_STATE
SSM_COLS = SSM_WIDTH + SSM_XBC + 2 * SSM_HEADS

IN_COLS = RWKV_COLS + SSM_COLS

PEER_HEADS = 8
PEER_KEYS = 128
PEER_EXPERTS = PEER_KEYS * PEER_KEYS
PEER_QDIM = 256
PEER_TOPK = 16
PEER_BLOCK = 64

kernel_name = "hybrid_rwkv7_ssd_peer_dit_block"


def rmsnorm(h, g):
    hf = h.astype(jnp.float32)
    hf = hf * lax.rsqrt(jnp.mean(hf * hf, axis=-1, keepdims=True) + RMS_EPS)
    return hf.astype(h.dtype) * g


def modulate(h, g, shift, scale):
    return rmsnorm(h, g) * (1 + scale) + shift


def stack_dirs(fwd, bwd):
    return jnp.concatenate([fwd, jnp.flip(bwd, axis=1)], axis=0)


def unstack_dirs(y):
    b = y.shape[0] // 2
    return y[:b] + jnp.flip(y[b:], axis=1)


def grid_token_shift(p, rows):
    b, t, ch = p.shape
    q = p.reshape(b, rows, GRID_W, ch // 4, 4)
    left = jnp.pad(q[:, :, :-1, :, 0], ((0, 0), (0, 0), (1, 0), (0, 0)))
    right = jnp.pad(q[:, :, 1:, :, 1], ((0, 0), (0, 0), (0, 1), (0, 0)))
    up = jnp.pad(q[:, :-1, :, :, 2], ((0, 0), (1, 0), (0, 0), (0, 0)))
    down = jnp.pad(q[:, 1:, :, :, 3], ((0, 0), (0, 1), (0, 0), (0, 0)))
    return jnp.stack([left, right, up, down], axis=-1).reshape(b, t, ch)


def seq_token_shift(p):
    b, t, ch = p.shape
    q = p.reshape(b, t, ch // 2, 2)
    prev = jnp.pad(q[:, :-1, :, 0], ((0, 0), (1, 0), (0, 0)))
    nxt = jnp.pad(q[:, 1:, :, 1], ((0, 0), (0, 1), (0, 0)))
    return jnp.stack([prev, nxt], axis=-1).reshape(b, t, ch)


def rwkv_prepare(cols, shifted, lp):
    b, t, _ = cols.shape
    xm = cols + lp["rwkv_mu"] * (shifted - cols)
    r, k, v, w_lr, a_lr, g_lr = jnp.split(xm, RWKV_SPLITS, axis=-1)
    w_lr = w_lr.reshape(b, t, 2, DECAY_RANK)
    a_lr = a_lr.reshape(b, t, 2, ICL_RANK)
    w = -jax.nn.softplus(-(lp["rwkv_w0"] + jnp.einsum("btdr,drc->btdc", jnp.tanh(w_lr), lp["rwkv_w2"]))) - 0.5
    decay = jnp.exp(-jnp.exp(w))
    a = jax.nn.sigmoid(lp["rwkv_a0"] + jnp.einsum("btdr,drc->btdc", a_lr, lp["rwkv_a2"]))
    g = jax.nn.sigmoid(g_lr) @ lp["rwkv_g2"]
    k_dir = k[:, :, None, :] * (1 + (a - 1) * lp["rwkv_k_a"])
    heads = lambda z: z.reshape(*z.shape[:-1], RWKV_HEADS, RWKV_HEAD)
    r_h, v_h, decay_h, a_h, k_h = heads(r), heads(v), heads(decay), heads(a), heads(k_dir)
    kk = heads(k * lp["rwkv_k_k"]).astype(jnp.float32)
    kk = (kk * lax.rsqrt(jnp.maximum(jnp.sum(kk * kk, axis=-1, keepdims=True), 1e-24))).astype(k.dtype)
    scan_in = (stack_dirs(r_h, r_h),
               stack_dirs(decay_h[:, :, 0], decay_h[:, :, 1]),
               stack_dirs(k_h[:, :, 0], k_h[:, :, 1]),
               stack_dirs(v_h, v_h),
               stack_dirs(-kk, -kk),
               stack_dirs(kk * a_h[:, :, 0], kk * a_h[:, :, 1]))
    bonus = jnp.einsum("bthn,btdhn,hn->bth", r_h, k_h, lp["rwkv_r_k"])[..., None] * v_h
    return scan_in, bonus, g


def rwkv7_scan(r, w, k, v, a, b, s0):
    def step(s, inp):
        r_t, w_t, k_t, v_t, a_t, b_t = inp
        sa = jnp.einsum("ghij,ghj->ghi", s, a_t)
        s = s * w_t[:, :, None, :] + sa[..., None] * b_t[:, :, None, :] + v_t[..., None] * k_t[:, :, None, :]
        return s, jnp.einsum("ghij,ghj->ghi", s, r_t)
    xs = tuple(jnp.moveaxis(z, 1, 0) for z in (r, w, k, v, a, b))
    s_fin, out = lax.scan(step, s0, xs)
    return jnp.moveaxis(out, 0, 1), s_fin


def rwkv_finish(out_dirs, bonus, g, lp):
    o = unstack_dirs(out_dirs).astype(jnp.float32)
    mean = jnp.mean(o, axis=-1, keepdims=True)
    var = jnp.mean(jnp.square(o - mean), axis=-1, keepdims=True)
    o = ((o - mean) * lax.rsqrt(var + RWKV_GN_EPS)).astype(g.dtype)
    b, t = o.shape[:2]
    o = o.reshape(b, t, RWKV_WIDTH) * lp["rwkv_ln_w"] + lp["rwkv_ln_b"]
    return (o + bonus.reshape(b, t, RWKV_WIDTH)) * g


def centred_dwconv(x, w, bias):
    half = (w.shape[0] - 1) // 2
    y = lax.conv_general_dilated(x, w[:, None, :], window_strides=(1,), padding=[(half, half)],
                                 dimension_numbers=("NWC", "WIO", "NWC"),
                                 feature_group_count=x.shape[-1])
    return y + bias


def ssd_prepare(cols, lp):
    b, t, _ = cols.shape
    z, xbc, dt_raw = jnp.split(cols, (SSM_WIDTH, SSM_WIDTH + SSM_XBC), axis=-1)
    xbc = jax.nn.silu(centred_dwconv(xbc, lp["ssm_conv_w"], lp["ssm_conv_b"]))
    xs, bm, cm = jnp.split(xbc, (SSM_WIDTH, SSM_WIDTH + SSM_GROUPS * SSM_STATE), axis=-1)
    xs = xs.reshape(b, t, SSM_HEADS, SSM_HEAD)
    bm = bm.reshape(b, t, SSM_GROUPS, SSM_STATE)
    cm = cm.reshape(b, t, SSM_GROUPS, SSM_STATE)
    dt = jax.nn.softplus(dt_raw.reshape(b, t, 2, SSM_HEADS) + lp["ssm_dt_bias"])
    log_a = dt * -jnp.exp(lp["ssm_a_log"])
    xdt = xs[:, :, None] * dt[..., None]
    scan_in = (stack_dirs(xdt[:, :, 0], xdt[:, :, 1]),
               stack_dirs(log_a[:, :, 0], log_a[:, :, 1]),
               stack_dirs(bm, bm),
               stack_dirs(cm, cm))
    return scan_in, xs, z


def ssd_chunked(x, la, bm, cm, s0):
    gb, t, h, p = x.shape
    ng, n = bm.shape[2], bm.shape[3]
    r = h // ng
    L = SSM_CHUNK
    nc = t // L
    x = x.reshape(gb, nc, L, ng, r, p)
    la = la.reshape(gb, nc, L, ng, r)
    bm = bm.reshape(gb, nc, L, ng, n)
    cm = cm.reshape(gb, nc, L, ng, n)
    cum = jnp.cumsum(la.astype(jnp.float32), axis=2)
    lower = jnp.tril(jnp.ones((L, L), dtype=bool))[None, None, :, :, None, None]
    seg = cum[:, :, :, None] - cum[:, :, None, :]
    decay_ls = jnp.exp(jnp.where(lower, seg, -jnp.inf)).astype(x.dtype)
    cb = jnp.einsum("bclgn,bcsgn->bclsg", cm, bm)
    y_diag = jnp.einsum("bclsg,bclsgr,bcsgrp->bclgrp", cb, decay_ls, x)
    decay_end = jnp.exp(cum[:, :, -1:] - cum).astype(x.dtype)
    chunk_states = jnp.einsum("bclgn,bclgr,bclgrp->bcgrpn", bm, decay_end, x)
    chunk_decay = jnp.exp(cum[:, :, -1]).astype(x.dtype)

    def carry_state(s, inp):
        dec, st = inp
        return dec[..., None, None] * s + st, s

    s_fin, s_prev = lax.scan(carry_state, s0.reshape(gb, ng, r, p, n),
                             (jnp.moveaxis(chunk_decay, 1, 0), jnp.moveaxis(chunk_states, 1, 0)))
    s_prev = jnp.moveaxis(s_prev, 0, 1)
    y_off = jnp.einsum("bclgn,bcgrpn,bclgr->bclgrp", cm, s_prev, jnp.exp(cum).astype(x.dtype))
    y = (y_diag + y_off).reshape(gb, t, h, p)
    return y, s_fin.reshape(gb, h, p, n)


def ssd_finish(y_dirs, xs, z, lp):
    b, t = xs.shape[:2]
    y = unstack_dirs(y_dirs) + lp["ssm_d"][:, None] * xs
    y = y.reshape(b, t, SSM_WIDTH) * jax.nn.silu(z)
    yf = y.reshape(b, t, SSM_GROUPS, SSM_WIDTH // SSM_GROUPS).astype(jnp.float32)
    yf = yf * lax.rsqrt(jnp.mean(yf * yf, axis=-1, keepdims=True) + RMS_EPS)
    return yf.reshape(b, t, SSM_WIDTH).astype(y.dtype) * lp["ssm_norm_w"]


def hybrid_mixer(n_x, n_c, rows, lp, ctx_out):
    b = n_x.shape[0]
    p_x = n_x @ lp["w_in"]
    p_c = n_c @ lp["w_in"]
    rw_x, ss_x = p_x[..., :RWKV_COLS], p_x[..., RWKV_COLS:]
    rw_c, ss_c = p_c[..., :RWKV_COLS], p_c[..., RWKV_COLS:]
    rin_c, rb_c, rg_c = rwkv_prepare(rw_c, seq_token_shift(rw_c), lp)
    rin_x, rb_x, rg_x = rwkv_prepare(rw_x, grid_token_shift(rw_x, rows), lp)
    s0 = jnp.zeros((2 * b, RWKV_HEADS, RWKV_HEAD, RWKV_HEAD), n_x.dtype)
    ro_c, rs_c = rwkv7_scan(*rin_c, s0)
    ro_x, _ = rwkv7_scan(*rin_x, rs_c)
    sin_c, xs_c, z_c = ssd_prepare(ss_c, lp)
    sin_x, xs_x, z_x = ssd_prepare(ss_x, lp)
    h0 = jnp.zeros((2 * b, SSM_HEADS, SSM_HEAD, SSM_STATE), n_x.dtype)
    so_c, hs_c = ssd_chunked(*sin_c, h0)
    so_x, _ = ssd_chunked(*sin_x, hs_c)
    y_x = jnp.concatenate([rwkv_finish(ro_x, rb_x, rg_x, lp), ssd_finish(so_x, xs_x, z_x, lp)], axis=-1) @ lp["w_out"]
    if ctx_out:
        y_c = jnp.concatenate([rwkv_finish(ro_c, rb_c, rg_c, lp), ssd_finish(so_c, xs_c, z_c, lp)], axis=-1) @ lp["w_out"]
    else:
        y_c = None
    return y_x, y_c


def peer_ffn(xn, lp):
    b, t, d = xn.shape
    w_q, k1, k2, u_tab, v_tab = lp["peer_wq"], lp["peer_k1"], lp["peer_k2"], lp["peer_u"], lp["peer_v"]

    def block(xb):
        q = (xb @ w_q).reshape(PEER_BLOCK, PEER_HEADS, 2, PEER_QDIM // 2)
        s1 = jnp.einsum("thd,hkd->thk", q[:, :, 0], k1).astype(jnp.float32)
        s2 = jnp.einsum("thd,hkd->thk", q[:, :, 1], k2).astype(jnp.float32)
        v1, i1 = lax.top_k(s1, PEER_TOPK)
        v2, i2 = lax.top_k(s2, PEER_TOPK)
        cand = (v1[..., :, None] + v2[..., None, :]).reshape(PEER_BLOCK, PEER_HEADS, PEER_TOPK * PEER_TOPK)
        best, flat = lax.top_k(cand, PEER_TOPK)
        expert = (jnp.take_along_axis(i1, flat // PEER_TOPK, axis=-1) * PEER_KEYS
                  + jnp.take_along_axis(i2, flat % PEER_TOPK, axis=-1))
        gate = jax.nn.softmax(best, axis=-1).astype(xb.dtype)
        act = jax.nn.gelu(jnp.einsum("td,thkd->thk", xb, u_tab[expert]), approximate=False)
        return jnp.einsum("thk,thkd->td", gate * act, v_tab[expert])

    out = lax.map(block, xn.reshape(-1, PEER_BLOCK, d))
    return out.reshape(b, t, d)


def setup_inputs(seed: int = 0) -> dict:
    key = jax.random.key(seed)
    keys = list(jax.random.split(key, 40))
    nxt = lambda: keys.pop()
    nrm = lambda shape, s: jax.random.normal(nxt(), shape, jnp.float32) * s
    uni = lambda shape, lo, hi: jax.random.uniform(nxt(), shape, jnp.float32, minval=lo, maxval=hi)
    L, C = DEPTH, RWKV_WIDTH
    dt_init = jnp.exp(uni((L, 2, SSM_HEADS), math.log(1e-3), math.log(1e-1)))
    return {
        "x": nrm((BATCH, SEQ, D_MODEL), 1.0),
        "c": nrm((BATCH, D_MODEL), 1.0),
        "ctx": nrm((BATCH, CTX_LEN, D_MODEL), 1.0),
        "c_ctx": nrm((D_MODEL,), 1.0),
        "w_mod": nrm((L, D_MODEL, N_MOD * D_MODEL), 0.5 * D_MODEL ** -0.5),
        "b_mod": nrm((L, N_MOD * D_MODEL), 0.01),
        "norm1_g": 1.0 + nrm((L, D_MODEL), 0.02),
        "norm2_g": 1.0 + nrm((L, D_MODEL), 0.02),
        "w_in": nrm((L, D_MODEL, IN_COLS), D_MODEL ** -0.5),
        "w_out": nrm((L, D_MODEL, D_MODEL), D_MODEL ** -0.5),
        "rwkv_mu": uni((L, RWKV_COLS), 0.0, 1.0),
        "rwkv_w0": uni((L, 2, C), -5.0, -1.0),
        "rwkv_w2": nrm((L, 2, DECAY_RANK, C), 0.5 * DECAY_RANK ** -0.5),
        "rwkv_a0": nrm((L, 2, C), 0.1),
        "rwkv_a2": nrm((L, 2, ICL_RANK, C), 0.5 * ICL_RANK ** -0.5),
        "rwkv_g2": nrm((L, GATE_RANK, C), GATE_RANK ** -0.5),
        "rwkv_k_k": 0.85 + nrm((L, C), 0.05),
        "rwkv_k_a": 1.0 + nrm((L, C), 0.05),
        "rwkv_r_k": nrm((L, RWKV_HEADS, RWKV_HEAD), 0.1),
        "rwkv_ln_w": 1.0 + nrm((L, C), 0.02),
        "rwkv_ln_b": nrm((L, C), 0.01),
        "ssm_conv_w": nrm((L, SSM_CONV, SSM_XBC), SSM_CONV ** -0.5),
        "ssm_conv_b": nrm((L, SSM_XBC), 0.01),
        "ssm_dt_bias": dt_init + jnp.log(-jnp.expm1(-dt_init)),
        "ssm_a_log": jnp.log(uni((L, 2, SSM_HEADS), 1.0, 16.0)),
        "ssm_d": 1.0 + nrm((L, SSM_HEADS), 0.1),
        "ssm_norm_w": 1.0 + nrm((L, SSM_WIDTH), 0.02),
        "peer_wq": nrm((L, D_MODEL, PEER_HEADS * PEER_QDIM), D_MODEL ** -0.5),
        "peer_k1": nrm((L, PEER_HEADS, PEER_KEYS, PEER_QDIM // 2), (PEER_QDIM // 2) ** -0.5),
        "peer_k2": nrm((L, PEER_HEADS, PEER_KEYS, PEER_QDIM // 2), (PEER_QDIM // 2) ** -0.5),
        "peer_u": nrm((L, PEER_EXPERTS, D_MODEL), D_MODEL ** -0.5),
        "peer_v": nrm((L, PEER_EXPERTS, D_MODEL), 0.5),
        "final_g": 1.0 + nrm((D_MODEL,), 0.02),
    }


def reference(x, c, ctx, c_ctx, w_mod, b_mod, norm1_g, norm2_g, w_in, w_out,
              rwkv_mu, rwkv_w0, rwkv_w2, rwkv_a0, rwkv_a2, rwkv_g2, rwkv_k_k, rwkv_k_a,
              rwkv_r_k, rwkv_ln_w, rwkv_ln_b, ssm_conv_w, ssm_conv_b, ssm_dt_bias, ssm_a_log,
              ssm_d, ssm_norm_w, peer_wq, peer_k1, peer_k2, peer_u, peer_v, final_g):
    rows = x.shape[1] // GRID_W
    h_x, h_c = x, ctx
    s_c = jax.nn.silu(c)
    s_cc = jax.nn.silu(c_ctx)
    for l in range(DEPTH):
        last = l == DEPTH - 1
        lp = {"w_in": w_in[l], "w_out": w_out[l],
              "rwkv_mu": rwkv_mu[l], "rwkv_w0": rwkv_w0[l], "rwkv_w2": rwkv_w2[l],
              "rwkv_a0": rwkv_a0[l], "rwkv_a2": rwkv_a2[l], "rwkv_g2": rwkv_g2[l],
              "rwkv_k_k": rwkv_k_k[l], "rwkv_k_a": rwkv_k_a[l], "rwkv_r_k": rwkv_r_k[l],
              "rwkv_ln_w": rwkv_ln_w[l], "rwkv_ln_b": rwkv_ln_b[l],
              "ssm_conv_w": ssm_conv_w[l], "ssm_conv_b": ssm_conv_b[l],
              "ssm_dt_bias": ssm_dt_bias[l], "ssm_a_log": ssm_a_log[l],
              "ssm_d": ssm_d[l], "ssm_norm_w": ssm_norm_w[l],
              "peer_wq": peer_wq[l], "peer_k1": peer_k1[l], "peer_k2": peer_k2[l],
              "peer_u": peer_u[l], "peer_v": peer_v[l]}
        mod_x = (s_c @ w_mod[l] + b_mod[l])[:, None, :]
        mod_c = (s_cc @ w_mod[l] + b_mod[l])[None, None, :]
        sh1x, sc1x, gt1x, sh2x, sc2x, gt2x = jnp.split(mod_x, N_MOD, axis=-1)
        sh1c, sc1c, gt1c, sh2c, sc2c, gt2c = jnp.split(mod_c, N_MOD, axis=-1)
        n_x = modulate(h_x, norm1_g[l], sh1x, sc1x)
        n_c = modulate(h_c, norm1_g[l], sh1c, sc1c)
        o_x, o_c = hybrid_mixer(n_x, n_c, rows, lp, not last)
        h_x = h_x + gt1x * o_x
        h_x = h_x + gt2x * peer_ffn(modulate(h_x, norm2_g[l], sh2x, sc2x), lp)
        if not last:
            h_c = h_c + gt1c * o_c
            h_c = h_c + gt2c * peer_ffn(modulate(h_c, norm2_g[l], sh2c, sc2c), lp)
    return rmsnorm(h_x, final_g)
```

```cpp
#define MK_N_LAUNCHES 13
#include <hip/hip_runtime.h>
#include <stdint.h>
#include <stdio.h>
namespace pg8 {
#define PG8_LAS __attribute__((address_space(3)))
typedef unsigned short bf16_t;
typedef short bf16x8 __attribute__((ext_vector_type(8)));
typedef float f32x4 __attribute__((ext_vector_type(4)));
typedef unsigned u32x4 __attribute__((ext_vector_type(4)));
constexpr int BM = 256, BK = 64, HALF = 128, HTB = HALF * BK * 2  , STAGE_BYTES = 8 * HTB, NXCD = 8, WGM = 8;

__host__ __device__ __forceinline__ int lds_byte(int r, int c) { const int st = (r >> 4) * 2 + (c >> 5), rr = r & 15, cc = c & 31, ob = rr * 64 + cc * 2; return st * 1024 + (ob ^ (((ob >> 9) & 1) << 5)); }
__host__ __device__ __forceinline__ void stage_rc(int b, int& R, int& C) { const int st = b / 1024, sb = b % 1024, swz = sb ^ (((sb >> 9) & 1) << 5); R = (st >> 1) * 16 + swz / 64; C = (st & 1) * 32 + (swz % 64) / 2; }
__host__ __device__ __forceinline__ int perm32(int rho) { const int n = rho >> 4, i = rho & 15; return 8 * (i >> 2) + 4 * n + (i & 3); }

struct Unit { int pm, pn; };
struct Gemm { const bf16_t* A; const bf16_t* Bt; int M, N, K; };

struct StaticOrder {
    int nM, nN, nwg, G, c;
    __host__ __device__ void init(int M, int N, int G_, int c_) { nM = M / BM; nN = N / BM; nwg = nM * nN; G = G_; c = c_; }
    __host__ __device__ bool next(int i, Unit& u) const {
        const long L = (long)i * G + c; if (L >= nwg) return false;
        int wgid = (int)L; { const int q = nwg / NXCD, r = nwg % NXCD, xcd = wgid % NXCD, off = wgid / NXCD; wgid = (xcd < r ? xcd * (q + 1) : r * (q + 1) + (xcd - r) * q) + off; }
        const int nig = WGM * nN, gid = wgid / nig, fm = gid * WGM, gsz = (nM - fm) < WGM ? (nM - fm) : WGM;
        u.pm = fm + ((wgid % nig) % gsz); u.pn = (wgid % nig) / gsz; return true;
    }
    __device__ __forceinline__ void a_ready(const Unit&) const {}
    __device__ __forceinline__ void done(const Unit&) const {}
};
__device__ __forceinline__ unsigned cvt_pk_bf16(float lo, float hi) { unsigned r; asm volatile("v_cvt_pk_bf16_f32 %0, %1, %2" : "=v"(r) : "v"(lo), "v"(hi)); return r; }
typedef float f32x2 __attribute__((ext_vector_type(2)));
__device__ __forceinline__ f32x2 gelu_pk(f32x2 v) {
    const f32x2 av = __builtin_elementwise_abs(v), d = av * 0.2316418882f + 1.0f;
    f32x2 t; t.x = __builtin_amdgcn_rcpf(d.x); t.y = __builtin_amdgcn_rcpf(d.y);
    f32x2 q = t * 0.5307027145f + (-0.7265760135f); q = q * t + 0.7107068705f; q = q * t + (-0.142248368f); q = q * t + 0.127414796f; q = q * t;
    const f32x2 s = (v * v) * (-0.72134752044f);
    f32x2 e; e.x = __builtin_amdgcn_exp2f(s.x); e.y = __builtin_amdgcn_exp2f(s.y);
    const f32x2 m = v * (q * e), r = v - m;
    f32x2 o; o.x = v.x < 0.f ? m.x : r.x; o.y = v.y < 0.f ? m.y : r.y; return o;
}

struct EpiF32 {
    static constexpr bool PERM = false, AFTER_DRAIN = false;
    float* C; int ldc; const float* bias;
    __device__ __forceinline__ void operator()(const f32x4 (&acc)[2][2][4][2], const Unit& u, int wr, int wc, int fr, int fq) const {
        const int row0 = u.pm * BM + wr * 64 + fr, col0 = u.pn * BM + wc * 32 + 4 * fq;
        f32x4 bv[2][2];
#pragma unroll
        for (int bj = 0; bj < 2; ++bj)
#pragma unroll
            for (int n = 0; n < 2; ++n) bv[bj][n] = bias ? *(const f32x4*)(bias + col0 + bj * HALF + n * 16) : (f32x4){0.f, 0.f, 0.f, 0.f};
#pragma unroll
        for (int ai = 0; ai < 2; ++ai)
#pragma unroll
            for (int m = 0; m < 4; ++m) { float* rowp = C + (size_t)(row0 + ai * HALF + m * 16) * ldc + col0;
#pragma unroll
                for (int bj = 0; bj < 2; ++bj)
#pragma unroll
                    for (int n = 0; n < 2; ++n) *(f32x4*)(rowp + bj * HALF + n * 16) = acc[ai][bj][m][n] + bv[bj][n]; }
    }
};
template <int ACT  > struct EpiBf16 {
    static constexpr bool PERM = true, AFTER_DRAIN = false;
    bf16_t* O; int ldc; const float* bias; int split_cols; size_t split_stride;
    __device__ __forceinline__ void operator()(const f32x4 (&acc)[2][2][4][2], const Unit& u, int wr, int wc, int fr, int fq) const {
        const int row0 = u.pm * BM + wr * 64 + fr; int colt = u.pn * BM; bf16_t* base = O;
        if (split_cols) { const int t = colt / split_cols; base += (size_t)t * split_stride; colt -= t * split_cols; }
        const int col0 = colt + wc * 32 + 8 * fq, bcol0 = u.pn * BM + wc * 32 + 8 * fq;
        f32x4 bv[2][2];
#pragma unroll
        for (int bj = 0; bj < 2; ++bj)
#pragma unroll
            for (int n = 0; n < 2; ++n) bv[bj][n] = bias ? *(const f32x4*)(bias + bcol0 + bj * HALF + 4 * n) : (f32x4){0.f, 0.f, 0.f, 0.f};
#pragma unroll
        for (int ai = 0; ai < 2; ++ai)
#pragma unroll
            for (int m = 0; m < 4; ++m) { bf16_t* rowp = base + (size_t)(row0 + ai * HALF + m * 16) * ldc + col0;
#pragma unroll
                for (int bj = 0; bj < 2; ++bj) { f32x4 v0 = acc[ai][bj][m][0] + bv[bj][0], v1 = acc[ai][bj][m][1] + bv[bj][1];
                    if (ACT == 1) { f32x2 a = gelu_pk((f32x2){v0[0], v0[1]}), b = gelu_pk((f32x2){v0[2], v0[3]}), c = gelu_pk((f32x2){v1[0], v1[1]}), d = gelu_pk((f32x2){v1[2], v1[3]});
                        v0 = (f32x4){a.x, a.y, b.x, b.y}; v1 = (f32x4){c.x, c.y, d.x, d.y}; }
                    if (ACT == 2) {
#pragma unroll
                        for (int j = 0; j < 4; ++j) { v0[j] = 0.5f * v0[j] * (1.0f + erff(v0[j] * 0.70710678f)); v1[j] = 0.5f * v1[j] * (1.0f + erff(v1[j] * 0.70710678f)); } }
                    u32x4 w; w.x = cvt_pk_bf16(v0[0], v0[1]); w.y = cvt_pk_bf16(v0[2], v0[3]); w.z = cvt_pk_bf16(v1[0], v1[1]); w.w = cvt_pk_bf16(v1[2], v1[3]);
                    *(u32x4*)(rowp + bj * HALF) = w; } }
    }
};
template <class Epi, class Sched, bool STAMP = false>
__device__ __forceinline__ void gemm_phase(PG8_LAS unsigned char* lds, const Gemm g, const Sched& S, const Epi& E, unsigned long long* stamps) {
    const int tid = threadIdx.x, wid = __builtin_amdgcn_readfirstlane(tid >> 6), lane = tid & 63, wr = wid >> 2, wc = wid & 3, fr = lane & 15, fq = lane >> 4;
    const int K = g.K, nt = K / BK;
    int ts_lo = 0, ts_hi = 0, nts = 0; const unsigned long long rt_entry = STAMP ? (unsigned long long)wall_clock64() : 0ull;
#define PG8_STAMP() do { if (STAMP && wid == 0 && nts < 64) { const unsigned long long _c = (unsigned long long)clock64(); \
        ts_lo = (lane == nts) ? (int)(unsigned)_c : ts_lo; ts_hi = (lane == nts) ? (int)(unsigned)(_c >> 32) : ts_hi; ++nts; } } while (0)
    PG8_STAMP();
    unsigned voffA[2], voffB[2];
#pragma unroll
    for (int i = 0; i < 2; ++i) { int R, C; stage_rc(tid * 16 + i * 8192, R, C); const int Rb = Epi::PERM ? ((R & ~31) + perm32(R & 31)) : R;
        voffA[i] = (unsigned)(R * K + C) * 2u; voffB[i] = (unsigned)(Rb * K + C) * 2u; }
    const size_t kstep = (size_t)(BK * 2);
    const size_t hstep = (size_t)HALF * K * 2;
    const size_t tstep = 2 * hstep;
    const unsigned ldsw = (unsigned)wid * 1024u;
    const int aoff = lds_byte(wr * 64 + fr, fq * 8), boff = lds_byte(wc * 32 + fr, fq * 8);
#define PG8_SA(b, h) (((b) * 2 + (h)) * HTB)
#define PG8_SB(b, h) ((4 + (b) * 2 + (h)) * HTB)
#define PG8_STAGE(bufoff, gbase, voff) do { _Pragma("unroll") for (int _i = 0; _i < 2; ++_i) \
        __builtin_amdgcn_global_load_lds((const unsigned*)((const char*)(gbase) + (voff)[_i]), (PG8_LAS unsigned*)(lds + (bufoff) + ldsw + _i * 8192), 16, 0, 0); } while (0)
#define PG8_LDA(dst, b, h) do { _Pragma("unroll") for (int m = 0; m < 4; ++m) _Pragma("unroll") for (int k = 0; k < 2; ++k) dst[m][k] = *(const PG8_LAS bf16x8*)(lds + PG8_SA(b, h) + aoff + m * 2048 + k * 1024); } while (0)
#define PG8_LDB(dst, b, h) do { _Pragma("unroll") for (int n = 0; n < 2; ++n) _Pragma("unroll") for (int k = 0; k < 2; ++k) dst[n][k] = *(const PG8_LAS bf16x8*)(lds + PG8_SB(b, h) + boff + n * 2048 + k * 1024); } while (0)
#define PG8_MMA(ai, bj, At, Bt) do { __builtin_amdgcn_s_setprio(1); _Pragma("unroll") for (int m = 0; m < 4; ++m) _Pragma("unroll") for (int n = 0; n < 2; ++n) _Pragma("unroll") for (int k = 0; k < 2; ++k) \
        acc[ai][bj][m][n] = __builtin_amdgcn_mfma_f32_16x16x32_bf16(Bt[n][k], At[m][k], acc[ai][bj][m][n], 0, 0, 0); __builtin_amdgcn_s_setprio(0); } while (0)
#define PG8_WAIT_V(n) asm volatile("s_waitcnt vmcnt(" #n ")" ::: "memory")
#define PG8_WAIT_L(n) asm volatile("s_waitcnt lgkmcnt(" #n ")" ::: "memory")
#define PG8_BAR __builtin_amdgcn_s_barrier()
#define PG8_SCHED __builtin_amdgcn_sched_barrier(0)
    Unit cur, nxt; int ui = 0;
    if (!S.next(0, cur)) return;
    f32x4 acc[2][2][4][2];
#pragma unroll
    for (int a = 0; a < 2; ++a)
#pragma unroll
        for (int b = 0; b < 2; ++b)
#pragma unroll
            for (int m = 0; m < 4; ++m)
#pragma unroll
                for (int n = 0; n < 2; ++n) acc[a][b][m][n] = (f32x4){0.f, 0.f, 0.f, 0.f};
    bf16x8 At[4][2], B0[2][2], B1[2][2];
    const char* cA = (const char*)g.A + (size_t)cur.pm * tstep; const char* cB = (const char*)g.Bt + (size_t)cur.pn * tstep;
    S.a_ready(cur);
    PG8_STAGE(PG8_SB(0, 0), cB, voffB); PG8_STAGE(PG8_SA(0, 0), cA, voffA); PG8_STAGE(PG8_SB(0, 1), cB + hstep, voffB); PG8_STAGE(PG8_SA(0, 1), cA + hstep, voffA);
    if (wr == 1) PG8_BAR;
    PG8_WAIT_V(4); PG8_BAR;
    PG8_STAGE(PG8_SB(1, 0), cB + kstep, voffB); PG8_STAGE(PG8_SA(1, 0), cA + kstep, voffA); PG8_STAGE(PG8_SB(1, 1), cB + hstep + kstep, voffB);
    PG8_WAIT_V(6); PG8_BAR;
    PG8_STAMP();
    for (;;) {
        const bool has_next = S.next(ui + 1, nxt);
        const char* nA = has_next ? (const char*)g.A + (size_t)nxt.pm * tstep : cA; const char* nB = has_next ? (const char*)g.Bt + (size_t)nxt.pn * tstep : cB;
        for (int t = 0; t < nt; t += 2) {
            const bool last = (t == nt - 2);
            const char* a1 = cA + (size_t)(t + 1) * kstep;
            const char* a2 = last ? nA : cA + (size_t)(t + 2) * kstep; const char* b2 = last ? nB : cB + (size_t)(t + 2) * kstep;
            const char* a3 = a2 + kstep; const char* b3 = b2 + kstep;
            if (last && has_next) S.a_ready(nxt);
            PG8_LDB(B0, 0, 0); PG8_SCHED; PG8_LDA(At, 0, 0); PG8_STAGE(PG8_SA(1, 1), a1 + hstep, voffA);
            PG8_WAIT_L(8); PG8_BAR; PG8_WAIT_L(0); PG8_MMA(0, 0, At, B0); PG8_BAR; PG8_SCHED;
            PG8_LDB(B1, 0, 1); PG8_STAGE(PG8_SB(0, 0), b2, voffB);
            PG8_BAR; PG8_WAIT_L(0); PG8_MMA(0, 1, At, B1); PG8_BAR;
            PG8_LDA(At, 0, 1); PG8_STAGE(PG8_SA(0, 0), a2, voffA);
            PG8_BAR; PG8_WAIT_L(0); PG8_MMA(1, 0, At, B0); PG8_BAR; PG8_SCHED;
            PG8_STAGE(PG8_SB(0, 1), b2 + hstep, voffB);
            PG8_WAIT_V(6); PG8_BAR; PG8_MMA(1, 1, At, B1); PG8_BAR;
            PG8_LDB(B0, 1, 0); PG8_SCHED; PG8_LDA(At, 1, 0); PG8_STAGE(PG8_SA(0, 1), a2 + hstep, voffA);
            PG8_WAIT_L(8); PG8_BAR; PG8_WAIT_L(0); PG8_MMA(0, 0, At, B0); PG8_BAR; PG8_SCHED;
            PG8_LDB(B1, 1, 1); PG8_STAGE(PG8_SB(1, 0), b3, voffB);
            PG8_BAR; PG8_WAIT_L(0); PG8_MMA(0, 1, At, B1); PG8_BAR;
            PG8_LDA(At, 1, 1); PG8_STAGE(PG8_SA(1, 0), a3, voffA);
            PG8_BAR; PG8_WAIT_L(0); PG8_MMA(1, 0, At, B0); PG8_BAR; PG8_SCHED;
            PG8_STAGE(PG8_SB(1, 1), b3 + hstep, voffB);
            PG8_WAIT_V(6); PG8_BAR; PG8_MMA(1, 1, At, B1); PG8_BAR;
        }
        PG8_STAMP();
        if constexpr (!Epi::AFTER_DRAIN) { E(acc, cur, wr, wc, fr, fq); S.done(cur); }
        PG8_STAMP();
        if (!has_next) break;
#pragma unroll
        for (int a = 0; a < 2; ++a)
#pragma unroll
            for (int b = 0; b < 2; ++b)
#pragma unroll
                for (int m = 0; m < 4; ++m)
#pragma unroll
                    for (int n = 0; n < 2; ++n) acc[a][b][m][n] = (f32x4){0.f, 0.f, 0.f, 0.f};
        cur = nxt; cA = nA; cB = nB; ++ui;
    }
    PG8_WAIT_V(0);
    if (wr == 0) PG8_BAR;
    PG8_BAR;
    if constexpr (Epi::AFTER_DRAIN) { E.fused(acc, cur, wr, wc, fr, fq, lds, wid, lane); S.done(cur); }
    PG8_STAMP();
    if (STAMP && wid == 0) { stamps[lane] = lane < nts ? (((unsigned long long)(unsigned)ts_hi << 32) | (unsigned)ts_lo) : 0ull;
        if (lane == 62) stamps[62] = rt_entry; if (lane == 63) stamps[63] = (unsigned long long)wall_clock64(); }
#undef PG8_STAMP
#undef PG8_SA
#undef PG8_SB
#undef PG8_STAGE
#undef PG8_LDA
#undef PG8_LDB
#undef PG8_MMA
#undef PG8_WAIT_V
#undef PG8_WAIT_L
#undef PG8_BAR
#undef PG8_SCHED
}
}

#define LAS __attribute__((address_space(3)))
typedef unsigned short bf16;
typedef float f32x4 __attribute__((ext_vector_type(4)));

#ifndef MK_N_LAUNCHES
#define MK_N_LAUNCHES 1
#endif
#ifndef MK_PHASE_MASK
#define MK_PHASE_MASK 0x1FFF
#endif
#ifndef MK_SKIP_MIXER
#define MK_SKIP_MIXER 0
#endif
#ifndef MK_SKIP_PEER
#define MK_SKIP_PEER 0
#endif
#ifndef MK_SKIP_RWKV
#define MK_SKIP_RWKV 0
#endif
#ifndef MK_SKIP_SSD
#define MK_SKIP_SSD 0
#endif

constexpr int DM = 4096, NBATCH = 4, SEQ = 4096, CTXL = 256;
constexpr int MX = NBATCH * SEQ;
constexpr int MC = NBATCH * CTXL;
constexpr int MT = MX + MC;
constexpr int RW = 2048;
constexpr int RCOLS = 6784;
constexpr int NIN = 12992, NINP = 13056;
constexpr int COL_Z = 6784, COL_XBC = 8832, COL_DT = 12928;
constexpr int NLR = 10240, KLR = 640;
constexpr int NMOD = 6 * DM;
constexpr float RMS_EPS = 1e-6f, GN_EPS = 64e-5f;
constexpr int NSTEP = CTXL + SEQ;

constexpr size_t MiB = (size_t)1 << 20;
constexpr size_t WS_CTL = 0, CTL_ZERO_BYTES = 1 * MiB;
constexpr size_t WS_MOD = 64 * 1024;
constexpr size_t WS_WT_OUT = 2 * MiB;
constexpr size_t WS_WT_Q = 34 * MiB;
constexpr size_t WS_WLR = 50 * MiB;
constexpr size_t WS_KBD = 63 * MiB;
constexpr size_t WS_DT = 71 * MiB;
constexpr size_t WS_LA = WS_DT + (size_t)MT * 64 * 4;
constexpr size_t WS_ALR = 80 * MiB;
constexpr size_t WS_WT_IN = 102 * MiB;
constexpr size_t WS_A1 = 204 * MiB;
constexpr size_t WS_P = 340 * MiB;
constexpr size_t WS_R = 774 * MiB, WS_K = 842 * MiB, WS_V = 910 * MiB, WS_KK = 978 * MiB;
constexpr size_t WS_XS = 1046 * MiB, WS_BC = 1114 * MiB;
constexpr size_t WS_Z = 102 * MiB;
constexpr size_t WS_LR = 340 * MiB;
constexpr size_t WS_A2 = 166 * MiB;
constexpr size_t WS_XN2 = 340 * MiB;
constexpr size_t WS_Q = 468 * MiB;
constexpr size_t WS_S = 532 * MiB;
constexpr size_t WS_U16 = 774 * MiB, WS_V16 = 902 * MiB;
constexpr size_t WS_END = 1182 * MiB;
static_assert(WS_WT_IN + (size_t)NINP * DM * 2 <= WS_A1 && WS_A1 + (size_t)MT * DM * 2 <= WS_P && WS_P + (size_t)MT * NINP * 2 <= WS_R, "ws map 1");
static_assert(WS_LR + (size_t)MT * NLR * 2 <= WS_R && WS_Z + (size_t)MX * RW * 2 <= WS_A2 && WS_A2 + (size_t)MX * DM * 2 <= WS_P, "ws map 2");
static_assert(WS_LA + (size_t)MT * 64 * 4 <= WS_ALR && WS_ALR + (size_t)MT * KLR * 2 <= WS_WT_IN && WS_WLR + (size_t)NLR * KLR * 2 <= WS_KBD, "ws map 3");
static_assert(WS_S + (size_t)MX * 2048 * 4 <= WS_R && WS_V16 + (size_t)16384 * DM * 2 <= WS_XS, "ws map 4");

constexpr int LDS_BYTES = 147456;
constexpr int LDS_MISC = 131072 + 320;

enum { I_X = 0, I_C, I_CTX, I_CCTX, I_WMOD, I_BMOD, I_N1G, I_N2G, I_WIN, I_WOUT, I_MU, I_W0, I_W2, I_A0, I_A2, I_G2, I_KK, I_KA, I_RK, I_LNW, I_LNB,
       I_CONVW, I_CONVB, I_DTB, I_ALOG, I_SSMD, I_NORMW, I_WQ, I_K1, I_K2, I_PU, I_PV, I_FG, N_IN };

struct Args { const float* in[N_IN]; float* out; unsigned char* ws; int ph_lo, ph_hi; };

__device__ __forceinline__ unsigned f2bf(float f) { unsigned u = __float_as_uint(f); return (u + 0x7fffu + ((u >> 16) & 1u)) >> 16; }
__device__ __forceinline__ unsigned pk2(float lo, float hi) { return f2bf(lo) | (f2bf(hi) << 16); }
__device__ __forceinline__ float bflo(unsigned u) { return __uint_as_float(u << 16); }
__device__ __forceinline__ float bfhi(unsigned u) { return __uint_as_float(u & 0xffff0000u); }
__device__ __forceinline__ void unpack8(const uint4& u, float (&f)[8]) {
    f[0] = bflo(u.x); f[1] = bfhi(u.x); f[2] = bflo(u.y); f[3] = bfhi(u.y); f[4] = bflo(u.z); f[5] = bfhi(u.z); f[6] = bflo(u.w); f[7] = bfhi(u.w);
}
__device__ __forceinline__ uint4 pack8(const float (&f)[8]) { uint4 u; u.x = pk2(f[0], f[1]); u.y = pk2(f[2], f[3]); u.z = pk2(f[4], f[5]); u.w = pk2(f[6], f[7]); return u; }
__device__ __forceinline__ uint4 ld16(const bf16* p) { return *(const uint4*)p; }
__device__ __forceinline__ void st16(bf16* p, const uint4& v) { *(uint4*)p = v; }
__device__ __forceinline__ void ldf8(const float* p, float (&f)[8]) { const float4 a = *(const float4*)p, b = *(const float4*)(p + 4); f[0] = a.x; f[1] = a.y; f[2] = a.z; f[3] = a.w; f[4] = b.x; f[5] = b.y; f[6] = b.z; f[7] = b.w; }
#define PIN8(a) asm volatile("" : "+v"((a)[0]), "+v"((a)[1]), "+v"((a)[2]), "+v"((a)[3]), "+v"((a)[4]), "+v"((a)[5]), "+v"((a)[6]), "+v"((a)[7]))
__device__ __forceinline__ float wave_sum(float v) {
#pragma unroll
    for (int o = 1; o < 64; o <<= 1) v += __shfl_xor(v, o);
    return v;
}
__device__ __forceinline__ float wave_max(float v) {
#pragma unroll
    for (int o = 1; o < 64; o <<= 1) v = fmaxf(v, __shfl_xor(v, o));
    return v;
}
__device__ __forceinline__ float sigmoidf_(float x) { return 1.f / (1.f + __expf(-x)); }
__device__ __forceinline__ float siluf_(float x) { return x / (1.f + __expf(-x)); }

struct EpiLR {
    static constexpr bool PERM = true, AFTER_DRAIN = false;
    bf16* O; const float* w0; const float* a0;
    __device__ __forceinline__ void operator()(const pg8::f32x4 (&acc)[2][2][4][2], const pg8::Unit& u, int wr, int wc, int fr, int fq) const {
        const int row0 = u.pm * 256 + wr * 64 + fr; const int colt = u.pn * 256; const int type = colt >> 11;
        const int col0 = colt + wc * 32 + 8 * fq;
        const float* bias = type < 2 ? (w0 + type * 2048) : (a0 + (type - 2) * 2048);
        pg8::f32x4 bv[2][2];
#pragma unroll
        for (int bj = 0; bj < 2; ++bj)
#pragma unroll
            for (int n = 0; n < 2; ++n) bv[bj][n] = type < 4 ? *(const pg8::f32x4*)(bias + ((col0 + bj * 128 + 4 * n) & 2047)) : (pg8::f32x4){0.f, 0.f, 0.f, 0.f};
#pragma unroll
        for (int ai = 0; ai < 2; ++ai)
#pragma unroll
            for (int m = 0; m < 4; ++m) { bf16* rowp = O + (size_t)(row0 + ai * 128 + m * 16) * NLR + col0;
#pragma unroll
                for (int bj = 0; bj < 2; ++bj) { pg8::f32x4 v0 = acc[ai][bj][m][0] + bv[bj][0], v1 = acc[ai][bj][m][1] + bv[bj][1];
                    if (type < 4) {
#pragma unroll
                        for (int j = 0; j < 4; ++j) { float s0 = 1.f / (1.f + __expf(-v0[j])), s1 = 1.f / (1.f + __expf(-v1[j]));
                            if (type < 2) { s0 = -expm1f(-0.60653066f * s0); s1 = -expm1f(-0.60653066f * s1); }
                            v0[j] = s0; v1[j] = s1; } }
                    pg8::u32x4 w; w.x = pg8::cvt_pk_bf16(v0[0], v0[1]); w.y = pg8::cvt_pk_bf16(v0[2], v0[3]); w.z = pg8::cvt_pk_bf16(v1[0], v1[1]); w.w = pg8::cvt_pk_bf16(v1[2], v1[3]);
                    *(pg8::u32x4*)(rowp + bj * 128) = w; } }
    }
};
struct EpiRes {
    static constexpr bool PERM = false, AFTER_DRAIN = false;
    float* C; const float* X; const float* mod;
    __device__ __forceinline__ void operator()(const pg8::f32x4 (&acc)[2][2][4][2], const pg8::Unit& u, int wr, int wc, int fr, int fq) const {
        const int row0 = u.pm * 256 + wr * 64 + fr, col0 = u.pn * 256 + wc * 32 + 4 * fq;
        const float* gt = mod + (size_t)((u.pm * 256) / SEQ) * NMOD + 2 * DM;
        pg8::f32x4 gv[2][2];
#pragma unroll
        for (int bj = 0; bj < 2; ++bj)
#pragma unroll
            for (int n = 0; n < 2; ++n) gv[bj][n] = *(const pg8::f32x4*)(gt + col0 + bj * 128 + n * 16);
#pragma unroll
        for (int ai = 0; ai < 2; ++ai)
#pragma unroll
            for (int m = 0; m < 4; ++m) { const size_t off = (size_t)(row0 + ai * 128 + m * 16) * DM + col0;
#pragma unroll
                for (int bj = 0; bj < 2; ++bj)
#pragma unroll
                    for (int n = 0; n < 2; ++n) { const pg8::f32x4 xv = *(const pg8::f32x4*)(X + off + bj * 128 + n * 16);
#if MK_SKIP_MIXER
                        *(pg8::f32x4*)(C + off + bj * 128 + n * 16) = xv;
#else
                        *(pg8::f32x4*)(C + off + bj * 128 + n * 16) = xv + gv[bj][n] * acc[ai][bj][m][n];
#endif
                    }
                asm volatile("" ::: "memory"); }
    }
};

#define XB_TMO      128
#define XB_XCNT(j)  (256  + 64 * (j))
#define XB_XSUB(j)  (1280 + 64 * (j))
#define XB_XGEN(j)  (2304 + 64 * (j))
#define XB_TOP      3328
#define XB_TOPGEN   3392
#define XCD_BAR_WORDS 3456
#define XB_SPIN_CAP (1u << 18)
__device__ __forceinline__ unsigned xb_ld(unsigned* p)              { return __hip_atomic_load(p, __ATOMIC_RELAXED, __HIP_MEMORY_SCOPE_AGENT); }
__device__ __forceinline__ unsigned xb_add(unsigned* p, unsigned v) { return __hip_atomic_fetch_add(p, v, __ATOMIC_RELAXED, __HIP_MEMORY_SCOPE_AGENT); }
__device__ __forceinline__ unsigned xb_xcc_id() { return (unsigned)__builtin_amdgcn_s_getreg((3 << 11) | 20) & 0xFu; }
#define XB_SPIN(cond, bar) do { unsigned _sp = 0; while (cond) { __builtin_amdgcn_s_sleep(1); \
    if ((++_sp & 255u) == 0u) { if (xb_ld(&(bar)[XB_TMO])) break; if (_sp > XB_SPIN_CAP) { atomicAdd(&(bar)[XB_TMO], 1u); break; } } } } while (0)
struct XcdBarrier { unsigned* bar; unsigned x; volatile LAS unsigned* st; };
__device__ __forceinline__ XcdBarrier xcd_barrier_post(unsigned* bar, volatile LAS unsigned* st) {
    XcdBarrier b; b.bar = bar; b.x = xb_xcc_id(); b.st = st;
    if (threadIdx.x == 0) (void)xb_add(&bar[XB_XCNT(b.x)], 1u);
    return b;
}
__device__ __forceinline__ void xcd_barrier_complete(unsigned* bar, unsigned x, unsigned& nloc, unsigned& nx) {
    const unsigned G = gridDim.x * gridDim.y * gridDim.z;
    unsigned sum, cnt, mine, sp = 0u;
    for (;;) {
        sum = 0u; cnt = 0u; mine = 0u;
#pragma unroll
        for (unsigned j = 0; j < 16; ++j) { const unsigned c = xb_ld(&bar[XB_XCNT(j)]); sum += c; cnt += (c > 0u) ? 1u : 0u; mine = (j == x) ? c : mine; }
        if (sum == G) break;
        __builtin_amdgcn_s_sleep(1);
        if ((++sp & 255u) == 0u) { if (xb_ld(&bar[XB_TMO])) break; if (sp > XB_SPIN_CAP) { atomicAdd(&bar[XB_TMO], 1u); break; } }
    }
    nloc = mine > 0u ? mine : 1u; nx = cnt > 0u ? cnt : 1u;
}
__device__ __forceinline__ void xcd_barrier(const XcdBarrier& b) {
    asm volatile("s_waitcnt vmcnt(0)" ::: "memory");
    __syncthreads();
    if (threadIdx.x == 0) {
        unsigned* bar = b.bar;
        __builtin_amdgcn_s_waitcnt(0);
        unsigned nloc = b.st[0], nx = b.st[1];
        if (nloc == 0u) { xcd_barrier_complete(bar, b.x, nloc, nx); b.st[0] = nloc; b.st[1] = nx; }
        const unsigned old = xb_add(&bar[XB_XSUB(b.x)], 1u);
        const unsigned gen = old / nloc;
        if (old + 1u == (gen + 1u) * nloc) {
            __builtin_amdgcn_fence(__ATOMIC_RELEASE, "agent");
            asm volatile("s_waitcnt vmcnt(0)" ::: "memory");
            const unsigned og = xb_add(&bar[XB_TOP], 1u);
            const unsigned tg = og / nx;
            if (og + 1u == (tg + 1u) * nx) xb_add(&bar[XB_TOPGEN], 1u);
            else XB_SPIN(xb_ld(&bar[XB_TOPGEN]) == tg, bar);
            __builtin_amdgcn_fence(__ATOMIC_ACQUIRE, "agent");
            xb_add(&bar[XB_XGEN(b.x)], 1u);
            asm volatile("s_waitcnt vmcnt(0)" ::: "memory");
        } else {
            XB_SPIN(xb_ld(&bar[XB_XGEN(b.x)]) == gen, bar);
            __builtin_amdgcn_fence(__ATOMIC_ACQUIRE, "agent");
            asm volatile("s_waitcnt vmcnt(0)" ::: "memory");
        }
    }
    __syncthreads();
}

#define TID ((int)threadIdx.x)
#define LANE ((int)(threadIdx.x & 63))
#define WAVE ((int)__builtin_amdgcn_readfirstlane((int)(threadIdx.x >> 6)))
#define GW ((int)blockIdx.x * 8 + WAVE)
#define NGW ((int)gridDim.x * 8)

__device__ __forceinline__ void ph_mod(const Args& a, LAS unsigned char* lds) {
    const float* c = a.in[I_C]; const float* cc = a.in[I_CCTX]; const float* w_mod = a.in[I_WMOD]; const float* b_mod = a.in[I_BMOD];
    float* mod = (float*)(a.ws + WS_MOD);
    LAS float* sS = (LAS float*)lds;
    LAS float* red = (LAS float*)(lds + 81920);
    const int tid = TID, lane = LANE, wave = WAVE;
    if ((int)blockIdx.x < 192) {
        for (int i = tid; i < 5 * DM; i += 512) { const int v = i >> 12, k = i & (DM - 1); const float xv = v < 4 ? c[v * DM + k] : cc[k]; sS[i] = xv / (1.f + expf(-xv)); }
    }
    __syncthreads();
    for (int u = blockIdx.x; u < 192; u += gridDim.x) {
        const int cl = lane & 31, kh = lane >> 5;
        float acc[5][4];
#pragma unroll
        for (int v = 0; v < 5; ++v)
#pragma unroll
            for (int e = 0; e < 4; ++e) acc[v][e] = 0.f;
        const float* wp = w_mod + (size_t)(wave * 512 + kh) * NMOD + u * 128 + cl * 4;
#pragma unroll 8
        for (int i = 0; i < 256; ++i) {
            const float4 w = *(const float4*)(wp + (size_t)(2 * i) * NMOD);
#pragma unroll
            for (int v = 0; v < 5; ++v) { const float s = sS[v * DM + wave * 512 + 2 * i + kh]; acc[v][0] += s * w.x; acc[v][1] += s * w.y; acc[v][2] += s * w.z; acc[v][3] += s * w.w; }
        }
#pragma unroll
        for (int v = 0; v < 5; ++v)
#pragma unroll
            for (int e = 0; e < 4; ++e) acc[v][e] += __shfl_xor(acc[v][e], 32);
        if (kh == 0) {
#pragma unroll
            for (int v = 0; v < 5; ++v) *(LAS f32x4*)(red + ((wave * 5 + v) * 128 + cl * 4)) = (f32x4){acc[v][0], acc[v][1], acc[v][2], acc[v][3]};
        }
        __syncthreads();
        for (int i = tid; i < 640; i += 512) { const int v = i >> 7, n = i & 127; float s = b_mod[u * 128 + n];
#pragma unroll
            for (int w = 0; w < 8; ++w) s += red[(w * 5 + v) * 128 + n];
            mod[v * NMOD + u * 128 + n] = s; }
        __syncthreads();
    }
    __syncthreads();
}

__device__ __forceinline__ void transpose_item(const float* W, int K, int N, bf16* WT, LAS float* scr, int item, int lane) {
    const int nblk = N / 32, kb = item / nblk, nb = item % nblk, k0 = 64 * kb, n0 = 32 * nb;
#pragma unroll 8
    for (int i = 0; i < 32; ++i) { const int kk = 2 * i + (lane >> 5); scr[kk * 33 + (lane & 31)] = W[(size_t)(k0 + kk) * N + n0 + (lane & 31)]; }
    asm volatile("s_waitcnt lgkmcnt(0)" ::: "memory");
    const int c = lane & 7;
#pragma unroll
    for (int j = 0; j < 4; ++j) { const int n = (lane >> 3) + 8 * j; const LAS float* s = scr + (8 * c) * 33 + n;
        uint4 o; o.x = pk2(s[0 * 33], s[1 * 33]); o.y = pk2(s[2 * 33], s[3 * 33]); o.z = pk2(s[4 * 33], s[5 * 33]); o.w = pk2(s[6 * 33], s[7 * 33]);
        *(uint4*)(WT + (size_t)(n0 + n) * K + k0 + 8 * c) = o; }
    asm volatile("s_waitcnt lgkmcnt(0)" ::: "memory");
}
__device__ __forceinline__ void ph_conv(const Args& a, LAS unsigned char* lds) {
    const int lane = LANE, wave = WAVE, gw = GW, ngw = NGW;
    LAS float* scr = (LAS float*)(lds + wave * 16384);
    bf16* wt_in = (bf16*)(a.ws + WS_WT_IN); bf16* wt_out = (bf16*)(a.ws + WS_WT_OUT); bf16* wt_q = (bf16*)(a.ws + WS_WT_Q);
    constexpr int IT_IN = (DM / 64) * (NIN / 32), IT_OUT = (DM / 64) * (DM / 32), IT_Q = (DM / 64) * (2048 / 32);
    for (int it = gw; it < IT_IN + IT_OUT + IT_Q; it += ngw) {
        int r = it;
        if (r < IT_IN) { transpose_item(a.in[I_WIN], DM, NIN, wt_in, scr, r, lane); continue; } r -= IT_IN;
        if (r < IT_OUT) { transpose_item(a.in[I_WOUT], DM, DM, wt_out, scr, r, lane); continue; } r -= IT_OUT;
        transpose_item(a.in[I_WQ], DM, 2048, wt_q, scr, r, lane);
    }
    const int gt = blockIdx.x * 512 + TID, ngt = gridDim.x * 512;
    for (int i = gt; i < (NINP - NIN) * DM / 8; i += ngt) *(uint4*)(wt_in + (size_t)NIN * DM + (size_t)i * 8) = make_uint4(0u, 0u, 0u, 0u);
    { bf16* wlr = (bf16*)(a.ws + WS_WLR); const float* w2 = a.in[I_W2]; const float* a2 = a.in[I_A2]; const float* g2 = a.in[I_G2];
      for (int i = gt; i < NLR * (KLR / 8); i += ngt) { const int n = i / (KLR / 8), k0 = (i % (KLR / 8)) * 8; const int type = n >> 11, cch = n & 2047;
          float f[8];
#pragma unroll
          for (int e = 0; e < 8; ++e) { const int k = k0 + e; float v = 0.f;
              if (type == 0) { if (k < 96) v = w2[(size_t)(0 * 96 + k) * RW + cch]; }
              else if (type == 1) { if (k >= 96 && k < 192) v = w2[(size_t)(1 * 96 + (k - 96)) * RW + cch]; }
              else if (type == 2) { if (k >= 192 && k < 288) v = a2[(size_t)(0 * 96 + (k - 192)) * RW + cch]; }
              else if (type == 3) { if (k >= 288 && k < 384) v = a2[(size_t)(1 * 96 + (k - 288)) * RW + cch]; }
              else { if (k >= 384) v = g2[(size_t)(k - 384) * RW + cch]; }
              f[e] = v; }
          st16(wlr + (size_t)n * KLR + k0, pack8(f)); } }
    { bf16* kbd = (bf16*)(a.ws + WS_KBD); const float* k1 = a.in[I_K1]; const float* k2 = a.in[I_K2];
      for (int i = gt; i < 2048 * 256; i += ngt) { const int n = i >> 8, k0 = (i & 255) * 8; float f[8];
          if ((n >> 7) == (k0 >> 7)) { const int h = n >> 8, s = (n >> 7) & 1, key = n & 127, d0 = k0 & 127; const float* src = (s ? k2 : k1) + ((size_t)(h * 128 + key) * 128 + d0); ldf8(src, f); }
          else {
#pragma unroll
              for (int e = 0; e < 8; ++e) f[e] = 0.f; }
          st16(kbd + (size_t)n * 2048 + k0, pack8(f)); } }
}

__device__ __forceinline__ void norm_mod_row(const float* src, const float* g, const float* sh, const float* sc, bf16* dst, int lane) {
    float4 v[16]; float ss = 0.f;
#pragma unroll
    for (int j = 0; j < 16; ++j) { v[j] = *(const float4*)(src + (lane + 64 * j) * 4); ss += (v[j].x * v[j].x + v[j].y * v[j].y) + (v[j].z * v[j].z + v[j].w * v[j].w); }
    const float rstd = rsqrtf(wave_sum(ss) * (1.f / DM) + RMS_EPS);
#pragma unroll
    for (int j = 0; j < 16; ++j) { const int c = (lane + 64 * j) * 4; const float4 gg = *(const float4*)(g + c), s1 = *(const float4*)(sc + c), s0 = *(const float4*)(sh + c);
        const float o0 = v[j].x * rstd * gg.x * (1.f + s1.x) + s0.x, o1 = v[j].y * rstd * gg.y * (1.f + s1.y) + s0.y, o2 = v[j].z * rstd * gg.z * (1.f + s1.z) + s0.z, o3 = v[j].w * rstd * gg.w * (1.f + s1.w) + s0.w;
        uint2 w; w.x = pk2(o0, o1); w.y = pk2(o2, o3); *(uint2*)(dst + c) = w; }
}
__device__ __forceinline__ void ph_norm1(const Args& a) {
    const int lane = LANE; const float* mod = (const float*)(a.ws + WS_MOD); bf16* A1 = (bf16*)(a.ws + WS_A1);
    for (int m = GW; m < MT; m += NGW) {
        const float* src = m < MX ? a.in[I_X] + (size_t)m * DM : a.in[I_CTX] + (size_t)(m - MX) * DM;
        const int v = m < MX ? m / SEQ : 4;
        norm_mod_row(src, a.in[I_N1G], mod + (size_t)v * NMOD, mod + (size_t)v * NMOD + DM, A1 + (size_t)m * DM, lane);
    }
}
__device__ __forceinline__ void ph_norm2(const Args& a) {
    const int lane = LANE; const float* mod = (const float*)(a.ws + WS_MOD); bf16* XN2 = (bf16*)(a.ws + WS_XN2);
    for (int m = GW; m < MX; m += NGW) {
        const int v = m / SEQ;
        norm_mod_row(a.out + (size_t)m * DM, a.in[I_N2G], mod + (size_t)v * NMOD + 3 * DM, mod + (size_t)v * NMOD + 4 * DM, XN2 + (size_t)m * DM, lane);
    }
    const int gt = blockIdx.x * 512 + TID, ngt = gridDim.x * 512;
    bf16* U16 = (bf16*)(a.ws + WS_U16); bf16* V16 = (bf16*)(a.ws + WS_V16); const float* pu = a.in[I_PU]; const float* pv = a.in[I_PV];
    for (int i = gt; i < 16384 * DM / 8; i += ngt) { float f[8]; ldf8(pu + (size_t)i * 8, f); st16(U16 + (size_t)i * 8, pack8(f)); ldf8(pv + (size_t)i * 8, f); st16(V16 + (size_t)i * 8, pack8(f)); }
}

__device__ __forceinline__ void ph_prep_rwkv(const Args& a) {
    const int lane = LANE;
    const bf16* P = (const bf16*)(a.ws + WS_P);
    bf16* R = (bf16*)(a.ws + WS_R); bf16* K = (bf16*)(a.ws + WS_K); bf16* V = (bf16*)(a.ws + WS_V); bf16* KK = (bf16*)(a.ws + WS_KK); bf16* ALR = (bf16*)(a.ws + WS_ALR);
    const float* mu = a.in[I_MU]; const float* k_k = a.in[I_KK];
    for (int m = GW; m < MT; m += NGW) {
        const bool lat = m < MX;
        bool h0, h1, h2 = false, h3 = false; size_t r0, r1, r2 = 0, r3 = 0;
        if (lat) { const int t = m & (SEQ - 1), row = t >> 6, col = t & 63; h0 = col > 0; h1 = col < 63; h2 = row > 0; h3 = row < 63; r0 = (size_t)(m - 1); r1 = (size_t)(m + 1); r2 = (size_t)(m - 64); r3 = (size_t)(m + 64); }
        else { const int t = (m - MX) & (CTXL - 1); h0 = t > 0; h1 = t < CTXL - 1; r0 = (size_t)(m - 1); r1 = (size_t)(m + 1); }
        const bf16* prow = P + (size_t)m * NINP;
#pragma unroll
        for (int i = 0; i < 14; ++i) {
            const int chunk = lane + 64 * i;
            if (chunk < RCOLS / 8) {
                const int c0 = chunk * 8;
                float own[8], n0[8], n1[8], sh[8], xm[8], muv[8];
                const uint4 z4 = make_uint4(0u, 0u, 0u, 0u);
                unpack8(ld16(prow + c0), own);
                unpack8(h0 ? ld16(P + r0 * NINP + c0) : z4, n0);
                unpack8(h1 ? ld16(P + r1 * NINP + c0) : z4, n1);
                if (lat) { float n2[8], n3[8];
                    unpack8(h2 ? ld16(P + r2 * NINP + c0) : z4, n2);
                    unpack8(h3 ? ld16(P + r3 * NINP + c0) : z4, n3);
#pragma unroll
                    for (int e = 0; e < 8; ++e) sh[e] = (e & 3) == 0 ? n0[e] : (e & 3) == 1 ? n1[e] : (e & 3) == 2 ? n2[e] : n3[e];
                } else {
#pragma unroll
                    for (int e = 0; e < 8; ++e) sh[e] = (e & 1) == 0 ? n0[e] : n1[e];
                }
                ldf8(mu + c0, muv);
#pragma unroll
                for (int e = 0; e < 8; ++e) xm[e] = own[e] + muv[e] * (sh[e] - own[e]);
                if (i < 4) st16(R + (size_t)m * RW + c0, pack8(xm));
                else if (i < 8) { const int cc = c0 - 2048; st16(K + (size_t)m * RW + cc, pack8(xm));
                    float kv[8], kkv[8]; ldf8(k_k + cc, kv); float ss = 0.f;
#pragma unroll
                    for (int e = 0; e < 8; ++e) { kkv[e] = xm[e] * kv[e]; ss += kkv[e] * kkv[e]; }
                    ss += __shfl_xor(ss, 1); ss += __shfl_xor(ss, 2); ss += __shfl_xor(ss, 4);
                    const float inv = rsqrtf(fmaxf(ss, 1e-24f));
#pragma unroll
                    for (int e = 0; e < 8; ++e) kkv[e] *= inv;
                    st16(KK + (size_t)m * RW + cc, pack8(kkv)); }
                else if (i < 12) st16(V + (size_t)m * RW + (c0 - 4096), pack8(xm));
                else { const int j0 = c0 - 6144; float f[8];
#pragma unroll
                    for (int e = 0; e < 8; ++e) f[e] = j0 < 192 ? tanhf(xm[e]) : (j0 < 384 ? xm[e] : 1.f / (1.f + __expf(-xm[e])));
                    st16(ALR + (size_t)m * KLR + j0, pack8(f)); }
            }
        }
    }
}

__device__ __forceinline__ void ph_prep_ssd(const Args& a) {
    const int lane = LANE;
    const bf16* P = (const bf16*)(a.ws + WS_P);
    bf16* XS = (bf16*)(a.ws + WS_XS); bf16* BC = (bf16*)(a.ws + WS_BC); bf16* Z = (bf16*)(a.ws + WS_Z); float* DT = (float*)(a.ws + WS_DT); float* LA = (float*)(a.ws + WS_LA);
    const float* cw = a.in[I_CONVW]; const float* cb = a.in[I_CONVB];
    for (int m = GW; m < MT; m += NGW) {
        const bool lat = m < MX; bool hp, hn;
        if (lat) { const int t = m & (SEQ - 1); hp = t > 0; hn = t < SEQ - 1; } else { const int t = (m - MX) & (CTXL - 1); hp = t > 0; hn = t < CTXL - 1; }
        const bf16* prow = P + (size_t)m * NINP;
#pragma unroll
        for (int i = 0; i < 8; ++i) {
            const int c0 = (lane + 64 * i) * 8; const uint4 z4 = make_uint4(0u, 0u, 0u, 0u);
            float cur[8], pv[8], nx[8], w0[8], w1[8], w2[8], bb[8], y[8];
            unpack8(ld16(prow + COL_XBC + c0), cur);
            unpack8(hp ? ld16(prow - NINP + COL_XBC + c0) : z4, pv);
            unpack8(hn ? ld16(prow + NINP + COL_XBC + c0) : z4, nx);
            ldf8(cw + c0, w0); ldf8(cw + 4096 + c0, w1); ldf8(cw + 8192 + c0, w2); ldf8(cb + c0, bb);
#pragma unroll
            for (int e = 0; e < 8; ++e) { const float t = w0[e] * pv[e] + w1[e] * cur[e] + w2[e] * nx[e] + bb[e]; y[e] = t / (1.f + __expf(-t)); }
            if (i < 4) st16(XS + (size_t)m * RW + c0, pack8(y)); else st16(BC + (size_t)m * RW + (c0 - 2048), pack8(y));
        }
        { const float raw = __uint_as_float((unsigned)prow[COL_DT + lane] << 16) + a.in[I_DTB][lane];
          const float dtv = raw > 20.f ? raw : log1pf(expf(raw));
          DT[(size_t)m * 64 + lane] = dtv; LA[(size_t)m * 64 + lane] = -dtv * expf(a.in[I_ALOG][lane]); }
        if (lat) {
#pragma unroll
            for (int i = 0; i < 4; ++i) { const int c0 = (lane + 64 * i) * 8; st16(Z + (size_t)m * RW + c0, ld16(prow + COL_Z + c0)); }
        }
    }
}

__device__ __forceinline__ int scan_row(int n, int dir, int b) { return n < CTXL ? MX + b * CTXL + (dir ? CTXL - 1 - n : n) : b * SEQ + (dir ? NSTEP - 1 - n : n - CTXL); }

struct RIn { uint4 r, k, kk, w, a; unsigned v; };
__device__ __forceinline__ void rwkv_load(RIn& x, const bf16* R, const bf16* K, const bf16* V, const bf16* KK, const bf16* LR, int m, int ch, int chi, int dir) {
    x.r = ld16(R + (size_t)m * RW + ch); x.k = ld16(K + (size_t)m * RW + ch); x.kk = ld16(KK + (size_t)m * RW + ch);
    x.w = ld16(LR + (size_t)m * NLR + dir * 2048 + ch); x.a = ld16(LR + (size_t)m * NLR + 4096 + dir * 2048 + ch);
    x.v = V[(size_t)m * RW + chi];
}
__device__ __forceinline__ float rwkv_step(float (&S)[8], const RIn& x, const float (&ka)[8]) {
    float r[8], k[8], kk[8], w1[8], av[8];
    unpack8(x.r, r); unpack8(x.k, k); unpack8(x.kk, kk); unpack8(x.w, w1); unpack8(x.a, av);
    const float v = __uint_as_float(x.v << 16);
    float sa = 0.f;
#pragma unroll
    for (int e = 0; e < 8; ++e) sa -= S[e] * kk[e];
    sa += __shfl_xor(sa, 1); sa += __shfl_xor(sa, 2); sa += __shfl_xor(sa, 4);
    float o = 0.f;
#pragma unroll
    for (int e = 0; e < 8; ++e) { const float kd = k[e] * (1.f + (av[e] - 1.f) * ka[e]); const float b = kk[e] * av[e];
        S[e] = S[e] * (1.f - w1[e]) + sa * b + v * kd; o += S[e] * r[e]; }
    o += __shfl_xor(o, 1); o += __shfl_xor(o, 2); o += __shfl_xor(o, 4);
    return o;
}
__device__ __forceinline__ void ph_rwkv_scan(const Args& a) {
    const int lane = LANE, wave = WAVE;
    const bf16* R = (const bf16*)(a.ws + WS_R); const bf16* K = (const bf16*)(a.ws + WS_K); const bf16* V = (const bf16*)(a.ws + WS_V); const bf16* KK = (const bf16*)(a.ws + WS_KK);
    const bf16* LR = (const bf16*)(a.ws + WS_LR); bf16* OR = (bf16*)a.out;
    for (int u = blockIdx.x; u < 256; u += gridDim.x) {
        const int g = u >> 5, h = u & 31, dir = g >> 2, b = g & 3;
        const int i = wave * 8 + (lane >> 3), jb = lane & 7, ch = h * 64 + jb * 8, chi = h * 64 + i;
        float ka[8]; ldf8(a.in[I_KA] + ch, ka);
        float S[8];
#pragma unroll
        for (int e = 0; e < 8; ++e) S[e] = 0.f;
        RIn A[4], B[4];
#pragma unroll
        for (int s = 0; s < 4; ++s) rwkv_load(A[s], R, K, V, KK, LR, scan_row(s, dir, b), ch, chi, dir);
        for (int n0 = 0; n0 < NSTEP; n0 += 8) {
#pragma unroll
            for (int s = 0; s < 4; ++s) rwkv_load(B[s], R, K, V, KK, LR, scan_row(n0 + 4 + s, dir, b), ch, chi, dir);
#pragma unroll
            for (int s = 0; s < 4; ++s) { const int n = n0 + s; const float o = rwkv_step(S, A[s], ka);
                if (n >= CTXL && jb == 0) OR[((size_t)dir * MX + scan_row(n, dir, b)) * RW + chi] = (bf16)f2bf(o); }
            if (n0 + 8 < NSTEP) {
#pragma unroll
                for (int s = 0; s < 4; ++s) rwkv_load(A[s], R, K, V, KK, LR, scan_row(n0 + 8 + s, dir, b), ch, chi, dir);
            }
#pragma unroll
            for (int s = 0; s < 4; ++s) { const int n = n0 + 4 + s; const float o = rwkv_step(S, B[s], ka);
                if (n >= CTXL && jb == 0) OR[((size_t)dir * MX + scan_row(n, dir, b)) * RW + chi] = (bf16)f2bf(o); }
        }
    }
}

struct SIn { uint4 b0, b1, c0, c1; unsigned xs; float dt, la; };
__device__ __forceinline__ void ssd_load(SIn& x, const bf16* XS, const bf16* BC, const float* DT, const float* LA, int m, int chx, int cb, int dh) {
    x.b0 = ld16(BC + (size_t)m * RW + cb); x.b1 = ld16(BC + (size_t)m * RW + cb + 8); x.c0 = ld16(BC + (size_t)m * RW + 1024 + cb); x.c1 = ld16(BC + (size_t)m * RW + 1024 + cb + 8);
    x.xs = XS[(size_t)m * RW + chx]; x.dt = DT[(size_t)m * 64 + dh]; x.la = LA[(size_t)m * 64 + dh];
}
__device__ __forceinline__ float ssd_step(float (&s)[16], const SIn& x) {
    float B0[8], B1[8], C0[8], C1[8]; unpack8(x.b0, B0); unpack8(x.b1, B1); unpack8(x.c0, C0); unpack8(x.c1, C1);
    const float dec = __expf(x.la), xdt = __uint_as_float(x.xs << 16) * x.dt; float y = 0.f;
#pragma unroll
    for (int e = 0; e < 8; ++e) { s[e] = dec * s[e] + xdt * B0[e]; y += s[e] * C0[e]; s[8 + e] = dec * s[8 + e] + xdt * B1[e]; y += s[8 + e] * C1[e]; }
    y += __shfl_xor(y, 1); y += __shfl_xor(y, 2); y += __shfl_xor(y, 4);
    return y;
}
__device__ __forceinline__ void ph_ssd_scan(const Args& a) {
    const int lane = LANE, wave = WAVE;
    const bf16* XS = (const bf16*)(a.ws + WS_XS); const bf16* BC = (const bf16*)(a.ws + WS_BC); const float* DT = (const float*)(a.ws + WS_DT); const float* LA = (const float*)(a.ws + WS_LA);
    bf16* YS = (bf16*)a.out + (size_t)2 * MX * RW;
    for (int u = blockIdx.x; u < 256; u += gridDim.x) {
        const int g = u >> 5, h = u & 31, dir = g >> 2, b = g & 3;
        const int p = wave * 8 + (lane >> 3), nb = lane & 7, chx = h * 64 + p, cb = (h >> 2) * 128 + nb * 16, dh = dir * 32 + h;
        float s[16];
#pragma unroll
        for (int e = 0; e < 16; ++e) s[e] = 0.f;
        SIn A[4], B[4];
#pragma unroll
        for (int q = 0; q < 4; ++q) ssd_load(A[q], XS, BC, DT, LA, scan_row(q, dir, b), chx, cb, dh);
        for (int n0 = 0; n0 < NSTEP; n0 += 8) {
#pragma unroll
            for (int q = 0; q < 4; ++q) ssd_load(B[q], XS, BC, DT, LA, scan_row(n0 + 4 + q, dir, b), chx, cb, dh);
#pragma unroll
            for (int q = 0; q < 4; ++q) { const int n = n0 + q; const float y = ssd_step(s, A[q]);
                if (n >= CTXL && nb == 0) YS[((size_t)dir * MX + scan_row(n, dir, b)) * RW + chx] = (bf16)f2bf(y); }
            if (n0 + 8 < NSTEP) {
#pragma unroll
                for (int q = 0; q < 4; ++q) ssd_load(A[q], XS, BC, DT, LA, scan_row(n0 + 8 + q, dir, b), chx, cb, dh);
            }
#pragma unroll
            for (int q = 0; q < 4; ++q) { const int n = n0 + 4 + q; const float y = ssd_step(s, B[q]);
                if (n >= CTXL && nb == 0) YS[((size_t)dir * MX + scan_row(n, dir, b)) * RW + chx] = (bf16)f2bf(y); }
        }
    }
}

__device__ __forceinline__ void ph_finish(const Args& a) {
    const int lane = LANE;
    const bf16* R = (const bf16*)(a.ws + WS_R); const bf16* K = (const bf16*)(a.ws + WS_K); const bf16* V = (const bf16*)(a.ws + WS_V);
    const bf16* LR = (const bf16*)(a.ws + WS_LR); const bf16* XS = (const bf16*)(a.ws + WS_XS); const bf16* Z = (const bf16*)(a.ws + WS_Z);
    const bf16* OR = (const bf16*)a.out; const bf16* YS = (const bf16*)a.out + (size_t)2 * MX * RW;
    bf16* A2 = (bf16*)(a.ws + WS_A2);
    for (int m = GW; m < MX; m += NGW) {
#pragma unroll
        for (int i = 0; i < 4; ++i) {
            const int c0 = (lane + 64 * i) * 8;
            float of[8], ob[8], o[8], res[8];
#if MK_SKIP_RWKV
#pragma unroll
            for (int e = 0; e < 8; ++e) res[e] = 0.f;
#else
            unpack8(ld16(OR + (size_t)m * RW + c0), of); unpack8(ld16(OR + ((size_t)MX + m) * RW + c0), ob);
            float sm = 0.f;
#pragma unroll
            for (int e = 0; e < 8; ++e) { o[e] = of[e] + ob[e]; sm += o[e]; }
            sm += __shfl_xor(sm, 1); sm += __shfl_xor(sm, 2); sm += __shfl_xor(sm, 4);
            const float mean = sm * (1.f / 64.f); float sq = 0.f;
#pragma unroll
            for (int e = 0; e < 8; ++e) { o[e] -= mean; sq += o[e] * o[e]; }
            sq += __shfl_xor(sq, 1); sq += __shfl_xor(sq, 2); sq += __shfl_xor(sq, 4);
            const float rstd = rsqrtf(sq * (1.f / 64.f) + GN_EPS);
            float lw[8], lb[8], r[8], k[8], v[8], a0[8], a1[8], ka[8], rk[8], gg[8];
            ldf8(a.in[I_LNW] + c0, lw); ldf8(a.in[I_LNB] + c0, lb); ldf8(a.in[I_KA] + c0, ka); ldf8(a.in[I_RK] + c0, rk);
            unpack8(ld16(R + (size_t)m * RW + c0), r); unpack8(ld16(K + (size_t)m * RW + c0), k); unpack8(ld16(V + (size_t)m * RW + c0), v);
            unpack8(ld16(LR + (size_t)m * NLR + 4096 + c0), a0); unpack8(ld16(LR + (size_t)m * NLR + 6144 + c0), a1); unpack8(ld16(LR + (size_t)m * NLR + 8192 + c0), gg);
            float bs = 0.f;
#pragma unroll
            for (int e = 0; e < 8; ++e) { const float kd = k[e] * (2.f + (a0[e] + a1[e] - 2.f) * ka[e]); bs += r[e] * kd * rk[e]; }
            bs += __shfl_xor(bs, 1); bs += __shfl_xor(bs, 2); bs += __shfl_xor(bs, 4);
#pragma unroll
            for (int e = 0; e < 8; ++e) res[e] = (o[e] * rstd * lw[e] + lb[e] + bs * v[e]) * gg[e];
#endif
            st16(A2 + (size_t)m * DM + c0, pack8(res));
        }
#pragma unroll
        for (int i = 0; i < 4; ++i) {
            const int c0 = (lane + 64 * i) * 8;
            float yf[8], yb[8], xs[8], z[8], nw[8], y[8];
#if MK_SKIP_SSD
#pragma unroll
            for (int e = 0; e < 8; ++e) y[e] = 0.f;
#else
            unpack8(ld16(YS + (size_t)m * RW + c0), yf); unpack8(ld16(YS + ((size_t)MX + m) * RW + c0), yb);
            unpack8(ld16(XS + (size_t)m * RW + c0), xs); unpack8(ld16(Z + (size_t)m * RW + c0), z); ldf8(a.in[I_NORMW] + c0, nw);
            const float dsk = a.in[I_SSMD][c0 >> 6]; float ss = 0.f;
#pragma unroll
            for (int e = 0; e < 8; ++e) { y[e] = (yf[e] + yb[e] + dsk * xs[e]) * (z[e] / (1.f + __expf(-z[e]))); ss += y[e] * y[e]; }
            ss += __shfl_xor(ss, 1); ss += __shfl_xor(ss, 2); ss += __shfl_xor(ss, 4); ss += __shfl_xor(ss, 8); ss += __shfl_xor(ss, 16);
            const float rstd = rsqrtf(ss * (1.f / 256.f) + RMS_EPS);
#pragma unroll
            for (int e = 0; e < 8; ++e) y[e] = y[e] * rstd * nw[e];
#endif
            st16(A2 + (size_t)m * DM + 2048 + c0, pack8(y));
        }
    }
}

__device__ __forceinline__ float enc_key(float v, int idx) { return __uint_as_float((__float_as_uint(v) & 0xffffff00u) | (unsigned)idx); }
__device__ __forceinline__ void ph_peer(const Args& a) {
    const int lane = LANE;
    const float* mod = (const float*)(a.ws + WS_MOD); const float* S = (const float*)(a.ws + WS_S);
    const bf16* U16 = (const bf16*)(a.ws + WS_U16); const bf16* V16 = (const bf16*)(a.ws + WS_V16);
    for (int m = GW; m < MX; m += NGW) {
        const int bb = m / SEQ;
        float* hrow = a.out + (size_t)m * DM;
        int l8 = lane * 8; asm volatile("" : "+v"(l8));
        float acc[8][8];
#if MK_SKIP_PEER
#pragma unroll
        for (int j = 0; j < 8; ++j)
#pragma unroll
            for (int e = 0; e < 8; ++e) acc[j][e] = 0.f;
#else
        float xn[8][8];
        { float ss = 0.f; float hv[8][8];
#pragma unroll
          for (int j = 0; j < 8; ++j) ldf8(hrow + 512 * j + l8, hv[j]);
#pragma unroll
          for (int j = 0; j < 8; ++j)
#pragma unroll
              for (int e = 0; e < 8; ++e) ss += hv[j][e] * hv[j][e];
          const float rstd = rsqrtf(wave_sum(ss) * (1.f / DM) + RMS_EPS);
          const float* sh2 = mod + (size_t)bb * NMOD + 3 * DM; const float* sc2 = mod + (size_t)bb * NMOD + 4 * DM; const float* g2 = a.in[I_N2G];
#pragma unroll
          for (int j = 0; j < 8; ++j) { float gg[8], s0[8], s1[8]; const int c = 512 * j + l8; ldf8(g2 + c, gg); ldf8(sh2 + c, s0); ldf8(sc2 + c, s1);
#pragma unroll
              for (int e = 0; e < 8; ++e) xn[j][e] = hv[j][e] * rstd * gg[e] * (1.f + s1[e]) + s0[e];
              PIN8(xn[j]); asm volatile("" ::: "memory"); } }
        int eid0 = 0, eid1 = 0; float gt0 = 0.f, gt1 = 0.f;
        const float NEG = -3.0e38f;
#pragma unroll 1
        for (int hd = 0; hd < 8; ++hd) {
            const float* srow = S + (size_t)m * 2048 + hd * 256;
            float c1a = enc_key(srow[lane], lane), c1b = enc_key(srow[64 + lane], 64 + lane), c2a = enc_key(srow[128 + lane], lane), c2b = enc_key(srow[192 + lane], 64 + lane);
            float t1 = NEG, t2 = NEG;
#pragma unroll 1
            for (int k = 0; k < 16; ++k) {
                const float m1 = wave_max(fmaxf(c1a, c1b)), m2 = wave_max(fmaxf(c2a, c2b));
                if (c1a == m1) c1a = NEG; if (c1b == m1) c1b = NEG; if (c2a == m2) c2a = NEG; if (c2b == m2) c2b = NEG;
                if (lane == k) { t1 = m1; t2 = m2; }
            }
            const float v1 = __uint_as_float(__float_as_uint(t1) & 0xffffff00u), v2 = __uint_as_float(__float_as_uint(t2) & 0xffffff00u);
            const int i1 = (int)(__float_as_uint(t1) & 0xffu), i2 = (int)(__float_as_uint(t2) & 0xffu);
            float cd[4];
#pragma unroll
            for (int e = 0; e < 4; ++e) { const float va = __shfl(v1, (lane >> 4) + 4 * e), vb = __shfl(v2, lane & 15); cd[e] = enc_key(va + vb, lane + 64 * e); }
            float best = NEG; int ex = 0;
#pragma unroll 1
            for (int k = 0; k < 16; ++k) {
                const float mx = wave_max(fmaxf(fmaxf(cd[0], cd[1]), fmaxf(cd[2], cd[3])));
#pragma unroll
                for (int e = 0; e < 4; ++e) if (cd[e] == mx) cd[e] = NEG;
                const int cidx = (int)(__float_as_uint(mx) & 0xffu);
                const int ea = __shfl(i1, cidx >> 4), eb = __shfl(i2, cidx & 15);
                if (lane == k) { best = __uint_as_float(__float_as_uint(mx) & 0xffffff00u); ex = ea * 128 + eb; }
            }
            const float bmax = __shfl(best, 0);
            const float pe = lane < 16 ? __expf(best - bmax) : 0.f;
            const float gate = pe / wave_sum(pe);
            const float gsh = __shfl(gate, lane & 15); const int esh = __shfl(ex, lane & 15);
            if ((lane >> 4) == (hd & 3)) { if (hd < 4) { gt0 = gsh; eid0 = esh; } else { gt1 = gsh; eid1 = esh; } }
        }
        float cf0 = 0.f, cf1 = 0.f;
#pragma unroll 1
        for (int p = 0; p < 128; ++p) {
            const int e = __builtin_amdgcn_readlane(p < 64 ? eid0 : eid1, p & 63);
            const bf16* urow = U16 + (size_t)e * DM + l8;
            float d = 0.f;
#pragma unroll
            for (int j = 0; j < 8; ++j) { float f[8]; unpack8(ld16(urow + 512 * j), f);
#pragma unroll
                for (int q = 0; q < 8; ++q) d += xn[j][q] * f[q]; }
            d = wave_sum(d);
            const float act = 0.5f * d * (1.f + erff(d * 0.70710678f));
            if (lane == (p & 63)) { if (p < 64) cf0 = gt0 * act; else cf1 = gt1 * act; }
        }
#pragma unroll
        for (int j = 0; j < 8; ++j)
#pragma unroll
            for (int e = 0; e < 8; ++e) acc[j][e] = 0.f;
#pragma unroll 1
        for (int p = 0; p < 128; ++p) {
            const int e = __builtin_amdgcn_readlane(p < 64 ? eid0 : eid1, p & 63);
            const float cf = __uint_as_float(__builtin_amdgcn_readlane(__float_as_uint(p < 64 ? cf0 : cf1), p & 63));
            const bf16* vrow = V16 + (size_t)e * DM + l8;
#pragma unroll
            for (int j = 0; j < 8; ++j) { float f[8]; unpack8(ld16(vrow + 512 * j), f);
#pragma unroll
                for (int q = 0; q < 8; ++q) acc[j][q] += cf * f[q]; }
        }
#endif
        { const float* gt2 = mod + (size_t)bb * NMOD + 5 * DM; float ss = 0.f;
#pragma unroll
          for (int j = 0; j < 8; ++j) { float g[8], hvj[8]; ldf8(gt2 + 512 * j + l8, g); ldf8(hrow + 512 * j + l8, hvj);
#pragma unroll
              for (int e = 0; e < 8; ++e) { acc[j][e] = hvj[e] + g[e] * acc[j][e]; ss += acc[j][e] * acc[j][e]; }
              PIN8(acc[j]); asm volatile("" ::: "memory"); }
          const float rstd = rsqrtf(wave_sum(ss) * (1.f / DM) + RMS_EPS);
#pragma unroll
          for (int j = 0; j < 8; ++j) { float fg[8]; const int c = 512 * j + l8; ldf8(a.in[I_FG] + c, fg);
              *(float4*)(hrow + c) = make_float4(acc[j][0] * rstd * fg[0], acc[j][1] * rstd * fg[1], acc[j][2] * rstd * fg[2], acc[j][3] * rstd * fg[3]);
              *(float4*)(hrow + c + 4) = make_float4(acc[j][4] * rstd * fg[4], acc[j][5] * rstd * fg[5], acc[j][6] * rstd * fg[6], acc[j][7] * rstd * fg[7]);
              asm volatile("" ::: "memory"); } }
    }
}

constexpr int N_PHASES = 13;
__global__ void __launch_bounds__(512, 2) hybrid_fwd(Args args) {
    extern __shared__ __attribute__((aligned(16))) unsigned char lds_raw[];
    LAS unsigned char* lds = (LAS unsigned char*)lds_raw;
    volatile LAS unsigned* MISC = (volatile LAS unsigned*)(lds + LDS_MISC);
    for (int u = TID; u < (LDS_BYTES - 131072) / 4; u += 512) ((LAS unsigned*)(lds + 131072))[u] = 0u;
    __syncthreads();
    const int lo = args.ph_lo, hi = args.ph_hi;
    XcdBarrier bar; bar.bar = (unsigned*)(args.ws + WS_CTL); bar.x = 0; bar.st = nullptr;
    if (hi - lo > 1) bar = xcd_barrier_post((unsigned*)(args.ws + WS_CTL), MISC + 8);
#define IN(k) (lo <= (k) && (k) < hi && ((MK_PHASE_MASK >> (k)) & 1))
#define SEAM(k) do { if (IN(k) && IN((k) + 1)) xcd_barrier(bar); } while (0)
    const int bid = (int)blockIdx.x, G = (int)gridDim.x;

    if (IN(0)) { ph_mod(args, lds); ph_conv(args, lds); }
    SEAM(0);
    if (IN(1)) ph_norm1(args);
    SEAM(1);
    if (IN(2)) { pg8::Gemm g{(const bf16*)(args.ws + WS_A1), (const bf16*)(args.ws + WS_WT_IN), MT, NINP, DM}; pg8::StaticOrder S; S.init(MT, NINP, G, bid);
        pg8::EpiBf16<0> E{(bf16*)(args.ws + WS_P), NINP, nullptr, 0, 0}; pg8::gemm_phase<pg8::EpiBf16<0>, pg8::StaticOrder>(lds, g, S, E, nullptr); }
    SEAM(2);
    if (IN(3)) { ph_prep_rwkv(args); ph_prep_ssd(args); }
    SEAM(3);
    if (IN(4)) { pg8::Gemm g{(const bf16*)(args.ws + WS_ALR), (const bf16*)(args.ws + WS_WLR), MT, NLR, KLR}; pg8::StaticOrder S; S.init(MT, NLR, G, bid);
        EpiLR E{(bf16*)(args.ws + WS_LR), args.in[I_W0], args.in[I_A0]}; pg8::gemm_phase<EpiLR, pg8::StaticOrder>(lds, g, S, E, nullptr); }
    SEAM(4);
    if (IN(5)) ph_rwkv_scan(args);
    SEAM(5);
    if (IN(6)) ph_ssd_scan(args);
    SEAM(6);
    if (IN(7)) ph_finish(args);
    SEAM(7);
    if (IN(8)) { pg8::Gemm g{(const bf16*)(args.ws + WS_A2), (const bf16*)(args.ws + WS_WT_OUT), MX, DM, DM}; pg8::StaticOrder S; S.init(MX, DM, G, bid);
        EpiRes E{args.out, args.in[I_X], (const float*)(args.ws + WS_MOD)}; pg8::gemm_phase<EpiRes, pg8::StaticOrder>(lds, g, S, E, nullptr); }
    SEAM(8);
    if (IN(9)) ph_norm2(args);
    SEAM(9);
    if (IN(10)) { pg8::Gemm g{(const bf16*)(args.ws + WS_XN2), (const bf16*)(args.ws + WS_WT_Q), MX, 2048, DM}; pg8::StaticOrder S; S.init(MX, 2048, G, bid);
        pg8::EpiBf16<0> E{(bf16*)(args.ws + WS_Q), 2048, nullptr, 0, 0}; pg8::gemm_phase<pg8::EpiBf16<0>, pg8::StaticOrder>(lds, g, S, E, nullptr); }
    SEAM(10);
    if (IN(11)) { pg8::Gemm g{(const bf16*)(args.ws + WS_Q), (const bf16*)(args.ws + WS_KBD), MX, 2048, 2048}; pg8::StaticOrder S; S.init(MX, 2048, G, bid);
        pg8::EpiF32 E{(float*)(args.ws + WS_S), 2048, nullptr}; pg8::gemm_phase<pg8::EpiF32, pg8::StaticOrder>(lds, g, S, E, nullptr); }
    SEAM(11);
    if (IN(12)) ph_peer(args);
#undef IN
#undef SEAM
}

extern "C" void kernel_launch(void* const* d_in, const int* in_sizes, int n_in, void* d_out, int out_size, void* d_ws, size_t ws_size, hipStream_t stream) {
    static int grid = 0;
    if (grid == 0) {
        if (n_in != N_IN || out_size != MX * DM || ws_size < WS_END) { fprintf(stderr, "kernel_launch: unexpected shapes (n_in %d out %d ws %zu)\n", n_in, out_size, ws_size); grid = -1; return; }
        int dev = 0, cus = 0, per_cu = 0;
        if (hipGetDevice(&dev) != hipSuccess || hipDeviceGetAttribute(&cus, hipDeviceAttributeMultiprocessorCount, dev) != hipSuccess) { grid = -1; return; }
        if (hipFuncSetAttribute((const void*)hybrid_fwd, hipFuncAttributeMaxDynamicSharedMemorySize, LDS_BYTES) != hipSuccess) { fprintf(stderr, "kernel_launch: hipFuncSetAttribute failed\n"); grid = -1; return; }
        if (hipOccupancyMaxActiveBlocksPerMultiprocessor(&per_cu, (const void*)hybrid_fwd, 512, LDS_BYTES) != hipSuccess || per_cu < 1) fprintf(stderr, "kernel_launch: occupancy query reports %d\n", per_cu);
        (void)hipGetLastError();
        grid = cus;
    }
    if (grid < 0) return;
    (void)in_sizes;
    if (hipMemsetAsync((char*)d_ws + WS_CTL, 0, CTL_ZERO_BYTES, stream) != hipSuccess) return;
    Args a{};
    for (int i = 0; i < N_IN; ++i) a.in[i] = (const float*)d_in[i];
    a.out = (float*)d_out; a.ws = (unsigned char*)d_ws;
#if MK_N_LAUNCHES == 1
    a.ph_lo = 0; a.ph_hi = N_PHASES;
    hipLaunchKernelGGL(hybrid_fwd, dim3(grid), dim3(512), LDS_BYTES, stream, a);
#else
    for (int ph = 0; ph < N_PHASES; ++ph) { if (!((MK_PHASE_MASK >> ph) & 1)) continue; a.ph_lo = ph; a.ph_hi = ph + 1; hipLaunchKernelGGL(hybrid_fwd, dim3(grid), dim3(512), LDS_BYTES, stream, a); }
#endif
}
```

```cpp
#include <hip/hip_runtime.h>
#include <stdint.h>
#include <stdio.h>
namespace pg8 {
#define PG8_LAS __attribute__((address_space(3)))
typedef unsigned short bf16_t;
typedef short bf16x8 __attribute__((ext_vector_type(8)));
typedef float f32x4 __attribute__((ext_vector_type(4)));
typedef unsigned u32x4 __attribute__((ext_vector_type(4)));
constexpr int BM = 256, BK = 64, HALF = 128, HTB = HALF * BK * 2  , STAGE_BYTES = 8 * HTB, NXCD = 8, WGM = 8;

__host__ __device__ __forceinline__ int lds_byte(int r, int c) { const int st = (r >> 4) * 2 + (c >> 5), rr = r & 15, cc = c & 31, ob = rr * 64 + cc * 2; return st * 1024 + (ob ^ (((ob >> 9) & 1) << 5)); }
__host__ __device__ __forceinline__ void stage_rc(int b, int& R, int& C) { const int st = b / 1024, sb = b % 1024, swz = sb ^ (((sb >> 9) & 1) << 5); R = (st >> 1) * 16 + swz / 64; C = (st & 1) * 32 + (swz % 64) / 2; }
__host__ __device__ __forceinline__ int perm32(int rho) { const int n = rho >> 4, i = rho & 15; return 8 * (i >> 2) + 4 * n + (i & 3); }

struct Unit { int pm, pn; };
struct Gemm { const bf16_t* A; const bf16_t* Bt; int M, N, K; };

struct StaticOrder {
    int nM, nN, nwg, G, c;
    __host__ __device__ void init(int M, int N, int G_, int c_) { nM = M / BM; nN = N / BM; nwg = nM * nN; G = G_; c = c_; }
    __host__ __device__ bool next(int i, Unit& u) const {
        const long L = (long)i * G + c; if (L >= nwg) return false;
        int wgid = (int)L; { const int q = nwg / NXCD, r = nwg % NXCD, xcd = wgid % NXCD, off = wgid / NXCD; wgid = (xcd < r ? xcd * (q + 1) : r * (q + 1) + (xcd - r) * q) + off; }
        const int nig = WGM * nN, gid = wgid / nig, fm = gid * WGM, gsz = (nM - fm) < WGM ? (nM - fm) : WGM;
        u.pm = fm + ((wgid % nig) % gsz); u.pn = (wgid % nig) / gsz; return true;
    }
    __device__ __forceinline__ void a_ready(const Unit&) const {}
    __device__ __forceinline__ void done(const Unit&) const {}
};
__device__ __forceinline__ unsigned cvt_pk_bf16(float lo, float hi) { unsigned r; asm volatile("v_cvt_pk_bf16_f32 %0, %1, %2" : "=v"(r) : "v"(lo), "v"(hi)); return r; }
typedef float f32x2 __attribute__((ext_vector_type(2)));
__device__ __forceinline__ f32x2 gelu_pk(f32x2 v) {
    const f32x2 av = __builtin_elementwise_abs(v), d = av * 0.2316418882f + 1.0f;
    f32x2 t; t.x = __builtin_amdgcn_rcpf(d.x); t.y = __builtin_amdgcn_rcpf(d.y);
    f32x2 q = t * 0.5307027145f + (-0.7265760135f); q = q * t + 0.7107068705f; q = q * t + (-0.142248368f); q = q * t + 0.127414796f; q = q * t;
    const f32x2 s = (v * v) * (-0.72134752044f);
    f32x2 e; e.x = __builtin_amdgcn_exp2f(s.x); e.y = __builtin_amdgcn_exp2f(s.y);
    const f32x2 m = v * (q * e), r = v - m;
    f32x2 o; o.x = v.x < 0.f ? m.x : r.x; o.y = v.y < 0.f ? m.y : r.y; return o;
}

struct EpiF32 {
    static constexpr bool PERM = false, AFTER_DRAIN = false;
    float* C; int ldc; const float* bias;
    __device__ __forceinline__ void operator()(const f32x4 (&acc)[2][2][4][2], const Unit& u, int wr, int wc, int fr, int fq) const {
        const int row0 = u.pm * BM + wr * 64 + fr, col0 = u.pn * BM + wc * 32 + 4 * fq;
        f32x4 bv[2][2];
#pragma unroll
        for (int bj = 0; bj < 2; ++bj)
#pragma unroll
            for (int n = 0; n < 2; ++n) bv[bj][n] = bias ? *(const f32x4*)(bias + col0 + bj * HALF + n * 16) : (f32x4){0.f, 0.f, 0.f, 0.f};
#pragma unroll
        for (int ai = 0; ai < 2; ++ai)
#pragma unroll
            for (int m = 0; m < 4; ++m) { float* rowp = C + (size_t)(row0 + ai * HALF + m * 16) * ldc + col0;
#pragma unroll
                for (int bj = 0; bj < 2; ++bj)
#pragma unroll
                    for (int n = 0; n < 2; ++n) *(f32x4*)(rowp + bj * HALF + n * 16) = acc[ai][bj][m][n] + bv[bj][n]; }
    }
};
template <int ACT  > struct EpiBf16 {
    static constexpr bool PERM = true, AFTER_DRAIN = false;
    bf16_t* O; int ldc; const float* bias; int split_cols; size_t split_stride;
    __device__ __forceinline__ void operator()(const f32x4 (&acc)[2][2][4][2], const Unit& u, int wr, int wc, int fr, int fq) const {
        const int row0 = u.pm * BM + wr * 64 + fr; int colt = u.pn * BM; bf16_t* base = O;
        if (split_cols) { const int t = colt / split_cols; base += (size_t)t * split_stride; colt -= t * split_cols; }
        const int col0 = colt + wc * 32 + 8 * fq, bcol0 = u.pn * BM + wc * 32 + 8 * fq;
        f32x4 bv[2][2];
#pragma unroll
        for (int bj = 0; bj < 2; ++bj)
#pragma unroll
            for (int n = 0; n < 2; ++n) bv[bj][n] = bias ? *(const f32x4*)(bias + bcol0 + bj * HALF + 4 * n) : (f32x4){0.f, 0.f, 0.f, 0.f};
#pragma unroll
        for (int ai = 0; ai < 2; ++ai)
#pragma unroll
            for (int m = 0; m < 4; ++m) { bf16_t* rowp = base + (size_t)(row0 + ai * HALF + m * 16) * ldc + col0;
#pragma unroll
                for (int bj = 0; bj < 2; ++bj) { f32x4 v0 = acc[ai][bj][m][0] + bv[bj][0], v1 = acc[ai][bj][m][1] + bv[bj][1];
                    if (ACT == 1) { f32x2 a = gelu_pk((f32x2){v0[0], v0[1]}), b = gelu_pk((f32x2){v0[2], v0[3]}), c = gelu_pk((f32x2){v1[0], v1[1]}), d = gelu_pk((f32x2){v1[2], v1[3]});
                        v0 = (f32x4){a.x, a.y, b.x, b.y}; v1 = (f32x4){c.x, c.y, d.x, d.y}; }
                    if (ACT == 2) {
#pragma unroll
                        for (int j = 0; j < 4; ++j) { v0[j] = 0.5f * v0[j] * (1.0f + erff(v0[j] * 0.70710678f)); v1[j] = 0.5f * v1[j] * (1.0f + erff(v1[j] * 0.70710678f)); } }
                    u32x4 w; w.x = cvt_pk_bf16(v0[0], v0[1]); w.y = cvt_pk_bf16(v0[2], v0[3]); w.z = cvt_pk_bf16(v1[0], v1[1]); w.w = cvt_pk_bf16(v1[2], v1[3]);
                    *(u32x4*)(rowp + bj * HALF) = w; } }
    }
};
template <class Epi, class Sched, bool STAMP = false>
__device__ __forceinline__ void gemm_phase(PG8_LAS unsigned char* lds, const Gemm g, const Sched& S, const Epi& E, unsigned long long* stamps) {
    const int tid = threadIdx.x, wid = __builtin_amdgcn_readfirstlane(tid >> 6), lane = tid & 63, wr = wid >> 2, wc = wid & 3, fr = lane & 15, fq = lane >> 4;
    const int K = g.K, nt = K / BK;
    int ts_lo = 0, ts_hi = 0, nts = 0; const unsigned long long rt_entry = STAMP ? (unsigned long long)wall_clock64() : 0ull;
#define PG8_STAMP() do { if (STAMP && wid == 0 && nts < 64) { const unsigned long long _c = (unsigned long long)clock64(); \
        ts_lo = (lane == nts) ? (int)(unsigned)_c : ts_lo; ts_hi = (lane == nts) ? (int)(unsigned)(_c >> 32) : ts_hi; ++nts; } } while (0)
    PG8_STAMP();
    unsigned voffA[2], voffB[2];
#pragma unroll
    for (int i = 0; i < 2; ++i) { int R, C; stage_rc(tid * 16 + i * 8192, R, C); const int Rb = Epi::PERM ? ((R & ~31) + perm32(R & 31)) : R;
        voffA[i] = (unsigned)(R * K + C) * 2u; voffB[i] = (unsigned)(Rb * K + C) * 2u; }
    const size_t kstep = (size_t)(BK * 2);
    const size_t hstep = (size_t)HALF * K * 2;
    const size_t tstep = 2 * hstep;
    const unsigned ldsw = (unsigned)wid * 1024u;
    const int aoff = lds_byte(wr * 64 + fr, fq * 8), boff = lds_byte(wc * 32 + fr, fq * 8);
#define PG8_SA(b, h) (((b) * 2 + (h)) * HTB)
#define PG8_SB(b, h) ((4 + (b) * 2 + (h)) * HTB)
#define PG8_STAGE(bufoff, gbase, voff) do { _Pragma("unroll") for (int _i = 0; _i < 2; ++_i) \
        __builtin_amdgcn_global_load_lds((const unsigned*)((const char*)(gbase) + (voff)[_i]), (PG8_LAS unsigned*)(lds + (bufoff) + ldsw + _i * 8192), 16, 0, 0); } while (0)
#define PG8_LDA(dst, b, h) do { _Pragma("unroll") for (int m = 0; m < 4; ++m) _Pragma("unroll") for (int k = 0; k < 2; ++k) dst[m][k] = *(const PG8_LAS bf16x8*)(lds + PG8_SA(b, h) + aoff + m * 2048 + k * 1024); } while (0)
#define PG8_LDB(dst, b, h) do { _Pragma("unroll") for (int n = 0; n < 2; ++n) _Pragma("unroll") for (int k = 0; k < 2; ++k) dst[n][k] = *(const PG8_LAS bf16x8*)(lds + PG8_SB(b, h) + boff + n * 2048 + k * 1024); } while (0)
#define PG8_MMA(ai, bj, At, Bt) do { __builtin_amdgcn_s_setprio(1); _Pragma("unroll") for (int m = 0; m < 4; ++m) _Pragma("unroll") for (int n = 0; n < 2; ++n) _Pragma("unroll") for (int k = 0; k < 2; ++k) \
        acc[ai][bj][m][n] = __builtin_amdgcn_mfma_f32_16x16x32_bf16(Bt[n][k], At[m][k], acc[ai][bj][m][n], 0, 0, 0); __builtin_amdgcn_s_setprio(0); } while (0)
#define PG8_WAIT_V(n) asm volatile("s_waitcnt vmcnt(" #n ")" ::: "memory")
#define PG8_WAIT_L(n) asm volatile("s_waitcnt lgkmcnt(" #n ")" ::: "memory")
#define PG8_BAR __builtin_amdgcn_s_barrier()
#define PG8_SCHED __builtin_amdgcn_sched_barrier(0)
    Unit cur, nxt; int ui = 0;
    if (!S.next(0, cur)) return;
    f32x4 acc[2][2][4][2];
#pragma unroll
    for (int a = 0; a < 2; ++a)
#pragma unroll
        for (int b = 0; b < 2; ++b)
#pragma unroll
            for (int m = 0; m < 4; ++m)
#pragma unroll
                for (int n = 0; n < 2; ++n) acc[a][b][m][n] = (f32x4){0.f, 0.f, 0.f, 0.f};
    bf16x8 At[4][2], B0[2][2], B1[2][2];
    const char* cA = (const char*)g.A + (size_t)cur.pm * tstep; const char* cB = (const char*)g.Bt + (size_t)cur.pn * tstep;
    S.a_ready(cur);
    PG8_STAGE(PG8_SB(0, 0), cB, voffB); PG8_STAGE(PG8_SA(0, 0), cA, voffA); PG8_STAGE(PG8_SB(0, 1), cB + hstep, voffB); PG8_STAGE(PG8_SA(0, 1), cA + hstep, voffA);
    if (wr == 1) PG8_BAR;
    PG8_WAIT_V(4); PG8_BAR;
    PG8_STAGE(PG8_SB(1, 0), cB + kstep, voffB); PG8_STAGE(PG8_SA(1, 0), cA + kstep, voffA); PG8_STAGE(PG8_SB(1, 1), cB + hstep + kstep, voffB);
    PG8_WAIT_V(6); PG8_BAR;
    PG8_STAMP();
    for (;;) {
        const bool has_next = S.next(ui + 1, nxt);
        const char* nA = has_next ? (const char*)g.A + (size_t)nxt.pm * tstep : cA; const char* nB = has_next ? (const char*)g.Bt + (size_t)nxt.pn * tstep : cB;
        for (int t = 0; t < nt; t += 2) {
            const bool last = (t == nt - 2);
            const char* a1 = cA + (size_t)(t + 1) * kstep;
            const char* a2 = last ? nA : cA + (size_t)(t + 2) * kstep; const char* b2 = last ? nB : cB + (size_t)(t + 2) * kstep;
            const char* a3 = a2 + kstep; const char* b3 = b2 + kstep;
            if (last && has_next) S.a_ready(nxt);
            PG8_LDB(B0, 0, 0); PG8_SCHED; PG8_LDA(At, 0, 0); PG8_STAGE(PG8_SA(1, 1), a1 + hstep, voffA);
            PG8_WAIT_L(8); PG8_BAR; PG8_WAIT_L(0); PG8_MMA(0, 0, At, B0); PG8_BAR; PG8_SCHED;
            PG8_LDB(B1, 0, 1); PG8_STAGE(PG8_SB(0, 0), b2, voffB);
            PG8_BAR; PG8_WAIT_L(0); PG8_MMA(0, 1, At, B1); PG8_BAR;
            PG8_LDA(At, 0, 1); PG8_STAGE(PG8_SA(0, 0), a2, voffA);
            PG8_BAR; PG8_WAIT_L(0); PG8_MMA(1, 0, At, B0); PG8_BAR; PG8_SCHED;
            PG8_STAGE(PG8_SB(0, 1), b2 + hstep, voffB);
            PG8_WAIT_V(6); PG8_BAR; PG8_MMA(1, 1, At, B1); PG8_BAR;
            PG8_LDB(B0, 1, 0); PG8_SCHED; PG8_LDA(At, 1, 0); PG8_STAGE(PG8_SA(0, 1), a2 + hstep, voffA);
            PG8_WAIT_L(8); PG8_BAR; PG8_WAIT_L(0); PG8_MMA(0, 0, At, B0); PG8_BAR; PG8_SCHED;
            PG8_LDB(B1, 1, 1); PG8_STAGE(PG8_SB(1, 0), b3, voffB);
            PG8_BAR; PG8_WAIT_L(0); PG8_MMA(0, 1, At, B1); PG8_BAR;
            PG8_LDA(At, 1, 1); PG8_STAGE(PG8_SA(1, 0), a3, voffA);
            PG8_BAR; PG8_WAIT_L(0); PG8_MMA(1, 0, At, B0); PG8_BAR; PG8_SCHED;
            PG8_STAGE(PG8_SB(1, 1), b3 + hstep, voffB);
            PG8_WAIT_V(6); PG8_BAR; PG8_MMA(1, 1, At, B1); PG8_BAR;
        }
        PG8_STAMP();
        if constexpr (!Epi::AFTER_DRAIN) { E(acc, cur, wr, wc, fr, fq); S.done(cur); }
        PG8_STAMP();
        if (!has_next) break;
#pragma unroll
        for (int a = 0; a < 2; ++a)
#pragma unroll
            for (int b = 0; b < 2; ++b)
#pragma unroll
                for (int m = 0; m < 4; ++m)
#pragma unroll
                    for (int n = 0; n < 2; ++n) acc[a][b][m][n] = (f32x4){0.f, 0.f, 0.f, 0.f};
        cur = nxt; cA = nA; cB = nB; ++ui;
    }
    PG8_WAIT_V(0);
    if (wr == 0) PG8_BAR;
    PG8_BAR;
    if constexpr (Epi::AFTER_DRAIN) { E.fused(acc, cur, wr, wc, fr, fq, lds, wid, lane); S.done(cur); }
    PG8_STAMP();
    if (STAMP && wid == 0) { stamps[lane] = lane < nts ? (((unsigned long long)(unsigned)ts_hi << 32) | (unsigned)ts_lo) : 0ull;
        if (lane == 62) stamps[62] = rt_entry; if (lane == 63) stamps[63] = (unsigned long long)wall_clock64(); }
#undef PG8_STAMP
#undef PG8_SA
#undef PG8_SB
#undef PG8_STAGE
#undef PG8_LDA
#undef PG8_LDB
#undef PG8_MMA
#undef PG8_WAIT_V
#undef PG8_WAIT_L
#undef PG8_BAR
#undef PG8_SCHED
}
}

#define LAS __attribute__((address_space(3)))
typedef unsigned short bf16;
typedef float f32x4 __attribute__((ext_vector_type(4)));

#ifndef MK_N_LAUNCHES
#define MK_N_LAUNCHES 1
#endif
#ifndef MK_PHASE_MASK
#define MK_PHASE_MASK 0x1FFF
#endif
#ifndef MK_SKIP_MIXER
#define MK_SKIP_MIXER 0
#endif
#ifndef MK_SKIP_PEER
#define MK_SKIP_PEER 0
#endif
#ifndef MK_SKIP_RWKV
#define MK_SKIP_RWKV 0
#endif
#ifndef MK_SKIP_SSD
#define MK_SKIP_SSD 0
#endif

constexpr int DM = 4096, NBATCH = 4, SEQ = 4096, CTXL = 256;
constexpr int MX = NBATCH * SEQ;
constexpr int MC = NBATCH * CTXL;
constexpr int MT = MX + MC;
constexpr int RW = 2048;
constexpr int RCOLS = 6784;
constexpr int NIN = 12992, NINP = 13056;
constexpr int COL_Z = 6784, COL_XBC = 8832, COL_DT = 12928;
constexpr int NLR = 10240, KLR = 640;
constexpr int NMOD = 6 * DM;
constexpr float RMS_EPS = 1e-6f, GN_EPS = 64e-5f;
constexpr int NSTEP = CTXL + SEQ;

constexpr size_t MiB = (size_t)1 << 20;
constexpr size_t WS_CTL = 0, CTL_ZERO_BYTES = 1 * MiB;
constexpr size_t WS_MOD = 64 * 1024;
constexpr size_t WS_WT_OUT = 2 * MiB;
constexpr size_t WS_WT_Q = 34 * MiB;
constexpr size_t WS_WLR = 50 * MiB;
constexpr size_t WS_KBD = 63 * MiB;
constexpr size_t WS_DT = 71 * MiB;
constexpr size_t WS_LA = WS_DT + (size_t)MT * 64 * 4;
constexpr size_t WS_ALR = 80 * MiB;
constexpr size_t WS_WT_IN = 102 * MiB;
constexpr size_t WS_A1 = 204 * MiB;
constexpr size_t WS_P = 340 * MiB;
constexpr size_t WS_R = 774 * MiB, WS_K = 842 * MiB, WS_V = 910 * MiB, WS_KK = 978 * MiB;
constexpr size_t WS_XS = 1046 * MiB, WS_BC = 1114 * MiB;
constexpr size_t WS_Z = 102 * MiB;
constexpr size_t WS_LR = 340 * MiB;
constexpr size_t WS_A2 = 166 * MiB;
constexpr size_t WS_XN2 = 340 * MiB;
constexpr size_t WS_Q = 468 * MiB;
constexpr size_t WS_S = 532 * MiB;
constexpr size_t WS_U16 = 774 * MiB, WS_V16 = 902 * MiB;
constexpr size_t WS_END = 1182 * MiB;
static_assert(WS_WT_IN + (size_t)NINP * DM * 2 <= WS_A1 && WS_A1 + (size_t)MT * DM * 2 <= WS_P && WS_P + (size_t)MT * NINP * 2 <= WS_R, "ws map 1");
static_assert(WS_LR + (size_t)MT * NLR * 2 <= WS_R && WS_Z + (size_t)MX * RW * 2 <= WS_A2 && WS_A2 + (size_t)MX * DM * 2 <= WS_P, "ws map 2");
static_assert(WS_LA + (size_t)MT * 64 * 4 <= WS_ALR && WS_ALR + (size_t)MT * KLR * 2 <= WS_WT_IN && WS_WLR + (size_t)NLR * KLR * 2 <= WS_KBD, "ws map 3");
static_assert(WS_S + (size_t)MX * 2048 * 4 <= WS_R && WS_V16 + (size_t)16384 * DM * 2 <= WS_XS, "ws map 4");

constexpr int LDS_BYTES = 147456;
constexpr int LDS_MISC = 131072 + 320;

enum { I_X = 0, I_C, I_CTX, I_CCTX, I_WMOD, I_BMOD, I_N1G, I_N2G, I_WIN, I_WOUT, I_MU, I_W0, I_W2, I_A0, I_A2, I_G2, I_KK, I_KA, I_RK, I_LNW, I_LNB,
       I_CONVW, I_CONVB, I_DTB, I_ALOG, I_SSMD, I_NORMW, I_WQ, I_K1, I_K2, I_PU, I_PV, I_FG, N_IN };

struct Args { const float* in[N_IN]; float* out; unsigned char* ws; int ph_lo, ph_hi; };

__device__ __forceinline__ unsigned f2bf(float f) { unsigned u = __float_as_uint(f); return (u + 0x7fffu + ((u >> 16) & 1u)) >> 16; }
__device__ __forceinline__ unsigned pk2(float lo, float hi) { return f2bf(lo) | (f2bf(hi) << 16); }
__device__ __forceinline__ float bflo(unsigned u) { return __uint_as_float(u << 16); }
__device__ __forceinline__ float bfhi(unsigned u) { return __uint_as_float(u & 0xffff0000u); }
__device__ __forceinline__ void unpack8(const uint4& u, float (&f)[8]) {
    f[0] = bflo(u.x); f[1] = bfhi(u.x); f[2] = bflo(u.y); f[3] = bfhi(u.y); f[4] = bflo(u.z); f[5] = bfhi(u.z); f[6] = bflo(u.w); f[7] = bfhi(u.w);
}
__device__ __forceinline__ uint4 pack8(const float (&f)[8]) { uint4 u; u.x = pk2(f[0], f[1]); u.y = pk2(f[2], f[3]); u.z = pk2(f[4], f[5]); u.w = pk2(f[6], f[7]); return u; }
__device__ __forceinline__ uint4 ld16(const bf16* p) { return *(const uint4*)p; }
__device__ __forceinline__ void st16(bf16* p, const uint4& v) { *(uint4*)p = v; }
__device__ __forceinline__ void ldf8(const float* p, float (&f)[8]) { const float4 a = *(const float4*)p, b = *(const float4*)(p + 4); f[0] = a.x; f[1] = a.y; f[2] = a.z; f[3] = a.w; f[4] = b.x; f[5] = b.y; f[6] = b.z; f[7] = b.w; }
#define PIN8(a) asm volatile("" : "+v"((a)[0]), "+v"((a)[1]), "+v"((a)[2]), "+v"((a)[3]), "+v"((a)[4]), "+v"((a)[5]), "+v"((a)[6]), "+v"((a)[7]))
__device__ __forceinline__ float wave_sum(float v) {
#pragma unroll
    for (int o = 1; o < 64; o <<= 1) v += __shfl_xor(v, o);
    return v;
}
__device__ __forceinline__ float wave_max(float v) {
#pragma unroll
    for (int o = 1; o < 64; o <<= 1) v = fmaxf(v, __shfl_xor(v, o));
    return v;
}
__device__ __forceinline__ float sigmoidf_(float x) { return 1.f / (1.f + __expf(-x)); }
__device__ __forceinline__ float siluf_(float x) { return x / (1.f + __expf(-x)); }

struct EpiLR {
    static constexpr bool PERM = true, AFTER_DRAIN = false;
    bf16* O; const float* w0; const float* a0;
    __device__ __forceinline__ void operator()(const pg8::f32x4 (&acc)[2][2][4][2], const pg8::Unit& u, int wr, int wc, int fr, int fq) const {
        const int row0 = u.pm * 256 + wr * 64 + fr; const int colt = u.pn * 256; const int type = colt >> 11;
        const int col0 = colt + wc * 32 + 8 * fq;
        const float* bias = type < 2 ? (w0 + type * 2048) : (a0 + (type - 2) * 2048);
        pg8::f32x4 bv[2][2];
#pragma unroll
        for (int bj = 0; bj < 2; ++bj)
#pragma unroll
            for (int n = 0; n < 2; ++n) bv[bj][n] = type < 4 ? *(const pg8::f32x4*)(bias + ((col0 + bj * 128 + 4 * n) & 2047)) : (pg8::f32x4){0.f, 0.f, 0.f, 0.f};
#pragma unroll
        for (int ai = 0; ai < 2; ++ai)
#pragma unroll
            for (int m = 0; m < 4; ++m) { bf16* rowp = O + (size_t)(row0 + ai * 128 + m * 16) * NLR + col0;
#pragma unroll
                for (int bj = 0; bj < 2; ++bj) { pg8::f32x4 v0 = acc[ai][bj][m][0] + bv[bj][0], v1 = acc[ai][bj][m][1] + bv[bj][1];
                    if (type < 4) {
#pragma unroll
                        for (int j = 0; j < 4; ++j) { float s0 = 1.f / (1.f + __expf(-v0[j])), s1 = 1.f / (1.f + __expf(-v1[j]));
                            if (type < 2) { s0 = -expm1f(-0.60653066f * s0); s1 = -expm1f(-0.60653066f * s1); }
                            v0[j] = s0; v1[j] = s1; } }
                    pg8::u32x4 w; w.x = pg8::cvt_pk_bf16(v0[0], v0[1]); w.y = pg8::cvt_pk_bf16(v0[2], v0[3]); w.z = pg8::cvt_pk_bf16(v1[0], v1[1]); w.w = pg8::cvt_pk_bf16(v1[2], v1[3]);
                    *(pg8::u32x4*)(rowp + bj * 128) = w; } }
    }
};
struct EpiRes {
    static constexpr bool PERM = false, AFTER_DRAIN = false;
    float* C; const float* X; const float* mod;
    __device__ __forceinline__ void operator()(const pg8::f32x4 (&acc)[2][2][4][2], const pg8::Unit& u, int wr, int wc, int fr, int fq) const {
        const int row0 = u.pm * 256 + wr * 64 + fr, col0 = u.pn * 256 + wc * 32 + 4 * fq;
        const float* gt = mod + (size_t)((u.pm * 256) / SEQ) * NMOD + 2 * DM;
        pg8::f32x4 gv[2][2];
#pragma unroll
        for (int bj = 0; bj < 2; ++bj)
#pragma unroll
            for (int n = 0; n < 2; ++n) gv[bj][n] = *(const pg8::f32x4*)(gt + col0 + bj * 128 + n * 16);
#pragma unroll
        for (int ai = 0; ai < 2; ++ai)
#pragma unroll
            for (int m = 0; m < 4; ++m) { const size_t off = (size_t)(row0 + ai * 128 + m * 16) * DM + col0;
#pragma unroll
                for (int bj = 0; bj < 2; ++bj)
#pragma unroll
                    for (int n = 0; n < 2; ++n) { const pg8::f32x4 xv = *(const pg8::f32x4*)(X + off + bj * 128 + n * 16);
#if MK_SKIP_MIXER
                        *(pg8::f32x4*)(C + off + bj * 128 + n * 16) = xv;
#else
                        *(pg8::f32x4*)(C + off + bj * 128 + n * 16) = xv + gv[bj][n] * acc[ai][bj][m][n];
#endif
                    }
                asm volatile("" ::: "memory"); }
    }
};

#define XB_TMO      128
#define XB_XCNT(j)  (256  + 64 * (j))
#define XB_XSUB(j)  (1280 + 64 * (j))
#define XB_XGEN(j)  (2304 + 64 * (j))
#define XB_TOP      3328
#define XB_TOPGEN   3392
#define XCD_BAR_WORDS 3456
#define XB_SPIN_CAP (1u << 18)
__device__ __forceinline__ unsigned xb_ld(unsigned* p)              { return __hip_atomic_load(p, __ATOMIC_RELAXED, __HIP_MEMORY_SCOPE_AGENT); }
__device__ __forceinline__ unsigned xb_add(unsigned* p, unsigned v) { return __hip_atomic_fetch_add(p, v, __ATOMIC_RELAXED, __HIP_MEMORY_SCOPE_AGENT); }
__device__ __forceinline__ unsigned xb_xcc_id() { return (unsigned)__builtin_amdgcn_s_getreg((3 << 11) | 20) & 0xFu; }
#define XB_SPIN(cond, bar) do { unsigned _sp = 0; while (cond) { __builtin_amdgcn_s_sleep(1); \
    if ((++_sp & 255u) == 0u) { if (xb_ld(&(bar)[XB_TMO])) break; if (_sp > XB_SPIN_CAP) { atomicAdd(&(bar)[XB_TMO], 1u); break; } } } } while (0)
struct XcdBarrier { unsigned* bar; unsigned x; volatile LAS unsigned* st; };
__device__ __forceinline__ XcdBarrier xcd_barrier_post(unsigned* bar, volatile LAS unsigned* st) {
    XcdBarrier b; b.bar = bar; b.x = xb_xcc_id(); b.st = st;
    if (threadIdx.x == 0) (void)xb_add(&bar[XB_XCNT(b.x)], 1u);
    return b;
}
__device__ __forceinline__ void xcd_barrier_complete(unsigned* bar, unsigned x, unsigned& nloc, unsigned& nx) {
    const unsigned G = gridDim.x * gridDim.y * gridDim.z;
    unsigned sum, cnt, mine, sp = 0u;
    for (;;) {
        sum = 0u; cnt = 0u; mine = 0u;
#pragma unroll
        for (unsigned j = 0; j < 16; ++j) { const unsigned c = xb_ld(&bar[XB_XCNT(j)]); sum += c; cnt += (c > 0u) ? 1u : 0u; mine = (j == x) ? c : mine; }
        if (sum == G) break;
        __builtin_amdgcn_s_sleep(1);
        if ((++sp & 255u) == 0u) { if (xb_ld(&bar[XB_TMO])) break; if (sp > XB_SPIN_CAP) { atomicAdd(&bar[XB_TMO], 1u); break; } }
    }
    nloc = mine > 0u ? mine : 1u; nx = cnt > 0u ? cnt : 1u;
}
__device__ __forceinline__ void xcd_barrier(const XcdBarrier& b) {
    asm volatile("s_waitcnt vmcnt(0)" ::: "memory");
    __syncthreads();
    if (threadIdx.x == 0) {
        unsigned* bar = b.bar;
        __builtin_amdgcn_s_waitcnt(0);
        unsigned nloc = b.st[0], nx = b.st[1];
        if (nloc == 0u) { xcd_barrier_complete(bar, b.x, nloc, nx); b.st[0] = nloc; b.st[1] = nx; }
        const unsigned old = xb_add(&bar[XB_XSUB(b.x)], 1u);
        const unsigned gen = old / nloc;
        if (old + 1u == (gen + 1u) * nloc) {
            __builtin_amdgcn_fence(__ATOMIC_RELEASE, "agent");
            asm volatile("s_waitcnt vmcnt(0)" ::: "memory");
            const unsigned og = xb_add(&bar[XB_TOP], 1u);
            const unsigned tg = og / nx;
            if (og + 1u == (tg + 1u) * nx) xb_add(&bar[XB_TOPGEN], 1u);
            else XB_SPIN(xb_ld(&bar[XB_TOPGEN]) == tg, bar);
            __builtin_amdgcn_fence(__ATOMIC_ACQUIRE, "agent");
            xb_add(&bar[XB_XGEN(b.x)], 1u);
            asm volatile("s_waitcnt vmcnt(0)" ::: "memory");
        } else {
            XB_SPIN(xb_ld(&bar[XB_XGEN(b.x)]) == gen, bar);
            __builtin_amdgcn_fence(__ATOMIC_ACQUIRE, "agent");
            asm volatile("s_waitcnt vmcnt(0)" ::: "memory");
        }
    }
    __syncthreads();
}

#define TID ((int)threadIdx.x)
#define LANE ((int)(threadIdx.x & 63))
#define WAVE ((int)__builtin_amdgcn_readfirstlane((int)(threadIdx.x >> 6)))
#define GW ((int)blockIdx.x * 8 + WAVE)
#define NGW ((int)gridDim.x * 8)

__device__ __forceinline__ void ph_mod(const Args& a, LAS unsigned char* lds) {
    const float* c = a.in[I_C]; const float* cc = a.in[I_CCTX]; const float* w_mod = a.in[I_WMOD]; const float* b_mod = a.in[I_BMOD];
    float* mod = (float*)(a.ws + WS_MOD);
    LAS float* sS = (LAS float*)lds;
    LAS float* red = (LAS float*)(lds + 81920);
    const int tid = TID, lane = LANE, wave = WAVE;
    if ((int)blockIdx.x < 192) {
        for (int i = tid; i < 5 * DM; i += 512) { const int v = i >> 12, k = i & (DM - 1); const float xv = v < 4 ? c[v * DM + k] : cc[k]; sS[i] = xv / (1.f + expf(-xv)); }
    }
    __syncthreads();
    for (int u = blockIdx.x; u < 192; u += gridDim.x) {
        const int cl = lane & 31, kh = lane >> 5;
        float acc[5][4];
#pragma unroll
        for (int v = 0; v < 5; ++v)
#pragma unroll
            for (int e = 0; e < 4; ++e) acc[v][e] = 0.f;
        const float* wp = w_mod + (size_t)(wave * 512 + kh) * NMOD + u * 128 + cl * 4;
#pragma unroll 8
        for (int i = 0; i < 256; ++i) {
            const float4 w = *(const float4*)(wp + (size_t)(2 * i) * NMOD);
#pragma unroll
            for (int v = 0; v < 5; ++v) { const float s = sS[v * DM + wave * 512 + 2 * i + kh]; acc[v][0] += s * w.x; acc[v][1] += s * w.y; acc[v][2] += s * w.z; acc[v][3] += s * w.w; }
        }
#pragma unroll
        for (int v = 0; v < 5; ++v)
#pragma unroll
            for (int e = 0; e < 4; ++e) acc[v][e] += __shfl_xor(acc[v][e], 32);
        if (kh == 0) {
#pragma unroll
            for (int v = 0; v < 5; ++v) *(LAS f32x4*)(red + ((wave * 5 + v) * 128 + cl * 4)) = (f32x4){acc[v][0], acc[v][1], acc[v][2], acc[v][3]};
        }
        __syncthreads();
        for (int i = tid; i < 640; i += 512) { const int v = i >> 7, n = i & 127; float s = b_mod[u * 128 + n];
#pragma unroll
            for (int w = 0; w < 8; ++w) s += red[(w * 5 + v) * 128 + n];
            mod[v * NMOD + u * 128 + n] = s; }
        __syncthreads();
    }
    __syncthreads();
}

__device__ __forceinline__ void transpose_item(const float* W, int K, int N, bf16* WT, LAS float* scr, int item, int lane) {
    const int nblk = N / 32, kb = item / nblk, nb = item % nblk, k0 = 64 * kb, n0 = 32 * nb;
#pragma unroll 8
    for (int i = 0; i < 32; ++i) { const int kk = 2 * i + (lane >> 5); scr[kk * 33 + (lane & 31)] = W[(size_t)(k0 + kk) * N + n0 + (lane & 31)]; }
    asm volatile("s_waitcnt lgkmcnt(0)" ::: "memory");
    const int c = lane & 7;
#pragma unroll
    for (int j = 0; j < 4; ++j) { const int n = (lane >> 3) + 8 * j; const LAS float* s = scr + (8 * c) * 33 + n;
        uint4 o; o.x = pk2(s[0 * 33], s[1 * 33]); o.y = pk2(s[2 * 33], s[3 * 33]); o.z = pk2(s[4 * 33], s[5 * 33]); o.w = pk2(s[6 * 33], s[7 * 33]);
        *(uint4*)(WT + (size_t)(n0 + n) * K + k0 + 8 * c) = o; }
    asm volatile("s_waitcnt lgkmcnt(0)" ::: "memory");
}
__device__ __forceinline__ void ph_conv(const Args& a, LAS unsigned char* lds) {
    const int lane = LANE, wave = WAVE, gw = GW, ngw = NGW;
    LAS float* scr = (LAS float*)(lds + wave * 16384);
    bf16* wt_in = (bf16*)(a.ws + WS_WT_IN); bf16* wt_out = (bf16*)(a.ws + WS_WT_OUT); bf16* wt_q = (bf16*)(a.ws + WS_WT_Q);
    constexpr int IT_IN = (DM / 64) * (NIN / 32), IT_OUT = (DM / 64) * (DM / 32), IT_Q = (DM / 64) * (2048 / 32);
    for (int it = gw; it < IT_IN + IT_OUT + IT_Q; it += ngw) {
        int r = it;
        if (r < IT_IN) { transpose_item(a.in[I_WIN], DM, NIN, wt_in, scr, r, lane); continue; } r -= IT_IN;
        if (r < IT_OUT) { transpose_item(a.in[I_WOUT], DM, DM, wt_out, scr, r, lane); continue; } r -= IT_OUT;
        transpose_item(a.in[I_WQ], DM, 2048, wt_q, scr, r, lane);
    }
    const int gt = blockIdx.x * 512 + TID, ngt = gridDim.x * 512;
    for (int i = gt; i < (NINP - NIN) * DM / 8; i += ngt) *(uint4*)(wt_in + (size_t)NIN * DM + (size_t)i * 8) = make_uint4(0u, 0u, 0u, 0u);
    { bf16* wlr = (bf16*)(a.ws + WS_WLR); const float* w2 = a.in[I_W2]; const float* a2 = a.in[I_A2]; const float* g2 = a.in[I_G2];
      for (int i = gt; i < NLR * (KLR / 8); i += ngt) { const int n = i / (KLR / 8), k0 = (i % (KLR / 8)) * 8; const int type = n >> 11, cch = n & 2047;
          float f[8];
#pragma unroll
          for (int e = 0; e < 8; ++e) { const int k = k0 + e; float v = 0.f;
              if (type == 0) { if (k < 96) v = w2[(size_t)(0 * 96 + k) * RW + cch]; }
              else if (type == 1) { if (k >= 96 && k < 192) v = w2[(size_t)(1 * 96 + (k - 96)) * RW + cch]; }
              else if (type == 2) { if (k >= 192 && k < 288) v = a2[(size_t)(0 * 96 + (k - 192)) * RW + cch]; }
              else if (type == 3) { if (k >= 288 && k < 384) v = a2[(size_t)(1 * 96 + (k - 288)) * RW + cch]; }
              else { if (k >= 384) v = g2[(size_t)(k - 384) * RW + cch]; }
              f[e] = v; }
          st16(wlr + (size_t)n * KLR + k0, pack8(f)); } }
    { bf16* kbd = (bf16*)(a.ws + WS_KBD); const float* k1 = a.in[I_K1]; const float* k2 = a.in[I_K2];
      for (int i = gt; i < 2048 * 256; i += ngt) { const int n = i >> 8, k0 = (i & 255) * 8; float f[8];
          if ((n >> 7) == (k0 >> 7)) { const int h = n >> 8, s = (n >> 7) & 1, key = n & 127, d0 = k0 & 127; const float* src = (s ? k2 : k1) + ((size_t)(h * 128 + key) * 128 + d0); ldf8(src, f); }
          else {
#pragma unroll
              for (int e = 0; e < 8; ++e) f[e] = 0.f; }
          st16(kbd + (size_t)n * 2048 + k0, pack8(f)); } }
}

__device__ __forceinline__ void norm_mod_row(const float* src, const float* g, const float* sh, const float* sc, bf16* dst, int lane) {
    float4 v[16]; float ss = 0.f;
#pragma unroll
    for (int j = 0; j < 16; ++j) { v[j] = *(const float4*)(src + (lane + 64 * j) * 4); ss += (v[j].x * v[j].x + v[j].y * v[j].y) + (v[j].z * v[j].z + v[j].w * v[j].w); }
    const float rstd = rsqrtf(wave_sum(ss) * (1.f / DM) + RMS_EPS);
#pragma unroll
    for (int j = 0; j < 16; ++j) { const int c = (lane + 64 * j) * 4; const float4 gg = *(const float4*)(g + c), s1 = *(const float4*)(sc + c), s0 = *(const float4*)(sh + c);
        const float o0 = v[j].x * rstd * gg.x * (1.f + s1.x) + s0.x, o1 = v[j].y * rstd * gg.y * (1.f + s1.y) + s0.y, o2 = v[j].z * rstd * gg.z * (1.f + s1.z) + s0.z, o3 = v[j].w * rstd * gg.w * (1.f + s1.w) + s0.w;
        uint2 w; w.x = pk2(o0, o1); w.y = pk2(o2, o3); *(uint2*)(dst + c) = w; }
}
__device__ __forceinline__ void ph_norm1(const Args& a) {
    const int lane = LANE; const float* mod = (const float*)(a.ws + WS_MOD); bf16* A1 = (bf16*)(a.ws + WS_A1);
    for (int m = GW; m < MT; m += NGW) {
        const float* src = m < MX ? a.in[I_X] + (size_t)m * DM : a.in[I_CTX] + (size_t)(m - MX) * DM;
        const int v = m < MX ? m / SEQ : 4;
        norm_mod_row(src, a.in[I_N1G], mod + (size_t)v * NMOD, mod + (size_t)v * NMOD + DM, A1 + (size_t)m * DM, lane);
    }
}
__device__ __forceinline__ void ph_norm2(const Args& a) {
    const int lane = LANE; const float* mod = (const float*)(a.ws + WS_MOD); bf16* XN2 = (bf16*)(a.ws + WS_XN2);
    for (int m = GW; m < MX; m += NGW) {
        const int v = m / SEQ;
        norm_mod_row(a.out + (size_t)m * DM, a.in[I_N2G], mod + (size_t)v * NMOD + 3 * DM, mod + (size_t)v * NMOD + 4 * DM, XN2 + (size_t)m * DM, lane);
    }
    const int gt = blockIdx.x * 512 + TID, ngt = gridDim.x * 512;
    bf16* U16 = (bf16*)(a.ws + WS_U16); bf16* V16 = (bf16*)(a.ws + WS_V16); const float* pu = a.in[I_PU]; const float* pv = a.in[I_PV];
    for (int i = gt; i < 16384 * DM / 8; i += ngt) { float f[8]; ldf8(pu + (size_t)i * 8, f); st16(U16 + (size_t)i * 8, pack8(f)); ldf8(pv + (size_t)i * 8, f); st16(V16 + (size_t)i * 8, pack8(f)); }
}

__device__ __forceinline__ void ph_prep_rwkv(const Args& a) {
    const int lane = LANE;
    const bf16* P = (const bf16*)(a.ws + WS_P);
    bf16* R = (bf16*)(a.ws + WS_R); bf16* K = (bf16*)(a.ws + WS_K); bf16* V = (bf16*)(a.ws + WS_V); bf16* KK = (bf16*)(a.ws + WS_KK); bf16* ALR = (bf16*)(a.ws + WS_ALR);
    const float* mu = a.in[I_MU]; const float* k_k = a.in[I_KK];
    for (int m = GW; m < MT; m += NGW) {
        const bool lat = m < MX;
        bool h0, h1, h2 = false, h3 = false; size_t r0, r1, r2 = 0, r3 = 0;
        if (lat) { const int t = m & (SEQ - 1), row = t >> 6, col = t & 63; h0 = col > 0; h1 = col < 63; h2 = row > 0; h3 = row < 63; r0 = (size_t)(m - 1); r1 = (size_t)(m + 1); r2 = (size_t)(m - 64); r3 = (size_t)(m + 64); }
        else { const int t = (m - MX) & (CTXL - 1); h0 = t > 0; h1 = t < CTXL - 1; r0 = (size_t)(m - 1); r1 = (size_t)(m + 1); }
        const bf16* prow = P + (size_t)m * NINP;
#pragma unroll
        for (int i = 0; i < 14; ++i) {
            const int chunk = lane + 64 * i;
            if (chunk < RCOLS / 8) {
                const int c0 = chunk * 8;
                float own[8], n0[8], n1[8], sh[8], xm[8], muv[8];
                const uint4 z4 = make_uint4(0u, 0u, 0u, 0u);
                unpack8(ld16(prow + c0), own);
                unpack8(h0 ? ld16(P + r0 * NINP + c0) : z4, n0);
                unpack8(h1 ? ld16(P + r1 * NINP + c0) : z4, n1);
                if (lat) { float n2[8], n3[8];
                    unpack8(h2 ? ld16(P + r2 * NINP + c0) : z4, n2);
                    unpack8(h3 ? ld16(P + r3 * NINP + c0) : z4, n3);
#pragma unroll
                    for (int e = 0; e < 8; ++e) sh[e] = (e & 3) == 0 ? n0[e] : (e & 3) == 1 ? n1[e] : (e & 3) == 2 ? n2[e] : n3[e];
                } else {
#pragma unroll
                    for (int e = 0; e < 8; ++e) sh[e] = (e & 1) == 0 ? n0[e] : n1[e];
                }
                ldf8(mu + c0, muv);
#pragma unroll
                for (int e = 0; e < 8; ++e) xm[e] = own[e] + muv[e] * (sh[e] - own[e]);
                if (i < 4) st16(R + (size_t)m * RW + c0, pack8(xm));
                else if (i < 8) { const int cc = c0 - 2048; st16(K + (size_t)m * RW + cc, pack8(xm));
                    float kv[8], kkv[8]; ldf8(k_k + cc, kv); float ss = 0.f;
#pragma unroll
                    for (int e = 0; e < 8; ++e) { kkv[e] = xm[e] * kv[e]; ss += kkv[e] * kkv[e]; }
                    ss += __shfl_xor(ss, 1); ss += __shfl_xor(ss, 2); ss += __shfl_xor(ss, 4);
                    const float inv = rsqrtf(fmaxf(ss, 1e-24f));
#pragma unroll
                    for (int e = 0; e < 8; ++e) kkv[e] *= inv;
                    st16(KK + (size_t)m * RW + cc, pack8(kkv)); }
                else if (i < 12) st16(V + (size_t)m * RW + (c0 - 4096), pack8(xm));
                else { const int j0 = c0 - 6144; float f[8];
#pragma unroll
                    for (int e = 0; e < 8; ++e) f[e] = j0 < 192 ? tanhf(xm[e]) : (j0 < 384 ? xm[e] : 1.f / (1.f + __expf(-xm[e])));
                    st16(ALR + (size_t)m * KLR + j0, pack8(f)); }
            }
        }
    }
}

__device__ __forceinline__ void ph_prep_ssd(const Args& a) {
    const int lane = LANE;
    const bf16* P = (const bf16*)(a.ws + WS_P);
    bf16* XS = (bf16*)(a.ws + WS_XS); bf16* BC = (bf16*)(a.ws + WS_BC); bf16* Z = (bf16*)(a.ws + WS_Z); float* DT = (float*)(a.ws + WS_DT); float* LA = (float*)(a.ws + WS_LA);
    const float* cw = a.in[I_CONVW]; const float* cb = a.in[I_CONVB];
    for (int m = GW; m < MT; m += NGW) {
        const bool lat = m < MX; bool hp, hn;
        if (lat) { const int t = m & (SEQ - 1); hp = t > 0; hn = t < SEQ - 1; } else { const int t = (m - MX) & (CTXL - 1); hp = t > 0; hn = t < CTXL - 1; }
        const bf16* prow = P + (size_t)m * NINP;
#pragma unroll
        for (int i = 0; i < 8; ++i) {
            const int c0 = (lane + 64 * i) * 8; const uint4 z4 = make_uint4(0u, 0u, 0u, 0u);
            float cur[8], pv[8], nx[8], w0[8], w1[8], w2[8], bb[8], y[8];
            unpack8(ld16(prow + COL_XBC + c0), cur);
            unpack8(hp ? ld16(prow - NINP + COL_XBC + c0) : z4, pv);
            unpack8(hn ? ld16(prow + NINP + COL_XBC + c0) : z4, nx);
            ldf8(cw + c0, w0); ldf8(cw + 4096 + c0, w1); ldf8(cw + 8192 + c0, w2); ldf8(cb + c0, bb);
#pragma unroll
            for (int e = 0; e < 8; ++e) { const float t = w0[e] * pv[e] + w1[e] * cur[e] + w2[e] * nx[e] + bb[e]; y[e] = t / (1.f + __expf(-t)); }
            if (i < 4) st16(XS + (size_t)m * RW + c0, pack8(y)); else st16(BC + (size_t)m * RW + (c0 - 2048), pack8(y));
        }
        { const float raw = __uint_as_float((unsigned)prow[COL_DT + lane] << 16) + a.in[I_DTB][lane];
          const float dtv = raw > 20.f ? raw : log1pf(expf(raw));
          DT[(size_t)m * 64 + lane] = dtv; LA[(size_t)m * 64 + lane] = -dtv * expf(a.in[I_ALOG][lane]); }
        if (lat) {
#pragma unroll
            for (int i = 0; i < 4; ++i) { const int c0 = (lane + 64 * i) * 8; st16(Z + (size_t)m * RW + c0, ld16(prow + COL_Z + c0)); }
        }
    }
}

__device__ __forceinline__ int scan_row(int n, int dir, int b) { return n < CTXL ? MX + b * CTXL + (dir ? CTXL - 1 - n : n) : b * SEQ + (dir ? NSTEP - 1 - n : n - CTXL); }

struct RIn { uint4 r, k, kk, w, a; unsigned v; };
__device__ __forceinline__ void rwkv_load(RIn& x, const bf16* R, const bf16* K, const bf16* V, const bf16* KK, const bf16* LR, int m, int ch, int chi, int dir) {
    x.r = ld16(R + (size_t)m * RW + ch); x.k = ld16(K + (size_t)m * RW + ch); x.kk = ld16(KK + (size_t)m * RW + ch);
    x.w = ld16(LR + (size_t)m * NLR + dir * 2048 + ch); x.a = ld16(LR + (size_t)m * NLR + 4096 + dir * 2048 + ch);
    x.v = V[(size_t)m * RW + chi];
}
__device__ __forceinline__ float rwkv_step(float (&S)[8], const RIn& x, const float (&ka)[8]) {
    float r[8], k[8], kk[8], w1[8], av[8];
    unpack8(x.r, r); unpack8(x.k, k); unpack8(x.kk, kk); unpack8(x.w, w1); unpack8(x.a, av);
    const float v = __uint_as_float(x.v << 16);
    float sa = 0.f;
#pragma unroll
    for (int e = 0; e < 8; ++e) sa -= S[e] * kk[e];
    sa += __shfl_xor(sa, 1); sa += __shfl_xor(sa, 2); sa += __shfl_xor(sa, 4);
    float o = 0.f;
#pragma unroll
    for (int e = 0; e < 8; ++e) { const float kd = k[e] * (1.f + (av[e] - 1.f) * ka[e]); const float b = kk[e] * av[e];
        S[e] = S[e] * (1.f - w1[e]) + sa * b + v * kd; o += S[e] * r[e]; }
    o += __shfl_xor(o, 1); o += __shfl_xor(o, 2); o += __shfl_xor(o, 4);
    return o;
}
__device__ __forceinline__ void ph_rwkv_scan(const Args& a) {
    const int lane = LANE, wave = WAVE;
    const bf16* R = (const bf16*)(a.ws + WS_R); const bf16* K = (const bf16*)(a.ws + WS_K); const bf16* V = (const bf16*)(a.ws + WS_V); const bf16* KK = (const bf16*)(a.ws + WS_KK);
    const bf16* LR = (const bf16*)(a.ws + WS_LR); bf16* OR = (bf16*)a.out;
    for (int u = blockIdx.x; u < 256; u += gridDim.x) {
        const int g = u >> 5, h = u & 31, dir = g >> 2, b = g & 3;
        const int i = wave * 8 + (lane >> 3), jb = lane & 7, ch = h * 64 + jb * 8, chi = h * 64 + i;
        float ka[8]; ldf8(a.in[I_KA] + ch, ka);
        float S[8];
#pragma unroll
        for (int e = 0; e < 8; ++e) S[e] = 0.f;
        RIn A[4], B[4];
#pragma unroll
        for (int s = 0; s < 4; ++s) rwkv_load(A[s], R, K, V, KK, LR, scan_row(s, dir, b), ch, chi, dir);
        for (int n0 = 0; n0 < NSTEP; n0 += 8) {
#pragma unroll
            for (int s = 0; s < 4; ++s) rwkv_load(B[s], R, K, V, KK, LR, scan_row(n0 + 4 + s, dir, b), ch, chi, dir);
#pragma unroll
            for (int s = 0; s < 4; ++s) { const int n = n0 + s; const float o = rwkv_step(S, A[s], ka);
                if (n >= CTXL && jb == 0) OR[((size_t)dir * MX + scan_row(n, dir, b)) * RW + chi] = (bf16)f2bf(o); }
            if (n0 + 8 < NSTEP) {
#pragma unroll
                for (int s = 0; s < 4; ++s) rwkv_load(A[s], R, K, V, KK, LR, scan_row(n0 + 8 + s, dir, b), ch, chi, dir);
            }
#pragma unroll
            for (int s = 0; s < 4; ++s) { const int n = n0 + 4 + s; const float o = rwkv_step(S, B[s], ka);
                if (n >= CTXL && jb == 0) OR[((size_t)dir * MX + scan_row(n, dir, b)) * RW + chi] = (bf16)f2bf(o); }
        }
    }
}

struct SIn { uint4 b0, b1, c0, c1; unsigned xs; float dt, la; };
__device__ __forceinline__ void ssd_load(SIn& x, const bf16* XS, const bf16* BC, const float* DT, const float* LA, int m, int chx, int cb, int dh) {
    x.b0 = ld16(BC + (size_t)m * RW + cb); x.b1 = ld16(BC + (size_t)m * RW + cb + 8); x.c0 = ld16(BC + (size_t)m * RW + 1024 + cb); x.c1 = ld16(BC + (size_t)m * RW + 1024 + cb + 8);
    x.xs = XS[(size_t)m * RW + chx]; x.dt = DT[(size_t)m * 64 + dh]; x.la = LA[(size_t)m * 64 + dh];
}
__device__ __forceinline__ float ssd_step(float (&s)[16], const SIn& x) {
    float B0[8], B1[8], C0[8], C1[8]; unpack8(x.b0, B0); unpack8(x.b1, B1); unpack8(x.c0, C0); unpack8(x.c1, C1);
    const float dec = __expf(x.la), xdt = __uint_as_float(x.xs << 16) * x.dt; float y = 0.f;
#pragma unroll
    for (int e = 0; e < 8; ++e) { s[e] = dec * s[e] + xdt * B0[e]; y += s[e] * C0[e]; s[8 + e] = dec * s[8 + e] + xdt * B1[e]; y += s[8 + e] * C1[e]; }
    y += __shfl_xor(y, 1); y += __shfl_xor(y, 2); y += __shfl_xor(y, 4);
    return y;
}
__device__ __forceinline__ void ph_ssd_scan(const Args& a) {
    const int lane = LANE, wave = WAVE;
    const bf16* XS = (const bf16*)(a.ws + WS_XS); const bf16* BC = (const bf16*)(a.ws + WS_BC); const float* DT = (const float*)(a.ws + WS_DT); const float* LA = (const float*)(a.ws + WS_LA);
    bf16* YS = (bf16*)a.out + (size_t)2 * MX * RW;
    for (int u = blockIdx.x; u < 256; u += gridDim.x) {
        const int g = u >> 5, h = u & 31, dir = g >> 2, b = g & 3;
        const int p = wave * 8 + (lane >> 3), nb = lane & 7, chx = h * 64 + p, cb = (h >> 2) * 128 + nb * 16, dh = dir * 32 + h;
        float s[16];
#pragma unroll
        for (int e = 0; e < 16; ++e) s[e] = 0.f;
        SIn A[4], B[4];
#pragma unroll
        for (int q = 0; q < 4; ++q) ssd_load(A[q], XS, BC, DT, LA, scan_row(q, dir, b), chx, cb, dh);
        for (int n0 = 0; n0 < NSTEP; n0 += 8) {
#pragma unroll
            for (int q = 0; q < 4; ++q) ssd_load(B[q], XS, BC, DT, LA, scan_row(n0 + 4 + q, dir, b), chx, cb, dh);
#pragma unroll
            for (int q = 0; q < 4; ++q) { const int n = n0 + q; const float y = ssd_step(s, A[q]);
                if (n >= CTXL && nb == 0) YS[((size_t)dir * MX + scan_row(n, dir, b)) * RW + chx] = (bf16)f2bf(y); }
            if (n0 + 8 < NSTEP) {
#pragma unroll
                for (int q = 0; q < 4; ++q) ssd_load(A[q], XS, BC, DT, LA, scan_row(n0 + 8 + q, dir, b), chx, cb, dh);
            }
#pragma unroll
            for (int q = 0; q < 4; ++q) { const int n = n0 + 4 + q; const float y = ssd_step(s, B[q]);
                if (n >= CTXL && nb == 0) YS[((size_t)dir * MX + scan_row(n, dir, b)) * RW + chx] = (bf16)f2bf(y); }
        }
    }
}

__device__ __forceinline__ void ph_finish(const Args& a) {
    const int lane = LANE;
    const bf16* R = (const bf16*)(a.ws + WS_R); const bf16* K = (const bf16*)(a.ws + WS_K); const bf16* V = (const bf16*)(a.ws + WS_V);
    const bf16* LR = (const bf16*)(a.ws + WS_LR); const bf16* XS = (const bf16*)(a.ws + WS_XS); const bf16* Z = (const bf16*)(a.ws + WS_Z);
    const bf16* OR = (const bf16*)a.out; const bf16* YS = (const bf16*)a.out + (size_t)2 * MX * RW;
    bf16* A2 = (bf16*)(a.ws + WS_A2);
    for (int m = GW; m < MX; m += NGW) {
#pragma unroll
        for (int i = 0; i < 4; ++i) {
            const int c0 = (lane + 64 * i) * 8;
            float of[8], ob[8], o[8], res[8];
#if MK_SKIP_RWKV
#pragma unroll
            for (int e = 0; e < 8; ++e) res[e] = 0.f;
#else
            unpack8(ld16(OR + (size_t)m * RW + c0), of); unpack8(ld16(OR + ((size_t)MX + m) * RW + c0), ob);
            float sm = 0.f;
#pragma unroll
            for (int e = 0; e < 8; ++e) { o[e] = of[e] + ob[e]; sm += o[e]; }
            sm += __shfl_xor(sm, 1); sm += __shfl_xor(sm, 2); sm += __shfl_xor(sm, 4);
            const float mean = sm * (1.f / 64.f); float sq = 0.f;
#pragma unroll
            for (int e = 0; e < 8; ++e) { o[e] -= mean; sq += o[e] * o[e]; }
            sq += __shfl_xor(sq, 1); sq += __shfl_xor(sq, 2); sq += __shfl_xor(sq, 4);
            const float rstd = rsqrtf(sq * (1.f / 64.f) + GN_EPS);
            float lw[8], lb[8], r[8], k[8], v[8], a0[8], a1[8], ka[8], rk[8], gg[8];
            ldf8(a.in[I_LNW] + c0, lw); ldf8(a.in[I_LNB] + c0, lb); ldf8(a.in[I_KA] + c0, ka); ldf8(a.in[I_RK] + c0, rk);
            unpack8(ld16(R + (size_t)m * RW + c0), r); unpack8(ld16(K + (size_t)m * RW + c0), k); unpack8(ld16(V + (size_t)m * RW + c0), v);
            unpack8(ld16(LR + (size_t)m * NLR + 4096 + c0), a0); unpack8(ld16(LR + (size_t)m * NLR + 6144 + c0), a1); unpack8(ld16(LR + (size_t)m * NLR + 8192 + c0), gg);
            float bs = 0.f;
#pragma unroll
            for (int e = 0; e < 8; ++e) { const float kd = k[e] * (2.f + (a0[e] + a1[e] - 2.f) * ka[e]); bs += r[e] * kd * rk[e]; }
            bs += __shfl_xor(bs, 1); bs += __shfl_xor(bs, 2); bs += __shfl_xor(bs, 4);
#pragma unroll
            for (int e = 0; e < 8; ++e) res[e] = (o[e] * rstd * lw[e] + lb[e] + bs * v[e]) * gg[e];
#endif
            st16(A2 + (size_t)m * DM + c0, pack8(res));
        }
#pragma unroll
        for (int i = 0; i < 4; ++i) {
            const int c0 = (lane + 64 * i) * 8;
            float yf[8], yb[8], xs[8], z[8], nw[8], y[8];
#if MK_SKIP_SSD
#pragma unroll
            for (int e = 0; e < 8; ++e) y[e] = 0.f;
#else
            unpack8(ld16(YS + (size_t)m * RW + c0), yf); unpack8(ld16(YS + ((size_t)MX + m) * RW + c0), yb);
            unpack8(ld16(XS + (size_t)m * RW + c0), xs); unpack8(ld16(Z + (size_t)m * RW + c0), z); ldf8(a.in[I_NORMW] + c0, nw);
            const float dsk = a.in[I_SSMD][c0 >> 6]; float ss = 0.f;
#pragma unroll
            for (int e = 0; e < 8; ++e) { y[e] = (yf[e] + yb[e] + dsk * xs[e]) * (z[e] / (1.f + __expf(-z[e]))); ss += y[e] * y[e]; }
            ss += __shfl_xor(ss, 1); ss += __shfl_xor(ss, 2); ss += __shfl_xor(ss, 4); ss += __shfl_xor(ss, 8); ss += __shfl_xor(ss, 16);
            const float rstd = rsqrtf(ss * (1.f / 256.f) + RMS_EPS);
#pragma unroll
            for (int e = 0; e < 8; ++e) y[e] = y[e] * rstd * nw[e];
#endif
            st16(A2 + (size_t)m * DM + 2048 + c0, pack8(y));
        }
    }
}

__device__ __forceinline__ float enc_key(float v, int idx) { return __uint_as_float((__float_as_uint(v) & 0xffffff00u) | (unsigned)idx); }
__device__ __forceinline__ void ph_peer(const Args& a) {
    const int lane = LANE;
    const float* mod = (const float*)(a.ws + WS_MOD); const float* S = (const float*)(a.ws + WS_S);
    const bf16* U16 = (const bf16*)(a.ws + WS_U16); const bf16* V16 = (const bf16*)(a.ws + WS_V16);
    for (int m = GW; m < MX; m += NGW) {
        const int bb = m / SEQ;
        float* hrow = a.out + (size_t)m * DM;
        int l8 = lane * 8; asm volatile("" : "+v"(l8));
        float acc[8][8];
#if MK_SKIP_PEER
#pragma unroll
        for (int j = 0; j < 8; ++j)
#pragma unroll
            for (int e = 0; e < 8; ++e) acc[j][e] = 0.f;
#else
        float xn[8][8];
        { float ss = 0.f; float hv[8][8];
#pragma unroll
          for (int j = 0; j < 8; ++j) ldf8(hrow + 512 * j + l8, hv[j]);
#pragma unroll
          for (int j = 0; j < 8; ++j)
#pragma unroll
              for (int e = 0; e < 8; ++e) ss += hv[j][e] * hv[j][e];
          const float rstd = rsqrtf(wave_sum(ss) * (1.f / DM) + RMS_EPS);
          const float* sh2 = mod + (size_t)bb * NMOD + 3 * DM; const float* sc2 = mod + (size_t)bb * NMOD + 4 * DM; const float* g2 = a.in[I_N2G];
#pragma unroll
          for (int j = 0; j < 8; ++j) { float gg[8], s0[8], s1[8]; const int c = 512 * j + l8; ldf8(g2 + c, gg); ldf8(sh2 + c, s0); ldf8(sc2 + c, s1);
#pragma unroll
              for (int e = 0; e < 8; ++e) xn[j][e] = hv[j][e] * rstd * gg[e] * (1.f + s1[e]) + s0[e];
              PIN8(xn[j]); asm volatile("" ::: "memory"); } }
        int eid0 = 0, eid1 = 0; float gt0 = 0.f, gt1 = 0.f;
        const float NEG = -3.0e38f;
#pragma unroll 1
        for (int hd = 0; hd < 8; ++hd) {
            const float* srow = S + (size_t)m * 2048 + hd * 256;
            float c1a = enc_key(srow[lane], lane), c1b = enc_key(srow[64 + lane], 64 + lane), c2a = enc_key(srow[128 + lane], lane), c2b = enc_key(srow[192 + lane], 64 + lane);
            float t1 = NEG, t2 = NEG;
#pragma unroll 1
            for (int k = 0; k < 16; ++k) {
                const float m1 = wave_max(fmaxf(c1a, c1b)), m2 = wave_max(fmaxf(c2a, c2b));
                if (c1a == m1) c1a = NEG; if (c1b == m1) c1b = NEG; if (c2a == m2) c2a = NEG; if (c2b == m2) c2b = NEG;
                if (lane == k) { t1 = m1; t2 = m2; }
            }
            const float v1 = __uint_as_float(__float_as_uint(t1) & 0xffffff00u), v2 = __uint_as_float(__float_as_uint(t2) & 0xffffff00u);
            const int i1 = (int)(__float_as_uint(t1) & 0xffu), i2 = (int)(__float_as_uint(t2) & 0xffu);
            float cd[4];
#pragma unroll
            for (int e = 0; e < 4; ++e) { const float va = __shfl(v1, (lane >> 4) + 4 * e), vb = __shfl(v2, lane & 15); cd[e] = enc_key(va + vb, lane + 64 * e); }
            float best = NEG; int ex = 0;
#pragma unroll 1
            for (int k = 0; k < 16; ++k) {
                const float mx = wave_max(fmaxf(fmaxf(cd[0], cd[1]), fmaxf(cd[2], cd[3])));
#pragma unroll
                for (int e = 0; e < 4; ++e) if (cd[e] == mx) cd[e] = NEG;
                const int cidx = (int)(__float_as_uint(mx) & 0xffu);
                const int ea = __shfl(i1, cidx >> 4), eb = __shfl(i2, cidx & 15);
                if (lane == k) { best = __uint_as_float(__float_as_uint(mx) & 0xffffff00u); ex = ea * 128 + eb; }
            }
            const float bmax = __shfl(best, 0);
            const float pe = lane < 16 ? __expf(best - bmax) : 0.f;
            const float gate = pe / wave_sum(pe);
            const float gsh = __shfl(gate, lane & 15); const int esh = __shfl(ex, lane & 15);
            if ((lane >> 4) == (hd & 3)) { if (hd < 4) { gt0 = gsh; eid0 = esh; } else { gt1 = gsh; eid1 = esh; } }
        }
        float cf0 = 0.f, cf1 = 0.f;
#pragma unroll 1
        for (int p = 0; p < 128; ++p) {
            const int e = __builtin_amdgcn_readlane(p < 64 ? eid0 : eid1, p & 63);
            const bf16* urow = U16 + (size_t)e * DM + l8;
            float d = 0.f;
#pragma unroll
            for (int j = 0; j < 8; ++j) { float f[8]; unpack8(ld16(urow + 512 * j), f);
#pragma unroll
                for (int q = 0; q < 8; ++q) d += xn[j][q] * f[q]; }
            d = wave_sum(d);
            const float act = 0.5f * d * (1.f + erff(d * 0.70710678f));
            if (lane == (p & 63)) { if (p < 64) cf0 = gt0 * act; else cf1 = gt1 * act; }
        }
#pragma unroll
        for (int j = 0; j < 8; ++j)
#pragma unroll
            for (int e = 0; e < 8; ++e) acc[j][e] = 0.f;
#pragma unroll 1
        for (int p = 0; p < 128; ++p) {
            const int e = __builtin_amdgcn_readlane(p < 64 ? eid0 : eid1, p & 63);
            const float cf = __uint_as_float(__builtin_amdgcn_readlane(__float_as_uint(p < 64 ? cf0 : cf1), p & 63));
            const bf16* vrow = V16 + (size_t)e * DM + l8;
#pragma unroll
            for (int j = 0; j < 8; ++j) { float f[8]; unpack8(ld16(vrow + 512 * j), f);
#pragma unroll
                for (int q = 0; q < 8; ++q) acc[j][q] += cf * f[q]; }
        }
#endif
        { const float* gt2 = mod + (size_t)bb * NMOD + 5 * DM; float ss = 0.f;
#pragma unroll
          for (int j = 0; j < 8; ++j) { float g[8], hvj[8]; ldf8(gt2 + 512 * j + l8, g); ldf8(hrow + 512 * j + l8, hvj);
#pragma unroll
              for (int e = 0; e < 8; ++e) { acc[j][e] = hvj[e] + g[e] * acc[j][e]; ss += acc[j][e] * acc[j][e]; }
              PIN8(acc[j]); asm volatile("" ::: "memory"); }
          const float rstd = rsqrtf(wave_sum(ss) * (1.f / DM) + RMS_EPS);
#pragma unroll
          for (int j = 0; j < 8; ++j) { float fg[8]; const int c = 512 * j + l8; ldf8(a.in[I_FG] + c, fg);
              *(float4*)(hrow + c) = make_float4(acc[j][0] * rstd * fg[0], acc[j][1] * rstd * fg[1], acc[j][2] * rstd * fg[2], acc[j][3] * rstd * fg[3]);
              *(float4*)(hrow + c + 4) = make_float4(acc[j][4] * rstd * fg[4], acc[j][5] * rstd * fg[5], acc[j][6] * rstd * fg[6], acc[j][7] * rstd * fg[7]);
              asm volatile("" ::: "memory"); } }
    }
}

constexpr int N_PHASES = 13;
__global__ void __launch_bounds__(512, 2) hybrid_fwd(Args args) {
    extern __shared__ __attribute__((aligned(16))) unsigned char lds_raw[];
    LAS unsigned char* lds = (LAS unsigned char*)lds_raw;
    volatile LAS unsigned* MISC = (volatile LAS unsigned*)(lds + LDS_MISC);
    for (int u = TID; u < (LDS_BYTES - 131072) / 4; u += 512) ((LAS unsigned*)(lds + 131072))[u] = 0u;
    __syncthreads();
    const int lo = args.ph_lo, hi = args.ph_hi;
    XcdBarrier bar; bar.bar = (unsigned*)(args.ws + WS_CTL); bar.x = 0; bar.st = nullptr;
    if (hi - lo > 1) bar = xcd_barrier_post((unsigned*)(args.ws + WS_CTL), MISC + 8);
#define IN(k) (lo <= (k) && (k) < hi && ((MK_PHASE_MASK >> (k)) & 1))
#define SEAM(k) do { if (IN(k) && IN((k) + 1)) xcd_barrier(bar); } while (0)
    const int bid = (int)blockIdx.x, G = (int)gridDim.x;

    if (IN(0)) { ph_mod(args, lds); ph_conv(args, lds); }
    SEAM(0);
    if (IN(1)) ph_norm1(args);
    SEAM(1);
    if (IN(2)) { pg8::Gemm g{(const bf16*)(args.ws + WS_A1), (const bf16*)(args.ws + WS_WT_IN), MT, NINP, DM}; pg8::StaticOrder S; S.init(MT, NINP, G, bid);
        pg8::EpiBf16<0> E{(bf16*)(args.ws + WS_P), NINP, nullptr, 0, 0}; pg8::gemm_phase<pg8::EpiBf16<0>, pg8::StaticOrder>(lds, g, S, E, nullptr); }
    SEAM(2);
    if (IN(3)) { ph_prep_rwkv(args); ph_prep_ssd(args); }
    SEAM(3);
    if (IN(4)) { pg8::Gemm g{(const bf16*)(args.ws + WS_ALR), (const bf16*)(args.ws + WS_WLR), MT, NLR, KLR}; pg8::StaticOrder S; S.init(MT, NLR, G, bid);
        EpiLR E{(bf16*)(args.ws + WS_LR), args.in[I_W0], args.in[I_A0]}; pg8::gemm_phase<EpiLR, pg8::StaticOrder>(lds, g, S, E, nullptr); }
    SEAM(4);
    if (IN(5)) ph_rwkv_scan(args);
    SEAM(5);
    if (IN(6)) ph_ssd_scan(args);
    SEAM(6);
    if (IN(7)) ph_finish(args);
    SEAM(7);
    if (IN(8)) { pg8::Gemm g{(const bf16*)(args.ws + WS_A2), (const bf16*)(args.ws + WS_WT_OUT), MX, DM, DM}; pg8::StaticOrder S; S.init(MX, DM, G, bid);
        EpiRes E{args.out, args.in[I_X], (const float*)(args.ws + WS_MOD)}; pg8::gemm_phase<EpiRes, pg8::StaticOrder>(lds, g, S, E, nullptr); }
    SEAM(8);
    if (IN(9)) ph_norm2(args);
    SEAM(9);
    if (IN(10)) { pg8::Gemm g{(const bf16*)(args.ws + WS_XN2), (const bf16*)(args.ws + WS_WT_Q), MX, 2048, DM}; pg8::StaticOrder S; S.init(MX, 2048, G, bid);
        pg8::EpiBf16<0> E{(bf16*)(args.ws + WS_Q), 2048, nullptr, 0, 0}; pg8::gemm_phase<pg8::EpiBf16<0>, pg8::StaticOrder>(lds, g, S, E, nullptr); }
    SEAM(10);
    if (IN(11)) { pg8::Gemm g{(const bf16*)(args.ws + WS_Q), (const bf16*)(args.ws + WS_KBD), MX, 2048, 2048}; pg8::StaticOrder S; S.init(MX, 2048, G, bid);
        pg8::EpiF32 E{(float*)(args.ws + WS_S), 2048, nullptr}; pg8::gemm_phase<pg8::EpiF32, pg8::StaticOrder>(lds, g, S, E, nullptr); }
    SEAM(11);
    if (IN(12)) ph_peer(args);
#undef IN
#undef SEAM
}

extern "C" void kernel_launch(void* const* d_in, const int* in_sizes, int n_in, void* d_out, int out_size, void* d_ws, size_t ws_size, hipStream_t stream) {
    static int grid = 0;
    if (grid == 0) {
        if (n_in != N_IN || out_size != MX * DM || ws_size < WS_END) { fprintf(stderr, "kernel_launch: unexpected shapes (n_in %d out %d ws %zu)\n", n_in, out_size, ws_size); grid = -1; return; }
        int dev = 0, cus = 0, per_cu = 0;
        if (hipGetDevice(&dev) != hipSuccess || hipDeviceGetAttribute(&cus, hipDeviceAttributeMultiprocessorCount, dev) != hipSuccess) { grid = -1; return; }
        if (hipFuncSetAttribute((const void*)hybrid_fwd, hipFuncAttributeMaxDynamicSharedMemorySize, LDS_BYTES) != hipSuccess) { fprintf(stderr, "kernel_launch: hipFuncSetAttribute failed\n"); grid = -1; return; }
        if (hipOccupancyMaxActiveBlocksPerMultiprocessor(&per_cu, (const void*)hybrid_fwd, 512, LDS_BYTES) != hipSuccess || per_cu < 1) fprintf(stderr, "kernel_launch: occupancy query reports %d\n", per_cu);
        (void)hipGetLastError();
        grid = cus;
    }
    if (grid < 0) return;
    (void)in_sizes;
    if (hipMemsetAsync((char*)d_ws + WS_CTL, 0, CTL_ZERO_BYTES, stream) != hipSuccess) return;
    Args a{};
    for (int i = 0; i < N_IN; ++i) a.in[i] = (const float*)d_in[i];
    a.out = (float*)d_out; a.ws = (unsigned char*)d_ws;
#if MK_N_LAUNCHES == 1
    a.ph_lo = 0; a.ph_hi = N_PHASES;
    hipLaunchKernelGGL(hybrid_fwd, dim3(grid), dim3(512), LDS_BYTES, stream, a);
#else
    for (int ph = 0; ph < N_PHASES; ++ph) { if (!((MK_PHASE_MASK >> ph) & 1)) continue; a.ph_lo = ph; a.ph_hi = ph + 1; hipLaunchKernelGGL(hybrid_fwd, dim3(grid), dim3(512), LDS_BYTES, stream, a); }
#endif
}
```

```cpp
#include <hip/hip_runtime.h>
#include <stdint.h>
#include <stdio.h>
namespace pg8 {
#define PG8_LAS __attribute__((address_space(3)))
typedef unsigned short bf16_t;
typedef short bf16x8 __attribute__((ext_vector_type(8)));
typedef float f32x4 __attribute__((ext_vector_type(4)));
typedef unsigned u32x4 __attribute__((ext_vector_type(4)));
constexpr int BM = 256, BK = 64, HALF = 128, HTB = HALF * BK * 2  , STAGE_BYTES = 8 * HTB, NXCD = 8, WGM = 8;

__host__ __device__ __forceinline__ int lds_byte(int r, int c) { const int st = (r >> 4) * 2 + (c >> 5), rr = r & 15, cc = c & 31, ob = rr * 64 + cc * 2; return st * 1024 + (ob ^ (((ob >> 9) & 1) << 5)); }
__host__ __device__ __forceinline__ void stage_rc(int b, int& R, int& C) { const int st = b / 1024, sb = b % 1024, swz = sb ^ (((sb >> 9) & 1) << 5); R = (st >> 1) * 16 + swz / 64; C = (st & 1) * 32 + (swz % 64) / 2; }
__host__ __device__ __forceinline__ int perm32(int rho) { const int n = rho >> 4, i = rho & 15; return 8 * (i >> 2) + 4 * n + (i & 3); }

struct Unit { int pm, pn; };
struct Gemm { const bf16_t* A; const bf16_t* Bt; int M, N, K; };

struct StaticOrder {
    int nM, nN, nwg, G, c;
    __host__ __device__ void init(int M, int N, int G_, int c_) { nM = M / BM; nN = N / BM; nwg = nM * nN; G = G_; c = c_; }
    __host__ __device__ bool next(int i, Unit& u) const {
        const long L = (long)i * G + c; if (L >= nwg) return false;
        int wgid = (int)L; { const int q = nwg / NXCD, r = nwg % NXCD, xcd = wgid % NXCD, off = wgid / NXCD; wgid = (xcd < r ? xcd * (q + 1) : r * (q + 1) + (xcd - r) * q) + off; }
        const int nig = WGM * nN, gid = wgid / nig, fm = gid * WGM, gsz = (nM - fm) < WGM ? (nM - fm) : WGM;
        u.pm = fm + ((wgid % nig) % gsz); u.pn = (wgid % nig) / gsz; return true;
    }
    __device__ __forceinline__ void a_ready(const Unit&) const {}
    __device__ __forceinline__ void done(const Unit&) const {}
};
__device__ __forceinline__ unsigned cvt_pk_bf16(float lo, float hi) { unsigned r; asm volatile("v_cvt_pk_bf16_f32 %0, %1, %2" : "=v"(r) : "v"(lo), "v"(hi)); return r; }
typedef float f32x2 __attribute__((ext_vector_type(2)));
__device__ __forceinline__ f32x2 gelu_pk(f32x2 v) {
    const f32x2 av = __builtin_elementwise_abs(v), d = av * 0.2316418882f + 1.0f;
    f32x2 t; t.x = __builtin_amdgcn_rcpf(d.x); t.y = __builtin_amdgcn_rcpf(d.y);
    f32x2 q = t * 0.5307027145f + (-0.7265760135f); q = q * t + 0.7107068705f; q = q * t + (-0.142248368f); q = q * t + 0.127414796f; q = q * t;
    const f32x2 s = (v * v) * (-0.72134752044f);
    f32x2 e; e.x = __builtin_amdgcn_exp2f(s.x); e.y = __builtin_amdgcn_exp2f(s.y);
    const f32x2 m = v * (q * e), r = v - m;
    f32x2 o; o.x = v.x < 0.f ? m.x : r.x; o.y = v.y < 0.f ? m.y : r.y; return o;
}

struct EpiF32 {
    static constexpr bool PERM = false, AFTER_DRAIN = false;
    float* C; int ldc; const float* bias;
    __device__ __forceinline__ void operator()(const f32x4 (&acc)[2][2][4][2], const Unit& u, int wr, int wc, int fr, int fq) const {
        const int row0 = u.pm * BM + wr * 64 + fr, col0 = u.pn * BM + wc * 32 + 4 * fq;
        f32x4 bv[2][2];
#pragma unroll
        for (int bj = 0; bj < 2; ++bj)
#pragma unroll
            for (int n = 0; n < 2; ++n) bv[bj][n] = bias ? *(const f32x4*)(bias + col0 + bj * HALF + n * 16) : (f32x4){0.f, 0.f, 0.f, 0.f};
#pragma unroll
        for (int ai = 0; ai < 2; ++ai)
#pragma unroll
            for (int m = 0; m < 4; ++m) { float* rowp = C + (size_t)(row0 + ai * HALF + m * 16) * ldc + col0;
#pragma unroll
                for (int bj = 0; bj < 2; ++bj)
#pragma unroll
                    for (int n = 0; n < 2; ++n) *(f32x4*)(rowp + bj * HALF + n * 16) = acc[ai][bj][m][n] + bv[bj][n]; }
    }
};
template <int ACT  > struct EpiBf16 {
    static constexpr bool PERM = true, AFTER_DRAIN = false;
    bf16_t* O; int ldc; const float* bias; int split_cols; size_t split_stride;
    __device__ __forceinline__ void operator()(const f32x4 (&acc)[2][2][4][2], const Unit& u, int wr, int wc, int fr, int fq) const {
        const int row0 = u.pm * BM + wr * 64 + fr; int colt = u.pn * BM; bf16_t* base = O;
        if (split_cols) { const int t = colt / split_cols; base += (size_t)t * split_stride; colt -= t * split_cols; }
        const int col0 = colt + wc * 32 + 8 * fq, bcol0 = u.pn * BM + wc * 32 + 8 * fq;
        f32x4 bv[2][2];
#pragma unroll
        for (int bj = 0; bj < 2; ++bj)
#pragma unroll
            for (int n = 0; n < 2; ++n) bv[bj][n] = bias ? *(const f32x4*)(bias + bcol0 + bj * HALF + 4 * n) : (f32x4){0.f, 0.f, 0.f, 0.f};
#pragma unroll
        for (int ai = 0; ai < 2; ++ai)
#pragma unroll
            for (int m = 0; m < 4; ++m) { bf16_t* rowp = base + (size_t)(row0 + ai * HALF + m * 16) * ldc + col0;
#pragma unroll
                for (int bj = 0; bj < 2; ++bj) { f32x4 v0 = acc[ai][bj][m][0] + bv[bj][0], v1 = acc[ai][bj][m][1] + bv[bj][1];
                    if (ACT == 1) { f32x2 a = gelu_pk((f32x2){v0[0], v0[1]}), b = gelu_pk((f32x2){v0[2], v0[3]}), c = gelu_pk((f32x2){v1[0], v1[1]}), d = gelu_pk((f32x2){v1[2], v1[3]});
                        v0 = (f32x4){a.x, a.y, b.x, b.y}; v1 = (f32x4){c.x, c.y, d.x, d.y}; }
                    if (ACT == 2) {
#pragma unroll
                        for (int j = 0; j < 4; ++j) { v0[j] = 0.5f * v0[j] * (1.0f + erff(v0[j] * 0.70710678f)); v1[j] = 0.5f * v1[j] * (1.0f + erff(v1[j] * 0.70710678f)); } }
                    u32x4 w; w.x = cvt_pk_bf16(v0[0], v0[1]); w.y = cvt_pk_bf16(v0[2], v0[3]); w.z = cvt_pk_bf16(v1[0], v1[1]); w.w = cvt_pk_bf16(v1[2], v1[3]);
                    *(u32x4*)(rowp + bj * HALF) = w; } }
    }
};
template <class Epi, class Sched, bool STAMP = false>
__device__ __forceinline__ void gemm_phase(PG8_LAS unsigned char* lds, const Gemm g, const Sched& S, const Epi& E, unsigned long long* stamps) {
    const int tid = threadIdx.x, wid = __builtin_amdgcn_readfirstlane(tid >> 6), lane = tid & 63, wr = wid >> 2, wc = wid & 3, fr = lane & 15, fq = lane >> 4;
    const int K = g.K, nt = K / BK;
    int ts_lo = 0, ts_hi = 0, nts = 0; const unsigned long long rt_entry = STAMP ? (unsigned long long)wall_clock64() : 0ull;
#define PG8_STAMP() do { if (STAMP && wid == 0 && nts < 64) { const unsigned long long _c = (unsigned long long)clock64(); \
        ts_lo = (lane == nts) ? (int)(unsigned)_c : ts_lo; ts_hi = (lane == nts) ? (int)(unsigned)(_c >> 32) : ts_hi; ++nts; } } while (0)
    PG8_STAMP();
    unsigned voffA[2], voffB[2];
#pragma unroll
    for (int i = 0; i < 2; ++i) { int R, C; stage_rc(tid * 16 + i * 8192, R, C); const int Rb = Epi::PERM ? ((R & ~31) + perm32(R & 31)) : R;
        voffA[i] = (unsigned)(R * K + C) * 2u; voffB[i] = (unsigned)(Rb * K + C) * 2u; }
    const size_t kstep = (size_t)(BK * 2);
    const size_t hstep = (size_t)HALF * K * 2;
    const size_t tstep = 2 * hstep;
    const unsigned ldsw = (unsigned)wid * 1024u;
    const int aoff = lds_byte(wr * 64 + fr, fq * 8), boff = lds_byte(wc * 32 + fr, fq * 8);
#define PG8_SA(b, h) (((b) * 2 + (h)) * HTB)
#define PG8_SB(b, h) ((4 + (b) * 2 + (h)) * HTB)
#define PG8_STAGE(bufoff, gbase, voff) do { _Pragma("unroll") for (int _i = 0; _i < 2; ++_i) \
        __builtin_amdgcn_global_load_lds((const unsigned*)((const char*)(gbase) + (voff)[_i]), (PG8_LAS unsigned*)(lds + (bufoff) + ldsw + _i * 8192), 16, 0, 0); } while (0)
#define PG8_LDA(dst, b, h) do { _Pragma("unroll") for (int m = 0; m < 4; ++m) _Pragma("unroll") for (int k = 0; k < 2; ++k) dst[m][k] = *(const PG8_LAS bf16x8*)(lds + PG8_SA(b, h) + aoff + m * 2048 + k * 1024); } while (0)
#define PG8_LDB(dst, b, h) do { _Pragma("unroll") for (int n = 0; n < 2; ++n) _Pragma("unroll") for (int k = 0; k < 2; ++k) dst[n][k] = *(const PG8_LAS bf16x8*)(lds + PG8_SB(b, h) + boff + n * 2048 + k * 1024); } while (0)
#define PG8_MMA(ai, bj, At, Bt) do { __builtin_amdgcn_s_setprio(1); _Pragma("unroll") for (int m = 0; m < 4; ++m) _Pragma("unroll") for (int n = 0; n < 2; ++n) _Pragma("unroll") for (int k = 0; k < 2; ++k) \
        acc[ai][bj][m][n] = __builtin_amdgcn_mfma_f32_16x16x32_bf16(Bt[n][k], At[m][k], acc[ai][bj][m][n], 0, 0, 0); __builtin_amdgcn_s_setprio(0); } while (0)
#define PG8_WAIT_V(n) asm volatile("s_waitcnt vmcnt(" #n ")" ::: "memory")
#define PG8_WAIT_L(n) asm volatile("s_waitcnt lgkmcnt(" #n ")" ::: "memory")
#define PG8_BAR __builtin_amdgcn_s_barrier()
#define PG8_SCHED __builtin_amdgcn_sched_barrier(0)
    Unit cur, nxt; int ui = 0;
    if (!S.next(0, cur)) return;
    f32x4 acc[2][2][4][2];
#pragma unroll
    for (int a = 0; a < 2; ++a)
#pragma unroll
        for (int b = 0; b < 2; ++b)
#pragma unroll
            for (int m = 0; m < 4; ++m)
#pragma unroll
                for (int n = 0; n < 2; ++n) acc[a][b][m][n] = (f32x4){0.f, 0.f, 0.f, 0.f};
    bf16x8 At[4][2], B0[2][2], B1[2][2];
    const char* cA = (const char*)g.A + (size_t)cur.pm * tstep; const char* cB = (const char*)g.Bt + (size_t)cur.pn * tstep;
    S.a_ready(cur);
    PG8_STAGE(PG8_SB(0, 0), cB, voffB); PG8_STAGE(PG8_SA(0, 0), cA, voffA); PG8_STAGE(PG8_SB(0, 1), cB + hstep, voffB); PG8_STAGE(PG8_SA(0, 1), cA + hstep, voffA);
    if (wr == 1) PG8_BAR;
    PG8_WAIT_V(4); PG8_BAR;
    PG8_STAGE(PG8_SB(1, 0), cB + kstep, voffB); PG8_STAGE(PG8_SA(1, 0), cA + kstep, voffA); PG8_STAGE(PG8_SB(1, 1), cB + hstep + kstep, voffB);
    PG8_WAIT_V(6); PG8_BAR;
    PG8_STAMP();
    for (;;) {
        const bool has_next = S.next(ui + 1, nxt);
        const char* nA = has_next ? (const char*)g.A + (size_t)nxt.pm * tstep : cA; const char* nB = has_next ? (const char*)g.Bt + (size_t)nxt.pn * tstep : cB;
        for (int t = 0; t < nt; t += 2) {
            const bool last = (t == nt - 2);
            const char* a1 = cA + (size_t)(t + 1) * kstep;
            const char* a2 = last ? nA : cA + (size_t)(t + 2) * kstep; const char* b2 = last ? nB : cB + (size_t)(t + 2) * kstep;
            const char* a3 = a2 + kstep; const char* b3 = b2 + kstep;
            if (last && has_next) S.a_ready(nxt);
            PG8_LDB(B0, 0, 0); PG8_SCHED; PG8_LDA(At, 0, 0); PG8_STAGE(PG8_SA(1, 1), a1 + hstep, voffA);
            PG8_WAIT_L(8); PG8_BAR; PG8_WAIT_L(0); PG8_MMA(0, 0, At, B0); PG8_BAR; PG8_SCHED;
            PG8_LDB(B1, 0, 1); PG8_STAGE(PG8_SB(0, 0), b2, voffB);
            PG8_BAR; PG8_WAIT_L(0); PG8_MMA(0, 1, At, B1); PG8_BAR;
            PG8_LDA(At, 0, 1); PG8_STAGE(PG8_SA(0, 0), a2, voffA);
            PG8_BAR; PG8_WAIT_L(0); PG8_MMA(1, 0, At, B0); PG8_BAR; PG8_SCHED;
            PG8_STAGE(PG8_SB(0, 1), b2 + hstep, voffB);
            PG8_WAIT_V(6); PG8_BAR; PG8_MMA(1, 1, At, B1); PG8_BAR;
            PG8_LDB(B0, 1, 0); PG8_SCHED; PG8_LDA(At, 1, 0); PG8_STAGE(PG8_SA(0, 1), a2 + hstep, voffA);
            PG8_WAIT_L(8); PG8_BAR; PG8_WAIT_L(0); PG8_MMA(0, 0, At, B0); PG8_BAR; PG8_SCHED;
            PG8_LDB(B1, 1, 1); PG8_STAGE(PG8_SB(1, 0), b3, voffB);
            PG8_BAR; PG8_WAIT_L(0); PG8_MMA(0, 1, At, B1); PG8_BAR;
            PG8_LDA(At, 1, 1); PG8_STAGE(PG8_SA(1, 0), a3, voffA);
            PG8_BAR; PG8_WAIT_L(0); PG8_MMA(1, 0, At, B0); PG8_BAR; PG8_SCHED;
            PG8_STAGE(PG8_SB(1, 1), b3 + hstep, voffB);
            PG8_WAIT_V(6); PG8_BAR; PG8_MMA(1, 1, At, B1); PG8_BAR;
        }
        PG8_STAMP();
        if constexpr (!Epi::AFTER_DRAIN) { E(acc, cur, wr, wc, fr, fq); S.done(cur); }
        PG8_STAMP();
        if (!has_next) break;
#pragma unroll
        for (int a = 0; a < 2; ++a)
#pragma unroll
            for (int b = 0; b < 2; ++b)
#pragma unroll
                for (int m = 0; m < 4; ++m)
#pragma unroll
                    for (int n = 0; n < 2; ++n) acc[a][b][m][n] = (f32x4){0.f, 0.f, 0.f, 0.f};
        cur = nxt; cA = nA; cB = nB; ++ui;
    }
    PG8_WAIT_V(0);
    if (wr == 0) PG8_BAR;
    PG8_BAR;
    if constexpr (Epi::AFTER_DRAIN) { E.fused(acc, cur, wr, wc, fr, fq, lds, wid, lane); S.done(cur); }
    PG8_STAMP();
    if (STAMP && wid == 0) { stamps[lane] = lane < nts ? (((unsigned long long)(unsigned)ts_hi << 32) | (unsigned)ts_lo) : 0ull;
        if (lane == 62) stamps[62] = rt_entry; if (lane == 63) stamps[63] = (unsigned long long)wall_clock64(); }
#undef PG8_STAMP
#undef PG8_SA
#undef PG8_SB
#undef PG8_STAGE
#undef PG8_LDA
#undef PG8_LDB
#undef PG8_MMA
#undef PG8_WAIT_V
#undef PG8_WAIT_L
#undef PG8_BAR
#undef PG8_SCHED
}
}

#define LAS __attribute__((address_space(3)))
typedef unsigned short bf16;
typedef float f32x4 __attribute__((ext_vector_type(4)));

#ifndef MK_N_LAUNCHES
#define MK_N_LAUNCHES 1
#endif
#ifndef MK_PHASE_MASK
#define MK_PHASE_MASK 0x1FFF
#endif
#ifndef MK_REPEAT
#define MK_REPEAT -1
#endif
#ifndef MK_SKIP_MIXER
#define MK_SKIP_MIXER 0
#endif
#ifndef MK_SKIP_PEER
#define MK_SKIP_PEER 0
#endif
#ifndef MK_SKIP_RWKV
#define MK_SKIP_RWKV 0
#endif
#ifndef MK_SKIP_SSD
#define MK_SKIP_SSD 0
#endif

constexpr int DM = 4096, NBATCH = 4, SEQ = 4096, CTXL = 256;
constexpr int MX = NBATCH * SEQ;
constexpr int MC = NBATCH * CTXL;
constexpr int MT = MX + MC;
constexpr int RW = 2048;
constexpr int RCOLS = 6784;
constexpr int NIN = 12992, NINP = 13056;
constexpr int COL_Z = 6784, COL_XBC = 8832, COL_DT = 12928;
constexpr int NLR = 10240, KLR = 640;
constexpr int NMOD = 6 * DM;
constexpr float RMS_EPS = 1e-6f, GN_EPS = 64e-5f;
constexpr int NSTEP = CTXL + SEQ;

constexpr size_t MiB = (size_t)1 << 20;
constexpr size_t WS_CTL = 0, CTL_ZERO_BYTES = 1 * MiB;
constexpr size_t WS_MOD = 64 * 1024;
constexpr size_t WS_WT_OUT = 2 * MiB;
constexpr size_t WS_WT_Q = 34 * MiB;
constexpr size_t WS_WLR = 50 * MiB;
constexpr size_t WS_KBD = 63 * MiB;
constexpr size_t WS_DT = 71 * MiB;
constexpr size_t WS_LA = WS_DT + (size_t)MT * 64 * 4;
constexpr size_t WS_ALR = 80 * MiB;
constexpr size_t WS_WT_IN = 102 * MiB;
constexpr size_t WS_A1 = 204 * MiB;
constexpr size_t WS_P = 340 * MiB;
constexpr size_t WS_R = 774 * MiB, WS_K = 842 * MiB, WS_V = 910 * MiB, WS_KK = 978 * MiB;
constexpr size_t WS_XS = 1046 * MiB, WS_BC = 1114 * MiB;
constexpr size_t WS_Z = 102 * MiB;
constexpr size_t WS_LR = 340 * MiB;
constexpr size_t WS_A2 = 166 * MiB;
constexpr size_t WS_XN2 = 340 * MiB;
constexpr size_t WS_Q = 468 * MiB;
constexpr size_t WS_S = 532 * MiB;
constexpr size_t WS_U8 = 774 * MiB, WS_V8 = 838 * MiB;
constexpr size_t WS_USC = 902 * MiB, WS_VSC = WS_USC + 65536;
constexpr size_t WS_END = 1182 * MiB;
static_assert(WS_WT_IN + (size_t)NINP * DM * 2 <= WS_A1 && WS_A1 + (size_t)MT * DM * 2 <= WS_P && WS_P + (size_t)MT * NINP * 2 <= WS_R, "ws map 1");
static_assert(WS_LR + (size_t)MT * NLR * 2 <= WS_R && WS_Z + (size_t)MX * RW * 2 <= WS_A2 && WS_A2 + (size_t)MX * DM * 2 <= WS_P, "ws map 2");
static_assert(WS_LA + (size_t)MT * 64 * 4 <= WS_ALR && WS_ALR + (size_t)MT * KLR * 2 <= WS_WT_IN && WS_WLR + (size_t)NLR * KLR * 2 <= WS_KBD, "ws map 3");
static_assert(WS_S + (size_t)MX * 2048 * 4 <= WS_R && WS_VSC + 65536 <= WS_XS, "ws map 4");

constexpr int LDS_BYTES = 147456;
constexpr int LDS_MISC = 131072 + 320;

enum { I_X = 0, I_C, I_CTX, I_CCTX, I_WMOD, I_BMOD, I_N1G, I_N2G, I_WIN, I_WOUT, I_MU, I_W0, I_W2, I_A0, I_A2, I_G2, I_KK, I_KA, I_RK, I_LNW, I_LNB,
       I_CONVW, I_CONVB, I_DTB, I_ALOG, I_SSMD, I_NORMW, I_WQ, I_K1, I_K2, I_PU, I_PV, I_FG, N_IN };

struct Args { const float* in[N_IN]; float* out; unsigned char* ws; int ph_lo, ph_hi; };

__device__ __forceinline__ unsigned f2bf(float f) { unsigned u = __float_as_uint(f); return (u + 0x7fffu + ((u >> 16) & 1u)) >> 16; }
__device__ __forceinline__ unsigned pk2(float lo, float hi) { return f2bf(lo) | (f2bf(hi) << 16); }
__device__ __forceinline__ float bflo(unsigned u) { return __uint_as_float(u << 16); }
__device__ __forceinline__ float bfhi(unsigned u) { return __uint_as_float(u & 0xffff0000u); }
__device__ __forceinline__ void unpack8(const uint4& u, float (&f)[8]) {
    f[0] = bflo(u.x); f[1] = bfhi(u.x); f[2] = bflo(u.y); f[3] = bfhi(u.y); f[4] = bflo(u.z); f[5] = bfhi(u.z); f[6] = bflo(u.w); f[7] = bfhi(u.w);
}
__device__ __forceinline__ uint4 pack8(const float (&f)[8]) { uint4 u; u.x = pk2(f[0], f[1]); u.y = pk2(f[2], f[3]); u.z = pk2(f[4], f[5]); u.w = pk2(f[6], f[7]); return u; }
__device__ __forceinline__ uint4 ld16(const bf16* p) { return *(const uint4*)p; }
__device__ __forceinline__ void st16(bf16* p, const uint4& v) { *(uint4*)p = v; }
__device__ __forceinline__ void ldf8(const float* p, float (&f)[8]) { const float4 a = *(const float4*)p, b = *(const float4*)(p + 4); f[0] = a.x; f[1] = a.y; f[2] = a.z; f[3] = a.w; f[4] = b.x; f[5] = b.y; f[6] = b.z; f[7] = b.w; }
#define PIN8(a) asm volatile("" : "+v"((a)[0]), "+v"((a)[1]), "+v"((a)[2]), "+v"((a)[3]), "+v"((a)[4]), "+v"((a)[5]), "+v"((a)[6]), "+v"((a)[7]))
template <int CTRL> __device__ __forceinline__ float dppf(float v) { return __uint_as_float((unsigned)__builtin_amdgcn_update_dpp(0, (int)__float_as_uint(v), CTRL, 0xF, 0xF, true)); }
__device__ __forceinline__ float rlane(float v, int l) { return __uint_as_float((unsigned)__builtin_amdgcn_readlane((int)__float_as_uint(v), l)); }
__device__ __forceinline__ float sum8(float v) { v += dppf<0xB1>(v); v += dppf<0x4E>(v); v += dppf<0x141>(v); return v; }
__device__ __forceinline__ float sum16(float v) { v = sum8(v); v += dppf<0x140>(v); return v; }
__device__ __forceinline__ float sum32(float v) { v = sum16(v); v += __shfl_xor(v, 16); return v; }
__device__ __forceinline__ float wave_sum(float v) { v = sum16(v); return (rlane(v, 0) + rlane(v, 16)) + (rlane(v, 32) + rlane(v, 48)); }
__device__ __forceinline__ float wave_max(float v) {
    v = fmaxf(v, dppf<0xB1>(v)); v = fmaxf(v, dppf<0x4E>(v)); v = fmaxf(v, dppf<0x141>(v)); v = fmaxf(v, dppf<0x140>(v));
    return fmaxf(fmaxf(rlane(v, 0), rlane(v, 16)), fmaxf(rlane(v, 32), rlane(v, 48)));
}
__device__ __forceinline__ float sigmoidf_(float x) { return 1.f / (1.f + __expf(-x)); }
__device__ __forceinline__ float siluf_(float x) { return x / (1.f + __expf(-x)); }

struct EpiLR {
    static constexpr bool PERM = true, AFTER_DRAIN = false;
    bf16* O; const float* w0; const float* a0;
    __device__ __forceinline__ void operator()(const pg8::f32x4 (&acc)[2][2][4][2], const pg8::Unit& u, int wr, int wc, int fr, int fq) const {
        const int row0 = u.pm * 256 + wr * 64 + fr; const int colt = u.pn * 256; const int type = colt >> 11;
        const int col0 = colt + wc * 32 + 8 * fq;
        const float* bias = type < 2 ? (w0 + type * 2048) : (a0 + (type - 2) * 2048);
        pg8::f32x4 bv[2][2];
#pragma unroll
        for (int bj = 0; bj < 2; ++bj)
#pragma unroll
            for (int n = 0; n < 2; ++n) bv[bj][n] = type < 4 ? *(const pg8::f32x4*)(bias + ((col0 + bj * 128 + 4 * n) & 2047)) : (pg8::f32x4){0.f, 0.f, 0.f, 0.f};
#pragma unroll
        for (int ai = 0; ai < 2; ++ai)
#pragma unroll
            for (int m = 0; m < 4; ++m) { bf16* rowp = O + (size_t)(row0 + ai * 128 + m * 16) * NLR + col0;
#pragma unroll
                for (int bj = 0; bj < 2; ++bj) { pg8::f32x4 v0 = acc[ai][bj][m][0] + bv[bj][0], v1 = acc[ai][bj][m][1] + bv[bj][1];
                    if (type < 4) {
#pragma unroll
                        for (int j = 0; j < 4; ++j) { float s0 = 1.f / (1.f + __expf(-v0[j])), s1 = 1.f / (1.f + __expf(-v1[j]));
                            if (type < 2) { s0 = -expm1f(-0.60653066f * s0); s1 = -expm1f(-0.60653066f * s1); }
                            v0[j] = s0; v1[j] = s1; } }
                    pg8::u32x4 w; w.x = pg8::cvt_pk_bf16(v0[0], v0[1]); w.y = pg8::cvt_pk_bf16(v0[2], v0[3]); w.z = pg8::cvt_pk_bf16(v1[0], v1[1]); w.w = pg8::cvt_pk_bf16(v1[2], v1[3]);
                    *(pg8::u32x4*)(rowp + bj * 128) = w; } }
    }
};
struct EpiRes {
    static constexpr bool PERM = false, AFTER_DRAIN = false;
    float* C; const float* X; const float* mod;
    __device__ __forceinline__ void operator()(const pg8::f32x4 (&acc)[2][2][4][2], const pg8::Unit& u, int wr, int wc, int fr, int fq) const {
        const int row0 = u.pm * 256 + wr * 64 + fr, col0 = u.pn * 256 + wc * 32 + 4 * fq;
        const float* gt = mod + (size_t)((u.pm * 256) / SEQ) * NMOD + 2 * DM;
        pg8::f32x4 gv[2][2];
#pragma unroll
        for (int bj = 0; bj < 2; ++bj)
#pragma unroll
            for (int n = 0; n < 2; ++n) gv[bj][n] = *(const pg8::f32x4*)(gt + col0 + bj * 128 + n * 16);
#pragma unroll
        for (int ai = 0; ai < 2; ++ai)
#pragma unroll
            for (int m = 0; m < 4; ++m) { const size_t off = (size_t)(row0 + ai * 128 + m * 16) * DM + col0;
#pragma unroll
                for (int bj = 0; bj < 2; ++bj)
#pragma unroll
                    for (int n = 0; n < 2; ++n) { const pg8::f32x4 xv = *(const pg8::f32x4*)(X + off + bj * 128 + n * 16);
#if MK_SKIP_MIXER
                        *(pg8::f32x4*)(C + off + bj * 128 + n * 16) = xv;
#else
                        *(pg8::f32x4*)(C + off + bj * 128 + n * 16) = xv + gv[bj][n] * acc[ai][bj][m][n];
#endif
                    }
                asm volatile("" ::: "memory"); }
    }
};

#define XB_TMO      128
#define XB_XCNT(j)  (256  + 64 * (j))
#define XB_XSUB(j)  (1280 + 64 * (j))
#define XB_XGEN(j)  (2304 + 64 * (j))
#define XB_TOP      3328
#define XB_TOPGEN   3392
#define XCD_BAR_WORDS 3456
#define XB_SPIN_CAP (1u << 18)
__device__ __forceinline__ unsigned xb_ld(unsigned* p)              { return __hip_atomic_load(p, __ATOMIC_RELAXED, __HIP_MEMORY_SCOPE_AGENT); }
__device__ __forceinline__ unsigned xb_add(unsigned* p, unsigned v) { return __hip_atomic_fetch_add(p, v, __ATOMIC_RELAXED, __HIP_MEMORY_SCOPE_AGENT); }
__device__ __forceinline__ unsigned xb_xcc_id() { return (unsigned)__builtin_amdgcn_s_getreg((3 << 11) | 20) & 0xFu; }
#define XB_SPIN(cond, bar) do { unsigned _sp = 0; while (cond) { __builtin_amdgcn_s_sleep(1); \
    if ((++_sp & 255u) == 0u) { if (xb_ld(&(bar)[XB_TMO])) break; if (_sp > XB_SPIN_CAP) { atomicAdd(&(bar)[XB_TMO], 1u); break; } } } } while (0)
struct XcdBarrier { unsigned* bar; unsigned x; volatile LAS unsigned* st; };
__device__ __forceinline__ XcdBarrier xcd_barrier_post(unsigned* bar, volatile LAS unsigned* st) {
    XcdBarrier b; b.bar = bar; b.x = xb_xcc_id(); b.st = st;
    if (threadIdx.x == 0) (void)xb_add(&bar[XB_XCNT(b.x)], 1u);
    return b;
}
__device__ __forceinline__ void xcd_barrier_complete(unsigned* bar, unsigned x, unsigned& nloc, unsigned& nx) {
    const unsigned G = gridDim.x * gridDim.y * gridDim.z;
    unsigned sum, cnt, mine, sp = 0u;
    for (;;) {
        sum = 0u; cnt = 0u; mine = 0u;
#pragma unroll
        for (unsigned j = 0; j < 16; ++j) { const unsigned c = xb_ld(&bar[XB_XCNT(j)]); sum += c; cnt += (c > 0u) ? 1u : 0u; mine = (j == x) ? c : mine; }
        if (sum == G) break;
        __builtin_amdgcn_s_sleep(1);
        if ((++sp & 255u) == 0u) { if (xb_ld(&bar[XB_TMO])) break; if (sp > XB_SPIN_CAP) { atomicAdd(&bar[XB_TMO], 1u); break; } }
    }
    nloc = mine > 0u ? mine : 1u; nx = cnt > 0u ? cnt : 1u;
}
__device__ __forceinline__ void xcd_barrier(const XcdBarrier& b) {
    asm volatile("s_waitcnt vmcnt(0)" ::: "memory");
    __syncthreads();
    if (threadIdx.x == 0) {
        unsigned* bar = b.bar;
        __builtin_amdgcn_s_waitcnt(0);
        unsigned nloc = b.st[0], nx = b.st[1];
        if (nloc == 0u) { xcd_barrier_complete(bar, b.x, nloc, nx); b.st[0] = nloc; b.st[1] = nx; }
        const unsigned old = xb_add(&bar[XB_XSUB(b.x)], 1u);
        const unsigned gen = old / nloc;
        if (old + 1u == (gen + 1u) * nloc) {
            __builtin_amdgcn_fence(__ATOMIC_RELEASE, "agent");
            asm volatile("s_waitcnt vmcnt(0)" ::: "memory");
            const unsigned og = xb_add(&bar[XB_TOP], 1u);
            const unsigned tg = og / nx;
            if (og + 1u == (tg + 1u) * nx) xb_add(&bar[XB_TOPGEN], 1u);
            else XB_SPIN(xb_ld(&bar[XB_TOPGEN]) == tg, bar);
            __builtin_amdgcn_fence(__ATOMIC_ACQUIRE, "agent");
            xb_add(&bar[XB_XGEN(b.x)], 1u);
            asm volatile("s_waitcnt vmcnt(0)" ::: "memory");
        } else {
            XB_SPIN(xb_ld(&bar[XB_XGEN(b.x)]) == gen, bar);
            __builtin_amdgcn_fence(__ATOMIC_ACQUIRE, "agent");
            asm volatile("s_waitcnt vmcnt(0)" ::: "memory");
        }
    }
    __syncthreads();
}

#define TID ((int)threadIdx.x)
#define LANE ((int)(threadIdx.x & 63))
#define WAVE ((int)__builtin_amdgcn_readfirstlane((int)(threadIdx.x >> 6)))
#define GW ((int)blockIdx.x * 8 + WAVE)
#define NGW ((int)gridDim.x * 8)

__device__ __forceinline__ void ph_mod(const Args& a, LAS unsigned char* lds) {
    const float* c = a.in[I_C]; const float* cc = a.in[I_CCTX]; const float* w_mod = a.in[I_WMOD]; const float* b_mod = a.in[I_BMOD];
    float* mod = (float*)(a.ws + WS_MOD);
    LAS float* sS = (LAS float*)lds;
    LAS float* red = (LAS float*)(lds + 81920);
    const int tid = TID, lane = LANE, wave = WAVE;
    if ((int)blockIdx.x < 192) {
        for (int i = tid; i < 5 * DM; i += 512) { const int v = i >> 12, k = i & (DM - 1); const float xv = v < 4 ? c[v * DM + k] : cc[k]; sS[i] = xv / (1.f + expf(-xv)); }
    }
    __syncthreads();
    for (int u = blockIdx.x; u < 192; u += gridDim.x) {
        const int cl = lane & 31, kh = lane >> 5;
        float acc[5][4];
#pragma unroll
        for (int v = 0; v < 5; ++v)
#pragma unroll
            for (int e = 0; e < 4; ++e) acc[v][e] = 0.f;
        const float* wp = w_mod + (size_t)(wave * 512 + kh) * NMOD + u * 128 + cl * 4;
#pragma unroll 8
        for (int i = 0; i < 256; ++i) {
            const float4 w = *(const float4*)(wp + (size_t)(2 * i) * NMOD);
#pragma unroll
            for (int v = 0; v < 5; ++v) { const float s = sS[v * DM + wave * 512 + 2 * i + kh]; acc[v][0] += s * w.x; acc[v][1] += s * w.y; acc[v][2] += s * w.z; acc[v][3] += s * w.w; }
        }
#pragma unroll
        for (int v = 0; v < 5; ++v)
#pragma unroll
            for (int e = 0; e < 4; ++e) acc[v][e] += __shfl_xor(acc[v][e], 32);
        if (kh == 0) {
#pragma unroll
            for (int v = 0; v < 5; ++v) *(LAS f32x4*)(red + ((wave * 5 + v) * 128 + cl * 4)) = (f32x4){acc[v][0], acc[v][1], acc[v][2], acc[v][3]};
        }
        __syncthreads();
        for (int i = tid; i < 640; i += 512) { const int v = i >> 7, n = i & 127; float s = b_mod[u * 128 + n];
#pragma unroll
            for (int w = 0; w < 8; ++w) s += red[(w * 5 + v) * 128 + n];
            mod[v * NMOD + u * 128 + n] = s; }
        __syncthreads();
    }
    __syncthreads();
}

__device__ __forceinline__ void transpose_item(const float* W, int K, int N, bf16* WT, LAS float* scr, int item, int lane) {
    const int nblk = N / 32, kb = item / nblk, nb = item % nblk, k0 = 64 * kb, n0 = 32 * nb;
#pragma unroll 8
    for (int i = 0; i < 32; ++i) { const int kk = 2 * i + (lane >> 5); scr[kk * 33 + (lane & 31)] = W[(size_t)(k0 + kk) * N + n0 + (lane & 31)]; }
    asm volatile("s_waitcnt lgkmcnt(0)" ::: "memory");
    const int c = lane & 7;
#pragma unroll
    for (int j = 0; j < 4; ++j) { const int n = (lane >> 3) + 8 * j; const LAS float* s = scr + (8 * c) * 33 + n;
        uint4 o; o.x = pk2(s[0 * 33], s[1 * 33]); o.y = pk2(s[2 * 33], s[3 * 33]); o.z = pk2(s[4 * 33], s[5 * 33]); o.w = pk2(s[6 * 33], s[7 * 33]);
        *(uint4*)(WT + (size_t)(n0 + n) * K + k0 + 8 * c) = o; }
    asm volatile("s_waitcnt lgkmcnt(0)" ::: "memory");
}
__device__ __forceinline__ void ph_conv(const Args& a, LAS unsigned char* lds) {
    const int lane = LANE, wave = WAVE, gw = GW, ngw = NGW;
    LAS float* scr = (LAS float*)(lds + wave * 16384);
    bf16* wt_in = (bf16*)(a.ws + WS_WT_IN); bf16* wt_out = (bf16*)(a.ws + WS_WT_OUT); bf16* wt_q = (bf16*)(a.ws + WS_WT_Q);
    constexpr int IT_IN = (DM / 64) * (NIN / 32), IT_OUT = (DM / 64) * (DM / 32), IT_Q = (DM / 64) * (2048 / 32);
    for (int it = gw; it < IT_IN + IT_OUT + IT_Q; it += ngw) {
        int r = it;
        if (r < IT_IN) { transpose_item(a.in[I_WIN], DM, NIN, wt_in, scr, r, lane); continue; } r -= IT_IN;
        if (r < IT_OUT) { transpose_item(a.in[I_WOUT], DM, DM, wt_out, scr, r, lane); continue; } r -= IT_OUT;
        transpose_item(a.in[I_WQ], DM, 2048, wt_q, scr, r, lane);
    }
    const int gt = blockIdx.x * 512 + TID, ngt = gridDim.x * 512;
    for (int i = gt; i < (NINP - NIN) * DM / 8; i += ngt) *(uint4*)(wt_in + (size_t)NIN * DM + (size_t)i * 8) = make_uint4(0u, 0u, 0u, 0u);
    { bf16* wlr = (bf16*)(a.ws + WS_WLR); const float* w2 = a.in[I_W2]; const float* a2 = a.in[I_A2]; const float* g2 = a.in[I_G2];
      for (int i = gt; i < NLR * (KLR / 8); i += ngt) { const int n = i / (KLR / 8), k0 = (i % (KLR / 8)) * 8; const int type = n >> 11, cch = n & 2047;
          float f[8];
#pragma unroll
          for (int e = 0; e < 8; ++e) { const int k = k0 + e; float v = 0.f;
              if (type == 0) { if (k < 96) v = w2[(size_t)(0 * 96 + k) * RW + cch]; }
              else if (type == 1) { if (k >= 96 && k < 192) v = w2[(size_t)(1 * 96 + (k - 96)) * RW + cch]; }
              else if (type == 2) { if (k >= 192 && k < 288) v = a2[(size_t)(0 * 96 + (k - 192)) * RW + cch]; }
              else if (type == 3) { if (k >= 288 && k < 384) v = a2[(size_t)(1 * 96 + (k - 288)) * RW + cch]; }
              else { if (k >= 384) v = g2[(size_t)(k - 384) * RW + cch]; }
              f[e] = v; }
          st16(wlr + (size_t)n * KLR + k0, pack8(f)); } }
    { bf16* kbd = (bf16*)(a.ws + WS_KBD); const float* k1 = a.in[I_K1]; const float* k2 = a.in[I_K2];
      for (int i = gt; i < 2048 * 256; i += ngt) { const int n = i >> 8, k0 = (i & 255) * 8; float f[8];
          if ((n >> 7) == (k0 >> 7)) { const int h = n >> 8, s = (n >> 7) & 1, key = n & 127, d0 = k0 & 127; const float* src = (s ? k2 : k1) + ((size_t)(h * 128 + key) * 128 + d0); ldf8(src, f); }
          else {
#pragma unroll
              for (int e = 0; e < 8; ++e) f[e] = 0.f; }
          st16(kbd + (size_t)n * 2048 + k0, pack8(f)); } }
}

__device__ __forceinline__ void norm_mod_row(const float* src, const float* g, const float* sh, const float* sc, bf16* dst, int lane) {
    float4 v[16]; float ss = 0.f;
#pragma unroll
    for (int j = 0; j < 16; ++j) { v[j] = *(const float4*)(src + (lane + 64 * j) * 4); ss += (v[j].x * v[j].x + v[j].y * v[j].y) + (v[j].z * v[j].z + v[j].w * v[j].w); }
    const float rstd = rsqrtf(wave_sum(ss) * (1.f / DM) + RMS_EPS);
#pragma unroll
    for (int j = 0; j < 16; ++j) { const int c = (lane + 64 * j) * 4; const float4 gg = *(const float4*)(g + c), s1 = *(const float4*)(sc + c), s0 = *(const float4*)(sh + c);
        const float o0 = v[j].x * rstd * gg.x * (1.f + s1.x) + s0.x, o1 = v[j].y * rstd * gg.y * (1.f + s1.y) + s0.y, o2 = v[j].z * rstd * gg.z * (1.f + s1.z) + s0.z, o3 = v[j].w * rstd * gg.w * (1.f + s1.w) + s0.w;
        uint2 w; w.x = pk2(o0, o1); w.y = pk2(o2, o3); *(uint2*)(dst + c) = w; }
}
__device__ __forceinline__ void ph_norm1(const Args& a) {
    const int lane = LANE; const float* mod = (const float*)(a.ws + WS_MOD); bf16* A1 = (bf16*)(a.ws + WS_A1);
    for (int m = GW; m < MT; m += NGW) {
        const float* src = m < MX ? a.in[I_X] + (size_t)m * DM : a.in[I_CTX] + (size_t)(m - MX) * DM;
        const int v = m < MX ? m / SEQ : 4;
        norm_mod_row(src, a.in[I_N1G], mod + (size_t)v * NMOD, mod + (size_t)v * NMOD + DM, A1 + (size_t)m * DM, lane);
    }
}
__device__ __forceinline__ void ph_norm2(const Args& a) {
    const int lane = LANE; const float* mod = (const float*)(a.ws + WS_MOD); bf16* XN2 = (bf16*)(a.ws + WS_XN2);
    for (int m = GW; m < MX; m += NGW) {
        const int v = m / SEQ;
        norm_mod_row(a.out + (size_t)m * DM, a.in[I_N2G], mod + (size_t)v * NMOD + 3 * DM, mod + (size_t)v * NMOD + 4 * DM, XN2 + (size_t)m * DM, lane);
    }
    unsigned* U8 = (unsigned*)(a.ws + WS_U8); unsigned* V8 = (unsigned*)(a.ws + WS_V8); float* USC = (float*)(a.ws + WS_USC); float* VSC = (float*)(a.ws + WS_VSC);
    for (int row = GW; row < 2 * 16384; row += NGW) {
        const int tb = row >> 14, r = row & 16383;
        const float* src = (tb ? a.in[I_PV] : a.in[I_PU]) + (size_t)r * DM;
        float4 v[16]; float am = 0.f;
#pragma unroll
        for (int j = 0; j < 16; ++j) { v[j] = *(const float4*)(src + (lane + 64 * j) * 4); am = fmaxf(fmaxf(am, fmaxf(fabsf(v[j].x), fabsf(v[j].y))), fmaxf(fabsf(v[j].z), fabsf(v[j].w))); }
        am = wave_max(am);
        const float scale = am > 0.f ? am * (1.f / 448.f) : 1.f, inv = 1.f / scale;
        unsigned* dst = (tb ? V8 : U8) + (size_t)r * (DM / 4);
#pragma unroll
        for (int j = 0; j < 16; ++j) { int p = __builtin_amdgcn_cvt_pk_fp8_f32(v[j].x * inv, v[j].y * inv, 0, false); p = __builtin_amdgcn_cvt_pk_fp8_f32(v[j].z * inv, v[j].w * inv, p, true); dst[lane + 64 * j] = (unsigned)p; }
        if (lane == 0) (tb ? VSC : USC)[r] = scale;
    }
}

__device__ __forceinline__ void ph_prep_rwkv(const Args& a) {
    const int lane = LANE;
    const bf16* P = (const bf16*)(a.ws + WS_P);
    bf16* R = (bf16*)(a.ws + WS_R); bf16* K = (bf16*)(a.ws + WS_K); bf16* V = (bf16*)(a.ws + WS_V); bf16* KK = (bf16*)(a.ws + WS_KK); bf16* ALR = (bf16*)(a.ws + WS_ALR);
    const float* mu = a.in[I_MU]; const float* k_k = a.in[I_KK];
    for (int m = GW; m < MT; m += NGW) {
        const bool lat = m < MX;
        bool h0, h1, h2 = false, h3 = false; size_t r0, r1, r2 = 0, r3 = 0;
        if (lat) { const int t = m & (SEQ - 1), row = t >> 6, col = t & 63; h0 = col > 0; h1 = col < 63; h2 = row > 0; h3 = row < 63; r0 = (size_t)(m - 1); r1 = (size_t)(m + 1); r2 = (size_t)(m - 64); r3 = (size_t)(m + 64); }
        else { const int t = (m - MX) & (CTXL - 1); h0 = t > 0; h1 = t < CTXL - 1; r0 = (size_t)(m - 1); r1 = (size_t)(m + 1); }
        const bf16* prow = P + (size_t)m * NINP;
#pragma unroll
        for (int i = 0; i < 14; ++i) {
            const int chunk = lane + 64 * i;
            if (chunk < RCOLS / 8) {
                const int c0 = chunk * 8;
                float own[8], n0[8], n1[8], sh[8], xm[8], muv[8];
                const uint4 z4 = make_uint4(0u, 0u, 0u, 0u);
                unpack8(ld16(prow + c0), own);
                unpack8(h0 ? ld16(P + r0 * NINP + c0) : z4, n0);
                unpack8(h1 ? ld16(P + r1 * NINP + c0) : z4, n1);
                if (lat) { float n2[8], n3[8];
                    unpack8(h2 ? ld16(P + r2 * NINP + c0) : z4, n2);
                    unpack8(h3 ? ld16(P + r3 * NINP + c0) : z4, n3);
#pragma unroll
                    for (int e = 0; e < 8; ++e) sh[e] = (e & 3) == 0 ? n0[e] : (e & 3) == 1 ? n1[e] : (e & 3) == 2 ? n2[e] : n3[e];
                } else {
#pragma unroll
                    for (int e = 0; e < 8; ++e) sh[e] = (e & 1) == 0 ? n0[e] : n1[e];
                }
                ldf8(mu + c0, muv);
#pragma unroll
                for (int e = 0; e < 8; ++e) xm[e] = own[e] + muv[e] * (sh[e] - own[e]);
                if (i < 4) st16(R + (size_t)m * RW + c0, pack8(xm));
                else if (i < 8) { const int cc = c0 - 2048; st16(K + (size_t)m * RW + cc, pack8(xm));
                    float kv[8], kkv[8]; ldf8(k_k + cc, kv); float ss = 0.f;
#pragma unroll
                    for (int e = 0; e < 8; ++e) { kkv[e] = xm[e] * kv[e]; ss += kkv[e] * kkv[e]; }
                    ss = sum8(ss);
                    const float inv = rsqrtf(fmaxf(ss, 1e-24f));
#pragma unroll
                    for (int e = 0; e < 8; ++e) kkv[e] *= inv;
                    st16(KK + (size_t)m * RW + cc, pack8(kkv)); }
                else if (i < 12) st16(V + (size_t)m * RW + (c0 - 4096), pack8(xm));
                else { const int j0 = c0 - 6144; float f[8];
#pragma unroll
                    for (int e = 0; e < 8; ++e) f[e] = j0 < 192 ? tanhf(xm[e]) : (j0 < 384 ? xm[e] : 1.f / (1.f + __expf(-xm[e])));
                    st16(ALR + (size_t)m * KLR + j0, pack8(f)); }
            }
        }
    }
}

__device__ __forceinline__ void ph_prep_ssd(const Args& a) {
    const int lane = LANE;
    const bf16* P = (const bf16*)(a.ws + WS_P);
    bf16* XS = (bf16*)(a.ws + WS_XS); bf16* BC = (bf16*)(a.ws + WS_BC); bf16* Z = (bf16*)(a.ws + WS_Z); float* DT = (float*)(a.ws + WS_DT); float* LA = (float*)(a.ws + WS_LA);
    const float* cw = a.in[I_CONVW]; const float* cb = a.in[I_CONVB];
    for (int m = GW; m < MT; m += NGW) {
        const bool lat = m < MX; bool hp, hn;
        if (lat) { const int t = m & (SEQ - 1); hp = t > 0; hn = t < SEQ - 1; } else { const int t = (m - MX) & (CTXL - 1); hp = t > 0; hn = t < CTXL - 1; }
        const bf16* prow = P + (size_t)m * NINP;
#pragma unroll
        for (int i = 0; i < 8; ++i) {
            const int c0 = (lane + 64 * i) * 8; const uint4 z4 = make_uint4(0u, 0u, 0u, 0u);
            float cur[8], pv[8], nx[8], w0[8], w1[8], w2[8], bb[8], y[8];
            unpack8(ld16(prow + COL_XBC + c0), cur);
            unpack8(hp ? ld16(prow - NINP + COL_XBC + c0) : z4, pv);
            unpack8(hn ? ld16(prow + NINP + COL_XBC + c0) : z4, nx);
            ldf8(cw + c0, w0); ldf8(cw + 4096 + c0, w1); ldf8(cw + 8192 + c0, w2); ldf8(cb + c0, bb);
#pragma unroll
            for (int e = 0; e < 8; ++e) { const float t = w0[e] * pv[e] + w1[e] * cur[e] + w2[e] * nx[e] + bb[e]; y[e] = t / (1.f + __expf(-t)); }
            if (i < 4) st16(XS + (size_t)m * RW + c0, pack8(y)); else st16(BC + (size_t)m * RW + (c0 - 2048), pack8(y));
        }
        { const float raw = __uint_as_float((unsigned)prow[COL_DT + lane] << 16) + a.in[I_DTB][lane];
          const float dtv = raw > 20.f ? raw : log1pf(expf(raw));
          DT[(size_t)m * 64 + lane] = dtv; LA[(size_t)m * 64 + lane] = -dtv * expf(a.in[I_ALOG][lane]); }
        if (lat) {
#pragma unroll
            for (int i = 0; i < 4; ++i) { const int c0 = (lane + 64 * i) * 8; st16(Z + (size_t)m * RW + c0, ld16(prow + COL_Z + c0)); }
        }
    }
}

__device__ __forceinline__ int scan_row(int n, int dir, int b) { return n < CTXL ? MX + b * CTXL + (dir ? CTXL - 1 - n : n) : b * SEQ + (dir ? NSTEP - 1 - n : n - CTXL); }

struct RIn { uint4 r, k, kk, w, a; unsigned v; };
__device__ __forceinline__ void rwkv_load(RIn& x, const bf16* R, const bf16* K, const bf16* V, const bf16* KK, const bf16* LR, int m, int ch, int chi, int dir) {
    x.r = ld16(R + (size_t)m * RW + ch); x.k = ld16(K + (size_t)m * RW + ch); x.kk = ld16(KK + (size_t)m * RW + ch);
    x.w = ld16(LR + (size_t)m * NLR + dir * 2048 + ch); x.a = ld16(LR + (size_t)m * NLR + 4096 + dir * 2048 + ch);
    x.v = V[(size_t)m * RW + chi];
}
__device__ __forceinline__ float rwkv_step(float (&S)[8], const RIn& x, const float (&ka)[8]) {
    float r[8], k[8], kk[8], w1[8], av[8];
    unpack8(x.r, r); unpack8(x.k, k); unpack8(x.kk, kk); unpack8(x.w, w1); unpack8(x.a, av);
    const float v = __uint_as_float(x.v << 16);
    float sa = 0.f;
#pragma unroll
    for (int e = 0; e < 8; ++e) sa -= S[e] * kk[e];
    sa = sum8(sa);
    float o = 0.f;
#pragma unroll
    for (int e = 0; e < 8; ++e) { const float kd = k[e] * (1.f + (av[e] - 1.f) * ka[e]); const float b = kk[e] * av[e];
        S[e] = S[e] * (1.f - w1[e]) + sa * b + v * kd; o += S[e] * r[e]; }
    o = sum8(o);
    return o;
}
__device__ __forceinline__ void ph_rwkv_scan(const Args& a) {
    const int lane = LANE, wave = WAVE;
    const bf16* R = (const bf16*)(a.ws + WS_R); const bf16* K = (const bf16*)(a.ws + WS_K); const bf16* V = (const bf16*)(a.ws + WS_V); const bf16* KK = (const bf16*)(a.ws + WS_KK);
    const bf16* LR = (const bf16*)(a.ws + WS_LR); bf16* OR = (bf16*)a.out;
    for (int u = blockIdx.x; u < 256; u += gridDim.x) {
        const int g = u >> 5, h = u & 31, dir = g >> 2, b = g & 3;
        const int i = wave * 8 + (lane >> 3), jb = lane & 7, ch = h * 64 + jb * 8, chi = h * 64 + i;
        float ka[8]; ldf8(a.in[I_KA] + ch, ka);
        float S[8];
#pragma unroll
        for (int e = 0; e < 8; ++e) S[e] = 0.f;
        RIn A[4], B[4];
#pragma unroll
        for (int s = 0; s < 4; ++s) rwkv_load(A[s], R, K, V, KK, LR, scan_row(s, dir, b), ch, chi, dir);
        for (int n0 = 0; n0 < NSTEP; n0 += 8) {
#pragma unroll
            for (int s = 0; s < 4; ++s) rwkv_load(B[s], R, K, V, KK, LR, scan_row(n0 + 4 + s, dir, b), ch, chi, dir);
#pragma unroll
            for (int s = 0; s < 4; ++s) { const int n = n0 + s; const float o = rwkv_step(S, A[s], ka);
                if (n >= CTXL && jb == 0) OR[((size_t)dir * MX + scan_row(n, dir, b)) * RW + chi] = (bf16)f2bf(o); }
            if (n0 + 8 < NSTEP) {
#pragma unroll
                for (int s = 0; s < 4; ++s) rwkv_load(A[s], R, K, V, KK, LR, scan_row(n0 + 8 + s, dir, b), ch, chi, dir);
            }
#pragma unroll
            for (int s = 0; s < 4; ++s) { const int n = n0 + 4 + s; const float o = rwkv_step(S, B[s], ka);
                if (n >= CTXL && jb == 0) OR[((size_t)dir * MX + scan_row(n, dir, b)) * RW + chi] = (bf16)f2bf(o); }
        }
    }
}

struct SIn { uint4 b0, b1, c0, c1; unsigned xs; float dt, la; };
__device__ __forceinline__ void ssd_load(SIn& x, const bf16* XS, const bf16* BC, const float* DT, const float* LA, int m, int chx, int cb, int dh) {
    x.b0 = ld16(BC + (size_t)m * RW + cb); x.b1 = ld16(BC + (size_t)m * RW + cb + 8); x.c0 = ld16(BC + (size_t)m * RW + 1024 + cb); x.c1 = ld16(BC + (size_t)m * RW + 1024 + cb + 8);
    x.xs = XS[(size_t)m * RW + chx]; x.dt = DT[(size_t)m * 64 + dh]; x.la = LA[(size_t)m * 64 + dh];
}
__device__ __forceinline__ float ssd_step(float (&s)[16], const SIn& x) {
    float B0[8], B1[8], C0[8], C1[8]; unpack8(x.b0, B0); unpack8(x.b1, B1); unpack8(x.c0, C0); unpack8(x.c1, C1);
    const float dec = __expf(x.la), xdt = __uint_as_float(x.xs << 16) * x.dt; float y = 0.f;
#pragma unroll
    for (int e = 0; e < 8; ++e) { s[e] = dec * s[e] + xdt * B0[e]; y += s[e] * C0[e]; s[8 + e] = dec * s[8 + e] + xdt * B1[e]; y += s[8 + e] * C1[e]; }
    y = sum8(y);
    return y;
}
__device__ __forceinline__ void ph_ssd_scan(const Args& a) {
    const int lane = LANE, wave = WAVE;
    const bf16* XS = (const bf16*)(a.ws + WS_XS); const bf16* BC = (const bf16*)(a.ws + WS_BC); const float* DT = (const float*)(a.ws + WS_DT); const float* LA = (const float*)(a.ws + WS_LA);
    bf16* YS = (bf16*)a.out + (size_t)2 * MX * RW;
    for (int u = blockIdx.x; u < 256; u += gridDim.x) {
        const int g = u >> 5, h = u & 31, dir = g >> 2, b = g & 3;
        const int p = wave * 8 + (lane >> 3), nb = lane & 7, chx = h * 64 + p, cb = (h >> 2) * 128 + nb * 16, dh = dir * 32 + h;
        float s[16];
#pragma unroll
        for (int e = 0; e < 16; ++e) s[e] = 0.f;
        SIn A[4], B[4];
#pragma unroll
        for (int q = 0; q < 4; ++q) ssd_load(A[q], XS, BC, DT, LA, scan_row(q, dir, b), chx, cb, dh);
        for (int n0 = 0; n0 < NSTEP; n0 += 8) {
#pragma unroll
            for (int q = 0; q < 4; ++q) ssd_load(B[q], XS, BC, DT, LA, scan_row(n0 + 4 + q, dir, b), chx, cb, dh);
#pragma unroll
            for (int q = 0; q < 4; ++q) { const int n = n0 + q; const float y = ssd_step(s, A[q]);
                if (n >= CTXL && nb == 0) YS[((size_t)dir * MX + scan_row(n, dir, b)) * RW + chx] = (bf16)f2bf(y); }
            if (n0 + 8 < NSTEP) {
#pragma unroll
                for (int q = 0; q < 4; ++q) ssd_load(A[q], XS, BC, DT, LA, scan_row(n0 + 8 + q, dir, b), chx, cb, dh);
            }
#pragma unroll
            for (int q = 0; q < 4; ++q) { const int n = n0 + 4 + q; const float y = ssd_step(s, B[q]);
                if (n >= CTXL && nb == 0) YS[((size_t)dir * MX + scan_row(n, dir, b)) * RW + chx] = (bf16)f2bf(y); }
        }
    }
}

__device__ __forceinline__ void ph_finish(const Args& a) {
    const int lane = LANE;
    const bf16* R = (const bf16*)(a.ws + WS_R); const bf16* K = (const bf16*)(a.ws + WS_K); const bf16* V = (const bf16*)(a.ws + WS_V);
    const bf16* LR = (const bf16*)(a.ws + WS_LR); const bf16* XS = (const bf16*)(a.ws + WS_XS); const bf16* Z = (const bf16*)(a.ws + WS_Z);
    const bf16* OR = (const bf16*)a.out; const bf16* YS = (const bf16*)a.out + (size_t)2 * MX * RW;
    bf16* A2 = (bf16*)(a.ws + WS_A2);
    for (int m = GW; m < MX; m += NGW) {
#pragma unroll
        for (int i = 0; i < 4; ++i) {
            const int c0 = (lane + 64 * i) * 8;
            float of[8], ob[8], o[8], res[8];
#if MK_SKIP_RWKV
#pragma unroll
            for (int e = 0; e < 8; ++e) res[e] = 0.f;
#else
            unpack8(ld16(OR + (size_t)m * RW + c0), of); unpack8(ld16(OR + ((size_t)MX + m) * RW + c0), ob);
            float sm = 0.f;
#pragma unroll
            for (int e = 0; e < 8; ++e) { o[e] = of[e] + ob[e]; sm += o[e]; }
            sm = sum8(sm);
            const float mean = sm * (1.f / 64.f); float sq = 0.f;
#pragma unroll
            for (int e = 0; e < 8; ++e) { o[e] -= mean; sq += o[e] * o[e]; }
            sq = sum8(sq);
            const float rstd = rsqrtf(sq * (1.f / 64.f) + GN_EPS);
            float lw[8], lb[8], r[8], k[8], v[8], a0[8], a1[8], ka[8], rk[8], gg[8];
            ldf8(a.in[I_LNW] + c0, lw); ldf8(a.in[I_LNB] + c0, lb); ldf8(a.in[I_KA] + c0, ka); ldf8(a.in[I_RK] + c0, rk);
            unpack8(ld16(R + (size_t)m * RW + c0), r); unpack8(ld16(K + (size_t)m * RW + c0), k); unpack8(ld16(V + (size_t)m * RW + c0), v);
            unpack8(ld16(LR + (size_t)m * NLR + 4096 + c0), a0); unpack8(ld16(LR + (size_t)m * NLR + 6144 + c0), a1); unpack8(ld16(LR + (size_t)m * NLR + 8192 + c0), gg);
            float bs = 0.f;
#pragma unroll
            for (int e = 0; e < 8; ++e) { const float kd = k[e] * (2.f + (a0[e] + a1[e] - 2.f) * ka[e]); bs += r[e] * kd * rk[e]; }
            bs = sum8(bs);
#pragma unroll
            for (int e = 0; e < 8; ++e) res[e] = (o[e] * rstd * lw[e] + lb[e] + bs * v[e]) * gg[e];
#endif
            st16(A2 + (size_t)m * DM + c0, pack8(res));
        }
#pragma unroll
        for (int i = 0; i < 4; ++i) {
            const int c0 = (lane + 64 * i) * 8;
            float yf[8], yb[8], xs[8], z[8], nw[8], y[8];
#if MK_SKIP_SSD
#pragma unroll
            for (int e = 0; e < 8; ++e) y[e] = 0.f;
#else
            unpack8(ld16(YS + (size_t)m * RW + c0), yf); unpack8(ld16(YS + ((size_t)MX + m) * RW + c0), yb);
            unpack8(ld16(XS + (size_t)m * RW + c0), xs); unpack8(ld16(Z + (size_t)m * RW + c0), z); ldf8(a.in[I_NORMW] + c0, nw);
            const float dsk = a.in[I_SSMD][c0 >> 6]; float ss = 0.f;
#pragma unroll
            for (int e = 0; e < 8; ++e) { y[e] = (yf[e] + yb[e] + dsk * xs[e]) * (z[e] / (1.f + __expf(-z[e]))); ss += y[e] * y[e]; }
            ss = sum32(ss);
            const float rstd = rsqrtf(ss * (1.f / 256.f) + RMS_EPS);
#pragma unroll
            for (int e = 0; e < 8; ++e) y[e] = y[e] * rstd * nw[e];
#endif
            st16(A2 + (size_t)m * DM + 2048 + c0, pack8(y));
        }
    }
}

__device__ __forceinline__ float enc_key(float v, int idx) { return __uint_as_float((__float_as_uint(v) & 0xffffff00u) | (unsigned)idx); }
__device__ __forceinline__ void ldf16(const float* p, float (&f)[16]) {
    const float4 a = *(const float4*)p, b = *(const float4*)(p + 4), c = *(const float4*)(p + 8), d = *(const float4*)(p + 12);
    f[0] = a.x; f[1] = a.y; f[2] = a.z; f[3] = a.w; f[4] = b.x; f[5] = b.y; f[6] = b.z; f[7] = b.w; f[8] = c.x; f[9] = c.y; f[10] = c.z; f[11] = c.w; f[12] = d.x; f[13] = d.y; f[14] = d.z; f[15] = d.w;
}
typedef float f32x2 __attribute__((ext_vector_type(2)));
__device__ __forceinline__ void unpack_fp8x16(const uint4& q, float (&f)[16]) {
    const unsigned w[4] = {q.x, q.y, q.z, q.w};
#pragma unroll
    for (int i = 0; i < 4; ++i) { const f32x2 lo = __builtin_amdgcn_cvt_pk_f32_fp8((int)w[i], false), hi = __builtin_amdgcn_cvt_pk_f32_fp8((int)w[i], true);
        f[4 * i] = lo.x; f[4 * i + 1] = lo.y; f[4 * i + 2] = hi.x; f[4 * i + 3] = hi.y; }
}
#define PIN16(a) do { PIN8(a); PIN8((a) + 8); } while (0)
__device__ __forceinline__ void ph_peer(const Args& a) {
    const int lane = LANE;
    const float* mod = (const float*)(a.ws + WS_MOD); const float* S = (const float*)(a.ws + WS_S);
    const unsigned char* U8 = (const unsigned char*)(a.ws + WS_U8); const unsigned char* V8 = (const unsigned char*)(a.ws + WS_V8);
    const float* USC = (const float*)(a.ws + WS_USC); const float* VSC = (const float*)(a.ws + WS_VSC);
    for (int m = GW; m < MX; m += NGW) {
        const int bb = m / SEQ;
        float* hrow = a.out + (size_t)m * DM;
        int l16 = lane * 16; asm volatile("" : "+v"(l16));
        float acc[4][16];
#if MK_SKIP_PEER
#pragma unroll
        for (int j = 0; j < 4; ++j)
#pragma unroll
            for (int e = 0; e < 16; ++e) acc[j][e] = 0.f;
#else
        float xn[4][16];
        { float ss = 0.f; float hv[4][16];
#pragma unroll
          for (int j = 0; j < 4; ++j) { ldf16(hrow + 1024 * j + l16, hv[j]);
#pragma unroll
              for (int e = 0; e < 16; ++e) ss += hv[j][e] * hv[j][e]; }
          const float rstd = rsqrtf(wave_sum(ss) * (1.f / DM) + RMS_EPS);
          const float* sh2 = mod + (size_t)bb * NMOD + 3 * DM; const float* sc2 = mod + (size_t)bb * NMOD + 4 * DM; const float* g2 = a.in[I_N2G];
#pragma unroll
          for (int j = 0; j < 4; ++j) {
#pragma unroll
              for (int hf = 0; hf < 2; ++hf) { float gg[8], s0[8], s1[8]; const int c = 1024 * j + l16 + 8 * hf; ldf8(g2 + c, gg); ldf8(sh2 + c, s0); ldf8(sc2 + c, s1);
#pragma unroll
                  for (int e = 0; e < 8; ++e) xn[j][8 * hf + e] = hv[j][8 * hf + e] * rstd * gg[e] * (1.f + s1[e]) + s0[e];
                  PIN8(xn[j] + 8 * hf); asm volatile("" ::: "memory"); } } }
        int eid0 = 0, eid1 = 0; float gt0 = 0.f, gt1 = 0.f;
        const float NEG = -3.0e38f;
#pragma unroll 1
        for (int hd = 0; hd < 8; ++hd) {
            const float* srow = S + (size_t)m * 2048 + hd * 256;
            float c1a = enc_key(srow[lane], lane), c1b = enc_key(srow[64 + lane], 64 + lane), c2a = enc_key(srow[128 + lane], lane), c2b = enc_key(srow[192 + lane], 64 + lane);
            float t1 = NEG, t2 = NEG;
#pragma unroll 1
            for (int k = 0; k < 16; ++k) {
                const float m1 = wave_max(fmaxf(c1a, c1b)), m2 = wave_max(fmaxf(c2a, c2b));
                if (c1a == m1) c1a = NEG; if (c1b == m1) c1b = NEG; if (c2a == m2) c2a = NEG; if (c2b == m2) c2b = NEG;
                if (lane == k) { t1 = m1; t2 = m2; }
            }
            const float v1 = __uint_as_float(__float_as_uint(t1) & 0xffffff00u), v2 = __uint_as_float(__float_as_uint(t2) & 0xffffff00u);
            const int i1 = (int)(__float_as_uint(t1) & 0xffu), i2 = (int)(__float_as_uint(t2) & 0xffu);
            float cd[4];
#pragma unroll
            for (int e = 0; e < 4; ++e) { const float va = __shfl(v1, (lane >> 4) + 4 * e), vb = __shfl(v2, lane & 15); cd[e] = enc_key(va + vb, lane + 64 * e); }
            float best = NEG; int ex = 0;
#pragma unroll 1
            for (int k = 0; k < 16; ++k) {
                const float mx = wave_max(fmaxf(fmaxf(cd[0], cd[1]), fmaxf(cd[2], cd[3])));
#pragma unroll
                for (int e = 0; e < 4; ++e) if (cd[e] == mx) cd[e] = NEG;
                const int cidx = (int)(__float_as_uint(mx) & 0xffu);
                const int ea = __shfl(i1, cidx >> 4), eb = __shfl(i2, cidx & 15);
                if (lane == k) { best = __uint_as_float(__float_as_uint(mx) & 0xffffff00u); ex = ea * 128 + eb; }
            }
            const float bmax = __shfl(best, 0);
            const float pe = lane < 16 ? __expf(best - bmax) : 0.f;
            const float gate = pe / wave_sum(pe);
            const float gsh = __shfl(gate, lane & 15); const int esh = __shfl(ex, lane & 15);
            if ((lane >> 4) == (hd & 3)) { if (hd < 4) { gt0 = gsh; eid0 = esh; } else { gt1 = gsh; eid1 = esh; } }
        }
        float cf0 = 0.f, cf1 = 0.f;
#pragma unroll 1
        for (int p0 = 0; p0 < 128; p0 += 4) {
            float d[4]; uint4 qu[4][4];
#pragma unroll
            for (int q = 0; q < 4; ++q) {
                const int e = __builtin_amdgcn_readlane(p0 < 64 ? eid0 : eid1, (p0 + q) & 63);
                const unsigned char* urow = U8 + (size_t)e * DM + l16;
#pragma unroll
                for (int j = 0; j < 4; ++j) qu[q][j] = *(const uint4*)(urow + 1024 * j);
            }
#pragma unroll
            for (int q = 0; q < 4; ++q) {
                float dd = 0.f;
#pragma unroll
                for (int j = 0; j < 4; ++j) { float f[16]; unpack_fp8x16(qu[q][j], f);
#pragma unroll
                    for (int t = 0; t < 16; ++t) dd += xn[j][t] * f[t];
                    asm volatile("" : "+v"(dd)); }
                d[q] = dd;
            }
#pragma unroll
            for (int q = 0; q < 4; ++q) {
                const int p = p0 + q; const int e = __builtin_amdgcn_readlane(p0 < 64 ? eid0 : eid1, p & 63);
                const float dot = wave_sum(d[q]) * USC[e];
                const float act = 0.5f * dot * (1.f + erff(dot * 0.70710678f)) * VSC[e];
                if (lane == (p & 63)) { if (p0 < 64) cf0 = gt0 * act; else cf1 = gt1 * act; }
            }
        }
#pragma unroll
        for (int j = 0; j < 4; ++j)
#pragma unroll
            for (int e = 0; e < 16; ++e) acc[j][e] = 0.f;
#pragma unroll 1
        for (int p0 = 0; p0 < 128; p0 += 4) {
            uint4 qv[4][4]; float cfv[4];
#pragma unroll
            for (int q = 0; q < 4; ++q) {
                const int e = __builtin_amdgcn_readlane(p0 < 64 ? eid0 : eid1, (p0 + q) & 63);
                cfv[q] = rlane(p0 < 64 ? cf0 : cf1, (p0 + q) & 63);
                const unsigned char* vrow = V8 + (size_t)e * DM + l16;
#pragma unroll
                for (int j = 0; j < 4; ++j) qv[q][j] = *(const uint4*)(vrow + 1024 * j);
            }
#pragma unroll
            for (int q = 0; q < 4; ++q)
#pragma unroll
                for (int j = 0; j < 4; ++j) { float f[16]; unpack_fp8x16(qv[q][j], f);
#pragma unroll
                    for (int t = 0; t < 16; ++t) acc[j][t] += cfv[q] * f[t];
                    PIN16(acc[j]); }
        }
#endif
        { const float* gt2 = mod + (size_t)bb * NMOD + 5 * DM; float ss = 0.f;
#pragma unroll
          for (int j = 0; j < 4; ++j) {
#pragma unroll
              for (int hf = 0; hf < 2; ++hf) { float g[8], hvj[8]; const int c = 1024 * j + l16 + 8 * hf; ldf8(gt2 + c, g); ldf8(hrow + c, hvj);
#pragma unroll
                  for (int e = 0; e < 8; ++e) { acc[j][8 * hf + e] = hvj[e] + g[e] * acc[j][8 * hf + e]; ss += acc[j][8 * hf + e] * acc[j][8 * hf + e]; }
                  PIN8(acc[j] + 8 * hf); asm volatile("" ::: "memory"); } }
          const float rstd = rsqrtf(wave_sum(ss) * (1.f / DM) + RMS_EPS);
#pragma unroll
          for (int j = 0; j < 4; ++j) {
#pragma unroll
              for (int hf = 0; hf < 2; ++hf) { float fg[8]; const int c = 1024 * j + l16 + 8 * hf; ldf8(a.in[I_FG] + c, fg); const float* ac = acc[j] + 8 * hf;
                  *(float4*)(hrow + c) = make_float4(ac[0] * rstd * fg[0], ac[1] * rstd * fg[1], ac[2] * rstd * fg[2], ac[3] * rstd * fg[3]);
                  *(float4*)(hrow + c + 4) = make_float4(ac[4] * rstd * fg[4], ac[5] * rstd * fg[5], ac[6] * rstd * fg[6], ac[7] * rstd * fg[7]);
                  asm volatile("" ::: "memory"); } } }
    }
}

constexpr int N_PHASES = 13;
__global__ void __launch_bounds__(512, 2) hybrid_fwd(Args args) {
    extern __shared__ __attribute__((aligned(16))) unsigned char lds_raw[];
    LAS unsigned char* lds = (LAS unsigned char*)lds_raw;
    volatile LAS unsigned* MISC = (volatile LAS unsigned*)(lds + LDS_MISC);
    for (int u = TID; u < (LDS_BYTES - 131072) / 4; u += 512) ((LAS unsigned*)(lds + 131072))[u] = 0u;
    __syncthreads();
    const int lo = args.ph_lo, hi = args.ph_hi;
    XcdBarrier bar; bar.bar = (unsigned*)(args.ws + WS_CTL); bar.x = 0; bar.st = nullptr;
    if (hi - lo > 1) bar = xcd_barrier_post((unsigned*)(args.ws + WS_CTL), MISC + 8);
#define IN(k) (lo <= (k) && (k) < hi && ((MK_PHASE_MASK >> (k)) & 1))
#define SEAM(k) do { if (IN(k) && IN((k) + 1)) xcd_barrier(bar); } while (0)
    const int bid = (int)blockIdx.x, G = (int)gridDim.x;

    if (IN(0)) { ph_mod(args, lds); ph_conv(args, lds); if (MK_REPEAT == 0) { ph_mod(args, lds); ph_conv(args, lds); } }
    SEAM(0);
    if (IN(1)) { ph_norm1(args); if (MK_REPEAT == 1) ph_norm1(args); }
    SEAM(1);
    if (IN(2)) { pg8::Gemm g{(const bf16*)(args.ws + WS_A1), (const bf16*)(args.ws + WS_WT_IN), MT, NINP, DM}; pg8::StaticOrder S; S.init(MT, NINP, G, bid);
        pg8::EpiBf16<0> E{(bf16*)(args.ws + WS_P), NINP, nullptr, 0, 0}; pg8::gemm_phase<pg8::EpiBf16<0>, pg8::StaticOrder>(lds, g, S, E, nullptr); }
    SEAM(2);
    if (IN(3)) { ph_prep_rwkv(args); ph_prep_ssd(args); if (MK_REPEAT == 3) { ph_prep_rwkv(args); ph_prep_ssd(args); } }
    SEAM(3);
    if (IN(4)) { pg8::Gemm g{(const bf16*)(args.ws + WS_ALR), (const bf16*)(args.ws + WS_WLR), MT, NLR, KLR}; pg8::StaticOrder S; S.init(MT, NLR, G, bid);
        EpiLR E{(bf16*)(args.ws + WS_LR), args.in[I_W0], args.in[I_A0]}; pg8::gemm_phase<EpiLR, pg8::StaticOrder>(lds, g, S, E, nullptr); }
    SEAM(4);
    if (IN(5)) { ph_rwkv_scan(args); if (MK_REPEAT == 5) ph_rwkv_scan(args); }
    SEAM(5);
    if (IN(6)) { ph_ssd_scan(args); if (MK_REPEAT == 6) ph_ssd_scan(args); }
    SEAM(6);
    if (IN(7)) { ph_finish(args); if (MK_REPEAT == 7) ph_finish(args); }
    SEAM(7);
    if (IN(8)) { pg8::Gemm g{(const bf16*)(args.ws + WS_A2), (const bf16*)(args.ws + WS_WT_OUT), MX, DM, DM}; pg8::StaticOrder S; S.init(MX, DM, G, bid);
        EpiRes E{args.out, args.in[I_X], (const float*)(args.ws + WS_MOD)}; pg8::gemm_phase<EpiRes, pg8::StaticOrder>(lds, g, S, E, nullptr); }
    SEAM(8);
    if (IN(9)) { ph_norm2(args); if (MK_REPEAT == 9) ph_norm2(args); }
    SEAM(9);
    if (IN(10)) { pg8::Gemm g{(const bf16*)(args.ws + WS_XN2), (const bf16*)(args.ws + WS_WT_Q), MX, 2048, DM}; pg8::StaticOrder S; S.init(MX, 2048, G, bid);
        pg8::EpiBf16<0> E{(bf16*)(args.ws + WS_Q), 2048, nullptr, 0, 0}; pg8::gemm_phase<pg8::EpiBf16<0>, pg8::StaticOrder>(lds, g, S, E, nullptr); }
    SEAM(10);
    if (IN(11)) { pg8::Gemm g{(const bf16*)(args.ws + WS_Q), (const bf16*)(args.ws + WS_KBD), MX, 2048, 2048}; pg8::StaticOrder S; S.init(MX, 2048, G, bid);
        pg8::EpiF32 E{(float*)(args.ws + WS_S), 2048, nullptr}; pg8::gemm_phase<pg8::EpiF32, pg8::StaticOrder>(lds, g, S, E, nullptr); }
    SEAM(11);
    if (IN(12)) ph_peer(args);
#undef IN
#undef SEAM
}

extern "C" void kernel_launch(void* const* d_in, const int* in_sizes, int n_in, void* d_out, int out_size, void* d_ws, size_t ws_size, hipStream_t stream) {
    static int grid = 0;
    if (grid == 0) {
        if (n_in != N_IN || out_size != MX * DM || ws_size < WS_END) { fprintf(stderr, "kernel_launch: unexpected shapes (n_in %d out %d ws %zu)\n", n_in, out_size, ws_size); grid = -1; return; }
        int dev = 0, cus = 0, per_cu = 0;
        if (hipGetDevice(&dev) != hipSuccess || hipDeviceGetAttribute(&cus, hipDeviceAttributeMultiprocessorCount, dev) != hipSuccess) { grid = -1; return; }
        if (hipFuncSetAttribute((const void*)hybrid_fwd, hipFuncAttributeMaxDynamicSharedMemorySize, LDS_BYTES) != hipSuccess) { fprintf(stderr, "kernel_launch: hipFuncSetAttribute failed\n"); grid = -1; return; }
        if (hipOccupancyMaxActiveBlocksPerMultiprocessor(&per_cu, (const void*)hybrid_fwd, 512, LDS_BYTES) != hipSuccess || per_cu < 1) fprintf(stderr, "kernel_launch: occupancy query reports %d\n", per_cu);
        (void)hipGetLastError();
        grid = cus;
    }
    if (grid < 0) return;
    (void)in_sizes;
    if (hipMemsetAsync((char*)d_ws + WS_CTL, 0, CTL_ZERO_BYTES, stream) != hipSuccess) return;
    Args a{};
    for (int i = 0; i < N_IN; ++i) a.in[i] = (const float*)d_in[i];
    a.out = (float*)d_out; a.ws = (unsigned char*)d_ws;
#if MK_N_LAUNCHES == 1
    a.ph_lo = 0; a.ph_hi = N_PHASES;
    hipLaunchKernelGGL(hybrid_fwd, dim3(grid), dim3(512), LDS_BYTES, stream, a);
#else
    for (int ph = 0; ph < N_PHASES; ++ph) { if (!((MK_PHASE_MASK >> ph) & 1)) continue; a.ph_lo = ph; a.ph_hi = ph + 1; hipLaunchKernelGGL(hybrid_fwd, dim3(grid), dim3(512), LDS_BYTES, stream, a); }
#endif
}
```

```cpp
#include <hip/hip_runtime.h>
#include <stdint.h>
#include <stdio.h>
namespace pg8 {
#define PG8_LAS __attribute__((address_space(3)))
typedef unsigned short bf16_t;
typedef short bf16x8 __attribute__((ext_vector_type(8)));
typedef float f32x4 __attribute__((ext_vector_type(4)));
typedef unsigned u32x4 __attribute__((ext_vector_type(4)));
constexpr int BM = 256, BK = 64, HALF = 128, HTB = HALF * BK * 2  , STAGE_BYTES = 8 * HTB, NXCD = 8, WGM = 8;

__host__ __device__ __forceinline__ int lds_byte(int r, int c) { const int st = (r >> 4) * 2 + (c >> 5), rr = r & 15, cc = c & 31, ob = rr * 64 + cc * 2; return st * 1024 + (ob ^ (((ob >> 9) & 1) << 5)); }
__host__ __device__ __forceinline__ void stage_rc(int b, int& R, int& C) { const int st = b / 1024, sb = b % 1024, swz = sb ^ (((sb >> 9) & 1) << 5); R = (st >> 1) * 16 + swz / 64; C = (st & 1) * 32 + (swz % 64) / 2; }
__host__ __device__ __forceinline__ int perm32(int rho) { const int n = rho >> 4, i = rho & 15; return 8 * (i >> 2) + 4 * n + (i & 3); }

struct Unit { int pm, pn; };
struct Gemm { const bf16_t* A; const bf16_t* Bt; int M, N, K; };

struct StaticOrder {
    int nM, nN, nwg, G, c;
    __host__ __device__ void init(int M, int N, int G_, int c_) { nM = M / BM; nN = N / BM; nwg = nM * nN; G = G_; c = c_; }
    __host__ __device__ bool next(int i, Unit& u) const {
        const long L = (long)i * G + c; if (L >= nwg) return false;
        int wgid = (int)L; { const int q = nwg / NXCD, r = nwg % NXCD, xcd = wgid % NXCD, off = wgid / NXCD; wgid = (xcd < r ? xcd * (q + 1) : r * (q + 1) + (xcd - r) * q) + off; }
        const int nig = WGM * nN, gid = wgid / nig, fm = gid * WGM, gsz = (nM - fm) < WGM ? (nM - fm) : WGM;
        u.pm = fm + ((wgid % nig) % gsz); u.pn = (wgid % nig) / gsz; return true;
    }
    __device__ __forceinline__ void a_ready(const Unit&) const {}
    __device__ __forceinline__ void done(const Unit&) const {}
};
__device__ __forceinline__ unsigned cvt_pk_bf16(float lo, float hi) { unsigned r; asm volatile("v_cvt_pk_bf16_f32 %0, %1, %2" : "=v"(r) : "v"(lo), "v"(hi)); return r; }
typedef float f32x2 __attribute__((ext_vector_type(2)));
__device__ __forceinline__ f32x2 gelu_pk(f32x2 v) {
    const f32x2 av = __builtin_elementwise_abs(v), d = av * 0.2316418882f + 1.0f;
    f32x2 t; t.x = __builtin_amdgcn_rcpf(d.x); t.y = __builtin_amdgcn_rcpf(d.y);
    f32x2 q = t * 0.5307027145f + (-0.7265760135f); q = q * t + 0.7107068705f; q = q * t + (-0.142248368f); q = q * t + 0.127414796f; q = q * t;
    const f32x2 s = (v * v) * (-0.72134752044f);
    f32x2 e; e.x = __builtin_amdgcn_exp2f(s.x); e.y = __builtin_amdgcn_exp2f(s.y);
    const f32x2 m = v * (q * e), r = v - m;
    f32x2 o; o.x = v.x < 0.f ? m.x : r.x; o.y = v.y < 0.f ? m.y : r.y; return o;
}

struct EpiF32 {
    static constexpr bool PERM = false, AFTER_DRAIN = false;
    float* C; int ldc; const float* bias;
    __device__ __forceinline__ void operator()(const f32x4 (&acc)[2][2][4][2], const Unit& u, int wr, int wc, int fr, int fq) const {
        const int row0 = u.pm * BM + wr * 64 + fr, col0 = u.pn * BM + wc * 32 + 4 * fq;
        f32x4 bv[2][2];
#pragma unroll
        for (int bj = 0; bj < 2; ++bj)
#pragma unroll
            for (int n = 0; n < 2; ++n) bv[bj][n] = bias ? *(const f32x4*)(bias + col0 + bj * HALF + n * 16) : (f32x4){0.f, 0.f, 0.f, 0.f};
#pragma unroll
        for (int ai = 0; ai < 2; ++ai)
#pragma unroll
            for (int m = 0; m < 4; ++m) { float* rowp = C + (size_t)(row0 + ai * HALF + m * 16) * ldc + col0;
#pragma unroll
                for (int bj = 0; bj < 2; ++bj)
#pragma unroll
                    for (int n = 0; n < 2; ++n) *(f32x4*)(rowp + bj * HALF + n * 16) = acc[ai][bj][m][n] + bv[bj][n]; }
    }
};
template <int ACT  > struct EpiBf16 {
    static constexpr bool PERM = true, AFTER_DRAIN = false;
    bf16_t* O; int ldc; const float* bias; int split_cols; size_t split_stride;
    __device__ __forceinline__ void operator()(const f32x4 (&acc)[2][2][4][2], const Unit& u, int wr, int wc, int fr, int fq) const {
        const int row0 = u.pm * BM + wr * 64 + fr; int colt = u.pn * BM; bf16_t* base = O;
        if (split_cols) { const int t = colt / split_cols; base += (size_t)t * split_stride; colt -= t * split_cols; }
        const int col0 = colt + wc * 32 + 8 * fq, bcol0 = u.pn * BM + wc * 32 + 8 * fq;
        f32x4 bv[2][2];
#pragma unroll
        for (int bj = 0; bj < 2; ++bj)
#pragma unroll
            for (int n = 0; n < 2; ++n) bv[bj][n] = bias ? *(const f32x4*)(bias + bcol0 + bj * HALF + 4 * n) : (f32x4){0.f, 0.f, 0.f, 0.f};
#pragma unroll
        for (int ai = 0; ai < 2; ++ai)
#pragma unroll
            for (int m = 0; m < 4; ++m) { bf16_t* rowp = base + (size_t)(row0 + ai * HALF + m * 16) * ldc + col0;
#pragma unroll
                for (int bj = 0; bj < 2; ++bj) { f32x4 v0 = acc[ai][bj][m][0] + bv[bj][0], v1 = acc[ai][bj][m][1] + bv[bj][1];
                    if (ACT == 1) { f32x2 a = gelu_pk((f32x2){v0[0], v0[1]}), b = gelu_pk((f32x2){v0[2], v0[3]}), c = gelu_pk((f32x2){v1[0], v1[1]}), d = gelu_pk((f32x2){v1[2], v1[3]});
                        v0 = (f32x4){a.x, a.y, b.x, b.y}; v1 = (f32x4){c.x, c.y, d.x, d.y}; }
                    if (ACT == 2) {
#pragma unroll
                        for (int j = 0; j < 4; ++j) { v0[j] = 0.5f * v0[j] * (1.0f + erff(v0[j] * 0.70710678f)); v1[j] = 0.5f * v1[j] * (1.0f + erff(v1[j] * 0.70710678f)); } }
                    u32x4 w; w.x = cvt_pk_bf16(v0[0], v0[1]); w.y = cvt_pk_bf16(v0[2], v0[3]); w.z = cvt_pk_bf16(v1[0], v1[1]); w.w = cvt_pk_bf16(v1[2], v1[3]);
                    *(u32x4*)(rowp + bj * HALF) = w; } }
    }
};
template <class Epi, class Sched, bool STAMP = false>
__device__ __forceinline__ void gemm_phase(PG8_LAS unsigned char* lds, const Gemm g, const Sched& S, const Epi& E, unsigned long long* stamps) {
    const int tid = threadIdx.x, wid = __builtin_amdgcn_readfirstlane(tid >> 6), lane = tid & 63, wr = wid >> 2, wc = wid & 3, fr = lane & 15, fq = lane >> 4;
    const int K = g.K, nt = K / BK;
    int ts_lo = 0, ts_hi = 0, nts = 0; const unsigned long long rt_entry = STAMP ? (unsigned long long)wall_clock64() : 0ull;
#define PG8_STAMP() do { if (STAMP && wid == 0 && nts < 64) { const unsigned long long _c = (unsigned long long)clock64(); \
        ts_lo = (lane == nts) ? (int)(unsigned)_c : ts_lo; ts_hi = (lane == nts) ? (int)(unsigned)(_c >> 32) : ts_hi; ++nts; } } while (0)
    PG8_STAMP();
    unsigned voffA[2], voffB[2];
#pragma unroll
    for (int i = 0; i < 2; ++i) { int R, C; stage_rc(tid * 16 + i * 8192, R, C); const int Rb = Epi::PERM ? ((R & ~31) + perm32(R & 31)) : R;
        voffA[i] = (unsigned)(R * K + C) * 2u; voffB[i] = (unsigned)(Rb * K + C) * 2u; }
    const size_t kstep = (size_t)(BK * 2);
    const size_t hstep = (size_t)HALF * K * 2;
    const size_t tstep = 2 * hstep;
    const unsigned ldsw = (unsigned)wid * 1024u;
    const int aoff = lds_byte(wr * 64 + fr, fq * 8), boff = lds_byte(wc * 32 + fr, fq * 8);
#define PG8_SA(b, h) (((b) * 2 + (h)) * HTB)
#define PG8_SB(b, h) ((4 + (b) * 2 + (h)) * HTB)
#define PG8_STAGE(bufoff, gbase, voff) do { _Pragma("unroll") for (int _i = 0; _i < 2; ++_i) \
        __builtin_amdgcn_global_load_lds((const unsigned*)((const char*)(gbase) + (voff)[_i]), (PG8_LAS unsigned*)(lds + (bufoff) + ldsw + _i * 8192), 16, 0, 0); } while (0)
#define PG8_LDA(dst, b, h) do { _Pragma("unroll") for (int m = 0; m < 4; ++m) _Pragma("unroll") for (int k = 0; k < 2; ++k) dst[m][k] = *(const PG8_LAS bf16x8*)(lds + PG8_SA(b, h) + aoff + m * 2048 + k * 1024); } while (0)
#define PG8_LDB(dst, b, h) do { _Pragma("unroll") for (int n = 0; n < 2; ++n) _Pragma("unroll") for (int k = 0; k < 2; ++k) dst[n][k] = *(const PG8_LAS bf16x8*)(lds + PG8_SB(b, h) + boff + n * 2048 + k * 1024); } while (0)
#define PG8_MMA(ai, bj, At, Bt) do { __builtin_amdgcn_s_setprio(1); _Pragma("unroll") for (int m = 0; m < 4; ++m) _Pragma("unroll") for (int n = 0; n < 2; ++n) _Pragma("unroll") for (int k = 0; k < 2; ++k) \
        acc[ai][bj][m][n] = __builtin_amdgcn_mfma_f32_16x16x32_bf16(Bt[n][k], At[m][k], acc[ai][bj][m][n], 0, 0, 0); __builtin_amdgcn_s_setprio(0); } while (0)
#define PG8_WAIT_V(n) asm volatile("s_waitcnt vmcnt(" #n ")" ::: "memory")
#define PG8_WAIT_L(n) asm volatile("s_waitcnt lgkmcnt(" #n ")" ::: "memory")
#define PG8_BAR __builtin_amdgcn_s_barrier()
#define PG8_SCHED __builtin_amdgcn_sched_barrier(0)
    Unit cur, nxt; int ui = 0;
    if (!S.next(0, cur)) return;
    f32x4 acc[2][2][4][2];
#pragma unroll
    for (int a = 0; a < 2; ++a)
#pragma unroll
        for (int b = 0; b < 2; ++b)
#pragma unroll
            for (int m = 0; m < 4; ++m)
#pragma unroll
                for (int n = 0; n < 2; ++n) acc[a][b][m][n] = (f32x4){0.f, 0.f, 0.f, 0.f};
    bf16x8 At[4][2], B0[2][2], B1[2][2];
    const char* cA = (const char*)g.A + (size_t)cur.pm * tstep; const char* cB = (const char*)g.Bt + (size_t)cur.pn * tstep;
    S.a_ready(cur);
    PG8_STAGE(PG8_SB(0, 0), cB, voffB); PG8_STAGE(PG8_SA(0, 0), cA, voffA); PG8_STAGE(PG8_SB(0, 1), cB + hstep, voffB); PG8_STAGE(PG8_SA(0, 1), cA + hstep, voffA);
    if (wr == 1) PG8_BAR;
    PG8_WAIT_V(4); PG8_BAR;
    PG8_STAGE(PG8_SB(1, 0), cB + kstep, voffB); PG8_STAGE(PG8_SA(1, 0), cA + kstep, voffA); PG8_STAGE(PG8_SB(1, 1), cB + hstep + kstep, voffB);
    PG8_WAIT_V(6); PG8_BAR;
    PG8_STAMP();
    for (;;) {
        const bool has_next = S.next(ui + 1, nxt);
        const char* nA = has_next ? (const char*)g.A + (size_t)nxt.pm * tstep : cA; const char* nB = has_next ? (const char*)g.Bt + (size_t)nxt.pn * tstep : cB;
        for (int t = 0; t < nt; t += 2) {
            const bool last = (t == nt - 2);
            const char* a1 = cA + (size_t)(t + 1) * kstep;
            const char* a2 = last ? nA : cA + (size_t)(t + 2) * kstep; const char* b2 = last ? nB : cB + (size_t)(t + 2) * kstep;
            const char* a3 = a2 + kstep; const char* b3 = b2 + kstep;
            if (last && has_next) S.a_ready(nxt);
            PG8_LDB(B0, 0, 0); PG8_SCHED; PG8_LDA(At, 0, 0); PG8_STAGE(PG8_SA(1, 1), a1 + hstep, voffA);
            PG8_WAIT_L(8); PG8_BAR; PG8_WAIT_L(0); PG8_MMA(0, 0, At, B0); PG8_BAR; PG8_SCHED;
            PG8_LDB(B1, 0, 1); PG8_STAGE(PG8_SB(0, 0), b2, voffB);
            PG8_BAR; PG8_WAIT_L(0); PG8_MMA(0, 1, At, B1); PG8_BAR;
            PG8_LDA(At, 0, 1); PG8_STAGE(PG8_SA(0, 0), a2, voffA);
            PG8_BAR; PG8_WAIT_L(0); PG8_MMA(1, 0, At, B0); PG8_BAR; PG8_SCHED;
            PG8_STAGE(PG8_SB(0, 1), b2 + hstep, voffB);
            PG8_WAIT_V(6); PG8_BAR; PG8_MMA(1, 1, At, B1); PG8_BAR;
            PG8_LDB(B0, 1, 0); PG8_SCHED; PG8_LDA(At, 1, 0); PG8_STAGE(PG8_SA(0, 1), a2 + hstep, voffA);
            PG8_WAIT_L(8); PG8_BAR; PG8_WAIT_L(0); PG8_MMA(0, 0, At, B0); PG8_BAR; PG8_SCHED;
            PG8_LDB(B1, 1, 1); PG8_STAGE(PG8_SB(1, 0), b3, voffB);
            PG8_BAR; PG8_WAIT_L(0); PG8_MMA(0, 1, At, B1); PG8_BAR;
            PG8_LDA(At, 1, 1); PG8_STAGE(PG8_SA(1, 0), a3, voffA);
            PG8_BAR; PG8_WAIT_L(0); PG8_MMA(1, 0, At, B0); PG8_BAR; PG8_SCHED;
            PG8_STAGE(PG8_SB(1, 1), b3 + hstep, voffB);
            PG8_WAIT_V(6); PG8_BAR; PG8_MMA(1, 1, At, B1); PG8_BAR;
        }
        PG8_STAMP();
        if constexpr (!Epi::AFTER_DRAIN) { E(acc, cur, wr, wc, fr, fq); S.done(cur); }
        PG8_STAMP();
        if (!has_next) break;
#pragma unroll
        for (int a = 0; a < 2; ++a)
#pragma unroll
            for (int b = 0; b < 2; ++b)
#pragma unroll
                for (int m = 0; m < 4; ++m)
#pragma unroll
                    for (int n = 0; n < 2; ++n) acc[a][b][m][n] = (f32x4){0.f, 0.f, 0.f, 0.f};
        cur = nxt; cA = nA; cB = nB; ++ui;
    }
    PG8_WAIT_V(0);
    if (wr == 0) PG8_BAR;
    PG8_BAR;
    if constexpr (Epi::AFTER_DRAIN) { E.fused(acc, cur, wr, wc, fr, fq, lds, wid, lane); S.done(cur); }
    PG8_STAMP();
    if (STAMP && wid == 0) { stamps[lane] = lane < nts ? (((unsigned long long)(unsigned)ts_hi << 32) | (unsigned)ts_lo) : 0ull;
        if (lane == 62) stamps[62] = rt_entry; if (lane == 63) stamps[63] = (unsigned long long)wall_clock64(); }
#undef PG8_STAMP
#undef PG8_SA
#undef PG8_SB
#undef PG8_STAGE
#undef PG8_LDA
#undef PG8_LDB
#undef PG8_MMA
#undef PG8_WAIT_V
#undef PG8_WAIT_L
#undef PG8_BAR
#undef PG8_SCHED
}
}

#define LAS __attribute__((address_space(3)))
typedef unsigned short bf16;
typedef float f32x4 __attribute__((ext_vector_type(4)));

#ifndef MK_N_LAUNCHES
#define MK_N_LAUNCHES 1
#endif
#ifndef MK_PHASE_MASK
#define MK_PHASE_MASK 0x1FFF
#endif
#ifndef MK_REPEAT
#define MK_REPEAT -1
#endif
#ifndef MK_SSD_SEQ
#define MK_SSD_SEQ 0
#endif
#ifndef MK_SKIP_MIXER
#define MK_SKIP_MIXER 0
#endif
#ifndef MK_SKIP_PEER
#define MK_SKIP_PEER 0
#endif
#ifndef MK_SKIP_RWKV
#define MK_SKIP_RWKV 0
#endif
#ifndef MK_SKIP_SSD
#define MK_SKIP_SSD 0
#endif

constexpr int DM = 4096, NBATCH = 4, SEQ = 4096, CTXL = 256;
constexpr int MX = NBATCH * SEQ;
constexpr int MC = NBATCH * CTXL;
constexpr int MT = MX + MC;
constexpr int RW = 2048;
constexpr int RCOLS = 6784;
constexpr int NIN = 12992, NINP = 13056;
constexpr int COL_Z = 6784, COL_XBC = 8832, COL_DT = 12928;
constexpr int NLR = 10240, KLR = 640;
constexpr int NMOD = 6 * DM;
constexpr float RMS_EPS = 1e-6f, GN_EPS = 64e-5f;
constexpr int NSTEP = CTXL + SEQ;

constexpr size_t MiB = (size_t)1 << 20;
constexpr size_t WS_CTL = 0, CTL_ZERO_BYTES = 1 * MiB;
constexpr size_t WS_MOD = 64 * 1024;
constexpr size_t WS_WT_OUT = 2 * MiB;
constexpr size_t WS_WT_Q = 34 * MiB;
constexpr size_t WS_WLR = 50 * MiB;
constexpr size_t WS_KBD = 63 * MiB;
constexpr size_t WS_DT = 71 * MiB;
constexpr size_t WS_LA = WS_DT + (size_t)MT * 64 * 4;
constexpr size_t WS_ALR = 80 * MiB;
constexpr size_t WS_WT_IN = 102 * MiB;
constexpr size_t WS_A1 = 204 * MiB;
constexpr size_t WS_P = 340 * MiB;
constexpr size_t WS_R = 774 * MiB, WS_K = 842 * MiB, WS_V = 910 * MiB, WS_KK = 978 * MiB;
constexpr size_t WS_XS = 1046 * MiB, WS_BC = 1114 * MiB;
constexpr size_t WS_Z = 102 * MiB;
constexpr size_t WS_LR = 340 * MiB;
constexpr size_t WS_A2 = 166 * MiB;
constexpr size_t WS_XN2 = 340 * MiB;
constexpr size_t WS_Q = 468 * MiB;
constexpr size_t WS_S = 532 * MiB;
constexpr size_t WS_U8 = 774 * MiB, WS_V8 = 838 * MiB;
constexpr size_t WS_USC = 902 * MiB, WS_VSC = WS_USC + 65536;
constexpr size_t WS_END = 1182 * MiB;
static_assert(WS_WT_IN + (size_t)NINP * DM * 2 <= WS_A1 && WS_A1 + (size_t)MT * DM * 2 <= WS_P && WS_P + (size_t)MT * NINP * 2 <= WS_R, "ws map 1");
static_assert(WS_LR + (size_t)MT * NLR * 2 <= WS_R && WS_Z + (size_t)MX * RW * 2 <= WS_A2 && WS_A2 + (size_t)MX * DM * 2 <= WS_P, "ws map 2");
static_assert(WS_LA + (size_t)MT * 64 * 4 <= WS_ALR && WS_ALR + (size_t)MT * KLR * 2 <= WS_WT_IN && WS_WLR + (size_t)NLR * KLR * 2 <= WS_KBD, "ws map 3");
static_assert(WS_S + (size_t)MX * 2048 * 4 <= WS_R && WS_VSC + 65536 <= WS_XS, "ws map 4");

constexpr int LDS_BYTES = 147456;
constexpr int LDS_CTL = 143360;
constexpr int LDS_MISC = LDS_CTL + 320;

enum { I_X = 0, I_C, I_CTX, I_CCTX, I_WMOD, I_BMOD, I_N1G, I_N2G, I_WIN, I_WOUT, I_MU, I_W0, I_W2, I_A0, I_A2, I_G2, I_KK, I_KA, I_RK, I_LNW, I_LNB,
       I_CONVW, I_CONVB, I_DTB, I_ALOG, I_SSMD, I_NORMW, I_WQ, I_K1, I_K2, I_PU, I_PV, I_FG, N_IN };

struct Args { const float* in[N_IN]; float* out; unsigned char* ws; int ph_lo, ph_hi; };

__device__ __forceinline__ unsigned f2bf(float f) { unsigned u = __float_as_uint(f); return (u + 0x7fffu + ((u >> 16) & 1u)) >> 16; }
__device__ __forceinline__ unsigned pk2(float lo, float hi) { return f2bf(lo) | (f2bf(hi) << 16); }
__device__ __forceinline__ float bflo(unsigned u) { return __uint_as_float(u << 16); }
__device__ __forceinline__ float bfhi(unsigned u) { return __uint_as_float(u & 0xffff0000u); }
__device__ __forceinline__ void unpack8(const uint4& u, float (&f)[8]) {
    f[0] = bflo(u.x); f[1] = bfhi(u.x); f[2] = bflo(u.y); f[3] = bfhi(u.y); f[4] = bflo(u.z); f[5] = bfhi(u.z); f[6] = bflo(u.w); f[7] = bfhi(u.w);
}
__device__ __forceinline__ uint4 pack8(const float (&f)[8]) { uint4 u; u.x = pk2(f[0], f[1]); u.y = pk2(f[2], f[3]); u.z = pk2(f[4], f[5]); u.w = pk2(f[6], f[7]); return u; }
__device__ __forceinline__ uint4 ld16(const bf16* p) { return *(const uint4*)p; }
__device__ __forceinline__ void st16(bf16* p, const uint4& v) { *(uint4*)p = v; }
__device__ __forceinline__ void ldf8(const float* p, float (&f)[8]) { const float4 a = *(const float4*)p, b = *(const float4*)(p + 4); f[0] = a.x; f[1] = a.y; f[2] = a.z; f[3] = a.w; f[4] = b.x; f[5] = b.y; f[6] = b.z; f[7] = b.w; }
#define PIN8(a) asm volatile("" : "+v"((a)[0]), "+v"((a)[1]), "+v"((a)[2]), "+v"((a)[3]), "+v"((a)[4]), "+v"((a)[5]), "+v"((a)[6]), "+v"((a)[7]))
template <int CTRL> __device__ __forceinline__ float dppf(float v) { return __uint_as_float((unsigned)__builtin_amdgcn_update_dpp(0, (int)__float_as_uint(v), CTRL, 0xF, 0xF, true)); }
__device__ __forceinline__ float rlane(float v, int l) { return __uint_as_float((unsigned)__builtin_amdgcn_readlane((int)__float_as_uint(v), l)); }
__device__ __forceinline__ float sum8(float v) { v += dppf<0xB1>(v); v += dppf<0x4E>(v); v += dppf<0x141>(v); return v; }
__device__ __forceinline__ float sum16(float v) { v = sum8(v); v += dppf<0x140>(v); return v; }
__device__ __forceinline__ float sum32(float v) { v = sum16(v); v += __shfl_xor(v, 16); return v; }
__device__ __forceinline__ float wave_sum(float v) { v = sum16(v); return (rlane(v, 0) + rlane(v, 16)) + (rlane(v, 32) + rlane(v, 48)); }
__device__ __forceinline__ float wave_max(float v) {
    v = fmaxf(v, dppf<0xB1>(v)); v = fmaxf(v, dppf<0x4E>(v)); v = fmaxf(v, dppf<0x141>(v)); v = fmaxf(v, dppf<0x140>(v));
    return fmaxf(fmaxf(rlane(v, 0), rlane(v, 16)), fmaxf(rlane(v, 32), rlane(v, 48)));
}
__device__ __forceinline__ float sigmoidf_(float x) { return 1.f / (1.f + __expf(-x)); }
__device__ __forceinline__ float siluf_(float x) { return x / (1.f + __expf(-x)); }

struct EpiLR {
    static constexpr bool PERM = true, AFTER_DRAIN = false;
    bf16* O; const float* w0; const float* a0;
    __device__ __forceinline__ void operator()(const pg8::f32x4 (&acc)[2][2][4][2], const pg8::Unit& u, int wr, int wc, int fr, int fq) const {
        const int row0 = u.pm * 256 + wr * 64 + fr; const int colt = u.pn * 256; const int type = colt >> 11;
        const int col0 = colt + wc * 32 + 8 * fq;
        const float* bias = type < 2 ? (w0 + type * 2048) : (a0 + (type - 2) * 2048);
        pg8::f32x4 bv[2][2];
#pragma unroll
        for (int bj = 0; bj < 2; ++bj)
#pragma unroll
            for (int n = 0; n < 2; ++n) bv[bj][n] = type < 4 ? *(const pg8::f32x4*)(bias + ((col0 + bj * 128 + 4 * n) & 2047)) : (pg8::f32x4){0.f, 0.f, 0.f, 0.f};
#pragma unroll
        for (int ai = 0; ai < 2; ++ai)
#pragma unroll
            for (int m = 0; m < 4; ++m) { bf16* rowp = O + (size_t)(row0 + ai * 128 + m * 16) * NLR + col0;
#pragma unroll
                for (int bj = 0; bj < 2; ++bj) { pg8::f32x4 v0 = acc[ai][bj][m][0] + bv[bj][0], v1 = acc[ai][bj][m][1] + bv[bj][1];
                    if (type < 4) {
#pragma unroll
                        for (int j = 0; j < 4; ++j) { float s0 = 1.f / (1.f + __expf(-v0[j])), s1 = 1.f / (1.f + __expf(-v1[j]));
                            if (type < 2) { s0 = -expm1f(-0.60653066f * s0); s1 = -expm1f(-0.60653066f * s1); }
                            v0[j] = s0; v1[j] = s1; } }
                    pg8::u32x4 w; w.x = pg8::cvt_pk_bf16(v0[0], v0[1]); w.y = pg8::cvt_pk_bf16(v0[2], v0[3]); w.z = pg8::cvt_pk_bf16(v1[0], v1[1]); w.w = pg8::cvt_pk_bf16(v1[2], v1[3]);
                    *(pg8::u32x4*)(rowp + bj * 128) = w; } }
    }
};
struct EpiRes {
    static constexpr bool PERM = false, AFTER_DRAIN = false;
    float* C; const float* X; const float* mod;
    __device__ __forceinline__ void operator()(const pg8::f32x4 (&acc)[2][2][4][2], const pg8::Unit& u, int wr, int wc, int fr, int fq) const {
        const int row0 = u.pm * 256 + wr * 64 + fr, col0 = u.pn * 256 + wc * 32 + 4 * fq;
        const float* gt = mod + (size_t)((u.pm * 256) / SEQ) * NMOD + 2 * DM;
        pg8::f32x4 gv[2][2];
#pragma unroll
        for (int bj = 0; bj < 2; ++bj)
#pragma unroll
            for (int n = 0; n < 2; ++n) gv[bj][n] = *(const pg8::f32x4*)(gt + col0 + bj * 128 + n * 16);
#pragma unroll
        for (int ai = 0; ai < 2; ++ai)
#pragma unroll
            for (int m = 0; m < 4; ++m) { const size_t off = (size_t)(row0 + ai * 128 + m * 16) * DM + col0;
#pragma unroll
                for (int bj = 0; bj < 2; ++bj)
#pragma unroll
                    for (int n = 0; n < 2; ++n) { const pg8::f32x4 xv = *(const pg8::f32x4*)(X + off + bj * 128 + n * 16);
#if MK_SKIP_MIXER
                        *(pg8::f32x4*)(C + off + bj * 128 + n * 16) = xv;
#else
                        *(pg8::f32x4*)(C + off + bj * 128 + n * 16) = xv + gv[bj][n] * acc[ai][bj][m][n];
#endif
                    }
                asm volatile("" ::: "memory"); }
    }
};

#define XB_TMO      128
#define XB_XCNT(j)  (256  + 64 * (j))
#define XB_XSUB(j)  (1280 + 64 * (j))
#define XB_XGEN(j)  (2304 + 64 * (j))
#define XB_TOP      3328
#define XB_TOPGEN   3392
#define XCD_BAR_WORDS 3456
#define XB_SPIN_CAP (1u << 18)
__device__ __forceinline__ unsigned xb_ld(unsigned* p)              { return __hip_atomic_load(p, __ATOMIC_RELAXED, __HIP_MEMORY_SCOPE_AGENT); }
__device__ __forceinline__ unsigned xb_add(unsigned* p, unsigned v) { return __hip_atomic_fetch_add(p, v, __ATOMIC_RELAXED, __HIP_MEMORY_SCOPE_AGENT); }
__device__ __forceinline__ unsigned xb_xcc_id() { return (unsigned)__builtin_amdgcn_s_getreg((3 << 11) | 20) & 0xFu; }
#define XB_SPIN(cond, bar) do { unsigned _sp = 0; while (cond) { __builtin_amdgcn_s_sleep(1); \
    if ((++_sp & 255u) == 0u) { if (xb_ld(&(bar)[XB_TMO])) break; if (_sp > XB_SPIN_CAP) { atomicAdd(&(bar)[XB_TMO], 1u); break; } } } } while (0)
struct XcdBarrier { unsigned* bar; unsigned x; volatile LAS unsigned* st; };
__device__ __forceinline__ XcdBarrier xcd_barrier_post(unsigned* bar, volatile LAS unsigned* st) {
    XcdBarrier b; b.bar = bar; b.x = xb_xcc_id(); b.st = st;
    if (threadIdx.x == 0) (void)xb_add(&bar[XB_XCNT(b.x)], 1u);
    return b;
}
__device__ __forceinline__ void xcd_barrier_complete(unsigned* bar, unsigned x, unsigned& nloc, unsigned& nx) {
    const unsigned G = gridDim.x * gridDim.y * gridDim.z;
    unsigned sum, cnt, mine, sp = 0u;
    for (;;) {
        sum = 0u; cnt = 0u; mine = 0u;
#pragma unroll
        for (unsigned j = 0; j < 16; ++j) { const unsigned c = xb_ld(&bar[XB_XCNT(j)]); sum += c; cnt += (c > 0u) ? 1u : 0u; mine = (j == x) ? c : mine; }
        if (sum == G) break;
        __builtin_amdgcn_s_sleep(1);
        if ((++sp & 255u) == 0u) { if (xb_ld(&bar[XB_TMO])) break; if (sp > XB_SPIN_CAP) { atomicAdd(&bar[XB_TMO], 1u); break; } }
    }
    nloc = mine > 0u ? mine : 1u; nx = cnt > 0u ? cnt : 1u;
}
__device__ __forceinline__ void xcd_barrier(const XcdBarrier& b) {
    asm volatile("s_waitcnt vmcnt(0)" ::: "memory");
    __syncthreads();
    if (threadIdx.x == 0) {
        unsigned* bar = b.bar;
        __builtin_amdgcn_s_waitcnt(0);
        unsigned nloc = b.st[0], nx = b.st[1];
        if (nloc == 0u) { xcd_barrier_complete(bar, b.x, nloc, nx); b.st[0] = nloc; b.st[1] = nx; }
        const unsigned old = xb_add(&bar[XB_XSUB(b.x)], 1u);
        const unsigned gen = old / nloc;
        if (old + 1u == (gen + 1u) * nloc) {
            __builtin_amdgcn_fence(__ATOMIC_RELEASE, "agent");
            asm volatile("s_waitcnt vmcnt(0)" ::: "memory");
            const unsigned og = xb_add(&bar[XB_TOP], 1u);
            const unsigned tg = og / nx;
            if (og + 1u == (tg + 1u) * nx) xb_add(&bar[XB_TOPGEN], 1u);
            else XB_SPIN(xb_ld(&bar[XB_TOPGEN]) == tg, bar);
            __builtin_amdgcn_fence(__ATOMIC_ACQUIRE, "agent");
            xb_add(&bar[XB_XGEN(b.x)], 1u);
            asm volatile("s_waitcnt vmcnt(0)" ::: "memory");
        } else {
            XB_SPIN(xb_ld(&bar[XB_XGEN(b.x)]) == gen, bar);
            __builtin_amdgcn_fence(__ATOMIC_ACQUIRE, "agent");
            asm volatile("s_waitcnt vmcnt(0)" ::: "memory");
        }
    }
    __syncthreads();
}

#define TID ((int)threadIdx.x)
#define LANE ((int)(threadIdx.x & 63))
#define WAVE ((int)__builtin_amdgcn_readfirstlane((int)(threadIdx.x >> 6)))
#define GW ((int)blockIdx.x * 8 + WAVE)
#define NGW ((int)gridDim.x * 8)

__device__ __forceinline__ void ph_mod(const Args& a, LAS unsigned char* lds) {
    const float* c = a.in[I_C]; const float* cc = a.in[I_CCTX]; const float* w_mod = a.in[I_WMOD]; const float* b_mod = a.in[I_BMOD];
    float* mod = (float*)(a.ws + WS_MOD);
    LAS float* sS = (LAS float*)lds;
    LAS float* red = (LAS float*)(lds + 81920);
    const int tid = TID, lane = LANE, wave = WAVE;
    if ((int)blockIdx.x < 192) {
        for (int i = tid; i < 5 * DM; i += 512) { const int v = i >> 12, k = i & (DM - 1); const float xv = v < 4 ? c[v * DM + k] : cc[k]; sS[i] = xv / (1.f + expf(-xv)); }
    }
    __syncthreads();
    for (int u = blockIdx.x; u < 192; u += gridDim.x) {
        const int cl = lane & 31, kh = lane >> 5;
        float acc[5][4];
#pragma unroll
        for (int v = 0; v < 5; ++v)
#pragma unroll
            for (int e = 0; e < 4; ++e) acc[v][e] = 0.f;
        const float* wp = w_mod + (size_t)(wave * 512 + kh) * NMOD + u * 128 + cl * 4;
#pragma unroll 8
        for (int i = 0; i < 256; ++i) {
            const float4 w = *(const float4*)(wp + (size_t)(2 * i) * NMOD);
#pragma unroll
            for (int v = 0; v < 5; ++v) { const float s = sS[v * DM + wave * 512 + 2 * i + kh]; acc[v][0] += s * w.x; acc[v][1] += s * w.y; acc[v][2] += s * w.z; acc[v][3] += s * w.w; }
        }
#pragma unroll
        for (int v = 0; v < 5; ++v)
#pragma unroll
            for (int e = 0; e < 4; ++e) acc[v][e] += __shfl_xor(acc[v][e], 32);
        if (kh == 0) {
#pragma unroll
            for (int v = 0; v < 5; ++v) *(LAS f32x4*)(red + ((wave * 5 + v) * 128 + cl * 4)) = (f32x4){acc[v][0], acc[v][1], acc[v][2], acc[v][3]};
        }
        __syncthreads();
        for (int i = tid; i < 640; i += 512) { const int v = i >> 7, n = i & 127; float s = b_mod[u * 128 + n];
#pragma unroll
            for (int w = 0; w < 8; ++w) s += red[(w * 5 + v) * 128 + n];
            mod[v * NMOD + u * 128 + n] = s; }
        __syncthreads();
    }
    __syncthreads();
}

__device__ __forceinline__ void transpose_item(const float* W, int K, int N, bf16* WT, LAS float* scr, int item, int lane) {
    const int nblk = N / 32, kb = item / nblk, nb = item % nblk, k0 = 64 * kb, n0 = 32 * nb;
#pragma unroll 8
    for (int i = 0; i < 32; ++i) { const int kk = 2 * i + (lane >> 5); scr[kk * 33 + (lane & 31)] = W[(size_t)(k0 + kk) * N + n0 + (lane & 31)]; }
    asm volatile("s_waitcnt lgkmcnt(0)" ::: "memory");
    const int c = lane & 7;
#pragma unroll
    for (int j = 0; j < 4; ++j) { const int n = (lane >> 3) + 8 * j; const LAS float* s = scr + (8 * c) * 33 + n;
        uint4 o; o.x = pk2(s[0 * 33], s[1 * 33]); o.y = pk2(s[2 * 33], s[3 * 33]); o.z = pk2(s[4 * 33], s[5 * 33]); o.w = pk2(s[6 * 33], s[7 * 33]);
        *(uint4*)(WT + (size_t)(n0 + n) * K + k0 + 8 * c) = o; }
    asm volatile("s_waitcnt lgkmcnt(0)" ::: "memory");
}
__device__ __forceinline__ void ph_conv(const Args& a, LAS unsigned char* lds) {
    const int lane = LANE, wave = WAVE, gw = GW, ngw = NGW;
    LAS float* scr = (LAS float*)(lds + wave * 16384);
    bf16* wt_in = (bf16*)(a.ws + WS_WT_IN); bf16* wt_out = (bf16*)(a.ws + WS_WT_OUT); bf16* wt_q = (bf16*)(a.ws + WS_WT_Q);
    constexpr int IT_IN = (DM / 64) * (NIN / 32), IT_OUT = (DM / 64) * (DM / 32), IT_Q = (DM / 64) * (2048 / 32);
    for (int it = gw; it < IT_IN + IT_OUT + IT_Q; it += ngw) {
        int r = it;
        if (r < IT_IN) { transpose_item(a.in[I_WIN], DM, NIN, wt_in, scr, r, lane); continue; } r -= IT_IN;
        if (r < IT_OUT) { transpose_item(a.in[I_WOUT], DM, DM, wt_out, scr, r, lane); continue; } r -= IT_OUT;
        transpose_item(a.in[I_WQ], DM, 2048, wt_q, scr, r, lane);
    }
    const int gt = blockIdx.x * 512 + TID, ngt = gridDim.x * 512;
    for (int i = gt; i < (NINP - NIN) * DM / 8; i += ngt) *(uint4*)(wt_in + (size_t)NIN * DM + (size_t)i * 8) = make_uint4(0u, 0u, 0u, 0u);
    { bf16* wlr = (bf16*)(a.ws + WS_WLR); const float* w2 = a.in[I_W2]; const float* a2 = a.in[I_A2]; const float* g2 = a.in[I_G2];
      for (int i = gt; i < NLR * (KLR / 8); i += ngt) { const int n = i / (KLR / 8), k0 = (i % (KLR / 8)) * 8; const int type = n >> 11, cch = n & 2047;
          float f[8];
#pragma unroll
          for (int e = 0; e < 8; ++e) { const int k = k0 + e; float v = 0.f;
              if (type == 0) { if (k < 96) v = w2[(size_t)(0 * 96 + k) * RW + cch]; }
              else if (type == 1) { if (k >= 96 && k < 192) v = w2[(size_t)(1 * 96 + (k - 96)) * RW + cch]; }
              else if (type == 2) { if (k >= 192 && k < 288) v = a2[(size_t)(0 * 96 + (k - 192)) * RW + cch]; }
              else if (type == 3) { if (k >= 288 && k < 384) v = a2[(size_t)(1 * 96 + (k - 288)) * RW + cch]; }
              else { if (k >= 384) v = g2[(size_t)(k - 384) * RW + cch]; }
              f[e] = v; }
          st16(wlr + (size_t)n * KLR + k0, pack8(f)); } }
    { bf16* kbd = (bf16*)(a.ws + WS_KBD); const float* k1 = a.in[I_K1]; const float* k2 = a.in[I_K2];
      for (int i = gt; i < 2048 * 256; i += ngt) { const int n = i >> 8, k0 = (i & 255) * 8; float f[8];
          if ((n >> 7) == (k0 >> 7)) { const int h = n >> 8, s = (n >> 7) & 1, key = n & 127, d0 = k0 & 127; const float* src = (s ? k2 : k1) + ((size_t)(h * 128 + key) * 128 + d0); ldf8(src, f); }
          else {
#pragma unroll
              for (int e = 0; e < 8; ++e) f[e] = 0.f; }
          st16(kbd + (size_t)n * 2048 + k0, pack8(f)); } }
}

__device__ __forceinline__ void norm_mod_row(const float* src, const float* g, const float* sh, const float* sc, bf16* dst, int lane) {
    float4 v[16]; float ss = 0.f;
#pragma unroll
    for (int j = 0; j < 16; ++j) { v[j] = *(const float4*)(src + (lane + 64 * j) * 4); ss += (v[j].x * v[j].x + v[j].y * v[j].y) + (v[j].z * v[j].z + v[j].w * v[j].w); }
    const float rstd = rsqrtf(wave_sum(ss) * (1.f / DM) + RMS_EPS);
#pragma unroll
    for (int j = 0; j < 16; ++j) { const int c = (lane + 64 * j) * 4; const float4 gg = *(const float4*)(g + c), s1 = *(const float4*)(sc + c), s0 = *(const float4*)(sh + c);
        const float o0 = v[j].x * rstd * gg.x * (1.f + s1.x) + s0.x, o1 = v[j].y * rstd * gg.y * (1.f + s1.y) + s0.y, o2 = v[j].z * rstd * gg.z * (1.f + s1.z) + s0.z, o3 = v[j].w * rstd * gg.w * (1.f + s1.w) + s0.w;
        uint2 w; w.x = pk2(o0, o1); w.y = pk2(o2, o3); *(uint2*)(dst + c) = w; }
}
__device__ __forceinline__ void ph_norm1(const Args& a) {
    const int lane = LANE; const float* mod = (const float*)(a.ws + WS_MOD); bf16* A1 = (bf16*)(a.ws + WS_A1);
    for (int m = GW; m < MT; m += NGW) {
        const float* src = m < MX ? a.in[I_X] + (size_t)m * DM : a.in[I_CTX] + (size_t)(m - MX) * DM;
        const int v = m < MX ? m / SEQ : 4;
        norm_mod_row(src, a.in[I_N1G], mod + (size_t)v * NMOD, mod + (size_t)v * NMOD + DM, A1 + (size_t)m * DM, lane);
    }
}
__device__ __forceinline__ void ph_norm2(const Args& a) {
    const int lane = LANE; const float* mod = (const float*)(a.ws + WS_MOD); bf16* XN2 = (bf16*)(a.ws + WS_XN2);
    for (int m = GW; m < MX; m += NGW) {
        const int v = m / SEQ;
        norm_mod_row(a.out + (size_t)m * DM, a.in[I_N2G], mod + (size_t)v * NMOD + 3 * DM, mod + (size_t)v * NMOD + 4 * DM, XN2 + (size_t)m * DM, lane);
    }
    unsigned* U8 = (unsigned*)(a.ws + WS_U8); unsigned* V8 = (unsigned*)(a.ws + WS_V8); float* USC = (float*)(a.ws + WS_USC); float* VSC = (float*)(a.ws + WS_VSC);
    for (int row = GW; row < 2 * 16384; row += NGW) {
        const int tb = row >> 14, r = row & 16383;
        const float* src = (tb ? a.in[I_PV] : a.in[I_PU]) + (size_t)r * DM;
        float4 v[16]; float am = 0.f;
#pragma unroll
        for (int j = 0; j < 16; ++j) { v[j] = *(const float4*)(src + (lane + 64 * j) * 4); am = fmaxf(fmaxf(am, fmaxf(fabsf(v[j].x), fabsf(v[j].y))), fmaxf(fabsf(v[j].z), fabsf(v[j].w))); }
        am = wave_max(am);
        const float scale = am > 0.f ? am * (1.f / 448.f) : 1.f, inv = 1.f / scale;
        unsigned* dst = (tb ? V8 : U8) + (size_t)r * (DM / 4);
#pragma unroll
        for (int j = 0; j < 16; ++j) { int p = __builtin_amdgcn_cvt_pk_fp8_f32(v[j].x * inv, v[j].y * inv, 0, false); p = __builtin_amdgcn_cvt_pk_fp8_f32(v[j].z * inv, v[j].w * inv, p, true); dst[lane + 64 * j] = (unsigned)p; }
        if (lane == 0) (tb ? VSC : USC)[r] = scale;
    }
}

__device__ __forceinline__ void ph_prep_rwkv(const Args& a) {
    const int lane = LANE;
    const bf16* P = (const bf16*)(a.ws + WS_P);
    bf16* R = (bf16*)(a.ws + WS_R); bf16* K = (bf16*)(a.ws + WS_K); bf16* V = (bf16*)(a.ws + WS_V); bf16* KK = (bf16*)(a.ws + WS_KK); bf16* ALR = (bf16*)(a.ws + WS_ALR);
    const float* mu = a.in[I_MU]; const float* k_k = a.in[I_KK];
    for (int m = GW; m < MT; m += NGW) {
        const bool lat = m < MX;
        bool h0, h1, h2 = false, h3 = false; size_t r0, r1, r2 = 0, r3 = 0;
        if (lat) { const int t = m & (SEQ - 1), row = t >> 6, col = t & 63; h0 = col > 0; h1 = col < 63; h2 = row > 0; h3 = row < 63; r0 = (size_t)(m - 1); r1 = (size_t)(m + 1); r2 = (size_t)(m - 64); r3 = (size_t)(m + 64); }
        else { const int t = (m - MX) & (CTXL - 1); h0 = t > 0; h1 = t < CTXL - 1; r0 = (size_t)(m - 1); r1 = (size_t)(m + 1); }
        const bf16* prow = P + (size_t)m * NINP;
#pragma unroll
        for (int i = 0; i < 14; ++i) {
            const int chunk = lane + 64 * i;
            if (chunk < RCOLS / 8) {
                const int c0 = chunk * 8;
                float own[8], n0[8], n1[8], sh[8], xm[8], muv[8];
                const uint4 z4 = make_uint4(0u, 0u, 0u, 0u);
                unpack8(ld16(prow + c0), own);
                unpack8(h0 ? ld16(P + r0 * NINP + c0) : z4, n0);
                unpack8(h1 ? ld16(P + r1 * NINP + c0) : z4, n1);
                if (lat) { float n2[8], n3[8];
                    unpack8(h2 ? ld16(P + r2 * NINP + c0) : z4, n2);
                    unpack8(h3 ? ld16(P + r3 * NINP + c0) : z4, n3);
#pragma unroll
                    for (int e = 0; e < 8; ++e) sh[e] = (e & 3) == 0 ? n0[e] : (e & 3) == 1 ? n1[e] : (e & 3) == 2 ? n2[e] : n3[e];
                } else {
#pragma unroll
                    for (int e = 0; e < 8; ++e) sh[e] = (e & 1) == 0 ? n0[e] : n1[e];
                }
                ldf8(mu + c0, muv);
#pragma unroll
                for (int e = 0; e < 8; ++e) xm[e] = own[e] + muv[e] * (sh[e] - own[e]);
                if (i < 4) st16(R + (size_t)m * RW + c0, pack8(xm));
                else if (i < 8) { const int cc = c0 - 2048; st16(K + (size_t)m * RW + cc, pack8(xm));
                    float kv[8], kkv[8]; ldf8(k_k + cc, kv); float ss = 0.f;
#pragma unroll
                    for (int e = 0; e < 8; ++e) { kkv[e] = xm[e] * kv[e]; ss += kkv[e] * kkv[e]; }
                    ss = sum8(ss);
                    const float inv = rsqrtf(fmaxf(ss, 1e-24f));
#pragma unroll
                    for (int e = 0; e < 8; ++e) kkv[e] *= inv;
                    st16(KK + (size_t)m * RW + cc, pack8(kkv)); }
                else if (i < 12) st16(V + (size_t)m * RW + (c0 - 4096), pack8(xm));
                else { const int j0 = c0 - 6144; float f[8];
#pragma unroll
                    for (int e = 0; e < 8; ++e) f[e] = j0 < 192 ? tanhf(xm[e]) : (j0 < 384 ? xm[e] : 1.f / (1.f + __expf(-xm[e])));
                    st16(ALR + (size_t)m * KLR + j0, pack8(f)); }
            }
        }
    }
}

__device__ __forceinline__ void ph_prep_ssd(const Args& a) {
    const int lane = LANE;
    const bf16* P = (const bf16*)(a.ws + WS_P);
    bf16* XS = (bf16*)(a.ws + WS_XS); bf16* BC = (bf16*)(a.ws + WS_BC); bf16* Z = (bf16*)(a.ws + WS_Z); float* DT = (float*)(a.ws + WS_DT); float* LA = (float*)(a.ws + WS_LA);
    const float* cw = a.in[I_CONVW]; const float* cb = a.in[I_CONVB];
    for (int m = GW; m < MT; m += NGW) {
        const bool lat = m < MX; bool hp, hn;
        if (lat) { const int t = m & (SEQ - 1); hp = t > 0; hn = t < SEQ - 1; } else { const int t = (m - MX) & (CTXL - 1); hp = t > 0; hn = t < CTXL - 1; }
        const bf16* prow = P + (size_t)m * NINP;
#pragma unroll
        for (int i = 0; i < 8; ++i) {
            const int c0 = (lane + 64 * i) * 8; const uint4 z4 = make_uint4(0u, 0u, 0u, 0u);
            float cur[8], pv[8], nx[8], w0[8], w1[8], w2[8], bb[8], y[8];
            unpack8(ld16(prow + COL_XBC + c0), cur);
            unpack8(hp ? ld16(prow - NINP + COL_XBC + c0) : z4, pv);
            unpack8(hn ? ld16(prow + NINP + COL_XBC + c0) : z4, nx);
            ldf8(cw + c0, w0); ldf8(cw + 4096 + c0, w1); ldf8(cw + 8192 + c0, w2); ldf8(cb + c0, bb);
#pragma unroll
            for (int e = 0; e < 8; ++e) { const float t = w0[e] * pv[e] + w1[e] * cur[e] + w2[e] * nx[e] + bb[e]; y[e] = t / (1.f + __expf(-t)); }
            if (i < 4) st16(XS + (size_t)m * RW + c0, pack8(y)); else st16(BC + (size_t)m * RW + (c0 - 2048), pack8(y));
        }
        { const float raw = __uint_as_float((unsigned)prow[COL_DT + lane] << 16) + a.in[I_DTB][lane];
          const float dtv = raw > 20.f ? raw : log1pf(expf(raw));
          DT[(size_t)m * 64 + lane] = dtv; LA[(size_t)m * 64 + lane] = -dtv * expf(a.in[I_ALOG][lane]); }
        if (lat) {
#pragma unroll
            for (int i = 0; i < 4; ++i) { const int c0 = (lane + 64 * i) * 8; st16(Z + (size_t)m * RW + c0, ld16(prow + COL_Z + c0)); }
        }
    }
}

__device__ __forceinline__ int scan_row(int n, int dir, int b) { return n < CTXL ? MX + b * CTXL + (dir ? CTXL - 1 - n : n) : b * SEQ + (dir ? NSTEP - 1 - n : n - CTXL); }

struct RIn { uint4 r, k, kk, w, a; unsigned v; };
__device__ __forceinline__ void rwkv_load(RIn& x, const bf16* R, const bf16* K, const bf16* V, const bf16* KK, const bf16* LR, int m, int ch, int chi, int dir) {
    x.r = ld16(R + (size_t)m * RW + ch); x.k = ld16(K + (size_t)m * RW + ch); x.kk = ld16(KK + (size_t)m * RW + ch);
    x.w = ld16(LR + (size_t)m * NLR + dir * 2048 + ch); x.a = ld16(LR + (size_t)m * NLR + 4096 + dir * 2048 + ch);
    x.v = V[(size_t)m * RW + chi];
}
__device__ __forceinline__ float rwkv_step(float (&S)[8], const RIn& x, const float (&ka)[8]) {
    float r[8], k[8], kk[8], w1[8], av[8];
    unpack8(x.r, r); unpack8(x.k, k); unpack8(x.kk, kk); unpack8(x.w, w1); unpack8(x.a, av);
    const float v = __uint_as_float(x.v << 16);
    float sa = 0.f;
#pragma unroll
    for (int e = 0; e < 8; ++e) sa -= S[e] * kk[e];
    sa = sum8(sa);
    float o = 0.f;
#pragma unroll
    for (int e = 0; e < 8; ++e) { const float kd = k[e] * (1.f + (av[e] - 1.f) * ka[e]); const float b = kk[e] * av[e];
        S[e] = S[e] * (1.f - w1[e]) + sa * b + v * kd; o += S[e] * r[e]; }
    o = sum8(o);
    return o;
}
__device__ __forceinline__ void ph_rwkv_scan(const Args& a) {
    const int lane = LANE, wave = WAVE;
    const bf16* R = (const bf16*)(a.ws + WS_R); const bf16* K = (const bf16*)(a.ws + WS_K); const bf16* V = (const bf16*)(a.ws + WS_V); const bf16* KK = (const bf16*)(a.ws + WS_KK);
    const bf16* LR = (const bf16*)(a.ws + WS_LR); bf16* OR = (bf16*)a.out;
    for (int u = blockIdx.x; u < 256; u += gridDim.x) {
        const int g = u >> 5, h = u & 31, dir = g >> 2, b = g & 3;
        const int i = wave * 8 + (lane >> 3), jb = lane & 7, ch = h * 64 + jb * 8, chi = h * 64 + i;
        float ka[8]; ldf8(a.in[I_KA] + ch, ka);
        float S[8];
#pragma unroll
        for (int e = 0; e < 8; ++e) S[e] = 0.f;
        RIn A[4], B[4];
#pragma unroll
        for (int s = 0; s < 4; ++s) rwkv_load(A[s], R, K, V, KK, LR, scan_row(s, dir, b), ch, chi, dir);
        for (int n0 = 0; n0 < NSTEP; n0 += 8) {
#pragma unroll
            for (int s = 0; s < 4; ++s) rwkv_load(B[s], R, K, V, KK, LR, scan_row(n0 + 4 + s, dir, b), ch, chi, dir);
#pragma unroll
            for (int s = 0; s < 4; ++s) { const int n = n0 + s; const float o = rwkv_step(S, A[s], ka);
                if (n >= CTXL && jb == 0) OR[((size_t)dir * MX + scan_row(n, dir, b)) * RW + chi] = (bf16)f2bf(o); }
            if (n0 + 8 < NSTEP) {
#pragma unroll
                for (int s = 0; s < 4; ++s) rwkv_load(A[s], R, K, V, KK, LR, scan_row(n0 + 8 + s, dir, b), ch, chi, dir);
            }
#pragma unroll
            for (int s = 0; s < 4; ++s) { const int n = n0 + 4 + s; const float o = rwkv_step(S, B[s], ka);
                if (n >= CTXL && jb == 0) OR[((size_t)dir * MX + scan_row(n, dir, b)) * RW + chi] = (bf16)f2bf(o); }
        }
    }
}

struct SIn { uint4 b0, b1, c0, c1; unsigned xs; float dt, la; };
__device__ __forceinline__ void ssd_load(SIn& x, const bf16* XS, const bf16* BC, const float* DT, const float* LA, int m, int chx, int cb, int dh) {
    x.b0 = ld16(BC + (size_t)m * RW + cb); x.b1 = ld16(BC + (size_t)m * RW + cb + 8); x.c0 = ld16(BC + (size_t)m * RW + 1024 + cb); x.c1 = ld16(BC + (size_t)m * RW + 1024 + cb + 8);
    x.xs = XS[(size_t)m * RW + chx]; x.dt = DT[(size_t)m * 64 + dh]; x.la = LA[(size_t)m * 64 + dh];
}
__device__ __forceinline__ float ssd_step(float (&s)[16], const SIn& x) {
    float B0[8], B1[8], C0[8], C1[8]; unpack8(x.b0, B0); unpack8(x.b1, B1); unpack8(x.c0, C0); unpack8(x.c1, C1);
    const float dec = __expf(x.la), xdt = __uint_as_float(x.xs << 16) * x.dt; float y = 0.f;
#pragma unroll
    for (int e = 0; e < 8; ++e) { s[e] = dec * s[e] + xdt * B0[e]; y += s[e] * C0[e]; s[8 + e] = dec * s[8 + e] + xdt * B1[e]; y += s[8 + e] * C1[e]; }
    y = sum8(y);
    return y;
}
__device__ __forceinline__ void ph_ssd_scan(const Args& a) {
    const int lane = LANE, wave = WAVE;
    const bf16* XS = (const bf16*)(a.ws + WS_XS); const bf16* BC = (const bf16*)(a.ws + WS_BC); const float* DT = (const float*)(a.ws + WS_DT); const float* LA = (const float*)(a.ws + WS_LA);
    bf16* YS = (bf16*)a.out + (size_t)2 * MX * RW;
    for (int u = blockIdx.x; u < 256; u += gridDim.x) {
        const int g = u >> 5, h = u & 31, dir = g >> 2, b = g & 3;
        const int p = wave * 8 + (lane >> 3), nb = lane & 7, chx = h * 64 + p, cb = (h >> 2) * 128 + nb * 16, dh = dir * 32 + h;
        float s[16];
#pragma unroll
        for (int e = 0; e < 16; ++e) s[e] = 0.f;
        SIn A[4], B[4];
#pragma unroll
        for (int q = 0; q < 4; ++q) ssd_load(A[q], XS, BC, DT, LA, scan_row(q, dir, b), chx, cb, dh);
        for (int n0 = 0; n0 < NSTEP; n0 += 8) {
#pragma unroll
            for (int q = 0; q < 4; ++q) ssd_load(B[q], XS, BC, DT, LA, scan_row(n0 + 4 + q, dir, b), chx, cb, dh);
#pragma unroll
            for (int q = 0; q < 4; ++q) { const int n = n0 + q; const float y = ssd_step(s, A[q]);
                if (n >= CTXL && nb == 0) YS[((size_t)dir * MX + scan_row(n, dir, b)) * RW + chx] = (bf16)f2bf(y); }
            if (n0 + 8 < NSTEP) {
#pragma unroll
                for (int q = 0; q < 4; ++q) ssd_load(A[q], XS, BC, DT, LA, scan_row(n0 + 8 + q, dir, b), chx, cb, dh);
            }
#pragma unroll
            for (int q = 0; q < 4; ++q) { const int n = n0 + 4 + q; const float y = ssd_step(s, B[q]);
                if (n >= CTXL && nb == 0) YS[((size_t)dir * MX + scan_row(n, dir, b)) * RW + chx] = (bf16)f2bf(y); }
        }
    }
}

typedef short bf16x8_t __attribute__((ext_vector_type(8)));
typedef float f32x16 __attribute__((ext_vector_type(16)));
constexpr int SLD = 272;
constexpr int L_C = 0, L_B = 34816, L_BT = 69632, L_XT = 104448, L_S = 121856, L_F = 139264;
static_assert(L_F + 4 * 512 <= LDS_CTL, "ssd lds map");
typedef unsigned u32x4_t __attribute__((ext_vector_type(4)));
__device__ __forceinline__ void lds_st16(LAS unsigned char* p, const uint4& v) { *(LAS u32x4_t*)p = (u32x4_t){v.x, v.y, v.z, v.w}; }
__device__ __forceinline__ uint4 lds_ld16(const LAS unsigned char* p) { const u32x4_t t = *(const LAS u32x4_t*)p; return make_uint4(t[0], t[1], t[2], t[3]); }
__device__ __forceinline__ bf16x8_t lfrag(LAS unsigned char* img, int row, int k) { return *(LAS bf16x8_t*)(img + row * SLD + k * 2); }
__device__ __forceinline__ void ph_ssd_chunked(const Args& a, LAS unsigned char* lds) {
    const int tid = TID, lane = LANE, wave = WAVE, r = lane & 31, hh = lane >> 5;
    const bf16* XS = (const bf16*)(a.ws + WS_XS); const bf16* BC = (const bf16*)(a.ws + WS_BC); const float* DT = (const float*)(a.ws + WS_DT); const float* LA = (const float*)(a.ws + WS_LA);
    bf16* YS = (bf16*)a.out + (size_t)2 * MX * RW;
    LAS float* laS = (LAS float*)(lds + L_F); LAS float* dtS = laS + 128; LAS float* cumS = laS + 256;
    for (int u = blockIdx.x; u < 256; u += gridDim.x) {
        const int g = u >> 5, h = u & 31, dir = g >> 2, b = g & 3, gi = h >> 2;
        f32x16 st;
#pragma unroll
        for (int q = 0; q < 16; ++q) st[q] = 0.f;
        __syncthreads();
        for (int i = tid; i < 64 * SLD / 4; i += 512) ((LAS unsigned*)(lds + L_S))[i] = 0u;
        for (int c = 0; c < NSTEP / 128; ++c) {
            const int n0 = c * 128; const bool lat = c >= CTXL / 128;
            for (int i = tid; i < 2048; i += 512) { const int l = i >> 4, pc = i & 15; const size_t m = (size_t)scan_row(n0 + l, dir, b);
                lds_st16(lds + L_B + l * SLD + pc * 16, ld16(BC + m * RW + gi * 128 + pc * 8));
                if (lat) lds_st16(lds + L_C + l * SLD + pc * 16, ld16(BC + m * RW + 1024 + gi * 128 + pc * 8)); }
            for (int i = tid; i < 1024; i += 512) { const int l = i >> 3, pc = i & 7; const size_t m = (size_t)scan_row(n0 + l, dir, b);
                const uint4 v = ld16(XS + m * RW + h * 64 + pc * 8); const unsigned w[4] = {v.x, v.y, v.z, v.w};
#pragma unroll
                for (int e = 0; e < 8; ++e) *(LAS bf16*)(lds + L_XT + (pc * 8 + e) * SLD + l * 2) = (bf16)((e & 1) ? (w[e >> 1] >> 16) : (w[e >> 1] & 0xffffu)); }
            if (tid < 128) { const size_t m = (size_t)scan_row(n0 + tid, dir, b); laS[tid] = LA[m * 64 + dir * 32 + h]; dtS[tid] = DT[m * 64 + dir * 32 + h]; }
            __syncthreads();
            if (wave == 0) { const float a0 = laS[2 * lane], b0 = laS[2 * lane + 1]; float x = a0 + b0;
#pragma unroll
                for (int d = 1; d < 64; d <<= 1) { const float y = __shfl_up(x, d); if (lane >= d) x += y; }
                cumS[2 * lane + 1] = x; cumS[2 * lane] = x - b0; }
            __syncthreads();
            const float ctot = cumS[127];
            for (int i = tid; i < 2048; i += 512) { const int l = i >> 4, pc = i & 15; const float wl = dtS[l] * __expf(ctot - cumS[l]);
                float f[8]; unpack8(lds_ld16(lds + L_B + l * SLD + pc * 16), f);
#pragma unroll
                for (int e = 0; e < 8; ++e) *(LAS bf16*)(lds + L_BT + (pc * 8 + e) * SLD + l * 2) = (bf16)f2bf(f[e] * wl); }
            f32x16 acc0, acc1;
            const int lt = wave >> 1, st0 = 2 * (wave & 1);
            if (lat) {
#pragma unroll
                for (int q = 0; q < 16; ++q) { acc0[q] = 0.f; acc1[q] = 0.f; }
                if (st0 <= lt) {
#pragma unroll
                    for (int ks = 0; ks < 8; ++ks) { const bf16x8_t af = lfrag(lds + L_C, lt * 32 + r, ks * 16 + 8 * hh);
                        acc0 = __builtin_amdgcn_mfma_f32_32x32x16_bf16(af, lfrag(lds + L_B, st0 * 32 + r, ks * 16 + 8 * hh), acc0, 0, 0, 0);
                        if (st0 + 1 <= lt) acc1 = __builtin_amdgcn_mfma_f32_32x32x16_bf16(af, lfrag(lds + L_B, (st0 + 1) * 32 + r, ks * 16 + 8 * hh), acc1, 0, 0, 0); }
                }
            }
            __syncthreads();
            if (lat) {
#pragma unroll
                for (int t = 0; t < 2; ++t) { const int stt = st0 + t;
                    if (stt <= lt) { const int sidx = stt * 32 + r; const float cs = cumS[sidx], ds = dtS[sidx];
#pragma unroll
                        for (int q = 0; q < 16; ++q) { const int l = lt * 32 + (q & 3) + 8 * (q >> 2) + 4 * hh; const float v = t ? acc1[q] : acc0[q];
                            const float wv = sidx <= l ? v * __expf(cumS[l] - cs) * ds : 0.f;
                            *(LAS bf16*)(lds + L_B + l * SLD + sidx * 2) = (bf16)f2bf(wv); } } }
            }
            __syncthreads();
            if (lat) {
                const int pt = wave & 1;
                f32x16 accd, acco;
#pragma unroll
                for (int q = 0; q < 16; ++q) { accd[q] = 0.f; acco[q] = 0.f; }
                for (int ks = 0; ks < 2 * (lt + 1); ++ks)
                    accd = __builtin_amdgcn_mfma_f32_32x32x16_bf16(lfrag(lds + L_B, lt * 32 + r, ks * 16 + 8 * hh), lfrag(lds + L_XT, pt * 32 + r, ks * 16 + 8 * hh), accd, 0, 0, 0);
#pragma unroll
                for (int ks = 0; ks < 8; ++ks)
                    acco = __builtin_amdgcn_mfma_f32_32x32x16_bf16(lfrag(lds + L_C, lt * 32 + r, ks * 16 + 8 * hh), lfrag(lds + L_S, pt * 32 + r, ks * 16 + 8 * hh), acco, 0, 0, 0);
#pragma unroll
                for (int q = 0; q < 16; ++q) { const int l = lt * 32 + (q & 3) + 8 * (q >> 2) + 4 * hh; const float y = accd[q] + __expf(cumS[l]) * acco[q];
                    YS[((size_t)dir * MX + scan_row(n0 + l, dir, b)) * RW + h * 64 + pt * 32 + r] = (bf16)f2bf(y); }
            }
            const int pt2 = wave >> 2, nt = wave & 3;
            { const float dc = __expf(ctot);
#pragma unroll
              for (int q = 0; q < 16; ++q) st[q] *= dc;
#pragma unroll
              for (int ks = 0; ks < 8; ++ks)
                  st = __builtin_amdgcn_mfma_f32_32x32x16_bf16(lfrag(lds + L_XT, pt2 * 32 + r, ks * 16 + 8 * hh), lfrag(lds + L_BT, nt * 32 + r, ks * 16 + 8 * hh), st, 0, 0, 0); }
            __syncthreads();
#pragma unroll
            for (int q = 0; q < 16; ++q) { const int p = pt2 * 32 + (q & 3) + 8 * (q >> 2) + 4 * hh; *(LAS bf16*)(lds + L_S + p * SLD + (nt * 32 + r) * 2) = (bf16)f2bf(st[q]); }
            __syncthreads();
        }
    }
}

__device__ __forceinline__ void ph_finish(const Args& a) {
    const int lane = LANE;
    const bf16* R = (const bf16*)(a.ws + WS_R); const bf16* K = (const bf16*)(a.ws + WS_K); const bf16* V = (const bf16*)(a.ws + WS_V);
    const bf16* LR = (const bf16*)(a.ws + WS_LR); const bf16* XS = (const bf16*)(a.ws + WS_XS); const bf16* Z = (const bf16*)(a.ws + WS_Z);
    const bf16* OR = (const bf16*)a.out; const bf16* YS = (const bf16*)a.out + (size_t)2 * MX * RW;
    bf16* A2 = (bf16*)(a.ws + WS_A2);
    for (int m = GW; m < MX; m += NGW) {
#pragma unroll
        for (int i = 0; i < 4; ++i) {
            const int c0 = (lane + 64 * i) * 8;
            float of[8], ob[8], o[8], res[8];
#if MK_SKIP_RWKV
#pragma unroll
            for (int e = 0; e < 8; ++e) res[e] = 0.f;
#else
            unpack8(ld16(OR + (size_t)m * RW + c0), of); unpack8(ld16(OR + ((size_t)MX + m) * RW + c0), ob);
            float sm = 0.f;
#pragma unroll
            for (int e = 0; e < 8; ++e) { o[e] = of[e] + ob[e]; sm += o[e]; }
            sm = sum8(sm);
            const float mean = sm * (1.f / 64.f); float sq = 0.f;
#pragma unroll
            for (int e = 0; e < 8; ++e) { o[e] -= mean; sq += o[e] * o[e]; }
            sq = sum8(sq);
            const float rstd = rsqrtf(sq * (1.f / 64.f) + GN_EPS);
            float lw[8], lb[8], r[8], k[8], v[8], a0[8], a1[8], ka[8], rk[8], gg[8];
            ldf8(a.in[I_LNW] + c0, lw); ldf8(a.in[I_LNB] + c0, lb); ldf8(a.in[I_KA] + c0, ka); ldf8(a.in[I_RK] + c0, rk);
            unpack8(ld16(R + (size_t)m * RW + c0), r); unpack8(ld16(K + (size_t)m * RW + c0), k); unpack8(ld16(V + (size_t)m * RW + c0), v);
            unpack8(ld16(LR + (size_t)m * NLR + 4096 + c0), a0); unpack8(ld16(LR + (size_t)m * NLR + 6144 + c0), a1); unpack8(ld16(LR + (size_t)m * NLR + 8192 + c0), gg);
            float bs = 0.f;
#pragma unroll
            for (int e = 0; e < 8; ++e) { const float kd = k[e] * (2.f + (a0[e] + a1[e] - 2.f) * ka[e]); bs += r[e] * kd * rk[e]; }
            bs = sum8(bs);
#pragma unroll
            for (int e = 0; e < 8; ++e) res[e] = (o[e] * rstd * lw[e] + lb[e] + bs * v[e]) * gg[e];
#endif
            st16(A2 + (size_t)m * DM + c0, pack8(res));
        }
#pragma unroll
        for (int i = 0; i < 4; ++i) {
            const int c0 = (lane + 64 * i) * 8;
            float yf[8], yb[8], xs[8], z[8], nw[8], y[8];
#if MK_SKIP_SSD
#pragma unroll
            for (int e = 0; e < 8; ++e) y[e] = 0.f;
#else
            unpack8(ld16(YS + (size_t)m * RW + c0), yf); unpack8(ld16(YS + ((size_t)MX + m) * RW + c0), yb);
            unpack8(ld16(XS + (size_t)m * RW + c0), xs); unpack8(ld16(Z + (size_t)m * RW + c0), z); ldf8(a.in[I_NORMW] + c0, nw);
            const float dsk = a.in[I_SSMD][c0 >> 6]; float ss = 0.f;
#pragma unroll
            for (int e = 0; e < 8; ++e) { y[e] = (yf[e] + yb[e] + dsk * xs[e]) * (z[e] / (1.f + __expf(-z[e]))); ss += y[e] * y[e]; }
            ss = sum32(ss);
            const float rstd = rsqrtf(ss * (1.f / 256.f) + RMS_EPS);
#pragma unroll
            for (int e = 0; e < 8; ++e) y[e] = y[e] * rstd * nw[e];
#endif
            st16(A2 + (size_t)m * DM + 2048 + c0, pack8(y));
        }
    }
}

__device__ __forceinline__ float enc_key(float v, int idx) { return __uint_as_float((__float_as_uint(v) & 0xffffff00u) | (unsigned)idx); }
__device__ __forceinline__ void ldf16(const float* p, float (&f)[16]) {
    const float4 a = *(const float4*)p, b = *(const float4*)(p + 4), c = *(const float4*)(p + 8), d = *(const float4*)(p + 12);
    f[0] = a.x; f[1] = a.y; f[2] = a.z; f[3] = a.w; f[4] = b.x; f[5] = b.y; f[6] = b.z; f[7] = b.w; f[8] = c.x; f[9] = c.y; f[10] = c.z; f[11] = c.w; f[12] = d.x; f[13] = d.y; f[14] = d.z; f[15] = d.w;
}
typedef float f32x2 __attribute__((ext_vector_type(2)));
__device__ __forceinline__ void unpack_fp8x16(const uint4& q, float (&f)[16]) {
    const unsigned w[4] = {q.x, q.y, q.z, q.w};
#pragma unroll
    for (int i = 0; i < 4; ++i) { const f32x2 lo = __builtin_amdgcn_cvt_pk_f32_fp8((int)w[i], false), hi = __builtin_amdgcn_cvt_pk_f32_fp8((int)w[i], true);
        f[4 * i] = lo.x; f[4 * i + 1] = lo.y; f[4 * i + 2] = hi.x; f[4 * i + 3] = hi.y; }
}
#define PIN16(a) do { PIN8(a); PIN8((a) + 8); } while (0)
__device__ __forceinline__ void ph_peer(const Args& a) {
    const int lane = LANE;
    const float* mod = (const float*)(a.ws + WS_MOD); const float* S = (const float*)(a.ws + WS_S);
    const unsigned char* U8 = (const unsigned char*)(a.ws + WS_U8); const unsigned char* V8 = (const unsigned char*)(a.ws + WS_V8);
    const float* USC = (const float*)(a.ws + WS_USC); const float* VSC = (const float*)(a.ws + WS_VSC);
    for (int m = GW; m < MX; m += NGW) {
        const int bb = m / SEQ;
        float* hrow = a.out + (size_t)m * DM;
        int l16 = lane * 16; asm volatile("" : "+v"(l16));
        float acc[4][16];
#if MK_SKIP_PEER
#pragma unroll
        for (int j = 0; j < 4; ++j)
#pragma unroll
            for (int e = 0; e < 16; ++e) acc[j][e] = 0.f;
#else
        float xn[4][16];
        { float ss = 0.f; float hv[4][16];
#pragma unroll
          for (int j = 0; j < 4; ++j) { ldf16(hrow + 1024 * j + l16, hv[j]);
#pragma unroll
              for (int e = 0; e < 16; ++e) ss += hv[j][e] * hv[j][e]; }
          const float rstd = rsqrtf(wave_sum(ss) * (1.f / DM) + RMS_EPS);
          const float* sh2 = mod + (size_t)bb * NMOD + 3 * DM; const float* sc2 = mod + (size_t)bb * NMOD + 4 * DM; const float* g2 = a.in[I_N2G];
#pragma unroll
          for (int j = 0; j < 4; ++j) {
#pragma unroll
              for (int hf = 0; hf < 2; ++hf) { float gg[8], s0[8], s1[8]; const int c = 1024 * j + l16 + 8 * hf; ldf8(g2 + c, gg); ldf8(sh2 + c, s0); ldf8(sc2 + c, s1);
#pragma unroll
                  for (int e = 0; e < 8; ++e) xn[j][8 * hf + e] = hv[j][8 * hf + e] * rstd * gg[e] * (1.f + s1[e]) + s0[e];
                  PIN8(xn[j] + 8 * hf); asm volatile("" ::: "memory"); } } }
        int eid0 = 0, eid1 = 0; float gt0 = 0.f, gt1 = 0.f;
        const float NEG = -3.0e38f;
#pragma unroll 1
        for (int hd = 0; hd < 8; ++hd) {
            const float* srow = S + (size_t)m * 2048 + hd * 256;
            float c1a = enc_key(srow[lane], lane), c1b = enc_key(srow[64 + lane], 64 + lane), c2a = enc_key(srow[128 + lane], lane), c2b = enc_key(srow[192 + lane], 64 + lane);
            float t1 = NEG, t2 = NEG;
#pragma unroll 1
            for (int k = 0; k < 16; ++k) {
                const float m1 = wave_max(fmaxf(c1a, c1b)), m2 = wave_max(fmaxf(c2a, c2b));
                if (c1a == m1) c1a = NEG; if (c1b == m1) c1b = NEG; if (c2a == m2) c2a = NEG; if (c2b == m2) c2b = NEG;
                if (lane == k) { t1 = m1; t2 = m2; }
            }
            const float v1 = __uint_as_float(__float_as_uint(t1) & 0xffffff00u), v2 = __uint_as_float(__float_as_uint(t2) & 0xffffff00u);
            const int i1 = (int)(__float_as_uint(t1) & 0xffu), i2 = (int)(__float_as_uint(t2) & 0xffu);
            float cd[4];
#pragma unroll
            for (int e = 0; e < 4; ++e) { const float va = __shfl(v1, (lane >> 4) + 4 * e), vb = __shfl(v2, lane & 15); cd[e] = enc_key(va + vb, lane + 64 * e); }
            float best = NEG; int ex = 0;
#pragma unroll 1
            for (int k = 0; k < 16; ++k) {
                const float mx = wave_max(fmaxf(fmaxf(cd[0], cd[1]), fmaxf(cd[2], cd[3])));
#pragma unroll
                for (int e = 0; e < 4; ++e) if (cd[e] == mx) cd[e] = NEG;
                const int cidx = (int)(__float_as_uint(mx) & 0xffu);
                const int ea = __shfl(i1, cidx >> 4), eb = __shfl(i2, cidx & 15);
                if (lane == k) { best = __uint_as_float(__float_as_uint(mx) & 0xffffff00u); ex = ea * 128 + eb; }
            }
            const float bmax = __shfl(best, 0);
            const float pe = lane < 16 ? __expf(best - bmax) : 0.f;
            const float gate = pe / wave_sum(pe);
            const float gsh = __shfl(gate, lane & 15); const int esh = __shfl(ex, lane & 15);
            if ((lane >> 4) == (hd & 3)) { if (hd < 4) { gt0 = gsh; eid0 = esh; } else { gt1 = gsh; eid1 = esh; } }
        }
        float cf0 = 0.f, cf1 = 0.f;
#pragma unroll 1
        for (int p0 = 0; p0 < 128; p0 += 4) {
            float d[4]; uint4 qu[4][4];
#pragma unroll
            for (int q = 0; q < 4; ++q) {
                const int e = __builtin_amdgcn_readlane(p0 < 64 ? eid0 : eid1, (p0 + q) & 63);
                const unsigned char* urow = U8 + (size_t)e * DM + l16;
#pragma unroll
                for (int j = 0; j < 4; ++j) qu[q][j] = *(const uint4*)(urow + 1024 * j);
            }
#pragma unroll
            for (int q = 0; q < 4; ++q) {
                float dd = 0.f;
#pragma unroll
                for (int j = 0; j < 4; ++j) { float f[16]; unpack_fp8x16(qu[q][j], f);
#pragma unroll
                    for (int t = 0; t < 16; ++t) dd += xn[j][t] * f[t];
                    asm volatile("" : "+v"(dd)); }
                d[q] = dd;
            }
#pragma unroll
            for (int q = 0; q < 4; ++q) {
                const int p = p0 + q; const int e = __builtin_amdgcn_readlane(p0 < 64 ? eid0 : eid1, p & 63);
                const float dot = wave_sum(d[q]) * USC[e];
                const float act = 0.5f * dot * (1.f + erff(dot * 0.70710678f)) * VSC[e];
                if (lane == (p & 63)) { if (p0 < 64) cf0 = gt0 * act; else cf1 = gt1 * act; }
            }
        }
#pragma unroll
        for (int j = 0; j < 4; ++j)
#pragma unroll
            for (int e = 0; e < 16; ++e) acc[j][e] = 0.f;
#pragma unroll 1
        for (int p0 = 0; p0 < 128; p0 += 4) {
            uint4 qv[4][4]; float cfv[4];
#pragma unroll
            for (int q = 0; q < 4; ++q) {
                const int e = __builtin_amdgcn_readlane(p0 < 64 ? eid0 : eid1, (p0 + q) & 63);
                cfv[q] = rlane(p0 < 64 ? cf0 : cf1, (p0 + q) & 63);
                const unsigned char* vrow = V8 + (size_t)e * DM + l16;
#pragma unroll
                for (int j = 0; j < 4; ++j) qv[q][j] = *(const uint4*)(vrow + 1024 * j);
            }
#pragma unroll
            for (int q = 0; q < 4; ++q)
#pragma unroll
                for (int j = 0; j < 4; ++j) { float f[16]; unpack_fp8x16(qv[q][j], f);
#pragma unroll
                    for (int t = 0; t < 16; ++t) acc[j][t] += cfv[q] * f[t];
                    PIN16(acc[j]); }
        }
#endif
        { const float* gt2 = mod + (size_t)bb * NMOD + 5 * DM; float ss = 0.f;
#pragma unroll
          for (int j = 0; j < 4; ++j) {
#pragma unroll
              for (int hf = 0; hf < 2; ++hf) { float g[8], hvj[8]; const int c = 1024 * j + l16 + 8 * hf; ldf8(gt2 + c, g); ldf8(hrow + c, hvj);
#pragma unroll
                  for (int e = 0; e < 8; ++e) { acc[j][8 * hf + e] = hvj[e] + g[e] * acc[j][8 * hf + e]; ss += acc[j][8 * hf + e] * acc[j][8 * hf + e]; }
                  PIN8(acc[j] + 8 * hf); asm volatile("" ::: "memory"); } }
          const float rstd = rsqrtf(wave_sum(ss) * (1.f / DM) + RMS_EPS);
#pragma unroll
          for (int j = 0; j < 4; ++j) {
#pragma unroll
              for (int hf = 0; hf < 2; ++hf) { float fg[8]; const int c = 1024 * j + l16 + 8 * hf; ldf8(a.in[I_FG] + c, fg); const float* ac = acc[j] + 8 * hf;
                  *(float4*)(hrow + c) = make_float4(ac[0] * rstd * fg[0], ac[1] * rstd * fg[1], ac[2] * rstd * fg[2], ac[3] * rstd * fg[3]);
                  *(float4*)(hrow + c + 4) = make_float4(ac[4] * rstd * fg[4], ac[5] * rstd * fg[5], ac[6] * rstd * fg[6], ac[7] * rstd * fg[7]);
                  asm volatile("" ::: "memory"); } } }
    }
}

constexpr int N_PHASES = 13;
__global__ void __launch_bounds__(512, 2) hybrid_fwd(Args args) {
    extern __shared__ __attribute__((aligned(16))) unsigned char lds_raw[];
    LAS unsigned char* lds = (LAS unsigned char*)lds_raw;
    volatile LAS unsigned* MISC = (volatile LAS unsigned*)(lds + LDS_MISC);
    for (int u = TID; u < (LDS_BYTES - LDS_CTL) / 4; u += 512) ((LAS unsigned*)(lds + LDS_CTL))[u] = 0u;
    __syncthreads();
    const int lo = args.ph_lo, hi = args.ph_hi;
    XcdBarrier bar; bar.bar = (unsigned*)(args.ws + WS_CTL); bar.x = 0; bar.st = nullptr;
    if (hi - lo > 1) bar = xcd_barrier_post((unsigned*)(args.ws + WS_CTL), MISC + 8);
#define IN(k) (lo <= (k) && (k) < hi && ((MK_PHASE_MASK >> (k)) & 1))
#define SEAM(k) do { if (IN(k) && IN((k) + 1)) xcd_barrier(bar); } while (0)
    const int bid = (int)blockIdx.x, G = (int)gridDim.x;

    if (IN(0)) { ph_mod(args, lds); ph_conv(args, lds); if (MK_REPEAT == 0) { ph_mod(args, lds); ph_conv(args, lds); } }
    SEAM(0);
    if (IN(1)) { ph_norm1(args); if (MK_REPEAT == 1) ph_norm1(args); }
    SEAM(1);
    if (IN(2)) { pg8::Gemm g{(const bf16*)(args.ws + WS_A1), (const bf16*)(args.ws + WS_WT_IN), MT, NINP, DM}; pg8::StaticOrder S; S.init(MT, NINP, G, bid);
        pg8::EpiBf16<0> E{(bf16*)(args.ws + WS_P), NINP, nullptr, 0, 0}; pg8::gemm_phase<pg8::EpiBf16<0>, pg8::StaticOrder>(lds, g, S, E, nullptr); }
    SEAM(2);
    if (IN(3)) { ph_prep_rwkv(args); ph_prep_ssd(args); if (MK_REPEAT == 3) { ph_prep_rwkv(args); ph_prep_ssd(args); } }
    SEAM(3);
    if (IN(4)) { pg8::Gemm g{(const bf16*)(args.ws + WS_ALR), (const bf16*)(args.ws + WS_WLR), MT, NLR, KLR}; pg8::StaticOrder S; S.init(MT, NLR, G, bid);
        EpiLR E{(bf16*)(args.ws + WS_LR), args.in[I_W0], args.in[I_A0]}; pg8::gemm_phase<EpiLR, pg8::StaticOrder>(lds, g, S, E, nullptr); }
    SEAM(4);
    if (IN(5)) { ph_rwkv_scan(args); if (MK_REPEAT == 5) ph_rwkv_scan(args); }
    SEAM(5);
#if MK_SSD_SEQ
    if (IN(6)) { ph_ssd_scan(args); if (MK_REPEAT == 6) ph_ssd_scan(args); }
#else
    if (IN(6)) { ph_ssd_chunked(args, lds); if (MK_REPEAT == 6) ph_ssd_chunked(args, lds); }
#endif
    SEAM(6);
    if (IN(7)) { ph_finish(args); if (MK_REPEAT == 7) ph_finish(args); }
    SEAM(7);
    if (IN(8)) { pg8::Gemm g{(const bf16*)(args.ws + WS_A2), (const bf16*)(args.ws + WS_WT_OUT), MX, DM, DM}; pg8::StaticOrder S; S.init(MX, DM, G, bid);
        EpiRes E{args.out, args.in[I_X], (const float*)(args.ws + WS_MOD)}; pg8::gemm_phase<EpiRes, pg8::StaticOrder>(lds, g, S, E, nullptr); }
    SEAM(8);
    if (IN(9)) { ph_norm2(args); if (MK_REPEAT == 9) ph_norm2(args); }
    SEAM(9);
    if (IN(10)) { pg8::Gemm g{(const bf16*)(args.ws + WS_XN2), (const bf16*)(args.ws + WS_WT_Q), MX, 2048, DM}; pg8::StaticOrder S; S.init(MX, 2048, G, bid);
        pg8::EpiBf16<0> E{(bf16*)(args.ws + WS_Q), 2048, nullptr, 0, 0}; pg8::gemm_phase<pg8::EpiBf16<0>, pg8::StaticOrder>(lds, g, S, E, nullptr); }
    SEAM(10);
    if (IN(11)) { pg8::Gemm g{(const bf16*)(args.ws + WS_Q), (const bf16*)(args.ws + WS_KBD), MX, 2048, 2048}; pg8::StaticOrder S; S.init(MX, 2048, G, bid);
        pg8::EpiF32 E{(float*)(args.ws + WS_S), 2048, nullptr}; pg8::gemm_phase<pg8::EpiF32, pg8::StaticOrder>(lds, g, S, E, nullptr); }
    SEAM(11);
    if (IN(12)) ph_peer(args);
#undef IN
#undef SEAM
}

extern "C" void kernel_launch(void* const* d_in, const int* in_sizes, int n_in, void* d_out, int out_size, void* d_ws, size_t ws_size, hipStream_t stream) {
    static int grid = 0;
    if (grid == 0) {
        if (n_in != N_IN || out_size != MX * DM || ws_size < WS_END) { fprintf(stderr, "kernel_launch: unexpected shapes (n_in %d out %d ws %zu)\n", n_in, out_size, ws_size); grid = -1; return; }
        int dev = 0, cus = 0, per_cu = 0;
        if (hipGetDevice(&dev) != hipSuccess || hipDeviceGetAttribute(&cus, hipDeviceAttributeMultiprocessorCount, dev) != hipSuccess) { grid = -1; return; }
        if (hipFuncSetAttribute((const void*)hybrid_fwd, hipFuncAttributeMaxDynamicSharedMemorySize, LDS_BYTES) != hipSuccess) { fprintf(stderr, "kernel_launch: hipFuncSetAttribute failed\n"); grid = -1; return; }
        if (hipOccupancyMaxActiveBlocksPerMultiprocessor(&per_cu, (const void*)hybrid_fwd, 512, LDS_BYTES) != hipSuccess || per_cu < 1) fprintf(stderr, "kernel_launch: occupancy query reports %d\n", per_cu);
        (void)hipGetLastError();
        grid = cus;
    }
    if (grid < 0) return;
    (void)in_sizes;
    if (hipMemsetAsync((char*)d_ws + WS_CTL, 0, CTL_ZERO_BYTES, stream) != hipSuccess) return;
    Args a{};
    for (int i = 0; i < N_IN; ++i) a.in[i] = (const float*)d_in[i];
    a.out = (float*)d_out; a.ws = (unsigned char*)d_ws;
#if MK_N_LAUNCHES == 1
    a.ph_lo = 0; a.ph_hi = N_PHASES;
    hipLaunchKernelGGL(hybrid_fwd, dim3(grid), dim3(512), LDS_BYTES, stream, a);
#else
    for (int ph = 0; ph < N_PHASES; ++ph) { if (!((MK_PHASE_MASK >> ph) & 1)) continue; a.ph_lo = ph; a.ph_hi = ph + 1; hipLaunchKernelGGL(hybrid_fwd, dim3(grid), dim3(512), LDS_BYTES, stream, a); }
#endif
}
```

```cpp
#include <hip/hip_runtime.h>
#include <stdint.h>
#include <stdio.h>
namespace pg8 {
#define PG8_LAS __attribute__((address_space(3)))
typedef unsigned short bf16_t;
typedef short bf16x8 __attribute__((ext_vector_type(8)));
typedef float f32x4 __attribute__((ext_vector_type(4)));
typedef unsigned u32x4 __attribute__((ext_vector_type(4)));
constexpr int BM = 256, BK = 64, HALF = 128, HTB = HALF * BK * 2  , STAGE_BYTES = 8 * HTB, NXCD = 8, WGM = 8;

__host__ __device__ __forceinline__ int lds_byte(int r, int c) { const int st = (r >> 4) * 2 + (c >> 5), rr = r & 15, cc = c & 31, ob = rr * 64 + cc * 2; return st * 1024 + (ob ^ (((ob >> 9) & 1) << 5)); }
__host__ __device__ __forceinline__ void stage_rc(int b, int& R, int& C) { const int st = b / 1024, sb = b % 1024, swz = sb ^ (((sb >> 9) & 1) << 5); R = (st >> 1) * 16 + swz / 64; C = (st & 1) * 32 + (swz % 64) / 2; }
__host__ __device__ __forceinline__ int perm32(int rho) { const int n = rho >> 4, i = rho & 15; return 8 * (i >> 2) + 4 * n + (i & 3); }

struct Unit { int pm, pn; };
struct Gemm { const bf16_t* A; const bf16_t* Bt; int M, N, K; };

struct StaticOrder {
    int nM, nN, nwg, G, c;
    __host__ __device__ void init(int M, int N, int G_, int c_) { nM = M / BM; nN = N / BM; nwg = nM * nN; G = G_; c = c_; }
    __host__ __device__ bool next(int i, Unit& u) const {
        const long L = (long)i * G + c; if (L >= nwg) return false;
        int wgid = (int)L; { const int q = nwg / NXCD, r = nwg % NXCD, xcd = wgid % NXCD, off = wgid / NXCD; wgid = (xcd < r ? xcd * (q + 1) : r * (q + 1) + (xcd - r) * q) + off; }
        const int nig = WGM * nN, gid = wgid / nig, fm = gid * WGM, gsz = (nM - fm) < WGM ? (nM - fm) : WGM;
        u.pm = fm + ((wgid % nig) % gsz); u.pn = (wgid % nig) / gsz; return true;
    }
    __device__ __forceinline__ void a_ready(const Unit&) const {}
    __device__ __forceinline__ void done(const Unit&) const {}
};
__device__ __forceinline__ unsigned cvt_pk_bf16(float lo, float hi) { unsigned r; asm volatile("v_cvt_pk_bf16_f32 %0, %1, %2" : "=v"(r) : "v"(lo), "v"(hi)); return r; }
typedef float f32x2 __attribute__((ext_vector_type(2)));
__device__ __forceinline__ f32x2 gelu_pk(f32x2 v) {
    const f32x2 av = __builtin_elementwise_abs(v), d = av * 0.2316418882f + 1.0f;
    f32x2 t; t.x = __builtin_amdgcn_rcpf(d.x); t.y = __builtin_amdgcn_rcpf(d.y);
    f32x2 q = t * 0.5307027145f + (-0.7265760135f); q = q * t + 0.7107068705f; q = q * t + (-0.142248368f); q = q * t + 0.127414796f; q = q * t;
    const f32x2 s = (v * v) * (-0.72134752044f);
    f32x2 e; e.x = __builtin_amdgcn_exp2f(s.x); e.y = __builtin_amdgcn_exp2f(s.y);
    const f32x2 m = v * (q * e), r = v - m;
    f32x2 o; o.x = v.x < 0.f ? m.x : r.x; o.y = v.y < 0.f ? m.y : r.y; return o;
}

struct EpiF32 {
    static constexpr bool PERM = false, AFTER_DRAIN = false;
    float* C; int ldc; const float* bias;
    __device__ __forceinline__ void operator()(const f32x4 (&acc)[2][2][4][2], const Unit& u, int wr, int wc, int fr, int fq) const {
        const int row0 = u.pm * BM + wr * 64 + fr, col0 = u.pn * BM + wc * 32 + 4 * fq;
        f32x4 bv[2][2];
#pragma unroll
        for (int bj = 0; bj < 2; ++bj)
#pragma unroll
            for (int n = 0; n < 2; ++n) bv[bj][n] = bias ? *(const f32x4*)(bias + col0 + bj * HALF + n * 16) : (f32x4){0.f, 0.f, 0.f, 0.f};
#pragma unroll
        for (int ai = 0; ai < 2; ++ai)
#pragma unroll
            for (int m = 0; m < 4; ++m) { float* rowp = C + (size_t)(row0 + ai * HALF + m * 16) * ldc + col0;
#pragma unroll
                for (int bj = 0; bj < 2; ++bj)
#pragma unroll
                    for (int n = 0; n < 2; ++n) *(f32x4*)(rowp + bj * HALF + n * 16) = acc[ai][bj][m][n] + bv[bj][n]; }
    }
};
template <int ACT  > struct EpiBf16 {
    static constexpr bool PERM = true, AFTER_DRAIN = false;
    bf16_t* O; int ldc; const float* bias; int split_cols; size_t split_stride;
    __device__ __forceinline__ void operator()(const f32x4 (&acc)[2][2][4][2], const Unit& u, int wr, int wc, int fr, int fq) const {
        const int row0 = u.pm * BM + wr * 64 + fr; int colt = u.pn * BM; bf16_t* base = O;
        if (split_cols) { const int t = colt / split_cols; base += (size_t)t * split_stride; colt -= t * split_cols; }
        const int col0 = colt + wc * 32 + 8 * fq, bcol0 = u.pn * BM + wc * 32 + 8 * fq;
        f32x4 bv[2][2];
#pragma unroll
        for (int bj = 0; bj < 2; ++bj)
#pragma unroll
            for (int n = 0; n < 2; ++n) bv[bj][n] = bias ? *(const f32x4*)(bias + bcol0 + bj * HALF + 4 * n) : (f32x4){0.f, 0.f, 0.f, 0.f};
#pragma unroll
        for (int ai = 0; ai < 2; ++ai)
#pragma unroll
            for (int m = 0; m < 4; ++m) { bf16_t* rowp = base + (size_t)(row0 + ai * HALF + m * 16) * ldc + col0;
#pragma unroll
                for (int bj = 0; bj < 2; ++bj) { f32x4 v0 = acc[ai][bj][m][0] + bv[bj][0], v1 = acc[ai][bj][m][1] + bv[bj][1];
                    if (ACT == 1) { f32x2 a = gelu_pk((f32x2){v0[0], v0[1]}), b = gelu_pk((f32x2){v0[2], v0[3]}), c = gelu_pk((f32x2){v1[0], v1[1]}), d = gelu_pk((f32x2){v1[2], v1[3]});
                        v0 = (f32x4){a.x, a.y, b.x, b.y}; v1 = (f32x4){c.x, c.y, d.x, d.y}; }
                    if (ACT == 2) {
#pragma unroll
                        for (int j = 0; j < 4; ++j) { v0[j] = 0.5f * v0[j] * (1.0f + erff(v0[j] * 0.70710678f)); v1[j] = 0.5f * v1[j] * (1.0f + erff(v1[j] * 0.70710678f)); } }
                    u32x4 w; w.x = cvt_pk_bf16(v0[0], v0[1]); w.y = cvt_pk_bf16(v0[2], v0[3]); w.z = cvt_pk_bf16(v1[0], v1[1]); w.w = cvt_pk_bf16(v1[2], v1[3]);
                    *(u32x4*)(rowp + bj * HALF) = w; } }
    }
};
template <class Epi, class Sched, bool STAMP = false>
__device__ __forceinline__ void gemm_phase(PG8_LAS unsigned char* lds, const Gemm g, const Sched& S, const Epi& E, unsigned long long* stamps) {
    const int tid = threadIdx.x, wid = __builtin_amdgcn_readfirstlane(tid >> 6), lane = tid & 63, wr = wid >> 2, wc = wid & 3, fr = lane & 15, fq = lane >> 4;
    const int K = g.K, nt = K / BK;
    int ts_lo = 0, ts_hi = 0, nts = 0; const unsigned long long rt_entry = STAMP ? (unsigned long long)wall_clock64() : 0ull;
#define PG8_STAMP() do { if (STAMP && wid == 0 && nts < 64) { const unsigned long long _c = (unsigned long long)clock64(); \
        ts_lo = (lane == nts) ? (int)(unsigned)_c : ts_lo; ts_hi = (lane == nts) ? (int)(unsigned)(_c >> 32) : ts_hi; ++nts; } } while (0)
    PG8_STAMP();
    unsigned voffA[2], voffB[2];
#pragma unroll
    for (int i = 0; i < 2; ++i) { int R, C; stage_rc(tid * 16 + i * 8192, R, C); const int Rb = Epi::PERM ? ((R & ~31) + perm32(R & 31)) : R;
        voffA[i] = (unsigned)(R * K + C) * 2u; voffB[i] = (unsigned)(Rb * K + C) * 2u; }
    const size_t kstep = (size_t)(BK * 2);
    const size_t hstep = (size_t)HALF * K * 2;
    const size_t tstep = 2 * hstep;
    const unsigned ldsw = (unsigned)wid * 1024u;
    const int aoff = lds_byte(wr * 64 + fr, fq * 8), boff = lds_byte(wc * 32 + fr, fq * 8);
#define PG8_SA(b, h) (((b) * 2 + (h)) * HTB)
#define PG8_SB(b, h) ((4 + (b) * 2 + (h)) * HTB)
#define PG8_STAGE(bufoff, gbase, voff) do { _Pragma("unroll") for (int _i = 0; _i < 2; ++_i) \
        __builtin_amdgcn_global_load_lds((const unsigned*)((const char*)(gbase) + (voff)[_i]), (PG8_LAS unsigned*)(lds + (bufoff) + ldsw + _i * 8192), 16, 0, 0); } while (0)
#define PG8_LDA(dst, b, h) do { _Pragma("unroll") for (int m = 0; m < 4; ++m) _Pragma("unroll") for (int k = 0; k < 2; ++k) dst[m][k] = *(const PG8_LAS bf16x8*)(lds + PG8_SA(b, h) + aoff + m * 2048 + k * 1024); } while (0)
#define PG8_LDB(dst, b, h) do { _Pragma("unroll") for (int n = 0; n < 2; ++n) _Pragma("unroll") for (int k = 0; k < 2; ++k) dst[n][k] = *(const PG8_LAS bf16x8*)(lds + PG8_SB(b, h) + boff + n * 2048 + k * 1024); } while (0)
#define PG8_MMA(ai, bj, At, Bt) do { __builtin_amdgcn_s_setprio(1); _Pragma("unroll") for (int m = 0; m < 4; ++m) _Pragma("unroll") for (int n = 0; n < 2; ++n) _Pragma("unroll") for (int k = 0; k < 2; ++k) \
        acc[ai][bj][m][n] = __builtin_amdgcn_mfma_f32_16x16x32_bf16(Bt[n][k], At[m][k], acc[ai][bj][m][n], 0, 0, 0); __builtin_amdgcn_s_setprio(0); } while (0)
#define PG8_WAIT_V(n) asm volatile("s_waitcnt vmcnt(" #n ")" ::: "memory")
#define PG8_WAIT_L(n) asm volatile("s_waitcnt lgkmcnt(" #n ")" ::: "memory")
#define PG8_BAR __builtin_amdgcn_s_barrier()
#define PG8_SCHED __builtin_amdgcn_sched_barrier(0)
    Unit cur, nxt; int ui = 0;
    if (!S.next(0, cur)) return;
    f32x4 acc[2][2][4][2];
#pragma unroll
    for (int a = 0; a < 2; ++a)
#pragma unroll
        for (int b = 0; b < 2; ++b)
#pragma unroll
            for (int m = 0; m < 4; ++m)
#pragma unroll
                for (int n = 0; n < 2; ++n) acc[a][b][m][n] = (f32x4){0.f, 0.f, 0.f, 0.f};
    bf16x8 At[4][2], B0[2][2], B1[2][2];
    const char* cA = (const char*)g.A + (size_t)cur.pm * tstep; const char* cB = (const char*)g.Bt + (size_t)cur.pn * tstep;
    S.a_ready(cur);
    PG8_STAGE(PG8_SB(0, 0), cB, voffB); PG8_STAGE(PG8_SA(0, 0), cA, voffA); PG8_STAGE(PG8_SB(0, 1), cB + hstep, voffB); PG8_STAGE(PG8_SA(0, 1), cA + hstep, voffA);
    if (wr == 1) PG8_BAR;
    PG8_WAIT_V(4); PG8_BAR;
    PG8_STAGE(PG8_SB(1, 0), cB + kstep, voffB); PG8_STAGE(PG8_SA(1, 0), cA + kstep, voffA); PG8_STAGE(PG8_SB(1, 1), cB + hstep + kstep, voffB);
    PG8_WAIT_V(6); PG8_BAR;
    PG8_STAMP();
    for (;;) {
        const bool has_next = S.next(ui + 1, nxt);
        const char* nA = has_next ? (const char*)g.A + (size_t)nxt.pm * tstep : cA; const char* nB = has_next ? (const char*)g.Bt + (size_t)nxt.pn * tstep : cB;
        for (int t = 0; t < nt; t += 2) {
            const bool last = (t == nt - 2);
            const char* a1 = cA + (size_t)(t + 1) * kstep;
            const char* a2 = last ? nA : cA + (size_t)(t + 2) * kstep; const char* b2 = last ? nB : cB + (size_t)(t + 2) * kstep;
            const char* a3 = a2 + kstep; const char* b3 = b2 + kstep;
            if (last && has_next) S.a_ready(nxt);
            PG8_LDB(B0, 0, 0); PG8_SCHED; PG8_LDA(At, 0, 0); PG8_STAGE(PG8_SA(1, 1), a1 + hstep, voffA);
            PG8_WAIT_L(8); PG8_BAR; PG8_WAIT_L(0); PG8_MMA(0, 0, At, B0); PG8_BAR; PG8_SCHED;
            PG8_LDB(B1, 0, 1); PG8_STAGE(PG8_SB(0, 0), b2, voffB);
            PG8_BAR; PG8_WAIT_L(0); PG8_MMA(0, 1, At, B1); PG8_BAR;
            PG8_LDA(At, 0, 1); PG8_STAGE(PG8_SA(0, 0), a2, voffA);
            PG8_BAR; PG8_WAIT_L(0); PG8_MMA(1, 0, At, B0); PG8_BAR; PG8_SCHED;
            PG8_STAGE(PG8_SB(0, 1), b2 + hstep, voffB);
            PG8_WAIT_V(6); PG8_BAR; PG8_MMA(1, 1, At, B1); PG8_BAR;
            PG8_LDB(B0, 1, 0); PG8_SCHED; PG8_LDA(At, 1, 0); PG8_STAGE(PG8_SA(0, 1), a2 + hstep, voffA);
            PG8_WAIT_L(8); PG8_BAR; PG8_WAIT_L(0); PG8_MMA(0, 0, At, B0); PG8_BAR; PG8_SCHED;
            PG8_LDB(B1, 1, 1); PG8_STAGE(PG8_SB(1, 0), b3, voffB);
            PG8_BAR; PG8_WAIT_L(0); PG8_MMA(0, 1, At, B1); PG8_BAR;
            PG8_LDA(At, 1, 1); PG8_STAGE(PG8_SA(1, 0), a3, voffA);
            PG8_BAR; PG8_WAIT_L(0); PG8_MMA(1, 0, At, B0); PG8_BAR; PG8_SCHED;
            PG8_STAGE(PG8_SB(1, 1), b3 + hstep, voffB);
            PG8_WAIT_V(6); PG8_BAR; PG8_MMA(1, 1, At, B1); PG8_BAR;
        }
        PG8_STAMP();
        if constexpr (!Epi::AFTER_DRAIN) { E(acc, cur, wr, wc, fr, fq); S.done(cur); }
        PG8_STAMP();
        if (!has_next) break;
#pragma unroll
        for (int a = 0; a < 2; ++a)
#pragma unroll
            for (int b = 0; b < 2; ++b)
#pragma unroll
                for (int m = 0; m < 4; ++m)
#pragma unroll
                    for (int n = 0; n < 2; ++n) acc[a][b][m][n] = (f32x4){0.f, 0.f, 0.f, 0.f};
        cur = nxt; cA = nA; cB = nB; ++ui;
    }
    PG8_WAIT_V(0);
    if (wr == 0) PG8_BAR;
    PG8_BAR;
    if constexpr (Epi::AFTER_DRAIN) { E.fused(acc, cur, wr, wc, fr, fq, lds, wid, lane); S.done(cur); }
    PG8_STAMP();
    if (STAMP && wid == 0) { stamps[lane] = lane < nts ? (((unsigned long long)(unsigned)ts_hi << 32) | (unsigned)ts_lo) : 0ull;
        if (lane == 62) stamps[62] = rt_entry; if (lane == 63) stamps[63] = (unsigned long long)wall_clock64(); }
#undef PG8_STAMP
#undef PG8_SA
#undef PG8_SB
#undef PG8_STAGE
#undef PG8_LDA
#undef PG8_LDB
#undef PG8_MMA
#undef PG8_WAIT_V
#undef PG8_WAIT_L
#undef PG8_BAR
#undef PG8_SCHED
}
}

#define LAS __attribute__((address_space(3)))
typedef unsigned short bf16;
typedef float f32x4 __attribute__((ext_vector_type(4)));

#ifndef MK_N_LAUNCHES
#define MK_N_LAUNCHES 1
#endif
#ifndef MK_PHASE_MASK
#define MK_PHASE_MASK 0x1FFF
#endif
#ifndef MK_REPEAT
#define MK_REPEAT -1
#endif
#ifndef MK_RWKV_SEQ
#define MK_RWKV_SEQ 0
#endif
#ifndef MK_SSD_SEQ
#define MK_SSD_SEQ 0
#endif
#ifndef MK_SKIP_MIXER
#define MK_SKIP_MIXER 0
#endif
#ifndef MK_SKIP_PEER
#define MK_SKIP_PEER 0
#endif
#ifndef MK_SKIP_RWKV
#define MK_SKIP_RWKV 0
#endif
#ifndef MK_SKIP_SSD
#define MK_SKIP_SSD 0
#endif

constexpr int DM = 4096, NBATCH = 4, SEQ = 4096, CTXL = 256;
constexpr int MX = NBATCH * SEQ;
constexpr int MC = NBATCH * CTXL;
constexpr int MT = MX + MC;
constexpr int RW = 2048;
constexpr int RCOLS = 6784;
constexpr int NIN = 12992, NINP = 13056;
constexpr int COL_Z = 6784, COL_XBC = 8832, COL_DT = 12928;
constexpr int NLR = 10240, KLR = 640;
constexpr int NMOD = 6 * DM;
constexpr float RMS_EPS = 1e-6f, GN_EPS = 64e-5f;
constexpr int NSTEP = CTXL + SEQ;

constexpr size_t MiB = (size_t)1 << 20;
constexpr size_t WS_CTL = 0, CTL_ZERO_BYTES = 1 * MiB;
constexpr size_t WS_MOD = 64 * 1024;
constexpr size_t WS_WT_OUT = 2 * MiB;
constexpr size_t WS_WT_Q = 34 * MiB;
constexpr size_t WS_WLR = 50 * MiB;
constexpr size_t WS_KBD = 63 * MiB;
constexpr size_t WS_DT = 71 * MiB;
constexpr size_t WS_LA = WS_DT + (size_t)MT * 64 * 4;
constexpr size_t WS_ALR = 80 * MiB;
constexpr size_t WS_WT_IN = 102 * MiB;
constexpr size_t WS_A1 = 204 * MiB;
constexpr size_t WS_P = 340 * MiB;
constexpr size_t WS_R = 774 * MiB, WS_K = 842 * MiB, WS_V = 910 * MiB, WS_KK = 978 * MiB;
constexpr size_t WS_XS = 1046 * MiB, WS_BC = 1114 * MiB;
constexpr size_t WS_Z = 102 * MiB;
constexpr size_t WS_LR = 340 * MiB;
constexpr size_t WS_A2 = 166 * MiB;
constexpr size_t WS_XN2 = 340 * MiB;
constexpr size_t WS_Q = 468 * MiB;
constexpr size_t WS_S = 532 * MiB;
constexpr size_t WS_U8 = 774 * MiB, WS_V8 = 838 * MiB;
constexpr size_t WS_USC = 902 * MiB, WS_VSC = WS_USC + 65536;
constexpr size_t WS_END = 1182 * MiB;
static_assert(WS_WT_IN + (size_t)NINP * DM * 2 <= WS_A1 && WS_A1 + (size_t)MT * DM * 2 <= WS_P && WS_P + (size_t)MT * NINP * 2 <= WS_R, "ws map 1");
static_assert(WS_LR + (size_t)MT * NLR * 2 <= WS_R && WS_Z + (size_t)MX * RW * 2 <= WS_A2 && WS_A2 + (size_t)MX * DM * 2 <= WS_P, "ws map 2");
static_assert(WS_LA + (size_t)MT * 64 * 4 <= WS_ALR && WS_ALR + (size_t)MT * KLR * 2 <= WS_WT_IN && WS_WLR + (size_t)NLR * KLR * 2 <= WS_KBD, "ws map 3");
static_assert(WS_S + (size_t)MX * 2048 * 4 <= WS_R && WS_VSC + 65536 <= WS_XS, "ws map 4");

constexpr int LDS_BYTES = 147456;
constexpr int LDS_CTL = 143360;
constexpr int LDS_MISC = LDS_CTL + 320;

enum { I_X = 0, I_C, I_CTX, I_CCTX, I_WMOD, I_BMOD, I_N1G, I_N2G, I_WIN, I_WOUT, I_MU, I_W0, I_W2, I_A0, I_A2, I_G2, I_KK, I_KA, I_RK, I_LNW, I_LNB,
       I_CONVW, I_CONVB, I_DTB, I_ALOG, I_SSMD, I_NORMW, I_WQ, I_K1, I_K2, I_PU, I_PV, I_FG, N_IN };

struct Args { const float* in[N_IN]; float* out; unsigned char* ws; int ph_lo, ph_hi; };

__device__ __forceinline__ unsigned f2bf(float f) { unsigned u = __float_as_uint(f); return (u + 0x7fffu + ((u >> 16) & 1u)) >> 16; }
__device__ __forceinline__ unsigned pk2(float lo, float hi) { return f2bf(lo) | (f2bf(hi) << 16); }
__device__ __forceinline__ float bflo(unsigned u) { return __uint_as_float(u << 16); }
__device__ __forceinline__ float bfhi(unsigned u) { return __uint_as_float(u & 0xffff0000u); }
__device__ __forceinline__ void unpack8(const uint4& u, float (&f)[8]) {
    f[0] = bflo(u.x); f[1] = bfhi(u.x); f[2] = bflo(u.y); f[3] = bfhi(u.y); f[4] = bflo(u.z); f[5] = bfhi(u.z); f[6] = bflo(u.w); f[7] = bfhi(u.w);
}
__device__ __forceinline__ uint4 pack8(const float (&f)[8]) { uint4 u; u.x = pk2(f[0], f[1]); u.y = pk2(f[2], f[3]); u.z = pk2(f[4], f[5]); u.w = pk2(f[6], f[7]); return u; }
__device__ __forceinline__ uint4 ld16(const bf16* p) { return *(const uint4*)p; }
__device__ __forceinline__ void st16(bf16* p, const uint4& v) { *(uint4*)p = v; }
__device__ __forceinline__ void ldf8(const float* p, float (&f)[8]) { const float4 a = *(const float4*)p, b = *(const float4*)(p + 4); f[0] = a.x; f[1] = a.y; f[2] = a.z; f[3] = a.w; f[4] = b.x; f[5] = b.y; f[6] = b.z; f[7] = b.w; }
#define PIN8(a) asm volatile("" : "+v"((a)[0]), "+v"((a)[1]), "+v"((a)[2]), "+v"((a)[3]), "+v"((a)[4]), "+v"((a)[5]), "+v"((a)[6]), "+v"((a)[7]))
template <int CTRL> __device__ __forceinline__ float dppf(float v) { return __uint_as_float((unsigned)__builtin_amdgcn_update_dpp(0, (int)__float_as_uint(v), CTRL, 0xF, 0xF, true)); }
__device__ __forceinline__ float rlane(float v, int l) { return __uint_as_float((unsigned)__builtin_amdgcn_readlane((int)__float_as_uint(v), l)); }
__device__ __forceinline__ float sum8(float v) { v += dppf<0xB1>(v); v += dppf<0x4E>(v); v += dppf<0x141>(v); return v; }
__device__ __forceinline__ float sum16(float v) { v = sum8(v); v += dppf<0x140>(v); return v; }
__device__ __forceinline__ float sum32(float v) { v = sum16(v); v += __shfl_xor(v, 16); return v; }
__device__ __forceinline__ float wave_sum(float v) { v = sum16(v); return (rlane(v, 0) + rlane(v, 16)) + (rlane(v, 32) + rlane(v, 48)); }
__device__ __forceinline__ float wave_max(float v) {
    v = fmaxf(v, dppf<0xB1>(v)); v = fmaxf(v, dppf<0x4E>(v)); v = fmaxf(v, dppf<0x141>(v)); v = fmaxf(v, dppf<0x140>(v));
    return fmaxf(fmaxf(rlane(v, 0), rlane(v, 16)), fmaxf(rlane(v, 32), rlane(v, 48)));
}
__device__ __forceinline__ float sigmoidf_(float x) { return 1.f / (1.f + __expf(-x)); }
__device__ __forceinline__ float siluf_(float x) { return x / (1.f + __expf(-x)); }

struct EpiLR {
    static constexpr bool PERM = true, AFTER_DRAIN = false;
    bf16* O; const float* w0; const float* a0;
    __device__ __forceinline__ void operator()(const pg8::f32x4 (&acc)[2][2][4][2], const pg8::Unit& u, int wr, int wc, int fr, int fq) const {
        const int row0 = u.pm * 256 + wr * 64 + fr; const int colt = u.pn * 256; const int type = colt >> 11;
        const int col0 = colt + wc * 32 + 8 * fq;
        const float* bias = type < 2 ? (w0 + type * 2048) : (a0 + (type - 2) * 2048);
        pg8::f32x4 bv[2][2];
#pragma unroll
        for (int bj = 0; bj < 2; ++bj)
#pragma unroll
            for (int n = 0; n < 2; ++n) bv[bj][n] = type < 4 ? *(const pg8::f32x4*)(bias + ((col0 + bj * 128 + 4 * n) & 2047)) : (pg8::f32x4){0.f, 0.f, 0.f, 0.f};
#pragma unroll
        for (int ai = 0; ai < 2; ++ai)
#pragma unroll
            for (int m = 0; m < 4; ++m) { bf16* rowp = O + (size_t)(row0 + ai * 128 + m * 16) * NLR + col0;
#pragma unroll
                for (int bj = 0; bj < 2; ++bj) { pg8::f32x4 v0 = acc[ai][bj][m][0] + bv[bj][0], v1 = acc[ai][bj][m][1] + bv[bj][1];
                    if (type < 4) {
#pragma unroll
                        for (int j = 0; j < 4; ++j) { float s0 = 1.f / (1.f + __expf(-v0[j])), s1 = 1.f / (1.f + __expf(-v1[j]));
                            if (type < 2) { s0 = -expm1f(-0.60653066f * s0); s1 = -expm1f(-0.60653066f * s1); }
                            v0[j] = s0; v1[j] = s1; } }
                    pg8::u32x4 w; w.x = pg8::cvt_pk_bf16(v0[0], v0[1]); w.y = pg8::cvt_pk_bf16(v0[2], v0[3]); w.z = pg8::cvt_pk_bf16(v1[0], v1[1]); w.w = pg8::cvt_pk_bf16(v1[2], v1[3]);
                    *(pg8::u32x4*)(rowp + bj * 128) = w; } }
    }
};
struct EpiRes {
    static constexpr bool PERM = false, AFTER_DRAIN = false;
    float* C; const float* X; const float* mod;
    __device__ __forceinline__ void operator()(const pg8::f32x4 (&acc)[2][2][4][2], const pg8::Unit& u, int wr, int wc, int fr, int fq) const {
        const int row0 = u.pm * 256 + wr * 64 + fr, col0 = u.pn * 256 + wc * 32 + 4 * fq;
        const float* gt = mod + (size_t)((u.pm * 256) / SEQ) * NMOD + 2 * DM;
        pg8::f32x4 gv[2][2];
#pragma unroll
        for (int bj = 0; bj < 2; ++bj)
#pragma unroll
            for (int n = 0; n < 2; ++n) gv[bj][n] = *(const pg8::f32x4*)(gt + col0 + bj * 128 + n * 16);
#pragma unroll
        for (int ai = 0; ai < 2; ++ai)
#pragma unroll
            for (int m = 0; m < 4; ++m) { const size_t off = (size_t)(row0 + ai * 128 + m * 16) * DM + col0;
#pragma unroll
                for (int bj = 0; bj < 2; ++bj)
#pragma unroll
                    for (int n = 0; n < 2; ++n) { const pg8::f32x4 xv = *(const pg8::f32x4*)(X + off + bj * 128 + n * 16);
#if MK_SKIP_MIXER
                        *(pg8::f32x4*)(C + off + bj * 128 + n * 16) = xv;
#else
                        *(pg8::f32x4*)(C + off + bj * 128 + n * 16) = xv + gv[bj][n] * acc[ai][bj][m][n];
#endif
                    }
                asm volatile("" ::: "memory"); }
    }
};

#define XB_TMO      128
#define XB_XCNT(j)  (256  + 64 * (j))
#define XB_XSUB(j)  (1280 + 64 * (j))
#define XB_XGEN(j)  (2304 + 64 * (j))
#define XB_TOP      3328
#define XB_TOPGEN   3392
#define XCD_BAR_WORDS 3456
#define XB_SPIN_CAP (1u << 18)
__device__ __forceinline__ unsigned xb_ld(unsigned* p)              { return __hip_atomic_load(p, __ATOMIC_RELAXED, __HIP_MEMORY_SCOPE_AGENT); }
__device__ __forceinline__ unsigned xb_add(unsigned* p, unsigned v) { return __hip_atomic_fetch_add(p, v, __ATOMIC_RELAXED, __HIP_MEMORY_SCOPE_AGENT); }
__device__ __forceinline__ unsigned xb_xcc_id() { return (unsigned)__builtin_amdgcn_s_getreg((3 << 11) | 20) & 0xFu; }
#define XB_SPIN(cond, bar) do { unsigned _sp = 0; while (cond) { __builtin_amdgcn_s_sleep(1); \
    if ((++_sp & 255u) == 0u) { if (xb_ld(&(bar)[XB_TMO])) break; if (_sp > XB_SPIN_CAP) { atomicAdd(&(bar)[XB_TMO], 1u); break; } } } } while (0)
struct XcdBarrier { unsigned* bar; unsigned x; volatile LAS unsigned* st; };
__device__ __forceinline__ XcdBarrier xcd_barrier_post(unsigned* bar, volatile LAS unsigned* st) {
    XcdBarrier b; b.bar = bar; b.x = xb_xcc_id(); b.st = st;
    if (threadIdx.x == 0) (void)xb_add(&bar[XB_XCNT(b.x)], 1u);
    return b;
}
__device__ __forceinline__ void xcd_barrier_complete(unsigned* bar, unsigned x, unsigned& nloc, unsigned& nx) {
    const unsigned G = gridDim.x * gridDim.y * gridDim.z;
    unsigned sum, cnt, mine, sp = 0u;
    for (;;) {
        sum = 0u; cnt = 0u; mine = 0u;
#pragma unroll
        for (unsigned j = 0; j < 16; ++j) { const unsigned c = xb_ld(&bar[XB_XCNT(j)]); sum += c; cnt += (c > 0u) ? 1u : 0u; mine = (j == x) ? c : mine; }
        if (sum == G) break;
        __builtin_amdgcn_s_sleep(1);
        if ((++sp & 255u) == 0u) { if (xb_ld(&bar[XB_TMO])) break; if (sp > XB_SPIN_CAP) { atomicAdd(&bar[XB_TMO], 1u); break; } }
    }
    nloc = mine > 0u ? mine : 1u; nx = cnt > 0u ? cnt : 1u;
}
__device__ __forceinline__ void xcd_barrier(const XcdBarrier& b) {
    asm volatile("s_waitcnt vmcnt(0)" ::: "memory");
    __syncthreads();
    if (threadIdx.x == 0) {
        unsigned* bar = b.bar;
        __builtin_amdgcn_s_waitcnt(0);
        unsigned nloc = b.st[0], nx = b.st[1];
        if (nloc == 0u) { xcd_barrier_complete(bar, b.x, nloc, nx); b.st[0] = nloc; b.st[1] = nx; }
        const unsigned old = xb_add(&bar[XB_XSUB(b.x)], 1u);
        const unsigned gen = old / nloc;
        if (old + 1u == (gen + 1u) * nloc) {
            __builtin_amdgcn_fence(__ATOMIC_RELEASE, "agent");
            asm volatile("s_waitcnt vmcnt(0)" ::: "memory");
            const unsigned og = xb_add(&bar[XB_TOP], 1u);
            const unsigned tg = og / nx;
            if (og + 1u == (tg + 1u) * nx) xb_add(&bar[XB_TOPGEN], 1u);
            else XB_SPIN(xb_ld(&bar[XB_TOPGEN]) == tg, bar);
            __builtin_amdgcn_fence(__ATOMIC_ACQUIRE, "agent");
            xb_add(&bar[XB_XGEN(b.x)], 1u);
            asm volatile("s_waitcnt vmcnt(0)" ::: "memory");
        } else {
            XB_SPIN(xb_ld(&bar[XB_XGEN(b.x)]) == gen, bar);
            __builtin_amdgcn_fence(__ATOMIC_ACQUIRE, "agent");
            asm volatile("s_waitcnt vmcnt(0)" ::: "memory");
        }
    }
    __syncthreads();
}

#define TID ((int)threadIdx.x)
#define LANE ((int)(threadIdx.x & 63))
#define WAVE ((int)__builtin_amdgcn_readfirstlane((int)(threadIdx.x >> 6)))
#define GW ((int)blockIdx.x * 8 + WAVE)
#define NGW ((int)gridDim.x * 8)

__device__ __forceinline__ void ph_mod(const Args& a, LAS unsigned char* lds) {
    const float* c = a.in[I_C]; const float* cc = a.in[I_CCTX]; const float* w_mod = a.in[I_WMOD]; const float* b_mod = a.in[I_BMOD];
    float* mod = (float*)(a.ws + WS_MOD);
    LAS float* sS = (LAS float*)lds;
    LAS float* red = (LAS float*)(lds + 81920);
    const int tid = TID, lane = LANE, wave = WAVE;
    if ((int)blockIdx.x < 192) {
        for (int i = tid; i < 5 * DM; i += 512) { const int v = i >> 12, k = i & (DM - 1); const float xv = v < 4 ? c[v * DM + k] : cc[k]; sS[i] = xv / (1.f + expf(-xv)); }
    }
    __syncthreads();
    for (int u = blockIdx.x; u < 192; u += gridDim.x) {
        const int cl = lane & 31, kh = lane >> 5;
        float acc[5][4];
#pragma unroll
        for (int v = 0; v < 5; ++v)
#pragma unroll
            for (int e = 0; e < 4; ++e) acc[v][e] = 0.f;
        const float* wp = w_mod + (size_t)(wave * 512 + kh) * NMOD + u * 128 + cl * 4;
#pragma unroll 8
        for (int i = 0; i < 256; ++i) {
            const float4 w = *(const float4*)(wp + (size_t)(2 * i) * NMOD);
#pragma unroll
            for (int v = 0; v < 5; ++v) { const float s = sS[v * DM + wave * 512 + 2 * i + kh]; acc[v][0] += s * w.x; acc[v][1] += s * w.y; acc[v][2] += s * w.z; acc[v][3] += s * w.w; }
        }
#pragma unroll
        for (int v = 0; v < 5; ++v)
#pragma unroll
            for (int e = 0; e < 4; ++e) acc[v][e] += __shfl_xor(acc[v][e], 32);
        if (kh == 0) {
#pragma unroll
            for (int v = 0; v < 5; ++v) *(LAS f32x4*)(red + ((wave * 5 + v) * 128 + cl * 4)) = (f32x4){acc[v][0], acc[v][1], acc[v][2], acc[v][3]};
        }
        __syncthreads();
        for (int i = tid; i < 640; i += 512) { const int v = i >> 7, n = i & 127; float s = b_mod[u * 128 + n];
#pragma unroll
            for (int w = 0; w < 8; ++w) s += red[(w * 5 + v) * 128 + n];
            mod[v * NMOD + u * 128 + n] = s; }
        __syncthreads();
    }
    __syncthreads();
}

__device__ __forceinline__ void transpose_item(const float* W, int K, int N, bf16* WT, LAS float* scr, int item, int lane) {
    const int nblk = N / 32, kb = item / nblk, nb = item % nblk, k0 = 64 * kb, n0 = 32 * nb;
#pragma unroll 8
    for (int i = 0; i < 32; ++i) { const int kk = 2 * i + (lane >> 5); scr[kk * 33 + (lane & 31)] = W[(size_t)(k0 + kk) * N + n0 + (lane & 31)]; }
    asm volatile("s_waitcnt lgkmcnt(0)" ::: "memory");
    const int c = lane & 7;
#pragma unroll
    for (int j = 0; j < 4; ++j) { const int n = (lane >> 3) + 8 * j; const LAS float* s = scr + (8 * c) * 33 + n;
        uint4 o; o.x = pk2(s[0 * 33], s[1 * 33]); o.y = pk2(s[2 * 33], s[3 * 33]); o.z = pk2(s[4 * 33], s[5 * 33]); o.w = pk2(s[6 * 33], s[7 * 33]);
        *(uint4*)(WT + (size_t)(n0 + n) * K + k0 + 8 * c) = o; }
    asm volatile("s_waitcnt lgkmcnt(0)" ::: "memory");
}
__device__ __forceinline__ void ph_conv(const Args& a, LAS unsigned char* lds) {
    const int lane = LANE, wave = WAVE, gw = GW, ngw = NGW;
    LAS float* scr = (LAS float*)(lds + wave * 16384);
    bf16* wt_in = (bf16*)(a.ws + WS_WT_IN); bf16* wt_out = (bf16*)(a.ws + WS_WT_OUT); bf16* wt_q = (bf16*)(a.ws + WS_WT_Q);
    constexpr int IT_IN = (DM / 64) * (NIN / 32), IT_OUT = (DM / 64) * (DM / 32), IT_Q = (DM / 64) * (2048 / 32);
    for (int it = gw; it < IT_IN + IT_OUT + IT_Q; it += ngw) {
        int r = it;
        if (r < IT_IN) { transpose_item(a.in[I_WIN], DM, NIN, wt_in, scr, r, lane); continue; } r -= IT_IN;
        if (r < IT_OUT) { transpose_item(a.in[I_WOUT], DM, DM, wt_out, scr, r, lane); continue; } r -= IT_OUT;
        transpose_item(a.in[I_WQ], DM, 2048, wt_q, scr, r, lane);
    }
    const int gt = blockIdx.x * 512 + TID, ngt = gridDim.x * 512;
    for (int i = gt; i < (NINP - NIN) * DM / 8; i += ngt) *(uint4*)(wt_in + (size_t)NIN * DM + (size_t)i * 8) = make_uint4(0u, 0u, 0u, 0u);
    { bf16* wlr = (bf16*)(a.ws + WS_WLR); const float* w2 = a.in[I_W2]; const float* a2 = a.in[I_A2]; const float* g2 = a.in[I_G2];
      for (int i = gt; i < NLR * (KLR / 8); i += ngt) { const int n = i / (KLR / 8), k0 = (i % (KLR / 8)) * 8; const int type = n >> 11, cch = n & 2047;
          float f[8];
#pragma unroll
          for (int e = 0; e < 8; ++e) { const int k = k0 + e; float v = 0.f;
              if (type == 0) { if (k < 96) v = w2[(size_t)(0 * 96 + k) * RW + cch]; }
              else if (type == 1) { if (k >= 96 && k < 192) v = w2[(size_t)(1 * 96 + (k - 96)) * RW + cch]; }
              else if (type == 2) { if (k >= 192 && k < 288) v = a2[(size_t)(0 * 96 + (k - 192)) * RW + cch]; }
              else if (type == 3) { if (k >= 288 && k < 384) v = a2[(size_t)(1 * 96 + (k - 288)) * RW + cch]; }
              else { if (k >= 384) v = g2[(size_t)(k - 384) * RW + cch]; }
              f[e] = v; }
          st16(wlr + (size_t)n * KLR + k0, pack8(f)); } }
    { bf16* kbd = (bf16*)(a.ws + WS_KBD); const float* k1 = a.in[I_K1]; const float* k2 = a.in[I_K2];
      for (int i = gt; i < 2048 * 256; i += ngt) { const int n = i >> 8, k0 = (i & 255) * 8; float f[8];
          if ((n >> 7) == (k0 >> 7)) { const int h = n >> 8, s = (n >> 7) & 1, key = n & 127, d0 = k0 & 127; const float* src = (s ? k2 : k1) + ((size_t)(h * 128 + key) * 128 + d0); ldf8(src, f); }
          else {
#pragma unroll
              for (int e = 0; e < 8; ++e) f[e] = 0.f; }
          st16(kbd + (size_t)n * 2048 + k0, pack8(f)); } }
}

__device__ __forceinline__ void norm_mod_row(const float* src, const float* g, const float* sh, const float* sc, bf16* dst, int lane) {
    float4 v[16]; float ss = 0.f;
#pragma unroll
    for (int j = 0; j < 16; ++j) { v[j] = *(const float4*)(src + (lane + 64 * j) * 4); ss += (v[j].x * v[j].x + v[j].y * v[j].y) + (v[j].z * v[j].z + v[j].w * v[j].w); }
    const float rstd = rsqrtf(wave_sum(ss) * (1.f / DM) + RMS_EPS);
#pragma unroll
    for (int j = 0; j < 16; ++j) { const int c = (lane + 64 * j) * 4; const float4 gg = *(const float4*)(g + c), s1 = *(const float4*)(sc + c), s0 = *(const float4*)(sh + c);
        const float o0 = v[j].x * rstd * gg.x * (1.f + s1.x) + s0.x, o1 = v[j].y * rstd * gg.y * (1.f + s1.y) + s0.y, o2 = v[j].z * rstd * gg.z * (1.f + s1.z) + s0.z, o3 = v[j].w * rstd * gg.w * (1.f + s1.w) + s0.w;
        uint2 w; w.x = pk2(o0, o1); w.y = pk2(o2, o3); *(uint2*)(dst + c) = w; }
}
__device__ __forceinline__ void ph_norm1(const Args& a) {
    const int lane = LANE; const float* mod = (const float*)(a.ws + WS_MOD); bf16* A1 = (bf16*)(a.ws + WS_A1);
    for (int m = GW; m < MT; m += NGW) {
        const float* src = m < MX ? a.in[I_X] + (size_t)m * DM : a.in[I_CTX] + (size_t)(m - MX) * DM;
        const int v = m < MX ? m / SEQ : 4;
        norm_mod_row(src, a.in[I_N1G], mod + (size_t)v * NMOD, mod + (size_t)v * NMOD + DM, A1 + (size_t)m * DM, lane);
    }
}
__device__ __forceinline__ void ph_norm2(const Args& a) {
    const int lane = LANE; const float* mod = (const float*)(a.ws + WS_MOD); bf16* XN2 = (bf16*)(a.ws + WS_XN2);
    for (int m = GW; m < MX; m += NGW) {
        const int v = m / SEQ;
        norm_mod_row(a.out + (size_t)m * DM, a.in[I_N2G], mod + (size_t)v * NMOD + 3 * DM, mod + (size_t)v * NMOD + 4 * DM, XN2 + (size_t)m * DM, lane);
    }
    unsigned* U8 = (unsigned*)(a.ws + WS_U8); unsigned* V8 = (unsigned*)(a.ws + WS_V8); float* USC = (float*)(a.ws + WS_USC); float* VSC = (float*)(a.ws + WS_VSC);
    for (int row = GW; row < 2 * 16384; row += NGW) {
        const int tb = row >> 14, r = row & 16383;
        const float* src = (tb ? a.in[I_PV] : a.in[I_PU]) + (size_t)r * DM;
        float4 v[16]; float am = 0.f;
#pragma unroll
        for (int j = 0; j < 16; ++j) { v[j] = *(const float4*)(src + (lane + 64 * j) * 4); am = fmaxf(fmaxf(am, fmaxf(fabsf(v[j].x), fabsf(v[j].y))), fmaxf(fabsf(v[j].z), fabsf(v[j].w))); }
        am = wave_max(am);
        const float scale = am > 0.f ? am * (1.f / 448.f) : 1.f, inv = 1.f / scale;
        unsigned* dst = (tb ? V8 : U8) + (size_t)r * (DM / 4);
#pragma unroll
        for (int j = 0; j < 16; ++j) { int p = __builtin_amdgcn_cvt_pk_fp8_f32(v[j].x * inv, v[j].y * inv, 0, false); p = __builtin_amdgcn_cvt_pk_fp8_f32(v[j].z * inv, v[j].w * inv, p, true); dst[lane + 64 * j] = (unsigned)p; }
        if (lane == 0) (tb ? VSC : USC)[r] = scale;
    }
}

__device__ __forceinline__ void ph_prep_rwkv(const Args& a) {
    const int lane = LANE;
    const bf16* P = (const bf16*)(a.ws + WS_P);
    bf16* R = (bf16*)(a.ws + WS_R); bf16* K = (bf16*)(a.ws + WS_K); bf16* V = (bf16*)(a.ws + WS_V); bf16* KK = (bf16*)(a.ws + WS_KK); bf16* ALR = (bf16*)(a.ws + WS_ALR);
    const float* mu = a.in[I_MU]; const float* k_k = a.in[I_KK];
    for (int m = GW; m < MT; m += NGW) {
        const bool lat = m < MX;
        bool h0, h1, h2 = false, h3 = false; size_t r0, r1, r2 = 0, r3 = 0;
        if (lat) { const int t = m & (SEQ - 1), row = t >> 6, col = t & 63; h0 = col > 0; h1 = col < 63; h2 = row > 0; h3 = row < 63; r0 = (size_t)(m - 1); r1 = (size_t)(m + 1); r2 = (size_t)(m - 64); r3 = (size_t)(m + 64); }
        else { const int t = (m - MX) & (CTXL - 1); h0 = t > 0; h1 = t < CTXL - 1; r0 = (size_t)(m - 1); r1 = (size_t)(m + 1); }
        const bf16* prow = P + (size_t)m * NINP;
#pragma unroll
        for (int i = 0; i < 14; ++i) {
            const int chunk = lane + 64 * i;
            if (chunk < RCOLS / 8) {
                const int c0 = chunk * 8;
                float own[8], n0[8], n1[8], sh[8], xm[8], muv[8];
                const uint4 z4 = make_uint4(0u, 0u, 0u, 0u);
                unpack8(ld16(prow + c0), own);
                unpack8(h0 ? ld16(P + r0 * NINP + c0) : z4, n0);
                unpack8(h1 ? ld16(P + r1 * NINP + c0) : z4, n1);
                if (lat) { float n2[8], n3[8];
                    unpack8(h2 ? ld16(P + r2 * NINP + c0) : z4, n2);
                    unpack8(h3 ? ld16(P + r3 * NINP + c0) : z4, n3);
#pragma unroll
                    for (int e = 0; e < 8; ++e) sh[e] = (e & 3) == 0 ? n0[e] : (e & 3) == 1 ? n1[e] : (e & 3) == 2 ? n2[e] : n3[e];
                } else {
#pragma unroll
                    for (int e = 0; e < 8; ++e) sh[e] = (e & 1) == 0 ? n0[e] : n1[e];
                }
                ldf8(mu + c0, muv);
#pragma unroll
                for (int e = 0; e < 8; ++e) xm[e] = own[e] + muv[e] * (sh[e] - own[e]);
                if (i < 4) st16(R + (size_t)m * RW + c0, pack8(xm));
                else if (i < 8) { const int cc = c0 - 2048; st16(K + (size_t)m * RW + cc, pack8(xm));
                    float kv[8], kkv[8]; ldf8(k_k + cc, kv); float ss = 0.f;
#pragma unroll
                    for (int e = 0; e < 8; ++e) { kkv[e] = xm[e] * kv[e]; ss += kkv[e] * kkv[e]; }
                    ss = sum8(ss);
                    const float inv = rsqrtf(fmaxf(ss, 1e-24f));
#pragma unroll
                    for (int e = 0; e < 8; ++e) kkv[e] *= inv;
                    st16(KK + (size_t)m * RW + cc, pack8(kkv)); }
                else if (i < 12) st16(V + (size_t)m * RW + (c0 - 4096), pack8(xm));
                else { const int j0 = c0 - 6144; float f[8];
#pragma unroll
                    for (int e = 0; e < 8; ++e) f[e] = j0 < 192 ? tanhf(xm[e]) : (j0 < 384 ? xm[e] : 1.f / (1.f + __expf(-xm[e])));
                    st16(ALR + (size_t)m * KLR + j0, pack8(f)); }
            }
        }
    }
}

__device__ __forceinline__ void ph_prep_ssd(const Args& a) {
    const int lane = LANE;
    const bf16* P = (const bf16*)(a.ws + WS_P);
    bf16* XS = (bf16*)(a.ws + WS_XS); bf16* BC = (bf16*)(a.ws + WS_BC); bf16* Z = (bf16*)(a.ws + WS_Z); float* DT = (float*)(a.ws + WS_DT); float* LA = (float*)(a.ws + WS_LA);
    const float* cw = a.in[I_CONVW]; const float* cb = a.in[I_CONVB];
    for (int m = GW; m < MT; m += NGW) {
        const bool lat = m < MX; bool hp, hn;
        if (lat) { const int t = m & (SEQ - 1); hp = t > 0; hn = t < SEQ - 1; } else { const int t = (m - MX) & (CTXL - 1); hp = t > 0; hn = t < CTXL - 1; }
        const bf16* prow = P + (size_t)m * NINP;
#pragma unroll
        for (int i = 0; i < 8; ++i) {
            const int c0 = (lane + 64 * i) * 8; const uint4 z4 = make_uint4(0u, 0u, 0u, 0u);
            float cur[8], pv[8], nx[8], w0[8], w1[8], w2[8], bb[8], y[8];
            unpack8(ld16(prow + COL_XBC + c0), cur);
            unpack8(hp ? ld16(prow - NINP + COL_XBC + c0) : z4, pv);
            unpack8(hn ? ld16(prow + NINP + COL_XBC + c0) : z4, nx);
            ldf8(cw + c0, w0); ldf8(cw + 4096 + c0, w1); ldf8(cw + 8192 + c0, w2); ldf8(cb + c0, bb);
#pragma unroll
            for (int e = 0; e < 8; ++e) { const float t = w0[e] * pv[e] + w1[e] * cur[e] + w2[e] * nx[e] + bb[e]; y[e] = t / (1.f + __expf(-t)); }
            if (i < 4) st16(XS + (size_t)m * RW + c0, pack8(y)); else st16(BC + (size_t)m * RW + (c0 - 2048), pack8(y));
        }
        { const float raw = __uint_as_float((unsigned)prow[COL_DT + lane] << 16) + a.in[I_DTB][lane];
          const float dtv = raw > 20.f ? raw : log1pf(expf(raw));
          DT[(size_t)m * 64 + lane] = dtv; LA[(size_t)m * 64 + lane] = -dtv * expf(a.in[I_ALOG][lane]); }
        if (lat) {
#pragma unroll
            for (int i = 0; i < 4; ++i) { const int c0 = (lane + 64 * i) * 8; st16(Z + (size_t)m * RW + c0, ld16(prow + COL_Z + c0)); }
        }
    }
}

__device__ __forceinline__ int scan_row(int n, int dir, int b) { return n < CTXL ? MX + b * CTXL + (dir ? CTXL - 1 - n : n) : b * SEQ + (dir ? NSTEP - 1 - n : n - CTXL); }

struct RIn { uint4 r, k, kk, w, a; unsigned v; };
__device__ __forceinline__ void rwkv_load(RIn& x, const bf16* R, const bf16* K, const bf16* V, const bf16* KK, const bf16* LR, int m, int ch, int chi, int dir) {
    x.r = ld16(R + (size_t)m * RW + ch); x.k = ld16(K + (size_t)m * RW + ch); x.kk = ld16(KK + (size_t)m * RW + ch);
    x.w = ld16(LR + (size_t)m * NLR + dir * 2048 + ch); x.a = ld16(LR + (size_t)m * NLR + 4096 + dir * 2048 + ch);
    x.v = V[(size_t)m * RW + chi];
}
__device__ __forceinline__ float rwkv_step(float (&S)[8], const RIn& x, const float (&ka)[8]) {
    float r[8], k[8], kk[8], w1[8], av[8];
    unpack8(x.r, r); unpack8(x.k, k); unpack8(x.kk, kk); unpack8(x.w, w1); unpack8(x.a, av);
    const float v = __uint_as_float(x.v << 16);
    float sa = 0.f;
#pragma unroll
    for (int e = 0; e < 8; ++e) sa -= S[e] * kk[e];
    sa = sum8(sa);
    float o = 0.f;
#pragma unroll
    for (int e = 0; e < 8; ++e) { const float kd = k[e] * (1.f + (av[e] - 1.f) * ka[e]); const float b = kk[e] * av[e];
        S[e] = S[e] * (1.f - w1[e]) + sa * b + v * kd; o += S[e] * r[e]; }
    o = sum8(o);
    return o;
}
__device__ __forceinline__ void ph_rwkv_scan(const Args& a) {
    const int lane = LANE, wave = WAVE;
    const bf16* R = (const bf16*)(a.ws + WS_R); const bf16* K = (const bf16*)(a.ws + WS_K); const bf16* V = (const bf16*)(a.ws + WS_V); const bf16* KK = (const bf16*)(a.ws + WS_KK);
    const bf16* LR = (const bf16*)(a.ws + WS_LR); bf16* OR = (bf16*)a.out;
    for (int u = blockIdx.x; u < 256; u += gridDim.x) {
        const int g = u >> 5, h = u & 31, dir = g >> 2, b = g & 3;
        const int i = wave * 8 + (lane >> 3), jb = lane & 7, ch = h * 64 + jb * 8, chi = h * 64 + i;
        float ka[8]; ldf8(a.in[I_KA] + ch, ka);
        float S[8];
#pragma unroll
        for (int e = 0; e < 8; ++e) S[e] = 0.f;
        RIn A[4], B[4];
#pragma unroll
        for (int s = 0; s < 4; ++s) rwkv_load(A[s], R, K, V, KK, LR, scan_row(s, dir, b), ch, chi, dir);
        for (int n0 = 0; n0 < NSTEP; n0 += 8) {
#pragma unroll
            for (int s = 0; s < 4; ++s) rwkv_load(B[s], R, K, V, KK, LR, scan_row(n0 + 4 + s, dir, b), ch, chi, dir);
#pragma unroll
            for (int s = 0; s < 4; ++s) { const int n = n0 + s; const float o = rwkv_step(S, A[s], ka);
                if (n >= CTXL && jb == 0) OR[((size_t)dir * MX + scan_row(n, dir, b)) * RW + chi] = (bf16)f2bf(o); }
            if (n0 + 8 < NSTEP) {
#pragma unroll
                for (int s = 0; s < 4; ++s) rwkv_load(A[s], R, K, V, KK, LR, scan_row(n0 + 8 + s, dir, b), ch, chi, dir);
            }
#pragma unroll
            for (int s = 0; s < 4; ++s) { const int n = n0 + 4 + s; const float o = rwkv_step(S, B[s], ka);
                if (n >= CTXL && jb == 0) OR[((size_t)dir * MX + scan_row(n, dir, b)) * RW + chi] = (bf16)f2bf(o); }
        }
    }
}

typedef float f32x2_t __attribute__((ext_vector_type(2)));
constexpr int RS_TS = 32, RS_STEP_B = 6 * 256, RS_BUF_B = RS_TS * RS_STEP_B;
constexpr int RS_OBUF = 2 * RS_BUF_B, RS_OBUF_B = RS_TS * 64 * 2;
constexpr int RS_DUMP = RS_OBUF + 2 * RS_OBUF_B;
static_assert(RS_DUMP + 2048 <= 131072, "rwkv scan lds map");
struct RRaw { uint2 r, k, kk, v, w, a; };
__device__ __forceinline__ void rs_load(RRaw& x, const bf16* R, const bf16* K, const bf16* V, const bf16* KK, const bf16* LR, int m, int ch, int dir) {
    x.r = *(const uint2*)(R + (size_t)m * RW + ch); x.k = *(const uint2*)(K + (size_t)m * RW + ch); x.kk = *(const uint2*)(KK + (size_t)m * RW + ch); x.v = *(const uint2*)(V + (size_t)m * RW + ch);
    x.w = *(const uint2*)(LR + (size_t)m * NLR + dir * 2048 + ch); x.a = *(const uint2*)(LR + (size_t)m * NLR + 4096 + dir * 2048 + ch);
}
__device__ __forceinline__ void rs_stage(const RRaw& x, const float (&ka)[4], LAS unsigned char* dst) {
    const float r[4] = {bflo(x.r.x), bfhi(x.r.x), bflo(x.r.y), bfhi(x.r.y)}, k[4] = {bflo(x.k.x), bfhi(x.k.x), bflo(x.k.y), bfhi(x.k.y)};
    const float kk[4] = {bflo(x.kk.x), bfhi(x.kk.x), bflo(x.kk.y), bfhi(x.kk.y)}, v[4] = {bflo(x.v.x), bfhi(x.v.x), bflo(x.v.y), bfhi(x.v.y)};
    const float w1[4] = {bflo(x.w.x), bfhi(x.w.x), bflo(x.w.y), bfhi(x.w.y)}, av[4] = {bflo(x.a.x), bfhi(x.a.x), bflo(x.a.y), bfhi(x.a.y)};
    f32x4 nkk, w, b, kd, rr, vv;
#pragma unroll
    for (int e = 0; e < 4; ++e) { nkk[e] = -kk[e]; w[e] = 1.f - w1[e]; b[e] = kk[e] * av[e]; kd[e] = k[e] * (1.f + (av[e] - 1.f) * ka[e]); rr[e] = r[e]; vv[e] = v[e]; }
    *(LAS f32x4*)(dst) = nkk; *(LAS f32x4*)(dst + 256) = w; *(LAS f32x4*)(dst + 512) = b; *(LAS f32x4*)(dst + 768) = kd; *(LAS f32x4*)(dst + 1024) = rr; *(LAS f32x4*)(dst + 1280) = vv;
}
__device__ __forceinline__ float amul(float a, float b) { float d; asm("v_mul_f32 %0, %1, %2" : "=v"(d) : "v"(a), "v"(b)); return d; }
__device__ __forceinline__ void afmac(float& d, float a, float b) { asm("v_fmac_f32 %0, %1, %2" : "+v"(d) : "v"(a), "v"(b)); }
__device__ __forceinline__ float afma(float a, float b, float c) { float d; asm("v_fma_f32 %0, %1, %2, %3" : "=v"(d) : "v"(a), "v"(b), "v"(c)); return d; }
__device__ __forceinline__ void sum16x2(float& a, float& b) {
    asm("s_nop 1\n\t"
        "v_add_f32_dpp %0, %0, %0 quad_perm:[1,0,3,2] row_mask:0xf bank_mask:0xf bound_ctrl:1\n\t"
        "v_add_f32_dpp %1, %1, %1 quad_perm:[1,0,3,2] row_mask:0xf bank_mask:0xf bound_ctrl:1\n\t"
        "s_nop 0\n\t"
        "v_add_f32_dpp %0, %0, %0 quad_perm:[2,3,0,1] row_mask:0xf bank_mask:0xf bound_ctrl:1\n\t"
        "v_add_f32_dpp %1, %1, %1 quad_perm:[2,3,0,1] row_mask:0xf bank_mask:0xf bound_ctrl:1\n\t"
        "s_nop 0\n\t"
        "v_add_f32_dpp %0, %0, %0 row_half_mirror row_mask:0xf bank_mask:0xf bound_ctrl:1\n\t"
        "v_add_f32_dpp %1, %1, %1 row_half_mirror row_mask:0xf bank_mask:0xf bound_ctrl:1\n\t"
        "s_nop 0\n\t"
        "v_add_f32_dpp %0, %0, %0 row_mirror row_mask:0xf bank_mask:0xf bound_ctrl:1\n\t"
        "v_add_f32_dpp %1, %1, %1 row_mirror row_mask:0xf bank_mask:0xf bound_ctrl:1"
        : "+v"(a), "+v"(b));
}
template <bool OUT> __device__ __forceinline__ void rs_chunk(float (&S)[2][4], const LAS unsigned char* buf, LAS unsigned char* obuf, LAS unsigned char* dump, int j0, int i0, int jb) {
#pragma unroll 4
    for (int s = 0; s < RS_TS; ++s) {
        const LAS unsigned char* base = buf + s * RS_STEP_B;
        const f32x4 nkk = *(const LAS f32x4*)(base + j0 * 4), w = *(const LAS f32x4*)(base + 256 + j0 * 4), b = *(const LAS f32x4*)(base + 512 + j0 * 4), kd = *(const LAS f32x4*)(base + 768 + j0 * 4);
        const f32x2_t v = *(const LAS f32x2_t*)(base + 1280 + i0 * 4);
        float sa0 = amul(S[0][0], nkk[0]), sa1 = amul(S[1][0], nkk[0]);
#pragma unroll
        for (int e = 1; e < 4; ++e) { afmac(sa0, S[0][e], nkk[e]); afmac(sa1, S[1][e], nkk[e]); }
        sum16x2(sa0, sa1);
#pragma unroll
        for (int e = 0; e < 4; ++e) { float t0 = amul(sa0, b[e]), t1 = amul(sa1, b[e]); afmac(t0, v[0], kd[e]); afmac(t1, v[1], kd[e]); S[0][e] = afma(S[0][e], w[e], t0); S[1][e] = afma(S[1][e], w[e], t1); }
        if (OUT) {
            const f32x4 r = *(const LAS f32x4*)(base + 1024 + j0 * 4);
            float o0 = amul(S[0][0], r[0]), o1 = amul(S[1][0], r[0]);
#pragma unroll
            for (int e = 1; e < 4; ++e) { afmac(o0, S[0][e], r[e]); afmac(o1, S[1][e], r[e]); }
            sum16x2(o0, o1);
            *(LAS unsigned*)(jb == 0 ? obuf + (s * 64 + i0) * 2 : dump) = pg8::cvt_pk_bf16(o0, o1);
        }
    }
}
__device__ __forceinline__ void ph_rwkv_scan2(const Args& a, LAS unsigned char* lds) {
    const int tid = TID, lane = LANE, wave = WAVE;
    const bf16* R = (const bf16*)(a.ws + WS_R); const bf16* K = (const bf16*)(a.ws + WS_K); const bf16* V = (const bf16*)(a.ws + WS_V); const bf16* KK = (const bf16*)(a.ws + WS_KK);
    const bf16* LR = (const bf16*)(a.ws + WS_LR); bf16* OR = (bf16*)a.out;
    constexpr int NCH = NSTEP / RS_TS;
    for (int u = blockIdx.x; u < 256; u += gridDim.x) {
        const int g = u >> 5, h = u & 31, dir = g >> 2, b = g & 3;
        const int ip = lane >> 4, jb = lane & 15, i0 = wave * 8 + ip * 2, j0 = jb * 4;
        const int ss = tid >> 4, cgp = tid & 15, ch = h * 64 + cgp * 4;
        float ka[4];
#pragma unroll
        for (int e = 0; e < 4; ++e) ka[e] = a.in[I_KA][ch + e];
        float S[2][4];
#pragma unroll
        for (int e = 0; e < 4; ++e) { S[0][e] = 0.f; S[1][e] = 0.f; }
        RRaw raw;
        __syncthreads();
        rs_load(raw, R, K, V, KK, LR, scan_row(ss, dir, b), ch, dir);
        rs_stage(raw, ka, lds + ss * RS_STEP_B + cgp * 16);
        __syncthreads();
        for (int c = 0; c < NCH; ++c) {
            LAS unsigned char* buf = lds + (c & 1) * RS_BUF_B; LAS unsigned char* nbuf = lds + ((c + 1) & 1) * RS_BUF_B; LAS unsigned char* obuf = lds + RS_OBUF + (c & 1) * RS_OBUF_B;
            const bool more = c + 1 < NCH;
            if (more) rs_load(raw, R, K, V, KK, LR, scan_row((c + 1) * RS_TS + ss, dir, b), ch, dir);
            const bool lat = c >= CTXL / RS_TS;
            if (lat) rs_chunk<true>(S, buf, obuf, lds + RS_DUMP + tid * 4, j0, i0, jb); else rs_chunk<false>(S, buf, obuf, lds + RS_DUMP + tid * 4, j0, i0, jb);
            if (more) rs_stage(raw, ka, nbuf + ss * RS_STEP_B + cgp * 16);
            __syncthreads();
            if (lat) { typedef unsigned u32x2_t __attribute__((ext_vector_type(2))); const u32x2_t ov = *(const LAS u32x2_t*)(obuf + (ss * 64 + cgp * 4) * 2);
                *(uint2*)(OR + ((size_t)dir * MX + scan_row(c * RS_TS + ss, dir, b)) * RW + ch) = make_uint2(ov[0], ov[1]); }
        }
    }
}

struct SIn { uint4 b0, b1, c0, c1; unsigned xs; float dt, la; };
__device__ __forceinline__ void ssd_load(SIn& x, const bf16* XS, const bf16* BC, const float* DT, const float* LA, int m, int chx, int cb, int dh) {
    x.b0 = ld16(BC + (size_t)m * RW + cb); x.b1 = ld16(BC + (size_t)m * RW + cb + 8); x.c0 = ld16(BC + (size_t)m * RW + 1024 + cb); x.c1 = ld16(BC + (size_t)m * RW + 1024 + cb + 8);
    x.xs = XS[(size_t)m * RW + chx]; x.dt = DT[(size_t)m * 64 + dh]; x.la = LA[(size_t)m * 64 + dh];
}
__device__ __forceinline__ float ssd_step(float (&s)[16], const SIn& x) {
    float B0[8], B1[8], C0[8], C1[8]; unpack8(x.b0, B0); unpack8(x.b1, B1); unpack8(x.c0, C0); unpack8(x.c1, C1);
    const float dec = __expf(x.la), xdt = __uint_as_float(x.xs << 16) * x.dt; float y = 0.f;
#pragma unroll
    for (int e = 0; e < 8; ++e) { s[e] = dec * s[e] + xdt * B0[e]; y += s[e] * C0[e]; s[8 + e] = dec * s[8 + e] + xdt * B1[e]; y += s[8 + e] * C1[e]; }
    y = sum8(y);
    return y;
}
__device__ __forceinline__ void ph_ssd_scan(const Args& a) {
    const int lane = LANE, wave = WAVE;
    const bf16* XS = (const bf16*)(a.ws + WS_XS); const bf16* BC = (const bf16*)(a.ws + WS_BC); const float* DT = (const float*)(a.ws + WS_DT); const float* LA = (const float*)(a.ws + WS_LA);
    bf16* YS = (bf16*)a.out + (size_t)2 * MX * RW;
    for (int u = blockIdx.x; u < 256; u += gridDim.x) {
        const int g = u >> 5, h = u & 31, dir = g >> 2, b = g & 3;
        const int p = wave * 8 + (lane >> 3), nb = lane & 7, chx = h * 64 + p, cb = (h >> 2) * 128 + nb * 16, dh = dir * 32 + h;
        float s[16];
#pragma unroll
        for (int e = 0; e < 16; ++e) s[e] = 0.f;
        SIn A[4], B[4];
#pragma unroll
        for (int q = 0; q < 4; ++q) ssd_load(A[q], XS, BC, DT, LA, scan_row(q, dir, b), chx, cb, dh);
        for (int n0 = 0; n0 < NSTEP; n0 += 8) {
#pragma unroll
            for (int q = 0; q < 4; ++q) ssd_load(B[q], XS, BC, DT, LA, scan_row(n0 + 4 + q, dir, b), chx, cb, dh);
#pragma unroll
            for (int q = 0; q < 4; ++q) { const int n = n0 + q; const float y = ssd_step(s, A[q]);
                if (n >= CTXL && nb == 0) YS[((size_t)dir * MX + scan_row(n, dir, b)) * RW + chx] = (bf16)f2bf(y); }
            if (n0 + 8 < NSTEP) {
#pragma unroll
                for (int q = 0; q < 4; ++q) ssd_load(A[q], XS, BC, DT, LA, scan_row(n0 + 8 + q, dir, b), chx, cb, dh);
            }
#pragma unroll
            for (int q = 0; q < 4; ++q) { const int n = n0 + 4 + q; const float y = ssd_step(s, B[q]);
                if (n >= CTXL && nb == 0) YS[((size_t)dir * MX + scan_row(n, dir, b)) * RW + chx] = (bf16)f2bf(y); }
        }
    }
}

typedef short bf16x8_t __attribute__((ext_vector_type(8)));
typedef float f32x16 __attribute__((ext_vector_type(16)));
constexpr int SLD = 272;
constexpr int L_C = 0, L_B = 34816, L_BT = 69632, L_XT = 104448, L_S = 121856, L_F = 139264;
static_assert(L_F + 4 * 512 <= LDS_CTL, "ssd lds map");
typedef unsigned u32x4_t __attribute__((ext_vector_type(4)));
__device__ __forceinline__ void lds_st16(LAS unsigned char* p, const uint4& v) { *(LAS u32x4_t*)p = (u32x4_t){v.x, v.y, v.z, v.w}; }
__device__ __forceinline__ uint4 lds_ld16(const LAS unsigned char* p) { const u32x4_t t = *(const LAS u32x4_t*)p; return make_uint4(t[0], t[1], t[2], t[3]); }
__device__ __forceinline__ bf16x8_t lfrag(LAS unsigned char* img, int row, int k) { return *(LAS bf16x8_t*)(img + row * SLD + k * 2); }
__device__ __forceinline__ void ph_ssd_chunked(const Args& a, LAS unsigned char* lds) {
    const int tid = TID, lane = LANE, wave = WAVE, r = lane & 31, hh = lane >> 5;
    const bf16* XS = (const bf16*)(a.ws + WS_XS); const bf16* BC = (const bf16*)(a.ws + WS_BC); const float* DT = (const float*)(a.ws + WS_DT); const float* LA = (const float*)(a.ws + WS_LA);
    bf16* YS = (bf16*)a.out + (size_t)2 * MX * RW;
    LAS float* laS = (LAS float*)(lds + L_F); LAS float* dtS = laS + 128; LAS float* cumS = laS + 256;
    for (int u = blockIdx.x; u < 256; u += gridDim.x) {
        const int g = u >> 5, h = u & 31, dir = g >> 2, b = g & 3, gi = h >> 2;
        f32x16 st;
#pragma unroll
        for (int q = 0; q < 16; ++q) st[q] = 0.f;
        __syncthreads();
        for (int i = tid; i < 64 * SLD / 4; i += 512) ((LAS unsigned*)(lds + L_S))[i] = 0u;
        for (int c = 0; c < NSTEP / 128; ++c) {
            const int n0 = c * 128; const bool lat = c >= CTXL / 128;
            for (int i = tid; i < 2048; i += 512) { const int l = i >> 4, pc = i & 15; const size_t m = (size_t)scan_row(n0 + l, dir, b);
                lds_st16(lds + L_B + l * SLD + pc * 16, ld16(BC + m * RW + gi * 128 + pc * 8));
                if (lat) lds_st16(lds + L_C + l * SLD + pc * 16, ld16(BC + m * RW + 1024 + gi * 128 + pc * 8)); }
            for (int i = tid; i < 1024; i += 512) { const int l = i >> 3, pc = i & 7; const size_t m = (size_t)scan_row(n0 + l, dir, b);
                const uint4 v = ld16(XS + m * RW + h * 64 + pc * 8); const unsigned w[4] = {v.x, v.y, v.z, v.w};
#pragma unroll
                for (int e = 0; e < 8; ++e) *(LAS bf16*)(lds + L_XT + (pc * 8 + e) * SLD + l * 2) = (bf16)((e & 1) ? (w[e >> 1] >> 16) : (w[e >> 1] & 0xffffu)); }
            if (tid < 128) { const size_t m = (size_t)scan_row(n0 + tid, dir, b); laS[tid] = LA[m * 64 + dir * 32 + h]; dtS[tid] = DT[m * 64 + dir * 32 + h]; }
            __syncthreads();
            if (wave == 0) { const float a0 = laS[2 * lane], b0 = laS[2 * lane + 1]; float x = a0 + b0;
#pragma unroll
                for (int d = 1; d < 64; d <<= 1) { const float y = __shfl_up(x, d); if (lane >= d) x += y; }
                cumS[2 * lane + 1] = x; cumS[2 * lane] = x - b0; }
            __syncthreads();
            const float ctot = cumS[127];
            for (int i = tid; i < 2048; i += 512) { const int l = i >> 4, pc = i & 15; const float wl = dtS[l] * __expf(ctot - cumS[l]);
                float f[8]; unpack8(lds_ld16(lds + L_B + l * SLD + pc * 16), f);
#pragma unroll
                for (int e = 0; e < 8; ++e) *(LAS bf16*)(lds + L_BT + (pc * 8 + e) * SLD + l * 2) = (bf16)f2bf(f[e] * wl); }
            f32x16 acc0, acc1;
            const int lt = wave >> 1, st0 = 2 * (wave & 1);
            if (lat) {
#pragma unroll
                for (int q = 0; q < 16; ++q) { acc0[q] = 0.f; acc1[q] = 0.f; }
                if (st0 <= lt) {
#pragma unroll
                    for (int ks = 0; ks < 8; ++ks) { const bf16x8_t af = lfrag(lds + L_C, lt * 32 + r, ks * 16 + 8 * hh);
                        acc0 = __builtin_amdgcn_mfma_f32_32x32x16_bf16(af, lfrag(lds + L_B, st0 * 32 + r, ks * 16 + 8 * hh), acc0, 0, 0, 0);
                        if (st0 + 1 <= lt) acc1 = __builtin_amdgcn_mfma_f32_32x32x16_bf16(af, lfrag(lds + L_B, (st0 + 1) * 32 + r, ks * 16 + 8 * hh), acc1, 0, 0, 0); }
                }
            }
            __syncthreads();
            if (lat) {
#pragma unroll
                for (int t = 0; t < 2; ++t) { const int stt = st0 + t;
                    if (stt <= lt) { const int sidx = stt * 32 + r; const float cs = cumS[sidx], ds = dtS[sidx];
#pragma unroll
                        for (int q = 0; q < 16; ++q) { const int l = lt * 32 + (q & 3) + 8 * (q >> 2) + 4 * hh; const float v = t ? acc1[q] : acc0[q];
                            const float wv = sidx <= l ? v * __expf(cumS[l] - cs) * ds : 0.f;
                            *(LAS bf16*)(lds + L_B + l * SLD + sidx * 2) = (bf16)f2bf(wv); } } }
            }
            __syncthreads();
            if (lat) {
                const int pt = wave & 1;
                f32x16 accd, acco;
#pragma unroll
                for (int q = 0; q < 16; ++q) { accd[q] = 0.f; acco[q] = 0.f; }
                for (int ks = 0; ks < 2 * (lt + 1); ++ks)
                    accd = __builtin_amdgcn_mfma_f32_32x32x16_bf16(lfrag(lds + L_B, lt * 32 + r, ks * 16 + 8 * hh), lfrag(lds + L_XT, pt * 32 + r, ks * 16 + 8 * hh), accd, 0, 0, 0);
#pragma unroll
                for (int ks = 0; ks < 8; ++ks)
                    acco = __builtin_amdgcn_mfma_f32_32x32x16_bf16(lfrag(lds + L_C, lt * 32 + r, ks * 16 + 8 * hh), lfrag(lds + L_S, pt * 32 + r, ks * 16 + 8 * hh), acco, 0, 0, 0);
#pragma unroll
                for (int q = 0; q < 16; ++q) { const int l = lt * 32 + (q & 3) + 8 * (q >> 2) + 4 * hh; const float y = accd[q] + __expf(cumS[l]) * acco[q];
                    YS[((size_t)dir * MX + scan_row(n0 + l, dir, b)) * RW + h * 64 + pt * 32 + r] = (bf16)f2bf(y); }
            }
            const int pt2 = wave >> 2, nt = wave & 3;
            { const float dc = __expf(ctot);
#pragma unroll
              for (int q = 0; q < 16; ++q) st[q] *= dc;
#pragma unroll
              for (int ks = 0; ks < 8; ++ks)
                  st = __builtin_amdgcn_mfma_f32_32x32x16_bf16(lfrag(lds + L_XT, pt2 * 32 + r, ks * 16 + 8 * hh), lfrag(lds + L_BT, nt * 32 + r, ks * 16 + 8 * hh), st, 0, 0, 0); }
            __syncthreads();
#pragma unroll
            for (int q = 0; q < 16; ++q) { const int p = pt2 * 32 + (q & 3) + 8 * (q >> 2) + 4 * hh; *(LAS bf16*)(lds + L_S + p * SLD + (nt * 32 + r) * 2) = (bf16)f2bf(st[q]); }
            __syncthreads();
        }
    }
}

__device__ __forceinline__ void ph_finish(const Args& a) {
    const int lane = LANE;
    const bf16* R = (const bf16*)(a.ws + WS_R); const bf16* K = (const bf16*)(a.ws + WS_K); const bf16* V = (const bf16*)(a.ws + WS_V);
    const bf16* LR = (const bf16*)(a.ws + WS_LR); const bf16* XS = (const bf16*)(a.ws + WS_XS); const bf16* Z = (const bf16*)(a.ws + WS_Z);
    const bf16* OR = (const bf16*)a.out; const bf16* YS = (const bf16*)a.out + (size_t)2 * MX * RW;
    bf16* A2 = (bf16*)(a.ws + WS_A2);
    for (int m = GW; m < MX; m += NGW) {
#pragma unroll
        for (int i = 0; i < 4; ++i) {
            const int c0 = (lane + 64 * i) * 8;
            float of[8], ob[8], o[8], res[8];
#if MK_SKIP_RWKV
#pragma unroll
            for (int e = 0; e < 8; ++e) res[e] = 0.f;
#else
            unpack8(ld16(OR + (size_t)m * RW + c0), of); unpack8(ld16(OR + ((size_t)MX + m) * RW + c0), ob);
            float sm = 0.f;
#pragma unroll
            for (int e = 0; e < 8; ++e) { o[e] = of[e] + ob[e]; sm += o[e]; }
            sm = sum8(sm);
            const float mean = sm * (1.f / 64.f); float sq = 0.f;
#pragma unroll
            for (int e = 0; e < 8; ++e) { o[e] -= mean; sq += o[e] * o[e]; }
            sq = sum8(sq);
            const float rstd = rsqrtf(sq * (1.f / 64.f) + GN_EPS);
            float lw[8], lb[8], r[8], k[8], v[8], a0[8], a1[8], ka[8], rk[8], gg[8];
            ldf8(a.in[I_LNW] + c0, lw); ldf8(a.in[I_LNB] + c0, lb); ldf8(a.in[I_KA] + c0, ka); ldf8(a.in[I_RK] + c0, rk);
            unpack8(ld16(R + (size_t)m * RW + c0), r); unpack8(ld16(K + (size_t)m * RW + c0), k); unpack8(ld16(V + (size_t)m * RW + c0), v);
            unpack8(ld16(LR + (size_t)m * NLR + 4096 + c0), a0); unpack8(ld16(LR + (size_t)m * NLR + 6144 + c0), a1); unpack8(ld16(LR + (size_t)m * NLR + 8192 + c0), gg);
            float bs = 0.f;
#pragma unroll
            for (int e = 0; e < 8; ++e) { const float kd = k[e] * (2.f + (a0[e] + a1[e] - 2.f) * ka[e]); bs += r[e] * kd * rk[e]; }
            bs = sum8(bs);
#pragma unroll
            for (int e = 0; e < 8; ++e) res[e] = (o[e] * rstd * lw[e] + lb[e] + bs * v[e]) * gg[e];
#endif
            st16(A2 + (size_t)m * DM + c0, pack8(res));
        }
#pragma unroll
        for (int i = 0; i < 4; ++i) {
            const int c0 = (lane + 64 * i) * 8;
            float yf[8], yb[8], xs[8], z[8], nw[8], y[8];
#if MK_SKIP_SSD
#pragma unroll
            for (int e = 0; e < 8; ++e) y[e] = 0.f;
#else
            unpack8(ld16(YS + (size_t)m * RW + c0), yf); unpack8(ld16(YS + ((size_t)MX + m) * RW + c0), yb);
            unpack8(ld16(XS + (size_t)m * RW + c0), xs); unpack8(ld16(Z + (size_t)m * RW + c0), z); ldf8(a.in[I_NORMW] + c0, nw);
            const float dsk = a.in[I_SSMD][c0 >> 6]; float ss = 0.f;
#pragma unroll
            for (int e = 0; e < 8; ++e) { y[e] = (yf[e] + yb[e] + dsk * xs[e]) * (z[e] / (1.f + __expf(-z[e]))); ss += y[e] * y[e]; }
            ss = sum32(ss);
            const float rstd = rsqrtf(ss * (1.f / 256.f) + RMS_EPS);
#pragma unroll
            for (int e = 0; e < 8; ++e) y[e] = y[e] * rstd * nw[e];
#endif
            st16(A2 + (size_t)m * DM + 2048 + c0, pack8(y));
        }
    }
}

__device__ __forceinline__ float enc_key(float v, int idx) { return __uint_as_float((__float_as_uint(v) & 0xffffff00u) | (unsigned)idx); }
__device__ __forceinline__ void ldf16(const float* p, float (&f)[16]) {
    const float4 a = *(const float4*)p, b = *(const float4*)(p + 4), c = *(const float4*)(p + 8), d = *(const float4*)(p + 12);
    f[0] = a.x; f[1] = a.y; f[2] = a.z; f[3] = a.w; f[4] = b.x; f[5] = b.y; f[6] = b.z; f[7] = b.w; f[8] = c.x; f[9] = c.y; f[10] = c.z; f[11] = c.w; f[12] = d.x; f[13] = d.y; f[14] = d.z; f[15] = d.w;
}
typedef float f32x2 __attribute__((ext_vector_type(2)));
__device__ __forceinline__ void unpack_fp8x16(const uint4& q, float (&f)[16]) {
    const unsigned w[4] = {q.x, q.y, q.z, q.w};
#pragma unroll
    for (int i = 0; i < 4; ++i) { const f32x2 lo = __builtin_amdgcn_cvt_pk_f32_fp8((int)w[i], false), hi = __builtin_amdgcn_cvt_pk_f32_fp8((int)w[i], true);
        f[4 * i] = lo.x; f[4 * i + 1] = lo.y; f[4 * i + 2] = hi.x; f[4 * i + 3] = hi.y; }
}
#define PIN16(a) do { PIN8(a); PIN8((a) + 8); } while (0)
__device__ __forceinline__ void ph_peer(const Args& a) {
    const int lane = LANE;
    const float* mod = (const float*)(a.ws + WS_MOD); const float* S = (const float*)(a.ws + WS_S);
    const unsigned char* U8 = (const unsigned char*)(a.ws + WS_U8); const unsigned char* V8 = (const unsigned char*)(a.ws + WS_V8);
    const float* USC = (const float*)(a.ws + WS_USC); const float* VSC = (const float*)(a.ws + WS_VSC);
    for (int m = GW; m < MX; m += NGW) {
        const int bb = m / SEQ;
        float* hrow = a.out + (size_t)m * DM;
        int l16 = lane * 16; asm volatile("" : "+v"(l16));
        float acc[4][16];
#if MK_SKIP_PEER
#pragma unroll
        for (int j = 0; j < 4; ++j)
#pragma unroll
            for (int e = 0; e < 16; ++e) acc[j][e] = 0.f;
#else
        float xn[4][16];
        { float ss = 0.f; float hv[4][16];
#pragma unroll
          for (int j = 0; j < 4; ++j) { ldf16(hrow + 1024 * j + l16, hv[j]);
#pragma unroll
              for (int e = 0; e < 16; ++e) ss += hv[j][e] * hv[j][e]; }
          const float rstd = rsqrtf(wave_sum(ss) * (1.f / DM) + RMS_EPS);
          const float* sh2 = mod + (size_t)bb * NMOD + 3 * DM; const float* sc2 = mod + (size_t)bb * NMOD + 4 * DM; const float* g2 = a.in[I_N2G];
#pragma unroll
          for (int j = 0; j < 4; ++j) {
#pragma unroll
              for (int hf = 0; hf < 2; ++hf) { float gg[8], s0[8], s1[8]; const int c = 1024 * j + l16 + 8 * hf; ldf8(g2 + c, gg); ldf8(sh2 + c, s0); ldf8(sc2 + c, s1);
#pragma unroll
                  for (int e = 0; e < 8; ++e) xn[j][8 * hf + e] = hv[j][8 * hf + e] * rstd * gg[e] * (1.f + s1[e]) + s0[e];
                  PIN8(xn[j] + 8 * hf); asm volatile("" ::: "memory"); } } }
        int eid0 = 0, eid1 = 0; float gt0 = 0.f, gt1 = 0.f;
        const float NEG = -3.0e38f;
#pragma unroll 1
        for (int hd = 0; hd < 8; ++hd) {
            const float* srow = S + (size_t)m * 2048 + hd * 256;
            float c1a = enc_key(srow[lane], lane), c1b = enc_key(srow[64 + lane], 64 + lane), c2a = enc_key(srow[128 + lane], lane), c2b = enc_key(srow[192 + lane], 64 + lane);
            float t1 = NEG, t2 = NEG;
#pragma unroll 1
            for (int k = 0; k < 16; ++k) {
                const float m1 = wave_max(fmaxf(c1a, c1b)), m2 = wave_max(fmaxf(c2a, c2b));
                if (c1a == m1) c1a = NEG; if (c1b == m1) c1b = NEG; if (c2a == m2) c2a = NEG; if (c2b == m2) c2b = NEG;
                if (lane == k) { t1 = m1; t2 = m2; }
            }
            const float v1 = __uint_as_float(__float_as_uint(t1) & 0xffffff00u), v2 = __uint_as_float(__float_as_uint(t2) & 0xffffff00u);
            const int i1 = (int)(__float_as_uint(t1) & 0xffu), i2 = (int)(__float_as_uint(t2) & 0xffu);
            float cd[4];
#pragma unroll
            for (int e = 0; e < 4; ++e) { const float va = __shfl(v1, (lane >> 4) + 4 * e), vb = __shfl(v2, lane & 15); cd[e] = enc_key(va + vb, lane + 64 * e); }
            float best = NEG; int ex = 0;
#pragma unroll 1
            for (int k = 0; k < 16; ++k) {
                const float mx = wave_max(fmaxf(fmaxf(cd[0], cd[1]), fmaxf(cd[2], cd[3])));
#pragma unroll
                for (int e = 0; e < 4; ++e) if (cd[e] == mx) cd[e] = NEG;
                const int cidx = (int)(__float_as_uint(mx) & 0xffu);
                const int ea = __shfl(i1, cidx >> 4), eb = __shfl(i2, cidx & 15);
                if (lane == k) { best = __uint_as_float(__float_as_uint(mx) & 0xffffff00u); ex = ea * 128 + eb; }
            }
            const float bmax = __shfl(best, 0);
            const float pe = lane < 16 ? __expf(best - bmax) : 0.f;
            const float gate = pe / wave_sum(pe);
            const float gsh = __shfl(gate, lane & 15); const int esh = __shfl(ex, lane & 15);
            if ((lane >> 4) == (hd & 3)) { if (hd < 4) { gt0 = gsh; eid0 = esh; } else { gt1 = gsh; eid1 = esh; } }
        }
        float cf0 = 0.f, cf1 = 0.f;
#pragma unroll 1
        for (int p0 = 0; p0 < 128; p0 += 4) {
            float d[4]; uint4 qu[4][4];
#pragma unroll
            for (int q = 0; q < 4; ++q) {
                const int e = __builtin_amdgcn_readlane(p0 < 64 ? eid0 : eid1, (p0 + q) & 63);
                const unsigned char* urow = U8 + (size_t)e * DM + l16;
#pragma unroll
                for (int j = 0; j < 4; ++j) qu[q][j] = *(const uint4*)(urow + 1024 * j);
            }
#pragma unroll
            for (int q = 0; q < 4; ++q) {
                float dd = 0.f;
#pragma unroll
                for (int j = 0; j < 4; ++j) { float f[16]; unpack_fp8x16(qu[q][j], f);
#pragma unroll
                    for (int t = 0; t < 16; ++t) dd += xn[j][t] * f[t];
                    asm volatile("" : "+v"(dd)); }
                d[q] = dd;
            }
#pragma unroll
            for (int q = 0; q < 4; ++q) {
                const int p = p0 + q; const int e = __builtin_amdgcn_readlane(p0 < 64 ? eid0 : eid1, p & 63);
                const float dot = wave_sum(d[q]) * USC[e];
                const float act = 0.5f * dot * (1.f + erff(dot * 0.70710678f)) * VSC[e];
                if (lane == (p & 63)) { if (p0 < 64) cf0 = gt0 * act; else cf1 = gt1 * act; }
            }
        }
#pragma unroll
        for (int j = 0; j < 4; ++j)
#pragma unroll
            for (int e = 0; e < 16; ++e) acc[j][e] = 0.f;
#pragma unroll 1
        for (int p0 = 0; p0 < 128; p0 += 4) {
            uint4 qv[4][4]; float cfv[4];
#pragma unroll
            for (int q = 0; q < 4; ++q) {
                const int e = __builtin_amdgcn_readlane(p0 < 64 ? eid0 : eid1, (p0 + q) & 63);
                cfv[q] = rlane(p0 < 64 ? cf0 : cf1, (p0 + q) & 63);
                const unsigned char* vrow = V8 + (size_t)e * DM + l16;
#pragma unroll
                for (int j = 0; j < 4; ++j) qv[q][j] = *(const uint4*)(vrow + 1024 * j);
            }
#pragma unroll
            for (int q = 0; q < 4; ++q)
#pragma unroll
                for (int j = 0; j < 4; ++j) { float f[16]; unpack_fp8x16(qv[q][j], f);
#pragma unroll
                    for (int t = 0; t < 16; ++t) acc[j][t] += cfv[q] * f[t];
                    PIN16(acc[j]); }
        }
#endif
        { const float* gt2 = mod + (size_t)bb * NMOD + 5 * DM; float ss = 0.f;
#pragma unroll
          for (int j = 0; j < 4; ++j) {
#pragma unroll
              for (int hf = 0; hf < 2; ++hf) { float g[8], hvj[8]; const int c = 1024 * j + l16 + 8 * hf; ldf8(gt2 + c, g); ldf8(hrow + c, hvj);
#pragma unroll
                  for (int e = 0; e < 8; ++e) { acc[j][8 * hf + e] = hvj[e] + g[e] * acc[j][8 * hf + e]; ss += acc[j][8 * hf + e] * acc[j][8 * hf + e]; }
                  PIN8(acc[j] + 8 * hf); asm volatile("" ::: "memory"); } }
          const float rstd = rsqrtf(wave_sum(ss) * (1.f / DM) + RMS_EPS);
#pragma unroll
          for (int j = 0; j < 4; ++j) {
#pragma unroll
              for (int hf = 0; hf < 2; ++hf) { float fg[8]; const int c = 1024 * j + l16 + 8 * hf; ldf8(a.in[I_FG] + c, fg); const float* ac = acc[j] + 8 * hf;
                  *(float4*)(hrow + c) = make_float4(ac[0] * rstd * fg[0], ac[1] * rstd * fg[1], ac[2] * rstd * fg[2], ac[3] * rstd * fg[3]);
                  *(float4*)(hrow + c + 4) = make_float4(ac[4] * rstd * fg[4], ac[5] * rstd * fg[5], ac[6] * rstd * fg[6], ac[7] * rstd * fg[7]);
                  asm volatile("" ::: "memory"); } } }
    }
}

constexpr int N_PHASES = 13;
__global__ void __launch_bounds__(512, 2) hybrid_fwd(Args args) {
    extern __shared__ __attribute__((aligned(16))) unsigned char lds_raw[];
    LAS unsigned char* lds = (LAS unsigned char*)lds_raw;
    volatile LAS unsigned* MISC = (volatile LAS unsigned*)(lds + LDS_MISC);
    for (int u = TID; u < (LDS_BYTES - LDS_CTL) / 4; u += 512) ((LAS unsigned*)(lds + LDS_CTL))[u] = 0u;
    __syncthreads();
    const int lo = args.ph_lo, hi = args.ph_hi;
    XcdBarrier bar; bar.bar = (unsigned*)(args.ws + WS_CTL); bar.x = 0; bar.st = nullptr;
    if (hi - lo > 1) bar = xcd_barrier_post((unsigned*)(args.ws + WS_CTL), MISC + 8);
#define IN(k) (lo <= (k) && (k) < hi && ((MK_PHASE_MASK >> (k)) & 1))
#define SEAM(k) do { if (IN(k) && IN((k) + 1)) xcd_barrier(bar); } while (0)
    const int bid = (int)blockIdx.x, G = (int)gridDim.x;

    if (IN(0)) { ph_mod(args, lds); ph_conv(args, lds); if (MK_REPEAT == 0) { ph_mod(args, lds); ph_conv(args, lds); } }
    SEAM(0);
    if (IN(1)) { ph_norm1(args); if (MK_REPEAT == 1) ph_norm1(args); }
    SEAM(1);
    if (IN(2)) { pg8::Gemm g{(const bf16*)(args.ws + WS_A1), (const bf16*)(args.ws + WS_WT_IN), MT, NINP, DM}; pg8::StaticOrder S; S.init(MT, NINP, G, bid);
        pg8::EpiBf16<0> E{(bf16*)(args.ws + WS_P), NINP, nullptr, 0, 0}; pg8::gemm_phase<pg8::EpiBf16<0>, pg8::StaticOrder>(lds, g, S, E, nullptr); }
    SEAM(2);
    if (IN(3)) { ph_prep_rwkv(args); ph_prep_ssd(args); if (MK_REPEAT == 3) { ph_prep_rwkv(args); ph_prep_ssd(args); } }
    SEAM(3);
    if (IN(4)) { pg8::Gemm g{(const bf16*)(args.ws + WS_ALR), (const bf16*)(args.ws + WS_WLR), MT, NLR, KLR}; pg8::StaticOrder S; S.init(MT, NLR, G, bid);
        EpiLR E{(bf16*)(args.ws + WS_LR), args.in[I_W0], args.in[I_A0]}; pg8::gemm_phase<EpiLR, pg8::StaticOrder>(lds, g, S, E, nullptr); }
    SEAM(4);
#if MK_RWKV_SEQ
    if (IN(5)) { ph_rwkv_scan(args); if (MK_REPEAT == 5) ph_rwkv_scan(args); }
#else
    if (IN(5)) { ph_rwkv_scan2(args, lds); if (MK_REPEAT == 5) ph_rwkv_scan2(args, lds); }
#endif
    SEAM(5);
#if MK_SSD_SEQ
    if (IN(6)) { ph_ssd_scan(args); if (MK_REPEAT == 6) ph_ssd_scan(args); }
#else
    if (IN(6)) { ph_ssd_chunked(args, lds); if (MK_REPEAT == 6) ph_ssd_chunked(args, lds); }
#endif
    SEAM(6);
    if (IN(7)) { ph_finish(args); if (MK_REPEAT == 7) ph_finish(args); }
    SEAM(7);
    if (IN(8)) { pg8::Gemm g{(const bf16*)(args.ws + WS_A2), (const bf16*)(args.ws + WS_WT_OUT), MX, DM, DM}; pg8::StaticOrder S; S.init(MX, DM, G, bid);
        EpiRes E{args.out, args.in[I_X], (const float*)(args.ws + WS_MOD)}; pg8::gemm_phase<EpiRes, pg8::StaticOrder>(lds, g, S, E, nullptr); }
    SEAM(8);
    if (IN(9)) { ph_norm2(args); if (MK_REPEAT == 9) ph_norm2(args); }
    SEAM(9);
    if (IN(10)) { pg8::Gemm g{(const bf16*)(args.ws + WS_XN2), (const bf16*)(args.ws + WS_WT_Q), MX, 2048, DM}; pg8::StaticOrder S; S.init(MX, 2048, G, bid);
        pg8::EpiBf16<0> E{(bf16*)(args.ws + WS_Q), 2048, nullptr, 0, 0}; pg8::gemm_phase<pg8::EpiBf16<0>, pg8::StaticOrder>(lds, g, S, E, nullptr); }
    SEAM(10);
    if (IN(11)) { pg8::Gemm g{(const bf16*)(args.ws + WS_Q), (const bf16*)(args.ws + WS_KBD), MX, 2048, 2048}; pg8::StaticOrder S; S.init(MX, 2048, G, bid);
        pg8::EpiF32 E{(float*)(args.ws + WS_S), 2048, nullptr}; pg8::gemm_phase<pg8::EpiF32, pg8::StaticOrder>(lds, g, S, E, nullptr); }
    SEAM(11);
    if (IN(12)) ph_peer(args);
#undef IN
#undef SEAM
}

extern "C" void kernel_launch(void* const* d_in, const int* in_sizes, int n_in, void* d_out, int out_size, void* d_ws, size_t ws_size, hipStream_t stream) {
    static int grid = 0;
    if (grid == 0) {
        if (n_in != N_IN || out_size != MX * DM || ws_size < WS_END) { fprintf(stderr, "kernel_launch: unexpected shapes (n_in %d out %d ws %zu)\n", n_in, out_size, ws_size); grid = -1; return; }
        int dev = 0, cus = 0, per_cu = 0;
        if (hipGetDevice(&dev) != hipSuccess || hipDeviceGetAttribute(&cus, hipDeviceAttributeMultiprocessorCount, dev) != hipSuccess) { grid = -1; return; }
        if (hipFuncSetAttribute((const void*)hybrid_fwd, hipFuncAttributeMaxDynamicSharedMemorySize, LDS_BYTES) != hipSuccess) { fprintf(stderr, "kernel_launch: hipFuncSetAttribute failed\n"); grid = -1; return; }
        if (hipOccupancyMaxActiveBlocksPerMultiprocessor(&per_cu, (const void*)hybrid_fwd, 512, LDS_BYTES) != hipSuccess || per_cu < 1) fprintf(stderr, "kernel_launch: occupancy query reports %d\n", per_cu);
        (void)hipGetLastError();
        grid = cus;
    }
    if (grid < 0) return;
    (void)in_sizes;
    if (hipMemsetAsync((char*)d_ws + WS_CTL, 0, CTL_ZERO_BYTES, stream) != hipSuccess) return;
    Args a{};
    for (int i = 0; i < N_IN; ++i) a.in[i] = (const float*)d_in[i];
    a.out = (float*)d_out; a.ws = (unsigned char*)d_ws;
#if MK_N_LAUNCHES == 1
    a.ph_lo = 0; a.ph_hi = N_PHASES;
    hipLaunchKernelGGL(hybrid_fwd, dim3(grid), dim3(512), LDS_BYTES, stream, a);
#else
    for (int ph = 0; ph < N_PHASES; ++ph) { if (!((MK_PHASE_MASK >> ph) & 1)) continue; a.ph_lo = ph; a.ph_hi = ph + 1; hipLaunchKernelGGL(hybrid_fwd, dim3(grid), dim3(512), LDS_BYTES, stream, a); }
#endif
}
```

```cpp
#include <hip/hip_runtime.h>
#include <stdint.h>
#include <stdio.h>
namespace pg8 {
#define PG8_LAS __attribute__((address_space(3)))
typedef unsigned short bf16_t;
typedef short bf16x8 __attribute__((ext_vector_type(8)));
typedef float f32x4 __attribute__((ext_vector_type(4)));
typedef unsigned u32x4 __attribute__((ext_vector_type(4)));
constexpr int BM = 256, BK = 64, HALF = 128, HTB = HALF * BK * 2  , STAGE_BYTES = 8 * HTB, NXCD = 8, WGM = 8;

__host__ __device__ __forceinline__ int lds_byte(int r, int c) { const int st = (r >> 4) * 2 + (c >> 5), rr = r & 15, cc = c & 31, ob = rr * 64 + cc * 2; return st * 1024 + (ob ^ (((ob >> 9) & 1) << 5)); }
__host__ __device__ __forceinline__ void stage_rc(int b, int& R, int& C) { const int st = b / 1024, sb = b % 1024, swz = sb ^ (((sb >> 9) & 1) << 5); R = (st >> 1) * 16 + swz / 64; C = (st & 1) * 32 + (swz % 64) / 2; }
__host__ __device__ __forceinline__ int perm32(int rho) { const int n = rho >> 4, i = rho & 15; return 8 * (i >> 2) + 4 * n + (i & 3); }

struct Unit { int pm, pn; };
struct Gemm { const bf16_t* A; const bf16_t* Bt; int M, N, K; };

struct StaticOrder {
    int nM, nN, nwg, G, c;
    __host__ __device__ void init(int M, int N, int G_, int c_) { nM = M / BM; nN = N / BM; nwg = nM * nN; G = G_; c = c_; }
    __host__ __device__ bool next(int i, Unit& u) const {
        const long L = (long)i * G + c; if (L >= nwg) return false;
        int wgid = (int)L; { const int q = nwg / NXCD, r = nwg % NXCD, xcd = wgid % NXCD, off = wgid / NXCD; wgid = (xcd < r ? xcd * (q + 1) : r * (q + 1) + (xcd - r) * q) + off; }
        const int nig = WGM * nN, gid = wgid / nig, fm = gid * WGM, gsz = (nM - fm) < WGM ? (nM - fm) : WGM;
        u.pm = fm + ((wgid % nig) % gsz); u.pn = (wgid % nig) / gsz; return true;
    }
    __device__ __forceinline__ void a_ready(const Unit&) const {}
    __device__ __forceinline__ void done(const Unit&) const {}
};
__device__ __forceinline__ unsigned cvt_pk_bf16(float lo, float hi) { unsigned r; asm volatile("v_cvt_pk_bf16_f32 %0, %1, %2" : "=v"(r) : "v"(lo), "v"(hi)); return r; }
typedef float f32x2 __attribute__((ext_vector_type(2)));
__device__ __forceinline__ f32x2 gelu_pk(f32x2 v) {
    const f32x2 av = __builtin_elementwise_abs(v), d = av * 0.2316418882f + 1.0f;
    f32x2 t; t.x = __builtin_amdgcn_rcpf(d.x); t.y = __builtin_amdgcn_rcpf(d.y);
    f32x2 q = t * 0.5307027145f + (-0.7265760135f); q = q * t + 0.7107068705f; q = q * t + (-0.142248368f); q = q * t + 0.127414796f; q = q * t;
    const f32x2 s = (v * v) * (-0.72134752044f);
    f32x2 e; e.x = __builtin_amdgcn_exp2f(s.x); e.y = __builtin_amdgcn_exp2f(s.y);
    const f32x2 m = v * (q * e), r = v - m;
    f32x2 o; o.x = v.x < 0.f ? m.x : r.x; o.y = v.y < 0.f ? m.y : r.y; return o;
}

struct EpiF32 {
    static constexpr bool PERM = false, AFTER_DRAIN = false;
    float* C; int ldc; const float* bias;
    __device__ __forceinline__ void operator()(const f32x4 (&acc)[2][2][4][2], const Unit& u, int wr, int wc, int fr, int fq) const {
        const int row0 = u.pm * BM + wr * 64 + fr, col0 = u.pn * BM + wc * 32 + 4 * fq;
        f32x4 bv[2][2];
#pragma unroll
        for (int bj = 0; bj < 2; ++bj)
#pragma unroll
            for (int n = 0; n < 2; ++n) bv[bj][n] = bias ? *(const f32x4*)(bias + col0 + bj * HALF + n * 16) : (f32x4){0.f, 0.f, 0.f, 0.f};
#pragma unroll
        for (int ai = 0; ai < 2; ++ai)
#pragma unroll
            for (int m = 0; m < 4; ++m) { float* rowp = C + (size_t)(row0 + ai * HALF + m * 16) * ldc + col0;
#pragma unroll
                for (int bj = 0; bj < 2; ++bj)
#pragma unroll
                    for (int n = 0; n < 2; ++n) *(f32x4*)(rowp + bj * HALF + n * 16) = acc[ai][bj][m][n] + bv[bj][n]; }
    }
};
template <int ACT  > struct EpiBf16 {
    static constexpr bool PERM = true, AFTER_DRAIN = false;
    bf16_t* O; int ldc; const float* bias; int split_cols; size_t split_stride;
    __device__ __forceinline__ void operator()(const f32x4 (&acc)[2][2][4][2], const Unit& u, int wr, int wc, int fr, int fq) const {
        const int row0 = u.pm * BM + wr * 64 + fr; int colt = u.pn * BM; bf16_t* base = O;
        if (split_cols) { const int t = colt / split_cols; base += (size_t)t * split_stride; colt -= t * split_cols; }
        const int col0 = colt + wc * 32 + 8 * fq, bcol0 = u.pn * BM + wc * 32 + 8 * fq;
        f32x4 bv[2][2];
#pragma unroll
        for (int bj = 0; bj < 2; ++bj)
#pragma unroll
            for (int n = 0; n < 2; ++n) bv[bj][n] = bias ? *(const f32x4*)(bias + bcol0 + bj * HALF + 4 * n) : (f32x4){0.f, 0.f, 0.f, 0.f};
#pragma unroll
        for (int ai = 0; ai < 2; ++ai)
#pragma unroll
            for (int m = 0; m < 4; ++m) { bf16_t* rowp = base + (size_t)(row0 + ai * HALF + m * 16) * ldc + col0;
#pragma unroll
                for (int bj = 0; bj < 2; ++bj) { f32x4 v0 = acc[ai][bj][m][0] + bv[bj][0], v1 = acc[ai][bj][m][1] + bv[bj][1];
                    if (ACT == 1) { f32x2 a = gelu_pk((f32x2){v0[0], v0[1]}), b = gelu_pk((f32x2){v0[2], v0[3]}), c = gelu_pk((f32x2){v1[0], v1[1]}), d = gelu_pk((f32x2){v1[2], v1[3]});
                        v0 = (f32x4){a.x, a.y, b.x, b.y}; v1 = (f32x4){c.x, c.y, d.x, d.y}; }
                    if (ACT == 2) {
#pragma unroll
                        for (int j = 0; j < 4; ++j) { v0[j] = 0.5f * v0[j] * (1.0f + erff(v0[j] * 0.70710678f)); v1[j] = 0.5f * v1[j] * (1.0f + erff(v1[j] * 0.70710678f)); } }
                    u32x4 w; w.x = cvt_pk_bf16(v0[0], v0[1]); w.y = cvt_pk_bf16(v0[2], v0[3]); w.z = cvt_pk_bf16(v1[0], v1[1]); w.w = cvt_pk_bf16(v1[2], v1[3]);
                    *(u32x4*)(rowp + bj * HALF) = w; } }
    }
};
template <class Epi, class Sched, bool STAMP = false>
__device__ __forceinline__ void gemm_phase(PG8_LAS unsigned char* lds, const Gemm g, const Sched& S, const Epi& E, unsigned long long* stamps) {
    const int tid = threadIdx.x, wid = __builtin_amdgcn_readfirstlane(tid >> 6), lane = tid & 63, wr = wid >> 2, wc = wid & 3, fr = lane & 15, fq = lane >> 4;
    const int K = g.K, nt = K / BK;
    int ts_lo = 0, ts_hi = 0, nts = 0; const unsigned long long rt_entry = STAMP ? (unsigned long long)wall_clock64() : 0ull;
#define PG8_STAMP() do { if (STAMP && wid == 0 && nts < 64) { const unsigned long long _c = (unsigned long long)clock64(); \
        ts_lo = (lane == nts) ? (int)(unsigned)_c : ts_lo; ts_hi = (lane == nts) ? (int)(unsigned)(_c >> 32) : ts_hi; ++nts; } } while (0)
    PG8_STAMP();
    unsigned voffA[2], voffB[2];
#pragma unroll
    for (int i = 0; i < 2; ++i) { int R, C; stage_rc(tid * 16 + i * 8192, R, C); const int Rb = Epi::PERM ? ((R & ~31) + perm32(R & 31)) : R;
        voffA[i] = (unsigned)(R * K + C) * 2u; voffB[i] = (unsigned)(Rb * K + C) * 2u; }
    const size_t kstep = (size_t)(BK * 2);
    const size_t hstep = (size_t)HALF * K * 2;
    const size_t tstep = 2 * hstep;
    const unsigned ldsw = (unsigned)wid * 1024u;
    const int aoff = lds_byte(wr * 64 + fr, fq * 8), boff = lds_byte(wc * 32 + fr, fq * 8);
#define PG8_SA(b, h) (((b) * 2 + (h)) * HTB)
#define PG8_SB(b, h) ((4 + (b) * 2 + (h)) * HTB)
#define PG8_STAGE(bufoff, gbase, voff) do { _Pragma("unroll") for (int _i = 0; _i < 2; ++_i) \
        __builtin_amdgcn_global_load_lds((const unsigned*)((const char*)(gbase) + (voff)[_i]), (PG8_LAS unsigned*)(lds + (bufoff) + ldsw + _i * 8192), 16, 0, 0); } while (0)
#define PG8_LDA(dst, b, h) do { _Pragma("unroll") for (int m = 0; m < 4; ++m) _Pragma("unroll") for (int k = 0; k < 2; ++k) dst[m][k] = *(const PG8_LAS bf16x8*)(lds + PG8_SA(b, h) + aoff + m * 2048 + k * 1024); } while (0)
#define PG8_LDB(dst, b, h) do { _Pragma("unroll") for (int n = 0; n < 2; ++n) _Pragma("unroll") for (int k = 0; k < 2; ++k) dst[n][k] = *(const PG8_LAS bf16x8*)(lds + PG8_SB(b, h) + boff + n * 2048 + k * 1024); } while (0)
#define PG8_MMA(ai, bj, At, Bt) do { __builtin_amdgcn_s_setprio(1); _Pragma("unroll") for (int m = 0; m < 4; ++m) _Pragma("unroll") for (int n = 0; n < 2; ++n) _Pragma("unroll") for (int k = 0; k < 2; ++k) \
        acc[ai][bj][m][n] = __builtin_amdgcn_mfma_f32_16x16x32_bf16(Bt[n][k], At[m][k], acc[ai][bj][m][n], 0, 0, 0); __builtin_amdgcn_s_setprio(0); } while (0)
#define PG8_WAIT_V(n) asm volatile("s_waitcnt vmcnt(" #n ")" ::: "memory")
#define PG8_WAIT_L(n) asm volatile("s_waitcnt lgkmcnt(" #n ")" ::: "memory")
#define PG8_BAR __builtin_amdgcn_s_barrier()
#define PG8_SCHED __builtin_amdgcn_sched_barrier(0)
    Unit cur, nxt; int ui = 0;
    if (!S.next(0, cur)) return;
    f32x4 acc[2][2][4][2];
#pragma unroll
    for (int a = 0; a < 2; ++a)
#pragma unroll
        for (int b = 0; b < 2; ++b)
#pragma unroll
            for (int m = 0; m < 4; ++m)
#pragma unroll
                for (int n = 0; n < 2; ++n) acc[a][b][m][n] = (f32x4){0.f, 0.f, 0.f, 0.f};
    bf16x8 At[4][2], B0[2][2], B1[2][2];
    const char* cA = (const char*)g.A + (size_t)cur.pm * tstep; const char* cB = (const char*)g.Bt + (size_t)cur.pn * tstep;
    S.a_ready(cur);
    PG8_STAGE(PG8_SB(0, 0), cB, voffB); PG8_STAGE(PG8_SA(0, 0), cA, voffA); PG8_STAGE(PG8_SB(0, 1), cB + hstep, voffB); PG8_STAGE(PG8_SA(0, 1), cA + hstep, voffA);
    if (wr == 1) PG8_BAR;
    PG8_WAIT_V(4); PG8_BAR;
    PG8_STAGE(PG8_SB(1, 0), cB + kstep, voffB); PG8_STAGE(PG8_SA(1, 0), cA + kstep, voffA); PG8_STAGE(PG8_SB(1, 1), cB + hstep + kstep, voffB);
    PG8_WAIT_V(6); PG8_BAR;
    PG8_STAMP();
    for (;;) {
        const bool has_next = S.next(ui + 1, nxt);
        const char* nA = has_next ? (const char*)g.A + (size_t)nxt.pm * tstep : cA; const char* nB = has_next ? (const char*)g.Bt + (size_t)nxt.pn * tstep : cB;
        for (int t = 0; t < nt; t += 2) {
            const bool last = (t == nt - 2);
            const char* a1 = cA + (size_t)(t + 1) * kstep;
            const char* a2 = last ? nA : cA + (size_t)(t + 2) * kstep; const char* b2 = last ? nB : cB + (size_t)(t + 2) * kstep;
            const char* a3 = a2 + kstep; const char* b3 = b2 + kstep;
            if (last && has_next) S.a_ready(nxt);
            PG8_LDB(B0, 0, 0); PG8_SCHED; PG8_LDA(At, 0, 0); PG8_STAGE(PG8_SA(1, 1), a1 + hstep, voffA);
            PG8_WAIT_L(8); PG8_BAR; PG8_WAIT_L(0); PG8_MMA(0, 0, At, B0); PG8_BAR; PG8_SCHED;
            PG8_LDB(B1, 0, 1); PG8_STAGE(PG8_SB(0, 0), b2, voffB);
            PG8_BAR; PG8_WAIT_L(0); PG8_MMA(0, 1, At, B1); PG8_BAR;
            PG8_LDA(At, 0, 1); PG8_STAGE(PG8_SA(0, 0), a2, voffA);
            PG8_BAR; PG8_WAIT_L(0); PG8_MMA(1, 0, At, B0); PG8_BAR; PG8_SCHED;
            PG8_STAGE(PG8_SB(0, 1), b2 + hstep, voffB);
            PG8_WAIT_V(6); PG8_BAR; PG8_MMA(1, 1, At, B1); PG8_BAR;
            PG8_LDB(B0, 1, 0); PG8_SCHED; PG8_LDA(At, 1, 0); PG8_STAGE(PG8_SA(0, 1), a2 + hstep, voffA);
            PG8_WAIT_L(8); PG8_BAR; PG8_WAIT_L(0); PG8_MMA(0, 0, At, B0); PG8_BAR; PG8_SCHED;
            PG8_LDB(B1, 1, 1); PG8_STAGE(PG8_SB(1, 0), b3, voffB);
            PG8_BAR; PG8_WAIT_L(0); PG8_MMA(0, 1, At, B1); PG8_BAR;
            PG8_LDA(At, 1, 1); PG8_STAGE(PG8_SA(1, 0), a3, voffA);
            PG8_BAR; PG8_WAIT_L(0); PG8_MMA(1, 0, At, B0); PG8_BAR; PG8_SCHED;
            PG8_STAGE(PG8_SB(1, 1), b3 + hstep, voffB);
            PG8_WAIT_V(6); PG8_BAR; PG8_MMA(1, 1, At, B1); PG8_BAR;
        }
        PG8_STAMP();
        if constexpr (!Epi::AFTER_DRAIN) { E(acc, cur, wr, wc, fr, fq); S.done(cur); }
        PG8_STAMP();
        if (!has_next) break;
#pragma unroll
        for (int a = 0; a < 2; ++a)
#pragma unroll
            for (int b = 0; b < 2; ++b)
#pragma unroll
                for (int m = 0; m < 4; ++m)
#pragma unroll
                    for (int n = 0; n < 2; ++n) acc[a][b][m][n] = (f32x4){0.f, 0.f, 0.f, 0.f};
        cur = nxt; cA = nA; cB = nB; ++ui;
    }
    PG8_WAIT_V(0);
    if (wr == 0) PG8_BAR;
    PG8_BAR;
    if constexpr (Epi::AFTER_DRAIN) { E.fused(acc, cur, wr, wc, fr, fq, lds, wid, lane); S.done(cur); }
    PG8_STAMP();
    if (STAMP && wid == 0) { stamps[lane] = lane < nts ? (((unsigned long long)(unsigned)ts_hi << 32) | (unsigned)ts_lo) : 0ull;
        if (lane == 62) stamps[62] = rt_entry; if (lane == 63) stamps[63] = (unsigned long long)wall_clock64(); }
#undef PG8_STAMP
#undef PG8_SA
#undef PG8_SB
#undef PG8_STAGE
#undef PG8_LDA
#undef PG8_LDB
#undef PG8_MMA
#undef PG8_WAIT_V
#undef PG8_WAIT_L
#undef PG8_BAR
#undef PG8_SCHED
}
}

#define LAS __attribute__((address_space(3)))
typedef unsigned short bf16;
typedef float f32x4 __attribute__((ext_vector_type(4)));

#ifndef MK_N_LAUNCHES
#define MK_N_LAUNCHES 1
#endif
#ifndef MK_PHASE_MASK
#define MK_PHASE_MASK 0x1FFF
#endif
#ifndef MK_REPEAT
#define MK_REPEAT -1
#endif
#ifndef MK_RWKV_SEQ
#define MK_RWKV_SEQ 0
#endif
#ifndef MK_SSD_SEQ
#define MK_SSD_SEQ 0
#endif
#ifndef MK_SKIP_MIXER
#define MK_SKIP_MIXER 0
#endif
#ifndef MK_SKIP_PEER
#define MK_SKIP_PEER 0
#endif
#ifndef MK_SKIP_RWKV
#define MK_SKIP_RWKV 0
#endif
#ifndef MK_SKIP_SSD
#define MK_SKIP_SSD 0
#endif

constexpr int DM = 4096, NBATCH = 4, SEQ = 4096, CTXL = 256;
constexpr int MX = NBATCH * SEQ;
constexpr int MC = NBATCH * CTXL;
constexpr int MT = MX + MC;
constexpr int RW = 2048;
constexpr int RCOLS = 6784;
constexpr int NIN = 12992, NINP = 13056;
constexpr int COL_Z = 6784, COL_XBC = 8832, COL_DT = 12928;
constexpr int NLR = 10240, KLR = 640;
constexpr int NMOD = 6 * DM;
constexpr float RMS_EPS = 1e-6f, GN_EPS = 64e-5f;
constexpr int NSTEP = CTXL + SEQ;

constexpr size_t MiB = (size_t)1 << 20;
constexpr size_t WS_CTL = 0, CTL_ZERO_BYTES = 1 * MiB;
constexpr size_t WS_MOD = 64 * 1024;
constexpr size_t WS_WT_OUT = 2 * MiB;
constexpr size_t WS_WT_Q = 34 * MiB;
constexpr size_t WS_WLR = 50 * MiB;
constexpr size_t WS_KBD = 63 * MiB;
constexpr size_t WS_DT = 71 * MiB;
constexpr size_t WS_LA = WS_DT + (size_t)MT * 64 * 4;
constexpr size_t WS_ALR = 80 * MiB;
constexpr size_t WS_WT_IN = 102 * MiB;
constexpr size_t WS_A1 = 204 * MiB;
constexpr size_t WS_P = 340 * MiB;
constexpr size_t WS_R = 774 * MiB, WS_K = 842 * MiB, WS_V = 910 * MiB, WS_KK = 978 * MiB;
constexpr size_t WS_XS = 1046 * MiB, WS_BC = 1114 * MiB;
constexpr size_t WS_Z = 102 * MiB;
constexpr size_t WS_LR = 340 * MiB;
constexpr size_t WS_A2 = 166 * MiB;
constexpr size_t WS_XN2 = 340 * MiB;
constexpr size_t WS_Q = 468 * MiB;
constexpr size_t WS_S = 532 * MiB;
constexpr size_t WS_U8 = 774 * MiB, WS_V8 = 838 * MiB;
constexpr size_t WS_USC = 902 * MiB, WS_VSC = WS_USC + 65536;
constexpr size_t WS_END = 1182 * MiB;
static_assert(WS_WT_IN + (size_t)NINP * DM * 2 <= WS_A1 && WS_A1 + (size_t)MT * DM * 2 <= WS_P && WS_P + (size_t)MT * NINP * 2 <= WS_R, "ws map 1");
static_assert(WS_LR + (size_t)MT * NLR * 2 <= WS_R && WS_Z + (size_t)MX * RW * 2 <= WS_A2 && WS_A2 + (size_t)MX * DM * 2 <= WS_P, "ws map 2");
static_assert(WS_LA + (size_t)MT * 64 * 4 <= WS_ALR && WS_ALR + (size_t)MT * KLR * 2 <= WS_WT_IN && WS_WLR + (size_t)NLR * KLR * 2 <= WS_KBD, "ws map 3");
static_assert(WS_S + (size_t)MX * 2048 * 4 <= WS_R && WS_VSC + 65536 <= WS_XS, "ws map 4");

constexpr int LDS_BYTES = 147456;
constexpr int LDS_CTL = 143360;
constexpr int LDS_MISC = LDS_CTL + 320;

enum { I_X = 0, I_C, I_CTX, I_CCTX, I_WMOD, I_BMOD, I_N1G, I_N2G, I_WIN, I_WOUT, I_MU, I_W0, I_W2, I_A0, I_A2, I_G2, I_KK, I_KA, I_RK, I_LNW, I_LNB,
       I_CONVW, I_CONVB, I_DTB, I_ALOG, I_SSMD, I_NORMW, I_WQ, I_K1, I_K2, I_PU, I_PV, I_FG, N_IN };

struct Args { const float* in[N_IN]; float* out; unsigned char* ws; int ph_lo, ph_hi; };

__device__ __forceinline__ unsigned f2bf(float f) { unsigned u = __float_as_uint(f); return (u + 0x7fffu + ((u >> 16) & 1u)) >> 16; }
__device__ __forceinline__ unsigned pk2(float lo, float hi) { return f2bf(lo) | (f2bf(hi) << 16); }
__device__ __forceinline__ float bflo(unsigned u) { return __uint_as_float(u << 16); }
__device__ __forceinline__ float bfhi(unsigned u) { return __uint_as_float(u & 0xffff0000u); }
__device__ __forceinline__ void unpack8(const uint4& u, float (&f)[8]) {
    f[0] = bflo(u.x); f[1] = bfhi(u.x); f[2] = bflo(u.y); f[3] = bfhi(u.y); f[4] = bflo(u.z); f[5] = bfhi(u.z); f[6] = bflo(u.w); f[7] = bfhi(u.w);
}
__device__ __forceinline__ uint4 pack8(const float (&f)[8]) { uint4 u; u.x = pk2(f[0], f[1]); u.y = pk2(f[2], f[3]); u.z = pk2(f[4], f[5]); u.w = pk2(f[6], f[7]); return u; }
__device__ __forceinline__ uint4 ld16(const bf16* p) { return *(const uint4*)p; }
__device__ __forceinline__ void st16(bf16* p, const uint4& v) { *(uint4*)p = v; }
__device__ __forceinline__ void ldf8(const float* p, float (&f)[8]) { const float4 a = *(const float4*)p, b = *(const float4*)(p + 4); f[0] = a.x; f[1] = a.y; f[2] = a.z; f[3] = a.w; f[4] = b.x; f[5] = b.y; f[6] = b.z; f[7] = b.w; }
#define PIN8(a) asm volatile("" : "+v"((a)[0]), "+v"((a)[1]), "+v"((a)[2]), "+v"((a)[3]), "+v"((a)[4]), "+v"((a)[5]), "+v"((a)[6]), "+v"((a)[7]))
template <int CTRL> __device__ __forceinline__ float dppf(float v) { return __uint_as_float((unsigned)__builtin_amdgcn_update_dpp(0, (int)__float_as_uint(v), CTRL, 0xF, 0xF, true)); }
__device__ __forceinline__ float rlane(float v, int l) { return __uint_as_float((unsigned)__builtin_amdgcn_readlane((int)__float_as_uint(v), l)); }
__device__ __forceinline__ float sum8(float v) { v += dppf<0xB1>(v); v += dppf<0x4E>(v); v += dppf<0x141>(v); return v; }
__device__ __forceinline__ float sum16(float v) { v = sum8(v); v += dppf<0x140>(v); return v; }
__device__ __forceinline__ float sum32(float v) { v = sum16(v); v += __shfl_xor(v, 16); return v; }
__device__ __forceinline__ float wave_sum(float v) { v = sum16(v); return (rlane(v, 0) + rlane(v, 16)) + (rlane(v, 32) + rlane(v, 48)); }
__device__ __forceinline__ float wave_max(float v) {
    v = fmaxf(v, dppf<0xB1>(v)); v = fmaxf(v, dppf<0x4E>(v)); v = fmaxf(v, dppf<0x141>(v)); v = fmaxf(v, dppf<0x140>(v));
    return fmaxf(fmaxf(rlane(v, 0), rlane(v, 16)), fmaxf(rlane(v, 32), rlane(v, 48)));
}
__device__ __forceinline__ float sigmoidf_(float x) { return 1.f / (1.f + __expf(-x)); }
__device__ __forceinline__ float siluf_(float x) { return x / (1.f + __expf(-x)); }

struct EpiLR {
    static constexpr bool PERM = true, AFTER_DRAIN = false;
    bf16* O; const float* w0; const float* a0;
    __device__ __forceinline__ void operator()(const pg8::f32x4 (&acc)[2][2][4][2], const pg8::Unit& u, int wr, int wc, int fr, int fq) const {
        const int row0 = u.pm * 256 + wr * 64 + fr; const int colt = u.pn * 256; const int type = colt >> 11;
        const int col0 = colt + wc * 32 + 8 * fq;
        const float* bias = type < 2 ? (w0 + type * 2048) : (a0 + (type - 2) * 2048);
        pg8::f32x4 bv[2][2];
#pragma unroll
        for (int bj = 0; bj < 2; ++bj)
#pragma unroll
            for (int n = 0; n < 2; ++n) bv[bj][n] = type < 4 ? *(const pg8::f32x4*)(bias + ((col0 + bj * 128 + 4 * n) & 2047)) : (pg8::f32x4){0.f, 0.f, 0.f, 0.f};
#pragma unroll
        for (int ai = 0; ai < 2; ++ai)
#pragma unroll
            for (int m = 0; m < 4; ++m) { bf16* rowp = O + (size_t)(row0 + ai * 128 + m * 16) * NLR + col0;
#pragma unroll
                for (int bj = 0; bj < 2; ++bj) { pg8::f32x4 v0 = acc[ai][bj][m][0] + bv[bj][0], v1 = acc[ai][bj][m][1] + bv[bj][1];
                    if (type < 4) {
#pragma unroll
                        for (int j = 0; j < 4; ++j) { float s0 = 1.f / (1.f + __expf(-v0[j])), s1 = 1.f / (1.f + __expf(-v1[j]));
                            if (type < 2) { s0 = -expm1f(-0.60653066f * s0); s1 = -expm1f(-0.60653066f * s1); }
                            v0[j] = s0; v1[j] = s1; } }
                    pg8::u32x4 w; w.x = pg8::cvt_pk_bf16(v0[0], v0[1]); w.y = pg8::cvt_pk_bf16(v0[2], v0[3]); w.z = pg8::cvt_pk_bf16(v1[0], v1[1]); w.w = pg8::cvt_pk_bf16(v1[2], v1[3]);
                    *(pg8::u32x4*)(rowp + bj * 128) = w; } }
    }
};
struct EpiRes {
    static constexpr bool PERM = false, AFTER_DRAIN = false;
    float* C; const float* X; const float* mod;
    __device__ __forceinline__ void operator()(const pg8::f32x4 (&acc)[2][2][4][2], const pg8::Unit& u, int wr, int wc, int fr, int fq) const {
        const int row0 = u.pm * 256 + wr * 64 + fr, col0 = u.pn * 256 + wc * 32 + 4 * fq;
        const float* gt = mod + (size_t)((u.pm * 256) / SEQ) * NMOD + 2 * DM;
        pg8::f32x4 gv[2][2];
#pragma unroll
        for (int bj = 0; bj < 2; ++bj)
#pragma unroll
            for (int n = 0; n < 2; ++n) gv[bj][n] = *(const pg8::f32x4*)(gt + col0 + bj * 128 + n * 16);
#pragma unroll
        for (int ai = 0; ai < 2; ++ai)
#pragma unroll
            for (int m = 0; m < 4; ++m) { const size_t off = (size_t)(row0 + ai * 128 + m * 16) * DM + col0;
#pragma unroll
                for (int bj = 0; bj < 2; ++bj)
#pragma unroll
                    for (int n = 0; n < 2; ++n) { const pg8::f32x4 xv = *(const pg8::f32x4*)(X + off + bj * 128 + n * 16);
#if MK_SKIP_MIXER
                        *(pg8::f32x4*)(C + off + bj * 128 + n * 16) = xv;
#else
                        *(pg8::f32x4*)(C + off + bj * 128 + n * 16) = xv + gv[bj][n] * acc[ai][bj][m][n];
#endif
                    }
                asm volatile("" ::: "memory"); }
    }
};

#define XB_TMO      128
#define XB_XCNT(j)  (256  + 64 * (j))
#define XB_XSUB(j)  (1280 + 64 * (j))
#define XB_XGEN(j)  (2304 + 64 * (j))
#define XB_TOP      3328
#define XB_TOPGEN   3392
#define XCD_BAR_WORDS 3456
#define XB_SPIN_CAP (1u << 18)
__device__ __forceinline__ unsigned xb_ld(unsigned* p)              { return __hip_atomic_load(p, __ATOMIC_RELAXED, __HIP_MEMORY_SCOPE_AGENT); }
__device__ __forceinline__ unsigned xb_add(unsigned* p, unsigned v) { return __hip_atomic_fetch_add(p, v, __ATOMIC_RELAXED, __HIP_MEMORY_SCOPE_AGENT); }
__device__ __forceinline__ unsigned xb_xcc_id() { return (unsigned)__builtin_amdgcn_s_getreg((3 << 11) | 20) & 0xFu; }
#define XB_SPIN(cond, bar) do { unsigned _sp = 0; while (cond) { __builtin_amdgcn_s_sleep(1); \
    if ((++_sp & 255u) == 0u) { if (xb_ld(&(bar)[XB_TMO])) break; if (_sp > XB_SPIN_CAP) { atomicAdd(&(bar)[XB_TMO], 1u); break; } } } } while (0)
struct XcdBarrier { unsigned* bar; unsigned x; volatile LAS unsigned* st; };
__device__ __forceinline__ XcdBarrier xcd_barrier_post(unsigned* bar, volatile LAS unsigned* st) {
    XcdBarrier b; b.bar = bar; b.x = xb_xcc_id(); b.st = st;
    if (threadIdx.x == 0) (void)xb_add(&bar[XB_XCNT(b.x)], 1u);
    return b;
}
__device__ __forceinline__ void xcd_barrier_complete(unsigned* bar, unsigned x, unsigned& nloc, unsigned& nx) {
    const unsigned G = gridDim.x * gridDim.y * gridDim.z;
    unsigned sum, cnt, mine, sp = 0u;
    for (;;) {
        sum = 0u; cnt = 0u; mine = 0u;
#pragma unroll
        for (unsigned j = 0; j < 16; ++j) { const unsigned c = xb_ld(&bar[XB_XCNT(j)]); sum += c; cnt += (c > 0u) ? 1u : 0u; mine = (j == x) ? c : mine; }
        if (sum == G) break;
        __builtin_amdgcn_s_sleep(1);
        if ((++sp & 255u) == 0u) { if (xb_ld(&bar[XB_TMO])) break; if (sp > XB_SPIN_CAP) { atomicAdd(&bar[XB_TMO], 1u); break; } }
    }
    nloc = mine > 0u ? mine : 1u; nx = cnt > 0u ? cnt : 1u;
}
__device__ __forceinline__ void xcd_barrier(const XcdBarrier& b) {
    asm volatile("s_waitcnt vmcnt(0)" ::: "memory");
    __syncthreads();
    if (threadIdx.x == 0) {
        unsigned* bar = b.bar;
        __builtin_amdgcn_s_waitcnt(0);
        unsigned nloc = b.st[0], nx = b.st[1];
        if (nloc == 0u) { xcd_barrier_complete(bar, b.x, nloc, nx); b.st[0] = nloc; b.st[1] = nx; }
        const unsigned old = xb_add(&bar[XB_XSUB(b.x)], 1u);
        const unsigned gen = old / nloc;
        if (old + 1u == (gen + 1u) * nloc) {
            __builtin_amdgcn_fence(__ATOMIC_RELEASE, "agent");
            asm volatile("s_waitcnt vmcnt(0)" ::: "memory");
            const unsigned og = xb_add(&bar[XB_TOP], 1u);
            const unsigned tg = og / nx;
            if (og + 1u == (tg + 1u) * nx) xb_add(&bar[XB_TOPGEN], 1u);
            else XB_SPIN(xb_ld(&bar[XB_TOPGEN]) == tg, bar);
            __builtin_amdgcn_fence(__ATOMIC_ACQUIRE, "agent");
            xb_add(&bar[XB_XGEN(b.x)], 1u);
            asm volatile("s_waitcnt vmcnt(0)" ::: "memory");
        } else {
            XB_SPIN(xb_ld(&bar[XB_XGEN(b.x)]) == gen, bar);
            __builtin_amdgcn_fence(__ATOMIC_ACQUIRE, "agent");
            asm volatile("s_waitcnt vmcnt(0)" ::: "memory");
        }
    }
    __syncthreads();
}

#define TID ((int)threadIdx.x)
#define LANE ((int)(threadIdx.x & 63))
#define WAVE ((int)__builtin_amdgcn_readfirstlane((int)(threadIdx.x >> 6)))
#define GW ((int)blockIdx.x * 8 + WAVE)
#define NGW ((int)gridDim.x * 8)

__device__ __forceinline__ void ph_mod(const Args& a, LAS unsigned char* lds) {
    const float* c = a.in[I_C]; const float* cc = a.in[I_CCTX]; const float* w_mod = a.in[I_WMOD]; const float* b_mod = a.in[I_BMOD];
    float* mod = (float*)(a.ws + WS_MOD);
    LAS float* sS = (LAS float*)lds;
    LAS float* red = (LAS float*)(lds + 81920);
    const int tid = TID, lane = LANE, wave = WAVE;
    if ((int)blockIdx.x < 192) {
        for (int i = tid; i < 5 * DM; i += 512) { const int v = i >> 12, k = i & (DM - 1); const float xv = v < 4 ? c[v * DM + k] : cc[k]; sS[i] = xv / (1.f + expf(-xv)); }
    }
    __syncthreads();
    for (int u = blockIdx.x; u < 192; u += gridDim.x) {
        const int cl = lane & 31, kh = lane >> 5;
        float acc[5][4];
#pragma unroll
        for (int v = 0; v < 5; ++v)
#pragma unroll
            for (int e = 0; e < 4; ++e) acc[v][e] = 0.f;
        const float* wp = w_mod + (size_t)(wave * 512 + kh) * NMOD + u * 128 + cl * 4;
#pragma unroll 8
        for (int i = 0; i < 256; ++i) {
            const float4 w = *(const float4*)(wp + (size_t)(2 * i) * NMOD);
#pragma unroll
            for (int v = 0; v < 5; ++v) { const float s = sS[v * DM + wave * 512 + 2 * i + kh]; acc[v][0] += s * w.x; acc[v][1] += s * w.y; acc[v][2] += s * w.z; acc[v][3] += s * w.w; }
        }
#pragma unroll
        for (int v = 0; v < 5; ++v)
#pragma unroll
            for (int e = 0; e < 4; ++e) acc[v][e] += __shfl_xor(acc[v][e], 32);
        if (kh == 0) {
#pragma unroll
            for (int v = 0; v < 5; ++v) *(LAS f32x4*)(red + ((wave * 5 + v) * 128 + cl * 4)) = (f32x4){acc[v][0], acc[v][1], acc[v][2], acc[v][3]};
        }
        __syncthreads();
        for (int i = tid; i < 640; i += 512) { const int v = i >> 7, n = i & 127; float s = b_mod[u * 128 + n];
#pragma unroll
            for (int w = 0; w < 8; ++w) s += red[(w * 5 + v) * 128 + n];
            mod[v * NMOD + u * 128 + n] = s; }
        __syncthreads();
    }
    __syncthreads();
}

__device__ __forceinline__ void transpose_item(const float* W, int K, int N, bf16* WT, LAS float* scr, int item, int lane) {
    const int nblk = N / 32, kb = item / nblk, nb = item % nblk, k0 = 64 * kb, n0 = 32 * nb;
#pragma unroll 8
    for (int i = 0; i < 32; ++i) { const int kk = 2 * i + (lane >> 5); scr[kk * 33 + (lane & 31)] = W[(size_t)(k0 + kk) * N + n0 + (lane & 31)]; }
    asm volatile("s_waitcnt lgkmcnt(0)" ::: "memory");
    const int c = lane & 7;
#pragma unroll
    for (int j = 0; j < 4; ++j) { const int n = (lane >> 3) + 8 * j; const LAS float* s = scr + (8 * c) * 33 + n;
        uint4 o; o.x = pk2(s[0 * 33], s[1 * 33]); o.y = pk2(s[2 * 33], s[3 * 33]); o.z = pk2(s[4 * 33], s[5 * 33]); o.w = pk2(s[6 * 33], s[7 * 33]);
        *(uint4*)(WT + (size_t)(n0 + n) * K + k0 + 8 * c) = o; }
    asm volatile("s_waitcnt lgkmcnt(0)" ::: "memory");
}
__device__ __forceinline__ void ph_conv(const Args& a, LAS unsigned char* lds) {
    const int lane = LANE, wave = WAVE, gw = GW, ngw = NGW;
    LAS float* scr = (LAS float*)(lds + wave * 16384);
    bf16* wt_in = (bf16*)(a.ws + WS_WT_IN); bf16* wt_out = (bf16*)(a.ws + WS_WT_OUT); bf16* wt_q = (bf16*)(a.ws + WS_WT_Q);
    constexpr int IT_IN = (DM / 64) * (NIN / 32), IT_OUT = (DM / 64) * (DM / 32), IT_Q = (DM / 64) * (2048 / 32);
    for (int it = gw; it < IT_IN + IT_OUT + IT_Q; it += ngw) {
        int r = it;
        if (r < IT_IN) { transpose_item(a.in[I_WIN], DM, NIN, wt_in, scr, r, lane); continue; } r -= IT_IN;
        if (r < IT_OUT) { transpose_item(a.in[I_WOUT], DM, DM, wt_out, scr, r, lane); continue; } r -= IT_OUT;
        transpose_item(a.in[I_WQ], DM, 2048, wt_q, scr, r, lane);
    }
    const int gt = blockIdx.x * 512 + TID, ngt = gridDim.x * 512;
    for (int i = gt; i < (NINP - NIN) * DM / 8; i += ngt) *(uint4*)(wt_in + (size_t)NIN * DM + (size_t)i * 8) = make_uint4(0u, 0u, 0u, 0u);
    { bf16* wlr = (bf16*)(a.ws + WS_WLR); const float* w2 = a.in[I_W2]; const float* a2 = a.in[I_A2]; const float* g2 = a.in[I_G2];
      for (int i = gt; i < NLR * (KLR / 8); i += ngt) { const int n = i / (KLR / 8), k0 = (i % (KLR / 8)) * 8; const int type = n >> 11, cch = n & 2047;
          float f[8];
#pragma unroll
          for (int e = 0; e < 8; ++e) { const int k = k0 + e; float v = 0.f;
              if (type == 0) { if (k < 96) v = w2[(size_t)(0 * 96 + k) * RW + cch]; }
              else if (type == 1) { if (k >= 96 && k < 192) v = w2[(size_t)(1 * 96 + (k - 96)) * RW + cch]; }
              else if (type == 2) { if (k >= 192 && k < 288) v = a2[(size_t)(0 * 96 + (k - 192)) * RW + cch]; }
              else if (type == 3) { if (k >= 288 && k < 384) v = a2[(size_t)(1 * 96 + (k - 288)) * RW + cch]; }
              else { if (k >= 384) v = g2[(size_t)(k - 384) * RW + cch]; }
              f[e] = v; }
          st16(wlr + (size_t)n * KLR + k0, pack8(f)); } }
    { bf16* kbd = (bf16*)(a.ws + WS_KBD); const float* k1 = a.in[I_K1]; const float* k2 = a.in[I_K2];
      for (int i = gt; i < 2048 * 256; i += ngt) { const int n = i >> 8, k0 = (i & 255) * 8; float f[8];
          if ((n >> 7) == (k0 >> 7)) { const int h = n >> 8, s = (n >> 7) & 1, key = n & 127, d0 = k0 & 127; const float* src = (s ? k2 : k1) + ((size_t)(h * 128 + key) * 128 + d0); ldf8(src, f); }
          else {
#pragma unroll
              for (int e = 0; e < 8; ++e) f[e] = 0.f; }
          st16(kbd + (size_t)n * 2048 + k0, pack8(f)); } }
}

__device__ __forceinline__ void norm_mod_row(const float* src, const float* g, const float* sh, const float* sc, bf16* dst, int lane) {
    float4 v[16]; float ss = 0.f;
#pragma unroll
    for (int j = 0; j < 16; ++j) { v[j] = *(const float4*)(src + (lane + 64 * j) * 4); ss += (v[j].x * v[j].x + v[j].y * v[j].y) + (v[j].z * v[j].z + v[j].w * v[j].w); }
    const float rstd = rsqrtf(wave_sum(ss) * (1.f / DM) + RMS_EPS);
#pragma unroll
    for (int j = 0; j < 16; ++j) { const int c = (lane + 64 * j) * 4; const float4 gg = *(const float4*)(g + c), s1 = *(const float4*)(sc + c), s0 = *(const float4*)(sh + c);
        const float o0 = v[j].x * rstd * gg.x * (1.f + s1.x) + s0.x, o1 = v[j].y * rstd * gg.y * (1.f + s1.y) + s0.y, o2 = v[j].z * rstd * gg.z * (1.f + s1.z) + s0.z, o3 = v[j].w * rstd * gg.w * (1.f + s1.w) + s0.w;
        uint2 w; w.x = pk2(o0, o1); w.y = pk2(o2, o3); *(uint2*)(dst + c) = w; }
}
__device__ __forceinline__ void ph_norm1(const Args& a) {
    const int lane = LANE; const float* mod = (const float*)(a.ws + WS_MOD); bf16* A1 = (bf16*)(a.ws + WS_A1);
    for (int m = GW; m < MT; m += NGW) {
        const float* src = m < MX ? a.in[I_X] + (size_t)m * DM : a.in[I_CTX] + (size_t)(m - MX) * DM;
        const int v = m < MX ? m / SEQ : 4;
        norm_mod_row(src, a.in[I_N1G], mod + (size_t)v * NMOD, mod + (size_t)v * NMOD + DM, A1 + (size_t)m * DM, lane);
    }
}
__device__ __forceinline__ void ph_norm2(const Args& a) {
    const int lane = LANE; const float* mod = (const float*)(a.ws + WS_MOD); bf16* XN2 = (bf16*)(a.ws + WS_XN2);
    for (int m = GW; m < MX; m += NGW) {
        const int v = m / SEQ;
        norm_mod_row(a.out + (size_t)m * DM, a.in[I_N2G], mod + (size_t)v * NMOD + 3 * DM, mod + (size_t)v * NMOD + 4 * DM, XN2 + (size_t)m * DM, lane);
    }
    unsigned char* U8 = a.ws + WS_U8; unsigned char* V8 = a.ws + WS_V8; float* USC = (float*)(a.ws + WS_USC); float* VSC = (float*)(a.ws + WS_VSC);
    for (int row = GW; row < 2 * 16384; row += NGW) {
        const int tb = row >> 14, r = row & 16383;
        const float* src = (tb ? a.in[I_PV] : a.in[I_PU]) + (size_t)r * DM;
        float4 v[16]; float am = 0.f;
#pragma unroll
        for (int j = 0; j < 16; ++j) { v[j] = *(const float4*)(src + (lane + 64 * j) * 4); am = fmaxf(fmaxf(am, fmaxf(fabsf(v[j].x), fabsf(v[j].y))), fmaxf(fabsf(v[j].z), fabsf(v[j].w))); }
        am = wave_max(am);
        const float scale = am > 0.f ? am * (1.f / 7.5f) : 1.f, inv = 1.f / scale;
        unsigned char* dst = (tb ? V8 : U8) + (size_t)r * 3072 + lane * 48;
#pragma unroll
        for (int p = 0; p < 2; ++p) {
            unsigned long long w0 = 0ull, w1 = 0ull, w2 = 0ull;
#pragma unroll
            for (int k = 0; k < 32; ++k) {
                const float4 q = v[8 * p + (k >> 2)]; const float x = ((k & 3) == 0 ? q.x : (k & 3) == 1 ? q.y : (k & 3) == 2 ? q.z : q.w) * inv; const float ax = fabsf(x);
                float cf = ax < 2.f ? rintf(ax * 8.f) : (ax < 4.f ? rintf(ax * 4.f) + 8.f : rintf(ax * 2.f) + 16.f);
                cf = fminf(cf, 31.f);
                const unsigned long long code = (unsigned long long)((unsigned)cf | (x < 0.f ? 32u : 0u));
                const int pos = 6 * k, wd = pos >> 6, off = pos & 63;
                if (wd == 0) w0 |= code << off; else if (wd == 1) w1 |= code << off; else w2 |= code << off;
                if (off > 58) { if (wd == 0) w1 |= code >> (64 - off); else w2 |= code >> (64 - off); }
            }
            *(uint2*)(dst + 24 * p) = make_uint2((unsigned)w0, (unsigned)(w0 >> 32)); *(uint2*)(dst + 24 * p + 8) = make_uint2((unsigned)w1, (unsigned)(w1 >> 32)); *(uint2*)(dst + 24 * p + 16) = make_uint2((unsigned)w2, (unsigned)(w2 >> 32));
        }
        if (lane == 0) (tb ? VSC : USC)[r] = scale;
    }
}

__device__ __forceinline__ void ph_prep_rwkv(const Args& a) {
    const int lane = LANE;
    const bf16* P = (const bf16*)(a.ws + WS_P);
    bf16* R = (bf16*)(a.ws + WS_R); bf16* K = (bf16*)(a.ws + WS_K); bf16* V = (bf16*)(a.ws + WS_V); bf16* KK = (bf16*)(a.ws + WS_KK); bf16* ALR = (bf16*)(a.ws + WS_ALR);
    const float* mu = a.in[I_MU]; const float* k_k = a.in[I_KK];
    for (int m = GW; m < MT; m += NGW) {
        const bool lat = m < MX;
        bool h0, h1, h2 = false, h3 = false; size_t r0, r1, r2 = 0, r3 = 0;
        if (lat) { const int t = m & (SEQ - 1), row = t >> 6, col = t & 63; h0 = col > 0; h1 = col < 63; h2 = row > 0; h3 = row < 63; r0 = (size_t)(m - 1); r1 = (size_t)(m + 1); r2 = (size_t)(m - 64); r3 = (size_t)(m + 64); }
        else { const int t = (m - MX) & (CTXL - 1); h0 = t > 0; h1 = t < CTXL - 1; r0 = (size_t)(m - 1); r1 = (size_t)(m + 1); }
        const bf16* prow = P + (size_t)m * NINP;
#pragma unroll
        for (int i = 0; i < 14; ++i) {
            const int chunk = lane + 64 * i;
            if (chunk < RCOLS / 8) {
                const int c0 = chunk * 8;
                float own[8], n0[8], n1[8], sh[8], xm[8], muv[8];
                const uint4 z4 = make_uint4(0u, 0u, 0u, 0u);
                unpack8(ld16(prow + c0), own);
                unpack8(h0 ? ld16(P + r0 * NINP + c0) : z4, n0);
                unpack8(h1 ? ld16(P + r1 * NINP + c0) : z4, n1);
                if (lat) { float n2[8], n3[8];
                    unpack8(h2 ? ld16(P + r2 * NINP + c0) : z4, n2);
                    unpack8(h3 ? ld16(P + r3 * NINP + c0) : z4, n3);
#pragma unroll
                    for (int e = 0; e < 8; ++e) sh[e] = (e & 3) == 0 ? n0[e] : (e & 3) == 1 ? n1[e] : (e & 3) == 2 ? n2[e] : n3[e];
                } else {
#pragma unroll
                    for (int e = 0; e < 8; ++e) sh[e] = (e & 1) == 0 ? n0[e] : n1[e];
                }
                ldf8(mu + c0, muv);
#pragma unroll
                for (int e = 0; e < 8; ++e) xm[e] = own[e] + muv[e] * (sh[e] - own[e]);
                if (i < 4) st16(R + (size_t)m * RW + c0, pack8(xm));
                else if (i < 8) { const int cc = c0 - 2048; st16(K + (size_t)m * RW + cc, pack8(xm));
                    float kv[8], kkv[8]; ldf8(k_k + cc, kv); float ss = 0.f;
#pragma unroll
                    for (int e = 0; e < 8; ++e) { kkv[e] = xm[e] * kv[e]; ss += kkv[e] * kkv[e]; }
                    ss = sum8(ss);
                    const float inv = rsqrtf(fmaxf(ss, 1e-24f));
#pragma unroll
                    for (int e = 0; e < 8; ++e) kkv[e] *= inv;
                    st16(KK + (size_t)m * RW + cc, pack8(kkv)); }
                else if (i < 12) st16(V + (size_t)m * RW + (c0 - 4096), pack8(xm));
                else { const int j0 = c0 - 6144; float f[8];
#pragma unroll
                    for (int e = 0; e < 8; ++e) f[e] = j0 < 192 ? tanhf(xm[e]) : (j0 < 384 ? xm[e] : 1.f / (1.f + __expf(-xm[e])));
                    st16(ALR + (size_t)m * KLR + j0, pack8(f)); }
            }
        }
    }
}

__device__ __forceinline__ void ph_prep_ssd(const Args& a) {
    const int lane = LANE;
    const bf16* P = (const bf16*)(a.ws + WS_P);
    bf16* XS = (bf16*)(a.ws + WS_XS); bf16* BC = (bf16*)(a.ws + WS_BC); bf16* Z = (bf16*)(a.ws + WS_Z); float* DT = (float*)(a.ws + WS_DT); float* LA = (float*)(a.ws + WS_LA);
    const float* cw = a.in[I_CONVW]; const float* cb = a.in[I_CONVB];
    for (int m = GW; m < MT; m += NGW) {
        const bool lat = m < MX; bool hp, hn;
        if (lat) { const int t = m & (SEQ - 1); hp = t > 0; hn = t < SEQ - 1; } else { const int t = (m - MX) & (CTXL - 1); hp = t > 0; hn = t < CTXL - 1; }
        const bf16* prow = P + (size_t)m * NINP;
#pragma unroll
        for (int i = 0; i < 8; ++i) {
            const int c0 = (lane + 64 * i) * 8; const uint4 z4 = make_uint4(0u, 0u, 0u, 0u);
            float cur[8], pv[8], nx[8], w0[8], w1[8], w2[8], bb[8], y[8];
            unpack8(ld16(prow + COL_XBC + c0), cur);
            unpack8(hp ? ld16(prow - NINP + COL_XBC + c0) : z4, pv);
            unpack8(hn ? ld16(prow + NINP + COL_XBC + c0) : z4, nx);
            ldf8(cw + c0, w0); ldf8(cw + 4096 + c0, w1); ldf8(cw + 8192 + c0, w2); ldf8(cb + c0, bb);
#pragma unroll
            for (int e = 0; e < 8; ++e) { const float t = w0[e] * pv[e] + w1[e] * cur[e] + w2[e] * nx[e] + bb[e]; y[e] = t / (1.f + __expf(-t)); }
            if (i < 4) st16(XS + (size_t)m * RW + c0, pack8(y)); else st16(BC + (size_t)m * RW + (c0 - 2048), pack8(y));
        }
        { const float raw = __uint_as_float((unsigned)prow[COL_DT + lane] << 16) + a.in[I_DTB][lane];
          const float dtv = raw > 20.f ? raw : log1pf(expf(raw));
          DT[(size_t)m * 64 + lane] = dtv; LA[(size_t)m * 64 + lane] = -dtv * expf(a.in[I_ALOG][lane]); }
        if (lat) {
#pragma unroll
            for (int i = 0; i < 4; ++i) { const int c0 = (lane + 64 * i) * 8; st16(Z + (size_t)m * RW + c0, ld16(prow + COL_Z + c0)); }
        }
    }
}

__device__ __forceinline__ int scan_row(int n, int dir, int b) { return n < CTXL ? MX + b * CTXL + (dir ? CTXL - 1 - n : n) : b * SEQ + (dir ? NSTEP - 1 - n : n - CTXL); }

struct RIn { uint4 r, k, kk, w, a; unsigned v; };
__device__ __forceinline__ void rwkv_load(RIn& x, const bf16* R, const bf16* K, const bf16* V, const bf16* KK, const bf16* LR, int m, int ch, int chi, int dir) {
    x.r = ld16(R + (size_t)m * RW + ch); x.k = ld16(K + (size_t)m * RW + ch); x.kk = ld16(KK + (size_t)m * RW + ch);
    x.w = ld16(LR + (size_t)m * NLR + dir * 2048 + ch); x.a = ld16(LR + (size_t)m * NLR + 4096 + dir * 2048 + ch);
    x.v = V[(size_t)m * RW + chi];
}
__device__ __forceinline__ float rwkv_step(float (&S)[8], const RIn& x, const float (&ka)[8]) {
    float r[8], k[8], kk[8], w1[8], av[8];
    unpack8(x.r, r); unpack8(x.k, k); unpack8(x.kk, kk); unpack8(x.w, w1); unpack8(x.a, av);
    const float v = __uint_as_float(x.v << 16);
    float sa = 0.f;
#pragma unroll
    for (int e = 0; e < 8; ++e) sa -= S[e] * kk[e];
    sa = sum8(sa);
    float o = 0.f;
#pragma unroll
    for (int e = 0; e < 8; ++e) { const float kd = k[e] * (1.f + (av[e] - 1.f) * ka[e]); const float b = kk[e] * av[e];
        S[e] = S[e] * (1.f - w1[e]) + sa * b + v * kd; o += S[e] * r[e]; }
    o = sum8(o);
    return o;
}
__device__ __forceinline__ void ph_rwkv_scan(const Args& a) {
    const int lane = LANE, wave = WAVE;
    const bf16* R = (const bf16*)(a.ws + WS_R); const bf16* K = (const bf16*)(a.ws + WS_K); const bf16* V = (const bf16*)(a.ws + WS_V); const bf16* KK = (const bf16*)(a.ws + WS_KK);
    const bf16* LR = (const bf16*)(a.ws + WS_LR); bf16* OR = (bf16*)a.out;
    for (int u = blockIdx.x; u < 256; u += gridDim.x) {
        const int g = u >> 5, h = u & 31, dir = g >> 2, b = g & 3;
        const int i = wave * 8 + (lane >> 3), jb = lane & 7, ch = h * 64 + jb * 8, chi = h * 64 + i;
        float ka[8]; ldf8(a.in[I_KA] + ch, ka);
        float S[8];
#pragma unroll
        for (int e = 0; e < 8; ++e) S[e] = 0.f;
        RIn A[4], B[4];
#pragma unroll
        for (int s = 0; s < 4; ++s) rwkv_load(A[s], R, K, V, KK, LR, scan_row(s, dir, b), ch, chi, dir);
        for (int n0 = 0; n0 < NSTEP; n0 += 8) {
#pragma unroll
            for (int s = 0; s < 4; ++s) rwkv_load(B[s], R, K, V, KK, LR, scan_row(n0 + 4 + s, dir, b), ch, chi, dir);
#pragma unroll
            for (int s = 0; s < 4; ++s) { const int n = n0 + s; const float o = rwkv_step(S, A[s], ka);
                if (n >= CTXL && jb == 0) OR[((size_t)dir * MX + scan_row(n, dir, b)) * RW + chi] = (bf16)f2bf(o); }
            if (n0 + 8 < NSTEP) {
#pragma unroll
                for (int s = 0; s < 4; ++s) rwkv_load(A[s], R, K, V, KK, LR, scan_row(n0 + 8 + s, dir, b), ch, chi, dir);
            }
#pragma unroll
            for (int s = 0; s < 4; ++s) { const int n = n0 + 4 + s; const float o = rwkv_step(S, B[s], ka);
                if (n >= CTXL && jb == 0) OR[((size_t)dir * MX + scan_row(n, dir, b)) * RW + chi] = (bf16)f2bf(o); }
        }
    }
}

typedef float f32x2_t __attribute__((ext_vector_type(2)));
constexpr int RS_TS = 32, RS_STEP_B = 6 * 256, RS_BUF_B = RS_TS * RS_STEP_B;
constexpr int RS_OBUF = 2 * RS_BUF_B, RS_OBUF_B = RS_TS * 64 * 2;
constexpr int RS_DUMP = RS_OBUF + 2 * RS_OBUF_B;
static_assert(RS_DUMP + 2048 <= 131072, "rwkv scan lds map");
struct RRaw { uint2 r, k, kk, v, w, a; };
__device__ __forceinline__ void rs_load(RRaw& x, const bf16* R, const bf16* K, const bf16* V, const bf16* KK, const bf16* LR, int m, int ch, int dir) {
    x.r = *(const uint2*)(R + (size_t)m * RW + ch); x.k = *(const uint2*)(K + (size_t)m * RW + ch); x.kk = *(const uint2*)(KK + (size_t)m * RW + ch); x.v = *(const uint2*)(V + (size_t)m * RW + ch);
    x.w = *(const uint2*)(LR + (size_t)m * NLR + dir * 2048 + ch); x.a = *(const uint2*)(LR + (size_t)m * NLR + 4096 + dir * 2048 + ch);
}
__device__ __forceinline__ void rs_stage(const RRaw& x, const float (&ka)[4], LAS unsigned char* dst) {
    const float r[4] = {bflo(x.r.x), bfhi(x.r.x), bflo(x.r.y), bfhi(x.r.y)}, k[4] = {bflo(x.k.x), bfhi(x.k.x), bflo(x.k.y), bfhi(x.k.y)};
    const float kk[4] = {bflo(x.kk.x), bfhi(x.kk.x), bflo(x.kk.y), bfhi(x.kk.y)}, v[4] = {bflo(x.v.x), bfhi(x.v.x), bflo(x.v.y), bfhi(x.v.y)};
    const float w1[4] = {bflo(x.w.x), bfhi(x.w.x), bflo(x.w.y), bfhi(x.w.y)}, av[4] = {bflo(x.a.x), bfhi(x.a.x), bflo(x.a.y), bfhi(x.a.y)};
    f32x4 nkk, w, b, kd, rr, vv;
#pragma unroll
    for (int e = 0; e < 4; ++e) { nkk[e] = -kk[e]; w[e] = 1.f - w1[e]; b[e] = kk[e] * av[e]; kd[e] = k[e] * (1.f + (av[e] - 1.f) * ka[e]); rr[e] = r[e]; vv[e] = v[e]; }
    *(LAS f32x4*)(dst) = nkk; *(LAS f32x4*)(dst + 256) = w; *(LAS f32x4*)(dst + 512) = b; *(LAS f32x4*)(dst + 768) = kd; *(LAS f32x4*)(dst + 1024) = rr; *(LAS f32x4*)(dst + 1280) = vv;
}
__device__ __forceinline__ float amul(float a, float b) { float d; asm("v_mul_f32 %0, %1, %2" : "=v"(d) : "v"(a), "v"(b)); return d; }
__device__ __forceinline__ void afmac(float& d, float a, float b) { asm("v_fmac_f32 %0, %1, %2" : "+v"(d) : "v"(a), "v"(b)); }
__device__ __forceinline__ float afma(float a, float b, float c) { float d; asm("v_fma_f32 %0, %1, %2, %3" : "=v"(d) : "v"(a), "v"(b), "v"(c)); return d; }
__device__ __forceinline__ void sum16x2(float& a, float& b) {
    asm("s_nop 1\n\t"
        "v_add_f32_dpp %0, %0, %0 quad_perm:[1,0,3,2] row_mask:0xf bank_mask:0xf bound_ctrl:1\n\t"
        "v_add_f32_dpp %1, %1, %1 quad_perm:[1,0,3,2] row_mask:0xf bank_mask:0xf bound_ctrl:1\n\t"
        "s_nop 0\n\t"
        "v_add_f32_dpp %0, %0, %0 quad_perm:[2,3,0,1] row_mask:0xf bank_mask:0xf bound_ctrl:1\n\t"
        "v_add_f32_dpp %1, %1, %1 quad_perm:[2,3,0,1] row_mask:0xf bank_mask:0xf bound_ctrl:1\n\t"
        "s_nop 0\n\t"
        "v_add_f32_dpp %0, %0, %0 row_half_mirror row_mask:0xf bank_mask:0xf bound_ctrl:1\n\t"
        "v_add_f32_dpp %1, %1, %1 row_half_mirror row_mask:0xf bank_mask:0xf bound_ctrl:1\n\t"
        "s_nop 0\n\t"
        "v_add_f32_dpp %0, %0, %0 row_mirror row_mask:0xf bank_mask:0xf bound_ctrl:1\n\t"
        "v_add_f32_dpp %1, %1, %1 row_mirror row_mask:0xf bank_mask:0xf bound_ctrl:1"
        : "+v"(a), "+v"(b));
}
template <bool OUT> __device__ __forceinline__ void rs_chunk(float (&S)[2][4], const LAS unsigned char* buf, LAS unsigned char* obuf, LAS unsigned char* dump, int j0, int i0, int jb) {
#pragma unroll 4
    for (int s = 0; s < RS_TS; ++s) {
        const LAS unsigned char* base = buf + s * RS_STEP_B;
        const f32x4 nkk = *(const LAS f32x4*)(base + j0 * 4), w = *(const LAS f32x4*)(base + 256 + j0 * 4), b = *(const LAS f32x4*)(base + 512 + j0 * 4), kd = *(const LAS f32x4*)(base + 768 + j0 * 4);
        const f32x2_t v = *(const LAS f32x2_t*)(base + 1280 + i0 * 4);
        float sa0 = amul(S[0][0], nkk[0]), sa1 = amul(S[1][0], nkk[0]);
#pragma unroll
        for (int e = 1; e < 4; ++e) { afmac(sa0, S[0][e], nkk[e]); afmac(sa1, S[1][e], nkk[e]); }
        sum16x2(sa0, sa1);
#pragma unroll
        for (int e = 0; e < 4; ++e) { float t0 = amul(sa0, b[e]), t1 = amul(sa1, b[e]); afmac(t0, v[0], kd[e]); afmac(t1, v[1], kd[e]); S[0][e] = afma(S[0][e], w[e], t0); S[1][e] = afma(S[1][e], w[e], t1); }
        if (OUT) {
            const f32x4 r = *(const LAS f32x4*)(base + 1024 + j0 * 4);
            float o0 = amul(S[0][0], r[0]), o1 = amul(S[1][0], r[0]);
#pragma unroll
            for (int e = 1; e < 4; ++e) { afmac(o0, S[0][e], r[e]); afmac(o1, S[1][e], r[e]); }
            sum16x2(o0, o1);
            *(LAS unsigned*)(jb == 0 ? obuf + (s * 64 + i0) * 2 : dump) = pg8::cvt_pk_bf16(o0, o1);
        }
    }
}
__device__ __forceinline__ void ph_rwkv_scan2(const Args& a, LAS unsigned char* lds) {
    const int tid = TID, lane = LANE, wave = WAVE;
    const bf16* R = (const bf16*)(a.ws + WS_R); const bf16* K = (const bf16*)(a.ws + WS_K); const bf16* V = (const bf16*)(a.ws + WS_V); const bf16* KK = (const bf16*)(a.ws + WS_KK);
    const bf16* LR = (const bf16*)(a.ws + WS_LR); bf16* OR = (bf16*)a.out;
    constexpr int NCH = NSTEP / RS_TS;
    for (int u = blockIdx.x; u < 256; u += gridDim.x) {
        const int g = u >> 5, h = u & 31, dir = g >> 2, b = g & 3;
        const int ip = lane >> 4, jb = lane & 15, i0 = wave * 8 + ip * 2, j0 = jb * 4;
        const int ss = tid >> 4, cgp = tid & 15, ch = h * 64 + cgp * 4;
        float ka[4];
#pragma unroll
        for (int e = 0; e < 4; ++e) ka[e] = a.in[I_KA][ch + e];
        float S[2][4];
#pragma unroll
        for (int e = 0; e < 4; ++e) { S[0][e] = 0.f; S[1][e] = 0.f; }
        RRaw raw;
        __syncthreads();
        rs_load(raw, R, K, V, KK, LR, scan_row(ss, dir, b), ch, dir);
        rs_stage(raw, ka, lds + ss * RS_STEP_B + cgp * 16);
        __syncthreads();
        for (int c = 0; c < NCH; ++c) {
            LAS unsigned char* buf = lds + (c & 1) * RS_BUF_B; LAS unsigned char* nbuf = lds + ((c + 1) & 1) * RS_BUF_B; LAS unsigned char* obuf = lds + RS_OBUF + (c & 1) * RS_OBUF_B;
            const bool more = c + 1 < NCH;
            if (more) rs_load(raw, R, K, V, KK, LR, scan_row((c + 1) * RS_TS + ss, dir, b), ch, dir);
            const bool lat = c >= CTXL / RS_TS;
            if (lat) rs_chunk<true>(S, buf, obuf, lds + RS_DUMP + tid * 4, j0, i0, jb); else rs_chunk<false>(S, buf, obuf, lds + RS_DUMP + tid * 4, j0, i0, jb);
            if (more) rs_stage(raw, ka, nbuf + ss * RS_STEP_B + cgp * 16);
            __syncthreads();
            if (lat) { typedef unsigned u32x2_t __attribute__((ext_vector_type(2))); const u32x2_t ov = *(const LAS u32x2_t*)(obuf + (ss * 64 + cgp * 4) * 2);
                *(uint2*)(OR + ((size_t)dir * MX + scan_row(c * RS_TS + ss, dir, b)) * RW + ch) = make_uint2(ov[0], ov[1]); }
        }
    }
}

struct SIn { uint4 b0, b1, c0, c1; unsigned xs; float dt, la; };
__device__ __forceinline__ void ssd_load(SIn& x, const bf16* XS, const bf16* BC, const float* DT, const float* LA, int m, int chx, int cb, int dh) {
    x.b0 = ld16(BC + (size_t)m * RW + cb); x.b1 = ld16(BC + (size_t)m * RW + cb + 8); x.c0 = ld16(BC + (size_t)m * RW + 1024 + cb); x.c1 = ld16(BC + (size_t)m * RW + 1024 + cb + 8);
    x.xs = XS[(size_t)m * RW + chx]; x.dt = DT[(size_t)m * 64 + dh]; x.la = LA[(size_t)m * 64 + dh];
}
__device__ __forceinline__ float ssd_step(float (&s)[16], const SIn& x) {
    float B0[8], B1[8], C0[8], C1[8]; unpack8(x.b0, B0); unpack8(x.b1, B1); unpack8(x.c0, C0); unpack8(x.c1, C1);
    const float dec = __expf(x.la), xdt = __uint_as_float(x.xs << 16) * x.dt; float y = 0.f;
#pragma unroll
    for (int e = 0; e < 8; ++e) { s[e] = dec * s[e] + xdt * B0[e]; y += s[e] * C0[e]; s[8 + e] = dec * s[8 + e] + xdt * B1[e]; y += s[8 + e] * C1[e]; }
    y = sum8(y);
    return y;
}
__device__ __forceinline__ void ph_ssd_scan(const Args& a) {
    const int lane = LANE, wave = WAVE;
    const bf16* XS = (const bf16*)(a.ws + WS_XS); const bf16* BC = (const bf16*)(a.ws + WS_BC); const float* DT = (const float*)(a.ws + WS_DT); const float* LA = (const float*)(a.ws + WS_LA);
    bf16* YS = (bf16*)a.out + (size_t)2 * MX * RW;
    for (int u = blockIdx.x; u < 256; u += gridDim.x) {
        const int g = u >> 5, h = u & 31, dir = g >> 2, b = g & 3;
        const int p = wave * 8 + (lane >> 3), nb = lane & 7, chx = h * 64 + p, cb = (h >> 2) * 128 + nb * 16, dh = dir * 32 + h;
        float s[16];
#pragma unroll
        for (int e = 0; e < 16; ++e) s[e] = 0.f;
        SIn A[4], B[4];
#pragma unroll
        for (int q = 0; q < 4; ++q) ssd_load(A[q], XS, BC, DT, LA, scan_row(q, dir, b), chx, cb, dh);
        for (int n0 = 0; n0 < NSTEP; n0 += 8) {
#pragma unroll
            for (int q = 0; q < 4; ++q) ssd_load(B[q], XS, BC, DT, LA, scan_row(n0 + 4 + q, dir, b), chx, cb, dh);
#pragma unroll
            for (int q = 0; q < 4; ++q) { const int n = n0 + q; const float y = ssd_step(s, A[q]);
                if (n >= CTXL && nb == 0) YS[((size_t)dir * MX + scan_row(n, dir, b)) * RW + chx] = (bf16)f2bf(y); }
            if (n0 + 8 < NSTEP) {
#pragma unroll
                for (int q = 0; q < 4; ++q) ssd_load(A[q], XS, BC, DT, LA, scan_row(n0 + 8 + q, dir, b), chx, cb, dh);
            }
#pragma unroll
            for (int q = 0; q < 4; ++q) { const int n = n0 + 4 + q; const float y = ssd_step(s, B[q]);
                if (n >= CTXL && nb == 0) YS[((size_t)dir * MX + scan_row(n, dir, b)) * RW + chx] = (bf16)f2bf(y); }
        }
    }
}

typedef short bf16x8_t __attribute__((ext_vector_type(8)));
typedef float f32x16 __attribute__((ext_vector_type(16)));
constexpr int SLD = 272;
constexpr int L_C = 0, L_B = 34816, L_BT = 69632, L_XT = 104448, L_S = 121856, L_F = 139264;
static_assert(L_F + 4 * 512 <= LDS_CTL, "ssd lds map");
typedef unsigned u32x4_t __attribute__((ext_vector_type(4)));
__device__ __forceinline__ void lds_st16(LAS unsigned char* p, const uint4& v) { *(LAS u32x4_t*)p = (u32x4_t){v.x, v.y, v.z, v.w}; }
__device__ __forceinline__ uint4 lds_ld16(const LAS unsigned char* p) { const u32x4_t t = *(const LAS u32x4_t*)p; return make_uint4(t[0], t[1], t[2], t[3]); }
__device__ __forceinline__ bf16x8_t lfrag(LAS unsigned char* img, int row, int k) { return *(LAS bf16x8_t*)(img + row * SLD + k * 2); }
__device__ __forceinline__ void ph_ssd_chunked(const Args& a, LAS unsigned char* lds) {
    const int tid = TID, lane = LANE, wave = WAVE, r = lane & 31, hh = lane >> 5;
    const bf16* XS = (const bf16*)(a.ws + WS_XS); const bf16* BC = (const bf16*)(a.ws + WS_BC); const float* DT = (const float*)(a.ws + WS_DT); const float* LA = (const float*)(a.ws + WS_LA);
    bf16* YS = (bf16*)a.out + (size_t)2 * MX * RW;
    LAS float* laS = (LAS float*)(lds + L_F); LAS float* dtS = laS + 128; LAS float* cumS = laS + 256;
    for (int u = blockIdx.x; u < 256; u += gridDim.x) {
        const int g = u >> 5, h = u & 31, dir = g >> 2, b = g & 3, gi = h >> 2;
        f32x16 st;
#pragma unroll
        for (int q = 0; q < 16; ++q) st[q] = 0.f;
        __syncthreads();
        for (int i = tid; i < 64 * SLD / 4; i += 512) ((LAS unsigned*)(lds + L_S))[i] = 0u;
        for (int c = 0; c < NSTEP / 128; ++c) {
            const int n0 = c * 128; const bool lat = c >= CTXL / 128;
            for (int i = tid; i < 2048; i += 512) { const int l = i >> 4, pc = i & 15; const size_t m = (size_t)scan_row(n0 + l, dir, b);
                lds_st16(lds + L_B + l * SLD + pc * 16, ld16(BC + m * RW + gi * 128 + pc * 8));
                if (lat) lds_st16(lds + L_C + l * SLD + pc * 16, ld16(BC + m * RW + 1024 + gi * 128 + pc * 8)); }
            for (int i = tid; i < 1024; i += 512) { const int l = i >> 3, pc = i & 7; const size_t m = (size_t)scan_row(n0 + l, dir, b);
                const uint4 v = ld16(XS + m * RW + h * 64 + pc * 8); const unsigned w[4] = {v.x, v.y, v.z, v.w};
#pragma unroll
                for (int e = 0; e < 8; ++e) *(LAS bf16*)(lds + L_XT + (pc * 8 + e) * SLD + l * 2) = (bf16)((e & 1) ? (w[e >> 1] >> 16) : (w[e >> 1] & 0xffffu)); }
            if (tid < 128) { const size_t m = (size_t)scan_row(n0 + tid, dir, b); laS[tid] = LA[m * 64 + dir * 32 + h]; dtS[tid] = DT[m * 64 + dir * 32 + h]; }
            __syncthreads();
            if (wave == 0) { const float a0 = laS[2 * lane], b0 = laS[2 * lane + 1]; float x = a0 + b0;
#pragma unroll
                for (int d = 1; d < 64; d <<= 1) { const float y = __shfl_up(x, d); if (lane >= d) x += y; }
                cumS[2 * lane + 1] = x; cumS[2 * lane] = x - b0; }
            __syncthreads();
            const float ctot = cumS[127];
            for (int i = tid; i < 2048; i += 512) { const int l = i >> 4, pc = i & 15; const float wl = dtS[l] * __expf(ctot - cumS[l]);
                float f[8]; unpack8(lds_ld16(lds + L_B + l * SLD + pc * 16), f);
#pragma unroll
                for (int e = 0; e < 8; ++e) *(LAS bf16*)(lds + L_BT + (pc * 8 + e) * SLD + l * 2) = (bf16)f2bf(f[e] * wl); }
            f32x16 acc0, acc1;
            const int lt = wave >> 1, st0 = 2 * (wave & 1);
            if (lat) {
#pragma unroll
                for (int q = 0; q < 16; ++q) { acc0[q] = 0.f; acc1[q] = 0.f; }
                if (st0 <= lt) {
#pragma unroll
                    for (int ks = 0; ks < 8; ++ks) { const bf16x8_t af = lfrag(lds + L_C, lt * 32 + r, ks * 16 + 8 * hh);
                        acc0 = __builtin_amdgcn_mfma_f32_32x32x16_bf16(af, lfrag(lds + L_B, st0 * 32 + r, ks * 16 + 8 * hh), acc0, 0, 0, 0);
                        if (st0 + 1 <= lt) acc1 = __builtin_amdgcn_mfma_f32_32x32x16_bf16(af, lfrag(lds + L_B, (st0 + 1) * 32 + r, ks * 16 + 8 * hh), acc1, 0, 0, 0); }
                }
            }
            __syncthreads();
            if (lat) {
#pragma unroll
                for (int t = 0; t < 2; ++t) { const int stt = st0 + t;
                    if (stt <= lt) { const int sidx = stt * 32 + r; const float cs = cumS[sidx], ds = dtS[sidx];
#pragma unroll
                        for (int q = 0; q < 16; ++q) { const int l = lt * 32 + (q & 3) + 8 * (q >> 2) + 4 * hh; const float v = t ? acc1[q] : acc0[q];
                            const float wv = sidx <= l ? v * __expf(cumS[l] - cs) * ds : 0.f;
                            *(LAS bf16*)(lds + L_B + l * SLD + sidx * 2) = (bf16)f2bf(wv); } } }
            }
            __syncthreads();
            if (lat) {
                const int pt = wave & 1;
                f32x16 accd, acco;
#pragma unroll
                for (int q = 0; q < 16; ++q) { accd[q] = 0.f; acco[q] = 0.f; }
                for (int ks = 0; ks < 2 * (lt + 1); ++ks)
                    accd = __builtin_amdgcn_mfma_f32_32x32x16_bf16(lfrag(lds + L_B, lt * 32 + r, ks * 16 + 8 * hh), lfrag(lds + L_XT, pt * 32 + r, ks * 16 + 8 * hh), accd, 0, 0, 0);
#pragma unroll
                for (int ks = 0; ks < 8; ++ks)
                    acco = __builtin_amdgcn_mfma_f32_32x32x16_bf16(lfrag(lds + L_C, lt * 32 + r, ks * 16 + 8 * hh), lfrag(lds + L_S, pt * 32 + r, ks * 16 + 8 * hh), acco, 0, 0, 0);
#pragma unroll
                for (int q = 0; q < 16; ++q) { const int l = lt * 32 + (q & 3) + 8 * (q >> 2) + 4 * hh; const float y = accd[q] + __expf(cumS[l]) * acco[q];
                    YS[((size_t)dir * MX + scan_row(n0 + l, dir, b)) * RW + h * 64 + pt * 32 + r] = (bf16)f2bf(y); }
            }
            const int pt2 = wave >> 2, nt = wave & 3;
            { const float dc = __expf(ctot);
#pragma unroll
              for (int q = 0; q < 16; ++q) st[q] *= dc;
#pragma unroll
              for (int ks = 0; ks < 8; ++ks)
                  st = __builtin_amdgcn_mfma_f32_32x32x16_bf16(lfrag(lds + L_XT, pt2 * 32 + r, ks * 16 + 8 * hh), lfrag(lds + L_BT, nt * 32 + r, ks * 16 + 8 * hh), st, 0, 0, 0); }
            __syncthreads();
#pragma unroll
            for (int q = 0; q < 16; ++q) { const int p = pt2 * 32 + (q & 3) + 8 * (q >> 2) + 4 * hh; *(LAS bf16*)(lds + L_S + p * SLD + (nt * 32 + r) * 2) = (bf16)f2bf(st[q]); }
            __syncthreads();
        }
    }
}

__device__ __forceinline__ void ph_finish(const Args& a) {
    const int lane = LANE;
    const bf16* R = (const bf16*)(a.ws + WS_R); const bf16* K = (const bf16*)(a.ws + WS_K); const bf16* V = (const bf16*)(a.ws + WS_V);
    const bf16* LR = (const bf16*)(a.ws + WS_LR); const bf16* XS = (const bf16*)(a.ws + WS_XS); const bf16* Z = (const bf16*)(a.ws + WS_Z);
    const bf16* OR = (const bf16*)a.out; const bf16* YS = (const bf16*)a.out + (size_t)2 * MX * RW;
    bf16* A2 = (bf16*)(a.ws + WS_A2);
    for (int m = GW; m < MX; m += NGW) {
#pragma unroll
        for (int i = 0; i < 4; ++i) {
            const int c0 = (lane + 64 * i) * 8;
            float of[8], ob[8], o[8], res[8];
#if MK_SKIP_RWKV
#pragma unroll
            for (int e = 0; e < 8; ++e) res[e] = 0.f;
#else
            unpack8(ld16(OR + (size_t)m * RW + c0), of); unpack8(ld16(OR + ((size_t)MX + m) * RW + c0), ob);
            float sm = 0.f;
#pragma unroll
            for (int e = 0; e < 8; ++e) { o[e] = of[e] + ob[e]; sm += o[e]; }
            sm = sum8(sm);
            const float mean = sm * (1.f / 64.f); float sq = 0.f;
#pragma unroll
            for (int e = 0; e < 8; ++e) { o[e] -= mean; sq += o[e] * o[e]; }
            sq = sum8(sq);
            const float rstd = rsqrtf(sq * (1.f / 64.f) + GN_EPS);
            float lw[8], lb[8], r[8], k[8], v[8], a0[8], a1[8], ka[8], rk[8], gg[8];
            ldf8(a.in[I_LNW] + c0, lw); ldf8(a.in[I_LNB] + c0, lb); ldf8(a.in[I_KA] + c0, ka); ldf8(a.in[I_RK] + c0, rk);
            unpack8(ld16(R + (size_t)m * RW + c0), r); unpack8(ld16(K + (size_t)m * RW + c0), k); unpack8(ld16(V + (size_t)m * RW + c0), v);
            unpack8(ld16(LR + (size_t)m * NLR + 4096 + c0), a0); unpack8(ld16(LR + (size_t)m * NLR + 6144 + c0), a1); unpack8(ld16(LR + (size_t)m * NLR + 8192 + c0), gg);
            float bs = 0.f;
#pragma unroll
            for (int e = 0; e < 8; ++e) { const float kd = k[e] * (2.f + (a0[e] + a1[e] - 2.f) * ka[e]); bs += r[e] * kd * rk[e]; }
            bs = sum8(bs);
#pragma unroll
            for (int e = 0; e < 8; ++e) res[e] = (o[e] * rstd * lw[e] + lb[e] + bs * v[e]) * gg[e];
#endif
            st16(A2 + (size_t)m * DM + c0, pack8(res));
        }
#pragma unroll
        for (int i = 0; i < 4; ++i) {
            const int c0 = (lane + 64 * i) * 8;
            float yf[8], yb[8], xs[8], z[8], nw[8], y[8];
#if MK_SKIP_SSD
#pragma unroll
            for (int e = 0; e < 8; ++e) y[e] = 0.f;
#else
            unpack8(ld16(YS + (size_t)m * RW + c0), yf); unpack8(ld16(YS + ((size_t)MX + m) * RW + c0), yb);
            unpack8(ld16(XS + (size_t)m * RW + c0), xs); unpack8(ld16(Z + (size_t)m * RW + c0), z); ldf8(a.in[I_NORMW] + c0, nw);
            const float dsk = a.in[I_SSMD][c0 >> 6]; float ss = 0.f;
#pragma unroll
            for (int e = 0; e < 8; ++e) { y[e] = (yf[e] + yb[e] + dsk * xs[e]) * (z[e] / (1.f + __expf(-z[e]))); ss += y[e] * y[e]; }
            ss = sum32(ss);
            const float rstd = rsqrtf(ss * (1.f / 256.f) + RMS_EPS);
#pragma unroll
            for (int e = 0; e < 8; ++e) y[e] = y[e] * rstd * nw[e];
#endif
            st16(A2 + (size_t)m * DM + 2048 + c0, pack8(y));
        }
    }
}

__device__ __forceinline__ float enc_key(float v, int idx) { return __uint_as_float((__float_as_uint(v) & 0xffffff00u) | (unsigned)idx); }
typedef float f32x32_t __attribute__((ext_vector_type(32)));
typedef unsigned u32x6_t __attribute__((ext_vector_type(6)));
struct Fp6Row { uint4 q0, q1, q2; };
__device__ __forceinline__ Fp6Row ld_fp6row(const unsigned char* p) { Fp6Row r; r.q0 = *(const uint4*)p; r.q1 = *(const uint4*)(p + 16); r.q2 = *(const uint4*)(p + 32); return r; }
__device__ __forceinline__ f32x32_t fp6_unpack(const Fp6Row& r, int p, float one) {
    u32x6_t s; if (p == 0) { s[0] = r.q0.x; s[1] = r.q0.y; s[2] = r.q0.z; s[3] = r.q0.w; s[4] = r.q1.x; s[5] = r.q1.y; } else { s[0] = r.q1.z; s[1] = r.q1.w; s[2] = r.q2.x; s[3] = r.q2.y; s[4] = r.q2.z; s[5] = r.q2.w; }
    return __builtin_amdgcn_cvt_scalef32_pk32_f32_fp6(s, one);
}
#define PIN4(a) asm volatile("" : "+v"((a)[0]), "+v"((a)[1]), "+v"((a)[2]), "+v"((a)[3]))
__device__ __forceinline__ void ph_peer(const Args& a) {
    const int lane = LANE;
    const float* mod = (const float*)(a.ws + WS_MOD); const float* S = (const float*)(a.ws + WS_S);
    const unsigned char* U8 = (const unsigned char*)(a.ws + WS_U8); const unsigned char* V8 = (const unsigned char*)(a.ws + WS_V8);
    const float* USC = (const float*)(a.ws + WS_USC); const float* VSC = (const float*)(a.ws + WS_VSC);
    for (int m = GW; m < MX; m += NGW) {
        const int bb = m / SEQ;
        float* hrow = a.out + (size_t)m * DM;
        int l4 = lane * 4; asm volatile("" : "+v"(l4));
        float acc[16][4];
#if MK_SKIP_PEER
#pragma unroll
        for (int j = 0; j < 16; ++j)
#pragma unroll
            for (int e = 0; e < 4; ++e) acc[j][e] = 0.f;
#else
        float xn[16][4];
        { float ss = 0.f;
#pragma unroll
          for (int j = 0; j < 16; ++j) { const float4 h4 = *(const float4*)(hrow + 256 * j + l4); xn[j][0] = h4.x; xn[j][1] = h4.y; xn[j][2] = h4.z; xn[j][3] = h4.w; ss += (h4.x * h4.x + h4.y * h4.y) + (h4.z * h4.z + h4.w * h4.w); }
          const float rstd = rsqrtf(wave_sum(ss) * (1.f / DM) + RMS_EPS);
          const float* sh2 = mod + (size_t)bb * NMOD + 3 * DM; const float* sc2 = mod + (size_t)bb * NMOD + 4 * DM; const float* g2 = a.in[I_N2G];
#pragma unroll
          for (int j = 0; j < 16; ++j) { const int c = 256 * j + l4; const float4 gg = *(const float4*)(g2 + c), s0 = *(const float4*)(sh2 + c), s1 = *(const float4*)(sc2 + c);
              xn[j][0] = xn[j][0] * rstd * gg.x * (1.f + s1.x) + s0.x; xn[j][1] = xn[j][1] * rstd * gg.y * (1.f + s1.y) + s0.y; xn[j][2] = xn[j][2] * rstd * gg.z * (1.f + s1.z) + s0.z; xn[j][3] = xn[j][3] * rstd * gg.w * (1.f + s1.w) + s0.w;
              if ((j & 3) == 3) { PIN4(xn[j - 3]); PIN4(xn[j - 2]); PIN4(xn[j - 1]); PIN4(xn[j]); asm volatile("" ::: "memory"); } } }
        int eid0 = 0, eid1 = 0; float gt0 = 0.f, gt1 = 0.f;
        const float NEG = -3.0e38f;
#pragma unroll 1
        for (int hd = 0; hd < 8; ++hd) {
            const float* srow = S + (size_t)m * 2048 + hd * 256;
            float c1a = enc_key(srow[lane], lane), c1b = enc_key(srow[64 + lane], 64 + lane), c2a = enc_key(srow[128 + lane], lane), c2b = enc_key(srow[192 + lane], 64 + lane);
            float t1 = NEG, t2 = NEG;
#pragma unroll 1
            for (int k = 0; k < 16; ++k) {
                const float m1 = wave_max(fmaxf(c1a, c1b)), m2 = wave_max(fmaxf(c2a, c2b));
                if (c1a == m1) c1a = NEG; if (c1b == m1) c1b = NEG; if (c2a == m2) c2a = NEG; if (c2b == m2) c2b = NEG;
                if (lane == k) { t1 = m1; t2 = m2; }
            }
            const float v1 = __uint_as_float(__float_as_uint(t1) & 0xffffff00u), v2 = __uint_as_float(__float_as_uint(t2) & 0xffffff00u);
            const int i1 = (int)(__float_as_uint(t1) & 0xffu), i2 = (int)(__float_as_uint(t2) & 0xffu);
            float cd[4];
#pragma unroll
            for (int e = 0; e < 4; ++e) { const float va = __shfl(v1, (lane >> 4) + 4 * e), vb = __shfl(v2, lane & 15); cd[e] = enc_key(va + vb, lane + 64 * e); }
            float best = NEG; int ex = 0;
#pragma unroll 1
            for (int k = 0; k < 16; ++k) {
                const float mx = wave_max(fmaxf(fmaxf(cd[0], cd[1]), fmaxf(cd[2], cd[3])));
#pragma unroll
                for (int e = 0; e < 4; ++e) if (cd[e] == mx) cd[e] = NEG;
                const int cidx = (int)(__float_as_uint(mx) & 0xffu);
                const int ea = __shfl(i1, cidx >> 4), eb = __shfl(i2, cidx & 15);
                if (lane == k) { best = __uint_as_float(__float_as_uint(mx) & 0xffffff00u); ex = ea * 128 + eb; }
            }
            const float bmax = __shfl(best, 0);
            const float pe = lane < 16 ? __expf(best - bmax) : 0.f;
            const float gate = pe / wave_sum(pe);
            const float gsh = __shfl(gate, lane & 15); const int esh = __shfl(ex, lane & 15);
            if ((lane >> 4) == (hd & 3)) { if (hd < 4) { gt0 = gsh; eid0 = esh; } else { gt1 = gsh; eid1 = esh; } }
        }
        const int l48 = lane * 48;
        float cf0 = 0.f, cf1 = 0.f;
#pragma unroll 1
        for (int p0 = 0; p0 < 128; p0 += 4) {
            float d[4]; Fp6Row qu[4];
#pragma unroll
            for (int q = 0; q < 4; ++q) { const int e = __builtin_amdgcn_readlane(p0 < 64 ? eid0 : eid1, (p0 + q) & 63); qu[q] = ld_fp6row(U8 + (size_t)e * 3072 + l48); }
#pragma unroll
            for (int q = 0; q < 4; ++q) {
                float dd = 0.f;
#pragma unroll
                for (int p = 0; p < 2; ++p) { float one = 1.0f; asm volatile("" : "+v"(one)); const f32x32_t f = fp6_unpack(qu[q], p, one);
#pragma unroll
                    for (int t = 0; t < 32; ++t) dd += xn[8 * p + (t >> 2)][t & 3] * f[t];
                    asm volatile("" : "+v"(dd)); }
                d[q] = dd;
            }
#pragma unroll
            for (int q = 0; q < 4; ++q) {
                const int p = p0 + q; const int e = __builtin_amdgcn_readlane(p0 < 64 ? eid0 : eid1, p & 63);
                const float dot = wave_sum(d[q]) * USC[e];
                const float act = 0.5f * dot * (1.f + erff(dot * 0.70710678f)) * VSC[e];
                if (lane == (p & 63)) { if (p0 < 64) cf0 = gt0 * act; else cf1 = gt1 * act; }
            }
        }
#pragma unroll
        for (int j = 0; j < 16; ++j)
#pragma unroll
            for (int e = 0; e < 4; ++e) acc[j][e] = 0.f;
#pragma unroll 1
        for (int p0 = 0; p0 < 128; p0 += 4) {
            Fp6Row qv[4]; float cfv[4];
#pragma unroll
            for (int q = 0; q < 4; ++q) { const int e = __builtin_amdgcn_readlane(p0 < 64 ? eid0 : eid1, (p0 + q) & 63); cfv[q] = rlane(p0 < 64 ? cf0 : cf1, (p0 + q) & 63); qv[q] = ld_fp6row(V8 + (size_t)e * 3072 + l48); }
#pragma unroll
            for (int q = 0; q < 4; ++q)
#pragma unroll
                for (int p = 0; p < 2; ++p) { float one = 1.0f; asm volatile("" : "+v"(one)); const f32x32_t f = fp6_unpack(qv[q], p, one);
#pragma unroll
                    for (int t = 0; t < 32; ++t) acc[8 * p + (t >> 2)][t & 3] += cfv[q] * f[t];
#pragma unroll
                    for (int jj = 0; jj < 8; ++jj) PIN4(acc[8 * p + jj]); }
        }
#endif
        { const float* gt2 = mod + (size_t)bb * NMOD + 5 * DM; float ss = 0.f;
#pragma unroll
          for (int j = 0; j < 16; ++j) { const int c = 256 * j + l4; const float4 g = *(const float4*)(gt2 + c), h4 = *(const float4*)(hrow + c);
              acc[j][0] = h4.x + g.x * acc[j][0]; acc[j][1] = h4.y + g.y * acc[j][1]; acc[j][2] = h4.z + g.z * acc[j][2]; acc[j][3] = h4.w + g.w * acc[j][3];
              ss += (acc[j][0] * acc[j][0] + acc[j][1] * acc[j][1]) + (acc[j][2] * acc[j][2] + acc[j][3] * acc[j][3]);
              if ((j & 3) == 3) { PIN4(acc[j - 3]); PIN4(acc[j - 2]); PIN4(acc[j - 1]); PIN4(acc[j]); asm volatile("" ::: "memory"); } }
          const float rstd = rsqrtf(wave_sum(ss) * (1.f / DM) + RMS_EPS);
#pragma unroll
          for (int j = 0; j < 16; ++j) { const int c = 256 * j + l4; const float4 fg = *(const float4*)(a.in[I_FG] + c);
              *(float4*)(hrow + c) = make_float4(acc[j][0] * rstd * fg.x, acc[j][1] * rstd * fg.y, acc[j][2] * rstd * fg.z, acc[j][3] * rstd * fg.w);
              if ((j & 3) == 3) asm volatile("" ::: "memory"); } }
    }
}

constexpr int N_PHASES = 13;
__global__ void __launch_bounds__(512, 2) hybrid_fwd(Args args) {
    extern __shared__ __attribute__((aligned(16))) unsigned char lds_raw[];
    LAS unsigned char* lds = (LAS unsigned char*)lds_raw;
    volatile LAS unsigned* MISC = (volatile LAS unsigned*)(lds + LDS_MISC);
    for (int u = TID; u < (LDS_BYTES - LDS_CTL) / 4; u += 512) ((LAS unsigned*)(lds + LDS_CTL))[u] = 0u;
    __syncthreads();
    const int lo = args.ph_lo, hi = args.ph_hi;
    XcdBarrier bar; bar.bar = (unsigned*)(args.ws + WS_CTL); bar.x = 0; bar.st = nullptr;
    if (hi - lo > 1) bar = xcd_barrier_post((unsigned*)(args.ws + WS_CTL), MISC + 8);
#define IN(k) (lo <= (k) && (k) < hi && ((MK_PHASE_MASK >> (k)) & 1))
#define SEAM(k) do { if (IN(k) && IN((k) + 1)) xcd_barrier(bar); } while (0)
    const int bid = (int)blockIdx.x, G = (int)gridDim.x;

    if (IN(0)) { ph_mod(args, lds); ph_conv(args, lds); if (MK_REPEAT == 0) { ph_mod(args, lds); ph_conv(args, lds); } }
    SEAM(0);
    if (IN(1)) { ph_norm1(args); if (MK_REPEAT == 1) ph_norm1(args); }
    SEAM(1);
    if (IN(2)) { pg8::Gemm g{(const bf16*)(args.ws + WS_A1), (const bf16*)(args.ws + WS_WT_IN), MT, NINP, DM}; pg8::StaticOrder S; S.init(MT, NINP, G, bid);
        pg8::EpiBf16<0> E{(bf16*)(args.ws + WS_P), NINP, nullptr, 0, 0}; pg8::gemm_phase<pg8::EpiBf16<0>, pg8::StaticOrder>(lds, g, S, E, nullptr); }
    SEAM(2);
    if (IN(3)) { ph_prep_rwkv(args); ph_prep_ssd(args); if (MK_REPEAT == 3) { ph_prep_rwkv(args); ph_prep_ssd(args); } }
    SEAM(3);
    if (IN(4)) { pg8::Gemm g{(const bf16*)(args.ws + WS_ALR), (const bf16*)(args.ws + WS_WLR), MT, NLR, KLR}; pg8::StaticOrder S; S.init(MT, NLR, G, bid);
        EpiLR E{(bf16*)(args.ws + WS_LR), args.in[I_W0], args.in[I_A0]}; pg8::gemm_phase<EpiLR, pg8::StaticOrder>(lds, g, S, E, nullptr); }
    SEAM(4);
#if MK_RWKV_SEQ
    if (IN(5)) { ph_rwkv_scan(args); if (MK_REPEAT == 5) ph_rwkv_scan(args); }
#else
    if (IN(5)) { ph_rwkv_scan2(args, lds); if (MK_REPEAT == 5) ph_rwkv_scan2(args, lds); }
#endif
    SEAM(5);
#if MK_SSD_SEQ
    if (IN(6)) { ph_ssd_scan(args); if (MK_REPEAT == 6) ph_ssd_scan(args); }
#else
    if (IN(6)) { ph_ssd_chunked(args, lds); if (MK_REPEAT == 6) ph_ssd_chunked(args, lds); }
#endif
    SEAM(6);
    if (IN(7)) { ph_finish(args); if (MK_REPEAT == 7) ph_finish(args); }
    SEAM(7);
    if (IN(8)) { pg8::Gemm g{(const bf16*)(args.ws + WS_A2), (const bf16*)(args.ws + WS_WT_OUT), MX, DM, DM}; pg8::StaticOrder S; S.init(MX, DM, G, bid);
        EpiRes E{args.out, args.in[I_X], (const float*)(args.ws + WS_MOD)}; pg8::gemm_phase<EpiRes, pg8::StaticOrder>(lds, g, S, E, nullptr); }
    SEAM(8);
    if (IN(9)) { ph_norm2(args); if (MK_REPEAT == 9) ph_norm2(args); }
    SEAM(9);
    if (IN(10)) { pg8::Gemm g{(const bf16*)(args.ws + WS_XN2), (const bf16*)(args.ws + WS_WT_Q), MX, 2048, DM}; pg8::StaticOrder S; S.init(MX, 2048, G, bid);
        pg8::EpiBf16<0> E{(bf16*)(args.ws + WS_Q), 2048, nullptr, 0, 0}; pg8::gemm_phase<pg8::EpiBf16<0>, pg8::StaticOrder>(lds, g, S, E, nullptr); }
    SEAM(10);
    if (IN(11)) { pg8::Gemm g{(const bf16*)(args.ws + WS_Q), (const bf16*)(args.ws + WS_KBD), MX, 2048, 2048}; pg8::StaticOrder S; S.init(MX, 2048, G, bid);
        pg8::EpiF32 E{(float*)(args.ws + WS_S), 2048, nullptr}; pg8::gemm_phase<pg8::EpiF32, pg8::StaticOrder>(lds, g, S, E, nullptr); }
    SEAM(11);
    if (IN(12)) ph_peer(args);
#undef IN
#undef SEAM
}

extern "C" void kernel_launch(void* const* d_in, const int* in_sizes, int n_in, void* d_out, int out_size, void* d_ws, size_t ws_size, hipStream_t stream) {
    static int grid = 0;
    if (grid == 0) {
        if (n_in != N_IN || out_size != MX * DM || ws_size < WS_END) { fprintf(stderr, "kernel_launch: unexpected shapes (n_in %d out %d ws %zu)\n", n_in, out_size, ws_size); grid = -1; return; }
        int dev = 0, cus = 0, per_cu = 0;
        if (hipGetDevice(&dev) != hipSuccess || hipDeviceGetAttribute(&cus, hipDeviceAttributeMultiprocessorCount, dev) != hipSuccess) { grid = -1; return; }
        if (hipFuncSetAttribute((const void*)hybrid_fwd, hipFuncAttributeMaxDynamicSharedMemorySize, LDS_BYTES) != hipSuccess) { fprintf(stderr, "kernel_launch: hipFuncSetAttribute failed\n"); grid = -1; return; }
        if (hipOccupancyMaxActiveBlocksPerMultiprocessor(&per_cu, (const void*)hybrid_fwd, 512, LDS_BYTES) != hipSuccess || per_cu < 1) fprintf(stderr, "kernel_launch: occupancy query reports %d\n", per_cu);
        (void)hipGetLastError();
        grid = cus;
    }
    if (grid < 0) return;
    (void)in_sizes;
    if (hipMemsetAsync((char*)d_ws + WS_CTL, 0, CTL_ZERO_BYTES, stream) != hipSuccess) return;
    Args a{};
    for (int i = 0; i < N_IN; ++i) a.in[i] = (const float*)d_in[i];
    a.out = (float*)d_out; a.ws = (unsigned char*)d_ws;
#if MK_N_LAUNCHES == 1
    a.ph_lo = 0; a.ph_hi = N_PHASES;
    hipLaunchKernelGGL(hybrid_fwd, dim3(grid), dim3(512), LDS_BYTES, stream, a);
#else
    for (int ph = 0; ph < N_PHASES; ++ph) { if (!((MK_PHASE_MASK >> ph) & 1)) continue; a.ph_lo = ph; a.ph_hi = ph + 1; hipLaunchKernelGGL(hybrid_fwd, dim3(grid), dim3(512), LDS_BYTES, stream, a); }
#endif
}
```

```cpp
#include <hip/hip_runtime.h>
#include <stdint.h>
#include <stdio.h>
namespace pg8 {
#define PG8_LAS __attribute__((address_space(3)))
typedef unsigned short bf16_t;
typedef short bf16x8 __attribute__((ext_vector_type(8)));
typedef float f32x4 __attribute__((ext_vector_type(4)));
typedef unsigned u32x4 __attribute__((ext_vector_type(4)));
constexpr int BM = 256, BK = 64, HALF = 128, HTB = HALF * BK * 2  , STAGE_BYTES = 8 * HTB, NXCD = 8, WGM = 8;

__host__ __device__ __forceinline__ int lds_byte(int r, int c) { const int st = (r >> 4) * 2 + (c >> 5), rr = r & 15, cc = c & 31, ob = rr * 64 + cc * 2; return st * 1024 + (ob ^ (((ob >> 9) & 1) << 5)); }
__host__ __device__ __forceinline__ void stage_rc(int b, int& R, int& C) { const int st = b / 1024, sb = b % 1024, swz = sb ^ (((sb >> 9) & 1) << 5); R = (st >> 1) * 16 + swz / 64; C = (st & 1) * 32 + (swz % 64) / 2; }
__host__ __device__ __forceinline__ int perm32(int rho) { const int n = rho >> 4, i = rho & 15; return 8 * (i >> 2) + 4 * n + (i & 3); }

struct Unit { int pm, pn; };
struct Gemm { const bf16_t* A; const bf16_t* Bt; int M, N, K; int lda, ldb, kshift, kmul; };

struct StaticOrder {
    int nM, nN, nwg, G, c;
    __host__ __device__ void init(int M, int N, int G_, int c_) { nM = M / BM; nN = N / BM; nwg = nM * nN; G = G_; c = c_; }
    __host__ __device__ bool next(int i, Unit& u) const {
        const long L = (long)i * G + c; if (L >= nwg) return false;
        int wgid = (int)L; { const int q = nwg / NXCD, r = nwg % NXCD, xcd = wgid % NXCD, off = wgid / NXCD; wgid = (xcd < r ? xcd * (q + 1) : r * (q + 1) + (xcd - r) * q) + off; }
        const int nig = WGM * nN, gid = wgid / nig, fm = gid * WGM, gsz = (nM - fm) < WGM ? (nM - fm) : WGM;
        u.pm = fm + ((wgid % nig) % gsz); u.pn = (wgid % nig) / gsz; return true;
    }
    __device__ __forceinline__ void a_ready(const Unit&) const {}
    __device__ __forceinline__ void done(const Unit&) const {}
};
__device__ __forceinline__ unsigned cvt_pk_bf16(float lo, float hi) { unsigned r; asm volatile("v_cvt_pk_bf16_f32 %0, %1, %2" : "=v"(r) : "v"(lo), "v"(hi)); return r; }
typedef float f32x2 __attribute__((ext_vector_type(2)));
__device__ __forceinline__ f32x2 gelu_pk(f32x2 v) {
    const f32x2 av = __builtin_elementwise_abs(v), d = av * 0.2316418882f + 1.0f;
    f32x2 t; t.x = __builtin_amdgcn_rcpf(d.x); t.y = __builtin_amdgcn_rcpf(d.y);
    f32x2 q = t * 0.5307027145f + (-0.7265760135f); q = q * t + 0.7107068705f; q = q * t + (-0.142248368f); q = q * t + 0.127414796f; q = q * t;
    const f32x2 s = (v * v) * (-0.72134752044f);
    f32x2 e; e.x = __builtin_amdgcn_exp2f(s.x); e.y = __builtin_amdgcn_exp2f(s.y);
    const f32x2 m = v * (q * e), r = v - m;
    f32x2 o; o.x = v.x < 0.f ? m.x : r.x; o.y = v.y < 0.f ? m.y : r.y; return o;
}

struct EpiF32 {
    static constexpr bool PERM = false, AFTER_DRAIN = false;
    float* C; int ldc; const float* bias;
    __device__ __forceinline__ void operator()(const f32x4 (&acc)[2][2][4][2], const Unit& u, int wr, int wc, int fr, int fq) const {
        const int row0 = u.pm * BM + wr * 64 + fr, col0 = u.pn * BM + wc * 32 + 4 * fq;
        f32x4 bv[2][2];
#pragma unroll
        for (int bj = 0; bj < 2; ++bj)
#pragma unroll
            for (int n = 0; n < 2; ++n) bv[bj][n] = bias ? *(const f32x4*)(bias + col0 + bj * HALF + n * 16) : (f32x4){0.f, 0.f, 0.f, 0.f};
#pragma unroll
        for (int ai = 0; ai < 2; ++ai)
#pragma unroll
            for (int m = 0; m < 4; ++m) { float* rowp = C + (size_t)(row0 + ai * HALF + m * 16) * ldc + col0;
#pragma unroll
                for (int bj = 0; bj < 2; ++bj)
#pragma unroll
                    for (int n = 0; n < 2; ++n) *(f32x4*)(rowp + bj * HALF + n * 16) = acc[ai][bj][m][n] + bv[bj][n]; }
    }
};
template <int ACT  > struct EpiBf16 {
    static constexpr bool PERM = true, AFTER_DRAIN = false;
    bf16_t* O; int ldc; const float* bias; int split_cols; size_t split_stride;
    __device__ __forceinline__ void operator()(const f32x4 (&acc)[2][2][4][2], const Unit& u, int wr, int wc, int fr, int fq) const {
        const int row0 = u.pm * BM + wr * 64 + fr; int colt = u.pn * BM; bf16_t* base = O;
        if (split_cols) { const int t = colt / split_cols; base += (size_t)t * split_stride; colt -= t * split_cols; }
        const int col0 = colt + wc * 32 + 8 * fq, bcol0 = u.pn * BM + wc * 32 + 8 * fq;
        f32x4 bv[2][2];
#pragma unroll
        for (int bj = 0; bj < 2; ++bj)
#pragma unroll
            for (int n = 0; n < 2; ++n) bv[bj][n] = bias ? *(const f32x4*)(bias + bcol0 + bj * HALF + 4 * n) : (f32x4){0.f, 0.f, 0.f, 0.f};
#pragma unroll
        for (int ai = 0; ai < 2; ++ai)
#pragma unroll
            for (int m = 0; m < 4; ++m) { bf16_t* rowp = base + (size_t)(row0 + ai * HALF + m * 16) * ldc + col0;
#pragma unroll
                for (int bj = 0; bj < 2; ++bj) { f32x4 v0 = acc[ai][bj][m][0] + bv[bj][0], v1 = acc[ai][bj][m][1] + bv[bj][1];
                    if (ACT == 1) { f32x2 a = gelu_pk((f32x2){v0[0], v0[1]}), b = gelu_pk((f32x2){v0[2], v0[3]}), c = gelu_pk((f32x2){v1[0], v1[1]}), d = gelu_pk((f32x2){v1[2], v1[3]});
                        v0 = (f32x4){a.x, a.y, b.x, b.y}; v1 = (f32x4){c.x, c.y, d.x, d.y}; }
                    if (ACT == 2) {
#pragma unroll
                        for (int j = 0; j < 4; ++j) { v0[j] = 0.5f * v0[j] * (1.0f + erff(v0[j] * 0.70710678f)); v1[j] = 0.5f * v1[j] * (1.0f + erff(v1[j] * 0.70710678f)); } }
                    u32x4 w; w.x = cvt_pk_bf16(v0[0], v0[1]); w.y = cvt_pk_bf16(v0[2], v0[3]); w.z = cvt_pk_bf16(v1[0], v1[1]); w.w = cvt_pk_bf16(v1[2], v1[3]);
                    *(u32x4*)(rowp + bj * HALF) = w; } }
    }
};
template <class Epi, class Sched, bool STAMP = false>
__device__ __forceinline__ void gemm_phase(PG8_LAS unsigned char* lds, const Gemm g, const Sched& S, const Epi& E, unsigned long long* stamps) {
    const int tid = threadIdx.x, wid = __builtin_amdgcn_readfirstlane(tid >> 6), lane = tid & 63, wr = wid >> 2, wc = wid & 3, fr = lane & 15, fq = lane >> 4;
    const int K = g.K, nt = K / BK;
    int ts_lo = 0, ts_hi = 0, nts = 0; const unsigned long long rt_entry = STAMP ? (unsigned long long)wall_clock64() : 0ull;
#define PG8_STAMP() do { if (STAMP && wid == 0 && nts < 64) { const unsigned long long _c = (unsigned long long)clock64(); \
        ts_lo = (lane == nts) ? (int)(unsigned)_c : ts_lo; ts_hi = (lane == nts) ? (int)(unsigned)(_c >> 32) : ts_hi; ++nts; } } while (0)
    PG8_STAMP();
    unsigned voffA[2], voffB[2];
#pragma unroll
    for (int i = 0; i < 2; ++i) { int R, C; stage_rc(tid * 16 + i * 8192, R, C); const int Rb = Epi::PERM ? ((R & ~31) + perm32(R & 31)) : R;
        voffA[i] = (unsigned)(R * g.lda + C) * 2u; voffB[i] = (unsigned)(Rb * g.ldb + C) * 2u; }
    const size_t kstep = (size_t)(BK * 2);
    const size_t hstepA = (size_t)HALF * g.lda * 2, hstepB = (size_t)HALF * g.ldb * 2;
    const size_t tstepA = 2 * hstepA, tstepB = 2 * hstepB;
    const unsigned ldsw = (unsigned)wid * 1024u;
    const int aoff = lds_byte(wr * 64 + fr, fq * 8), boff = lds_byte(wc * 32 + fr, fq * 8);
#define PG8_SA(b, h) (((b) * 2 + (h)) * HTB)
#define PG8_SB(b, h) ((4 + (b) * 2 + (h)) * HTB)
#define PG8_STAGE(bufoff, gbase, voff) do { _Pragma("unroll") for (int _i = 0; _i < 2; ++_i) \
        __builtin_amdgcn_global_load_lds((const unsigned*)((const char*)(gbase) + (voff)[_i]), (PG8_LAS unsigned*)(lds + (bufoff) + ldsw + _i * 8192), 16, 0, 0); } while (0)
#define PG8_LDA(dst, b, h) do { _Pragma("unroll") for (int m = 0; m < 4; ++m) _Pragma("unroll") for (int k = 0; k < 2; ++k) dst[m][k] = *(const PG8_LAS bf16x8*)(lds + PG8_SA(b, h) + aoff + m * 2048 + k * 1024); } while (0)
#define PG8_LDB(dst, b, h) do { _Pragma("unroll") for (int n = 0; n < 2; ++n) _Pragma("unroll") for (int k = 0; k < 2; ++k) dst[n][k] = *(const PG8_LAS bf16x8*)(lds + PG8_SB(b, h) + boff + n * 2048 + k * 1024); } while (0)
#define PG8_MMA(ai, bj, At, Bt) do { __builtin_amdgcn_s_setprio(1); _Pragma("unroll") for (int m = 0; m < 4; ++m) _Pragma("unroll") for (int n = 0; n < 2; ++n) _Pragma("unroll") for (int k = 0; k < 2; ++k) \
        acc[ai][bj][m][n] = __builtin_amdgcn_mfma_f32_16x16x32_bf16(Bt[n][k], At[m][k], acc[ai][bj][m][n], 0, 0, 0); __builtin_amdgcn_s_setprio(0); } while (0)
#define PG8_WAIT_V(n) asm volatile("s_waitcnt vmcnt(" #n ")" ::: "memory")
#define PG8_WAIT_L(n) asm volatile("s_waitcnt lgkmcnt(" #n ")" ::: "memory")
#define PG8_BAR __builtin_amdgcn_s_barrier()
#define PG8_SCHED __builtin_amdgcn_sched_barrier(0)
    Unit cur, nxt; int ui = 0;
    if (!S.next(0, cur)) return;
    f32x4 acc[2][2][4][2];
#pragma unroll
    for (int a = 0; a < 2; ++a)
#pragma unroll
        for (int b = 0; b < 2; ++b)
#pragma unroll
            for (int m = 0; m < 4; ++m)
#pragma unroll
                for (int n = 0; n < 2; ++n) acc[a][b][m][n] = (f32x4){0.f, 0.f, 0.f, 0.f};
    bf16x8 At[4][2], B0[2][2], B1[2][2];
    const char* cA = (const char*)g.A + (size_t)cur.pm * tstepA + (size_t)((cur.pn >> g.kshift) * g.kmul) * 2; const char* cB = (const char*)g.Bt + (size_t)cur.pn * tstepB;
    S.a_ready(cur);
    PG8_STAGE(PG8_SB(0, 0), cB, voffB); PG8_STAGE(PG8_SA(0, 0), cA, voffA); PG8_STAGE(PG8_SB(0, 1), cB + hstepB, voffB); PG8_STAGE(PG8_SA(0, 1), cA + hstepA, voffA);
    if (wr == 1) PG8_BAR;
    PG8_WAIT_V(4); PG8_BAR;
    PG8_STAGE(PG8_SB(1, 0), cB + kstep, voffB); PG8_STAGE(PG8_SA(1, 0), cA + kstep, voffA); PG8_STAGE(PG8_SB(1, 1), cB + hstepB + kstep, voffB);
    PG8_WAIT_V(6); PG8_BAR;
    PG8_STAMP();
    for (;;) {
        const bool has_next = S.next(ui + 1, nxt);
        const char* nA = has_next ? (const char*)g.A + (size_t)nxt.pm * tstepA + (size_t)((nxt.pn >> g.kshift) * g.kmul) * 2 : cA; const char* nB = has_next ? (const char*)g.Bt + (size_t)nxt.pn * tstepB : cB;
        for (int t = 0; t < nt; t += 2) {
            const bool last = (t == nt - 2);
            const char* a1 = cA + (size_t)(t + 1) * kstep;
            const char* a2 = last ? nA : cA + (size_t)(t + 2) * kstep; const char* b2 = last ? nB : cB + (size_t)(t + 2) * kstep;
            const char* a3 = a2 + kstep; const char* b3 = b2 + kstep;
            if (last && has_next) S.a_ready(nxt);
            PG8_LDB(B0, 0, 0); PG8_SCHED; PG8_LDA(At, 0, 0); PG8_STAGE(PG8_SA(1, 1), a1 + hstepA, voffA);
            PG8_WAIT_L(8); PG8_BAR; PG8_WAIT_L(0); PG8_MMA(0, 0, At, B0); PG8_BAR; PG8_SCHED;
            PG8_LDB(B1, 0, 1); PG8_STAGE(PG8_SB(0, 0), b2, voffB);
            PG8_BAR; PG8_WAIT_L(0); PG8_MMA(0, 1, At, B1); PG8_BAR;
            PG8_LDA(At, 0, 1); PG8_STAGE(PG8_SA(0, 0), a2, voffA);
            PG8_BAR; PG8_WAIT_L(0); PG8_MMA(1, 0, At, B0); PG8_BAR; PG8_SCHED;
            PG8_STAGE(PG8_SB(0, 1), b2 + hstepB, voffB);
            PG8_WAIT_V(6); PG8_BAR; PG8_MMA(1, 1, At, B1); PG8_BAR;
            PG8_LDB(B0, 1, 0); PG8_SCHED; PG8_LDA(At, 1, 0); PG8_STAGE(PG8_SA(0, 1), a2 + hstepA, voffA);
            PG8_WAIT_L(8); PG8_BAR; PG8_WAIT_L(0); PG8_MMA(0, 0, At, B0); PG8_BAR; PG8_SCHED;
            PG8_LDB(B1, 1, 1); PG8_STAGE(PG8_SB(1, 0), b3, voffB);
            PG8_BAR; PG8_WAIT_L(0); PG8_MMA(0, 1, At, B1); PG8_BAR;
            PG8_LDA(At, 1, 1); PG8_STAGE(PG8_SA(1, 0), a3, voffA);
            PG8_BAR; PG8_WAIT_L(0); PG8_MMA(1, 0, At, B0); PG8_BAR; PG8_SCHED;
            PG8_STAGE(PG8_SB(1, 1), b3 + hstepB, voffB);
            PG8_WAIT_V(6); PG8_BAR; PG8_MMA(1, 1, At, B1); PG8_BAR;
        }
        PG8_STAMP();
        if constexpr (!Epi::AFTER_DRAIN) { E(acc, cur, wr, wc, fr, fq); S.done(cur); }
        PG8_STAMP();
        if (!has_next) break;
#pragma unroll
        for (int a = 0; a < 2; ++a)
#pragma unroll
            for (int b = 0; b < 2; ++b)
#pragma unroll
                for (int m = 0; m < 4; ++m)
#pragma unroll
                    for (int n = 0; n < 2; ++n) acc[a][b][m][n] = (f32x4){0.f, 0.f, 0.f, 0.f};
        cur = nxt; cA = nA; cB = nB; ++ui;
    }
    PG8_WAIT_V(0);
    if (wr == 0) PG8_BAR;
    PG8_BAR;
    if constexpr (Epi::AFTER_DRAIN) { E.fused(acc, cur, wr, wc, fr, fq, lds, wid, lane); S.done(cur); }
    PG8_STAMP();
    if (STAMP && wid == 0) { stamps[lane] = lane < nts ? (((unsigned long long)(unsigned)ts_hi << 32) | (unsigned)ts_lo) : 0ull;
        if (lane == 62) stamps[62] = rt_entry; if (lane == 63) stamps[63] = (unsigned long long)wall_clock64(); }
#undef PG8_STAMP
#undef PG8_SA
#undef PG8_SB
#undef PG8_STAGE
#undef PG8_LDA
#undef PG8_LDB
#undef PG8_MMA
#undef PG8_WAIT_V
#undef PG8_WAIT_L
#undef PG8_BAR
#undef PG8_SCHED
}
}

#define LAS __attribute__((address_space(3)))
typedef unsigned short bf16;
typedef float f32x4 __attribute__((ext_vector_type(4)));

#ifndef MK_N_LAUNCHES
#define MK_N_LAUNCHES 1
#endif
#ifndef MK_PHASE_MASK
#define MK_PHASE_MASK 0x1FFF
#endif
#ifndef MK_REPEAT
#define MK_REPEAT -1
#endif
#ifndef MK_RWKV_SEQ
#define MK_RWKV_SEQ 0
#endif
#ifndef MK_SSD_SEQ
#define MK_SSD_SEQ 0
#endif
#ifndef MK_SKIP_MIXER
#define MK_SKIP_MIXER 0
#endif
#ifndef MK_SKIP_PEER
#define MK_SKIP_PEER 0
#endif
#ifndef MK_SKIP_RWKV
#define MK_SKIP_RWKV 0
#endif
#ifndef MK_SKIP_SSD
#define MK_SKIP_SSD 0
#endif

constexpr int DM = 4096, NBATCH = 4, SEQ = 4096, CTXL = 256;
constexpr int MX = NBATCH * SEQ;
constexpr int MC = NBATCH * CTXL;
constexpr int MT = MX + MC;
constexpr int RW = 2048;
constexpr int RCOLS = 6784;
constexpr int NIN = 12992, NINP = 13056;
constexpr int COL_Z = 6784, COL_XBC = 8832, COL_DT = 12928;
constexpr int NLR = 10240, KLR = 768, KLRW = 256;
constexpr int NMOD = 6 * DM;
constexpr float RMS_EPS = 1e-6f, GN_EPS = 64e-5f;
constexpr int NSTEP = CTXL + SEQ;

constexpr size_t MiB = (size_t)1 << 20;
constexpr size_t WS_CTL = 0, CTL_ZERO_BYTES = 1 * MiB;
constexpr size_t WS_MOD = 64 * 1024;
constexpr size_t WS_WT_OUT = 2 * MiB;
constexpr size_t WS_WT_Q = 34 * MiB;
constexpr size_t WS_WLR = 50 * MiB;
constexpr size_t WS_KBD = 63 * MiB;
constexpr size_t WS_DT = 71 * MiB;
constexpr size_t WS_LA = WS_DT + (size_t)MT * 64 * 4;
constexpr size_t WS_ALR = 300 * MiB;
constexpr size_t WS_WT_IN = 102 * MiB;
constexpr size_t WS_A1 = 204 * MiB;
constexpr size_t WS_P = 340 * MiB;
constexpr size_t WS_R = 774 * MiB, WS_K = 842 * MiB, WS_V = 910 * MiB, WS_KK = 978 * MiB;
constexpr size_t WS_XS = 1046 * MiB, WS_BC = 1114 * MiB;
constexpr size_t WS_Z = 102 * MiB;
constexpr size_t WS_LR = 340 * MiB;
constexpr size_t WS_A2 = 166 * MiB;
constexpr size_t WS_XN2 = 340 * MiB;
constexpr size_t WS_Q = 468 * MiB;
constexpr size_t WS_S = 532 * MiB;
constexpr size_t WS_U8 = 774 * MiB, WS_V8 = 838 * MiB;
constexpr size_t WS_USC = 902 * MiB, WS_VSC = WS_USC + 65536;
constexpr size_t WS_END = 1182 * MiB;
static_assert(WS_WT_IN + (size_t)NINP * DM * 2 <= WS_A1 && WS_A1 + (size_t)MT * DM * 2 <= WS_P && WS_P + (size_t)MT * NINP * 2 <= WS_R, "ws map 1");
static_assert(WS_LR + (size_t)MT * NLR * 2 <= WS_R && WS_Z + (size_t)MX * RW * 2 <= WS_A2 && WS_A2 + (size_t)MX * DM * 2 <= WS_P, "ws map 2");
static_assert(WS_LA + (size_t)MT * 64 * 4 <= WS_WT_IN && WS_ALR + (size_t)MT * KLR * 2 <= WS_P && WS_ALR >= WS_A2 + (size_t)MX * DM * 2 && WS_WLR + (size_t)NLR * KLRW * 2 <= WS_KBD, "ws map 3");
static_assert(WS_S + (size_t)MX * 2048 * 4 <= WS_R && WS_VSC + 65536 <= WS_XS, "ws map 4");

constexpr int LDS_BYTES = 147456;
constexpr int LDS_CTL = 143360;
constexpr int LDS_MISC = LDS_CTL + 320;

enum { I_X = 0, I_C, I_CTX, I_CCTX, I_WMOD, I_BMOD, I_N1G, I_N2G, I_WIN, I_WOUT, I_MU, I_W0, I_W2, I_A0, I_A2, I_G2, I_KK, I_KA, I_RK, I_LNW, I_LNB,
       I_CONVW, I_CONVB, I_DTB, I_ALOG, I_SSMD, I_NORMW, I_WQ, I_K1, I_K2, I_PU, I_PV, I_FG, N_IN };

struct Args { const float* in[N_IN]; float* out; unsigned char* ws; int ph_lo, ph_hi; };

__device__ __forceinline__ unsigned f2bf(float f) { unsigned u = __float_as_uint(f); return (u + 0x7fffu + ((u >> 16) & 1u)) >> 16; }
__device__ __forceinline__ unsigned pk2(float lo, float hi) { return f2bf(lo) | (f2bf(hi) << 16); }
__device__ __forceinline__ float bflo(unsigned u) { return __uint_as_float(u << 16); }
__device__ __forceinline__ float bfhi(unsigned u) { return __uint_as_float(u & 0xffff0000u); }
__device__ __forceinline__ void unpack8(const uint4& u, float (&f)[8]) {
    f[0] = bflo(u.x); f[1] = bfhi(u.x); f[2] = bflo(u.y); f[3] = bfhi(u.y); f[4] = bflo(u.z); f[5] = bfhi(u.z); f[6] = bflo(u.w); f[7] = bfhi(u.w);
}
__device__ __forceinline__ uint4 pack8(const float (&f)[8]) { uint4 u; u.x = pk2(f[0], f[1]); u.y = pk2(f[2], f[3]); u.z = pk2(f[4], f[5]); u.w = pk2(f[6], f[7]); return u; }
__device__ __forceinline__ uint4 ld16(const bf16* p) { return *(const uint4*)p; }
__device__ __forceinline__ void st16(bf16* p, const uint4& v) { *(uint4*)p = v; }
__device__ __forceinline__ void ldf8(const float* p, float (&f)[8]) { const float4 a = *(const float4*)p, b = *(const float4*)(p + 4); f[0] = a.x; f[1] = a.y; f[2] = a.z; f[3] = a.w; f[4] = b.x; f[5] = b.y; f[6] = b.z; f[7] = b.w; }
#define PIN8(a) asm volatile("" : "+v"((a)[0]), "+v"((a)[1]), "+v"((a)[2]), "+v"((a)[3]), "+v"((a)[4]), "+v"((a)[5]), "+v"((a)[6]), "+v"((a)[7]))
template <int CTRL> __device__ __forceinline__ float dppf(float v) { return __uint_as_float((unsigned)__builtin_amdgcn_update_dpp(0, (int)__float_as_uint(v), CTRL, 0xF, 0xF, true)); }
__device__ __forceinline__ float rlane(float v, int l) { return __uint_as_float((unsigned)__builtin_amdgcn_readlane((int)__float_as_uint(v), l)); }
__device__ __forceinline__ float sum8(float v) { v += dppf<0xB1>(v); v += dppf<0x4E>(v); v += dppf<0x141>(v); return v; }
__device__ __forceinline__ float sum16(float v) { v = sum8(v); v += dppf<0x140>(v); return v; }
__device__ __forceinline__ float sum32(float v) { v = sum16(v); v += __shfl_xor(v, 16); return v; }
__device__ __forceinline__ float wave_sum(float v) { v = sum16(v); return (rlane(v, 0) + rlane(v, 16)) + (rlane(v, 32) + rlane(v, 48)); }
__device__ __forceinline__ float wave_max(float v) {
    v = fmaxf(v, dppf<0xB1>(v)); v = fmaxf(v, dppf<0x4E>(v)); v = fmaxf(v, dppf<0x141>(v)); v = fmaxf(v, dppf<0x140>(v));
    return fmaxf(fmaxf(rlane(v, 0), rlane(v, 16)), fmaxf(rlane(v, 32), rlane(v, 48)));
}
__device__ __forceinline__ float sigmoidf_(float x) { return 1.f / (1.f + __expf(-x)); }
__device__ __forceinline__ float siluf_(float x) { return x / (1.f + __expf(-x)); }

struct EpiLR {
    static constexpr bool PERM = true, AFTER_DRAIN = false;
    bf16* O; const float* w0; const float* a0;
    __device__ __forceinline__ void operator()(const pg8::f32x4 (&acc)[2][2][4][2], const pg8::Unit& u, int wr, int wc, int fr, int fq) const {
        const int row0 = u.pm * 256 + wr * 64 + fr; const int colt = u.pn * 256; const int type = colt >> 11;
        const int col0 = colt + wc * 32 + 8 * fq;
        const float* bias = type < 2 ? (w0 + type * 2048) : (a0 + (type - 2) * 2048);
        pg8::f32x4 bv[2][2];
#pragma unroll
        for (int bj = 0; bj < 2; ++bj)
#pragma unroll
            for (int n = 0; n < 2; ++n) bv[bj][n] = type < 4 ? *(const pg8::f32x4*)(bias + ((col0 + bj * 128 + 4 * n) & 2047)) : (pg8::f32x4){0.f, 0.f, 0.f, 0.f};
#pragma unroll
        for (int ai = 0; ai < 2; ++ai)
#pragma unroll
            for (int m = 0; m < 4; ++m) { bf16* rowp = O + (size_t)(row0 + ai * 128 + m * 16) * NLR + col0;
#pragma unroll
                for (int bj = 0; bj < 2; ++bj) { pg8::f32x4 v0 = acc[ai][bj][m][0] + bv[bj][0], v1 = acc[ai][bj][m][1] + bv[bj][1];
                    if (type < 4) {
#pragma unroll
                        for (int j = 0; j < 4; ++j) { float s0 = 1.f / (1.f + __expf(-v0[j])), s1 = 1.f / (1.f + __expf(-v1[j]));
                            if (type < 2) { s0 = -expm1f(-0.60653066f * s0); s1 = -expm1f(-0.60653066f * s1); }
                            v0[j] = s0; v1[j] = s1; } }
                    pg8::u32x4 w; w.x = pg8::cvt_pk_bf16(v0[0], v0[1]); w.y = pg8::cvt_pk_bf16(v0[2], v0[3]); w.z = pg8::cvt_pk_bf16(v1[0], v1[1]); w.w = pg8::cvt_pk_bf16(v1[2], v1[3]);
                    *(pg8::u32x4*)(rowp + bj * 128) = w; } }
    }
};
struct EpiRes {
    static constexpr bool PERM = false, AFTER_DRAIN = false;
    float* C; const float* X; const float* mod;
    __device__ __forceinline__ void operator()(const pg8::f32x4 (&acc)[2][2][4][2], const pg8::Unit& u, int wr, int wc, int fr, int fq) const {
        const int row0 = u.pm * 256 + wr * 64 + fr, col0 = u.pn * 256 + wc * 32 + 4 * fq;
        const float* gt = mod + (size_t)((u.pm * 256) / SEQ) * NMOD + 2 * DM;
        pg8::f32x4 gv[2][2];
#pragma unroll
        for (int bj = 0; bj < 2; ++bj)
#pragma unroll
            for (int n = 0; n < 2; ++n) gv[bj][n] = *(const pg8::f32x4*)(gt + col0 + bj * 128 + n * 16);
#pragma unroll
        for (int ai = 0; ai < 2; ++ai)
#pragma unroll
            for (int m = 0; m < 4; ++m) { const size_t off = (size_t)(row0 + ai * 128 + m * 16) * DM + col0;
#pragma unroll
                for (int bj = 0; bj < 2; ++bj)
#pragma unroll
                    for (int n = 0; n < 2; ++n) { const pg8::f32x4 xv = *(const pg8::f32x4*)(X + off + bj * 128 + n * 16);
#if MK_SKIP_MIXER
                        *(pg8::f32x4*)(C + off + bj * 128 + n * 16) = xv;
#else
                        *(pg8::f32x4*)(C + off + bj * 128 + n * 16) = xv + gv[bj][n] * acc[ai][bj][m][n];
#endif
                    }
                asm volatile("" ::: "memory"); }
    }
};

#define XB_TMO      128
#define XB_XCNT(j)  (256  + 64 * (j))
#define XB_XSUB(j)  (1280 + 64 * (j))
#define XB_XGEN(j)  (2304 + 64 * (j))
#define XB_TOP      3328
#define XB_TOPGEN   3392
#define XCD_BAR_WORDS 3456
#define XB_SPIN_CAP (1u << 18)
__device__ __forceinline__ unsigned xb_ld(unsigned* p)              { return __hip_atomic_load(p, __ATOMIC_RELAXED, __HIP_MEMORY_SCOPE_AGENT); }
__device__ __forceinline__ unsigned xb_add(unsigned* p, unsigned v) { return __hip_atomic_fetch_add(p, v, __ATOMIC_RELAXED, __HIP_MEMORY_SCOPE_AGENT); }
__device__ __forceinline__ unsigned xb_xcc_id() { return (unsigned)__builtin_amdgcn_s_getreg((3 << 11) | 20) & 0xFu; }
#define XB_SPIN(cond, bar) do { unsigned _sp = 0; while (cond) { __builtin_amdgcn_s_sleep(1); \
    if ((++_sp & 255u) == 0u) { if (xb_ld(&(bar)[XB_TMO])) break; if (_sp > XB_SPIN_CAP) { atomicAdd(&(bar)[XB_TMO], 1u); break; } } } } while (0)
struct XcdBarrier { unsigned* bar; unsigned x; volatile LAS unsigned* st; };
__device__ __forceinline__ XcdBarrier xcd_barrier_post(unsigned* bar, volatile LAS unsigned* st) {
    XcdBarrier b; b.bar = bar; b.x = xb_xcc_id(); b.st = st;
    if (threadIdx.x == 0) (void)xb_add(&bar[XB_XCNT(b.x)], 1u);
    return b;
}
__device__ __forceinline__ void xcd_barrier_complete(unsigned* bar, unsigned x, unsigned& nloc, unsigned& nx) {
    const unsigned G = gridDim.x * gridDim.y * gridDim.z;
    unsigned sum, cnt, mine, sp = 0u;
    for (;;) {
        sum = 0u; cnt = 0u; mine = 0u;
#pragma unroll
        for (unsigned j = 0; j < 16; ++j) { const unsigned c = xb_ld(&bar[XB_XCNT(j)]); sum += c; cnt += (c > 0u) ? 1u : 0u; mine = (j == x) ? c : mine; }
        if (sum == G) break;
        __builtin_amdgcn_s_sleep(1);
        if ((++sp & 255u) == 0u) { if (xb_ld(&bar[XB_TMO])) break; if (sp > XB_SPIN_CAP) { atomicAdd(&bar[XB_TMO], 1u); break; } }
    }
    nloc = mine > 0u ? mine : 1u; nx = cnt > 0u ? cnt : 1u;
}
__device__ __forceinline__ void xcd_barrier(const XcdBarrier& b) {
    asm volatile("s_waitcnt vmcnt(0)" ::: "memory");
    __syncthreads();
    if (threadIdx.x == 0) {
        unsigned* bar = b.bar;
        __builtin_amdgcn_s_waitcnt(0);
        unsigned nloc = b.st[0], nx = b.st[1];
        if (nloc == 0u) { xcd_barrier_complete(bar, b.x, nloc, nx); b.st[0] = nloc; b.st[1] = nx; }
        const unsigned old = xb_add(&bar[XB_XSUB(b.x)], 1u);
        const unsigned gen = old / nloc;
        if (old + 1u == (gen + 1u) * nloc) {
            __builtin_amdgcn_fence(__ATOMIC_RELEASE, "agent");
            asm volatile("s_waitcnt vmcnt(0)" ::: "memory");
            const unsigned og = xb_add(&bar[XB_TOP], 1u);
            const unsigned tg = og / nx;
            if (og + 1u == (tg + 1u) * nx) xb_add(&bar[XB_TOPGEN], 1u);
            else XB_SPIN(xb_ld(&bar[XB_TOPGEN]) == tg, bar);
            __builtin_amdgcn_fence(__ATOMIC_ACQUIRE, "agent");
            xb_add(&bar[XB_XGEN(b.x)], 1u);
            asm volatile("s_waitcnt vmcnt(0)" ::: "memory");
        } else {
            XB_SPIN(xb_ld(&bar[XB_XGEN(b.x)]) == gen, bar);
            __builtin_amdgcn_fence(__ATOMIC_ACQUIRE, "agent");
            asm volatile("s_waitcnt vmcnt(0)" ::: "memory");
        }
    }
    __syncthreads();
}

#define TID ((int)threadIdx.x)
#define LANE ((int)(threadIdx.x & 63))
#define WAVE ((int)__builtin_amdgcn_readfirstlane((int)(threadIdx.x >> 6)))
#define GW ((int)blockIdx.x * 8 + WAVE)
#define NGW ((int)gridDim.x * 8)

__device__ __forceinline__ void ph_mod(const Args& a, LAS unsigned char* lds) {
    const float* c = a.in[I_C]; const float* cc = a.in[I_CCTX]; const float* w_mod = a.in[I_WMOD]; const float* b_mod = a.in[I_BMOD];
    float* mod = (float*)(a.ws + WS_MOD);
    LAS float* sS = (LAS float*)lds;
    LAS float* red = (LAS float*)(lds + 81920);
    const int tid = TID, lane = LANE, wave = WAVE;
    if ((int)blockIdx.x < 192) {
        for (int i = tid; i < 5 * DM; i += 512) { const int v = i >> 12, k = i & (DM - 1); const float xv = v < 4 ? c[v * DM + k] : cc[k]; sS[i] = xv / (1.f + expf(-xv)); }
    }
    __syncthreads();
    for (int u = blockIdx.x; u < 192; u += gridDim.x) {
        const int cl = lane & 31, kh = lane >> 5;
        float acc[5][4];
#pragma unroll
        for (int v = 0; v < 5; ++v)
#pragma unroll
            for (int e = 0; e < 4; ++e) acc[v][e] = 0.f;
        const float* wp = w_mod + (size_t)(wave * 512 + kh) * NMOD + u * 128 + cl * 4;
#pragma unroll 8
        for (int i = 0; i < 256; ++i) {
            const float4 w = *(const float4*)(wp + (size_t)(2 * i) * NMOD);
#pragma unroll
            for (int v = 0; v < 5; ++v) { const float s = sS[v * DM + wave * 512 + 2 * i + kh]; acc[v][0] += s * w.x; acc[v][1] += s * w.y; acc[v][2] += s * w.z; acc[v][3] += s * w.w; }
        }
#pragma unroll
        for (int v = 0; v < 5; ++v)
#pragma unroll
            for (int e = 0; e < 4; ++e) acc[v][e] += __shfl_xor(acc[v][e], 32);
        if (kh == 0) {
#pragma unroll
            for (int v = 0; v < 5; ++v) *(LAS f32x4*)(red + ((wave * 5 + v) * 128 + cl * 4)) = (f32x4){acc[v][0], acc[v][1], acc[v][2], acc[v][3]};
        }
        __syncthreads();
        for (int i = tid; i < 640; i += 512) { const int v = i >> 7, n = i & 127; float s = b_mod[u * 128 + n];
#pragma unroll
            for (int w = 0; w < 8; ++w) s += red[(w * 5 + v) * 128 + n];
            mod[v * NMOD + u * 128 + n] = s; }
        __syncthreads();
    }
    __syncthreads();
}

__device__ __forceinline__ void transpose_item(const float* W, int K, int N, bf16* WT, LAS float* scr, int item, int lane) {
    const int nblk = N / 32, kb = item / nblk, nb = item % nblk, k0 = 64 * kb, n0 = 32 * nb;
#pragma unroll 8
    for (int i = 0; i < 32; ++i) { const int kk = 2 * i + (lane >> 5); scr[kk * 33 + (lane & 31)] = W[(size_t)(k0 + kk) * N + n0 + (lane & 31)]; }
    asm volatile("s_waitcnt lgkmcnt(0)" ::: "memory");
    const int c = lane & 7;
#pragma unroll
    for (int j = 0; j < 4; ++j) { const int n = (lane >> 3) + 8 * j; const LAS float* s = scr + (8 * c) * 33 + n;
        uint4 o; o.x = pk2(s[0 * 33], s[1 * 33]); o.y = pk2(s[2 * 33], s[3 * 33]); o.z = pk2(s[4 * 33], s[5 * 33]); o.w = pk2(s[6 * 33], s[7 * 33]);
        *(uint4*)(WT + (size_t)(n0 + n) * K + k0 + 8 * c) = o; }
    asm volatile("s_waitcnt lgkmcnt(0)" ::: "memory");
}
__device__ __forceinline__ void ph_conv(const Args& a, LAS unsigned char* lds) {
    const int lane = LANE, wave = WAVE, gw = GW, ngw = NGW;
    LAS float* scr = (LAS float*)(lds + wave * 16384);
    bf16* wt_in = (bf16*)(a.ws + WS_WT_IN); bf16* wt_out = (bf16*)(a.ws + WS_WT_OUT); bf16* wt_q = (bf16*)(a.ws + WS_WT_Q);
    constexpr int IT_IN = (DM / 64) * (NIN / 32), IT_OUT = (DM / 64) * (DM / 32), IT_Q = (DM / 64) * (2048 / 32);
    for (int it = gw; it < IT_IN + IT_OUT + IT_Q; it += ngw) {
        int r = it;
        if (r < IT_IN) { transpose_item(a.in[I_WIN], DM, NIN, wt_in, scr, r, lane); continue; } r -= IT_IN;
        if (r < IT_OUT) { transpose_item(a.in[I_WOUT], DM, DM, wt_out, scr, r, lane); continue; } r -= IT_OUT;
        transpose_item(a.in[I_WQ], DM, 2048, wt_q, scr, r, lane);
    }
    const int gt = blockIdx.x * 512 + TID, ngt = gridDim.x * 512;
    for (int i = gt; i < (NINP - NIN) * DM / 8; i += ngt) *(uint4*)(wt_in + (size_t)NIN * DM + (size_t)i * 8) = make_uint4(0u, 0u, 0u, 0u);
    { bf16* wlr = (bf16*)(a.ws + WS_WLR); const float* w2 = a.in[I_W2]; const float* a2 = a.in[I_A2]; const float* g2 = a.in[I_G2];
      for (int i = gt; i < NLR * (KLRW / 8); i += ngt) { const int n = i / (KLRW / 8), k0 = (i % (KLRW / 8)) * 8; const int type = n >> 11, cch = n & 2047;
          float f[8];
#pragma unroll
          for (int e = 0; e < 8; ++e) { const int k = k0 + e; float v = 0.f;
              if (type == 4) v = g2[(size_t)k * RW + cch];
              else { const int d = type & 1, kk = k - 128 * d; const float* src = type < 2 ? w2 : a2; if (kk >= 0 && kk < 96) v = src[(size_t)(d * 96 + kk) * RW + cch]; }
              f[e] = v; }
          st16(wlr + (size_t)n * KLRW + k0, pack8(f)); } }
    { bf16* kbd = (bf16*)(a.ws + WS_KBD); const float* k1 = a.in[I_K1]; const float* k2 = a.in[I_K2];
      for (int i = gt; i < 2048 * 32; i += ngt) { const int n = i >> 5, k0 = (i & 31) * 8; float f[8];
          const int h = n >> 8, sb = (n >> 7) & 1, key = n & 127;
          if ((k0 >> 7) == sb) { const float* src = (sb ? k2 : k1) + ((size_t)(h * 128 + key) * 128 + (k0 & 127)); ldf8(src, f); }
          else {
#pragma unroll
              for (int e = 0; e < 8; ++e) f[e] = 0.f; }
          st16(kbd + (size_t)n * 256 + k0, pack8(f)); } }
}

__device__ __forceinline__ void norm_mod_row(const float* src, const float* g, const float* sh, const float* sc, bf16* dst, int lane) {
    float4 v[16]; float ss = 0.f;
#pragma unroll
    for (int j = 0; j < 16; ++j) { v[j] = *(const float4*)(src + (lane + 64 * j) * 4); ss += (v[j].x * v[j].x + v[j].y * v[j].y) + (v[j].z * v[j].z + v[j].w * v[j].w); }
    const float rstd = rsqrtf(wave_sum(ss) * (1.f / DM) + RMS_EPS);
#pragma unroll
    for (int j = 0; j < 16; ++j) { const int c = (lane + 64 * j) * 4; const float4 gg = *(const float4*)(g + c), s1 = *(const float4*)(sc + c), s0 = *(const float4*)(sh + c);
        const float o0 = v[j].x * rstd * gg.x * (1.f + s1.x) + s0.x, o1 = v[j].y * rstd * gg.y * (1.f + s1.y) + s0.y, o2 = v[j].z * rstd * gg.z * (1.f + s1.z) + s0.z, o3 = v[j].w * rstd * gg.w * (1.f + s1.w) + s0.w;
        uint2 w; w.x = pk2(o0, o1); w.y = pk2(o2, o3); *(uint2*)(dst + c) = w; }
}
__device__ __forceinline__ void ph_norm1(const Args& a) {
    const int lane = LANE; const float* mod = (const float*)(a.ws + WS_MOD); bf16* A1 = (bf16*)(a.ws + WS_A1);
    for (int m = GW; m < MT; m += NGW) {
        const float* src = m < MX ? a.in[I_X] + (size_t)m * DM : a.in[I_CTX] + (size_t)(m - MX) * DM;
        const int v = m < MX ? m / SEQ : 4;
        norm_mod_row(src, a.in[I_N1G], mod + (size_t)v * NMOD, mod + (size_t)v * NMOD + DM, A1 + (size_t)m * DM, lane);
    }
}
__device__ __forceinline__ void ph_norm2(const Args& a) {
    const int lane = LANE; const float* mod = (const float*)(a.ws + WS_MOD); bf16* XN2 = (bf16*)(a.ws + WS_XN2);
    for (int m = GW; m < MX; m += NGW) {
        const int v = m / SEQ;
        norm_mod_row(a.out + (size_t)m * DM, a.in[I_N2G], mod + (size_t)v * NMOD + 3 * DM, mod + (size_t)v * NMOD + 4 * DM, XN2 + (size_t)m * DM, lane);
    }
    unsigned char* U8 = a.ws + WS_U8; unsigned char* V8 = a.ws + WS_V8; float* USC = (float*)(a.ws + WS_USC); float* VSC = (float*)(a.ws + WS_VSC);
    for (int row = GW; row < 2 * 16384; row += NGW) {
        const int tb = row >> 14, r = row & 16383;
        const float* src = (tb ? a.in[I_PV] : a.in[I_PU]) + (size_t)r * DM;
        float4 v[16]; float am = 0.f;
#pragma unroll
        for (int j = 0; j < 16; ++j) { v[j] = *(const float4*)(src + (lane + 64 * j) * 4); am = fmaxf(fmaxf(am, fmaxf(fabsf(v[j].x), fabsf(v[j].y))), fmaxf(fabsf(v[j].z), fabsf(v[j].w))); }
        am = wave_max(am);
        const float scale = am > 0.f ? am * (1.f / 7.5f) : 1.f, inv = 1.f / scale;
        unsigned char* dst = (tb ? V8 : U8) + (size_t)r * 3072 + lane * 48;
#pragma unroll
        for (int p = 0; p < 2; ++p) {
            unsigned long long w0 = 0ull, w1 = 0ull, w2 = 0ull;
#pragma unroll
            for (int k = 0; k < 32; ++k) {
                const float4 q = v[8 * p + (k >> 2)]; const float x = ((k & 3) == 0 ? q.x : (k & 3) == 1 ? q.y : (k & 3) == 2 ? q.z : q.w) * inv; const float ax = fabsf(x);
                float cf = ax < 2.f ? rintf(ax * 8.f) : (ax < 4.f ? rintf(ax * 4.f) + 8.f : rintf(ax * 2.f) + 16.f);
                cf = fminf(cf, 31.f);
                const unsigned long long code = (unsigned long long)((unsigned)cf | (x < 0.f ? 32u : 0u));
                const int pos = 6 * k, wd = pos >> 6, off = pos & 63;
                if (wd == 0) w0 |= code << off; else if (wd == 1) w1 |= code << off; else w2 |= code << off;
                if (off > 58) { if (wd == 0) w1 |= code >> (64 - off); else w2 |= code >> (64 - off); }
            }
            *(uint2*)(dst + 24 * p) = make_uint2((unsigned)w0, (unsigned)(w0 >> 32)); *(uint2*)(dst + 24 * p + 8) = make_uint2((unsigned)w1, (unsigned)(w1 >> 32)); *(uint2*)(dst + 24 * p + 16) = make_uint2((unsigned)w2, (unsigned)(w2 >> 32));
        }
        if (lane == 0) (tb ? VSC : USC)[r] = scale;
    }
}

__device__ __forceinline__ void ph_prep_rwkv(const Args& a) {
    const int lane = LANE;
    const bf16* P = (const bf16*)(a.ws + WS_P);
    bf16* R = (bf16*)(a.ws + WS_R); bf16* K = (bf16*)(a.ws + WS_K); bf16* V = (bf16*)(a.ws + WS_V); bf16* KK = (bf16*)(a.ws + WS_KK); bf16* ALR = (bf16*)(a.ws + WS_ALR);
    const float* mu = a.in[I_MU]; const float* k_k = a.in[I_KK];
    for (int m = GW; m < MT; m += NGW) {
        const bool lat = m < MX;
        bool h0, h1, h2 = false, h3 = false; size_t r0, r1, r2 = 0, r3 = 0;
        if (lat) { const int t = m & (SEQ - 1), row = t >> 6, col = t & 63; h0 = col > 0; h1 = col < 63; h2 = row > 0; h3 = row < 63; r0 = (size_t)(m - 1); r1 = (size_t)(m + 1); r2 = (size_t)(m - 64); r3 = (size_t)(m + 64); }
        else { const int t = (m - MX) & (CTXL - 1); h0 = t > 0; h1 = t < CTXL - 1; r0 = (size_t)(m - 1); r1 = (size_t)(m + 1); }
        const bf16* prow = P + (size_t)m * NINP;
#pragma unroll
        for (int i = 0; i < 14; ++i) {
            const int chunk = lane + 64 * i;
            if (chunk < RCOLS / 8) {
                const int c0 = chunk * 8;
                float own[8], n0[8], n1[8], sh[8], xm[8], muv[8];
                const uint4 z4 = make_uint4(0u, 0u, 0u, 0u);
                unpack8(ld16(prow + c0), own);
                unpack8(h0 ? ld16(P + r0 * NINP + c0) : z4, n0);
                unpack8(h1 ? ld16(P + r1 * NINP + c0) : z4, n1);
                if (lat) { float n2[8], n3[8];
                    unpack8(h2 ? ld16(P + r2 * NINP + c0) : z4, n2);
                    unpack8(h3 ? ld16(P + r3 * NINP + c0) : z4, n3);
#pragma unroll
                    for (int e = 0; e < 8; ++e) sh[e] = (e & 3) == 0 ? n0[e] : (e & 3) == 1 ? n1[e] : (e & 3) == 2 ? n2[e] : n3[e];
                } else {
#pragma unroll
                    for (int e = 0; e < 8; ++e) sh[e] = (e & 1) == 0 ? n0[e] : n1[e];
                }
                ldf8(mu + c0, muv);
#pragma unroll
                for (int e = 0; e < 8; ++e) xm[e] = own[e] + muv[e] * (sh[e] - own[e]);
                if (i < 4) st16(R + (size_t)m * RW + c0, pack8(xm));
                else if (i < 8) { const int cc = c0 - 2048; st16(K + (size_t)m * RW + cc, pack8(xm));
                    float kv[8], kkv[8]; ldf8(k_k + cc, kv); float ss = 0.f;
#pragma unroll
                    for (int e = 0; e < 8; ++e) { kkv[e] = xm[e] * kv[e]; ss += kkv[e] * kkv[e]; }
                    ss = sum8(ss);
                    const float inv = rsqrtf(fmaxf(ss, 1e-24f));
#pragma unroll
                    for (int e = 0; e < 8; ++e) kkv[e] *= inv;
                    st16(KK + (size_t)m * RW + cc, pack8(kkv)); }
                else if (i < 12) st16(V + (size_t)m * RW + (c0 - 4096), pack8(xm));
                else { const int j0 = c0 - 6144; float f[8];
#pragma unroll
                    for (int e = 0; e < 8; ++e) f[e] = j0 < 192 ? tanhf(xm[e]) : (j0 < 384 ? xm[e] : 1.f / (1.f + __expf(-xm[e])));
                    const int col = j0 < 384 ? (j0 / 96) * 128 + (j0 % 96) : j0 + 128;
                    st16(ALR + (size_t)m * KLR + col, pack8(f)); }
            } else if (i == 13 && lane < 32) {
                const int pc = lane - 16; st16(ALR + (size_t)m * KLR + (pc >> 2) * 128 + 96 + (pc & 3) * 8, make_uint4(0u, 0u, 0u, 0u));
            }
        }
    }
}

__device__ __forceinline__ void ph_prep_ssd(const Args& a) {
    const int lane = LANE;
    const bf16* P = (const bf16*)(a.ws + WS_P);
    bf16* XS = (bf16*)(a.ws + WS_XS); bf16* BC = (bf16*)(a.ws + WS_BC); bf16* Z = (bf16*)(a.ws + WS_Z); float* DT = (float*)(a.ws + WS_DT); float* LA = (float*)(a.ws + WS_LA);
    const float* cw = a.in[I_CONVW]; const float* cb = a.in[I_CONVB];
    for (int m = GW; m < MT; m += NGW) {
        const bool lat = m < MX; bool hp, hn;
        if (lat) { const int t = m & (SEQ - 1); hp = t > 0; hn = t < SEQ - 1; } else { const int t = (m - MX) & (CTXL - 1); hp = t > 0; hn = t < CTXL - 1; }
        const bf16* prow = P + (size_t)m * NINP;
#pragma unroll
        for (int i = 0; i < 8; ++i) {
            const int c0 = (lane + 64 * i) * 8; const uint4 z4 = make_uint4(0u, 0u, 0u, 0u);
            float cur[8], pv[8], nx[8], w0[8], w1[8], w2[8], bb[8], y[8];
            unpack8(ld16(prow + COL_XBC + c0), cur);
            unpack8(hp ? ld16(prow - NINP + COL_XBC + c0) : z4, pv);
            unpack8(hn ? ld16(prow + NINP + COL_XBC + c0) : z4, nx);
            ldf8(cw + c0, w0); ldf8(cw + 4096 + c0, w1); ldf8(cw + 8192 + c0, w2); ldf8(cb + c0, bb);
#pragma unroll
            for (int e = 0; e < 8; ++e) { const float t = w0[e] * pv[e] + w1[e] * cur[e] + w2[e] * nx[e] + bb[e]; y[e] = t / (1.f + __expf(-t)); }
            if (i < 4) st16(XS + (size_t)m * RW + c0, pack8(y)); else st16(BC + (size_t)m * RW + (c0 - 2048), pack8(y));
        }
        { const float raw = __uint_as_float((unsigned)prow[COL_DT + lane] << 16) + a.in[I_DTB][lane];
          const float dtv = raw > 20.f ? raw : log1pf(expf(raw));
          DT[(size_t)m * 64 + lane] = dtv; LA[(size_t)m * 64 + lane] = -dtv * expf(a.in[I_ALOG][lane]); }
        if (lat) {
#pragma unroll
            for (int i = 0; i < 4; ++i) { const int c0 = (lane + 64 * i) * 8; st16(Z + (size_t)m * RW + c0, ld16(prow + COL_Z + c0)); }
        }
    }
}

__device__ __forceinline__ int scan_row(int n, int dir, int b) { return n < CTXL ? MX + b * CTXL + (dir ? CTXL - 1 - n : n) : b * SEQ + (dir ? NSTEP - 1 - n : n - CTXL); }

struct RIn { uint4 r, k, kk, w, a; unsigned v; };
__device__ __forceinline__ void rwkv_load(RIn& x, const bf16* R, const bf16* K, const bf16* V, const bf16* KK, const bf16* LR, int m, int ch, int chi, int dir) {
    x.r = ld16(R + (size_t)m * RW + ch); x.k = ld16(K + (size_t)m * RW + ch); x.kk = ld16(KK + (size_t)m * RW + ch);
    x.w = ld16(LR + (size_t)m * NLR + dir * 2048 + ch); x.a = ld16(LR + (size_t)m * NLR + 4096 + dir * 2048 + ch);
    x.v = V[(size_t)m * RW + chi];
}
__device__ __forceinline__ float rwkv_step(float (&S)[8], const RIn& x, const float (&ka)[8]) {
    float r[8], k[8], kk[8], w1[8], av[8];
    unpack8(x.r, r); unpack8(x.k, k); unpack8(x.kk, kk); unpack8(x.w, w1); unpack8(x.a, av);
    const float v = __uint_as_float(x.v << 16);
    float sa = 0.f;
#pragma unroll
    for (int e = 0; e < 8; ++e) sa -= S[e] * kk[e];
    sa = sum8(sa);
    float o = 0.f;
#pragma unroll
    for (int e = 0; e < 8; ++e) { const float kd = k[e] * (1.f + (av[e] - 1.f) * ka[e]); const float b = kk[e] * av[e];
        S[e] = S[e] * (1.f - w1[e]) + sa * b + v * kd; o += S[e] * r[e]; }
    o = sum8(o);
    return o;
}
__device__ __forceinline__ void ph_rwkv_scan(const Args& a) {
    const int lane = LANE, wave = WAVE;
    const bf16* R = (const bf16*)(a.ws + WS_R); const bf16* K = (const bf16*)(a.ws + WS_K); const bf16* V = (const bf16*)(a.ws + WS_V); const bf16* KK = (const bf16*)(a.ws + WS_KK);
    const bf16* LR = (const bf16*)(a.ws + WS_LR); bf16* OR = (bf16*)a.out;
    for (int u = blockIdx.x; u < 256; u += gridDim.x) {
        const int g = u >> 5, h = u & 31, dir = g >> 2, b = g & 3;
        const int i = wave * 8 + (lane >> 3), jb = lane & 7, ch = h * 64 + jb * 8, chi = h * 64 + i;
        float ka[8]; ldf8(a.in[I_KA] + ch, ka);
        float S[8];
#pragma unroll
        for (int e = 0; e < 8; ++e) S[e] = 0.f;
        RIn A[4], B[4];
#pragma unroll
        for (int s = 0; s < 4; ++s) rwkv_load(A[s], R, K, V, KK, LR, scan_row(s, dir, b), ch, chi, dir);
        for (int n0 = 0; n0 < NSTEP; n0 += 8) {
#pragma unroll
            for (int s = 0; s < 4; ++s) rwkv_load(B[s], R, K, V, KK, LR, scan_row(n0 + 4 + s, dir, b), ch, chi, dir);
#pragma unroll
            for (int s = 0; s < 4; ++s) { const int n = n0 + s; const float o = rwkv_step(S, A[s], ka);
                if (n >= CTXL && jb == 0) OR[((size_t)dir * MX + scan_row(n, dir, b)) * RW + chi] = (bf16)f2bf(o); }
            if (n0 + 8 < NSTEP) {
#pragma unroll
                for (int s = 0; s < 4; ++s) rwkv_load(A[s], R, K, V, KK, LR, scan_row(n0 + 8 + s, dir, b), ch, chi, dir);
            }
#pragma unroll
            for (int s = 0; s < 4; ++s) { const int n = n0 + 4 + s; const float o = rwkv_step(S, B[s], ka);
                if (n >= CTXL && jb == 0) OR[((size_t)dir * MX + scan_row(n, dir, b)) * RW + chi] = (bf16)f2bf(o); }
        }
    }
}

typedef float f32x2_t __attribute__((ext_vector_type(2)));
constexpr int RS_TS = 32, RS_STEP_B = 6 * 256, RS_BUF_B = RS_TS * RS_STEP_B;
constexpr int RS_OBUF = 2 * RS_BUF_B, RS_OBUF_B = RS_TS * 64 * 2;
constexpr int RS_DUMP = RS_OBUF + 2 * RS_OBUF_B;
static_assert(RS_DUMP + 2048 <= 131072, "rwkv scan lds map");
struct RRaw { uint2 r, k, kk, v, w, a; };
__device__ __forceinline__ void rs_load(RRaw& x, const bf16* R, const bf16* K, const bf16* V, const bf16* KK, const bf16* LR, int m, int ch, int dir) {
    x.r = *(const uint2*)(R + (size_t)m * RW + ch); x.k = *(const uint2*)(K + (size_t)m * RW + ch); x.kk = *(const uint2*)(KK + (size_t)m * RW + ch); x.v = *(const uint2*)(V + (size_t)m * RW + ch);
    x.w = *(const uint2*)(LR + (size_t)m * NLR + dir * 2048 + ch); x.a = *(const uint2*)(LR + (size_t)m * NLR + 4096 + dir * 2048 + ch);
}
__device__ __forceinline__ void rs_stage(const RRaw& x, const float (&ka)[4], LAS unsigned char* dst) {
    const float r[4] = {bflo(x.r.x), bfhi(x.r.x), bflo(x.r.y), bfhi(x.r.y)}, k[4] = {bflo(x.k.x), bfhi(x.k.x), bflo(x.k.y), bfhi(x.k.y)};
    const float kk[4] = {bflo(x.kk.x), bfhi(x.kk.x), bflo(x.kk.y), bfhi(x.kk.y)}, v[4] = {bflo(x.v.x), bfhi(x.v.x), bflo(x.v.y), bfhi(x.v.y)};
    const float w1[4] = {bflo(x.w.x), bfhi(x.w.x), bflo(x.w.y), bfhi(x.w.y)}, av[4] = {bflo(x.a.x), bfhi(x.a.x), bflo(x.a.y), bfhi(x.a.y)};
    f32x4 nkk, w, b, kd, rr, vv;
#pragma unroll
    for (int e = 0; e < 4; ++e) { nkk[e] = -kk[e]; w[e] = 1.f - w1[e]; b[e] = kk[e] * av[e]; kd[e] = k[e] * (1.f + (av[e] - 1.f) * ka[e]); rr[e] = r[e]; vv[e] = v[e]; }
    *(LAS f32x4*)(dst) = nkk; *(LAS f32x4*)(dst + 256) = w; *(LAS f32x4*)(dst + 512) = b; *(LAS f32x4*)(dst + 768) = kd; *(LAS f32x4*)(dst + 1024) = rr; *(LAS f32x4*)(dst + 1280) = vv;
}
__device__ __forceinline__ float amul(float a, float b) { float d; asm("v_mul_f32 %0, %1, %2" : "=v"(d) : "v"(a), "v"(b)); return d; }
__device__ __forceinline__ void afmac(float& d, float a, float b) { asm("v_fmac_f32 %0, %1, %2" : "+v"(d) : "v"(a), "v"(b)); }
__device__ __forceinline__ float afma(float a, float b, float c) { float d; asm("v_fma_f32 %0, %1, %2, %3" : "=v"(d) : "v"(a), "v"(b), "v"(c)); return d; }
__device__ __forceinline__ void sum16x2(float& a, float& b) {
    asm("s_nop 1\n\t"
        "v_add_f32_dpp %0, %0, %0 quad_perm:[1,0,3,2] row_mask:0xf bank_mask:0xf bound_ctrl:1\n\t"
        "v_add_f32_dpp %1, %1, %1 quad_perm:[1,0,3,2] row_mask:0xf bank_mask:0xf bound_ctrl:1\n\t"
        "s_nop 0\n\t"
        "v_add_f32_dpp %0, %0, %0 quad_perm:[2,3,0,1] row_mask:0xf bank_mask:0xf bound_ctrl:1\n\t"
        "v_add_f32_dpp %1, %1, %1 quad_perm:[2,3,0,1] row_mask:0xf bank_mask:0xf bound_ctrl:1\n\t"
        "s_nop 0\n\t"
        "v_add_f32_dpp %0, %0, %0 row_half_mirror row_mask:0xf bank_mask:0xf bound_ctrl:1\n\t"
        "v_add_f32_dpp %1, %1, %1 row_half_mirror row_mask:0xf bank_mask:0xf bound_ctrl:1\n\t"
        "s_nop 0\n\t"
        "v_add_f32_dpp %0, %0, %0 row_mirror row_mask:0xf bank_mask:0xf bound_ctrl:1\n\t"
        "v_add_f32_dpp %1, %1, %1 row_mirror row_mask:0xf bank_mask:0xf bound_ctrl:1"
        : "+v"(a), "+v"(b));
}
template <bool OUT> __device__ __forceinline__ void rs_chunk(float (&S)[2][4], const LAS unsigned char* buf, LAS unsigned char* obuf, LAS unsigned char* dump, int j0, int i0, int jb) {
#pragma unroll 4
    for (int s = 0; s < RS_TS; ++s) {
        const LAS unsigned char* base = buf + s * RS_STEP_B;
        const f32x4 nkk = *(const LAS f32x4*)(base + j0 * 4), w = *(const LAS f32x4*)(base + 256 + j0 * 4), b = *(const LAS f32x4*)(base + 512 + j0 * 4), kd = *(const LAS f32x4*)(base + 768 + j0 * 4);
        const f32x2_t v = *(const LAS f32x2_t*)(base + 1280 + i0 * 4);
        float sa0 = amul(S[0][0], nkk[0]), sa1 = amul(S[1][0], nkk[0]);
#pragma unroll
        for (int e = 1; e < 4; ++e) { afmac(sa0, S[0][e], nkk[e]); afmac(sa1, S[1][e], nkk[e]); }
        sum16x2(sa0, sa1);
#pragma unroll
        for (int e = 0; e < 4; ++e) { float t0 = amul(sa0, b[e]), t1 = amul(sa1, b[e]); afmac(t0, v[0], kd[e]); afmac(t1, v[1], kd[e]); S[0][e] = afma(S[0][e], w[e], t0); S[1][e] = afma(S[1][e], w[e], t1); }
        if (OUT) {
            const f32x4 r = *(const LAS f32x4*)(base + 1024 + j0 * 4);
            float o0 = amul(S[0][0], r[0]), o1 = amul(S[1][0], r[0]);
#pragma unroll
            for (int e = 1; e < 4; ++e) { afmac(o0, S[0][e], r[e]); afmac(o1, S[1][e], r[e]); }
            sum16x2(o0, o1);
            *(LAS unsigned*)(jb == 0 ? obuf + (s * 64 + i0) * 2 : dump) = pg8::cvt_pk_bf16(o0, o1);
        }
    }
}
__device__ __forceinline__ void ph_rwkv_scan2(const Args& a, LAS unsigned char* lds) {
    const int tid = TID, lane = LANE, wave = WAVE;
    const bf16* R = (const bf16*)(a.ws + WS_R); const bf16* K = (const bf16*)(a.ws + WS_K); const bf16* V = (const bf16*)(a.ws + WS_V); const bf16* KK = (const bf16*)(a.ws + WS_KK);
    const bf16* LR = (const bf16*)(a.ws + WS_LR); bf16* OR = (bf16*)a.out;
    constexpr int NCH = NSTEP / RS_TS;
    for (int u = blockIdx.x; u < 256; u += gridDim.x) {
        const int g = u >> 5, h = u & 31, dir = g >> 2, b = g & 3;
        const int ip = lane >> 4, jb = lane & 15, i0 = wave * 8 + ip * 2, j0 = jb * 4;
        const int ss = tid >> 4, cgp = tid & 15, ch = h * 64 + cgp * 4;
        float ka[4];
#pragma unroll
        for (int e = 0; e < 4; ++e) ka[e] = a.in[I_KA][ch + e];
        float S[2][4];
#pragma unroll
        for (int e = 0; e < 4; ++e) { S[0][e] = 0.f; S[1][e] = 0.f; }
        RRaw raw;
        __syncthreads();
        rs_load(raw, R, K, V, KK, LR, scan_row(ss, dir, b), ch, dir);
        rs_stage(raw, ka, lds + ss * RS_STEP_B + cgp * 16);
        __syncthreads();
        for (int c = 0; c < NCH; ++c) {
            LAS unsigned char* buf = lds + (c & 1) * RS_BUF_B; LAS unsigned char* nbuf = lds + ((c + 1) & 1) * RS_BUF_B; LAS unsigned char* obuf = lds + RS_OBUF + (c & 1) * RS_OBUF_B;
            const bool more = c + 1 < NCH;
            if (more) rs_load(raw, R, K, V, KK, LR, scan_row((c + 1) * RS_TS + ss, dir, b), ch, dir);
            const bool lat = c >= CTXL / RS_TS;
            if (lat) rs_chunk<true>(S, buf, obuf, lds + RS_DUMP + tid * 4, j0, i0, jb); else rs_chunk<false>(S, buf, obuf, lds + RS_DUMP + tid * 4, j0, i0, jb);
            if (more) rs_stage(raw, ka, nbuf + ss * RS_STEP_B + cgp * 16);
            __syncthreads();
            if (lat) { typedef unsigned u32x2_t __attribute__((ext_vector_type(2))); const u32x2_t ov = *(const LAS u32x2_t*)(obuf + (ss * 64 + cgp * 4) * 2);
                *(uint2*)(OR + ((size_t)dir * MX + scan_row(c * RS_TS + ss, dir, b)) * RW + ch) = make_uint2(ov[0], ov[1]); }
        }
    }
}

struct SIn { uint4 b0, b1, c0, c1; unsigned xs; float dt, la; };
__device__ __forceinline__ void ssd_load(SIn& x, const bf16* XS, const bf16* BC, const float* DT, const float* LA, int m, int chx, int cb, int dh) {
    x.b0 = ld16(BC + (size_t)m * RW + cb); x.b1 = ld16(BC + (size_t)m * RW + cb + 8); x.c0 = ld16(BC + (size_t)m * RW + 1024 + cb); x.c1 = ld16(BC + (size_t)m * RW + 1024 + cb + 8);
    x.xs = XS[(size_t)m * RW + chx]; x.dt = DT[(size_t)m * 64 + dh]; x.la = LA[(size_t)m * 64 + dh];
}
__device__ __forceinline__ float ssd_step(float (&s)[16], const SIn& x) {
    float B0[8], B1[8], C0[8], C1[8]; unpack8(x.b0, B0); unpack8(x.b1, B1); unpack8(x.c0, C0); unpack8(x.c1, C1);
    const float dec = __expf(x.la), xdt = __uint_as_float(x.xs << 16) * x.dt; float y = 0.f;
#pragma unroll
    for (int e = 0; e < 8; ++e) { s[e] = dec * s[e] + xdt * B0[e]; y += s[e] * C0[e]; s[8 + e] = dec * s[8 + e] + xdt * B1[e]; y += s[8 + e] * C1[e]; }
    y = sum8(y);
    return y;
}
__device__ __forceinline__ void ph_ssd_scan(const Args& a) {
    const int lane = LANE, wave = WAVE;
    const bf16* XS = (const bf16*)(a.ws + WS_XS); const bf16* BC = (const bf16*)(a.ws + WS_BC); const float* DT = (const float*)(a.ws + WS_DT); const float* LA = (const float*)(a.ws + WS_LA);
    bf16* YS = (bf16*)a.out + (size_t)2 * MX * RW;
    for (int u = blockIdx.x; u < 256; u += gridDim.x) {
        const int g = u >> 5, h = u & 31, dir = g >> 2, b = g & 3;
        const int p = wave * 8 + (lane >> 3), nb = lane & 7, chx = h * 64 + p, cb = (h >> 2) * 128 + nb * 16, dh = dir * 32 + h;
        float s[16];
#pragma unroll
        for (int e = 0; e < 16; ++e) s[e] = 0.f;
        SIn A[4], B[4];
#pragma unroll
        for (int q = 0; q < 4; ++q) ssd_load(A[q], XS, BC, DT, LA, scan_row(q, dir, b), chx, cb, dh);
        for (int n0 = 0; n0 < NSTEP; n0 += 8) {
#pragma unroll
            for (int q = 0; q < 4; ++q) ssd_load(B[q], XS, BC, DT, LA, scan_row(n0 + 4 + q, dir, b), chx, cb, dh);
#pragma unroll
            for (int q = 0; q < 4; ++q) { const int n = n0 + q; const float y = ssd_step(s, A[q]);
                if (n >= CTXL && nb == 0) YS[((size_t)dir * MX + scan_row(n, dir, b)) * RW + chx] = (bf16)f2bf(y); }
            if (n0 + 8 < NSTEP) {
#pragma unroll
                for (int q = 0; q < 4; ++q) ssd_load(A[q], XS, BC, DT, LA, scan_row(n0 + 8 + q, dir, b), chx, cb, dh);
            }
#pragma unroll
            for (int q = 0; q < 4; ++q) { const int n = n0 + 4 + q; const float y = ssd_step(s, B[q]);
                if (n >= CTXL && nb == 0) YS[((size_t)dir * MX + scan_row(n, dir, b)) * RW + chx] = (bf16)f2bf(y); }
        }
    }
}

typedef short bf16x8_t __attribute__((ext_vector_type(8)));
typedef float f32x16 __attribute__((ext_vector_type(16)));
constexpr int SLD = 272;
constexpr int L_C = 0, L_B = 34816, L_BT = 69632, L_XT = 104448, L_S = 121856, L_F = 139264;
static_assert(L_F + 4 * 512 <= LDS_CTL, "ssd lds map");
typedef unsigned u32x4_t __attribute__((ext_vector_type(4)));
__device__ __forceinline__ void lds_st16(LAS unsigned char* p, const uint4& v) { *(LAS u32x4_t*)p = (u32x4_t){v.x, v.y, v.z, v.w}; }
__device__ __forceinline__ uint4 lds_ld16(const LAS unsigned char* p) { const u32x4_t t = *(const LAS u32x4_t*)p; return make_uint4(t[0], t[1], t[2], t[3]); }
__device__ __forceinline__ bf16x8_t lfrag(LAS unsigned char* img, int row, int k) { return *(LAS bf16x8_t*)(img + row * SLD + k * 2); }
__device__ __forceinline__ void ph_ssd_chunked(const Args& a, LAS unsigned char* lds) {
    const int tid = TID, lane = LANE, wave = WAVE, r = lane & 31, hh = lane >> 5;
    const bf16* XS = (const bf16*)(a.ws + WS_XS); const bf16* BC = (const bf16*)(a.ws + WS_BC); const float* DT = (const float*)(a.ws + WS_DT); const float* LA = (const float*)(a.ws + WS_LA);
    bf16* YS = (bf16*)a.out + (size_t)2 * MX * RW;
    LAS float* laS = (LAS float*)(lds + L_F); LAS float* dtS = laS + 128; LAS float* cumS = laS + 256;
    for (int u = blockIdx.x; u < 256; u += gridDim.x) {
        const int g = u >> 5, h = u & 31, dir = g >> 2, b = g & 3, gi = h >> 2;
        f32x16 st;
#pragma unroll
        for (int q = 0; q < 16; ++q) st[q] = 0.f;
        __syncthreads();
        for (int i = tid; i < 64 * SLD / 4; i += 512) ((LAS unsigned*)(lds + L_S))[i] = 0u;
        for (int c = 0; c < NSTEP / 128; ++c) {
            const int n0 = c * 128; const bool lat = c >= CTXL / 128;
            for (int i = tid; i < 2048; i += 512) { const int l = i >> 4, pc = i & 15; const size_t m = (size_t)scan_row(n0 + l, dir, b);
                lds_st16(lds + L_B + l * SLD + pc * 16, ld16(BC + m * RW + gi * 128 + pc * 8));
                if (lat) lds_st16(lds + L_C + l * SLD + pc * 16, ld16(BC + m * RW + 1024 + gi * 128 + pc * 8)); }
            for (int i = tid; i < 1024; i += 512) { const int l = i >> 3, pc = i & 7; const size_t m = (size_t)scan_row(n0 + l, dir, b);
                const uint4 v = ld16(XS + m * RW + h * 64 + pc * 8); const unsigned w[4] = {v.x, v.y, v.z, v.w};
#pragma unroll
                for (int e = 0; e < 8; ++e) *(LAS bf16*)(lds + L_XT + (pc * 8 + e) * SLD + l * 2) = (bf16)((e & 1) ? (w[e >> 1] >> 16) : (w[e >> 1] & 0xffffu)); }
            if (tid < 128) { const size_t m = (size_t)scan_row(n0 + tid, dir, b); laS[tid] = LA[m * 64 + dir * 32 + h]; dtS[tid] = DT[m * 64 + dir * 32 + h]; }
            __syncthreads();
            if (wave == 0) { const float a0 = laS[2 * lane], b0 = laS[2 * lane + 1]; float x = a0 + b0;
#pragma unroll
                for (int d = 1; d < 64; d <<= 1) { const float y = __shfl_up(x, d); if (lane >= d) x += y; }
                cumS[2 * lane + 1] = x; cumS[2 * lane] = x - b0; }
            __syncthreads();
            const float ctot = cumS[127];
            for (int i = tid; i < 2048; i += 512) { const int l = i >> 4, pc = i & 15; const float wl = dtS[l] * __expf(ctot - cumS[l]);
                float f[8]; unpack8(lds_ld16(lds + L_B + l * SLD + pc * 16), f);
#pragma unroll
                for (int e = 0; e < 8; ++e) *(LAS bf16*)(lds + L_BT + (pc * 8 + e) * SLD + l * 2) = (bf16)f2bf(f[e] * wl); }
            f32x16 acc0, acc1;
            const int lt = wave >> 1, st0 = 2 * (wave & 1);
            if (lat) {
#pragma unroll
                for (int q = 0; q < 16; ++q) { acc0[q] = 0.f; acc1[q] = 0.f; }
                if (st0 <= lt) {
#pragma unroll
                    for (int ks = 0; ks < 8; ++ks) { const bf16x8_t af = lfrag(lds + L_C, lt * 32 + r, ks * 16 + 8 * hh);
                        acc0 = __builtin_amdgcn_mfma_f32_32x32x16_bf16(af, lfrag(lds + L_B, st0 * 32 + r, ks * 16 + 8 * hh), acc0, 0, 0, 0);
                        if (st0 + 1 <= lt) acc1 = __builtin_amdgcn_mfma_f32_32x32x16_bf16(af, lfrag(lds + L_B, (st0 + 1) * 32 + r, ks * 16 + 8 * hh), acc1, 0, 0, 0); }
                }
            }
            __syncthreads();
            if (lat) {
#pragma unroll
                for (int t = 0; t < 2; ++t) { const int stt = st0 + t;
                    if (stt <= lt) { const int sidx = stt * 32 + r; const float cs = cumS[sidx], ds = dtS[sidx];
#pragma unroll
                        for (int q = 0; q < 16; ++q) { const int l = lt * 32 + (q & 3) + 8 * (q >> 2) + 4 * hh; const float v = t ? acc1[q] : acc0[q];
                            const float wv = sidx <= l ? v * __expf(cumS[l] - cs) * ds : 0.f;
                            *(LAS bf16*)(lds + L_B + l * SLD + sidx * 2) = (bf16)f2bf(wv); } } }
            }
            __syncthreads();
            if (lat) {
                const int pt = wave & 1;
                f32x16 accd, acco;
#pragma unroll
                for (int q = 0; q < 16; ++q) { accd[q] = 0.f; acco[q] = 0.f; }
                for (int ks = 0; ks < 2 * (lt + 1); ++ks)
                    accd = __builtin_amdgcn_mfma_f32_32x32x16_bf16(lfrag(lds + L_B, lt * 32 + r, ks * 16 + 8 * hh), lfrag(lds + L_XT, pt * 32 + r, ks * 16 + 8 * hh), accd, 0, 0, 0);
#pragma unroll
                for (int ks = 0; ks < 8; ++ks)
                    acco = __builtin_amdgcn_mfma_f32_32x32x16_bf16(lfrag(lds + L_C, lt * 32 + r, ks * 16 + 8 * hh), lfrag(lds + L_S, pt * 32 + r, ks * 16 + 8 * hh), acco, 0, 0, 0);
#pragma unroll
                for (int q = 0; q < 16; ++q) { const int l = lt * 32 + (q & 3) + 8 * (q >> 2) + 4 * hh; const float y = accd[q] + __expf(cumS[l]) * acco[q];
                    YS[((size_t)dir * MX + scan_row(n0 + l, dir, b)) * RW + h * 64 + pt * 32 + r] = (bf16)f2bf(y); }
            }
            const int pt2 = wave >> 2, nt = wave & 3;
            { const float dc = __expf(ctot);
#pragma unroll
              for (int q = 0; q < 16; ++q) st[q] *= dc;
#pragma unroll
              for (int ks = 0; ks < 8; ++ks)
                  st = __builtin_amdgcn_mfma_f32_32x32x16_bf16(lfrag(lds + L_XT, pt2 * 32 + r, ks * 16 + 8 * hh), lfrag(lds + L_BT, nt * 32 + r, ks * 16 + 8 * hh), st, 0, 0, 0); }
            __syncthreads();
#pragma unroll
            for (int q = 0; q < 16; ++q) { const int p = pt2 * 32 + (q & 3) + 8 * (q >> 2) + 4 * hh; *(LAS bf16*)(lds + L_S + p * SLD + (nt * 32 + r) * 2) = (bf16)f2bf(st[q]); }
            __syncthreads();
        }
    }
}

__device__ __forceinline__ void ph_finish(const Args& a) {
    const int lane = LANE;
    const bf16* R = (const bf16*)(a.ws + WS_R); const bf16* K = (const bf16*)(a.ws + WS_K); const bf16* V = (const bf16*)(a.ws + WS_V);
    const bf16* LR = (const bf16*)(a.ws + WS_LR); const bf16* XS = (const bf16*)(a.ws + WS_XS); const bf16* Z = (const bf16*)(a.ws + WS_Z);
    const bf16* OR = (const bf16*)a.out; const bf16* YS = (const bf16*)a.out + (size_t)2 * MX * RW;
    bf16* A2 = (bf16*)(a.ws + WS_A2);
    for (int m = GW; m < MX; m += NGW) {
#pragma unroll
        for (int i = 0; i < 4; ++i) {
            const int c0 = (lane + 64 * i) * 8;
            float of[8], ob[8], o[8], res[8];
#if MK_SKIP_RWKV
#pragma unroll
            for (int e = 0; e < 8; ++e) res[e] = 0.f;
#else
            unpack8(ld16(OR + (size_t)m * RW + c0), of); unpack8(ld16(OR + ((size_t)MX + m) * RW + c0), ob);
            float sm = 0.f;
#pragma unroll
            for (int e = 0; e < 8; ++e) { o[e] = of[e] + ob[e]; sm += o[e]; }
            sm = sum8(sm);
            const float mean = sm * (1.f / 64.f); float sq = 0.f;
#pragma unroll
            for (int e = 0; e < 8; ++e) { o[e] -= mean; sq += o[e] * o[e]; }
            sq = sum8(sq);
            const float rstd = rsqrtf(sq * (1.f / 64.f) + GN_EPS);
            float lw[8], lb[8], r[8], k[8], v[8], a0[8], a1[8], ka[8], rk[8], gg[8];
            ldf8(a.in[I_LNW] + c0, lw); ldf8(a.in[I_LNB] + c0, lb); ldf8(a.in[I_KA] + c0, ka); ldf8(a.in[I_RK] + c0, rk);
            unpack8(ld16(R + (size_t)m * RW + c0), r); unpack8(ld16(K + (size_t)m * RW + c0), k); unpack8(ld16(V + (size_t)m * RW + c0), v);
            unpack8(ld16(LR + (size_t)m * NLR + 4096 + c0), a0); unpack8(ld16(LR + (size_t)m * NLR + 6144 + c0), a1); unpack8(ld16(LR + (size_t)m * NLR + 8192 + c0), gg);
            float bs = 0.f;
#pragma unroll
            for (int e = 0; e < 8; ++e) { const float kd = k[e] * (2.f + (a0[e] + a1[e] - 2.f) * ka[e]); bs += r[e] * kd * rk[e]; }
            bs = sum8(bs);
#pragma unroll
            for (int e = 0; e < 8; ++e) res[e] = (o[e] * rstd * lw[e] + lb[e] + bs * v[e]) * gg[e];
#endif
            st16(A2 + (size_t)m * DM + c0, pack8(res));
        }
#pragma unroll
        for (int i = 0; i < 4; ++i) {
            const int c0 = (lane + 64 * i) * 8;
            float yf[8], yb[8], xs[8], z[8], nw[8], y[8];
#if MK_SKIP_SSD
#pragma unroll
            for (int e = 0; e < 8; ++e) y[e] = 0.f;
#else
            unpack8(ld16(YS + (size_t)m * RW + c0), yf); unpack8(ld16(YS + ((size_t)MX + m) * RW + c0), yb);
            unpack8(ld16(XS + (size_t)m * RW + c0), xs); unpack8(ld16(Z + (size_t)m * RW + c0), z); ldf8(a.in[I_NORMW] + c0, nw);
            const float dsk = a.in[I_SSMD][c0 >> 6]; float ss = 0.f;
#pragma unroll
            for (int e = 0; e < 8; ++e) { y[e] = (yf[e] + yb[e] + dsk * xs[e]) * (z[e] / (1.f + __expf(-z[e]))); ss += y[e] * y[e]; }
            ss = sum32(ss);
            const float rstd = rsqrtf(ss * (1.f / 256.f) + RMS_EPS);
#pragma unroll
            for (int e = 0; e < 8; ++e) y[e] = y[e] * rstd * nw[e];
#endif
            st16(A2 + (size_t)m * DM + 2048 + c0, pack8(y));
        }
    }
}

__device__ __forceinline__ float enc_key(float v, int idx) { return __uint_as_float((__float_as_uint(v) & 0xffffff00u) | (unsigned)idx); }
typedef float f32x32_t __attribute__((ext_vector_type(32)));
typedef unsigned u32x6_t __attribute__((ext_vector_type(6)));
struct Fp6Row { uint4 q0, q1, q2; };
__device__ __forceinline__ Fp6Row ld_fp6row(const unsigned char* p) { Fp6Row r; r.q0 = *(const uint4*)p; r.q1 = *(const uint4*)(p + 16); r.q2 = *(const uint4*)(p + 32); return r; }
__device__ __forceinline__ f32x32_t fp6_unpack(const Fp6Row& r, int p, float one) {
    u32x6_t s; if (p == 0) { s[0] = r.q0.x; s[1] = r.q0.y; s[2] = r.q0.z; s[3] = r.q0.w; s[4] = r.q1.x; s[5] = r.q1.y; } else { s[0] = r.q1.z; s[1] = r.q1.w; s[2] = r.q2.x; s[3] = r.q2.y; s[4] = r.q2.z; s[5] = r.q2.w; }
    return __builtin_amdgcn_cvt_scalef32_pk32_f32_fp6(s, one);
}
#define PIN4(a) asm volatile("" : "+v"((a)[0]), "+v"((a)[1]), "+v"((a)[2]), "+v"((a)[3]))
__device__ __forceinline__ void ph_peer(const Args& a, float* outp) {
    const int lane = LANE;
    const float* mod = (const float*)(a.ws + WS_MOD); const float* S = (const float*)(a.ws + WS_S);
    const unsigned char* U8 = (const unsigned char*)(a.ws + WS_U8); const unsigned char* V8 = (const unsigned char*)(a.ws + WS_V8);
    const float* USC = (const float*)(a.ws + WS_USC); const float* VSC = (const float*)(a.ws + WS_VSC);
    for (int m = GW; m < MX; m += NGW) {
        const int bb = m / SEQ;
        float* hrow = a.out + (size_t)m * DM;
        int l4 = lane * 4; asm volatile("" : "+v"(l4));
        float acc[16][4];
#if MK_SKIP_PEER
#pragma unroll
        for (int j = 0; j < 16; ++j)
#pragma unroll
            for (int e = 0; e < 4; ++e) acc[j][e] = 0.f;
#else
        float xn[16][4];
        { float ss = 0.f;
#pragma unroll
          for (int j = 0; j < 16; ++j) { const float4 h4 = *(const float4*)(hrow + 256 * j + l4); xn[j][0] = h4.x; xn[j][1] = h4.y; xn[j][2] = h4.z; xn[j][3] = h4.w; ss += (h4.x * h4.x + h4.y * h4.y) + (h4.z * h4.z + h4.w * h4.w); }
          const float rstd = rsqrtf(wave_sum(ss) * (1.f / DM) + RMS_EPS);
          const float* sh2 = mod + (size_t)bb * NMOD + 3 * DM; const float* sc2 = mod + (size_t)bb * NMOD + 4 * DM; const float* g2 = a.in[I_N2G];
#pragma unroll
          for (int j = 0; j < 16; ++j) { const int c = 256 * j + l4; const float4 gg = *(const float4*)(g2 + c), s0 = *(const float4*)(sh2 + c), s1 = *(const float4*)(sc2 + c);
              xn[j][0] = xn[j][0] * rstd * gg.x * (1.f + s1.x) + s0.x; xn[j][1] = xn[j][1] * rstd * gg.y * (1.f + s1.y) + s0.y; xn[j][2] = xn[j][2] * rstd * gg.z * (1.f + s1.z) + s0.z; xn[j][3] = xn[j][3] * rstd * gg.w * (1.f + s1.w) + s0.w;
              if ((j & 3) == 3) { PIN4(xn[j - 3]); PIN4(xn[j - 2]); PIN4(xn[j - 1]); PIN4(xn[j]); asm volatile("" ::: "memory"); } } }
        int eid0 = 0, eid1 = 0; float gt0 = 0.f, gt1 = 0.f;
        const float NEG = -3.0e38f;
#pragma unroll 1
        for (int hd = 0; hd < 8; ++hd) {
            const float* srow = S + (size_t)m * 2048 + hd * 256;
            float c1a = enc_key(srow[lane], lane), c1b = enc_key(srow[64 + lane], 64 + lane), c2a = enc_key(srow[128 + lane], lane), c2b = enc_key(srow[192 + lane], 64 + lane);
            float t1 = NEG, t2 = NEG;
#pragma unroll 1
            for (int k = 0; k < 16; ++k) {
                const float m1 = wave_max(fmaxf(c1a, c1b)), m2 = wave_max(fmaxf(c2a, c2b));
                if (c1a == m1) c1a = NEG; if (c1b == m1) c1b = NEG; if (c2a == m2) c2a = NEG; if (c2b == m2) c2b = NEG;
                if (lane == k) { t1 = m1; t2 = m2; }
            }
            const float v1 = __uint_as_float(__float_as_uint(t1) & 0xffffff00u), v2 = __uint_as_float(__float_as_uint(t2) & 0xffffff00u);
            const int i1 = (int)(__float_as_uint(t1) & 0xffu), i2 = (int)(__float_as_uint(t2) & 0xffu);
            float cd[4];
#pragma unroll
            for (int e = 0; e < 4; ++e) { const float va = __shfl(v1, (lane >> 4) + 4 * e), vb = __shfl(v2, lane & 15); cd[e] = enc_key(va + vb, lane + 64 * e); }
            float best = NEG; int ex = 0;
#pragma unroll 1
            for (int k = 0; k < 16; ++k) {
                const float mx = wave_max(fmaxf(fmaxf(cd[0], cd[1]), fmaxf(cd[2], cd[3])));
#pragma unroll
                for (int e = 0; e < 4; ++e) if (cd[e] == mx) cd[e] = NEG;
                const int cidx = (int)(__float_as_uint(mx) & 0xffu);
                const int ea = __shfl(i1, cidx >> 4), eb = __shfl(i2, cidx & 15);
                if (lane == k) { best = __uint_as_float(__float_as_uint(mx) & 0xffffff00u); ex = ea * 128 + eb; }
            }
            const float bmax = __shfl(best, 0);
            const float pe = lane < 16 ? __expf(best - bmax) : 0.f;
            const float gate = pe / wave_sum(pe);
            const float gsh = __shfl(gate, lane & 15); const int esh = __shfl(ex, lane & 15);
            if ((lane >> 4) == (hd & 3)) { if (hd < 4) { gt0 = gsh; eid0 = esh; } else { gt1 = gsh; eid1 = esh; } }
        }
        const int l48 = lane * 48;
        float cf0 = 0.f, cf1 = 0.f;
#pragma unroll 1
        for (int p0 = 0; p0 < 128; p0 += 4) {
            float d[4]; Fp6Row qu[4];
#pragma unroll
            for (int q = 0; q < 4; ++q) { const int e = __builtin_amdgcn_readlane(p0 < 64 ? eid0 : eid1, (p0 + q) & 63); qu[q] = ld_fp6row(U8 + (size_t)e * 3072 + l48); }
#pragma unroll
            for (int q = 0; q < 4; ++q) {
                float dd = 0.f;
#pragma unroll
                for (int p = 0; p < 2; ++p) { float one = 1.0f; asm volatile("" : "+v"(one)); const f32x32_t f = fp6_unpack(qu[q], p, one);
#pragma unroll
                    for (int t = 0; t < 32; ++t) dd += xn[8 * p + (t >> 2)][t & 3] * f[t];
                    asm volatile("" : "+v"(dd)); }
                d[q] = dd;
            }
#pragma unroll
            for (int q = 0; q < 4; ++q) {
                const int p = p0 + q; const int e = __builtin_amdgcn_readlane(p0 < 64 ? eid0 : eid1, p & 63);
                const float dot = wave_sum(d[q]) * USC[e];
                const float act = 0.5f * dot * (1.f + erff(dot * 0.70710678f)) * VSC[e];
                if (lane == (p & 63)) { if (p0 < 64) cf0 = gt0 * act; else cf1 = gt1 * act; }
            }
        }
#pragma unroll
        for (int j = 0; j < 16; ++j)
#pragma unroll
            for (int e = 0; e < 4; ++e) acc[j][e] = 0.f;
#pragma unroll 1
        for (int p0 = 0; p0 < 128; p0 += 4) {
            Fp6Row qv[4]; float cfv[4];
#pragma unroll
            for (int q = 0; q < 4; ++q) { const int e = __builtin_amdgcn_readlane(p0 < 64 ? eid0 : eid1, (p0 + q) & 63); cfv[q] = rlane(p0 < 64 ? cf0 : cf1, (p0 + q) & 63); qv[q] = ld_fp6row(V8 + (size_t)e * 3072 + l48); }
#pragma unroll
            for (int q = 0; q < 4; ++q)
#pragma unroll
                for (int p = 0; p < 2; ++p) { float one = 1.0f; asm volatile("" : "+v"(one)); const f32x32_t f = fp6_unpack(qv[q], p, one);
#pragma unroll
                    for (int t = 0; t < 32; ++t) acc[8 * p + (t >> 2)][t & 3] += cfv[q] * f[t];
#pragma unroll
                    for (int jj = 0; jj < 8; ++jj) PIN4(acc[8 * p + jj]); }
        }
#endif
        { const float* gt2 = mod + (size_t)bb * NMOD + 5 * DM; float ss = 0.f;
#pragma unroll
          for (int j = 0; j < 16; ++j) { const int c = 256 * j + l4; const float4 g = *(const float4*)(gt2 + c), h4 = *(const float4*)(hrow + c);
              acc[j][0] = h4.x + g.x * acc[j][0]; acc[j][1] = h4.y + g.y * acc[j][1]; acc[j][2] = h4.z + g.z * acc[j][2]; acc[j][3] = h4.w + g.w * acc[j][3];
              ss += (acc[j][0] * acc[j][0] + acc[j][1] * acc[j][1]) + (acc[j][2] * acc[j][2] + acc[j][3] * acc[j][3]);
              if ((j & 3) == 3) { PIN4(acc[j - 3]); PIN4(acc[j - 2]); PIN4(acc[j - 1]); PIN4(acc[j]); asm volatile("" ::: "memory"); } }
          const float rstd = rsqrtf(wave_sum(ss) * (1.f / DM) + RMS_EPS);
#pragma unroll
          for (int j = 0; j < 16; ++j) { const int c = 256 * j + l4; const float4 fg = *(const float4*)(a.in[I_FG] + c);
              *(float4*)(outp + (size_t)m * DM + c) = make_float4(acc[j][0] * rstd * fg.x, acc[j][1] * rstd * fg.y, acc[j][2] * rstd * fg.z, acc[j][3] * rstd * fg.w);
              if ((j & 3) == 3) asm volatile("" ::: "memory"); } }
    }
}

constexpr int N_PHASES = 13;
__global__ void __launch_bounds__(512, 2) hybrid_fwd(Args args) {
    extern __shared__ __attribute__((aligned(16))) unsigned char lds_raw[];
    LAS unsigned char* lds = (LAS unsigned char*)lds_raw;
    volatile LAS unsigned* MISC = (volatile LAS unsigned*)(lds + LDS_MISC);
    for (int u = TID; u < (LDS_BYTES - LDS_CTL) / 4; u += 512) ((LAS unsigned*)(lds + LDS_CTL))[u] = 0u;
    __syncthreads();
    const int lo = args.ph_lo, hi = args.ph_hi;
    XcdBarrier bar; bar.bar = (unsigned*)(args.ws + WS_CTL); bar.x = 0; bar.st = nullptr;
    if (hi - lo > 1) bar = xcd_barrier_post((unsigned*)(args.ws + WS_CTL), MISC + 8);
#define IN(k) (lo <= (k) && (k) < hi && ((MK_PHASE_MASK >> (k)) & 1))
#define SEAM(k) do { if (IN(k) && IN((k) + 1)) xcd_barrier(bar); } while (0)
    const int bid = (int)blockIdx.x, G = (int)gridDim.x;

    if (IN(0)) { ph_mod(args, lds); ph_conv(args, lds); if (MK_REPEAT == 0) { ph_mod(args, lds); ph_conv(args, lds); } }
    SEAM(0);
    if (IN(1)) { ph_norm1(args); if (MK_REPEAT == 1) ph_norm1(args); }
    SEAM(1);
    if (IN(2)) { pg8::Gemm g{(const bf16*)(args.ws + WS_A1), (const bf16*)(args.ws + WS_WT_IN), MT, NINP, DM, DM, DM, 0, 0}; pg8::StaticOrder S; S.init(MT, NINP, G, bid);
        pg8::EpiBf16<0> E{(bf16*)(args.ws + WS_P), NINP, nullptr, 0, 0}; pg8::gemm_phase<pg8::EpiBf16<0>, pg8::StaticOrder>(lds, g, S, E, nullptr); }
    SEAM(2);
    if (IN(3)) { ph_prep_rwkv(args); ph_prep_ssd(args); if (MK_REPEAT == 3) { ph_prep_rwkv(args); ph_prep_ssd(args); } }
    SEAM(3);
    if (IN(4)) { int kw = KLRW; asm volatile("" : "+s"(kw));
        pg8::Gemm g{(const bf16*)(args.ws + WS_ALR), (const bf16*)(args.ws + WS_WLR), MT, NLR, kw, KLR, KLRW, 4, 256}; pg8::StaticOrder S; S.init(MT, NLR, G, bid);
        EpiLR E{(bf16*)(args.ws + WS_LR), args.in[I_W0], args.in[I_A0]}; pg8::gemm_phase<EpiLR, pg8::StaticOrder>(lds, g, S, E, nullptr); }
    SEAM(4);
#if MK_RWKV_SEQ
    if (IN(5)) { ph_rwkv_scan(args); if (MK_REPEAT == 5) ph_rwkv_scan(args); }
#else
    if (IN(5)) { ph_rwkv_scan2(args, lds); if (MK_REPEAT == 5) ph_rwkv_scan2(args, lds); }
#endif
    SEAM(5);
#if MK_SSD_SEQ
    if (IN(6)) { ph_ssd_scan(args); if (MK_REPEAT == 6) ph_ssd_scan(args); }
#else
    if (IN(6)) { ph_ssd_chunked(args, lds); if (MK_REPEAT == 6) ph_ssd_chunked(args, lds); }
#endif
    SEAM(6);
    if (IN(7)) { ph_finish(args); if (MK_REPEAT == 7) ph_finish(args); }
    SEAM(7);
    if (IN(8)) { pg8::Gemm g{(const bf16*)(args.ws + WS_A2), (const bf16*)(args.ws + WS_WT_OUT), MX, DM, DM, DM, DM, 0, 0}; pg8::StaticOrder S; S.init(MX, DM, G, bid);
        EpiRes E{args.out, args.in[I_X], (const float*)(args.ws + WS_MOD)}; pg8::gemm_phase<EpiRes, pg8::StaticOrder>(lds, g, S, E, nullptr); }
    SEAM(8);
    if (IN(9)) { ph_norm2(args); if (MK_REPEAT == 9) ph_norm2(args); }
    SEAM(9);
    if (IN(10)) { pg8::Gemm g{(const bf16*)(args.ws + WS_XN2), (const bf16*)(args.ws + WS_WT_Q), MX, 2048, DM, DM, DM, 0, 0}; pg8::StaticOrder S; S.init(MX, 2048, G, bid);
        pg8::EpiBf16<0> E{(bf16*)(args.ws + WS_Q), 2048, nullptr, 0, 0}; pg8::gemm_phase<pg8::EpiBf16<0>, pg8::StaticOrder>(lds, g, S, E, nullptr); }
    SEAM(10);
    if (IN(11)) { int kw = 256; asm volatile("" : "+s"(kw));
        pg8::Gemm g{(const bf16*)(args.ws + WS_Q), (const bf16*)(args.ws + WS_KBD), MX, 2048, kw, 2048, 256, 0, 256}; pg8::StaticOrder S; S.init(MX, 2048, G, bid);
        pg8::EpiF32 E{(float*)(args.ws + WS_S), 2048, nullptr}; pg8::gemm_phase<pg8::EpiF32, pg8::StaticOrder>(lds, g, S, E, nullptr); }
    SEAM(11);
    if (IN(12)) { if (MK_REPEAT == 12) ph_peer(args, (float*)(args.ws + 903 * MiB)); ph_peer(args, args.out); }
#undef IN
#undef SEAM
}

extern "C" void kernel_launch(void* const* d_in, const int* in_sizes, int n_in, void* d_out, int out_size, void* d_ws, size_t ws_size, hipStream_t stream) {
    static int grid = 0;
    if (grid == 0) {
        if (n_in != N_IN || out_size != MX * DM || ws_size < WS_END) { fprintf(stderr, "kernel_launch: unexpected shapes (n_in %d out %d ws %zu)\n", n_in, out_size, ws_size); grid = -1; return; }
        int dev = 0, cus = 0, per_cu = 0;
        if (hipGetDevice(&dev) != hipSuccess || hipDeviceGetAttribute(&cus, hipDeviceAttributeMultiprocessorCount, dev) != hipSuccess) { grid = -1; return; }
        if (hipFuncSetAttribute((const void*)hybrid_fwd, hipFuncAttributeMaxDynamicSharedMemorySize, LDS_BYTES) != hipSuccess) { fprintf(stderr, "kernel_launch: hipFuncSetAttribute failed\n"); grid = -1; return; }
        if (hipOccupancyMaxActiveBlocksPerMultiprocessor(&per_cu, (const void*)hybrid_fwd, 512, LDS_BYTES) != hipSuccess || per_cu < 1) fprintf(stderr, "kernel_launch: occupancy query reports %d\n", per_cu);
        (void)hipGetLastError();
        grid = cus;
    }
    if (grid < 0) return;
    (void)in_sizes;
    if (hipMemsetAsync((char*)d_ws + WS_CTL, 0, CTL_ZERO_BYTES, stream) != hipSuccess) return;
    Args a{};
    for (int i = 0; i < N_IN; ++i) a.in[i] = (const float*)d_in[i];
    a.out = (float*)d_out; a.ws = (unsigned char*)d_ws;
#if MK_N_LAUNCHES == 1
    a.ph_lo = 0; a.ph_hi = N_PHASES;
    hipLaunchKernelGGL(hybrid_fwd, dim3(grid), dim3(512), LDS_BYTES, stream, a);
#else
    for (int ph = 0; ph < N_PHASES; ++ph) { if (!((MK_PHASE_MASK >> ph) & 1)) continue; a.ph_lo = ph; a.ph_hi = ph + 1; hipLaunchKernelGGL(hybrid_fwd, dim3(grid), dim3(512), LDS_BYTES, stream, a); }
#endif
}
```

```cpp
#include <hip/hip_runtime.h>
#include <stdint.h>
#include <stdio.h>
namespace pg8 {
#define PG8_LAS __attribute__((address_space(3)))
typedef unsigned short bf16_t;
typedef short bf16x8 __attribute__((ext_vector_type(8)));
typedef float f32x4 __attribute__((ext_vector_type(4)));
typedef unsigned u32x4 __attribute__((ext_vector_type(4)));
constexpr int BM = 256, BK = 64, HALF = 128, HTB = HALF * BK * 2  , STAGE_BYTES = 8 * HTB, NXCD = 8, WGM = 8;

__host__ __device__ __forceinline__ int lds_byte(int r, int c) { const int st = (r >> 4) * 2 + (c >> 5), rr = r & 15, cc = c & 31, ob = rr * 64 + cc * 2; return st * 1024 + (ob ^ (((ob >> 9) & 1) << 5)); }
__host__ __device__ __forceinline__ void stage_rc(int b, int& R, int& C) { const int st = b / 1024, sb = b % 1024, swz = sb ^ (((sb >> 9) & 1) << 5); R = (st >> 1) * 16 + swz / 64; C = (st & 1) * 32 + (swz % 64) / 2; }
__host__ __device__ __forceinline__ int perm32(int rho) { const int n = rho >> 4, i = rho & 15; return 8 * (i >> 2) + 4 * n + (i & 3); }

struct Unit { int pm, pn; };
struct Gemm { const bf16_t* A; const bf16_t* Bt; int M, N, K; int lda, ldb, kshift, kmul; };

struct StaticOrder {
    int nM, nN, nwg, G, c;
    __host__ __device__ void init(int M, int N, int G_, int c_) { nM = M / BM; nN = N / BM; nwg = nM * nN; G = G_; c = c_; }
    __host__ __device__ bool next(int i, Unit& u) const {
        const long L = (long)i * G + c; if (L >= nwg) return false;
        int wgid = (int)L; { const int q = nwg / NXCD, r = nwg % NXCD, xcd = wgid % NXCD, off = wgid / NXCD; wgid = (xcd < r ? xcd * (q + 1) : r * (q + 1) + (xcd - r) * q) + off; }
        const int nig = WGM * nN, gid = wgid / nig, fm = gid * WGM, gsz = (nM - fm) < WGM ? (nM - fm) : WGM;
        u.pm = fm + ((wgid % nig) % gsz); u.pn = (wgid % nig) / gsz; return true;
    }
    __device__ __forceinline__ void a_ready(const Unit&) const {}
    __device__ __forceinline__ void done(const Unit&) const {}
};
__device__ __forceinline__ unsigned cvt_pk_bf16(float lo, float hi) { unsigned r; asm volatile("v_cvt_pk_bf16_f32 %0, %1, %2" : "=v"(r) : "v"(lo), "v"(hi)); return r; }
typedef float f32x2 __attribute__((ext_vector_type(2)));
__device__ __forceinline__ f32x2 gelu_pk(f32x2 v) {
    const f32x2 av = __builtin_elementwise_abs(v), d = av * 0.2316418882f + 1.0f;
    f32x2 t; t.x = __builtin_amdgcn_rcpf(d.x); t.y = __builtin_amdgcn_rcpf(d.y);
    f32x2 q = t * 0.5307027145f + (-0.7265760135f); q = q * t + 0.7107068705f; q = q * t + (-0.142248368f); q = q * t + 0.127414796f; q = q * t;
    const f32x2 s = (v * v) * (-0.72134752044f);
    f32x2 e; e.x = __builtin_amdgcn_exp2f(s.x); e.y = __builtin_amdgcn_exp2f(s.y);
    const f32x2 m = v * (q * e), r = v - m;
    f32x2 o; o.x = v.x < 0.f ? m.x : r.x; o.y = v.y < 0.f ? m.y : r.y; return o;
}

struct EpiF32 {
    static constexpr bool PERM = false, AFTER_DRAIN = false;
    float* C; int ldc; const float* bias;
    __device__ __forceinline__ void operator()(const f32x4 (&acc)[2][2][4][2], const Unit& u, int wr, int wc, int fr, int fq) const {
        const int row0 = u.pm * BM + wr * 64 + fr, col0 = u.pn * BM + wc * 32 + 4 * fq;
        f32x4 bv[2][2];
#pragma unroll
        for (int bj = 0; bj < 2; ++bj)
#pragma unroll
            for (int n = 0; n < 2; ++n) bv[bj][n] = bias ? *(const f32x4*)(bias + col0 + bj * HALF + n * 16) : (f32x4){0.f, 0.f, 0.f, 0.f};
#pragma unroll
        for (int ai = 0; ai < 2; ++ai)
#pragma unroll
            for (int m = 0; m < 4; ++m) { float* rowp = C + (size_t)(row0 + ai * HALF + m * 16) * ldc + col0;
#pragma unroll
                for (int bj = 0; bj < 2; ++bj)
#pragma unroll
                    for (int n = 0; n < 2; ++n) *(f32x4*)(rowp + bj * HALF + n * 16) = acc[ai][bj][m][n] + bv[bj][n]; }
    }
};
template <int ACT  > struct EpiBf16 {
    static constexpr bool PERM = true, AFTER_DRAIN = false;
    bf16_t* O; int ldc; const float* bias; int split_cols; size_t split_stride;
    __device__ __forceinline__ void operator()(const f32x4 (&acc)[2][2][4][2], const Unit& u, int wr, int wc, int fr, int fq) const {
        const int row0 = u.pm * BM + wr * 64 + fr; int colt = u.pn * BM; bf16_t* base = O;
        if (split_cols) { const int t = colt / split_cols; base += (size_t)t * split_stride; colt -= t * split_cols; }
        const int col0 = colt + wc * 32 + 8 * fq, bcol0 = u.pn * BM + wc * 32 + 8 * fq;
        f32x4 bv[2][2];
#pragma unroll
        for (int bj = 0; bj < 2; ++bj)
#pragma unroll
            for (int n = 0; n < 2; ++n) bv[bj][n] = bias ? *(const f32x4*)(bias + bcol0 + bj * HALF + 4 * n) : (f32x4){0.f, 0.f, 0.f, 0.f};
#pragma unroll
        for (int ai = 0; ai < 2; ++ai)
#pragma unroll
            for (int m = 0; m < 4; ++m) { bf16_t* rowp = base + (size_t)(row0 + ai * HALF + m * 16) * ldc + col0;
#pragma unroll
                for (int bj = 0; bj < 2; ++bj) { f32x4 v0 = acc[ai][bj][m][0] + bv[bj][0], v1 = acc[ai][bj][m][1] + bv[bj][1];
                    if (ACT == 1) { f32x2 a = gelu_pk((f32x2){v0[0], v0[1]}), b = gelu_pk((f32x2){v0[2], v0[3]}), c = gelu_pk((f32x2){v1[0], v1[1]}), d = gelu_pk((f32x2){v1[2], v1[3]});
                        v0 = (f32x4){a.x, a.y, b.x, b.y}; v1 = (f32x4){c.x, c.y, d.x, d.y}; }
                    if (ACT == 2) {
#pragma unroll
                        for (int j = 0; j < 4; ++j) { v0[j] = 0.5f * v0[j] * (1.0f + erff(v0[j] * 0.70710678f)); v1[j] = 0.5f * v1[j] * (1.0f + erff(v1[j] * 0.70710678f)); } }
                    u32x4 w; w.x = cvt_pk_bf16(v0[0], v0[1]); w.y = cvt_pk_bf16(v0[2], v0[3]); w.z = cvt_pk_bf16(v1[0], v1[1]); w.w = cvt_pk_bf16(v1[2], v1[3]);
                    *(u32x4*)(rowp + bj * HALF) = w; } }
    }
};
template <class Epi, class Sched, bool STAMP = false>
__device__ __forceinline__ void gemm_phase(PG8_LAS unsigned char* lds, const Gemm g, const Sched& S, const Epi& E, unsigned long long* stamps) {
    const int tid = threadIdx.x, wid = __builtin_amdgcn_readfirstlane(tid >> 6), lane = tid & 63, wr = wid >> 2, wc = wid & 3, fr = lane & 15, fq = lane >> 4;
    const int K = g.K, nt = K / BK;
    int ts_lo = 0, ts_hi = 0, nts = 0; const unsigned long long rt_entry = STAMP ? (unsigned long long)wall_clock64() : 0ull;
#define PG8_STAMP() do { if (STAMP && wid == 0 && nts < 64) { const unsigned long long _c = (unsigned long long)clock64(); \
        ts_lo = (lane == nts) ? (int)(unsigned)_c : ts_lo; ts_hi = (lane == nts) ? (int)(unsigned)(_c >> 32) : ts_hi; ++nts; } } while (0)
    PG8_STAMP();
    unsigned voffA[2], voffB[2];
#pragma unroll
    for (int i = 0; i < 2; ++i) { int R, C; stage_rc(tid * 16 + i * 8192, R, C); const int Rb = Epi::PERM ? ((R & ~31) + perm32(R & 31)) : R;
        voffA[i] = (unsigned)(R * g.lda + C) * 2u; voffB[i] = (unsigned)(Rb * g.ldb + C) * 2u; }
    const size_t kstep = (size_t)(BK * 2);
    const size_t hstepA = (size_t)HALF * g.lda * 2, hstepB = (size_t)HALF * g.ldb * 2;
    const size_t tstepA = 2 * hstepA, tstepB = 2 * hstepB;
    const unsigned ldsw = (unsigned)wid * 1024u;
    const int aoff = lds_byte(wr * 64 + fr, fq * 8), boff = lds_byte(wc * 32 + fr, fq * 8);
#define PG8_SA(b, h) (((b) * 2 + (h)) * HTB)
#define PG8_SB(b, h) ((4 + (b) * 2 + (h)) * HTB)
#define PG8_STAGE(bufoff, gbase, voff) do { _Pragma("unroll") for (int _i = 0; _i < 2; ++_i) \
        __builtin_amdgcn_global_load_lds((const unsigned*)((const char*)(gbase) + (voff)[_i]), (PG8_LAS unsigned*)(lds + (bufoff) + ldsw + _i * 8192), 16, 0, 0); } while (0)
#define PG8_LDA(dst, b, h) do { _Pragma("unroll") for (int m = 0; m < 4; ++m) _Pragma("unroll") for (int k = 0; k < 2; ++k) dst[m][k] = *(const PG8_LAS bf16x8*)(lds + PG8_SA(b, h) + aoff + m * 2048 + k * 1024); } while (0)
#define PG8_LDB(dst, b, h) do { _Pragma("unroll") for (int n = 0; n < 2; ++n) _Pragma("unroll") for (int k = 0; k < 2; ++k) dst[n][k] = *(const PG8_LAS bf16x8*)(lds + PG8_SB(b, h) + boff + n * 2048 + k * 1024); } while (0)
#define PG8_MMA(ai, bj, At, Bt) do { __builtin_amdgcn_s_setprio(1); _Pragma("unroll") for (int m = 0; m < 4; ++m) _Pragma("unroll") for (int n = 0; n < 2; ++n) _Pragma("unroll") for (int k = 0; k < 2; ++k) \
        acc[ai][bj][m][n] = __builtin_amdgcn_mfma_f32_16x16x32_bf16(Bt[n][k], At[m][k], acc[ai][bj][m][n], 0, 0, 0); __builtin_amdgcn_s_setprio(0); } while (0)
#define PG8_WAIT_V(n) asm volatile("s_waitcnt vmcnt(" #n ")" ::: "memory")
#define PG8_WAIT_L(n) asm volatile("s_waitcnt lgkmcnt(" #n ")" ::: "memory")
#define PG8_BAR __builtin_amdgcn_s_barrier()
#define PG8_SCHED __builtin_amdgcn_sched_barrier(0)
    Unit cur, nxt; int ui = 0;
    if (!S.next(0, cur)) return;
    f32x4 acc[2][2][4][2];
#pragma unroll
    for (int a = 0; a < 2; ++a)
#pragma unroll
        for (int b = 0; b < 2; ++b)
#pragma unroll
            for (int m = 0; m < 4; ++m)
#pragma unroll
                for (int n = 0; n < 2; ++n) acc[a][b][m][n] = (f32x4){0.f, 0.f, 0.f, 0.f};
    bf16x8 At[4][2], B0[2][2], B1[2][2];
    const char* cA = (const char*)g.A + (size_t)cur.pm * tstepA + (size_t)((cur.pn >> g.kshift) * g.kmul) * 2; const char* cB = (const char*)g.Bt + (size_t)cur.pn * tstepB;
    S.a_ready(cur);
    PG8_STAGE(PG8_SB(0, 0), cB, voffB); PG8_STAGE(PG8_SA(0, 0), cA, voffA); PG8_STAGE(PG8_SB(0, 1), cB + hstepB, voffB); PG8_STAGE(PG8_SA(0, 1), cA + hstepA, voffA);
    if (wr == 1) PG8_BAR;
    PG8_WAIT_V(4); PG8_BAR;
    PG8_STAGE(PG8_SB(1, 0), cB + kstep, voffB); PG8_STAGE(PG8_SA(1, 0), cA + kstep, voffA); PG8_STAGE(PG8_SB(1, 1), cB + hstepB + kstep, voffB);
    PG8_WAIT_V(6); PG8_BAR;
    PG8_STAMP();
    for (;;) {
        const bool has_next = S.next(ui + 1, nxt);
        const char* nA = has_next ? (const char*)g.A + (size_t)nxt.pm * tstepA + (size_t)((nxt.pn >> g.kshift) * g.kmul) * 2 : cA; const char* nB = has_next ? (const char*)g.Bt + (size_t)nxt.pn * tstepB : cB;
        for (int t = 0; t < nt; t += 2) {
            const bool last = (t == nt - 2);
            const char* a1 = cA + (size_t)(t + 1) * kstep;
            const char* a2 = last ? nA : cA + (size_t)(t + 2) * kstep; const char* b2 = last ? nB : cB + (size_t)(t + 2) * kstep;
            const char* a3 = a2 + kstep; const char* b3 = b2 + kstep;
            if (last && has_next) S.a_ready(nxt);
            PG8_LDB(B0, 0, 0); PG8_SCHED; PG8_LDA(At, 0, 0); PG8_STAGE(PG8_SA(1, 1), a1 + hstepA, voffA);
            PG8_WAIT_L(8); PG8_BAR; PG8_WAIT_L(0); PG8_MMA(0, 0, At, B0); PG8_BAR; PG8_SCHED;
            PG8_LDB(B1, 0, 1); PG8_STAGE(PG8_SB(0, 0), b2, voffB);
            PG8_BAR; PG8_WAIT_L(0); PG8_MMA(0, 1, At, B1); PG8_BAR;
            PG8_LDA(At, 0, 1); PG8_STAGE(PG8_SA(0, 0), a2, voffA);
            PG8_BAR; PG8_WAIT_L(0); PG8_MMA(1, 0, At, B0); PG8_BAR; PG8_SCHED;
            PG8_STAGE(PG8_SB(0, 1), b2 + hstepB, voffB);
            PG8_WAIT_V(6); PG8_BAR; PG8_MMA(1, 1, At, B1); PG8_BAR;
            PG8_LDB(B0, 1, 0); PG8_SCHED; PG8_LDA(At, 1, 0); PG8_STAGE(PG8_SA(0, 1), a2 + hstepA, voffA);
            PG8_WAIT_L(8); PG8_BAR; PG8_WAIT_L(0); PG8_MMA(0, 0, At, B0); PG8_BAR; PG8_SCHED;
            PG8_LDB(B1, 1, 1); PG8_STAGE(PG8_SB(1, 0), b3, voffB);
            PG8_BAR; PG8_WAIT_L(0); PG8_MMA(0, 1, At, B1); PG8_BAR;
            PG8_LDA(At, 1, 1); PG8_STAGE(PG8_SA(1, 0), a3, voffA);
            PG8_BAR; PG8_WAIT_L(0); PG8_MMA(1, 0, At, B0); PG8_BAR; PG8_SCHED;
            PG8_STAGE(PG8_SB(1, 1), b3 + hstepB, voffB);
            PG8_WAIT_V(6); PG8_BAR; PG8_MMA(1, 1, At, B1); PG8_BAR;
        }
        PG8_STAMP();
        if constexpr (!Epi::AFTER_DRAIN) { E(acc, cur, wr, wc, fr, fq); S.done(cur); }
        PG8_STAMP();
        if (!has_next) break;
#pragma unroll
        for (int a = 0; a < 2; ++a)
#pragma unroll
            for (int b = 0; b < 2; ++b)
#pragma unroll
                for (int m = 0; m < 4; ++m)
#pragma unroll
                    for (int n = 0; n < 2; ++n) acc[a][b][m][n] = (f32x4){0.f, 0.f, 0.f, 0.f};
        cur = nxt; cA = nA; cB = nB; ++ui;
    }
    PG8_WAIT_V(0);
    if (wr == 0) PG8_BAR;
    PG8_BAR;
    if constexpr (Epi::AFTER_DRAIN) { E.fused(acc, cur, wr, wc, fr, fq, lds, wid, lane); S.done(cur); }
    PG8_STAMP();
    if (STAMP && wid == 0) { stamps[lane] = lane < nts ? (((unsigned long long)(unsigned)ts_hi << 32) | (unsigned)ts_lo) : 0ull;
        if (lane == 62) stamps[62] = rt_entry; if (lane == 63) stamps[63] = (unsigned long long)wall_clock64(); }
#undef PG8_STAMP
#undef PG8_SA
#undef PG8_SB
#undef PG8_STAGE
#undef PG8_LDA
#undef PG8_LDB
#undef PG8_MMA
#undef PG8_WAIT_V
#undef PG8_WAIT_L
#undef PG8_BAR
#undef PG8_SCHED
}
}

#define LAS __attribute__((address_space(3)))
typedef unsigned short bf16;
typedef float f32x4 __attribute__((ext_vector_type(4)));

#ifndef MK_N_LAUNCHES
#define MK_N_LAUNCHES 1
#endif
#ifndef MK_PHASE_MASK
#define MK_PHASE_MASK 0x1FFF
#endif
#ifndef MK_REPEAT
#define MK_REPEAT -1
#endif
#ifndef MK_RWKV_LDS
#define MK_RWKV_LDS 0
#endif
#ifndef MK_RWKV_SEQ
#define MK_RWKV_SEQ 0
#endif
#ifndef MK_SSD_SEQ
#define MK_SSD_SEQ 0
#endif
#ifndef MK_SKIP_MIXER
#define MK_SKIP_MIXER 0
#endif
#ifndef MK_SKIP_PEER
#define MK_SKIP_PEER 0
#endif
#ifndef MK_SKIP_RWKV
#define MK_SKIP_RWKV 0
#endif
#ifndef MK_SKIP_SSD
#define MK_SKIP_SSD 0
#endif

constexpr int DM = 4096, NBATCH = 4, SEQ = 4096, CTXL = 256;
constexpr int MX = NBATCH * SEQ;
constexpr int MC = NBATCH * CTXL;
constexpr int MT = MX + MC;
constexpr int RW = 2048;
constexpr int RCOLS = 6784;
constexpr int NIN = 12992, NINP = 13056;
constexpr int COL_Z = 6784, COL_XBC = 8832, COL_DT = 12928;
constexpr int NLR = 10240, KLR = 768, KLRW = 256;
constexpr int NMOD = 6 * DM;
constexpr float RMS_EPS = 1e-6f, GN_EPS = 64e-5f;
constexpr int NSTEP = CTXL + SEQ;

constexpr size_t MiB = (size_t)1 << 20;
constexpr size_t WS_CTL = 0, CTL_ZERO_BYTES = 1 * MiB;
constexpr size_t WS_MOD = 64 * 1024;
constexpr size_t WS_WT_OUT = 2 * MiB;
constexpr size_t WS_WT_Q = 34 * MiB;
constexpr size_t WS_WLR = 50 * MiB;
constexpr size_t WS_KBD = 63 * MiB;
constexpr size_t WS_DT = 71 * MiB;
constexpr size_t WS_LA = WS_DT + (size_t)MT * 64 * 4;
constexpr size_t WS_ALR = 300 * MiB;
constexpr size_t WS_WT_IN = 102 * MiB;
constexpr size_t WS_A1 = 204 * MiB;
constexpr size_t WS_P = 340 * MiB;
constexpr size_t WS_R = 774 * MiB, WS_K = 842 * MiB, WS_V = 910 * MiB, WS_KK = 978 * MiB;
constexpr size_t WS_XS = 1046 * MiB, WS_BC = 1114 * MiB;
constexpr size_t WS_Z = 102 * MiB;
constexpr size_t WS_LR = 340 * MiB;
constexpr size_t WS_A2 = 166 * MiB;
constexpr size_t WS_XN2 = 340 * MiB;
constexpr size_t WS_Q = 468 * MiB;
constexpr size_t WS_S = 532 * MiB;
constexpr size_t WS_U8 = 774 * MiB, WS_V8 = 838 * MiB;
constexpr size_t WS_USC = 902 * MiB, WS_VSC = WS_USC + 65536;
constexpr size_t WS_END = 1182 * MiB;
static_assert(WS_WT_IN + (size_t)NINP * DM * 2 <= WS_A1 && WS_A1 + (size_t)MT * DM * 2 <= WS_P && WS_P + (size_t)MT * NINP * 2 <= WS_R, "ws map 1");
static_assert(WS_LR + (size_t)MT * NLR * 2 <= WS_R && WS_Z + (size_t)MX * RW * 2 <= WS_A2 && WS_A2 + (size_t)MX * DM * 2 <= WS_P, "ws map 2");
static_assert(WS_LA + (size_t)MT * 64 * 4 <= WS_WT_IN && WS_ALR + (size_t)MT * KLR * 2 <= WS_P && WS_ALR >= WS_A2 + (size_t)MX * DM * 2 && WS_WLR + (size_t)NLR * KLRW * 2 <= WS_KBD, "ws map 3");
static_assert(WS_S + (size_t)MX * 2048 * 4 <= WS_R && WS_VSC + 65536 <= WS_XS, "ws map 4");

constexpr int LDS_BYTES = 147456;
constexpr int LDS_CTL = 143360;
constexpr int LDS_MISC = LDS_CTL + 320;

enum { I_X = 0, I_C, I_CTX, I_CCTX, I_WMOD, I_BMOD, I_N1G, I_N2G, I_WIN, I_WOUT, I_MU, I_W0, I_W2, I_A0, I_A2, I_G2, I_KK, I_KA, I_RK, I_LNW, I_LNB,
       I_CONVW, I_CONVB, I_DTB, I_ALOG, I_SSMD, I_NORMW, I_WQ, I_K1, I_K2, I_PU, I_PV, I_FG, N_IN };

struct Args { const float* in[N_IN]; float* out; unsigned char* ws; int ph_lo, ph_hi; };

__device__ __forceinline__ unsigned f2bf(float f) { unsigned u = __float_as_uint(f); return (u + 0x7fffu + ((u >> 16) & 1u)) >> 16; }
__device__ __forceinline__ unsigned pk2(float lo, float hi) { return f2bf(lo) | (f2bf(hi) << 16); }
__device__ __forceinline__ float bflo(unsigned u) { return __uint_as_float(u << 16); }
__device__ __forceinline__ float bfhi(unsigned u) { return __uint_as_float(u & 0xffff0000u); }
__device__ __forceinline__ void unpack8(const uint4& u, float (&f)[8]) {
    f[0] = bflo(u.x); f[1] = bfhi(u.x); f[2] = bflo(u.y); f[3] = bfhi(u.y); f[4] = bflo(u.z); f[5] = bfhi(u.z); f[6] = bflo(u.w); f[7] = bfhi(u.w);
}
__device__ __forceinline__ uint4 pack8(const float (&f)[8]) { uint4 u; u.x = pk2(f[0], f[1]); u.y = pk2(f[2], f[3]); u.z = pk2(f[4], f[5]); u.w = pk2(f[6], f[7]); return u; }
__device__ __forceinline__ uint4 ld16(const bf16* p) { return *(const uint4*)p; }
__device__ __forceinline__ void st16(bf16* p, const uint4& v) { *(uint4*)p = v; }
__device__ __forceinline__ void ldf8(const float* p, float (&f)[8]) { const float4 a = *(const float4*)p, b = *(const float4*)(p + 4); f[0] = a.x; f[1] = a.y; f[2] = a.z; f[3] = a.w; f[4] = b.x; f[5] = b.y; f[6] = b.z; f[7] = b.w; }
#define PIN8(a) asm volatile("" : "+v"((a)[0]), "+v"((a)[1]), "+v"((a)[2]), "+v"((a)[3]), "+v"((a)[4]), "+v"((a)[5]), "+v"((a)[6]), "+v"((a)[7]))
template <int CTRL> __device__ __forceinline__ float dppf(float v) { return __uint_as_float((unsigned)__builtin_amdgcn_update_dpp(0, (int)__float_as_uint(v), CTRL, 0xF, 0xF, true)); }
__device__ __forceinline__ float rlane(float v, int l) { return __uint_as_float((unsigned)__builtin_amdgcn_readlane((int)__float_as_uint(v), l)); }
__device__ __forceinline__ float sum8(float v) { v += dppf<0xB1>(v); v += dppf<0x4E>(v); v += dppf<0x141>(v); return v; }
__device__ __forceinline__ float sum16(float v) { v = sum8(v); v += dppf<0x140>(v); return v; }
__device__ __forceinline__ float sum32(float v) { v = sum16(v); v += __shfl_xor(v, 16); return v; }
__device__ __forceinline__ float wave_sum(float v) { v = sum16(v); return (rlane(v, 0) + rlane(v, 16)) + (rlane(v, 32) + rlane(v, 48)); }
__device__ __forceinline__ float wave_max(float v) {
    v = fmaxf(v, dppf<0xB1>(v)); v = fmaxf(v, dppf<0x4E>(v)); v = fmaxf(v, dppf<0x141>(v)); v = fmaxf(v, dppf<0x140>(v));
    return fmaxf(fmaxf(rlane(v, 0), rlane(v, 16)), fmaxf(rlane(v, 32), rlane(v, 48)));
}
__device__ __forceinline__ float sigmoidf_(float x) { return 1.f / (1.f + __expf(-x)); }
__device__ __forceinline__ float siluf_(float x) { return x / (1.f + __expf(-x)); }

struct EpiLR {
    static constexpr bool PERM = true, AFTER_DRAIN = false;
    bf16* O; const float* w0; const float* a0;
    __device__ __forceinline__ void operator()(const pg8::f32x4 (&acc)[2][2][4][2], const pg8::Unit& u, int wr, int wc, int fr, int fq) const {
        const int row0 = u.pm * 256 + wr * 64 + fr; const int colt = u.pn * 256; const int type = colt >> 11;
        const int col0 = colt + wc * 32 + 8 * fq;
        const float* bias = type < 2 ? (w0 + type * 2048) : (a0 + (type - 2) * 2048);
        pg8::f32x4 bv[2][2];
#pragma unroll
        for (int bj = 0; bj < 2; ++bj)
#pragma unroll
            for (int n = 0; n < 2; ++n) bv[bj][n] = type < 4 ? *(const pg8::f32x4*)(bias + ((col0 + bj * 128 + 4 * n) & 2047)) : (pg8::f32x4){0.f, 0.f, 0.f, 0.f};
#pragma unroll
        for (int ai = 0; ai < 2; ++ai)
#pragma unroll
            for (int m = 0; m < 4; ++m) { bf16* rowp = O + (size_t)(row0 + ai * 128 + m * 16) * NLR + col0;
#pragma unroll
                for (int bj = 0; bj < 2; ++bj) { pg8::f32x4 v0 = acc[ai][bj][m][0] + bv[bj][0], v1 = acc[ai][bj][m][1] + bv[bj][1];
                    if (type < 4) {
#pragma unroll
                        for (int j = 0; j < 4; ++j) { float s0 = 1.f / (1.f + __expf(-v0[j])), s1 = 1.f / (1.f + __expf(-v1[j]));
                            if (type < 2) { s0 = -expm1f(-0.60653066f * s0); s1 = -expm1f(-0.60653066f * s1); }
                            v0[j] = s0; v1[j] = s1; } }
                    pg8::u32x4 w; w.x = pg8::cvt_pk_bf16(v0[0], v0[1]); w.y = pg8::cvt_pk_bf16(v0[2], v0[3]); w.z = pg8::cvt_pk_bf16(v1[0], v1[1]); w.w = pg8::cvt_pk_bf16(v1[2], v1[3]);
                    *(pg8::u32x4*)(rowp + bj * 128) = w; } }
    }
};
struct EpiRes {
    static constexpr bool PERM = false, AFTER_DRAIN = false;
    float* C; const float* X; const float* mod;
    __device__ __forceinline__ void operator()(const pg8::f32x4 (&acc)[2][2][4][2], const pg8::Unit& u, int wr, int wc, int fr, int fq) const {
        const int row0 = u.pm * 256 + wr * 64 + fr, col0 = u.pn * 256 + wc * 32 + 4 * fq;
        const float* gt = mod + (size_t)((u.pm * 256) / SEQ) * NMOD + 2 * DM;
        pg8::f32x4 gv[2][2];
#pragma unroll
        for (int bj = 0; bj < 2; ++bj)
#pragma unroll
            for (int n = 0; n < 2; ++n) gv[bj][n] = *(const pg8::f32x4*)(gt + col0 + bj * 128 + n * 16);
#pragma unroll
        for (int ai = 0; ai < 2; ++ai)
#pragma unroll
            for (int m = 0; m < 4; ++m) { const size_t off = (size_t)(row0 + ai * 128 + m * 16) * DM + col0;
#pragma unroll
                for (int bj = 0; bj < 2; ++bj)
#pragma unroll
                    for (int n = 0; n < 2; ++n) { const pg8::f32x4 xv = *(const pg8::f32x4*)(X + off + bj * 128 + n * 16);
#if MK_SKIP_MIXER
                        *(pg8::f32x4*)(C + off + bj * 128 + n * 16) = xv;
#else
                        *(pg8::f32x4*)(C + off + bj * 128 + n * 16) = xv + gv[bj][n] * acc[ai][bj][m][n];
#endif
                    }
                asm volatile("" ::: "memory"); }
    }
};

#define XB_TMO      128
#define XB_XCNT(j)  (256  + 64 * (j))
#define XB_XSUB(j)  (1280 + 64 * (j))
#define XB_XGEN(j)  (2304 + 64 * (j))
#define XB_TOP      3328
#define XB_TOPGEN   3392
#define XCD_BAR_WORDS 3456
#define XB_SPIN_CAP (1u << 18)
__device__ __forceinline__ unsigned xb_ld(unsigned* p)              { return __hip_atomic_load(p, __ATOMIC_RELAXED, __HIP_MEMORY_SCOPE_AGENT); }
__device__ __forceinline__ unsigned xb_add(unsigned* p, unsigned v) { return __hip_atomic_fetch_add(p, v, __ATOMIC_RELAXED, __HIP_MEMORY_SCOPE_AGENT); }
__device__ __forceinline__ unsigned xb_xcc_id() { return (unsigned)__builtin_amdgcn_s_getreg((3 << 11) | 20) & 0xFu; }
#define XB_SPIN(cond, bar) do { unsigned _sp = 0; while (cond) { __builtin_amdgcn_s_sleep(1); \
    if ((++_sp & 255u) == 0u) { if (xb_ld(&(bar)[XB_TMO])) break; if (_sp > XB_SPIN_CAP) { atomicAdd(&(bar)[XB_TMO], 1u); break; } } } } while (0)
struct XcdBarrier { unsigned* bar; unsigned x; volatile LAS unsigned* st; };
__device__ __forceinline__ XcdBarrier xcd_barrier_post(unsigned* bar, volatile LAS unsigned* st) {
    XcdBarrier b; b.bar = bar; b.x = xb_xcc_id(); b.st = st;
    if (threadIdx.x == 0) (void)xb_add(&bar[XB_XCNT(b.x)], 1u);
    return b;
}
__device__ __forceinline__ void xcd_barrier_complete(unsigned* bar, unsigned x, unsigned& nloc, unsigned& nx) {
    const unsigned G = gridDim.x * gridDim.y * gridDim.z;
    unsigned sum, cnt, mine, sp = 0u;
    for (;;) {
        sum = 0u; cnt = 0u; mine = 0u;
#pragma unroll
        for (unsigned j = 0; j < 16; ++j) { const unsigned c = xb_ld(&bar[XB_XCNT(j)]); sum += c; cnt += (c > 0u) ? 1u : 0u; mine = (j == x) ? c : mine; }
        if (sum == G) break;
        __builtin_amdgcn_s_sleep(1);
        if ((++sp & 255u) == 0u) { if (xb_ld(&bar[XB_TMO])) break; if (sp > XB_SPIN_CAP) { atomicAdd(&bar[XB_TMO], 1u); break; } }
    }
    nloc = mine > 0u ? mine : 1u; nx = cnt > 0u ? cnt : 1u;
}
__device__ __forceinline__ void xcd_barrier(const XcdBarrier& b) {
    asm volatile("s_waitcnt vmcnt(0)" ::: "memory");
    __syncthreads();
    if (threadIdx.x == 0) {
        unsigned* bar = b.bar;
        __builtin_amdgcn_s_waitcnt(0);
        unsigned nloc = b.st[0], nx = b.st[1];
        if (nloc == 0u) { xcd_barrier_complete(bar, b.x, nloc, nx); b.st[0] = nloc; b.st[1] = nx; }
        const unsigned old = xb_add(&bar[XB_XSUB(b.x)], 1u);
        const unsigned gen = old / nloc;
        if (old + 1u == (gen + 1u) * nloc) {
            __builtin_amdgcn_fence(__ATOMIC_RELEASE, "agent");
            asm volatile("s_waitcnt vmcnt(0)" ::: "memory");
            const unsigned og = xb_add(&bar[XB_TOP], 1u);
            const unsigned tg = og / nx;
            if (og + 1u == (tg + 1u) * nx) xb_add(&bar[XB_TOPGEN], 1u);
            else XB_SPIN(xb_ld(&bar[XB_TOPGEN]) == tg, bar);
            __builtin_amdgcn_fence(__ATOMIC_ACQUIRE, "agent");
            xb_add(&bar[XB_XGEN(b.x)], 1u);
            asm volatile("s_waitcnt vmcnt(0)" ::: "memory");
        } else {
            XB_SPIN(xb_ld(&bar[XB_XGEN(b.x)]) == gen, bar);
            __builtin_amdgcn_fence(__ATOMIC_ACQUIRE, "agent");
            asm volatile("s_waitcnt vmcnt(0)" ::: "memory");
        }
    }
    __syncthreads();
}

#define TID ((int)threadIdx.x)
#define LANE ((int)(threadIdx.x & 63))
#define WAVE ((int)__builtin_amdgcn_readfirstlane((int)(threadIdx.x >> 6)))
#define GW ((int)blockIdx.x * 8 + WAVE)
#define NGW ((int)gridDim.x * 8)

__device__ __forceinline__ void ph_mod(const Args& a, LAS unsigned char* lds) {
    const float* c = a.in[I_C]; const float* cc = a.in[I_CCTX]; const float* w_mod = a.in[I_WMOD]; const float* b_mod = a.in[I_BMOD];
    float* mod = (float*)(a.ws + WS_MOD);
    LAS float* sS = (LAS float*)lds;
    LAS float* red = (LAS float*)(lds + 81920);
    const int tid = TID, lane = LANE, wave = WAVE;
    if ((int)blockIdx.x < 192) {
        for (int i = tid; i < 5 * DM; i += 512) { const int v = i >> 12, k = i & (DM - 1); const float xv = v < 4 ? c[v * DM + k] : cc[k]; sS[i] = xv / (1.f + expf(-xv)); }
    }
    __syncthreads();
    for (int u = blockIdx.x; u < 192; u += gridDim.x) {
        const int cl = lane & 31, kh = lane >> 5;
        float acc[5][4];
#pragma unroll
        for (int v = 0; v < 5; ++v)
#pragma unroll
            for (int e = 0; e < 4; ++e) acc[v][e] = 0.f;
        const float* wp = w_mod + (size_t)(wave * 512 + kh) * NMOD + u * 128 + cl * 4;
#pragma unroll 8
        for (int i = 0; i < 256; ++i) {
            const float4 w = *(const float4*)(wp + (size_t)(2 * i) * NMOD);
#pragma unroll
            for (int v = 0; v < 5; ++v) { const float s = sS[v * DM + wave * 512 + 2 * i + kh]; acc[v][0] += s * w.x; acc[v][1] += s * w.y; acc[v][2] += s * w.z; acc[v][3] += s * w.w; }
        }
#pragma unroll
        for (int v = 0; v < 5; ++v)
#pragma unroll
            for (int e = 0; e < 4; ++e) acc[v][e] += __shfl_xor(acc[v][e], 32);
        if (kh == 0) {
#pragma unroll
            for (int v = 0; v < 5; ++v) *(LAS f32x4*)(red + ((wave * 5 + v) * 128 + cl * 4)) = (f32x4){acc[v][0], acc[v][1], acc[v][2], acc[v][3]};
        }
        __syncthreads();
        for (int i = tid; i < 640; i += 512) { const int v = i >> 7, n = i & 127; float s = b_mod[u * 128 + n];
#pragma unroll
            for (int w = 0; w < 8; ++w) s += red[(w * 5 + v) * 128 + n];
            mod[v * NMOD + u * 128 + n] = s; }
        __syncthreads();
    }
    __syncthreads();
}

__device__ __forceinline__ void transpose_item(const float* W, int K, int N, bf16* WT, LAS float* scr, int item, int lane) {
    const int nblk = N / 32, kb = item / nblk, nb = item % nblk, k0 = 64 * kb, n0 = 32 * nb;
#pragma unroll 8
    for (int i = 0; i < 32; ++i) { const int kk = 2 * i + (lane >> 5); scr[kk * 33 + (lane & 31)] = W[(size_t)(k0 + kk) * N + n0 + (lane & 31)]; }
    asm volatile("s_waitcnt lgkmcnt(0)" ::: "memory");
    const int c = lane & 7;
#pragma unroll
    for (int j = 0; j < 4; ++j) { const int n = (lane >> 3) + 8 * j; const LAS float* s = scr + (8 * c) * 33 + n;
        uint4 o; o.x = pk2(s[0 * 33], s[1 * 33]); o.y = pk2(s[2 * 33], s[3 * 33]); o.z = pk2(s[4 * 33], s[5 * 33]); o.w = pk2(s[6 * 33], s[7 * 33]);
        *(uint4*)(WT + (size_t)(n0 + n) * K + k0 + 8 * c) = o; }
    asm volatile("s_waitcnt lgkmcnt(0)" ::: "memory");
}
__device__ __forceinline__ void ph_conv(const Args& a, LAS unsigned char* lds) {
    const int lane = LANE, wave = WAVE, gw = GW, ngw = NGW;
    LAS float* scr = (LAS float*)(lds + wave * 16384);
    bf16* wt_in = (bf16*)(a.ws + WS_WT_IN); bf16* wt_out = (bf16*)(a.ws + WS_WT_OUT); bf16* wt_q = (bf16*)(a.ws + WS_WT_Q);
    constexpr int IT_IN = (DM / 64) * (NIN / 32), IT_OUT = (DM / 64) * (DM / 32), IT_Q = (DM / 64) * (2048 / 32);
    for (int it = gw; it < IT_IN + IT_OUT + IT_Q; it += ngw) {
        int r = it;
        if (r < IT_IN) { transpose_item(a.in[I_WIN], DM, NIN, wt_in, scr, r, lane); continue; } r -= IT_IN;
        if (r < IT_OUT) { transpose_item(a.in[I_WOUT], DM, DM, wt_out, scr, r, lane); continue; } r -= IT_OUT;
        transpose_item(a.in[I_WQ], DM, 2048, wt_q, scr, r, lane);
    }
    const int gt = blockIdx.x * 512 + TID, ngt = gridDim.x * 512;
    for (int i = gt; i < (NINP - NIN) * DM / 8; i += ngt) *(uint4*)(wt_in + (size_t)NIN * DM + (size_t)i * 8) = make_uint4(0u, 0u, 0u, 0u);
    { bf16* wlr = (bf16*)(a.ws + WS_WLR); const float* w2 = a.in[I_W2]; const float* a2 = a.in[I_A2]; const float* g2 = a.in[I_G2];
      for (int i = gt; i < NLR * (KLRW / 8); i += ngt) { const int n = i / (KLRW / 8), k0 = (i % (KLRW / 8)) * 8; const int type = n >> 11, cch = n & 2047;
          float f[8];
#pragma unroll
          for (int e = 0; e < 8; ++e) { const int k = k0 + e; float v = 0.f;
              if (type == 4) v = g2[(size_t)k * RW + cch];
              else { const int d = type & 1, kk = k - 128 * d; const float* src = type < 2 ? w2 : a2; if (kk >= 0 && kk < 96) v = src[(size_t)(d * 96 + kk) * RW + cch]; }
              f[e] = v; }
          st16(wlr + (size_t)n * KLRW + k0, pack8(f)); } }
    { bf16* kbd = (bf16*)(a.ws + WS_KBD); const float* k1 = a.in[I_K1]; const float* k2 = a.in[I_K2];
      for (int i = gt; i < 2048 * 32; i += ngt) { const int n = i >> 5, k0 = (i & 31) * 8; float f[8];
          const int h = n >> 8, sb = (n >> 7) & 1, key = n & 127;
          if ((k0 >> 7) == sb) { const float* src = (sb ? k2 : k1) + ((size_t)(h * 128 + key) * 128 + (k0 & 127)); ldf8(src, f); }
          else {
#pragma unroll
              for (int e = 0; e < 8; ++e) f[e] = 0.f; }
          st16(kbd + (size_t)n * 256 + k0, pack8(f)); } }
}

__device__ __forceinline__ void norm_mod_row(const float* src, const float* g, const float* sh, const float* sc, bf16* dst, int lane) {
    float4 v[16]; float ss = 0.f;
#pragma unroll
    for (int j = 0; j < 16; ++j) { v[j] = *(const float4*)(src + (lane + 64 * j) * 4); ss += (v[j].x * v[j].x + v[j].y * v[j].y) + (v[j].z * v[j].z + v[j].w * v[j].w); }
    const float rstd = rsqrtf(wave_sum(ss) * (1.f / DM) + RMS_EPS);
#pragma unroll
    for (int j = 0; j < 16; ++j) { const int c = (lane + 64 * j) * 4; const float4 gg = *(const float4*)(g + c), s1 = *(const float4*)(sc + c), s0 = *(const float4*)(sh + c);
        const float o0 = v[j].x * rstd * gg.x * (1.f + s1.x) + s0.x, o1 = v[j].y * rstd * gg.y * (1.f + s1.y) + s0.y, o2 = v[j].z * rstd * gg.z * (1.f + s1.z) + s0.z, o3 = v[j].w * rstd * gg.w * (1.f + s1.w) + s0.w;
        uint2 w; w.x = pk2(o0, o1); w.y = pk2(o2, o3); *(uint2*)(dst + c) = w; }
}
__device__ __forceinline__ void ph_norm1(const Args& a) {
    const int lane = LANE; const float* mod = (const float*)(a.ws + WS_MOD); bf16* A1 = (bf16*)(a.ws + WS_A1);
    for (int m = GW; m < MT; m += NGW) {
        const float* src = m < MX ? a.in[I_X] + (size_t)m * DM : a.in[I_CTX] + (size_t)(m - MX) * DM;
        const int v = m < MX ? m / SEQ : 4;
        norm_mod_row(src, a.in[I_N1G], mod + (size_t)v * NMOD, mod + (size_t)v * NMOD + DM, A1 + (size_t)m * DM, lane);
    }
}
__device__ __forceinline__ void ph_norm2(const Args& a) {
    const int lane = LANE; const float* mod = (const float*)(a.ws + WS_MOD); bf16* XN2 = (bf16*)(a.ws + WS_XN2);
    for (int m = GW; m < MX; m += NGW) {
        const int v = m / SEQ;
        norm_mod_row(a.out + (size_t)m * DM, a.in[I_N2G], mod + (size_t)v * NMOD + 3 * DM, mod + (size_t)v * NMOD + 4 * DM, XN2 + (size_t)m * DM, lane);
    }
    unsigned char* U8 = a.ws + WS_U8; unsigned char* V8 = a.ws + WS_V8; float* USC = (float*)(a.ws + WS_USC); float* VSC = (float*)(a.ws + WS_VSC);
    for (int row = GW; row < 2 * 16384; row += NGW) {
        const int tb = row >> 14, r = row & 16383;
        const float* src = (tb ? a.in[I_PV] : a.in[I_PU]) + (size_t)r * DM;
        float4 v[16]; float am = 0.f;
#pragma unroll
        for (int j = 0; j < 16; ++j) { v[j] = *(const float4*)(src + (lane + 64 * j) * 4); am = fmaxf(fmaxf(am, fmaxf(fabsf(v[j].x), fabsf(v[j].y))), fmaxf(fabsf(v[j].z), fabsf(v[j].w))); }
        am = wave_max(am);
        const float scale = am > 0.f ? am * (1.f / 7.5f) : 1.f, inv = 1.f / scale;
        unsigned char* dst = (tb ? V8 : U8) + (size_t)r * 3072 + lane * 48;
#pragma unroll
        for (int p = 0; p < 2; ++p) {
            unsigned long long w0 = 0ull, w1 = 0ull, w2 = 0ull;
#pragma unroll
            for (int k = 0; k < 32; ++k) {
                const float4 q = v[8 * p + (k >> 2)]; const float x = ((k & 3) == 0 ? q.x : (k & 3) == 1 ? q.y : (k & 3) == 2 ? q.z : q.w) * inv; const float ax = fabsf(x);
                float cf = ax < 2.f ? rintf(ax * 8.f) : (ax < 4.f ? rintf(ax * 4.f) + 8.f : rintf(ax * 2.f) + 16.f);
                cf = fminf(cf, 31.f);
                const unsigned long long code = (unsigned long long)((unsigned)cf | (x < 0.f ? 32u : 0u));
                const int pos = 6 * k, wd = pos >> 6, off = pos & 63;
                if (wd == 0) w0 |= code << off; else if (wd == 1) w1 |= code << off; else w2 |= code << off;
                if (off > 58) { if (wd == 0) w1 |= code >> (64 - off); else w2 |= code >> (64 - off); }
            }
            *(uint2*)(dst + 24 * p) = make_uint2((unsigned)w0, (unsigned)(w0 >> 32)); *(uint2*)(dst + 24 * p + 8) = make_uint2((unsigned)w1, (unsigned)(w1 >> 32)); *(uint2*)(dst + 24 * p + 16) = make_uint2((unsigned)w2, (unsigned)(w2 >> 32));
        }
        if (lane == 0) (tb ? VSC : USC)[r] = scale;
    }
}

__device__ __forceinline__ void ph_prep_rwkv(const Args& a) {
    const int lane = LANE;
    const bf16* P = (const bf16*)(a.ws + WS_P);
    bf16* R = (bf16*)(a.ws + WS_R); bf16* K = (bf16*)(a.ws + WS_K); bf16* V = (bf16*)(a.ws + WS_V); bf16* KK = (bf16*)(a.ws + WS_KK); bf16* ALR = (bf16*)(a.ws + WS_ALR);
    const float* mu = a.in[I_MU]; const float* k_k = a.in[I_KK];
    for (int m = GW; m < MT; m += NGW) {
        const bool lat = m < MX;
        bool h0, h1, h2 = false, h3 = false; size_t r0, r1, r2 = 0, r3 = 0;
        if (lat) { const int t = m & (SEQ - 1), row = t >> 6, col = t & 63; h0 = col > 0; h1 = col < 63; h2 = row > 0; h3 = row < 63; r0 = (size_t)(m - 1); r1 = (size_t)(m + 1); r2 = (size_t)(m - 64); r3 = (size_t)(m + 64); }
        else { const int t = (m - MX) & (CTXL - 1); h0 = t > 0; h1 = t < CTXL - 1; r0 = (size_t)(m - 1); r1 = (size_t)(m + 1); }
        const bf16* prow = P + (size_t)m * NINP;
#pragma unroll
        for (int i = 0; i < 14; ++i) {
            const int chunk = lane + 64 * i;
            if (chunk < RCOLS / 8) {
                const int c0 = chunk * 8;
                float own[8], n0[8], n1[8], sh[8], xm[8], muv[8];
                const uint4 z4 = make_uint4(0u, 0u, 0u, 0u);
                unpack8(ld16(prow + c0), own);
                unpack8(h0 ? ld16(P + r0 * NINP + c0) : z4, n0);
                unpack8(h1 ? ld16(P + r1 * NINP + c0) : z4, n1);
                if (lat) { float n2[8], n3[8];
                    unpack8(h2 ? ld16(P + r2 * NINP + c0) : z4, n2);
                    unpack8(h3 ? ld16(P + r3 * NINP + c0) : z4, n3);
#pragma unroll
                    for (int e = 0; e < 8; ++e) sh[e] = (e & 3) == 0 ? n0[e] : (e & 3) == 1 ? n1[e] : (e & 3) == 2 ? n2[e] : n3[e];
                } else {
#pragma unroll
                    for (int e = 0; e < 8; ++e) sh[e] = (e & 1) == 0 ? n0[e] : n1[e];
                }
                ldf8(mu + c0, muv);
#pragma unroll
                for (int e = 0; e < 8; ++e) xm[e] = own[e] + muv[e] * (sh[e] - own[e]);
                if (i < 4) st16(R + (size_t)m * RW + c0, pack8(xm));
                else if (i < 8) { const int cc = c0 - 2048; st16(K + (size_t)m * RW + cc, pack8(xm));
                    float kv[8], kkv[8]; ldf8(k_k + cc, kv); float ss = 0.f;
#pragma unroll
                    for (int e = 0; e < 8; ++e) { kkv[e] = xm[e] * kv[e]; ss += kkv[e] * kkv[e]; }
                    ss = sum8(ss);
                    const float inv = rsqrtf(fmaxf(ss, 1e-24f));
#pragma unroll
                    for (int e = 0; e < 8; ++e) kkv[e] *= inv;
                    st16(KK + (size_t)m * RW + cc, pack8(kkv)); }
                else if (i < 12) st16(V + (size_t)m * RW + (c0 - 4096), pack8(xm));
                else { const int j0 = c0 - 6144; float f[8];
#pragma unroll
                    for (int e = 0; e < 8; ++e) f[e] = j0 < 192 ? tanhf(xm[e]) : (j0 < 384 ? xm[e] : 1.f / (1.f + __expf(-xm[e])));
                    const int col = j0 < 384 ? (j0 / 96) * 128 + (j0 % 96) : j0 + 128;
                    st16(ALR + (size_t)m * KLR + col, pack8(f)); }
            } else if (i == 13 && lane < 32) {
                const int pc = lane - 16; st16(ALR + (size_t)m * KLR + (pc >> 2) * 128 + 96 + (pc & 3) * 8, make_uint4(0u, 0u, 0u, 0u));
            }
        }
    }
}

__device__ __forceinline__ void ph_prep_ssd(const Args& a) {
    const int lane = LANE;
    const bf16* P = (const bf16*)(a.ws + WS_P);
    bf16* XS = (bf16*)(a.ws + WS_XS); bf16* BC = (bf16*)(a.ws + WS_BC); bf16* Z = (bf16*)(a.ws + WS_Z); float* DT = (float*)(a.ws + WS_DT); float* LA = (float*)(a.ws + WS_LA);
    const float* cw = a.in[I_CONVW]; const float* cb = a.in[I_CONVB];
    for (int m = GW; m < MT; m += NGW) {
        const bool lat = m < MX; bool hp, hn;
        if (lat) { const int t = m & (SEQ - 1); hp = t > 0; hn = t < SEQ - 1; } else { const int t = (m - MX) & (CTXL - 1); hp = t > 0; hn = t < CTXL - 1; }
        const bf16* prow = P + (size_t)m * NINP;
#pragma unroll
        for (int i = 0; i < 8; ++i) {
            const int c0 = (lane + 64 * i) * 8; const uint4 z4 = make_uint4(0u, 0u, 0u, 0u);
            float cur[8], pv[8], nx[8], w0[8], w1[8], w2[8], bb[8], y[8];
            unpack8(ld16(prow + COL_XBC + c0), cur);
            unpack8(hp ? ld16(prow - NINP + COL_XBC + c0) : z4, pv);
            unpack8(hn ? ld16(prow + NINP + COL_XBC + c0) : z4, nx);
            ldf8(cw + c0, w0); ldf8(cw + 4096 + c0, w1); ldf8(cw + 8192 + c0, w2); ldf8(cb + c0, bb);
#pragma unroll
            for (int e = 0; e < 8; ++e) { const float t = w0[e] * pv[e] + w1[e] * cur[e] + w2[e] * nx[e] + bb[e]; y[e] = t / (1.f + __expf(-t)); }
            if (i < 4) st16(XS + (size_t)m * RW + c0, pack8(y)); else st16(BC + (size_t)m * RW + (c0 - 2048), pack8(y));
        }
        { const float raw = __uint_as_float((unsigned)prow[COL_DT + lane] << 16) + a.in[I_DTB][lane];
          const float dtv = raw > 20.f ? raw : log1pf(expf(raw));
          DT[(size_t)m * 64 + lane] = dtv; LA[(size_t)m * 64 + lane] = -dtv * expf(a.in[I_ALOG][lane]); }
        if (lat) {
#pragma unroll
            for (int i = 0; i < 4; ++i) { const int c0 = (lane + 64 * i) * 8; st16(Z + (size_t)m * RW + c0, ld16(prow + COL_Z + c0)); }
        }
    }
}

__device__ __forceinline__ int scan_row(int n, int dir, int b) { return n < CTXL ? MX + b * CTXL + (dir ? CTXL - 1 - n : n) : b * SEQ + (dir ? NSTEP - 1 - n : n - CTXL); }

struct RIn { uint4 r, k, kk, w, a; unsigned v; };
__device__ __forceinline__ void rwkv_load(RIn& x, const bf16* R, const bf16* K, const bf16* V, const bf16* KK, const bf16* LR, int m, int ch, int chi, int dir) {
    x.r = ld16(R + (size_t)m * RW + ch); x.k = ld16(K + (size_t)m * RW + ch); x.kk = ld16(KK + (size_t)m * RW + ch);
    x.w = ld16(LR + (size_t)m * NLR + dir * 2048 + ch); x.a = ld16(LR + (size_t)m * NLR + 4096 + dir * 2048 + ch);
    x.v = V[(size_t)m * RW + chi];
}
__device__ __forceinline__ float rwkv_step(float (&S)[8], const RIn& x, const float (&ka)[8]) {
    float r[8], k[8], kk[8], w1[8], av[8];
    unpack8(x.r, r); unpack8(x.k, k); unpack8(x.kk, kk); unpack8(x.w, w1); unpack8(x.a, av);
    const float v = __uint_as_float(x.v << 16);
    float sa = 0.f;
#pragma unroll
    for (int e = 0; e < 8; ++e) sa -= S[e] * kk[e];
    sa = sum8(sa);
    float o = 0.f;
#pragma unroll
    for (int e = 0; e < 8; ++e) { const float kd = k[e] * (1.f + (av[e] - 1.f) * ka[e]); const float b = kk[e] * av[e];
        S[e] = S[e] * (1.f - w1[e]) + sa * b + v * kd; o += S[e] * r[e]; }
    o = sum8(o);
    return o;
}
__device__ __forceinline__ void ph_rwkv_scan(const Args& a) {
    const int lane = LANE, wave = WAVE;
    const bf16* R = (const bf16*)(a.ws + WS_R); const bf16* K = (const bf16*)(a.ws + WS_K); const bf16* V = (const bf16*)(a.ws + WS_V); const bf16* KK = (const bf16*)(a.ws + WS_KK);
    const bf16* LR = (const bf16*)(a.ws + WS_LR); bf16* OR = (bf16*)a.out;
    for (int u = blockIdx.x; u < 256; u += gridDim.x) {
        const int g = u >> 5, h = u & 31, dir = g >> 2, b = g & 3;
        const int i = wave * 8 + (lane >> 3), jb = lane & 7, ch = h * 64 + jb * 8, chi = h * 64 + i;
        float ka[8]; ldf8(a.in[I_KA] + ch, ka);
        float S[8];
#pragma unroll
        for (int e = 0; e < 8; ++e) S[e] = 0.f;
        RIn A[4], B[4];
#pragma unroll
        for (int s = 0; s < 4; ++s) rwkv_load(A[s], R, K, V, KK, LR, scan_row(s, dir, b), ch, chi, dir);
        for (int n0 = 0; n0 < NSTEP; n0 += 8) {
#pragma unroll
            for (int s = 0; s < 4; ++s) rwkv_load(B[s], R, K, V, KK, LR, scan_row(n0 + 4 + s, dir, b), ch, chi, dir);
#pragma unroll
            for (int s = 0; s < 4; ++s) { const int n = n0 + s; const float o = rwkv_step(S, A[s], ka);
                if (n >= CTXL && jb == 0) OR[((size_t)dir * MX + scan_row(n, dir, b)) * RW + chi] = (bf16)f2bf(o); }
            if (n0 + 8 < NSTEP) {
#pragma unroll
                for (int s = 0; s < 4; ++s) rwkv_load(A[s], R, K, V, KK, LR, scan_row(n0 + 8 + s, dir, b), ch, chi, dir);
            }
#pragma unroll
            for (int s = 0; s < 4; ++s) { const int n = n0 + 4 + s; const float o = rwkv_step(S, B[s], ka);
                if (n >= CTXL && jb == 0) OR[((size_t)dir * MX + scan_row(n, dir, b)) * RW + chi] = (bf16)f2bf(o); }
        }
    }
}

typedef float f32x2_t __attribute__((ext_vector_type(2)));
constexpr int RS_TS = 32, RS_STEP_B = 6 * 256, RS_BUF_B = RS_TS * RS_STEP_B;
constexpr int RS_OBUF = 2 * RS_BUF_B, RS_OBUF_B = RS_TS * 64 * 2;
constexpr int RS_DUMP = RS_OBUF + 2 * RS_OBUF_B;
static_assert(RS_DUMP + 2048 <= 131072, "rwkv scan lds map");
struct RRaw { uint2 r, k, kk, v, w, a; };
__device__ __forceinline__ void rs_load(RRaw& x, const bf16* R, const bf16* K, const bf16* V, const bf16* KK, const bf16* LR, int m, int ch, int dir) {
    x.r = *(const uint2*)(R + (size_t)m * RW + ch); x.k = *(const uint2*)(K + (size_t)m * RW + ch); x.kk = *(const uint2*)(KK + (size_t)m * RW + ch); x.v = *(const uint2*)(V + (size_t)m * RW + ch);
    x.w = *(const uint2*)(LR + (size_t)m * NLR + dir * 2048 + ch); x.a = *(const uint2*)(LR + (size_t)m * NLR + 4096 + dir * 2048 + ch);
}
__device__ __forceinline__ void rs_stage(const RRaw& x, const float (&ka)[4], LAS unsigned char* dst) {
    const float r[4] = {bflo(x.r.x), bfhi(x.r.x), bflo(x.r.y), bfhi(x.r.y)}, k[4] = {bflo(x.k.x), bfhi(x.k.x), bflo(x.k.y), bfhi(x.k.y)};
    const float kk[4] = {bflo(x.kk.x), bfhi(x.kk.x), bflo(x.kk.y), bfhi(x.kk.y)}, v[4] = {bflo(x.v.x), bfhi(x.v.x), bflo(x.v.y), bfhi(x.v.y)};
    const float w1[4] = {bflo(x.w.x), bfhi(x.w.x), bflo(x.w.y), bfhi(x.w.y)}, av[4] = {bflo(x.a.x), bfhi(x.a.x), bflo(x.a.y), bfhi(x.a.y)};
    f32x4 nkk, w, b, kd, rr, vv;
#pragma unroll
    for (int e = 0; e < 4; ++e) { nkk[e] = -kk[e]; w[e] = 1.f - w1[e]; b[e] = kk[e] * av[e]; kd[e] = k[e] * (1.f + (av[e] - 1.f) * ka[e]); rr[e] = r[e]; vv[e] = v[e]; }
    *(LAS f32x4*)(dst) = nkk; *(LAS f32x4*)(dst + 256) = w; *(LAS f32x4*)(dst + 512) = b; *(LAS f32x4*)(dst + 768) = kd; *(LAS f32x4*)(dst + 1024) = rr; *(LAS f32x4*)(dst + 1280) = vv;
}
__device__ __forceinline__ float amul(float a, float b) { float d; asm("v_mul_f32 %0, %1, %2" : "=v"(d) : "v"(a), "v"(b)); return d; }
__device__ __forceinline__ void afmac(float& d, float a, float b) { asm("v_fmac_f32 %0, %1, %2" : "+v"(d) : "v"(a), "v"(b)); }
__device__ __forceinline__ float afma(float a, float b, float c) { float d; asm("v_fma_f32 %0, %1, %2, %3" : "=v"(d) : "v"(a), "v"(b), "v"(c)); return d; }
__device__ __forceinline__ void sum16x2(float& a, float& b) {
    asm("s_nop 1\n\t"
        "v_add_f32_dpp %0, %0, %0 quad_perm:[1,0,3,2] row_mask:0xf bank_mask:0xf bound_ctrl:1\n\t"
        "v_add_f32_dpp %1, %1, %1 quad_perm:[1,0,3,2] row_mask:0xf bank_mask:0xf bound_ctrl:1\n\t"
        "s_nop 0\n\t"
        "v_add_f32_dpp %0, %0, %0 quad_perm:[2,3,0,1] row_mask:0xf bank_mask:0xf bound_ctrl:1\n\t"
        "v_add_f32_dpp %1, %1, %1 quad_perm:[2,3,0,1] row_mask:0xf bank_mask:0xf bound_ctrl:1\n\t"
        "s_nop 0\n\t"
        "v_add_f32_dpp %0, %0, %0 row_half_mirror row_mask:0xf bank_mask:0xf bound_ctrl:1\n\t"
        "v_add_f32_dpp %1, %1, %1 row_half_mirror row_mask:0xf bank_mask:0xf bound_ctrl:1\n\t"
        "s_nop 0\n\t"
        "v_add_f32_dpp %0, %0, %0 row_mirror row_mask:0xf bank_mask:0xf bound_ctrl:1\n\t"
        "v_add_f32_dpp %1, %1, %1 row_mirror row_mask:0xf bank_mask:0xf bound_ctrl:1"
        : "+v"(a), "+v"(b));
}
template <bool OUT> __device__ __forceinline__ void rs_chunk(float (&S)[2][4], const LAS unsigned char* buf, LAS unsigned char* obuf, LAS unsigned char* dump, int j0, int i0, int jb) {
#pragma unroll 4
    for (int s = 0; s < RS_TS; ++s) {
        const LAS unsigned char* base = buf + s * RS_STEP_B;
        const f32x4 nkk = *(const LAS f32x4*)(base + j0 * 4), w = *(const LAS f32x4*)(base + 256 + j0 * 4), b = *(const LAS f32x4*)(base + 512 + j0 * 4), kd = *(const LAS f32x4*)(base + 768 + j0 * 4);
        const f32x2_t v = *(const LAS f32x2_t*)(base + 1280 + i0 * 4);
        float sa0 = amul(S[0][0], nkk[0]), sa1 = amul(S[1][0], nkk[0]);
#pragma unroll
        for (int e = 1; e < 4; ++e) { afmac(sa0, S[0][e], nkk[e]); afmac(sa1, S[1][e], nkk[e]); }
        sum16x2(sa0, sa1);
#pragma unroll
        for (int e = 0; e < 4; ++e) { float t0 = amul(sa0, b[e]), t1 = amul(sa1, b[e]); afmac(t0, v[0], kd[e]); afmac(t1, v[1], kd[e]); S[0][e] = afma(S[0][e], w[e], t0); S[1][e] = afma(S[1][e], w[e], t1); }
        if (OUT) {
            const f32x4 r = *(const LAS f32x4*)(base + 1024 + j0 * 4);
            float o0 = amul(S[0][0], r[0]), o1 = amul(S[1][0], r[0]);
#pragma unroll
            for (int e = 1; e < 4; ++e) { afmac(o0, S[0][e], r[e]); afmac(o1, S[1][e], r[e]); }
            sum16x2(o0, o1);
            *(LAS unsigned*)(jb == 0 ? obuf + (s * 64 + i0) * 2 : dump) = pg8::cvt_pk_bf16(o0, o1);
        }
    }
}
__device__ __forceinline__ void ph_rwkv_scan2(const Args& a, LAS unsigned char* lds) {
    const int tid = TID, lane = LANE, wave = WAVE;
    const bf16* R = (const bf16*)(a.ws + WS_R); const bf16* K = (const bf16*)(a.ws + WS_K); const bf16* V = (const bf16*)(a.ws + WS_V); const bf16* KK = (const bf16*)(a.ws + WS_KK);
    const bf16* LR = (const bf16*)(a.ws + WS_LR); bf16* OR = (bf16*)a.out;
    constexpr int NCH = NSTEP / RS_TS;
    for (int u = blockIdx.x; u < 256; u += gridDim.x) {
        const int g = u >> 5, h = u & 31, dir = g >> 2, b = g & 3;
        const int ip = lane >> 4, jb = lane & 15, i0 = wave * 8 + ip * 2, j0 = jb * 4;
        const int ss = tid >> 4, cgp = tid & 15, ch = h * 64 + cgp * 4;
        float ka[4];
#pragma unroll
        for (int e = 0; e < 4; ++e) ka[e] = a.in[I_KA][ch + e];
        float S[2][4];
#pragma unroll
        for (int e = 0; e < 4; ++e) { S[0][e] = 0.f; S[1][e] = 0.f; }
        RRaw raw;
        __syncthreads();
        rs_load(raw, R, K, V, KK, LR, scan_row(ss, dir, b), ch, dir);
        rs_stage(raw, ka, lds + ss * RS_STEP_B + cgp * 16);
        __syncthreads();
        for (int c = 0; c < NCH; ++c) {
            LAS unsigned char* buf = lds + (c & 1) * RS_BUF_B; LAS unsigned char* nbuf = lds + ((c + 1) & 1) * RS_BUF_B; LAS unsigned char* obuf = lds + RS_OBUF + (c & 1) * RS_OBUF_B;
            const bool more = c + 1 < NCH;
            if (more) rs_load(raw, R, K, V, KK, LR, scan_row((c + 1) * RS_TS + ss, dir, b), ch, dir);
            const bool lat = c >= CTXL / RS_TS;
            if (lat) rs_chunk<true>(S, buf, obuf, lds + RS_DUMP + tid * 4, j0, i0, jb); else rs_chunk<false>(S, buf, obuf, lds + RS_DUMP + tid * 4, j0, i0, jb);
            if (more) rs_stage(raw, ka, nbuf + ss * RS_STEP_B + cgp * 16);
            __syncthreads();
            if (lat) { typedef unsigned u32x2_t __attribute__((ext_vector_type(2))); const u32x2_t ov = *(const LAS u32x2_t*)(obuf + (ss * 64 + cgp * 4) * 2);
                *(uint2*)(OR + ((size_t)dir * MX + scan_row(c * RS_TS + ss, dir, b)) * RW + ch) = make_uint2(ov[0], ov[1]); }
        }
    }
}

struct SIn { uint4 b0, b1, c0, c1; unsigned xs; float dt, la; };
__device__ __forceinline__ void ssd_load(SIn& x, const bf16* XS, const bf16* BC, const float* DT, const float* LA, int m, int chx, int cb, int dh) {
    x.b0 = ld16(BC + (size_t)m * RW + cb); x.b1 = ld16(BC + (size_t)m * RW + cb + 8); x.c0 = ld16(BC + (size_t)m * RW + 1024 + cb); x.c1 = ld16(BC + (size_t)m * RW + 1024 + cb + 8);
    x.xs = XS[(size_t)m * RW + chx]; x.dt = DT[(size_t)m * 64 + dh]; x.la = LA[(size_t)m * 64 + dh];
}
__device__ __forceinline__ float ssd_step(float (&s)[16], const SIn& x) {
    float B0[8], B1[8], C0[8], C1[8]; unpack8(x.b0, B0); unpack8(x.b1, B1); unpack8(x.c0, C0); unpack8(x.c1, C1);
    const float dec = __expf(x.la), xdt = __uint_as_float(x.xs << 16) * x.dt; float y = 0.f;
#pragma unroll
    for (int e = 0; e < 8; ++e) { s[e] = dec * s[e] + xdt * B0[e]; y += s[e] * C0[e]; s[8 + e] = dec * s[8 + e] + xdt * B1[e]; y += s[8 + e] * C1[e]; }
    y = sum8(y);
    return y;
}
__device__ __forceinline__ void ph_ssd_scan(const Args& a) {
    const int lane = LANE, wave = WAVE;
    const bf16* XS = (const bf16*)(a.ws + WS_XS); const bf16* BC = (const bf16*)(a.ws + WS_BC); const float* DT = (const float*)(a.ws + WS_DT); const float* LA = (const float*)(a.ws + WS_LA);
    bf16* YS = (bf16*)a.out + (size_t)2 * MX * RW;
    for (int u = blockIdx.x; u < 256; u += gridDim.x) {
        const int g = u >> 5, h = u & 31, dir = g >> 2, b = g & 3;
        const int p = wave * 8 + (lane >> 3), nb = lane & 7, chx = h * 64 + p, cb = (h >> 2) * 128 + nb * 16, dh = dir * 32 + h;
        float s[16];
#pragma unroll
        for (int e = 0; e < 16; ++e) s[e] = 0.f;
        SIn A[4], B[4];
#pragma unroll
        for (int q = 0; q < 4; ++q) ssd_load(A[q], XS, BC, DT, LA, scan_row(q, dir, b), chx, cb, dh);
        for (int n0 = 0; n0 < NSTEP; n0 += 8) {
#pragma unroll
            for (int q = 0; q < 4; ++q) ssd_load(B[q], XS, BC, DT, LA, scan_row(n0 + 4 + q, dir, b), chx, cb, dh);
#pragma unroll
            for (int q = 0; q < 4; ++q) { const int n = n0 + q; const float y = ssd_step(s, A[q]);
                if (n >= CTXL && nb == 0) YS[((size_t)dir * MX + scan_row(n, dir, b)) * RW + chx] = (bf16)f2bf(y); }
            if (n0 + 8 < NSTEP) {
#pragma unroll
                for (int q = 0; q < 4; ++q) ssd_load(A[q], XS, BC, DT, LA, scan_row(n0 + 8 + q, dir, b), chx, cb, dh);
            }
#pragma unroll
            for (int q = 0; q < 4; ++q) { const int n = n0 + 4 + q; const float y = ssd_step(s, B[q]);
                if (n >= CTXL && nb == 0) YS[((size_t)dir * MX + scan_row(n, dir, b)) * RW + chx] = (bf16)f2bf(y); }
        }
    }
}

typedef short bf16x8_t __attribute__((ext_vector_type(8)));
typedef float f32x16 __attribute__((ext_vector_type(16)));
constexpr int SLD = 272;
constexpr int L_C = 0, L_B = 34816, L_BT = 69632, L_XT = 104448, L_S = 121856, L_F = 139264;
static_assert(L_F + 4 * 512 <= LDS_CTL, "ssd lds map");
typedef unsigned u32x4_t __attribute__((ext_vector_type(4)));
__device__ __forceinline__ void lds_st16(LAS unsigned char* p, const uint4& v) { *(LAS u32x4_t*)p = (u32x4_t){v.x, v.y, v.z, v.w}; }
__device__ __forceinline__ uint4 lds_ld16(const LAS unsigned char* p) { const u32x4_t t = *(const LAS u32x4_t*)p; return make_uint4(t[0], t[1], t[2], t[3]); }
__device__ __forceinline__ bf16x8_t lfrag(LAS unsigned char* img, int row, int k) { return *(LAS bf16x8_t*)(img + row * SLD + k * 2); }
__device__ __forceinline__ void ph_ssd_chunked(const Args& a, LAS unsigned char* lds) {
    const int tid = TID, lane = LANE, wave = WAVE, r = lane & 31, hh = lane >> 5;
    const bf16* XS = (const bf16*)(a.ws + WS_XS); const bf16* BC = (const bf16*)(a.ws + WS_BC); const float* DT = (const float*)(a.ws + WS_DT); const float* LA = (const float*)(a.ws + WS_LA);
    bf16* YS = (bf16*)a.out + (size_t)2 * MX * RW;
    LAS float* laS = (LAS float*)(lds + L_F); LAS float* dtS = laS + 128; LAS float* cumS = laS + 256;
    for (int u = blockIdx.x; u < 256; u += gridDim.x) {
        const int g = u >> 5, h = u & 31, dir = g >> 2, b = g & 3, gi = h >> 2;
        f32x16 st;
#pragma unroll
        for (int q = 0; q < 16; ++q) st[q] = 0.f;
        __syncthreads();
        for (int i = tid; i < 64 * SLD / 4; i += 512) ((LAS unsigned*)(lds + L_S))[i] = 0u;
        for (int c = 0; c < NSTEP / 128; ++c) {
            const int n0 = c * 128; const bool lat = c >= CTXL / 128;
            for (int i = tid; i < 2048; i += 512) { const int l = i >> 4, pc = i & 15; const size_t m = (size_t)scan_row(n0 + l, dir, b);
                lds_st16(lds + L_B + l * SLD + pc * 16, ld16(BC + m * RW + gi * 128 + pc * 8));
                if (lat) lds_st16(lds + L_C + l * SLD + pc * 16, ld16(BC + m * RW + 1024 + gi * 128 + pc * 8)); }
            for (int i = tid; i < 1024; i += 512) { const int l = i >> 3, pc = i & 7; const size_t m = (size_t)scan_row(n0 + l, dir, b);
                const uint4 v = ld16(XS + m * RW + h * 64 + pc * 8); const unsigned w[4] = {v.x, v.y, v.z, v.w};
#pragma unroll
                for (int e = 0; e < 8; ++e) *(LAS bf16*)(lds + L_XT + (pc * 8 + e) * SLD + l * 2) = (bf16)((e & 1) ? (w[e >> 1] >> 16) : (w[e >> 1] & 0xffffu)); }
            if (tid < 128) { const size_t m = (size_t)scan_row(n0 + tid, dir, b); laS[tid] = LA[m * 64 + dir * 32 + h]; dtS[tid] = DT[m * 64 + dir * 32 + h]; }
            __syncthreads();
            if (wave == 0) { const float a0 = laS[2 * lane], b0 = laS[2 * lane + 1]; float x = a0 + b0;
#pragma unroll
                for (int d = 1; d < 64; d <<= 1) { const float y = __shfl_up(x, d); if (lane >= d) x += y; }
                cumS[2 * lane + 1] = x; cumS[2 * lane] = x - b0; }
            __syncthreads();
            const float ctot = cumS[127];
            for (int i = tid; i < 2048; i += 512) { const int l = i >> 4, pc = i & 15; const float wl = dtS[l] * __expf(ctot - cumS[l]);
                float f[8]; unpack8(lds_ld16(lds + L_B + l * SLD + pc * 16), f);
#pragma unroll
                for (int e = 0; e < 8; ++e) *(LAS bf16*)(lds + L_BT + (pc * 8 + e) * SLD + l * 2) = (bf16)f2bf(f[e] * wl); }
            f32x16 acc0, acc1;
            const int lt = wave >> 1, st0 = 2 * (wave & 1);
            if (lat) {
#pragma unroll
                for (int q = 0; q < 16; ++q) { acc0[q] = 0.f; acc1[q] = 0.f; }
                if (st0 <= lt) {
#pragma unroll
                    for (int ks = 0; ks < 8; ++ks) { const bf16x8_t af = lfrag(lds + L_C, lt * 32 + r, ks * 16 + 8 * hh);
                        acc0 = __builtin_amdgcn_mfma_f32_32x32x16_bf16(af, lfrag(lds + L_B, st0 * 32 + r, ks * 16 + 8 * hh), acc0, 0, 0, 0);
                        if (st0 + 1 <= lt) acc1 = __builtin_amdgcn_mfma_f32_32x32x16_bf16(af, lfrag(lds + L_B, (st0 + 1) * 32 + r, ks * 16 + 8 * hh), acc1, 0, 0, 0); }
                }
            }
            __syncthreads();
            if (lat) {
#pragma unroll
                for (int t = 0; t < 2; ++t) { const int stt = st0 + t;
                    if (stt <= lt) { const int sidx = stt * 32 + r; const float cs = cumS[sidx], ds = dtS[sidx];
#pragma unroll
                        for (int q = 0; q < 16; ++q) { const int l = lt * 32 + (q & 3) + 8 * (q >> 2) + 4 * hh; const float v = t ? acc1[q] : acc0[q];
                            const float wv = sidx <= l ? v * __expf(cumS[l] - cs) * ds : 0.f;
                            *(LAS bf16*)(lds + L_B + l * SLD + sidx * 2) = (bf16)f2bf(wv); } } }
            }
            __syncthreads();
            if (lat) {
                const int pt = wave & 1;
                f32x16 accd, acco;
#pragma unroll
                for (int q = 0; q < 16; ++q) { accd[q] = 0.f; acco[q] = 0.f; }
                for (int ks = 0; ks < 2 * (lt + 1); ++ks)
                    accd = __builtin_amdgcn_mfma_f32_32x32x16_bf16(lfrag(lds + L_B, lt * 32 + r, ks * 16 + 8 * hh), lfrag(lds + L_XT, pt * 32 + r, ks * 16 + 8 * hh), accd, 0, 0, 0);
#pragma unroll
                for (int ks = 0; ks < 8; ++ks)
                    acco = __builtin_amdgcn_mfma_f32_32x32x16_bf16(lfrag(lds + L_C, lt * 32 + r, ks * 16 + 8 * hh), lfrag(lds + L_S, pt * 32 + r, ks * 16 + 8 * hh), acco, 0, 0, 0);
#pragma unroll
                for (int q = 0; q < 16; ++q) { const int l = lt * 32 + (q & 3) + 8 * (q >> 2) + 4 * hh; const float y = accd[q] + __expf(cumS[l]) * acco[q];
                    YS[((size_t)dir * MX + scan_row(n0 + l, dir, b)) * RW + h * 64 + pt * 32 + r] = (bf16)f2bf(y); }
            }
            const int pt2 = wave >> 2, nt = wave & 3;
            { const float dc = __expf(ctot);
#pragma unroll
              for (int q = 0; q < 16; ++q) st[q] *= dc;
#pragma unroll
              for (int ks = 0; ks < 8; ++ks)
                  st = __builtin_amdgcn_mfma_f32_32x32x16_bf16(lfrag(lds + L_XT, pt2 * 32 + r, ks * 16 + 8 * hh), lfrag(lds + L_BT, nt * 32 + r, ks * 16 + 8 * hh), st, 0, 0, 0); }
            __syncthreads();
#pragma unroll
            for (int q = 0; q < 16; ++q) { const int p = pt2 * 32 + (q & 3) + 8 * (q >> 2) + 4 * hh; *(LAS bf16*)(lds + L_S + p * SLD + (nt * 32 + r) * 2) = (bf16)f2bf(st[q]); }
            __syncthreads();
        }
    }
}

constexpr int CR_T = 32, CR_PJ = 144, CR_PS = 80, CR_PF = 272;
constexpr int CR_AR = 0, CR_BK = CR_AR + 64 * CR_PJ, CR_BHT = CR_BK + 64 * CR_PJ, CR_KHT = CR_BHT + 64 * CR_PS, CR_VT = CR_KHT + 64 * CR_PS, CR_SB = CR_VT + 64 * CR_PS,
              CR_NAK = CR_SB + 2 * 64 * CR_PJ, CR_PBR = CR_NAK + 32 * CR_PS, CR_PKR = CR_PBR + 32 * CR_PS, CR_NABF = CR_PKR + 32 * CR_PS, CR_RT = CR_NABF + 32 * CR_PJ,
              CR_SA = CR_RT + 32 * CR_PF, CR_GT = CR_SA + 64 * CR_PS, CR_CP = CR_GT + 256, CR_OB = CR_CP + 8 * 256, CR_END = CR_OB + 32 * 128;
static_assert(CR_END <= 131072, "chunked rwkv lds map");
__device__ __forceinline__ f32x16 mfma32(const bf16x8_t& a, const bf16x8_t& b, const f32x16& c) { return __builtin_amdgcn_mfma_f32_32x32x16_bf16(a, b, c, 0, 0, 0); }
__device__ __forceinline__ bf16x8_t cfrag(const LAS unsigned char* img, int pitch, int row, int k) { return *(const LAS bf16x8_t*)(img + row * pitch + k * 2); }
struct CRaw { unsigned short r[4], k[4], kk[4], w[4], al[4], v[4]; };
__device__ __forceinline__ void cr_load(CRaw& x, const bf16* R, const bf16* K, const bf16* V, const bf16* KK, const bf16* LR, int n0, int dir, int b, int chn) {
#pragma unroll
    for (int u = 0; u < 4; ++u) { const size_t m = (size_t)scan_row(n0 + u, dir, b);
        x.r[u] = R[m * RW + chn]; x.k[u] = K[m * RW + chn]; x.kk[u] = KK[m * RW + chn]; x.v[u] = V[m * RW + chn];
        x.w[u] = LR[m * NLR + dir * 2048 + chn]; x.al[u] = LR[m * NLR + 4096 + dir * 2048 + chn]; }
}
__device__ __forceinline__ void ph_rwkv_chunked(const Args& a, LAS unsigned char* lds) {
    const int tid = TID, lane = LANE, wave = WAVE, r = lane & 31, hh = lane >> 5;
    const bf16* R = (const bf16*)(a.ws + WS_R); const bf16* K = (const bf16*)(a.ws + WS_K); const bf16* V = (const bf16*)(a.ws + WS_V); const bf16* KK = (const bf16*)(a.ws + WS_KK);
    const bf16* LR = (const bf16*)(a.ws + WS_LR); bf16* OR = (bf16*)a.out;
    constexpr int NCH = NSTEP / CR_T;
    LAS float* GT = (LAS float*)(lds + CR_GT); LAS float* CP = (LAS float*)(lds + CR_CP);
    for (int u0 = blockIdx.x; u0 < 256; u0 += gridDim.x) {
        const int g = u0 >> 5, h = u0 & 31, dir = g >> 2, b = g & 3, chn = h * 64 + lane;
        const float ka = a.in[I_KA][chn];
        f32x16 st;
#pragma unroll
        for (int q = 0; q < 16; ++q) st[q] = 0.f;
        __syncthreads();
        for (int i = tid; i < 64 * CR_PJ / 4; i += 512) ((LAS unsigned*)(lds + CR_SB))[i] = 0u;
        CRaw raw; cr_load(raw, R, K, V, KK, LR, 4 * wave, dir, b, chn);
        for (int c = 0; c < NCH; ++c) {
            const bool lat = c >= CTXL / CR_T;
            const LAS unsigned char* SBc = lds + CR_SB + (c & 1) * 64 * CR_PJ; LAS unsigned char* SBn = lds + CR_SB + ((c + 1) & 1) * 64 * CR_PJ;
            float rv[4], kd[4], bv[4], av[4], vv[4], lw[4], cl[4];
            { float run = 0.f;
#pragma unroll
              for (int u = 0; u < 4; ++u) { const float kk = __uint_as_float((unsigned)raw.kk[u] << 16), al = __uint_as_float((unsigned)raw.al[u] << 16), kx = __uint_as_float((unsigned)raw.k[u] << 16);
                  rv[u] = __uint_as_float((unsigned)raw.r[u] << 16); vv[u] = __uint_as_float((unsigned)raw.v[u] << 16);
                  const float w = 1.f - __uint_as_float((unsigned)raw.w[u] << 16); lw[u] = __logf(w); run += lw[u]; cl[u] = run;
                  av[u] = -kk; bv[u] = kk * al; kd[u] = kx * (1.f + (al - 1.f) * ka); }
              CP[wave * 64 + lane] = run; }
            if (c + 1 < NCH) cr_load(raw, R, K, V, KK, LR, (c + 1) * CR_T + 4 * wave, dir, b, chn);
            __syncthreads();
            { float pre = 0.f, tot = 0.f;
#pragma unroll
              for (int q = 0; q < 8; ++q) { const float x = CP[q * 64 + lane]; tot += x; if (q < wave) pre += x; }
              const float gT = __expf(tot); if (wave == 0) GT[lane] = gT;
#pragma unroll
              for (int u = 0; u < 4; ++u) { const int t = 4 * wave + u; const float ct = pre + cl[u], e1 = __expf(ct), einv = 1.f / e1, ep = __expf(ct - lw[u]), eh = gT * einv;
                  *(LAS bf16*)(lds + CR_AR + t * CR_PJ + lane * 2) = (bf16)f2bf(av[u] * ep); *(LAS bf16*)(lds + CR_AR + (32 + t) * CR_PJ + lane * 2) = (bf16)f2bf(rv[u] * e1);
                  *(LAS bf16*)(lds + CR_BK + t * CR_PJ + lane * 2) = (bf16)f2bf(bv[u] * einv); *(LAS bf16*)(lds + CR_BK + (32 + t) * CR_PJ + lane * 2) = (bf16)f2bf(kd[u] * einv);
                  *(LAS bf16*)(lds + CR_BHT + lane * CR_PS + t * 2) = (bf16)f2bf(bv[u] * eh); *(LAS bf16*)(lds + CR_KHT + lane * CR_PS + t * 2) = (bf16)f2bf(kd[u] * eh);
                  *(LAS bf16*)(lds + CR_VT + lane * CR_PS + t * 2) = (bf16)f2bf(vv[u]); } }
            __syncthreads();
            f32x16 acc;
#pragma unroll
            for (int q = 0; q < 16; ++q) acc[q] = 0.f;
            if (wave < 4) {
                const int rb = wave >> 1, cb = wave & 1;
#pragma unroll
                for (int ks = 0; ks < 4; ++ks) acc = mfma32(cfrag(lds + CR_BK, CR_PJ, 32 * rb + r, 16 * ks + 8 * hh), cfrag(lds + CR_AR, CR_PJ, 32 * cb + r, 16 * ks + 8 * hh), acc);
#pragma unroll
                for (int gq = 0; gq < 4; ++gq) { float o[4];
#pragma unroll
                    for (int e = 0; e < 4; ++e) { const int sidx = 8 * gq + 4 * hh + e; const bool keep = cb ? (sidx <= r) : (sidx < r); o[e] = keep ? acc[4 * gq + e] : 0.f; }
                    if (wave == 0) *(LAS f32x4*)(lds + CR_NABF + r * CR_PJ + (8 * gq + 4 * hh) * 4) = (f32x4){o[0], o[1], o[2], o[3]};
                    else { LAS unsigned char* dst = lds + (wave == 1 ? CR_PBR : wave == 2 ? CR_NAK : CR_PKR) + r * CR_PS + (8 * gq + 4 * hh) * 2;
                        typedef unsigned u32x2_t __attribute__((ext_vector_type(2))); *(LAS u32x2_t*)dst = (u32x2_t){pk2(o[0], o[1]), pk2(o[2], o[3])}; } }
            } else if (wave < 6 || lat) {
                const int it = wave & 1, cb = wave >> 1 & 1 ? 32 : 0;
#pragma unroll
                for (int ks = 0; ks < 4; ++ks) acc = mfma32(cfrag(SBc, CR_PJ, 32 * it + r, 16 * ks + 8 * hh), cfrag(lds + CR_AR, CR_PJ, cb + r, 16 * ks + 8 * hh), acc);
            }
            __syncthreads();
            if (wave >= 4 && (wave < 6 || lat)) {
                const int it = wave & 1; const LAS unsigned char* NT = lds + (wave < 6 ? CR_NAK : CR_PKR);
#pragma unroll
                for (int ks = 0; ks < 2; ++ks) acc = mfma32(cfrag(lds + CR_VT, CR_PS, 32 * it + r, 16 * ks + 8 * hh), cfrag(NT, CR_PS, r, 16 * ks + 8 * hh), acc);
                if (wave < 6) {
#pragma unroll
                    for (int gq = 0; gq < 4; ++gq) *(LAS f32x4*)(lds + CR_RT + r * CR_PF + (32 * it + 8 * gq + 4 * hh) * 4) = (f32x4){acc[4 * gq], acc[4 * gq + 1], acc[4 * gq + 2], acc[4 * gq + 3]};
                }
            }
            __syncthreads();
            if (wave == 0) {
                float sa[32];
#pragma unroll
                for (int t = 0; t < 32; ++t) sa[t] = 0.f;
#pragma unroll
                for (int t = 0; t < 32; ++t) {
                    float x = *(LAS float*)(lds + CR_RT + t * CR_PF + lane * 4);
#pragma unroll
                    for (int s4 = 0; s4 < (t + 3) / 4; ++s4) { const f32x4 nv = *(LAS f32x4*)(lds + CR_NABF + t * CR_PJ + s4 * 16);
                        x += sa[4 * s4] * nv[0]; x += sa[4 * s4 + 1] * nv[1]; x += sa[4 * s4 + 2] * nv[2]; x += sa[4 * s4 + 3] * nv[3]; }
                    sa[t] = x; asm volatile("" : "+v"(sa[t]) :: "memory");
                }
#pragma unroll
                for (int q4 = 0; q4 < 4; ++q4) { u32x4_t w4;
#pragma unroll
                    for (int e = 0; e < 4; ++e) w4[e] = pk2(sa[8 * q4 + 2 * e], sa[8 * q4 + 2 * e + 1]);
                    *(LAS u32x4_t*)(lds + CR_SA + lane * CR_PS + q4 * 16) = w4; }
            }
            __syncthreads();
            if (wave < 4) {
                const int jt = wave >> 1, it = wave & 1;
#pragma unroll
                for (int gq = 0; gq < 4; ++gq) { const f32x4 gv = *(LAS f32x4*)(lds + CR_GT + (32 * jt + 8 * gq + 4 * hh) * 4);
#pragma unroll
                    for (int e = 0; e < 4; ++e) st[4 * gq + e] *= gv[e]; }
#pragma unroll
                for (int ks = 0; ks < 2; ++ks) { st = mfma32(cfrag(lds + CR_BHT, CR_PS, 32 * jt + r, 16 * ks + 8 * hh), cfrag(lds + CR_SA, CR_PS, 32 * it + r, 16 * ks + 8 * hh), st);
                    st = mfma32(cfrag(lds + CR_KHT, CR_PS, 32 * jt + r, 16 * ks + 8 * hh), cfrag(lds + CR_VT, CR_PS, 32 * it + r, 16 * ks + 8 * hh), st); }
#pragma unroll
                for (int gq = 0; gq < 4; ++gq) { typedef unsigned u32x2_t __attribute__((ext_vector_type(2)));
                    *(LAS u32x2_t*)(SBn + (32 * it + r) * CR_PJ + (32 * jt + 8 * gq + 4 * hh) * 2) = (u32x2_t){pk2(st[4 * gq], st[4 * gq + 1]), pk2(st[4 * gq + 2], st[4 * gq + 3])}; }
            } else if (wave >= 6 && lat) {
                const int it = wave & 1;
#pragma unroll
                for (int ks = 0; ks < 2; ++ks) acc = mfma32(cfrag(lds + CR_SA, CR_PS, 32 * it + r, 16 * ks + 8 * hh), cfrag(lds + CR_PBR, CR_PS, r, 16 * ks + 8 * hh), acc);
#pragma unroll
                for (int gq = 0; gq < 4; ++gq) { typedef unsigned u32x2_t __attribute__((ext_vector_type(2)));
                    *(LAS u32x2_t*)(lds + CR_OB + r * 128 + (32 * it + 8 * gq + 4 * hh) * 2) = (u32x2_t){pk2(acc[4 * gq], acc[4 * gq + 1]), pk2(acc[4 * gq + 2], acc[4 * gq + 3])}; }
            }
            __syncthreads();
            if (lat) { const int ss = tid >> 4, cgp = tid & 15; typedef unsigned u32x2_t __attribute__((ext_vector_type(2)));
                const u32x2_t ov = *(const LAS u32x2_t*)(lds + CR_OB + ss * 128 + cgp * 8);
                *(uint2*)(OR + ((size_t)dir * MX + scan_row(c * CR_T + ss, dir, b)) * RW + h * 64 + cgp * 4) = make_uint2(ov[0], ov[1]); }
        }
    }
}

__device__ __forceinline__ void ph_finish(const Args& a) {
    const int lane = LANE;
    const bf16* R = (const bf16*)(a.ws + WS_R); const bf16* K = (const bf16*)(a.ws + WS_K); const bf16* V = (const bf16*)(a.ws + WS_V);
    const bf16* LR = (const bf16*)(a.ws + WS_LR); const bf16* XS = (const bf16*)(a.ws + WS_XS); const bf16* Z = (const bf16*)(a.ws + WS_Z);
    const bf16* OR = (const bf16*)a.out; const bf16* YS = (const bf16*)a.out + (size_t)2 * MX * RW;
    bf16* A2 = (bf16*)(a.ws + WS_A2);
    for (int m = GW; m < MX; m += NGW) {
#pragma unroll
        for (int i = 0; i < 4; ++i) {
            const int c0 = (lane + 64 * i) * 8;
            float of[8], ob[8], o[8], res[8];
#if MK_SKIP_RWKV
#pragma unroll
            for (int e = 0; e < 8; ++e) res[e] = 0.f;
#else
            unpack8(ld16(OR + (size_t)m * RW + c0), of); unpack8(ld16(OR + ((size_t)MX + m) * RW + c0), ob);
            float sm = 0.f;
#pragma unroll
            for (int e = 0; e < 8; ++e) { o[e] = of[e] + ob[e]; sm += o[e]; }
            sm = sum8(sm);
            const float mean = sm * (1.f / 64.f); float sq = 0.f;
#pragma unroll
            for (int e = 0; e < 8; ++e) { o[e] -= mean; sq += o[e] * o[e]; }
            sq = sum8(sq);
            const float rstd = rsqrtf(sq * (1.f / 64.f) + GN_EPS);
            float lw[8], lb[8], r[8], k[8], v[8], a0[8], a1[8], ka[8], rk[8], gg[8];
            ldf8(a.in[I_LNW] + c0, lw); ldf8(a.in[I_LNB] + c0, lb); ldf8(a.in[I_KA] + c0, ka); ldf8(a.in[I_RK] + c0, rk);
            unpack8(ld16(R + (size_t)m * RW + c0), r); unpack8(ld16(K + (size_t)m * RW + c0), k); unpack8(ld16(V + (size_t)m * RW + c0), v);
            unpack8(ld16(LR + (size_t)m * NLR + 4096 + c0), a0); unpack8(ld16(LR + (size_t)m * NLR + 6144 + c0), a1); unpack8(ld16(LR + (size_t)m * NLR + 8192 + c0), gg);
            float bs = 0.f;
#pragma unroll
            for (int e = 0; e < 8; ++e) { const float kd = k[e] * (2.f + (a0[e] + a1[e] - 2.f) * ka[e]); bs += r[e] * kd * rk[e]; }
            bs = sum8(bs);
#pragma unroll
            for (int e = 0; e < 8; ++e) res[e] = (o[e] * rstd * lw[e] + lb[e] + bs * v[e]) * gg[e];
#endif
            st16(A2 + (size_t)m * DM + c0, pack8(res));
        }
#pragma unroll
        for (int i = 0; i < 4; ++i) {
            const int c0 = (lane + 64 * i) * 8;
            float yf[8], yb[8], xs[8], z[8], nw[8], y[8];
#if MK_SKIP_SSD
#pragma unroll
            for (int e = 0; e < 8; ++e) y[e] = 0.f;
#else
            unpack8(ld16(YS + (size_t)m * RW + c0), yf); unpack8(ld16(YS + ((size_t)MX + m) * RW + c0), yb);
            unpack8(ld16(XS + (size_t)m * RW + c0), xs); unpack8(ld16(Z + (size_t)m * RW + c0), z); ldf8(a.in[I_NORMW] + c0, nw);
            const float dsk = a.in[I_SSMD][c0 >> 6]; float ss = 0.f;
#pragma unroll
            for (int e = 0; e < 8; ++e) { y[e] = (yf[e] + yb[e] + dsk * xs[e]) * (z[e] / (1.f + __expf(-z[e]))); ss += y[e] * y[e]; }
            ss = sum32(ss);
            const float rstd = rsqrtf(ss * (1.f / 256.f) + RMS_EPS);
#pragma unroll
            for (int e = 0; e < 8; ++e) y[e] = y[e] * rstd * nw[e];
#endif
            st16(A2 + (size_t)m * DM + 2048 + c0, pack8(y));
        }
    }
}

__device__ __forceinline__ float enc_key(float v, int idx) { return __uint_as_float((__float_as_uint(v) & 0xffffff00u) | (unsigned)idx); }
typedef float f32x32_t __attribute__((ext_vector_type(32)));
typedef unsigned u32x6_t __attribute__((ext_vector_type(6)));
struct Fp6Row { uint4 q0, q1, q2; };
__device__ __forceinline__ Fp6Row ld_fp6row(const unsigned char* p) { Fp6Row r; r.q0 = *(const uint4*)p; r.q1 = *(const uint4*)(p + 16); r.q2 = *(const uint4*)(p + 32); return r; }
__device__ __forceinline__ f32x32_t fp6_unpack(const Fp6Row& r, int p, float one) {
    u32x6_t s; if (p == 0) { s[0] = r.q0.x; s[1] = r.q0.y; s[2] = r.q0.z; s[3] = r.q0.w; s[4] = r.q1.x; s[5] = r.q1.y; } else { s[0] = r.q1.z; s[1] = r.q1.w; s[2] = r.q2.x; s[3] = r.q2.y; s[4] = r.q2.z; s[5] = r.q2.w; }
    return __builtin_amdgcn_cvt_scalef32_pk32_f32_fp6(s, one);
}
#define PIN4(a) asm volatile("" : "+v"((a)[0]), "+v"((a)[1]), "+v"((a)[2]), "+v"((a)[3]))
__device__ __forceinline__ void ph_peer(const Args& a, float* outp) {
    const int lane = LANE;
    const float* mod = (const float*)(a.ws + WS_MOD); const float* S = (const float*)(a.ws + WS_S);
    const unsigned char* U8 = (const unsigned char*)(a.ws + WS_U8); const unsigned char* V8 = (const unsigned char*)(a.ws + WS_V8);
    const float* USC = (const float*)(a.ws + WS_USC); const float* VSC = (const float*)(a.ws + WS_VSC);
    for (int m = GW; m < MX; m += NGW) {
        const int bb = m / SEQ;
        float* hrow = a.out + (size_t)m * DM;
        int l4 = lane * 4; asm volatile("" : "+v"(l4));
        float acc[16][4];
#if MK_SKIP_PEER
#pragma unroll
        for (int j = 0; j < 16; ++j)
#pragma unroll
            for (int e = 0; e < 4; ++e) acc[j][e] = 0.f;
#else
        float xn[16][4];
        { float ss = 0.f;
#pragma unroll
          for (int j = 0; j < 16; ++j) { const float4 h4 = *(const float4*)(hrow + 256 * j + l4); xn[j][0] = h4.x; xn[j][1] = h4.y; xn[j][2] = h4.z; xn[j][3] = h4.w; ss += (h4.x * h4.x + h4.y * h4.y) + (h4.z * h4.z + h4.w * h4.w); }
          const float rstd = rsqrtf(wave_sum(ss) * (1.f / DM) + RMS_EPS);
          const float* sh2 = mod + (size_t)bb * NMOD + 3 * DM; const float* sc2 = mod + (size_t)bb * NMOD + 4 * DM; const float* g2 = a.in[I_N2G];
#pragma unroll
          for (int j = 0; j < 16; ++j) { const int c = 256 * j + l4; const float4 gg = *(const float4*)(g2 + c), s0 = *(const float4*)(sh2 + c), s1 = *(const float4*)(sc2 + c);
              xn[j][0] = xn[j][0] * rstd * gg.x * (1.f + s1.x) + s0.x; xn[j][1] = xn[j][1] * rstd * gg.y * (1.f + s1.y) + s0.y; xn[j][2] = xn[j][2] * rstd * gg.z * (1.f + s1.z) + s0.z; xn[j][3] = xn[j][3] * rstd * gg.w * (1.f + s1.w) + s0.w;
              if ((j & 3) == 3) { PIN4(xn[j - 3]); PIN4(xn[j - 2]); PIN4(xn[j - 1]); PIN4(xn[j]); asm volatile("" ::: "memory"); } } }
        int eid0 = 0, eid1 = 0; float gt0 = 0.f, gt1 = 0.f;
        const float NEG = -3.0e38f;
#pragma unroll 1
        for (int hd = 0; hd < 8; ++hd) {
            const float* srow = S + (size_t)m * 2048 + hd * 256;
            float c1a = enc_key(srow[lane], lane), c1b = enc_key(srow[64 + lane], 64 + lane), c2a = enc_key(srow[128 + lane], lane), c2b = enc_key(srow[192 + lane], 64 + lane);
            float t1 = NEG, t2 = NEG;
#pragma unroll 1
            for (int k = 0; k < 16; ++k) {
                const float m1 = wave_max(fmaxf(c1a, c1b)), m2 = wave_max(fmaxf(c2a, c2b));
                if (c1a == m1) c1a = NEG; if (c1b == m1) c1b = NEG; if (c2a == m2) c2a = NEG; if (c2b == m2) c2b = NEG;
                if (lane == k) { t1 = m1; t2 = m2; }
            }
            const float v1 = __uint_as_float(__float_as_uint(t1) & 0xffffff00u), v2 = __uint_as_float(__float_as_uint(t2) & 0xffffff00u);
            const int i1 = (int)(__float_as_uint(t1) & 0xffu), i2 = (int)(__float_as_uint(t2) & 0xffu);
            float cd[4];
#pragma unroll
            for (int e = 0; e < 4; ++e) { const float va = __shfl(v1, (lane >> 4) + 4 * e), vb = __shfl(v2, lane & 15); cd[e] = enc_key(va + vb, lane + 64 * e); }
            float best = NEG; int ex = 0;
#pragma unroll 1
            for (int k = 0; k < 16; ++k) {
                const float mx = wave_max(fmaxf(fmaxf(cd[0], cd[1]), fmaxf(cd[2], cd[3])));
#pragma unroll
                for (int e = 0; e < 4; ++e) if (cd[e] == mx) cd[e] = NEG;
                const int cidx = (int)(__float_as_uint(mx) & 0xffu);
                const int ea = __shfl(i1, cidx >> 4), eb = __shfl(i2, cidx & 15);
                if (lane == k) { best = __uint_as_float(__float_as_uint(mx) & 0xffffff00u); ex = ea * 128 + eb; }
            }
            const float bmax = __shfl(best, 0);
            const float pe = lane < 16 ? __expf(best - bmax) : 0.f;
            const float gate = pe / wave_sum(pe);
            const float gsh = __shfl(gate, lane & 15); const int esh = __shfl(ex, lane & 15);
            if ((lane >> 4) == (hd & 3)) { if (hd < 4) { gt0 = gsh; eid0 = esh; } else { gt1 = gsh; eid1 = esh; } }
        }
        const int l48 = lane * 48;
        float cf0 = 0.f, cf1 = 0.f;
#pragma unroll 1
        for (int p0 = 0; p0 < 128; p0 += 4) {
            float d[4]; Fp6Row qu[4];
#pragma unroll
            for (int q = 0; q < 4; ++q) { const int e = __builtin_amdgcn_readlane(p0 < 64 ? eid0 : eid1, (p0 + q) & 63); qu[q] = ld_fp6row(U8 + (size_t)e * 3072 + l48); }
#pragma unroll
            for (int q = 0; q < 4; ++q) {
                float dd = 0.f;
#pragma unroll
                for (int p = 0; p < 2; ++p) { float one = 1.0f; asm volatile("" : "+v"(one)); const f32x32_t f = fp6_unpack(qu[q], p, one);
#pragma unroll
                    for (int t = 0; t < 32; ++t) dd += xn[8 * p + (t >> 2)][t & 3] * f[t];
                    asm volatile("" : "+v"(dd)); }
                d[q] = dd;
            }
#pragma unroll
            for (int q = 0; q < 4; ++q) {
                const int p = p0 + q; const int e = __builtin_amdgcn_readlane(p0 < 64 ? eid0 : eid1, p & 63);
                const float dot = wave_sum(d[q]) * USC[e];
                const float act = 0.5f * dot * (1.f + erff(dot * 0.70710678f)) * VSC[e];
                if (lane == (p & 63)) { if (p0 < 64) cf0 = gt0 * act; else cf1 = gt1 * act; }
            }
        }
#pragma unroll
        for (int j = 0; j < 16; ++j)
#pragma unroll
            for (int e = 0; e < 4; ++e) acc[j][e] = 0.f;
#pragma unroll 1
        for (int p0 = 0; p0 < 128; p0 += 4) {
            Fp6Row qv[4]; float cfv[4];
#pragma unroll
            for (int q = 0; q < 4; ++q) { const int e = __builtin_amdgcn_readlane(p0 < 64 ? eid0 : eid1, (p0 + q) & 63); cfv[q] = rlane(p0 < 64 ? cf0 : cf1, (p0 + q) & 63); qv[q] = ld_fp6row(V8 + (size_t)e * 3072 + l48); }
#pragma unroll
            for (int q = 0; q < 4; ++q)
#pragma unroll
                for (int p = 0; p < 2; ++p) { float one = 1.0f; asm volatile("" : "+v"(one)); const f32x32_t f = fp6_unpack(qv[q], p, one);
#pragma unroll
                    for (int t = 0; t < 32; ++t) acc[8 * p + (t >> 2)][t & 3] += cfv[q] * f[t];
#pragma unroll
                    for (int jj = 0; jj < 8; ++jj) PIN4(acc[8 * p + jj]); }
        }
#endif
        { const float* gt2 = mod + (size_t)bb * NMOD + 5 * DM; float ss = 0.f;
#pragma unroll
          for (int j = 0; j < 16; ++j) { const int c = 256 * j + l4; const float4 g = *(const float4*)(gt2 + c), h4 = *(const float4*)(hrow + c);
              acc[j][0] = h4.x + g.x * acc[j][0]; acc[j][1] = h4.y + g.y * acc[j][1]; acc[j][2] = h4.z + g.z * acc[j][2]; acc[j][3] = h4.w + g.w * acc[j][3];
              ss += (acc[j][0] * acc[j][0] + acc[j][1] * acc[j][1]) + (acc[j][2] * acc[j][2] + acc[j][3] * acc[j][3]);
              if ((j & 3) == 3) { PIN4(acc[j - 3]); PIN4(acc[j - 2]); PIN4(acc[j - 1]); PIN4(acc[j]); asm volatile("" ::: "memory"); } }
          const float rstd = rsqrtf(wave_sum(ss) * (1.f / DM) + RMS_EPS);
#pragma unroll
          for (int j = 0; j < 16; ++j) { const int c = 256 * j + l4; const float4 fg = *(const float4*)(a.in[I_FG] + c);
              *(float4*)(outp + (size_t)m * DM + c) = make_float4(acc[j][0] * rstd * fg.x, acc[j][1] * rstd * fg.y, acc[j][2] * rstd * fg.z, acc[j][3] * rstd * fg.w);
              if ((j & 3) == 3) asm volatile("" ::: "memory"); } }
    }
}

constexpr int N_PHASES = 13;
__global__ void __launch_bounds__(512, 2) hybrid_fwd(Args args) {
    extern __shared__ __attribute__((aligned(16))) unsigned char lds_raw[];
    LAS unsigned char* lds = (LAS unsigned char*)lds_raw;
    volatile LAS unsigned* MISC = (volatile LAS unsigned*)(lds + LDS_MISC);
    for (int u = TID; u < (LDS_BYTES - LDS_CTL) / 4; u += 512) ((LAS unsigned*)(lds + LDS_CTL))[u] = 0u;
    __syncthreads();
    const int lo = args.ph_lo, hi = args.ph_hi;
    XcdBarrier bar; bar.bar = (unsigned*)(args.ws + WS_CTL); bar.x = 0; bar.st = nullptr;
    if (hi - lo > 1) bar = xcd_barrier_post((unsigned*)(args.ws + WS_CTL), MISC + 8);
#define IN(k) (lo <= (k) && (k) < hi && ((MK_PHASE_MASK >> (k)) & 1))
#define SEAM(k) do { if (IN(k) && IN((k) + 1)) xcd_barrier(bar); } while (0)
    const int bid = (int)blockIdx.x, G = (int)gridDim.x;

    if (IN(0)) { ph_mod(args, lds); ph_conv(args, lds); if (MK_REPEAT == 0) { ph_mod(args, lds); ph_conv(args, lds); } }
    SEAM(0);
    if (IN(1)) { ph_norm1(args); if (MK_REPEAT == 1) ph_norm1(args); }
    SEAM(1);
    if (IN(2)) { pg8::Gemm g{(const bf16*)(args.ws + WS_A1), (const bf16*)(args.ws + WS_WT_IN), MT, NINP, DM, DM, DM, 0, 0}; pg8::StaticOrder S; S.init(MT, NINP, G, bid);
        pg8::EpiBf16<0> E{(bf16*)(args.ws + WS_P), NINP, nullptr, 0, 0}; pg8::gemm_phase<pg8::EpiBf16<0>, pg8::StaticOrder>(lds, g, S, E, nullptr); }
    SEAM(2);
    if (IN(3)) { ph_prep_rwkv(args); ph_prep_ssd(args); if (MK_REPEAT == 3) { ph_prep_rwkv(args); ph_prep_ssd(args); } }
    SEAM(3);
    if (IN(4)) { int kw = KLRW; asm volatile("" : "+s"(kw));
        pg8::Gemm g{(const bf16*)(args.ws + WS_ALR), (const bf16*)(args.ws + WS_WLR), MT, NLR, kw, KLR, KLRW, 4, 256}; pg8::StaticOrder S; S.init(MT, NLR, G, bid);
        EpiLR E{(bf16*)(args.ws + WS_LR), args.in[I_W0], args.in[I_A0]}; pg8::gemm_phase<EpiLR, pg8::StaticOrder>(lds, g, S, E, nullptr); }
    SEAM(4);
#if MK_RWKV_SEQ
    if (IN(5)) { ph_rwkv_scan(args); if (MK_REPEAT == 5) ph_rwkv_scan(args); }
#else
    if (IN(5)) {
#if MK_RWKV_LDS
        ph_rwkv_scan2(args, lds); if (MK_REPEAT == 5) ph_rwkv_scan2(args, lds);
#else
        ph_rwkv_chunked(args, lds); if (MK_REPEAT == 5) ph_rwkv_chunked(args, lds);
#endif
    }
#endif
    SEAM(5);
#if MK_SSD_SEQ
    if (IN(6)) { ph_ssd_scan(args); if (MK_REPEAT == 6) ph_ssd_scan(args); }
#else
    if (IN(6)) { ph_ssd_chunked(args, lds); if (MK_REPEAT == 6) ph_ssd_chunked(args, lds); }
#endif
    SEAM(6);
    if (IN(7)) { ph_finish(args); if (MK_REPEAT == 7) ph_finish(args); }
    SEAM(7);
    if (IN(8)) { pg8::Gemm g{(const bf16*)(args.ws + WS_A2), (const bf16*)(args.ws + WS_WT_OUT), MX, DM, DM, DM, DM, 0, 0}; pg8::StaticOrder S; S.init(MX, DM, G, bid);
        EpiRes E{args.out, args.in[I_X], (const float*)(args.ws + WS_MOD)}; pg8::gemm_phase<EpiRes, pg8::StaticOrder>(lds, g, S, E, nullptr); }
    SEAM(8);
    if (IN(9)) { ph_norm2(args); if (MK_REPEAT == 9) ph_norm2(args); }
    SEAM(9);
    if (IN(10)) { pg8::Gemm g{(const bf16*)(args.ws + WS_XN2), (const bf16*)(args.ws + WS_WT_Q), MX, 2048, DM, DM, DM, 0, 0}; pg8::StaticOrder S; S.init(MX, 2048, G, bid);
        pg8::EpiBf16<0> E{(bf16*)(args.ws + WS_Q), 2048, nullptr, 0, 0}; pg8::gemm_phase<pg8::EpiBf16<0>, pg8::StaticOrder>(lds, g, S, E, nullptr); }
    SEAM(10);
    if (IN(11)) { int kw = 256; asm volatile("" : "+s"(kw));
        pg8::Gemm g{(const bf16*)(args.ws + WS_Q), (const bf16*)(args.ws + WS_KBD), MX, 2048, kw, 2048, 256, 0, 256}; pg8::StaticOrder S; S.init(MX, 2048, G, bid);
        pg8::EpiF32 E{(float*)(args.ws + WS_S), 2048, nullptr}; pg8::gemm_phase<pg8::EpiF32, pg8::StaticOrder>(lds, g, S, E, nullptr); }
    SEAM(11);
    if (IN(12)) { if (MK_REPEAT == 12) ph_peer(args, (float*)(args.ws + 903 * MiB)); ph_peer(args, args.out); }
#undef IN
#undef SEAM
}

extern "C" void kernel_launch(void* const* d_in, const int* in_sizes, int n_in, void* d_out, int out_size, void* d_ws, size_t ws_size, hipStream_t stream) {
    static int grid = 0;
    if (grid == 0) {
        if (n_in != N_IN || out_size != MX * DM || ws_size < WS_END) { fprintf(stderr, "kernel_launch: unexpected shapes (n_in %d out %d ws %zu)\n", n_in, out_size, ws_size); grid = -1; return; }
        int dev = 0, cus = 0, per_cu = 0;
        if (hipGetDevice(&dev) != hipSuccess || hipDeviceGetAttribute(&cus, hipDeviceAttributeMultiprocessorCount, dev) != hipSuccess) { grid = -1; return; }
        if (hipFuncSetAttribute((const void*)hybrid_fwd, hipFuncAttributeMaxDynamicSharedMemorySize, LDS_BYTES) != hipSuccess) { fprintf(stderr, "kernel_launch: hipFuncSetAttribute failed\n"); grid = -1; return; }
        if (hipOccupancyMaxActiveBlocksPerMultiprocessor(&per_cu, (const void*)hybrid_fwd, 512, LDS_BYTES) != hipSuccess || per_cu < 1) fprintf(stderr, "kernel_launch: occupancy query reports %d\n", per_cu);
        (void)hipGetLastError();
        grid = cus;
    }
    if (grid < 0) return;
    (void)in_sizes;
    if (hipMemsetAsync((char*)d_ws + WS_CTL, 0, CTL_ZERO_BYTES, stream) != hipSuccess) return;
    Args a{};
    for (int i = 0; i < N_IN; ++i) a.in[i] = (const float*)d_in[i];
    a.out = (float*)d_out; a.ws = (unsigned char*)d_ws;
#if MK_N_LAUNCHES == 1
    a.ph_lo = 0; a.ph_hi = N_PHASES;
    hipLaunchKernelGGL(hybrid_fwd, dim3(grid), dim3(512), LDS_BYTES, stream, a);
#else
    for (int ph = 0; ph < N_PHASES; ++ph) { if (!((MK_PHASE_MASK >> ph) & 1)) continue; a.ph_lo = ph; a.ph_hi = ph + 1; hipLaunchKernelGGL(hybrid_fwd, dim3(grid), dim3(512), LDS_BYTES, stream, a); }
#endif
}
```

```cpp
#include <hip/hip_runtime.h>
#include <stdint.h>
#include <stdio.h>
namespace pg8 {
#define PG8_LAS __attribute__((address_space(3)))
typedef unsigned short bf16_t;
typedef short bf16x8 __attribute__((ext_vector_type(8)));
typedef float f32x4 __attribute__((ext_vector_type(4)));
typedef unsigned u32x4 __attribute__((ext_vector_type(4)));
constexpr int BM = 256, BK = 64, HALF = 128, HTB = HALF * BK * 2  , STAGE_BYTES = 8 * HTB, NXCD = 8, WGM = 8;

__host__ __device__ __forceinline__ int lds_byte(int r, int c) { const int st = (r >> 4) * 2 + (c >> 5), rr = r & 15, cc = c & 31, ob = rr * 64 + cc * 2; return st * 1024 + (ob ^ (((ob >> 9) & 1) << 5)); }
__host__ __device__ __forceinline__ void stage_rc(int b, int& R, int& C) { const int st = b / 1024, sb = b % 1024, swz = sb ^ (((sb >> 9) & 1) << 5); R = (st >> 1) * 16 + swz / 64; C = (st & 1) * 32 + (swz % 64) / 2; }
__host__ __device__ __forceinline__ int perm32(int rho) { const int n = rho >> 4, i = rho & 15; return 8 * (i >> 2) + 4 * n + (i & 3); }

struct Unit { int pm, pn; };
struct Gemm { const bf16_t* A; const bf16_t* Bt; int M, N, K; int lda, ldb, kshift, kmul; };

struct StaticOrder {
    int nM, nN, nwg, G, c;
    __host__ __device__ void init(int M, int N, int G_, int c_) { nM = M / BM; nN = N / BM; nwg = nM * nN; G = G_; c = c_; }
    __host__ __device__ bool next(int i, Unit& u) const {
        const long L = (long)i * G + c; if (L >= nwg) return false;
        int wgid = (int)L; { const int q = nwg / NXCD, r = nwg % NXCD, xcd = wgid % NXCD, off = wgid / NXCD; wgid = (xcd < r ? xcd * (q + 1) : r * (q + 1) + (xcd - r) * q) + off; }
        const int nig = WGM * nN, gid = wgid / nig, fm = gid * WGM, gsz = (nM - fm) < WGM ? (nM - fm) : WGM;
        u.pm = fm + ((wgid % nig) % gsz); u.pn = (wgid % nig) / gsz; return true;
    }
    __device__ __forceinline__ void a_ready(const Unit&) const {}
    __device__ __forceinline__ void done(const Unit&) const {}
};
__device__ __forceinline__ unsigned cvt_pk_bf16(float lo, float hi) { unsigned r; asm volatile("v_cvt_pk_bf16_f32 %0, %1, %2" : "=v"(r) : "v"(lo), "v"(hi)); return r; }
typedef float f32x2 __attribute__((ext_vector_type(2)));
__device__ __forceinline__ f32x2 gelu_pk(f32x2 v) {
    const f32x2 av = __builtin_elementwise_abs(v), d = av * 0.2316418882f + 1.0f;
    f32x2 t; t.x = __builtin_amdgcn_rcpf(d.x); t.y = __builtin_amdgcn_rcpf(d.y);
    f32x2 q = t * 0.5307027145f + (-0.7265760135f); q = q * t + 0.7107068705f; q = q * t + (-0.142248368f); q = q * t + 0.127414796f; q = q * t;
    const f32x2 s = (v * v) * (-0.72134752044f);
    f32x2 e; e.x = __builtin_amdgcn_exp2f(s.x); e.y = __builtin_amdgcn_exp2f(s.y);
    const f32x2 m = v * (q * e), r = v - m;
    f32x2 o; o.x = v.x < 0.f ? m.x : r.x; o.y = v.y < 0.f ? m.y : r.y; return o;
}

struct EpiF32 {
    static constexpr bool PERM = false, AFTER_DRAIN = false;
    float* C; int ldc; const float* bias;
    __device__ __forceinline__ void operator()(const f32x4 (&acc)[2][2][4][2], const Unit& u, int wr, int wc, int fr, int fq) const {
        const int row0 = u.pm * BM + wr * 64 + fr, col0 = u.pn * BM + wc * 32 + 4 * fq;
        f32x4 bv[2][2];
#pragma unroll
        for (int bj = 0; bj < 2; ++bj)
#pragma unroll
            for (int n = 0; n < 2; ++n) bv[bj][n] = bias ? *(const f32x4*)(bias + col0 + bj * HALF + n * 16) : (f32x4){0.f, 0.f, 0.f, 0.f};
#pragma unroll
        for (int ai = 0; ai < 2; ++ai)
#pragma unroll
            for (int m = 0; m < 4; ++m) { float* rowp = C + (size_t)(row0 + ai * HALF + m * 16) * ldc + col0;
#pragma unroll
                for (int bj = 0; bj < 2; ++bj)
#pragma unroll
                    for (int n = 0; n < 2; ++n) *(f32x4*)(rowp + bj * HALF + n * 16) = acc[ai][bj][m][n] + bv[bj][n]; }
    }
};
template <int ACT  > struct EpiBf16 {
    static constexpr bool PERM = true, AFTER_DRAIN = false;
    bf16_t* O; int ldc; const float* bias; int split_cols; size_t split_stride;
    __device__ __forceinline__ void operator()(const f32x4 (&acc)[2][2][4][2], const Unit& u, int wr, int wc, int fr, int fq) const {
        const int row0 = u.pm * BM + wr * 64 + fr; int colt = u.pn * BM; bf16_t* base = O;
        if (split_cols) { const int t = colt / split_cols; base += (size_t)t * split_stride; colt -= t * split_cols; }
        const int col0 = colt + wc * 32 + 8 * fq, bcol0 = u.pn * BM + wc * 32 + 8 * fq;
        f32x4 bv[2][2];
#pragma unroll
        for (int bj = 0; bj < 2; ++bj)
#pragma unroll
            for (int n = 0; n < 2; ++n) bv[bj][n] = bias ? *(const f32x4*)(bias + bcol0 + bj * HALF + 4 * n) : (f32x4){0.f, 0.f, 0.f, 0.f};
#pragma unroll
        for (int ai = 0; ai < 2; ++ai)
#pragma unroll
            for (int m = 0; m < 4; ++m) { bf16_t* rowp = base + (size_t)(row0 + ai * HALF + m * 16) * ldc + col0;
#pragma unroll
                for (int bj = 0; bj < 2; ++bj) { f32x4 v0 = acc[ai][bj][m][0] + bv[bj][0], v1 = acc[ai][bj][m][1] + bv[bj][1];
                    if (ACT == 1) { f32x2 a = gelu_pk((f32x2){v0[0], v0[1]}), b = gelu_pk((f32x2){v0[2], v0[3]}), c = gelu_pk((f32x2){v1[0], v1[1]}), d = gelu_pk((f32x2){v1[2], v1[3]});
                        v0 = (f32x4){a.x, a.y, b.x, b.y}; v1 = (f32x4){c.x, c.y, d.x, d.y}; }
                    if (ACT == 2) {
#pragma unroll
                        for (int j = 0; j < 4; ++j) { v0[j] = 0.5f * v0[j] * (1.0f + erff(v0[j] * 0.70710678f)); v1[j] = 0.5f * v1[j] * (1.0f + erff(v1[j] * 0.70710678f)); } }
                    u32x4 w; w.x = cvt_pk_bf16(v0[0], v0[1]); w.y = cvt_pk_bf16(v0[2], v0[3]); w.z = cvt_pk_bf16(v1[0], v1[1]); w.w = cvt_pk_bf16(v1[2], v1[3]);
                    *(u32x4*)(rowp + bj * HALF) = w; } }
    }
};
template <class Epi, class Sched, bool STAMP = false>
__device__ __forceinline__ void gemm_phase(PG8_LAS unsigned char* lds, const Gemm g, const Sched& S, const Epi& E, unsigned long long* stamps) {
    const int tid = threadIdx.x, wid = __builtin_amdgcn_readfirstlane(tid >> 6), lane = tid & 63, wr = wid >> 2, wc = wid & 3, fr = lane & 15, fq = lane >> 4;
    const int K = g.K, nt = K / BK;
    int ts_lo = 0, ts_hi = 0, nts = 0; const unsigned long long rt_entry = STAMP ? (unsigned long long)wall_clock64() : 0ull;
#define PG8_STAMP() do { if (STAMP && wid == 0 && nts < 64) { const unsigned long long _c = (unsigned long long)clock64(); \
        ts_lo = (lane == nts) ? (int)(unsigned)_c : ts_lo; ts_hi = (lane == nts) ? (int)(unsigned)(_c >> 32) : ts_hi; ++nts; } } while (0)
    PG8_STAMP();
    unsigned voffA[2], voffB[2];
#pragma unroll
    for (int i = 0; i < 2; ++i) { int R, C; stage_rc(tid * 16 + i * 8192, R, C); const int Rb = Epi::PERM ? ((R & ~31) + perm32(R & 31)) : R;
        voffA[i] = (unsigned)(R * g.lda + C) * 2u; voffB[i] = (unsigned)(Rb * g.ldb + C) * 2u; }
    const size_t kstep = (size_t)(BK * 2);
    const size_t hstepA = (size_t)HALF * g.lda * 2, hstepB = (size_t)HALF * g.ldb * 2;
    const size_t tstepA = 2 * hstepA, tstepB = 2 * hstepB;
    const unsigned ldsw = (unsigned)wid * 1024u;
    const int aoff = lds_byte(wr * 64 + fr, fq * 8), boff = lds_byte(wc * 32 + fr, fq * 8);
#define PG8_SA(b, h) (((b) * 2 + (h)) * HTB)
#define PG8_SB(b, h) ((4 + (b) * 2 + (h)) * HTB)
#define PG8_STAGE(bufoff, gbase, voff) do { _Pragma("unroll") for (int _i = 0; _i < 2; ++_i) \
        __builtin_amdgcn_global_load_lds((const unsigned*)((const char*)(gbase) + (voff)[_i]), (PG8_LAS unsigned*)(lds + (bufoff) + ldsw + _i * 8192), 16, 0, 0); } while (0)
#define PG8_LDA(dst, b, h) do { _Pragma("unroll") for (int m = 0; m < 4; ++m) _Pragma("unroll") for (int k = 0; k < 2; ++k) dst[m][k] = *(const PG8_LAS bf16x8*)(lds + PG8_SA(b, h) + aoff + m * 2048 + k * 1024); } while (0)
#define PG8_LDB(dst, b, h) do { _Pragma("unroll") for (int n = 0; n < 2; ++n) _Pragma("unroll") for (int k = 0; k < 2; ++k) dst[n][k] = *(const PG8_LAS bf16x8*)(lds + PG8_SB(b, h) + boff + n * 2048 + k * 1024); } while (0)
#define PG8_MMA(ai, bj, At, Bt) do { __builtin_amdgcn_s_setprio(1); _Pragma("unroll") for (int m = 0; m < 4; ++m) _Pragma("unroll") for (int n = 0; n < 2; ++n) _Pragma("unroll") for (int k = 0; k < 2; ++k) \
        acc[ai][bj][m][n] = __builtin_amdgcn_mfma_f32_16x16x32_bf16(Bt[n][k], At[m][k], acc[ai][bj][m][n], 0, 0, 0); __builtin_amdgcn_s_setprio(0); } while (0)
#define PG8_WAIT_V(n) asm volatile("s_waitcnt vmcnt(" #n ")" ::: "memory")
#define PG8_WAIT_L(n) asm volatile("s_waitcnt lgkmcnt(" #n ")" ::: "memory")
#define PG8_BAR __builtin_amdgcn_s_barrier()
#define PG8_SCHED __builtin_amdgcn_sched_barrier(0)
    Unit cur, nxt; int ui = 0;
    if (!S.next(0, cur)) return;
    f32x4 acc[2][2][4][2];
#pragma unroll
    for (int a = 0; a < 2; ++a)
#pragma unroll
        for (int b = 0; b < 2; ++b)
#pragma unroll
            for (int m = 0; m < 4; ++m)
#pragma unroll
                for (int n = 0; n < 2; ++n) acc[a][b][m][n] = (f32x4){0.f, 0.f, 0.f, 0.f};
    bf16x8 At[4][2], B0[2][2], B1[2][2];
    const char* cA = (const char*)g.A + (size_t)cur.pm * tstepA + (size_t)((cur.pn >> g.kshift) * g.kmul) * 2; const char* cB = (const char*)g.Bt + (size_t)cur.pn * tstepB;
    S.a_ready(cur);
    PG8_STAGE(PG8_SB(0, 0), cB, voffB); PG8_STAGE(PG8_SA(0, 0), cA, voffA); PG8_STAGE(PG8_SB(0, 1), cB + hstepB, voffB); PG8_STAGE(PG8_SA(0, 1), cA + hstepA, voffA);
    if (wr == 1) PG8_BAR;
    PG8_WAIT_V(4); PG8_BAR;
    PG8_STAGE(PG8_SB(1, 0), cB + kstep, voffB); PG8_STAGE(PG8_SA(1, 0), cA + kstep, voffA); PG8_STAGE(PG8_SB(1, 1), cB + hstepB + kstep, voffB);
    PG8_WAIT_V(6); PG8_BAR;
    PG8_STAMP();
    for (;;) {
        const bool has_next = S.next(ui + 1, nxt);
        const char* nA = has_next ? (const char*)g.A + (size_t)nxt.pm * tstepA + (size_t)((nxt.pn >> g.kshift) * g.kmul) * 2 : cA; const char* nB = has_next ? (const char*)g.Bt + (size_t)nxt.pn * tstepB : cB;
        for (int t = 0; t < nt; t += 2) {
            const bool last = (t == nt - 2);
            const char* a1 = cA + (size_t)(t + 1) * kstep;
            const char* a2 = last ? nA : cA + (size_t)(t + 2) * kstep; const char* b2 = last ? nB : cB + (size_t)(t + 2) * kstep;
            const char* a3 = a2 + kstep; const char* b3 = b2 + kstep;
            if (last && has_next) S.a_ready(nxt);
            PG8_LDB(B0, 0, 0); PG8_SCHED; PG8_LDA(At, 0, 0); PG8_STAGE(PG8_SA(1, 1), a1 + hstepA, voffA);
            PG8_WAIT_L(8); PG8_BAR; PG8_WAIT_L(0); PG8_MMA(0, 0, At, B0); PG8_BAR; PG8_SCHED;
            PG8_LDB(B1, 0, 1); PG8_STAGE(PG8_SB(0, 0), b2, voffB);
            PG8_BAR; PG8_WAIT_L(0); PG8_MMA(0, 1, At, B1); PG8_BAR;
            PG8_LDA(At, 0, 1); PG8_STAGE(PG8_SA(0, 0), a2, voffA);
            PG8_BAR; PG8_WAIT_L(0); PG8_MMA(1, 0, At, B0); PG8_BAR; PG8_SCHED;
            PG8_STAGE(PG8_SB(0, 1), b2 + hstepB, voffB);
            PG8_WAIT_V(6); PG8_BAR; PG8_MMA(1, 1, At, B1); PG8_BAR;
            PG8_LDB(B0, 1, 0); PG8_SCHED; PG8_LDA(At, 1, 0); PG8_STAGE(PG8_SA(0, 1), a2 + hstepA, voffA);
            PG8_WAIT_L(8); PG8_BAR; PG8_WAIT_L(0); PG8_MMA(0, 0, At, B0); PG8_BAR; PG8_SCHED;
            PG8_LDB(B1, 1, 1); PG8_STAGE(PG8_SB(1, 0), b3, voffB);
            PG8_BAR; PG8_WAIT_L(0); PG8_MMA(0, 1, At, B1); PG8_BAR;
            PG8_LDA(At, 1, 1); PG8_STAGE(PG8_SA(1, 0), a3, voffA);
            PG8_BAR; PG8_WAIT_L(0); PG8_MMA(1, 0, At, B0); PG8_BAR; PG8_SCHED;
            PG8_STAGE(PG8_SB(1, 1), b3 + hstepB, voffB);
            PG8_WAIT_V(6); PG8_BAR; PG8_MMA(1, 1, At, B1); PG8_BAR;
        }
        PG8_STAMP();
        if constexpr (!Epi::AFTER_DRAIN) { E(acc, cur, wr, wc, fr, fq); S.done(cur); }
        PG8_STAMP();
        if (!has_next) break;
#pragma unroll
        for (int a = 0; a < 2; ++a)
#pragma unroll
            for (int b = 0; b < 2; ++b)
#pragma unroll
                for (int m = 0; m < 4; ++m)
#pragma unroll
                    for (int n = 0; n < 2; ++n) acc[a][b][m][n] = (f32x4){0.f, 0.f, 0.f, 0.f};
        cur = nxt; cA = nA; cB = nB; ++ui;
    }
    PG8_WAIT_V(0);
    if (wr == 0) PG8_BAR;
    PG8_BAR;
    if constexpr (Epi::AFTER_DRAIN) { E.fused(acc, cur, wr, wc, fr, fq, lds, wid, lane); S.done(cur); }
    PG8_STAMP();
    if (STAMP && wid == 0) { stamps[lane] = lane < nts ? (((unsigned long long)(unsigned)ts_hi << 32) | (unsigned)ts_lo) : 0ull;
        if (lane == 62) stamps[62] = rt_entry; if (lane == 63) stamps[63] = (unsigned long long)wall_clock64(); }
#undef PG8_STAMP
#undef PG8_SA
#undef PG8_SB
#undef PG8_STAGE
#undef PG8_LDA
#undef PG8_LDB
#undef PG8_MMA
#undef PG8_WAIT_V
#undef PG8_WAIT_L
#undef PG8_BAR
#undef PG8_SCHED
}
}

#define LAS __attribute__((address_space(3)))
typedef unsigned short bf16;
typedef float f32x4 __attribute__((ext_vector_type(4)));

#ifndef MK_N_LAUNCHES
#define MK_N_LAUNCHES 1
#endif
#ifndef MK_PHASE_MASK
#define MK_PHASE_MASK 0x1FFF
#endif
#ifndef MK_REPEAT
#define MK_REPEAT -1
#endif
#ifndef MK_RWKV_LDS
#define MK_RWKV_LDS 0
#endif
#ifndef MK_RWKV_SEQ
#define MK_RWKV_SEQ 0
#endif
#ifndef MK_SSD_SEQ
#define MK_SSD_SEQ 0
#endif
#ifndef MK_SKIP_MIXER
#define MK_SKIP_MIXER 0
#endif
#ifndef MK_SKIP_PEER
#define MK_SKIP_PEER 0
#endif
#ifndef MK_SKIP_RWKV
#define MK_SKIP_RWKV 0
#endif
#ifndef MK_SKIP_SSD
#define MK_SKIP_SSD 0
#endif

constexpr int DM = 4096, NBATCH = 4, SEQ = 4096, CTXL = 256;
constexpr int MX = NBATCH * SEQ;
constexpr int MC = NBATCH * CTXL;
constexpr int MT = MX + MC;
constexpr int RW = 2048;
constexpr int RCOLS = 6784;
constexpr int NIN = 12992, NINP = 13056;
constexpr int COL_Z = 6784, COL_XBC = 8832, COL_DT = 12928;
constexpr int NLR = 10240, KLR = 768, KLRW = 256;
constexpr int NMOD = 6 * DM;
constexpr float RMS_EPS = 1e-6f, GN_EPS = 64e-5f;
constexpr int NSTEP = CTXL + SEQ;

constexpr size_t MiB = (size_t)1 << 20;
constexpr size_t WS_CTL = 0, CTL_ZERO_BYTES = 1 * MiB;
constexpr size_t WS_MOD = 64 * 1024;
constexpr size_t WS_WT_OUT = 2 * MiB;
constexpr size_t WS_WT_Q = 34 * MiB;
constexpr size_t WS_WLR = 50 * MiB;
constexpr size_t WS_KBD = 63 * MiB;
constexpr size_t WS_DT = 71 * MiB;
constexpr size_t WS_LA = WS_DT + (size_t)MT * 64 * 4;
constexpr size_t WS_ALR = 300 * MiB;
constexpr size_t WS_WT_IN = 102 * MiB;
constexpr size_t WS_A1 = 204 * MiB;
constexpr size_t WS_P = 340 * MiB;
constexpr size_t WS_R = 774 * MiB, WS_K = 842 * MiB, WS_V = 910 * MiB, WS_KK = 978 * MiB;
constexpr size_t WS_XS = 1046 * MiB, WS_BC = 1114 * MiB;
constexpr size_t WS_Z = 102 * MiB;
constexpr size_t WS_LR = 340 * MiB;
constexpr size_t WS_A2 = 166 * MiB;
constexpr size_t WS_XN2 = 340 * MiB;
constexpr size_t WS_Q = 468 * MiB;
constexpr size_t WS_S = 532 * MiB;
constexpr size_t WS_U8 = 774 * MiB, WS_V8 = 838 * MiB;
constexpr size_t WS_USC = 902 * MiB, WS_VSC = WS_USC + 65536;
constexpr size_t WS_END = 1182 * MiB;
static_assert(WS_WT_IN + (size_t)NINP * DM * 2 <= WS_A1 && WS_A1 + (size_t)MT * DM * 2 <= WS_P && WS_P + (size_t)MT * NINP * 2 <= WS_R, "ws map 1");
static_assert(WS_LR + (size_t)MT * NLR * 2 <= WS_R && WS_Z + (size_t)MX * RW * 2 <= WS_A2 && WS_A2 + (size_t)MX * DM * 2 <= WS_P, "ws map 2");
static_assert(WS_LA + (size_t)MT * 64 * 4 <= WS_WT_IN && WS_ALR + (size_t)MT * KLR * 2 <= WS_P && WS_ALR >= WS_A2 + (size_t)MX * DM * 2 && WS_WLR + (size_t)NLR * KLRW * 2 <= WS_KBD, "ws map 3");
static_assert(WS_S + (size_t)MX * 2048 * 4 <= WS_R && WS_VSC + 65536 <= WS_XS, "ws map 4");

constexpr int LDS_BYTES = 147456;
constexpr int LDS_CTL = 143360;
constexpr int LDS_MISC = LDS_CTL + 320;

enum { I_X = 0, I_C, I_CTX, I_CCTX, I_WMOD, I_BMOD, I_N1G, I_N2G, I_WIN, I_WOUT, I_MU, I_W0, I_W2, I_A0, I_A2, I_G2, I_KK, I_KA, I_RK, I_LNW, I_LNB,
       I_CONVW, I_CONVB, I_DTB, I_ALOG, I_SSMD, I_NORMW, I_WQ, I_K1, I_K2, I_PU, I_PV, I_FG, N_IN };

struct Args { const float* in[N_IN]; float* out; unsigned char* ws; int ph_lo, ph_hi; };

__device__ __forceinline__ unsigned f2bf(float f) { unsigned u = __float_as_uint(f); return (u + 0x7fffu + ((u >> 16) & 1u)) >> 16; }
__device__ __forceinline__ unsigned pk2(float lo, float hi) { return f2bf(lo) | (f2bf(hi) << 16); }
__device__ __forceinline__ float bflo(unsigned u) { return __uint_as_float(u << 16); }
__device__ __forceinline__ float bfhi(unsigned u) { return __uint_as_float(u & 0xffff0000u); }
__device__ __forceinline__ void unpack8(const uint4& u, float (&f)[8]) {
    f[0] = bflo(u.x); f[1] = bfhi(u.x); f[2] = bflo(u.y); f[3] = bfhi(u.y); f[4] = bflo(u.z); f[5] = bfhi(u.z); f[6] = bflo(u.w); f[7] = bfhi(u.w);
}
__device__ __forceinline__ uint4 pack8(const float (&f)[8]) { uint4 u; u.x = pk2(f[0], f[1]); u.y = pk2(f[2], f[3]); u.z = pk2(f[4], f[5]); u.w = pk2(f[6], f[7]); return u; }
__device__ __forceinline__ uint4 ld16(const bf16* p) { return *(const uint4*)p; }
__device__ __forceinline__ void st16(bf16* p, const uint4& v) { *(uint4*)p = v; }
__device__ __forceinline__ void ldf8(const float* p, float (&f)[8]) { const float4 a = *(const float4*)p, b = *(const float4*)(p + 4); f[0] = a.x; f[1] = a.y; f[2] = a.z; f[3] = a.w; f[4] = b.x; f[5] = b.y; f[6] = b.z; f[7] = b.w; }
#define PIN8(a) asm volatile("" : "+v"((a)[0]), "+v"((a)[1]), "+v"((a)[2]), "+v"((a)[3]), "+v"((a)[4]), "+v"((a)[5]), "+v"((a)[6]), "+v"((a)[7]))
template <int CTRL> __device__ __forceinline__ float dppf(float v) { return __uint_as_float((unsigned)__builtin_amdgcn_update_dpp(0, (int)__float_as_uint(v), CTRL, 0xF, 0xF, true)); }
__device__ __forceinline__ float rlane(float v, int l) { return __uint_as_float((unsigned)__builtin_amdgcn_readlane((int)__float_as_uint(v), l)); }
__device__ __forceinline__ float sum8(float v) { v += dppf<0xB1>(v); v += dppf<0x4E>(v); v += dppf<0x141>(v); return v; }
__device__ __forceinline__ float sum16(float v) { v = sum8(v); v += dppf<0x140>(v); return v; }
__device__ __forceinline__ float sum32(float v) { v = sum16(v); v += __shfl_xor(v, 16); return v; }
__device__ __forceinline__ float wave_sum(float v) { v = sum16(v); return (rlane(v, 0) + rlane(v, 16)) + (rlane(v, 32) + rlane(v, 48)); }
__device__ __forceinline__ float wave_max(float v) {
    v = fmaxf(v, dppf<0xB1>(v)); v = fmaxf(v, dppf<0x4E>(v)); v = fmaxf(v, dppf<0x141>(v)); v = fmaxf(v, dppf<0x140>(v));
    return fmaxf(fmaxf(rlane(v, 0), rlane(v, 16)), fmaxf(rlane(v, 32), rlane(v, 48)));
}
__device__ __forceinline__ float sigmoidf_(float x) { return 1.f / (1.f + __expf(-x)); }
__device__ __forceinline__ float siluf_(float x) { return x / (1.f + __expf(-x)); }

struct EpiLR {
    static constexpr bool PERM = true, AFTER_DRAIN = false;
    bf16* O; const float* w0; const float* a0;
    __device__ __forceinline__ void operator()(const pg8::f32x4 (&acc)[2][2][4][2], const pg8::Unit& u, int wr, int wc, int fr, int fq) const {
        const int row0 = u.pm * 256 + wr * 64 + fr; const int colt = u.pn * 256; const int type = colt >> 11;
        const int col0 = colt + wc * 32 + 8 * fq;
        const float* bias = type < 2 ? (w0 + type * 2048) : (a0 + (type - 2) * 2048);
        pg8::f32x4 bv[2][2];
#pragma unroll
        for (int bj = 0; bj < 2; ++bj)
#pragma unroll
            for (int n = 0; n < 2; ++n) bv[bj][n] = type < 4 ? *(const pg8::f32x4*)(bias + ((col0 + bj * 128 + 4 * n) & 2047)) : (pg8::f32x4){0.f, 0.f, 0.f, 0.f};
#pragma unroll
        for (int ai = 0; ai < 2; ++ai)
#pragma unroll
            for (int m = 0; m < 4; ++m) { bf16* rowp = O + (size_t)(row0 + ai * 128 + m * 16) * NLR + col0;
#pragma unroll
                for (int bj = 0; bj < 2; ++bj) { pg8::f32x4 v0 = acc[ai][bj][m][0] + bv[bj][0], v1 = acc[ai][bj][m][1] + bv[bj][1];
                    if (type < 4) {
#pragma unroll
                        for (int j = 0; j < 4; ++j) { float s0 = 1.f / (1.f + __expf(-v0[j])), s1 = 1.f / (1.f + __expf(-v1[j]));
                            if (type < 2) { s0 = -expm1f(-0.60653066f * s0); s1 = -expm1f(-0.60653066f * s1); }
                            v0[j] = s0; v1[j] = s1; } }
                    pg8::u32x4 w; w.x = pg8::cvt_pk_bf16(v0[0], v0[1]); w.y = pg8::cvt_pk_bf16(v0[2], v0[3]); w.z = pg8::cvt_pk_bf16(v1[0], v1[1]); w.w = pg8::cvt_pk_bf16(v1[2], v1[3]);
                    *(pg8::u32x4*)(rowp + bj * 128) = w; } }
    }
};
struct EpiRes {
    static constexpr bool PERM = false, AFTER_DRAIN = false;
    float* C; const float* X; const float* mod;
    __device__ __forceinline__ void operator()(const pg8::f32x4 (&acc)[2][2][4][2], const pg8::Unit& u, int wr, int wc, int fr, int fq) const {
        const int row0 = u.pm * 256 + wr * 64 + fr, col0 = u.pn * 256 + wc * 32 + 4 * fq;
        const float* gt = mod + (size_t)((u.pm * 256) / SEQ) * NMOD + 2 * DM;
        pg8::f32x4 gv[2][2];
#pragma unroll
        for (int bj = 0; bj < 2; ++bj)
#pragma unroll
            for (int n = 0; n < 2; ++n) gv[bj][n] = *(const pg8::f32x4*)(gt + col0 + bj * 128 + n * 16);
#pragma unroll
        for (int ai = 0; ai < 2; ++ai)
#pragma unroll
            for (int m = 0; m < 4; ++m) { const size_t off = (size_t)(row0 + ai * 128 + m * 16) * DM + col0;
#pragma unroll
                for (int bj = 0; bj < 2; ++bj)
#pragma unroll
                    for (int n = 0; n < 2; ++n) { const pg8::f32x4 xv = *(const pg8::f32x4*)(X + off + bj * 128 + n * 16);
#if MK_SKIP_MIXER
                        *(pg8::f32x4*)(C + off + bj * 128 + n * 16) = xv;
#else
                        *(pg8::f32x4*)(C + off + bj * 128 + n * 16) = xv + gv[bj][n] * acc[ai][bj][m][n];
#endif
                    }
                asm volatile("" ::: "memory"); }
    }
};

#define XB_TMO      128
#define XB_XCNT(j)  (256  + 64 * (j))
#define XB_XSUB(j)  (1280 + 64 * (j))
#define XB_XGEN(j)  (2304 + 64 * (j))
#define XB_TOP      3328
#define XB_TOPGEN   3392
#define XCD_BAR_WORDS 3456
#define XB_SPIN_CAP (1u << 18)
__device__ __forceinline__ unsigned xb_ld(unsigned* p)              { return __hip_atomic_load(p, __ATOMIC_RELAXED, __HIP_MEMORY_SCOPE_AGENT); }
__device__ __forceinline__ unsigned xb_add(unsigned* p, unsigned v) { return __hip_atomic_fetch_add(p, v, __ATOMIC_RELAXED, __HIP_MEMORY_SCOPE_AGENT); }
__device__ __forceinline__ unsigned xb_xcc_id() { return (unsigned)__builtin_amdgcn_s_getreg((3 << 11) | 20) & 0xFu; }
#define XB_SPIN(cond, bar) do { unsigned _sp = 0; while (cond) { __builtin_amdgcn_s_sleep(1); \
    if ((++_sp & 255u) == 0u) { if (xb_ld(&(bar)[XB_TMO])) break; if (_sp > XB_SPIN_CAP) { atomicAdd(&(bar)[XB_TMO], 1u); break; } } } } while (0)
struct XcdBarrier { unsigned* bar; unsigned x; volatile LAS unsigned* st; };
__device__ __forceinline__ XcdBarrier xcd_barrier_post(unsigned* bar, volatile LAS unsigned* st) {
    XcdBarrier b; b.bar = bar; b.x = xb_xcc_id(); b.st = st;
    if (threadIdx.x == 0) (void)xb_add(&bar[XB_XCNT(b.x)], 1u);
    return b;
}
__device__ __forceinline__ void xcd_barrier_complete(unsigned* bar, unsigned x, unsigned& nloc, unsigned& nx) {
    const unsigned G = gridDim.x * gridDim.y * gridDim.z;
    unsigned sum, cnt, mine, sp = 0u;
    for (;;) {
        sum = 0u; cnt = 0u; mine = 0u;
#pragma unroll
        for (unsigned j = 0; j < 16; ++j) { const unsigned c = xb_ld(&bar[XB_XCNT(j)]); sum += c; cnt += (c > 0u) ? 1u : 0u; mine = (j == x) ? c : mine; }
        if (sum == G) break;
        __builtin_amdgcn_s_sleep(1);
        if ((++sp & 255u) == 0u) { if (xb_ld(&bar[XB_TMO])) break; if (sp > XB_SPIN_CAP) { atomicAdd(&bar[XB_TMO], 1u); break; } }
    }
    nloc = mine > 0u ? mine : 1u; nx = cnt > 0u ? cnt : 1u;
}
__device__ __forceinline__ void xcd_barrier(const XcdBarrier& b) {
    asm volatile("s_waitcnt vmcnt(0)" ::: "memory");
    __syncthreads();
    if (threadIdx.x == 0) {
        unsigned* bar = b.bar;
        __builtin_amdgcn_s_waitcnt(0);
        unsigned nloc = b.st[0], nx = b.st[1];
        if (nloc == 0u) { xcd_barrier_complete(bar, b.x, nloc, nx); b.st[0] = nloc; b.st[1] = nx; }
        const unsigned old = xb_add(&bar[XB_XSUB(b.x)], 1u);
        const unsigned gen = old / nloc;
        if (old + 1u == (gen + 1u) * nloc) {
            __builtin_amdgcn_fence(__ATOMIC_RELEASE, "agent");
            asm volatile("s_waitcnt vmcnt(0)" ::: "memory");
            const unsigned og = xb_add(&bar[XB_TOP], 1u);
            const unsigned tg = og / nx;
            if (og + 1u == (tg + 1u) * nx) xb_add(&bar[XB_TOPGEN], 1u);
            else XB_SPIN(xb_ld(&bar[XB_TOPGEN]) == tg, bar);
            __builtin_amdgcn_fence(__ATOMIC_ACQUIRE, "agent");
            xb_add(&bar[XB_XGEN(b.x)], 1u);
            asm volatile("s_waitcnt vmcnt(0)" ::: "memory");
        } else {
            XB_SPIN(xb_ld(&bar[XB_XGEN(b.x)]) == gen, bar);
            __builtin_amdgcn_fence(__ATOMIC_ACQUIRE, "agent");
            asm volatile("s_waitcnt vmcnt(0)" ::: "memory");
        }
    }
    __syncthreads();
}

#define TID ((int)threadIdx.x)
#define LANE ((int)(threadIdx.x & 63))
#define WAVE ((int)__builtin_amdgcn_readfirstlane((int)(threadIdx.x >> 6)))
#define GW ((int)blockIdx.x * 8 + WAVE)
#define NGW ((int)gridDim.x * 8)

__device__ __forceinline__ void ph_mod(const Args& a, LAS unsigned char* lds) {
    const float* c = a.in[I_C]; const float* cc = a.in[I_CCTX]; const float* w_mod = a.in[I_WMOD]; const float* b_mod = a.in[I_BMOD];
    float* mod = (float*)(a.ws + WS_MOD);
    LAS float* sS = (LAS float*)lds;
    LAS float* red = (LAS float*)(lds + 81920);
    const int tid = TID, lane = LANE, wave = WAVE;
    if ((int)blockIdx.x < 192) {
        for (int i = tid; i < 5 * DM; i += 512) { const int v = i >> 12, k = i & (DM - 1); const float xv = v < 4 ? c[v * DM + k] : cc[k]; sS[i] = xv / (1.f + expf(-xv)); }
    }
    __syncthreads();
    for (int u = blockIdx.x; u < 192; u += gridDim.x) {
        const int cl = lane & 31, kh = lane >> 5;
        float acc[5][4];
#pragma unroll
        for (int v = 0; v < 5; ++v)
#pragma unroll
            for (int e = 0; e < 4; ++e) acc[v][e] = 0.f;
        const float* wp = w_mod + (size_t)(wave * 512 + kh) * NMOD + u * 128 + cl * 4;
#pragma unroll 8
        for (int i = 0; i < 256; ++i) {
            const float4 w = *(const float4*)(wp + (size_t)(2 * i) * NMOD);
#pragma unroll
            for (int v = 0; v < 5; ++v) { const float s = sS[v * DM + wave * 512 + 2 * i + kh]; acc[v][0] += s * w.x; acc[v][1] += s * w.y; acc[v][2] += s * w.z; acc[v][3] += s * w.w; }
        }
#pragma unroll
        for (int v = 0; v < 5; ++v)
#pragma unroll
            for (int e = 0; e < 4; ++e) acc[v][e] += __shfl_xor(acc[v][e], 32);
        if (kh == 0) {
#pragma unroll
            for (int v = 0; v < 5; ++v) *(LAS f32x4*)(red + ((wave * 5 + v) * 128 + cl * 4)) = (f32x4){acc[v][0], acc[v][1], acc[v][2], acc[v][3]};
        }
        __syncthreads();
        for (int i = tid; i < 640; i += 512) { const int v = i >> 7, n = i & 127; float s = b_mod[u * 128 + n];
#pragma unroll
            for (int w = 0; w < 8; ++w) s += red[(w * 5 + v) * 128 + n];
            mod[v * NMOD + u * 128 + n] = s; }
        __syncthreads();
    }
    __syncthreads();
}

__device__ __forceinline__ void transpose_item(const float* W, int K, int N, bf16* WT, LAS float* scr, int item, int lane) {
    const int nblk = N / 32, kb = item / nblk, nb = item % nblk, k0 = 64 * kb, n0 = 32 * nb;
#pragma unroll 8
    for (int i = 0; i < 32; ++i) { const int kk = 2 * i + (lane >> 5); scr[kk * 33 + (lane & 31)] = W[(size_t)(k0 + kk) * N + n0 + (lane & 31)]; }
    asm volatile("s_waitcnt lgkmcnt(0)" ::: "memory");
    const int c = lane & 7;
#pragma unroll
    for (int j = 0; j < 4; ++j) { const int n = (lane >> 3) + 8 * j; const LAS float* s = scr + (8 * c) * 33 + n;
        uint4 o; o.x = pk2(s[0 * 33], s[1 * 33]); o.y = pk2(s[2 * 33], s[3 * 33]); o.z = pk2(s[4 * 33], s[5 * 33]); o.w = pk2(s[6 * 33], s[7 * 33]);
        *(uint4*)(WT + (size_t)(n0 + n) * K + k0 + 8 * c) = o; }
    asm volatile("s_waitcnt lgkmcnt(0)" ::: "memory");
}
__device__ __forceinline__ void ph_conv(const Args& a, LAS unsigned char* lds) {
    const int lane = LANE, wave = WAVE, gw = GW, ngw = NGW;
    LAS float* scr = (LAS float*)(lds + wave * 16384);
    bf16* wt_in = (bf16*)(a.ws + WS_WT_IN); bf16* wt_out = (bf16*)(a.ws + WS_WT_OUT); bf16* wt_q = (bf16*)(a.ws + WS_WT_Q);
    constexpr int IT_IN = (DM / 64) * (NIN / 32), IT_OUT = (DM / 64) * (DM / 32), IT_Q = (DM / 64) * (2048 / 32);
    for (int it = gw; it < IT_IN + IT_OUT + IT_Q; it += ngw) {
        int r = it;
        if (r < IT_IN) { transpose_item(a.in[I_WIN], DM, NIN, wt_in, scr, r, lane); continue; } r -= IT_IN;
        if (r < IT_OUT) { transpose_item(a.in[I_WOUT], DM, DM, wt_out, scr, r, lane); continue; } r -= IT_OUT;
        transpose_item(a.in[I_WQ], DM, 2048, wt_q, scr, r, lane);
    }
    const int gt = blockIdx.x * 512 + TID, ngt = gridDim.x * 512;
    for (int i = gt; i < (NINP - NIN) * DM / 8; i += ngt) *(uint4*)(wt_in + (size_t)NIN * DM + (size_t)i * 8) = make_uint4(0u, 0u, 0u, 0u);
    { bf16* wlr = (bf16*)(a.ws + WS_WLR); const float* w2 = a.in[I_W2]; const float* a2 = a.in[I_A2]; const float* g2 = a.in[I_G2];
      for (int i = gt; i < NLR * (KLRW / 8); i += ngt) { const int n = i / (KLRW / 8), k0 = (i % (KLRW / 8)) * 8; const int type = n >> 11, cch = n & 2047;
          float f[8];
#pragma unroll
          for (int e = 0; e < 8; ++e) { const int k = k0 + e; float v = 0.f;
              if (type == 4) v = g2[(size_t)k * RW + cch];
              else { const int d = type & 1, kk = k - 128 * d; const float* src = type < 2 ? w2 : a2; if (kk >= 0 && kk < 96) v = src[(size_t)(d * 96 + kk) * RW + cch]; }
              f[e] = v; }
          st16(wlr + (size_t)n * KLRW + k0, pack8(f)); } }
    { bf16* kbd = (bf16*)(a.ws + WS_KBD); const float* k1 = a.in[I_K1]; const float* k2 = a.in[I_K2];
      for (int i = gt; i < 2048 * 32; i += ngt) { const int n = i >> 5, k0 = (i & 31) * 8; float f[8];
          const int h = n >> 8, sb = (n >> 7) & 1, key = n & 127;
          if ((k0 >> 7) == sb) { const float* src = (sb ? k2 : k1) + ((size_t)(h * 128 + key) * 128 + (k0 & 127)); ldf8(src, f); }
          else {
#pragma unroll
              for (int e = 0; e < 8; ++e) f[e] = 0.f; }
          st16(kbd + (size_t)n * 256 + k0, pack8(f)); } }
}

__device__ __forceinline__ void norm_mod_row(const float* src, const float* g, const float* sh, const float* sc, bf16* dst, int lane) {
    float4 v[16]; float ss = 0.f;
#pragma unroll
    for (int j = 0; j < 16; ++j) { v[j] = *(const float4*)(src + (lane + 64 * j) * 4); ss += (v[j].x * v[j].x + v[j].y * v[j].y) + (v[j].z * v[j].z + v[j].w * v[j].w); }
    const float rstd = rsqrtf(wave_sum(ss) * (1.f / DM) + RMS_EPS);
#pragma unroll
    for (int j = 0; j < 16; ++j) { const int c = (lane + 64 * j) * 4; const float4 gg = *(const float4*)(g + c), s1 = *(const float4*)(sc + c), s0 = *(const float4*)(sh + c);
        const float o0 = v[j].x * rstd * gg.x * (1.f + s1.x) + s0.x, o1 = v[j].y * rstd * gg.y * (1.f + s1.y) + s0.y, o2 = v[j].z * rstd * gg.z * (1.f + s1.z) + s0.z, o3 = v[j].w * rstd * gg.w * (1.f + s1.w) + s0.w;
        uint2 w; w.x = pk2(o0, o1); w.y = pk2(o2, o3); *(uint2*)(dst + c) = w; }
}
__device__ __forceinline__ void ph_norm1(const Args& a) {
    const int lane = LANE; const float* mod = (const float*)(a.ws + WS_MOD); bf16* A1 = (bf16*)(a.ws + WS_A1);
    for (int m = GW; m < MT; m += NGW) {
        const float* src = m < MX ? a.in[I_X] + (size_t)m * DM : a.in[I_CTX] + (size_t)(m - MX) * DM;
        const int v = m < MX ? m / SEQ : 4;
        norm_mod_row(src, a.in[I_N1G], mod + (size_t)v * NMOD, mod + (size_t)v * NMOD + DM, A1 + (size_t)m * DM, lane);
    }
}
__device__ __forceinline__ void ph_norm2(const Args& a) {
    const int lane = LANE; const float* mod = (const float*)(a.ws + WS_MOD); bf16* XN2 = (bf16*)(a.ws + WS_XN2);
    for (int m = GW; m < MX; m += NGW) {
        const int v = m / SEQ;
        norm_mod_row(a.out + (size_t)m * DM, a.in[I_N2G], mod + (size_t)v * NMOD + 3 * DM, mod + (size_t)v * NMOD + 4 * DM, XN2 + (size_t)m * DM, lane);
    }
    unsigned char* U8 = a.ws + WS_U8; unsigned char* V8 = a.ws + WS_V8; float* USC = (float*)(a.ws + WS_USC); float* VSC = (float*)(a.ws + WS_VSC);
    for (int row = GW; row < 2 * 16384; row += NGW) {
        const int tb = row >> 14, r = row & 16383;
        const float* src = (tb ? a.in[I_PV] : a.in[I_PU]) + (size_t)r * DM;
        float4 v[16]; float am = 0.f;
#pragma unroll
        for (int j = 0; j < 16; ++j) { v[j] = *(const float4*)(src + (lane + 64 * j) * 4); am = fmaxf(fmaxf(am, fmaxf(fabsf(v[j].x), fabsf(v[j].y))), fmaxf(fabsf(v[j].z), fabsf(v[j].w))); }
        am = wave_max(am);
        const float scale = am > 0.f ? am * (1.f / 7.5f) : 1.f, inv = 1.f / scale;
        unsigned char* dst = (tb ? V8 : U8) + (size_t)r * 3072 + lane * 48;
#pragma unroll
        for (int p = 0; p < 2; ++p) {
            unsigned long long w0 = 0ull, w1 = 0ull, w2 = 0ull;
#pragma unroll
            for (int k = 0; k < 32; ++k) {
                const float4 q = v[8 * p + (k >> 2)]; const float x = ((k & 3) == 0 ? q.x : (k & 3) == 1 ? q.y : (k & 3) == 2 ? q.z : q.w) * inv; const float ax = fabsf(x);
                float cf = ax < 2.f ? rintf(ax * 8.f) : (ax < 4.f ? rintf(ax * 4.f) + 8.f : rintf(ax * 2.f) + 16.f);
                cf = fminf(cf, 31.f);
                const unsigned long long code = (unsigned long long)((unsigned)cf | (x < 0.f ? 32u : 0u));
                const int pos = 6 * k, wd = pos >> 6, off = pos & 63;
                if (wd == 0) w0 |= code << off; else if (wd == 1) w1 |= code << off; else w2 |= code << off;
                if (off > 58) { if (wd == 0) w1 |= code >> (64 - off); else w2 |= code >> (64 - off); }
            }
            *(uint2*)(dst + 24 * p) = make_uint2((unsigned)w0, (unsigned)(w0 >> 32)); *(uint2*)(dst + 24 * p + 8) = make_uint2((unsigned)w1, (unsigned)(w1 >> 32)); *(uint2*)(dst + 24 * p + 16) = make_uint2((unsigned)w2, (unsigned)(w2 >> 32));
        }
        if (lane == 0) (tb ? VSC : USC)[r] = scale;
    }
}

__device__ __forceinline__ void ph_prep_rwkv(const Args& a) {
    const int lane = LANE;
    const bf16* P = (const bf16*)(a.ws + WS_P);
    bf16* R = (bf16*)(a.ws + WS_R); bf16* K = (bf16*)(a.ws + WS_K); bf16* V = (bf16*)(a.ws + WS_V); bf16* KK = (bf16*)(a.ws + WS_KK); bf16* ALR = (bf16*)(a.ws + WS_ALR);
    const float* mu = a.in[I_MU]; const float* k_k = a.in[I_KK];
    for (int m = GW; m < MT; m += NGW) {
        const bool lat = m < MX;
        bool h0, h1, h2 = false, h3 = false; size_t r0, r1, r2 = 0, r3 = 0;
        if (lat) { const int t = m & (SEQ - 1), row = t >> 6, col = t & 63; h0 = col > 0; h1 = col < 63; h2 = row > 0; h3 = row < 63; r0 = (size_t)(m - 1); r1 = (size_t)(m + 1); r2 = (size_t)(m - 64); r3 = (size_t)(m + 64); }
        else { const int t = (m - MX) & (CTXL - 1); h0 = t > 0; h1 = t < CTXL - 1; r0 = (size_t)(m - 1); r1 = (size_t)(m + 1); }
        const bf16* prow = P + (size_t)m * NINP;
#pragma unroll
        for (int i = 0; i < 14; ++i) {
            const int chunk = lane + 64 * i;
            if (chunk < RCOLS / 8) {
                const int c0 = chunk * 8;
                float own[8], n0[8], n1[8], sh[8], xm[8], muv[8];
                const uint4 z4 = make_uint4(0u, 0u, 0u, 0u);
                unpack8(ld16(prow + c0), own);
                unpack8(h0 ? ld16(P + r0 * NINP + c0) : z4, n0);
                unpack8(h1 ? ld16(P + r1 * NINP + c0) : z4, n1);
                if (lat) { float n2[8], n3[8];
                    unpack8(h2 ? ld16(P + r2 * NINP + c0) : z4, n2);
                    unpack8(h3 ? ld16(P + r3 * NINP + c0) : z4, n3);
#pragma unroll
                    for (int e = 0; e < 8; ++e) sh[e] = (e & 3) == 0 ? n0[e] : (e & 3) == 1 ? n1[e] : (e & 3) == 2 ? n2[e] : n3[e];
                } else {
#pragma unroll
                    for (int e = 0; e < 8; ++e) sh[e] = (e & 1) == 0 ? n0[e] : n1[e];
                }
                ldf8(mu + c0, muv);
#pragma unroll
                for (int e = 0; e < 8; ++e) xm[e] = own[e] + muv[e] * (sh[e] - own[e]);
                if (i < 4) st16(R + (size_t)m * RW + c0, pack8(xm));
                else if (i < 8) { const int cc = c0 - 2048; st16(K + (size_t)m * RW + cc, pack8(xm));
                    float kv[8], kkv[8]; ldf8(k_k + cc, kv); float ss = 0.f;
#pragma unroll
                    for (int e = 0; e < 8; ++e) { kkv[e] = xm[e] * kv[e]; ss += kkv[e] * kkv[e]; }
                    ss = sum8(ss);
                    const float inv = rsqrtf(fmaxf(ss, 1e-24f));
#pragma unroll
                    for (int e = 0; e < 8; ++e) kkv[e] *= inv;
                    st16(KK + (size_t)m * RW + cc, pack8(kkv)); }
                else if (i < 12) st16(V + (size_t)m * RW + (c0 - 4096), pack8(xm));
                else { const int j0 = c0 - 6144; float f[8];
#pragma unroll
                    for (int e = 0; e < 8; ++e) f[e] = j0 < 192 ? tanhf(xm[e]) : (j0 < 384 ? xm[e] : 1.f / (1.f + __expf(-xm[e])));
                    const int col = j0 < 384 ? (j0 / 96) * 128 + (j0 % 96) : j0 + 128;
                    st16(ALR + (size_t)m * KLR + col, pack8(f)); }
            } else if (i == 13 && lane < 32) {
                const int pc = lane - 16; st16(ALR + (size_t)m * KLR + (pc >> 2) * 128 + 96 + (pc & 3) * 8, make_uint4(0u, 0u, 0u, 0u));
            }
        }
    }
}

__device__ __forceinline__ void ph_prep_ssd(const Args& a) {
    const int lane = LANE;
    const bf16* P = (const bf16*)(a.ws + WS_P);
    bf16* XS = (bf16*)(a.ws + WS_XS); bf16* BC = (bf16*)(a.ws + WS_BC); bf16* Z = (bf16*)(a.ws + WS_Z); float* DT = (float*)(a.ws + WS_DT); float* LA = (float*)(a.ws + WS_LA);
    const float* cw = a.in[I_CONVW]; const float* cb = a.in[I_CONVB];
    for (int m = GW; m < MT; m += NGW) {
        const bool lat = m < MX; bool hp, hn;
        if (lat) { const int t = m & (SEQ - 1); hp = t > 0; hn = t < SEQ - 1; } else { const int t = (m - MX) & (CTXL - 1); hp = t > 0; hn = t < CTXL - 1; }
        const bf16* prow = P + (size_t)m * NINP;
#pragma unroll
        for (int i = 0; i < 8; ++i) {
            const int c0 = (lane + 64 * i) * 8; const uint4 z4 = make_uint4(0u, 0u, 0u, 0u);
            float cur[8], pv[8], nx[8], w0[8], w1[8], w2[8], bb[8], y[8];
            unpack8(ld16(prow + COL_XBC + c0), cur);
            unpack8(hp ? ld16(prow - NINP + COL_XBC + c0) : z4, pv);
            unpack8(hn ? ld16(prow + NINP + COL_XBC + c0) : z4, nx);
            ldf8(cw + c0, w0); ldf8(cw + 4096 + c0, w1); ldf8(cw + 8192 + c0, w2); ldf8(cb + c0, bb);
#pragma unroll
            for (int e = 0; e < 8; ++e) { const float t = w0[e] * pv[e] + w1[e] * cur[e] + w2[e] * nx[e] + bb[e]; y[e] = t / (1.f + __expf(-t)); }
            if (i < 4) st16(XS + (size_t)m * RW + c0, pack8(y)); else st16(BC + (size_t)m * RW + (c0 - 2048), pack8(y));
        }
        { const float raw = __uint_as_float((unsigned)prow[COL_DT + lane] << 16) + a.in[I_DTB][lane];
          const float dtv = raw > 20.f ? raw : log1pf(expf(raw));
          DT[(size_t)m * 64 + lane] = dtv; LA[(size_t)m * 64 + lane] = -dtv * expf(a.in[I_ALOG][lane]); }
        if (lat) {
#pragma unroll
            for (int i = 0; i < 4; ++i) { const int c0 = (lane + 64 * i) * 8; st16(Z + (size_t)m * RW + c0, ld16(prow + COL_Z + c0)); }
        }
    }
}

__device__ __forceinline__ int scan_row(int n, int dir, int b) { return n < CTXL ? MX + b * CTXL + (dir ? CTXL - 1 - n : n) : b * SEQ + (dir ? NSTEP - 1 - n : n - CTXL); }

struct RIn { uint4 r, k, kk, w, a; unsigned v; };
__device__ __forceinline__ void rwkv_load(RIn& x, const bf16* R, const bf16* K, const bf16* V, const bf16* KK, const bf16* LR, int m, int ch, int chi, int dir) {
    x.r = ld16(R + (size_t)m * RW + ch); x.k = ld16(K + (size_t)m * RW + ch); x.kk = ld16(KK + (size_t)m * RW + ch);
    x.w = ld16(LR + (size_t)m * NLR + dir * 2048 + ch); x.a = ld16(LR + (size_t)m * NLR + 4096 + dir * 2048 + ch);
    x.v = V[(size_t)m * RW + chi];
}
__device__ __forceinline__ float rwkv_step(float (&S)[8], const RIn& x, const float (&ka)[8]) {
    float r[8], k[8], kk[8], w1[8], av[8];
    unpack8(x.r, r); unpack8(x.k, k); unpack8(x.kk, kk); unpack8(x.w, w1); unpack8(x.a, av);
    const float v = __uint_as_float(x.v << 16);
    float sa = 0.f;
#pragma unroll
    for (int e = 0; e < 8; ++e) sa -= S[e] * kk[e];
    sa = sum8(sa);
    float o = 0.f;
#pragma unroll
    for (int e = 0; e < 8; ++e) { const float kd = k[e] * (1.f + (av[e] - 1.f) * ka[e]); const float b = kk[e] * av[e];
        S[e] = S[e] * (1.f - w1[e]) + sa * b + v * kd; o += S[e] * r[e]; }
    o = sum8(o);
    return o;
}
__device__ __forceinline__ void ph_rwkv_scan(const Args& a) {
    const int lane = LANE, wave = WAVE;
    const bf16* R = (const bf16*)(a.ws + WS_R); const bf16* K = (const bf16*)(a.ws + WS_K); const bf16* V = (const bf16*)(a.ws + WS_V); const bf16* KK = (const bf16*)(a.ws + WS_KK);
    const bf16* LR = (const bf16*)(a.ws + WS_LR); bf16* OR = (bf16*)a.out;
    for (int u = blockIdx.x; u < 256; u += gridDim.x) {
        const int g = u >> 5, h = u & 31, dir = g >> 2, b = g & 3;
        const int i = wave * 8 + (lane >> 3), jb = lane & 7, ch = h * 64 + jb * 8, chi = h * 64 + i;
        float ka[8]; ldf8(a.in[I_KA] + ch, ka);
        float S[8];
#pragma unroll
        for (int e = 0; e < 8; ++e) S[e] = 0.f;
        RIn A[4], B[4];
#pragma unroll
        for (int s = 0; s < 4; ++s) rwkv_load(A[s], R, K, V, KK, LR, scan_row(s, dir, b), ch, chi, dir);
        for (int n0 = 0; n0 < NSTEP; n0 += 8) {
#pragma unroll
            for (int s = 0; s < 4; ++s) rwkv_load(B[s], R, K, V, KK, LR, scan_row(n0 + 4 + s, dir, b), ch, chi, dir);
#pragma unroll
            for (int s = 0; s < 4; ++s) { const int n = n0 + s; const float o = rwkv_step(S, A[s], ka);
                if (n >= CTXL && jb == 0) OR[((size_t)dir * MX + scan_row(n, dir, b)) * RW + chi] = (bf16)f2bf(o); }
            if (n0 + 8 < NSTEP) {
#pragma unroll
                for (int s = 0; s < 4; ++s) rwkv_load(A[s], R, K, V, KK, LR, scan_row(n0 + 8 + s, dir, b), ch, chi, dir);
            }
#pragma unroll
            for (int s = 0; s < 4; ++s) { const int n = n0 + 4 + s; const float o = rwkv_step(S, B[s], ka);
                if (n >= CTXL && jb == 0) OR[((size_t)dir * MX + scan_row(n, dir, b)) * RW + chi] = (bf16)f2bf(o); }
        }
    }
}

typedef float f32x2_t __attribute__((ext_vector_type(2)));
constexpr int RS_TS = 32, RS_STEP_B = 6 * 256, RS_BUF_B = RS_TS * RS_STEP_B;
constexpr int RS_OBUF = 2 * RS_BUF_B, RS_OBUF_B = RS_TS * 64 * 2;
constexpr int RS_DUMP = RS_OBUF + 2 * RS_OBUF_B;
static_assert(RS_DUMP + 2048 <= 131072, "rwkv scan lds map");
struct RRaw { uint2 r, k, kk, v, w, a; };
__device__ __forceinline__ void rs_load(RRaw& x, const bf16* R, const bf16* K, const bf16* V, const bf16* KK, const bf16* LR, int m, int ch, int dir) {
    x.r = *(const uint2*)(R + (size_t)m * RW + ch); x.k = *(const uint2*)(K + (size_t)m * RW + ch); x.kk = *(const uint2*)(KK + (size_t)m * RW + ch); x.v = *(const uint2*)(V + (size_t)m * RW + ch);
    x.w = *(const uint2*)(LR + (size_t)m * NLR + dir * 2048 + ch); x.a = *(const uint2*)(LR + (size_t)m * NLR + 4096 + dir * 2048 + ch);
}
__device__ __forceinline__ void rs_stage(const RRaw& x, const float (&ka)[4], LAS unsigned char* dst) {
    const float r[4] = {bflo(x.r.x), bfhi(x.r.x), bflo(x.r.y), bfhi(x.r.y)}, k[4] = {bflo(x.k.x), bfhi(x.k.x), bflo(x.k.y), bfhi(x.k.y)};
    const float kk[4] = {bflo(x.kk.x), bfhi(x.kk.x), bflo(x.kk.y), bfhi(x.kk.y)}, v[4] = {bflo(x.v.x), bfhi(x.v.x), bflo(x.v.y), bfhi(x.v.y)};
    const float w1[4] = {bflo(x.w.x), bfhi(x.w.x), bflo(x.w.y), bfhi(x.w.y)}, av[4] = {bflo(x.a.x), bfhi(x.a.x), bflo(x.a.y), bfhi(x.a.y)};
    f32x4 nkk, w, b, kd, rr, vv;
#pragma unroll
    for (int e = 0; e < 4; ++e) { nkk[e] = -kk[e]; w[e] = 1.f - w1[e]; b[e] = kk[e] * av[e]; kd[e] = k[e] * (1.f + (av[e] - 1.f) * ka[e]); rr[e] = r[e]; vv[e] = v[e]; }
    *(LAS f32x4*)(dst) = nkk; *(LAS f32x4*)(dst + 256) = w; *(LAS f32x4*)(dst + 512) = b; *(LAS f32x4*)(dst + 768) = kd; *(LAS f32x4*)(dst + 1024) = rr; *(LAS f32x4*)(dst + 1280) = vv;
}
__device__ __forceinline__ float amul(float a, float b) { float d; asm("v_mul_f32 %0, %1, %2" : "=v"(d) : "v"(a), "v"(b)); return d; }
__device__ __forceinline__ void afmac(float& d, float a, float b) { asm("v_fmac_f32 %0, %1, %2" : "+v"(d) : "v"(a), "v"(b)); }
__device__ __forceinline__ float afma(float a, float b, float c) { float d; asm("v_fma_f32 %0, %1, %2, %3" : "=v"(d) : "v"(a), "v"(b), "v"(c)); return d; }
__device__ __forceinline__ void sum16x2(float& a, float& b) {
    asm("s_nop 1\n\t"
        "v_add_f32_dpp %0, %0, %0 quad_perm:[1,0,3,2] row_mask:0xf bank_mask:0xf bound_ctrl:1\n\t"
        "v_add_f32_dpp %1, %1, %1 quad_perm:[1,0,3,2] row_mask:0xf bank_mask:0xf bound_ctrl:1\n\t"
        "s_nop 0\n\t"
        "v_add_f32_dpp %0, %0, %0 quad_perm:[2,3,0,1] row_mask:0xf bank_mask:0xf bound_ctrl:1\n\t"
        "v_add_f32_dpp %1, %1, %1 quad_perm:[2,3,0,1] row_mask:0xf bank_mask:0xf bound_ctrl:1\n\t"
        "s_nop 0\n\t"
        "v_add_f32_dpp %0, %0, %0 row_half_mirror row_mask:0xf bank_mask:0xf bound_ctrl:1\n\t"
        "v_add_f32_dpp %1, %1, %1 row_half_mirror row_mask:0xf bank_mask:0xf bound_ctrl:1\n\t"
        "s_nop 0\n\t"
        "v_add_f32_dpp %0, %0, %0 row_mirror row_mask:0xf bank_mask:0xf bound_ctrl:1\n\t"
        "v_add_f32_dpp %1, %1, %1 row_mirror row_mask:0xf bank_mask:0xf bound_ctrl:1"
        : "+v"(a), "+v"(b));
}
template <bool OUT> __device__ __forceinline__ void rs_chunk(float (&S)[2][4], const LAS unsigned char* buf, LAS unsigned char* obuf, LAS unsigned char* dump, int j0, int i0, int jb) {
#pragma unroll 4
    for (int s = 0; s < RS_TS; ++s) {
        const LAS unsigned char* base = buf + s * RS_STEP_B;
        const f32x4 nkk = *(const LAS f32x4*)(base + j0 * 4), w = *(const LAS f32x4*)(base + 256 + j0 * 4), b = *(const LAS f32x4*)(base + 512 + j0 * 4), kd = *(const LAS f32x4*)(base + 768 + j0 * 4);
        const f32x2_t v = *(const LAS f32x2_t*)(base + 1280 + i0 * 4);
        float sa0 = amul(S[0][0], nkk[0]), sa1 = amul(S[1][0], nkk[0]);
#pragma unroll
        for (int e = 1; e < 4; ++e) { afmac(sa0, S[0][e], nkk[e]); afmac(sa1, S[1][e], nkk[e]); }
        sum16x2(sa0, sa1);
#pragma unroll
        for (int e = 0; e < 4; ++e) { float t0 = amul(sa0, b[e]), t1 = amul(sa1, b[e]); afmac(t0, v[0], kd[e]); afmac(t1, v[1], kd[e]); S[0][e] = afma(S[0][e], w[e], t0); S[1][e] = afma(S[1][e], w[e], t1); }
        if (OUT) {
            const f32x4 r = *(const LAS f32x4*)(base + 1024 + j0 * 4);
            float o0 = amul(S[0][0], r[0]), o1 = amul(S[1][0], r[0]);
#pragma unroll
            for (int e = 1; e < 4; ++e) { afmac(o0, S[0][e], r[e]); afmac(o1, S[1][e], r[e]); }
            sum16x2(o0, o1);
            *(LAS unsigned*)(jb == 0 ? obuf + (s * 64 + i0) * 2 : dump) = pg8::cvt_pk_bf16(o0, o1);
        }
    }
}
__device__ __forceinline__ void ph_rwkv_scan2(const Args& a, LAS unsigned char* lds) {
    const int tid = TID, lane = LANE, wave = WAVE;
    const bf16* R = (const bf16*)(a.ws + WS_R); const bf16* K = (const bf16*)(a.ws + WS_K); const bf16* V = (const bf16*)(a.ws + WS_V); const bf16* KK = (const bf16*)(a.ws + WS_KK);
    const bf16* LR = (const bf16*)(a.ws + WS_LR); bf16* OR = (bf16*)a.out;
    constexpr int NCH = NSTEP / RS_TS;
    for (int u = blockIdx.x; u < 256; u += gridDim.x) {
        const int g = u >> 5, h = u & 31, dir = g >> 2, b = g & 3;
        const int ip = lane >> 4, jb = lane & 15, i0 = wave * 8 + ip * 2, j0 = jb * 4;
        const int ss = tid >> 4, cgp = tid & 15, ch = h * 64 + cgp * 4;
        float ka[4];
#pragma unroll
        for (int e = 0; e < 4; ++e) ka[e] = a.in[I_KA][ch + e];
        float S[2][4];
#pragma unroll
        for (int e = 0; e < 4; ++e) { S[0][e] = 0.f; S[1][e] = 0.f; }
        RRaw raw;
        __syncthreads();
        rs_load(raw, R, K, V, KK, LR, scan_row(ss, dir, b), ch, dir);
        rs_stage(raw, ka, lds + ss * RS_STEP_B + cgp * 16);
        __syncthreads();
        for (int c = 0; c < NCH; ++c) {
            LAS unsigned char* buf = lds + (c & 1) * RS_BUF_B; LAS unsigned char* nbuf = lds + ((c + 1) & 1) * RS_BUF_B; LAS unsigned char* obuf = lds + RS_OBUF + (c & 1) * RS_OBUF_B;
            const bool more = c + 1 < NCH;
            if (more) rs_load(raw, R, K, V, KK, LR, scan_row((c + 1) * RS_TS + ss, dir, b), ch, dir);
            const bool lat = c >= CTXL / RS_TS;
            if (lat) rs_chunk<true>(S, buf, obuf, lds + RS_DUMP + tid * 4, j0, i0, jb); else rs_chunk<false>(S, buf, obuf, lds + RS_DUMP + tid * 4, j0, i0, jb);
            if (more) rs_stage(raw, ka, nbuf + ss * RS_STEP_B + cgp * 16);
            __syncthreads();
            if (lat) { typedef unsigned u32x2_t __attribute__((ext_vector_type(2))); const u32x2_t ov = *(const LAS u32x2_t*)(obuf + (ss * 64 + cgp * 4) * 2);
                *(uint2*)(OR + ((size_t)dir * MX + scan_row(c * RS_TS + ss, dir, b)) * RW + ch) = make_uint2(ov[0], ov[1]); }
        }
    }
}

struct SIn { uint4 b0, b1, c0, c1; unsigned xs; float dt, la; };
__device__ __forceinline__ void ssd_load(SIn& x, const bf16* XS, const bf16* BC, const float* DT, const float* LA, int m, int chx, int cb, int dh) {
    x.b0 = ld16(BC + (size_t)m * RW + cb); x.b1 = ld16(BC + (size_t)m * RW + cb + 8); x.c0 = ld16(BC + (size_t)m * RW + 1024 + cb); x.c1 = ld16(BC + (size_t)m * RW + 1024 + cb + 8);
    x.xs = XS[(size_t)m * RW + chx]; x.dt = DT[(size_t)m * 64 + dh]; x.la = LA[(size_t)m * 64 + dh];
}
__device__ __forceinline__ float ssd_step(float (&s)[16], const SIn& x) {
    float B0[8], B1[8], C0[8], C1[8]; unpack8(x.b0, B0); unpack8(x.b1, B1); unpack8(x.c0, C0); unpack8(x.c1, C1);
    const float dec = __expf(x.la), xdt = __uint_as_float(x.xs << 16) * x.dt; float y = 0.f;
#pragma unroll
    for (int e = 0; e < 8; ++e) { s[e] = dec * s[e] + xdt * B0[e]; y += s[e] * C0[e]; s[8 + e] = dec * s[8 + e] + xdt * B1[e]; y += s[8 + e] * C1[e]; }
    y = sum8(y);
    return y;
}
__device__ __forceinline__ void ph_ssd_scan(const Args& a) {
    const int lane = LANE, wave = WAVE;
    const bf16* XS = (const bf16*)(a.ws + WS_XS); const bf16* BC = (const bf16*)(a.ws + WS_BC); const float* DT = (const float*)(a.ws + WS_DT); const float* LA = (const float*)(a.ws + WS_LA);
    bf16* YS = (bf16*)a.out + (size_t)2 * MX * RW;
    for (int u = blockIdx.x; u < 256; u += gridDim.x) {
        const int g = u >> 5, h = u & 31, dir = g >> 2, b = g & 3;
        const int p = wave * 8 + (lane >> 3), nb = lane & 7, chx = h * 64 + p, cb = (h >> 2) * 128 + nb * 16, dh = dir * 32 + h;
        float s[16];
#pragma unroll
        for (int e = 0; e < 16; ++e) s[e] = 0.f;
        SIn A[4], B[4];
#pragma unroll
        for (int q = 0; q < 4; ++q) ssd_load(A[q], XS, BC, DT, LA, scan_row(q, dir, b), chx, cb, dh);
        for (int n0 = 0; n0 < NSTEP; n0 += 8) {
#pragma unroll
            for (int q = 0; q < 4; ++q) ssd_load(B[q], XS, BC, DT, LA, scan_row(n0 + 4 + q, dir, b), chx, cb, dh);
#pragma unroll
            for (int q = 0; q < 4; ++q) { const int n = n0 + q; const float y = ssd_step(s, A[q]);
                if (n >= CTXL && nb == 0) YS[((size_t)dir * MX + scan_row(n, dir, b)) * RW + chx] = (bf16)f2bf(y); }
            if (n0 + 8 < NSTEP) {
#pragma unroll
                for (int q = 0; q < 4; ++q) ssd_load(A[q], XS, BC, DT, LA, scan_row(n0 + 8 + q, dir, b), chx, cb, dh);
            }
#pragma unroll
            for (int q = 0; q < 4; ++q) { const int n = n0 + 4 + q; const float y = ssd_step(s, B[q]);
                if (n >= CTXL && nb == 0) YS[((size_t)dir * MX + scan_row(n, dir, b)) * RW + chx] = (bf16)f2bf(y); }
        }
    }
}

typedef short bf16x8_t __attribute__((ext_vector_type(8)));
typedef float f32x16 __attribute__((ext_vector_type(16)));
constexpr int SLD = 272;
constexpr int L_C = 0, L_B = 34816, L_BT = 69632, L_XT = 104448, L_S = 121856, L_F = 139264;
static_assert(L_F + 4 * 512 <= LDS_CTL, "ssd lds map");
typedef unsigned u32x4_t __attribute__((ext_vector_type(4)));
__device__ __forceinline__ void lds_st16(LAS unsigned char* p, const uint4& v) { *(LAS u32x4_t*)p = (u32x4_t){v.x, v.y, v.z, v.w}; }
__device__ __forceinline__ uint4 lds_ld16(const LAS unsigned char* p) { const u32x4_t t = *(const LAS u32x4_t*)p; return make_uint4(t[0], t[1], t[2], t[3]); }
__device__ __forceinline__ bf16x8_t lfrag(LAS unsigned char* img, int row, int k) { return *(LAS bf16x8_t*)(img + row * SLD + k * 2); }
__device__ __forceinline__ void ph_ssd_chunked(const Args& a, LAS unsigned char* lds) {
    const int tid = TID, lane = LANE, wave = WAVE, r = lane & 31, hh = lane >> 5;
    const bf16* XS = (const bf16*)(a.ws + WS_XS); const bf16* BC = (const bf16*)(a.ws + WS_BC); const float* DT = (const float*)(a.ws + WS_DT); const float* LA = (const float*)(a.ws + WS_LA);
    bf16* YS = (bf16*)a.out + (size_t)2 * MX * RW;
    LAS float* laS = (LAS float*)(lds + L_F); LAS float* dtS = laS + 128; LAS float* cumS = laS + 256;
    for (int u = blockIdx.x; u < 256; u += gridDim.x) {
        const int g = u >> 5, h = u & 31, dir = g >> 2, b = g & 3, gi = h >> 2;
        f32x16 st;
#pragma unroll
        for (int q = 0; q < 16; ++q) st[q] = 0.f;
        __syncthreads();
        for (int i = tid; i < 64 * SLD / 4; i += 512) ((LAS unsigned*)(lds + L_S))[i] = 0u;
        for (int c = 0; c < NSTEP / 128; ++c) {
            const int n0 = c * 128; const bool lat = c >= CTXL / 128;
            for (int i = tid; i < 2048; i += 512) { const int l = i >> 4, pc = i & 15; const size_t m = (size_t)scan_row(n0 + l, dir, b);
                lds_st16(lds + L_B + l * SLD + pc * 16, ld16(BC + m * RW + gi * 128 + pc * 8));
                if (lat) lds_st16(lds + L_C + l * SLD + pc * 16, ld16(BC + m * RW + 1024 + gi * 128 + pc * 8)); }
            for (int i = tid; i < 1024; i += 512) { const int l = i >> 3, pc = i & 7; const size_t m = (size_t)scan_row(n0 + l, dir, b);
                const uint4 v = ld16(XS + m * RW + h * 64 + pc * 8); const unsigned w[4] = {v.x, v.y, v.z, v.w};
#pragma unroll
                for (int e = 0; e < 8; ++e) *(LAS bf16*)(lds + L_XT + (pc * 8 + e) * SLD + l * 2) = (bf16)((e & 1) ? (w[e >> 1] >> 16) : (w[e >> 1] & 0xffffu)); }
            if (tid < 128) { const size_t m = (size_t)scan_row(n0 + tid, dir, b); laS[tid] = LA[m * 64 + dir * 32 + h]; dtS[tid] = DT[m * 64 + dir * 32 + h]; }
            __syncthreads();
            if (wave == 0) { const float a0 = laS[2 * lane], b0 = laS[2 * lane + 1]; float x = a0 + b0;
#pragma unroll
                for (int d = 1; d < 64; d <<= 1) { const float y = __shfl_up(x, d); if (lane >= d) x += y; }
                cumS[2 * lane + 1] = x; cumS[2 * lane] = x - b0; }
            __syncthreads();
            const float ctot = cumS[127];
            for (int i = tid; i < 2048; i += 512) { const int l = i >> 4, pc = i & 15; const float wl = dtS[l] * __expf(ctot - cumS[l]);
                float f[8]; unpack8(lds_ld16(lds + L_B + l * SLD + pc * 16), f);
#pragma unroll
                for (int e = 0; e < 8; ++e) *(LAS bf16*)(lds + L_BT + (pc * 8 + e) * SLD + l * 2) = (bf16)f2bf(f[e] * wl); }
            f32x16 acc0, acc1;
            const int lt = wave >> 1, st0 = 2 * (wave & 1);
            if (lat) {
#pragma unroll
                for (int q = 0; q < 16; ++q) { acc0[q] = 0.f; acc1[q] = 0.f; }
                if (st0 <= lt) {
#pragma unroll
                    for (int ks = 0; ks < 8; ++ks) { const bf16x8_t af = lfrag(lds + L_C, lt * 32 + r, ks * 16 + 8 * hh);
                        acc0 = __builtin_amdgcn_mfma_f32_32x32x16_bf16(af, lfrag(lds + L_B, st0 * 32 + r, ks * 16 + 8 * hh), acc0, 0, 0, 0);
                        if (st0 + 1 <= lt) acc1 = __builtin_amdgcn_mfma_f32_32x32x16_bf16(af, lfrag(lds + L_B, (st0 + 1) * 32 + r, ks * 16 + 8 * hh), acc1, 0, 0, 0); }
                }
            }
            __syncthreads();
            if (lat) {
#pragma unroll
                for (int t = 0; t < 2; ++t) { const int stt = st0 + t;
                    if (stt <= lt) { const int sidx = stt * 32 + r; const float cs = cumS[sidx], ds = dtS[sidx];
#pragma unroll
                        for (int q = 0; q < 16; ++q) { const int l = lt * 32 + (q & 3) + 8 * (q >> 2) + 4 * hh; const float v = t ? acc1[q] : acc0[q];
                            const float wv = sidx <= l ? v * __expf(cumS[l] - cs) * ds : 0.f;
                            *(LAS bf16*)(lds + L_B + l * SLD + sidx * 2) = (bf16)f2bf(wv); } } }
            }
            __syncthreads();
            if (lat) {
                const int pt = wave & 1;
                f32x16 accd, acco;
#pragma unroll
                for (int q = 0; q < 16; ++q) { accd[q] = 0.f; acco[q] = 0.f; }
                for (int ks = 0; ks < 2 * (lt + 1); ++ks)
                    accd = __builtin_amdgcn_mfma_f32_32x32x16_bf16(lfrag(lds + L_B, lt * 32 + r, ks * 16 + 8 * hh), lfrag(lds + L_XT, pt * 32 + r, ks * 16 + 8 * hh), accd, 0, 0, 0);
#pragma unroll
                for (int ks = 0; ks < 8; ++ks)
                    acco = __builtin_amdgcn_mfma_f32_32x32x16_bf16(lfrag(lds + L_C, lt * 32 + r, ks * 16 + 8 * hh), lfrag(lds + L_S, pt * 32 + r, ks * 16 + 8 * hh), acco, 0, 0, 0);
#pragma unroll
                for (int q = 0; q < 16; ++q) { const int l = lt * 32 + (q & 3) + 8 * (q >> 2) + 4 * hh; const float y = accd[q] + __expf(cumS[l]) * acco[q];
                    YS[((size_t)dir * MX + scan_row(n0 + l, dir, b)) * RW + h * 64 + pt * 32 + r] = (bf16)f2bf(y); }
            }
            const int pt2 = wave >> 2, nt = wave & 3;
            { const float dc = __expf(ctot);
#pragma unroll
              for (int q = 0; q < 16; ++q) st[q] *= dc;
#pragma unroll
              for (int ks = 0; ks < 8; ++ks)
                  st = __builtin_amdgcn_mfma_f32_32x32x16_bf16(lfrag(lds + L_XT, pt2 * 32 + r, ks * 16 + 8 * hh), lfrag(lds + L_BT, nt * 32 + r, ks * 16 + 8 * hh), st, 0, 0, 0); }
            __syncthreads();
#pragma unroll
            for (int q = 0; q < 16; ++q) { const int p = pt2 * 32 + (q & 3) + 8 * (q >> 2) + 4 * hh; *(LAS bf16*)(lds + L_S + p * SLD + (nt * 32 + r) * 2) = (bf16)f2bf(st[q]); }
            __syncthreads();
        }
    }
}

constexpr int CR_T = 32, CR_PJ = 144, CR_PS = 80, CR_PF = 272;
constexpr int CR_AR = 0, CR_BK = CR_AR + 64 * CR_PJ, CR_BHT = CR_BK + 64 * CR_PJ, CR_KHT = CR_BHT + 64 * CR_PS, CR_VT = CR_KHT + 64 * CR_PS, CR_SB = CR_VT + 64 * CR_PS,
              CR_NAK = CR_SB + 2 * 64 * CR_PJ, CR_PBR = CR_NAK + 32 * CR_PS, CR_PKR = CR_PBR + 32 * CR_PS, CR_NABF = CR_PKR + 32 * CR_PS, CR_RT = CR_NABF + 32 * CR_PJ,
              CR_SA = CR_RT + 32 * CR_PF, CR_GT = CR_SA + 64 * CR_PS, CR_CP = CR_GT + 256, CR_OB = CR_CP + 8 * 256, CR_END = CR_OB + 32 * 128;
static_assert(CR_END <= 131072, "chunked rwkv lds map");
__device__ __forceinline__ f32x16 mfma32(const bf16x8_t& a, const bf16x8_t& b, const f32x16& c) { return __builtin_amdgcn_mfma_f32_32x32x16_bf16(a, b, c, 0, 0, 0); }
__device__ __forceinline__ bf16x8_t cfrag(const LAS unsigned char* img, int pitch, int row, int k) { return *(const LAS bf16x8_t*)(img + row * pitch + k * 2); }
struct CRaw { unsigned short r[4], k[4], kk[4], w[4], al[4], v[4]; };
__device__ __forceinline__ void cr_load(CRaw& x, const bf16* R, const bf16* K, const bf16* V, const bf16* KK, const bf16* LR, int n0, int dir, int b, int chn) {
#pragma unroll
    for (int u = 0; u < 4; ++u) { const size_t m = (size_t)scan_row(n0 + u, dir, b);
        x.r[u] = R[m * RW + chn]; x.k[u] = K[m * RW + chn]; x.kk[u] = KK[m * RW + chn]; x.v[u] = V[m * RW + chn];
        x.w[u] = LR[m * NLR + dir * 2048 + chn]; x.al[u] = LR[m * NLR + 4096 + dir * 2048 + chn]; }
}
__device__ __forceinline__ void ph_rwkv_chunked(const Args& a, LAS unsigned char* lds) {
    const int tid = TID, lane = LANE, wave = WAVE, r = lane & 31, hh = lane >> 5;
    const bf16* R = (const bf16*)(a.ws + WS_R); const bf16* K = (const bf16*)(a.ws + WS_K); const bf16* V = (const bf16*)(a.ws + WS_V); const bf16* KK = (const bf16*)(a.ws + WS_KK);
    const bf16* LR = (const bf16*)(a.ws + WS_LR); bf16* OR = (bf16*)a.out;
    constexpr int NCH = NSTEP / CR_T;
    LAS float* GT = (LAS float*)(lds + CR_GT); LAS float* CP = (LAS float*)(lds + CR_CP);
    for (int u0 = blockIdx.x; u0 < 256; u0 += gridDim.x) {
        const int g = u0 >> 5, h = u0 & 31, dir = g >> 2, b = g & 3, chn = h * 64 + lane;
        const float ka = a.in[I_KA][chn];
        f32x16 st;
#pragma unroll
        for (int q = 0; q < 16; ++q) st[q] = 0.f;
        __syncthreads();
        for (int i = tid; i < 64 * CR_PJ / 4; i += 512) ((LAS unsigned*)(lds + CR_SB))[i] = 0u;
        CRaw raw; cr_load(raw, R, K, V, KK, LR, 4 * wave, dir, b, chn);
        for (int c = 0; c < NCH; ++c) {
            const bool lat = c >= CTXL / CR_T;
            const LAS unsigned char* SBc = lds + CR_SB + (c & 1) * 64 * CR_PJ; LAS unsigned char* SBn = lds + CR_SB + ((c + 1) & 1) * 64 * CR_PJ;
            float rv[4], kd[4], bv[4], av[4], vv[4], lw[4], cl[4];
            { float run = 0.f;
#pragma unroll
              for (int u = 0; u < 4; ++u) { const float kk = __uint_as_float((unsigned)raw.kk[u] << 16), al = __uint_as_float((unsigned)raw.al[u] << 16), kx = __uint_as_float((unsigned)raw.k[u] << 16);
                  rv[u] = __uint_as_float((unsigned)raw.r[u] << 16); vv[u] = __uint_as_float((unsigned)raw.v[u] << 16);
                  const float w = 1.f - __uint_as_float((unsigned)raw.w[u] << 16); lw[u] = __logf(w); run += lw[u]; cl[u] = run;
                  av[u] = -kk; bv[u] = kk * al; kd[u] = kx * (1.f + (al - 1.f) * ka); }
              CP[wave * 64 + lane] = run; }
            if (c + 1 < NCH) cr_load(raw, R, K, V, KK, LR, (c + 1) * CR_T + 4 * wave, dir, b, chn);
            __syncthreads();
            { float pre = 0.f, tot = 0.f;
#pragma unroll
              for (int q = 0; q < 8; ++q) { const float x = CP[q * 64 + lane]; tot += x; if (q < wave) pre += x; }
              const float gT = __expf(tot); if (wave == 0) GT[lane] = gT;
#pragma unroll
              for (int u = 0; u < 4; ++u) { const int t = 4 * wave + u; const float ct = pre + cl[u], e1 = __expf(ct), einv = 1.f / e1, ep = __expf(ct - lw[u]), eh = gT * einv;
                  *(LAS bf16*)(lds + CR_AR + t * CR_PJ + lane * 2) = (bf16)f2bf(av[u] * ep); *(LAS bf16*)(lds + CR_AR + (32 + t) * CR_PJ + lane * 2) = (bf16)f2bf(rv[u] * e1);
                  *(LAS bf16*)(lds + CR_BK + t * CR_PJ + lane * 2) = (bf16)f2bf(bv[u] * einv); *(LAS bf16*)(lds + CR_BK + (32 + t) * CR_PJ + lane * 2) = (bf16)f2bf(kd[u] * einv);
                  *(LAS bf16*)(lds + CR_BHT + lane * CR_PS + t * 2) = (bf16)f2bf(bv[u] * eh); *(LAS bf16*)(lds + CR_KHT + lane * CR_PS + t * 2) = (bf16)f2bf(kd[u] * eh);
                  *(LAS bf16*)(lds + CR_VT + lane * CR_PS + t * 2) = (bf16)f2bf(vv[u]); } }
            __syncthreads();
            f32x16 acc;
#pragma unroll
            for (int q = 0; q < 16; ++q) acc[q] = 0.f;
            if (wave < 4) {
                const int rb = wave >> 1, cb = wave & 1;
#pragma unroll
                for (int ks = 0; ks < 4; ++ks) acc = mfma32(cfrag(lds + CR_BK, CR_PJ, 32 * rb + r, 16 * ks + 8 * hh), cfrag(lds + CR_AR, CR_PJ, 32 * cb + r, 16 * ks + 8 * hh), acc);
#pragma unroll
                for (int gq = 0; gq < 4; ++gq) { float o[4];
#pragma unroll
                    for (int e = 0; e < 4; ++e) { const int sidx = 8 * gq + 4 * hh + e; const bool keep = cb ? (sidx <= r) : (sidx < r); o[e] = keep ? acc[4 * gq + e] : 0.f; }
                    if (wave == 0) {
#pragma unroll
                        for (int e = 0; e < 4; ++e) *(LAS float*)(lds + CR_NABF + r * CR_PJ + (e * 8 + 2 * gq + hh) * 4) = o[e]; }
                    else { LAS unsigned char* dst = lds + (wave == 1 ? CR_PBR : wave == 2 ? CR_NAK : CR_PKR) + r * CR_PS + (8 * gq + 4 * hh) * 2;
                        typedef unsigned u32x2_t __attribute__((ext_vector_type(2))); *(LAS u32x2_t*)dst = (u32x2_t){pk2(o[0], o[1]), pk2(o[2], o[3])}; } }
            } else if (wave < 6 || lat) {
                const int it = wave & 1, cb = wave >> 1 & 1 ? 32 : 0;
#pragma unroll
                for (int ks = 0; ks < 4; ++ks) acc = mfma32(cfrag(SBc, CR_PJ, 32 * it + r, 16 * ks + 8 * hh), cfrag(lds + CR_AR, CR_PJ, cb + r, 16 * ks + 8 * hh), acc);
            }
            __syncthreads();
            if (wave >= 4 && (wave < 6 || lat)) {
                const int it = wave & 1; const LAS unsigned char* NT = lds + (wave < 6 ? CR_NAK : CR_PKR);
#pragma unroll
                for (int ks = 0; ks < 2; ++ks) acc = mfma32(cfrag(lds + CR_VT, CR_PS, 32 * it + r, 16 * ks + 8 * hh), cfrag(NT, CR_PS, r, 16 * ks + 8 * hh), acc);
                if (wave < 6) {
#pragma unroll
                    for (int gq = 0; gq < 4; ++gq) *(LAS f32x4*)(lds + CR_RT + r * CR_PF + (32 * it + 8 * gq + 4 * hh) * 4) = (f32x4){acc[4 * gq], acc[4 * gq + 1], acc[4 * gq + 2], acc[4 * gq + 3]};
                }
            }
            __syncthreads();
            if (wave < 4) {
                const int q = lane & 3, irow = 16 * wave + (lane >> 2);
                const LAS unsigned char* nrow = lds + CR_NABF + q * 32; const LAS unsigned char* rcol = lds + CR_RT + irow * 4;
                float mysa[8];
#pragma unroll
                for (int u = 0; u < 8; ++u) mysa[u] = 0.f;
                f32x4 NA[34], NB[34]; float RH[34];
#pragma unroll
                for (int t = 0; t < 2; ++t) { NA[t] = *(const LAS f32x4*)(nrow + t * CR_PJ); NB[t] = NA[t]; RH[t] = *(const LAS float*)(rcol + t * CR_PF); }
#pragma unroll
                for (int t = 0; t < 32; ++t) {
                    if (t + 2 < 32) { NA[t + 2] = *(const LAS f32x4*)(nrow + (t + 2) * CR_PJ); if (t + 2 > 16) NB[t + 2] = *(const LAS f32x4*)(nrow + (t + 2) * CR_PJ + 16); RH[t + 2] = *(const LAS float*)(rcol + (t + 2) * CR_PF); }
                    asm volatile("" ::: "memory");
                    float p0 = 0.f, p1 = 0.f;
#pragma unroll
                    for (int u = 0; u < 4; ++u) if (u < (t + 3) / 4) { if (u & 1) p1 += mysa[u] * NA[t][u]; else p0 += mysa[u] * NA[t][u]; }
#pragma unroll
                    for (int u = 4; u < 8; ++u) if (u < (t + 3) / 4) { if (u & 1) p1 += mysa[u] * NB[t][u - 4]; else p0 += mysa[u] * NB[t][u - 4]; }
                    float part = p0 + p1;
                    part += dppf<0xB1>(part); part += dppf<0x4E>(part);
                    const float x = RH[t] + part;
                    mysa[t >> 2] = (q == (t & 3)) ? x : mysa[t >> 2];
                    asm volatile("" : "+v"(mysa[t >> 2]));
                }
#pragma unroll
                for (int u = 0; u < 8; ++u) *(LAS bf16*)(lds + CR_SA + irow * CR_PS + (4 * u + q) * 2) = (bf16)f2bf(mysa[u]);
            }
            __syncthreads();
            if (wave < 4) {
                const int jt = wave >> 1, it = wave & 1;
#pragma unroll
                for (int gq = 0; gq < 4; ++gq) { const f32x4 gv = *(LAS f32x4*)(lds + CR_GT + (32 * jt + 8 * gq + 4 * hh) * 4);
#pragma unroll
                    for (int e = 0; e < 4; ++e) st[4 * gq + e] *= gv[e]; }
#pragma unroll
                for (int ks = 0; ks < 2; ++ks) { st = mfma32(cfrag(lds + CR_BHT, CR_PS, 32 * jt + r, 16 * ks + 8 * hh), cfrag(lds + CR_SA, CR_PS, 32 * it + r, 16 * ks + 8 * hh), st);
                    st = mfma32(cfrag(lds + CR_KHT, CR_PS, 32 * jt + r, 16 * ks + 8 * hh), cfrag(lds + CR_VT, CR_PS, 32 * it + r, 16 * ks + 8 * hh), st); }
#pragma unroll
                for (int gq = 0; gq < 4; ++gq) { typedef unsigned u32x2_t __attribute__((ext_vector_type(2)));
                    *(LAS u32x2_t*)(SBn + (32 * it + r) * CR_PJ + (32 * jt + 8 * gq + 4 * hh) * 2) = (u32x2_t){pk2(st[4 * gq], st[4 * gq + 1]), pk2(st[4 * gq + 2], st[4 * gq + 3])}; }
            } else if (wave >= 6 && lat) {
                const int it = wave & 1;
#pragma unroll
                for (int ks = 0; ks < 2; ++ks) acc = mfma32(cfrag(lds + CR_SA, CR_PS, 32 * it + r, 16 * ks + 8 * hh), cfrag(lds + CR_PBR, CR_PS, r, 16 * ks + 8 * hh), acc);
#pragma unroll
                for (int gq = 0; gq < 4; ++gq) { typedef unsigned u32x2_t __attribute__((ext_vector_type(2)));
                    *(LAS u32x2_t*)(lds + CR_OB + r * 128 + (32 * it + 8 * gq + 4 * hh) * 2) = (u32x2_t){pk2(acc[4 * gq], acc[4 * gq + 1]), pk2(acc[4 * gq + 2], acc[4 * gq + 3])}; }
            }
            __syncthreads();
            if (lat) { const int ss = tid >> 4, cgp = tid & 15; typedef unsigned u32x2_t __attribute__((ext_vector_type(2)));
                const u32x2_t ov = *(const LAS u32x2_t*)(lds + CR_OB + ss * 128 + cgp * 8);
                *(uint2*)(OR + ((size_t)dir * MX + scan_row(c * CR_T + ss, dir, b)) * RW + h * 64 + cgp * 4) = make_uint2(ov[0], ov[1]); }
        }
    }
}

__device__ __forceinline__ void ph_finish(const Args& a) {
    const int lane = LANE;
    const bf16* R = (const bf16*)(a.ws + WS_R); const bf16* K = (const bf16*)(a.ws + WS_K); const bf16* V = (const bf16*)(a.ws + WS_V);
    const bf16* LR = (const bf16*)(a.ws + WS_LR); const bf16* XS = (const bf16*)(a.ws + WS_XS); const bf16* Z = (const bf16*)(a.ws + WS_Z);
    const bf16* OR = (const bf16*)a.out; const bf16* YS = (const bf16*)a.out + (size_t)2 * MX * RW;
    bf16* A2 = (bf16*)(a.ws + WS_A2);
    for (int m = GW; m < MX; m += NGW) {
#pragma unroll
        for (int i = 0; i < 4; ++i) {
            const int c0 = (lane + 64 * i) * 8;
            float of[8], ob[8], o[8], res[8];
#if MK_SKIP_RWKV
#pragma unroll
            for (int e = 0; e < 8; ++e) res[e] = 0.f;
#else
            unpack8(ld16(OR + (size_t)m * RW + c0), of); unpack8(ld16(OR + ((size_t)MX + m) * RW + c0), ob);
            float sm = 0.f;
#pragma unroll
            for (int e = 0; e < 8; ++e) { o[e] = of[e] + ob[e]; sm += o[e]; }
            sm = sum8(sm);
            const float mean = sm * (1.f / 64.f); float sq = 0.f;
#pragma unroll
            for (int e = 0; e < 8; ++e) { o[e] -= mean; sq += o[e] * o[e]; }
            sq = sum8(sq);
            const float rstd = rsqrtf(sq * (1.f / 64.f) + GN_EPS);
            float lw[8], lb[8], r[8], k[8], v[8], a0[8], a1[8], ka[8], rk[8], gg[8];
            ldf8(a.in[I_LNW] + c0, lw); ldf8(a.in[I_LNB] + c0, lb); ldf8(a.in[I_KA] + c0, ka); ldf8(a.in[I_RK] + c0, rk);
            unpack8(ld16(R + (size_t)m * RW + c0), r); unpack8(ld16(K + (size_t)m * RW + c0), k); unpack8(ld16(V + (size_t)m * RW + c0), v);
            unpack8(ld16(LR + (size_t)m * NLR + 4096 + c0), a0); unpack8(ld16(LR + (size_t)m * NLR + 6144 + c0), a1); unpack8(ld16(LR + (size_t)m * NLR + 8192 + c0), gg);
            float bs = 0.f;
#pragma unroll
            for (int e = 0; e < 8; ++e) { const float kd = k[e] * (2.f + (a0[e] + a1[e] - 2.f) * ka[e]); bs += r[e] * kd * rk[e]; }
            bs = sum8(bs);
#pragma unroll
            for (int e = 0; e < 8; ++e) res[e] = (o[e] * rstd * lw[e] + lb[e] + bs * v[e]) * gg[e];
#endif
            st16(A2 + (size_t)m * DM + c0, pack8(res));
        }
#pragma unroll
        for (int i = 0; i < 4; ++i) {
            const int c0 = (lane + 64 * i) * 8;
            float yf[8], yb[8], xs[8], z[8], nw[8], y[8];
#if MK_SKIP_SSD
#pragma unroll
            for (int e = 0; e < 8; ++e) y[e] = 0.f;
#else
            unpack8(ld16(YS + (size_t)m * RW + c0), yf); unpack8(ld16(YS + ((size_t)MX + m) * RW + c0), yb);
            unpack8(ld16(XS + (size_t)m * RW + c0), xs); unpack8(ld16(Z + (size_t)m * RW + c0), z); ldf8(a.in[I_NORMW] + c0, nw);
            const float dsk = a.in[I_SSMD][c0 >> 6]; float ss = 0.f;
#pragma unroll
            for (int e = 0; e < 8; ++e) { y[e] = (yf[e] + yb[e] + dsk * xs[e]) * (z[e] / (1.f + __expf(-z[e]))); ss += y[e] * y[e]; }
            ss = sum32(ss);
            const float rstd = rsqrtf(ss * (1.f / 256.f) + RMS_EPS);
#pragma unroll
            for (int e = 0; e < 8; ++e) y[e] = y[e] * rstd * nw[e];
#endif
            st16(A2 + (size_t)m * DM + 2048 + c0, pack8(y));
        }
    }
}

__device__ __forceinline__ float enc_key(float v, int idx) { return __uint_as_float((__float_as_uint(v) & 0xffffff00u) | (unsigned)idx); }
typedef float f32x32_t __attribute__((ext_vector_type(32)));
typedef unsigned u32x6_t __attribute__((ext_vector_type(6)));
struct Fp6Row { uint4 q0, q1, q2; };
__device__ __forceinline__ Fp6Row ld_fp6row(const unsigned char* p) { Fp6Row r; r.q0 = *(const uint4*)p; r.q1 = *(const uint4*)(p + 16); r.q2 = *(const uint4*)(p + 32); return r; }
__device__ __forceinline__ f32x32_t fp6_unpack(const Fp6Row& r, int p, float one) {
    u32x6_t s; if (p == 0) { s[0] = r.q0.x; s[1] = r.q0.y; s[2] = r.q0.z; s[3] = r.q0.w; s[4] = r.q1.x; s[5] = r.q1.y; } else { s[0] = r.q1.z; s[1] = r.q1.w; s[2] = r.q2.x; s[3] = r.q2.y; s[4] = r.q2.z; s[5] = r.q2.w; }
    return __builtin_amdgcn_cvt_scalef32_pk32_f32_fp6(s, one);
}
#define PIN4(a) asm volatile("" : "+v"((a)[0]), "+v"((a)[1]), "+v"((a)[2]), "+v"((a)[3]))
__device__ __forceinline__ void ph_peer(const Args& a, float* outp) {
    const int lane = LANE;
    const float* mod = (const float*)(a.ws + WS_MOD); const float* S = (const float*)(a.ws + WS_S);
    const unsigned char* U8 = (const unsigned char*)(a.ws + WS_U8); const unsigned char* V8 = (const unsigned char*)(a.ws + WS_V8);
    const float* USC = (const float*)(a.ws + WS_USC); const float* VSC = (const float*)(a.ws + WS_VSC);
    for (int m = GW; m < MX; m += NGW) {
        const int bb = m / SEQ;
        float* hrow = a.out + (size_t)m * DM;
        int l4 = lane * 4; asm volatile("" : "+v"(l4));
        float acc[16][4];
#if MK_SKIP_PEER
#pragma unroll
        for (int j = 0; j < 16; ++j)
#pragma unroll
            for (int e = 0; e < 4; ++e) acc[j][e] = 0.f;
#else
        float xn[16][4];
        { float ss = 0.f;
#pragma unroll
          for (int j = 0; j < 16; ++j) { const float4 h4 = *(const float4*)(hrow + 256 * j + l4); xn[j][0] = h4.x; xn[j][1] = h4.y; xn[j][2] = h4.z; xn[j][3] = h4.w; ss += (h4.x * h4.x + h4.y * h4.y) + (h4.z * h4.z + h4.w * h4.w); }
          const float rstd = rsqrtf(wave_sum(ss) * (1.f / DM) + RMS_EPS);
          const float* sh2 = mod + (size_t)bb * NMOD + 3 * DM; const float* sc2 = mod + (size_t)bb * NMOD + 4 * DM; const float* g2 = a.in[I_N2G];
#pragma unroll
          for (int j = 0; j < 16; ++j) { const int c = 256 * j + l4; const float4 gg = *(const float4*)(g2 + c), s0 = *(const float4*)(sh2 + c), s1 = *(const float4*)(sc2 + c);
              xn[j][0] = xn[j][0] * rstd * gg.x * (1.f + s1.x) + s0.x; xn[j][1] = xn[j][1] * rstd * gg.y * (1.f + s1.y) + s0.y; xn[j][2] = xn[j][2] * rstd * gg.z * (1.f + s1.z) + s0.z; xn[j][3] = xn[j][3] * rstd * gg.w * (1.f + s1.w) + s0.w;
              if ((j & 3) == 3) { PIN4(xn[j - 3]); PIN4(xn[j - 2]); PIN4(xn[j - 1]); PIN4(xn[j]); asm volatile("" ::: "memory"); } } }
        int eid0 = 0, eid1 = 0; float gt0 = 0.f, gt1 = 0.f;
        const float NEG = -3.0e38f;
#pragma unroll 1
        for (int hd = 0; hd < 8; ++hd) {
            const float* srow = S + (size_t)m * 2048 + hd * 256;
            float c1a = enc_key(srow[lane], lane), c1b = enc_key(srow[64 + lane], 64 + lane), c2a = enc_key(srow[128 + lane], lane), c2b = enc_key(srow[192 + lane], 64 + lane);
            float t1 = NEG, t2 = NEG;
#pragma unroll 1
            for (int k = 0; k < 16; ++k) {
                const float m1 = wave_max(fmaxf(c1a, c1b)), m2 = wave_max(fmaxf(c2a, c2b));
                if (c1a == m1) c1a = NEG; if (c1b == m1) c1b = NEG; if (c2a == m2) c2a = NEG; if (c2b == m2) c2b = NEG;
                if (lane == k) { t1 = m1; t2 = m2; }
            }
            const float v1 = __uint_as_float(__float_as_uint(t1) & 0xffffff00u), v2 = __uint_as_float(__float_as_uint(t2) & 0xffffff00u);
            const int i1 = (int)(__float_as_uint(t1) & 0xffu), i2 = (int)(__float_as_uint(t2) & 0xffu);
            float cd[4];
#pragma unroll
            for (int e = 0; e < 4; ++e) { const float va = __shfl(v1, (lane >> 4) + 4 * e), vb = __shfl(v2, lane & 15); cd[e] = enc_key(va + vb, lane + 64 * e); }
            float best = NEG; int ex = 0;
#pragma unroll 1
            for (int k = 0; k < 16; ++k) {
                const float mx = wave_max(fmaxf(fmaxf(cd[0], cd[1]), fmaxf(cd[2], cd[3])));
#pragma unroll
                for (int e = 0; e < 4; ++e) if (cd[e] == mx) cd[e] = NEG;
                const int cidx = (int)(__float_as_uint(mx) & 0xffu);
                const int ea = __shfl(i1, cidx >> 4), eb = __shfl(i2, cidx & 15);
                if (lane == k) { best = __uint_as_float(__float_as_uint(mx) & 0xffffff00u); ex = ea * 128 + eb; }
            }
            const float bmax = __shfl(best, 0);
            const float pe = lane < 16 ? __expf(best - bmax) : 0.f;
            const float gate = pe / wave_sum(pe);
            const float gsh = __shfl(gate, lane & 15); const int esh = __shfl(ex, lane & 15);
            if ((lane >> 4) == (hd & 3)) { if (hd < 4) { gt0 = gsh; eid0 = esh; } else { gt1 = gsh; eid1 = esh; } }
        }
        const int l48 = lane * 48;
        float cf0 = 0.f, cf1 = 0.f;
        {
            Fp6Row qa[4], qb[4];
#pragma unroll
            for (int q = 0; q < 4; ++q) { const int e = __builtin_amdgcn_readlane(eid0, q); qa[q] = ld_fp6row(U8 + (size_t)e * 3072 + l48); }
#pragma unroll 1
            for (int p0 = 0; p0 < 128; p0 += 8) {
#pragma unroll
                for (int half = 0; half < 2; ++half) {
                    const int pb = p0 + 4 * half;
                    float d[4];
#pragma unroll
                    for (int q = 0; q < 4; ++q) {
                        if (q == 2 && pb + 4 < 128) { asm volatile("" ::: "memory");
#pragma unroll
                            for (int q2 = 0; q2 < 4; ++q2) { const int e = __builtin_amdgcn_readlane(pb + 4 < 64 ? eid0 : eid1, (pb + 4 + q2) & 63); const Fp6Row t = ld_fp6row(U8 + (size_t)e * 3072 + l48); if (half) qa[q2] = t; else qb[q2] = t; }
                        }
                        float dd = 0.f;
#pragma unroll
                        for (int p = 0; p < 2; ++p) { float one = 1.0f; asm volatile("" : "+v"(one)); const f32x32_t f = fp6_unpack(half ? qb[q] : qa[q], p, one);
#pragma unroll
                            for (int t = 0; t < 32; ++t) dd += xn[8 * p + (t >> 2)][t & 3] * f[t];
                            asm volatile("" : "+v"(dd)); }
                        d[q] = dd;
                    }
#pragma unroll
                    for (int q = 0; q < 4; ++q) {
                        const int p = pb + q; const int e = __builtin_amdgcn_readlane(pb < 64 ? eid0 : eid1, p & 63);
                        const float dot = wave_sum(d[q]) * USC[e];
                        const float act = 0.5f * dot * (1.f + erff(dot * 0.70710678f)) * VSC[e];
                        if (lane == (p & 63)) { if (pb < 64) cf0 = gt0 * act; else cf1 = gt1 * act; }
                    }
                }
            }
        }
#pragma unroll
        for (int j = 0; j < 16; ++j)
#pragma unroll
            for (int e = 0; e < 4; ++e) acc[j][e] = 0.f;
        {
            Fp6Row qa[4], qb[4];
#pragma unroll
            for (int q = 0; q < 4; ++q) { const int e = __builtin_amdgcn_readlane(eid0, q); qa[q] = ld_fp6row(V8 + (size_t)e * 3072 + l48); }
#pragma unroll 1
            for (int p0 = 0; p0 < 128; p0 += 8) {
#pragma unroll
                for (int half = 0; half < 2; ++half) {
                    const int pb = p0 + 4 * half;
                    float cfv[4];
#pragma unroll
                    for (int q = 0; q < 4; ++q) cfv[q] = rlane(pb < 64 ? cf0 : cf1, (pb + q) & 63);
#pragma unroll
                    for (int q = 0; q < 4; ++q) {
                        if (q == 2 && pb + 4 < 128) { asm volatile("" ::: "memory");
#pragma unroll
                            for (int q2 = 0; q2 < 4; ++q2) { const int e = __builtin_amdgcn_readlane(pb + 4 < 64 ? eid0 : eid1, (pb + 4 + q2) & 63); const Fp6Row t = ld_fp6row(V8 + (size_t)e * 3072 + l48); if (half) qa[q2] = t; else qb[q2] = t; }
                        }
#pragma unroll
                        for (int p = 0; p < 2; ++p) { float one = 1.0f; asm volatile("" : "+v"(one)); const f32x32_t f = fp6_unpack(half ? qb[q] : qa[q], p, one);
#pragma unroll
                            for (int t = 0; t < 32; ++t) acc[8 * p + (t >> 2)][t & 3] += cfv[q] * f[t];
#pragma unroll
                            for (int jj = 0; jj < 8; ++jj) PIN4(acc[8 * p + jj]); }
                    }
                }
            }
        }
#endif
        { const float* gt2 = mod + (size_t)bb * NMOD + 5 * DM; float ss = 0.f;
          int l4 = lane * 4; asm volatile("" : "+v"(l4));
#pragma unroll
          for (int j = 0; j < 16; ++j) { const int c = 256 * j + l4; const float4 g = *(const float4*)(gt2 + c), h4 = *(const float4*)(hrow + c);
              acc[j][0] = h4.x + g.x * acc[j][0]; acc[j][1] = h4.y + g.y * acc[j][1]; acc[j][2] = h4.z + g.z * acc[j][2]; acc[j][3] = h4.w + g.w * acc[j][3];
              ss += (acc[j][0] * acc[j][0] + acc[j][1] * acc[j][1]) + (acc[j][2] * acc[j][2] + acc[j][3] * acc[j][3]);
              if ((j & 3) == 3) { PIN4(acc[j - 3]); PIN4(acc[j - 2]); PIN4(acc[j - 1]); PIN4(acc[j]); asm volatile("" ::: "memory"); } }
          const float rstd = rsqrtf(wave_sum(ss) * (1.f / DM) + RMS_EPS);
#pragma unroll
          for (int j = 0; j < 16; ++j) { const int c = 256 * j + l4; const float4 fg = *(const float4*)(a.in[I_FG] + c);
              *(float4*)(outp + (size_t)m * DM + c) = make_float4(acc[j][0] * rstd * fg.x, acc[j][1] * rstd * fg.y, acc[j][2] * rstd * fg.z, acc[j][3] * rstd * fg.w);
              if ((j & 3) == 3) asm volatile("" ::: "memory"); } }
    }
}

constexpr int N_PHASES = 13;
__global__ void __launch_bounds__(512, 2) hybrid_fwd(Args args) {
    extern __shared__ __attribute__((aligned(16))) unsigned char lds_raw[];
    LAS unsigned char* lds = (LAS unsigned char*)lds_raw;
    volatile LAS unsigned* MISC = (volatile LAS unsigned*)(lds + LDS_MISC);
    for (int u = TID; u < (LDS_BYTES - LDS_CTL) / 4; u += 512) ((LAS unsigned*)(lds + LDS_CTL))[u] = 0u;
    __syncthreads();
    const int lo = args.ph_lo, hi = args.ph_hi;
    XcdBarrier bar; bar.bar = (unsigned*)(args.ws + WS_CTL); bar.x = 0; bar.st = nullptr;
    if (hi - lo > 1) bar = xcd_barrier_post((unsigned*)(args.ws + WS_CTL), MISC + 8);
#define IN(k) (lo <= (k) && (k) < hi && ((MK_PHASE_MASK >> (k)) & 1))
#define SEAM(k) do { if (IN(k) && IN((k) + 1)) xcd_barrier(bar); } while (0)
    const int bid = (int)blockIdx.x, G = (int)gridDim.x;

    if (IN(0)) { ph_mod(args, lds); ph_conv(args, lds); if (MK_REPEAT == 0) { ph_mod(args, lds); ph_conv(args, lds); } }
    SEAM(0);
    if (IN(1)) { ph_norm1(args); if (MK_REPEAT == 1) ph_norm1(args); }
    SEAM(1);
    if (IN(2)) { pg8::Gemm g{(const bf16*)(args.ws + WS_A1), (const bf16*)(args.ws + WS_WT_IN), MT, NINP, DM, DM, DM, 0, 0}; pg8::StaticOrder S; S.init(MT, NINP, G, bid);
        pg8::EpiBf16<0> E{(bf16*)(args.ws + WS_P), NINP, nullptr, 0, 0}; pg8::gemm_phase<pg8::EpiBf16<0>, pg8::StaticOrder>(lds, g, S, E, nullptr); }
    SEAM(2);
    if (IN(3)) { ph_prep_rwkv(args); ph_prep_ssd(args); if (MK_REPEAT == 3) { ph_prep_rwkv(args); ph_prep_ssd(args); } }
    SEAM(3);
    if (IN(4)) { int kw = KLRW; asm volatile("" : "+s"(kw));
        pg8::Gemm g{(const bf16*)(args.ws + WS_ALR), (const bf16*)(args.ws + WS_WLR), MT, NLR, kw, KLR, KLRW, 4, 256}; pg8::StaticOrder S; S.init(MT, NLR, G, bid);
        EpiLR E{(bf16*)(args.ws + WS_LR), args.in[I_W0], args.in[I_A0]}; pg8::gemm_phase<EpiLR, pg8::StaticOrder>(lds, g, S, E, nullptr); }
    SEAM(4);
#if MK_RWKV_SEQ
    if (IN(5)) { ph_rwkv_scan(args); if (MK_REPEAT == 5) ph_rwkv_scan(args); }
#else
    if (IN(5)) {
#if MK_RWKV_LDS
        ph_rwkv_scan2(args, lds); if (MK_REPEAT == 5) ph_rwkv_scan2(args, lds);
#else
        ph_rwkv_chunked(args, lds); if (MK_REPEAT == 5) ph_rwkv_chunked(args, lds);
#endif
    }
#endif
    SEAM(5);
#if MK_SSD_SEQ
    if (IN(6)) { ph_ssd_scan(args); if (MK_REPEAT == 6) ph_ssd_scan(args); }
#else
    if (IN(6)) { ph_ssd_chunked(args, lds); if (MK_REPEAT == 6) ph_ssd_chunked(args, lds); }
#endif
    SEAM(6);
    if (IN(7)) { ph_finish(args); if (MK_REPEAT == 7) ph_finish(args); }
    SEAM(7);
    if (IN(8)) { pg8::Gemm g{(const bf16*)(args.ws + WS_A2), (const bf16*)(args.ws + WS_WT_OUT), MX, DM, DM, DM, DM, 0, 0}; pg8::StaticOrder S; S.init(MX, DM, G, bid);
        EpiRes E{args.out, args.in[I_X], (const float*)(args.ws + WS_MOD)}; pg8::gemm_phase<EpiRes, pg8::StaticOrder>(lds, g, S, E, nullptr); }
    SEAM(8);
    if (IN(9)) { ph_norm2(args); if (MK_REPEAT == 9) ph_norm2(args); }
    SEAM(9);
    if (IN(10)) { pg8::Gemm g{(const bf16*)(args.ws + WS_XN2), (const bf16*)(args.ws + WS_WT_Q), MX, 2048, DM, DM, DM, 0, 0}; pg8::StaticOrder S; S.init(MX, 2048, G, bid);
        pg8::EpiBf16<0> E{(bf16*)(args.ws + WS_Q), 2048, nullptr, 0, 0}; pg8::gemm_phase<pg8::EpiBf16<0>, pg8::StaticOrder>(lds, g, S, E, nullptr); }
    SEAM(10);
    if (IN(11)) { int kw = 256; asm volatile("" : "+s"(kw));
        pg8::Gemm g{(const bf16*)(args.ws + WS_Q), (const bf16*)(args.ws + WS_KBD), MX, 2048, kw, 2048, 256, 0, 256}; pg8::StaticOrder S; S.init(MX, 2048, G, bid);
        pg8::EpiF32 E{(float*)(args.ws + WS_S), 2048, nullptr}; pg8::gemm_phase<pg8::EpiF32, pg8::StaticOrder>(lds, g, S, E, nullptr); }
    SEAM(11);
    if (IN(12)) { if (MK_REPEAT == 12) ph_peer(args, (float*)(args.ws + 903 * MiB)); ph_peer(args, args.out); }
#undef IN
#undef SEAM
}

extern "C" void kernel_launch(void* const* d_in, const int* in_sizes, int n_in, void* d_out, int out_size, void* d_ws, size_t ws_size, hipStream_t stream) {
    static int grid = 0;
    if (grid == 0) {
        if (n_in != N_IN || out_size != MX * DM || ws_size < WS_END) { fprintf(stderr, "kernel_launch: unexpected shapes (n_in %d out %d ws %zu)\n", n_in, out_size, ws_size); grid = -1; return; }
        int dev = 0, cus = 0, per_cu = 0;
        if (hipGetDevice(&dev) != hipSuccess || hipDeviceGetAttribute(&cus, hipDeviceAttributeMultiprocessorCount, dev) != hipSuccess) { grid = -1; return; }
        if (hipFuncSetAttribute((const void*)hybrid_fwd, hipFuncAttributeMaxDynamicSharedMemorySize, LDS_BYTES) != hipSuccess) { fprintf(stderr, "kernel_launch: hipFuncSetAttribute failed\n"); grid = -1; return; }
        if (hipOccupancyMaxActiveBlocksPerMultiprocessor(&per_cu, (const void*)hybrid_fwd, 512, LDS_BYTES) != hipSuccess || per_cu < 1) fprintf(stderr, "kernel_launch: occupancy query reports %d\n", per_cu);
        (void)hipGetLastError();
        grid = cus;
    }
    if (grid < 0) return;
    (void)in_sizes;
    if (hipMemsetAsync((char*)d_ws + WS_CTL, 0, CTL_ZERO_BYTES, stream) != hipSuccess) return;
    Args a{};
    for (int i = 0; i < N_IN; ++i) a.in[i] = (const float*)d_in[i];
    a.out = (float*)d_out; a.ws = (unsigned char*)d_ws;
#if MK_N_LAUNCHES == 1
    a.ph_lo = 0; a.ph_hi = N_PHASES;
    hipLaunchKernelGGL(hybrid_fwd, dim3(grid), dim3(512), LDS_BYTES, stream, a);
#else
    for (int ph = 0; ph < N_PHASES; ++ph) { if (!((MK_PHASE_MASK >> ph) & 1)) continue; a.ph_lo = ph; a.ph_hi = ph + 1; hipLaunchKernelGGL(hybrid_fwd, dim3(grid), dim3(512), LDS_BYTES, stream, a); }
#endif
}
```

```cpp
#include <hip/hip_runtime.h>
#include <stdint.h>
#include <stdio.h>
namespace pg8 {
#define PG8_LAS __attribute__((address_space(3)))
typedef unsigned short bf16_t;
typedef short bf16x8 __attribute__((ext_vector_type(8)));
typedef float f32x4 __attribute__((ext_vector_type(4)));
typedef unsigned u32x4 __attribute__((ext_vector_type(4)));
constexpr int BM = 256, BK = 64, HALF = 128, HTB = HALF * BK * 2  , STAGE_BYTES = 8 * HTB, NXCD = 8, WGM = 8;

__host__ __device__ __forceinline__ int lds_byte(int r, int c) { const int st = (r >> 4) * 2 + (c >> 5), rr = r & 15, cc = c & 31, ob = rr * 64 + cc * 2; return st * 1024 + (ob ^ (((ob >> 9) & 1) << 5)); }
__host__ __device__ __forceinline__ void stage_rc(int b, int& R, int& C) { const int st = b / 1024, sb = b % 1024, swz = sb ^ (((sb >> 9) & 1) << 5); R = (st >> 1) * 16 + swz / 64; C = (st & 1) * 32 + (swz % 64) / 2; }
__host__ __device__ __forceinline__ int perm32(int rho) { const int n = rho >> 4, i = rho & 15; return 8 * (i >> 2) + 4 * n + (i & 3); }

struct Unit { int pm, pn; };
struct Gemm { const bf16_t* A; const bf16_t* Bt; int M, N, K; int lda, ldb, kshift, kmul; };

struct StaticOrder {
    int nM, nN, nwg, G, c;
    __host__ __device__ void init(int M, int N, int G_, int c_) { nM = M / BM; nN = N / BM; nwg = nM * nN; G = G_; c = c_; }
    __host__ __device__ bool next(int i, Unit& u) const {
        const long L = (long)i * G + c; if (L >= nwg) return false;
        int wgid = (int)L; { const int q = nwg / NXCD, r = nwg % NXCD, xcd = wgid % NXCD, off = wgid / NXCD; wgid = (xcd < r ? xcd * (q + 1) : r * (q + 1) + (xcd - r) * q) + off; }
        const int nig = WGM * nN, gid = wgid / nig, fm = gid * WGM, gsz = (nM - fm) < WGM ? (nM - fm) : WGM;
        u.pm = fm + ((wgid % nig) % gsz); u.pn = (wgid % nig) / gsz; return true;
    }
    __device__ __forceinline__ void a_ready(const Unit&) const {}
    __device__ __forceinline__ void done(const Unit&) const {}
};
__device__ __forceinline__ unsigned cvt_pk_bf16(float lo, float hi) { unsigned r; asm volatile("v_cvt_pk_bf16_f32 %0, %1, %2" : "=v"(r) : "v"(lo), "v"(hi)); return r; }
typedef float f32x2 __attribute__((ext_vector_type(2)));
__device__ __forceinline__ f32x2 gelu_pk(f32x2 v) {
    const f32x2 av = __builtin_elementwise_abs(v), d = av * 0.2316418882f + 1.0f;
    f32x2 t; t.x = __builtin_amdgcn_rcpf(d.x); t.y = __builtin_amdgcn_rcpf(d.y);
    f32x2 q = t * 0.5307027145f + (-0.7265760135f); q = q * t + 0.7107068705f; q = q * t + (-0.142248368f); q = q * t + 0.127414796f; q = q * t;
    const f32x2 s = (v * v) * (-0.72134752044f);
    f32x2 e; e.x = __builtin_amdgcn_exp2f(s.x); e.y = __builtin_amdgcn_exp2f(s.y);
    const f32x2 m = v * (q * e), r = v - m;
    f32x2 o; o.x = v.x < 0.f ? m.x : r.x; o.y = v.y < 0.f ? m.y : r.y; return o;
}

struct EpiF32 {
    static constexpr bool PERM = false, AFTER_DRAIN = false;
    float* C; int ldc; const float* bias;
    __device__ __forceinline__ void operator()(const f32x4 (&acc)[2][2][4][2], const Unit& u, int wr, int wc, int fr, int fq) const {
        const int row0 = u.pm * BM + wr * 64 + fr, col0 = u.pn * BM + wc * 32 + 4 * fq;
        f32x4 bv[2][2];
#pragma unroll
        for (int bj = 0; bj < 2; ++bj)
#pragma unroll
            for (int n = 0; n < 2; ++n) bv[bj][n] = bias ? *(const f32x4*)(bias + col0 + bj * HALF + n * 16) : (f32x4){0.f, 0.f, 0.f, 0.f};
#pragma unroll
        for (int ai = 0; ai < 2; ++ai)
#pragma unroll
            for (int m = 0; m < 4; ++m) { float* rowp = C + (size_t)(row0 + ai * HALF + m * 16) * ldc + col0;
#pragma unroll
                for (int bj = 0; bj < 2; ++bj)
#pragma unroll
                    for (int n = 0; n < 2; ++n) *(f32x4*)(rowp + bj * HALF + n * 16) = acc[ai][bj][m][n] + bv[bj][n]; }
    }
};
template <int ACT  > struct EpiBf16 {
    static constexpr bool PERM = true, AFTER_DRAIN = false;
    bf16_t* O; int ldc; const float* bias; int split_cols; size_t split_stride;
    __device__ __forceinline__ void operator()(const f32x4 (&acc)[2][2][4][2], const Unit& u, int wr, int wc, int fr, int fq) const {
        const int row0 = u.pm * BM + wr * 64 + fr; int colt = u.pn * BM; bf16_t* base = O;
        if (split_cols) { const int t = colt / split_cols; base += (size_t)t * split_stride; colt -= t * split_cols; }
        const int col0 = colt + wc * 32 + 8 * fq, bcol0 = u.pn * BM + wc * 32 + 8 * fq;
        f32x4 bv[2][2];
#pragma unroll
        for (int bj = 0; bj < 2; ++bj)
#pragma unroll
            for (int n = 0; n < 2; ++n) bv[bj][n] = bias ? *(const f32x4*)(bias + bcol0 + bj * HALF + 4 * n) : (f32x4){0.f, 0.f, 0.f, 0.f};
#pragma unroll
        for (int ai = 0; ai < 2; ++ai)
#pragma unroll
            for (int m = 0; m < 4; ++m) { bf16_t* rowp = base + (size_t)(row0 + ai * HALF + m * 16) * ldc + col0;
#pragma unroll
                for (int bj = 0; bj < 2; ++bj) { f32x4 v0 = acc[ai][bj][m][0] + bv[bj][0], v1 = acc[ai][bj][m][1] + bv[bj][1];
                    if (ACT == 1) { f32x2 a = gelu_pk((f32x2){v0[0], v0[1]}), b = gelu_pk((f32x2){v0[2], v0[3]}), c = gelu_pk((f32x2){v1[0], v1[1]}), d = gelu_pk((f32x2){v1[2], v1[3]});
                        v0 = (f32x4){a.x, a.y, b.x, b.y}; v1 = (f32x4){c.x, c.y, d.x, d.y}; }
                    if (ACT == 2) {
#pragma unroll
                        for (int j = 0; j < 4; ++j) { v0[j] = 0.5f * v0[j] * (1.0f + erff(v0[j] * 0.70710678f)); v1[j] = 0.5f * v1[j] * (1.0f + erff(v1[j] * 0.70710678f)); } }
                    u32x4 w; w.x = cvt_pk_bf16(v0[0], v0[1]); w.y = cvt_pk_bf16(v0[2], v0[3]); w.z = cvt_pk_bf16(v1[0], v1[1]); w.w = cvt_pk_bf16(v1[2], v1[3]);
                    *(u32x4*)(rowp + bj * HALF) = w; } }
    }
};
template <class Epi, class Sched, bool STAMP = false>
__device__ __forceinline__ void gemm_phase(PG8_LAS unsigned char* lds, const Gemm g, const Sched& S, const Epi& E, unsigned long long* stamps) {
    const int tid = threadIdx.x, wid = __builtin_amdgcn_readfirstlane(tid >> 6), lane = tid & 63, wr = wid >> 2, wc = wid & 3, fr = lane & 15, fq = lane >> 4;
    const int K = g.K, nt = K / BK;
    int ts_lo = 0, ts_hi = 0, nts = 0; const unsigned long long rt_entry = STAMP ? (unsigned long long)wall_clock64() : 0ull;
#define PG8_STAMP() do { if (STAMP && wid == 0 && nts < 64) { const unsigned long long _c = (unsigned long long)clock64(); \
        ts_lo = (lane == nts) ? (int)(unsigned)_c : ts_lo; ts_hi = (lane == nts) ? (int)(unsigned)(_c >> 32) : ts_hi; ++nts; } } while (0)
    PG8_STAMP();
    unsigned voffA[2], voffB[2];
#pragma unroll
    for (int i = 0; i < 2; ++i) { int R, C; stage_rc(tid * 16 + i * 8192, R, C); const int Rb = Epi::PERM ? ((R & ~31) + perm32(R & 31)) : R;
        voffA[i] = (unsigned)(R * g.lda + C) * 2u; voffB[i] = (unsigned)(Rb * g.ldb + C) * 2u; }
    const size_t kstep = (size_t)(BK * 2);
    const size_t hstepA = (size_t)HALF * g.lda * 2, hstepB = (size_t)HALF * g.ldb * 2;
    const size_t tstepA = 2 * hstepA, tstepB = 2 * hstepB;
    const unsigned ldsw = (unsigned)wid * 1024u;
    const int aoff = lds_byte(wr * 64 + fr, fq * 8), boff = lds_byte(wc * 32 + fr, fq * 8);
#define PG8_SA(b, h) (((b) * 2 + (h)) * HTB)
#define PG8_SB(b, h) ((4 + (b) * 2 + (h)) * HTB)
#define PG8_STAGE(bufoff, gbase, voff) do { _Pragma("unroll") for (int _i = 0; _i < 2; ++_i) \
        __builtin_amdgcn_global_load_lds((const unsigned*)((const char*)(gbase) + (voff)[_i]), (PG8_LAS unsigned*)(lds + (bufoff) + ldsw + _i * 8192), 16, 0, 0); } while (0)
#define PG8_LDA(dst, b, h) do { _Pragma("unroll") for (int m = 0; m < 4; ++m) _Pragma("unroll") for (int k = 0; k < 2; ++k) dst[m][k] = *(const PG8_LAS bf16x8*)(lds + PG8_SA(b, h) + aoff + m * 2048 + k * 1024); } while (0)
#define PG8_LDB(dst, b, h) do { _Pragma("unroll") for (int n = 0; n < 2; ++n) _Pragma("unroll") for (int k = 0; k < 2; ++k) dst[n][k] = *(const PG8_LAS bf16x8*)(lds + PG8_SB(b, h) + boff + n * 2048 + k * 1024); } while (0)
#define PG8_MMA(ai, bj, At, Bt) do { __builtin_amdgcn_s_setprio(1); _Pragma("unroll") for (int m = 0; m < 4; ++m) _Pragma("unroll") for (int n = 0; n < 2; ++n) _Pragma("unroll") for (int k = 0; k < 2; ++k) \
        acc[ai][bj][m][n] = __builtin_amdgcn_mfma_f32_16x16x32_bf16(Bt[n][k], At[m][k], acc[ai][bj][m][n], 0, 0, 0); __builtin_amdgcn_s_setprio(0); } while (0)
#define PG8_WAIT_V(n) asm volatile("s_waitcnt vmcnt(" #n ")" ::: "memory")
#define PG8_WAIT_L(n) asm volatile("s_waitcnt lgkmcnt(" #n ")" ::: "memory")
#define PG8_BAR __builtin_amdgcn_s_barrier()
#define PG8_SCHED __builtin_amdgcn_sched_barrier(0)
    Unit cur, nxt; int ui = 0;
    if (!S.next(0, cur)) return;
    f32x4 acc[2][2][4][2];
#pragma unroll
    for (int a = 0; a < 2; ++a)
#pragma unroll
        for (int b = 0; b < 2; ++b)
#pragma unroll
            for (int m = 0; m < 4; ++m)
#pragma unroll
                for (int n = 0; n < 2; ++n) acc[a][b][m][n] = (f32x4){0.f, 0.f, 0.f, 0.f};
    bf16x8 At[4][2], B0[2][2], B1[2][2];
    const char* cA = (const char*)g.A + (size_t)cur.pm * tstepA + (size_t)((cur.pn >> g.kshift) * g.kmul) * 2; const char* cB = (const char*)g.Bt + (size_t)cur.pn * tstepB;
    S.a_ready(cur);
    PG8_STAGE(PG8_SB(0, 0), cB, voffB); PG8_STAGE(PG8_SA(0, 0), cA, voffA); PG8_STAGE(PG8_SB(0, 1), cB + hstepB, voffB); PG8_STAGE(PG8_SA(0, 1), cA + hstepA, voffA);
    if (wr == 1) PG8_BAR;
    PG8_WAIT_V(4); PG8_BAR;
    PG8_STAGE(PG8_SB(1, 0), cB + kstep, voffB); PG8_STAGE(PG8_SA(1, 0), cA + kstep, voffA); PG8_STAGE(PG8_SB(1, 1), cB + hstepB + kstep, voffB);
    PG8_WAIT_V(6); PG8_BAR;
    PG8_STAMP();
    for (;;) {
        const bool has_next = S.next(ui + 1, nxt);
        const char* nA = has_next ? (const char*)g.A + (size_t)nxt.pm * tstepA + (size_t)((nxt.pn >> g.kshift) * g.kmul) * 2 : cA; const char* nB = has_next ? (const char*)g.Bt + (size_t)nxt.pn * tstepB : cB;
        for (int t = 0; t < nt; t += 2) {
            const bool last = (t == nt - 2);
            const char* a1 = cA + (size_t)(t + 1) * kstep;
            const char* a2 = last ? nA : cA + (size_t)(t + 2) * kstep; const char* b2 = last ? nB : cB + (size_t)(t + 2) * kstep;
            const char* a3 = a2 + kstep; const char* b3 = b2 + kstep;
            if (last && has_next) S.a_ready(nxt);
            PG8_LDB(B0, 0, 0); PG8_SCHED; PG8_LDA(At, 0, 0); PG8_STAGE(PG8_SA(1, 1), a1 + hstepA, voffA);
            PG8_WAIT_L(8); PG8_BAR; PG8_WAIT_L(0); PG8_MMA(0, 0, At, B0); PG8_BAR; PG8_SCHED;
            PG8_LDB(B1, 0, 1); PG8_STAGE(PG8_SB(0, 0), b2, voffB);
            PG8_BAR; PG8_WAIT_L(0); PG8_MMA(0, 1, At, B1); PG8_BAR;
            PG8_LDA(At, 0, 1); PG8_STAGE(PG8_SA(0, 0), a2, voffA);
            PG8_BAR; PG8_WAIT_L(0); PG8_MMA(1, 0, At, B0); PG8_BAR; PG8_SCHED;
            PG8_STAGE(PG8_SB(0, 1), b2 + hstepB, voffB);
            PG8_WAIT_V(6); PG8_BAR; PG8_MMA(1, 1, At, B1); PG8_BAR;
            PG8_LDB(B0, 1, 0); PG8_SCHED; PG8_LDA(At, 1, 0); PG8_STAGE(PG8_SA(0, 1), a2 + hstepA, voffA);
            PG8_WAIT_L(8); PG8_BAR; PG8_WAIT_L(0); PG8_MMA(0, 0, At, B0); PG8_BAR; PG8_SCHED;
            PG8_LDB(B1, 1, 1); PG8_STAGE(PG8_SB(1, 0), b3, voffB);
            PG8_BAR; PG8_WAIT_L(0); PG8_MMA(0, 1, At, B1); PG8_BAR;
            PG8_LDA(At, 1, 1); PG8_STAGE(PG8_SA(1, 0), a3, voffA);
            PG8_BAR; PG8_WAIT_L(0); PG8_MMA(1, 0, At, B0); PG8_BAR; PG8_SCHED;
            PG8_STAGE(PG8_SB(1, 1), b3 + hstepB, voffB);
            PG8_WAIT_V(6); PG8_BAR; PG8_MMA(1, 1, At, B1); PG8_BAR;
        }
        PG8_STAMP();
        if constexpr (!Epi::AFTER_DRAIN) { E(acc, cur, wr, wc, fr, fq); S.done(cur); }
        PG8_STAMP();
        if (!has_next) break;
#pragma unroll
        for (int a = 0; a < 2; ++a)
#pragma unroll
            for (int b = 0; b < 2; ++b)
#pragma unroll
                for (int m = 0; m < 4; ++m)
#pragma unroll
                    for (int n = 0; n < 2; ++n) acc[a][b][m][n] = (f32x4){0.f, 0.f, 0.f, 0.f};
        cur = nxt; cA = nA; cB = nB; ++ui;
    }
    PG8_WAIT_V(0);
    if (wr == 0) PG8_BAR;
    PG8_BAR;
    if constexpr (Epi::AFTER_DRAIN) { E.fused(acc, cur, wr, wc, fr, fq, lds, wid, lane); S.done(cur); }
    PG8_STAMP();
    if (STAMP && wid == 0) { stamps[lane] = lane < nts ? (((unsigned long long)(unsigned)ts_hi << 32) | (unsigned)ts_lo) : 0ull;
        if (lane == 62) stamps[62] = rt_entry; if (lane == 63) stamps[63] = (unsigned long long)wall_clock64(); }
#undef PG8_STAMP
#undef PG8_SA
#undef PG8_SB
#undef PG8_STAGE
#undef PG8_LDA
#undef PG8_LDB
#undef PG8_MMA
#undef PG8_WAIT_V
#undef PG8_WAIT_L
#undef PG8_BAR
#undef PG8_SCHED
}
}

#define LAS __attribute__((address_space(3)))
typedef unsigned short bf16;
typedef float f32x4 __attribute__((ext_vector_type(4)));

#ifndef MK_N_LAUNCHES
#define MK_N_LAUNCHES 1
#endif
#ifndef MK_PHASE_MASK
#define MK_PHASE_MASK 0x1FFF
#endif
#ifndef MK_REPEAT
#define MK_REPEAT -1
#endif
#ifndef MK_RWKV_LDS
#define MK_RWKV_LDS 0
#endif
#ifndef MK_RWKV_SEQ
#define MK_RWKV_SEQ 0
#endif
#ifndef MK_SSD_SEQ
#define MK_SSD_SEQ 0
#endif
#ifndef MK_SKIP_MIXER
#define MK_SKIP_MIXER 0
#endif
#ifndef MK_SKIP_PEER
#define MK_SKIP_PEER 0
#endif
#ifndef MK_SKIP_RWKV
#define MK_SKIP_RWKV 0
#endif
#ifndef MK_SKIP_SSD
#define MK_SKIP_SSD 0
#endif

constexpr int DM = 4096, NBATCH = 4, SEQ = 4096, CTXL = 256;
constexpr int MX = NBATCH * SEQ;
constexpr int MC = NBATCH * CTXL;
constexpr int MT = MX + MC;
constexpr int RW = 2048;
constexpr int RCOLS = 6784;
constexpr int NIN = 12992, NINP = 13056;
constexpr int COL_Z = 6784, COL_XBC = 8832, COL_DT = 12928;
constexpr int NLR = 10240, KLR = 768, KLRW = 256;
constexpr int NMOD = 6 * DM;
constexpr float RMS_EPS = 1e-6f, GN_EPS = 64e-5f;
constexpr int NSTEP = CTXL + SEQ;

constexpr size_t MiB = (size_t)1 << 20;
constexpr size_t WS_CTL = 0, CTL_ZERO_BYTES = 1 * MiB;
constexpr size_t WS_MOD = 64 * 1024;
constexpr size_t WS_WT_OUT = 2 * MiB;
constexpr size_t WS_WT_Q = 34 * MiB;
constexpr size_t WS_WLR = 50 * MiB;
constexpr size_t WS_KBD = 63 * MiB;
constexpr size_t WS_DT = 71 * MiB;
constexpr size_t WS_LA = WS_DT + (size_t)MT * 64 * 4;
constexpr size_t WS_ALR = 300 * MiB;
constexpr size_t WS_WT_IN = 102 * MiB;
constexpr size_t WS_A1 = 204 * MiB;
constexpr size_t WS_P = 340 * MiB;
constexpr size_t WS_R = 774 * MiB, WS_K = 842 * MiB, WS_V = 910 * MiB, WS_KK = 978 * MiB;
constexpr size_t WS_XS = 1046 * MiB, WS_BC = 1114 * MiB;
constexpr size_t WS_Z = 102 * MiB;
constexpr size_t WS_LR = 340 * MiB;
constexpr size_t WS_A2 = 166 * MiB;
constexpr size_t WS_XN2 = 340 * MiB;
constexpr size_t WS_Q = 468 * MiB;
constexpr size_t WS_S = 532 * MiB;
constexpr size_t WS_U8 = 774 * MiB, WS_V8 = 838 * MiB;
constexpr size_t WS_USC = 902 * MiB, WS_VSC = WS_USC + 65536;
constexpr size_t WS_END = 1182 * MiB;
static_assert(WS_WT_IN + (size_t)NINP * DM * 2 <= WS_A1 && WS_A1 + (size_t)MT * DM * 2 <= WS_P && WS_P + (size_t)MT * NINP * 2 <= WS_R, "ws map 1");
static_assert(WS_LR + (size_t)MT * NLR * 2 <= WS_R && WS_Z + (size_t)MX * RW * 2 <= WS_A2 && WS_A2 + (size_t)MX * DM * 2 <= WS_P, "ws map 2");
static_assert(WS_LA + (size_t)MT * 64 * 4 <= WS_WT_IN && WS_ALR + (size_t)MT * KLR * 2 <= WS_P && WS_ALR >= WS_A2 + (size_t)MX * DM * 2 && WS_WLR + (size_t)NLR * KLRW * 2 <= WS_KBD, "ws map 3");
static_assert(WS_S + (size_t)MX * 2048 * 4 <= WS_R && WS_VSC + 65536 <= WS_XS, "ws map 4");

constexpr int LDS_BYTES = 147456;
constexpr int LDS_CTL = 143360;
constexpr int LDS_MISC = LDS_CTL + 320;

enum { I_X = 0, I_C, I_CTX, I_CCTX, I_WMOD, I_BMOD, I_N1G, I_N2G, I_WIN, I_WOUT, I_MU, I_W0, I_W2, I_A0, I_A2, I_G2, I_KK, I_KA, I_RK, I_LNW, I_LNB,
       I_CONVW, I_CONVB, I_DTB, I_ALOG, I_SSMD, I_NORMW, I_WQ, I_K1, I_K2, I_PU, I_PV, I_FG, N_IN };

struct Args { const float* in[N_IN]; float* out; unsigned char* ws; int ph_lo, ph_hi; };

__device__ __forceinline__ unsigned f2bf(float f) { unsigned u = __float_as_uint(f); return (u + 0x7fffu + ((u >> 16) & 1u)) >> 16; }
__device__ __forceinline__ unsigned pk2(float lo, float hi) { return f2bf(lo) | (f2bf(hi) << 16); }
__device__ __forceinline__ float bflo(unsigned u) { return __uint_as_float(u << 16); }
__device__ __forceinline__ float bfhi(unsigned u) { return __uint_as_float(u & 0xffff0000u); }
__device__ __forceinline__ void unpack8(const uint4& u, float (&f)[8]) {
    f[0] = bflo(u.x); f[1] = bfhi(u.x); f[2] = bflo(u.y); f[3] = bfhi(u.y); f[4] = bflo(u.z); f[5] = bfhi(u.z); f[6] = bflo(u.w); f[7] = bfhi(u.w);
}
__device__ __forceinline__ uint4 pack8(const float (&f)[8]) { uint4 u; u.x = pk2(f[0], f[1]); u.y = pk2(f[2], f[3]); u.z = pk2(f[4], f[5]); u.w = pk2(f[6], f[7]); return u; }
__device__ __forceinline__ uint4 ld16(const bf16* p) { return *(const uint4*)p; }
__device__ __forceinline__ void st16(bf16* p, const uint4& v) { *(uint4*)p = v; }
__device__ __forceinline__ void ldf8(const float* p, float (&f)[8]) { const float4 a = *(const float4*)p, b = *(const float4*)(p + 4); f[0] = a.x; f[1] = a.y; f[2] = a.z; f[3] = a.w; f[4] = b.x; f[5] = b.y; f[6] = b.z; f[7] = b.w; }
#define PIN8(a) asm volatile("" : "+v"((a)[0]), "+v"((a)[1]), "+v"((a)[2]), "+v"((a)[3]), "+v"((a)[4]), "+v"((a)[5]), "+v"((a)[6]), "+v"((a)[7]))
template <int CTRL> __device__ __forceinline__ float dppf(float v) { return __uint_as_float((unsigned)__builtin_amdgcn_update_dpp(0, (int)__float_as_uint(v), CTRL, 0xF, 0xF, true)); }
__device__ __forceinline__ float rlane(float v, int l) { return __uint_as_float((unsigned)__builtin_amdgcn_readlane((int)__float_as_uint(v), l)); }
__device__ __forceinline__ float sum8(float v) { v += dppf<0xB1>(v); v += dppf<0x4E>(v); v += dppf<0x141>(v); return v; }
__device__ __forceinline__ float sum16(float v) { v = sum8(v); v += dppf<0x140>(v); return v; }
__device__ __forceinline__ float sum32(float v) { v = sum16(v); v += __shfl_xor(v, 16); return v; }
__device__ __forceinline__ float wave_sum(float v) { v = sum16(v); return (rlane(v, 0) + rlane(v, 16)) + (rlane(v, 32) + rlane(v, 48)); }
__device__ __forceinline__ float wave_max(float v) {
    v = fmaxf(v, dppf<0xB1>(v)); v = fmaxf(v, dppf<0x4E>(v)); v = fmaxf(v, dppf<0x141>(v)); v = fmaxf(v, dppf<0x140>(v));
    return fmaxf(fmaxf(rlane(v, 0), rlane(v, 16)), fmaxf(rlane(v, 32), rlane(v, 48)));
}
__device__ __forceinline__ void lds_barrier() { asm volatile("s_waitcnt lgkmcnt(0)\n\ts_barrier" ::: "memory"); }
__device__ __forceinline__ float sigmoidf_(float x) { return 1.f / (1.f + __expf(-x)); }
__device__ __forceinline__ float siluf_(float x) { return x / (1.f + __expf(-x)); }

struct EpiLR {
    static constexpr bool PERM = true, AFTER_DRAIN = false;
    bf16* O; const float* w0; const float* a0;
    __device__ __forceinline__ void operator()(const pg8::f32x4 (&acc)[2][2][4][2], const pg8::Unit& u, int wr, int wc, int fr, int fq) const {
        const int row0 = u.pm * 256 + wr * 64 + fr; const int colt = u.pn * 256; const int type = colt >> 11;
        const int col0 = colt + wc * 32 + 8 * fq;
        const float* bias = type < 2 ? (w0 + type * 2048) : (a0 + (type - 2) * 2048);
        pg8::f32x4 bv[2][2];
#pragma unroll
        for (int bj = 0; bj < 2; ++bj)
#pragma unroll
            for (int n = 0; n < 2; ++n) bv[bj][n] = type < 4 ? *(const pg8::f32x4*)(bias + ((col0 + bj * 128 + 4 * n) & 2047)) : (pg8::f32x4){0.f, 0.f, 0.f, 0.f};
#pragma unroll
        for (int ai = 0; ai < 2; ++ai)
#pragma unroll
            for (int m = 0; m < 4; ++m) { bf16* rowp = O + (size_t)(row0 + ai * 128 + m * 16) * NLR + col0;
#pragma unroll
                for (int bj = 0; bj < 2; ++bj) { pg8::f32x4 v0 = acc[ai][bj][m][0] + bv[bj][0], v1 = acc[ai][bj][m][1] + bv[bj][1];
                    if (type < 4) {
#pragma unroll
                        for (int j = 0; j < 4; ++j) { float s0 = 1.f / (1.f + __expf(-v0[j])), s1 = 1.f / (1.f + __expf(-v1[j]));
                            if (type < 2) { s0 = -expm1f(-0.60653066f * s0); s1 = -expm1f(-0.60653066f * s1); }
                            v0[j] = s0; v1[j] = s1; } }
                    pg8::u32x4 w; w.x = pg8::cvt_pk_bf16(v0[0], v0[1]); w.y = pg8::cvt_pk_bf16(v0[2], v0[3]); w.z = pg8::cvt_pk_bf16(v1[0], v1[1]); w.w = pg8::cvt_pk_bf16(v1[2], v1[3]);
                    *(pg8::u32x4*)(rowp + bj * 128) = w; } }
    }
};
struct EpiRes {
    static constexpr bool PERM = false, AFTER_DRAIN = false;
    float* C; const float* X; const float* mod;
    __device__ __forceinline__ void operator()(const pg8::f32x4 (&acc)[2][2][4][2], const pg8::Unit& u, int wr, int wc, int fr, int fq) const {
        const int row0 = u.pm * 256 + wr * 64 + fr, col0 = u.pn * 256 + wc * 32 + 4 * fq;
        const float* gt = mod + (size_t)((u.pm * 256) / SEQ) * NMOD + 2 * DM;
        pg8::f32x4 gv[2][2];
#pragma unroll
        for (int bj = 0; bj < 2; ++bj)
#pragma unroll
            for (int n = 0; n < 2; ++n) gv[bj][n] = *(const pg8::f32x4*)(gt + col0 + bj * 128 + n * 16);
#pragma unroll
        for (int ai = 0; ai < 2; ++ai)
#pragma unroll
            for (int m = 0; m < 4; ++m) { const size_t off = (size_t)(row0 + ai * 128 + m * 16) * DM + col0;
#pragma unroll
                for (int bj = 0; bj < 2; ++bj)
#pragma unroll
                    for (int n = 0; n < 2; ++n) { const pg8::f32x4 xv = *(const pg8::f32x4*)(X + off + bj * 128 + n * 16);
#if MK_SKIP_MIXER
                        *(pg8::f32x4*)(C + off + bj * 128 + n * 16) = xv;
#else
                        *(pg8::f32x4*)(C + off + bj * 128 + n * 16) = xv + gv[bj][n] * acc[ai][bj][m][n];
#endif
                    }
                asm volatile("" ::: "memory"); }
    }
};

#define XB_TMO      128
#define XB_XCNT(j)  (256  + 64 * (j))
#define XB_XSUB(j)  (1280 + 64 * (j))
#define XB_XGEN(j)  (2304 + 64 * (j))
#define XB_TOP      3328
#define XB_TOPGEN   3392
#define XCD_BAR_WORDS 3456
#define XB_SPIN_CAP (1u << 18)
__device__ __forceinline__ unsigned xb_ld(unsigned* p)              { return __hip_atomic_load(p, __ATOMIC_RELAXED, __HIP_MEMORY_SCOPE_AGENT); }
__device__ __forceinline__ unsigned xb_add(unsigned* p, unsigned v) { return __hip_atomic_fetch_add(p, v, __ATOMIC_RELAXED, __HIP_MEMORY_SCOPE_AGENT); }
__device__ __forceinline__ unsigned xb_xcc_id() { return (unsigned)__builtin_amdgcn_s_getreg((3 << 11) | 20) & 0xFu; }
#define XB_SPIN(cond, bar) do { unsigned _sp = 0; while (cond) { __builtin_amdgcn_s_sleep(1); \
    if ((++_sp & 255u) == 0u) { if (xb_ld(&(bar)[XB_TMO])) break; if (_sp > XB_SPIN_CAP) { atomicAdd(&(bar)[XB_TMO], 1u); break; } } } } while (0)
struct XcdBarrier { unsigned* bar; unsigned x; volatile LAS unsigned* st; };
__device__ __forceinline__ XcdBarrier xcd_barrier_post(unsigned* bar, volatile LAS unsigned* st) {
    XcdBarrier b; b.bar = bar; b.x = xb_xcc_id(); b.st = st;
    if (threadIdx.x == 0) (void)xb_add(&bar[XB_XCNT(b.x)], 1u);
    return b;
}
__device__ __forceinline__ void xcd_barrier_complete(unsigned* bar, unsigned x, unsigned& nloc, unsigned& nx) {
    const unsigned G = gridDim.x * gridDim.y * gridDim.z;
    unsigned sum, cnt, mine, sp = 0u;
    for (;;) {
        sum = 0u; cnt = 0u; mine = 0u;
#pragma unroll
        for (unsigned j = 0; j < 16; ++j) { const unsigned c = xb_ld(&bar[XB_XCNT(j)]); sum += c; cnt += (c > 0u) ? 1u : 0u; mine = (j == x) ? c : mine; }
        if (sum == G) break;
        __builtin_amdgcn_s_sleep(1);
        if ((++sp & 255u) == 0u) { if (xb_ld(&bar[XB_TMO])) break; if (sp > XB_SPIN_CAP) { atomicAdd(&bar[XB_TMO], 1u); break; } }
    }
    nloc = mine > 0u ? mine : 1u; nx = cnt > 0u ? cnt : 1u;
}
__device__ __forceinline__ void xcd_barrier(const XcdBarrier& b) {
    asm volatile("s_waitcnt vmcnt(0)" ::: "memory");
    __syncthreads();
    if (threadIdx.x == 0) {
        unsigned* bar = b.bar;
        __builtin_amdgcn_s_waitcnt(0);
        unsigned nloc = b.st[0], nx = b.st[1];
        if (nloc == 0u) { xcd_barrier_complete(bar, b.x, nloc, nx); b.st[0] = nloc; b.st[1] = nx; }
        const unsigned old = xb_add(&bar[XB_XSUB(b.x)], 1u);
        const unsigned gen = old / nloc;
        if (old + 1u == (gen + 1u) * nloc) {
            __builtin_amdgcn_fence(__ATOMIC_RELEASE, "agent");
            asm volatile("s_waitcnt vmcnt(0)" ::: "memory");
            const unsigned og = xb_add(&bar[XB_TOP], 1u);
            const unsigned tg = og / nx;
            if (og + 1u == (tg + 1u) * nx) xb_add(&bar[XB_TOPGEN], 1u);
            else XB_SPIN(xb_ld(&bar[XB_TOPGEN]) == tg, bar);
            __builtin_amdgcn_fence(__ATOMIC_ACQUIRE, "agent");
            xb_add(&bar[XB_XGEN(b.x)], 1u);
            asm volatile("s_waitcnt vmcnt(0)" ::: "memory");
        } else {
            XB_SPIN(xb_ld(&bar[XB_XGEN(b.x)]) == gen, bar);
            __builtin_amdgcn_fence(__ATOMIC_ACQUIRE, "agent");
            asm volatile("s_waitcnt vmcnt(0)" ::: "memory");
        }
    }
    __syncthreads();
}

#define TID ((int)threadIdx.x)
#define LANE ((int)(threadIdx.x & 63))
#define WAVE ((int)__builtin_amdgcn_readfirstlane((int)(threadIdx.x >> 6)))
#define GW ((int)blockIdx.x * 8 + WAVE)
#define NGW ((int)gridDim.x * 8)

__device__ __forceinline__ void ph_mod(const Args& a, LAS unsigned char* lds) {
    const float* c = a.in[I_C]; const float* cc = a.in[I_CCTX]; const float* w_mod = a.in[I_WMOD]; const float* b_mod = a.in[I_BMOD];
    float* mod = (float*)(a.ws + WS_MOD);
    LAS float* sS = (LAS float*)lds;
    LAS float* red = (LAS float*)(lds + 81920);
    const int tid = TID, lane = LANE, wave = WAVE;
    if ((int)blockIdx.x < 192) {
        for (int i = tid; i < 5 * DM; i += 512) { const int v = i >> 12, k = i & (DM - 1); const float xv = v < 4 ? c[v * DM + k] : cc[k]; sS[i] = xv / (1.f + expf(-xv)); }
    }
    __syncthreads();
    for (int u = blockIdx.x; u < 192; u += gridDim.x) {
        const int cl = lane & 31, kh = lane >> 5;
        float acc[5][4];
#pragma unroll
        for (int v = 0; v < 5; ++v)
#pragma unroll
            for (int e = 0; e < 4; ++e) acc[v][e] = 0.f;
        const float* wp = w_mod + (size_t)(wave * 512 + kh) * NMOD + u * 128 + cl * 4;
#pragma unroll 8
        for (int i = 0; i < 256; ++i) {
            const float4 w = *(const float4*)(wp + (size_t)(2 * i) * NMOD);
#pragma unroll
            for (int v = 0; v < 5; ++v) { const float s = sS[v * DM + wave * 512 + 2 * i + kh]; acc[v][0] += s * w.x; acc[v][1] += s * w.y; acc[v][2] += s * w.z; acc[v][3] += s * w.w; }
        }
#pragma unroll
        for (int v = 0; v < 5; ++v)
#pragma unroll
            for (int e = 0; e < 4; ++e) acc[v][e] += __shfl_xor(acc[v][e], 32);
        if (kh == 0) {
#pragma unroll
            for (int v = 0; v < 5; ++v) *(LAS f32x4*)(red + ((wave * 5 + v) * 128 + cl * 4)) = (f32x4){acc[v][0], acc[v][1], acc[v][2], acc[v][3]};
        }
        __syncthreads();
        for (int i = tid; i < 640; i += 512) { const int v = i >> 7, n = i & 127; float s = b_mod[u * 128 + n];
#pragma unroll
            for (int w = 0; w < 8; ++w) s += red[(w * 5 + v) * 128 + n];
            mod[v * NMOD + u * 128 + n] = s; }
        __syncthreads();
    }
    __syncthreads();
}

__device__ __forceinline__ void transpose_item(const float* W, int K, int N, bf16* WT, LAS float* scr, int item, int lane) {
    const int nblk = N / 32, kb = item / nblk, nb = item % nblk, k0 = 64 * kb, n0 = 32 * nb;
#pragma unroll 8
    for (int i = 0; i < 32; ++i) { const int kk = 2 * i + (lane >> 5); scr[kk * 33 + (lane & 31)] = W[(size_t)(k0 + kk) * N + n0 + (lane & 31)]; }
    asm volatile("s_waitcnt lgkmcnt(0)" ::: "memory");
    const int c = lane & 7;
#pragma unroll
    for (int j = 0; j < 4; ++j) { const int n = (lane >> 3) + 8 * j; const LAS float* s = scr + (8 * c) * 33 + n;
        uint4 o; o.x = pk2(s[0 * 33], s[1 * 33]); o.y = pk2(s[2 * 33], s[3 * 33]); o.z = pk2(s[4 * 33], s[5 * 33]); o.w = pk2(s[6 * 33], s[7 * 33]);
        *(uint4*)(WT + (size_t)(n0 + n) * K + k0 + 8 * c) = o; }
    asm volatile("s_waitcnt lgkmcnt(0)" ::: "memory");
}
__device__ __forceinline__ void ph_conv(const Args& a, LAS unsigned char* lds) {
    const int lane = LANE, wave = WAVE, gw = GW, ngw = NGW;
    LAS float* scr = (LAS float*)(lds + wave * 16384);
    bf16* wt_in = (bf16*)(a.ws + WS_WT_IN); bf16* wt_out = (bf16*)(a.ws + WS_WT_OUT); bf16* wt_q = (bf16*)(a.ws + WS_WT_Q);
    constexpr int IT_IN = (DM / 64) * (NIN / 32), IT_OUT = (DM / 64) * (DM / 32), IT_Q = (DM / 64) * (2048 / 32);
    for (int it = gw; it < IT_IN + IT_OUT + IT_Q; it += ngw) {
        int r = it;
        if (r < IT_IN) { transpose_item(a.in[I_WIN], DM, NIN, wt_in, scr, r, lane); continue; } r -= IT_IN;
        if (r < IT_OUT) { transpose_item(a.in[I_WOUT], DM, DM, wt_out, scr, r, lane); continue; } r -= IT_OUT;
        transpose_item(a.in[I_WQ], DM, 2048, wt_q, scr, r, lane);
    }
    const int gt = blockIdx.x * 512 + TID, ngt = gridDim.x * 512;
    for (int i = gt; i < (NINP - NIN) * DM / 8; i += ngt) *(uint4*)(wt_in + (size_t)NIN * DM + (size_t)i * 8) = make_uint4(0u, 0u, 0u, 0u);
    { bf16* wlr = (bf16*)(a.ws + WS_WLR); const float* w2 = a.in[I_W2]; const float* a2 = a.in[I_A2]; const float* g2 = a.in[I_G2];
      for (int i = gt; i < NLR * (KLRW / 8); i += ngt) { const int n = i / (KLRW / 8), k0 = (i % (KLRW / 8)) * 8; const int type = n >> 11, cch = n & 2047;
          float f[8];
#pragma unroll
          for (int e = 0; e < 8; ++e) { const int k = k0 + e; float v = 0.f;
              if (type == 4) v = g2[(size_t)k * RW + cch];
              else { const int d = type & 1, kk = k - 128 * d; const float* src = type < 2 ? w2 : a2; if (kk >= 0 && kk < 96) v = src[(size_t)(d * 96 + kk) * RW + cch]; }
              f[e] = v; }
          st16(wlr + (size_t)n * KLRW + k0, pack8(f)); } }
    { bf16* kbd = (bf16*)(a.ws + WS_KBD); const float* k1 = a.in[I_K1]; const float* k2 = a.in[I_K2];
      for (int i = gt; i < 2048 * 32; i += ngt) { const int n = i >> 5, k0 = (i & 31) * 8; float f[8];
          const int h = n >> 8, sb = (n >> 7) & 1, key = n & 127;
          if ((k0 >> 7) == sb) { const float* src = (sb ? k2 : k1) + ((size_t)(h * 128 + key) * 128 + (k0 & 127)); ldf8(src, f); }
          else {
#pragma unroll
              for (int e = 0; e < 8; ++e) f[e] = 0.f; }
          st16(kbd + (size_t)n * 256 + k0, pack8(f)); } }
}

__device__ __forceinline__ void norm_mod_row(const float* src, const float* g, const float* sh, const float* sc, bf16* dst, int lane) {
    float4 v[16]; float ss = 0.f;
#pragma unroll
    for (int j = 0; j < 16; ++j) { v[j] = *(const float4*)(src + (lane + 64 * j) * 4); ss += (v[j].x * v[j].x + v[j].y * v[j].y) + (v[j].z * v[j].z + v[j].w * v[j].w); }
    const float rstd = rsqrtf(wave_sum(ss) * (1.f / DM) + RMS_EPS);
#pragma unroll
    for (int j = 0; j < 16; ++j) { const int c = (lane + 64 * j) * 4; const float4 gg = *(const float4*)(g + c), s1 = *(const float4*)(sc + c), s0 = *(const float4*)(sh + c);
        const float o0 = v[j].x * rstd * gg.x * (1.f + s1.x) + s0.x, o1 = v[j].y * rstd * gg.y * (1.f + s1.y) + s0.y, o2 = v[j].z * rstd * gg.z * (1.f + s1.z) + s0.z, o3 = v[j].w * rstd * gg.w * (1.f + s1.w) + s0.w;
        uint2 w; w.x = pk2(o0, o1); w.y = pk2(o2, o3); *(uint2*)(dst + c) = w; }
}
__device__ __forceinline__ void ph_norm1(const Args& a) {
    const int lane = LANE; const float* mod = (const float*)(a.ws + WS_MOD); bf16* A1 = (bf16*)(a.ws + WS_A1);
    for (int m = GW; m < MT; m += NGW) {
        const float* src = m < MX ? a.in[I_X] + (size_t)m * DM : a.in[I_CTX] + (size_t)(m - MX) * DM;
        const int v = m < MX ? m / SEQ : 4;
        norm_mod_row(src, a.in[I_N1G], mod + (size_t)v * NMOD, mod + (size_t)v * NMOD + DM, A1 + (size_t)m * DM, lane);
    }
}
__device__ __forceinline__ void ph_norm2(const Args& a) {
    const int lane = LANE; const float* mod = (const float*)(a.ws + WS_MOD); bf16* XN2 = (bf16*)(a.ws + WS_XN2);
    for (int m = GW; m < MX; m += NGW) {
        const int v = m / SEQ;
        norm_mod_row(a.out + (size_t)m * DM, a.in[I_N2G], mod + (size_t)v * NMOD + 3 * DM, mod + (size_t)v * NMOD + 4 * DM, XN2 + (size_t)m * DM, lane);
    }
    unsigned char* U8 = a.ws + WS_U8; unsigned char* V8 = a.ws + WS_V8; float* USC = (float*)(a.ws + WS_USC); float* VSC = (float*)(a.ws + WS_VSC);
    for (int row = GW; row < 2 * 16384; row += NGW) {
        const int tb = row >> 14, r = row & 16383;
        const float* src = (tb ? a.in[I_PV] : a.in[I_PU]) + (size_t)r * DM;
        float4 v[16]; float am = 0.f;
#pragma unroll
        for (int j = 0; j < 16; ++j) { v[j] = *(const float4*)(src + (lane + 64 * j) * 4); am = fmaxf(fmaxf(am, fmaxf(fabsf(v[j].x), fabsf(v[j].y))), fmaxf(fabsf(v[j].z), fabsf(v[j].w))); }
        am = wave_max(am);
        const float scale = am > 0.f ? am * (1.f / 7.5f) : 1.f, inv = 1.f / scale;
        unsigned char* dst = (tb ? V8 : U8) + (size_t)r * 3072 + lane * 16;
        unsigned long long pk[6];
#pragma unroll
        for (int p = 0; p < 2; ++p) {
            unsigned long long w0 = 0ull, w1 = 0ull, w2 = 0ull;
#pragma unroll
            for (int k = 0; k < 32; ++k) {
                const float4 q = v[8 * p + (k >> 2)]; const float x = ((k & 3) == 0 ? q.x : (k & 3) == 1 ? q.y : (k & 3) == 2 ? q.z : q.w) * inv; const float ax = fabsf(x);
                float cf = ax < 2.f ? rintf(ax * 8.f) : (ax < 4.f ? rintf(ax * 4.f) + 8.f : rintf(ax * 2.f) + 16.f);
                cf = fminf(cf, 31.f);
                const unsigned long long code = (unsigned long long)((unsigned)cf | (x < 0.f ? 32u : 0u));
                const int pos = 6 * k, wd = pos >> 6, off = pos & 63;
                if (wd == 0) w0 |= code << off; else if (wd == 1) w1 |= code << off; else w2 |= code << off;
                if (off > 58) { if (wd == 0) w1 |= code >> (64 - off); else w2 |= code >> (64 - off); }
            }
            pk[3 * p] = w0; pk[3 * p + 1] = w1; pk[3 * p + 2] = w2;
        }
#pragma unroll
        for (int k = 0; k < 3; ++k) *(uint4*)(dst + 1024 * k) = make_uint4((unsigned)pk[2 * k], (unsigned)(pk[2 * k] >> 32), (unsigned)pk[2 * k + 1], (unsigned)(pk[2 * k + 1] >> 32));
        if (lane == 0) (tb ? VSC : USC)[r] = scale;
    }
}

__device__ __forceinline__ void ldf8s(const LAS float* p, float (&f)[8]) { const f32x4 a = *(const LAS f32x4*)p, b = *(const LAS f32x4*)(p + 4); f[0] = a[0]; f[1] = a[1]; f[2] = a[2]; f[3] = a[3]; f[4] = b[0]; f[5] = b[1]; f[6] = b[2]; f[7] = b[3]; }
constexpr int PL_MU = 0, PL_KK = 27136, PL_CW = 35328, PL_CB = 84480, PL_END = 100864;
__device__ __forceinline__ void ph_prep_stage(const Args& a, LAS unsigned char* lds) {
    const int tid = TID;
    for (int i = tid; i < RCOLS; i += 512) ((LAS float*)(lds + PL_MU))[i] = a.in[I_MU][i];
    for (int i = tid; i < RW; i += 512) ((LAS float*)(lds + PL_KK))[i] = a.in[I_KK][i];
    for (int i = tid; i < 3 * 4096; i += 512) ((LAS float*)(lds + PL_CW))[i] = a.in[I_CONVW][i];
    for (int i = tid; i < 4096; i += 512) ((LAS float*)(lds + PL_CB))[i] = a.in[I_CONVB][i];
    __syncthreads();
}
__device__ __forceinline__ void ph_prep_rwkv(const Args& a, LAS unsigned char* lds) {
    const int lane = LANE;
    const bf16* P = (const bf16*)(a.ws + WS_P);
    bf16* R = (bf16*)(a.ws + WS_R); bf16* K = (bf16*)(a.ws + WS_K); bf16* V = (bf16*)(a.ws + WS_V); bf16* KK = (bf16*)(a.ws + WS_KK); bf16* ALR = (bf16*)(a.ws + WS_ALR);
    const LAS float* mu = (const LAS float*)(lds + PL_MU); const LAS float* k_k = (const LAS float*)(lds + PL_KK);
    for (int m = GW; m < MT; m += NGW) {
        const bool lat = m < MX;
        bool h0, h1, h2 = false, h3 = false; size_t r0, r1, r2 = (size_t)m, r3 = (size_t)m;
        if (lat) { const int t = m & (SEQ - 1), row = t >> 6, col = t & 63; h0 = col > 0; h1 = col < 63; h2 = row > 0; h3 = row < 63; r0 = (size_t)(m - 1); r1 = (size_t)(m + 1); r2 = (size_t)(m - 64); r3 = (size_t)(m + 64); }
        else { const int t = (m - MX) & (CTXL - 1); h0 = t > 0; h1 = t < CTXL - 1; r0 = (size_t)(m - 1); r1 = (size_t)(m + 1); }
        if (!h0) r0 = (size_t)m; if (!h1) r1 = (size_t)m; if (!h2) r2 = (size_t)m; if (!h3) r3 = (size_t)m;
        const bf16* prow = P + (size_t)m * NINP; const bf16* p0 = P + r0 * NINP; const bf16* p1 = P + r1 * NINP; const bf16* p2 = P + r2 * NINP; const bf16* p3 = P + r3 * NINP;
        const float f0 = h0 ? 1.f : 0.f, f1 = h1 ? 1.f : 0.f, f2 = h2 ? 1.f : 0.f, f3 = h3 ? 1.f : 0.f;
        uint4 qo[2][2], q0[2][2], q1[2][2], q2[2][2], q3[2][2];
#define PREP_LOAD(buf, i2v) do { _Pragma("unroll") for (int ii = 0; ii < 2; ++ii) { const int chunk_ = lane + 64 * ((i2v) + ii); const int c0_ = (chunk_ < RCOLS / 8 ? chunk_ : 0) * 8; \
            qo[buf][ii] = ld16(prow + c0_); q0[buf][ii] = ld16(p0 + c0_); q1[buf][ii] = ld16(p1 + c0_); \
            if (lat) { q2[buf][ii] = ld16(p2 + c0_); q3[buf][ii] = ld16(p3 + c0_); } else { q2[buf][ii] = qo[buf][ii]; q3[buf][ii] = qo[buf][ii]; } } } while (0)
        PREP_LOAD(0, 0);
#pragma unroll
        for (int i2 = 0; i2 < 14; i2 += 2) {
            const int cb_ = (i2 >> 1) & 1;
            if (i2 + 2 < 14) { if (cb_) PREP_LOAD(0, i2 + 2); else PREP_LOAD(1, i2 + 2); }
            asm volatile("" ::: "memory");
#pragma unroll
            for (int ii = 0; ii < 2; ++ii) { const int i = i2 + ii; const int chunk = lane + 64 * i;
              if (chunk < RCOLS / 8) {
                const int c0 = chunk * 8;
                float own[8], n0[8], n1[8], sh[8], xm[8], muv[8];
                unpack8(qo[cb_][ii], own); unpack8(q0[cb_][ii], n0); unpack8(q1[cb_][ii], n1);
                if (lat) { float n2[8], n3[8]; unpack8(q2[cb_][ii], n2); unpack8(q3[cb_][ii], n3);
#pragma unroll
                    for (int e = 0; e < 8; ++e) sh[e] = (e & 3) == 0 ? n0[e] * f0 : (e & 3) == 1 ? n1[e] * f1 : (e & 3) == 2 ? n2[e] * f2 : n3[e] * f3;
                } else {
#pragma unroll
                    for (int e = 0; e < 8; ++e) sh[e] = (e & 1) == 0 ? n0[e] * f0 : n1[e] * f1;
                }
                ldf8s(mu + c0, muv);
#pragma unroll
                for (int e = 0; e < 8; ++e) xm[e] = own[e] + muv[e] * (sh[e] - own[e]);
                if (i < 4) st16(R + (size_t)m * RW + c0, pack8(xm));
                else if (i < 8) { const int cc = c0 - 2048; st16(K + (size_t)m * RW + cc, pack8(xm));
                    float kv[8], kkv[8]; ldf8s(k_k + cc, kv); float ss = 0.f;
#pragma unroll
                    for (int e = 0; e < 8; ++e) { kkv[e] = xm[e] * kv[e]; ss += kkv[e] * kkv[e]; }
                    ss = sum8(ss);
                    const float inv = rsqrtf(fmaxf(ss, 1e-24f));
#pragma unroll
                    for (int e = 0; e < 8; ++e) kkv[e] *= inv;
                    st16(KK + (size_t)m * RW + cc, pack8(kkv)); }
                else if (i < 12) st16(V + (size_t)m * RW + (c0 - 4096), pack8(xm));
                else { const int j0 = c0 - 6144; float f[8];
#pragma unroll
                    for (int e = 0; e < 8; ++e) f[e] = j0 < 192 ? tanhf(xm[e]) : (j0 < 384 ? xm[e] : 1.f / (1.f + __expf(-xm[e])));
                    const int col = j0 < 384 ? (j0 / 96) * 128 + (j0 % 96) : j0 + 128;
                    st16(ALR + (size_t)m * KLR + col, pack8(f)); }
              } else if (i == 13 && lane < 32) {
                const int pc = lane - 16; st16(ALR + (size_t)m * KLR + (pc >> 2) * 128 + 96 + (pc & 3) * 8, make_uint4(0u, 0u, 0u, 0u));
              }
            }
        }
    }
}

__device__ __forceinline__ void ph_prep_ssd(const Args& a, LAS unsigned char* lds) {
    const int lane = LANE;
    const bf16* P = (const bf16*)(a.ws + WS_P);
    bf16* XS = (bf16*)(a.ws + WS_XS); bf16* BC = (bf16*)(a.ws + WS_BC); bf16* Z = (bf16*)(a.ws + WS_Z); float* DT = (float*)(a.ws + WS_DT); float* LA = (float*)(a.ws + WS_LA);
    const LAS float* cw = (const LAS float*)(lds + PL_CW); const LAS float* cb = (const LAS float*)(lds + PL_CB);
    for (int m = GW; m < MT; m += NGW) {
        const bool lat = m < MX; bool hp, hn;
        if (lat) { const int t = m & (SEQ - 1); hp = t > 0; hn = t < SEQ - 1; } else { const int t = (m - MX) & (CTXL - 1); hp = t > 0; hn = t < CTXL - 1; }
        const bf16* prow = P + (size_t)m * NINP; const bf16* pp = hp ? prow - NINP : prow; const bf16* pn = hn ? prow + NINP : prow;
        const float fp = hp ? 1.f : 0.f, fn = hn ? 1.f : 0.f;
        uint4 zq[4];
        if (lat) {
#pragma unroll
            for (int i = 0; i < 4; ++i) zq[i] = ld16(prow + COL_Z + (lane + 64 * i) * 8);
        }
        const unsigned short dtraw = prow[COL_DT + lane];
        uint4 qc[2][2], qp[2][2], qn[2][2];
#define SSDP_LOAD(buf, i2v) do { _Pragma("unroll") for (int ii = 0; ii < 2; ++ii) { const int c0_ = (lane + 64 * ((i2v) + ii)) * 8; qc[buf][ii] = ld16(prow + COL_XBC + c0_); qp[buf][ii] = ld16(pp + COL_XBC + c0_); qn[buf][ii] = ld16(pn + COL_XBC + c0_); } } while (0)
        SSDP_LOAD(0, 0);
#pragma unroll
        for (int i2 = 0; i2 < 8; i2 += 2) {
            const int cb_ = (i2 >> 1) & 1;
            if (i2 + 2 < 8) { if (cb_) SSDP_LOAD(0, i2 + 2); else SSDP_LOAD(1, i2 + 2); }
            asm volatile("" ::: "memory");
#pragma unroll
            for (int ii = 0; ii < 2; ++ii) { const int i = i2 + ii; const int c0 = (lane + 64 * i) * 8;
                float cur[8], pv[8], nx[8], w0[8], w1[8], w2[8], bb[8], y[8];
                unpack8(qc[cb_][ii], cur); unpack8(qp[cb_][ii], pv); unpack8(qn[cb_][ii], nx);
                ldf8s(cw + c0, w0); ldf8s(cw + 4096 + c0, w1); ldf8s(cw + 8192 + c0, w2); ldf8s(cb + c0, bb);
#pragma unroll
                for (int e = 0; e < 8; ++e) { const float t = w0[e] * (pv[e] * fp) + w1[e] * cur[e] + w2[e] * (nx[e] * fn) + bb[e]; y[e] = t / (1.f + __expf(-t)); }
                if (i < 4) st16(XS + (size_t)m * RW + c0, pack8(y)); else st16(BC + (size_t)m * RW + (c0 - 2048), pack8(y)); }
        }
        { const float raw = __uint_as_float((unsigned)dtraw << 16) + a.in[I_DTB][lane];
          const float dtv = raw > 20.f ? raw : log1pf(expf(raw));
          DT[(size_t)m * 64 + lane] = dtv; LA[(size_t)m * 64 + lane] = -dtv * expf(a.in[I_ALOG][lane]); }
        if (lat) {
#pragma unroll
            for (int i = 0; i < 4; ++i) st16(Z + (size_t)m * RW + (lane + 64 * i) * 8, zq[i]);
        }
    }
}

__device__ __forceinline__ int scan_row(int n, int dir, int b) { return n < CTXL ? MX + b * CTXL + (dir ? CTXL - 1 - n : n) : b * SEQ + (dir ? NSTEP - 1 - n : n - CTXL); }

struct RIn { uint4 r, k, kk, w, a; unsigned v; };
__device__ __forceinline__ void rwkv_load(RIn& x, const bf16* R, const bf16* K, const bf16* V, const bf16* KK, const bf16* LR, int m, int ch, int chi, int dir) {
    x.r = ld16(R + (size_t)m * RW + ch); x.k = ld16(K + (size_t)m * RW + ch); x.kk = ld16(KK + (size_t)m * RW + ch);
    x.w = ld16(LR + (size_t)m * NLR + dir * 2048 + ch); x.a = ld16(LR + (size_t)m * NLR + 4096 + dir * 2048 + ch);
    x.v = V[(size_t)m * RW + chi];
}
__device__ __forceinline__ float rwkv_step(float (&S)[8], const RIn& x, const float (&ka)[8]) {
    float r[8], k[8], kk[8], w1[8], av[8];
    unpack8(x.r, r); unpack8(x.k, k); unpack8(x.kk, kk); unpack8(x.w, w1); unpack8(x.a, av);
    const float v = __uint_as_float(x.v << 16);
    float sa = 0.f;
#pragma unroll
    for (int e = 0; e < 8; ++e) sa -= S[e] * kk[e];
    sa = sum8(sa);
    float o = 0.f;
#pragma unroll
    for (int e = 0; e < 8; ++e) { const float kd = k[e] * (1.f + (av[e] - 1.f) * ka[e]); const float b = kk[e] * av[e];
        S[e] = S[e] * (1.f - w1[e]) + sa * b + v * kd; o += S[e] * r[e]; }
    o = sum8(o);
    return o;
}
__device__ __forceinline__ void ph_rwkv_scan(const Args& a) {
    const int lane = LANE, wave = WAVE;
    const bf16* R = (const bf16*)(a.ws + WS_R); const bf16* K = (const bf16*)(a.ws + WS_K); const bf16* V = (const bf16*)(a.ws + WS_V); const bf16* KK = (const bf16*)(a.ws + WS_KK);
    const bf16* LR = (const bf16*)(a.ws + WS_LR); bf16* OR = (bf16*)a.out;
    for (int u = blockIdx.x; u < 256; u += gridDim.x) {
        const int g = u >> 5, h = u & 31, dir = g >> 2, b = g & 3;
        const int i = wave * 8 + (lane >> 3), jb = lane & 7, ch = h * 64 + jb * 8, chi = h * 64 + i;
        float ka[8]; ldf8(a.in[I_KA] + ch, ka);
        float S[8];
#pragma unroll
        for (int e = 0; e < 8; ++e) S[e] = 0.f;
        RIn A[4], B[4];
#pragma unroll
        for (int s = 0; s < 4; ++s) rwkv_load(A[s], R, K, V, KK, LR, scan_row(s, dir, b), ch, chi, dir);
        for (int n0 = 0; n0 < NSTEP; n0 += 8) {
#pragma unroll
            for (int s = 0; s < 4; ++s) rwkv_load(B[s], R, K, V, KK, LR, scan_row(n0 + 4 + s, dir, b), ch, chi, dir);
#pragma unroll
            for (int s = 0; s < 4; ++s) { const int n = n0 + s; const float o = rwkv_step(S, A[s], ka);
                if (n >= CTXL && jb == 0) OR[((size_t)dir * MX + scan_row(n, dir, b)) * RW + chi] = (bf16)f2bf(o); }
            if (n0 + 8 < NSTEP) {
#pragma unroll
                for (int s = 0; s < 4; ++s) rwkv_load(A[s], R, K, V, KK, LR, scan_row(n0 + 8 + s, dir, b), ch, chi, dir);
            }
#pragma unroll
            for (int s = 0; s < 4; ++s) { const int n = n0 + 4 + s; const float o = rwkv_step(S, B[s], ka);
                if (n >= CTXL && jb == 0) OR[((size_t)dir * MX + scan_row(n, dir, b)) * RW + chi] = (bf16)f2bf(o); }
        }
    }
}

typedef float f32x2_t __attribute__((ext_vector_type(2)));
constexpr int RS_TS = 32, RS_STEP_B = 6 * 256, RS_BUF_B = RS_TS * RS_STEP_B;
constexpr int RS_OBUF = 2 * RS_BUF_B, RS_OBUF_B = RS_TS * 64 * 2;
constexpr int RS_DUMP = RS_OBUF + 2 * RS_OBUF_B;
static_assert(RS_DUMP + 2048 <= 131072, "rwkv scan lds map");
struct RRaw { uint2 r, k, kk, v, w, a; };
__device__ __forceinline__ void rs_load(RRaw& x, const bf16* R, const bf16* K, const bf16* V, const bf16* KK, const bf16* LR, int m, int ch, int dir) {
    x.r = *(const uint2*)(R + (size_t)m * RW + ch); x.k = *(const uint2*)(K + (size_t)m * RW + ch); x.kk = *(const uint2*)(KK + (size_t)m * RW + ch); x.v = *(const uint2*)(V + (size_t)m * RW + ch);
    x.w = *(const uint2*)(LR + (size_t)m * NLR + dir * 2048 + ch); x.a = *(const uint2*)(LR + (size_t)m * NLR + 4096 + dir * 2048 + ch);
}
__device__ __forceinline__ void rs_stage(const RRaw& x, const float (&ka)[4], LAS unsigned char* dst) {
    const float r[4] = {bflo(x.r.x), bfhi(x.r.x), bflo(x.r.y), bfhi(x.r.y)}, k[4] = {bflo(x.k.x), bfhi(x.k.x), bflo(x.k.y), bfhi(x.k.y)};
    const float kk[4] = {bflo(x.kk.x), bfhi(x.kk.x), bflo(x.kk.y), bfhi(x.kk.y)}, v[4] = {bflo(x.v.x), bfhi(x.v.x), bflo(x.v.y), bfhi(x.v.y)};
    const float w1[4] = {bflo(x.w.x), bfhi(x.w.x), bflo(x.w.y), bfhi(x.w.y)}, av[4] = {bflo(x.a.x), bfhi(x.a.x), bflo(x.a.y), bfhi(x.a.y)};
    f32x4 nkk, w, b, kd, rr, vv;
#pragma unroll
    for (int e = 0; e < 4; ++e) { nkk[e] = -kk[e]; w[e] = 1.f - w1[e]; b[e] = kk[e] * av[e]; kd[e] = k[e] * (1.f + (av[e] - 1.f) * ka[e]); rr[e] = r[e]; vv[e] = v[e]; }
    *(LAS f32x4*)(dst) = nkk; *(LAS f32x4*)(dst + 256) = w; *(LAS f32x4*)(dst + 512) = b; *(LAS f32x4*)(dst + 768) = kd; *(LAS f32x4*)(dst + 1024) = rr; *(LAS f32x4*)(dst + 1280) = vv;
}
__device__ __forceinline__ float amul(float a, float b) { float d; asm("v_mul_f32 %0, %1, %2" : "=v"(d) : "v"(a), "v"(b)); return d; }
__device__ __forceinline__ void afmac(float& d, float a, float b) { asm("v_fmac_f32 %0, %1, %2" : "+v"(d) : "v"(a), "v"(b)); }
__device__ __forceinline__ float afma(float a, float b, float c) { float d; asm("v_fma_f32 %0, %1, %2, %3" : "=v"(d) : "v"(a), "v"(b), "v"(c)); return d; }
__device__ __forceinline__ void sum16x2(float& a, float& b) {
    asm("s_nop 1\n\t"
        "v_add_f32_dpp %0, %0, %0 quad_perm:[1,0,3,2] row_mask:0xf bank_mask:0xf bound_ctrl:1\n\t"
        "v_add_f32_dpp %1, %1, %1 quad_perm:[1,0,3,2] row_mask:0xf bank_mask:0xf bound_ctrl:1\n\t"
        "s_nop 0\n\t"
        "v_add_f32_dpp %0, %0, %0 quad_perm:[2,3,0,1] row_mask:0xf bank_mask:0xf bound_ctrl:1\n\t"
        "v_add_f32_dpp %1, %1, %1 quad_perm:[2,3,0,1] row_mask:0xf bank_mask:0xf bound_ctrl:1\n\t"
        "s_nop 0\n\t"
        "v_add_f32_dpp %0, %0, %0 row_half_mirror row_mask:0xf bank_mask:0xf bound_ctrl:1\n\t"
        "v_add_f32_dpp %1, %1, %1 row_half_mirror row_mask:0xf bank_mask:0xf bound_ctrl:1\n\t"
        "s_nop 0\n\t"
        "v_add_f32_dpp %0, %0, %0 row_mirror row_mask:0xf bank_mask:0xf bound_ctrl:1\n\t"
        "v_add_f32_dpp %1, %1, %1 row_mirror row_mask:0xf bank_mask:0xf bound_ctrl:1"
        : "+v"(a), "+v"(b));
}
template <bool OUT> __device__ __forceinline__ void rs_chunk(float (&S)[2][4], const LAS unsigned char* buf, LAS unsigned char* obuf, LAS unsigned char* dump, int j0, int i0, int jb) {
#pragma unroll 4
    for (int s = 0; s < RS_TS; ++s) {
        const LAS unsigned char* base = buf + s * RS_STEP_B;
        const f32x4 nkk = *(const LAS f32x4*)(base + j0 * 4), w = *(const LAS f32x4*)(base + 256 + j0 * 4), b = *(const LAS f32x4*)(base + 512 + j0 * 4), kd = *(const LAS f32x4*)(base + 768 + j0 * 4);
        const f32x2_t v = *(const LAS f32x2_t*)(base + 1280 + i0 * 4);
        float sa0 = amul(S[0][0], nkk[0]), sa1 = amul(S[1][0], nkk[0]);
#pragma unroll
        for (int e = 1; e < 4; ++e) { afmac(sa0, S[0][e], nkk[e]); afmac(sa1, S[1][e], nkk[e]); }
        sum16x2(sa0, sa1);
#pragma unroll
        for (int e = 0; e < 4; ++e) { float t0 = amul(sa0, b[e]), t1 = amul(sa1, b[e]); afmac(t0, v[0], kd[e]); afmac(t1, v[1], kd[e]); S[0][e] = afma(S[0][e], w[e], t0); S[1][e] = afma(S[1][e], w[e], t1); }
        if (OUT) {
            const f32x4 r = *(const LAS f32x4*)(base + 1024 + j0 * 4);
            float o0 = amul(S[0][0], r[0]), o1 = amul(S[1][0], r[0]);
#pragma unroll
            for (int e = 1; e < 4; ++e) { afmac(o0, S[0][e], r[e]); afmac(o1, S[1][e], r[e]); }
            sum16x2(o0, o1);
            *(LAS unsigned*)(jb == 0 ? obuf + (s * 64 + i0) * 2 : dump) = pg8::cvt_pk_bf16(o0, o1);
        }
    }
}
__device__ __forceinline__ void ph_rwkv_scan2(const Args& a, LAS unsigned char* lds) {
    const int tid = TID, lane = LANE, wave = WAVE;
    const bf16* R = (const bf16*)(a.ws + WS_R); const bf16* K = (const bf16*)(a.ws + WS_K); const bf16* V = (const bf16*)(a.ws + WS_V); const bf16* KK = (const bf16*)(a.ws + WS_KK);
    const bf16* LR = (const bf16*)(a.ws + WS_LR); bf16* OR = (bf16*)a.out;
    constexpr int NCH = NSTEP / RS_TS;
    for (int u = blockIdx.x; u < 256; u += gridDim.x) {
        const int g = u >> 5, h = u & 31, dir = g >> 2, b = g & 3;
        const int ip = lane >> 4, jb = lane & 15, i0 = wave * 8 + ip * 2, j0 = jb * 4;
        const int ss = tid >> 4, cgp = tid & 15, ch = h * 64 + cgp * 4;
        float ka[4];
#pragma unroll
        for (int e = 0; e < 4; ++e) ka[e] = a.in[I_KA][ch + e];
        float S[2][4];
#pragma unroll
        for (int e = 0; e < 4; ++e) { S[0][e] = 0.f; S[1][e] = 0.f; }
        RRaw raw;
        __syncthreads();
        rs_load(raw, R, K, V, KK, LR, scan_row(ss, dir, b), ch, dir);
        rs_stage(raw, ka, lds + ss * RS_STEP_B + cgp * 16);
        __syncthreads();
        for (int c = 0; c < NCH; ++c) {
            LAS unsigned char* buf = lds + (c & 1) * RS_BUF_B; LAS unsigned char* nbuf = lds + ((c + 1) & 1) * RS_BUF_B; LAS unsigned char* obuf = lds + RS_OBUF + (c & 1) * RS_OBUF_B;
            const bool more = c + 1 < NCH;
            if (more) rs_load(raw, R, K, V, KK, LR, scan_row((c + 1) * RS_TS + ss, dir, b), ch, dir);
            const bool lat = c >= CTXL / RS_TS;
            if (lat) rs_chunk<true>(S, buf, obuf, lds + RS_DUMP + tid * 4, j0, i0, jb); else rs_chunk<false>(S, buf, obuf, lds + RS_DUMP + tid * 4, j0, i0, jb);
            if (more) rs_stage(raw, ka, nbuf + ss * RS_STEP_B + cgp * 16);
            __syncthreads();
            if (lat) { typedef unsigned u32x2_t __attribute__((ext_vector_type(2))); const u32x2_t ov = *(const LAS u32x2_t*)(obuf + (ss * 64 + cgp * 4) * 2);
                *(uint2*)(OR + ((size_t)dir * MX + scan_row(c * RS_TS + ss, dir, b)) * RW + ch) = make_uint2(ov[0], ov[1]); }
        }
    }
}

struct SIn { uint4 b0, b1, c0, c1; unsigned xs; float dt, la; };
__device__ __forceinline__ void ssd_load(SIn& x, const bf16* XS, const bf16* BC, const float* DT, const float* LA, int m, int chx, int cb, int dh) {
    x.b0 = ld16(BC + (size_t)m * RW + cb); x.b1 = ld16(BC + (size_t)m * RW + cb + 8); x.c0 = ld16(BC + (size_t)m * RW + 1024 + cb); x.c1 = ld16(BC + (size_t)m * RW + 1024 + cb + 8);
    x.xs = XS[(size_t)m * RW + chx]; x.dt = DT[(size_t)m * 64 + dh]; x.la = LA[(size_t)m * 64 + dh];
}
__device__ __forceinline__ float ssd_step(float (&s)[16], const SIn& x) {
    float B0[8], B1[8], C0[8], C1[8]; unpack8(x.b0, B0); unpack8(x.b1, B1); unpack8(x.c0, C0); unpack8(x.c1, C1);
    const float dec = __expf(x.la), xdt = __uint_as_float(x.xs << 16) * x.dt; float y = 0.f;
#pragma unroll
    for (int e = 0; e < 8; ++e) { s[e] = dec * s[e] + xdt * B0[e]; y += s[e] * C0[e]; s[8 + e] = dec * s[8 + e] + xdt * B1[e]; y += s[8 + e] * C1[e]; }
    y = sum8(y);
    return y;
}
__device__ __forceinline__ void ph_ssd_scan(const Args& a) {
    const int lane = LANE, wave = WAVE;
    const bf16* XS = (const bf16*)(a.ws + WS_XS); const bf16* BC = (const bf16*)(a.ws + WS_BC); const float* DT = (const float*)(a.ws + WS_DT); const float* LA = (const float*)(a.ws + WS_LA);
    bf16* YS = (bf16*)a.out + (size_t)2 * MX * RW;
    for (int u = blockIdx.x; u < 256; u += gridDim.x) {
        const int g = u >> 5, h = u & 31, dir = g >> 2, b = g & 3;
        const int p = wave * 8 + (lane >> 3), nb = lane & 7, chx = h * 64 + p, cb = (h >> 2) * 128 + nb * 16, dh = dir * 32 + h;
        float s[16];
#pragma unroll
        for (int e = 0; e < 16; ++e) s[e] = 0.f;
        SIn A[4], B[4];
#pragma unroll
        for (int q = 0; q < 4; ++q) ssd_load(A[q], XS, BC, DT, LA, scan_row(q, dir, b), chx, cb, dh);
        for (int n0 = 0; n0 < NSTEP; n0 += 8) {
#pragma unroll
            for (int q = 0; q < 4; ++q) ssd_load(B[q], XS, BC, DT, LA, scan_row(n0 + 4 + q, dir, b), chx, cb, dh);
#pragma unroll
            for (int q = 0; q < 4; ++q) { const int n = n0 + q; const float y = ssd_step(s, A[q]);
                if (n >= CTXL && nb == 0) YS[((size_t)dir * MX + scan_row(n, dir, b)) * RW + chx] = (bf16)f2bf(y); }
            if (n0 + 8 < NSTEP) {
#pragma unroll
                for (int q = 0; q < 4; ++q) ssd_load(A[q], XS, BC, DT, LA, scan_row(n0 + 8 + q, dir, b), chx, cb, dh);
            }
#pragma unroll
            for (int q = 0; q < 4; ++q) { const int n = n0 + 4 + q; const float y = ssd_step(s, B[q]);
                if (n >= CTXL && nb == 0) YS[((size_t)dir * MX + scan_row(n, dir, b)) * RW + chx] = (bf16)f2bf(y); }
        }
    }
}

typedef short bf16x8_t __attribute__((ext_vector_type(8)));
typedef float f32x16 __attribute__((ext_vector_type(16)));
constexpr int SLD = 272;
constexpr int L_C = 0, L_B = 34816, L_BT = 69632, L_XT = 104448, L_S = 121856, L_F = 139264;
static_assert(L_F + 4 * 512 <= LDS_CTL, "ssd lds map");
typedef unsigned u32x4_t __attribute__((ext_vector_type(4)));
__device__ __forceinline__ void lds_st16(LAS unsigned char* p, const uint4& v) { *(LAS u32x4_t*)p = (u32x4_t){v.x, v.y, v.z, v.w}; }
__device__ __forceinline__ uint4 lds_ld16(const LAS unsigned char* p) { const u32x4_t t = *(const LAS u32x4_t*)p; return make_uint4(t[0], t[1], t[2], t[3]); }
__device__ __forceinline__ bf16x8_t lfrag(LAS unsigned char* img, int row, int k) { return *(LAS bf16x8_t*)(img + row * SLD + k * 2); }
__device__ __forceinline__ void ph_ssd_chunked(const Args& a, LAS unsigned char* lds) {
    const int tid = TID, lane = LANE, wave = WAVE, r = lane & 31, hh = lane >> 5;
    const bf16* XS = (const bf16*)(a.ws + WS_XS); const bf16* BC = (const bf16*)(a.ws + WS_BC); const float* DT = (const float*)(a.ws + WS_DT); const float* LA = (const float*)(a.ws + WS_LA);
    bf16* YS = (bf16*)a.out + (size_t)2 * MX * RW;
    LAS float* laS = (LAS float*)(lds + L_F); LAS float* dtS = laS + 128; LAS float* cumS = laS + 256;
    for (int u = blockIdx.x; u < 256; u += gridDim.x) {
        const int g = u >> 5, h = u & 31, dir = g >> 2, b = g & 3, gi = h >> 2;
        f32x16 st;
#pragma unroll
        for (int q = 0; q < 16; ++q) st[q] = 0.f;
        __syncthreads();
        for (int i = tid; i < 64 * SLD / 4; i += 512) ((LAS unsigned*)(lds + L_S))[i] = 0u;
        uint4 pB[4], pC[4], pX[2]; float pla = 0.f, pdt = 0.f;
#define SSD_FETCH(cc) do { const int n0_ = (cc) * 128; const bool lat_ = (cc) >= CTXL / 128; \
            _Pragma("unroll") for (int k_ = 0; k_ < 4; ++k_) { const int i_ = tid + 512 * k_; const int l_ = i_ >> 4, pc_ = i_ & 15; const size_t m_ = (size_t)scan_row(n0_ + l_, dir, b); \
                pB[k_] = ld16(BC + m_ * RW + gi * 128 + pc_ * 8); if (lat_) pC[k_] = ld16(BC + m_ * RW + 1024 + gi * 128 + pc_ * 8); } \
            _Pragma("unroll") for (int k_ = 0; k_ < 2; ++k_) { const int i_ = tid + 512 * k_; const int l_ = i_ >> 3, pc_ = i_ & 7; const size_t m_ = (size_t)scan_row(n0_ + l_, dir, b); pX[k_] = ld16(XS + m_ * RW + h * 64 + pc_ * 8); } \
            if (tid < 128) { const size_t m_ = (size_t)scan_row(n0_ + tid, dir, b); pla = LA[m_ * 64 + dir * 32 + h]; pdt = DT[m_ * 64 + dir * 32 + h]; } } while (0)
        SSD_FETCH(0);
        for (int c = 0; c < NSTEP / 128; ++c) {
            const int n0 = c * 128; const bool lat = c >= CTXL / 128;
#pragma unroll
            for (int k = 0; k < 4; ++k) { const int i = tid + 512 * k; const int l = i >> 4, pc = i & 15;
                lds_st16(lds + L_B + l * SLD + pc * 16, pB[k]); if (lat) lds_st16(lds + L_C + l * SLD + pc * 16, pC[k]); }
#pragma unroll
            for (int k = 0; k < 2; ++k) { const int i = tid + 512 * k; const int l = i >> 3, pc = i & 7; const unsigned w[4] = {pX[k].x, pX[k].y, pX[k].z, pX[k].w};
#pragma unroll
                for (int e = 0; e < 8; ++e) *(LAS bf16*)(lds + L_XT + (pc * 8 + e) * SLD + l * 2) = (bf16)((e & 1) ? (w[e >> 1] >> 16) : (w[e >> 1] & 0xffffu)); }
            if (tid < 128) { laS[tid] = pla; dtS[tid] = pdt; }
            if (c + 1 < NSTEP / 128) SSD_FETCH(c + 1);
            lds_barrier();
            if (wave == 0) { const float a0 = laS[2 * lane], b0 = laS[2 * lane + 1]; float x = a0 + b0;
#pragma unroll
                for (int d = 1; d < 64; d <<= 1) { const float y = __shfl_up(x, d); if (lane >= d) x += y; }
                cumS[2 * lane + 1] = x; cumS[2 * lane] = x - b0; }
            lds_barrier();
            const float ctot = cumS[127];
            for (int i = tid; i < 2048; i += 512) { const int l = i >> 4, pc = i & 15; const float wl = dtS[l] * __expf(ctot - cumS[l]);
                float f[8]; unpack8(lds_ld16(lds + L_B + l * SLD + pc * 16), f);
#pragma unroll
                for (int e = 0; e < 8; ++e) *(LAS bf16*)(lds + L_BT + (pc * 8 + e) * SLD + l * 2) = (bf16)f2bf(f[e] * wl); }
            f32x16 acc0, acc1;
            const int lt = wave >> 1, st0 = 2 * (wave & 1);
            if (lat) {
#pragma unroll
                for (int q = 0; q < 16; ++q) { acc0[q] = 0.f; acc1[q] = 0.f; }
                if (st0 <= lt) {
#pragma unroll
                    for (int ks = 0; ks < 8; ++ks) { const bf16x8_t af = lfrag(lds + L_C, lt * 32 + r, ks * 16 + 8 * hh);
                        acc0 = __builtin_amdgcn_mfma_f32_32x32x16_bf16(af, lfrag(lds + L_B, st0 * 32 + r, ks * 16 + 8 * hh), acc0, 0, 0, 0);
                        if (st0 + 1 <= lt) acc1 = __builtin_amdgcn_mfma_f32_32x32x16_bf16(af, lfrag(lds + L_B, (st0 + 1) * 32 + r, ks * 16 + 8 * hh), acc1, 0, 0, 0); }
                }
            }
            lds_barrier();
            if (lat) {
#pragma unroll
                for (int t = 0; t < 2; ++t) { const int stt = st0 + t;
                    if (stt <= lt) { const int sidx = stt * 32 + r; const float cs = cumS[sidx], ds = dtS[sidx];
#pragma unroll
                        for (int q = 0; q < 16; ++q) { const int l = lt * 32 + (q & 3) + 8 * (q >> 2) + 4 * hh; const float v = t ? acc1[q] : acc0[q];
                            const float wv = sidx <= l ? v * __expf(cumS[l] - cs) * ds : 0.f;
                            *(LAS bf16*)(lds + L_B + l * SLD + sidx * 2) = (bf16)f2bf(wv); } } }
            }
            lds_barrier();
            if (lat) {
                const int pt = wave & 1;
                f32x16 accd, acco;
#pragma unroll
                for (int q = 0; q < 16; ++q) { accd[q] = 0.f; acco[q] = 0.f; }
                for (int ks = 0; ks < 2 * (lt + 1); ++ks)
                    accd = __builtin_amdgcn_mfma_f32_32x32x16_bf16(lfrag(lds + L_B, lt * 32 + r, ks * 16 + 8 * hh), lfrag(lds + L_XT, pt * 32 + r, ks * 16 + 8 * hh), accd, 0, 0, 0);
#pragma unroll
                for (int ks = 0; ks < 8; ++ks)
                    acco = __builtin_amdgcn_mfma_f32_32x32x16_bf16(lfrag(lds + L_C, lt * 32 + r, ks * 16 + 8 * hh), lfrag(lds + L_S, pt * 32 + r, ks * 16 + 8 * hh), acco, 0, 0, 0);
#pragma unroll
                for (int q = 0; q < 16; ++q) { const int l = lt * 32 + (q & 3) + 8 * (q >> 2) + 4 * hh; const float y = accd[q] + __expf(cumS[l]) * acco[q];
                    YS[((size_t)dir * MX + scan_row(n0 + l, dir, b)) * RW + h * 64 + pt * 32 + r] = (bf16)f2bf(y); }
            }
            const int pt2 = wave >> 2, nt = wave & 3;
            { const float dc = __expf(ctot);
#pragma unroll
              for (int q = 0; q < 16; ++q) st[q] *= dc;
#pragma unroll
              for (int ks = 0; ks < 8; ++ks)
                  st = __builtin_amdgcn_mfma_f32_32x32x16_bf16(lfrag(lds + L_XT, pt2 * 32 + r, ks * 16 + 8 * hh), lfrag(lds + L_BT, nt * 32 + r, ks * 16 + 8 * hh), st, 0, 0, 0); }
            lds_barrier();
#pragma unroll
            for (int q = 0; q < 16; ++q) { const int p = pt2 * 32 + (q & 3) + 8 * (q >> 2) + 4 * hh; *(LAS bf16*)(lds + L_S + p * SLD + (nt * 32 + r) * 2) = (bf16)f2bf(st[q]); }
            lds_barrier();
        }
    }
}

constexpr int CR_T = 32, CR_PJ = 144, CR_PS = 80, CR_PF = 272;
constexpr int CR_AR = 0, CR_BK = CR_AR + 64 * CR_PJ, CR_BHT = CR_BK + 64 * CR_PJ, CR_KHT = CR_BHT + 64 * CR_PS, CR_VT = CR_KHT + 64 * CR_PS, CR_SB = CR_VT + 64 * CR_PS,
              CR_NAK = CR_SB + 2 * 64 * CR_PJ, CR_PBR = CR_NAK + 32 * CR_PS, CR_PKR = CR_PBR + 32 * CR_PS, CR_NABF = CR_PKR + 32 * CR_PS, CR_RT = CR_NABF + 32 * CR_PJ,
              CR_SA = CR_RT + 32 * CR_PF, CR_GT = CR_SA + 64 * CR_PS, CR_CP = CR_GT + 256, CR_OB = CR_CP + 16 * 256, CR_END = CR_OB + 32 * 128;
static_assert(CR_END <= 131072, "chunked rwkv lds map");
__device__ __forceinline__ f32x16 mfma32(const bf16x8_t& a, const bf16x8_t& b, const f32x16& c) { return __builtin_amdgcn_mfma_f32_32x32x16_bf16(a, b, c, 0, 0, 0); }
__device__ __forceinline__ bf16x8_t cfrag(const LAS unsigned char* img, int pitch, int row, int k) { return *(const LAS bf16x8_t*)(img + row * pitch + k * 2); }
struct CRaw { unsigned r[2], k[2], kk[2], w[2], al[2], v[2]; };
__device__ __forceinline__ void cr_load(CRaw& x, const bf16* R, const bf16* K, const bf16* V, const bf16* KK, const bf16* LR, int n0, int dir, int b, int chn) {
#pragma unroll
    for (int u = 0; u < 2; ++u) { const size_t m = (size_t)scan_row(n0 + u, dir, b);
        x.r[u] = *(const unsigned*)(R + m * RW + chn); x.k[u] = *(const unsigned*)(K + m * RW + chn); x.kk[u] = *(const unsigned*)(KK + m * RW + chn); x.v[u] = *(const unsigned*)(V + m * RW + chn);
        x.w[u] = *(const unsigned*)(LR + m * NLR + dir * 2048 + chn); x.al[u] = *(const unsigned*)(LR + m * NLR + 4096 + dir * 2048 + chn); }
}
__device__ __forceinline__ void ph_rwkv_chunked(const Args& a, LAS unsigned char* lds) {
    const int tid = TID, lane = LANE, wave = WAVE, r = lane & 31, hh = lane >> 5;
    const bf16* R = (const bf16*)(a.ws + WS_R); const bf16* K = (const bf16*)(a.ws + WS_K); const bf16* V = (const bf16*)(a.ws + WS_V); const bf16* KK = (const bf16*)(a.ws + WS_KK);
    const bf16* LR = (const bf16*)(a.ws + WS_LR); bf16* OR = (bf16*)a.out;
    constexpr int NCH = NSTEP / CR_T;
    LAS float* GT = (LAS float*)(lds + CR_GT); LAS float* CP = (LAS float*)(lds + CR_CP);
    for (int u0 = blockIdx.x; u0 < 256; u0 += gridDim.x) {
        const int g = u0 >> 5, h = u0 & 31, dir = g >> 2, b = g & 3;
        const int jp = lane & 31, sh2 = lane >> 5, chn = h * 64 + 2 * jp, tq = 2 * wave + sh2;
        const float ka0 = a.in[I_KA][chn], ka1 = a.in[I_KA][chn + 1];
        f32x16 st;
#pragma unroll
        for (int q = 0; q < 16; ++q) st[q] = 0.f;
        __syncthreads();
        for (int i = tid; i < 64 * CR_PJ / 4; i += 512) ((LAS unsigned*)(lds + CR_SB))[i] = 0u;
        CRaw raw; cr_load(raw, R, K, V, KK, LR, 2 * tq, dir, b, chn);
        for (int c = 0; c < NCH; ++c) {
            const bool lat = c >= CTXL / CR_T;
            const LAS unsigned char* SBc = lds + CR_SB + (c & 1) * 64 * CR_PJ; LAS unsigned char* SBn = lds + CR_SB + ((c + 1) & 1) * 64 * CR_PJ;
            float rv[2][2], kd[2][2], bv[2][2], av[2][2], vv[2][2], cl[2][2], cx[2][2];
            { float run0 = 1.f, run1 = 1.f;
#pragma unroll
              for (int u = 0; u < 2; ++u) {
                  const float kk0 = bflo(raw.kk[u]), kk1 = bfhi(raw.kk[u]), al0 = bflo(raw.al[u]), al1 = bfhi(raw.al[u]);
                  rv[u][0] = bflo(raw.r[u]); rv[u][1] = bfhi(raw.r[u]); vv[u][0] = bflo(raw.v[u]); vv[u][1] = bfhi(raw.v[u]);
                  av[u][0] = -kk0; av[u][1] = -kk1; bv[u][0] = kk0 * al0; bv[u][1] = kk1 * al1;
                  kd[u][0] = bflo(raw.k[u]) * (1.f + (al0 - 1.f) * ka0); kd[u][1] = bfhi(raw.k[u]) * (1.f + (al1 - 1.f) * ka1);
                  cx[u][0] = run0; cx[u][1] = run1; run0 *= 1.f - bflo(raw.w[u]); run1 *= 1.f - bfhi(raw.w[u]); cl[u][0] = run0; cl[u][1] = run1; }
              *(LAS f32x2_t*)(lds + CR_CP + (tq * 64 + 2 * jp) * 4) = (f32x2_t){run0, run1}; }
            if (c + 1 < NCH) cr_load(raw, R, K, V, KK, LR, (c + 1) * CR_T + 2 * tq, dir, b, chn);
            lds_barrier();
            { float pre0 = 1.f, pre1 = 1.f, tot0 = 1.f, tot1 = 1.f;
#pragma unroll
              for (int q = 0; q < 16; ++q) { const f32x2_t x = *(const LAS f32x2_t*)(lds + CR_CP + (q * 64 + 2 * jp) * 4); tot0 *= x[0]; tot1 *= x[1]; if (q < tq) { pre0 *= x[0]; pre1 *= x[1]; } }
              if (tq == 0) *(LAS f32x2_t*)(lds + CR_GT + 2 * jp * 4) = (f32x2_t){tot0, tot1};
              unsigned bh[2], kh[2], vt[2];
              float tb[2][2], tk[2][2];
#pragma unroll
              for (int u = 0; u < 2; ++u) { const int t = 2 * tq + u;
                  const float g0 = pre0 * cl[u][0], g1 = pre1 * cl[u][1], gp0 = pre0 * cx[u][0], gp1 = pre1 * cx[u][1];
                  const float i0 = __builtin_amdgcn_rcpf(g0), i1 = __builtin_amdgcn_rcpf(g1);
                  *(LAS unsigned*)(lds + CR_AR + t * CR_PJ + jp * 4) = pg8::cvt_pk_bf16(av[u][0] * gp0, av[u][1] * gp1);
                  *(LAS unsigned*)(lds + CR_AR + (32 + t) * CR_PJ + jp * 4) = pg8::cvt_pk_bf16(rv[u][0] * g0, rv[u][1] * g1);
                  *(LAS unsigned*)(lds + CR_BK + t * CR_PJ + jp * 4) = pg8::cvt_pk_bf16(bv[u][0] * i0, bv[u][1] * i1);
                  *(LAS unsigned*)(lds + CR_BK + (32 + t) * CR_PJ + jp * 4) = pg8::cvt_pk_bf16(kd[u][0] * i0, kd[u][1] * i1);
                  tb[u][0] = bv[u][0] * (tot0 * i0); tb[u][1] = bv[u][1] * (tot1 * i1); tk[u][0] = kd[u][0] * (tot0 * i0); tk[u][1] = kd[u][1] * (tot1 * i1); }
#pragma unroll
              for (int ch = 0; ch < 2; ++ch) { bh[ch] = pg8::cvt_pk_bf16(tb[0][ch], tb[1][ch]); kh[ch] = pg8::cvt_pk_bf16(tk[0][ch], tk[1][ch]); vt[ch] = pg8::cvt_pk_bf16(vv[0][ch], vv[1][ch]);
                  *(LAS unsigned*)(lds + CR_BHT + (2 * jp + ch) * CR_PS + tq * 4) = bh[ch]; *(LAS unsigned*)(lds + CR_KHT + (2 * jp + ch) * CR_PS + tq * 4) = kh[ch]; *(LAS unsigned*)(lds + CR_VT + (2 * jp + ch) * CR_PS + tq * 4) = vt[ch]; } }
            lds_barrier();
            f32x16 acc;
#pragma unroll
            for (int q = 0; q < 16; ++q) acc[q] = 0.f;
            if (wave < 4) {
                const int rb = wave >> 1, cb = wave & 1;
#pragma unroll
                for (int ks = 0; ks < 4; ++ks) acc = mfma32(cfrag(lds + CR_BK, CR_PJ, 32 * rb + r, 16 * ks + 8 * hh), cfrag(lds + CR_AR, CR_PJ, 32 * cb + r, 16 * ks + 8 * hh), acc);
#pragma unroll
                for (int gq = 0; gq < 4; ++gq) { float o[4];
#pragma unroll
                    for (int e = 0; e < 4; ++e) { const int sidx = 8 * gq + 4 * hh + e; const bool keep = cb ? (sidx <= r) : (sidx < r); o[e] = keep ? acc[4 * gq + e] : 0.f; }
                    if (wave == 0) {
#pragma unroll
                        for (int e = 0; e < 4; ++e) *(LAS float*)(lds + CR_NABF + r * CR_PJ + (e * 8 + 2 * gq + hh) * 4) = o[e]; }
                    else { LAS unsigned char* dst = lds + (wave == 1 ? CR_PBR : wave == 2 ? CR_NAK : CR_PKR) + r * CR_PS + (8 * gq + 4 * hh) * 2;
                        typedef unsigned u32x2_t __attribute__((ext_vector_type(2))); *(LAS u32x2_t*)dst = (u32x2_t){pk2(o[0], o[1]), pk2(o[2], o[3])}; } }
            } else if (wave < 6 || lat) {
                const int it = wave & 1, cb = wave >> 1 & 1 ? 32 : 0;
#pragma unroll
                for (int ks = 0; ks < 4; ++ks) acc = mfma32(cfrag(SBc, CR_PJ, 32 * it + r, 16 * ks + 8 * hh), cfrag(lds + CR_AR, CR_PJ, cb + r, 16 * ks + 8 * hh), acc);
            }
            lds_barrier();
            if (wave >= 4 && (wave < 6 || lat)) {
                const int it = wave & 1; const LAS unsigned char* NT = lds + (wave < 6 ? CR_NAK : CR_PKR);
#pragma unroll
                for (int ks = 0; ks < 2; ++ks) acc = mfma32(cfrag(lds + CR_VT, CR_PS, 32 * it + r, 16 * ks + 8 * hh), cfrag(NT, CR_PS, r, 16 * ks + 8 * hh), acc);
                if (wave < 6) {
#pragma unroll
                    for (int gq = 0; gq < 4; ++gq) *(LAS f32x4*)(lds + CR_RT + r * CR_PF + (32 * it + 8 * gq + 4 * hh) * 4) = (f32x4){acc[4 * gq], acc[4 * gq + 1], acc[4 * gq + 2], acc[4 * gq + 3]};
                }
            }
            lds_barrier();
            if (wave < 4) {
                const int q = lane & 3, irow = 16 * wave + (lane >> 2);
                const LAS unsigned char* nrow = lds + CR_NABF + q * 32; const LAS unsigned char* rcol = lds + CR_RT + irow * 4;
                float mysa[8];
#pragma unroll
                for (int u = 0; u < 8; ++u) mysa[u] = 0.f;
                f32x4 NA[34], NB[34]; float RH[34];
#pragma unroll
                for (int t = 0; t < 2; ++t) { NA[t] = *(const LAS f32x4*)(nrow + t * CR_PJ); NB[t] = NA[t]; RH[t] = *(const LAS float*)(rcol + t * CR_PF); }
#pragma unroll
                for (int t = 0; t < 32; ++t) {
                    if (t + 2 < 32) { NA[t + 2] = *(const LAS f32x4*)(nrow + (t + 2) * CR_PJ); if (t + 2 > 16) NB[t + 2] = *(const LAS f32x4*)(nrow + (t + 2) * CR_PJ + 16); RH[t + 2] = *(const LAS float*)(rcol + (t + 2) * CR_PF); }
                    asm volatile("" ::: "memory");
                    float p0 = 0.f, p1 = 0.f;
#pragma unroll
                    for (int u = 0; u < 4; ++u) if (u < (t + 3) / 4) { if (u & 1) p1 += mysa[u] * NA[t][u]; else p0 += mysa[u] * NA[t][u]; }
#pragma unroll
                    for (int u = 4; u < 8; ++u) if (u < (t + 3) / 4) { if (u & 1) p1 += mysa[u] * NB[t][u - 4]; else p0 += mysa[u] * NB[t][u - 4]; }
                    float part = p0 + p1;
                    part += dppf<0xB1>(part); part += dppf<0x4E>(part);
                    const float x = RH[t] + part;
                    mysa[t >> 2] = (q == (t & 3)) ? x : mysa[t >> 2];
                    asm volatile("" : "+v"(mysa[t >> 2]));
                }
#pragma unroll
                for (int u = 0; u < 8; ++u) *(LAS bf16*)(lds + CR_SA + irow * CR_PS + (4 * u + q) * 2) = (bf16)f2bf(mysa[u]);
            }
            lds_barrier();
            if (wave < 4) {
                const int jt = wave >> 1, it = wave & 1;
#pragma unroll
                for (int gq = 0; gq < 4; ++gq) { const f32x4 gv = *(LAS f32x4*)(lds + CR_GT + (32 * jt + 8 * gq + 4 * hh) * 4);
#pragma unroll
                    for (int e = 0; e < 4; ++e) st[4 * gq + e] *= gv[e]; }
#pragma unroll
                for (int ks = 0; ks < 2; ++ks) { st = mfma32(cfrag(lds + CR_BHT, CR_PS, 32 * jt + r, 16 * ks + 8 * hh), cfrag(lds + CR_SA, CR_PS, 32 * it + r, 16 * ks + 8 * hh), st);
                    st = mfma32(cfrag(lds + CR_KHT, CR_PS, 32 * jt + r, 16 * ks + 8 * hh), cfrag(lds + CR_VT, CR_PS, 32 * it + r, 16 * ks + 8 * hh), st); }
#pragma unroll
                for (int gq = 0; gq < 4; ++gq) { typedef unsigned u32x2_t __attribute__((ext_vector_type(2)));
                    *(LAS u32x2_t*)(SBn + (32 * it + r) * CR_PJ + (32 * jt + 8 * gq + 4 * hh) * 2) = (u32x2_t){pk2(st[4 * gq], st[4 * gq + 1]), pk2(st[4 * gq + 2], st[4 * gq + 3])}; }
            } else if (wave >= 6 && lat) {
                const int it = wave & 1;
#pragma unroll
                for (int ks = 0; ks < 2; ++ks) acc = mfma32(cfrag(lds + CR_SA, CR_PS, 32 * it + r, 16 * ks + 8 * hh), cfrag(lds + CR_PBR, CR_PS, r, 16 * ks + 8 * hh), acc);
#pragma unroll
                for (int gq = 0; gq < 4; ++gq) { typedef unsigned u32x2_t __attribute__((ext_vector_type(2)));
                    *(LAS u32x2_t*)(lds + CR_OB + r * 128 + (32 * it + 8 * gq + 4 * hh) * 2) = (u32x2_t){pk2(acc[4 * gq], acc[4 * gq + 1]), pk2(acc[4 * gq + 2], acc[4 * gq + 3])}; }
            }
            lds_barrier();
            if (lat) { const int ss = tid >> 4, cgp = tid & 15; typedef unsigned u32x2_t __attribute__((ext_vector_type(2)));
                const u32x2_t ov = *(const LAS u32x2_t*)(lds + CR_OB + ss * 128 + cgp * 8);
                *(uint2*)(OR + ((size_t)dir * MX + scan_row(c * CR_T + ss, dir, b)) * RW + h * 64 + cgp * 4) = make_uint2(ov[0], ov[1]); }
        }
    }
}

__device__ __forceinline__ void ph_finish(const Args& a) {
    const int lane = LANE;
    const bf16* R = (const bf16*)(a.ws + WS_R); const bf16* K = (const bf16*)(a.ws + WS_K); const bf16* V = (const bf16*)(a.ws + WS_V);
    const bf16* LR = (const bf16*)(a.ws + WS_LR); const bf16* XS = (const bf16*)(a.ws + WS_XS); const bf16* Z = (const bf16*)(a.ws + WS_Z);
    const bf16* OR = (const bf16*)a.out; const bf16* YS = (const bf16*)a.out + (size_t)2 * MX * RW;
    bf16* A2 = (bf16*)(a.ws + WS_A2);
    for (int m = GW; m < MX; m += NGW) {
#pragma unroll
        for (int i = 0; i < 4; ++i) {
            const int c0 = (lane + 64 * i) * 8;
            float of[8], ob[8], o[8], res[8];
#if MK_SKIP_RWKV
#pragma unroll
            for (int e = 0; e < 8; ++e) res[e] = 0.f;
#else
            unpack8(ld16(OR + (size_t)m * RW + c0), of); unpack8(ld16(OR + ((size_t)MX + m) * RW + c0), ob);
            float sm = 0.f;
#pragma unroll
            for (int e = 0; e < 8; ++e) { o[e] = of[e] + ob[e]; sm += o[e]; }
            sm = sum8(sm);
            const float mean = sm * (1.f / 64.f); float sq = 0.f;
#pragma unroll
            for (int e = 0; e < 8; ++e) { o[e] -= mean; sq += o[e] * o[e]; }
            sq = sum8(sq);
            const float rstd = rsqrtf(sq * (1.f / 64.f) + GN_EPS);
            float lw[8], lb[8], r[8], k[8], v[8], a0[8], a1[8], ka[8], rk[8], gg[8];
            ldf8(a.in[I_LNW] + c0, lw); ldf8(a.in[I_LNB] + c0, lb); ldf8(a.in[I_KA] + c0, ka); ldf8(a.in[I_RK] + c0, rk);
            unpack8(ld16(R + (size_t)m * RW + c0), r); unpack8(ld16(K + (size_t)m * RW + c0), k); unpack8(ld16(V + (size_t)m * RW + c0), v);
            unpack8(ld16(LR + (size_t)m * NLR + 4096 + c0), a0); unpack8(ld16(LR + (size_t)m * NLR + 6144 + c0), a1); unpack8(ld16(LR + (size_t)m * NLR + 8192 + c0), gg);
            float bs = 0.f;
#pragma unroll
            for (int e = 0; e < 8; ++e) { const float kd = k[e] * (2.f + (a0[e] + a1[e] - 2.f) * ka[e]); bs += r[e] * kd * rk[e]; }
            bs = sum8(bs);
#pragma unroll
            for (int e = 0; e < 8; ++e) res[e] = (o[e] * rstd * lw[e] + lb[e] + bs * v[e]) * gg[e];
#endif
            st16(A2 + (size_t)m * DM + c0, pack8(res));
        }
#pragma unroll
        for (int i = 0; i < 4; ++i) {
            const int c0 = (lane + 64 * i) * 8;
            float yf[8], yb[8], xs[8], z[8], nw[8], y[8];
#if MK_SKIP_SSD
#pragma unroll
            for (int e = 0; e < 8; ++e) y[e] = 0.f;
#else
            unpack8(ld16(YS + (size_t)m * RW + c0), yf); unpack8(ld16(YS + ((size_t)MX + m) * RW + c0), yb);
            unpack8(ld16(XS + (size_t)m * RW + c0), xs); unpack8(ld16(Z + (size_t)m * RW + c0), z); ldf8(a.in[I_NORMW] + c0, nw);
            const float dsk = a.in[I_SSMD][c0 >> 6]; float ss = 0.f;
#pragma unroll
            for (int e = 0; e < 8; ++e) { y[e] = (yf[e] + yb[e] + dsk * xs[e]) * (z[e] / (1.f + __expf(-z[e]))); ss += y[e] * y[e]; }
            ss = sum32(ss);
            const float rstd = rsqrtf(ss * (1.f / 256.f) + RMS_EPS);
#pragma unroll
            for (int e = 0; e < 8; ++e) y[e] = y[e] * rstd * nw[e];
#endif
            st16(A2 + (size_t)m * DM + 2048 + c0, pack8(y));
        }
    }
}

__device__ __forceinline__ float enc_key(float v, int idx) { return __uint_as_float((__float_as_uint(v) & 0xffffff00u) | (unsigned)idx); }
typedef float f32x32_t __attribute__((ext_vector_type(32)));
typedef unsigned u32x6_t __attribute__((ext_vector_type(6)));
struct Fp6Row { uint4 q0, q1, q2; };
__device__ __forceinline__ Fp6Row ld_fp6row(const unsigned char* p) { Fp6Row r; r.q0 = *(const uint4*)p; r.q1 = *(const uint4*)(p + 1024); r.q2 = *(const uint4*)(p + 2048); return r; }
__device__ __forceinline__ f32x32_t fp6_unpack(const Fp6Row& r, int p, float one) {
    u32x6_t s; if (p == 0) { s[0] = r.q0.x; s[1] = r.q0.y; s[2] = r.q0.z; s[3] = r.q0.w; s[4] = r.q1.x; s[5] = r.q1.y; } else { s[0] = r.q1.z; s[1] = r.q1.w; s[2] = r.q2.x; s[3] = r.q2.y; s[4] = r.q2.z; s[5] = r.q2.w; }
    return __builtin_amdgcn_cvt_scalef32_pk32_f32_fp6(s, one);
}
#define PIN4(a) asm volatile("" : "+v"((a)[0]), "+v"((a)[1]), "+v"((a)[2]), "+v"((a)[3]))
__device__ __forceinline__ void ph_peer(const Args& a, float* outp) {
    const int lane = LANE;
    const float* mod = (const float*)(a.ws + WS_MOD); const float* S = (const float*)(a.ws + WS_S);
    const unsigned char* U8 = (const unsigned char*)(a.ws + WS_U8); const unsigned char* V8 = (const unsigned char*)(a.ws + WS_V8);
    const float* USC = (const float*)(a.ws + WS_USC); const float* VSC = (const float*)(a.ws + WS_VSC);
    for (int m = GW; m < MX; m += NGW) {
        const int bb = m / SEQ;
        float* hrow = a.out + (size_t)m * DM;
        int l4 = lane * 4; asm volatile("" : "+v"(l4));
        float acc[16][4];
#if MK_SKIP_PEER
#pragma unroll
        for (int j = 0; j < 16; ++j)
#pragma unroll
            for (int e = 0; e < 4; ++e) acc[j][e] = 0.f;
#else
        float xn[16][4];
        { float ss = 0.f;
#pragma unroll
          for (int j = 0; j < 16; ++j) { const float4 h4 = *(const float4*)(hrow + 256 * j + l4); xn[j][0] = h4.x; xn[j][1] = h4.y; xn[j][2] = h4.z; xn[j][3] = h4.w; ss += (h4.x * h4.x + h4.y * h4.y) + (h4.z * h4.z + h4.w * h4.w); }
          const float rstd = rsqrtf(wave_sum(ss) * (1.f / DM) + RMS_EPS);
          const float* sh2 = mod + (size_t)bb * NMOD + 3 * DM; const float* sc2 = mod + (size_t)bb * NMOD + 4 * DM; const float* g2 = a.in[I_N2G];
#pragma unroll
          for (int j = 0; j < 16; ++j) { const int c = 256 * j + l4; const float4 gg = *(const float4*)(g2 + c), s0 = *(const float4*)(sh2 + c), s1 = *(const float4*)(sc2 + c);
              xn[j][0] = xn[j][0] * rstd * gg.x * (1.f + s1.x) + s0.x; xn[j][1] = xn[j][1] * rstd * gg.y * (1.f + s1.y) + s0.y; xn[j][2] = xn[j][2] * rstd * gg.z * (1.f + s1.z) + s0.z; xn[j][3] = xn[j][3] * rstd * gg.w * (1.f + s1.w) + s0.w;
              if ((j & 3) == 3) { PIN4(xn[j - 3]); PIN4(xn[j - 2]); PIN4(xn[j - 1]); PIN4(xn[j]); asm volatile("" ::: "memory"); } } }
        int eid0 = 0, eid1 = 0; float gt0 = 0.f, gt1 = 0.f;
        const float NEG = -3.0e38f;
#pragma unroll 1
        for (int hd = 0; hd < 8; ++hd) {
            const float* srow = S + (size_t)m * 2048 + hd * 256;
            float c1a = enc_key(srow[lane], lane), c1b = enc_key(srow[64 + lane], 64 + lane), c2a = enc_key(srow[128 + lane], lane), c2b = enc_key(srow[192 + lane], 64 + lane);
            float t1 = NEG, t2 = NEG;
#pragma unroll 1
            for (int k = 0; k < 16; ++k) {
                const float m1 = wave_max(fmaxf(c1a, c1b)), m2 = wave_max(fmaxf(c2a, c2b));
                if (c1a == m1) c1a = NEG; if (c1b == m1) c1b = NEG; if (c2a == m2) c2a = NEG; if (c2b == m2) c2b = NEG;
                if (lane == k) { t1 = m1; t2 = m2; }
            }
            const float v1 = __uint_as_float(__float_as_uint(t1) & 0xffffff00u), v2 = __uint_as_float(__float_as_uint(t2) & 0xffffff00u);
            const int i1 = (int)(__float_as_uint(t1) & 0xffu), i2 = (int)(__float_as_uint(t2) & 0xffu);
            float cd[4];
#pragma unroll
            for (int e = 0; e < 4; ++e) { const float va = __shfl(v1, (lane >> 4) + 4 * e), vb = __shfl(v2, lane & 15); cd[e] = enc_key(va + vb, lane + 64 * e); }
            float best = NEG; int ex = 0;
#pragma unroll 1
            for (int k = 0; k < 16; ++k) {
                const float mx = wave_max(fmaxf(fmaxf(cd[0], cd[1]), fmaxf(cd[2], cd[3])));
#pragma unroll
                for (int e = 0; e < 4; ++e) if (cd[e] == mx) cd[e] = NEG;
                const int cidx = (int)(__float_as_uint(mx) & 0xffu);
                const int ea = __shfl(i1, cidx >> 4), eb = __shfl(i2, cidx & 15);
                if (lane == k) { best = __uint_as_float(__float_as_uint(mx) & 0xffffff00u); ex = ea * 128 + eb; }
            }
            const float bmax = __shfl(best, 0);
            const float pe = lane < 16 ? __expf(best - bmax) : 0.f;
            const float gate = pe / wave_sum(pe);
            const float gsh = __shfl(gate, lane & 15); const int esh = __shfl(ex, lane & 15);
            if ((lane >> 4) == (hd & 3)) { if (hd < 4) { gt0 = gsh; eid0 = esh; } else { gt1 = gsh; eid1 = esh; } }
        }
        const int l48 = lane * 16;
        float cf0 = 0.f, cf1 = 0.f;
        {
            Fp6Row qa[4], qb[4];
#pragma unroll
            for (int q = 0; q < 4; ++q) { const int e = __builtin_amdgcn_readlane(eid0, q); qa[q] = ld_fp6row(U8 + (size_t)e * 3072 + l48); }
#pragma unroll 1
            for (int p0 = 0; p0 < 128; p0 += 8) {
#pragma unroll
                for (int half = 0; half < 2; ++half) {
                    const int pb = p0 + 4 * half;
                    float d[4];
#pragma unroll
                    for (int q = 0; q < 4; ++q) {
                        if (q == 2 && pb + 4 < 128) { asm volatile("" ::: "memory");
#pragma unroll
                            for (int q2 = 0; q2 < 4; ++q2) { const int e = __builtin_amdgcn_readlane(pb + 4 < 64 ? eid0 : eid1, (pb + 4 + q2) & 63); const Fp6Row t = ld_fp6row(U8 + (size_t)e * 3072 + l48); if (half) qa[q2] = t; else qb[q2] = t; }
                        }
                        float dd = 0.f;
#pragma unroll
                        for (int p = 0; p < 2; ++p) { float one = 1.0f; asm volatile("" : "+v"(one)); const f32x32_t f = fp6_unpack(half ? qb[q] : qa[q], p, one);
#pragma unroll
                            for (int t = 0; t < 32; ++t) dd += xn[8 * p + (t >> 2)][t & 3] * f[t];
                            asm volatile("" : "+v"(dd)); }
                        d[q] = dd;
                    }
#pragma unroll
                    for (int q = 0; q < 4; ++q) {
                        const int p = pb + q; const int e = __builtin_amdgcn_readlane(pb < 64 ? eid0 : eid1, p & 63);
                        const float dot = wave_sum(d[q]) * USC[e];
                        const float act = 0.5f * dot * (1.f + erff(dot * 0.70710678f)) * VSC[e];
                        if (lane == (p & 63)) { if (pb < 64) cf0 = gt0 * act; else cf1 = gt1 * act; }
                    }
                }
            }
        }
#pragma unroll
        for (int j = 0; j < 16; ++j)
#pragma unroll
            for (int e = 0; e < 4; ++e) acc[j][e] = 0.f;
        {
            Fp6Row qa[4], qb[4];
#pragma unroll
            for (int q = 0; q < 4; ++q) { const int e = __builtin_amdgcn_readlane(eid0, q); qa[q] = ld_fp6row(V8 + (size_t)e * 3072 + l48); }
#pragma unroll 1
            for (int p0 = 0; p0 < 128; p0 += 8) {
#pragma unroll
                for (int half = 0; half < 2; ++half) {
                    const int pb = p0 + 4 * half;
                    float cfv[4];
#pragma unroll
                    for (int q = 0; q < 4; ++q) cfv[q] = rlane(pb < 64 ? cf0 : cf1, (pb + q) & 63);
#pragma unroll
                    for (int q = 0; q < 4; ++q) {
                        if (q == 2 && pb + 4 < 128) { asm volatile("" ::: "memory");
#pragma unroll
                            for (int q2 = 0; q2 < 4; ++q2) { const int e = __builtin_amdgcn_readlane(pb + 4 < 64 ? eid0 : eid1, (pb + 4 + q2) & 63); const Fp6Row t = ld_fp6row(V8 + (size_t)e * 3072 + l48); if (half) qa[q2] = t; else qb[q2] = t; }
                        }
#pragma unroll
                        for (int p = 0; p < 2; ++p) { float one = 1.0f; asm volatile("" : "+v"(one)); const f32x32_t f = fp6_unpack(half ? qb[q] : qa[q], p, one);
#pragma unroll
                            for (int t = 0; t < 32; ++t) acc[8 * p + (t >> 2)][t & 3] += cfv[q] * f[t];
#pragma unroll
                            for (int jj = 0; jj < 8; ++jj) PIN4(acc[8 * p + jj]); }
                    }
                }
            }
        }
#endif
        { const float* gt2 = mod + (size_t)bb * NMOD + 5 * DM; float ss = 0.f;
          int l4 = lane * 4; asm volatile("" : "+v"(l4));
#pragma unroll
          for (int j = 0; j < 16; ++j) { const int c = 256 * j + l4; const float4 g = *(const float4*)(gt2 + c), h4 = *(const float4*)(hrow + c);
              acc[j][0] = h4.x + g.x * acc[j][0]; acc[j][1] = h4.y + g.y * acc[j][1]; acc[j][2] = h4.z + g.z * acc[j][2]; acc[j][3] = h4.w + g.w * acc[j][3];
              ss += (acc[j][0] * acc[j][0] + acc[j][1] * acc[j][1]) + (acc[j][2] * acc[j][2] + acc[j][3] * acc[j][3]);
              if ((j & 3) == 3) { PIN4(acc[j - 3]); PIN4(acc[j - 2]); PIN4(acc[j - 1]); PIN4(acc[j]); asm volatile("" ::: "memory"); } }
          const float rstd = rsqrtf(wave_sum(ss) * (1.f / DM) + RMS_EPS);
#pragma unroll
          for (int j = 0; j < 16; ++j) { const int c = 256 * j + l4; const float4 fg = *(const float4*)(a.in[I_FG] + c);
              *(float4*)(outp + (size_t)m * DM + c) = make_float4(acc[j][0] * rstd * fg.x, acc[j][1] * rstd * fg.y, acc[j][2] * rstd * fg.z, acc[j][3] * rstd * fg.w);
              if ((j & 3) == 3) asm volatile("" ::: "memory"); } }
    }
}

constexpr int N_PHASES = 13;
__global__ void __launch_bounds__(512, 2) hybrid_fwd(Args args) {
    extern __shared__ __attribute__((aligned(16))) unsigned char lds_raw[];
    LAS unsigned char* lds = (LAS unsigned char*)lds_raw;
    volatile LAS unsigned* MISC = (volatile LAS unsigned*)(lds + LDS_MISC);
    for (int u = TID; u < (LDS_BYTES - LDS_CTL) / 4; u += 512) ((LAS unsigned*)(lds + LDS_CTL))[u] = 0u;
    __syncthreads();
    const int lo = args.ph_lo, hi = args.ph_hi;
    XcdBarrier bar; bar.bar = (unsigned*)(args.ws + WS_CTL); bar.x = 0; bar.st = nullptr;
    if (hi - lo > 1) bar = xcd_barrier_post((unsigned*)(args.ws + WS_CTL), MISC + 8);
#define IN(k) (lo <= (k) && (k) < hi && ((MK_PHASE_MASK >> (k)) & 1))
#define SEAM(k) do { if (IN(k) && IN((k) + 1)) xcd_barrier(bar); } while (0)
    const int bid = (int)blockIdx.x, G = (int)gridDim.x;

    if (IN(0)) { ph_mod(args, lds); ph_conv(args, lds); if (MK_REPEAT == 0) { ph_mod(args, lds); ph_conv(args, lds); } }
    SEAM(0);
    if (IN(1)) { ph_norm1(args); if (MK_REPEAT == 1) ph_norm1(args); }
    SEAM(1);
    if (IN(2)) { pg8::Gemm g{(const bf16*)(args.ws + WS_A1), (const bf16*)(args.ws + WS_WT_IN), MT, NINP, DM, DM, DM, 0, 0}; pg8::StaticOrder S; S.init(MT, NINP, G, bid);
        pg8::EpiBf16<0> E{(bf16*)(args.ws + WS_P), NINP, nullptr, 0, 0}; pg8::gemm_phase<pg8::EpiBf16<0>, pg8::StaticOrder>(lds, g, S, E, nullptr); }
    SEAM(2);
    if (IN(3)) { ph_prep_stage(args, lds); ph_prep_rwkv(args, lds); ph_prep_ssd(args, lds); if (MK_REPEAT == 3) { ph_prep_rwkv(args, lds); ph_prep_ssd(args, lds); } }
    SEAM(3);
    if (IN(4)) { int kw = KLRW; asm volatile("" : "+s"(kw));
        pg8::Gemm g{(const bf16*)(args.ws + WS_ALR), (const bf16*)(args.ws + WS_WLR), MT, NLR, kw, KLR, KLRW, 4, 256}; pg8::StaticOrder S; S.init(MT, NLR, G, bid);
        EpiLR E{(bf16*)(args.ws + WS_LR), args.in[I_W0], args.in[I_A0]}; pg8::gemm_phase<EpiLR, pg8::StaticOrder>(lds, g, S, E, nullptr); }
    SEAM(4);
#if MK_RWKV_SEQ
    if (IN(5)) { ph_rwkv_scan(args); if (MK_REPEAT == 5) ph_rwkv_scan(args); }
#else
    if (IN(5)) {
#if MK_RWKV_LDS
        ph_rwkv_scan2(args, lds); if (MK_REPEAT == 5) ph_rwkv_scan2(args, lds);
#else
        ph_rwkv_chunked(args, lds); if (MK_REPEAT == 5) ph_rwkv_chunked(args, lds);
#endif
    }
#endif
    SEAM(5);
#if MK_SSD_SEQ
    if (IN(6)) { ph_ssd_scan(args); if (MK_REPEAT == 6) ph_ssd_scan(args); }
#else
    if (IN(6)) { ph_ssd_chunked(args, lds); if (MK_REPEAT == 6) ph_ssd_chunked(args, lds); }
#endif
    SEAM(6);
    if (IN(7)) { ph_finish(args); if (MK_REPEAT == 7) ph_finish(args); }
    SEAM(7);
    if (IN(8)) { pg8::Gemm g{(const bf16*)(args.ws + WS_A2), (const bf16*)(args.ws + WS_WT_OUT), MX, DM, DM, DM, DM, 0, 0}; pg8::StaticOrder S; S.init(MX, DM, G, bid);
        EpiRes E{args.out, args.in[I_X], (const float*)(args.ws + WS_MOD)}; pg8::gemm_phase<EpiRes, pg8::StaticOrder>(lds, g, S, E, nullptr); }
    SEAM(8);
    if (IN(9)) { ph_norm2(args); if (MK_REPEAT == 9) ph_norm2(args); }
    SEAM(9);
    if (IN(10)) { pg8::Gemm g{(const bf16*)(args.ws + WS_XN2), (const bf16*)(args.ws + WS_WT_Q), MX, 2048, DM, DM, DM, 0, 0}; pg8::StaticOrder S; S.init(MX, 2048, G, bid);
        pg8::EpiBf16<0> E{(bf16*)(args.ws + WS_Q), 2048, nullptr, 0, 0}; pg8::gemm_phase<pg8::EpiBf16<0>, pg8::StaticOrder>(lds, g, S, E, nullptr); }
    SEAM(10);
    if (IN(11)) { int kw = 256; asm volatile("" : "+s"(kw));
        pg8::Gemm g{(const bf16*)(args.ws + WS_Q), (const bf16*)(args.ws + WS_KBD), MX, 2048, kw, 2048, 256, 0, 256}; pg8::StaticOrder S; S.init(MX, 2048, G, bid);
        pg8::EpiF32 E{(float*)(args.ws + WS_S), 2048, nullptr}; pg8::gemm_phase<pg8::EpiF32, pg8::StaticOrder>(lds, g, S, E, nullptr); }
    SEAM(11);
    if (IN(12)) { if (MK_REPEAT == 12) ph_peer(args, (float*)(args.ws + 903 * MiB)); ph_peer(args, args.out); }
#undef IN
#undef SEAM
}

extern "C" void kernel_launch(void* const* d_in, const int* in_sizes, int n_in, void* d_out, int out_size, void* d_ws, size_t ws_size, hipStream_t stream) {
    static int grid = 0;
    if (grid == 0) {
        if (n_in != N_IN || out_size != MX * DM || ws_size < WS_END) { fprintf(stderr, "kernel_launch: unexpected shapes (n_in %d out %d ws %zu)\n", n_in, out_size, ws_size); grid = -1; return; }
        int dev = 0, cus = 0, per_cu = 0;
        if (hipGetDevice(&dev) != hipSuccess || hipDeviceGetAttribute(&cus, hipDeviceAttributeMultiprocessorCount, dev) != hipSuccess) { grid = -1; return; }
        if (hipFuncSetAttribute((const void*)hybrid_fwd, hipFuncAttributeMaxDynamicSharedMemorySize, LDS_BYTES) != hipSuccess) { fprintf(stderr, "kernel_launch: hipFuncSetAttribute failed\n"); grid = -1; return; }
        if (hipOccupancyMaxActiveBlocksPerMultiprocessor(&per_cu, (const void*)hybrid_fwd, 512, LDS_BYTES) != hipSuccess || per_cu < 1) fprintf(stderr, "kernel_launch: occupancy query reports %d\n", per_cu);
        (void)hipGetLastError();
        grid = cus;
    }
    if (grid < 0) return;
    (void)in_sizes;
    if (hipMemsetAsync((char*)d_ws + WS_CTL, 0, CTL_ZERO_BYTES, stream) != hipSuccess) return;
    Args a{};
    for (int i = 0; i < N_IN; ++i) a.in[i] = (const float*)d_in[i];
    a.out = (float*)d_out; a.ws = (unsigned char*)d_ws;
#if MK_N_LAUNCHES == 1
    a.ph_lo = 0; a.ph_hi = N_PHASES;
    hipLaunchKernelGGL(hybrid_fwd, dim3(grid), dim3(512), LDS_BYTES, stream, a);
#else
    for (int ph = 0; ph < N_PHASES; ++ph) { if (!((MK_PHASE_MASK >> ph) & 1)) continue; a.ph_lo = ph; a.ph_hi = ph + 1; hipLaunchKernelGGL(hybrid_fwd, dim3(grid), dim3(512), LDS_BYTES, stream, a); }
#endif
}
```

```cpp
#define MK_PEER_FP4 0
#include <hip/hip_runtime.h>
#include <stdint.h>
#include <stdio.h>
namespace pg8 {
#define PG8_LAS __attribute__((address_space(3)))
typedef unsigned short bf16_t;
typedef short bf16x8 __attribute__((ext_vector_type(8)));
typedef float f32x4 __attribute__((ext_vector_type(4)));
typedef unsigned u32x4 __attribute__((ext_vector_type(4)));
constexpr int BM = 256, BK = 64, HALF = 128, HTB = HALF * BK * 2  , STAGE_BYTES = 8 * HTB, NXCD = 8, WGM = 8;

__host__ __device__ __forceinline__ int lds_byte(int r, int c) { const int st = (r >> 4) * 2 + (c >> 5), rr = r & 15, cc = c & 31, ob = rr * 64 + cc * 2; return st * 1024 + (ob ^ (((ob >> 9) & 1) << 5)); }
__host__ __device__ __forceinline__ void stage_rc(int b, int& R, int& C) { const int st = b / 1024, sb = b % 1024, swz = sb ^ (((sb >> 9) & 1) << 5); R = (st >> 1) * 16 + swz / 64; C = (st & 1) * 32 + (swz % 64) / 2; }
__host__ __device__ __forceinline__ int perm32(int rho) { const int n = rho >> 4, i = rho & 15; return 8 * (i >> 2) + 4 * n + (i & 3); }

struct Unit { int pm, pn; };
struct Gemm { const bf16_t* A; const bf16_t* Bt; int M, N, K; int lda, ldb, kshift, kmul; };

struct StaticOrder {
    int nM, nN, nwg, G, c;
    __host__ __device__ void init(int M, int N, int G_, int c_) { nM = M / BM; nN = N / BM; nwg = nM * nN; G = G_; c = c_; }
    __host__ __device__ bool next(int i, Unit& u) const {
        const long L = (long)i * G + c; if (L >= nwg) return false;
        int wgid = (int)L; { const int q = nwg / NXCD, r = nwg % NXCD, xcd = wgid % NXCD, off = wgid / NXCD; wgid = (xcd < r ? xcd * (q + 1) : r * (q + 1) + (xcd - r) * q) + off; }
        const int nig = WGM * nN, gid = wgid / nig, fm = gid * WGM, gsz = (nM - fm) < WGM ? (nM - fm) : WGM;
        u.pm = fm + ((wgid % nig) % gsz); u.pn = (wgid % nig) / gsz; return true;
    }
    __device__ __forceinline__ void a_ready(const Unit&) const {}
    __device__ __forceinline__ void done(const Unit&) const {}
};
__device__ __forceinline__ unsigned cvt_pk_bf16(float lo, float hi) { unsigned r; asm volatile("v_cvt_pk_bf16_f32 %0, %1, %2" : "=v"(r) : "v"(lo), "v"(hi)); return r; }
typedef float f32x2 __attribute__((ext_vector_type(2)));
__device__ __forceinline__ f32x2 gelu_pk(f32x2 v) {
    const f32x2 av = __builtin_elementwise_abs(v), d = av * 0.2316418882f + 1.0f;
    f32x2 t; t.x = __builtin_amdgcn_rcpf(d.x); t.y = __builtin_amdgcn_rcpf(d.y);
    f32x2 q = t * 0.5307027145f + (-0.7265760135f); q = q * t + 0.7107068705f; q = q * t + (-0.142248368f); q = q * t + 0.127414796f; q = q * t;
    const f32x2 s = (v * v) * (-0.72134752044f);
    f32x2 e; e.x = __builtin_amdgcn_exp2f(s.x); e.y = __builtin_amdgcn_exp2f(s.y);
    const f32x2 m = v * (q * e), r = v - m;
    f32x2 o; o.x = v.x < 0.f ? m.x : r.x; o.y = v.y < 0.f ? m.y : r.y; return o;
}

struct EpiF32 {
    static constexpr bool PERM = false, AFTER_DRAIN = false;
    float* C; int ldc; const float* bias;
    __device__ __forceinline__ void operator()(const f32x4 (&acc)[2][2][4][2], const Unit& u, int wr, int wc, int fr, int fq) const {
        const int row0 = u.pm * BM + wr * 64 + fr, col0 = u.pn * BM + wc * 32 + 4 * fq;
        f32x4 bv[2][2];
#pragma unroll
        for (int bj = 0; bj < 2; ++bj)
#pragma unroll
            for (int n = 0; n < 2; ++n) bv[bj][n] = bias ? *(const f32x4*)(bias + col0 + bj * HALF + n * 16) : (f32x4){0.f, 0.f, 0.f, 0.f};
#pragma unroll
        for (int ai = 0; ai < 2; ++ai)
#pragma unroll
            for (int m = 0; m < 4; ++m) { float* rowp = C + (size_t)(row0 + ai * HALF + m * 16) * ldc + col0;
#pragma unroll
                for (int bj = 0; bj < 2; ++bj)
#pragma unroll
                    for (int n = 0; n < 2; ++n) *(f32x4*)(rowp + bj * HALF + n * 16) = acc[ai][bj][m][n] + bv[bj][n]; }
    }
};
template <int ACT  > struct EpiBf16 {
    static constexpr bool PERM = true, AFTER_DRAIN = false;
    bf16_t* O; int ldc; const float* bias; int split_cols; size_t split_stride;
    __device__ __forceinline__ void operator()(const f32x4 (&acc)[2][2][4][2], const Unit& u, int wr, int wc, int fr, int fq) const {
        const int row0 = u.pm * BM + wr * 64 + fr; int colt = u.pn * BM; bf16_t* base = O;
        if (split_cols) { const int t = colt / split_cols; base += (size_t)t * split_stride; colt -= t * split_cols; }
        const int col0 = colt + wc * 32 + 8 * fq, bcol0 = u.pn * BM + wc * 32 + 8 * fq;
        f32x4 bv[2][2];
#pragma unroll
        for (int bj = 0; bj < 2; ++bj)
#pragma unroll
            for (int n = 0; n < 2; ++n) bv[bj][n] = bias ? *(const f32x4*)(bias + bcol0 + bj * HALF + 4 * n) : (f32x4){0.f, 0.f, 0.f, 0.f};
#pragma unroll
        for (int ai = 0; ai < 2; ++ai)
#pragma unroll
            for (int m = 0; m < 4; ++m) { bf16_t* rowp = base + (size_t)(row0 + ai * HALF + m * 16) * ldc + col0;
#pragma unroll
                for (int bj = 0; bj < 2; ++bj) { f32x4 v0 = acc[ai][bj][m][0] + bv[bj][0], v1 = acc[ai][bj][m][1] + bv[bj][1];
                    if (ACT == 1) { f32x2 a = gelu_pk((f32x2){v0[0], v0[1]}), b = gelu_pk((f32x2){v0[2], v0[3]}), c = gelu_pk((f32x2){v1[0], v1[1]}), d = gelu_pk((f32x2){v1[2], v1[3]});
                        v0 = (f32x4){a.x, a.y, b.x, b.y}; v1 = (f32x4){c.x, c.y, d.x, d.y}; }
                    if (ACT == 2) {
#pragma unroll
                        for (int j = 0; j < 4; ++j) { v0[j] = 0.5f * v0[j] * (1.0f + erff(v0[j] * 0.70710678f)); v1[j] = 0.5f * v1[j] * (1.0f + erff(v1[j] * 0.70710678f)); } }
                    u32x4 w; w.x = cvt_pk_bf16(v0[0], v0[1]); w.y = cvt_pk_bf16(v0[2], v0[3]); w.z = cvt_pk_bf16(v1[0], v1[1]); w.w = cvt_pk_bf16(v1[2], v1[3]);
                    *(u32x4*)(rowp + bj * HALF) = w; } }
    }
};
template <class Epi, class Sched, bool STAMP = false>
__device__ __forceinline__ void gemm_phase(PG8_LAS unsigned char* lds, const Gemm g, const Sched& S, const Epi& E, unsigned long long* stamps) {
    const int tid = threadIdx.x, wid = __builtin_amdgcn_readfirstlane(tid >> 6), lane = tid & 63, wr = wid >> 2, wc = wid & 3, fr = lane & 15, fq = lane >> 4;
    const int K = g.K, nt = K / BK;
    int ts_lo = 0, ts_hi = 0, nts = 0; const unsigned long long rt_entry = STAMP ? (unsigned long long)wall_clock64() : 0ull;
#define PG8_STAMP() do { if (STAMP && wid == 0 && nts < 64) { const unsigned long long _c = (unsigned long long)clock64(); \
        ts_lo = (lane == nts) ? (int)(unsigned)_c : ts_lo; ts_hi = (lane == nts) ? (int)(unsigned)(_c >> 32) : ts_hi; ++nts; } } while (0)
    PG8_STAMP();
    unsigned voffA[2], voffB[2];
#pragma unroll
    for (int i = 0; i < 2; ++i) { int R, C; stage_rc(tid * 16 + i * 8192, R, C); const int Rb = Epi::PERM ? ((R & ~31) + perm32(R & 31)) : R;
        voffA[i] = (unsigned)(R * g.lda + C) * 2u; voffB[i] = (unsigned)(Rb * g.ldb + C) * 2u; }
    const size_t kstep = (size_t)(BK * 2);
    const size_t hstepA = (size_t)HALF * g.lda * 2, hstepB = (size_t)HALF * g.ldb * 2;
    const size_t tstepA = 2 * hstepA, tstepB = 2 * hstepB;
    const unsigned ldsw = (unsigned)wid * 1024u;
    const int aoff = lds_byte(wr * 64 + fr, fq * 8), boff = lds_byte(wc * 32 + fr, fq * 8);
#define PG8_SA(b, h) (((b) * 2 + (h)) * HTB)
#define PG8_SB(b, h) ((4 + (b) * 2 + (h)) * HTB)
#define PG8_STAGE(bufoff, gbase, voff) do { _Pragma("unroll") for (int _i = 0; _i < 2; ++_i) \
        __builtin_amdgcn_global_load_lds((const unsigned*)((const char*)(gbase) + (voff)[_i]), (PG8_LAS unsigned*)(lds + (bufoff) + ldsw + _i * 8192), 16, 0, 0); } while (0)
#define PG8_LDA(dst, b, h) do { _Pragma("unroll") for (int m = 0; m < 4; ++m) _Pragma("unroll") for (int k = 0; k < 2; ++k) dst[m][k] = *(const PG8_LAS bf16x8*)(lds + PG8_SA(b, h) + aoff + m * 2048 + k * 1024); } while (0)
#define PG8_LDB(dst, b, h) do { _Pragma("unroll") for (int n = 0; n < 2; ++n) _Pragma("unroll") for (int k = 0; k < 2; ++k) dst[n][k] = *(const PG8_LAS bf16x8*)(lds + PG8_SB(b, h) + boff + n * 2048 + k * 1024); } while (0)
#define PG8_MMA(ai, bj, At, Bt) do { __builtin_amdgcn_s_setprio(1); _Pragma("unroll") for (int m = 0; m < 4; ++m) _Pragma("unroll") for (int n = 0; n < 2; ++n) _Pragma("unroll") for (int k = 0; k < 2; ++k) \
        acc[ai][bj][m][n] = __builtin_amdgcn_mfma_f32_16x16x32_bf16(Bt[n][k], At[m][k], acc[ai][bj][m][n], 0, 0, 0); __builtin_amdgcn_s_setprio(0); } while (0)
#define PG8_WAIT_V(n) asm volatile("s_waitcnt vmcnt(" #n ")" ::: "memory")
#define PG8_WAIT_L(n) asm volatile("s_waitcnt lgkmcnt(" #n ")" ::: "memory")
#define PG8_BAR __builtin_amdgcn_s_barrier()
#define PG8_SCHED __builtin_amdgcn_sched_barrier(0)
    Unit cur, nxt; int ui = 0;
    if (!S.next(0, cur)) return;
    f32x4 acc[2][2][4][2];
#pragma unroll
    for (int a = 0; a < 2; ++a)
#pragma unroll
        for (int b = 0; b < 2; ++b)
#pragma unroll
            for (int m = 0; m < 4; ++m)
#pragma unroll
                for (int n = 0; n < 2; ++n) acc[a][b][m][n] = (f32x4){0.f, 0.f, 0.f, 0.f};
    bf16x8 At[4][2], B0[2][2], B1[2][2];
    const char* cA = (const char*)g.A + (size_t)cur.pm * tstepA + (size_t)((cur.pn >> g.kshift) * g.kmul) * 2; const char* cB = (const char*)g.Bt + (size_t)cur.pn * tstepB;
    S.a_ready(cur);
    PG8_STAGE(PG8_SB(0, 0), cB, voffB); PG8_STAGE(PG8_SA(0, 0), cA, voffA); PG8_STAGE(PG8_SB(0, 1), cB + hstepB, voffB); PG8_STAGE(PG8_SA(0, 1), cA + hstepA, voffA);
    if (wr == 1) PG8_BAR;
    PG8_WAIT_V(4); PG8_BAR;
    PG8_STAGE(PG8_SB(1, 0), cB + kstep, voffB); PG8_STAGE(PG8_SA(1, 0), cA + kstep, voffA); PG8_STAGE(PG8_SB(1, 1), cB + hstepB + kstep, voffB);
    PG8_WAIT_V(6); PG8_BAR;
    PG8_STAMP();
    for (;;) {
        const bool has_next = S.next(ui + 1, nxt);
        const char* nA = has_next ? (const char*)g.A + (size_t)nxt.pm * tstepA + (size_t)((nxt.pn >> g.kshift) * g.kmul) * 2 : cA; const char* nB = has_next ? (const char*)g.Bt + (size_t)nxt.pn * tstepB : cB;
        for (int t = 0; t < nt; t += 2) {
            const bool last = (t == nt - 2);
            const char* a1 = cA + (size_t)(t + 1) * kstep;
            const char* a2 = last ? nA : cA + (size_t)(t + 2) * kstep; const char* b2 = last ? nB : cB + (size_t)(t + 2) * kstep;
            const char* a3 = a2 + kstep; const char* b3 = b2 + kstep;
            if (last && has_next) S.a_ready(nxt);
            PG8_LDB(B0, 0, 0); PG8_SCHED; PG8_LDA(At, 0, 0); PG8_STAGE(PG8_SA(1, 1), a1 + hstepA, voffA);
            PG8_WAIT_L(8); PG8_BAR; PG8_WAIT_L(0); PG8_MMA(0, 0, At, B0); PG8_BAR; PG8_SCHED;
            PG8_LDB(B1, 0, 1); PG8_STAGE(PG8_SB(0, 0), b2, voffB);
            PG8_BAR; PG8_WAIT_L(0); PG8_MMA(0, 1, At, B1); PG8_BAR;
            PG8_LDA(At, 0, 1); PG8_STAGE(PG8_SA(0, 0), a2, voffA);
            PG8_BAR; PG8_WAIT_L(0); PG8_MMA(1, 0, At, B0); PG8_BAR; PG8_SCHED;
            PG8_STAGE(PG8_SB(0, 1), b2 + hstepB, voffB);
            PG8_WAIT_V(6); PG8_BAR; PG8_MMA(1, 1, At, B1); PG8_BAR;
            PG8_LDB(B0, 1, 0); PG8_SCHED; PG8_LDA(At, 1, 0); PG8_STAGE(PG8_SA(0, 1), a2 + hstepA, voffA);
            PG8_WAIT_L(8); PG8_BAR; PG8_WAIT_L(0); PG8_MMA(0, 0, At, B0); PG8_BAR; PG8_SCHED;
            PG8_LDB(B1, 1, 1); PG8_STAGE(PG8_SB(1, 0), b3, voffB);
            PG8_BAR; PG8_WAIT_L(0); PG8_MMA(0, 1, At, B1); PG8_BAR;
            PG8_LDA(At, 1, 1); PG8_STAGE(PG8_SA(1, 0), a3, voffA);
            PG8_BAR; PG8_WAIT_L(0); PG8_MMA(1, 0, At, B0); PG8_BAR; PG8_SCHED;
            PG8_STAGE(PG8_SB(1, 1), b3 + hstepB, voffB);
            PG8_WAIT_V(6); PG8_BAR; PG8_MMA(1, 1, At, B1); PG8_BAR;
        }
        PG8_STAMP();
        if constexpr (!Epi::AFTER_DRAIN) { E(acc, cur, wr, wc, fr, fq); S.done(cur); }
        PG8_STAMP();
        if (!has_next) break;
#pragma unroll
        for (int a = 0; a < 2; ++a)
#pragma unroll
            for (int b = 0; b < 2; ++b)
#pragma unroll
                for (int m = 0; m < 4; ++m)
#pragma unroll
                    for (int n = 0; n < 2; ++n) acc[a][b][m][n] = (f32x4){0.f, 0.f, 0.f, 0.f};
        cur = nxt; cA = nA; cB = nB; ++ui;
    }
    PG8_WAIT_V(0);
    if (wr == 0) PG8_BAR;
    PG8_BAR;
    if constexpr (Epi::AFTER_DRAIN) { E.fused(acc, cur, wr, wc, fr, fq, lds, wid, lane); S.done(cur); }
    PG8_STAMP();
    if (STAMP && wid == 0) { stamps[lane] = lane < nts ? (((unsigned long long)(unsigned)ts_hi << 32) | (unsigned)ts_lo) : 0ull;
        if (lane == 62) stamps[62] = rt_entry; if (lane == 63) stamps[63] = (unsigned long long)wall_clock64(); }
#undef PG8_STAMP
#undef PG8_SA
#undef PG8_SB
#undef PG8_STAGE
#undef PG8_LDA
#undef PG8_LDB
#undef PG8_MMA
#undef PG8_WAIT_V
#undef PG8_WAIT_L
#undef PG8_BAR
#undef PG8_SCHED
}
}

#define LAS __attribute__((address_space(3)))
typedef unsigned short bf16;
typedef float f32x4 __attribute__((ext_vector_type(4)));

#ifndef MK_N_LAUNCHES
#define MK_N_LAUNCHES 1
#endif
#ifndef MK_PHASE_MASK
#define MK_PHASE_MASK 0x1FFF
#endif
#ifndef MK_REPEAT
#define MK_REPEAT -1
#endif
#ifndef MK_PEER_FP4
#define MK_PEER_FP4 2
#endif
#ifndef MK_RWKV_LDS
#define MK_RWKV_LDS 0
#endif
#ifndef MK_RWKV_SEQ
#define MK_RWKV_SEQ 0
#endif
#ifndef MK_SSD_SEQ
#define MK_SSD_SEQ 0
#endif
#ifndef MK_SKIP_MIXER
#define MK_SKIP_MIXER 0
#endif
#ifndef MK_SKIP_PEER
#define MK_SKIP_PEER 0
#endif
#ifndef MK_SKIP_RWKV
#define MK_SKIP_RWKV 0
#endif
#ifndef MK_SKIP_SSD
#define MK_SKIP_SSD 0
#endif

constexpr int DM = 4096, NBATCH = 4, SEQ = 4096, CTXL = 256;
constexpr int MX = NBATCH * SEQ;
constexpr int MC = NBATCH * CTXL;
constexpr int MT = MX + MC;
constexpr int RW = 2048;
constexpr int RCOLS = 6784;
constexpr int NIN = 12992, NINP = 13056;
constexpr int COL_Z = 6784, COL_XBC = 8832, COL_DT = 12928;
constexpr int NLR = 10240, KLR = 768, KLRW = 256;
constexpr int NMOD = 6 * DM;
constexpr float RMS_EPS = 1e-6f, GN_EPS = 64e-5f;
constexpr int NSTEP = CTXL + SEQ;

constexpr size_t MiB = (size_t)1 << 20;
constexpr size_t WS_CTL = 0, CTL_ZERO_BYTES = 1 * MiB;
constexpr size_t WS_MOD = 64 * 1024;
constexpr size_t WS_WT_OUT = 2 * MiB;
constexpr size_t WS_WT_Q = 34 * MiB;
constexpr size_t WS_WLR = 50 * MiB;
constexpr size_t WS_KBD = 63 * MiB;
constexpr size_t WS_DT = 71 * MiB;
constexpr size_t WS_LA = WS_DT + (size_t)MT * 64 * 4;
constexpr size_t WS_ALR = 300 * MiB;
constexpr size_t WS_WT_IN = 102 * MiB;
constexpr size_t WS_A1 = 204 * MiB;
constexpr size_t WS_P = 340 * MiB;
constexpr size_t WS_R = 774 * MiB, WS_K = 842 * MiB, WS_V = 910 * MiB, WS_KK = 978 * MiB;
constexpr size_t WS_XS = 1046 * MiB, WS_BC = 1114 * MiB;
constexpr size_t WS_Z = 102 * MiB;
constexpr size_t WS_LR = 340 * MiB;
constexpr size_t WS_A2 = 166 * MiB;
constexpr size_t WS_XN2 = 340 * MiB;
constexpr size_t WS_Q = 468 * MiB;
constexpr size_t WS_S = 532 * MiB;
constexpr size_t WS_U8 = 774 * MiB, WS_V8 = 838 * MiB;
constexpr size_t WS_USC = 902 * MiB, WS_VSC = WS_USC + 65536;
constexpr size_t WS_END = 1182 * MiB;
static_assert(WS_WT_IN + (size_t)NINP * DM * 2 <= WS_A1 && WS_A1 + (size_t)MT * DM * 2 <= WS_P && WS_P + (size_t)MT * NINP * 2 <= WS_R, "ws map 1");
static_assert(WS_LR + (size_t)MT * NLR * 2 <= WS_R && WS_Z + (size_t)MX * RW * 2 <= WS_A2 && WS_A2 + (size_t)MX * DM * 2 <= WS_P, "ws map 2");
static_assert(WS_LA + (size_t)MT * 64 * 4 <= WS_WT_IN && WS_ALR + (size_t)MT * KLR * 2 <= WS_P && WS_ALR >= WS_A2 + (size_t)MX * DM * 2 && WS_WLR + (size_t)NLR * KLRW * 2 <= WS_KBD, "ws map 3");
static_assert(WS_S + (size_t)MX * 2048 * 4 <= WS_R && WS_VSC + 65536 <= WS_XS, "ws map 4");

constexpr int LDS_BYTES = 147456;
constexpr int LDS_CTL = 143360;
constexpr int LDS_MISC = LDS_CTL + 320;

enum { I_X = 0, I_C, I_CTX, I_CCTX, I_WMOD, I_BMOD, I_N1G, I_N2G, I_WIN, I_WOUT, I_MU, I_W0, I_W2, I_A0, I_A2, I_G2, I_KK, I_KA, I_RK, I_LNW, I_LNB,
       I_CONVW, I_CONVB, I_DTB, I_ALOG, I_SSMD, I_NORMW, I_WQ, I_K1, I_K2, I_PU, I_PV, I_FG, N_IN };

struct Args { const float* in[N_IN]; float* out; unsigned char* ws; int ph_lo, ph_hi; };

__device__ __forceinline__ unsigned f2bf(float f) { unsigned u = __float_as_uint(f); return (u + 0x7fffu + ((u >> 16) & 1u)) >> 16; }
__device__ __forceinline__ unsigned pk2(float lo, float hi) { return f2bf(lo) | (f2bf(hi) << 16); }
__device__ __forceinline__ float bflo(unsigned u) { return __uint_as_float(u << 16); }
__device__ __forceinline__ float bfhi(unsigned u) { return __uint_as_float(u & 0xffff0000u); }
__device__ __forceinline__ void unpack8(const uint4& u, float (&f)[8]) {
    f[0] = bflo(u.x); f[1] = bfhi(u.x); f[2] = bflo(u.y); f[3] = bfhi(u.y); f[4] = bflo(u.z); f[5] = bfhi(u.z); f[6] = bflo(u.w); f[7] = bfhi(u.w);
}
__device__ __forceinline__ uint4 pack8(const float (&f)[8]) { uint4 u; u.x = pk2(f[0], f[1]); u.y = pk2(f[2], f[3]); u.z = pk2(f[4], f[5]); u.w = pk2(f[6], f[7]); return u; }
__device__ __forceinline__ uint4 ld16(const bf16* p) { return *(const uint4*)p; }
__device__ __forceinline__ void st16(bf16* p, const uint4& v) { *(uint4*)p = v; }
__device__ __forceinline__ void ldf8(const float* p, float (&f)[8]) { const float4 a = *(const float4*)p, b = *(const float4*)(p + 4); f[0] = a.x; f[1] = a.y; f[2] = a.z; f[3] = a.w; f[4] = b.x; f[5] = b.y; f[6] = b.z; f[7] = b.w; }
#define PIN8(a) asm volatile("" : "+v"((a)[0]), "+v"((a)[1]), "+v"((a)[2]), "+v"((a)[3]), "+v"((a)[4]), "+v"((a)[5]), "+v"((a)[6]), "+v"((a)[7]))
template <int CTRL> __device__ __forceinline__ float dppf(float v) { return __uint_as_float((unsigned)__builtin_amdgcn_update_dpp(0, (int)__float_as_uint(v), CTRL, 0xF, 0xF, true)); }
__device__ __forceinline__ float rlane(float v, int l) { return __uint_as_float((unsigned)__builtin_amdgcn_readlane((int)__float_as_uint(v), l)); }
__device__ __forceinline__ float sum8(float v) { v += dppf<0xB1>(v); v += dppf<0x4E>(v); v += dppf<0x141>(v); return v; }
__device__ __forceinline__ float sum16(float v) { v = sum8(v); v += dppf<0x140>(v); return v; }
__device__ __forceinline__ float sum32(float v) { v = sum16(v); v += __shfl_xor(v, 16); return v; }
__device__ __forceinline__ float wave_sum(float v) { v = sum16(v); return (rlane(v, 0) + rlane(v, 16)) + (rlane(v, 32) + rlane(v, 48)); }
__device__ __forceinline__ float wave_max(float v) {
    v = fmaxf(v, dppf<0xB1>(v)); v = fmaxf(v, dppf<0x4E>(v)); v = fmaxf(v, dppf<0x141>(v)); v = fmaxf(v, dppf<0x140>(v));
    return fmaxf(fmaxf(rlane(v, 0), rlane(v, 16)), fmaxf(rlane(v, 32), rlane(v, 48)));
}
__device__ __forceinline__ void lds_barrier() { asm volatile("s_waitcnt lgkmcnt(0)\n\ts_barrier" ::: "memory"); }
__device__ __forceinline__ float sigmoidf_(float x) { return 1.f / (1.f + __expf(-x)); }
__device__ __forceinline__ float siluf_(float x) { return x / (1.f + __expf(-x)); }

struct EpiLR {
    static constexpr bool PERM = true, AFTER_DRAIN = false;
    bf16* O; const float* w0; const float* a0;
    __device__ __forceinline__ void operator()(const pg8::f32x4 (&acc)[2][2][4][2], const pg8::Unit& u, int wr, int wc, int fr, int fq) const {
        const int row0 = u.pm * 256 + wr * 64 + fr; const int colt = u.pn * 256; const int type = colt >> 11;
        const int col0 = colt + wc * 32 + 8 * fq;
        const float* bias = type < 2 ? (w0 + type * 2048) : (a0 + (type - 2) * 2048);
        pg8::f32x4 bv[2][2];
#pragma unroll
        for (int bj = 0; bj < 2; ++bj)
#pragma unroll
            for (int n = 0; n < 2; ++n) bv[bj][n] = type < 4 ? *(const pg8::f32x4*)(bias + ((col0 + bj * 128 + 4 * n) & 2047)) : (pg8::f32x4){0.f, 0.f, 0.f, 0.f};
#pragma unroll
        for (int ai = 0; ai < 2; ++ai)
#pragma unroll
            for (int m = 0; m < 4; ++m) { bf16* rowp = O + (size_t)(row0 + ai * 128 + m * 16) * NLR + col0;
#pragma unroll
                for (int bj = 0; bj < 2; ++bj) { pg8::f32x4 v0 = acc[ai][bj][m][0] + bv[bj][0], v1 = acc[ai][bj][m][1] + bv[bj][1];
                    if (type < 4) {
#pragma unroll
                        for (int j = 0; j < 4; ++j) { float s0 = 1.f / (1.f + __expf(-v0[j])), s1 = 1.f / (1.f + __expf(-v1[j]));
                            if (type < 2) { s0 = -expm1f(-0.60653066f * s0); s1 = -expm1f(-0.60653066f * s1); }
                            v0[j] = s0; v1[j] = s1; } }
                    pg8::u32x4 w; w.x = pg8::cvt_pk_bf16(v0[0], v0[1]); w.y = pg8::cvt_pk_bf16(v0[2], v0[3]); w.z = pg8::cvt_pk_bf16(v1[0], v1[1]); w.w = pg8::cvt_pk_bf16(v1[2], v1[3]);
                    *(pg8::u32x4*)(rowp + bj * 128) = w; } }
    }
};
struct EpiRes {
    static constexpr bool PERM = false, AFTER_DRAIN = false;
    float* C; const float* X; const float* mod;
    __device__ __forceinline__ void operator()(const pg8::f32x4 (&acc)[2][2][4][2], const pg8::Unit& u, int wr, int wc, int fr, int fq) const {
        const int row0 = u.pm * 256 + wr * 64 + fr, col0 = u.pn * 256 + wc * 32 + 4 * fq;
        const float* gt = mod + (size_t)((u.pm * 256) / SEQ) * NMOD + 2 * DM;
        pg8::f32x4 gv[2][2];
#pragma unroll
        for (int bj = 0; bj < 2; ++bj)
#pragma unroll
            for (int n = 0; n < 2; ++n) gv[bj][n] = *(const pg8::f32x4*)(gt + col0 + bj * 128 + n * 16);
#pragma unroll
        for (int ai = 0; ai < 2; ++ai)
#pragma unroll
            for (int m = 0; m < 4; ++m) { const size_t off = (size_t)(row0 + ai * 128 + m * 16) * DM + col0;
#pragma unroll
                for (int bj = 0; bj < 2; ++bj)
#pragma unroll
                    for (int n = 0; n < 2; ++n) { const pg8::f32x4 xv = *(const pg8::f32x4*)(X + off + bj * 128 + n * 16);
#if MK_SKIP_MIXER
                        *(pg8::f32x4*)(C + off + bj * 128 + n * 16) = xv;
#else
                        *(pg8::f32x4*)(C + off + bj * 128 + n * 16) = xv + gv[bj][n] * acc[ai][bj][m][n];
#endif
                    }
                asm volatile("" ::: "memory"); }
    }
};

#define XB_TMO      128
#define XB_XCNT(j)  (256  + 64 * (j))
#define XB_XSUB(j)  (1280 + 64 * (j))
#define XB_XGEN(j)  (2304 + 64 * (j))
#define XB_TOP      3328
#define XB_TOPGEN   3392
#define XCD_BAR_WORDS 3456
#define XB_SPIN_CAP (1u << 18)
__device__ __forceinline__ unsigned xb_ld(unsigned* p)              { return __hip_atomic_load(p, __ATOMIC_RELAXED, __HIP_MEMORY_SCOPE_AGENT); }
__device__ __forceinline__ unsigned xb_add(unsigned* p, unsigned v) { return __hip_atomic_fetch_add(p, v, __ATOMIC_RELAXED, __HIP_MEMORY_SCOPE_AGENT); }
__device__ __forceinline__ unsigned xb_xcc_id() { return (unsigned)__builtin_amdgcn_s_getreg((3 << 11) | 20) & 0xFu; }
#define XB_SPIN(cond, bar) do { unsigned _sp = 0; while (cond) { __builtin_amdgcn_s_sleep(1); \
    if ((++_sp & 255u) == 0u) { if (xb_ld(&(bar)[XB_TMO])) break; if (_sp > XB_SPIN_CAP) { atomicAdd(&(bar)[XB_TMO], 1u); break; } } } } while (0)
struct XcdBarrier { unsigned* bar; unsigned x; volatile LAS unsigned* st; };
__device__ __forceinline__ XcdBarrier xcd_barrier_post(unsigned* bar, volatile LAS unsigned* st) {
    XcdBarrier b; b.bar = bar; b.x = xb_xcc_id(); b.st = st;
    if (threadIdx.x == 0) (void)xb_add(&bar[XB_XCNT(b.x)], 1u);
    return b;
}
__device__ __forceinline__ void xcd_barrier_complete(unsigned* bar, unsigned x, unsigned& nloc, unsigned& nx) {
    const unsigned G = gridDim.x * gridDim.y * gridDim.z;
    unsigned sum, cnt, mine, sp = 0u;
    for (;;) {
        sum = 0u; cnt = 0u; mine = 0u;
#pragma unroll
        for (unsigned j = 0; j < 16; ++j) { const unsigned c = xb_ld(&bar[XB_XCNT(j)]); sum += c; cnt += (c > 0u) ? 1u : 0u; mine = (j == x) ? c : mine; }
        if (sum == G) break;
        __builtin_amdgcn_s_sleep(1);
        if ((++sp & 255u) == 0u) { if (xb_ld(&bar[XB_TMO])) break; if (sp > XB_SPIN_CAP) { atomicAdd(&bar[XB_TMO], 1u); break; } }
    }
    nloc = mine > 0u ? mine : 1u; nx = cnt > 0u ? cnt : 1u;
}
__device__ __forceinline__ void xcd_barrier(const XcdBarrier& b) {
    asm volatile("s_waitcnt vmcnt(0)" ::: "memory");
    __syncthreads();
    if (threadIdx.x == 0) {
        unsigned* bar = b.bar;
        __builtin_amdgcn_s_waitcnt(0);
        unsigned nloc = b.st[0], nx = b.st[1];
        if (nloc == 0u) { xcd_barrier_complete(bar, b.x, nloc, nx); b.st[0] = nloc; b.st[1] = nx; }
        const unsigned old = xb_add(&bar[XB_XSUB(b.x)], 1u);
        const unsigned gen = old / nloc;
        if (old + 1u == (gen + 1u) * nloc) {
            __builtin_amdgcn_fence(__ATOMIC_RELEASE, "agent");
            asm volatile("s_waitcnt vmcnt(0)" ::: "memory");
            const unsigned og = xb_add(&bar[XB_TOP], 1u);
            const unsigned tg = og / nx;
            if (og + 1u == (tg + 1u) * nx) xb_add(&bar[XB_TOPGEN], 1u);
            else XB_SPIN(xb_ld(&bar[XB_TOPGEN]) == tg, bar);
            __builtin_amdgcn_fence(__ATOMIC_ACQUIRE, "agent");
            xb_add(&bar[XB_XGEN(b.x)], 1u);
            asm volatile("s_waitcnt vmcnt(0)" ::: "memory");
        } else {
            XB_SPIN(xb_ld(&bar[XB_XGEN(b.x)]) == gen, bar);
            __builtin_amdgcn_fence(__ATOMIC_ACQUIRE, "agent");
            asm volatile("s_waitcnt vmcnt(0)" ::: "memory");
        }
    }
    __syncthreads();
}

#define TID ((int)threadIdx.x)
#define LANE ((int)(threadIdx.x & 63))
#define WAVE ((int)__builtin_amdgcn_readfirstlane((int)(threadIdx.x >> 6)))
#define GW ((int)blockIdx.x * 8 + WAVE)
#define NGW ((int)gridDim.x * 8)

__device__ __forceinline__ void ph_mod(const Args& a, LAS unsigned char* lds) {
    const float* c = a.in[I_C]; const float* cc = a.in[I_CCTX]; const float* w_mod = a.in[I_WMOD]; const float* b_mod = a.in[I_BMOD];
    float* mod = (float*)(a.ws + WS_MOD);
    LAS float* sS = (LAS float*)lds;
    LAS float* red = (LAS float*)(lds + 81920);
    const int tid = TID, lane = LANE, wave = WAVE;
    if ((int)blockIdx.x < 192) {
        for (int i = tid; i < 5 * DM; i += 512) { const int v = i >> 12, k = i & (DM - 1); const float xv = v < 4 ? c[v * DM + k] : cc[k]; sS[i] = xv / (1.f + expf(-xv)); }
    }
    __syncthreads();
    for (int u = blockIdx.x; u < 192; u += gridDim.x) {
        const int cl = lane & 31, kh = lane >> 5;
        float acc[5][4];
#pragma unroll
        for (int v = 0; v < 5; ++v)
#pragma unroll
            for (int e = 0; e < 4; ++e) acc[v][e] = 0.f;
        const float* wp = w_mod + (size_t)(wave * 512 + kh) * NMOD + u * 128 + cl * 4;
#pragma unroll 8
        for (int i = 0; i < 256; ++i) {
            const float4 w = *(const float4*)(wp + (size_t)(2 * i) * NMOD);
#pragma unroll
            for (int v = 0; v < 5; ++v) { const float s = sS[v * DM + wave * 512 + 2 * i + kh]; acc[v][0] += s * w.x; acc[v][1] += s * w.y; acc[v][2] += s * w.z; acc[v][3] += s * w.w; }
        }
#pragma unroll
        for (int v = 0; v < 5; ++v)
#pragma unroll
            for (int e = 0; e < 4; ++e) acc[v][e] += __shfl_xor(acc[v][e], 32);
        if (kh == 0) {
#pragma unroll
            for (int v = 0; v < 5; ++v) *(LAS f32x4*)(red + ((wave * 5 + v) * 128 + cl * 4)) = (f32x4){acc[v][0], acc[v][1], acc[v][2], acc[v][3]};
        }
        __syncthreads();
        for (int i = tid; i < 640; i += 512) { const int v = i >> 7, n = i & 127; float s = b_mod[u * 128 + n];
#pragma unroll
            for (int w = 0; w < 8; ++w) s += red[(w * 5 + v) * 128 + n];
            mod[v * NMOD + u * 128 + n] = s; }
        __syncthreads();
    }
    __syncthreads();
}

__device__ __forceinline__ void transpose_item(const float* W, int K, int N, bf16* WT, LAS float* scr, int item, int lane) {
    const int nblk = N / 32, kb = item / nblk, nb = item % nblk, k0 = 64 * kb, n0 = 32 * nb;
#pragma unroll 8
    for (int i = 0; i < 32; ++i) { const int kk = 2 * i + (lane >> 5); scr[kk * 33 + (lane & 31)] = W[(size_t)(k0 + kk) * N + n0 + (lane & 31)]; }
    asm volatile("s_waitcnt lgkmcnt(0)" ::: "memory");
    const int c = lane & 7;
#pragma unroll
    for (int j = 0; j < 4; ++j) { const int n = (lane >> 3) + 8 * j; const LAS float* s = scr + (8 * c) * 33 + n;
        uint4 o; o.x = pk2(s[0 * 33], s[1 * 33]); o.y = pk2(s[2 * 33], s[3 * 33]); o.z = pk2(s[4 * 33], s[5 * 33]); o.w = pk2(s[6 * 33], s[7 * 33]);
        *(uint4*)(WT + (size_t)(n0 + n) * K + k0 + 8 * c) = o; }
    asm volatile("s_waitcnt lgkmcnt(0)" ::: "memory");
}
__device__ __forceinline__ void ph_conv(const Args& a, LAS unsigned char* lds) {
    const int lane = LANE, wave = WAVE, gw = GW, ngw = NGW;
    LAS float* scr = (LAS float*)(lds + wave * 16384);
    bf16* wt_in = (bf16*)(a.ws + WS_WT_IN); bf16* wt_out = (bf16*)(a.ws + WS_WT_OUT); bf16* wt_q = (bf16*)(a.ws + WS_WT_Q);
    constexpr int IT_IN = (DM / 64) * (NIN / 32), IT_OUT = (DM / 64) * (DM / 32), IT_Q = (DM / 64) * (2048 / 32);
    for (int it = gw; it < IT_IN + IT_OUT + IT_Q; it += ngw) {
        int r = it;
        if (r < IT_IN) { transpose_item(a.in[I_WIN], DM, NIN, wt_in, scr, r, lane); continue; } r -= IT_IN;
        if (r < IT_OUT) { transpose_item(a.in[I_WOUT], DM, DM, wt_out, scr, r, lane); continue; } r -= IT_OUT;
        transpose_item(a.in[I_WQ], DM, 2048, wt_q, scr, r, lane);
    }
    const int gt = blockIdx.x * 512 + TID, ngt = gridDim.x * 512;
    for (int i = gt; i < (NINP - NIN) * DM / 8; i += ngt) *(uint4*)(wt_in + (size_t)NIN * DM + (size_t)i * 8) = make_uint4(0u, 0u, 0u, 0u);
    { bf16* wlr = (bf16*)(a.ws + WS_WLR); const float* w2 = a.in[I_W2]; const float* a2 = a.in[I_A2]; const float* g2 = a.in[I_G2];
      for (int i = gt; i < NLR * (KLRW / 8); i += ngt) { const int n = i / (KLRW / 8), k0 = (i % (KLRW / 8)) * 8; const int type = n >> 11, cch = n & 2047;
          float f[8];
#pragma unroll
          for (int e = 0; e < 8; ++e) { const int k = k0 + e; float v = 0.f;
              if (type == 4) v = g2[(size_t)k * RW + cch];
              else { const int d = type & 1, kk = k - 128 * d; const float* src = type < 2 ? w2 : a2; if (kk >= 0 && kk < 96) v = src[(size_t)(d * 96 + kk) * RW + cch]; }
              f[e] = v; }
          st16(wlr + (size_t)n * KLRW + k0, pack8(f)); } }
    { bf16* kbd = (bf16*)(a.ws + WS_KBD); const float* k1 = a.in[I_K1]; const float* k2 = a.in[I_K2];
      for (int i = gt; i < 2048 * 32; i += ngt) { const int n = i >> 5, k0 = (i & 31) * 8; float f[8];
          const int h = n >> 8, sb = (n >> 7) & 1, key = n & 127;
          if ((k0 >> 7) == sb) { const float* src = (sb ? k2 : k1) + ((size_t)(h * 128 + key) * 128 + (k0 & 127)); ldf8(src, f); }
          else {
#pragma unroll
              for (int e = 0; e < 8; ++e) f[e] = 0.f; }
          st16(kbd + (size_t)n * 256 + k0, pack8(f)); } }
}

__device__ __forceinline__ void norm_mod_row(const float* src, const float* g, const float* sh, const float* sc, bf16* dst, int lane) {
    float4 v[16]; float ss = 0.f;
#pragma unroll
    for (int j = 0; j < 16; ++j) { v[j] = *(const float4*)(src + (lane + 64 * j) * 4); ss += (v[j].x * v[j].x + v[j].y * v[j].y) + (v[j].z * v[j].z + v[j].w * v[j].w); }
    const float rstd = rsqrtf(wave_sum(ss) * (1.f / DM) + RMS_EPS);
#pragma unroll
    for (int j = 0; j < 16; ++j) { const int c = (lane + 64 * j) * 4; const float4 gg = *(const float4*)(g + c), s1 = *(const float4*)(sc + c), s0 = *(const float4*)(sh + c);
        const float o0 = v[j].x * rstd * gg.x * (1.f + s1.x) + s0.x, o1 = v[j].y * rstd * gg.y * (1.f + s1.y) + s0.y, o2 = v[j].z * rstd * gg.z * (1.f + s1.z) + s0.z, o3 = v[j].w * rstd * gg.w * (1.f + s1.w) + s0.w;
        uint2 w; w.x = pk2(o0, o1); w.y = pk2(o2, o3); *(uint2*)(dst + c) = w; }
}
__device__ __forceinline__ void ph_norm1(const Args& a) {
    const int lane = LANE; const float* mod = (const float*)(a.ws + WS_MOD); bf16* A1 = (bf16*)(a.ws + WS_A1);
    for (int m = GW; m < MT; m += NGW) {
        const float* src = m < MX ? a.in[I_X] + (size_t)m * DM : a.in[I_CTX] + (size_t)(m - MX) * DM;
        const int v = m < MX ? m / SEQ : 4;
        norm_mod_row(src, a.in[I_N1G], mod + (size_t)v * NMOD, mod + (size_t)v * NMOD + DM, A1 + (size_t)m * DM, lane);
    }
}
__device__ __forceinline__ void ph_norm2(const Args& a) {
    const int lane = LANE; const float* mod = (const float*)(a.ws + WS_MOD); bf16* XN2 = (bf16*)(a.ws + WS_XN2);
    for (int m = GW; m < MX; m += NGW) {
        const int v = m / SEQ;
        norm_mod_row(a.out + (size_t)m * DM, a.in[I_N2G], mod + (size_t)v * NMOD + 3 * DM, mod + (size_t)v * NMOD + 4 * DM, XN2 + (size_t)m * DM, lane);
    }
    unsigned char* U8 = a.ws + WS_U8; unsigned char* V8 = a.ws + WS_V8; float* USC = (float*)(a.ws + WS_USC); float* VSC = (float*)(a.ws + WS_VSC);
    for (int row = GW; row < 2 * 16384; row += NGW) {
        const int tb = row >> 14, r = row & 16383;
        const float* src = (tb ? a.in[I_PV] : a.in[I_PU]) + (size_t)r * DM;
        float4 v[16]; float am = 0.f;
#pragma unroll
        for (int j = 0; j < 16; ++j) { v[j] = *(const float4*)(src + (lane + 64 * j) * 4); am = fmaxf(fmaxf(am, fmaxf(fabsf(v[j].x), fabsf(v[j].y))), fmaxf(fabsf(v[j].z), fabsf(v[j].w))); }
        am = wave_max(am);
        if ((tb ? MK_PEER_FP4 >= 1 : MK_PEER_FP4 >= 2)) {
            unsigned char* d4 = (tb ? V8 : U8) + (size_t)r * 2304 + lane * 16; unsigned scw = 0u;
#pragma unroll
            for (int p = 0; p < 2; ++p) {
                float bm = 0.f;
#pragma unroll
                for (int j = 0; j < 8; ++j) { const float4 q = v[8 * p + j]; bm = fmaxf(fmaxf(bm, fmaxf(fabsf(q.x), fabsf(q.y))), fmaxf(fabsf(q.z), fabsf(q.w))); }
                const unsigned sb = bm > 0.f ? f2bf(bm * (1.f / 6.f)) : 0x3f80u; const float binv = 1.f / __uint_as_float(sb << 16);
                scw |= sb << (16 * p);
                unsigned w4[4] = {0u, 0u, 0u, 0u};
#pragma unroll
                for (int d = 0; d < 4; ++d) { const float4 qa4 = v[8 * p + 2 * d], qb4 = v[8 * p + 2 * d + 1];
                    unsigned wv = 0u;
                    wv = __builtin_amdgcn_cvt_scalef32_pk_fp4_f32(wv, qa4.x * binv, qa4.y * binv, 1.0f, 0); wv = __builtin_amdgcn_cvt_scalef32_pk_fp4_f32(wv, qa4.z * binv, qa4.w * binv, 1.0f, 1);
                    wv = __builtin_amdgcn_cvt_scalef32_pk_fp4_f32(wv, qb4.x * binv, qb4.y * binv, 1.0f, 2); wv = __builtin_amdgcn_cvt_scalef32_pk_fp4_f32(wv, qb4.z * binv, qb4.w * binv, 1.0f, 3);
                    w4[d] = wv; }
                *(uint4*)(d4 + 1024 * p) = make_uint4(w4[0], w4[1], w4[2], w4[3]);
            }
            *(unsigned*)((tb ? V8 : U8) + (size_t)r * 2304 + 2048 + lane * 4) = scw;
            if (lane == 0) (tb ? VSC : USC)[r] = 1.f;
            continue;
        }
        const float scale = am > 0.f ? am * (1.f / 7.5f) : 1.f, inv = 1.f / scale;
        unsigned char* dst = (tb ? V8 : U8) + (size_t)r * 3072 + lane * 16;
        unsigned long long pk[6];
#pragma unroll
        for (int p = 0; p < 2; ++p) {
            unsigned long long w0 = 0ull, w1 = 0ull, w2 = 0ull;
#pragma unroll
            for (int k = 0; k < 32; ++k) {
                const float4 q = v[8 * p + (k >> 2)]; const float x = ((k & 3) == 0 ? q.x : (k & 3) == 1 ? q.y : (k & 3) == 2 ? q.z : q.w) * inv; const float ax = fabsf(x);
                float cf = ax < 2.f ? rintf(ax * 8.f) : (ax < 4.f ? rintf(ax * 4.f) + 8.f : rintf(ax * 2.f) + 16.f);
                cf = fminf(cf, 31.f);
                const unsigned long long code = (unsigned long long)((unsigned)cf | (x < 0.f ? 32u : 0u));
                const int pos = 6 * k, wd = pos >> 6, off = pos & 63;
                if (wd == 0) w0 |= code << off; else if (wd == 1) w1 |= code << off; else w2 |= code << off;
                if (off > 58) { if (wd == 0) w1 |= code >> (64 - off); else w2 |= code >> (64 - off); }
            }
            pk[3 * p] = w0; pk[3 * p + 1] = w1; pk[3 * p + 2] = w2;
        }
#pragma unroll
        for (int k = 0; k < 3; ++k) *(uint4*)(dst + 1024 * k) = make_uint4((unsigned)pk[2 * k], (unsigned)(pk[2 * k] >> 32), (unsigned)pk[2 * k + 1], (unsigned)(pk[2 * k + 1] >> 32));
        if (lane == 0) (tb ? VSC : USC)[r] = scale;
    }
}

__device__ __forceinline__ void ldf8s(const LAS float* p, float (&f)[8]) { const f32x4 a = *(const LAS f32x4*)p, b = *(const LAS f32x4*)(p + 4); f[0] = a[0]; f[1] = a[1]; f[2] = a[2]; f[3] = a[3]; f[4] = b[0]; f[5] = b[1]; f[6] = b[2]; f[7] = b[3]; }
constexpr int PL_MU = 0, PL_KK = 27136, PL_CW = 35328, PL_CB = 84480, PL_END = 100864;
__device__ __forceinline__ void ph_prep_stage(const Args& a, LAS unsigned char* lds) {
    const int tid = TID;
    for (int i = tid; i < RCOLS; i += 512) ((LAS float*)(lds + PL_MU))[i] = a.in[I_MU][i];
    for (int i = tid; i < RW; i += 512) ((LAS float*)(lds + PL_KK))[i] = a.in[I_KK][i];
    for (int i = tid; i < 3 * 4096; i += 512) ((LAS float*)(lds + PL_CW))[i] = a.in[I_CONVW][i];
    for (int i = tid; i < 4096; i += 512) ((LAS float*)(lds + PL_CB))[i] = a.in[I_CONVB][i];
    __syncthreads();
}
__device__ __forceinline__ void ph_prep_rwkv(const Args& a, LAS unsigned char* lds) {
    const int lane = LANE;
    const bf16* P = (const bf16*)(a.ws + WS_P);
    bf16* R = (bf16*)(a.ws + WS_R); bf16* K = (bf16*)(a.ws + WS_K); bf16* V = (bf16*)(a.ws + WS_V); bf16* KK = (bf16*)(a.ws + WS_KK); bf16* ALR = (bf16*)(a.ws + WS_ALR);
    const LAS float* mu = (const LAS float*)(lds + PL_MU); const LAS float* k_k = (const LAS float*)(lds + PL_KK);
    for (int m = GW; m < MT; m += NGW) {
        const bool lat = m < MX;
        bool h0, h1, h2 = false, h3 = false; size_t r0, r1, r2 = (size_t)m, r3 = (size_t)m;
        if (lat) { const int t = m & (SEQ - 1), row = t >> 6, col = t & 63; h0 = col > 0; h1 = col < 63; h2 = row > 0; h3 = row < 63; r0 = (size_t)(m - 1); r1 = (size_t)(m + 1); r2 = (size_t)(m - 64); r3 = (size_t)(m + 64); }
        else { const int t = (m - MX) & (CTXL - 1); h0 = t > 0; h1 = t < CTXL - 1; r0 = (size_t)(m - 1); r1 = (size_t)(m + 1); }
        if (!h0) r0 = (size_t)m; if (!h1) r1 = (size_t)m; if (!h2) r2 = (size_t)m; if (!h3) r3 = (size_t)m;
        const bf16* prow = P + (size_t)m * NINP; const bf16* p0 = P + r0 * NINP; const bf16* p1 = P + r1 * NINP; const bf16* p2 = P + r2 * NINP; const bf16* p3 = P + r3 * NINP;
        const float f0 = h0 ? 1.f : 0.f, f1 = h1 ? 1.f : 0.f, f2 = h2 ? 1.f : 0.f, f3 = h3 ? 1.f : 0.f;
        uint4 qo[2][2], q0[2][2], q1[2][2], q2[2][2], q3[2][2];
#define PREP_LOAD(buf, i2v) do { _Pragma("unroll") for (int ii = 0; ii < 2; ++ii) { const int chunk_ = lane + 64 * ((i2v) + ii); const int c0_ = (chunk_ < RCOLS / 8 ? chunk_ : 0) * 8; \
            qo[buf][ii] = ld16(prow + c0_); q0[buf][ii] = ld16(p0 + c0_); q1[buf][ii] = ld16(p1 + c0_); \
            if (lat) { q2[buf][ii] = ld16(p2 + c0_); q3[buf][ii] = ld16(p3 + c0_); } else { q2[buf][ii] = qo[buf][ii]; q3[buf][ii] = qo[buf][ii]; } } } while (0)
        PREP_LOAD(0, 0);
#pragma unroll
        for (int i2 = 0; i2 < 14; i2 += 2) {
            const int cb_ = (i2 >> 1) & 1;
            if (i2 + 2 < 14) { if (cb_) PREP_LOAD(0, i2 + 2); else PREP_LOAD(1, i2 + 2); }
            asm volatile("" ::: "memory");
#pragma unroll
            for (int ii = 0; ii < 2; ++ii) { const int i = i2 + ii; const int chunk = lane + 64 * i;
              if (chunk < RCOLS / 8) {
                const int c0 = chunk * 8;
                float own[8], n0[8], n1[8], sh[8], xm[8], muv[8];
                unpack8(qo[cb_][ii], own); unpack8(q0[cb_][ii], n0); unpack8(q1[cb_][ii], n1);
                if (lat) { float n2[8], n3[8]; unpack8(q2[cb_][ii], n2); unpack8(q3[cb_][ii], n3);
#pragma unroll
                    for (int e = 0; e < 8; ++e) sh[e] = (e & 3) == 0 ? n0[e] * f0 : (e & 3) == 1 ? n1[e] * f1 : (e & 3) == 2 ? n2[e] * f2 : n3[e] * f3;
                } else {
#pragma unroll
                    for (int e = 0; e < 8; ++e) sh[e] = (e & 1) == 0 ? n0[e] * f0 : n1[e] * f1;
                }
                ldf8s(mu + c0, muv);
#pragma unroll
                for (int e = 0; e < 8; ++e) xm[e] = own[e] + muv[e] * (sh[e] - own[e]);
                if (i < 4) st16(R + (size_t)m * RW + c0, pack8(xm));
                else if (i < 8) { const int cc = c0 - 2048; st16(K + (size_t)m * RW + cc, pack8(xm));
                    float kv[8], kkv[8]; ldf8s(k_k + cc, kv); float ss = 0.f;
#pragma unroll
                    for (int e = 0; e < 8; ++e) { kkv[e] = xm[e] * kv[e]; ss += kkv[e] * kkv[e]; }
                    ss = sum8(ss);
                    const float inv = rsqrtf(fmaxf(ss, 1e-24f));
#pragma unroll
                    for (int e = 0; e < 8; ++e) kkv[e] *= inv;
                    st16(KK + (size_t)m * RW + cc, pack8(kkv)); }
                else if (i < 12) st16(V + (size_t)m * RW + (c0 - 4096), pack8(xm));
                else { const int j0 = c0 - 6144; float f[8];
#pragma unroll
                    for (int e = 0; e < 8; ++e) f[e] = j0 < 192 ? tanhf(xm[e]) : (j0 < 384 ? xm[e] : 1.f / (1.f + __expf(-xm[e])));
                    const int col = j0 < 384 ? (j0 / 96) * 128 + (j0 % 96) : j0 + 128;
                    st16(ALR + (size_t)m * KLR + col, pack8(f)); }
              } else if (i == 13 && lane < 32) {
                const int pc = lane - 16; st16(ALR + (size_t)m * KLR + (pc >> 2) * 128 + 96 + (pc & 3) * 8, make_uint4(0u, 0u, 0u, 0u));
              }
            }
        }
    }
}

__device__ __forceinline__ void ph_prep_ssd(const Args& a, LAS unsigned char* lds) {
    const int lane = LANE;
    const bf16* P = (const bf16*)(a.ws + WS_P);
    bf16* XS = (bf16*)(a.ws + WS_XS); bf16* BC = (bf16*)(a.ws + WS_BC); bf16* Z = (bf16*)(a.ws + WS_Z); float* DT = (float*)(a.ws + WS_DT); float* LA = (float*)(a.ws + WS_LA);
    const LAS float* cw = (const LAS float*)(lds + PL_CW); const LAS float* cb = (const LAS float*)(lds + PL_CB);
    for (int m = GW; m < MT; m += NGW) {
        const bool lat = m < MX; bool hp, hn;
        if (lat) { const int t = m & (SEQ - 1); hp = t > 0; hn = t < SEQ - 1; } else { const int t = (m - MX) & (CTXL - 1); hp = t > 0; hn = t < CTXL - 1; }
        const bf16* prow = P + (size_t)m * NINP; const bf16* pp = hp ? prow - NINP : prow; const bf16* pn = hn ? prow + NINP : prow;
        const float fp = hp ? 1.f : 0.f, fn = hn ? 1.f : 0.f;
        uint4 zq[4];
        if (lat) {
#pragma unroll
            for (int i = 0; i < 4; ++i) zq[i] = ld16(prow + COL_Z + (lane + 64 * i) * 8);
        }
        const unsigned short dtraw = prow[COL_DT + lane];
        uint4 qc[2][2], qp[2][2], qn[2][2];
#define SSDP_LOAD(buf, i2v) do { _Pragma("unroll") for (int ii = 0; ii < 2; ++ii) { const int c0_ = (lane + 64 * ((i2v) + ii)) * 8; qc[buf][ii] = ld16(prow + COL_XBC + c0_); qp[buf][ii] = ld16(pp + COL_XBC + c0_); qn[buf][ii] = ld16(pn + COL_XBC + c0_); } } while (0)
        SSDP_LOAD(0, 0);
#pragma unroll
        for (int i2 = 0; i2 < 8; i2 += 2) {
            const int cb_ = (i2 >> 1) & 1;
            if (i2 + 2 < 8) { if (cb_) SSDP_LOAD(0, i2 + 2); else SSDP_LOAD(1, i2 + 2); }
            asm volatile("" ::: "memory");
#pragma unroll
            for (int ii = 0; ii < 2; ++ii) { const int i = i2 + ii; const int c0 = (lane + 64 * i) * 8;
                float cur[8], pv[8], nx[8], w0[8], w1[8], w2[8], bb[8], y[8];
                unpack8(qc[cb_][ii], cur); unpack8(qp[cb_][ii], pv); unpack8(qn[cb_][ii], nx);
                ldf8s(cw + c0, w0); ldf8s(cw + 4096 + c0, w1); ldf8s(cw + 8192 + c0, w2); ldf8s(cb + c0, bb);
#pragma unroll
                for (int e = 0; e < 8; ++e) { const float t = w0[e] * (pv[e] * fp) + w1[e] * cur[e] + w2[e] * (nx[e] * fn) + bb[e]; y[e] = t / (1.f + __expf(-t)); }
                if (i < 4) st16(XS + (size_t)m * RW + c0, pack8(y)); else st16(BC + (size_t)m * RW + (c0 - 2048), pack8(y)); }
        }
        { const float raw = __uint_as_float((unsigned)dtraw << 16) + a.in[I_DTB][lane];
          const float dtv = raw > 20.f ? raw : log1pf(expf(raw));
          DT[(size_t)m * 64 + lane] = dtv; LA[(size_t)m * 64 + lane] = -dtv * expf(a.in[I_ALOG][lane]); }
        if (lat) {
#pragma unroll
            for (int i = 0; i < 4; ++i) st16(Z + (size_t)m * RW + (lane + 64 * i) * 8, zq[i]);
        }
    }
}

__device__ __forceinline__ int scan_row(int n, int dir, int b) { return n < CTXL ? MX + b * CTXL + (dir ? CTXL - 1 - n : n) : b * SEQ + (dir ? NSTEP - 1 - n : n - CTXL); }

struct RIn { uint4 r, k, kk, w, a; unsigned v; };
__device__ __forceinline__ void rwkv_load(RIn& x, const bf16* R, const bf16* K, const bf16* V, const bf16* KK, const bf16* LR, int m, int ch, int chi, int dir) {
    x.r = ld16(R + (size_t)m * RW + ch); x.k = ld16(K + (size_t)m * RW + ch); x.kk = ld16(KK + (size_t)m * RW + ch);
    x.w = ld16(LR + (size_t)m * NLR + dir * 2048 + ch); x.a = ld16(LR + (size_t)m * NLR + 4096 + dir * 2048 + ch);
    x.v = V[(size_t)m * RW + chi];
}
__device__ __forceinline__ float rwkv_step(float (&S)[8], const RIn& x, const float (&ka)[8]) {
    float r[8], k[8], kk[8], w1[8], av[8];
    unpack8(x.r, r); unpack8(x.k, k); unpack8(x.kk, kk); unpack8(x.w, w1); unpack8(x.a, av);
    const float v = __uint_as_float(x.v << 16);
    float sa = 0.f;
#pragma unroll
    for (int e = 0; e < 8; ++e) sa -= S[e] * kk[e];
    sa = sum8(sa);
    float o = 0.f;
#pragma unroll
    for (int e = 0; e < 8; ++e) { const float kd = k[e] * (1.f + (av[e] - 1.f) * ka[e]); const float b = kk[e] * av[e];
        S[e] = S[e] * (1.f - w1[e]) + sa * b + v * kd; o += S[e] * r[e]; }
    o = sum8(o);
    return o;
}
__device__ __forceinline__ void ph_rwkv_scan(const Args& a) {
    const int lane = LANE, wave = WAVE;
    const bf16* R = (const bf16*)(a.ws + WS_R); const bf16* K = (const bf16*)(a.ws + WS_K); const bf16* V = (const bf16*)(a.ws + WS_V); const bf16* KK = (const bf16*)(a.ws + WS_KK);
    const bf16* LR = (const bf16*)(a.ws + WS_LR); bf16* OR = (bf16*)a.out;
    for (int u = blockIdx.x; u < 256; u += gridDim.x) {
        const int g = u >> 5, h = u & 31, dir = g >> 2, b = g & 3;
        const int i = wave * 8 + (lane >> 3), jb = lane & 7, ch = h * 64 + jb * 8, chi = h * 64 + i;
        float ka[8]; ldf8(a.in[I_KA] + ch, ka);
        float S[8];
#pragma unroll
        for (int e = 0; e < 8; ++e) S[e] = 0.f;
        RIn A[4], B[4];
#pragma unroll
        for (int s = 0; s < 4; ++s) rwkv_load(A[s], R, K, V, KK, LR, scan_row(s, dir, b), ch, chi, dir);
        for (int n0 = 0; n0 < NSTEP; n0 += 8) {
#pragma unroll
            for (int s = 0; s < 4; ++s) rwkv_load(B[s], R, K, V, KK, LR, scan_row(n0 + 4 + s, dir, b), ch, chi, dir);
#pragma unroll
            for (int s = 0; s < 4; ++s) { const int n = n0 + s; const float o = rwkv_step(S, A[s], ka);
                if (n >= CTXL && jb == 0) OR[((size_t)dir * MX + scan_row(n, dir, b)) * RW + chi] = (bf16)f2bf(o); }
            if (n0 + 8 < NSTEP) {
#pragma unroll
                for (int s = 0; s < 4; ++s) rwkv_load(A[s], R, K, V, KK, LR, scan_row(n0 + 8 + s, dir, b), ch, chi, dir);
            }
#pragma unroll
            for (int s = 0; s < 4; ++s) { const int n = n0 + 4 + s; const float o = rwkv_step(S, B[s], ka);
                if (n >= CTXL && jb == 0) OR[((size_t)dir * MX + scan_row(n, dir, b)) * RW + chi] = (bf16)f2bf(o); }
        }
    }
}

typedef float f32x2_t __attribute__((ext_vector_type(2)));
constexpr int RS_TS = 32, RS_STEP_B = 6 * 256, RS_BUF_B = RS_TS * RS_STEP_B;
constexpr int RS_OBUF = 2 * RS_BUF_B, RS_OBUF_B = RS_TS * 64 * 2;
constexpr int RS_DUMP = RS_OBUF + 2 * RS_OBUF_B;
static_assert(RS_DUMP + 2048 <= 131072, "rwkv scan lds map");
struct RRaw { uint2 r, k, kk, v, w, a; };
__device__ __forceinline__ void rs_load(RRaw& x, const bf16* R, const bf16* K, const bf16* V, const bf16* KK, const bf16* LR, int m, int ch, int dir) {
    x.r = *(const uint2*)(R + (size_t)m * RW + ch); x.k = *(const uint2*)(K + (size_t)m * RW + ch); x.kk = *(const uint2*)(KK + (size_t)m * RW + ch); x.v = *(const uint2*)(V + (size_t)m * RW + ch);
    x.w = *(const uint2*)(LR + (size_t)m * NLR + dir * 2048 + ch); x.a = *(const uint2*)(LR + (size_t)m * NLR + 4096 + dir * 2048 + ch);
}
__device__ __forceinline__ void rs_stage(const RRaw& x, const float (&ka)[4], LAS unsigned char* dst) {
    const float r[4] = {bflo(x.r.x), bfhi(x.r.x), bflo(x.r.y), bfhi(x.r.y)}, k[4] = {bflo(x.k.x), bfhi(x.k.x), bflo(x.k.y), bfhi(x.k.y)};
    const float kk[4] = {bflo(x.kk.x), bfhi(x.kk.x), bflo(x.kk.y), bfhi(x.kk.y)}, v[4] = {bflo(x.v.x), bfhi(x.v.x), bflo(x.v.y), bfhi(x.v.y)};
    const float w1[4] = {bflo(x.w.x), bfhi(x.w.x), bflo(x.w.y), bfhi(x.w.y)}, av[4] = {bflo(x.a.x), bfhi(x.a.x), bflo(x.a.y), bfhi(x.a.y)};
    f32x4 nkk, w, b, kd, rr, vv;
#pragma unroll
    for (int e = 0; e < 4; ++e) { nkk[e] = -kk[e]; w[e] = 1.f - w1[e]; b[e] = kk[e] * av[e]; kd[e] = k[e] * (1.f + (av[e] - 1.f) * ka[e]); rr[e] = r[e]; vv[e] = v[e]; }
    *(LAS f32x4*)(dst) = nkk; *(LAS f32x4*)(dst + 256) = w; *(LAS f32x4*)(dst + 512) = b; *(LAS f32x4*)(dst + 768) = kd; *(LAS f32x4*)(dst + 1024) = rr; *(LAS f32x4*)(dst + 1280) = vv;
}
__device__ __forceinline__ float amul(float a, float b) { float d; asm("v_mul_f32 %0, %1, %2" : "=v"(d) : "v"(a), "v"(b)); return d; }
__device__ __forceinline__ void afmac(float& d, float a, float b) { asm("v_fmac_f32 %0, %1, %2" : "+v"(d) : "v"(a), "v"(b)); }
__device__ __forceinline__ float afma(float a, float b, float c) { float d; asm("v_fma_f32 %0, %1, %2, %3" : "=v"(d) : "v"(a), "v"(b), "v"(c)); return d; }
__device__ __forceinline__ void sum16x2(float& a, float& b) {
    asm("s_nop 1\n\t"
        "v_add_f32_dpp %0, %0, %0 quad_perm:[1,0,3,2] row_mask:0xf bank_mask:0xf bound_ctrl:1\n\t"
        "v_add_f32_dpp %1, %1, %1 quad_perm:[1,0,3,2] row_mask:0xf bank_mask:0xf bound_ctrl:1\n\t"
        "s_nop 0\n\t"
        "v_add_f32_dpp %0, %0, %0 quad_perm:[2,3,0,1] row_mask:0xf bank_mask:0xf bound_ctrl:1\n\t"
        "v_add_f32_dpp %1, %1, %1 quad_perm:[2,3,0,1] row_mask:0xf bank_mask:0xf bound_ctrl:1\n\t"
        "s_nop 0\n\t"
        "v_add_f32_dpp %0, %0, %0 row_half_mirror row_mask:0xf bank_mask:0xf bound_ctrl:1\n\t"
        "v_add_f32_dpp %1, %1, %1 row_half_mirror row_mask:0xf bank_mask:0xf bound_ctrl:1\n\t"
        "s_nop 0\n\t"
        "v_add_f32_dpp %0, %0, %0 row_mirror row_mask:0xf bank_mask:0xf bound_ctrl:1\n\t"
        "v_add_f32_dpp %1, %1, %1 row_mirror row_mask:0xf bank_mask:0xf bound_ctrl:1"
        : "+v"(a), "+v"(b));
}
template <bool OUT> __device__ __forceinline__ void rs_chunk(float (&S)[2][4], const LAS unsigned char* buf, LAS unsigned char* obuf, LAS unsigned char* dump, int j0, int i0, int jb) {
#pragma unroll 4
    for (int s = 0; s < RS_TS; ++s) {
        const LAS unsigned char* base = buf + s * RS_STEP_B;
        const f32x4 nkk = *(const LAS f32x4*)(base + j0 * 4), w = *(const LAS f32x4*)(base + 256 + j0 * 4), b = *(const LAS f32x4*)(base + 512 + j0 * 4), kd = *(const LAS f32x4*)(base + 768 + j0 * 4);
        const f32x2_t v = *(const LAS f32x2_t*)(base + 1280 + i0 * 4);
        float sa0 = amul(S[0][0], nkk[0]), sa1 = amul(S[1][0], nkk[0]);
#pragma unroll
        for (int e = 1; e < 4; ++e) { afmac(sa0, S[0][e], nkk[e]); afmac(sa1, S[1][e], nkk[e]); }
        sum16x2(sa0, sa1);
#pragma unroll
        for (int e = 0; e < 4; ++e) { float t0 = amul(sa0, b[e]), t1 = amul(sa1, b[e]); afmac(t0, v[0], kd[e]); afmac(t1, v[1], kd[e]); S[0][e] = afma(S[0][e], w[e], t0); S[1][e] = afma(S[1][e], w[e], t1); }
        if (OUT) {
            const f32x4 r = *(const LAS f32x4*)(base + 1024 + j0 * 4);
            float o0 = amul(S[0][0], r[0]), o1 = amul(S[1][0], r[0]);
#pragma unroll
            for (int e = 1; e < 4; ++e) { afmac(o0, S[0][e], r[e]); afmac(o1, S[1][e], r[e]); }
            sum16x2(o0, o1);
            *(LAS unsigned*)(jb == 0 ? obuf + (s * 64 + i0) * 2 : dump) = pg8::cvt_pk_bf16(o0, o1);
        }
    }
}
__device__ __forceinline__ void ph_rwkv_scan2(const Args& a, LAS unsigned char* lds) {
    const int tid = TID, lane = LANE, wave = WAVE;
    const bf16* R = (const bf16*)(a.ws + WS_R); const bf16* K = (const bf16*)(a.ws + WS_K); const bf16* V = (const bf16*)(a.ws + WS_V); const bf16* KK = (const bf16*)(a.ws + WS_KK);
    const bf16* LR = (const bf16*)(a.ws + WS_LR); bf16* OR = (bf16*)a.out;
    constexpr int NCH = NSTEP / RS_TS;
    for (int u = blockIdx.x; u < 256; u += gridDim.x) {
        const int g = u >> 5, h = u & 31, dir = g >> 2, b = g & 3;
        const int ip = lane >> 4, jb = lane & 15, i0 = wave * 8 + ip * 2, j0 = jb * 4;
        const int ss = tid >> 4, cgp = tid & 15, ch = h * 64 + cgp * 4;
        float ka[4];
#pragma unroll
        for (int e = 0; e < 4; ++e) ka[e] = a.in[I_KA][ch + e];
        float S[2][4];
#pragma unroll
        for (int e = 0; e < 4; ++e) { S[0][e] = 0.f; S[1][e] = 0.f; }
        RRaw raw;
        __syncthreads();
        rs_load(raw, R, K, V, KK, LR, scan_row(ss, dir, b), ch, dir);
        rs_stage(raw, ka, lds + ss * RS_STEP_B + cgp * 16);
        __syncthreads();
        for (int c = 0; c < NCH; ++c) {
            LAS unsigned char* buf = lds + (c & 1) * RS_BUF_B; LAS unsigned char* nbuf = lds + ((c + 1) & 1) * RS_BUF_B; LAS unsigned char* obuf = lds + RS_OBUF + (c & 1) * RS_OBUF_B;
            const bool more = c + 1 < NCH;
            if (more) rs_load(raw, R, K, V, KK, LR, scan_row((c + 1) * RS_TS + ss, dir, b), ch, dir);
            const bool lat = c >= CTXL / RS_TS;
            if (lat) rs_chunk<true>(S, buf, obuf, lds + RS_DUMP + tid * 4, j0, i0, jb); else rs_chunk<false>(S, buf, obuf, lds + RS_DUMP + tid * 4, j0, i0, jb);
            if (more) rs_stage(raw, ka, nbuf + ss * RS_STEP_B + cgp * 16);
            __syncthreads();
            if (lat) { typedef unsigned u32x2_t __attribute__((ext_vector_type(2))); const u32x2_t ov = *(const LAS u32x2_t*)(obuf + (ss * 64 + cgp * 4) * 2);
                *(uint2*)(OR + ((size_t)dir * MX + scan_row(c * RS_TS + ss, dir, b)) * RW + ch) = make_uint2(ov[0], ov[1]); }
        }
    }
}

struct SIn { uint4 b0, b1, c0, c1; unsigned xs; float dt, la; };
__device__ __forceinline__ void ssd_load(SIn& x, const bf16* XS, const bf16* BC, const float* DT, const float* LA, int m, int chx, int cb, int dh) {
    x.b0 = ld16(BC + (size_t)m * RW + cb); x.b1 = ld16(BC + (size_t)m * RW + cb + 8); x.c0 = ld16(BC + (size_t)m * RW + 1024 + cb); x.c1 = ld16(BC + (size_t)m * RW + 1024 + cb + 8);
    x.xs = XS[(size_t)m * RW + chx]; x.dt = DT[(size_t)m * 64 + dh]; x.la = LA[(size_t)m * 64 + dh];
}
__device__ __forceinline__ float ssd_step(float (&s)[16], const SIn& x) {
    float B0[8], B1[8], C0[8], C1[8]; unpack8(x.b0, B0); unpack8(x.b1, B1); unpack8(x.c0, C0); unpack8(x.c1, C1);
    const float dec = __expf(x.la), xdt = __uint_as_float(x.xs << 16) * x.dt; float y = 0.f;
#pragma unroll
    for (int e = 0; e < 8; ++e) { s[e] = dec * s[e] + xdt * B0[e]; y += s[e] * C0[e]; s[8 + e] = dec * s[8 + e] + xdt * B1[e]; y += s[8 + e] * C1[e]; }
    y = sum8(y);
    return y;
}
__device__ __forceinline__ void ph_ssd_scan(const Args& a) {
    const int lane = LANE, wave = WAVE;
    const bf16* XS = (const bf16*)(a.ws + WS_XS); const bf16* BC = (const bf16*)(a.ws + WS_BC); const float* DT = (const float*)(a.ws + WS_DT); const float* LA = (const float*)(a.ws + WS_LA);
    bf16* YS = (bf16*)a.out + (size_t)2 * MX * RW;
    for (int u = blockIdx.x; u < 256; u += gridDim.x) {
        const int g = u >> 5, h = u & 31, dir = g >> 2, b = g & 3;
        const int p = wave * 8 + (lane >> 3), nb = lane & 7, chx = h * 64 + p, cb = (h >> 2) * 128 + nb * 16, dh = dir * 32 + h;
        float s[16];
#pragma unroll
        for (int e = 0; e < 16; ++e) s[e] = 0.f;
        SIn A[4], B[4];
#pragma unroll
        for (int q = 0; q < 4; ++q) ssd_load(A[q], XS, BC, DT, LA, scan_row(q, dir, b), chx, cb, dh);
        for (int n0 = 0; n0 < NSTEP; n0 += 8) {
#pragma unroll
            for (int q = 0; q < 4; ++q) ssd_load(B[q], XS, BC, DT, LA, scan_row(n0 + 4 + q, dir, b), chx, cb, dh);
#pragma unroll
            for (int q = 0; q < 4; ++q) { const int n = n0 + q; const float y = ssd_step(s, A[q]);
                if (n >= CTXL && nb == 0) YS[((size_t)dir * MX + scan_row(n, dir, b)) * RW + chx] = (bf16)f2bf(y); }
            if (n0 + 8 < NSTEP) {
#pragma unroll
                for (int q = 0; q < 4; ++q) ssd_load(A[q], XS, BC, DT, LA, scan_row(n0 + 8 + q, dir, b), chx, cb, dh);
            }
#pragma unroll
            for (int q = 0; q < 4; ++q) { const int n = n0 + 4 + q; const float y = ssd_step(s, B[q]);
                if (n >= CTXL && nb == 0) YS[((size_t)dir * MX + scan_row(n, dir, b)) * RW + chx] = (bf16)f2bf(y); }
        }
    }
}

typedef short bf16x8_t __attribute__((ext_vector_type(8)));
typedef float f32x16 __attribute__((ext_vector_type(16)));
constexpr int SLD = 272;
constexpr int L_C = 0, L_B = 34816, L_BT = 69632, L_XT = 104448, L_S = 121856, L_F = 139264;
static_assert(L_F + 4 * 512 <= LDS_CTL, "ssd lds map");
typedef unsigned u32x4_t __attribute__((ext_vector_type(4)));
__device__ __forceinline__ void lds_st16(LAS unsigned char* p, const uint4& v) { *(LAS u32x4_t*)p = (u32x4_t){v.x, v.y, v.z, v.w}; }
__device__ __forceinline__ uint4 lds_ld16(const LAS unsigned char* p) { const u32x4_t t = *(const LAS u32x4_t*)p; return make_uint4(t[0], t[1], t[2], t[3]); }
__device__ __forceinline__ bf16x8_t lfrag(LAS unsigned char* img, int row, int k) { return *(LAS bf16x8_t*)(img + row * SLD + k * 2); }
__device__ __forceinline__ void ph_ssd_chunked(const Args& a, LAS unsigned char* lds) {
    const int tid = TID, lane = LANE, wave = WAVE, r = lane & 31, hh = lane >> 5;
    const bf16* XS = (const bf16*)(a.ws + WS_XS); const bf16* BC = (const bf16*)(a.ws + WS_BC); const float* DT = (const float*)(a.ws + WS_DT); const float* LA = (const float*)(a.ws + WS_LA);
    bf16* YS = (bf16*)a.out + (size_t)2 * MX * RW;
    LAS float* laS = (LAS float*)(lds + L_F); LAS float* dtS = laS + 128; LAS float* cumS = laS + 256;
    for (int u = blockIdx.x; u < 256; u += gridDim.x) {
        const int g = u >> 5, h = u & 31, dir = g >> 2, b = g & 3, gi = h >> 2;
        f32x16 st;
#pragma unroll
        for (int q = 0; q < 16; ++q) st[q] = 0.f;
        __syncthreads();
        for (int i = tid; i < 64 * SLD / 4; i += 512) ((LAS unsigned*)(lds + L_S))[i] = 0u;
        uint4 pB[4], pC[4], pX[2]; float pla = 0.f, pdt = 0.f;
#define SSD_FETCH(cc) do { const int n0_ = (cc) * 128; const bool lat_ = (cc) >= CTXL / 128; \
            _Pragma("unroll") for (int k_ = 0; k_ < 4; ++k_) { const int i_ = tid + 512 * k_; const int l_ = i_ >> 4, pc_ = i_ & 15; const size_t m_ = (size_t)scan_row(n0_ + l_, dir, b); \
                pB[k_] = ld16(BC + m_ * RW + gi * 128 + pc_ * 8); if (lat_) pC[k_] = ld16(BC + m_ * RW + 1024 + gi * 128 + pc_ * 8); } \
            _Pragma("unroll") for (int k_ = 0; k_ < 2; ++k_) { const int i_ = tid + 512 * k_; const int l_ = i_ >> 3, pc_ = i_ & 7; const size_t m_ = (size_t)scan_row(n0_ + l_, dir, b); pX[k_] = ld16(XS + m_ * RW + h * 64 + pc_ * 8); } \
            if (tid < 128) { const size_t m_ = (size_t)scan_row(n0_ + tid, dir, b); pla = LA[m_ * 64 + dir * 32 + h]; pdt = DT[m_ * 64 + dir * 32 + h]; } } while (0)
        SSD_FETCH(0);
        for (int c = 0; c < NSTEP / 128; ++c) {
            const int n0 = c * 128; const bool lat = c >= CTXL / 128;
#pragma unroll
            for (int k = 0; k < 4; ++k) { const int i = tid + 512 * k; const int l = i >> 4, pc = i & 15;
                lds_st16(lds + L_B + l * SLD + pc * 16, pB[k]); if (lat) lds_st16(lds + L_C + l * SLD + pc * 16, pC[k]); }
#pragma unroll
            for (int k = 0; k < 2; ++k) { const int i = tid + 512 * k; const int l = i >> 3, pc = i & 7; const unsigned w[4] = {pX[k].x, pX[k].y, pX[k].z, pX[k].w};
#pragma unroll
                for (int e = 0; e < 8; ++e) *(LAS bf16*)(lds + L_XT + (pc * 8 + e) * SLD + l * 2) = (bf16)((e & 1) ? (w[e >> 1] >> 16) : (w[e >> 1] & 0xffffu)); }
            if (tid < 128) { laS[tid] = pla; dtS[tid] = pdt; }
            if (c + 1 < NSTEP / 128) SSD_FETCH(c + 1);
            lds_barrier();
            if (wave == 0) { const float a0 = laS[2 * lane], b0 = laS[2 * lane + 1]; float x = a0 + b0;
#pragma unroll
                for (int d = 1; d < 64; d <<= 1) { const float y = __shfl_up(x, d); if (lane >= d) x += y; }
                cumS[2 * lane + 1] = x; cumS[2 * lane] = x - b0; }
            lds_barrier();
            const float ctot = cumS[127];
            for (int i = tid; i < 2048; i += 512) { const int l = i >> 4, pc = i & 15; const float wl = dtS[l] * __expf(ctot - cumS[l]);
                float f[8]; unpack8(lds_ld16(lds + L_B + l * SLD + pc * 16), f);
#pragma unroll
                for (int e = 0; e < 8; ++e) *(LAS bf16*)(lds + L_BT + (pc * 8 + e) * SLD + l * 2) = (bf16)f2bf(f[e] * wl); }
            f32x16 acc0, acc1;
            const int lt = wave >> 1, st0 = 2 * (wave & 1);
            if (lat) {
#pragma unroll
                for (int q = 0; q < 16; ++q) { acc0[q] = 0.f; acc1[q] = 0.f; }
                if (st0 <= lt) {
#pragma unroll
                    for (int ks = 0; ks < 8; ++ks) { const bf16x8_t af = lfrag(lds + L_C, lt * 32 + r, ks * 16 + 8 * hh);
                        acc0 = __builtin_amdgcn_mfma_f32_32x32x16_bf16(af, lfrag(lds + L_B, st0 * 32 + r, ks * 16 + 8 * hh), acc0, 0, 0, 0);
                        if (st0 + 1 <= lt) acc1 = __builtin_amdgcn_mfma_f32_32x32x16_bf16(af, lfrag(lds + L_B, (st0 + 1) * 32 + r, ks * 16 + 8 * hh), acc1, 0, 0, 0); }
                }
            }
            lds_barrier();
            if (lat) {
#pragma unroll
                for (int t = 0; t < 2; ++t) { const int stt = st0 + t;
                    if (stt <= lt) { const int sidx = stt * 32 + r; const float cs = cumS[sidx], ds = dtS[sidx];
#pragma unroll
                        for (int q = 0; q < 16; ++q) { const int l = lt * 32 + (q & 3) + 8 * (q >> 2) + 4 * hh; const float v = t ? acc1[q] : acc0[q];
                            const float wv = sidx <= l ? v * __expf(cumS[l] - cs) * ds : 0.f;
                            *(LAS bf16*)(lds + L_B + l * SLD + sidx * 2) = (bf16)f2bf(wv); } } }
            }
            lds_barrier();
            if (lat) {
                const int pt = wave & 1;
                f32x16 accd, acco;
#pragma unroll
                for (int q = 0; q < 16; ++q) { accd[q] = 0.f; acco[q] = 0.f; }
                for (int ks = 0; ks < 2 * (lt + 1); ++ks)
                    accd = __builtin_amdgcn_mfma_f32_32x32x16_bf16(lfrag(lds + L_B, lt * 32 + r, ks * 16 + 8 * hh), lfrag(lds + L_XT, pt * 32 + r, ks * 16 + 8 * hh), accd, 0, 0, 0);
#pragma unroll
                for (int ks = 0; ks < 8; ++ks)
                    acco = __builtin_amdgcn_mfma_f32_32x32x16_bf16(lfrag(lds + L_C, lt * 32 + r, ks * 16 + 8 * hh), lfrag(lds + L_S, pt * 32 + r, ks * 16 + 8 * hh), acco, 0, 0, 0);
#pragma unroll
                for (int q = 0; q < 16; ++q) { const int l = lt * 32 + (q & 3) + 8 * (q >> 2) + 4 * hh; const float y = accd[q] + __expf(cumS[l]) * acco[q];
                    YS[((size_t)dir * MX + scan_row(n0 + l, dir, b)) * RW + h * 64 + pt * 32 + r] = (bf16)f2bf(y); }
            }
            const int pt2 = wave >> 2, nt = wave & 3;
            { const float dc = __expf(ctot);
#pragma unroll
              for (int q = 0; q < 16; ++q) st[q] *= dc;
#pragma unroll
              for (int ks = 0; ks < 8; ++ks)
                  st = __builtin_amdgcn_mfma_f32_32x32x16_bf16(lfrag(lds + L_XT, pt2 * 32 + r, ks * 16 + 8 * hh), lfrag(lds + L_BT, nt * 32 + r, ks * 16 + 8 * hh), st, 0, 0, 0); }
            lds_barrier();
#pragma unroll
            for (int q = 0; q < 16; ++q) { const int p = pt2 * 32 + (q & 3) + 8 * (q >> 2) + 4 * hh; *(LAS bf16*)(lds + L_S + p * SLD + (nt * 32 + r) * 2) = (bf16)f2bf(st[q]); }
            lds_barrier();
        }
    }
}

constexpr int CR_T = 32, CR_PJ = 144, CR_PS = 80, CR_PF = 272;
constexpr int CR_AR = 0, CR_BK = CR_AR + 64 * CR_PJ, CR_BHT = CR_BK + 64 * CR_PJ, CR_KHT = CR_BHT + 64 * CR_PS, CR_VT = CR_KHT + 64 * CR_PS, CR_SB = CR_VT + 64 * CR_PS,
              CR_NAK = CR_SB + 2 * 64 * CR_PJ, CR_PBR = CR_NAK + 32 * CR_PS, CR_PKR = CR_PBR + 32 * CR_PS, CR_NABF = CR_PKR + 32 * CR_PS, CR_RT = CR_NABF + 32 * CR_PJ,
              CR_SA = CR_RT + 32 * CR_PF, CR_GT = CR_SA + 64 * CR_PS, CR_CP = CR_GT + 256, CR_OB = CR_CP + 16 * 256, CR_END = CR_OB + 32 * 128;
static_assert(CR_END <= 131072, "chunked rwkv lds map");
__device__ __forceinline__ f32x16 mfma32(const bf16x8_t& a, const bf16x8_t& b, const f32x16& c) { return __builtin_amdgcn_mfma_f32_32x32x16_bf16(a, b, c, 0, 0, 0); }
__device__ __forceinline__ bf16x8_t cfrag(const LAS unsigned char* img, int pitch, int row, int k) { return *(const LAS bf16x8_t*)(img + row * pitch + k * 2); }
struct CRaw { unsigned r[2], k[2], kk[2], w[2], al[2], v[2]; };
__device__ __forceinline__ void cr_load(CRaw& x, const bf16* R, const bf16* K, const bf16* V, const bf16* KK, const bf16* LR, int n0, int dir, int b, int chn) {
#pragma unroll
    for (int u = 0; u < 2; ++u) { const size_t m = (size_t)scan_row(n0 + u, dir, b);
        x.r[u] = *(const unsigned*)(R + m * RW + chn); x.k[u] = *(const unsigned*)(K + m * RW + chn); x.kk[u] = *(const unsigned*)(KK + m * RW + chn); x.v[u] = *(const unsigned*)(V + m * RW + chn);
        x.w[u] = *(const unsigned*)(LR + m * NLR + dir * 2048 + chn); x.al[u] = *(const unsigned*)(LR + m * NLR + 4096 + dir * 2048 + chn); }
}
__device__ __forceinline__ void ph_rwkv_chunked(const Args& a, LAS unsigned char* lds) {
    const int tid = TID, lane = LANE, wave = WAVE, r = lane & 31, hh = lane >> 5;
    const bf16* R = (const bf16*)(a.ws + WS_R); const bf16* K = (const bf16*)(a.ws + WS_K); const bf16* V = (const bf16*)(a.ws + WS_V); const bf16* KK = (const bf16*)(a.ws + WS_KK);
    const bf16* LR = (const bf16*)(a.ws + WS_LR); bf16* OR = (bf16*)a.out;
    constexpr int NCH = NSTEP / CR_T;
    LAS float* GT = (LAS float*)(lds + CR_GT); LAS float* CP = (LAS float*)(lds + CR_CP);
    for (int u0 = blockIdx.x; u0 < 256; u0 += gridDim.x) {
        const int g = u0 >> 5, h = u0 & 31, dir = g >> 2, b = g & 3;
        const int jp = lane & 31, sh2 = lane >> 5, chn = h * 64 + 2 * jp, tq = 2 * wave + sh2;
        const float ka0 = a.in[I_KA][chn], ka1 = a.in[I_KA][chn + 1];
        f32x16 st;
#pragma unroll
        for (int q = 0; q < 16; ++q) st[q] = 0.f;
        __syncthreads();
        for (int i = tid; i < 64 * CR_PJ / 4; i += 512) ((LAS unsigned*)(lds + CR_SB))[i] = 0u;
        CRaw raw; cr_load(raw, R, K, V, KK, LR, 2 * tq, dir, b, chn);
        for (int c = 0; c < NCH; ++c) {
            const bool lat = c >= CTXL / CR_T;
            const LAS unsigned char* SBc = lds + CR_SB + (c & 1) * 64 * CR_PJ; LAS unsigned char* SBn = lds + CR_SB + ((c + 1) & 1) * 64 * CR_PJ;
            float rv[2][2], kd[2][2], bv[2][2], av[2][2], vv[2][2], cl[2][2], cx[2][2];
            { float run0 = 1.f, run1 = 1.f;
#pragma unroll
              for (int u = 0; u < 2; ++u) {
                  const float kk0 = bflo(raw.kk[u]), kk1 = bfhi(raw.kk[u]), al0 = bflo(raw.al[u]), al1 = bfhi(raw.al[u]);
                  rv[u][0] = bflo(raw.r[u]); rv[u][1] = bfhi(raw.r[u]); vv[u][0] = bflo(raw.v[u]); vv[u][1] = bfhi(raw.v[u]);
                  av[u][0] = -kk0; av[u][1] = -kk1; bv[u][0] = kk0 * al0; bv[u][1] = kk1 * al1;
                  kd[u][0] = bflo(raw.k[u]) * (1.f + (al0 - 1.f) * ka0); kd[u][1] = bfhi(raw.k[u]) * (1.f + (al1 - 1.f) * ka1);
                  cx[u][0] = run0; cx[u][1] = run1; run0 *= 1.f - bflo(raw.w[u]); run1 *= 1.f - bfhi(raw.w[u]); cl[u][0] = run0; cl[u][1] = run1; }
              *(LAS f32x2_t*)(lds + CR_CP + (tq * 64 + 2 * jp) * 4) = (f32x2_t){run0, run1}; }
            if (c + 1 < NCH) cr_load(raw, R, K, V, KK, LR, (c + 1) * CR_T + 2 * tq, dir, b, chn);
            lds_barrier();
            { float pre0 = 1.f, pre1 = 1.f, tot0 = 1.f, tot1 = 1.f;
#pragma unroll
              for (int q = 0; q < 16; ++q) { const f32x2_t x = *(const LAS f32x2_t*)(lds + CR_CP + (q * 64 + 2 * jp) * 4); tot0 *= x[0]; tot1 *= x[1]; if (q < tq) { pre0 *= x[0]; pre1 *= x[1]; } }
              if (tq == 0) *(LAS f32x2_t*)(lds + CR_GT + 2 * jp * 4) = (f32x2_t){tot0, tot1};
              unsigned bh[2], kh[2], vt[2];
              float tb[2][2], tk[2][2];
#pragma unroll
              for (int u = 0; u < 2; ++u) { const int t = 2 * tq + u;
                  const float g0 = pre0 * cl[u][0], g1 = pre1 * cl[u][1], gp0 = pre0 * cx[u][0], gp1 = pre1 * cx[u][1];
                  const float i0 = __builtin_amdgcn_rcpf(g0), i1 = __builtin_amdgcn_rcpf(g1);
                  *(LAS unsigned*)(lds + CR_AR + t * CR_PJ + jp * 4) = pg8::cvt_pk_bf16(av[u][0] * gp0, av[u][1] * gp1);
                  *(LAS unsigned*)(lds + CR_AR + (32 + t) * CR_PJ + jp * 4) = pg8::cvt_pk_bf16(rv[u][0] * g0, rv[u][1] * g1);
                  *(LAS unsigned*)(lds + CR_BK + t * CR_PJ + jp * 4) = pg8::cvt_pk_bf16(bv[u][0] * i0, bv[u][1] * i1);
                  *(LAS unsigned*)(lds + CR_BK + (32 + t) * CR_PJ + jp * 4) = pg8::cvt_pk_bf16(kd[u][0] * i0, kd[u][1] * i1);
                  tb[u][0] = bv[u][0] * (tot0 * i0); tb[u][1] = bv[u][1] * (tot1 * i1); tk[u][0] = kd[u][0] * (tot0 * i0); tk[u][1] = kd[u][1] * (tot1 * i1); }
#pragma unroll
              for (int ch = 0; ch < 2; ++ch) { bh[ch] = pg8::cvt_pk_bf16(tb[0][ch], tb[1][ch]); kh[ch] = pg8::cvt_pk_bf16(tk[0][ch], tk[1][ch]); vt[ch] = pg8::cvt_pk_bf16(vv[0][ch], vv[1][ch]);
                  *(LAS unsigned*)(lds + CR_BHT + (2 * jp + ch) * CR_PS + tq * 4) = bh[ch]; *(LAS unsigned*)(lds + CR_KHT + (2 * jp + ch) * CR_PS + tq * 4) = kh[ch]; *(LAS unsigned*)(lds + CR_VT + (2 * jp + ch) * CR_PS + tq * 4) = vt[ch]; } }
            lds_barrier();
            f32x16 acc;
#pragma unroll
            for (int q = 0; q < 16; ++q) acc[q] = 0.f;
            if (wave < 4) {
                const int rb = wave >> 1, cb = wave & 1;
#pragma unroll
                for (int ks = 0; ks < 4; ++ks) acc = mfma32(cfrag(lds + CR_BK, CR_PJ, 32 * rb + r, 16 * ks + 8 * hh), cfrag(lds + CR_AR, CR_PJ, 32 * cb + r, 16 * ks + 8 * hh), acc);
#pragma unroll
                for (int gq = 0; gq < 4; ++gq) { float o[4];
#pragma unroll
                    for (int e = 0; e < 4; ++e) { const int sidx = 8 * gq + 4 * hh + e; const bool keep = cb ? (sidx <= r) : (sidx < r); o[e] = keep ? acc[4 * gq + e] : 0.f; }
                    if (wave == 0) {
#pragma unroll
                        for (int e = 0; e < 4; ++e) *(LAS float*)(lds + CR_NABF + r * CR_PJ + (e * 8 + 2 * gq + hh) * 4) = o[e]; }
                    else { LAS unsigned char* dst = lds + (wave == 1 ? CR_PBR : wave == 2 ? CR_NAK : CR_PKR) + r * CR_PS + (8 * gq + 4 * hh) * 2;
                        typedef unsigned u32x2_t __attribute__((ext_vector_type(2))); *(LAS u32x2_t*)dst = (u32x2_t){pk2(o[0], o[1]), pk2(o[2], o[3])}; } }
            } else if (wave < 6 || lat) {
                const int it = wave & 1, cb = wave >> 1 & 1 ? 32 : 0;
#pragma unroll
                for (int ks = 0; ks < 4; ++ks) acc = mfma32(cfrag(SBc, CR_PJ, 32 * it + r, 16 * ks + 8 * hh), cfrag(lds + CR_AR, CR_PJ, cb + r, 16 * ks + 8 * hh), acc);
            }
            lds_barrier();
            if (wave >= 4 && (wave < 6 || lat)) {
                const int it = wave & 1; const LAS unsigned char* NT = lds + (wave < 6 ? CR_NAK : CR_PKR);
#pragma unroll
                for (int ks = 0; ks < 2; ++ks) acc = mfma32(cfrag(lds + CR_VT, CR_PS, 32 * it + r, 16 * ks + 8 * hh), cfrag(NT, CR_PS, r, 16 * ks + 8 * hh), acc);
                if (wave < 6) {
#pragma unroll
                    for (int gq = 0; gq < 4; ++gq) *(LAS f32x4*)(lds + CR_RT + r * CR_PF + (32 * it + 8 * gq + 4 * hh) * 4) = (f32x4){acc[4 * gq], acc[4 * gq + 1], acc[4 * gq + 2], acc[4 * gq + 3]};
                }
            }
            lds_barrier();
            if (wave < 4) {
                const int q = lane & 3, irow = 16 * wave + (lane >> 2);
                const LAS unsigned char* nrow = lds + CR_NABF + q * 32; const LAS unsigned char* rcol = lds + CR_RT + irow * 4;
                float mysa[8];
#pragma unroll
                for (int u = 0; u < 8; ++u) mysa[u] = 0.f;
                f32x4 NA[34], NB[34]; float RH[34];
#pragma unroll
                for (int t = 0; t < 2; ++t) { NA[t] = *(const LAS f32x4*)(nrow + t * CR_PJ); NB[t] = NA[t]; RH[t] = *(const LAS float*)(rcol + t * CR_PF); }
#pragma unroll
                for (int t = 0; t < 32; ++t) {
                    if (t + 2 < 32) { NA[t + 2] = *(const LAS f32x4*)(nrow + (t + 2) * CR_PJ); if (t + 2 > 16) NB[t + 2] = *(const LAS f32x4*)(nrow + (t + 2) * CR_PJ + 16); RH[t + 2] = *(const LAS float*)(rcol + (t + 2) * CR_PF); }
                    asm volatile("" ::: "memory");
                    float p0 = 0.f, p1 = 0.f;
#pragma unroll
                    for (int u = 0; u < 4; ++u) if (u < (t + 3) / 4) { if (u & 1) p1 += mysa[u] * NA[t][u]; else p0 += mysa[u] * NA[t][u]; }
#pragma unroll
                    for (int u = 4; u < 8; ++u) if (u < (t + 3) / 4) { if (u & 1) p1 += mysa[u] * NB[t][u - 4]; else p0 += mysa[u] * NB[t][u - 4]; }
                    float part = p0 + p1;
                    part += dppf<0xB1>(part); part += dppf<0x4E>(part);
                    const float x = RH[t] + part;
                    mysa[t >> 2] = (q == (t & 3)) ? x : mysa[t >> 2];
                    asm volatile("" : "+v"(mysa[t >> 2]));
                }
#pragma unroll
                for (int u = 0; u < 8; ++u) *(LAS bf16*)(lds + CR_SA + irow * CR_PS + (4 * u + q) * 2) = (bf16)f2bf(mysa[u]);
            }
            lds_barrier();
            if (wave < 4) {
                const int jt = wave >> 1, it = wave & 1;
#pragma unroll
                for (int gq = 0; gq < 4; ++gq) { const f32x4 gv = *(LAS f32x4*)(lds + CR_GT + (32 * jt + 8 * gq + 4 * hh) * 4);
#pragma unroll
                    for (int e = 0; e < 4; ++e) st[4 * gq + e] *= gv[e]; }
#pragma unroll
                for (int ks = 0; ks < 2; ++ks) { st = mfma32(cfrag(lds + CR_BHT, CR_PS, 32 * jt + r, 16 * ks + 8 * hh), cfrag(lds + CR_SA, CR_PS, 32 * it + r, 16 * ks + 8 * hh), st);
                    st = mfma32(cfrag(lds + CR_KHT, CR_PS, 32 * jt + r, 16 * ks + 8 * hh), cfrag(lds + CR_VT, CR_PS, 32 * it + r, 16 * ks + 8 * hh), st); }
#pragma unroll
                for (int gq = 0; gq < 4; ++gq) { typedef unsigned u32x2_t __attribute__((ext_vector_type(2)));
                    *(LAS u32x2_t*)(SBn + (32 * it + r) * CR_PJ + (32 * jt + 8 * gq + 4 * hh) * 2) = (u32x2_t){pk2(st[4 * gq], st[4 * gq + 1]), pk2(st[4 * gq + 2], st[4 * gq + 3])}; }
            } else if (wave >= 6 && lat) {
                const int it = wave & 1;
#pragma unroll
                for (int ks = 0; ks < 2; ++ks) acc = mfma32(cfrag(lds + CR_SA, CR_PS, 32 * it + r, 16 * ks + 8 * hh), cfrag(lds + CR_PBR, CR_PS, r, 16 * ks + 8 * hh), acc);
#pragma unroll
                for (int gq = 0; gq < 4; ++gq) { typedef unsigned u32x2_t __attribute__((ext_vector_type(2)));
                    *(LAS u32x2_t*)(lds + CR_OB + r * 128 + (32 * it + 8 * gq + 4 * hh) * 2) = (u32x2_t){pk2(acc[4 * gq], acc[4 * gq + 1]), pk2(acc[4 * gq + 2], acc[4 * gq + 3])}; }
            }
            lds_barrier();
            if (lat) { const int ss = tid >> 4, cgp = tid & 15; typedef unsigned u32x2_t __attribute__((ext_vector_type(2)));
                const u32x2_t ov = *(const LAS u32x2_t*)(lds + CR_OB + ss * 128 + cgp * 8);
                *(uint2*)(OR + ((size_t)dir * MX + scan_row(c * CR_T + ss, dir, b)) * RW + h * 64 + cgp * 4) = make_uint2(ov[0], ov[1]); }
        }
    }
}

__device__ __forceinline__ void ph_finish(const Args& a) {
    const int lane = LANE;
    const bf16* R = (const bf16*)(a.ws + WS_R); const bf16* K = (const bf16*)(a.ws + WS_K); const bf16* V = (const bf16*)(a.ws + WS_V);
    const bf16* LR = (const bf16*)(a.ws + WS_LR); const bf16* XS = (const bf16*)(a.ws + WS_XS); const bf16* Z = (const bf16*)(a.ws + WS_Z);
    const bf16* OR = (const bf16*)a.out; const bf16* YS = (const bf16*)a.out + (size_t)2 * MX * RW;
    bf16* A2 = (bf16*)(a.ws + WS_A2);
    for (int m = GW; m < MX; m += NGW) {
#pragma unroll
        for (int i = 0; i < 4; ++i) {
            const int c0 = (lane + 64 * i) * 8;
            float of[8], ob[8], o[8], res[8];
#if MK_SKIP_RWKV
#pragma unroll
            for (int e = 0; e < 8; ++e) res[e] = 0.f;
#else
            unpack8(ld16(OR + (size_t)m * RW + c0), of); unpack8(ld16(OR + ((size_t)MX + m) * RW + c0), ob);
            float sm = 0.f;
#pragma unroll
            for (int e = 0; e < 8; ++e) { o[e] = of[e] + ob[e]; sm += o[e]; }
            sm = sum8(sm);
            const float mean = sm * (1.f / 64.f); float sq = 0.f;
#pragma unroll
            for (int e = 0; e < 8; ++e) { o[e] -= mean; sq += o[e] * o[e]; }
            sq = sum8(sq);
            const float rstd = rsqrtf(sq * (1.f / 64.f) + GN_EPS);
            float lw[8], lb[8], r[8], k[8], v[8], a0[8], a1[8], ka[8], rk[8], gg[8];
            ldf8(a.in[I_LNW] + c0, lw); ldf8(a.in[I_LNB] + c0, lb); ldf8(a.in[I_KA] + c0, ka); ldf8(a.in[I_RK] + c0, rk);
            unpack8(ld16(R + (size_t)m * RW + c0), r); unpack8(ld16(K + (size_t)m * RW + c0), k); unpack8(ld16(V + (size_t)m * RW + c0), v);
            unpack8(ld16(LR + (size_t)m * NLR + 4096 + c0), a0); unpack8(ld16(LR + (size_t)m * NLR + 6144 + c0), a1); unpack8(ld16(LR + (size_t)m * NLR + 8192 + c0), gg);
            float bs = 0.f;
#pragma unroll
            for (int e = 0; e < 8; ++e) { const float kd = k[e] * (2.f + (a0[e] + a1[e] - 2.f) * ka[e]); bs += r[e] * kd * rk[e]; }
            bs = sum8(bs);
#pragma unroll
            for (int e = 0; e < 8; ++e) res[e] = (o[e] * rstd * lw[e] + lb[e] + bs * v[e]) * gg[e];
#endif
            st16(A2 + (size_t)m * DM + c0, pack8(res));
        }
#pragma unroll
        for (int i = 0; i < 4; ++i) {
            const int c0 = (lane + 64 * i) * 8;
            float yf[8], yb[8], xs[8], z[8], nw[8], y[8];
#if MK_SKIP_SSD
#pragma unroll
            for (int e = 0; e < 8; ++e) y[e] = 0.f;
#else
            unpack8(ld16(YS + (size_t)m * RW + c0), yf); unpack8(ld16(YS + ((size_t)MX + m) * RW + c0), yb);
            unpack8(ld16(XS + (size_t)m * RW + c0), xs); unpack8(ld16(Z + (size_t)m * RW + c0), z); ldf8(a.in[I_NORMW] + c0, nw);
            const float dsk = a.in[I_SSMD][c0 >> 6]; float ss = 0.f;
#pragma unroll
            for (int e = 0; e < 8; ++e) { y[e] = (yf[e] + yb[e] + dsk * xs[e]) * (z[e] / (1.f + __expf(-z[e]))); ss += y[e] * y[e]; }
            ss = sum32(ss);
            const float rstd = rsqrtf(ss * (1.f / 256.f) + RMS_EPS);
#pragma unroll
            for (int e = 0; e < 8; ++e) y[e] = y[e] * rstd * nw[e];
#endif
            st16(A2 + (size_t)m * DM + 2048 + c0, pack8(y));
        }
    }
}

__device__ __forceinline__ float enc_key(float v, int idx) { return __uint_as_float((__float_as_uint(v) & 0xffffff00u) | (unsigned)idx); }
typedef float f32x32_t __attribute__((ext_vector_type(32)));
typedef unsigned u32x6_t __attribute__((ext_vector_type(6)));
typedef float f32x2 __attribute__((ext_vector_type(2)));
struct Fp6Row { uint4 q0, q1, q2; float rs; };
template <bool FP4> __device__ __forceinline__ Fp6Row ld_row(const unsigned char* tab, const float* rsc, int e, int l16, int lane) {
    Fp6Row r; r.rs = FP4 ? 1.f : rsc[e];
    if (FP4) { const unsigned char* p = tab + (size_t)e * 2304; r.q0 = *(const uint4*)(p + l16); r.q1 = *(const uint4*)(p + 1024 + l16); r.q2 = make_uint4(*(const unsigned*)(p + 2048 + 4 * lane), 0u, 0u, 0u); }
    else { const unsigned char* p = tab + (size_t)e * 3072 + l16; r.q0 = *(const uint4*)p; r.q1 = *(const uint4*)(p + 1024); r.q2 = *(const uint4*)(p + 2048); }
    return r;
}
__device__ __forceinline__ f32x32_t fp6_unpack(const Fp6Row& r, int p, float one) {
    u32x6_t s; if (p == 0) { s[0] = r.q0.x; s[1] = r.q0.y; s[2] = r.q0.z; s[3] = r.q0.w; s[4] = r.q1.x; s[5] = r.q1.y; } else { s[0] = r.q1.z; s[1] = r.q1.w; s[2] = r.q2.x; s[3] = r.q2.y; s[4] = r.q2.z; s[5] = r.q2.w; }
    return __builtin_amdgcn_cvt_scalef32_pk32_f32_fp6(s, one);
}
template <bool FP4> __device__ __forceinline__ f32x32_t row_unpack(const Fp6Row& r, int p, float one, float& sc) {
    if (!FP4) { sc = 1.f; return fp6_unpack(r, p, one); }
    const uint4 q = p ? r.q1 : r.q0; const unsigned w[4] = {q.x, q.y, q.z, q.w}; f32x32_t f;
#pragma unroll
    for (int d = 0; d < 4; ++d)
        { const f32x2 t0 = __builtin_amdgcn_cvt_scalef32_pk_f32_fp4(w[d], one, 0), t1 = __builtin_amdgcn_cvt_scalef32_pk_f32_fp4(w[d], one, 1), t2 = __builtin_amdgcn_cvt_scalef32_pk_f32_fp4(w[d], one, 2), t3 = __builtin_amdgcn_cvt_scalef32_pk_f32_fp4(w[d], one, 3);
          f[8 * d] = t0.x; f[8 * d + 1] = t0.y; f[8 * d + 2] = t1.x; f[8 * d + 3] = t1.y; f[8 * d + 4] = t2.x; f[8 * d + 5] = t2.y; f[8 * d + 6] = t3.x; f[8 * d + 7] = t3.y; }
    sc = p ? bfhi(r.q2.x) : bflo(r.q2.x);
    return f;
}
__device__ __forceinline__ void fp4_unpack8(unsigned w, float one, float (&f)[8]) {
    const f32x2 t0 = __builtin_amdgcn_cvt_scalef32_pk_f32_fp4(w, one, 0), t1 = __builtin_amdgcn_cvt_scalef32_pk_f32_fp4(w, one, 1), t2 = __builtin_amdgcn_cvt_scalef32_pk_f32_fp4(w, one, 2), t3 = __builtin_amdgcn_cvt_scalef32_pk_f32_fp4(w, one, 3);
    f[0] = t0.x; f[1] = t0.y; f[2] = t1.x; f[3] = t1.y; f[4] = t2.x; f[5] = t2.y; f[6] = t3.x; f[7] = t3.y;
}
#define PIN4(a) asm volatile("" : "+v"((a)[0]), "+v"((a)[1]), "+v"((a)[2]), "+v"((a)[3]))
__device__ __forceinline__ void ph_peer(const Args& a, float* outp) {
    const int lane = LANE; constexpr bool UF4 = MK_PEER_FP4 >= 2, VF4 = MK_PEER_FP4 >= 1; constexpr int URING = UF4 ? 3 : 2, VRING = VF4 ? 3 : 2;
    const float* mod = (const float*)(a.ws + WS_MOD); const float* S = (const float*)(a.ws + WS_S);
    const unsigned char* U8 = (const unsigned char*)(a.ws + WS_U8); const unsigned char* V8 = (const unsigned char*)(a.ws + WS_V8);
    const float* USC = (const float*)(a.ws + WS_USC); const float* VSC = (const float*)(a.ws + WS_VSC);
    for (int m = GW; m < MX; m += NGW) {
        const int bb = m / SEQ;
        float* hrow = a.out + (size_t)m * DM;
        int l4 = lane * 4; asm volatile("" : "+v"(l4));
        float acc[16][4];
#if MK_SKIP_PEER
#pragma unroll
        for (int j = 0; j < 16; ++j)
#pragma unroll
            for (int e = 0; e < 4; ++e) acc[j][e] = 0.f;
#else
        float xn[16][4];
        { float ss = 0.f;
#pragma unroll
          for (int j = 0; j < 16; ++j) { const float4 h4 = *(const float4*)(hrow + 256 * j + l4); xn[j][0] = h4.x; xn[j][1] = h4.y; xn[j][2] = h4.z; xn[j][3] = h4.w; ss += (h4.x * h4.x + h4.y * h4.y) + (h4.z * h4.z + h4.w * h4.w); }
          const float rstd = rsqrtf(wave_sum(ss) * (1.f / DM) + RMS_EPS);
          const float* sh2 = mod + (size_t)bb * NMOD + 3 * DM; const float* sc2 = mod + (size_t)bb * NMOD + 4 * DM; const float* g2 = a.in[I_N2G];
#pragma unroll
          for (int j = 0; j < 16; ++j) { const int c = 256 * j + l4; const float4 gg = *(const float4*)(g2 + c), s0 = *(const float4*)(sh2 + c), s1 = *(const float4*)(sc2 + c);
              xn[j][0] = xn[j][0] * rstd * gg.x * (1.f + s1.x) + s0.x; xn[j][1] = xn[j][1] * rstd * gg.y * (1.f + s1.y) + s0.y; xn[j][2] = xn[j][2] * rstd * gg.z * (1.f + s1.z) + s0.z; xn[j][3] = xn[j][3] * rstd * gg.w * (1.f + s1.w) + s0.w;
              if ((j & 3) == 3) { PIN4(xn[j - 3]); PIN4(xn[j - 2]); PIN4(xn[j - 1]); PIN4(xn[j]); asm volatile("" ::: "memory"); } } }
        int eid0 = 0, eid1 = 0; float gt0 = 0.f, gt1 = 0.f;
        const float NEG = -3.0e38f;
        float sall[8][4];
#pragma unroll
        for (int hd = 0; hd < 8; ++hd)
#pragma unroll
            for (int e = 0; e < 4; ++e) sall[hd][e] = S[(size_t)m * 2048 + hd * 256 + 64 * e + lane];
#pragma unroll
        for (int hd = 0; hd < 8; ++hd) {
            float c1a = enc_key(sall[hd][0], lane), c1b = enc_key(sall[hd][1], 64 + lane), c2a = enc_key(sall[hd][2], lane), c2b = enc_key(sall[hd][3], 64 + lane);
            float t1 = NEG, t2 = NEG;
#pragma unroll 1
            for (int k = 0; k < 16; ++k) {
                const float m1 = wave_max(fmaxf(c1a, c1b)), m2 = wave_max(fmaxf(c2a, c2b));
                if (c1a == m1) c1a = NEG; if (c1b == m1) c1b = NEG; if (c2a == m2) c2a = NEG; if (c2b == m2) c2b = NEG;
                if (lane == k) { t1 = m1; t2 = m2; }
            }
            const float v1 = __uint_as_float(__float_as_uint(t1) & 0xffffff00u), v2 = __uint_as_float(__float_as_uint(t2) & 0xffffff00u);
            const int i1 = (int)(__float_as_uint(t1) & 0xffu), i2 = (int)(__float_as_uint(t2) & 0xffu);
            float cd[4];
#pragma unroll
            for (int e = 0; e < 4; ++e) { const float va = __shfl(v1, (lane >> 4) + 4 * e), vb = __shfl(v2, lane & 15); cd[e] = enc_key(va + vb, lane + 64 * e); }
            float best = NEG; int ex = 0;
#pragma unroll 1
            for (int k = 0; k < 16; ++k) {
                const float mx = wave_max(fmaxf(fmaxf(cd[0], cd[1]), fmaxf(cd[2], cd[3])));
#pragma unroll
                for (int e = 0; e < 4; ++e) if (cd[e] == mx) cd[e] = NEG;
                const int cidx = (int)(__float_as_uint(mx) & 0xffu);
                const int ea = __shfl(i1, cidx >> 4), eb = __shfl(i2, cidx & 15);
                if (lane == k) { best = __uint_as_float(__float_as_uint(mx) & 0xffffff00u); ex = ea * 128 + eb; }
            }
            const float bmax = __shfl(best, 0);
            const float pe = lane < 16 ? __expf(best - bmax) : 0.f;
            const float gate = pe / wave_sum(pe);
            const float gsh = __shfl(gate, lane & 15); const int esh = __shfl(ex, lane & 15);
            if ((lane >> 4) == (hd & 3)) { if (hd < 4) { gt0 = gsh; eid0 = esh; } else { gt1 = gsh; eid1 = esh; } }
        }
        const int l48 = lane * 16;
        float cf0 = 0.f, cf1 = 0.f;
#define PEER_EID(pp) __builtin_amdgcn_readlane((pp) < 64 ? eid0 : eid1, (pp) & 63)
#define PEER_FETCH(buf, pbase, TAB, F4) do { _Pragma("unroll") for (int q2 = 0; q2 < 4; ++q2) { const int e_ = PEER_EID((pbase) + q2); buf[q2] = ld_row<F4>(TAB, (TAB) == U8 ? USC : VSC, e_, l48, lane); } } while (0)
        {
            Fp6Row r0[4], r1[4], r2[4];
            PEER_FETCH(r0, 0, U8, UF4); if (URING == 3) PEER_FETCH(r1, 4, U8, UF4);
#pragma unroll 1
            for (int p0 = 0; p0 < 128; p0 += 4 * URING) {
#pragma unroll
                for (int gsel = 0; gsel < URING; ++gsel) {
                    const int pb = p0 + 4 * gsel;
                    if (pb < 128) {
                        asm volatile("" ::: "memory");
                        if (URING == 3) { if (pb + 8 < 128) { if (gsel == 0) PEER_FETCH(r2, pb + 8, U8, UF4); else if (gsel == 1) PEER_FETCH(r0, pb + 8, U8, UF4); else PEER_FETCH(r1, pb + 8, U8, UF4); } }
                        else { if (pb + 4 < 128) { if (gsel == 0) PEER_FETCH(r1, pb + 4, U8, UF4); else PEER_FETCH(r0, pb + 4, U8, UF4); } }
                        float d[4];
#pragma unroll
                        for (int q = 0; q < 4; ++q) {
                            float dd = 0.f;
#pragma unroll
                            for (int p = 0; p < 2; ++p) { const Fp6Row& rr = gsel == 0 ? r0[q] : gsel == 1 ? r1[q] : r2[q];
                                if (UF4) { const uint4 qq = p ? rr.q1 : rr.q0; const unsigned wq[4] = {qq.x, qq.y, qq.z, qq.w}; float dp = 0.f;
#pragma unroll
                                    for (int dw = 0; dw < 4; ++dw) { float one = 1.0f; asm volatile("" : "+v"(one)); float f8[8]; fp4_unpack8(wq[dw], one, f8);
#pragma unroll
                                        for (int t = 0; t < 8; ++t) dp += xn[8 * p + 2 * dw + (t >> 2)][t & 3] * f8[t];
                                        asm volatile("" : "+v"(dp)); }
                                    dd += dp * (p ? bfhi(rr.q2.x) : bflo(rr.q2.x));
                                } else { float one = 1.0f; asm volatile("" : "+v"(one)); float bsc; const f32x32_t f = row_unpack<UF4>(rr, p, one, bsc);
                                    float dp = 0.f;
#pragma unroll
                                    for (int t = 0; t < 32; ++t) dp += xn[8 * p + (t >> 2)][t & 3] * f[t];
                                    dd += dp * bsc; }
                                asm volatile("" : "+v"(dd)); }
                            d[q] = dd;
                        }
#pragma unroll
                        for (int q = 0; q < 4; ++q) {
                            const int p = pb + q;
                            const float dot = wave_sum(d[q]) * (gsel == 0 ? r0[q].rs : gsel == 1 ? r1[q].rs : r2[q].rs);
                            const float act = 0.5f * dot * (1.f + erff(dot * 0.70710678f));
                            if (lane == (p & 63)) { if (pb < 64) cf0 = gt0 * act; else cf1 = gt1 * act; }
                        }
                    }
                }
            }
        }
#pragma unroll
        for (int j = 0; j < 16; ++j)
#pragma unroll
            for (int e = 0; e < 4; ++e) acc[j][e] = 0.f;
        {
            Fp6Row r0[4], r1[4], r2[4];
            PEER_FETCH(r0, 0, V8, VF4); if (VRING == 3) PEER_FETCH(r1, 4, V8, VF4);
#pragma unroll 1
            for (int p0 = 0; p0 < 128; p0 += 4 * VRING) {
#pragma unroll
                for (int gsel = 0; gsel < VRING; ++gsel) {
                    const int pb = p0 + 4 * gsel;
                    if (pb < 128) {
                        asm volatile("" ::: "memory");
                        if (VRING == 3) { if (pb + 8 < 128) { if (gsel == 0) PEER_FETCH(r2, pb + 8, V8, VF4); else if (gsel == 1) PEER_FETCH(r0, pb + 8, V8, VF4); else PEER_FETCH(r1, pb + 8, V8, VF4); } }
                        else { if (pb + 4 < 128) { if (gsel == 0) PEER_FETCH(r1, pb + 4, V8, VF4); else PEER_FETCH(r0, pb + 4, V8, VF4); } }
                        float cfv[4];
#pragma unroll
                        for (int q = 0; q < 4; ++q) cfv[q] = rlane(pb < 64 ? cf0 : cf1, (pb + q) & 63) * (gsel == 0 ? r0[q].rs : gsel == 1 ? r1[q].rs : r2[q].rs);
#pragma unroll
                        for (int q = 0; q < 4; ++q)
#pragma unroll
                            for (int p = 0; p < 2; ++p) { const Fp6Row& rr = gsel == 0 ? r0[q] : gsel == 1 ? r1[q] : r2[q];
                                if (VF4) { const uint4 qq = p ? rr.q1 : rr.q0; const unsigned wq[4] = {qq.x, qq.y, qq.z, qq.w}; const float cfb = cfv[q] * (p ? bfhi(rr.q2.x) : bflo(rr.q2.x));
#pragma unroll
                                    for (int dw = 0; dw < 4; ++dw) { float one = 1.0f; asm volatile("" : "+v"(one)); float f8[8]; fp4_unpack8(wq[dw], one, f8);
#pragma unroll
                                        for (int t = 0; t < 8; ++t) acc[8 * p + 2 * dw + (t >> 2)][t & 3] += cfb * f8[t];
                                        PIN4(acc[8 * p + 2 * dw]); PIN4(acc[8 * p + 2 * dw + 1]); }
                                } else { float one = 1.0f; asm volatile("" : "+v"(one)); float bsc; const f32x32_t f = row_unpack<VF4>(rr, p, one, bsc);
                                    const float cfb = cfv[q] * bsc;
#pragma unroll
                                    for (int t = 0; t < 32; ++t) acc[8 * p + (t >> 2)][t & 3] += cfb * f[t];
#pragma unroll
                                    for (int jj = 0; jj < 8; ++jj) PIN4(acc[8 * p + jj]); } }
                    }
                }
            }
        }
#endif
        { const float* gt2 = mod + (size_t)bb * NMOD + 5 * DM; float ss = 0.f;
          int l4 = lane * 4; asm volatile("" : "+v"(l4));
#pragma unroll
          for (int j = 0; j < 16; ++j) { const int c = 256 * j + l4; const float4 g = *(const float4*)(gt2 + c), h4 = *(const float4*)(hrow + c);
              acc[j][0] = h4.x + g.x * acc[j][0]; acc[j][1] = h4.y + g.y * acc[j][1]; acc[j][2] = h4.z + g.z * acc[j][2]; acc[j][3] = h4.w + g.w * acc[j][3];
              ss += (acc[j][0] * acc[j][0] + acc[j][1] * acc[j][1]) + (acc[j][2] * acc[j][2] + acc[j][3] * acc[j][3]);
              if ((j & 3) == 3) { PIN4(acc[j - 3]); PIN4(acc[j - 2]); PIN4(acc[j - 1]); PIN4(acc[j]); asm volatile("" ::: "memory"); } }
          const float rstd = rsqrtf(wave_sum(ss) * (1.f / DM) + RMS_EPS);
#pragma unroll
          for (int j = 0; j < 16; ++j) { const int c = 256 * j + l4; const float4 fg = *(const float4*)(a.in[I_FG] + c);
              *(float4*)(outp + (size_t)m * DM + c) = make_float4(acc[j][0] * rstd * fg.x, acc[j][1] * rstd * fg.y, acc[j][2] * rstd * fg.z, acc[j][3] * rstd * fg.w);
              if ((j & 3) == 3) asm volatile("" ::: "memory"); } }
    }
}

constexpr int N_PHASES = 13;
__global__ void __launch_bounds__(512, 2) hybrid_fwd(Args args) {
    extern __shared__ __attribute__((aligned(16))) unsigned char lds_raw[];
    LAS unsigned char* lds = (LAS unsigned char*)lds_raw;
    volatile LAS unsigned* MISC = (volatile LAS unsigned*)(lds + LDS_MISC);
    for (int u = TID; u < (LDS_BYTES - LDS_CTL) / 4; u += 512) ((LAS unsigned*)(lds + LDS_CTL))[u] = 0u;
    __syncthreads();
    const int lo = args.ph_lo, hi = args.ph_hi;
    XcdBarrier bar; bar.bar = (unsigned*)(args.ws + WS_CTL); bar.x = 0; bar.st = nullptr;
    if (hi - lo > 1) bar = xcd_barrier_post((unsigned*)(args.ws + WS_CTL), MISC + 8);
#define IN(k) (lo <= (k) && (k) < hi && ((MK_PHASE_MASK >> (k)) & 1))
#define SEAM(k) do { if (IN(k) && IN((k) + 1)) xcd_barrier(bar); } while (0)
    const int bid = (int)blockIdx.x, G = (int)gridDim.x;

    if (IN(0)) { ph_mod(args, lds); ph_conv(args, lds); if (MK_REPEAT == 0) { ph_mod(args, lds); ph_conv(args, lds); } }
    SEAM(0);
    if (IN(1)) { ph_norm1(args); if (MK_REPEAT == 1) ph_norm1(args); }
    SEAM(1);
    if (IN(2)) { pg8::Gemm g{(const bf16*)(args.ws + WS_A1), (const bf16*)(args.ws + WS_WT_IN), MT, NINP, DM, DM, DM, 0, 0}; pg8::StaticOrder S; S.init(MT, NINP, G, bid);
        pg8::EpiBf16<0> E{(bf16*)(args.ws + WS_P), NINP, nullptr, 0, 0}; pg8::gemm_phase<pg8::EpiBf16<0>, pg8::StaticOrder>(lds, g, S, E, nullptr);
        if (MK_REPEAT == 2) pg8::gemm_phase<pg8::EpiBf16<0>, pg8::StaticOrder>(lds, g, S, E, nullptr); }
    SEAM(2);
    if (IN(3)) { ph_prep_stage(args, lds); ph_prep_rwkv(args, lds); ph_prep_ssd(args, lds); if (MK_REPEAT == 3) { ph_prep_rwkv(args, lds); ph_prep_ssd(args, lds); } }
    SEAM(3);
    if (IN(4)) { int kw = KLRW; asm volatile("" : "+s"(kw));
        pg8::Gemm g{(const bf16*)(args.ws + WS_ALR), (const bf16*)(args.ws + WS_WLR), MT, NLR, kw, KLR, KLRW, 4, 256}; pg8::StaticOrder S; S.init(MT, NLR, G, bid);
        EpiLR E{(bf16*)(args.ws + WS_LR), args.in[I_W0], args.in[I_A0]}; pg8::gemm_phase<EpiLR, pg8::StaticOrder>(lds, g, S, E, nullptr); }
    SEAM(4);
#if MK_RWKV_SEQ
    if (IN(5)) { ph_rwkv_scan(args); if (MK_REPEAT == 5) ph_rwkv_scan(args); }
#else
    if (IN(5)) {
#if MK_RWKV_LDS
        ph_rwkv_scan2(args, lds); if (MK_REPEAT == 5) ph_rwkv_scan2(args, lds);
#else
        ph_rwkv_chunked(args, lds); if (MK_REPEAT == 5) ph_rwkv_chunked(args, lds);
#endif
    }
#endif
    SEAM(5);
#if MK_SSD_SEQ
    if (IN(6)) { ph_ssd_scan(args); if (MK_REPEAT == 6) ph_ssd_scan(args); }
#else
    if (IN(6)) { ph_ssd_chunked(args, lds); if (MK_REPEAT == 6) ph_ssd_chunked(args, lds); }
#endif
    SEAM(6);
    if (IN(7)) { ph_finish(args); if (MK_REPEAT == 7) ph_finish(args); }
    SEAM(7);
    if (IN(8)) { pg8::Gemm g{(const bf16*)(args.ws + WS_A2), (const bf16*)(args.ws + WS_WT_OUT), MX, DM, DM, DM, DM, 0, 0}; pg8::StaticOrder S; S.init(MX, DM, G, bid);
        EpiRes E{args.out, args.in[I_X], (const float*)(args.ws + WS_MOD)}; pg8::gemm_phase<EpiRes, pg8::StaticOrder>(lds, g, S, E, nullptr);
        if (MK_REPEAT == 8) pg8::gemm_phase<EpiRes, pg8::StaticOrder>(lds, g, S, E, nullptr); }
    SEAM(8);
    if (IN(9)) { ph_norm2(args); if (MK_REPEAT == 9) ph_norm2(args); }
    SEAM(9);
    if (IN(10)) { pg8::Gemm g{(const bf16*)(args.ws + WS_XN2), (const bf16*)(args.ws + WS_WT_Q), MX, 2048, DM, DM, DM, 0, 0}; pg8::StaticOrder S; S.init(MX, 2048, G, bid);
        pg8::EpiBf16<0> E{(bf16*)(args.ws + WS_Q), 2048, nullptr, 0, 0}; pg8::gemm_phase<pg8::EpiBf16<0>, pg8::StaticOrder>(lds, g, S, E, nullptr); }
    SEAM(10);
    if (IN(11)) { int kw = 256; asm volatile("" : "+s"(kw));
        pg8::Gemm g{(const bf16*)(args.ws + WS_Q), (const bf16*)(args.ws + WS_KBD), MX, 2048, kw, 2048, 256, 0, 256}; pg8::StaticOrder S; S.init(MX, 2048, G, bid);
        pg8::EpiF32 E{(float*)(args.ws + WS_S), 2048, nullptr}; pg8::gemm_phase<pg8::EpiF32, pg8::StaticOrder>(lds, g, S, E, nullptr); }
    SEAM(11);
    if (IN(12)) { if (MK_REPEAT == 12) ph_peer(args, (float*)(args.ws + 903 * MiB)); ph_peer(args, args.out); }
#undef IN
#undef SEAM
}

extern "C" void kernel_launch(void* const* d_in, const int* in_sizes, int n_in, void* d_out, int out_size, void* d_ws, size_t ws_size, hipStream_t stream) {
    static int grid = 0;
    if (grid == 0) {
        if (n_in != N_IN || out_size != MX * DM || ws_size < WS_END) { fprintf(stderr, "kernel_launch: unexpected shapes (n_in %d out %d ws %zu)\n", n_in, out_size, ws_size); grid = -1; return; }
        int dev = 0, cus = 0, per_cu = 0;
        if (hipGetDevice(&dev) != hipSuccess || hipDeviceGetAttribute(&cus, hipDeviceAttributeMultiprocessorCount, dev) != hipSuccess) { grid = -1; return; }
        if (hipFuncSetAttribute((const void*)hybrid_fwd, hipFuncAttributeMaxDynamicSharedMemorySize, LDS_BYTES) != hipSuccess) { fprintf(stderr, "kernel_launch: hipFuncSetAttribute failed\n"); grid = -1; return; }
        if (hipOccupancyMaxActiveBlocksPerMultiprocessor(&per_cu, (const void*)hybrid_fwd, 512, LDS_BYTES) != hipSuccess || per_cu < 1) fprintf(stderr, "kernel_launch: occupancy query reports %d\n", per_cu);
        (void)hipGetLastError();
        grid = cus;
    }
    if (grid < 0) return;
    (void)in_sizes;
    if (hipMemsetAsync((char*)d_ws + WS_CTL, 0, CTL_ZERO_BYTES, stream) != hipSuccess) return;
    Args a{};
    for (int i = 0; i < N_IN; ++i) a.in[i] = (const float*)d_in[i];
    a.out = (float*)d_out; a.ws = (unsigned char*)d_ws;
#if MK_N_LAUNCHES == 1
    a.ph_lo = 0; a.ph_hi = N_PHASES;
    hipLaunchKernelGGL(hybrid_fwd, dim3(grid), dim3(512), LDS_BYTES, stream, a);
#else
    for (int ph = 0; ph < N_PHASES; ++ph) { if (!((MK_PHASE_MASK >> ph) & 1)) continue; a.ph_lo = ph; a.ph_hi = ph + 1; hipLaunchKernelGGL(hybrid_fwd, dim3(grid), dim3(512), LDS_BYTES, stream, a); }
#endif
}
```

```cpp
#define MK_PEER_FP4 0
#include <hip/hip_runtime.h>
#include <stdint.h>
#include <stdio.h>
namespace pg8 {
#define PG8_LAS __attribute__((address_space(3)))
typedef unsigned short bf16_t;
typedef short bf16x8 __attribute__((ext_vector_type(8)));
typedef float f32x4 __attribute__((ext_vector_type(4)));
typedef unsigned u32x4 __attribute__((ext_vector_type(4)));
constexpr int BM = 256, BK = 64, HALF = 128, HTB = HALF * BK * 2  , STAGE_BYTES = 8 * HTB, NXCD = 8, WGM = 8;

__host__ __device__ __forceinline__ int lds_byte(int r, int c) { const int st = (r >> 4) * 2 + (c >> 5), rr = r & 15, cc = c & 31, ob = rr * 64 + cc * 2; return st * 1024 + (ob ^ (((ob >> 9) & 1) << 5)); }
__host__ __device__ __forceinline__ void stage_rc(int b, int& R, int& C) { const int st = b / 1024, sb = b % 1024, swz = sb ^ (((sb >> 9) & 1) << 5); R = (st >> 1) * 16 + swz / 64; C = (st & 1) * 32 + (swz % 64) / 2; }
__host__ __device__ __forceinline__ int perm32(int rho) { const int n = rho >> 4, i = rho & 15; return 8 * (i >> 2) + 4 * n + (i & 3); }

struct Unit { int pm, pn; };
struct Gemm { const bf16_t* A; const bf16_t* Bt; int M, N, K; int lda, ldb, kshift, kmul; };

struct StaticOrder {
    int nM, nN, nwg, G, c;
    __host__ __device__ void init(int M, int N, int G_, int c_) { nM = M / BM; nN = N / BM; nwg = nM * nN; G = G_; c = c_; }
    __host__ __device__ bool next(int i, Unit& u) const {
        const long L = (long)i * G + c; if (L >= nwg) return false;
        int wgid = (int)L; { const int q = nwg / NXCD, r = nwg % NXCD, xcd = wgid % NXCD, off = wgid / NXCD; wgid = (xcd < r ? xcd * (q + 1) : r * (q + 1) + (xcd - r) * q) + off; }
        const int nig = WGM * nN, gid = wgid / nig, fm = gid * WGM, gsz = (nM - fm) < WGM ? (nM - fm) : WGM;
        u.pm = fm + ((wgid % nig) % gsz); u.pn = (wgid % nig) / gsz; return true;
    }
    __device__ __forceinline__ void a_ready(const Unit&) const {}
    __device__ __forceinline__ void done(const Unit&) const {}
};
__device__ __forceinline__ unsigned cvt_pk_bf16(float lo, float hi) { unsigned r; asm volatile("v_cvt_pk_bf16_f32 %0, %1, %2" : "=v"(r) : "v"(lo), "v"(hi)); return r; }
typedef float f32x2 __attribute__((ext_vector_type(2)));
__device__ __forceinline__ f32x2 gelu_pk(f32x2 v) {
    const f32x2 av = __builtin_elementwise_abs(v), d = av * 0.2316418882f + 1.0f;
    f32x2 t; t.x = __builtin_amdgcn_rcpf(d.x); t.y = __builtin_amdgcn_rcpf(d.y);
    f32x2 q = t * 0.5307027145f + (-0.7265760135f); q = q * t + 0.7107068705f; q = q * t + (-0.142248368f); q = q * t + 0.127414796f; q = q * t;
    const f32x2 s = (v * v) * (-0.72134752044f);
    f32x2 e; e.x = __builtin_amdgcn_exp2f(s.x); e.y = __builtin_amdgcn_exp2f(s.y);
    const f32x2 m = v * (q * e), r = v - m;
    f32x2 o; o.x = v.x < 0.f ? m.x : r.x; o.y = v.y < 0.f ? m.y : r.y; return o;
}

struct EpiF32 {
    static constexpr bool PERM = false, AFTER_DRAIN = false;
    float* C; int ldc; const float* bias;
    __device__ __forceinline__ void operator()(const f32x4 (&acc)[2][2][4][2], const Unit& u, int wr, int wc, int fr, int fq) const {
        const int row0 = u.pm * BM + wr * 64 + fr, col0 = u.pn * BM + wc * 32 + 4 * fq;
        f32x4 bv[2][2];
#pragma unroll
        for (int bj = 0; bj < 2; ++bj)
#pragma unroll
            for (int n = 0; n < 2; ++n) bv[bj][n] = bias ? *(const f32x4*)(bias + col0 + bj * HALF + n * 16) : (f32x4){0.f, 0.f, 0.f, 0.f};
#pragma unroll
        for (int ai = 0; ai < 2; ++ai)
#pragma unroll
            for (int m = 0; m < 4; ++m) { float* rowp = C + (size_t)(row0 + ai * HALF + m * 16) * ldc + col0;
#pragma unroll
                for (int bj = 0; bj < 2; ++bj)
#pragma unroll
                    for (int n = 0; n < 2; ++n) *(f32x4*)(rowp + bj * HALF + n * 16) = acc[ai][bj][m][n] + bv[bj][n]; }
    }
};
template <int ACT  > struct EpiBf16 {
    static constexpr bool PERM = true, AFTER_DRAIN = false;
    bf16_t* O; int ldc; const float* bias; int split_cols; size_t split_stride;
    __device__ __forceinline__ void operator()(const f32x4 (&acc)[2][2][4][2], const Unit& u, int wr, int wc, int fr, int fq) const {
        const int row0 = u.pm * BM + wr * 64 + fr; int colt = u.pn * BM; bf16_t* base = O;
        if (split_cols) { const int t = colt / split_cols; base += (size_t)t * split_stride; colt -= t * split_cols; }
        const int col0 = colt + wc * 32 + 8 * fq, bcol0 = u.pn * BM + wc * 32 + 8 * fq;
        f32x4 bv[2][2];
#pragma unroll
        for (int bj = 0; bj < 2; ++bj)
#pragma unroll
            for (int n = 0; n < 2; ++n) bv[bj][n] = bias ? *(const f32x4*)(bias + bcol0 + bj * HALF + 4 * n) : (f32x4){0.f, 0.f, 0.f, 0.f};
#pragma unroll
        for (int ai = 0; ai < 2; ++ai)
#pragma unroll
            for (int m = 0; m < 4; ++m) { bf16_t* rowp = base + (size_t)(row0 + ai * HALF + m * 16) * ldc + col0;
#pragma unroll
                for (int bj = 0; bj < 2; ++bj) { f32x4 v0 = acc[ai][bj][m][0] + bv[bj][0], v1 = acc[ai][bj][m][1] + bv[bj][1];
                    if (ACT == 1) { f32x2 a = gelu_pk((f32x2){v0[0], v0[1]}), b = gelu_pk((f32x2){v0[2], v0[3]}), c = gelu_pk((f32x2){v1[0], v1[1]}), d = gelu_pk((f32x2){v1[2], v1[3]});
                        v0 = (f32x4){a.x, a.y, b.x, b.y}; v1 = (f32x4){c.x, c.y, d.x, d.y}; }
                    if (ACT == 2) {
#pragma unroll
                        for (int j = 0; j < 4; ++j) { v0[j] = 0.5f * v0[j] * (1.0f + erff(v0[j] * 0.70710678f)); v1[j] = 0.5f * v1[j] * (1.0f + erff(v1[j] * 0.70710678f)); } }
                    u32x4 w; w.x = cvt_pk_bf16(v0[0], v0[1]); w.y = cvt_pk_bf16(v0[2], v0[3]); w.z = cvt_pk_bf16(v1[0], v1[1]); w.w = cvt_pk_bf16(v1[2], v1[3]);
                    *(u32x4*)(rowp + bj * HALF) = w; } }
    }
};
template <class Epi, class Sched, bool STAMP = false>
__device__ __forceinline__ void gemm_phase(PG8_LAS unsigned char* lds, const Gemm g, const Sched& S, const Epi& E, unsigned long long* stamps) {
    const int tid = threadIdx.x, wid = __builtin_amdgcn_readfirstlane(tid >> 6), lane = tid & 63, wr = wid >> 2, wc = wid & 3, fr = lane & 15, fq = lane >> 4;
    const int K = g.K, nt = K / BK;
    int ts_lo = 0, ts_hi = 0, nts = 0; const unsigned long long rt_entry = STAMP ? (unsigned long long)wall_clock64() : 0ull;
#define PG8_STAMP() do { if (STAMP && wid == 0 && nts < 64) { const unsigned long long _c = (unsigned long long)clock64(); \
        ts_lo = (lane == nts) ? (int)(unsigned)_c : ts_lo; ts_hi = (lane == nts) ? (int)(unsigned)(_c >> 32) : ts_hi; ++nts; } } while (0)
    PG8_STAMP();
    unsigned voffA[2], voffB[2];
#pragma unroll
    for (int i = 0; i < 2; ++i) { int R, C; stage_rc(tid * 16 + i * 8192, R, C); const int Rb = Epi::PERM ? ((R & ~31) + perm32(R & 31)) : R;
        voffA[i] = (unsigned)(R * g.lda + C) * 2u; voffB[i] = (unsigned)(Rb * g.ldb + C) * 2u; }
    const size_t kstep = (size_t)(BK * 2);
    const size_t hstepA = (size_t)HALF * g.lda * 2, hstepB = (size_t)HALF * g.ldb * 2;
    const size_t tstepA = 2 * hstepA, tstepB = 2 * hstepB;
    const unsigned ldsw = (unsigned)wid * 1024u;
    const int aoff = lds_byte(wr * 64 + fr, fq * 8), boff = lds_byte(wc * 32 + fr, fq * 8);
#define PG8_SA(b, h) (((b) * 2 + (h)) * HTB)
#define PG8_SB(b, h) ((4 + (b) * 2 + (h)) * HTB)
#define PG8_STAGE(bufoff, gbase, voff) do { _Pragma("unroll") for (int _i = 0; _i < 2; ++_i) \
        __builtin_amdgcn_global_load_lds((const unsigned*)((const char*)(gbase) + (voff)[_i]), (PG8_LAS unsigned*)(lds + (bufoff) + ldsw + _i * 8192), 16, 0, 0); } while (0)
#define PG8_LDA(dst, b, h) do { _Pragma("unroll") for (int m = 0; m < 4; ++m) _Pragma("unroll") for (int k = 0; k < 2; ++k) dst[m][k] = *(const PG8_LAS bf16x8*)(lds + PG8_SA(b, h) + aoff + m * 2048 + k * 1024); } while (0)
#define PG8_LDB(dst, b, h) do { _Pragma("unroll") for (int n = 0; n < 2; ++n) _Pragma("unroll") for (int k = 0; k < 2; ++k) dst[n][k] = *(const PG8_LAS bf16x8*)(lds + PG8_SB(b, h) + boff + n * 2048 + k * 1024); } while (0)
#define PG8_MMA(ai, bj, At, Bt) do { __builtin_amdgcn_s_setprio(1); _Pragma("unroll") for (int m = 0; m < 4; ++m) _Pragma("unroll") for (int n = 0; n < 2; ++n) _Pragma("unroll") for (int k = 0; k < 2; ++k) \
        acc[ai][bj][m][n] = __builtin_amdgcn_mfma_f32_16x16x32_bf16(Bt[n][k], At[m][k], acc[ai][bj][m][n], 0, 0, 0); __builtin_amdgcn_s_setprio(0); } while (0)
#define PG8_WAIT_V(n) asm volatile("s_waitcnt vmcnt(" #n ")" ::: "memory")
#define PG8_WAIT_L(n) asm volatile("s_waitcnt lgkmcnt(" #n ")" ::: "memory")
#define PG8_BAR __builtin_amdgcn_s_barrier()
#define PG8_SCHED __builtin_amdgcn_sched_barrier(0)
    Unit cur, nxt; int ui = 0;
    if (!S.next(0, cur)) return;
    f32x4 acc[2][2][4][2];
#pragma unroll
    for (int a = 0; a < 2; ++a)
#pragma unroll
        for (int b = 0; b < 2; ++b)
#pragma unroll
            for (int m = 0; m < 4; ++m)
#pragma unroll
                for (int n = 0; n < 2; ++n) acc[a][b][m][n] = (f32x4){0.f, 0.f, 0.f, 0.f};
    bf16x8 At[4][2], B0[2][2], B1[2][2];
    const char* cA = (const char*)g.A + (size_t)cur.pm * tstepA + (size_t)((cur.pn >> g.kshift) * g.kmul) * 2; const char* cB = (const char*)g.Bt + (size_t)cur.pn * tstepB;
    S.a_ready(cur);
    PG8_STAGE(PG8_SB(0, 0), cB, voffB); PG8_STAGE(PG8_SA(0, 0), cA, voffA); PG8_STAGE(PG8_SB(0, 1), cB + hstepB, voffB); PG8_STAGE(PG8_SA(0, 1), cA + hstepA, voffA);
    if (wr == 1) PG8_BAR;
    PG8_WAIT_V(4); PG8_BAR;
    PG8_STAGE(PG8_SB(1, 0), cB + kstep, voffB); PG8_STAGE(PG8_SA(1, 0), cA + kstep, voffA); PG8_STAGE(PG8_SB(1, 1), cB + hstepB + kstep, voffB);
    PG8_WAIT_V(6); PG8_BAR;
    PG8_STAMP();
    for (;;) {
        const bool has_next = S.next(ui + 1, nxt);
        const char* nA = has_next ? (const char*)g.A + (size_t)nxt.pm * tstepA + (size_t)((nxt.pn >> g.kshift) * g.kmul) * 2 : cA; const char* nB = has_next ? (const char*)g.Bt + (size_t)nxt.pn * tstepB : cB;
        for (int t = 0; t < nt; t += 2) {
            const bool last = (t == nt - 2);
            const char* a1 = cA + (size_t)(t + 1) * kstep;
            const char* a2 = last ? nA : cA + (size_t)(t + 2) * kstep; const char* b2 = last ? nB : cB + (size_t)(t + 2) * kstep;
            const char* a3 = a2 + kstep; const char* b3 = b2 + kstep;
            if (last && has_next) S.a_ready(nxt);
            PG8_LDB(B0, 0, 0); PG8_SCHED; PG8_LDA(At, 0, 0); PG8_STAGE(PG8_SA(1, 1), a1 + hstepA, voffA);
            PG8_WAIT_L(8); PG8_BAR; PG8_WAIT_L(0); PG8_MMA(0, 0, At, B0); PG8_BAR; PG8_SCHED;
            PG8_LDB(B1, 0, 1); PG8_STAGE(PG8_SB(0, 0), b2, voffB);
            PG8_BAR; PG8_WAIT_L(0); PG8_MMA(0, 1, At, B1); PG8_BAR;
            PG8_LDA(At, 0, 1); PG8_STAGE(PG8_SA(0, 0), a2, voffA);
            PG8_BAR; PG8_WAIT_L(0); PG8_MMA(1, 0, At, B0); PG8_BAR; PG8_SCHED;
            PG8_STAGE(PG8_SB(0, 1), b2 + hstepB, voffB);
            PG8_WAIT_V(6); PG8_BAR; PG8_MMA(1, 1, At, B1); PG8_BAR;
            PG8_LDB(B0, 1, 0); PG8_SCHED; PG8_LDA(At, 1, 0); PG8_STAGE(PG8_SA(0, 1), a2 + hstepA, voffA);
            PG8_WAIT_L(8); PG8_BAR; PG8_WAIT_L(0); PG8_MMA(0, 0, At, B0); PG8_BAR; PG8_SCHED;
            PG8_LDB(B1, 1, 1); PG8_STAGE(PG8_SB(1, 0), b3, voffB);
            PG8_BAR; PG8_WAIT_L(0); PG8_MMA(0, 1, At, B1); PG8_BAR;
            PG8_LDA(At, 1, 1); PG8_STAGE(PG8_SA(1, 0), a3, voffA);
            PG8_BAR; PG8_WAIT_L(0); PG8_MMA(1, 0, At, B0); PG8_BAR; PG8_SCHED;
            PG8_STAGE(PG8_SB(1, 1), b3 + hstepB, voffB);
            PG8_WAIT_V(6); PG8_BAR; PG8_MMA(1, 1, At, B1); PG8_BAR;
        }
        PG8_STAMP();
        if constexpr (!Epi::AFTER_DRAIN) { E(acc, cur, wr, wc, fr, fq); S.done(cur); }
        PG8_STAMP();
        if (!has_next) break;
#pragma unroll
        for (int a = 0; a < 2; ++a)
#pragma unroll
            for (int b = 0; b < 2; ++b)
#pragma unroll
                for (int m = 0; m < 4; ++m)
#pragma unroll
                    for (int n = 0; n < 2; ++n) acc[a][b][m][n] = (f32x4){0.f, 0.f, 0.f, 0.f};
        cur = nxt; cA = nA; cB = nB; ++ui;
    }
    PG8_WAIT_V(0);
    if (wr == 0) PG8_BAR;
    PG8_BAR;
    if constexpr (Epi::AFTER_DRAIN) { E.fused(acc, cur, wr, wc, fr, fq, lds, wid, lane); S.done(cur); }
    PG8_STAMP();
    if (STAMP && wid == 0) { stamps[lane] = lane < nts ? (((unsigned long long)(unsigned)ts_hi << 32) | (unsigned)ts_lo) : 0ull;
        if (lane == 62) stamps[62] = rt_entry; if (lane == 63) stamps[63] = (unsigned long long)wall_clock64(); }
#undef PG8_STAMP
#undef PG8_SA
#undef PG8_SB
#undef PG8_STAGE
#undef PG8_LDA
#undef PG8_LDB
#undef PG8_MMA
#undef PG8_WAIT_V
#undef PG8_WAIT_L
#undef PG8_BAR
#undef PG8_SCHED
}
}

#define LAS __attribute__((address_space(3)))
typedef unsigned short bf16;
typedef float f32x4 __attribute__((ext_vector_type(4)));

#ifndef MK_N_LAUNCHES
#define MK_N_LAUNCHES 1
#endif
#ifndef MK_PHASE_MASK
#define MK_PHASE_MASK 0x1FFF
#endif
#ifndef MK_REPEAT
#define MK_REPEAT -1
#endif
#ifndef MK_PEER_FP4
#define MK_PEER_FP4 2
#endif
#ifndef MK_RWKV_LDS
#define MK_RWKV_LDS 0
#endif
#ifndef MK_RWKV_SEQ
#define MK_RWKV_SEQ 0
#endif
#ifndef MK_SSD_SEQ
#define MK_SSD_SEQ 0
#endif
#ifndef MK_SKIP_MIXER
#define MK_SKIP_MIXER 0
#endif
#ifndef MK_SKIP_PEER
#define MK_SKIP_PEER 0
#endif
#ifndef MK_SKIP_RWKV
#define MK_SKIP_RWKV 0
#endif
#ifndef MK_SKIP_SSD
#define MK_SKIP_SSD 0
#endif

constexpr int DM = 4096, NBATCH = 4, SEQ = 4096, CTXL = 256;
constexpr int MX = NBATCH * SEQ;
constexpr int MC = NBATCH * CTXL;
constexpr int MT = MX + MC;
constexpr int RW = 2048;
constexpr int RCOLS = 6784;
constexpr int NIN = 12992, NINP = 13056;
constexpr int COL_Z = 6784, COL_XBC = 8832, COL_DT = 12928;
constexpr int NLR = 10240, KLR = 768, KLRW = 256;
constexpr int NMOD = 6 * DM;
constexpr float RMS_EPS = 1e-6f, GN_EPS = 64e-5f;
constexpr int NSTEP = CTXL + SEQ;

constexpr size_t MiB = (size_t)1 << 20;
constexpr size_t WS_CTL = 0, CTL_ZERO_BYTES = 1 * MiB;
constexpr size_t WS_MOD = 64 * 1024;
constexpr size_t WS_WT_OUT = 2 * MiB;
constexpr size_t WS_WT_Q = 34 * MiB;
constexpr size_t WS_WLR = 50 * MiB;
constexpr size_t WS_KBD = 63 * MiB;
constexpr size_t WS_DT = 71 * MiB;
constexpr size_t WS_LA = WS_DT + (size_t)MT * 64 * 4;
constexpr size_t WS_ALR = 300 * MiB;
constexpr size_t WS_WT_IN = 102 * MiB;
constexpr size_t WS_A1 = 204 * MiB;
constexpr size_t WS_P = 340 * MiB;
constexpr size_t WS_R = 774 * MiB, WS_K = 842 * MiB, WS_V = 910 * MiB, WS_KK = 978 * MiB;
constexpr size_t WS_XS = 1046 * MiB, WS_BC = 1114 * MiB;
constexpr size_t WS_Z = 102 * MiB;
constexpr size_t WS_LR = 340 * MiB;
constexpr size_t WS_A2 = 166 * MiB;
constexpr size_t WS_XN2 = 340 * MiB;
constexpr size_t WS_Q = 468 * MiB;
constexpr size_t WS_S = 532 * MiB;
constexpr size_t WS_U8 = 774 * MiB, WS_V8 = 838 * MiB;
constexpr size_t WS_USC = 902 * MiB, WS_VSC = WS_USC + 65536;
constexpr size_t WS_END = 1182 * MiB;
static_assert(WS_WT_IN + (size_t)NINP * DM * 2 <= WS_A1 && WS_A1 + (size_t)MT * DM * 2 <= WS_P && WS_P + (size_t)MT * NINP * 2 <= WS_R, "ws map 1");
static_assert(WS_LR + (size_t)MT * NLR * 2 <= WS_R && WS_Z + (size_t)MX * RW * 2 <= WS_A2 && WS_A2 + (size_t)MX * DM * 2 <= WS_P, "ws map 2");
static_assert(WS_LA + (size_t)MT * 64 * 4 <= WS_WT_IN && WS_ALR + (size_t)MT * KLR * 2 <= WS_P && WS_ALR >= WS_A2 + (size_t)MX * DM * 2 && WS_WLR + (size_t)NLR * KLRW * 2 <= WS_KBD, "ws map 3");
static_assert(WS_S + (size_t)MX * 2048 * 4 <= WS_R && WS_VSC + 65536 <= WS_XS, "ws map 4");

constexpr int LDS_BYTES = 147456;
constexpr int LDS_CTL = 143360;
constexpr int LDS_MISC = LDS_CTL + 320;

enum { I_X = 0, I_C, I_CTX, I_CCTX, I_WMOD, I_BMOD, I_N1G, I_N2G, I_WIN, I_WOUT, I_MU, I_W0, I_W2, I_A0, I_A2, I_G2, I_KK, I_KA, I_RK, I_LNW, I_LNB,
       I_CONVW, I_CONVB, I_DTB, I_ALOG, I_SSMD, I_NORMW, I_WQ, I_K1, I_K2, I_PU, I_PV, I_FG, N_IN };

struct Args { const float* in[N_IN]; float* out; unsigned char* ws; int ph_lo, ph_hi; };

__device__ __forceinline__ unsigned f2bf(float f) { unsigned u = __float_as_uint(f); return (u + 0x7fffu + ((u >> 16) & 1u)) >> 16; }
__device__ __forceinline__ unsigned pk2(float lo, float hi) { return f2bf(lo) | (f2bf(hi) << 16); }
__device__ __forceinline__ float bflo(unsigned u) { return __uint_as_float(u << 16); }
__device__ __forceinline__ float bfhi(unsigned u) { return __uint_as_float(u & 0xffff0000u); }
__device__ __forceinline__ void unpack8(const uint4& u, float (&f)[8]) {
    f[0] = bflo(u.x); f[1] = bfhi(u.x); f[2] = bflo(u.y); f[3] = bfhi(u.y); f[4] = bflo(u.z); f[5] = bfhi(u.z); f[6] = bflo(u.w); f[7] = bfhi(u.w);
}
__device__ __forceinline__ uint4 pack8(const float (&f)[8]) { uint4 u; u.x = pk2(f[0], f[1]); u.y = pk2(f[2], f[3]); u.z = pk2(f[4], f[5]); u.w = pk2(f[6], f[7]); return u; }
__device__ __forceinline__ uint4 ld16(const bf16* p) { return *(const uint4*)p; }
__device__ __forceinline__ void st16(bf16* p, const uint4& v) { *(uint4*)p = v; }
__device__ __forceinline__ void ldf8(const float* p, float (&f)[8]) { const float4 a = *(const float4*)p, b = *(const float4*)(p + 4); f[0] = a.x; f[1] = a.y; f[2] = a.z; f[3] = a.w; f[4] = b.x; f[5] = b.y; f[6] = b.z; f[7] = b.w; }
#define PIN8(a) asm volatile("" : "+v"((a)[0]), "+v"((a)[1]), "+v"((a)[2]), "+v"((a)[3]), "+v"((a)[4]), "+v"((a)[5]), "+v"((a)[6]), "+v"((a)[7]))
template <int CTRL> __device__ __forceinline__ float dppf(float v) { return __uint_as_float((unsigned)__builtin_amdgcn_update_dpp(0, (int)__float_as_uint(v), CTRL, 0xF, 0xF, true)); }
__device__ __forceinline__ float rlane(float v, int l) { return __uint_as_float((unsigned)__builtin_amdgcn_readlane((int)__float_as_uint(v), l)); }
__device__ __forceinline__ float sum8(float v) { v += dppf<0xB1>(v); v += dppf<0x4E>(v); v += dppf<0x141>(v); return v; }
__device__ __forceinline__ float sum16(float v) { v = sum8(v); v += dppf<0x140>(v); return v; }
__device__ __forceinline__ float sum32(float v) { v = sum16(v); v += __shfl_xor(v, 16); return v; }
__device__ __forceinline__ float wave_sum(float v) { v = sum16(v); return (rlane(v, 0) + rlane(v, 16)) + (rlane(v, 32) + rlane(v, 48)); }
__device__ __forceinline__ float wave_max(float v) {
    v = fmaxf(v, dppf<0xB1>(v)); v = fmaxf(v, dppf<0x4E>(v)); v = fmaxf(v, dppf<0x141>(v)); v = fmaxf(v, dppf<0x140>(v));
    return fmaxf(fmaxf(rlane(v, 0), rlane(v, 16)), fmaxf(rlane(v, 32), rlane(v, 48)));
}
__device__ __forceinline__ void lds_barrier() { asm volatile("s_waitcnt lgkmcnt(0)\n\ts_barrier" ::: "memory"); }
__device__ __forceinline__ float sigmoidf_(float x) { return 1.f / (1.f + __expf(-x)); }
__device__ __forceinline__ float siluf_(float x) { return x / (1.f + __expf(-x)); }

struct EpiLR {
    static constexpr bool PERM = true, AFTER_DRAIN = false;
    bf16* O; const float* w0; const float* a0;
    __device__ __forceinline__ void operator()(const pg8::f32x4 (&acc)[2][2][4][2], const pg8::Unit& u, int wr, int wc, int fr, int fq) const {
        const int row0 = u.pm * 256 + wr * 64 + fr; const int colt = u.pn * 256; const int type = colt >> 11;
        const int col0 = colt + wc * 32 + 8 * fq;
        const float* bias = type < 2 ? (w0 + type * 2048) : (a0 + (type - 2) * 2048);
        pg8::f32x4 bv[2][2];
#pragma unroll
        for (int bj = 0; bj < 2; ++bj)
#pragma unroll
            for (int n = 0; n < 2; ++n) bv[bj][n] = type < 4 ? *(const pg8::f32x4*)(bias + ((col0 + bj * 128 + 4 * n) & 2047)) : (pg8::f32x4){0.f, 0.f, 0.f, 0.f};
#pragma unroll
        for (int ai = 0; ai < 2; ++ai)
#pragma unroll
            for (int m = 0; m < 4; ++m) { bf16* rowp = O + (size_t)(row0 + ai * 128 + m * 16) * NLR + col0;
#pragma unroll
                for (int bj = 0; bj < 2; ++bj) { pg8::f32x4 v0 = acc[ai][bj][m][0] + bv[bj][0], v1 = acc[ai][bj][m][1] + bv[bj][1];
                    if (type < 4) {
#pragma unroll
                        for (int j = 0; j < 4; ++j) { float s0 = 1.f / (1.f + __expf(-v0[j])), s1 = 1.f / (1.f + __expf(-v1[j]));
                            if (type < 2) { s0 = -expm1f(-0.60653066f * s0); s1 = -expm1f(-0.60653066f * s1); }
                            v0[j] = s0; v1[j] = s1; } }
                    pg8::u32x4 w; w.x = pg8::cvt_pk_bf16(v0[0], v0[1]); w.y = pg8::cvt_pk_bf16(v0[2], v0[3]); w.z = pg8::cvt_pk_bf16(v1[0], v1[1]); w.w = pg8::cvt_pk_bf16(v1[2], v1[3]);
                    *(pg8::u32x4*)(rowp + bj * 128) = w; } }
    }
};
struct EpiRes {
    static constexpr bool PERM = false, AFTER_DRAIN = false;
    float* C; const float* X; const float* mod;
    __device__ __forceinline__ void operator()(const pg8::f32x4 (&acc)[2][2][4][2], const pg8::Unit& u, int wr, int wc, int fr, int fq) const {
        const int row0 = u.pm * 256 + wr * 64 + fr, col0 = u.pn * 256 + wc * 32 + 4 * fq;
        const float* gt = mod + (size_t)((u.pm * 256) / SEQ) * NMOD + 2 * DM;
        pg8::f32x4 gv[2][2];
#pragma unroll
        for (int bj = 0; bj < 2; ++bj)
#pragma unroll
            for (int n = 0; n < 2; ++n) gv[bj][n] = *(const pg8::f32x4*)(gt + col0 + bj * 128 + n * 16);
#pragma unroll
        for (int ai = 0; ai < 2; ++ai)
#pragma unroll
            for (int m = 0; m < 4; ++m) { const size_t off = (size_t)(row0 + ai * 128 + m * 16) * DM + col0;
#pragma unroll
                for (int bj = 0; bj < 2; ++bj)
#pragma unroll
                    for (int n = 0; n < 2; ++n) { const pg8::f32x4 xv = *(const pg8::f32x4*)(X + off + bj * 128 + n * 16);
#if MK_SKIP_MIXER
                        *(pg8::f32x4*)(C + off + bj * 128 + n * 16) = xv;
#else
                        *(pg8::f32x4*)(C + off + bj * 128 + n * 16) = xv + gv[bj][n] * acc[ai][bj][m][n];
#endif
                    }
                asm volatile("" ::: "memory"); }
    }
};

#define XB_TMO      128
#define XB_XCNT(j)  (256  + 64 * (j))
#define XB_XSUB(j)  (1280 + 64 * (j))
#define XB_XGEN(j)  (2304 + 64 * (j))
#define XB_TOP      3328
#define XB_TOPGEN   3392
#define XCD_BAR_WORDS 3456
#define XB_SPIN_CAP (1u << 18)
__device__ __forceinline__ unsigned xb_ld(unsigned* p)              { return __hip_atomic_load(p, __ATOMIC_RELAXED, __HIP_MEMORY_SCOPE_AGENT); }
__device__ __forceinline__ unsigned xb_add(unsigned* p, unsigned v) { return __hip_atomic_fetch_add(p, v, __ATOMIC_RELAXED, __HIP_MEMORY_SCOPE_AGENT); }
__device__ __forceinline__ unsigned xb_xcc_id() { return (unsigned)__builtin_amdgcn_s_getreg((3 << 11) | 20) & 0xFu; }
#define XB_SPIN(cond, bar) do { unsigned _sp = 0; while (cond) { __builtin_amdgcn_s_sleep(1); \
    if ((++_sp & 255u) == 0u) { if (xb_ld(&(bar)[XB_TMO])) break; if (_sp > XB_SPIN_CAP) { atomicAdd(&(bar)[XB_TMO], 1u); break; } } } } while (0)
struct XcdBarrier { unsigned* bar; unsigned x; volatile LAS unsigned* st; };
__device__ __forceinline__ XcdBarrier xcd_barrier_post(unsigned* bar, volatile LAS unsigned* st) {
    XcdBarrier b; b.bar = bar; b.x = xb_xcc_id(); b.st = st;
    if (threadIdx.x == 0) (void)xb_add(&bar[XB_XCNT(b.x)], 1u);
    return b;
}
__device__ __forceinline__ void xcd_barrier_complete(unsigned* bar, unsigned x, unsigned& nloc, unsigned& nx) {
    const unsigned G = gridDim.x * gridDim.y * gridDim.z;
    unsigned sum, cnt, mine, sp = 0u;
    for (;;) {
        sum = 0u; cnt = 0u; mine = 0u;
#pragma unroll
        for (unsigned j = 0; j < 16; ++j) { const unsigned c = xb_ld(&bar[XB_XCNT(j)]); sum += c; cnt += (c > 0u) ? 1u : 0u; mine = (j == x) ? c : mine; }
        if (sum == G) break;
        __builtin_amdgcn_s_sleep(1);
        if ((++sp & 255u) == 0u) { if (xb_ld(&bar[XB_TMO])) break; if (sp > XB_SPIN_CAP) { atomicAdd(&bar[XB_TMO], 1u); break; } }
    }
    nloc = mine > 0u ? mine : 1u; nx = cnt > 0u ? cnt : 1u;
}
__device__ __forceinline__ void xcd_barrier(const XcdBarrier& b) {
    asm volatile("s_waitcnt vmcnt(0)" ::: "memory");
    __syncthreads();
    if (threadIdx.x == 0) {
        unsigned* bar = b.bar;
        __builtin_amdgcn_s_waitcnt(0);
        unsigned nloc = b.st[0], nx = b.st[1];
        if (nloc == 0u) { xcd_barrier_complete(bar, b.x, nloc, nx); b.st[0] = nloc; b.st[1] = nx; }
        const unsigned old = xb_add(&bar[XB_XSUB(b.x)], 1u);
        const unsigned gen = old / nloc;
        if (old + 1u == (gen + 1u) * nloc) {
            __builtin_amdgcn_fence(__ATOMIC_RELEASE, "agent");
            asm volatile("s_waitcnt vmcnt(0)" ::: "memory");
            const unsigned og = xb_add(&bar[XB_TOP], 1u);
            const unsigned tg = og / nx;
            if (og + 1u == (tg + 1u) * nx) xb_add(&bar[XB_TOPGEN], 1u);
            else XB_SPIN(xb_ld(&bar[XB_TOPGEN]) == tg, bar);
            __builtin_amdgcn_fence(__ATOMIC_ACQUIRE, "agent");
            xb_add(&bar[XB_XGEN(b.x)], 1u);
            asm volatile("s_waitcnt vmcnt(0)" ::: "memory");
        } else {
            XB_SPIN(xb_ld(&bar[XB_XGEN(b.x)]) == gen, bar);
            __builtin_amdgcn_fence(__ATOMIC_ACQUIRE, "agent");
            asm volatile("s_waitcnt vmcnt(0)" ::: "memory");
        }
    }
    __syncthreads();
}

#define TID ((int)threadIdx.x)
#define LANE ((int)(threadIdx.x & 63))
#define WAVE ((int)__builtin_amdgcn_readfirstlane((int)(threadIdx.x >> 6)))
#define GW ((int)blockIdx.x * 8 + WAVE)
#define NGW ((int)gridDim.x * 8)

__device__ __forceinline__ void ph_mod(const Args& a, LAS unsigned char* lds) {
    const float* c = a.in[I_C]; const float* cc = a.in[I_CCTX]; const float* w_mod = a.in[I_WMOD]; const float* b_mod = a.in[I_BMOD];
    float* mod = (float*)(a.ws + WS_MOD);
    LAS float* sS = (LAS float*)lds;
    LAS float* red = (LAS float*)(lds + 81920);
    const int tid = TID, lane = LANE, wave = WAVE;
    if ((int)blockIdx.x < 192) {
        for (int i = tid; i < 5 * DM; i += 512) { const int v = i >> 12, k = i & (DM - 1); const float xv = v < 4 ? c[v * DM + k] : cc[k]; sS[i] = xv / (1.f + expf(-xv)); }
    }
    __syncthreads();
    for (int u = blockIdx.x; u < 192; u += gridDim.x) {
        const int cl = lane & 31, kh = lane >> 5;
        float acc[5][4];
#pragma unroll
        for (int v = 0; v < 5; ++v)
#pragma unroll
            for (int e = 0; e < 4; ++e) acc[v][e] = 0.f;
        const float* wp = w_mod + (size_t)(wave * 512 + kh) * NMOD + u * 128 + cl * 4;
#pragma unroll 8
        for (int i = 0; i < 256; ++i) {
            const float4 w = *(const float4*)(wp + (size_t)(2 * i) * NMOD);
#pragma unroll
            for (int v = 0; v < 5; ++v) { const float s = sS[v * DM + wave * 512 + 2 * i + kh]; acc[v][0] += s * w.x; acc[v][1] += s * w.y; acc[v][2] += s * w.z; acc[v][3] += s * w.w; }
        }
#pragma unroll
        for (int v = 0; v < 5; ++v)
#pragma unroll
            for (int e = 0; e < 4; ++e) acc[v][e] += __shfl_xor(acc[v][e], 32);
        if (kh == 0) {
#pragma unroll
            for (int v = 0; v < 5; ++v) *(LAS f32x4*)(red + ((wave * 5 + v) * 128 + cl * 4)) = (f32x4){acc[v][0], acc[v][1], acc[v][2], acc[v][3]};
        }
        __syncthreads();
        for (int i = tid; i < 640; i += 512) { const int v = i >> 7, n = i & 127; float s = b_mod[u * 128 + n];
#pragma unroll
            for (int w = 0; w < 8; ++w) s += red[(w * 5 + v) * 128 + n];
            mod[v * NMOD + u * 128 + n] = s; }
        __syncthreads();
    }
    __syncthreads();
}

__device__ __forceinline__ void transpose_item(const float* W, int K, int N, bf16* WT, LAS float* scr, int item, int lane) {
    const int nblk = N / 32, kb = item / nblk, nb = item % nblk, k0 = 64 * kb, n0 = 32 * nb;
#pragma unroll 8
    for (int i = 0; i < 32; ++i) { const int kk = 2 * i + (lane >> 5); scr[kk * 33 + (lane & 31)] = W[(size_t)(k0 + kk) * N + n0 + (lane & 31)]; }
    asm volatile("s_waitcnt lgkmcnt(0)" ::: "memory");
    const int c = lane & 7;
#pragma unroll
    for (int j = 0; j < 4; ++j) { const int n = (lane >> 3) + 8 * j; const LAS float* s = scr + (8 * c) * 33 + n;
        uint4 o; o.x = pk2(s[0 * 33], s[1 * 33]); o.y = pk2(s[2 * 33], s[3 * 33]); o.z = pk2(s[4 * 33], s[5 * 33]); o.w = pk2(s[6 * 33], s[7 * 33]);
        *(uint4*)(WT + (size_t)(n0 + n) * K + k0 + 8 * c) = o; }
    asm volatile("s_waitcnt lgkmcnt(0)" ::: "memory");
}
__device__ __forceinline__ void ph_conv(const Args& a, LAS unsigned char* lds) {
    const int lane = LANE, wave = WAVE, gw = GW, ngw = NGW;
    LAS float* scr = (LAS float*)(lds + wave * 16384);
    bf16* wt_in = (bf16*)(a.ws + WS_WT_IN); bf16* wt_out = (bf16*)(a.ws + WS_WT_OUT); bf16* wt_q = (bf16*)(a.ws + WS_WT_Q);
    constexpr int IT_IN = (DM / 64) * (NIN / 32), IT_OUT = (DM / 64) * (DM / 32), IT_Q = (DM / 64) * (2048 / 32);
    for (int it = gw; it < IT_IN + IT_OUT + IT_Q; it += ngw) {
        int r = it;
        if (r < IT_IN) { transpose_item(a.in[I_WIN], DM, NIN, wt_in, scr, r, lane); continue; } r -= IT_IN;
        if (r < IT_OUT) { transpose_item(a.in[I_WOUT], DM, DM, wt_out, scr, r, lane); continue; } r -= IT_OUT;
        transpose_item(a.in[I_WQ], DM, 2048, wt_q, scr, r, lane);
    }
    const int gt = blockIdx.x * 512 + TID, ngt = gridDim.x * 512;
    for (int i = gt; i < (NINP - NIN) * DM / 8; i += ngt) *(uint4*)(wt_in + (size_t)NIN * DM + (size_t)i * 8) = make_uint4(0u, 0u, 0u, 0u);
    { bf16* wlr = (bf16*)(a.ws + WS_WLR); const float* w2 = a.in[I_W2]; const float* a2 = a.in[I_A2]; const float* g2 = a.in[I_G2];
      for (int i = gt; i < NLR * (KLRW / 8); i += ngt) { const int n = i / (KLRW / 8), k0 = (i % (KLRW / 8)) * 8; const int type = n >> 11, cch = n & 2047;
          float f[8];
#pragma unroll
          for (int e = 0; e < 8; ++e) { const int k = k0 + e; float v = 0.f;
              if (type == 4) v = g2[(size_t)k * RW + cch];
              else { const int d = type & 1, kk = k - 128 * d; const float* src = type < 2 ? w2 : a2; if (kk >= 0 && kk < 96) v = src[(size_t)(d * 96 + kk) * RW + cch]; }
              f[e] = v; }
          st16(wlr + (size_t)n * KLRW + k0, pack8(f)); } }
    { bf16* kbd = (bf16*)(a.ws + WS_KBD); const float* k1 = a.in[I_K1]; const float* k2 = a.in[I_K2];
      for (int i = gt; i < 2048 * 32; i += ngt) { const int n = i >> 5, k0 = (i & 31) * 8; float f[8];
          const int h = n >> 8, sb = (n >> 7) & 1, key = n & 127;
          if ((k0 >> 7) == sb) { const float* src = (sb ? k2 : k1) + ((size_t)(h * 128 + key) * 128 + (k0 & 127)); ldf8(src, f); }
          else {
#pragma unroll
              for (int e = 0; e < 8; ++e) f[e] = 0.f; }
          st16(kbd + (size_t)n * 256 + k0, pack8(f)); } }
}

__device__ __forceinline__ void norm_mod_row(const float* src, const float* g, const float* sh, const float* sc, bf16* dst, int lane) {
    float4 v[16]; float ss = 0.f;
#pragma unroll
    for (int j = 0; j < 16; ++j) { v[j] = *(const float4*)(src + (lane + 64 * j) * 4); ss += (v[j].x * v[j].x + v[j].y * v[j].y) + (v[j].z * v[j].z + v[j].w * v[j].w); }
    const float rstd = rsqrtf(wave_sum(ss) * (1.f / DM) + RMS_EPS);
#pragma unroll
    for (int j = 0; j < 16; ++j) { const int c = (lane + 64 * j) * 4; const float4 gg = *(const float4*)(g + c), s1 = *(const float4*)(sc + c), s0 = *(const float4*)(sh + c);
        const float o0 = v[j].x * rstd * gg.x * (1.f + s1.x) + s0.x, o1 = v[j].y * rstd * gg.y * (1.f + s1.y) + s0.y, o2 = v[j].z * rstd * gg.z * (1.f + s1.z) + s0.z, o3 = v[j].w * rstd * gg.w * (1.f + s1.w) + s0.w;
        uint2 w; w.x = pk2(o0, o1); w.y = pk2(o2, o3); *(uint2*)(dst + c) = w; }
}
__device__ __forceinline__ void ph_norm1(const Args& a) {
    const int lane = LANE; const float* mod = (const float*)(a.ws + WS_MOD); bf16* A1 = (bf16*)(a.ws + WS_A1);
    for (int m = GW; m < MT; m += NGW) {
        const float* src = m < MX ? a.in[I_X] + (size_t)m * DM : a.in[I_CTX] + (size_t)(m - MX) * DM;
        const int v = m < MX ? m / SEQ : 4;
        norm_mod_row(src, a.in[I_N1G], mod + (size_t)v * NMOD, mod + (size_t)v * NMOD + DM, A1 + (size_t)m * DM, lane);
    }
}
__device__ __forceinline__ void ph_norm2(const Args& a) {
    const int lane = LANE; const float* mod = (const float*)(a.ws + WS_MOD); bf16* XN2 = (bf16*)(a.ws + WS_XN2);
    for (int m = GW; m < MX; m += NGW) {
        const int v = m / SEQ;
        norm_mod_row(a.out + (size_t)m * DM, a.in[I_N2G], mod + (size_t)v * NMOD + 3 * DM, mod + (size_t)v * NMOD + 4 * DM, XN2 + (size_t)m * DM, lane);
    }
    unsigned char* U8 = a.ws + WS_U8; unsigned char* V8 = a.ws + WS_V8; float* USC = (float*)(a.ws + WS_USC); float* VSC = (float*)(a.ws + WS_VSC);
    for (int row = GW; row < 2 * 16384; row += NGW) {
        const int tb = row >> 14, r = row & 16383;
        const float* src = (tb ? a.in[I_PV] : a.in[I_PU]) + (size_t)r * DM;
        float4 v[16]; float am = 0.f;
#pragma unroll
        for (int j = 0; j < 16; ++j) { v[j] = *(const float4*)(src + (lane + 64 * j) * 4); am = fmaxf(fmaxf(am, fmaxf(fabsf(v[j].x), fabsf(v[j].y))), fmaxf(fabsf(v[j].z), fabsf(v[j].w))); }
        am = wave_max(am);
        if ((tb ? MK_PEER_FP4 >= 1 : MK_PEER_FP4 >= 2)) {
            unsigned char* d4 = (tb ? V8 : U8) + (size_t)r * 2304 + lane * 16; unsigned scw = 0u;
#pragma unroll
            for (int p = 0; p < 2; ++p) {
                float bm = 0.f;
#pragma unroll
                for (int j = 0; j < 8; ++j) { const float4 q = v[8 * p + j]; bm = fmaxf(fmaxf(bm, fmaxf(fabsf(q.x), fabsf(q.y))), fmaxf(fabsf(q.z), fabsf(q.w))); }
                const unsigned sb = bm > 0.f ? f2bf(bm * (1.f / 6.f)) : 0x3f80u; const float binv = 1.f / __uint_as_float(sb << 16);
                scw |= sb << (16 * p);
                unsigned w4[4] = {0u, 0u, 0u, 0u};
#pragma unroll
                for (int d = 0; d < 4; ++d) { const float4 qa4 = v[8 * p + 2 * d], qb4 = v[8 * p + 2 * d + 1];
                    unsigned wv = 0u;
                    wv = __builtin_amdgcn_cvt_scalef32_pk_fp4_f32(wv, qa4.x * binv, qa4.y * binv, 1.0f, 0); wv = __builtin_amdgcn_cvt_scalef32_pk_fp4_f32(wv, qa4.z * binv, qa4.w * binv, 1.0f, 1);
                    wv = __builtin_amdgcn_cvt_scalef32_pk_fp4_f32(wv, qb4.x * binv, qb4.y * binv, 1.0f, 2); wv = __builtin_amdgcn_cvt_scalef32_pk_fp4_f32(wv, qb4.z * binv, qb4.w * binv, 1.0f, 3);
                    w4[d] = wv; }
                *(uint4*)(d4 + 1024 * p) = make_uint4(w4[0], w4[1], w4[2], w4[3]);
            }
            *(unsigned*)((tb ? V8 : U8) + (size_t)r * 2304 + 2048 + lane * 4) = scw;
            if (lane == 0) (tb ? VSC : USC)[r] = 1.f;
            continue;
        }
        const float scale = am > 0.f ? am * (1.f / 7.5f) : 1.f, inv = 1.f / scale;
        unsigned char* dst = (tb ? V8 : U8) + (size_t)r * 3072 + lane * 16;
        unsigned long long pk[6];
#pragma unroll
        for (int p = 0; p < 2; ++p) {
            unsigned long long w0 = 0ull, w1 = 0ull, w2 = 0ull;
#pragma unroll
            for (int k = 0; k < 32; ++k) {
                const float4 q = v[8 * p + (k >> 2)]; const float x = ((k & 3) == 0 ? q.x : (k & 3) == 1 ? q.y : (k & 3) == 2 ? q.z : q.w) * inv; const float ax = fabsf(x);
                float cf = ax < 2.f ? rintf(ax * 8.f) : (ax < 4.f ? rintf(ax * 4.f) + 8.f : rintf(ax * 2.f) + 16.f);
                cf = fminf(cf, 31.f);
                const unsigned long long code = (unsigned long long)((unsigned)cf | (x < 0.f ? 32u : 0u));
                const int pos = 6 * k, wd = pos >> 6, off = pos & 63;
                if (wd == 0) w0 |= code << off; else if (wd == 1) w1 |= code << off; else w2 |= code << off;
                if (off > 58) { if (wd == 0) w1 |= code >> (64 - off); else w2 |= code >> (64 - off); }
            }
            pk[3 * p] = w0; pk[3 * p + 1] = w1; pk[3 * p + 2] = w2;
        }
#pragma unroll
        for (int k = 0; k < 3; ++k) *(uint4*)(dst + 1024 * k) = make_uint4((unsigned)pk[2 * k], (unsigned)(pk[2 * k] >> 32), (unsigned)pk[2 * k + 1], (unsigned)(pk[2 * k + 1] >> 32));
        if (lane == 0) (tb ? VSC : USC)[r] = scale;
    }
}

__device__ __forceinline__ void ldf8s(const LAS float* p, float (&f)[8]) { const f32x4 a = *(const LAS f32x4*)p, b = *(const LAS f32x4*)(p + 4); f[0] = a[0]; f[1] = a[1]; f[2] = a[2]; f[3] = a[3]; f[4] = b[0]; f[5] = b[1]; f[6] = b[2]; f[7] = b[3]; }
constexpr int PL_MU = 0, PL_KK = 27136, PL_CW = 35328, PL_CB = 84480, PL_END = 100864;
__device__ __forceinline__ void ph_prep_stage(const Args& a, LAS unsigned char* lds) {
    const int tid = TID;
    for (int i = tid; i < RCOLS; i += 512) ((LAS float*)(lds + PL_MU))[i] = a.in[I_MU][i];
    for (int i = tid; i < RW; i += 512) ((LAS float*)(lds + PL_KK))[i] = a.in[I_KK][i];
    for (int i = tid; i < 3 * 4096; i += 512) ((LAS float*)(lds + PL_CW))[i] = a.in[I_CONVW][i];
    for (int i = tid; i < 4096; i += 512) ((LAS float*)(lds + PL_CB))[i] = a.in[I_CONVB][i];
    __syncthreads();
}
__device__ __forceinline__ void ph_prep_rwkv(const Args& a, LAS unsigned char* lds) {
    const int lane = LANE;
    const bf16* P = (const bf16*)(a.ws + WS_P);
    bf16* R = (bf16*)(a.ws + WS_R); bf16* K = (bf16*)(a.ws + WS_K); bf16* V = (bf16*)(a.ws + WS_V); bf16* KK = (bf16*)(a.ws + WS_KK); bf16* ALR = (bf16*)(a.ws + WS_ALR);
    const LAS float* mu = (const LAS float*)(lds + PL_MU); const LAS float* k_k = (const LAS float*)(lds + PL_KK);
    for (int m = GW; m < MT; m += NGW) {
        const bool lat = m < MX;
        bool h0, h1, h2 = false, h3 = false; size_t r0, r1, r2 = (size_t)m, r3 = (size_t)m;
        if (lat) { const int t = m & (SEQ - 1), row = t >> 6, col = t & 63; h0 = col > 0; h1 = col < 63; h2 = row > 0; h3 = row < 63; r0 = (size_t)(m - 1); r1 = (size_t)(m + 1); r2 = (size_t)(m - 64); r3 = (size_t)(m + 64); }
        else { const int t = (m - MX) & (CTXL - 1); h0 = t > 0; h1 = t < CTXL - 1; r0 = (size_t)(m - 1); r1 = (size_t)(m + 1); }
        if (!h0) r0 = (size_t)m; if (!h1) r1 = (size_t)m; if (!h2) r2 = (size_t)m; if (!h3) r3 = (size_t)m;
        const bf16* prow = P + (size_t)m * NINP; const bf16* p0 = P + r0 * NINP; const bf16* p1 = P + r1 * NINP; const bf16* p2 = P + r2 * NINP; const bf16* p3 = P + r3 * NINP;
        const float f0 = h0 ? 1.f : 0.f, f1 = h1 ? 1.f : 0.f, f2 = h2 ? 1.f : 0.f, f3 = h3 ? 1.f : 0.f;
        uint4 qo[2][2], q0[2][2], q1[2][2], q2[2][2], q3[2][2];
#define PREP_LOAD(buf, i2v) do { _Pragma("unroll") for (int ii = 0; ii < 2; ++ii) { const int chunk_ = lane + 64 * ((i2v) + ii); const int c0_ = (chunk_ < RCOLS / 8 ? chunk_ : 0) * 8; \
            qo[buf][ii] = ld16(prow + c0_); q0[buf][ii] = ld16(p0 + c0_); q1[buf][ii] = ld16(p1 + c0_); \
            if (lat) { q2[buf][ii] = ld16(p2 + c0_); q3[buf][ii] = ld16(p3 + c0_); } else { q2[buf][ii] = qo[buf][ii]; q3[buf][ii] = qo[buf][ii]; } } } while (0)
        PREP_LOAD(0, 0);
#pragma unroll
        for (int i2 = 0; i2 < 14; i2 += 2) {
            const int cb_ = (i2 >> 1) & 1;
            if (i2 + 2 < 14) { if (cb_) PREP_LOAD(0, i2 + 2); else PREP_LOAD(1, i2 + 2); }
            asm volatile("" ::: "memory");
#pragma unroll
            for (int ii = 0; ii < 2; ++ii) { const int i = i2 + ii; const int chunk = lane + 64 * i;
              if (chunk < RCOLS / 8) {
                const int c0 = chunk * 8;
                float own[8], n0[8], n1[8], sh[8], xm[8], muv[8];
                unpack8(qo[cb_][ii], own); unpack8(q0[cb_][ii], n0); unpack8(q1[cb_][ii], n1);
                if (lat) { float n2[8], n3[8]; unpack8(q2[cb_][ii], n2); unpack8(q3[cb_][ii], n3);
#pragma unroll
                    for (int e = 0; e < 8; ++e) sh[e] = (e & 3) == 0 ? n0[e] * f0 : (e & 3) == 1 ? n1[e] * f1 : (e & 3) == 2 ? n2[e] * f2 : n3[e] * f3;
                } else {
#pragma unroll
                    for (int e = 0; e < 8; ++e) sh[e] = (e & 1) == 0 ? n0[e] * f0 : n1[e] * f1;
                }
                ldf8s(mu + c0, muv);
#pragma unroll
                for (int e = 0; e < 8; ++e) xm[e] = own[e] + muv[e] * (sh[e] - own[e]);
                if (i < 4) st16(R + (size_t)m * RW + c0, pack8(xm));
                else if (i < 8) { const int cc = c0 - 2048; st16(K + (size_t)m * RW + cc, pack8(xm));
                    float kv[8], kkv[8]; ldf8s(k_k + cc, kv); float ss = 0.f;
#pragma unroll
                    for (int e = 0; e < 8; ++e) { kkv[e] = xm[e] * kv[e]; ss += kkv[e] * kkv[e]; }
                    ss = sum8(ss);
                    const float inv = rsqrtf(fmaxf(ss, 1e-24f));
#pragma unroll
                    for (int e = 0; e < 8; ++e) kkv[e] *= inv;
                    st16(KK + (size_t)m * RW + cc, pack8(kkv)); }
                else if (i < 12) st16(V + (size_t)m * RW + (c0 - 4096), pack8(xm));
                else { const int j0 = c0 - 6144; float f[8];
#pragma unroll
                    for (int e = 0; e < 8; ++e) f[e] = j0 < 192 ? tanhf(xm[e]) : (j0 < 384 ? xm[e] : 1.f / (1.f + __expf(-xm[e])));
                    const int col = j0 < 384 ? (j0 / 96) * 128 + (j0 % 96) : j0 + 128;
                    st16(ALR + (size_t)m * KLR + col, pack8(f)); }
              } else if (i == 13 && lane < 32) {
                const int pc = lane - 16; st16(ALR + (size_t)m * KLR + (pc >> 2) * 128 + 96 + (pc & 3) * 8, make_uint4(0u, 0u, 0u, 0u));
              }
            }
        }
    }
}

__device__ __forceinline__ void ph_prep_ssd(const Args& a, LAS unsigned char* lds) {
    const int lane = LANE;
    const bf16* P = (const bf16*)(a.ws + WS_P);
    bf16* XS = (bf16*)(a.ws + WS_XS); bf16* BC = (bf16*)(a.ws + WS_BC); bf16* Z = (bf16*)(a.ws + WS_Z); float* DT = (float*)(a.ws + WS_DT); float* LA = (float*)(a.ws + WS_LA);
    const LAS float* cw = (const LAS float*)(lds + PL_CW); const LAS float* cb = (const LAS float*)(lds + PL_CB);
    for (int m = GW; m < MT; m += NGW) {
        const bool lat = m < MX; bool hp, hn;
        if (lat) { const int t = m & (SEQ - 1); hp = t > 0; hn = t < SEQ - 1; } else { const int t = (m - MX) & (CTXL - 1); hp = t > 0; hn = t < CTXL - 1; }
        const bf16* prow = P + (size_t)m * NINP; const bf16* pp = hp ? prow - NINP : prow; const bf16* pn = hn ? prow + NINP : prow;
        const float fp = hp ? 1.f : 0.f, fn = hn ? 1.f : 0.f;
        uint4 zq[4];
        if (lat) {
#pragma unroll
            for (int i = 0; i < 4; ++i) zq[i] = ld16(prow + COL_Z + (lane + 64 * i) * 8);
        }
        const unsigned short dtraw = prow[COL_DT + lane];
        uint4 qc[2][2], qp[2][2], qn[2][2];
#define SSDP_LOAD(buf, i2v) do { _Pragma("unroll") for (int ii = 0; ii < 2; ++ii) { const int c0_ = (lane + 64 * ((i2v) + ii)) * 8; qc[buf][ii] = ld16(prow + COL_XBC + c0_); qp[buf][ii] = ld16(pp + COL_XBC + c0_); qn[buf][ii] = ld16(pn + COL_XBC + c0_); } } while (0)
        SSDP_LOAD(0, 0);
#pragma unroll
        for (int i2 = 0; i2 < 8; i2 += 2) {
            const int cb_ = (i2 >> 1) & 1;
            if (i2 + 2 < 8) { if (cb_) SSDP_LOAD(0, i2 + 2); else SSDP_LOAD(1, i2 + 2); }
            asm volatile("" ::: "memory");
#pragma unroll
            for (int ii = 0; ii < 2; ++ii) { const int i = i2 + ii; const int c0 = (lane + 64 * i) * 8;
                float cur[8], pv[8], nx[8], w0[8], w1[8], w2[8], bb[8], y[8];
                unpack8(qc[cb_][ii], cur); unpack8(qp[cb_][ii], pv); unpack8(qn[cb_][ii], nx);
                ldf8s(cw + c0, w0); ldf8s(cw + 4096 + c0, w1); ldf8s(cw + 8192 + c0, w2); ldf8s(cb + c0, bb);
#pragma unroll
                for (int e = 0; e < 8; ++e) { const float t = w0[e] * (pv[e] * fp) + w1[e] * cur[e] + w2[e] * (nx[e] * fn) + bb[e]; y[e] = t / (1.f + __expf(-t)); }
                if (i < 4) st16(XS + (size_t)m * RW + c0, pack8(y)); else st16(BC + (size_t)m * RW + (c0 - 2048), pack8(y)); }
        }
        { const float raw = __uint_as_float((unsigned)dtraw << 16) + a.in[I_DTB][lane];
          const float dtv = raw > 20.f ? raw : log1pf(expf(raw));
          DT[(size_t)m * 64 + lane] = dtv; LA[(size_t)m * 64 + lane] = -dtv * expf(a.in[I_ALOG][lane]); }
        if (lat) {
#pragma unroll
            for (int i = 0; i < 4; ++i) st16(Z + (size_t)m * RW + (lane + 64 * i) * 8, zq[i]);
        }
    }
}

__device__ __forceinline__ int scan_row(int n, int dir, int b) { return n < CTXL ? MX + b * CTXL + (dir ? CTXL - 1 - n : n) : b * SEQ + (dir ? NSTEP - 1 - n : n - CTXL); }

struct RIn { uint4 r, k, kk, w, a; unsigned v; };
__device__ __forceinline__ void rwkv_load(RIn& x, const bf16* R, const bf16* K, const bf16* V, const bf16* KK, const bf16* LR, int m, int ch, int chi, int dir) {
    x.r = ld16(R + (size_t)m * RW + ch); x.k = ld16(K + (size_t)m * RW + ch); x.kk = ld16(KK + (size_t)m * RW + ch);
    x.w = ld16(LR + (size_t)m * NLR + dir * 2048 + ch); x.a = ld16(LR + (size_t)m * NLR + 4096 + dir * 2048 + ch);
    x.v = V[(size_t)m * RW + chi];
}
__device__ __forceinline__ float rwkv_step(float (&S)[8], const RIn& x, const float (&ka)[8]) {
    float r[8], k[8], kk[8], w1[8], av[8];
    unpack8(x.r, r); unpack8(x.k, k); unpack8(x.kk, kk); unpack8(x.w, w1); unpack8(x.a, av);
    const float v = __uint_as_float(x.v << 16);
    float sa = 0.f;
#pragma unroll
    for (int e = 0; e < 8; ++e) sa -= S[e] * kk[e];
    sa = sum8(sa);
    float o = 0.f;
#pragma unroll
    for (int e = 0; e < 8; ++e) { const float kd = k[e] * (1.f + (av[e] - 1.f) * ka[e]); const float b = kk[e] * av[e];
        S[e] = S[e] * (1.f - w1[e]) + sa * b + v * kd; o += S[e] * r[e]; }
    o = sum8(o);
    return o;
}
__device__ __forceinline__ void ph_rwkv_scan(const Args& a) {
    const int lane = LANE, wave = WAVE;
    const bf16* R = (const bf16*)(a.ws + WS_R); const bf16* K = (const bf16*)(a.ws + WS_K); const bf16* V = (const bf16*)(a.ws + WS_V); const bf16* KK = (const bf16*)(a.ws + WS_KK);
    const bf16* LR = (const bf16*)(a.ws + WS_LR); bf16* OR = (bf16*)a.out;
    for (int u = blockIdx.x; u < 256; u += gridDim.x) {
        const int g = u >> 5, h = u & 31, dir = g >> 2, b = g & 3;
        const int i = wave * 8 + (lane >> 3), jb = lane & 7, ch = h * 64 + jb * 8, chi = h * 64 + i;
        float ka[8]; ldf8(a.in[I_KA] + ch, ka);
        float S[8];
#pragma unroll
        for (int e = 0; e < 8; ++e) S[e] = 0.f;
        RIn A[4], B[4];
#pragma unroll
        for (int s = 0; s < 4; ++s) rwkv_load(A[s], R, K, V, KK, LR, scan_row(s, dir, b), ch, chi, dir);
        for (int n0 = 0; n0 < NSTEP; n0 += 8) {
#pragma unroll
            for (int s = 0; s < 4; ++s) rwkv_load(B[s], R, K, V, KK, LR, scan_row(n0 + 4 + s, dir, b), ch, chi, dir);
#pragma unroll
            for (int s = 0; s < 4; ++s) { const int n = n0 + s; const float o = rwkv_step(S, A[s], ka);
                if (n >= CTXL && jb == 0) OR[((size_t)dir * MX + scan_row(n, dir, b)) * RW + chi] = (bf16)f2bf(o); }
            if (n0 + 8 < NSTEP) {
#pragma unroll
                for (int s = 0; s < 4; ++s) rwkv_load(A[s], R, K, V, KK, LR, scan_row(n0 + 8 + s, dir, b), ch, chi, dir);
            }
#pragma unroll
            for (int s = 0; s < 4; ++s) { const int n = n0 + 4 + s; const float o = rwkv_step(S, B[s], ka);
                if (n >= CTXL && jb == 0) OR[((size_t)dir * MX + scan_row(n, dir, b)) * RW + chi] = (bf16)f2bf(o); }
        }
    }
}

typedef float f32x2_t __attribute__((ext_vector_type(2)));
constexpr int RS_TS = 32, RS_STEP_B = 6 * 256, RS_BUF_B = RS_TS * RS_STEP_B;
constexpr int RS_OBUF = 2 * RS_BUF_B, RS_OBUF_B = RS_TS * 64 * 2;
constexpr int RS_DUMP = RS_OBUF + 2 * RS_OBUF_B;
static_assert(RS_DUMP + 2048 <= 131072, "rwkv scan lds map");
struct RRaw { uint2 r, k, kk, v, w, a; };
__device__ __forceinline__ void rs_load(RRaw& x, const bf16* R, const bf16* K, const bf16* V, const bf16* KK, const bf16* LR, int m, int ch, int dir) {
    x.r = *(const uint2*)(R + (size_t)m * RW + ch); x.k = *(const uint2*)(K + (size_t)m * RW + ch); x.kk = *(const uint2*)(KK + (size_t)m * RW + ch); x.v = *(const uint2*)(V + (size_t)m * RW + ch);
    x.w = *(const uint2*)(LR + (size_t)m * NLR + dir * 2048 + ch); x.a = *(const uint2*)(LR + (size_t)m * NLR + 4096 + dir * 2048 + ch);
}
__device__ __forceinline__ void rs_stage(const RRaw& x, const float (&ka)[4], LAS unsigned char* dst) {
    const float r[4] = {bflo(x.r.x), bfhi(x.r.x), bflo(x.r.y), bfhi(x.r.y)}, k[4] = {bflo(x.k.x), bfhi(x.k.x), bflo(x.k.y), bfhi(x.k.y)};
    const float kk[4] = {bflo(x.kk.x), bfhi(x.kk.x), bflo(x.kk.y), bfhi(x.kk.y)}, v[4] = {bflo(x.v.x), bfhi(x.v.x), bflo(x.v.y), bfhi(x.v.y)};
    const float w1[4] = {bflo(x.w.x), bfhi(x.w.x), bflo(x.w.y), bfhi(x.w.y)}, av[4] = {bflo(x.a.x), bfhi(x.a.x), bflo(x.a.y), bfhi(x.a.y)};
    f32x4 nkk, w, b, kd, rr, vv;
#pragma unroll
    for (int e = 0; e < 4; ++e) { nkk[e] = -kk[e]; w[e] = 1.f - w1[e]; b[e] = kk[e] * av[e]; kd[e] = k[e] * (1.f + (av[e] - 1.f) * ka[e]); rr[e] = r[e]; vv[e] = v[e]; }
    *(LAS f32x4*)(dst) = nkk; *(LAS f32x4*)(dst + 256) = w; *(LAS f32x4*)(dst + 512) = b; *(LAS f32x4*)(dst + 768) = kd; *(LAS f32x4*)(dst + 1024) = rr; *(LAS f32x4*)(dst + 1280) = vv;
}
__device__ __forceinline__ float amul(float a, float b) { float d; asm("v_mul_f32 %0, %1, %2" : "=v"(d) : "v"(a), "v"(b)); return d; }
__device__ __forceinline__ void afmac(float& d, float a, float b) { asm("v_fmac_f32 %0, %1, %2" : "+v"(d) : "v"(a), "v"(b)); }
__device__ __forceinline__ float afma(float a, float b, float c) { float d; asm("v_fma_f32 %0, %1, %2, %3" : "=v"(d) : "v"(a), "v"(b), "v"(c)); return d; }
__device__ __forceinline__ void sum16x2(float& a, float& b) {
    asm("s_nop 1\n\t"
        "v_add_f32_dpp %0, %0, %0 quad_perm:[1,0,3,2] row_mask:0xf bank_mask:0xf bound_ctrl:1\n\t"
        "v_add_f32_dpp %1, %1, %1 quad_perm:[1,0,3,2] row_mask:0xf bank_mask:0xf bound_ctrl:1\n\t"
        "s_nop 0\n\t"
        "v_add_f32_dpp %0, %0, %0 quad_perm:[2,3,0,1] row_mask:0xf bank_mask:0xf bound_ctrl:1\n\t"
        "v_add_f32_dpp %1, %1, %1 quad_perm:[2,3,0,1] row_mask:0xf bank_mask:0xf bound_ctrl:1\n\t"
        "s_nop 0\n\t"
        "v_add_f32_dpp %0, %0, %0 row_half_mirror row_mask:0xf bank_mask:0xf bound_ctrl:1\n\t"
        "v_add_f32_dpp %1, %1, %1 row_half_mirror row_mask:0xf bank_mask:0xf bound_ctrl:1\n\t"
        "s_nop 0\n\t"
        "v_add_f32_dpp %0, %0, %0 row_mirror row_mask:0xf bank_mask:0xf bound_ctrl:1\n\t"
        "v_add_f32_dpp %1, %1, %1 row_mirror row_mask:0xf bank_mask:0xf bound_ctrl:1"
        : "+v"(a), "+v"(b));
}
template <bool OUT> __device__ __forceinline__ void rs_chunk(float (&S)[2][4], const LAS unsigned char* buf, LAS unsigned char* obuf, LAS unsigned char* dump, int j0, int i0, int jb) {
#pragma unroll 4
    for (int s = 0; s < RS_TS; ++s) {
        const LAS unsigned char* base = buf + s * RS_STEP_B;
        const f32x4 nkk = *(const LAS f32x4*)(base + j0 * 4), w = *(const LAS f32x4*)(base + 256 + j0 * 4), b = *(const LAS f32x4*)(base + 512 + j0 * 4), kd = *(const LAS f32x4*)(base + 768 + j0 * 4);
        const f32x2_t v = *(const LAS f32x2_t*)(base + 1280 + i0 * 4);
        float sa0 = amul(S[0][0], nkk[0]), sa1 = amul(S[1][0], nkk[0]);
#pragma unroll
        for (int e = 1; e < 4; ++e) { afmac(sa0, S[0][e], nkk[e]); afmac(sa1, S[1][e], nkk[e]); }
        sum16x2(sa0, sa1);
#pragma unroll
        for (int e = 0; e < 4; ++e) { float t0 = amul(sa0, b[e]), t1 = amul(sa1, b[e]); afmac(t0, v[0], kd[e]); afmac(t1, v[1], kd[e]); S[0][e] = afma(S[0][e], w[e], t0); S[1][e] = afma(S[1][e], w[e], t1); }
        if (OUT) {
            const f32x4 r = *(const LAS f32x4*)(base + 1024 + j0 * 4);
            float o0 = amul(S[0][0], r[0]), o1 = amul(S[1][0], r[0]);
#pragma unroll
            for (int e = 1; e < 4; ++e) { afmac(o0, S[0][e], r[e]); afmac(o1, S[1][e], r[e]); }
            sum16x2(o0, o1);
            *(LAS unsigned*)(jb == 0 ? obuf + (s * 64 + i0) * 2 : dump) = pg8::cvt_pk_bf16(o0, o1);
        }
    }
}
__device__ __forceinline__ void ph_rwkv_scan2(const Args& a, LAS unsigned char* lds) {
    const int tid = TID, lane = LANE, wave = WAVE;
    const bf16* R = (const bf16*)(a.ws + WS_R); const bf16* K = (const bf16*)(a.ws + WS_K); const bf16* V = (const bf16*)(a.ws + WS_V); const bf16* KK = (const bf16*)(a.ws + WS_KK);
    const bf16* LR = (const bf16*)(a.ws + WS_LR); bf16* OR = (bf16*)a.out;
    constexpr int NCH = NSTEP / RS_TS;
    for (int u = blockIdx.x; u < 256; u += gridDim.x) {
        const int g = u >> 5, h = u & 31, dir = g >> 2, b = g & 3;
        const int ip = lane >> 4, jb = lane & 15, i0 = wave * 8 + ip * 2, j0 = jb * 4;
        const int ss = tid >> 4, cgp = tid & 15, ch = h * 64 + cgp * 4;
        float ka[4];
#pragma unroll
        for (int e = 0; e < 4; ++e) ka[e] = a.in[I_KA][ch + e];
        float S[2][4];
#pragma unroll
        for (int e = 0; e < 4; ++e) { S[0][e] = 0.f; S[1][e] = 0.f; }
        RRaw raw;
        __syncthreads();
        rs_load(raw, R, K, V, KK, LR, scan_row(ss, dir, b), ch, dir);
        rs_stage(raw, ka, lds + ss * RS_STEP_B + cgp * 16);
        __syncthreads();
        for (int c = 0; c < NCH; ++c) {
            LAS unsigned char* buf = lds + (c & 1) * RS_BUF_B; LAS unsigned char* nbuf = lds + ((c + 1) & 1) * RS_BUF_B; LAS unsigned char* obuf = lds + RS_OBUF + (c & 1) * RS_OBUF_B;
            const bool more = c + 1 < NCH;
            if (more) rs_load(raw, R, K, V, KK, LR, scan_row((c + 1) * RS_TS + ss, dir, b), ch, dir);
            const bool lat = c >= CTXL / RS_TS;
            if (lat) rs_chunk<true>(S, buf, obuf, lds + RS_DUMP + tid * 4, j0, i0, jb); else rs_chunk<false>(S, buf, obuf, lds + RS_DUMP + tid * 4, j0, i0, jb);
            if (more) rs_stage(raw, ka, nbuf + ss * RS_STEP_B + cgp * 16);
            __syncthreads();
            if (lat) { typedef unsigned u32x2_t __attribute__((ext_vector_type(2))); const u32x2_t ov = *(const LAS u32x2_t*)(obuf + (ss * 64 + cgp * 4) * 2);
                *(uint2*)(OR + ((size_t)dir * MX + scan_row(c * RS_TS + ss, dir, b)) * RW + ch) = make_uint2(ov[0], ov[1]); }
        }
    }
}

struct SIn { uint4 b0, b1, c0, c1; unsigned xs; float dt, la; };
__device__ __forceinline__ void ssd_load(SIn& x, const bf16* XS, const bf16* BC, const float* DT, const float* LA, int m, int chx, int cb, int dh) {
    x.b0 = ld16(BC + (size_t)m * RW + cb); x.b1 = ld16(BC + (size_t)m * RW + cb + 8); x.c0 = ld16(BC + (size_t)m * RW + 1024 + cb); x.c1 = ld16(BC + (size_t)m * RW + 1024 + cb + 8);
    x.xs = XS[(size_t)m * RW + chx]; x.dt = DT[(size_t)m * 64 + dh]; x.la = LA[(size_t)m * 64 + dh];
}
__device__ __forceinline__ float ssd_step(float (&s)[16], const SIn& x) {
    float B0[8], B1[8], C0[8], C1[8]; unpack8(x.b0, B0); unpack8(x.b1, B1); unpack8(x.c0, C0); unpack8(x.c1, C1);
    const float dec = __expf(x.la), xdt = __uint_as_float(x.xs << 16) * x.dt; float y = 0.f;
#pragma unroll
    for (int e = 0; e < 8; ++e) { s[e] = dec * s[e] + xdt * B0[e]; y += s[e] * C0[e]; s[8 + e] = dec * s[8 + e] + xdt * B1[e]; y += s[8 + e] * C1[e]; }
    y = sum8(y);
    return y;
}
__device__ __forceinline__ void ph_ssd_scan(const Args& a) {
    const int lane = LANE, wave = WAVE;
    const bf16* XS = (const bf16*)(a.ws + WS_XS); const bf16* BC = (const bf16*)(a.ws + WS_BC); const float* DT = (const float*)(a.ws + WS_DT); const float* LA = (const float*)(a.ws + WS_LA);
    bf16* YS = (bf16*)a.out + (size_t)2 * MX * RW;
    for (int u = blockIdx.x; u < 256; u += gridDim.x) {
        const int g = u >> 5, h = u & 31, dir = g >> 2, b = g & 3;
        const int p = wave * 8 + (lane >> 3), nb = lane & 7, chx = h * 64 + p, cb = (h >> 2) * 128 + nb * 16, dh = dir * 32 + h;
        float s[16];
#pragma unroll
        for (int e = 0; e < 16; ++e) s[e] = 0.f;
        SIn A[4], B[4];
#pragma unroll
        for (int q = 0; q < 4; ++q) ssd_load(A[q], XS, BC, DT, LA, scan_row(q, dir, b), chx, cb, dh);
        for (int n0 = 0; n0 < NSTEP; n0 += 8) {
#pragma unroll
            for (int q = 0; q < 4; ++q) ssd_load(B[q], XS, BC, DT, LA, scan_row(n0 + 4 + q, dir, b), chx, cb, dh);
#pragma unroll
            for (int q = 0; q < 4; ++q) { const int n = n0 + q; const float y = ssd_step(s, A[q]);
                if (n >= CTXL && nb == 0) YS[((size_t)dir * MX + scan_row(n, dir, b)) * RW + chx] = (bf16)f2bf(y); }
            if (n0 + 8 < NSTEP) {
#pragma unroll
                for (int q = 0; q < 4; ++q) ssd_load(A[q], XS, BC, DT, LA, scan_row(n0 + 8 + q, dir, b), chx, cb, dh);
            }
#pragma unroll
            for (int q = 0; q < 4; ++q) { const int n = n0 + 4 + q; const float y = ssd_step(s, B[q]);
                if (n >= CTXL && nb == 0) YS[((size_t)dir * MX + scan_row(n, dir, b)) * RW + chx] = (bf16)f2bf(y); }
        }
    }
}

typedef short bf16x8_t __attribute__((ext_vector_type(8)));
typedef float f32x16 __attribute__((ext_vector_type(16)));
constexpr int SLD = 272;
constexpr int L_C = 0, L_B = 34816, L_BT = 69632, L_XT = 104448, L_S = 121856, L_F = 139264;
static_assert(L_F + 4 * 512 <= LDS_CTL, "ssd lds map");
typedef unsigned u32x4_t __attribute__((ext_vector_type(4)));
__device__ __forceinline__ void lds_st16(LAS unsigned char* p, const uint4& v) { *(LAS u32x4_t*)p = (u32x4_t){v.x, v.y, v.z, v.w}; }
__device__ __forceinline__ uint4 lds_ld16(const LAS unsigned char* p) { const u32x4_t t = *(const LAS u32x4_t*)p; return make_uint4(t[0], t[1], t[2], t[3]); }
__device__ __forceinline__ bf16x8_t lfrag(LAS unsigned char* img, int row, int k) { return *(LAS bf16x8_t*)(img + row * SLD + k * 2); }
__device__ __forceinline__ void ph_ssd_chunked(const Args& a, LAS unsigned char* lds) {
    const int tid = TID, lane = LANE, wave = WAVE, r = lane & 31, hh = lane >> 5;
    typedef unsigned u32x2_t __attribute__((ext_vector_type(2)));
    const bf16* XS = (const bf16*)(a.ws + WS_XS); const bf16* BC = (const bf16*)(a.ws + WS_BC); const float* DT = (const float*)(a.ws + WS_DT); const float* LA = (const float*)(a.ws + WS_LA);
    bf16* YS = (bf16*)a.out + (size_t)2 * MX * RW;
    LAS float* laS = (LAS float*)(lds + L_F); LAS float* dtS = laS + 128; LAS float* cumS = laS + 256;
    for (int u = blockIdx.x; u < 256; u += gridDim.x) {
        const int g = u >> 5, h = u & 31, dir = g >> 2, b = g & 3, gi = h >> 2;
        f32x16 st;
#pragma unroll
        for (int q = 0; q < 16; ++q) st[q] = 0.f;
        __syncthreads();
        for (int i = tid; i < 64 * SLD / 4; i += 512) ((LAS unsigned*)(lds + L_S))[i] = 0u;
        uint4 pB[4], pC[4], pX[2]; float pla = 0.f, pdt = 0.f;
        const int bl0 = 4 * (tid >> 4), bpc = tid & 15, xl0 = 2 * (tid >> 3), xpc = tid & 7;
#define SSD_FETCH2(cc) do { const int n0_ = (cc) * 128; const bool lat_ = (cc) >= CTXL / 128; \
            _Pragma("unroll") for (int k_ = 0; k_ < 4; ++k_) { const size_t m_ = (size_t)scan_row(n0_ + bl0 + k_, dir, b); \
                pB[k_] = ld16(BC + m_ * RW + gi * 128 + bpc * 8); if (lat_) pC[k_] = ld16(BC + m_ * RW + 1024 + gi * 128 + bpc * 8); } \
            _Pragma("unroll") for (int k_ = 0; k_ < 2; ++k_) { const size_t m_ = (size_t)scan_row(n0_ + xl0 + k_, dir, b); pX[k_] = ld16(XS + m_ * RW + h * 64 + xpc * 8); } \
            if (tid < 128) { const size_t m_ = (size_t)scan_row(n0_ + tid, dir, b); pla = LA[m_ * 64 + dir * 32 + h]; pdt = DT[m_ * 64 + dir * 32 + h]; } } while (0)
        SSD_FETCH2(0);
        for (int c = 0; c < NSTEP / 128; ++c) {
            const int n0 = c * 128; const bool lat = c >= CTXL / 128;
#pragma unroll
            for (int k = 0; k < 4; ++k) { lds_st16(lds + L_B + (bl0 + k) * SLD + bpc * 16, pB[k]); if (lat) lds_st16(lds + L_C + (bl0 + k) * SLD + bpc * 16, pC[k]); }
            { const unsigned w0[4] = {pX[0].x, pX[0].y, pX[0].z, pX[0].w}, w1[4] = {pX[1].x, pX[1].y, pX[1].z, pX[1].w};
#pragma unroll
              for (int e = 0; e < 8; ++e) { const unsigned lo = (e & 1) ? (w0[e >> 1] >> 16) : (w0[e >> 1] & 0xffffu), hi = (e & 1) ? (w1[e >> 1] & 0xffff0000u) : (w1[e >> 1] << 16);
                  *(LAS unsigned*)(lds + L_XT + (xpc * 8 + e) * SLD + xl0 * 2) = lo | hi; } }
            if (tid < 128) { laS[tid] = pla; dtS[tid] = pdt; }
            lds_barrier();
            if (wave == 0) { const float a0 = laS[2 * lane], b0 = laS[2 * lane + 1]; float x = a0 + b0;
#pragma unroll
                for (int d = 1; d < 64; d <<= 1) { const float y = __shfl_up(x, d); if (lane >= d) x += y; }
                cumS[2 * lane + 1] = x; cumS[2 * lane] = x - b0; }
            lds_barrier();
            const float ctot = cumS[127];
            { float wl[4]; float fb[4][8];
#pragma unroll
              for (int k = 0; k < 4; ++k) { wl[k] = dtS[bl0 + k] * __expf(ctot - cumS[bl0 + k]); unpack8(pB[k], fb[k]); }
#pragma unroll
              for (int e = 0; e < 8; ++e) *(LAS u32x2_t*)(lds + L_BT + (bpc * 8 + e) * SLD + bl0 * 2) = (u32x2_t){pk2(fb[0][e] * wl[0], fb[1][e] * wl[1]), pk2(fb[2][e] * wl[2], fb[3][e] * wl[3])}; }
            if (c + 1 < NSTEP / 128) SSD_FETCH2(c + 1);
            f32x16 acc0, acc1;
            const int lt = wave >> 1, st0 = 2 * (wave & 1);
            if (lat) {
#pragma unroll
                for (int q = 0; q < 16; ++q) { acc0[q] = 0.f; acc1[q] = 0.f; }
                if (st0 <= lt) {
#pragma unroll
                    for (int ks = 0; ks < 8; ++ks) { const bf16x8_t cf = lfrag(lds + L_C, lt * 32 + r, ks * 16 + 8 * hh);
                        acc0 = __builtin_amdgcn_mfma_f32_32x32x16_bf16(lfrag(lds + L_B, st0 * 32 + r, ks * 16 + 8 * hh), cf, acc0, 0, 0, 0);
                        if (st0 + 1 <= lt) acc1 = __builtin_amdgcn_mfma_f32_32x32x16_bf16(lfrag(lds + L_B, (st0 + 1) * 32 + r, ks * 16 + 8 * hh), cf, acc1, 0, 0, 0); }
                }
            }
            lds_barrier();
            if (lat) {
                const int l = lt * 32 + r; const float cl = cumS[l];
#pragma unroll
                for (int t = 0; t < 2; ++t) { const int stt = st0 + t;
                    if (stt <= lt) {
#pragma unroll
                        for (int gq = 0; gq < 4; ++gq) { const int s0 = stt * 32 + 8 * gq + 4 * hh; const f32x4 cs = *(const LAS f32x4*)(cumS + s0), ds = *(const LAS f32x4*)(dtS + s0); float o[4];
#pragma unroll
                            for (int e = 0; e < 4; ++e) { const float v = t ? acc1[4 * gq + e] : acc0[4 * gq + e]; o[e] = (s0 + e) <= l ? v * __expf(cl - cs[e]) * ds[e] : 0.f; }
                            *(LAS u32x2_t*)(lds + L_B + l * SLD + s0 * 2) = (u32x2_t){pk2(o[0], o[1]), pk2(o[2], o[3])}; } } }
            }
            lds_barrier();
            if (lat) {
                const int pt = wave & 1;
                f32x16 accd, acco;
#pragma unroll
                for (int q = 0; q < 16; ++q) { accd[q] = 0.f; acco[q] = 0.f; }
                for (int ks = 0; ks < 2 * (lt + 1); ++ks)
                    accd = __builtin_amdgcn_mfma_f32_32x32x16_bf16(lfrag(lds + L_XT, pt * 32 + r, ks * 16 + 8 * hh), lfrag(lds + L_B, lt * 32 + r, ks * 16 + 8 * hh), accd, 0, 0, 0);
#pragma unroll
                for (int ks = 0; ks < 8; ++ks)
                    acco = __builtin_amdgcn_mfma_f32_32x32x16_bf16(lfrag(lds + L_S, pt * 32 + r, ks * 16 + 8 * hh), lfrag(lds + L_C, lt * 32 + r, ks * 16 + 8 * hh), acco, 0, 0, 0);
                const int l = lt * 32 + r; const float el = __expf(cumS[l]);
                bf16* yrow = YS + ((size_t)dir * MX + scan_row(n0 + l, dir, b)) * RW + h * 64 + pt * 32;
#pragma unroll
                for (int gq = 0; gq < 4; ++gq) { float y[4];
#pragma unroll
                    for (int e = 0; e < 4; ++e) y[e] = accd[4 * gq + e] + el * acco[4 * gq + e];
                    *(uint2*)(yrow + 8 * gq + 4 * hh) = make_uint2(pk2(y[0], y[1]), pk2(y[2], y[3])); }
            }
            const int nt = wave >> 1, pt2 = wave & 1;
            { const float dc = __expf(ctot);
#pragma unroll
              for (int q = 0; q < 16; ++q) st[q] *= dc;
#pragma unroll
              for (int ks = 0; ks < 8; ++ks)
                  st = __builtin_amdgcn_mfma_f32_32x32x16_bf16(lfrag(lds + L_BT, nt * 32 + r, ks * 16 + 8 * hh), lfrag(lds + L_XT, pt2 * 32 + r, ks * 16 + 8 * hh), st, 0, 0, 0); }
            lds_barrier();
#pragma unroll
            for (int gq = 0; gq < 4; ++gq) *(LAS u32x2_t*)(lds + L_S + (pt2 * 32 + r) * SLD + (nt * 32 + 8 * gq + 4 * hh) * 2) = (u32x2_t){pk2(st[4 * gq], st[4 * gq + 1]), pk2(st[4 * gq + 2], st[4 * gq + 3])};
            lds_barrier();
        }
    }
}

constexpr int CR_T = 32, CR_PJ = 144, CR_PS = 80, CR_PF = 272;
constexpr int CR_AR = 0, CR_BK = CR_AR + 64 * CR_PJ, CR_BHT = CR_BK + 64 * CR_PJ, CR_KHT = CR_BHT + 64 * CR_PS, CR_VT = CR_KHT + 64 * CR_PS, CR_SB = CR_VT + 64 * CR_PS,
              CR_NAK = CR_SB + 2 * 64 * CR_PJ, CR_PBR = CR_NAK + 32 * CR_PS, CR_PKR = CR_PBR + 32 * CR_PS, CR_NABF = CR_PKR + 32 * CR_PS, CR_RT = CR_NABF + 32 * CR_PJ,
              CR_SA = CR_RT + 32 * CR_PF, CR_GT = CR_SA + 64 * CR_PS, CR_CP = CR_GT + 256, CR_OB = CR_CP + 16 * 256, CR_END = CR_OB + 32 * 128;
static_assert(CR_END <= 131072, "chunked rwkv lds map");
__device__ __forceinline__ f32x16 mfma32(const bf16x8_t& a, const bf16x8_t& b, const f32x16& c) { return __builtin_amdgcn_mfma_f32_32x32x16_bf16(a, b, c, 0, 0, 0); }
__device__ __forceinline__ bf16x8_t cfrag(const LAS unsigned char* img, int pitch, int row, int k) { return *(const LAS bf16x8_t*)(img + row * pitch + k * 2); }
struct CRaw { unsigned r[2], k[2], kk[2], w[2], al[2], v[2]; };
__device__ __forceinline__ void cr_load(CRaw& x, const bf16* R, const bf16* K, const bf16* V, const bf16* KK, const bf16* LR, int n0, int dir, int b, int chn) {
#pragma unroll
    for (int u = 0; u < 2; ++u) { const size_t m = (size_t)scan_row(n0 + u, dir, b);
        x.r[u] = *(const unsigned*)(R + m * RW + chn); x.k[u] = *(const unsigned*)(K + m * RW + chn); x.kk[u] = *(const unsigned*)(KK + m * RW + chn); x.v[u] = *(const unsigned*)(V + m * RW + chn);
        x.w[u] = *(const unsigned*)(LR + m * NLR + dir * 2048 + chn); x.al[u] = *(const unsigned*)(LR + m * NLR + 4096 + dir * 2048 + chn); }
}
__device__ __forceinline__ void ph_rwkv_chunked(const Args& a, LAS unsigned char* lds) {
    const int tid = TID, lane = LANE, wave = WAVE, r = lane & 31, hh = lane >> 5;
    const bf16* R = (const bf16*)(a.ws + WS_R); const bf16* K = (const bf16*)(a.ws + WS_K); const bf16* V = (const bf16*)(a.ws + WS_V); const bf16* KK = (const bf16*)(a.ws + WS_KK);
    const bf16* LR = (const bf16*)(a.ws + WS_LR); bf16* OR = (bf16*)a.out;
    constexpr int NCH = NSTEP / CR_T;
    LAS float* GT = (LAS float*)(lds + CR_GT); LAS float* CP = (LAS float*)(lds + CR_CP);
    for (int u0 = blockIdx.x; u0 < 256; u0 += gridDim.x) {
        const int g = u0 >> 5, h = u0 & 31, dir = g >> 2, b = g & 3;
        const int jp = lane & 31, sh2 = lane >> 5, chn = h * 64 + 2 * jp, tq = 2 * wave + sh2;
        const float ka0 = a.in[I_KA][chn], ka1 = a.in[I_KA][chn + 1];
        f32x16 st;
#pragma unroll
        for (int q = 0; q < 16; ++q) st[q] = 0.f;
        __syncthreads();
        for (int i = tid; i < 64 * CR_PJ / 4; i += 512) ((LAS unsigned*)(lds + CR_SB))[i] = 0u;
        CRaw raw; cr_load(raw, R, K, V, KK, LR, 2 * tq, dir, b, chn);
        for (int c = 0; c < NCH; ++c) {
            const bool lat = c >= CTXL / CR_T;
            const LAS unsigned char* SBc = lds + CR_SB + (c & 1) * 64 * CR_PJ; LAS unsigned char* SBn = lds + CR_SB + ((c + 1) & 1) * 64 * CR_PJ;
            float rv[2][2], kd[2][2], bv[2][2], av[2][2], vv[2][2], cl[2][2], cx[2][2];
            { float run0 = 1.f, run1 = 1.f;
#pragma unroll
              for (int u = 0; u < 2; ++u) {
                  const float kk0 = bflo(raw.kk[u]), kk1 = bfhi(raw.kk[u]), al0 = bflo(raw.al[u]), al1 = bfhi(raw.al[u]);
                  rv[u][0] = bflo(raw.r[u]); rv[u][1] = bfhi(raw.r[u]); vv[u][0] = bflo(raw.v[u]); vv[u][1] = bfhi(raw.v[u]);
                  av[u][0] = -kk0; av[u][1] = -kk1; bv[u][0] = kk0 * al0; bv[u][1] = kk1 * al1;
                  kd[u][0] = bflo(raw.k[u]) * (1.f + (al0 - 1.f) * ka0); kd[u][1] = bfhi(raw.k[u]) * (1.f + (al1 - 1.f) * ka1);
                  cx[u][0] = run0; cx[u][1] = run1; run0 *= 1.f - bflo(raw.w[u]); run1 *= 1.f - bfhi(raw.w[u]); cl[u][0] = run0; cl[u][1] = run1; }
              *(LAS f32x2_t*)(lds + CR_CP + (tq * 64 + 2 * jp) * 4) = (f32x2_t){run0, run1}; }
            if (c + 1 < NCH) cr_load(raw, R, K, V, KK, LR, (c + 1) * CR_T + 2 * tq, dir, b, chn);
            lds_barrier();
            { float pre0 = 1.f, pre1 = 1.f, tot0 = 1.f, tot1 = 1.f;
#pragma unroll
              for (int q = 0; q < 16; ++q) { const f32x2_t x = *(const LAS f32x2_t*)(lds + CR_CP + (q * 64 + 2 * jp) * 4); tot0 *= x[0]; tot1 *= x[1]; if (q < tq) { pre0 *= x[0]; pre1 *= x[1]; } }
              if (tq == 0) *(LAS f32x2_t*)(lds + CR_GT + 2 * jp * 4) = (f32x2_t){tot0, tot1};
              unsigned bh[2], kh[2], vt[2];
              float tb[2][2], tk[2][2];
#pragma unroll
              for (int u = 0; u < 2; ++u) { const int t = 2 * tq + u;
                  const float g0 = pre0 * cl[u][0], g1 = pre1 * cl[u][1], gp0 = pre0 * cx[u][0], gp1 = pre1 * cx[u][1];
                  const float i0 = __builtin_amdgcn_rcpf(g0), i1 = __builtin_amdgcn_rcpf(g1);
                  *(LAS unsigned*)(lds + CR_AR + t * CR_PJ + jp * 4) = pg8::cvt_pk_bf16(av[u][0] * gp0, av[u][1] * gp1);
                  *(LAS unsigned*)(lds + CR_AR + (32 + t) * CR_PJ + jp * 4) = pg8::cvt_pk_bf16(rv[u][0] * g0, rv[u][1] * g1);
                  *(LAS unsigned*)(lds + CR_BK + t * CR_PJ + jp * 4) = pg8::cvt_pk_bf16(bv[u][0] * i0, bv[u][1] * i1);
                  *(LAS unsigned*)(lds + CR_BK + (32 + t) * CR_PJ + jp * 4) = pg8::cvt_pk_bf16(kd[u][0] * i0, kd[u][1] * i1);
                  tb[u][0] = bv[u][0] * (tot0 * i0); tb[u][1] = bv[u][1] * (tot1 * i1); tk[u][0] = kd[u][0] * (tot0 * i0); tk[u][1] = kd[u][1] * (tot1 * i1); }
#pragma unroll
              for (int ch = 0; ch < 2; ++ch) { bh[ch] = pg8::cvt_pk_bf16(tb[0][ch], tb[1][ch]); kh[ch] = pg8::cvt_pk_bf16(tk[0][ch], tk[1][ch]); vt[ch] = pg8::cvt_pk_bf16(vv[0][ch], vv[1][ch]);
                  *(LAS unsigned*)(lds + CR_BHT + (2 * jp + ch) * CR_PS + tq * 4) = bh[ch]; *(LAS unsigned*)(lds + CR_KHT + (2 * jp + ch) * CR_PS + tq * 4) = kh[ch]; *(LAS unsigned*)(lds + CR_VT + (2 * jp + ch) * CR_PS + tq * 4) = vt[ch]; } }
            lds_barrier();
            f32x16 acc;
#pragma unroll
            for (int q = 0; q < 16; ++q) acc[q] = 0.f;
            if (wave < 4) {
                const int rb = wave >> 1, cb = wave & 1;
#pragma unroll
                for (int ks = 0; ks < 4; ++ks) acc = mfma32(cfrag(lds + CR_BK, CR_PJ, 32 * rb + r, 16 * ks + 8 * hh), cfrag(lds + CR_AR, CR_PJ, 32 * cb + r, 16 * ks + 8 * hh), acc);
#pragma unroll
                for (int gq = 0; gq < 4; ++gq) { float o[4];
#pragma unroll
                    for (int e = 0; e < 4; ++e) { const int sidx = 8 * gq + 4 * hh + e; const bool keep = cb ? (sidx <= r) : (sidx < r); o[e] = keep ? acc[4 * gq + e] : 0.f; }
                    if (wave == 0) {
#pragma unroll
                        for (int e = 0; e < 4; ++e) *(LAS float*)(lds + CR_NABF + r * CR_PJ + (e * 8 + 2 * gq + hh) * 4) = o[e]; }
                    else { LAS unsigned char* dst = lds + (wave == 1 ? CR_PBR : wave == 2 ? CR_NAK : CR_PKR) + r * CR_PS + (8 * gq + 4 * hh) * 2;
                        typedef unsigned u32x2_t __attribute__((ext_vector_type(2))); *(LAS u32x2_t*)dst = (u32x2_t){pk2(o[0], o[1]), pk2(o[2], o[3])}; } }
            } else if (wave < 6 || lat) {
                const int it = wave & 1, cb = wave >> 1 & 1 ? 32 : 0;
#pragma unroll
                for (int ks = 0; ks < 4; ++ks) acc = mfma32(cfrag(SBc, CR_PJ, 32 * it + r, 16 * ks + 8 * hh), cfrag(lds + CR_AR, CR_PJ, cb + r, 16 * ks + 8 * hh), acc);
            }
            lds_barrier();
            if (wave >= 4 && (wave < 6 || lat)) {
                const int it = wave & 1; const LAS unsigned char* NT = lds + (wave < 6 ? CR_NAK : CR_PKR);
#pragma unroll
                for (int ks = 0; ks < 2; ++ks) acc = mfma32(cfrag(lds + CR_VT, CR_PS, 32 * it + r, 16 * ks + 8 * hh), cfrag(NT, CR_PS, r, 16 * ks + 8 * hh), acc);
                if (wave < 6) {
#pragma unroll
                    for (int gq = 0; gq < 4; ++gq) *(LAS f32x4*)(lds + CR_RT + r * CR_PF + (32 * it + 8 * gq + 4 * hh) * 4) = (f32x4){acc[4 * gq], acc[4 * gq + 1], acc[4 * gq + 2], acc[4 * gq + 3]};
                }
            }
            lds_barrier();
            if (wave < 4) {
                const int q = lane & 3, irow = 16 * wave + (lane >> 2);
                const LAS unsigned char* nrow = lds + CR_NABF + q * 32; const LAS unsigned char* rcol = lds + CR_RT + irow * 4;
                float mysa[8];
#pragma unroll
                for (int u = 0; u < 8; ++u) mysa[u] = 0.f;
                f32x4 NA[34], NB[34]; float RH[34];
#pragma unroll
                for (int t = 0; t < 2; ++t) { NA[t] = *(const LAS f32x4*)(nrow + t * CR_PJ); NB[t] = NA[t]; RH[t] = *(const LAS float*)(rcol + t * CR_PF); }
#pragma unroll
                for (int t = 0; t < 32; ++t) {
                    if (t + 2 < 32) { NA[t + 2] = *(const LAS f32x4*)(nrow + (t + 2) * CR_PJ); if (t + 2 > 16) NB[t + 2] = *(const LAS f32x4*)(nrow + (t + 2) * CR_PJ + 16); RH[t + 2] = *(const LAS float*)(rcol + (t + 2) * CR_PF); }
                    asm volatile("" ::: "memory");
                    float p0 = 0.f, p1 = 0.f;
#pragma unroll
                    for (int u = 0; u < 4; ++u) if (u < (t + 3) / 4) { if (u & 1) p1 += mysa[u] * NA[t][u]; else p0 += mysa[u] * NA[t][u]; }
#pragma unroll
                    for (int u = 4; u < 8; ++u) if (u < (t + 3) / 4) { if (u & 1) p1 += mysa[u] * NB[t][u - 4]; else p0 += mysa[u] * NB[t][u - 4]; }
                    float part = p0 + p1;
                    part += dppf<0xB1>(part); part += dppf<0x4E>(part);
                    const float x = RH[t] + part;
                    mysa[t >> 2] = (q == (t & 3)) ? x : mysa[t >> 2];
                    asm volatile("" : "+v"(mysa[t >> 2]));
                }
#pragma unroll
                for (int u = 0; u < 8; ++u) *(LAS bf16*)(lds + CR_SA + irow * CR_PS + (4 * u + q) * 2) = (bf16)f2bf(mysa[u]);
            }
            lds_barrier();
            if (wave < 4) {
                const int jt = wave >> 1, it = wave & 1;
#pragma unroll
                for (int gq = 0; gq < 4; ++gq) { const f32x4 gv = *(LAS f32x4*)(lds + CR_GT + (32 * jt + 8 * gq + 4 * hh) * 4);
#pragma unroll
                    for (int e = 0; e < 4; ++e) st[4 * gq + e] *= gv[e]; }
#pragma unroll
                for (int ks = 0; ks < 2; ++ks) { st = mfma32(cfrag(lds + CR_BHT, CR_PS, 32 * jt + r, 16 * ks + 8 * hh), cfrag(lds + CR_SA, CR_PS, 32 * it + r, 16 * ks + 8 * hh), st);
                    st = mfma32(cfrag(lds + CR_KHT, CR_PS, 32 * jt + r, 16 * ks + 8 * hh), cfrag(lds + CR_VT, CR_PS, 32 * it + r, 16 * ks + 8 * hh), st); }
#pragma unroll
                for (int gq = 0; gq < 4; ++gq) { typedef unsigned u32x2_t __attribute__((ext_vector_type(2)));
                    *(LAS u32x2_t*)(SBn + (32 * it + r) * CR_PJ + (32 * jt + 8 * gq + 4 * hh) * 2) = (u32x2_t){pk2(st[4 * gq], st[4 * gq + 1]), pk2(st[4 * gq + 2], st[4 * gq + 3])}; }
            } else if (wave >= 6 && lat) {
                const int it = wave & 1;
#pragma unroll
                for (int ks = 0; ks < 2; ++ks) acc = mfma32(cfrag(lds + CR_SA, CR_PS, 32 * it + r, 16 * ks + 8 * hh), cfrag(lds + CR_PBR, CR_PS, r, 16 * ks + 8 * hh), acc);
#pragma unroll
                for (int gq = 0; gq < 4; ++gq) { typedef unsigned u32x2_t __attribute__((ext_vector_type(2)));
                    *(LAS u32x2_t*)(lds + CR_OB + r * 128 + (32 * it + 8 * gq + 4 * hh) * 2) = (u32x2_t){pk2(acc[4 * gq], acc[4 * gq + 1]), pk2(acc[4 * gq + 2], acc[4 * gq + 3])}; }
            }
            lds_barrier();
            if (lat) { const int ss = tid >> 4, cgp = tid & 15; typedef unsigned u32x2_t __attribute__((ext_vector_type(2)));
                const u32x2_t ov = *(const LAS u32x2_t*)(lds + CR_OB + ss * 128 + cgp * 8);
                *(uint2*)(OR + ((size_t)dir * MX + scan_row(c * CR_T + ss, dir, b)) * RW + h * 64 + cgp * 4) = make_uint2(ov[0], ov[1]); }
        }
    }
}

__device__ __forceinline__ void ph_finish(const Args& a) {
    const int lane = LANE;
    const bf16* R = (const bf16*)(a.ws + WS_R); const bf16* K = (const bf16*)(a.ws + WS_K); const bf16* V = (const bf16*)(a.ws + WS_V);
    const bf16* LR = (const bf16*)(a.ws + WS_LR); const bf16* XS = (const bf16*)(a.ws + WS_XS); const bf16* Z = (const bf16*)(a.ws + WS_Z);
    const bf16* OR = (const bf16*)a.out; const bf16* YS = (const bf16*)a.out + (size_t)2 * MX * RW;
    bf16* A2 = (bf16*)(a.ws + WS_A2);
    for (int m = GW; m < MX; m += NGW) {
#pragma unroll
        for (int i = 0; i < 4; ++i) {
            const int c0 = (lane + 64 * i) * 8;
            float of[8], ob[8], o[8], res[8];
#if MK_SKIP_RWKV
#pragma unroll
            for (int e = 0; e < 8; ++e) res[e] = 0.f;
#else
            unpack8(ld16(OR + (size_t)m * RW + c0), of); unpack8(ld16(OR + ((size_t)MX + m) * RW + c0), ob);
            float sm = 0.f;
#pragma unroll
            for (int e = 0; e < 8; ++e) { o[e] = of[e] + ob[e]; sm += o[e]; }
            sm = sum8(sm);
            const float mean = sm * (1.f / 64.f); float sq = 0.f;
#pragma unroll
            for (int e = 0; e < 8; ++e) { o[e] -= mean; sq += o[e] * o[e]; }
            sq = sum8(sq);
            const float rstd = rsqrtf(sq * (1.f / 64.f) + GN_EPS);
            float lw[8], lb[8], r[8], k[8], v[8], a0[8], a1[8], ka[8], rk[8], gg[8];
            ldf8(a.in[I_LNW] + c0, lw); ldf8(a.in[I_LNB] + c0, lb); ldf8(a.in[I_KA] + c0, ka); ldf8(a.in[I_RK] + c0, rk);
            unpack8(ld16(R + (size_t)m * RW + c0), r); unpack8(ld16(K + (size_t)m * RW + c0), k); unpack8(ld16(V + (size_t)m * RW + c0), v);
            unpack8(ld16(LR + (size_t)m * NLR + 4096 + c0), a0); unpack8(ld16(LR + (size_t)m * NLR + 6144 + c0), a1); unpack8(ld16(LR + (size_t)m * NLR + 8192 + c0), gg);
            float bs = 0.f;
#pragma unroll
            for (int e = 0; e < 8; ++e) { const float kd = k[e] * (2.f + (a0[e] + a1[e] - 2.f) * ka[e]); bs += r[e] * kd * rk[e]; }
            bs = sum8(bs);
#pragma unroll
            for (int e = 0; e < 8; ++e) res[e] = (o[e] * rstd * lw[e] + lb[e] + bs * v[e]) * gg[e];
#endif
            st16(A2 + (size_t)m * DM + c0, pack8(res));
        }
#pragma unroll
        for (int i = 0; i < 4; ++i) {
            const int c0 = (lane + 64 * i) * 8;
            float yf[8], yb[8], xs[8], z[8], nw[8], y[8];
#if MK_SKIP_SSD
#pragma unroll
            for (int e = 0; e < 8; ++e) y[e] = 0.f;
#else
            unpack8(ld16(YS + (size_t)m * RW + c0), yf); unpack8(ld16(YS + ((size_t)MX + m) * RW + c0), yb);
            unpack8(ld16(XS + (size_t)m * RW + c0), xs); unpack8(ld16(Z + (size_t)m * RW + c0), z); ldf8(a.in[I_NORMW] + c0, nw);
            const float dsk = a.in[I_SSMD][c0 >> 6]; float ss = 0.f;
#pragma unroll
            for (int e = 0; e < 8; ++e) { y[e] = (yf[e] + yb[e] + dsk * xs[e]) * (z[e] / (1.f + __expf(-z[e]))); ss += y[e] * y[e]; }
            ss = sum32(ss);
            const float rstd = rsqrtf(ss * (1.f / 256.f) + RMS_EPS);
#pragma unroll
            for (int e = 0; e < 8; ++e) y[e] = y[e] * rstd * nw[e];
#endif
            st16(A2 + (size_t)m * DM + 2048 + c0, pack8(y));
        }
    }
}

__device__ __forceinline__ float enc_key(float v, int idx) { return __uint_as_float((__float_as_uint(v) & 0xffffff00u) | (unsigned)idx); }
typedef float f32x32_t __attribute__((ext_vector_type(32)));
typedef unsigned u32x6_t __attribute__((ext_vector_type(6)));
typedef float f32x2 __attribute__((ext_vector_type(2)));
struct Fp6Row { uint4 q0, q1, q2; float rs; };
template <bool FP4> __device__ __forceinline__ Fp6Row ld_row(const unsigned char* tab, const float* rsc, int e, int l16, int lane) {
    Fp6Row r; r.rs = FP4 ? 1.f : rsc[e];
    if (FP4) { const unsigned char* p = tab + (size_t)e * 2304; r.q0 = *(const uint4*)(p + l16); r.q1 = *(const uint4*)(p + 1024 + l16); r.q2 = make_uint4(*(const unsigned*)(p + 2048 + 4 * lane), 0u, 0u, 0u); }
    else { const unsigned char* p = tab + (size_t)e * 3072 + l16; r.q0 = *(const uint4*)p; r.q1 = *(const uint4*)(p + 1024); r.q2 = *(const uint4*)(p + 2048); }
    return r;
}
__device__ __forceinline__ f32x32_t fp6_unpack(const Fp6Row& r, int p, float one) {
    u32x6_t s; if (p == 0) { s[0] = r.q0.x; s[1] = r.q0.y; s[2] = r.q0.z; s[3] = r.q0.w; s[4] = r.q1.x; s[5] = r.q1.y; } else { s[0] = r.q1.z; s[1] = r.q1.w; s[2] = r.q2.x; s[3] = r.q2.y; s[4] = r.q2.z; s[5] = r.q2.w; }
    return __builtin_amdgcn_cvt_scalef32_pk32_f32_fp6(s, one);
}
template <bool FP4> __device__ __forceinline__ f32x32_t row_unpack(const Fp6Row& r, int p, float one, float& sc) {
    if (!FP4) { sc = 1.f; return fp6_unpack(r, p, one); }
    const uint4 q = p ? r.q1 : r.q0; const unsigned w[4] = {q.x, q.y, q.z, q.w}; f32x32_t f;
#pragma unroll
    for (int d = 0; d < 4; ++d)
        { const f32x2 t0 = __builtin_amdgcn_cvt_scalef32_pk_f32_fp4(w[d], one, 0), t1 = __builtin_amdgcn_cvt_scalef32_pk_f32_fp4(w[d], one, 1), t2 = __builtin_amdgcn_cvt_scalef32_pk_f32_fp4(w[d], one, 2), t3 = __builtin_amdgcn_cvt_scalef32_pk_f32_fp4(w[d], one, 3);
          f[8 * d] = t0.x; f[8 * d + 1] = t0.y; f[8 * d + 2] = t1.x; f[8 * d + 3] = t1.y; f[8 * d + 4] = t2.x; f[8 * d + 5] = t2.y; f[8 * d + 6] = t3.x; f[8 * d + 7] = t3.y; }
    sc = p ? bfhi(r.q2.x) : bflo(r.q2.x);
    return f;
}
__device__ __forceinline__ void fp4_unpack8(unsigned w, float one, float (&f)[8]) {
    const f32x2 t0 = __builtin_amdgcn_cvt_scalef32_pk_f32_fp4(w, one, 0), t1 = __builtin_amdgcn_cvt_scalef32_pk_f32_fp4(w, one, 1), t2 = __builtin_amdgcn_cvt_scalef32_pk_f32_fp4(w, one, 2), t3 = __builtin_amdgcn_cvt_scalef32_pk_f32_fp4(w, one, 3);
    f[0] = t0.x; f[1] = t0.y; f[2] = t1.x; f[3] = t1.y; f[4] = t2.x; f[5] = t2.y; f[6] = t3.x; f[7] = t3.y;
}
#define PIN4(a) asm volatile("" : "+v"((a)[0]), "+v"((a)[1]), "+v"((a)[2]), "+v"((a)[3]))
__device__ __forceinline__ void ph_peer(const Args& a, float* outp) {
    const int lane = LANE; constexpr bool UF4 = MK_PEER_FP4 >= 2, VF4 = MK_PEER_FP4 >= 1; constexpr int URING = UF4 ? 3 : 2, VRING = VF4 ? 3 : 2;
    const float* mod = (const float*)(a.ws + WS_MOD); const float* S = (const float*)(a.ws + WS_S);
    const unsigned char* U8 = (const unsigned char*)(a.ws + WS_U8); const unsigned char* V8 = (const unsigned char*)(a.ws + WS_V8);
    const float* USC = (const float*)(a.ws + WS_USC); const float* VSC = (const float*)(a.ws + WS_VSC);
    for (int m = GW; m < MX; m += NGW) {
        const int bb = m / SEQ;
        float* hrow = a.out + (size_t)m * DM;
        int l4 = lane * 4; asm volatile("" : "+v"(l4));
        float acc[16][4];
#if MK_SKIP_PEER
#pragma unroll
        for (int j = 0; j < 16; ++j)
#pragma unroll
            for (int e = 0; e < 4; ++e) acc[j][e] = 0.f;
#else
        float xn[16][4];
        { float ss = 0.f;
#pragma unroll
          for (int j = 0; j < 16; ++j) { const float4 h4 = *(const float4*)(hrow + 256 * j + l4); xn[j][0] = h4.x; xn[j][1] = h4.y; xn[j][2] = h4.z; xn[j][3] = h4.w; ss += (h4.x * h4.x + h4.y * h4.y) + (h4.z * h4.z + h4.w * h4.w); }
          const float rstd = rsqrtf(wave_sum(ss) * (1.f / DM) + RMS_EPS);
          const float* sh2 = mod + (size_t)bb * NMOD + 3 * DM; const float* sc2 = mod + (size_t)bb * NMOD + 4 * DM; const float* g2 = a.in[I_N2G];
#pragma unroll
          for (int j = 0; j < 16; ++j) { const int c = 256 * j + l4; const float4 gg = *(const float4*)(g2 + c), s0 = *(const float4*)(sh2 + c), s1 = *(const float4*)(sc2 + c);
              xn[j][0] = xn[j][0] * rstd * gg.x * (1.f + s1.x) + s0.x; xn[j][1] = xn[j][1] * rstd * gg.y * (1.f + s1.y) + s0.y; xn[j][2] = xn[j][2] * rstd * gg.z * (1.f + s1.z) + s0.z; xn[j][3] = xn[j][3] * rstd * gg.w * (1.f + s1.w) + s0.w;
              if ((j & 3) == 3) { PIN4(xn[j - 3]); PIN4(xn[j - 2]); PIN4(xn[j - 1]); PIN4(xn[j]); asm volatile("" ::: "memory"); } } }
        int eid0 = 0, eid1 = 0; float gt0 = 0.f, gt1 = 0.f;
        const float NEG = -3.0e38f;
        float c1a[8], c1b[8], c2a[8], c2b[8], t1[8], t2[8];
#pragma unroll
        for (int hd = 0; hd < 8; ++hd) { const float* sr = S + (size_t)m * 2048 + hd * 256 + lane;
            c1a[hd] = enc_key(sr[0], lane); c1b[hd] = enc_key(sr[64], 64 + lane); c2a[hd] = enc_key(sr[128], lane); c2b[hd] = enc_key(sr[192], 64 + lane); t1[hd] = NEG; t2[hd] = NEG; }
#pragma unroll 1
        for (int k = 0; k < 16; ++k) {
#pragma unroll
            for (int hd = 0; hd < 8; ++hd) {
                const float m1 = wave_max(fmaxf(c1a[hd], c1b[hd])), m2 = wave_max(fmaxf(c2a[hd], c2b[hd]));
                if (c1a[hd] == m1) c1a[hd] = NEG; if (c1b[hd] == m1) c1b[hd] = NEG; if (c2a[hd] == m2) c2a[hd] = NEG; if (c2b[hd] == m2) c2b[hd] = NEG;
                if (lane == k) { t1[hd] = m1; t2[hd] = m2; }
            }
        }
        float cd[8][4], best[8]; int i1[8], i2[8], ex[8];
#pragma unroll
        for (int hd = 0; hd < 8; ++hd) {
            const float v1 = __uint_as_float(__float_as_uint(t1[hd]) & 0xffffff00u), v2 = __uint_as_float(__float_as_uint(t2[hd]) & 0xffffff00u);
            i1[hd] = (int)(__float_as_uint(t1[hd]) & 0xffu); i2[hd] = (int)(__float_as_uint(t2[hd]) & 0xffu);
#pragma unroll
            for (int e = 0; e < 4; ++e) { const float va = __shfl(v1, (lane >> 4) + 4 * e), vb = __shfl(v2, lane & 15); cd[hd][e] = enc_key(va + vb, lane + 64 * e); }
            best[hd] = NEG; ex[hd] = 0;
        }
#pragma unroll 1
        for (int k = 0; k < 16; ++k) {
#pragma unroll
            for (int hd = 0; hd < 8; ++hd) {
                const float mx = wave_max(fmaxf(fmaxf(cd[hd][0], cd[hd][1]), fmaxf(cd[hd][2], cd[hd][3])));
#pragma unroll
                for (int e = 0; e < 4; ++e) if (cd[hd][e] == mx) cd[hd][e] = NEG;
                const int cidx = (int)(__float_as_uint(mx) & 0xffu);
                const int ea = __shfl(i1[hd], cidx >> 4), eb = __shfl(i2[hd], cidx & 15);
                if (lane == k) { best[hd] = __uint_as_float(__float_as_uint(mx) & 0xffffff00u); ex[hd] = ea * 128 + eb; }
            }
        }
#pragma unroll
        for (int hd = 0; hd < 8; ++hd) {
            const float bmax = __shfl(best[hd], 0);
            const float pe = lane < 16 ? __expf(best[hd] - bmax) : 0.f;
            const float gate = pe / wave_sum(pe);
            const float gsh = __shfl(gate, lane & 15); const int esh = __shfl(ex[hd], lane & 15);
            if ((lane >> 4) == (hd & 3)) { if (hd < 4) { gt0 = gsh; eid0 = esh; } else { gt1 = gsh; eid1 = esh; } }
        }
        const int l48 = lane * 16;
        float cf0 = 0.f, cf1 = 0.f;
#define PEER_EID(pp) __builtin_amdgcn_readlane((pp) < 64 ? eid0 : eid1, (pp) & 63)
#define PEER_FETCH(buf, pbase, TAB, F4) do { _Pragma("unroll") for (int q2 = 0; q2 < 4; ++q2) { const int e_ = PEER_EID((pbase) + q2); buf[q2] = ld_row<F4>(TAB, (TAB) == U8 ? USC : VSC, e_, l48, lane); } } while (0)
        {
            Fp6Row r0[4], r1[4], r2[4];
            PEER_FETCH(r0, 0, U8, UF4); if (URING == 3) PEER_FETCH(r1, 4, U8, UF4);
#pragma unroll 1
            for (int p0 = 0; p0 < 128; p0 += 4 * URING) {
#pragma unroll
                for (int gsel = 0; gsel < URING; ++gsel) {
                    const int pb = p0 + 4 * gsel;
                    if (pb < 128) {
                        asm volatile("" ::: "memory");
                        if (URING == 3) { if (pb + 8 < 128) { if (gsel == 0) PEER_FETCH(r2, pb + 8, U8, UF4); else if (gsel == 1) PEER_FETCH(r0, pb + 8, U8, UF4); else PEER_FETCH(r1, pb + 8, U8, UF4); } }
                        else { if (pb + 4 < 128) { if (gsel == 0) PEER_FETCH(r1, pb + 4, U8, UF4); else PEER_FETCH(r0, pb + 4, U8, UF4); } }
                        float d[4];
#pragma unroll
                        for (int q = 0; q < 4; ++q) {
                            float dd = 0.f;
#pragma unroll
                            for (int p = 0; p < 2; ++p) { const Fp6Row& rr = gsel == 0 ? r0[q] : gsel == 1 ? r1[q] : r2[q];
                                if (UF4) { const uint4 qq = p ? rr.q1 : rr.q0; const unsigned wq[4] = {qq.x, qq.y, qq.z, qq.w}; float dp = 0.f;
#pragma unroll
                                    for (int dw = 0; dw < 4; ++dw) { float one = 1.0f; asm volatile("" : "+v"(one)); float f8[8]; fp4_unpack8(wq[dw], one, f8);
#pragma unroll
                                        for (int t = 0; t < 8; ++t) dp += xn[8 * p + 2 * dw + (t >> 2)][t & 3] * f8[t];
                                        asm volatile("" : "+v"(dp)); }
                                    dd += dp * (p ? bfhi(rr.q2.x) : bflo(rr.q2.x));
                                } else { float one = 1.0f; asm volatile("" : "+v"(one)); float bsc; const f32x32_t f = row_unpack<UF4>(rr, p, one, bsc);
                                    float dp = 0.f;
#pragma unroll
                                    for (int t = 0; t < 32; ++t) dp += xn[8 * p + (t >> 2)][t & 3] * f[t];
                                    dd += dp * bsc; }
                                asm volatile("" : "+v"(dd)); }
                            d[q] = dd;
                        }
#pragma unroll
                        for (int q = 0; q < 4; ++q) {
                            const int p = pb + q;
                            const float dot = wave_sum(d[q]) * (gsel == 0 ? r0[q].rs : gsel == 1 ? r1[q].rs : r2[q].rs);
                            const float act = 0.5f * dot * (1.f + erff(dot * 0.70710678f));
                            if (lane == (p & 63)) { if (pb < 64) cf0 = gt0 * act; else cf1 = gt1 * act; }
                        }
                    }
                }
            }
        }
#pragma unroll
        for (int j = 0; j < 16; ++j)
#pragma unroll
            for (int e = 0; e < 4; ++e) acc[j][e] = 0.f;
        {
            Fp6Row r0[4], r1[4], r2[4];
            PEER_FETCH(r0, 0, V8, VF4); if (VRING == 3) PEER_FETCH(r1, 4, V8, VF4);
#pragma unroll 1
            for (int p0 = 0; p0 < 128; p0 += 4 * VRING) {
#pragma unroll
                for (int gsel = 0; gsel < VRING; ++gsel) {
                    const int pb = p0 + 4 * gsel;
                    if (pb < 128) {
                        asm volatile("" ::: "memory");
                        if (VRING == 3) { if (pb + 8 < 128) { if (gsel == 0) PEER_FETCH(r2, pb + 8, V8, VF4); else if (gsel == 1) PEER_FETCH(r0, pb + 8, V8, VF4); else PEER_FETCH(r1, pb + 8, V8, VF4); } }
                        else { if (pb + 4 < 128) { if (gsel == 0) PEER_FETCH(r1, pb + 4, V8, VF4); else PEER_FETCH(r0, pb + 4, V8, VF4); } }
                        float cfv[4];
#pragma unroll
                        for (int q = 0; q < 4; ++q) cfv[q] = rlane(pb < 64 ? cf0 : cf1, (pb + q) & 63) * (gsel == 0 ? r0[q].rs : gsel == 1 ? r1[q].rs : r2[q].rs);
#pragma unroll
                        for (int q = 0; q < 4; ++q)
#pragma unroll
                            for (int p = 0; p < 2; ++p) { const Fp6Row& rr = gsel == 0 ? r0[q] : gsel == 1 ? r1[q] : r2[q];
                                if (VF4) { const uint4 qq = p ? rr.q1 : rr.q0; const unsigned wq[4] = {qq.x, qq.y, qq.z, qq.w}; const float cfb = cfv[q] * (p ? bfhi(rr.q2.x) : bflo(rr.q2.x));
#pragma unroll
                                    for (int dw = 0; dw < 4; ++dw) { float one = 1.0f; asm volatile("" : "+v"(one)); float f8[8]; fp4_unpack8(wq[dw], one, f8);
#pragma unroll
                                        for (int t = 0; t < 8; ++t) acc[8 * p + 2 * dw + (t >> 2)][t & 3] += cfb * f8[t];
                                        PIN4(acc[8 * p + 2 * dw]); PIN4(acc[8 * p + 2 * dw + 1]); }
                                } else { float one = 1.0f; asm volatile("" : "+v"(one)); float bsc; const f32x32_t f = row_unpack<VF4>(rr, p, one, bsc);
                                    const float cfb = cfv[q] * bsc;
#pragma unroll
                                    for (int t = 0; t < 32; ++t) acc[8 * p + (t >> 2)][t & 3] += cfb * f[t];
#pragma unroll
                                    for (int jj = 0; jj < 8; ++jj) PIN4(acc[8 * p + jj]); } }
                    }
                }
            }
        }
#endif
        { const float* gt2 = mod + (size_t)bb * NMOD + 5 * DM; float ss = 0.f;
          int l4 = lane * 4; asm volatile("" : "+v"(l4));
#pragma unroll
          for (int j = 0; j < 16; ++j) { const int c = 256 * j + l4; const float4 g = *(const float4*)(gt2 + c), h4 = *(const float4*)(hrow + c);
              acc[j][0] = h4.x + g.x * acc[j][0]; acc[j][1] = h4.y + g.y * acc[j][1]; acc[j][2] = h4.z + g.z * acc[j][2]; acc[j][3] = h4.w + g.w * acc[j][3];
              ss += (acc[j][0] * acc[j][0] + acc[j][1] * acc[j][1]) + (acc[j][2] * acc[j][2] + acc[j][3] * acc[j][3]);
              if ((j & 3) == 3) { PIN4(acc[j - 3]); PIN4(acc[j - 2]); PIN4(acc[j - 1]); PIN4(acc[j]); asm volatile("" ::: "memory"); } }
          const float rstd = rsqrtf(wave_sum(ss) * (1.f / DM) + RMS_EPS);
#pragma unroll
          for (int j = 0; j < 16; ++j) { const int c = 256 * j + l4; const float4 fg = *(const float4*)(a.in[I_FG] + c);
              *(float4*)(outp + (size_t)m * DM + c) = make_float4(acc[j][0] * rstd * fg.x, acc[j][1] * rstd * fg.y, acc[j][2] * rstd * fg.z, acc[j][3] * rstd * fg.w);
              if ((j & 3) == 3) asm volatile("" ::: "memory"); } }
    }
}

constexpr int N_PHASES = 13;
__global__ void __launch_bounds__(512, 2) hybrid_fwd(Args args) {
    extern __shared__ __attribute__((aligned(16))) unsigned char lds_raw[];
    LAS unsigned char* lds = (LAS unsigned char*)lds_raw;
    volatile LAS unsigned* MISC = (volatile LAS unsigned*)(lds + LDS_MISC);
    for (int u = TID; u < (LDS_BYTES - LDS_CTL) / 4; u += 512) ((LAS unsigned*)(lds + LDS_CTL))[u] = 0u;
    __syncthreads();
    const int lo = args.ph_lo, hi = args.ph_hi;
    XcdBarrier bar; bar.bar = (unsigned*)(args.ws + WS_CTL); bar.x = 0; bar.st = nullptr;
    if (hi - lo > 1) bar = xcd_barrier_post((unsigned*)(args.ws + WS_CTL), MISC + 8);
#define IN(k) (lo <= (k) && (k) < hi && ((MK_PHASE_MASK >> (k)) & 1))
#define SEAM(k) do { if (IN(k) && IN((k) + 1)) xcd_barrier(bar); } while (0)
    const int bid = (int)blockIdx.x, G = (int)gridDim.x;

    if (IN(0)) { ph_mod(args, lds); ph_conv(args, lds); if (MK_REPEAT == 0) { ph_mod(args, lds); ph_conv(args, lds); } }
    SEAM(0);
    if (IN(1)) { ph_norm1(args); if (MK_REPEAT == 1) ph_norm1(args); }
    SEAM(1);
    if (IN(2)) { pg8::Gemm g{(const bf16*)(args.ws + WS_A1), (const bf16*)(args.ws + WS_WT_IN), MT, NINP, DM, DM, DM, 0, 0}; pg8::StaticOrder S; S.init(MT, NINP, G, bid);
        pg8::EpiBf16<0> E{(bf16*)(args.ws + WS_P), NINP, nullptr, 0, 0}; pg8::gemm_phase<pg8::EpiBf16<0>, pg8::StaticOrder>(lds, g, S, E, nullptr);
        if (MK_REPEAT == 2) pg8::gemm_phase<pg8::EpiBf16<0>, pg8::StaticOrder>(lds, g, S, E, nullptr); }
    SEAM(2);
    if (IN(3)) { ph_prep_stage(args, lds); ph_prep_rwkv(args, lds); ph_prep_ssd(args, lds); if (MK_REPEAT == 3) { ph_prep_rwkv(args, lds); ph_prep_ssd(args, lds); } }
    SEAM(3);
    if (IN(4)) { int kw = KLRW; asm volatile("" : "+s"(kw));
        pg8::Gemm g{(const bf16*)(args.ws + WS_ALR), (const bf16*)(args.ws + WS_WLR), MT, NLR, kw, KLR, KLRW, 4, 256}; pg8::StaticOrder S; S.init(MT, NLR, G, bid);
        EpiLR E{(bf16*)(args.ws + WS_LR), args.in[I_W0], args.in[I_A0]}; pg8::gemm_phase<EpiLR, pg8::StaticOrder>(lds, g, S, E, nullptr); }
    SEAM(4);
#if MK_RWKV_SEQ
    if (IN(5)) { ph_rwkv_scan(args); if (MK_REPEAT == 5) ph_rwkv_scan(args); }
#else
    if (IN(5)) {
#if MK_RWKV_LDS
        ph_rwkv_scan2(args, lds); if (MK_REPEAT == 5) ph_rwkv_scan2(args, lds);
#else
        ph_rwkv_chunked(args, lds); if (MK_REPEAT == 5) ph_rwkv_chunked(args, lds);
#endif
    }
#endif
#if MK_SSD_SEQ
    if (IN(6)) { ph_ssd_scan(args); if (MK_REPEAT == 6) ph_ssd_scan(args); }
#else
    if (IN(6)) { ph_ssd_chunked(args, lds); if (MK_REPEAT == 6) ph_ssd_chunked(args, lds); }
#endif
    SEAM(6);
    if (IN(7)) { ph_finish(args); if (MK_REPEAT == 7) ph_finish(args); }
    SEAM(7);
    if (IN(8)) { pg8::Gemm g{(const bf16*)(args.ws + WS_A2), (const bf16*)(args.ws + WS_WT_OUT), MX, DM, DM, DM, DM, 0, 0}; pg8::StaticOrder S; S.init(MX, DM, G, bid);
        EpiRes E{args.out, args.in[I_X], (const float*)(args.ws + WS_MOD)}; pg8::gemm_phase<EpiRes, pg8::StaticOrder>(lds, g, S, E, nullptr);
        if (MK_REPEAT == 8) pg8::gemm_phase<EpiRes, pg8::StaticOrder>(lds, g, S, E, nullptr); }
    SEAM(8);
    if (IN(9)) { ph_norm2(args); if (MK_REPEAT == 9) ph_norm2(args); }
    SEAM(9);
    if (IN(10)) { pg8::Gemm g{(const bf16*)(args.ws + WS_XN2), (const bf16*)(args.ws + WS_WT_Q), MX, 2048, DM, DM, DM, 0, 0}; pg8::StaticOrder S; S.init(MX, 2048, G, bid);
        pg8::EpiBf16<0> E{(bf16*)(args.ws + WS_Q), 2048, nullptr, 0, 0}; pg8::gemm_phase<pg8::EpiBf16<0>, pg8::StaticOrder>(lds, g, S, E, nullptr); }
    SEAM(10);
    if (IN(11)) { int kw = 256; asm volatile("" : "+s"(kw));
        pg8::Gemm g{(const bf16*)(args.ws + WS_Q), (const bf16*)(args.ws + WS_KBD), MX, 2048, kw, 2048, 256, 0, 256}; pg8::StaticOrder S; S.init(MX, 2048, G, bid);
        pg8::EpiF32 E{(float*)(args.ws + WS_S), 2048, nullptr}; pg8::gemm_phase<pg8::EpiF32, pg8::StaticOrder>(lds, g, S, E, nullptr); }
    SEAM(11);
    if (IN(12)) { if (MK_REPEAT == 12) ph_peer(args, (float*)(args.ws + 903 * MiB)); ph_peer(args, args.out); }
#undef IN
#undef SEAM
}

extern "C" void kernel_launch(void* const* d_in, const int* in_sizes, int n_in, void* d_out, int out_size, void* d_ws, size_t ws_size, hipStream_t stream) {
    static int grid = 0;
    if (grid == 0) {
        if (n_in != N_IN || out_size != MX * DM || ws_size < WS_END) { fprintf(stderr, "kernel_launch: unexpected shapes (n_in %d out %d ws %zu)\n", n_in, out_size, ws_size); grid = -1; return; }
        int dev = 0, cus = 0, per_cu = 0;
        if (hipGetDevice(&dev) != hipSuccess || hipDeviceGetAttribute(&cus, hipDeviceAttributeMultiprocessorCount, dev) != hipSuccess) { grid = -1; return; }
        if (hipFuncSetAttribute((const void*)hybrid_fwd, hipFuncAttributeMaxDynamicSharedMemorySize, LDS_BYTES) != hipSuccess) { fprintf(stderr, "kernel_launch: hipFuncSetAttribute failed\n"); grid = -1; return; }
        if (hipOccupancyMaxActiveBlocksPerMultiprocessor(&per_cu, (const void*)hybrid_fwd, 512, LDS_BYTES) != hipSuccess || per_cu < 1) fprintf(stderr, "kernel_launch: occupancy query reports %d\n", per_cu);
        (void)hipGetLastError();
        grid = cus;
    }
    if (grid < 0) return;
    (void)in_sizes;
    if (hipMemsetAsync((char*)d_ws + WS_CTL, 0, CTL_ZERO_BYTES, stream) != hipSuccess) return;
    Args a{};
    for (int i = 0; i < N_IN; ++i) a.in[i] = (const float*)d_in[i];
    a.out = (float*)d_out; a.ws = (unsigned char*)d_ws;
#if MK_N_LAUNCHES == 1
    a.ph_lo = 0; a.ph_hi = N_PHASES;
    hipLaunchKernelGGL(hybrid_fwd, dim3(grid), dim3(512), LDS_BYTES, stream, a);
#else
    for (int ph = 0; ph < N_PHASES; ++ph) { if (!((MK_PHASE_MASK >> ph) & 1)) continue; a.ph_lo = ph; a.ph_hi = ph + 1; hipLaunchKernelGGL(hybrid_fwd, dim3(grid), dim3(512), LDS_BYTES, stream, a); }
#endif
}
```

```cpp
#include <hip/hip_runtime.h>
#include <stdint.h>
#include <stdio.h>
namespace pg8 {
#define PG8_LAS __attribute__((address_space(3)))
typedef unsigned short bf16_t;
typedef short bf16x8 __attribute__((ext_vector_type(8)));
typedef float f32x4 __attribute__((ext_vector_type(4)));
typedef unsigned u32x4 __attribute__((ext_vector_type(4)));
constexpr int BM = 256, BK = 64, HALF = 128, HTB = HALF * BK * 2  , STAGE_BYTES = 8 * HTB, NXCD = 8, WGM = 8;

__host__ __device__ __forceinline__ int lds_byte(int r, int c) { const int st = (r >> 4) * 2 + (c >> 5), rr = r & 15, cc = c & 31, ob = rr * 64 + cc * 2; return st * 1024 + (ob ^ (((ob >> 9) & 1) << 5)); }
__host__ __device__ __forceinline__ void stage_rc(int b, int& R, int& C) { const int st = b / 1024, sb = b % 1024, swz = sb ^ (((sb >> 9) & 1) << 5); R = (st >> 1) * 16 + swz / 64; C = (st & 1) * 32 + (swz % 64) / 2; }
__host__ __device__ __forceinline__ int perm32(int rho) { const int n = rho >> 4, i = rho & 15; return 8 * (i >> 2) + 4 * n + (i & 3); }

struct Unit { int pm, pn; };
struct Gemm { const bf16_t* A; const bf16_t* Bt; int M, N, K; int lda, ldb, kshift, kmul; };

struct StaticOrder {
    int nM, nN, nwg, G, c;
    __host__ __device__ void init(int M, int N, int G_, int c_) { nM = M / BM; nN = N / BM; nwg = nM * nN; G = G_; c = c_; }
    __host__ __device__ bool next(int i, Unit& u) const {
        const long L = (long)i * G + c; if (L >= nwg) return false;
        int wgid = (int)L; { const int q = nwg / NXCD, r = nwg % NXCD, xcd = wgid % NXCD, off = wgid / NXCD; wgid = (xcd < r ? xcd * (q + 1) : r * (q + 1) + (xcd - r) * q) + off; }
        const int nig = WGM * nN, gid = wgid / nig, fm = gid * WGM, gsz = (nM - fm) < WGM ? (nM - fm) : WGM;
        u.pm = fm + ((wgid % nig) % gsz); u.pn = (wgid % nig) / gsz; return true;
    }
    __device__ __forceinline__ void a_ready(const Unit&) const {}
    __device__ __forceinline__ void done(const Unit&) const {}
};
__device__ __forceinline__ unsigned cvt_pk_bf16(float lo, float hi) { unsigned r; asm volatile("v_cvt_pk_bf16_f32 %0, %1, %2" : "=v"(r) : "v"(lo), "v"(hi)); return r; }
typedef float f32x2 __attribute__((ext_vector_type(2)));
__device__ __forceinline__ f32x2 gelu_pk(f32x2 v) {
    const f32x2 av = __builtin_elementwise_abs(v), d = av * 0.2316418882f + 1.0f;
    f32x2 t; t.x = __builtin_amdgcn_rcpf(d.x); t.y = __builtin_amdgcn_rcpf(d.y);
    f32x2 q = t * 0.5307027145f + (-0.7265760135f); q = q * t + 0.7107068705f; q = q * t + (-0.142248368f); q = q * t + 0.127414796f; q = q * t;
    const f32x2 s = (v * v) * (-0.72134752044f);
    f32x2 e; e.x = __builtin_amdgcn_exp2f(s.x); e.y = __builtin_amdgcn_exp2f(s.y);
    const f32x2 m = v * (q * e), r = v - m;
    f32x2 o; o.x = v.x < 0.f ? m.x : r.x; o.y = v.y < 0.f ? m.y : r.y; return o;
}

struct EpiF32 {
    static constexpr bool PERM = false, AFTER_DRAIN = false;
    float* C; int ldc; const float* bias;
    __device__ __forceinline__ void operator()(const f32x4 (&acc)[2][2][4][2], const Unit& u, int wr, int wc, int fr, int fq) const {
        const int row0 = u.pm * BM + wr * 64 + fr, col0 = u.pn * BM + wc * 32 + 4 * fq;
        f32x4 bv[2][2];
#pragma unroll
        for (int bj = 0; bj < 2; ++bj)
#pragma unroll
            for (int n = 0; n < 2; ++n) bv[bj][n] = bias ? *(const f32x4*)(bias + col0 + bj * HALF + n * 16) : (f32x4){0.f, 0.f, 0.f, 0.f};
#pragma unroll
        for (int ai = 0; ai < 2; ++ai)
#pragma unroll
            for (int m = 0; m < 4; ++m) { float* rowp = C + (size_t)(row0 + ai * HALF + m * 16) * ldc + col0;
#pragma unroll
                for (int bj = 0; bj < 2; ++bj)
#pragma unroll
                    for (int n = 0; n < 2; ++n) *(f32x4*)(rowp + bj * HALF + n * 16) = acc[ai][bj][m][n] + bv[bj][n]; }
    }
};
template <int ACT  > struct EpiBf16 {
    static constexpr bool PERM = true, AFTER_DRAIN = false;
    bf16_t* O; int ldc; const float* bias; int split_cols; size_t split_stride;
    __device__ __forceinline__ void operator()(const f32x4 (&acc)[2][2][4][2], const Unit& u, int wr, int wc, int fr, int fq) const {
        const int row0 = u.pm * BM + wr * 64 + fr; int colt = u.pn * BM; bf16_t* base = O;
        if (split_cols) { const int t = colt / split_cols; base += (size_t)t * split_stride; colt -= t * split_cols; }
        const int col0 = colt + wc * 32 + 8 * fq, bcol0 = u.pn * BM + wc * 32 + 8 * fq;
        f32x4 bv[2][2];
#pragma unroll
        for (int bj = 0; bj < 2; ++bj)
#pragma unroll
            for (int n = 0; n < 2; ++n) bv[bj][n] = bias ? *(const f32x4*)(bias + bcol0 + bj * HALF + 4 * n) : (f32x4){0.f, 0.f, 0.f, 0.f};
#pragma unroll
        for (int ai = 0; ai < 2; ++ai)
#pragma unroll
            for (int m = 0; m < 4; ++m) { bf16_t* rowp = base + (size_t)(row0 + ai * HALF + m * 16) * ldc + col0;
#pragma unroll
                for (int bj = 0; bj < 2; ++bj) { f32x4 v0 = acc[ai][bj][m][0] + bv[bj][0], v1 = acc[ai][bj][m][1] + bv[bj][1];
                    if (ACT == 1) { f32x2 a = gelu_pk((f32x2){v0[0], v0[1]}), b = gelu_pk((f32x2){v0[2], v0[3]}), c = gelu_pk((f32x2){v1[0], v1[1]}), d = gelu_pk((f32x2){v1[2], v1[3]});
                        v0 = (f32x4){a.x, a.y, b.x, b.y}; v1 = (f32x4){c.x, c.y, d.x, d.y}; }
                    if (ACT == 2) {
#pragma unroll
                        for (int j = 0; j < 4; ++j) { v0[j] = 0.5f * v0[j] * (1.0f + erff(v0[j] * 0.70710678f)); v1[j] = 0.5f * v1[j] * (1.0f + erff(v1[j] * 0.70710678f)); } }
                    u32x4 w; w.x = cvt_pk_bf16(v0[0], v0[1]); w.y = cvt_pk_bf16(v0[2], v0[3]); w.z = cvt_pk_bf16(v1[0], v1[1]); w.w = cvt_pk_bf16(v1[2], v1[3]);
                    *(u32x4*)(rowp + bj * HALF) = w; } }
    }
};
template <class Epi, class Sched, bool STAMP = false>
__device__ __forceinline__ void gemm_phase(PG8_LAS unsigned char* lds, const Gemm g, const Sched& S, const Epi& E, unsigned long long* stamps) {
    const int tid = threadIdx.x, wid = __builtin_amdgcn_readfirstlane(tid >> 6), lane = tid & 63, wr = wid >> 2, wc = wid & 3, fr = lane & 15, fq = lane >> 4;
    const int K = g.K, nt = K / BK;
    int ts_lo = 0, ts_hi = 0, nts = 0; const unsigned long long rt_entry = STAMP ? (unsigned long long)wall_clock64() : 0ull;
#define PG8_STAMP() do { if (STAMP && wid == 0 && nts < 64) { const unsigned long long _c = (unsigned long long)clock64(); \
        ts_lo = (lane == nts) ? (int)(unsigned)_c : ts_lo; ts_hi = (lane == nts) ? (int)(unsigned)(_c >> 32) : ts_hi; ++nts; } } while (0)
    PG8_STAMP();
    unsigned voffA[2], voffB[2];
#pragma unroll
    for (int i = 0; i < 2; ++i) { int R, C; stage_rc(tid * 16 + i * 8192, R, C); const int Rb = Epi::PERM ? ((R & ~31) + perm32(R & 31)) : R;
        voffA[i] = (unsigned)(R * g.lda + C) * 2u; voffB[i] = (unsigned)(Rb * g.ldb + C) * 2u; }
    const size_t kstep = (size_t)(BK * 2);
    const size_t hstepA = (size_t)HALF * g.lda * 2, hstepB = (size_t)HALF * g.ldb * 2;
    const size_t tstepA = 2 * hstepA, tstepB = 2 * hstepB;
    const unsigned ldsw = (unsigned)wid * 1024u;
    const int aoff = lds_byte(wr * 64 + fr, fq * 8), boff = lds_byte(wc * 32 + fr, fq * 8);
#define PG8_SA(b, h) (((b) * 2 + (h)) * HTB)
#define PG8_SB(b, h) ((4 + (b) * 2 + (h)) * HTB)
#define PG8_STAGE(bufoff, gbase, voff) do { _Pragma("unroll") for (int _i = 0; _i < 2; ++_i) \
        __builtin_amdgcn_global_load_lds((const unsigned*)((const char*)(gbase) + (voff)[_i]), (PG8_LAS unsigned*)(lds + (bufoff) + ldsw + _i * 8192), 16, 0, 0); } while (0)
#define PG8_LDA(dst, b, h) do { _Pragma("unroll") for (int m = 0; m < 4; ++m) _Pragma("unroll") for (int k = 0; k < 2; ++k) dst[m][k] = *(const PG8_LAS bf16x8*)(lds + PG8_SA(b, h) + aoff + m * 2048 + k * 1024); } while (0)
#define PG8_LDB(dst, b, h) do { _Pragma("unroll") for (int n = 0; n < 2; ++n) _Pragma("unroll") for (int k = 0; k < 2; ++k) dst[n][k] = *(const PG8_LAS bf16x8*)(lds + PG8_SB(b, h) + boff + n * 2048 + k * 1024); } while (0)
#define PG8_MMA(ai, bj, At, Bt) do { __builtin_amdgcn_s_setprio(1); _Pragma("unroll") for (int m = 0; m < 4; ++m) _Pragma("unroll") for (int n = 0; n < 2; ++n) _Pragma("unroll") for (int k = 0; k < 2; ++k) \
        acc[ai][bj][m][n] = __builtin_amdgcn_mfma_f32_16x16x32_bf16(Bt[n][k], At[m][k], acc[ai][bj][m][n], 0, 0, 0); __builtin_amdgcn_s_setprio(0); } while (0)
#define PG8_WAIT_V(n) asm volatile("s_waitcnt vmcnt(" #n ")" ::: "memory")
#define PG8_WAIT_L(n) asm volatile("s_waitcnt lgkmcnt(" #n ")" ::: "memory")
#define PG8_BAR __builtin_amdgcn_s_barrier()
#define PG8_SCHED __builtin_amdgcn_sched_barrier(0)
    Unit cur, nxt; int ui = 0;
    if (!S.next(0, cur)) return;
    f32x4 acc[2][2][4][2];
#pragma unroll
    for (int a = 0; a < 2; ++a)
#pragma unroll
        for (int b = 0; b < 2; ++b)
#pragma unroll
            for (int m = 0; m < 4; ++m)
#pragma unroll
                for (int n = 0; n < 2; ++n) acc[a][b][m][n] = (f32x4){0.f, 0.f, 0.f, 0.f};
    bf16x8 At[4][2], B0[2][2], B1[2][2];
    const char* cA = (const char*)g.A + (size_t)cur.pm * tstepA + (size_t)((cur.pn >> g.kshift) * g.kmul) * 2; const char* cB = (const char*)g.Bt + (size_t)cur.pn * tstepB;
    S.a_ready(cur);
    PG8_STAGE(PG8_SB(0, 0), cB, voffB); PG8_STAGE(PG8_SA(0, 0), cA, voffA); PG8_STAGE(PG8_SB(0, 1), cB + hstepB, voffB); PG8_STAGE(PG8_SA(0, 1), cA + hstepA, voffA);
    if (wr == 1) PG8_BAR;
    PG8_WAIT_V(4); PG8_BAR;
    PG8_STAGE(PG8_SB(1, 0), cB + kstep, voffB); PG8_STAGE(PG8_SA(1, 0), cA + kstep, voffA); PG8_STAGE(PG8_SB(1, 1), cB + hstepB + kstep, voffB);
    PG8_WAIT_V(6); PG8_BAR;
    PG8_STAMP();
    for (;;) {
        const bool has_next = S.next(ui + 1, nxt);
        const char* nA = has_next ? (const char*)g.A + (size_t)nxt.pm * tstepA + (size_t)((nxt.pn >> g.kshift) * g.kmul) * 2 : cA; const char* nB = has_next ? (const char*)g.Bt + (size_t)nxt.pn * tstepB : cB;
        for (int t = 0; t < nt; t += 2) {
            const bool last = (t == nt - 2);
            const char* a1 = cA + (size_t)(t + 1) * kstep;
            const char* a2 = last ? nA : cA + (size_t)(t + 2) * kstep; const char* b2 = last ? nB : cB + (size_t)(t + 2) * kstep;
            const char* a3 = a2 + kstep; const char* b3 = b2 + kstep;
            if (last && has_next) S.a_ready(nxt);
            PG8_LDB(B0, 0, 0); PG8_SCHED; PG8_LDA(At, 0, 0); PG8_STAGE(PG8_SA(1, 1), a1 + hstepA, voffA);
            PG8_WAIT_L(8); PG8_BAR; PG8_WAIT_L(0); PG8_MMA(0, 0, At, B0); PG8_BAR; PG8_SCHED;
            PG8_LDB(B1, 0, 1); PG8_STAGE(PG8_SB(0, 0), b2, voffB);
            PG8_BAR; PG8_WAIT_L(0); PG8_MMA(0, 1, At, B1); PG8_BAR;
            PG8_LDA(At, 0, 1); PG8_STAGE(PG8_SA(0, 0), a2, voffA);
            PG8_BAR; PG8_WAIT_L(0); PG8_MMA(1, 0, At, B0); PG8_BAR; PG8_SCHED;
            PG8_STAGE(PG8_SB(0, 1), b2 + hstepB, voffB);
            PG8_WAIT_V(6); PG8_BAR; PG8_MMA(1, 1, At, B1); PG8_BAR;
            PG8_LDB(B0, 1, 0); PG8_SCHED; PG8_LDA(At, 1, 0); PG8_STAGE(PG8_SA(0, 1), a2 + hstepA, voffA);
            PG8_WAIT_L(8); PG8_BAR; PG8_WAIT_L(0); PG8_MMA(0, 0, At, B0); PG8_BAR; PG8_SCHED;
            PG8_LDB(B1, 1, 1); PG8_STAGE(PG8_SB(1, 0), b3, voffB);
            PG8_BAR; PG8_WAIT_L(0); PG8_MMA(0, 1, At, B1); PG8_BAR;
            PG8_LDA(At, 1, 1); PG8_STAGE(PG8_SA(1, 0), a3, voffA);
            PG8_BAR; PG8_WAIT_L(0); PG8_MMA(1, 0, At, B0); PG8_BAR; PG8_SCHED;
            PG8_STAGE(PG8_SB(1, 1), b3 + hstepB, voffB);
            PG8_WAIT_V(6); PG8_BAR; PG8_MMA(1, 1, At, B1); PG8_BAR;
        }
        PG8_STAMP();
        if constexpr (!Epi::AFTER_DRAIN) { E(acc, cur, wr, wc, fr, fq); S.done(cur); }
        PG8_STAMP();
        if (!has_next) break;
#pragma unroll
        for (int a = 0; a < 2; ++a)
#pragma unroll
            for (int b = 0; b < 2; ++b)
#pragma unroll
                for (int m = 0; m < 4; ++m)
#pragma unroll
                    for (int n = 0; n < 2; ++n) acc[a][b][m][n] = (f32x4){0.f, 0.f, 0.f, 0.f};
        cur = nxt; cA = nA; cB = nB; ++ui;
    }
    PG8_WAIT_V(0);
    if (wr == 0) PG8_BAR;
    PG8_BAR;
    if constexpr (Epi::AFTER_DRAIN) { E.fused(acc, cur, wr, wc, fr, fq, lds, wid, lane); S.done(cur); }
    PG8_STAMP();
    if (STAMP && wid == 0) { stamps[lane] = lane < nts ? (((unsigned long long)(unsigned)ts_hi << 32) | (unsigned)ts_lo) : 0ull;
        if (lane == 62) stamps[62] = rt_entry; if (lane == 63) stamps[63] = (unsigned long long)wall_clock64(); }
#undef PG8_STAMP
#undef PG8_SA
#undef PG8_SB
#undef PG8_STAGE
#undef PG8_LDA
#undef PG8_LDB
#undef PG8_MMA
#undef PG8_WAIT_V
#undef PG8_WAIT_L
#undef PG8_BAR
#undef PG8_SCHED
}
}

#define LAS __attribute__((address_space(3)))
typedef unsigned short bf16;
typedef float f32x4 __attribute__((ext_vector_type(4)));

#ifndef MK_N_LAUNCHES
#define MK_N_LAUNCHES 1
#endif
#ifndef MK_PHASE_MASK
#define MK_PHASE_MASK 0x1FFF
#endif
#ifndef MK_REPEAT
#define MK_REPEAT -1
#endif
#ifndef MK_PEER_FP4
#define MK_PEER_FP4 2
#endif
#ifndef MK_RWKV_LDS
#define MK_RWKV_LDS 0
#endif
#ifndef MK_RWKV_SEQ
#define MK_RWKV_SEQ 0
#endif
#ifndef MK_SSD_SEQ
#define MK_SSD_SEQ 0
#endif
#ifndef MK_SKIP_MIXER
#define MK_SKIP_MIXER 0
#endif
#ifndef MK_SKIP_PEER
#define MK_SKIP_PEER 0
#endif
#ifndef MK_SKIP_RWKV
#define MK_SKIP_RWKV 0
#endif
#ifndef MK_SKIP_SSD
#define MK_SKIP_SSD 0
#endif

constexpr int DM = 4096, NBATCH = 4, SEQ = 4096, CTXL = 256;
constexpr int MX = NBATCH * SEQ;
constexpr int MC = NBATCH * CTXL;
constexpr int MT = MX + MC;
constexpr int RW = 2048;
constexpr int RCOLS = 6784;
constexpr int NIN = 12992, NINP = 13056;
constexpr int COL_Z = 6784, COL_XBC = 8832, COL_DT = 12928;
constexpr int NLR = 10240, KLR = 768, KLRW = 256;
constexpr int NMOD = 6 * DM;
constexpr float RMS_EPS = 1e-6f, GN_EPS = 64e-5f;
constexpr int NSTEP = CTXL + SEQ;

constexpr size_t MiB = (size_t)1 << 20;
constexpr size_t WS_CTL = 0, CTL_ZERO_BYTES = 1 * MiB;
constexpr size_t WS_MOD = 64 * 1024;
constexpr size_t WS_WT_OUT = 2 * MiB;
constexpr size_t WS_WT_Q = 34 * MiB;
constexpr size_t WS_WLR = 50 * MiB;
constexpr size_t WS_KBD = 63 * MiB;
constexpr size_t WS_DT = 71 * MiB;
constexpr size_t WS_LA = WS_DT + (size_t)MT * 64 * 4;
constexpr size_t WS_ALR = 300 * MiB;
constexpr size_t WS_WT_IN = 102 * MiB;
constexpr size_t WS_A1 = 204 * MiB;
constexpr size_t WS_P = 340 * MiB;
constexpr size_t WS_R = 774 * MiB, WS_K = 842 * MiB, WS_V = 910 * MiB, WS_KK = 978 * MiB;
constexpr size_t WS_XS = 1046 * MiB, WS_BC = 1114 * MiB;
constexpr size_t WS_Z = 102 * MiB;
constexpr size_t WS_LR = 340 * MiB;
constexpr size_t WS_A2 = 166 * MiB;
constexpr size_t WS_XN2 = 340 * MiB;
constexpr size_t WS_Q = 468 * MiB;
constexpr size_t WS_S = 532 * MiB;
constexpr size_t WS_U8 = 774 * MiB, WS_V8 = 838 * MiB;
constexpr size_t WS_USC = 902 * MiB, WS_VSC = WS_USC + 65536;
constexpr size_t WS_END = 1182 * MiB;
static_assert(WS_WT_IN + (size_t)NINP * DM * 2 <= WS_A1 && WS_A1 + (size_t)MT * DM * 2 <= WS_P && WS_P + (size_t)MT * NINP * 2 <= WS_R, "ws map 1");
static_assert(WS_LR + (size_t)MT * NLR * 2 <= WS_R && WS_Z + (size_t)MX * RW * 2 <= WS_A2 && WS_A2 + (size_t)MX * DM * 2 <= WS_P, "ws map 2");
static_assert(WS_LA + (size_t)MT * 64 * 4 <= WS_WT_IN && WS_ALR + (size_t)MT * KLR * 2 <= WS_P && WS_ALR >= WS_A2 + (size_t)MX * DM * 2 && WS_WLR + (size_t)NLR * KLRW * 2 <= WS_KBD, "ws map 3");
static_assert(WS_S + (size_t)MX * 2048 * 4 <= WS_R && WS_VSC + 65536 <= WS_XS, "ws map 4");

constexpr int LDS_BYTES = 147456;
constexpr int LDS_CTL = 143360;
constexpr int LDS_MISC = LDS_CTL + 320;

enum { I_X = 0, I_C, I_CTX, I_CCTX, I_WMOD, I_BMOD, I_N1G, I_N2G, I_WIN, I_WOUT, I_MU, I_W0, I_W2, I_A0, I_A2, I_G2, I_KK, I_KA, I_RK, I_LNW, I_LNB,
       I_CONVW, I_CONVB, I_DTB, I_ALOG, I_SSMD, I_NORMW, I_WQ, I_K1, I_K2, I_PU, I_PV, I_FG, N_IN };

struct Args { const float* in[N_IN]; float* out; unsigned char* ws; int ph_lo, ph_hi; };

__device__ __forceinline__ unsigned f2bf(float f) { unsigned u = __float_as_uint(f); return (u + 0x7fffu + ((u >> 16) & 1u)) >> 16; }
__device__ __forceinline__ unsigned pk2(float lo, float hi) { return f2bf(lo) | (f2bf(hi) << 16); }
__device__ __forceinline__ float bflo(unsigned u) { return __uint_as_float(u << 16); }
__device__ __forceinline__ float bfhi(unsigned u) { return __uint_as_float(u & 0xffff0000u); }
__device__ __forceinline__ void unpack8(const uint4& u, float (&f)[8]) {
    f[0] = bflo(u.x); f[1] = bfhi(u.x); f[2] = bflo(u.y); f[3] = bfhi(u.y); f[4] = bflo(u.z); f[5] = bfhi(u.z); f[6] = bflo(u.w); f[7] = bfhi(u.w);
}
__device__ __forceinline__ uint4 pack8(const float (&f)[8]) { uint4 u; u.x = pk2(f[0], f[1]); u.y = pk2(f[2], f[3]); u.z = pk2(f[4], f[5]); u.w = pk2(f[6], f[7]); return u; }
__device__ __forceinline__ uint4 ld16(const bf16* p) { return *(const uint4*)p; }
__device__ __forceinline__ void st16(bf16* p, const uint4& v) { *(uint4*)p = v; }
__device__ __forceinline__ void ldf8(const float* p, float (&f)[8]) { const float4 a = *(const float4*)p, b = *(const float4*)(p + 4); f[0] = a.x; f[1] = a.y; f[2] = a.z; f[3] = a.w; f[4] = b.x; f[5] = b.y; f[6] = b.z; f[7] = b.w; }
#define PIN8(a) asm volatile("" : "+v"((a)[0]), "+v"((a)[1]), "+v"((a)[2]), "+v"((a)[3]), "+v"((a)[4]), "+v"((a)[5]), "+v"((a)[6]), "+v"((a)[7]))
template <int CTRL> __device__ __forceinline__ float dppf(float v) { return __uint_as_float((unsigned)__builtin_amdgcn_update_dpp(0, (int)__float_as_uint(v), CTRL, 0xF, 0xF, true)); }
__device__ __forceinline__ float rlane(float v, int l) { return __uint_as_float((unsigned)__builtin_amdgcn_readlane((int)__float_as_uint(v), l)); }
__device__ __forceinline__ float sum8(float v) { v += dppf<0xB1>(v); v += dppf<0x4E>(v); v += dppf<0x141>(v); return v; }
__device__ __forceinline__ float sum16(float v) { v = sum8(v); v += dppf<0x140>(v); return v; }
__device__ __forceinline__ float sum32(float v) { v = sum16(v); v += __shfl_xor(v, 16); return v; }
__device__ __forceinline__ float wave_sum(float v) { v = sum16(v); return (rlane(v, 0) + rlane(v, 16)) + (rlane(v, 32) + rlane(v, 48)); }
__device__ __forceinline__ float wave_max(float v) {
    v = fmaxf(v, dppf<0xB1>(v)); v = fmaxf(v, dppf<0x4E>(v)); v = fmaxf(v, dppf<0x141>(v)); v = fmaxf(v, dppf<0x140>(v));
    return fmaxf(fmaxf(rlane(v, 0), rlane(v, 16)), fmaxf(rlane(v, 32), rlane(v, 48)));
}
__device__ __forceinline__ void lds_barrier() { asm volatile("s_waitcnt lgkmcnt(0)\n\ts_barrier" ::: "memory"); }
__device__ __forceinline__ float sigmoidf_(float x) { return 1.f / (1.f + __expf(-x)); }
__device__ __forceinline__ float siluf_(float x) { return x / (1.f + __expf(-x)); }

struct EpiLR {
    static constexpr bool PERM = true, AFTER_DRAIN = false;
    bf16* O; const float* w0; const float* a0;
    __device__ __forceinline__ void operator()(const pg8::f32x4 (&acc)[2][2][4][2], const pg8::Unit& u, int wr, int wc, int fr, int fq) const {
        const int row0 = u.pm * 256 + wr * 64 + fr; const int colt = u.pn * 256; const int type = colt >> 11;
        const int col0 = colt + wc * 32 + 8 * fq;
        const float* bias = type < 2 ? (w0 + type * 2048) : (a0 + (type - 2) * 2048);
        pg8::f32x4 bv[2][2];
#pragma unroll
        for (int bj = 0; bj < 2; ++bj)
#pragma unroll
            for (int n = 0; n < 2; ++n) bv[bj][n] = type < 4 ? *(const pg8::f32x4*)(bias + ((col0 + bj * 128 + 4 * n) & 2047)) : (pg8::f32x4){0.f, 0.f, 0.f, 0.f};
#pragma unroll
        for (int ai = 0; ai < 2; ++ai)
#pragma unroll
            for (int m = 0; m < 4; ++m) { bf16* rowp = O + (size_t)(row0 + ai * 128 + m * 16) * NLR + col0;
#pragma unroll
                for (int bj = 0; bj < 2; ++bj) { pg8::f32x4 v0 = acc[ai][bj][m][0] + bv[bj][0], v1 = acc[ai][bj][m][1] + bv[bj][1];
                    if (type < 4) {
#pragma unroll
                        for (int j = 0; j < 4; ++j) { float s0 = 1.f / (1.f + __expf(-v0[j])), s1 = 1.f / (1.f + __expf(-v1[j]));
                            if (type < 2) { s0 = -expm1f(-0.60653066f * s0); s1 = -expm1f(-0.60653066f * s1); }
                            v0[j] = s0; v1[j] = s1; } }
                    pg8::u32x4 w; w.x = pg8::cvt_pk_bf16(v0[0], v0[1]); w.y = pg8::cvt_pk_bf16(v0[2], v0[3]); w.z = pg8::cvt_pk_bf16(v1[0], v1[1]); w.w = pg8::cvt_pk_bf16(v1[2], v1[3]);
                    *(pg8::u32x4*)(rowp + bj * 128) = w; } }
    }
};
struct EpiRes {
    static constexpr bool PERM = false, AFTER_DRAIN = false;
    float* C; const float* X; const float* mod;
    __device__ __forceinline__ void operator()(const pg8::f32x4 (&acc)[2][2][4][2], const pg8::Unit& u, int wr, int wc, int fr, int fq) const {
        const int row0 = u.pm * 256 + wr * 64 + fr, col0 = u.pn * 256 + wc * 32 + 4 * fq;
        const float* gt = mod + (size_t)((u.pm * 256) / SEQ) * NMOD + 2 * DM;
        pg8::f32x4 gv[2][2];
#pragma unroll
        for (int bj = 0; bj < 2; ++bj)
#pragma unroll
            for (int n = 0; n < 2; ++n) gv[bj][n] = *(const pg8::f32x4*)(gt + col0 + bj * 128 + n * 16);
#pragma unroll
        for (int ai = 0; ai < 2; ++ai)
#pragma unroll
            for (int m = 0; m < 4; ++m) { const size_t off = (size_t)(row0 + ai * 128 + m * 16) * DM + col0;
#pragma unroll
                for (int bj = 0; bj < 2; ++bj)
#pragma unroll
                    for (int n = 0; n < 2; ++n) { const pg8::f32x4 xv = *(const pg8::f32x4*)(X + off + bj * 128 + n * 16);
#if MK_SKIP_MIXER
                        *(pg8::f32x4*)(C + off + bj * 128 + n * 16) = xv;
#else
                        *(pg8::f32x4*)(C + off + bj * 128 + n * 16) = xv + gv[bj][n] * acc[ai][bj][m][n];
#endif
                    }
                asm volatile("" ::: "memory"); }
    }
};

#define XB_TMO      128
#define XB_XCNT(j)  (256  + 64 * (j))
#define XB_XSUB(j)  (1280 + 64 * (j))
#define XB_XGEN(j)  (2304 + 64 * (j))
#define XB_TOP      3328
#define XB_TOPGEN   3392
#define XCD_BAR_WORDS 3456
#define XB_SPIN_CAP (1u << 18)
__device__ __forceinline__ unsigned xb_ld(unsigned* p)              { return __hip_atomic_load(p, __ATOMIC_RELAXED, __HIP_MEMORY_SCOPE_AGENT); }
__device__ __forceinline__ unsigned xb_add(unsigned* p, unsigned v) { return __hip_atomic_fetch_add(p, v, __ATOMIC_RELAXED, __HIP_MEMORY_SCOPE_AGENT); }
__device__ __forceinline__ unsigned xb_xcc_id() { return (unsigned)__builtin_amdgcn_s_getreg((3 << 11) | 20) & 0xFu; }
#define XB_SPIN(cond, bar) do { unsigned _sp = 0; while (cond) { __builtin_amdgcn_s_sleep(1); \
    if ((++_sp & 255u) == 0u) { if (xb_ld(&(bar)[XB_TMO])) break; if (_sp > XB_SPIN_CAP) { atomicAdd(&(bar)[XB_TMO], 1u); break; } } } } while (0)
struct XcdBarrier { unsigned* bar; unsigned x; volatile LAS unsigned* st; };
__device__ __forceinline__ XcdBarrier xcd_barrier_post(unsigned* bar, volatile LAS unsigned* st) {
    XcdBarrier b; b.bar = bar; b.x = xb_xcc_id(); b.st = st;
    if (threadIdx.x == 0) (void)xb_add(&bar[XB_XCNT(b.x)], 1u);
    return b;
}
__device__ __forceinline__ void xcd_barrier_complete(unsigned* bar, unsigned x, unsigned& nloc, unsigned& nx) {
    const unsigned G = gridDim.x * gridDim.y * gridDim.z;
    unsigned sum, cnt, mine, sp = 0u;
    for (;;) {
        sum = 0u; cnt = 0u; mine = 0u;
#pragma unroll
        for (unsigned j = 0; j < 16; ++j) { const unsigned c = xb_ld(&bar[XB_XCNT(j)]); sum += c; cnt += (c > 0u) ? 1u : 0u; mine = (j == x) ? c : mine; }
        if (sum == G) break;
        __builtin_amdgcn_s_sleep(1);
        if ((++sp & 255u) == 0u) { if (xb_ld(&bar[XB_TMO])) break; if (sp > XB_SPIN_CAP) { atomicAdd(&bar[XB_TMO], 1u); break; } }
    }
    nloc = mine > 0u ? mine : 1u; nx = cnt > 0u ? cnt : 1u;
}
__device__ __forceinline__ void xcd_barrier(const XcdBarrier& b) {
    asm volatile("s_waitcnt vmcnt(0)" ::: "memory");
    __syncthreads();
    if (threadIdx.x == 0) {
        unsigned* bar = b.bar;
        __builtin_amdgcn_s_waitcnt(0);
        unsigned nloc = b.st[0], nx = b.st[1];
        if (nloc == 0u) { xcd_barrier_complete(bar, b.x, nloc, nx); b.st[0] = nloc; b.st[1] = nx; }
        const unsigned old = xb_add(&bar[XB_XSUB(b.x)], 1u);
        const unsigned gen = old / nloc;
        if (old + 1u == (gen + 1u) * nloc) {
            __builtin_amdgcn_fence(__ATOMIC_RELEASE, "agent");
            asm volatile("s_waitcnt vmcnt(0)" ::: "memory");
            const unsigned og = xb_add(&bar[XB_TOP], 1u);
            const unsigned tg = og / nx;
            if (og + 1u == (tg + 1u) * nx) xb_add(&bar[XB_TOPGEN], 1u);
            else XB_SPIN(xb_ld(&bar[XB_TOPGEN]) == tg, bar);
            __builtin_amdgcn_fence(__ATOMIC_ACQUIRE, "agent");
            xb_add(&bar[XB_XGEN(b.x)], 1u);
            asm volatile("s_waitcnt vmcnt(0)" ::: "memory");
        } else {
            XB_SPIN(xb_ld(&bar[XB_XGEN(b.x)]) == gen, bar);
            __builtin_amdgcn_fence(__ATOMIC_ACQUIRE, "agent");
            asm volatile("s_waitcnt vmcnt(0)" ::: "memory");
        }
    }
    __syncthreads();
}

#define TID ((int)threadIdx.x)
#define LANE ((int)(threadIdx.x & 63))
#define WAVE ((int)__builtin_amdgcn_readfirstlane((int)(threadIdx.x >> 6)))
#define GW ((int)blockIdx.x * 8 + WAVE)
#define NGW ((int)gridDim.x * 8)

__device__ __forceinline__ void ph_mod(const Args& a, LAS unsigned char* lds) {
    const float* c = a.in[I_C]; const float* cc = a.in[I_CCTX]; const float* w_mod = a.in[I_WMOD]; const float* b_mod = a.in[I_BMOD];
    float* mod = (float*)(a.ws + WS_MOD);
    LAS float* sS = (LAS float*)lds;
    LAS float* red = (LAS float*)(lds + 81920);
    const int tid = TID, lane = LANE, wave = WAVE;
    if ((int)blockIdx.x < 192) {
        for (int i = tid; i < 5 * DM; i += 512) { const int v = i >> 12, k = i & (DM - 1); const float xv = v < 4 ? c[v * DM + k] : cc[k]; sS[i] = xv / (1.f + expf(-xv)); }
    }
    __syncthreads();
    for (int u = blockIdx.x; u < 192; u += gridDim.x) {
        const int cl = lane & 31, kh = lane >> 5;
        float acc[5][4];
#pragma unroll
        for (int v = 0; v < 5; ++v)
#pragma unroll
            for (int e = 0; e < 4; ++e) acc[v][e] = 0.f;
        const float* wp = w_mod + (size_t)(wave * 512 + kh) * NMOD + u * 128 + cl * 4;
#pragma unroll 8
        for (int i = 0; i < 256; ++i) {
            const float4 w = *(const float4*)(wp + (size_t)(2 * i) * NMOD);
#pragma unroll
            for (int v = 0; v < 5; ++v) { const float s = sS[v * DM + wave * 512 + 2 * i + kh]; acc[v][0] += s * w.x; acc[v][1] += s * w.y; acc[v][2] += s * w.z; acc[v][3] += s * w.w; }
        }
#pragma unroll
        for (int v = 0; v < 5; ++v)
#pragma unroll
            for (int e = 0; e < 4; ++e) acc[v][e] += __shfl_xor(acc[v][e], 32);
        if (kh == 0) {
#pragma unroll
            for (int v = 0; v < 5; ++v) *(LAS f32x4*)(red + ((wave * 5 + v) * 128 + cl * 4)) = (f32x4){acc[v][0], acc[v][1], acc[v][2], acc[v][3]};
        }
        __syncthreads();
        for (int i = tid; i < 640; i += 512) { const int v = i >> 7, n = i & 127; float s = b_mod[u * 128 + n];
#pragma unroll
            for (int w = 0; w < 8; ++w) s += red[(w * 5 + v) * 128 + n];
            mod[v * NMOD + u * 128 + n] = s; }
        __syncthreads();
    }
    __syncthreads();
}

__device__ __forceinline__ void transpose_item(const float* W, int K, int N, bf16* WT, LAS float* scr, int item, int lane) {
    const int nblk = N / 32, kb = item / nblk, nb = item % nblk, k0 = 64 * kb, n0 = 32 * nb;
#pragma unroll 8
    for (int i = 0; i < 32; ++i) { const int kk = 2 * i + (lane >> 5); scr[kk * 33 + (lane & 31)] = W[(size_t)(k0 + kk) * N + n0 + (lane & 31)]; }
    asm volatile("s_waitcnt lgkmcnt(0)" ::: "memory");
    const int c = lane & 7;
#pragma unroll
    for (int j = 0; j < 4; ++j) { const int n = (lane >> 3) + 8 * j; const LAS float* s = scr + (8 * c) * 33 + n;
        uint4 o; o.x = pk2(s[0 * 33], s[1 * 33]); o.y = pk2(s[2 * 33], s[3 * 33]); o.z = pk2(s[4 * 33], s[5 * 33]); o.w = pk2(s[6 * 33], s[7 * 33]);
        *(uint4*)(WT + (size_t)(n0 + n) * K + k0 + 8 * c) = o; }
    asm volatile("s_waitcnt lgkmcnt(0)" ::: "memory");
}
__device__ __forceinline__ void ph_conv(const Args& a, LAS unsigned char* lds) {
    const int lane = LANE, wave = WAVE, gw = GW, ngw = NGW;
    LAS float* scr = (LAS float*)(lds + wave * 16384);
    bf16* wt_in = (bf16*)(a.ws + WS_WT_IN); bf16* wt_out = (bf16*)(a.ws + WS_WT_OUT); bf16* wt_q = (bf16*)(a.ws + WS_WT_Q);
    constexpr int IT_IN = (DM / 64) * (NIN / 32), IT_OUT = (DM / 64) * (DM / 32), IT_Q = (DM / 64) * (2048 / 32);
    const int bidc = (int)blockIdx.x, nsl = bidc < 192 ? 2 : 5, sl0 = bidc < 192 ? (bidc * 8 + wave) * 2 : 3072 + ((bidc - 192) * 8 + wave) * 5;
    constexpr int NSLOT = 192 * 8 * 2 + 64 * 8 * 5;
    for (int sk = 0; sk < nsl; ++sk)
    for (int it = ((int)gridDim.x == 256 ? sl0 + sk : (sk == 0 ? gw : IT_IN + IT_OUT + IT_Q)); it < IT_IN + IT_OUT + IT_Q; it += ((int)gridDim.x == 256 ? NSLOT : ngw)) {
        int r = it;
        if (r < IT_IN) { transpose_item(a.in[I_WIN], DM, NIN, wt_in, scr, r, lane); continue; } r -= IT_IN;
        if (r < IT_OUT) { transpose_item(a.in[I_WOUT], DM, DM, wt_out, scr, r, lane); continue; } r -= IT_OUT;
        transpose_item(a.in[I_WQ], DM, 2048, wt_q, scr, r, lane);
    }
    const int gt = blockIdx.x * 512 + TID, ngt = gridDim.x * 512;
    for (int i = gt; i < (NINP - NIN) * DM / 8; i += ngt) *(uint4*)(wt_in + (size_t)NIN * DM + (size_t)i * 8) = make_uint4(0u, 0u, 0u, 0u);
    { bf16* wlr = (bf16*)(a.ws + WS_WLR); const float* w2 = a.in[I_W2]; const float* a2 = a.in[I_A2]; const float* g2 = a.in[I_G2];
      for (int i = gt; i < NLR * (KLRW / 8); i += ngt) { const int n = i / (KLRW / 8), k0 = (i % (KLRW / 8)) * 8; const int type = n >> 11, cch = n & 2047;
          float f[8];
#pragma unroll
          for (int e = 0; e < 8; ++e) { const int k = k0 + e; float v = 0.f;
              if (type == 4) v = g2[(size_t)k * RW + cch];
              else { const int d = type & 1, kk = k - 128 * d; const float* src = type < 2 ? w2 : a2; if (kk >= 0 && kk < 96) v = src[(size_t)(d * 96 + kk) * RW + cch]; }
              f[e] = v; }
          st16(wlr + (size_t)n * KLRW + k0, pack8(f)); } }
    { bf16* kbd = (bf16*)(a.ws + WS_KBD); const float* k1 = a.in[I_K1]; const float* k2 = a.in[I_K2];
      for (int i = gt; i < 2048 * 32; i += ngt) { const int n = i >> 5, k0 = (i & 31) * 8; float f[8];
          const int h = n >> 8, sb = (n >> 7) & 1, key = n & 127;
          if ((k0 >> 7) == sb) { const float* src = (sb ? k2 : k1) + ((size_t)(h * 128 + key) * 128 + (k0 & 127)); ldf8(src, f); }
          else {
#pragma unroll
              for (int e = 0; e < 8; ++e) f[e] = 0.f; }
          st16(kbd + (size_t)n * 256 + k0, pack8(f)); } }
}

__device__ __forceinline__ void norm_mod_row(const float* src, const float* g, const float* sh, const float* sc, bf16* dst, int lane) {
    float4 v[16]; float ss = 0.f;
#pragma unroll
    for (int j = 0; j < 16; ++j) { v[j] = *(const float4*)(src + (lane + 64 * j) * 4); ss += (v[j].x * v[j].x + v[j].y * v[j].y) + (v[j].z * v[j].z + v[j].w * v[j].w); }
    const float rstd = rsqrtf(wave_sum(ss) * (1.f / DM) + RMS_EPS);
#pragma unroll
    for (int j = 0; j < 16; ++j) { const int c = (lane + 64 * j) * 4; const float4 gg = *(const float4*)(g + c), s1 = *(const float4*)(sc + c), s0 = *(const float4*)(sh + c);
        const float o0 = v[j].x * rstd * gg.x * (1.f + s1.x) + s0.x, o1 = v[j].y * rstd * gg.y * (1.f + s1.y) + s0.y, o2 = v[j].z * rstd * gg.z * (1.f + s1.z) + s0.z, o3 = v[j].w * rstd * gg.w * (1.f + s1.w) + s0.w;
        uint2 w; w.x = pk2(o0, o1); w.y = pk2(o2, o3); *(uint2*)(dst + c) = w; }
}
__device__ __forceinline__ void ph_norm1(const Args& a) {
    const int lane = LANE; const float* mod = (const float*)(a.ws + WS_MOD); bf16* A1 = (bf16*)(a.ws + WS_A1);
    for (int m = GW; m < MT; m += NGW) {
        const float* src = m < MX ? a.in[I_X] + (size_t)m * DM : a.in[I_CTX] + (size_t)(m - MX) * DM;
        const int v = m < MX ? m / SEQ : 4;
        norm_mod_row(src, a.in[I_N1G], mod + (size_t)v * NMOD, mod + (size_t)v * NMOD + DM, A1 + (size_t)m * DM, lane);
    }
}
__device__ __forceinline__ void ph_norm2(const Args& a) {
    const int lane = LANE; const float* mod = (const float*)(a.ws + WS_MOD); bf16* XN2 = (bf16*)(a.ws + WS_XN2);
    for (int m = GW; m < MX; m += NGW) {
        const int v = m / SEQ;
        norm_mod_row(a.out + (size_t)m * DM, a.in[I_N2G], mod + (size_t)v * NMOD + 3 * DM, mod + (size_t)v * NMOD + 4 * DM, XN2 + (size_t)m * DM, lane);
    }
    unsigned char* U8 = a.ws + WS_U8; unsigned char* V8 = a.ws + WS_V8; float* USC = (float*)(a.ws + WS_USC); float* VSC = (float*)(a.ws + WS_VSC);
    for (int row = GW; row < 2 * 16384; row += NGW) {
        const int tb = row >> 14, r = row & 16383;
        const float* src = (tb ? a.in[I_PV] : a.in[I_PU]) + (size_t)r * DM;
        float4 v[16]; float am = 0.f;
#pragma unroll
        for (int j = 0; j < 16; ++j) { v[j] = *(const float4*)(src + (lane + 64 * j) * 4); am = fmaxf(fmaxf(am, fmaxf(fabsf(v[j].x), fabsf(v[j].y))), fmaxf(fabsf(v[j].z), fabsf(v[j].w))); }
        am = wave_max(am);
        if ((tb ? MK_PEER_FP4 >= 1 : MK_PEER_FP4 >= 2)) {
            unsigned char* d4 = (tb ? V8 : U8) + (size_t)r * 2304 + lane * 16; unsigned scw = 0u;
#pragma unroll
            for (int p = 0; p < 2; ++p) {
                float bm = 0.f;
#pragma unroll
                for (int j = 0; j < 8; ++j) { const float4 q = v[8 * p + j]; bm = fmaxf(fmaxf(bm, fmaxf(fabsf(q.x), fabsf(q.y))), fmaxf(fabsf(q.z), fabsf(q.w))); }
                const unsigned sb = bm > 0.f ? f2bf(bm * (1.f / 6.f)) : 0x3f80u; const float binv = 1.f / __uint_as_float(sb << 16);
                scw |= sb << (16 * p);
                unsigned w4[4] = {0u, 0u, 0u, 0u};
#pragma unroll
                for (int d = 0; d < 4; ++d) { const float4 qa4 = v[8 * p + 2 * d], qb4 = v[8 * p + 2 * d + 1];
                    unsigned wv = 0u;
                    wv = __builtin_amdgcn_cvt_scalef32_pk_fp4_f32(wv, qa4.x * binv, qa4.y * binv, 1.0f, 0); wv = __builtin_amdgcn_cvt_scalef32_pk_fp4_f32(wv, qa4.z * binv, qa4.w * binv, 1.0f, 1);
                    wv = __builtin_amdgcn_cvt_scalef32_pk_fp4_f32(wv, qb4.x * binv, qb4.y * binv, 1.0f, 2); wv = __builtin_amdgcn_cvt_scalef32_pk_fp4_f32(wv, qb4.z * binv, qb4.w * binv, 1.0f, 3);
                    w4[d] = wv; }
                *(uint4*)(d4 + 1024 * p) = make_uint4(w4[0], w4[1], w4[2], w4[3]);
            }
            *(unsigned*)((tb ? V8 : U8) + (size_t)r * 2304 + 2048 + lane * 4) = scw;
            if (lane == 0) (tb ? VSC : USC)[r] = 1.f;
            continue;
        }
        const float scale = am > 0.f ? am * (1.f / 7.5f) : 1.f, inv = 1.f / scale;
        unsigned char* dst = (tb ? V8 : U8) + (size_t)r * 3072 + lane * 16;
        unsigned long long pk[6];
#pragma unroll
        for (int p = 0; p < 2; ++p) {
            unsigned long long w0 = 0ull, w1 = 0ull, w2 = 0ull;
#pragma unroll
            for (int k = 0; k < 32; ++k) {
                const float4 q = v[8 * p + (k >> 2)]; const float x = ((k & 3) == 0 ? q.x : (k & 3) == 1 ? q.y : (k & 3) == 2 ? q.z : q.w) * inv; const float ax = fabsf(x);
                float cf = ax < 2.f ? rintf(ax * 8.f) : (ax < 4.f ? rintf(ax * 4.f) + 8.f : rintf(ax * 2.f) + 16.f);
                cf = fminf(cf, 31.f);
                const unsigned long long code = (unsigned long long)((unsigned)cf | (x < 0.f ? 32u : 0u));
                const int pos = 6 * k, wd = pos >> 6, off = pos & 63;
                if (wd == 0) w0 |= code << off; else if (wd == 1) w1 |= code << off; else w2 |= code << off;
                if (off > 58) { if (wd == 0) w1 |= code >> (64 - off); else w2 |= code >> (64 - off); }
            }
            pk[3 * p] = w0; pk[3 * p + 1] = w1; pk[3 * p + 2] = w2;
        }
#pragma unroll
        for (int k = 0; k < 3; ++k) *(uint4*)(dst + 1024 * k) = make_uint4((unsigned)pk[2 * k], (unsigned)(pk[2 * k] >> 32), (unsigned)pk[2 * k + 1], (unsigned)(pk[2 * k + 1] >> 32));
        if (lane == 0) (tb ? VSC : USC)[r] = scale;
    }
}

__device__ __forceinline__ void ldf8s(const LAS float* p, float (&f)[8]) { const f32x4 a = *(const LAS f32x4*)p, b = *(const LAS f32x4*)(p + 4); f[0] = a[0]; f[1] = a[1]; f[2] = a[2]; f[3] = a[3]; f[4] = b[0]; f[5] = b[1]; f[6] = b[2]; f[7] = b[3]; }
constexpr int PL_MU = 0, PL_KK = 27136, PL_CW = 35328, PL_CB = 84480, PL_END = 100864;
__device__ __forceinline__ void ph_prep_stage(const Args& a, LAS unsigned char* lds) {
    const int tid = TID;
    for (int i = tid; i < RCOLS; i += 512) ((LAS float*)(lds + PL_MU))[i] = a.in[I_MU][i];
    for (int i = tid; i < RW; i += 512) ((LAS float*)(lds + PL_KK))[i] = a.in[I_KK][i];
    for (int i = tid; i < 3 * 4096; i += 512) ((LAS float*)(lds + PL_CW))[i] = a.in[I_CONVW][i];
    for (int i = tid; i < 4096; i += 512) ((LAS float*)(lds + PL_CB))[i] = a.in[I_CONVB][i];
    __syncthreads();
}
__device__ __forceinline__ void ph_prep_rwkv(const Args& a, LAS unsigned char* lds) {
    const int lane = LANE;
    const bf16* P = (const bf16*)(a.ws + WS_P);
    bf16* R = (bf16*)(a.ws + WS_R); bf16* K = (bf16*)(a.ws + WS_K); bf16* V = (bf16*)(a.ws + WS_V); bf16* KK = (bf16*)(a.ws + WS_KK); bf16* ALR = (bf16*)(a.ws + WS_ALR);
    const LAS float* mu = (const LAS float*)(lds + PL_MU); const LAS float* k_k = (const LAS float*)(lds + PL_KK);
    for (int m = GW; m < MT; m += NGW) {
        const bool lat = m < MX;
        bool h0, h1, h2 = false, h3 = false; size_t r0, r1, r2 = (size_t)m, r3 = (size_t)m;
        if (lat) { const int t = m & (SEQ - 1), row = t >> 6, col = t & 63; h0 = col > 0; h1 = col < 63; h2 = row > 0; h3 = row < 63; r0 = (size_t)(m - 1); r1 = (size_t)(m + 1); r2 = (size_t)(m - 64); r3 = (size_t)(m + 64); }
        else { const int t = (m - MX) & (CTXL - 1); h0 = t > 0; h1 = t < CTXL - 1; r0 = (size_t)(m - 1); r1 = (size_t)(m + 1); }
        if (!h0) r0 = (size_t)m; if (!h1) r1 = (size_t)m; if (!h2) r2 = (size_t)m; if (!h3) r3 = (size_t)m;
        const bf16* prow = P + (size_t)m * NINP; const bf16* p0 = P + r0 * NINP; const bf16* p1 = P + r1 * NINP; const bf16* p2 = P + r2 * NINP; const bf16* p3 = P + r3 * NINP;
        const float f0 = h0 ? 1.f : 0.f, f1 = h1 ? 1.f : 0.f, f2 = h2 ? 1.f : 0.f, f3 = h3 ? 1.f : 0.f;
        uint4 qo[2][2], q0[2][2], q1[2][2], q2[2][2], q3[2][2];
#define PREP_LOAD(buf, i2v) do { _Pragma("unroll") for (int ii = 0; ii < 2; ++ii) { const int chunk_ = lane + 64 * ((i2v) + ii); const int c0_ = (chunk_ < RCOLS / 8 ? chunk_ : 0) * 8; \
            qo[buf][ii] = ld16(prow + c0_); q0[buf][ii] = ld16(p0 + c0_); q1[buf][ii] = ld16(p1 + c0_); \
            if (lat) { q2[buf][ii] = ld16(p2 + c0_); q3[buf][ii] = ld16(p3 + c0_); } else { q2[buf][ii] = qo[buf][ii]; q3[buf][ii] = qo[buf][ii]; } } } while (0)
        PREP_LOAD(0, 0);
#pragma unroll
        for (int i2 = 0; i2 < 14; i2 += 2) {
            const int cb_ = (i2 >> 1) & 1;
            if (i2 + 2 < 14) { if (cb_) PREP_LOAD(0, i2 + 2); else PREP_LOAD(1, i2 + 2); }
            asm volatile("" ::: "memory");
#pragma unroll
            for (int ii = 0; ii < 2; ++ii) { const int i = i2 + ii; const int chunk = lane + 64 * i;
              if (chunk < RCOLS / 8) {
                const int c0 = chunk * 8;
                float own[8], n0[8], n1[8], sh[8], xm[8], muv[8];
                unpack8(qo[cb_][ii], own); unpack8(q0[cb_][ii], n0); unpack8(q1[cb_][ii], n1);
                if (lat) { float n2[8], n3[8]; unpack8(q2[cb_][ii], n2); unpack8(q3[cb_][ii], n3);
#pragma unroll
                    for (int e = 0; e < 8; ++e) sh[e] = (e & 3) == 0 ? n0[e] * f0 : (e & 3) == 1 ? n1[e] * f1 : (e & 3) == 2 ? n2[e] * f2 : n3[e] * f3;
                } else {
#pragma unroll
                    for (int e = 0; e < 8; ++e) sh[e] = (e & 1) == 0 ? n0[e] * f0 : n1[e] * f1;
                }
                ldf8s(mu + c0, muv);
#pragma unroll
                for (int e = 0; e < 8; ++e) xm[e] = own[e] + muv[e] * (sh[e] - own[e]);
                if (i < 4) st16(R + (size_t)m * RW + c0, pack8(xm));
                else if (i < 8) { const int cc = c0 - 2048; st16(K + (size_t)m * RW + cc, pack8(xm));
                    float kv[8], kkv[8]; ldf8s(k_k + cc, kv); float ss = 0.f;
#pragma unroll
                    for (int e = 0; e < 8; ++e) { kkv[e] = xm[e] * kv[e]; ss += kkv[e] * kkv[e]; }
                    ss = sum8(ss);
                    const float inv = rsqrtf(fmaxf(ss, 1e-24f));
#pragma unroll
                    for (int e = 0; e < 8; ++e) kkv[e] *= inv;
                    st16(KK + (size_t)m * RW + cc, pack8(kkv)); }
                else if (i < 12) st16(V + (size_t)m * RW + (c0 - 4096), pack8(xm));
                else { const int j0 = c0 - 6144; float f[8];
#pragma unroll
                    for (int e = 0; e < 8; ++e) f[e] = j0 < 192 ? tanhf(xm[e]) : (j0 < 384 ? xm[e] : 1.f / (1.f + __expf(-xm[e])));
                    const int col = j0 < 384 ? (j0 / 96) * 128 + (j0 % 96) : j0 + 128;
                    st16(ALR + (size_t)m * KLR + col, pack8(f)); }
              } else if (i == 13 && lane < 32) {
                const int pc = lane - 16; st16(ALR + (size_t)m * KLR + (pc >> 2) * 128 + 96 + (pc & 3) * 8, make_uint4(0u, 0u, 0u, 0u));
              }
            }
        }
    }
}

__device__ __forceinline__ void ph_prep_ssd(const Args& a, LAS unsigned char* lds) {
    const int lane = LANE;
    const bf16* P = (const bf16*)(a.ws + WS_P);
    bf16* XS = (bf16*)(a.ws + WS_XS); bf16* BC = (bf16*)(a.ws + WS_BC); bf16* Z = (bf16*)(a.ws + WS_Z); float* DT = (float*)(a.ws + WS_DT); float* LA = (float*)(a.ws + WS_LA);
    const LAS float* cw = (const LAS float*)(lds + PL_CW); const LAS float* cb = (const LAS float*)(lds + PL_CB);
    for (int m = GW; m < MT; m += NGW) {
        const bool lat = m < MX; bool hp, hn;
        if (lat) { const int t = m & (SEQ - 1); hp = t > 0; hn = t < SEQ - 1; } else { const int t = (m - MX) & (CTXL - 1); hp = t > 0; hn = t < CTXL - 1; }
        const bf16* prow = P + (size_t)m * NINP; const bf16* pp = hp ? prow - NINP : prow; const bf16* pn = hn ? prow + NINP : prow;
        const float fp = hp ? 1.f : 0.f, fn = hn ? 1.f : 0.f;
        uint4 zq[4];
        if (lat) {
#pragma unroll
            for (int i = 0; i < 4; ++i) zq[i] = ld16(prow + COL_Z + (lane + 64 * i) * 8);
        }
        const unsigned short dtraw = prow[COL_DT + lane];
        uint4 qc[2][2], qp[2][2], qn[2][2];
#define SSDP_LOAD(buf, i2v) do { _Pragma("unroll") for (int ii = 0; ii < 2; ++ii) { const int c0_ = (lane + 64 * ((i2v) + ii)) * 8; qc[buf][ii] = ld16(prow + COL_XBC + c0_); qp[buf][ii] = ld16(pp + COL_XBC + c0_); qn[buf][ii] = ld16(pn + COL_XBC + c0_); } } while (0)
        SSDP_LOAD(0, 0);
#pragma unroll
        for (int i2 = 0; i2 < 8; i2 += 2) {
            const int cb_ = (i2 >> 1) & 1;
            if (i2 + 2 < 8) { if (cb_) SSDP_LOAD(0, i2 + 2); else SSDP_LOAD(1, i2 + 2); }
            asm volatile("" ::: "memory");
#pragma unroll
            for (int ii = 0; ii < 2; ++ii) { const int i = i2 + ii; const int c0 = (lane + 64 * i) * 8;
                float cur[8], pv[8], nx[8], w0[8], w1[8], w2[8], bb[8], y[8];
                unpack8(qc[cb_][ii], cur); unpack8(qp[cb_][ii], pv); unpack8(qn[cb_][ii], nx);
                ldf8s(cw + c0, w0); ldf8s(cw + 4096 + c0, w1); ldf8s(cw + 8192 + c0, w2); ldf8s(cb + c0, bb);
#pragma unroll
                for (int e = 0; e < 8; ++e) { const float t = w0[e] * (pv[e] * fp) + w1[e] * cur[e] + w2[e] * (nx[e] * fn) + bb[e]; y[e] = t / (1.f + __expf(-t)); }
                if (i < 4) st16(XS + (size_t)m * RW + c0, pack8(y)); else st16(BC + (size_t)m * RW + (c0 - 2048), pack8(y)); }
        }
        { const float raw = __uint_as_float((unsigned)dtraw << 16) + a.in[I_DTB][lane];
          const float dtv = raw > 20.f ? raw : log1pf(expf(raw));
          DT[(size_t)m * 64 + lane] = dtv; LA[(size_t)m * 64 + lane] = -dtv * expf(a.in[I_ALOG][lane]); }
        if (lat) {
#pragma unroll
            for (int i = 0; i < 4; ++i) st16(Z + (size_t)m * RW + (lane + 64 * i) * 8, zq[i]);
        }
    }
}

__device__ __forceinline__ int scan_row(int n, int dir, int b) { return n < CTXL ? MX + b * CTXL + (dir ? CTXL - 1 - n : n) : b * SEQ + (dir ? NSTEP - 1 - n : n - CTXL); }

struct RIn { uint4 r, k, kk, w, a; unsigned v; };
__device__ __forceinline__ void rwkv_load(RIn& x, const bf16* R, const bf16* K, const bf16* V, const bf16* KK, const bf16* LR, int m, int ch, int chi, int dir) {
    x.r = ld16(R + (size_t)m * RW + ch); x.k = ld16(K + (size_t)m * RW + ch); x.kk = ld16(KK + (size_t)m * RW + ch);
    x.w = ld16(LR + (size_t)m * NLR + dir * 2048 + ch); x.a = ld16(LR + (size_t)m * NLR + 4096 + dir * 2048 + ch);
    x.v = V[(size_t)m * RW + chi];
}
__device__ __forceinline__ float rwkv_step(float (&S)[8], const RIn& x, const float (&ka)[8]) {
    float r[8], k[8], kk[8], w1[8], av[8];
    unpack8(x.r, r); unpack8(x.k, k); unpack8(x.kk, kk); unpack8(x.w, w1); unpack8(x.a, av);
    const float v = __uint_as_float(x.v << 16);
    float sa = 0.f;
#pragma unroll
    for (int e = 0; e < 8; ++e) sa -= S[e] * kk[e];
    sa = sum8(sa);
    float o = 0.f;
#pragma unroll
    for (int e = 0; e < 8; ++e) { const float kd = k[e] * (1.f + (av[e] - 1.f) * ka[e]); const float b = kk[e] * av[e];
        S[e] = S[e] * (1.f - w1[e]) + sa * b + v * kd; o += S[e] * r[e]; }
    o = sum8(o);
    return o;
}
__device__ __forceinline__ void ph_rwkv_scan(const Args& a) {
    const int lane = LANE, wave = WAVE;
    const bf16* R = (const bf16*)(a.ws + WS_R); const bf16* K = (const bf16*)(a.ws + WS_K); const bf16* V = (const bf16*)(a.ws + WS_V); const bf16* KK = (const bf16*)(a.ws + WS_KK);
    const bf16* LR = (const bf16*)(a.ws + WS_LR); bf16* OR = (bf16*)a.out;
    for (int u = blockIdx.x; u < 256; u += gridDim.x) {
        const int g = u >> 5, h = u & 31, dir = g >> 2, b = g & 3;
        const int i = wave * 8 + (lane >> 3), jb = lane & 7, ch = h * 64 + jb * 8, chi = h * 64 + i;
        float ka[8]; ldf8(a.in[I_KA] + ch, ka);
        float S[8];
#pragma unroll
        for (int e = 0; e < 8; ++e) S[e] = 0.f;
        RIn A[4], B[4];
#pragma unroll
        for (int s = 0; s < 4; ++s) rwkv_load(A[s], R, K, V, KK, LR, scan_row(s, dir, b), ch, chi, dir);
        for (int n0 = 0; n0 < NSTEP; n0 += 8) {
#pragma unroll
            for (int s = 0; s < 4; ++s) rwkv_load(B[s], R, K, V, KK, LR, scan_row(n0 + 4 + s, dir, b), ch, chi, dir);
#pragma unroll
            for (int s = 0; s < 4; ++s) { const int n = n0 + s; const float o = rwkv_step(S, A[s], ka);
                if (n >= CTXL && jb == 0) OR[((size_t)dir * MX + scan_row(n, dir, b)) * RW + chi] = (bf16)f2bf(o); }
            if (n0 + 8 < NSTEP) {
#pragma unroll
                for (int s = 0; s < 4; ++s) rwkv_load(A[s], R, K, V, KK, LR, scan_row(n0 + 8 + s, dir, b), ch, chi, dir);
            }
#pragma unroll
            for (int s = 0; s < 4; ++s) { const int n = n0 + 4 + s; const float o = rwkv_step(S, B[s], ka);
                if (n >= CTXL && jb == 0) OR[((size_t)dir * MX + scan_row(n, dir, b)) * RW + chi] = (bf16)f2bf(o); }
        }
    }
}

typedef float f32x2_t __attribute__((ext_vector_type(2)));
constexpr int RS_TS = 32, RS_STEP_B = 6 * 256, RS_BUF_B = RS_TS * RS_STEP_B;
constexpr int RS_OBUF = 2 * RS_BUF_B, RS_OBUF_B = RS_TS * 64 * 2;
constexpr int RS_DUMP = RS_OBUF + 2 * RS_OBUF_B;
static_assert(RS_DUMP + 2048 <= 131072, "rwkv scan lds map");
struct RRaw { uint2 r, k, kk, v, w, a; };
__device__ __forceinline__ void rs_load(RRaw& x, const bf16* R, const bf16* K, const bf16* V, const bf16* KK, const bf16* LR, int m, int ch, int dir) {
    x.r = *(const uint2*)(R + (size_t)m * RW + ch); x.k = *(const uint2*)(K + (size_t)m * RW + ch); x.kk = *(const uint2*)(KK + (size_t)m * RW + ch); x.v = *(const uint2*)(V + (size_t)m * RW + ch);
    x.w = *(const uint2*)(LR + (size_t)m * NLR + dir * 2048 + ch); x.a = *(const uint2*)(LR + (size_t)m * NLR + 4096 + dir * 2048 + ch);
}
__device__ __forceinline__ void rs_stage(const RRaw& x, const float (&ka)[4], LAS unsigned char* dst) {
    const float r[4] = {bflo(x.r.x), bfhi(x.r.x), bflo(x.r.y), bfhi(x.r.y)}, k[4] = {bflo(x.k.x), bfhi(x.k.x), bflo(x.k.y), bfhi(x.k.y)};
    const float kk[4] = {bflo(x.kk.x), bfhi(x.kk.x), bflo(x.kk.y), bfhi(x.kk.y)}, v[4] = {bflo(x.v.x), bfhi(x.v.x), bflo(x.v.y), bfhi(x.v.y)};
    const float w1[4] = {bflo(x.w.x), bfhi(x.w.x), bflo(x.w.y), bfhi(x.w.y)}, av[4] = {bflo(x.a.x), bfhi(x.a.x), bflo(x.a.y), bfhi(x.a.y)};
    f32x4 nkk, w, b, kd, rr, vv;
#pragma unroll
    for (int e = 0; e < 4; ++e) { nkk[e] = -kk[e]; w[e] = 1.f - w1[e]; b[e] = kk[e] * av[e]; kd[e] = k[e] * (1.f + (av[e] - 1.f) * ka[e]); rr[e] = r[e]; vv[e] = v[e]; }
    *(LAS f32x4*)(dst) = nkk; *(LAS f32x4*)(dst + 256) = w; *(LAS f32x4*)(dst + 512) = b; *(LAS f32x4*)(dst + 768) = kd; *(LAS f32x4*)(dst + 1024) = rr; *(LAS f32x4*)(dst + 1280) = vv;
}
__device__ __forceinline__ float amul(float a, float b) { float d; asm("v_mul_f32 %0, %1, %2" : "=v"(d) : "v"(a), "v"(b)); return d; }
__device__ __forceinline__ void afmac(float& d, float a, float b) { asm("v_fmac_f32 %0, %1, %2" : "+v"(d) : "v"(a), "v"(b)); }
__device__ __forceinline__ float afma(float a, float b, float c) { float d; asm("v_fma_f32 %0, %1, %2, %3" : "=v"(d) : "v"(a), "v"(b), "v"(c)); return d; }
__device__ __forceinline__ void sum16x2(float& a, float& b) {
    asm("s_nop 1\n\t"
        "v_add_f32_dpp %0, %0, %0 quad_perm:[1,0,3,2] row_mask:0xf bank_mask:0xf bound_ctrl:1\n\t"
        "v_add_f32_dpp %1, %1, %1 quad_perm:[1,0,3,2] row_mask:0xf bank_mask:0xf bound_ctrl:1\n\t"
        "s_nop 0\n\t"
        "v_add_f32_dpp %0, %0, %0 quad_perm:[2,3,0,1] row_mask:0xf bank_mask:0xf bound_ctrl:1\n\t"
        "v_add_f32_dpp %1, %1, %1 quad_perm:[2,3,0,1] row_mask:0xf bank_mask:0xf bound_ctrl:1\n\t"
        "s_nop 0\n\t"
        "v_add_f32_dpp %0, %0, %0 row_half_mirror row_mask:0xf bank_mask:0xf bound_ctrl:1\n\t"
        "v_add_f32_dpp %1, %1, %1 row_half_mirror row_mask:0xf bank_mask:0xf bound_ctrl:1\n\t"
        "s_nop 0\n\t"
        "v_add_f32_dpp %0, %0, %0 row_mirror row_mask:0xf bank_mask:0xf bound_ctrl:1\n\t"
        "v_add_f32_dpp %1, %1, %1 row_mirror row_mask:0xf bank_mask:0xf bound_ctrl:1"
        : "+v"(a), "+v"(b));
}
template <bool OUT> __device__ __forceinline__ void rs_chunk(float (&S)[2][4], const LAS unsigned char* buf, LAS unsigned char* obuf, LAS unsigned char* dump, int j0, int i0, int jb) {
#pragma unroll 4
    for (int s = 0; s < RS_TS; ++s) {
        const LAS unsigned char* base = buf + s * RS_STEP_B;
        const f32x4 nkk = *(const LAS f32x4*)(base + j0 * 4), w = *(const LAS f32x4*)(base + 256 + j0 * 4), b = *(const LAS f32x4*)(base + 512 + j0 * 4), kd = *(const LAS f32x4*)(base + 768 + j0 * 4);
        const f32x2_t v = *(const LAS f32x2_t*)(base + 1280 + i0 * 4);
        float sa0 = amul(S[0][0], nkk[0]), sa1 = amul(S[1][0], nkk[0]);
#pragma unroll
        for (int e = 1; e < 4; ++e) { afmac(sa0, S[0][e], nkk[e]); afmac(sa1, S[1][e], nkk[e]); }
        sum16x2(sa0, sa1);
#pragma unroll
        for (int e = 0; e < 4; ++e) { float t0 = amul(sa0, b[e]), t1 = amul(sa1, b[e]); afmac(t0, v[0], kd[e]); afmac(t1, v[1], kd[e]); S[0][e] = afma(S[0][e], w[e], t0); S[1][e] = afma(S[1][e], w[e], t1); }
        if (OUT) {
            const f32x4 r = *(const LAS f32x4*)(base + 1024 + j0 * 4);
            float o0 = amul(S[0][0], r[0]), o1 = amul(S[1][0], r[0]);
#pragma unroll
            for (int e = 1; e < 4; ++e) { afmac(o0, S[0][e], r[e]); afmac(o1, S[1][e], r[e]); }
            sum16x2(o0, o1);
            *(LAS unsigned*)(jb == 0 ? obuf + (s * 64 + i0) * 2 : dump) = pg8::cvt_pk_bf16(o0, o1);
        }
    }
}
__device__ __forceinline__ void ph_rwkv_scan2(const Args& a, LAS unsigned char* lds) {
    const int tid = TID, lane = LANE, wave = WAVE;
    const bf16* R = (const bf16*)(a.ws + WS_R); const bf16* K = (const bf16*)(a.ws + WS_K); const bf16* V = (const bf16*)(a.ws + WS_V); const bf16* KK = (const bf16*)(a.ws + WS_KK);
    const bf16* LR = (const bf16*)(a.ws + WS_LR); bf16* OR = (bf16*)a.out;
    constexpr int NCH = NSTEP / RS_TS;
    for (int u = blockIdx.x; u < 256; u += gridDim.x) {
        const int g = u >> 5, h = u & 31, dir = g >> 2, b = g & 3;
        const int ip = lane >> 4, jb = lane & 15, i0 = wave * 8 + ip * 2, j0 = jb * 4;
        const int ss = tid >> 4, cgp = tid & 15, ch = h * 64 + cgp * 4;
        float ka[4];
#pragma unroll
        for (int e = 0; e < 4; ++e) ka[e] = a.in[I_KA][ch + e];
        float S[2][4];
#pragma unroll
        for (int e = 0; e < 4; ++e) { S[0][e] = 0.f; S[1][e] = 0.f; }
        RRaw raw;
        __syncthreads();
        rs_load(raw, R, K, V, KK, LR, scan_row(ss, dir, b), ch, dir);
        rs_stage(raw, ka, lds + ss * RS_STEP_B + cgp * 16);
        __syncthreads();
        for (int c = 0; c < NCH; ++c) {
            LAS unsigned char* buf = lds + (c & 1) * RS_BUF_B; LAS unsigned char* nbuf = lds + ((c + 1) & 1) * RS_BUF_B; LAS unsigned char* obuf = lds + RS_OBUF + (c & 1) * RS_OBUF_B;
            const bool more = c + 1 < NCH;
            if (more) rs_load(raw, R, K, V, KK, LR, scan_row((c + 1) * RS_TS + ss, dir, b), ch, dir);
            const bool lat = c >= CTXL / RS_TS;
            if (lat) rs_chunk<true>(S, buf, obuf, lds + RS_DUMP + tid * 4, j0, i0, jb); else rs_chunk<false>(S, buf, obuf, lds + RS_DUMP + tid * 4, j0, i0, jb);
            if (more) rs_stage(raw, ka, nbuf + ss * RS_STEP_B + cgp * 16);
            __syncthreads();
            if (lat) { typedef unsigned u32x2_t __attribute__((ext_vector_type(2))); const u32x2_t ov = *(const LAS u32x2_t*)(obuf + (ss * 64 + cgp * 4) * 2);
                *(uint2*)(OR + ((size_t)dir * MX + scan_row(c * RS_TS + ss, dir, b)) * RW + ch) = make_uint2(ov[0], ov[1]); }
        }
    }
}

struct SIn { uint4 b0, b1, c0, c1; unsigned xs; float dt, la; };
__device__ __forceinline__ void ssd_load(SIn& x, const bf16* XS, const bf16* BC, const float* DT, const float* LA, int m, int chx, int cb, int dh) {
    x.b0 = ld16(BC + (size_t)m * RW + cb); x.b1 = ld16(BC + (size_t)m * RW + cb + 8); x.c0 = ld16(BC + (size_t)m * RW + 1024 + cb); x.c1 = ld16(BC + (size_t)m * RW + 1024 + cb + 8);
    x.xs = XS[(size_t)m * RW + chx]; x.dt = DT[(size_t)m * 64 + dh]; x.la = LA[(size_t)m * 64 + dh];
}
__device__ __forceinline__ float ssd_step(float (&s)[16], const SIn& x) {
    float B0[8], B1[8], C0[8], C1[8]; unpack8(x.b0, B0); unpack8(x.b1, B1); unpack8(x.c0, C0); unpack8(x.c1, C1);
    const float dec = __expf(x.la), xdt = __uint_as_float(x.xs << 16) * x.dt; float y = 0.f;
#pragma unroll
    for (int e = 0; e < 8; ++e) { s[e] = dec * s[e] + xdt * B0[e]; y += s[e] * C0[e]; s[8 + e] = dec * s[8 + e] + xdt * B1[e]; y += s[8 + e] * C1[e]; }
    y = sum8(y);
    return y;
}
__device__ __forceinline__ void ph_ssd_scan(const Args& a) {
    const int lane = LANE, wave = WAVE;
    const bf16* XS = (const bf16*)(a.ws + WS_XS); const bf16* BC = (const bf16*)(a.ws + WS_BC); const float* DT = (const float*)(a.ws + WS_DT); const float* LA = (const float*)(a.ws + WS_LA);
    bf16* YS = (bf16*)a.out + (size_t)2 * MX * RW;
    for (int u = blockIdx.x; u < 256; u += gridDim.x) {
        const int g = u >> 5, h = u & 31, dir = g >> 2, b = g & 3;
        const int p = wave * 8 + (lane >> 3), nb = lane & 7, chx = h * 64 + p, cb = (h >> 2) * 128 + nb * 16, dh = dir * 32 + h;
        float s[16];
#pragma unroll
        for (int e = 0; e < 16; ++e) s[e] = 0.f;
        SIn A[4], B[4];
#pragma unroll
        for (int q = 0; q < 4; ++q) ssd_load(A[q], XS, BC, DT, LA, scan_row(q, dir, b), chx, cb, dh);
        for (int n0 = 0; n0 < NSTEP; n0 += 8) {
#pragma unroll
            for (int q = 0; q < 4; ++q) ssd_load(B[q], XS, BC, DT, LA, scan_row(n0 + 4 + q, dir, b), chx, cb, dh);
#pragma unroll
            for (int q = 0; q < 4; ++q) { const int n = n0 + q; const float y = ssd_step(s, A[q]);
                if (n >= CTXL && nb == 0) YS[((size_t)dir * MX + scan_row(n, dir, b)) * RW + chx] = (bf16)f2bf(y); }
            if (n0 + 8 < NSTEP) {
#pragma unroll
                for (int q = 0; q < 4; ++q) ssd_load(A[q], XS, BC, DT, LA, scan_row(n0 + 8 + q, dir, b), chx, cb, dh);
            }
#pragma unroll
            for (int q = 0; q < 4; ++q) { const int n = n0 + 4 + q; const float y = ssd_step(s, B[q]);
                if (n >= CTXL && nb == 0) YS[((size_t)dir * MX + scan_row(n, dir, b)) * RW + chx] = (bf16)f2bf(y); }
        }
    }
}

typedef short bf16x8_t __attribute__((ext_vector_type(8)));
typedef float f32x16 __attribute__((ext_vector_type(16)));
constexpr int SLD = 272;
constexpr int L_C = 0, L_B = 34816, L_BT = 69632, L_XT = 104448, L_S = 121856, L_F = 139264;
static_assert(L_F + 4 * 512 <= LDS_CTL, "ssd lds map");
typedef unsigned u32x4_t __attribute__((ext_vector_type(4)));
__device__ __forceinline__ void lds_st16(LAS unsigned char* p, const uint4& v) { *(LAS u32x4_t*)p = (u32x4_t){v.x, v.y, v.z, v.w}; }
__device__ __forceinline__ uint4 lds_ld16(const LAS unsigned char* p) { const u32x4_t t = *(const LAS u32x4_t*)p; return make_uint4(t[0], t[1], t[2], t[3]); }
__device__ __forceinline__ bf16x8_t lfrag(LAS unsigned char* img, int row, int k) { return *(LAS bf16x8_t*)(img + row * SLD + k * 2); }
__device__ __forceinline__ void ph_ssd_chunked(const Args& a, LAS unsigned char* lds) {
    const int tid = TID, lane = LANE, wave = WAVE, r = lane & 31, hh = lane >> 5;
    typedef unsigned u32x2_t __attribute__((ext_vector_type(2)));
    const bf16* XS = (const bf16*)(a.ws + WS_XS); const bf16* BC = (const bf16*)(a.ws + WS_BC); const float* DT = (const float*)(a.ws + WS_DT); const float* LA = (const float*)(a.ws + WS_LA);
    bf16* YS = (bf16*)a.out + (size_t)2 * MX * RW;
    LAS float* laS = (LAS float*)(lds + L_F); LAS float* dtS = laS + 128; LAS float* cumS = laS + 256;
    for (int u = blockIdx.x; u < 256; u += gridDim.x) {
        const int g = u >> 5, h = u & 31, dir = g >> 2, b = g & 3, gi = h >> 2;
        f32x16 st;
#pragma unroll
        for (int q = 0; q < 16; ++q) st[q] = 0.f;
        __syncthreads();
        for (int i = tid; i < 64 * SLD / 4; i += 512) ((LAS unsigned*)(lds + L_S))[i] = 0u;
        uint4 pB[4], pC[4], pX[2]; float pla = 0.f, pdt = 0.f;
        const int bl0 = 4 * (tid >> 4), bpc = tid & 15, xl0 = 2 * (tid >> 3), xpc = tid & 7;
#define SSD_FETCH2(cc) do { const int n0_ = (cc) * 128; const bool lat_ = (cc) >= CTXL / 128; \
            _Pragma("unroll") for (int k_ = 0; k_ < 4; ++k_) { const size_t m_ = (size_t)scan_row(n0_ + bl0 + k_, dir, b); \
                pB[k_] = ld16(BC + m_ * RW + gi * 128 + bpc * 8); if (lat_) pC[k_] = ld16(BC + m_ * RW + 1024 + gi * 128 + bpc * 8); } \
            _Pragma("unroll") for (int k_ = 0; k_ < 2; ++k_) { const size_t m_ = (size_t)scan_row(n0_ + xl0 + k_, dir, b); pX[k_] = ld16(XS + m_ * RW + h * 64 + xpc * 8); } \
            if (tid < 128) { const size_t m_ = (size_t)scan_row(n0_ + tid, dir, b); pla = LA[m_ * 64 + dir * 32 + h]; pdt = DT[m_ * 64 + dir * 32 + h]; } } while (0)
        SSD_FETCH2(0);
        for (int c = 0; c < NSTEP / 128; ++c) {
            const int n0 = c * 128; const bool lat = c >= CTXL / 128;
#pragma unroll
            for (int k = 0; k < 4; ++k) { lds_st16(lds + L_B + (bl0 + k) * SLD + bpc * 16, pB[k]); if (lat) lds_st16(lds + L_C + (bl0 + k) * SLD + bpc * 16, pC[k]); }
            { const unsigned w0[4] = {pX[0].x, pX[0].y, pX[0].z, pX[0].w}, w1[4] = {pX[1].x, pX[1].y, pX[1].z, pX[1].w};
#pragma unroll
              for (int e = 0; e < 8; ++e) { const unsigned lo = (e & 1) ? (w0[e >> 1] >> 16) : (w0[e >> 1] & 0xffffu), hi = (e & 1) ? (w1[e >> 1] & 0xffff0000u) : (w1[e >> 1] << 16);
                  *(LAS unsigned*)(lds + L_XT + (xpc * 8 + e) * SLD + xl0 * 2) = lo | hi; } }
            if (tid < 128) { laS[tid] = pla; dtS[tid] = pdt; }
            lds_barrier();
            if (wave == 0) { const float a0 = laS[2 * lane], b0 = laS[2 * lane + 1]; float x = a0 + b0;
#pragma unroll
                for (int d = 1; d < 64; d <<= 1) { const float y = __shfl_up(x, d); if (lane >= d) x += y; }
                cumS[2 * lane + 1] = x; cumS[2 * lane] = x - b0; }
            lds_barrier();
            const float ctot = cumS[127];
            { float wl[4]; float fb[4][8];
#pragma unroll
              for (int k = 0; k < 4; ++k) { wl[k] = dtS[bl0 + k] * __expf(ctot - cumS[bl0 + k]); unpack8(pB[k], fb[k]); }
#pragma unroll
              for (int e = 0; e < 8; ++e) *(LAS u32x2_t*)(lds + L_BT + (bpc * 8 + e) * SLD + bl0 * 2) = (u32x2_t){pk2(fb[0][e] * wl[0], fb[1][e] * wl[1]), pk2(fb[2][e] * wl[2], fb[3][e] * wl[3])}; }
            if (c + 1 < NSTEP / 128) SSD_FETCH2(c + 1);
            f32x16 acc0, acc1;
            const int lt = wave >> 1, st0 = 2 * (wave & 1);
            if (lat) {
#pragma unroll
                for (int q = 0; q < 16; ++q) { acc0[q] = 0.f; acc1[q] = 0.f; }
                if (st0 <= lt) {
#pragma unroll
                    for (int ks = 0; ks < 8; ++ks) { const bf16x8_t cf = lfrag(lds + L_C, lt * 32 + r, ks * 16 + 8 * hh);
                        acc0 = __builtin_amdgcn_mfma_f32_32x32x16_bf16(lfrag(lds + L_B, st0 * 32 + r, ks * 16 + 8 * hh), cf, acc0, 0, 0, 0);
                        if (st0 + 1 <= lt) acc1 = __builtin_amdgcn_mfma_f32_32x32x16_bf16(lfrag(lds + L_B, (st0 + 1) * 32 + r, ks * 16 + 8 * hh), cf, acc1, 0, 0, 0); }
                }
            }
            lds_barrier();
            if (lat) {
                const int l = lt * 32 + r; const float cl = cumS[l];
#pragma unroll
                for (int t = 0; t < 2; ++t) { const int stt = st0 + t;
                    if (stt <= lt) {
#pragma unroll
                        for (int gq = 0; gq < 4; ++gq) { const int s0 = stt * 32 + 8 * gq + 4 * hh; const f32x4 cs = *(const LAS f32x4*)(cumS + s0), ds = *(const LAS f32x4*)(dtS + s0); float o[4];
#pragma unroll
                            for (int e = 0; e < 4; ++e) { const float v = t ? acc1[4 * gq + e] : acc0[4 * gq + e]; o[e] = (s0 + e) <= l ? v * __expf(cl - cs[e]) * ds[e] : 0.f; }
                            *(LAS u32x2_t*)(lds + L_B + l * SLD + s0 * 2) = (u32x2_t){pk2(o[0], o[1]), pk2(o[2], o[3])}; } } }
            }
            lds_barrier();
            if (lat) {
                const int pt = wave & 1;
                f32x16 accd, acco;
#pragma unroll
                for (int q = 0; q < 16; ++q) { accd[q] = 0.f; acco[q] = 0.f; }
                for (int ks = 0; ks < 2 * (lt + 1); ++ks)
                    accd = __builtin_amdgcn_mfma_f32_32x32x16_bf16(lfrag(lds + L_XT, pt * 32 + r, ks * 16 + 8 * hh), lfrag(lds + L_B, lt * 32 + r, ks * 16 + 8 * hh), accd, 0, 0, 0);
#pragma unroll
                for (int ks = 0; ks < 8; ++ks)
                    acco = __builtin_amdgcn_mfma_f32_32x32x16_bf16(lfrag(lds + L_S, pt * 32 + r, ks * 16 + 8 * hh), lfrag(lds + L_C, lt * 32 + r, ks * 16 + 8 * hh), acco, 0, 0, 0);
                const int l = lt * 32 + r; const float el = __expf(cumS[l]);
                bf16* yrow = YS + ((size_t)dir * MX + scan_row(n0 + l, dir, b)) * RW + h * 64 + pt * 32;
#pragma unroll
                for (int gq = 0; gq < 4; ++gq) { float y[4];
#pragma unroll
                    for (int e = 0; e < 4; ++e) y[e] = accd[4 * gq + e] + el * acco[4 * gq + e];
                    *(uint2*)(yrow + 8 * gq + 4 * hh) = make_uint2(pk2(y[0], y[1]), pk2(y[2], y[3])); }
            }
            const int nt = wave >> 1, pt2 = wave & 1;
            { const float dc = __expf(ctot);
#pragma unroll
              for (int q = 0; q < 16; ++q) st[q] *= dc;
#pragma unroll
              for (int ks = 0; ks < 8; ++ks)
                  st = __builtin_amdgcn_mfma_f32_32x32x16_bf16(lfrag(lds + L_BT, nt * 32 + r, ks * 16 + 8 * hh), lfrag(lds + L_XT, pt2 * 32 + r, ks * 16 + 8 * hh), st, 0, 0, 0); }
            lds_barrier();
#pragma unroll
            for (int gq = 0; gq < 4; ++gq) *(LAS u32x2_t*)(lds + L_S + (pt2 * 32 + r) * SLD + (nt * 32 + 8 * gq + 4 * hh) * 2) = (u32x2_t){pk2(st[4 * gq], st[4 * gq + 1]), pk2(st[4 * gq + 2], st[4 * gq + 3])};
            lds_barrier();
        }
    }
}

constexpr int CR_T = 32, CR_PJ = 144, CR_PS = 80, CR_PF = 272;
constexpr int CR_AR = 0, CR_BK = CR_AR + 64 * CR_PJ, CR_BHT = CR_BK + 64 * CR_PJ, CR_KHT = CR_BHT + 64 * CR_PS, CR_VT = CR_KHT + 64 * CR_PS, CR_SB = CR_VT + 64 * CR_PS,
              CR_NAK = CR_SB + 2 * 64 * CR_PJ, CR_PBR = CR_NAK + 32 * CR_PS, CR_PKR = CR_PBR + 32 * CR_PS, CR_NABF = CR_PKR + 32 * CR_PS, CR_RT = CR_NABF + 32 * CR_PJ,
              CR_SA = CR_RT + 32 * CR_PF, CR_GT = CR_SA + 64 * CR_PS, CR_CP = CR_GT + 256, CR_OB = CR_CP + 16 * 256, CR_END = CR_OB + 32 * 128;
static_assert(CR_END <= 131072, "chunked rwkv lds map");
__device__ __forceinline__ f32x16 mfma32(const bf16x8_t& a, const bf16x8_t& b, const f32x16& c) { return __builtin_amdgcn_mfma_f32_32x32x16_bf16(a, b, c, 0, 0, 0); }
__device__ __forceinline__ bf16x8_t cfrag(const LAS unsigned char* img, int pitch, int row, int k) { return *(const LAS bf16x8_t*)(img + row * pitch + k * 2); }
struct CRaw { unsigned r[2], k[2], kk[2], w[2], al[2], v[2]; };
__device__ __forceinline__ void cr_load(CRaw& x, const bf16* R, const bf16* K, const bf16* V, const bf16* KK, const bf16* LR, int n0, int dir, int b, int chn) {
#pragma unroll
    for (int u = 0; u < 2; ++u) { const size_t m = (size_t)scan_row(n0 + u, dir, b);
        x.r[u] = *(const unsigned*)(R + m * RW + chn); x.k[u] = *(const unsigned*)(K + m * RW + chn); x.kk[u] = *(const unsigned*)(KK + m * RW + chn); x.v[u] = *(const unsigned*)(V + m * RW + chn);
        x.w[u] = *(const unsigned*)(LR + m * NLR + dir * 2048 + chn); x.al[u] = *(const unsigned*)(LR + m * NLR + 4096 + dir * 2048 + chn); }
}
__device__ __forceinline__ void ph_rwkv_chunked(const Args& a, LAS unsigned char* lds) {
    const int tid = TID, lane = LANE, wave = WAVE, r = lane & 31, hh = lane >> 5;
    const bf16* R = (const bf16*)(a.ws + WS_R); const bf16* K = (const bf16*)(a.ws + WS_K); const bf16* V = (const bf16*)(a.ws + WS_V); const bf16* KK = (const bf16*)(a.ws + WS_KK);
    const bf16* LR = (const bf16*)(a.ws + WS_LR); bf16* OR = (bf16*)a.out;
    constexpr int NCH = NSTEP / CR_T;
    LAS float* GT = (LAS float*)(lds + CR_GT); LAS float* CP = (LAS float*)(lds + CR_CP);
    for (int u0 = blockIdx.x; u0 < 256; u0 += gridDim.x) {
        const int g = u0 >> 5, h = u0 & 31, dir = g >> 2, b = g & 3;
        const int jp = lane & 31, sh2 = lane >> 5, chn = h * 64 + 2 * jp, tq = 2 * wave + sh2;
        const float ka0 = a.in[I_KA][chn], ka1 = a.in[I_KA][chn + 1];
        f32x16 st;
#pragma unroll
        for (int q = 0; q < 16; ++q) st[q] = 0.f;
        __syncthreads();
        for (int i = tid; i < 64 * CR_PJ / 4; i += 512) ((LAS unsigned*)(lds + CR_SB))[i] = 0u;
        CRaw raw; cr_load(raw, R, K, V, KK, LR, 2 * tq, dir, b, chn);
        for (int c = 0; c < NCH; ++c) {
            const bool lat = c >= CTXL / CR_T;
            const LAS unsigned char* SBc = lds + CR_SB + (c & 1) * 64 * CR_PJ; LAS unsigned char* SBn = lds + CR_SB + ((c + 1) & 1) * 64 * CR_PJ;
            float rv[2][2], kd[2][2], bv[2][2], av[2][2], vv[2][2], cl[2][2], cx[2][2];
            { float run0 = 1.f, run1 = 1.f;
#pragma unroll
              for (int u = 0; u < 2; ++u) {
                  const float kk0 = bflo(raw.kk[u]), kk1 = bfhi(raw.kk[u]), al0 = bflo(raw.al[u]), al1 = bfhi(raw.al[u]);
                  rv[u][0] = bflo(raw.r[u]); rv[u][1] = bfhi(raw.r[u]); vv[u][0] = bflo(raw.v[u]); vv[u][1] = bfhi(raw.v[u]);
                  av[u][0] = -kk0; av[u][1] = -kk1; bv[u][0] = kk0 * al0; bv[u][1] = kk1 * al1;
                  kd[u][0] = bflo(raw.k[u]) * (1.f + (al0 - 1.f) * ka0); kd[u][1] = bfhi(raw.k[u]) * (1.f + (al1 - 1.f) * ka1);
                  cx[u][0] = run0; cx[u][1] = run1; run0 *= 1.f - bflo(raw.w[u]); run1 *= 1.f - bfhi(raw.w[u]); cl[u][0] = run0; cl[u][1] = run1; }
              *(LAS f32x2_t*)(lds + CR_CP + (tq * 64 + 2 * jp) * 4) = (f32x2_t){run0, run1}; }
            if (c + 1 < NCH) cr_load(raw, R, K, V, KK, LR, (c + 1) * CR_T + 2 * tq, dir, b, chn);
            lds_barrier();
            { float pre0 = 1.f, pre1 = 1.f, tot0 = 1.f, tot1 = 1.f;
#pragma unroll
              for (int q = 0; q < 16; ++q) { const f32x2_t x = *(const LAS f32x2_t*)(lds + CR_CP + (q * 64 + 2 * jp) * 4); tot0 *= x[0]; tot1 *= x[1]; if (q < tq) { pre0 *= x[0]; pre1 *= x[1]; } }
              if (tq == 0) *(LAS f32x2_t*)(lds + CR_GT + 2 * jp * 4) = (f32x2_t){tot0, tot1};
              unsigned bh[2], kh[2], vt[2];
              float tb[2][2], tk[2][2];
#pragma unroll
              for (int u = 0; u < 2; ++u) { const int t = 2 * tq + u;
                  const float g0 = pre0 * cl[u][0], g1 = pre1 * cl[u][1], gp0 = pre0 * cx[u][0], gp1 = pre1 * cx[u][1];
                  const float i0 = __builtin_amdgcn_rcpf(g0), i1 = __builtin_amdgcn_rcpf(g1);
                  *(LAS unsigned*)(lds + CR_AR + t * CR_PJ + jp * 4) = pg8::cvt_pk_bf16(av[u][0] * gp0, av[u][1] * gp1);
                  *(LAS unsigned*)(lds + CR_AR + (32 + t) * CR_PJ + jp * 4) = pg8::cvt_pk_bf16(rv[u][0] * g0, rv[u][1] * g1);
                  *(LAS unsigned*)(lds + CR_BK + t * CR_PJ + jp * 4) = pg8::cvt_pk_bf16(bv[u][0] * i0, bv[u][1] * i1);
                  *(LAS unsigned*)(lds + CR_BK + (32 + t) * CR_PJ + jp * 4) = pg8::cvt_pk_bf16(kd[u][0] * i0, kd[u][1] * i1);
                  tb[u][0] = bv[u][0] * (tot0 * i0); tb[u][1] = bv[u][1] * (tot1 * i1); tk[u][0] = kd[u][0] * (tot0 * i0); tk[u][1] = kd[u][1] * (tot1 * i1); }
#pragma unroll
              for (int ch = 0; ch < 2; ++ch) { bh[ch] = pg8::cvt_pk_bf16(tb[0][ch], tb[1][ch]); kh[ch] = pg8::cvt_pk_bf16(tk[0][ch], tk[1][ch]); vt[ch] = pg8::cvt_pk_bf16(vv[0][ch], vv[1][ch]);
                  *(LAS unsigned*)(lds + CR_BHT + (2 * jp + ch) * CR_PS + tq * 4) = bh[ch]; *(LAS unsigned*)(lds + CR_KHT + (2 * jp + ch) * CR_PS + tq * 4) = kh[ch]; *(LAS unsigned*)(lds + CR_VT + (2 * jp + ch) * CR_PS + tq * 4) = vt[ch]; } }
            lds_barrier();
            f32x16 acc;
#pragma unroll
            for (int q = 0; q < 16; ++q) acc[q] = 0.f;
            if (wave < 4) {
                const int rb = wave >> 1, cb = wave & 1;
#pragma unroll
                for (int ks = 0; ks < 4; ++ks) acc = mfma32(cfrag(lds + CR_BK, CR_PJ, 32 * rb + r, 16 * ks + 8 * hh), cfrag(lds + CR_AR, CR_PJ, 32 * cb + r, 16 * ks + 8 * hh), acc);
#pragma unroll
                for (int gq = 0; gq < 4; ++gq) { float o[4];
#pragma unroll
                    for (int e = 0; e < 4; ++e) { const int sidx = 8 * gq + 4 * hh + e; const bool keep = cb ? (sidx <= r) : (sidx < r); o[e] = keep ? acc[4 * gq + e] : 0.f; }
                    if (wave == 0) {
#pragma unroll
                        for (int e = 0; e < 4; ++e) *(LAS float*)(lds + CR_NABF + r * CR_PJ + (e * 8 + 2 * gq + hh) * 4) = o[e]; }
                    else { LAS unsigned char* dst = lds + (wave == 1 ? CR_PBR : wave == 2 ? CR_NAK : CR_PKR) + r * CR_PS + (8 * gq + 4 * hh) * 2;
                        typedef unsigned u32x2_t __attribute__((ext_vector_type(2))); *(LAS u32x2_t*)dst = (u32x2_t){pk2(o[0], o[1]), pk2(o[2], o[3])}; } }
            } else if (wave < 6 || lat) {
                const int it = wave & 1, cb = wave >> 1 & 1 ? 32 : 0;
#pragma unroll
                for (int ks = 0; ks < 4; ++ks) acc = mfma32(cfrag(SBc, CR_PJ, 32 * it + r, 16 * ks + 8 * hh), cfrag(lds + CR_AR, CR_PJ, cb + r, 16 * ks + 8 * hh), acc);
            }
            lds_barrier();
            if (wave >= 4 && (wave < 6 || lat)) {
                const int it = wave & 1; const LAS unsigned char* NT = lds + (wave < 6 ? CR_NAK : CR_PKR);
#pragma unroll
                for (int ks = 0; ks < 2; ++ks) acc = mfma32(cfrag(lds + CR_VT, CR_PS, 32 * it + r, 16 * ks + 8 * hh), cfrag(NT, CR_PS, r, 16 * ks + 8 * hh), acc);
                if (wave < 6) {
#pragma unroll
                    for (int gq = 0; gq < 4; ++gq) *(LAS f32x4*)(lds + CR_RT + r * CR_PF + (32 * it + 8 * gq + 4 * hh) * 4) = (f32x4){acc[4 * gq], acc[4 * gq + 1], acc[4 * gq + 2], acc[4 * gq + 3]};
                }
            }
            lds_barrier();
            if (wave < 4) {
                const int q = lane & 3, irow = 16 * wave + (lane >> 2);
                const LAS unsigned char* nrow = lds + CR_NABF + q * 32; const LAS unsigned char* rcol = lds + CR_RT + irow * 4;
                float mysa[8];
#pragma unroll
                for (int u = 0; u < 8; ++u) mysa[u] = 0.f;
                f32x4 NA[34], NB[34]; float RH[34];
#pragma unroll
                for (int t = 0; t < 2; ++t) { NA[t] = *(const LAS f32x4*)(nrow + t * CR_PJ); NB[t] = NA[t]; RH[t] = *(const LAS float*)(rcol + t * CR_PF); }
#pragma unroll
                for (int t = 0; t < 32; ++t) {
                    if (t + 2 < 32) { NA[t + 2] = *(const LAS f32x4*)(nrow + (t + 2) * CR_PJ); if (t + 2 > 16) NB[t + 2] = *(const LAS f32x4*)(nrow + (t + 2) * CR_PJ + 16); RH[t + 2] = *(const LAS float*)(rcol + (t + 2) * CR_PF); }
                    asm volatile("" ::: "memory");
                    float p0 = 0.f, p1 = 0.f;
#pragma unroll
                    for (int u = 0; u < 4; ++u) if (u < (t + 3) / 4) { if (u & 1) p1 += mysa[u] * NA[t][u]; else p0 += mysa[u] * NA[t][u]; }
#pragma unroll
                    for (int u = 4; u < 8; ++u) if (u < (t + 3) / 4) { if (u & 1) p1 += mysa[u] * NB[t][u - 4]; else p0 += mysa[u] * NB[t][u - 4]; }
                    float part = p0 + p1;
                    part += dppf<0xB1>(part); part += dppf<0x4E>(part);
                    const float x = RH[t] + part;
                    mysa[t >> 2] = (q == (t & 3)) ? x : mysa[t >> 2];
                    asm volatile("" : "+v"(mysa[t >> 2]));
                }
#pragma unroll
                for (int u = 0; u < 8; ++u) *(LAS bf16*)(lds + CR_SA + irow * CR_PS + (4 * u + q) * 2) = (bf16)f2bf(mysa[u]);
            }
            lds_barrier();
            if (wave < 4) {
                const int jt = wave >> 1, it = wave & 1;
#pragma unroll
                for (int gq = 0; gq < 4; ++gq) { const f32x4 gv = *(LAS f32x4*)(lds + CR_GT + (32 * jt + 8 * gq + 4 * hh) * 4);
#pragma unroll
                    for (int e = 0; e < 4; ++e) st[4 * gq + e] *= gv[e]; }
#pragma unroll
                for (int ks = 0; ks < 2; ++ks) { st = mfma32(cfrag(lds + CR_BHT, CR_PS, 32 * jt + r, 16 * ks + 8 * hh), cfrag(lds + CR_SA, CR_PS, 32 * it + r, 16 * ks + 8 * hh), st);
                    st = mfma32(cfrag(lds + CR_KHT, CR_PS, 32 * jt + r, 16 * ks + 8 * hh), cfrag(lds + CR_VT, CR_PS, 32 * it + r, 16 * ks + 8 * hh), st); }
#pragma unroll
                for (int gq = 0; gq < 4; ++gq) { typedef unsigned u32x2_t __attribute__((ext_vector_type(2)));
                    *(LAS u32x2_t*)(SBn + (32 * it + r) * CR_PJ + (32 * jt + 8 * gq + 4 * hh) * 2) = (u32x2_t){pk2(st[4 * gq], st[4 * gq + 1]), pk2(st[4 * gq + 2], st[4 * gq + 3])}; }
            } else if (wave >= 6 && lat) {
                const int it = wave & 1;
#pragma unroll
                for (int ks = 0; ks < 2; ++ks) acc = mfma32(cfrag(lds + CR_SA, CR_PS, 32 * it + r, 16 * ks + 8 * hh), cfrag(lds + CR_PBR, CR_PS, r, 16 * ks + 8 * hh), acc);
#pragma unroll
                for (int gq = 0; gq < 4; ++gq) { typedef unsigned u32x2_t __attribute__((ext_vector_type(2)));
                    *(LAS u32x2_t*)(lds + CR_OB + r * 128 + (32 * it + 8 * gq + 4 * hh) * 2) = (u32x2_t){pk2(acc[4 * gq], acc[4 * gq + 1]), pk2(acc[4 * gq + 2], acc[4 * gq + 3])}; }
            }
            lds_barrier();
            if (lat) { const int ss = tid >> 4, cgp = tid & 15; typedef unsigned u32x2_t __attribute__((ext_vector_type(2)));
                const u32x2_t ov = *(const LAS u32x2_t*)(lds + CR_OB + ss * 128 + cgp * 8);
                *(uint2*)(OR + ((size_t)dir * MX + scan_row(c * CR_T + ss, dir, b)) * RW + h * 64 + cgp * 4) = make_uint2(ov[0], ov[1]); }
        }
    }
}

constexpr int FL_LNW = 0, FL_LNB = 8192, FL_KA = 16384, FL_RK = 24576, FL_NW = 32768, FL_D = 40960;
__device__ __forceinline__ void ph_finish(const Args& a, LAS unsigned char* lds) {
    const int lane = LANE, tid = TID;
    const bf16* R = (const bf16*)(a.ws + WS_R); const bf16* K = (const bf16*)(a.ws + WS_K); const bf16* V = (const bf16*)(a.ws + WS_V);
    const bf16* LR = (const bf16*)(a.ws + WS_LR); const bf16* XS = (const bf16*)(a.ws + WS_XS); const bf16* Z = (const bf16*)(a.ws + WS_Z);
    const bf16* OR = (const bf16*)a.out; const bf16* YS = (const bf16*)a.out + (size_t)2 * MX * RW;
    bf16* A2 = (bf16*)(a.ws + WS_A2);
    __syncthreads();
    for (int i = tid; i < RW; i += 512) { ((LAS float*)(lds + FL_LNW))[i] = a.in[I_LNW][i]; ((LAS float*)(lds + FL_LNB))[i] = a.in[I_LNB][i]; ((LAS float*)(lds + FL_KA))[i] = a.in[I_KA][i];
        ((LAS float*)(lds + FL_RK))[i] = a.in[I_RK][i]; ((LAS float*)(lds + FL_NW))[i] = a.in[I_NORMW][i]; }
    if (tid < 32) ((LAS float*)(lds + FL_D))[tid] = a.in[I_SSMD][tid];
    __syncthreads();
    for (int m = GW; m < MX; m += NGW) {
        uint4 q[2][8];
#define FIN_LOAD(buf, it) do { const int c0_ = (lane + 64 * ((it) & 3)) * 8; \
            if ((it) < 4) { q[buf][0] = ld16(OR + (size_t)m * RW + c0_); q[buf][1] = ld16(OR + ((size_t)MX + m) * RW + c0_); q[buf][2] = ld16(R + (size_t)m * RW + c0_); q[buf][3] = ld16(K + (size_t)m * RW + c0_); \
                q[buf][4] = ld16(V + (size_t)m * RW + c0_); q[buf][5] = ld16(LR + (size_t)m * NLR + 4096 + c0_); q[buf][6] = ld16(LR + (size_t)m * NLR + 6144 + c0_); q[buf][7] = ld16(LR + (size_t)m * NLR + 8192 + c0_); } \
            else { q[buf][0] = ld16(YS + (size_t)m * RW + c0_); q[buf][1] = ld16(YS + ((size_t)MX + m) * RW + c0_); q[buf][2] = ld16(XS + (size_t)m * RW + c0_); q[buf][3] = ld16(Z + (size_t)m * RW + c0_); } } while (0)
        FIN_LOAD(0, 0);
#pragma unroll
        for (int it = 0; it < 8; ++it) {
            const int cb = it & 1, c0 = (lane + 64 * (it & 3)) * 8;
            if (it + 1 < 8) { if (cb) FIN_LOAD(0, it + 1); else FIN_LOAD(1, it + 1); }
            asm volatile("" ::: "memory");
            if (it < 4) {
                float of[8], ob[8], o[8], res[8];
#if MK_SKIP_RWKV
#pragma unroll
                for (int e = 0; e < 8; ++e) res[e] = 0.f;
#else
                unpack8(q[cb][0], of); unpack8(q[cb][1], ob);
                float sm = 0.f;
#pragma unroll
                for (int e = 0; e < 8; ++e) { o[e] = of[e] + ob[e]; sm += o[e]; }
                sm = sum8(sm);
                const float mean = sm * (1.f / 64.f); float sq = 0.f;
#pragma unroll
                for (int e = 0; e < 8; ++e) { o[e] -= mean; sq += o[e] * o[e]; }
                sq = sum8(sq);
                const float rstd = rsqrtf(sq * (1.f / 64.f) + GN_EPS);
                float lw[8], lb[8], r[8], k[8], v[8], a0[8], a1[8], ka[8], rk[8], gg[8];
                ldf8s((const LAS float*)(lds + FL_LNW) + c0, lw); ldf8s((const LAS float*)(lds + FL_LNB) + c0, lb); ldf8s((const LAS float*)(lds + FL_KA) + c0, ka); ldf8s((const LAS float*)(lds + FL_RK) + c0, rk);
                unpack8(q[cb][2], r); unpack8(q[cb][3], k); unpack8(q[cb][4], v); unpack8(q[cb][5], a0); unpack8(q[cb][6], a1); unpack8(q[cb][7], gg);
                float bs = 0.f;
#pragma unroll
                for (int e = 0; e < 8; ++e) { const float kd = k[e] * (2.f + (a0[e] + a1[e] - 2.f) * ka[e]); bs += r[e] * kd * rk[e]; }
                bs = sum8(bs);
#pragma unroll
                for (int e = 0; e < 8; ++e) res[e] = (o[e] * rstd * lw[e] + lb[e] + bs * v[e]) * gg[e];
#endif
                st16(A2 + (size_t)m * DM + c0, pack8(res));
            } else {
                float yf[8], yb[8], xs[8], z[8], nw[8], y[8];
#if MK_SKIP_SSD
#pragma unroll
                for (int e = 0; e < 8; ++e) y[e] = 0.f;
#else
                unpack8(q[cb][0], yf); unpack8(q[cb][1], yb); unpack8(q[cb][2], xs); unpack8(q[cb][3], z); ldf8s((const LAS float*)(lds + FL_NW) + c0, nw);
                const float dsk = ((const LAS float*)(lds + FL_D))[c0 >> 6]; float ss = 0.f;
#pragma unroll
                for (int e = 0; e < 8; ++e) { y[e] = (yf[e] + yb[e] + dsk * xs[e]) * (z[e] / (1.f + __expf(-z[e]))); ss += y[e] * y[e]; }
                ss = sum32(ss);
                const float rstd = rsqrtf(ss * (1.f / 256.f) + RMS_EPS);
#pragma unroll
                for (int e = 0; e < 8; ++e) y[e] = y[e] * rstd * nw[e];
#endif
                st16(A2 + (size_t)m * DM + 2048 + c0, pack8(y));
            }
        }
    }
}

__device__ __forceinline__ float enc_key(float v, int idx) { return __uint_as_float((__float_as_uint(v) & 0xffffff00u) | (unsigned)idx); }
typedef float f32x32_t __attribute__((ext_vector_type(32)));
typedef unsigned u32x6_t __attribute__((ext_vector_type(6)));
typedef float f32x2 __attribute__((ext_vector_type(2)));
struct Fp6Row { uint4 q0, q1, q2; float rs; };
template <bool FP4> __device__ __forceinline__ Fp6Row ld_row(const unsigned char* tab, const float* rsc, int e, int l16, int lane) {
    Fp6Row r; r.rs = FP4 ? 1.f : rsc[e];
    if (FP4) { const unsigned char* p = tab + (size_t)e * 2304; r.q0 = *(const uint4*)(p + l16); r.q1 = *(const uint4*)(p + 1024 + l16); r.q2 = make_uint4(*(const unsigned*)(p + 2048 + 4 * lane), 0u, 0u, 0u); }
    else { const unsigned char* p = tab + (size_t)e * 3072 + l16; r.q0 = *(const uint4*)p; r.q1 = *(const uint4*)(p + 1024); r.q2 = *(const uint4*)(p + 2048); }
    return r;
}
__device__ __forceinline__ f32x32_t fp6_unpack(const Fp6Row& r, int p, float one) {
    u32x6_t s; if (p == 0) { s[0] = r.q0.x; s[1] = r.q0.y; s[2] = r.q0.z; s[3] = r.q0.w; s[4] = r.q1.x; s[5] = r.q1.y; } else { s[0] = r.q1.z; s[1] = r.q1.w; s[2] = r.q2.x; s[3] = r.q2.y; s[4] = r.q2.z; s[5] = r.q2.w; }
    return __builtin_amdgcn_cvt_scalef32_pk32_f32_fp6(s, one);
}
template <bool FP4> __device__ __forceinline__ f32x32_t row_unpack(const Fp6Row& r, int p, float one, float& sc) {
    if (!FP4) { sc = 1.f; return fp6_unpack(r, p, one); }
    const uint4 q = p ? r.q1 : r.q0; const unsigned w[4] = {q.x, q.y, q.z, q.w}; f32x32_t f;
#pragma unroll
    for (int d = 0; d < 4; ++d)
        { const f32x2 t0 = __builtin_amdgcn_cvt_scalef32_pk_f32_fp4(w[d], one, 0), t1 = __builtin_amdgcn_cvt_scalef32_pk_f32_fp4(w[d], one, 1), t2 = __builtin_amdgcn_cvt_scalef32_pk_f32_fp4(w[d], one, 2), t3 = __builtin_amdgcn_cvt_scalef32_pk_f32_fp4(w[d], one, 3);
          f[8 * d] = t0.x; f[8 * d + 1] = t0.y; f[8 * d + 2] = t1.x; f[8 * d + 3] = t1.y; f[8 * d + 4] = t2.x; f[8 * d + 5] = t2.y; f[8 * d + 6] = t3.x; f[8 * d + 7] = t3.y; }
    sc = p ? bfhi(r.q2.x) : bflo(r.q2.x);
    return f;
}
__device__ __forceinline__ void fp4_unpack8(unsigned w, float one, float (&f)[8]) {
    const f32x2 t0 = __builtin_amdgcn_cvt_scalef32_pk_f32_fp4(w, one, 0), t1 = __builtin_amdgcn_cvt_scalef32_pk_f32_fp4(w, one, 1), t2 = __builtin_amdgcn_cvt_scalef32_pk_f32_fp4(w, one, 2), t3 = __builtin_amdgcn_cvt_scalef32_pk_f32_fp4(w, one, 3);
    f[0] = t0.x; f[1] = t0.y; f[2] = t1.x; f[3] = t1.y; f[4] = t2.x; f[5] = t2.y; f[6] = t3.x; f[7] = t3.y;
}
#define PIN4(a) asm volatile("" : "+v"((a)[0]), "+v"((a)[1]), "+v"((a)[2]), "+v"((a)[3]))
__device__ __forceinline__ void ph_peer(const Args& a, float* outp) {
    const int lane = LANE; constexpr bool UF4 = MK_PEER_FP4 >= 2, VF4 = MK_PEER_FP4 >= 1; constexpr int URING = UF4 ? 3 : 2, VRING = VF4 ? 3 : 2;
    const float* mod = (const float*)(a.ws + WS_MOD); const float* S = (const float*)(a.ws + WS_S);
    const unsigned char* U8 = (const unsigned char*)(a.ws + WS_U8); const unsigned char* V8 = (const unsigned char*)(a.ws + WS_V8);
    const float* USC = (const float*)(a.ws + WS_USC); const float* VSC = (const float*)(a.ws + WS_VSC);
    for (int m = GW; m < MX; m += NGW) {
        const int bb = m / SEQ;
        float* hrow = a.out + (size_t)m * DM;
        int l4 = lane * 4; asm volatile("" : "+v"(l4));
        float acc[16][4];
#if MK_SKIP_PEER
#pragma unroll
        for (int j = 0; j < 16; ++j)
#pragma unroll
            for (int e = 0; e < 4; ++e) acc[j][e] = 0.f;
#else
        float xn[16][4];
        { float ss = 0.f;
#pragma unroll
          for (int j = 0; j < 16; ++j) { const float4 h4 = *(const float4*)(hrow + 256 * j + l4); xn[j][0] = h4.x; xn[j][1] = h4.y; xn[j][2] = h4.z; xn[j][3] = h4.w; ss += (h4.x * h4.x + h4.y * h4.y) + (h4.z * h4.z + h4.w * h4.w); }
          const float rstd = rsqrtf(wave_sum(ss) * (1.f / DM) + RMS_EPS);
          const float* sh2 = mod + (size_t)bb * NMOD + 3 * DM; const float* sc2 = mod + (size_t)bb * NMOD + 4 * DM; const float* g2 = a.in[I_N2G];
#pragma unroll
          for (int j = 0; j < 16; ++j) { const int c = 256 * j + l4; const float4 gg = *(const float4*)(g2 + c), s0 = *(const float4*)(sh2 + c), s1 = *(const float4*)(sc2 + c);
              xn[j][0] = xn[j][0] * rstd * gg.x * (1.f + s1.x) + s0.x; xn[j][1] = xn[j][1] * rstd * gg.y * (1.f + s1.y) + s0.y; xn[j][2] = xn[j][2] * rstd * gg.z * (1.f + s1.z) + s0.z; xn[j][3] = xn[j][3] * rstd * gg.w * (1.f + s1.w) + s0.w;
              if ((j & 3) == 3) { PIN4(xn[j - 3]); PIN4(xn[j - 2]); PIN4(xn[j - 1]); PIN4(xn[j]); asm volatile("" ::: "memory"); } } }
        int eid0 = 0, eid1 = 0; float gt0 = 0.f, gt1 = 0.f;
        const float NEG = -3.0e38f;
        float c1a[8], c1b[8], c2a[8], c2b[8], t1[8], t2[8];
        int lsc = lane; asm volatile("" : "+v"(lsc));
#pragma unroll
        for (int hd = 0; hd < 8; ++hd) { const float* sr = S + (size_t)m * 2048 + hd * 256 + lsc;
            c1a[hd] = enc_key(sr[0], lane); c1b[hd] = enc_key(sr[64], 64 + lane); c2a[hd] = enc_key(sr[128], lane); c2b[hd] = enc_key(sr[192], 64 + lane); t1[hd] = NEG; t2[hd] = NEG; }
#pragma unroll 1
        for (int k = 0; k < 16; ++k) {
#pragma unroll
            for (int hd = 0; hd < 8; ++hd) {
                const float m1 = wave_max(fmaxf(c1a[hd], c1b[hd])), m2 = wave_max(fmaxf(c2a[hd], c2b[hd]));
                if (c1a[hd] == m1) c1a[hd] = NEG; if (c1b[hd] == m1) c1b[hd] = NEG; if (c2a[hd] == m2) c2a[hd] = NEG; if (c2b[hd] == m2) c2b[hd] = NEG;
                if (lane == k) { t1[hd] = m1; t2[hd] = m2; }
            }
        }
        float cd[8][4], best[8]; int i1[8], i2[8], ex[8];
#pragma unroll
        for (int hd = 0; hd < 8; ++hd) {
            const float v1 = __uint_as_float(__float_as_uint(t1[hd]) & 0xffffff00u), v2 = __uint_as_float(__float_as_uint(t2[hd]) & 0xffffff00u);
            i1[hd] = (int)(__float_as_uint(t1[hd]) & 0xffu); i2[hd] = (int)(__float_as_uint(t2[hd]) & 0xffu);
#pragma unroll
            for (int e = 0; e < 4; ++e) { const float va = __shfl(v1, (lsc >> 4) + 4 * e), vb = __shfl(v2, lsc & 15); cd[hd][e] = enc_key(va + vb, lane + 64 * e); }
            best[hd] = NEG; ex[hd] = 0;
        }
#pragma unroll 1
        for (int k = 0; k < 16; ++k) {
#pragma unroll
            for (int hd = 0; hd < 8; ++hd) {
                const float mx = wave_max(fmaxf(fmaxf(cd[hd][0], cd[hd][1]), fmaxf(cd[hd][2], cd[hd][3])));
#pragma unroll
                for (int e = 0; e < 4; ++e) if (cd[hd][e] == mx) cd[hd][e] = NEG;
                const int cidx = (int)(__float_as_uint(mx) & 0xffu);
                const int ea = __shfl(i1[hd], cidx >> 4), eb = __shfl(i2[hd], cidx & 15);
                if (lane == k) { best[hd] = __uint_as_float(__float_as_uint(mx) & 0xffffff00u); ex[hd] = ea * 128 + eb; }
            }
        }
#pragma unroll
        for (int hd = 0; hd < 8; ++hd) {
            const float bmax = __shfl(best[hd], 0);
            const float pe = lane < 16 ? __expf(best[hd] - bmax) : 0.f;
            const float gate = pe / wave_sum(pe);
            const float gsh = __shfl(gate, lsc & 15); const int esh = __shfl(ex[hd], lsc & 15);
            if ((lsc >> 4) == (hd & 3)) { if (hd < 4) { gt0 = gsh; eid0 = esh; } else { gt1 = gsh; eid1 = esh; } }
        }
        const int l48 = lane * 16;
        float cf0 = 0.f, cf1 = 0.f;
#define PEER_EID(pp) __builtin_amdgcn_readlane((pp) < 64 ? eid0 : eid1, (pp) & 63)
#define PEER_FETCH(buf, pbase, TAB, F4) do { _Pragma("unroll") for (int q2 = 0; q2 < 4; ++q2) { const int e_ = PEER_EID((pbase) + q2); buf[q2] = ld_row<F4>(TAB, (TAB) == U8 ? USC : VSC, e_, l48, lane); } } while (0)
        {
            Fp6Row r0[4], r1[4], r2[4];
            PEER_FETCH(r0, 0, U8, UF4); if (URING == 3) PEER_FETCH(r1, 4, U8, UF4);
#pragma unroll 1
            for (int p0 = 0; p0 < 128; p0 += 4 * URING) {
#pragma unroll
                for (int gsel = 0; gsel < URING; ++gsel) {
                    const int pb = p0 + 4 * gsel;
                    if (pb < 128) {
                        asm volatile("" ::: "memory");
                        if (URING == 3) { if (pb + 8 < 128) { if (gsel == 0) PEER_FETCH(r2, pb + 8, U8, UF4); else if (gsel == 1) PEER_FETCH(r0, pb + 8, U8, UF4); else PEER_FETCH(r1, pb + 8, U8, UF4); } }
                        else { if (pb + 4 < 128) { if (gsel == 0) PEER_FETCH(r1, pb + 4, U8, UF4); else PEER_FETCH(r0, pb + 4, U8, UF4); } }
                        float d[4];
#pragma unroll
                        for (int q = 0; q < 4; ++q) {
                            float dd = 0.f;
#pragma unroll
                            for (int p = 0; p < 2; ++p) { const Fp6Row& rr = gsel == 0 ? r0[q] : gsel == 1 ? r1[q] : r2[q];
                                if (UF4) { const uint4 qq = p ? rr.q1 : rr.q0; const unsigned wq[4] = {qq.x, qq.y, qq.z, qq.w}; float dp = 0.f;
#pragma unroll
                                    for (int dw = 0; dw < 4; ++dw) { float one = 1.0f; asm volatile("" : "+v"(one)); float f8[8]; fp4_unpack8(wq[dw], one, f8);
#pragma unroll
                                        for (int t = 0; t < 8; ++t) dp += xn[8 * p + 2 * dw + (t >> 2)][t & 3] * f8[t];
                                        asm volatile("" : "+v"(dp)); }
                                    dd += dp * (p ? bfhi(rr.q2.x) : bflo(rr.q2.x));
                                } else { float one = 1.0f; asm volatile("" : "+v"(one)); float bsc; const f32x32_t f = row_unpack<UF4>(rr, p, one, bsc);
                                    float dp = 0.f;
#pragma unroll
                                    for (int t = 0; t < 32; ++t) dp += xn[8 * p + (t >> 2)][t & 3] * f[t];
                                    dd += dp * bsc; }
                                asm volatile("" : "+v"(dd)); }
                            d[q] = dd;
                        }
#pragma unroll
                        for (int q = 0; q < 4; ++q) {
                            const int p = pb + q;
                            const float dot = wave_sum(d[q]) * (gsel == 0 ? r0[q].rs : gsel == 1 ? r1[q].rs : r2[q].rs);
                            const float act = 0.5f * dot * (1.f + erff(dot * 0.70710678f));
                            if (lane == (p & 63)) { if (pb < 64) cf0 = gt0 * act; else cf1 = gt1 * act; }
                        }
                    }
                }
            }
        }
#pragma unroll
        for (int j = 0; j < 16; ++j)
#pragma unroll
            for (int e = 0; e < 4; ++e) acc[j][e] = 0.f;
        {
            Fp6Row r0[4], r1[4], r2[4];
            PEER_FETCH(r0, 0, V8, VF4); if (VRING == 3) PEER_FETCH(r1, 4, V8, VF4);
#pragma unroll 1
            for (int p0 = 0; p0 < 128; p0 += 4 * VRING) {
#pragma unroll
                for (int gsel = 0; gsel < VRING; ++gsel) {
                    const int pb = p0 + 4 * gsel;
                    if (pb < 128) {
                        asm volatile("" ::: "memory");
                        if (VRING == 3) { if (pb + 8 < 128) { if (gsel == 0) PEER_FETCH(r2, pb + 8, V8, VF4); else if (gsel == 1) PEER_FETCH(r0, pb + 8, V8, VF4); else PEER_FETCH(r1, pb + 8, V8, VF4); } }
                        else { if (pb + 4 < 128) { if (gsel == 0) PEER_FETCH(r1, pb + 4, V8, VF4); else PEER_FETCH(r0, pb + 4, V8, VF4); } }
                        float cfv[4];
#pragma unroll
                        for (int q = 0; q < 4; ++q) cfv[q] = rlane(pb < 64 ? cf0 : cf1, (pb + q) & 63) * (gsel == 0 ? r0[q].rs : gsel == 1 ? r1[q].rs : r2[q].rs);
#pragma unroll
                        for (int q = 0; q < 4; ++q)
#pragma unroll
                            for (int p = 0; p < 2; ++p) { const Fp6Row& rr = gsel == 0 ? r0[q] : gsel == 1 ? r1[q] : r2[q];
                                if (VF4) { const uint4 qq = p ? rr.q1 : rr.q0; const unsigned wq[4] = {qq.x, qq.y, qq.z, qq.w}; const float cfb = cfv[q] * (p ? bfhi(rr.q2.x) : bflo(rr.q2.x));
#pragma unroll
                                    for (int dw = 0; dw < 4; ++dw) { float one = 1.0f; asm volatile("" : "+v"(one)); float f8[8]; fp4_unpack8(wq[dw], one, f8);
#pragma unroll
                                        for (int t = 0; t < 8; ++t) acc[8 * p + 2 * dw + (t >> 2)][t & 3] += cfb * f8[t];
                                        PIN4(acc[8 * p + 2 * dw]); PIN4(acc[8 * p + 2 * dw + 1]); }
                                } else { float one = 1.0f; asm volatile("" : "+v"(one)); float bsc; const f32x32_t f = row_unpack<VF4>(rr, p, one, bsc);
                                    const float cfb = cfv[q] * bsc;
#pragma unroll
                                    for (int t = 0; t < 32; ++t) acc[8 * p + (t >> 2)][t & 3] += cfb * f[t];
#pragma unroll
                                    for (int jj = 0; jj < 8; ++jj) PIN4(acc[8 * p + jj]); } }
                    }
                }
            }
        }
#endif
        { const float* gt2 = mod + (size_t)bb * NMOD + 5 * DM; float ss = 0.f;
          int l4 = lane * 4; asm volatile("" : "+v"(l4));
#pragma unroll
          for (int j = 0; j < 16; ++j) { const int c = 256 * j + l4; const float4 g = *(const float4*)(gt2 + c), h4 = *(const float4*)(hrow + c);
              acc[j][0] = h4.x + g.x * acc[j][0]; acc[j][1] = h4.y + g.y * acc[j][1]; acc[j][2] = h4.z + g.z * acc[j][2]; acc[j][3] = h4.w + g.w * acc[j][3];
              ss += (acc[j][0] * acc[j][0] + acc[j][1] * acc[j][1]) + (acc[j][2] * acc[j][2] + acc[j][3] * acc[j][3]);
              if ((j & 3) == 3) { PIN4(acc[j - 3]); PIN4(acc[j - 2]); PIN4(acc[j - 1]); PIN4(acc[j]); asm volatile("" ::: "memory"); } }
          const float rstd = rsqrtf(wave_sum(ss) * (1.f / DM) + RMS_EPS);
#pragma unroll
          for (int j = 0; j < 16; ++j) { const int c = 256 * j + l4; const float4 fg = *(const float4*)(a.in[I_FG] + c);
              *(float4*)(outp + (size_t)m * DM + c) = make_float4(acc[j][0] * rstd * fg.x, acc[j][1] * rstd * fg.y, acc[j][2] * rstd * fg.z, acc[j][3] * rstd * fg.w);
              if ((j & 3) == 3) asm volatile("" ::: "memory"); } }
    }
}

constexpr int N_PHASES = 13;
__global__ void __launch_bounds__(512, 2) hybrid_fwd(Args args) {
    extern __shared__ __attribute__((aligned(16))) unsigned char lds_raw[];
    LAS unsigned char* lds = (LAS unsigned char*)lds_raw;
    volatile LAS unsigned* MISC = (volatile LAS unsigned*)(lds + LDS_MISC);
    for (int u = TID; u < (LDS_BYTES - LDS_CTL) / 4; u += 512) ((LAS unsigned*)(lds + LDS_CTL))[u] = 0u;
    __syncthreads();
    const int lo = args.ph_lo, hi = args.ph_hi;
    XcdBarrier bar; bar.bar = (unsigned*)(args.ws + WS_CTL); bar.x = 0; bar.st = nullptr;
    if (hi - lo > 1) bar = xcd_barrier_post((unsigned*)(args.ws + WS_CTL), MISC + 8);
#define IN(k) (lo <= (k) && (k) < hi && ((MK_PHASE_MASK >> (k)) & 1))
#define SEAM(k) do { if (IN(k) && IN((k) + 1)) xcd_barrier(bar); } while (0)
    const int bid = (int)blockIdx.x, G = (int)gridDim.x;

    if (IN(0)) { ph_mod(args, lds); ph_conv(args, lds); if (MK_REPEAT == 0) { ph_mod(args, lds); ph_conv(args, lds); } }
    SEAM(0);
    if (IN(1)) { ph_norm1(args); if (MK_REPEAT == 1) ph_norm1(args); }
    SEAM(1);
    if (IN(2)) { pg8::Gemm g{(const bf16*)(args.ws + WS_A1), (const bf16*)(args.ws + WS_WT_IN), MT, NINP, DM, DM, DM, 0, 0}; pg8::StaticOrder S; S.init(MT, NINP, G, bid);
        pg8::EpiBf16<0> E{(bf16*)(args.ws + WS_P), NINP, nullptr, 0, 0}; pg8::gemm_phase<pg8::EpiBf16<0>, pg8::StaticOrder>(lds, g, S, E, nullptr);
        if (MK_REPEAT == 2) pg8::gemm_phase<pg8::EpiBf16<0>, pg8::StaticOrder>(lds, g, S, E, nullptr); }
    SEAM(2);
    if (IN(3)) { ph_prep_stage(args, lds); ph_prep_rwkv(args, lds); ph_prep_ssd(args, lds); if (MK_REPEAT == 3) { ph_prep_rwkv(args, lds); ph_prep_ssd(args, lds); } }
    SEAM(3);
    if (IN(4)) { int kw = KLRW; asm volatile("" : "+s"(kw));
        pg8::Gemm g{(const bf16*)(args.ws + WS_ALR), (const bf16*)(args.ws + WS_WLR), MT, NLR, kw, KLR, KLRW, 4, 256}; pg8::StaticOrder S; S.init(MT, NLR, G, bid);
        EpiLR E{(bf16*)(args.ws + WS_LR), args.in[I_W0], args.in[I_A0]}; pg8::gemm_phase<EpiLR, pg8::StaticOrder>(lds, g, S, E, nullptr); }
    SEAM(4);
#if MK_RWKV_SEQ
    if (IN(5)) { ph_rwkv_scan(args); if (MK_REPEAT == 5) ph_rwkv_scan(args); }
#else
    if (IN(5)) {
#if MK_RWKV_LDS
        ph_rwkv_scan2(args, lds); if (MK_REPEAT == 5) ph_rwkv_scan2(args, lds);
#else
        ph_rwkv_chunked(args, lds); if (MK_REPEAT == 5) ph_rwkv_chunked(args, lds);
#endif
    }
#endif
#if MK_SSD_SEQ
    if (IN(6)) { ph_ssd_scan(args); if (MK_REPEAT == 6) ph_ssd_scan(args); }
#else
    if (IN(6)) { ph_ssd_chunked(args, lds); if (MK_REPEAT == 6) ph_ssd_chunked(args, lds); }
#endif
    SEAM(6);
    if (IN(7)) { ph_finish(args, lds); if (MK_REPEAT == 7) ph_finish(args, lds); }
    SEAM(7);
    if (IN(8)) { pg8::Gemm g{(const bf16*)(args.ws + WS_A2), (const bf16*)(args.ws + WS_WT_OUT), MX, DM, DM, DM, DM, 0, 0}; pg8::StaticOrder S; S.init(MX, DM, G, bid);
        EpiRes E{args.out, args.in[I_X], (const float*)(args.ws + WS_MOD)}; pg8::gemm_phase<EpiRes, pg8::StaticOrder>(lds, g, S, E, nullptr);
        if (MK_REPEAT == 8) pg8::gemm_phase<EpiRes, pg8::StaticOrder>(lds, g, S, E, nullptr); }
    SEAM(8);
    if (IN(9)) { ph_norm2(args); if (MK_REPEAT == 9) ph_norm2(args); }
    SEAM(9);
    if (IN(10)) { pg8::Gemm g{(const bf16*)(args.ws + WS_XN2), (const bf16*)(args.ws + WS_WT_Q), MX, 2048, DM, DM, DM, 0, 0}; pg8::StaticOrder S; S.init(MX, 2048, G, bid);
        pg8::EpiBf16<0> E{(bf16*)(args.ws + WS_Q), 2048, nullptr, 0, 0}; pg8::gemm_phase<pg8::EpiBf16<0>, pg8::StaticOrder>(lds, g, S, E, nullptr); }
    SEAM(10);
    if (IN(11)) { int kw = 256; asm volatile("" : "+s"(kw));
        pg8::Gemm g{(const bf16*)(args.ws + WS_Q), (const bf16*)(args.ws + WS_KBD), MX, 2048, kw, 2048, 256, 0, 256}; pg8::StaticOrder S; S.init(MX, 2048, G, bid);
        pg8::EpiF32 E{(float*)(args.ws + WS_S), 2048, nullptr}; pg8::gemm_phase<pg8::EpiF32, pg8::StaticOrder>(lds, g, S, E, nullptr); }
    SEAM(11);
    if (IN(12)) { if (MK_REPEAT == 12) ph_peer(args, (float*)(args.ws + 903 * MiB)); ph_peer(args, args.out); }
#undef IN
#undef SEAM
}

extern "C" void kernel_launch(void* const* d_in, const int* in_sizes, int n_in, void* d_out, int out_size, void* d_ws, size_t ws_size, hipStream_t stream) {
    static int grid = 0;
    if (grid == 0) {
        if (n_in != N_IN || out_size != MX * DM || ws_size < WS_END) { fprintf(stderr, "kernel_launch: unexpected shapes (n_in %d out %d ws %zu)\n", n_in, out_size, ws_size); grid = -1; return; }
        int dev = 0, cus = 0, per_cu = 0;
        if (hipGetDevice(&dev) != hipSuccess || hipDeviceGetAttribute(&cus, hipDeviceAttributeMultiprocessorCount, dev) != hipSuccess) { grid = -1; return; }
        if (hipFuncSetAttribute((const void*)hybrid_fwd, hipFuncAttributeMaxDynamicSharedMemorySize, LDS_BYTES) != hipSuccess) { fprintf(stderr, "kernel_launch: hipFuncSetAttribute failed\n"); grid = -1; return; }
        if (hipOccupancyMaxActiveBlocksPerMultiprocessor(&per_cu, (const void*)hybrid_fwd, 512, LDS_BYTES) != hipSuccess || per_cu < 1) fprintf(stderr, "kernel_launch: occupancy query reports %d\n", per_cu);
        (void)hipGetLastError();
        grid = cus;
    }
    if (grid < 0) return;
    (void)in_sizes;
    if (hipMemsetAsync((char*)d_ws + WS_CTL, 0, CTL_ZERO_BYTES, stream) != hipSuccess) return;
    Args a{};
    for (int i = 0; i < N_IN; ++i) a.in[i] = (const float*)d_in[i];
    a.out = (float*)d_out; a.ws = (unsigned char*)d_ws;
#if MK_N_LAUNCHES == 1
    a.ph_lo = 0; a.ph_hi = N_PHASES;
    hipLaunchKernelGGL(hybrid_fwd, dim3(grid), dim3(512), LDS_BYTES, stream, a);
#else
    for (int ph = 0; ph < N_PHASES; ++ph) { if (!((MK_PHASE_MASK >> ph) & 1)) continue; a.ph_lo = ph; a.ph_hi = ph + 1; hipLaunchKernelGGL(hybrid_fwd, dim3(grid), dim3(512), LDS_BYTES, stream, a); }
#endif
}
```

```cpp
#include <hip/hip_runtime.h>
#include <stdint.h>
#include <stdio.h>
namespace pg8 {
#define PG8_LAS __attribute__((address_space(3)))
typedef unsigned short bf16_t;
typedef short bf16x8 __attribute__((ext_vector_type(8)));
typedef float f32x4 __attribute__((ext_vector_type(4)));
typedef unsigned u32x4 __attribute__((ext_vector_type(4)));
typedef int i32x8 __attribute__((ext_vector_type(8)));
typedef int i32x4 __attribute__((ext_vector_type(4)));
constexpr int BM = 256, BK = 64, HALF = 128, HTB = HALF * BK * 2  , STAGE_BYTES = 8 * HTB, NXCD = 8, WGM = 8;

__host__ __device__ __forceinline__ int lds_byte(int r, int c) { const int st = (r >> 4) * 2 + (c >> 5), rr = r & 15, cc = c & 31, ob = rr * 64 + cc * 2; return st * 1024 + (ob ^ (((ob >> 9) & 1) << 5)); }
__host__ __device__ __forceinline__ void stage_rc(int b, int& R, int& C) { const int st = b / 1024, sb = b % 1024, swz = sb ^ (((sb >> 9) & 1) << 5); R = (st >> 1) * 16 + swz / 64; C = (st & 1) * 32 + (swz % 64) / 2; }
__host__ __device__ __forceinline__ int perm32(int rho) { const int n = rho >> 4, i = rho & 15; return 8 * (i >> 2) + 4 * n + (i & 3); }

struct Unit { int pm, pn; };
struct Gemm { const bf16_t* A; const bf16_t* Bt; int M, N, K; int lda, ldb, kshift, kmul; };

struct StaticOrder {
    int nM, nN, nwg, G, c;
    __host__ __device__ void init(int M, int N, int G_, int c_) { nM = M / BM; nN = N / BM; nwg = nM * nN; G = G_; c = c_; }
    __host__ __device__ bool next(int i, Unit& u) const {
        const long L = (long)i * G + c; if (L >= nwg) return false;
        int wgid = (int)L; { const int q = nwg / NXCD, r = nwg % NXCD, xcd = wgid % NXCD, off = wgid / NXCD; wgid = (xcd < r ? xcd * (q + 1) : r * (q + 1) + (xcd - r) * q) + off; }
        const int nig = WGM * nN, gid = wgid / nig, fm = gid * WGM, gsz = (nM - fm) < WGM ? (nM - fm) : WGM;
        u.pm = fm + ((wgid % nig) % gsz); u.pn = (wgid % nig) / gsz; return true;
    }
    __device__ __forceinline__ void a_ready(const Unit&) const {}
    __device__ __forceinline__ void done(const Unit&) const {}
};
typedef __bf16 bf16pair __attribute__((ext_vector_type(2))); typedef float f32pair __attribute__((ext_vector_type(2)));
__device__ __forceinline__ unsigned cvt_pk_bf16(float lo, float hi) { return __builtin_bit_cast(unsigned, __builtin_convertvector((f32pair){lo, hi}, bf16pair)); }
typedef float f32x2 __attribute__((ext_vector_type(2)));
__device__ __forceinline__ f32x2 gelu_pk(f32x2 v) {
    const f32x2 av = __builtin_elementwise_abs(v), d = av * 0.2316418882f + 1.0f;
    f32x2 t; t.x = __builtin_amdgcn_rcpf(d.x); t.y = __builtin_amdgcn_rcpf(d.y);
    f32x2 q = t * 0.5307027145f + (-0.7265760135f); q = q * t + 0.7107068705f; q = q * t + (-0.142248368f); q = q * t + 0.127414796f; q = q * t;
    const f32x2 s = (v * v) * (-0.72134752044f);
    f32x2 e; e.x = __builtin_amdgcn_exp2f(s.x); e.y = __builtin_amdgcn_exp2f(s.y);
    const f32x2 m = v * (q * e), r = v - m;
    f32x2 o; o.x = v.x < 0.f ? m.x : r.x; o.y = v.y < 0.f ? m.y : r.y; return o;
}

struct EpiF32 {
    static constexpr bool PERM = false, AFTER_DRAIN = false;
    float* C; int ldc; const float* bias;
    __device__ __forceinline__ void operator()(const f32x4 (&acc)[2][2][4][2], const Unit& u, int wr, int wc, int fr, int fq) const {
        const int row0 = u.pm * BM + wr * 64 + fr, col0 = u.pn * BM + wc * 32 + 4 * fq;
        f32x4 bv[2][2];
#pragma unroll
        for (int bj = 0; bj < 2; ++bj)
#pragma unroll
            for (int n = 0; n < 2; ++n) bv[bj][n] = bias ? *(const f32x4*)(bias + col0 + bj * HALF + n * 16) : (f32x4){0.f, 0.f, 0.f, 0.f};
#pragma unroll
        for (int ai = 0; ai < 2; ++ai)
#pragma unroll
            for (int m = 0; m < 4; ++m) { float* rowp = C + (size_t)(row0 + ai * HALF + m * 16) * ldc + col0;
#pragma unroll
                for (int bj = 0; bj < 2; ++bj)
#pragma unroll
                    for (int n = 0; n < 2; ++n) *(f32x4*)(rowp + bj * HALF + n * 16) = acc[ai][bj][m][n] + bv[bj][n]; }
    }
};
template <int ACT  > struct EpiBf16 {
    static constexpr bool PERM = true, AFTER_DRAIN = false;
    bf16_t* O; int ldc; const float* bias; int split_cols; size_t split_stride;
    __device__ __forceinline__ void operator()(const f32x4 (&acc)[2][2][4][2], const Unit& u, int wr, int wc, int fr, int fq) const {
        const int row0 = u.pm * BM + wr * 64 + fr; int colt = u.pn * BM; bf16_t* base = O;
        if (split_cols) { const int t = colt / split_cols; base += (size_t)t * split_stride; colt -= t * split_cols; }
        const int col0 = colt + wc * 32 + 8 * fq, bcol0 = u.pn * BM + wc * 32 + 8 * fq;
        f32x4 bv[2][2];
#pragma unroll
        for (int bj = 0; bj < 2; ++bj)
#pragma unroll
            for (int n = 0; n < 2; ++n) bv[bj][n] = bias ? *(const f32x4*)(bias + bcol0 + bj * HALF + 4 * n) : (f32x4){0.f, 0.f, 0.f, 0.f};
#pragma unroll
        for (int ai = 0; ai < 2; ++ai)
#pragma unroll
            for (int m = 0; m < 4; ++m) { bf16_t* rowp = base + (size_t)(row0 + ai * HALF + m * 16) * ldc + col0;
#pragma unroll
                for (int bj = 0; bj < 2; ++bj) { f32x4 v0 = acc[ai][bj][m][0] + bv[bj][0], v1 = acc[ai][bj][m][1] + bv[bj][1];
                    if (ACT == 1) { f32x2 a = gelu_pk((f32x2){v0[0], v0[1]}), b = gelu_pk((f32x2){v0[2], v0[3]}), c = gelu_pk((f32x2){v1[0], v1[1]}), d = gelu_pk((f32x2){v1[2], v1[3]});
                        v0 = (f32x4){a.x, a.y, b.x, b.y}; v1 = (f32x4){c.x, c.y, d.x, d.y}; }
                    if (ACT == 2) {
#pragma unroll
                        for (int j = 0; j < 4; ++j) { v0[j] = 0.5f * v0[j] * (1.0f + erff(v0[j] * 0.70710678f)); v1[j] = 0.5f * v1[j] * (1.0f + erff(v1[j] * 0.70710678f)); } }
                    u32x4 w; w.x = cvt_pk_bf16(v0[0], v0[1]); w.y = cvt_pk_bf16(v0[2], v0[3]); w.z = cvt_pk_bf16(v1[0], v1[1]); w.w = cvt_pk_bf16(v1[2], v1[3]);
                    *(u32x4*)(rowp + bj * HALF) = w; } }
    }
};
struct EpiBf16S {
    static constexpr bool PERM = true, AFTER_DRAIN = false;
    bf16_t* O; int ldc; const float* sa; const float* sb; bf16_t* O2; int c2lo, c2hi, ld2, m2;
    template <class AT> __device__ __forceinline__ void operator()(const AT (&acc)[2][2][4][2], const Unit& u, int wr, int wc, int fr, int fq) const {
        const int row0 = u.pm * BM + wr * 64 + fr, col0 = u.pn * BM + wc * 32 + 8 * fq;
        asm volatile("" ::: "memory");
        f32x4 cs[2][2];
#pragma unroll
        for (int bj = 0; bj < 2; ++bj)
#pragma unroll
            for (int n = 0; n < 2; ++n) cs[bj][n] = *(const f32x4*)(sb + col0 + bj * HALF + 4 * n);
#pragma unroll
        for (int ai = 0; ai < 2; ++ai)
#pragma unroll
            for (int m = 0; m < 4; ++m) { const int row = row0 + ai * HALF + m * 16; const float rs = sa[row];
#pragma unroll
                for (int bj = 0; bj < 2; ++bj) { const int ch = u.pn * BM + bj * HALF; const bool red = ch >= c2lo && ch < c2hi;
                    bf16_t* rowp = red ? O2 + (size_t)row * ld2 + (col0 - c2lo) : O + (size_t)row * ldc + col0; if (red && row >= m2) continue;
                    const f32x4 v0 = __builtin_convertvector(acc[ai][bj][m][0], f32x4) * cs[bj][0] * rs, v1 = __builtin_convertvector(acc[ai][bj][m][1], f32x4) * cs[bj][1] * rs;
                    u32x4 w; w.x = cvt_pk_bf16(v0[0], v0[1]); w.y = cvt_pk_bf16(v0[2], v0[3]); w.z = cvt_pk_bf16(v1[0], v1[1]); w.w = cvt_pk_bf16(v1[2], v1[3]);
                    *(u32x4*)(rowp + bj * HALF) = w; } }
    }
};
template <int QT> struct AccT { typedef f32x4 type; };
template <> struct AccT<2> { typedef i32x4 type; };
template <class Epi, class Sched, bool STAMP = false, int QT = 0>
__device__ __forceinline__ void gemm_phase(PG8_LAS unsigned char* lds, const Gemm g, const Sched& S, const Epi& E, unsigned long long* stamps) {
    const int tid = threadIdx.x, wid = __builtin_amdgcn_readfirstlane(tid >> 6), lane = tid & 63, wr = wid >> 2, wc = wid & 3, fr = lane & 15, fq = lane >> 4;
    const int K = g.K, nt = K / BK;
    int ts_lo = 0, ts_hi = 0, nts = 0; const unsigned long long rt_entry = STAMP ? (unsigned long long)wall_clock64() : 0ull;
#define PG8_STAMP() do { if (STAMP && wid == 0 && nts < 64) { const unsigned long long _c = (unsigned long long)clock64(); \
        ts_lo = (lane == nts) ? (int)(unsigned)_c : ts_lo; ts_hi = (lane == nts) ? (int)(unsigned)(_c >> 32) : ts_hi; ++nts; } } while (0)
    PG8_STAMP();
    unsigned voffA[2], voffB[2];
#pragma unroll
    for (int i = 0; i < 2; ++i) { int R, C; stage_rc(tid * 16 + i * 8192, R, C); const int Rb = Epi::PERM ? ((R & ~31) + perm32(R & 31)) : R;
        voffA[i] = (unsigned)(R * g.lda + C) * 2u; voffB[i] = (unsigned)(Rb * g.ldb + C) * 2u; }
    const size_t kstep = (size_t)(BK * 2);
    const size_t hstepA = (size_t)HALF * g.lda * 2, hstepB = (size_t)HALF * g.ldb * 2;
    const size_t tstepA = 2 * hstepA, tstepB = 2 * hstepB;
    const unsigned ldsw = (unsigned)wid * 1024u;
    const int aoff = lds_byte(wr * 64 + fr, fq * 8), boff = lds_byte(wc * 32 + fr, fq * 8);
#define PG8_SA(b, h) (((b) * 2 + (h)) * HTB)
#define PG8_SB(b, h) ((4 + (b) * 2 + (h)) * HTB)
#define PG8_STAGE(bufoff, gbase, voff) do { _Pragma("unroll") for (int _i = 0; _i < 2; ++_i) \
        __builtin_amdgcn_global_load_lds((const unsigned*)((const char*)(gbase) + (voff)[_i]), (PG8_LAS unsigned*)(lds + (bufoff) + ldsw + _i * 8192), 16, 0, 0); } while (0)
#define PG8_LDA(dst, b, h) do { _Pragma("unroll") for (int m = 0; m < 4; ++m) _Pragma("unroll") for (int k = 0; k < 2; ++k) dst[m][k] = *(const PG8_LAS bf16x8*)(lds + PG8_SA(b, h) + aoff + m * 2048 + k * 1024); } while (0)
#define PG8_LDB(dst, b, h) do { _Pragma("unroll") for (int n = 0; n < 2; ++n) _Pragma("unroll") for (int k = 0; k < 2; ++k) dst[n][k] = *(const PG8_LAS bf16x8*)(lds + PG8_SB(b, h) + boff + n * 2048 + k * 1024); } while (0)
#define PG8_CAT(x) __builtin_bit_cast(i32x8, __builtin_shufflevector((x)[0], (x)[1], 0, 1, 2, 3, 4, 5, 6, 7, 8, 9, 10, 11, 12, 13, 14, 15))
#define PG8_MMA(ai, bj, At, Bt) do { __builtin_amdgcn_s_setprio(1); _Pragma("unroll") for (int m = 0; m < 4; ++m) _Pragma("unroll") for (int n = 0; n < 2; ++n) { \
        if constexpr (QT == 1) { const i32x8 _b = PG8_CAT(Bt[n]), _a = PG8_CAT(At[m]); asm volatile("v_mfma_f32_16x16x128_f8f6f4 %0, %1, %2, %0" : "+v"(acc[ai][bj][m][n]) : "v"(_b), "v"(_a)); } \
        else if constexpr (QT == 2) { _Pragma("unroll") for (int k = 0; k < 2; ++k) acc[ai][bj][m][n] = __builtin_amdgcn_mfma_i32_16x16x64_i8(__builtin_bit_cast(i32x4, Bt[n][k]), __builtin_bit_cast(i32x4, At[m][k]), acc[ai][bj][m][n], 0, 0, 0); } \
        else { _Pragma("unroll") for (int k = 0; k < 2; ++k) acc[ai][bj][m][n] = __builtin_amdgcn_mfma_f32_16x16x32_bf16(Bt[n][k], At[m][k], acc[ai][bj][m][n], 0, 0, 0); } } \
        __builtin_amdgcn_s_setprio(0); } while (0)
#define PG8_WAIT_V(n) asm volatile("s_waitcnt vmcnt(" #n ")" ::: "memory")
#define PG8_WAIT_L(n) asm volatile("s_waitcnt lgkmcnt(" #n ")" ::: "memory")
#define PG8_BAR __builtin_amdgcn_s_barrier()
#define PG8_SCHED __builtin_amdgcn_sched_barrier(0)
    Unit cur, nxt; int ui = 0;
    if (!S.next(0, cur)) return;
    typedef typename AccT<QT>::type acc_t;
    acc_t acc[2][2][4][2];
#pragma unroll
    for (int a = 0; a < 2; ++a)
#pragma unroll
        for (int b = 0; b < 2; ++b)
#pragma unroll
            for (int m = 0; m < 4; ++m)
#pragma unroll
                for (int n = 0; n < 2; ++n) acc[a][b][m][n] = (acc_t){0, 0, 0, 0};
    bf16x8 At[4][2], B0[2][2], B1[2][2];
    const char* cA = (const char*)g.A + (size_t)cur.pm * tstepA + (size_t)((cur.pn >> g.kshift) * g.kmul) * 2; const char* cB = (const char*)g.Bt + (size_t)cur.pn * tstepB;
    S.a_ready(cur);
    PG8_STAGE(PG8_SB(0, 0), cB, voffB); PG8_STAGE(PG8_SA(0, 0), cA, voffA); PG8_STAGE(PG8_SB(0, 1), cB + hstepB, voffB); PG8_STAGE(PG8_SA(0, 1), cA + hstepA, voffA);
    if (wr == 1) PG8_BAR;
    PG8_WAIT_V(4); PG8_BAR;
    PG8_STAGE(PG8_SB(1, 0), cB + kstep, voffB); PG8_STAGE(PG8_SA(1, 0), cA + kstep, voffA); PG8_STAGE(PG8_SB(1, 1), cB + hstepB + kstep, voffB);
    PG8_WAIT_V(6); PG8_BAR;
    PG8_STAMP();
    for (;;) {
        const bool has_next = S.next(ui + 1, nxt);
        const char* nA = has_next ? (const char*)g.A + (size_t)nxt.pm * tstepA + (size_t)((nxt.pn >> g.kshift) * g.kmul) * 2 : cA; const char* nB = has_next ? (const char*)g.Bt + (size_t)nxt.pn * tstepB : cB;
        for (int t = 0; t < nt; t += 2) {
            const bool last = (t == nt - 2);
            const char* a1 = cA + (size_t)(t + 1) * kstep;
            const char* a2 = last ? nA : cA + (size_t)(t + 2) * kstep; const char* b2 = last ? nB : cB + (size_t)(t + 2) * kstep;
            const char* a3 = a2 + kstep; const char* b3 = b2 + kstep;
            if (last && has_next) S.a_ready(nxt);
            PG8_LDB(B0, 0, 0); PG8_SCHED; PG8_LDA(At, 0, 0); PG8_STAGE(PG8_SA(1, 1), a1 + hstepA, voffA);
            PG8_WAIT_L(8); PG8_BAR; PG8_WAIT_L(0); PG8_MMA(0, 0, At, B0); PG8_BAR; PG8_SCHED;
            PG8_LDB(B1, 0, 1); PG8_STAGE(PG8_SB(0, 0), b2, voffB);
            PG8_BAR; PG8_WAIT_L(0); PG8_MMA(0, 1, At, B1); PG8_BAR;
            PG8_LDA(At, 0, 1); PG8_STAGE(PG8_SA(0, 0), a2, voffA);
            PG8_BAR; PG8_WAIT_L(0); PG8_MMA(1, 0, At, B0); PG8_BAR; PG8_SCHED;
            PG8_STAGE(PG8_SB(0, 1), b2 + hstepB, voffB);
            PG8_WAIT_V(6); PG8_BAR; PG8_MMA(1, 1, At, B1); PG8_BAR;
            PG8_LDB(B0, 1, 0); PG8_SCHED; PG8_LDA(At, 1, 0); PG8_STAGE(PG8_SA(0, 1), a2 + hstepA, voffA);
            PG8_WAIT_L(8); PG8_BAR; PG8_WAIT_L(0); PG8_MMA(0, 0, At, B0); PG8_BAR; PG8_SCHED;
            PG8_LDB(B1, 1, 1); PG8_STAGE(PG8_SB(1, 0), b3, voffB);
            PG8_BAR; PG8_WAIT_L(0); PG8_MMA(0, 1, At, B1); PG8_BAR;
            PG8_LDA(At, 1, 1); PG8_STAGE(PG8_SA(1, 0), a3, voffA);
            PG8_BAR; PG8_WAIT_L(0); PG8_MMA(1, 0, At, B0); PG8_BAR; PG8_SCHED;
            PG8_STAGE(PG8_SB(1, 1), b3 + hstepB, voffB);
            PG8_WAIT_V(6); PG8_BAR; PG8_MMA(1, 1, At, B1); PG8_BAR;
        }
        PG8_STAMP();
        if constexpr (QT == 1) asm volatile("s_nop 15\n\ts_nop 15" ::: "memory");
        if constexpr (!Epi::AFTER_DRAIN) { E(acc, cur, wr, wc, fr, fq); S.done(cur); }
        PG8_STAMP();
        if (!has_next) break;
#pragma unroll
        for (int a = 0; a < 2; ++a)
#pragma unroll
            for (int b = 0; b < 2; ++b)
#pragma unroll
                for (int m = 0; m < 4; ++m)
#pragma unroll
                    for (int n = 0; n < 2; ++n) acc[a][b][m][n] = (acc_t){0, 0, 0, 0};
        cur = nxt; cA = nA; cB = nB; ++ui;
    }
    PG8_WAIT_V(0);
    if (wr == 0) PG8_BAR;
    PG8_BAR;
    if constexpr (Epi::AFTER_DRAIN) { E.fused(acc, cur, wr, wc, fr, fq, lds, wid, lane); S.done(cur); }
    PG8_STAMP();
    if (STAMP && wid == 0) { stamps[lane] = lane < nts ? (((unsigned long long)(unsigned)ts_hi << 32) | (unsigned)ts_lo) : 0ull;
        if (lane == 62) stamps[62] = rt_entry; if (lane == 63) stamps[63] = (unsigned long long)wall_clock64(); }
#undef PG8_STAMP
#undef PG8_SA
#undef PG8_SB
#undef PG8_STAGE
#undef PG8_LDA
#undef PG8_LDB
#undef PG8_MMA
#undef PG8_CAT
#undef PG8_WAIT_V
#undef PG8_WAIT_L
#undef PG8_BAR
#undef PG8_SCHED
}
}

#define LAS __attribute__((address_space(3)))
typedef unsigned short bf16;
typedef float f32x4 __attribute__((ext_vector_type(4)));

#ifndef MK_N_LAUNCHES
#define MK_N_LAUNCHES 1
#endif
#ifndef MK_PHASE_MASK
#define MK_PHASE_MASK 0x1FFF
#endif
#ifndef MK_PEER_FP4
#define MK_PEER_FP4 6
#endif
#ifndef MK_SKIP_MIXER
#define MK_SKIP_MIXER 0
#endif
#ifndef MK_SKIP_PEER
#define MK_SKIP_PEER 0
#endif
#ifndef MK_SKIP_RWKV
#define MK_SKIP_RWKV 0
#endif
#ifndef MK_SKIP_SSD
#define MK_SKIP_SSD 0
#endif

constexpr int DM = 4096, NBATCH = 4, SEQ = 4096, CTXL = 256;
constexpr int MX = NBATCH * SEQ;
constexpr int MC = NBATCH * CTXL;
constexpr int MT = MX + MC;
constexpr int RW = 2048;
constexpr int RCOLS = 6784;
constexpr int NIN = 12992, NINP = 13056;
constexpr int COL_Z = 6784, COL_XBC = 8832, COL_DT = 12928;
constexpr int NLR = 10240, KLR = 768, KLRW = 256;
constexpr int NMOD = 6 * DM;
constexpr float RMS_EPS = 1e-6f, GN_EPS = 64e-5f;
constexpr int NSTEP = CTXL + SEQ;

constexpr size_t MiB = (size_t)1 << 20;
constexpr size_t WS_CTL = 0, CTL_ZERO_BYTES = 1 * MiB;
constexpr size_t WS_MOD = 64 * 1024;
constexpr size_t WS_WT_OUT = 2 * MiB;
constexpr size_t WS_WT_Q = 34 * MiB;
constexpr size_t WS_WLR = 50 * MiB;
constexpr size_t WS_KBD = 63 * MiB;
constexpr size_t WS_DT = 71 * MiB;
constexpr size_t WS_LA = WS_DT + (size_t)MT * 64 * 4;
constexpr size_t WS_ALR = 300 * MiB;
constexpr size_t WS_WT_IN = 102 * MiB;
constexpr size_t WS_A1 = 204 * MiB;
constexpr size_t WS_W8 = 272 * MiB;
constexpr size_t WS_SA = 600 * 1024, WS_SB = 700 * 1024;
constexpr size_t WS_SB2 = 760 * 1024, WS_SBQ = 780 * 1024;
constexpr size_t WS_W8O = 80 * MiB, WS_W8Q = 55 * MiB;
constexpr size_t WS_P = 340 * MiB;
constexpr size_t WS_R = 774 * MiB, WS_K = 842 * MiB, WS_V = 910 * MiB, WS_KK = 978 * MiB;
constexpr size_t WS_XS = 1046 * MiB, WS_BC = 1114 * MiB;
constexpr size_t WS_Z = 102 * MiB;
constexpr size_t WS_LR = 340 * MiB;
constexpr size_t WS_A2 = 166 * MiB;
constexpr size_t WS_XN2 = 340 * MiB;
constexpr size_t WS_Q = 468 * MiB;
constexpr size_t WS_S = 532 * MiB;
constexpr size_t WS_U8 = 1182 * MiB, WS_V8 = (MK_PEER_FP4 == 3 ? 1246 : 1230) * MiB;
constexpr size_t WS_USC = (MK_PEER_FP4 == 3 ? 1310 : 1278) * MiB, WS_VSC = WS_USC + 65536;
constexpr size_t WS_END = WS_USC + MiB;
static_assert(WS_WT_IN + (size_t)NINP * DM * 2 <= WS_A1 && WS_A1 + (size_t)MT * DM * 2 <= WS_P && WS_P + (size_t)MT * NINP * 2 <= WS_R, "ws map 1");
static_assert(WS_LR + (size_t)MT * NLR * 2 <= WS_R && WS_Z + (size_t)MX * RW * 2 <= WS_A2 && WS_A2 + (size_t)MX * DM * 2 <= WS_P, "ws map 2");
static_assert(WS_LA + (size_t)MT * 64 * 4 <= WS_WT_IN && WS_ALR + (size_t)MT * KLR * 2 <= WS_P && WS_ALR >= WS_A2 + (size_t)MX * DM * 2 && WS_WLR + (size_t)NLR * KLRW * 2 <= WS_KBD, "ws map 3");
static_assert(WS_LA + (size_t)MT * 64 * 4 <= WS_W8O && WS_W8O + (size_t)DM * DM <= WS_WT_IN && WS_WLR + (size_t)NLR * KLRW * 2 <= WS_W8Q && WS_W8Q + (size_t)2048 * DM <= WS_KBD && WS_SB + (size_t)NINP * 4 <= WS_SB2 && WS_SB2 + DM * 4 <= WS_SBQ && WS_SBQ + 2048 * 4 <= CTL_ZERO_BYTES, "ws map 6");
static_assert(WS_MOD + (size_t)5 * NMOD * 4 <= WS_SA && WS_SA + (size_t)MT * 4 <= WS_SB && WS_SB + (size_t)NINP * 4 <= CTL_ZERO_BYTES && WS_A1 + (size_t)MT * DM <= WS_W8 && WS_W8 + (size_t)NINP * DM <= WS_P, "ws map 5");
static_assert(WS_S + (size_t)MX * 2048 * 4 <= WS_R && WS_VSC + 65536 <= WS_END && WS_BC + (size_t)MT * RW * 2 <= WS_U8 && WS_U8 + (size_t)16384 * (MK_PEER_FP4 == 3 ? 4096 : 3072) <= WS_V8 && WS_V8 + (size_t)16384 * (MK_PEER_FP4 == 3 ? 4096 : 3072) <= WS_USC, "ws map 4");

constexpr int LDS_BYTES = 147456;
constexpr int LDS_CTL = 143360;
constexpr int LDS_MISC = LDS_CTL + 320;

enum { I_X = 0, I_C, I_CTX, I_CCTX, I_WMOD, I_BMOD, I_N1G, I_N2G, I_WIN, I_WOUT, I_MU, I_W0, I_W2, I_A0, I_A2, I_G2, I_KK, I_KA, I_RK, I_LNW, I_LNB,
       I_CONVW, I_CONVB, I_DTB, I_ALOG, I_SSMD, I_NORMW, I_WQ, I_K1, I_K2, I_PU, I_PV, I_FG, N_IN };

struct Args { const float* in[N_IN]; float* out; unsigned char* ws; int ph_lo, ph_hi; };

__device__ __forceinline__ unsigned f2bf(float f) { unsigned u = __float_as_uint(f); return (u + 0x7fffu + ((u >> 16) & 1u)) >> 16; }
typedef __bf16 bf16pair_t __attribute__((ext_vector_type(2)));
typedef float f32pair_t __attribute__((ext_vector_type(2)));
__device__ __forceinline__ unsigned pk2(float lo, float hi) { return __builtin_bit_cast(unsigned, __builtin_convertvector((f32pair_t){lo, hi}, bf16pair_t)); }
__device__ __forceinline__ float bflo(unsigned u) { return __uint_as_float(u << 16); }
__device__ __forceinline__ float bfhi(unsigned u) { return __uint_as_float(u & 0xffff0000u); }
__device__ __forceinline__ void unpack8(const uint4& u, float (&f)[8]) {
    f[0] = bflo(u.x); f[1] = bfhi(u.x); f[2] = bflo(u.y); f[3] = bfhi(u.y); f[4] = bflo(u.z); f[5] = bfhi(u.z); f[6] = bflo(u.w); f[7] = bfhi(u.w);
}
__device__ __forceinline__ uint4 pack8(const float (&f)[8]) { uint4 u; u.x = pk2(f[0], f[1]); u.y = pk2(f[2], f[3]); u.z = pk2(f[4], f[5]); u.w = pk2(f[6], f[7]); return u; }
__device__ __forceinline__ uint4 ld16(const bf16* p) { return *(const uint4*)p; }
__device__ __forceinline__ void st16(bf16* p, const uint4& v) { *(uint4*)p = v; }
__device__ __forceinline__ void ldf8(const float* p, float (&f)[8]) { const float4 a = *(const float4*)p, b = *(const float4*)(p + 4); f[0] = a.x; f[1] = a.y; f[2] = a.z; f[3] = a.w; f[4] = b.x; f[5] = b.y; f[6] = b.z; f[7] = b.w; }
#define PIN8(a) asm volatile("" : "+v"((a)[0]), "+v"((a)[1]), "+v"((a)[2]), "+v"((a)[3]), "+v"((a)[4]), "+v"((a)[5]), "+v"((a)[6]), "+v"((a)[7]))
template <int CTRL> __device__ __forceinline__ float dppf(float v) { return __uint_as_float((unsigned)__builtin_amdgcn_update_dpp(0, (int)__float_as_uint(v), CTRL, 0xF, 0xF, true)); }
__device__ __forceinline__ float rlane(float v, int l) { return __uint_as_float((unsigned)__builtin_amdgcn_readlane((int)__float_as_uint(v), l)); }
__device__ __forceinline__ float sum8(float v) { v += dppf<0xB1>(v); v += dppf<0x4E>(v); v += dppf<0x141>(v); return v; }
__device__ __forceinline__ float sum16(float v) { v = sum8(v); v += dppf<0x140>(v); return v; }
__device__ __forceinline__ float sum32(float v) { v = sum16(v); v += __shfl_xor(v, 16); return v; }
__device__ __forceinline__ float wave_sum(float v) { v = sum16(v); return (rlane(v, 0) + rlane(v, 16)) + (rlane(v, 32) + rlane(v, 48)); }
__device__ __forceinline__ float wave_max(float v) {
    v = fmaxf(v, dppf<0xB1>(v)); v = fmaxf(v, dppf<0x4E>(v)); v = fmaxf(v, dppf<0x141>(v)); v = fmaxf(v, dppf<0x140>(v));
    return fmaxf(fmaxf(rlane(v, 0), rlane(v, 16)), fmaxf(rlane(v, 32), rlane(v, 48)));
}
__device__ __forceinline__ void lds_barrier() { asm volatile("s_waitcnt lgkmcnt(0)\n\ts_barrier" ::: "memory"); }
__device__ __forceinline__ float sigmoidf_(float x) { return 1.f / (1.f + __expf(-x)); }
__device__ __forceinline__ float siluf_(float x) { return x / (1.f + __expf(-x)); }

struct EpiLR {
    static constexpr bool PERM = true, AFTER_DRAIN = false;
    bf16* O; const float* w0; const float* a0;
    __device__ __forceinline__ void operator()(const pg8::f32x4 (&acc)[2][2][4][2], const pg8::Unit& u, int wr, int wc, int fr, int fq) const {
        const int row0 = u.pm * 256 + wr * 64 + fr; const int colt = u.pn * 256; const int type = colt >> 11;
        const int col0 = colt + wc * 32 + 8 * fq;
        const float* bias = type < 2 ? (w0 + type * 2048) : (a0 + (type - 2) * 2048);
        pg8::f32x4 bv[2][2];
#pragma unroll
        for (int bj = 0; bj < 2; ++bj)
#pragma unroll
            for (int n = 0; n < 2; ++n) bv[bj][n] = type < 4 ? *(const pg8::f32x4*)(bias + ((col0 + bj * 128 + 4 * n) & 2047)) : (pg8::f32x4){0.f, 0.f, 0.f, 0.f};
#pragma unroll
        for (int ai = 0; ai < 2; ++ai)
#pragma unroll
            for (int m = 0; m < 4; ++m) { bf16* rowp = O + (size_t)(row0 + ai * 128 + m * 16) * NLR + col0;
#pragma unroll
                for (int bj = 0; bj < 2; ++bj) { pg8::f32x4 v0 = acc[ai][bj][m][0] + bv[bj][0], v1 = acc[ai][bj][m][1] + bv[bj][1];
                    if (type < 4) {
#pragma unroll
                        for (int j = 0; j < 4; ++j) { float s0 = __builtin_amdgcn_rcpf(1.f + __expf(-v0[j])), s1 = __builtin_amdgcn_rcpf(1.f + __expf(-v1[j]));
                            if (type < 2) { s0 = 1.f - __expf(-0.60653066f * s0); s1 = 1.f - __expf(-0.60653066f * s1); }
                            v0[j] = s0; v1[j] = s1; } }
                    pg8::u32x4 w; w.x = pk2(v0[0], v0[1]); w.y = pk2(v0[2], v0[3]); w.z = pk2(v1[0], v1[1]); w.w = pk2(v1[2], v1[3]);
                    *(pg8::u32x4*)(rowp + bj * 128) = w; } }
    }
};
struct EpiRes {
    static constexpr bool PERM = false, AFTER_DRAIN = false;
    float* C; const float* X; const float* mod; const float* sa; const float* sb;
    template <class AT> __device__ __forceinline__ void operator()(const AT (&acc)[2][2][4][2], const pg8::Unit& u, int wr, int wc, int fr, int fq) const {
        const int row0 = u.pm * 256 + wr * 64 + fr, col0 = u.pn * 256 + wc * 32 + 4 * fq;
        const float* gt = mod + (size_t)((u.pm * 256) / SEQ) * NMOD + 2 * DM;
        asm volatile("" ::: "memory");
        pg8::f32x4 gv[2][2];
#pragma unroll
        for (int bj = 0; bj < 2; ++bj)
#pragma unroll
            for (int n = 0; n < 2; ++n) { gv[bj][n] = *(const pg8::f32x4*)(gt + col0 + bj * 128 + n * 16); if (sb) gv[bj][n] *= *(const pg8::f32x4*)(sb + col0 + bj * 128 + n * 16); }
#pragma unroll
        for (int ai = 0; ai < 2; ++ai)
#pragma unroll
            for (int m = 0; m < 4; ++m) { const size_t off = (size_t)(row0 + ai * 128 + m * 16) * DM + col0; const float rs = sa ? sa[row0 + ai * 128 + m * 16] : 1.f;
#pragma unroll
                for (int bj = 0; bj < 2; ++bj)
#pragma unroll
                    for (int n = 0; n < 2; ++n) { const pg8::f32x4 xv = *(const pg8::f32x4*)(X + off + bj * 128 + n * 16);
#if MK_SKIP_MIXER
                        *(pg8::f32x4*)(C + off + bj * 128 + n * 16) = xv;
#else
                        *(pg8::f32x4*)(C + off + bj * 128 + n * 16) = xv + gv[bj][n] * (__builtin_convertvector(acc[ai][bj][m][n], pg8::f32x4) * rs);
#endif
                    }
                asm volatile("" ::: "memory"); }
    }
};

#define XB_TMO      128
#define XB_XCNT(j)  (256  + 64 * (j))
#define XB_XSUB(j)  (1280 + 64 * (j))
#define XB_XGEN(j)  (2304 + 64 * (j))
#define XB_TOP      3328
#define XB_TOPGEN   3392
#define XCD_BAR_WORDS 3456
#define XB_SPIN_CAP (1u << 18)
__device__ __forceinline__ unsigned xb_ld(unsigned* p)              { return __hip_atomic_load(p, __ATOMIC_RELAXED, __HIP_MEMORY_SCOPE_AGENT); }
__device__ __forceinline__ unsigned xb_add(unsigned* p, unsigned v) { return __hip_atomic_fetch_add(p, v, __ATOMIC_RELAXED, __HIP_MEMORY_SCOPE_AGENT); }
__device__ __forceinline__ unsigned xb_xcc_id() { return (unsigned)__builtin_amdgcn_s_getreg((3 << 11) | 20) & 0xFu; }
#define XB_SPIN(cond, bar) do { unsigned _sp = 0; while (cond) { __builtin_amdgcn_s_sleep(1); \
    if ((++_sp & 255u) == 0u) { if (xb_ld(&(bar)[XB_TMO])) break; if (_sp > XB_SPIN_CAP) { atomicAdd(&(bar)[XB_TMO], 1u); break; } } } } while (0)
struct XcdBarrier { unsigned* bar; unsigned x; volatile LAS unsigned* st; };
__device__ __forceinline__ XcdBarrier xcd_barrier_post(unsigned* bar, volatile LAS unsigned* st) {
    XcdBarrier b; b.bar = bar; b.x = xb_xcc_id(); b.st = st;
    if (threadIdx.x == 0) (void)xb_add(&bar[XB_XCNT(b.x)], 1u);
    return b;
}
__device__ __forceinline__ void xcd_barrier_complete(unsigned* bar, unsigned x, unsigned& nloc, unsigned& nx) {
    const unsigned G = gridDim.x * gridDim.y * gridDim.z;
    unsigned sum, cnt, mine, sp = 0u;
    for (;;) {
        sum = 0u; cnt = 0u; mine = 0u;
#pragma unroll
        for (unsigned j = 0; j < 16; ++j) { const unsigned c = xb_ld(&bar[XB_XCNT(j)]); sum += c; cnt += (c > 0u) ? 1u : 0u; mine = (j == x) ? c : mine; }
        if (sum == G) break;
        __builtin_amdgcn_s_sleep(1);
        if ((++sp & 255u) == 0u) { if (xb_ld(&bar[XB_TMO])) break; if (sp > XB_SPIN_CAP) { atomicAdd(&bar[XB_TMO], 1u); break; } }
    }
    nloc = mine > 0u ? mine : 1u; nx = cnt > 0u ? cnt : 1u;
}
__device__ __forceinline__ void xcd_barrier(const XcdBarrier& b) {
    asm volatile("s_waitcnt vmcnt(0)" ::: "memory");
    __syncthreads();
    if (threadIdx.x == 0) {
        unsigned* bar = b.bar;
        __builtin_amdgcn_s_waitcnt(0);
        unsigned nloc = b.st[0], nx = b.st[1];
        if (nloc == 0u) { xcd_barrier_complete(bar, b.x, nloc, nx); b.st[0] = nloc; b.st[1] = nx; }
        const unsigned old = xb_add(&bar[XB_XSUB(b.x)], 1u);
        const unsigned gen = old / nloc;
        if (old + 1u == (gen + 1u) * nloc) {
            __builtin_amdgcn_fence(__ATOMIC_RELEASE, "agent");
            asm volatile("s_waitcnt vmcnt(0)" ::: "memory");
            const unsigned og = xb_add(&bar[XB_TOP], 1u);
            const unsigned tg = og / nx;
            if (og + 1u == (tg + 1u) * nx) xb_add(&bar[XB_TOPGEN], 1u);
            else XB_SPIN(xb_ld(&bar[XB_TOPGEN]) == tg, bar);
            __builtin_amdgcn_fence(__ATOMIC_ACQUIRE, "agent");
            xb_add(&bar[XB_XGEN(b.x)], 1u);
            asm volatile("s_waitcnt vmcnt(0)" ::: "memory");
        } else {
            XB_SPIN(xb_ld(&bar[XB_XGEN(b.x)]) == gen, bar);
            __builtin_amdgcn_fence(__ATOMIC_ACQUIRE, "agent");
            asm volatile("s_waitcnt vmcnt(0)" ::: "memory");
        }
    }
    __syncthreads();
}

#define TID ((int)threadIdx.x)
#define LANE ((int)(threadIdx.x & 63))
#define WAVE ((int)__builtin_amdgcn_readfirstlane((int)(threadIdx.x >> 6)))
#define GW ((int)blockIdx.x * 8 + WAVE)
#define NGW ((int)gridDim.x * 8)

__device__ __forceinline__ void ph_mod(const Args& a, LAS unsigned char* lds) {
    const float* c = a.in[I_C]; const float* cc = a.in[I_CCTX]; const float* w_mod = a.in[I_WMOD]; const float* b_mod = a.in[I_BMOD];
    float* mod = (float*)(a.ws + WS_MOD);
    LAS float* sS = (LAS float*)lds;
    LAS float* red = (LAS float*)(lds + 81920);
    const int tid = TID, lane = LANE, wave = WAVE;
    for (int i = tid; i < 5 * DM; i += 512) { const int v = i >> 12, k = i & (DM - 1); const float xv = v < 4 ? c[v * DM + k] : cc[k]; sS[i] = xv / (1.f + expf(-xv)); }
    __syncthreads();
    for (int u = blockIdx.x; u < 256; u += gridDim.x) {
        const bool act = lane < 48; const int cl = act ? lane % 24 : 0, kh = act ? lane / 24 : 0;
        float acc[5][4];
#pragma unroll
        for (int v = 0; v < 5; ++v)
#pragma unroll
            for (int e = 0; e < 4; ++e) acc[v][e] = 0.f;
        const float* wp = w_mod + (size_t)(wave * 512 + kh) * NMOD + u * 96 + cl * 4;
        if (act) {
#pragma unroll 8
            for (int i = 0; i < 256; ++i) {
                const float4 w = *(const float4*)(wp + (size_t)(2 * i) * NMOD);
#pragma unroll
                for (int v = 0; v < 5; ++v) { const float s = sS[v * DM + wave * 512 + 2 * i + kh]; acc[v][0] += s * w.x; acc[v][1] += s * w.y; acc[v][2] += s * w.z; acc[v][3] += s * w.w; }
            }
        }
#pragma unroll
        for (int v = 0; v < 5; ++v)
#pragma unroll
            for (int e = 0; e < 4; ++e) acc[v][e] += __shfl_down(acc[v][e], 24);
        if (lane < 24) {
#pragma unroll
            for (int v = 0; v < 5; ++v) *(LAS f32x4*)(red + ((wave * 5 + v) * 96 + cl * 4)) = (f32x4){acc[v][0], acc[v][1], acc[v][2], acc[v][3]};
        }
        __syncthreads();
        for (int i = tid; i < 480; i += 512) { const int v = i / 96, n = i % 96; float s = b_mod[u * 96 + n];
#pragma unroll
            for (int w = 0; w < 8; ++w) s += red[(w * 5 + v) * 96 + n];
            mod[v * NMOD + u * 96 + n] = s; }
        __syncthreads();
    }
    __syncthreads();
}

#ifndef MK_SIM_FP8
#define MK_SIM_FP8 0
#endif
__device__ __forceinline__ float m3r(float x) { unsigned u = __float_as_uint(x); u += 0x7FFFFu + ((u >> 20) & 1u); return __uint_as_float(u & 0xFFF00000u); }
__device__ __forceinline__ unsigned pk4_i8(float a0, float a1, float a2, float a3) { const float M = 12582912.f; const unsigned u0 = __float_as_uint(a0 + M), u1 = __float_as_uint(a1 + M), u2 = __float_as_uint(a2 + M), u3 = __float_as_uint(a3 + M);
    return (u0 & 0xffu) | ((u1 & 0xffu) << 8) | ((u2 & 0xffu) << 16) | (u3 << 24); }
template <bool SIM> __device__ __forceinline__ float simq(float x) { return SIM ? m3r(x) : x; }
template <bool SIM> __device__ __forceinline__ void transpose_item(const float* W, int K, int N, bf16* WT, LAS float* scr, int item, int lane) {
    const int nblk = N / 32, kb = item / nblk, nb = item % nblk, k0 = 64 * kb, n0 = 32 * nb;
#pragma unroll 8
    for (int i = 0; i < 32; ++i) { const int kk = 2 * i + (lane >> 5); scr[kk * 33 + (lane & 31)] = simq<SIM>(W[(size_t)(k0 + kk) * N + n0 + (lane & 31)]); }
    asm volatile("s_waitcnt lgkmcnt(0)" ::: "memory");
    const int c = lane & 7;
#pragma unroll
    for (int j = 0; j < 4; ++j) { const int n = (lane >> 3) + 8 * j; const LAS float* s = scr + (8 * c) * 33 + n;
        uint4 o; o.x = pk2(s[0 * 33], s[1 * 33]); o.y = pk2(s[2 * 33], s[3 * 33]); o.z = pk2(s[4 * 33], s[5 * 33]); o.w = pk2(s[6 * 33], s[7 * 33]);
        *(uint4*)(WT + (size_t)(n0 + n) * K + k0 + 8 * c) = o; }
    asm volatile("s_waitcnt lgkmcnt(0)" ::: "memory");
}
__device__ __forceinline__ void ph_conv(const Args& a, LAS unsigned char* lds, bool skipq) {
    const int lane = LANE, wave = WAVE, gw = GW, ngw = NGW;
    LAS float* scr = (LAS float*)(lds + wave * 16384);
    bf16* wt_in = (bf16*)(a.ws + WS_WT_IN); bf16* wt_out = (bf16*)(a.ws + WS_WT_OUT); bf16* wt_q = (bf16*)(a.ws + WS_WT_Q);
    constexpr int IT_IN = (DM / 64) * (NIN / 32), IT_OUT = (DM / 64) * (DM / 32), IT_Q = (DM / 64) * (2048 / 32);
    for (int it = gw; it < (skipq ? 0 : IT_IN + IT_OUT + IT_Q); it += ngw) {
        int r = it;
        if (r < IT_IN) { transpose_item<(MK_SIM_FP8 & 1) != 0>(a.in[I_WIN], DM, NIN, wt_in, scr, r, lane); continue; } r -= IT_IN;
        if (r < IT_OUT) { transpose_item<(MK_SIM_FP8 & 2) != 0>(a.in[I_WOUT], DM, DM, wt_out, scr, r, lane); continue; } r -= IT_OUT;
        transpose_item<(MK_SIM_FP8 & 4) != 0>(a.in[I_WQ], DM, 2048, wt_q, scr, r, lane);
    }
    const int gt = blockIdx.x * 512 + TID, ngt = gridDim.x * 512;
    for (int i = gt; i < (skipq ? 0 : (NINP - NIN) * DM / 8); i += ngt) *(uint4*)(wt_in + (size_t)NIN * DM + (size_t)i * 8) = make_uint4(0u, 0u, 0u, 0u);
    { bf16* wlr = (bf16*)(a.ws + WS_WLR); const float* w2 = a.in[I_W2]; const float* a2 = a.in[I_A2]; const float* g2 = a.in[I_G2];
      for (int i = gt; i < NLR * (KLRW / 8); i += ngt) { const int n = i / (KLRW / 8), k0 = (i % (KLRW / 8)) * 8; const int type = n >> 11, cch = n & 2047;
          float f[8];
#pragma unroll
          for (int e = 0; e < 8; ++e) { const int k = k0 + e; float v = 0.f;
              if (type == 4) v = g2[(size_t)k * RW + cch];
              else { const int d = type & 1, kk = k - 128 * d; const float* src = type < 2 ? w2 : a2; if (kk >= 0 && kk < 96) v = src[(size_t)(d * 96 + kk) * RW + cch]; }
              f[e] = v; }
          st16(wlr + (size_t)n * KLRW + k0, pack8(f)); } }
    { bf16* kbd = (bf16*)(a.ws + WS_KBD); const float* k1 = a.in[I_K1]; const float* k2 = a.in[I_K2];
      for (int i = gt; i < 2048 * 32; i += ngt) { const int n = i >> 5, k0 = (i & 31) * 8; float f[8];
          const int h = n >> 8, sb = (n >> 7) & 1, key = n & 127;
          if ((k0 >> 7) == sb) { const float* src = (sb ? k2 : k1) + ((size_t)(h * 128 + key) * 128 + (k0 & 127)); ldf8(src, f); }
          else {
#pragma unroll
              for (int e = 0; e < 8; ++e) f[e] = 0.f; }
          st16(kbd + (size_t)n * 256 + k0, pack8(f)); } }
}

template <bool SIM> __device__ __forceinline__ void norm_mod_row(const float* src, const float* g, const float* sh, const float* sc, bf16* dst, int lane) {
    float4 v[16]; float ss = 0.f;
#pragma unroll
    for (int j = 0; j < 16; ++j) { v[j] = *(const float4*)(src + (lane + 64 * j) * 4); ss += (v[j].x * v[j].x + v[j].y * v[j].y) + (v[j].z * v[j].z + v[j].w * v[j].w); }
    const float rstd = rsqrtf(wave_sum(ss) * (1.f / DM) + RMS_EPS);
#pragma unroll
    for (int j = 0; j < 16; ++j) { const int c = (lane + 64 * j) * 4; const float4 gg = *(const float4*)(g + c), s1 = *(const float4*)(sc + c), s0 = *(const float4*)(sh + c);
        const float o0 = v[j].x * rstd * gg.x * (1.f + s1.x) + s0.x, o1 = v[j].y * rstd * gg.y * (1.f + s1.y) + s0.y, o2 = v[j].z * rstd * gg.z * (1.f + s1.z) + s0.z, o3 = v[j].w * rstd * gg.w * (1.f + s1.w) + s0.w;
        uint2 w; w.x = pk2(simq<SIM>(o0), simq<SIM>(o1)); w.y = pk2(simq<SIM>(o2), simq<SIM>(o3)); *(uint2*)(dst + c) = w; }
}
#ifndef MK_F8
#define MK_F8 2
#endif
constexpr float QMAX = MK_F8 == 2 ? 127.f : 440.f;
__device__ __forceinline__ unsigned pk4_fp8(float a0, float a1, float a2, float a3) {
    if (MK_F8 == 2) { const float M = 12582912.f; const unsigned u0 = __float_as_uint(a0 + M), u1 = __float_as_uint(a1 + M), u2 = __float_as_uint(a2 + M), u3 = __float_as_uint(a3 + M);
        return (u0 & 0xffu) | ((u1 & 0xffu) << 8) | ((u2 & 0xffu) << 16) | (u3 << 24); }
    int w = 0; w = __builtin_amdgcn_cvt_pk_fp8_f32(a0, a1, w, false); w = __builtin_amdgcn_cvt_pk_fp8_f32(a2, a3, w, true); return (unsigned)w; }
constexpr float QMAX_XN2 = (MK_F8 == 2 && (MK_PEER_FP4 == 4 || MK_PEER_FP4 == 5 || MK_PEER_FP4 == 6)) ? 119.f : QMAX;
template <bool SRCBF = false> __device__ __forceinline__ void norm_mod_row_f8(const float* src, const float* g, const float* sh, const float* sc, unsigned char* dst, float* sa, int lane, float qmax = QMAX) {
    float4 v[16]; float ss = 0.f;
#pragma unroll
    for (int j = 0; j < 16; ++j) { if (SRCBF) { const uint2 q = *(const uint2*)((const bf16*)src + (lane + 64 * j) * 4); v[j] = make_float4(bflo(q.x), bfhi(q.x), bflo(q.y), bfhi(q.y)); } else v[j] = *(const float4*)(src + (lane + 64 * j) * 4); ss += (v[j].x * v[j].x + v[j].y * v[j].y) + (v[j].z * v[j].z + v[j].w * v[j].w); }
    const float rstd = rsqrtf(wave_sum(ss) * (1.f / DM) + RMS_EPS); float am = 0.f;
#pragma unroll
    for (int j = 0; j < 16; ++j) { const int c = (lane + 64 * j) * 4; const float4 gg = *(const float4*)(g + c), s1 = *(const float4*)(sc + c), s0 = *(const float4*)(sh + c);
        v[j].x = v[j].x * rstd * gg.x * (1.f + s1.x) + s0.x; v[j].y = v[j].y * rstd * gg.y * (1.f + s1.y) + s0.y; v[j].z = v[j].z * rstd * gg.z * (1.f + s1.z) + s0.z; v[j].w = v[j].w * rstd * gg.w * (1.f + s1.w) + s0.w;
        am = fmaxf(fmaxf(am, fmaxf(fabsf(v[j].x), fabsf(v[j].y))), fmaxf(fabsf(v[j].z), fabsf(v[j].w))); }
    am = wave_max(am);
    const float scale = am > 0.f ? am / qmax : 1.f, inv = 1.f / scale;
#pragma unroll
    for (int j = 0; j < 16; ++j) *(unsigned*)(dst + (lane + 64 * j) * 4) = pk4_fp8(v[j].x * inv, v[j].y * inv, v[j].z * inv, v[j].w * inv);
    if (lane == 0) *sa = scale;
}
#ifndef MK_QG
#define MK_QG 7
#endif
constexpr bool QG1 = MK_F8 && (MK_QG & 1), QG2 = MK_F8 && (MK_QG & 2), QGQ = MK_F8 && (MK_QG & 4);
#ifndef MK_HBF
#define MK_HBF 1
#endif
constexpr bool HBF = MK_HBF && QG2 && QGQ;
constexpr size_t WS_HB = WS_R;
static_assert(WS_HB + (size_t)MX * DM * 2 <= WS_V, "ws map hb");
struct EpiResB {
    static constexpr bool PERM = true, AFTER_DRAIN = false;
    bf16* H; const float* X; const float* mod; const float* sa; const float* sb;
    template <class AT> __device__ __forceinline__ void operator()(const AT (&acc)[2][2][4][2], const pg8::Unit& u, int wr, int wc, int fr, int fq) const {
        const int row0 = u.pm * 256 + wr * 64 + fr, col0 = u.pn * 256 + wc * 32 + 8 * fq;
        const float* gt = mod + (size_t)((u.pm * 256) / SEQ) * NMOD + 2 * DM;
        asm volatile("" ::: "memory");
        pg8::f32x4 gv[2][2];
#pragma unroll
        for (int bj = 0; bj < 2; ++bj)
#pragma unroll
            for (int n = 0; n < 2; ++n) gv[bj][n] = *(const pg8::f32x4*)(gt + col0 + bj * 128 + 4 * n) * *(const pg8::f32x4*)(sb + col0 + bj * 128 + 4 * n);
#pragma unroll
        for (int ai = 0; ai < 2; ++ai)
#pragma unroll
            for (int m = 0; m < 4; ++m) { const int row = row0 + ai * 128 + m * 16; const size_t off = (size_t)row * DM + col0; const float rs = sa[row];
#pragma unroll
                for (int bj = 0; bj < 2; ++bj) { const pg8::f32x4 x0 = *(const pg8::f32x4*)(X + off + bj * 128), x1 = *(const pg8::f32x4*)(X + off + bj * 128 + 4);
                    const pg8::f32x4 v0 = x0 + gv[bj][0] * (__builtin_convertvector(acc[ai][bj][m][0], pg8::f32x4) * rs), v1 = x1 + gv[bj][1] * (__builtin_convertvector(acc[ai][bj][m][1], pg8::f32x4) * rs);
                    pg8::u32x4 w; w.x = pk2(v0[0], v0[1]); w.y = pk2(v0[2], v0[3]); w.z = pk2(v1[0], v1[1]); w.w = pk2(v1[2], v1[3]);
                    *(pg8::u32x4*)(H + off + bj * 128) = w; }
                asm volatile("" ::: "memory"); }
    }
};
__device__ __forceinline__ void ph_w8(const Args& a) {
    const int lane = LANE;
    constexpr int N1 = QG1 ? NINP : 0, N2 = QG2 ? DM : 0, N3 = QGQ ? 2048 : 0;
    for (int r = GW; r < N1 + N2 + N3; r += NGW) {
        const bf16* wt; unsigned char* w8; float* sb; int n = r;
        if (n < N1) { wt = (const bf16*)(a.ws + WS_WT_IN); w8 = a.ws + WS_W8; sb = (float*)(a.ws + WS_SB); }
        else if (n < N1 + N2) { n -= N1; wt = (const bf16*)(a.ws + WS_WT_OUT); w8 = a.ws + WS_W8O; sb = (float*)(a.ws + WS_SB2); }
        else { n -= N1 + N2; wt = (const bf16*)(a.ws + WS_WT_Q); w8 = a.ws + WS_W8Q; sb = (float*)(a.ws + WS_SBQ); }
        uint4 q[8]; float am = 0.f;
#pragma unroll
        for (int j = 0; j < 8; ++j) q[j] = ld16(wt + (size_t)n * DM + (lane + 64 * j) * 8);
        float f[8][8];
#pragma unroll
        for (int j = 0; j < 8; ++j) { unpack8(q[j], f[j]);
#pragma unroll
            for (int e = 0; e < 8; ++e) am = fmaxf(am, fabsf(f[j][e])); }
        am = wave_max(am);
        const float scale = am > 0.f ? am * (1.f / QMAX) : 1.f, inv = 1.f / scale;
#pragma unroll
        for (int j = 0; j < 8; ++j) { uint2 w; w.x = pk4_fp8(f[j][0] * inv, f[j][1] * inv, f[j][2] * inv, f[j][3] * inv); w.y = pk4_fp8(f[j][4] * inv, f[j][5] * inv, f[j][6] * inv, f[j][7] * inv);
            *(uint2*)(w8 + (size_t)n * DM + (lane + 64 * j) * 8) = w; }
        if (lane == 0) sb[n] = scale;
    }
}
constexpr bool CONVQ = MK_F8 == 2 && (MK_QG & 7) == 7;
__device__ __forceinline__ void ph_convq(const Args& a, LAS unsigned char* lds) {
    const int lane = LANE, wave = WAVE, tid = TID;
    LAS float* scr = (LAS float*)(lds + wave * 16384); LAS float* cms = (LAS float*)(lds + 12288);
    constexpr int U_IN = NIN / 32, U_OUT = DM / 32, U_Q = 2048 / 32;
    for (int u = blockIdx.x; u < U_IN + U_OUT + U_Q; u += gridDim.x) {
        const float* W; int N; unsigned char* w8; float* sb; int n0;
        if (u < U_IN) { W = a.in[I_WIN]; N = NIN; w8 = a.ws + WS_W8; sb = (float*)(a.ws + WS_SB); n0 = 32 * u; }
        else if (u < U_IN + U_OUT) { W = a.in[I_WOUT]; N = DM; w8 = a.ws + WS_W8O; sb = (float*)(a.ws + WS_SB2); n0 = 32 * (u - U_IN); }
        else { W = a.in[I_WQ]; N = 2048; w8 = a.ws + WS_W8Q; sb = (float*)(a.ws + WS_SBQ); n0 = 32 * (u - U_IN - U_OUT); }
        const int cq = lane & 7, kr = lane >> 3;
        const float* wp = W + (size_t)(512 * wave + kr) * N + n0 + 4 * cq;
        float m0 = 0.f, m1 = 0.f, m2 = 0.f, m3 = 0.f;
#pragma unroll 1
        for (int t = 0; t < 8; ++t) {
#pragma unroll
            for (int i = 0; i < 8; ++i) { const float4 x = *(const float4*)(wp + (size_t)(64 * t + 8 * i) * N); m0 = fmaxf(m0, fabsf(x.x)); m1 = fmaxf(m1, fabsf(x.y)); m2 = fmaxf(m2, fabsf(x.z)); m3 = fmaxf(m3, fabsf(x.w)); }
        }
#pragma unroll
        for (int d = 8; d < 64; d <<= 1) { m0 = fmaxf(m0, __shfl_xor(m0, d)); m1 = fmaxf(m1, __shfl_xor(m1, d)); m2 = fmaxf(m2, __shfl_xor(m2, d)); m3 = fmaxf(m3, __shfl_xor(m3, d)); }
        if (lane < 8) *(LAS f32x4*)(cms + wave * 32 + 4 * lane) = (f32x4){m0, m1, m2, m3};
        __syncthreads();
        f32x4 cm = *(const LAS f32x4*)(cms + 4 * cq);
#pragma unroll
        for (int w = 1; w < 8; ++w) { const f32x4 o = *(const LAS f32x4*)(cms + w * 32 + 4 * cq); cm[0] = fmaxf(cm[0], o[0]); cm[1] = fmaxf(cm[1], o[1]); cm[2] = fmaxf(cm[2], o[2]); cm[3] = fmaxf(cm[3], o[3]); }
        f32x4 sc4, inv4;
#pragma unroll
        for (int e = 0; e < 4; ++e) { sc4[e] = cm[e] > 0.f ? cm[e] * (1.f / 127.f) : 1.f; inv4[e] = 1.f / sc4[e]; }
        if (tid < 8) *(f32x4*)(sb + n0 + 4 * tid) = sc4;
#pragma unroll 1
        for (int t = 0; t < 8; ++t) {
            const int k0 = 512 * wave + 64 * t;
#pragma unroll
            for (int i = 0; i < 8; ++i) { const float4 x = *(const float4*)(wp + (size_t)(64 * t + 8 * i) * N); LAS float* d = scr + (8 * i + kr) * 33 + 4 * cq;
                d[0] = x.x * inv4[0]; d[1] = x.y * inv4[1]; d[2] = x.z * inv4[2]; d[3] = x.w * inv4[3]; }
            asm volatile("s_waitcnt lgkmcnt(0)" ::: "memory");
            const int c = lane & 7;
#pragma unroll
            for (int j = 0; j < 4; ++j) { const int n = (lane >> 3) + 8 * j; const LAS float* sp = scr + (8 * c) * 33 + n;
                uint2 o; o.x = pk4_i8(sp[0 * 33], sp[1 * 33], sp[2 * 33], sp[3 * 33]); o.y = pk4_i8(sp[4 * 33], sp[5 * 33], sp[6 * 33], sp[7 * 33]);
                *(uint2*)(w8 + (size_t)(n0 + n) * DM + k0 + 8 * c) = o; }
            asm volatile("s_waitcnt lgkmcnt(0)" ::: "memory");
        }
        __syncthreads();
    }
    const int gt = blockIdx.x * 512 + tid, ngt = gridDim.x * 512;
    for (int i = gt; i < (NINP - NIN) * DM / 16; i += ngt) *(uint4*)(a.ws + WS_W8 + (size_t)NIN * DM + (size_t)i * 16) = make_uint4(0u, 0u, 0u, 0u);
    for (int i = gt; i < NINP - NIN; i += ngt) ((float*)(a.ws + WS_SB))[NIN + i] = 1.f;
}
__device__ __forceinline__ void ph_norm1(const Args& a) {
    const int lane = LANE; const float* mod = (const float*)(a.ws + WS_MOD); bf16* A1 = (bf16*)(a.ws + WS_A1);
    for (int m = GW; m < MT; m += NGW) {
        const float* src = m < MX ? a.in[I_X] + (size_t)m * DM : a.in[I_CTX] + (size_t)(m - MX) * DM;
        const int v = m < MX ? m / SEQ : 4;
#if MK_F8 && (MK_QG & 1)
        norm_mod_row_f8(src, a.in[I_N1G], mod + (size_t)v * NMOD, mod + (size_t)v * NMOD + DM, a.ws + WS_A1 + (size_t)m * DM, (float*)(a.ws + WS_SA) + m, lane);
#else
        norm_mod_row<(MK_SIM_FP8 & 1) != 0>(src, a.in[I_N1G], mod + (size_t)v * NMOD, mod + (size_t)v * NMOD + DM, A1 + (size_t)m * DM, lane);
#endif
    }
}
__device__ __forceinline__ void ph_norm2(const Args& a) {
    const int lane = LANE; const float* mod = (const float*)(a.ws + WS_MOD); bf16* XN2 = (bf16*)(a.ws + WS_XN2);
    for (int m = GW; m < MX; m += NGW) {
        const int v = m / SEQ;
#if MK_F8 && (MK_QG & 4)
        norm_mod_row_f8<HBF>(HBF ? (const float*)((const bf16*)(a.ws + WS_HB) + (size_t)m * DM) : a.out + (size_t)m * DM, a.in[I_N2G], mod + (size_t)v * NMOD + 3 * DM, mod + (size_t)v * NMOD + 4 * DM, a.ws + WS_XN2 + (size_t)m * DM, (float*)(a.ws + WS_SA) + m, lane, QMAX_XN2);
#else
        norm_mod_row<(MK_SIM_FP8 & 4) != 0>(a.out + (size_t)m * DM, a.in[I_N2G], mod + (size_t)v * NMOD + 3 * DM, mod + (size_t)v * NMOD + 4 * DM, XN2 + (size_t)m * DM, lane);
#endif
    }
}
__device__ __forceinline__ void ph_tabconv(const Args& a, int row0, int row1, int wv, int nwv) {
    const int lane = LANE;
    unsigned char* U8 = a.ws + WS_U8; unsigned char* V8 = a.ws + WS_V8; float* USC = (float*)(a.ws + WS_USC); float* VSC = (float*)(a.ws + WS_VSC);
    for (int row = row0 + wv; row < row1; row += nwv) {
        const int tb = row >> 14, r = row & 16383;
        const float* src = (tb ? a.in[I_PV] : a.in[I_PU]) + (size_t)r * DM;
        float4 v[16]; float am = 0.f;
#pragma unroll
        for (int j = 0; j < 16; ++j) { v[j] = *(const float4*)(src + (lane + 64 * j) * 4); am = fmaxf(fmaxf(am, fmaxf(fabsf(v[j].x), fabsf(v[j].y))), fmaxf(fabsf(v[j].z), fabsf(v[j].w))); }
        am = wave_max(am);
        if (MK_PEER_FP4 == 3) {
            const float scale = am > 0.f ? am * (1.f / 127.f) : 1.f, inv = 1.f / scale;
            unsigned char* d8 = (tb ? V8 : U8) + (size_t)r * 4096 + lane * 16;
#pragma unroll
            for (int p = 0; p < 4; ++p) { unsigned w4[4];
#pragma unroll
                for (int d = 0; d < 4; ++d) { const float4 q = v[4 * p + d]; w4[d] = pk4_i8(q.x * inv, q.y * inv, q.z * inv, q.w * inv); }
                *(uint4*)(d8 + 1024 * p) = make_uint4(w4[0], w4[1], w4[2], w4[3]); }
            if (lane == 0) (tb ? VSC : USC)[r] = scale;
            continue;
        }
        if (MK_PEER_FP4 == 6) {
            unsigned char* tabp = (tb ? V8 : U8) + (size_t)r * 2176; float bmx[2];
#pragma unroll
            for (int p = 0; p < 2; ++p) { float bm = 0.f;
#pragma unroll
                for (int j = 0; j < 8; ++j) { const float4 q = v[8 * p + j]; bm = fmaxf(fmaxf(bm, fmaxf(fabsf(q.x), fabsf(q.y))), fmaxf(fabsf(q.z), fabsf(q.w))); }
                bmx[p] = bm; }
            const float rs = am * (1.f / 7.f), rinv = rs > 0.f ? 1.f / rs : 0.f;
            unsigned codes = 0u;
#pragma unroll
            for (int p = 0; p < 2; ++p) {
                const float ratio = bmx[p] * (1.f / 7.f) * rinv;
                int code = __builtin_amdgcn_cvt_pk_fp8_f32(ratio, ratio, 0, false) & 0xff; float dec = __builtin_amdgcn_cvt_f32_fp8(code, 0);
                if (dec < ratio) { code += 1; dec = __builtin_amdgcn_cvt_f32_fp8(code, 0); }
                codes |= (unsigned)code << (8 * p);
                const float bsc = dec * rs, binv = bsc > 0.f ? 1.f / bsc : 0.f;
                unsigned w4[4];
#pragma unroll
                for (int d = 0; d < 4; ++d) { const float4 qa = v[8 * p + 2 * d], qb = v[8 * p + 2 * d + 1]; const float M = 12582912.f + (tb ? 8.f : 0.f);
                    w4[d] = (__float_as_uint(qa.x * binv + M) & 15u) | ((__float_as_uint(qa.y * binv + M) & 15u) << 4) | ((__float_as_uint(qa.z * binv + M) & 15u) << 8) | ((__float_as_uint(qa.w * binv + M) & 15u) << 12)
                          | ((__float_as_uint(qb.x * binv + M) & 15u) << 16) | ((__float_as_uint(qb.y * binv + M) & 15u) << 20) | ((__float_as_uint(qb.z * binv + M) & 15u) << 24) | (__float_as_uint(qb.w * binv + M) << 28); }
                *(uint4*)(tabp + 1024 * p + lane * 16) = make_uint4(w4[0], w4[1], w4[2], w4[3]);
            }
            *(unsigned short*)(tabp + 2048 + lane * 2) = (unsigned short)codes;
            if (lane == 0) (tb ? VSC : USC)[r] = rs;
            continue;
        }
        if (MK_PEER_FP4 == 5 && tb == 1) {
            unsigned char* d4 = V8 + (size_t)r * 2304 + lane * 16; unsigned scw = 0u; float smax = 0.f;
#pragma unroll
            for (int p = 0; p < 2; ++p) {
                float bm = 0.f;
#pragma unroll
                for (int j = 0; j < 8; ++j) { const float4 q = v[8 * p + j]; bm = fmaxf(fmaxf(bm, fmaxf(fabsf(q.x), fabsf(q.y))), fmaxf(fabsf(q.z), fabsf(q.w))); }
                const unsigned sb = bm > 0.f ? f2bf(bm * (1.f / 7.f)) : 0x3f80u; const float bsc = __uint_as_float(sb << 16), binv = 1.f / bsc;
                scw |= sb << (16 * p); smax = fmaxf(smax, bsc);
                unsigned w4[4];
#pragma unroll
                for (int d = 0; d < 4; ++d) { const float4 qa = v[8 * p + 2 * d], qb = v[8 * p + 2 * d + 1]; const float M = 12582912.f + 8.f;
                    w4[d] = (__float_as_uint(qa.x * binv + M) & 15u) | ((__float_as_uint(qa.y * binv + M) & 15u) << 4) | ((__float_as_uint(qa.z * binv + M) & 15u) << 8) | ((__float_as_uint(qa.w * binv + M) & 15u) << 12)
                          | ((__float_as_uint(qb.x * binv + M) & 15u) << 16) | ((__float_as_uint(qb.y * binv + M) & 15u) << 20) | ((__float_as_uint(qb.z * binv + M) & 15u) << 24) | (__float_as_uint(qb.w * binv + M) << 28); }
                *(uint4*)(d4 + 1024 * p) = make_uint4(w4[0], w4[1], w4[2], w4[3]);
            }
            *(unsigned*)(V8 + (size_t)r * 2304 + 2048 + lane * 4) = scw;
            smax = wave_max(smax);
            if (lane == 0) VSC[r] = smax;
            continue;
        }
        if ((MK_PEER_FP4 == 4 || MK_PEER_FP4 == 5) && tb == 0) {
            unsigned char* d4 = U8 + (size_t)r * 2304 + lane * 16; unsigned scw = 0u;
#pragma unroll
            for (int p = 0; p < 2; ++p) {
                float bm = 0.f;
#pragma unroll
                for (int j = 0; j < 8; ++j) { const float4 q = v[8 * p + j]; bm = fmaxf(fmaxf(bm, fmaxf(fabsf(q.x), fabsf(q.y))), fmaxf(fabsf(q.z), fabsf(q.w))); }
                const unsigned sb = bm > 0.f ? f2bf(bm * (1.f / 7.f)) : 0x3f80u; const float binv = 1.f / __uint_as_float(sb << 16);
                scw |= sb << (16 * p);
                unsigned w4[4];
#pragma unroll
                for (int d = 0; d < 4; ++d) { const float4 qa = v[8 * p + 2 * d], qb = v[8 * p + 2 * d + 1]; const float M = 12582912.f;
                    w4[d] = (__float_as_uint(qa.x * binv + M) & 15u) | ((__float_as_uint(qa.y * binv + M) & 15u) << 4) | ((__float_as_uint(qa.z * binv + M) & 15u) << 8) | ((__float_as_uint(qa.w * binv + M) & 15u) << 12)
                          | ((__float_as_uint(qb.x * binv + M) & 15u) << 16) | ((__float_as_uint(qb.y * binv + M) & 15u) << 20) | ((__float_as_uint(qb.z * binv + M) & 15u) << 24) | (__float_as_uint(qb.w * binv + M) << 28); }
                *(uint4*)(d4 + 1024 * p) = make_uint4(w4[0], w4[1], w4[2], w4[3]);
            }
            *(unsigned*)(U8 + (size_t)r * 2304 + 2048 + lane * 4) = scw;
            if (lane == 0) USC[r] = 1.f;
            continue;
        }
        if ((tb ? (MK_PEER_FP4 == 1 || MK_PEER_FP4 == 2) : MK_PEER_FP4 == 2)) {
            unsigned char* d4 = (tb ? V8 : U8) + (size_t)r * 2304 + lane * 16; unsigned scw = 0u;
#pragma unroll
            for (int p = 0; p < 2; ++p) {
                float bm = 0.f;
#pragma unroll
                for (int j = 0; j < 8; ++j) { const float4 q = v[8 * p + j]; bm = fmaxf(fmaxf(bm, fmaxf(fabsf(q.x), fabsf(q.y))), fmaxf(fabsf(q.z), fabsf(q.w))); }
                const unsigned sb = bm > 0.f ? f2bf(bm * (1.f / 6.f)) : 0x3f80u; const float binv = 1.f / __uint_as_float(sb << 16);
                scw |= sb << (16 * p);
                unsigned w4[4] = {0u, 0u, 0u, 0u};
#pragma unroll
                for (int d = 0; d < 4; ++d) { const float4 qa4 = v[8 * p + 2 * d], qb4 = v[8 * p + 2 * d + 1];
                    unsigned wv = 0u;
                    wv = __builtin_amdgcn_cvt_scalef32_pk_fp4_f32(wv, qa4.x * binv, qa4.y * binv, 1.0f, 0); wv = __builtin_amdgcn_cvt_scalef32_pk_fp4_f32(wv, qa4.z * binv, qa4.w * binv, 1.0f, 1);
                    wv = __builtin_amdgcn_cvt_scalef32_pk_fp4_f32(wv, qb4.x * binv, qb4.y * binv, 1.0f, 2); wv = __builtin_amdgcn_cvt_scalef32_pk_fp4_f32(wv, qb4.z * binv, qb4.w * binv, 1.0f, 3);
                    w4[d] = wv; }
                *(uint4*)(d4 + 1024 * p) = make_uint4(w4[0], w4[1], w4[2], w4[3]);
            }
            *(unsigned*)((tb ? V8 : U8) + (size_t)r * 2304 + 2048 + lane * 4) = scw;
            if (lane == 0) (tb ? VSC : USC)[r] = 1.f;
            continue;
        }
        const float scale = am > 0.f ? am * (1.f / 7.5f) : 1.f, inv = 1.f / scale;
        unsigned char* dst = (tb ? V8 : U8) + (size_t)r * 3072 + lane * 16;
        unsigned long long pk[6];
#pragma unroll
        for (int p = 0; p < 2; ++p) {
            unsigned long long w0 = 0ull, w1 = 0ull, w2 = 0ull;
#pragma unroll
            for (int k = 0; k < 32; ++k) {
                const float4 q = v[8 * p + (k >> 2)]; const float x = ((k & 3) == 0 ? q.x : (k & 3) == 1 ? q.y : (k & 3) == 2 ? q.z : q.w) * inv; const float ax = fabsf(x);
                float cf = ax < 2.f ? rintf(ax * 8.f) : (ax < 4.f ? rintf(ax * 4.f) + 8.f : rintf(ax * 2.f) + 16.f);
                cf = fminf(cf, 31.f);
                const unsigned long long code = (unsigned long long)((unsigned)cf | (x < 0.f ? 32u : 0u));
                const int pos = 6 * k, wd = pos >> 6, off = pos & 63;
                if (wd == 0) w0 |= code << off; else if (wd == 1) w1 |= code << off; else w2 |= code << off;
                if (off > 58) { if (wd == 0) w1 |= code >> (64 - off); else w2 |= code >> (64 - off); }
            }
            pk[3 * p] = w0; pk[3 * p + 1] = w1; pk[3 * p + 2] = w2;
        }
#pragma unroll
        for (int k = 0; k < 3; ++k) *(uint4*)(dst + 1024 * k) = make_uint4((unsigned)pk[2 * k], (unsigned)(pk[2 * k] >> 32), (unsigned)pk[2 * k + 1], (unsigned)(pk[2 * k + 1] >> 32));
        if (lane == 0) (tb ? VSC : USC)[r] = scale;
    }
}

__device__ __forceinline__ void ldf8s(const LAS float* p, float (&f)[8]) { const f32x4 a = *(const LAS f32x4*)p, b = *(const LAS f32x4*)(p + 4); f[0] = a[0]; f[1] = a[1]; f[2] = a[2]; f[3] = a[3]; f[4] = b[0]; f[5] = b[1]; f[6] = b[2]; f[7] = b[3]; }
constexpr int PL_MU = 0, PL_KK = 27136, PL_CW = 35328, PL_CB = 84480, PL_END = 100864;
__device__ __forceinline__ void ph_prep_stage(const Args& a, LAS unsigned char* lds) {
    const int tid = TID;
    for (int i = tid; i < RCOLS; i += 512) ((LAS float*)(lds + PL_MU))[i] = a.in[I_MU][i];
    for (int i = tid; i < RW; i += 512) ((LAS float*)(lds + PL_KK))[i] = a.in[I_KK][i];
    for (int i = tid; i < 3 * 4096; i += 512) ((LAS float*)(lds + PL_CW))[i] = a.in[I_CONVW][i];
    for (int i = tid; i < 4096; i += 512) ((LAS float*)(lds + PL_CB))[i] = a.in[I_CONVB][i];
    __syncthreads();
}
__device__ __forceinline__ void ph_prep_rwkv(const Args& a, LAS unsigned char* lds) {
    const int lane = LANE;
    const bf16* P = (const bf16*)(a.ws + WS_P);
    bf16* R = (bf16*)(a.ws + WS_R); bf16* K = (bf16*)(a.ws + WS_K); bf16* V = (bf16*)(a.ws + WS_V); bf16* KK = (bf16*)(a.ws + WS_KK); bf16* ALR = (bf16*)(a.ws + WS_ALR);
    const LAS float* mu = (const LAS float*)(lds + PL_MU); const LAS float* k_k = (const LAS float*)(lds + PL_KK);
    for (int m = GW; m < MT; m += NGW) {
        const bool lat = m < MX;
        bool h0, h1, h2 = false, h3 = false; size_t r0, r1, r2 = (size_t)m, r3 = (size_t)m;
        if (lat) { const int t = m & (SEQ - 1), row = t >> 6, col = t & 63; h0 = col > 0; h1 = col < 63; h2 = row > 0; h3 = row < 63; r0 = (size_t)(m - 1); r1 = (size_t)(m + 1); r2 = (size_t)(m - 64); r3 = (size_t)(m + 64); }
        else { const int t = (m - MX) & (CTXL - 1); h0 = t > 0; h1 = t < CTXL - 1; r0 = (size_t)(m - 1); r1 = (size_t)(m + 1); }
        if (!h0) r0 = (size_t)m; if (!h1) r1 = (size_t)m; if (!h2) r2 = (size_t)m; if (!h3) r3 = (size_t)m;
        const bf16* prow = P + (size_t)m * NINP; const bf16* p0 = P + r0 * NINP; const bf16* p1 = P + r1 * NINP; const bf16* p2 = P + r2 * NINP; const bf16* p3 = P + r3 * NINP;
        const float f0 = h0 ? 1.f : 0.f, f1 = h1 ? 1.f : 0.f, f2 = h2 ? 1.f : 0.f, f3 = h3 ? 1.f : 0.f;
        uint4 qo[2][2], q0[2][2], q1[2][2], q2[2][2], q3[2][2];
#define PREP_LOAD(buf, i2v) do { _Pragma("unroll") for (int ii = 0; ii < 2; ++ii) { const int chunk_ = lane + 64 * ((i2v) + ii); const int c0_ = (chunk_ < RCOLS / 8 ? chunk_ : 0) * 8; \
            qo[buf][ii] = ld16(prow + c0_); q0[buf][ii] = ld16(p0 + c0_); q1[buf][ii] = ld16(p1 + c0_); \
            if (lat) { q2[buf][ii] = ld16(p2 + c0_); q3[buf][ii] = ld16(p3 + c0_); } else { q2[buf][ii] = qo[buf][ii]; q3[buf][ii] = qo[buf][ii]; } } } while (0)
        PREP_LOAD(0, 0);
#pragma unroll
        for (int i2 = 0; i2 < 14; i2 += 2) {
            const int cb_ = (i2 >> 1) & 1;
            if (i2 + 2 < 14) { if (cb_) PREP_LOAD(0, i2 + 2); else PREP_LOAD(1, i2 + 2); }
            asm volatile("" ::: "memory");
#pragma unroll
            for (int ii = 0; ii < 2; ++ii) { const int i = i2 + ii; const int chunk = lane + 64 * i;
              if (chunk < RCOLS / 8) {
                const int c0 = chunk * 8;
                float own[8], n0[8], n1[8], sh[8], xm[8], muv[8];
                unpack8(qo[cb_][ii], own); unpack8(q0[cb_][ii], n0); unpack8(q1[cb_][ii], n1);
                if (lat) { float n2[8], n3[8]; unpack8(q2[cb_][ii], n2); unpack8(q3[cb_][ii], n3);
#pragma unroll
                    for (int e = 0; e < 8; ++e) sh[e] = (e & 3) == 0 ? n0[e] * f0 : (e & 3) == 1 ? n1[e] * f1 : (e & 3) == 2 ? n2[e] * f2 : n3[e] * f3;
                } else {
#pragma unroll
                    for (int e = 0; e < 8; ++e) sh[e] = (e & 1) == 0 ? n0[e] * f0 : n1[e] * f1;
                }
                ldf8s(mu + c0, muv);
#pragma unroll
                for (int e = 0; e < 8; ++e) xm[e] = own[e] + muv[e] * (sh[e] - own[e]);
                if (i < 4) st16(R + (size_t)m * RW + c0, pack8(xm));
                else if (i < 8) { const int cc = c0 - 2048; st16(K + (size_t)m * RW + cc, pack8(xm));
                    float kv[8], kkv[8]; ldf8s(k_k + cc, kv); float ss = 0.f;
#pragma unroll
                    for (int e = 0; e < 8; ++e) { kkv[e] = xm[e] * kv[e]; ss += kkv[e] * kkv[e]; }
                    ss = sum8(ss);
                    const float inv = rsqrtf(fmaxf(ss, 1e-24f));
#pragma unroll
                    for (int e = 0; e < 8; ++e) kkv[e] *= inv;
                    st16(KK + (size_t)m * RW + cc, pack8(kkv)); }
                else if (i < 12) st16(V + (size_t)m * RW + (c0 - 4096), pack8(xm));
                else { const int j0 = c0 - 6144; float f[8];
#pragma unroll
                    for (int e = 0; e < 8; ++e) f[e] = j0 < 192 ? 1.f - 2.f * __builtin_amdgcn_rcpf(1.f + __expf(2.f * xm[e])) : (j0 < 384 ? xm[e] : __builtin_amdgcn_rcpf(1.f + __expf(-xm[e])));
                    const int col = j0 < 384 ? (j0 / 96) * 128 + (j0 % 96) : j0 + 128;
                    st16(ALR + (size_t)m * KLR + col, pack8(f)); }
              } else if (i == 13 && lane < 32) {
                const int pc = lane - 16; st16(ALR + (size_t)m * KLR + (pc >> 2) * 128 + 96 + (pc & 3) * 8, make_uint4(0u, 0u, 0u, 0u));
              }
            }
        }
    }
}

constexpr bool ZDIRECT = QG1;
__device__ __forceinline__ void ph_prep_ssd(const Args& a, LAS unsigned char* lds) {
    const int lane = LANE;
    const bf16* P = (const bf16*)(a.ws + WS_P);
    bf16* XS = (bf16*)(a.ws + WS_XS); bf16* BC = (bf16*)(a.ws + WS_BC); bf16* Z = (bf16*)(a.ws + WS_Z); float* DT = (float*)(a.ws + WS_DT); float* LA = (float*)(a.ws + WS_LA);
    const LAS float* cw = (const LAS float*)(lds + PL_CW); const LAS float* cb = (const LAS float*)(lds + PL_CB);
    for (int m = GW; m < MT; m += NGW) {
        const bool lat = m < MX; bool hp, hn;
        if (lat) { const int t = m & (SEQ - 1); hp = t > 0; hn = t < SEQ - 1; } else { const int t = (m - MX) & (CTXL - 1); hp = t > 0; hn = t < CTXL - 1; }
        const bf16* prow = P + (size_t)m * NINP; const bf16* pp = hp ? prow - NINP : prow; const bf16* pn = hn ? prow + NINP : prow;
        const float fp = hp ? 1.f : 0.f, fn = hn ? 1.f : 0.f;
        uint4 zq[4];
        if (lat && !ZDIRECT) {
#pragma unroll
            for (int i = 0; i < 4; ++i) zq[i] = ld16(prow + COL_Z + (lane + 64 * i) * 8);
        }
        const unsigned short dtraw = prow[COL_DT + lane];
        uint4 qc[2][2], qp[2][2], qn[2][2];
#define SSDP_LOAD(buf, i2v) do { _Pragma("unroll") for (int ii = 0; ii < 2; ++ii) { const int c0_ = (lane + 64 * ((i2v) + ii)) * 8; qc[buf][ii] = ld16(prow + COL_XBC + c0_); qp[buf][ii] = ld16(pp + COL_XBC + c0_); qn[buf][ii] = ld16(pn + COL_XBC + c0_); } } while (0)
        SSDP_LOAD(0, 0);
#pragma unroll
        for (int i2 = 0; i2 < 8; i2 += 2) {
            const int cb_ = (i2 >> 1) & 1;
            if (i2 + 2 < 8) { if (cb_) SSDP_LOAD(0, i2 + 2); else SSDP_LOAD(1, i2 + 2); }
            asm volatile("" ::: "memory");
#pragma unroll
            for (int ii = 0; ii < 2; ++ii) { const int i = i2 + ii; const int c0 = (lane + 64 * i) * 8;
                float cur[8], pv[8], nx[8], w0[8], w1[8], w2[8], bb[8], y[8];
                unpack8(qc[cb_][ii], cur); unpack8(qp[cb_][ii], pv); unpack8(qn[cb_][ii], nx);
                ldf8s(cw + c0, w0); ldf8s(cw + 4096 + c0, w1); ldf8s(cw + 8192 + c0, w2); ldf8s(cb + c0, bb);
#pragma unroll
                for (int e = 0; e < 8; ++e) { const float t = w0[e] * (pv[e] * fp) + w1[e] * cur[e] + w2[e] * (nx[e] * fn) + bb[e]; y[e] = t * __builtin_amdgcn_rcpf(1.f + __expf(-t)); }
                if (i < 4) st16(XS + (size_t)m * RW + c0, pack8(y)); else st16(BC + (size_t)m * RW + (c0 - 2048), pack8(y)); }
        }
        { const float raw = __uint_as_float((unsigned)dtraw << 16) + a.in[I_DTB][lane];
          const float dtv = raw > 20.f ? raw : log1pf(expf(raw));
          DT[(size_t)m * 64 + lane] = dtv; LA[(size_t)m * 64 + lane] = -dtv * expf(a.in[I_ALOG][lane]); }
        if (lat && !ZDIRECT) {
#pragma unroll
            for (int i = 0; i < 4; ++i) st16(Z + (size_t)m * RW + (lane + 64 * i) * 8, zq[i]);
        }
    }
}

__device__ __forceinline__ int scan_row(int n, int dir, int b) { return n < CTXL ? MX + b * CTXL + (dir ? CTXL - 1 - n : n) : b * SEQ + (dir ? NSTEP - 1 - n : n - CTXL); }

typedef short bf16x8_t __attribute__((ext_vector_type(8)));
typedef float f32x16 __attribute__((ext_vector_type(16)));
constexpr int SLD = 272;
constexpr int L_C = 0, L_B = 34816, L_BT = 69632, L_XT = 104448, L_S = 121856, L_F = 139264;
static_assert(L_F + 4 * 512 <= LDS_CTL, "ssd lds map");
typedef unsigned u32x4_t __attribute__((ext_vector_type(4)));
__device__ __forceinline__ void lds_st16(LAS unsigned char* p, const uint4& v) { *(LAS u32x4_t*)p = (u32x4_t){v.x, v.y, v.z, v.w}; }
__device__ __forceinline__ uint4 lds_ld16(const LAS unsigned char* p) { const u32x4_t t = *(const LAS u32x4_t*)p; return make_uint4(t[0], t[1], t[2], t[3]); }
__device__ __forceinline__ bf16x8_t lfrag(LAS unsigned char* img, int row, int k) { return *(LAS bf16x8_t*)(img + row * SLD + k * 2); }
__device__ __forceinline__ void ph_ssd_chunked(const Args& a, LAS unsigned char* lds) {
    const int tid = TID, lane = LANE, wave = WAVE, r = lane & 31, hh = lane >> 5;
    typedef unsigned u32x2_t __attribute__((ext_vector_type(2)));
    const bf16* XS = (const bf16*)(a.ws + WS_XS); const bf16* BC = (const bf16*)(a.ws + WS_BC); const float* DT = (const float*)(a.ws + WS_DT); const float* LA = (const float*)(a.ws + WS_LA);
    bf16* YS = (bf16*)a.out + (size_t)2 * MX * RW;
    LAS float* laS = (LAS float*)(lds + L_F); LAS float* dtS = laS + 128; LAS float* cumS = laS + 256;
    for (int u = blockIdx.x; u < 256; u += gridDim.x) {
        const int g = u >> 5, h = u & 31, dir = g >> 2, b = g & 3, gi = h >> 2;
        f32x16 st;
#pragma unroll
        for (int q = 0; q < 16; ++q) st[q] = 0.f;
        __syncthreads();
        for (int i = tid; i < 64 * SLD / 4; i += 512) ((LAS unsigned*)(lds + L_S))[i] = 0u;
        uint4 pB[4], pC[4], pX[2]; float pla = 0.f, pdt = 0.f;
        const int bl0 = 4 * (tid >> 4), bpc = tid & 15, xl0 = 2 * (tid >> 3), xpc = tid & 7;
#define SSD_FETCH2(cc) do { const int n0_ = (cc) * 128; const bool lat_ = (cc) >= CTXL / 128; \
            _Pragma("unroll") for (int k_ = 0; k_ < 4; ++k_) { const size_t m_ = (size_t)scan_row(n0_ + bl0 + k_, dir, b); \
                pB[k_] = ld16(BC + m_ * RW + gi * 128 + bpc * 8); if (lat_) pC[k_] = ld16(BC + m_ * RW + 1024 + gi * 128 + bpc * 8); } \
            _Pragma("unroll") for (int k_ = 0; k_ < 2; ++k_) { const size_t m_ = (size_t)scan_row(n0_ + xl0 + k_, dir, b); pX[k_] = ld16(XS + m_ * RW + h * 64 + xpc * 8); } \
            if (tid < 128) { const size_t m_ = (size_t)scan_row(n0_ + tid, dir, b); pla = LA[m_ * 64 + dir * 32 + h]; pdt = DT[m_ * 64 + dir * 32 + h]; } } while (0)
        SSD_FETCH2(0);
        for (int c = 0; c < NSTEP / 128; ++c) {
            const int n0 = c * 128; const bool lat = c >= CTXL / 128;
#pragma unroll
            for (int k = 0; k < 4; ++k) { lds_st16(lds + L_B + (bl0 + k) * SLD + bpc * 16, pB[k]); if (lat) lds_st16(lds + L_C + (bl0 + k) * SLD + bpc * 16, pC[k]); }
            { const unsigned w0[4] = {pX[0].x, pX[0].y, pX[0].z, pX[0].w}, w1[4] = {pX[1].x, pX[1].y, pX[1].z, pX[1].w};
#pragma unroll
              for (int e = 0; e < 8; ++e) { const unsigned lo = (e & 1) ? (w0[e >> 1] >> 16) : (w0[e >> 1] & 0xffffu), hi = (e & 1) ? (w1[e >> 1] & 0xffff0000u) : (w1[e >> 1] << 16);
                  *(LAS unsigned*)(lds + L_XT + (xpc * 8 + e) * SLD + xl0 * 2) = lo | hi; } }
            if (tid < 128) { laS[tid] = pla; dtS[tid] = pdt; }
            lds_barrier();
            if (wave == 0) { const float a0 = laS[2 * lane], b0 = laS[2 * lane + 1]; float x = a0 + b0;
#pragma unroll
                for (int d = 1; d < 64; d <<= 1) { const float y = __shfl_up(x, d); if (lane >= d) x += y; }
                cumS[2 * lane + 1] = x; cumS[2 * lane] = x - b0; }
            lds_barrier();
            const float ctot = cumS[127];
            { float wl[4]; float fb[4][8];
#pragma unroll
              for (int k = 0; k < 4; ++k) { wl[k] = dtS[bl0 + k] * __expf(ctot - cumS[bl0 + k]); unpack8(pB[k], fb[k]); }
#pragma unroll
              for (int e = 0; e < 8; ++e) *(LAS u32x2_t*)(lds + L_BT + (bpc * 8 + e) * SLD + bl0 * 2) = (u32x2_t){pk2(fb[0][e] * wl[0], fb[1][e] * wl[1]), pk2(fb[2][e] * wl[2], fb[3][e] * wl[3])}; }
            if (c + 1 < NSTEP / 128) SSD_FETCH2(c + 1);
            f32x16 acc0, acc1;
            const int lt = wave >> 1, st0 = 2 * (wave & 1);
            if (lat) {
#pragma unroll
                for (int q = 0; q < 16; ++q) { acc0[q] = 0.f; acc1[q] = 0.f; }
                if (st0 <= lt) {
#pragma unroll
                    for (int ks = 0; ks < 8; ++ks) { const bf16x8_t cf = lfrag(lds + L_C, lt * 32 + r, ks * 16 + 8 * hh);
                        acc0 = __builtin_amdgcn_mfma_f32_32x32x16_bf16(lfrag(lds + L_B, st0 * 32 + r, ks * 16 + 8 * hh), cf, acc0, 0, 0, 0);
                        if (st0 + 1 <= lt) acc1 = __builtin_amdgcn_mfma_f32_32x32x16_bf16(lfrag(lds + L_B, (st0 + 1) * 32 + r, ks * 16 + 8 * hh), cf, acc1, 0, 0, 0); }
                }
            }
            lds_barrier();
            if (lat) {
                const int l = lt * 32 + r; const float cl = cumS[l];
#pragma unroll
                for (int t = 0; t < 2; ++t) { const int stt = st0 + t;
                    if (stt <= lt) {
#pragma unroll
                        for (int gq = 0; gq < 4; ++gq) { const int s0 = stt * 32 + 8 * gq + 4 * hh; const f32x4 cs = *(const LAS f32x4*)(cumS + s0), ds = *(const LAS f32x4*)(dtS + s0); float o[4];
#pragma unroll
                            for (int e = 0; e < 4; ++e) { const float v = t ? acc1[4 * gq + e] : acc0[4 * gq + e]; o[e] = (s0 + e) <= l ? v * __expf(cl - cs[e]) * ds[e] : 0.f; }
                            *(LAS u32x2_t*)(lds + L_B + l * SLD + s0 * 2) = (u32x2_t){pk2(o[0], o[1]), pk2(o[2], o[3])}; } } }
            }
            lds_barrier();
            if (lat) {
                const int pt = wave & 1;
                f32x16 accd, acco;
#pragma unroll
                for (int q = 0; q < 16; ++q) { accd[q] = 0.f; acco[q] = 0.f; }
                for (int ks = 0; ks < 2 * (lt + 1); ++ks)
                    accd = __builtin_amdgcn_mfma_f32_32x32x16_bf16(lfrag(lds + L_XT, pt * 32 + r, ks * 16 + 8 * hh), lfrag(lds + L_B, lt * 32 + r, ks * 16 + 8 * hh), accd, 0, 0, 0);
#pragma unroll
                for (int ks = 0; ks < 8; ++ks)
                    acco = __builtin_amdgcn_mfma_f32_32x32x16_bf16(lfrag(lds + L_S, pt * 32 + r, ks * 16 + 8 * hh), lfrag(lds + L_C, lt * 32 + r, ks * 16 + 8 * hh), acco, 0, 0, 0);
                const int l = lt * 32 + r; const float el = __expf(cumS[l]);
                bf16* yrow = YS + ((size_t)dir * MX + scan_row(n0 + l, dir, b)) * RW + h * 64 + pt * 32;
#pragma unroll
                for (int gq = 0; gq < 4; ++gq) { float y[4];
#pragma unroll
                    for (int e = 0; e < 4; ++e) y[e] = accd[4 * gq + e] + el * acco[4 * gq + e];
                    *(uint2*)(yrow + 8 * gq + 4 * hh) = make_uint2(pk2(y[0], y[1]), pk2(y[2], y[3])); }
            }
            const int nt = wave >> 1, pt2 = wave & 1;
            { const float dc = __expf(ctot);
#pragma unroll
              for (int q = 0; q < 16; ++q) st[q] *= dc;
#pragma unroll
              for (int ks = 0; ks < 8; ++ks)
                  st = __builtin_amdgcn_mfma_f32_32x32x16_bf16(lfrag(lds + L_BT, nt * 32 + r, ks * 16 + 8 * hh), lfrag(lds + L_XT, pt2 * 32 + r, ks * 16 + 8 * hh), st, 0, 0, 0); }
            lds_barrier();
#pragma unroll
            for (int gq = 0; gq < 4; ++gq) *(LAS u32x2_t*)(lds + L_S + (pt2 * 32 + r) * SLD + (nt * 32 + 8 * gq + 4 * hh) * 2) = (u32x2_t){pk2(st[4 * gq], st[4 * gq + 1]), pk2(st[4 * gq + 2], st[4 * gq + 3])};
            lds_barrier();
        }
    }
}

typedef float f32x2_t __attribute__((ext_vector_type(2)));
constexpr int CR_T = 32, CR_PJ = 144, CR_PS = 80, CR_PF = 272;
constexpr int CR_AR = 0, CR_BK = CR_AR + 64 * CR_PJ, CR_BHT = CR_BK + 64 * CR_PJ, CR_KHT = CR_BHT + 64 * CR_PS, CR_VT = CR_KHT + 64 * CR_PS, CR_SB = CR_VT + 64 * CR_PS,
              CR_NAK = CR_SB + 2 * 64 * CR_PJ, CR_PBR = CR_NAK + 32 * CR_PS, CR_PKR = CR_PBR + 32 * CR_PS, CR_NABF = CR_PKR + 32 * CR_PS, CR_RT = CR_NABF + 32 * CR_PJ,
              CR_SA = CR_RT + 32 * CR_PF, CR_GT = CR_SA + 64 * CR_PS, CR_CP = CR_GT + 256, CR_OB = CR_CP + 16 * 256, CR_END = CR_OB + 32 * 128;
static_assert(CR_END <= 131072, "chunked rwkv lds map");
__device__ __forceinline__ f32x16 mfma32(const bf16x8_t& a, const bf16x8_t& b, const f32x16& c) { return __builtin_amdgcn_mfma_f32_32x32x16_bf16(a, b, c, 0, 0, 0); }
__device__ __forceinline__ bf16x8_t cfrag(const LAS unsigned char* img, int pitch, int row, int k) { return *(const LAS bf16x8_t*)(img + row * pitch + k * 2); }
constexpr int P_IMG = 34048, P_GR = 12288, P_SET = P_IMG + P_GR;
constexpr int PO_AR = 0, PO_BK = 9216, PO_BHT = 18432, PO_KHT = 23552, PO_VT = 28672, PO_GT = 33792, PO_NAK = P_IMG, PO_PBR = P_IMG + 2560, PO_PKR = P_IMG + 5120, PO_NABF = P_IMG + 7680;
constexpr int PQ_SB = 2 * P_SET, PQ_RT = PQ_SB + 2 * 64 * CR_PJ, PQ_SA = PQ_RT + 32 * CR_PF, PQ_OB = PQ_SA + 64 * CR_PS, PQ_END = PQ_OB + 32 * 128;
static_assert(PQ_END <= LDS_CTL && (P_SET % 16) == 0, "pipelined rwkv lds map");
struct CRaw4 { unsigned r[4], k[4], kk[4], w[4], al[4], v[4]; };
__device__ __forceinline__ void cr_load4(CRaw4& x, const bf16* R, const bf16* K, const bf16* V, const bf16* KK, const bf16* LR, int n0, int dir, int b, int chn) {
#pragma unroll
    for (int u = 0; u < 4; ++u) { const size_t m = (size_t)scan_row(n0 + u, dir, b);
        x.r[u] = *(const unsigned*)(R + m * RW + chn); x.k[u] = *(const unsigned*)(K + m * RW + chn); x.kk[u] = *(const unsigned*)(KK + m * RW + chn); x.v[u] = *(const unsigned*)(V + m * RW + chn);
        x.w[u] = *(const unsigned*)(LR + m * NLR + dir * 2048 + chn); x.al[u] = *(const unsigned*)(LR + m * NLR + 4096 + dir * 2048 + chn); }
}
__device__ __forceinline__ void cr_stage4(const CRaw4& raw, LAS unsigned char* img, int chl, int sg, int lane, float ka0, float ka1) {
    typedef unsigned u32x2_t __attribute__((ext_vector_type(2)));
    float rv[4][2], kd[4][2], bv[4][2], av[4][2], vv[4][2], cl[4][2], cx[4][2];
    float run0 = 1.f, run1 = 1.f;
#pragma unroll
    for (int u = 0; u < 4; ++u) {
        const float kk0 = bflo(raw.kk[u]), kk1 = bfhi(raw.kk[u]), al0 = bflo(raw.al[u]), al1 = bfhi(raw.al[u]);
        rv[u][0] = bflo(raw.r[u]); rv[u][1] = bfhi(raw.r[u]); vv[u][0] = bflo(raw.v[u]); vv[u][1] = bfhi(raw.v[u]);
        av[u][0] = -kk0; av[u][1] = -kk1; bv[u][0] = kk0 * al0; bv[u][1] = kk1 * al1;
        kd[u][0] = bflo(raw.k[u]) * (1.f + (al0 - 1.f) * ka0); kd[u][1] = bfhi(raw.k[u]) * (1.f + (al1 - 1.f) * ka1);
        cx[u][0] = run0; cx[u][1] = run1; run0 *= 1.f - bflo(raw.w[u]); run1 *= 1.f - bfhi(raw.w[u]); cl[u][0] = run0; cl[u][1] = run1; }
    float inc0 = run0, inc1 = run1;
#pragma unroll
    for (int d = 8; d < 64; d <<= 1) { const float y0 = __shfl_up(inc0, d), y1 = __shfl_up(inc1, d); if (lane >= d) { inc0 *= y0; inc1 *= y1; } }
    float pre0 = __shfl_up(inc0, 8), pre1 = __shfl_up(inc1, 8); if (lane < 8) { pre0 = 1.f; pre1 = 1.f; }
    const float tot0 = __shfl(inc0, 56 + (lane & 7)), tot1 = __shfl(inc1, 56 + (lane & 7));
    if (sg == 0) *(LAS f32x2_t*)(img + PO_GT + chl * 4) = (f32x2_t){tot0, tot1};
    float tb[4][2], tk[4][2];
#pragma unroll
    for (int u = 0; u < 4; ++u) { const int t = 4 * sg + u;
        const float g0 = pre0 * cl[u][0], g1 = pre1 * cl[u][1], gp0 = pre0 * cx[u][0], gp1 = pre1 * cx[u][1];
        const float i0 = __builtin_amdgcn_rcpf(g0), i1 = __builtin_amdgcn_rcpf(g1);
        *(LAS unsigned*)(img + PO_AR + t * CR_PJ + chl * 2) = pk2(av[u][0] * gp0, av[u][1] * gp1);
        *(LAS unsigned*)(img + PO_AR + (32 + t) * CR_PJ + chl * 2) = pk2(rv[u][0] * g0, rv[u][1] * g1);
        *(LAS unsigned*)(img + PO_BK + t * CR_PJ + chl * 2) = pk2(bv[u][0] * i0, bv[u][1] * i1);
        *(LAS unsigned*)(img + PO_BK + (32 + t) * CR_PJ + chl * 2) = pk2(kd[u][0] * i0, kd[u][1] * i1);
        tb[u][0] = bv[u][0] * (tot0 * i0); tb[u][1] = bv[u][1] * (tot1 * i1); tk[u][0] = kd[u][0] * (tot0 * i0); tk[u][1] = kd[u][1] * (tot1 * i1); }
#pragma unroll
    for (int ch = 0; ch < 2; ++ch) {
        *(LAS u32x2_t*)(img + PO_BHT + (chl + ch) * CR_PS + sg * 8) = (u32x2_t){pk2(tb[0][ch], tb[1][ch]), pk2(tb[2][ch], tb[3][ch])};
        *(LAS u32x2_t*)(img + PO_KHT + (chl + ch) * CR_PS + sg * 8) = (u32x2_t){pk2(tk[0][ch], tk[1][ch]), pk2(tk[2][ch], tk[3][ch])};
        *(LAS u32x2_t*)(img + PO_VT + (chl + ch) * CR_PS + sg * 8) = (u32x2_t){pk2(vv[0][ch], vv[1][ch]), pk2(vv[2][ch], vv[3][ch])}; }
}
__device__ __forceinline__ void cr_gram(LAS unsigned char* set, int gtile, int r, int hh) {
    typedef unsigned u32x2_t __attribute__((ext_vector_type(2)));
    f32x16 acc;
#pragma unroll
    for (int q = 0; q < 16; ++q) acc[q] = 0.f;
    const int rb = gtile >> 1, cb = gtile & 1;
#pragma unroll
    for (int ks = 0; ks < 4; ++ks) acc = mfma32(cfrag(set + PO_BK, CR_PJ, 32 * rb + r, 16 * ks + 8 * hh), cfrag(set + PO_AR, CR_PJ, 32 * cb + r, 16 * ks + 8 * hh), acc);
#pragma unroll
    for (int gq = 0; gq < 4; ++gq) { float o[4];
#pragma unroll
        for (int e = 0; e < 4; ++e) { const int sidx = 8 * gq + 4 * hh + e; const bool keep = cb ? (sidx <= r) : (sidx < r); o[e] = keep ? acc[4 * gq + e] : 0.f; }
        if (gtile == 0) {
#pragma unroll
            for (int e = 0; e < 4; ++e) *(LAS float*)(set + PO_NABF + r * CR_PJ + (e * 8 + 2 * gq + hh) * 4) = o[e]; }
        else { LAS unsigned char* dst = set + (gtile == 1 ? PO_PBR : gtile == 2 ? PO_NAK : PO_PKR) + r * CR_PS + (8 * gq + 4 * hh) * 2; *(LAS u32x2_t*)dst = (u32x2_t){pk2(o[0], o[1]), pk2(o[2], o[3])}; } }
}
__device__ __forceinline__ void ph_rwkv_chunked2(const Args& a, LAS unsigned char* lds) {
    const int tid = TID, lane = LANE, wave = WAVE, r = lane & 31, hh = lane >> 5;
    typedef unsigned u32x2_t __attribute__((ext_vector_type(2)));
    const bf16* R = (const bf16*)(a.ws + WS_R); const bf16* K = (const bf16*)(a.ws + WS_K); const bf16* V = (const bf16*)(a.ws + WS_V); const bf16* KK = (const bf16*)(a.ws + WS_KK);
    const bf16* LR = (const bf16*)(a.ws + WS_LR); bf16* OR = (bf16*)a.out;
    constexpr int NCH = NSTEP / CR_T;
    for (int u0 = blockIdx.x; u0 < 256; u0 += gridDim.x) {
        const int g = u0 >> 5, h = u0 & 31, dir = g >> 2, b = g & 3;
        const int sw = wave & 3, cp = lane & 7, sg = lane >> 3, chl = 16 * sw + 2 * cp, chn = h * 64 + chl;
        const float ka0 = a.in[I_KA][chn], ka1 = a.in[I_KA][chn + 1];
        f32x16 st;
#pragma unroll
        for (int q = 0; q < 16; ++q) st[q] = 0.f;
        __syncthreads();
        for (int i = tid; i < 64 * CR_PJ / 4; i += 512) ((LAS unsigned*)(lds + PQ_SB))[i] = 0u;
        CRaw4 raw;
        if (wave >= 4) { cr_load4(raw, R, K, V, KK, LR, 4 * sg, dir, b, chn); cr_stage4(raw, lds, chl, sg, lane, ka0, ka1); cr_load4(raw, R, K, V, KK, LR, CR_T + 4 * sg, dir, b, chn); }
        lds_barrier();
        if (wave >= 4) cr_gram(lds, wave - 4, r, hh);
        lds_barrier();
        for (int c = 0; c < NCH; ++c) {
            const bool lat = c >= CTXL / CR_T;
            LAS unsigned char* setc = lds + (c & 1) * P_SET; LAS unsigned char* setn = lds + ((c + 1) & 1) * P_SET;
            const LAS unsigned char* SBc = lds + PQ_SB + (c & 1) * 64 * CR_PJ; LAS unsigned char* SBn = lds + PQ_SB + ((c + 1) & 1) * 64 * CR_PJ;
            f32x16 acc;
#pragma unroll
            for (int q = 0; q < 16; ++q) acc[q] = 0.f;
            if (wave >= 4 && (wave < 6 || lat)) {
                const int it = wave & 1, cbr = wave >= 6 ? 32 : 0; const LAS unsigned char* NT = setc + (wave < 6 ? PO_NAK : PO_PKR);
#pragma unroll
                for (int ks = 0; ks < 4; ++ks) acc = mfma32(cfrag(SBc, CR_PJ, 32 * it + r, 16 * ks + 8 * hh), cfrag(setc + PO_AR, CR_PJ, cbr + r, 16 * ks + 8 * hh), acc);
#pragma unroll
                for (int ks = 0; ks < 2; ++ks) acc = mfma32(cfrag(setc + PO_VT, CR_PS, 32 * it + r, 16 * ks + 8 * hh), cfrag(NT, CR_PS, r, 16 * ks + 8 * hh), acc);
                if (wave < 6) {
#pragma unroll
                    for (int gq = 0; gq < 4; ++gq) *(LAS f32x4*)(lds + PQ_RT + r * CR_PF + (32 * it + 8 * gq + 4 * hh) * 4) = (f32x4){acc[4 * gq], acc[4 * gq + 1], acc[4 * gq + 2], acc[4 * gq + 3]};
                }
            }
            lds_barrier();
            if (wave < 4) {
                const int q = lane & 3, irow = 16 * wave + (lane >> 2);
                const LAS unsigned char* nrow = setc + PO_NABF + q * 32; const LAS unsigned char* rcol = lds + PQ_RT + irow * 4;
                float mysa[8];
#pragma unroll
                for (int u = 0; u < 8; ++u) mysa[u] = 0.f;
                f32x4 NA[34], NB[34]; float RH[34];
#pragma unroll
                for (int t = 0; t < 2; ++t) { NA[t] = *(const LAS f32x4*)(nrow + t * CR_PJ); NB[t] = NA[t]; RH[t] = *(const LAS float*)(rcol + t * CR_PF); }
#pragma unroll
                for (int t = 0; t < 32; ++t) {
                    if (t + 2 < 32) { NA[t + 2] = *(const LAS f32x4*)(nrow + (t + 2) * CR_PJ); if (t + 2 > 16) NB[t + 2] = *(const LAS f32x4*)(nrow + (t + 2) * CR_PJ + 16); RH[t + 2] = *(const LAS float*)(rcol + (t + 2) * CR_PF); }
                    asm volatile("" ::: "memory");
                    float p0 = 0.f, p1 = 0.f;
#pragma unroll
                    for (int u = 0; u < 4; ++u) if (u < (t + 3) / 4) { if (u & 1) p1 += mysa[u] * NA[t][u]; else p0 += mysa[u] * NA[t][u]; }
#pragma unroll
                    for (int u = 4; u < 8; ++u) if (u < (t + 3) / 4) { if (u & 1) p1 += mysa[u] * NB[t][u - 4]; else p0 += mysa[u] * NB[t][u - 4]; }
                    float part = p0 + p1;
                    part += dppf<0xB1>(part); part += dppf<0x4E>(part);
                    const float x = RH[t] + part;
                    mysa[t >> 2] = (q == (t & 3)) ? x : mysa[t >> 2];
                    asm volatile("" : "+v"(mysa[t >> 2]));
                }
#pragma unroll
                for (int u = 0; u < 8; ++u) *(LAS bf16*)(lds + PQ_SA + irow * CR_PS + (4 * u + q) * 2) = (bf16)f2bf(mysa[u]);
            } else if (c + 1 < NCH) {
                cr_stage4(raw, setn, chl, sg, lane, ka0, ka1);
                if (c + 2 < NCH) cr_load4(raw, R, K, V, KK, LR, (c + 2) * CR_T + 4 * sg, dir, b, chn);
            }
            lds_barrier();
            if (wave < 4) {
                const int jt = wave >> 1, it = wave & 1;
#pragma unroll
                for (int gq = 0; gq < 4; ++gq) { const f32x4 gv = *(LAS f32x4*)(setc + PO_GT + (32 * jt + 8 * gq + 4 * hh) * 4);
#pragma unroll
                    for (int e = 0; e < 4; ++e) st[4 * gq + e] *= gv[e]; }
#pragma unroll
                for (int ks = 0; ks < 2; ++ks) { st = mfma32(cfrag(setc + PO_BHT, CR_PS, 32 * jt + r, 16 * ks + 8 * hh), cfrag(lds + PQ_SA, CR_PS, 32 * it + r, 16 * ks + 8 * hh), st);
                    st = mfma32(cfrag(setc + PO_KHT, CR_PS, 32 * jt + r, 16 * ks + 8 * hh), cfrag(setc + PO_VT, CR_PS, 32 * it + r, 16 * ks + 8 * hh), st); }
#pragma unroll
                for (int gq = 0; gq < 4; ++gq)
                    *(LAS u32x2_t*)(SBn + (32 * it + r) * CR_PJ + (32 * jt + 8 * gq + 4 * hh) * 2) = (u32x2_t){pk2(st[4 * gq], st[4 * gq + 1]), pk2(st[4 * gq + 2], st[4 * gq + 3])};
            } else {
                if (wave >= 6 && lat) {
                    const int it = wave & 1;
#pragma unroll
                    for (int ks = 0; ks < 2; ++ks) acc = mfma32(cfrag(lds + PQ_SA, CR_PS, 32 * it + r, 16 * ks + 8 * hh), cfrag(setc + PO_PBR, CR_PS, r, 16 * ks + 8 * hh), acc);
#pragma unroll
                    for (int gq = 0; gq < 4; ++gq)
                        *(LAS u32x2_t*)(lds + PQ_OB + r * 128 + (32 * it + 8 * gq + 4 * hh) * 2) = (u32x2_t){pk2(acc[4 * gq], acc[4 * gq + 1]), pk2(acc[4 * gq + 2], acc[4 * gq + 3])};
                }
                if (c + 1 < NCH) cr_gram(setn, wave - 4, r, hh);
            }
            lds_barrier();
            if (lat) { const int ss = tid >> 4, cgp = tid & 15;
                const u32x2_t ov = *(const LAS u32x2_t*)(lds + PQ_OB + ss * 128 + cgp * 8);
                *(uint2*)(OR + ((size_t)dir * MX + scan_row(c * CR_T + ss, dir, b)) * RW + h * 64 + cgp * 4) = make_uint2(ov[0], ov[1]); }
        }
    }
}

constexpr int FL_LNW = 0, FL_LNB = 8192, FL_KA = 16384, FL_RK = 24576, FL_NW = 32768, FL_D = 40960;
__device__ __forceinline__ void ph_finish(const Args& a, LAS unsigned char* lds) {
    const int lane = LANE, tid = TID;
    const bf16* R = (const bf16*)(a.ws + WS_R); const bf16* K = (const bf16*)(a.ws + WS_K); const bf16* V = (const bf16*)(a.ws + WS_V);
    const bf16* LR = (const bf16*)(a.ws + WS_LR); const bf16* XS = (const bf16*)(a.ws + WS_XS); const bf16* Z = (const bf16*)(a.ws + WS_Z);
    const bf16* OR = (const bf16*)a.out; const bf16* YS = (const bf16*)a.out + (size_t)2 * MX * RW;
    bf16* A2 = (bf16*)(a.ws + WS_A2);
    __syncthreads();
    for (int i = tid; i < RW; i += 512) { ((LAS float*)(lds + FL_LNW))[i] = a.in[I_LNW][i]; ((LAS float*)(lds + FL_LNB))[i] = a.in[I_LNB][i]; ((LAS float*)(lds + FL_KA))[i] = a.in[I_KA][i];
        ((LAS float*)(lds + FL_RK))[i] = a.in[I_RK][i]; ((LAS float*)(lds + FL_NW))[i] = a.in[I_NORMW][i]; }
    if (tid < 32) ((LAS float*)(lds + FL_D))[tid] = a.in[I_SSMD][tid];
    __syncthreads();
    for (int m = GW; m < MX; m += NGW) {
        uint4 q[2][8]; uint4 keep[8]; float am = 0.f;
#define FIN_LOAD(buf, it) do { const int c0_ = (lane + 64 * ((it) & 3)) * 8; \
            if ((it) < 4) { q[buf][0] = ld16(OR + (size_t)m * RW + c0_); q[buf][1] = ld16(OR + ((size_t)MX + m) * RW + c0_); q[buf][2] = ld16(R + (size_t)m * RW + c0_); q[buf][3] = ld16(K + (size_t)m * RW + c0_); \
                q[buf][4] = ld16(V + (size_t)m * RW + c0_); q[buf][5] = ld16(LR + (size_t)m * NLR + 4096 + c0_); q[buf][6] = ld16(LR + (size_t)m * NLR + 6144 + c0_); q[buf][7] = ld16(LR + (size_t)m * NLR + 8192 + c0_); } \
            else { q[buf][0] = ld16(YS + (size_t)m * RW + c0_); q[buf][1] = ld16(YS + ((size_t)MX + m) * RW + c0_); q[buf][2] = ld16(XS + (size_t)m * RW + c0_); q[buf][3] = ld16(Z + (size_t)m * RW + c0_); } } while (0)
        FIN_LOAD(0, 0);
#pragma unroll
        for (int it = 0; it < 8; ++it) {
            const int cb = it & 1, c0 = (lane + 64 * (it & 3)) * 8;
            if (it + 1 < 8) { if (cb) FIN_LOAD(0, it + 1); else FIN_LOAD(1, it + 1); }
            asm volatile("" ::: "memory");
            if (it < 4) {
                float of[8], ob[8], o[8], res[8];
#if MK_SKIP_RWKV
#pragma unroll
                for (int e = 0; e < 8; ++e) res[e] = 0.f;
#else
                unpack8(q[cb][0], of); unpack8(q[cb][1], ob);
                float sm = 0.f;
#pragma unroll
                for (int e = 0; e < 8; ++e) { o[e] = of[e] + ob[e]; sm += o[e]; }
                sm = sum8(sm);
                const float mean = sm * (1.f / 64.f); float sq = 0.f;
#pragma unroll
                for (int e = 0; e < 8; ++e) { o[e] -= mean; sq += o[e] * o[e]; }
                sq = sum8(sq);
                const float rstd = rsqrtf(sq * (1.f / 64.f) + GN_EPS);
                float lw[8], lb[8], r[8], k[8], v[8], a0[8], a1[8], ka[8], rk[8], gg[8];
                ldf8s((const LAS float*)(lds + FL_LNW) + c0, lw); ldf8s((const LAS float*)(lds + FL_LNB) + c0, lb); ldf8s((const LAS float*)(lds + FL_KA) + c0, ka); ldf8s((const LAS float*)(lds + FL_RK) + c0, rk);
                unpack8(q[cb][2], r); unpack8(q[cb][3], k); unpack8(q[cb][4], v); unpack8(q[cb][5], a0); unpack8(q[cb][6], a1); unpack8(q[cb][7], gg);
                float bs = 0.f;
#pragma unroll
                for (int e = 0; e < 8; ++e) { const float kd = k[e] * (2.f + (a0[e] + a1[e] - 2.f) * ka[e]); bs += r[e] * kd * rk[e]; }
                bs = sum8(bs);
#pragma unroll
                for (int e = 0; e < 8; ++e) res[e] = (o[e] * rstd * lw[e] + lb[e] + bs * v[e]) * gg[e];
#endif
#pragma unroll
                for (int e = 0; e < 8; ++e) res[e] = simq<(MK_SIM_FP8 & 2) != 0>(res[e]);
                if (QG2) { keep[it] = pack8(res);
#pragma unroll
                    for (int e = 0; e < 8; ++e) am = fmaxf(am, fabsf(res[e])); }
                else st16(A2 + (size_t)m * DM + c0, pack8(res));
            } else {
                float yf[8], yb[8], xs[8], z[8], nw[8], y[8];
#if MK_SKIP_SSD
#pragma unroll
                for (int e = 0; e < 8; ++e) y[e] = 0.f;
#else
                unpack8(q[cb][0], yf); unpack8(q[cb][1], yb); unpack8(q[cb][2], xs); unpack8(q[cb][3], z); ldf8s((const LAS float*)(lds + FL_NW) + c0, nw);
                const float dsk = ((const LAS float*)(lds + FL_D))[c0 >> 6]; float ss = 0.f;
#pragma unroll
                for (int e = 0; e < 8; ++e) { y[e] = (yf[e] + yb[e] + dsk * xs[e]) * (z[e] * __builtin_amdgcn_rcpf(1.f + __expf(-z[e]))); ss += y[e] * y[e]; }
                ss = sum32(ss);
                const float rstd = rsqrtf(ss * (1.f / 256.f) + RMS_EPS);
#pragma unroll
                for (int e = 0; e < 8; ++e) y[e] = y[e] * rstd * nw[e];
#endif
#pragma unroll
                for (int e = 0; e < 8; ++e) y[e] = simq<(MK_SIM_FP8 & 2) != 0>(y[e]);
                if (QG2) { keep[it] = pack8(y);
#pragma unroll
                    for (int e = 0; e < 8; ++e) am = fmaxf(am, fabsf(y[e])); }
                else st16(A2 + (size_t)m * DM + 2048 + c0, pack8(y));
            }
        }
        if (QG2) {
            am = wave_max(am);
            const float scale = am > 0.f ? am * (1.f / QMAX) : 1.f, inv = 1.f / scale; unsigned char* dst = a.ws + WS_A2 + (size_t)m * DM;
#pragma unroll
            for (int it = 0; it < 8; ++it) { float f[8]; unpack8(keep[it], f); uint2 w; w.x = pk4_fp8(f[0] * inv, f[1] * inv, f[2] * inv, f[3] * inv); w.y = pk4_fp8(f[4] * inv, f[5] * inv, f[6] * inv, f[7] * inv);
                *(uint2*)(dst + (it >> 2) * 2048 + (lane + 64 * (it & 3)) * 8) = w; }
            if (lane == 0) ((float*)(a.ws + WS_SA))[m] = scale;
        }
    }
}

__device__ __forceinline__ float enc_key(float v, int idx) { return __uint_as_float((__float_as_uint(v) & 0xffffff00u) | (unsigned)idx); }
typedef float f32x32_t __attribute__((ext_vector_type(32)));
typedef unsigned u32x6_t __attribute__((ext_vector_type(6)));
typedef float f32x2 __attribute__((ext_vector_type(2)));
struct Fp6Row { uint4 q0, q1, q2, q3; float rs; };
template <bool FP4> __device__ __forceinline__ Fp6Row ld_row(const unsigned char* tab, const float* rsc, int e, int l16, int lane) {
    Fp6Row r;
    if (MK_PEER_FP4 == 6) { const unsigned char* p = tab + (size_t)e * 2176; r.q0 = *(const uint4*)(p + l16); r.q1 = *(const uint4*)(p + 1024 + l16); r.q2 = make_uint4(*(const unsigned short*)(p + 2048 + 2 * lane), 0u, 0u, 0u);
        r.rs = rsc ? rsc[e] : 1.f; return r; }
    if (MK_PEER_FP4 == 3) { const unsigned char* p = tab + (size_t)e * 4096 + l16; r.q0 = *(const uint4*)p; r.q1 = *(const uint4*)(p + 1024); r.q2 = *(const uint4*)(p + 2048); r.q3 = *(const uint4*)(p + 3072); r.rs = rsc ? rsc[e] : 1.f; return r; }
    r.rs = FP4 ? 1.f : rsc[e];
    if (FP4) { const unsigned char* p = tab + (size_t)e * 2304; r.q0 = *(const uint4*)(p + l16); r.q1 = *(const uint4*)(p + 1024 + l16); r.q2 = make_uint4(*(const unsigned*)(p + 2048 + 4 * lane), 0u, 0u, 0u); }
    else { const unsigned char* p = tab + (size_t)e * 3072 + l16; r.q0 = *(const uint4*)p; r.q1 = *(const uint4*)(p + 1024); r.q2 = *(const uint4*)(p + 2048); }
    return r;
}
__device__ __forceinline__ f32x32_t fp6_unpack(const Fp6Row& r, int p, float one) {
    u32x6_t s; if (p == 0) { s[0] = r.q0.x; s[1] = r.q0.y; s[2] = r.q0.z; s[3] = r.q0.w; s[4] = r.q1.x; s[5] = r.q1.y; } else { s[0] = r.q1.z; s[1] = r.q1.w; s[2] = r.q2.x; s[3] = r.q2.y; s[4] = r.q2.z; s[5] = r.q2.w; }
    return __builtin_amdgcn_cvt_scalef32_pk32_f32_fp6(s, one);
}
typedef _Float16 h16x32_t __attribute__((ext_vector_type(32)));
typedef _Float16 h16x2_t __attribute__((ext_vector_type(2)));
__device__ __forceinline__ h16x32_t fp6_unpack_h(const Fp6Row& r, int p, float one) {
    u32x6_t s; if (p == 0) { s[0] = r.q0.x; s[1] = r.q0.y; s[2] = r.q0.z; s[3] = r.q0.w; s[4] = r.q1.x; s[5] = r.q1.y; } else { s[0] = r.q1.z; s[1] = r.q1.w; s[2] = r.q2.x; s[3] = r.q2.y; s[4] = r.q2.z; s[5] = r.q2.w; }
    return __builtin_amdgcn_cvt_scalef32_pk32_f16_fp6(s, one);
}
template <bool FP4, int VAR = 0> __device__ __forceinline__ f32x32_t row_unpack(const Fp6Row& r, int p, float one, float& sc) {
    if (!FP4 && VAR == 1) { sc = 1.f; const unsigned w[6] = {p ? r.q1.z : r.q0.x, p ? r.q1.w : r.q0.y, p ? r.q2.x : r.q0.z, p ? r.q2.y : r.q0.w, p ? r.q2.z : r.q1.x, p ? r.q2.w : r.q1.y}; f32x32_t f;
#pragma unroll
        for (int t = 0; t < 32; ++t) f[t] = __uint_as_float((w[t % 6] << (t & 7)) & 0x3fffffffu);
        return f; }
    if (!FP4) { sc = 1.f; return fp6_unpack(r, p, one); }
    const uint4 q = p ? r.q1 : r.q0; const unsigned w[4] = {q.x, q.y, q.z, q.w}; f32x32_t f;
#pragma unroll
    for (int d = 0; d < 4; ++d)
        { const f32x2 t0 = __builtin_amdgcn_cvt_scalef32_pk_f32_fp4(w[d], one, 0), t1 = __builtin_amdgcn_cvt_scalef32_pk_f32_fp4(w[d], one, 1), t2 = __builtin_amdgcn_cvt_scalef32_pk_f32_fp4(w[d], one, 2), t3 = __builtin_amdgcn_cvt_scalef32_pk_f32_fp4(w[d], one, 3);
          f[8 * d] = t0.x; f[8 * d + 1] = t0.y; f[8 * d + 2] = t1.x; f[8 * d + 3] = t1.y; f[8 * d + 4] = t2.x; f[8 * d + 5] = t2.y; f[8 * d + 6] = t3.x; f[8 * d + 7] = t3.y; }
    sc = p ? bfhi(r.q2.x) : bflo(r.q2.x);
    return f;
}
__device__ __forceinline__ void fp4_unpack8(unsigned w, float one, float (&f)[8]) {
    const f32x2 t0 = __builtin_amdgcn_cvt_scalef32_pk_f32_fp4(w, one, 0), t1 = __builtin_amdgcn_cvt_scalef32_pk_f32_fp4(w, one, 1), t2 = __builtin_amdgcn_cvt_scalef32_pk_f32_fp4(w, one, 2), t3 = __builtin_amdgcn_cvt_scalef32_pk_f32_fp4(w, one, 3);
    f[0] = t0.x; f[1] = t0.y; f[2] = t1.x; f[3] = t1.y; f[4] = t2.x; f[5] = t2.y; f[6] = t3.x; f[7] = t3.y;
}
#define PIN4(a) asm volatile("" : "+v"((a)[0]), "+v"((a)[1]), "+v"((a)[2]), "+v"((a)[3]))
#ifndef MK_PEER_PROBE
#define MK_PEER_PROBE 0
#endif
#ifndef MK_PEER_VAR
#define MK_PEER_VAR 0
#endif
template <int EMASK = 0x3fff, int VAR = 0> __device__ __forceinline__ void ph_peer(const Args& a, float* outp, LAS unsigned char* lds) {
    const int lane = LANE; constexpr bool I8 = MK_PEER_FP4 == 3, U4 = MK_PEER_FP4 == 4 || MK_PEER_FP4 == 5 || MK_PEER_FP4 == 6, V4 = MK_PEER_FP4 == 5 || MK_PEER_FP4 == 6, S8 = MK_PEER_FP4 == 6, UF4 = MK_PEER_FP4 == 2, VF4 = MK_PEER_FP4 == 1 || MK_PEER_FP4 == 2; constexpr int URING = UF4 ? 3 : 2, VRING = VF4 ? 3 : 2;
    const float* mod = (const float*)(a.ws + WS_MOD); const float* S = (const float*)(a.ws + WS_S);
    const unsigned char* U8 = (const unsigned char*)(a.ws + WS_U8); const unsigned char* V8 = (const unsigned char*)(a.ws + WS_V8);
    const float* USC = (const float*)(a.ws + WS_USC); const float* VSC = (const float*)(a.ws + WS_VSC);
    constexpr bool XQ = U4 && QGQ && MK_F8 == 2;
    __syncthreads();
    for (int i = TID; i < 5 * 1024; i += 512) { const int v = i >> 10, c = (i & 1023) * 4; const float* src = v < 4 ? mod + (size_t)v * NMOD + 5 * DM : a.in[I_FG];
        const float4 x4 = *(const float4*)(src + c); *(LAS f32x4*)(lds + (size_t)(v * 4096 + c) * 4) = (f32x4){x4.x, x4.y, x4.z, x4.w}; }
    __syncthreads();
    for (int m = GW; m < MX; m += NGW) {
        const int bb = m / SEQ;
        float* hrow = a.out + (size_t)m * DM; const bf16* hbrow = (const bf16*)(a.ws + WS_HB) + (size_t)m * DM;
        int l4 = lane * 4; asm volatile("" : "+v"(l4));
        float acc[16][4];
#if MK_SKIP_PEER
#pragma unroll
        for (int j = 0; j < 16; ++j)
#pragma unroll
            for (int e = 0; e < 4; ++e) acc[j][e] = 0.f;
#else
        float xn[16][4];
        if constexpr (!XQ) { float ss = 0.f;
#pragma unroll
          for (int j = 0; j < 16; ++j) { float4 h4; if (HBF) { const uint2 hq = *(const uint2*)(hbrow + 256 * j + l4); h4 = make_float4(bflo(hq.x), bfhi(hq.x), bflo(hq.y), bfhi(hq.y)); } else h4 = *(const float4*)(hrow + 256 * j + l4); xn[j][0] = h4.x; xn[j][1] = h4.y; xn[j][2] = h4.z; xn[j][3] = h4.w; ss += (h4.x * h4.x + h4.y * h4.y) + (h4.z * h4.z + h4.w * h4.w); }
          const float rstd = rsqrtf(wave_sum(ss) * (1.f / DM) + RMS_EPS);
          const float* sh2 = mod + (size_t)bb * NMOD + 3 * DM; const float* sc2 = mod + (size_t)bb * NMOD + 4 * DM; const float* g2 = a.in[I_N2G];
#pragma unroll
          for (int j = 0; j < 16; ++j) { const int c = 256 * j + l4; const float4 gg = *(const float4*)(g2 + c), s0 = *(const float4*)(sh2 + c), s1 = *(const float4*)(sc2 + c);
              xn[j][0] = xn[j][0] * rstd * gg.x * (1.f + s1.x) + s0.x; xn[j][1] = xn[j][1] * rstd * gg.y * (1.f + s1.y) + s0.y; xn[j][2] = xn[j][2] * rstd * gg.z * (1.f + s1.z) + s0.z; xn[j][3] = xn[j][3] * rstd * gg.w * (1.f + s1.w) + s0.w;
              if ((j & 3) == 3) { PIN4(xn[j - 3]); PIN4(xn[j - 2]); PIN4(xn[j - 1]); PIN4(xn[j]); asm volatile("" ::: "memory"); } } }
        int eid0 = 0, eid1 = 0; float gt0 = 0.f, gt1 = 0.f;
        const float NEG = -3.0e38f;
        if (VAR == 2) { eid0 = (m * 131 + lane * 977) & 16383; eid1 = (m * 197 + lane * 1531 + 7) & 16383; gt0 = 0.0625f; gt1 = 0.0625f; } else {
        float t1[8], t2[8];
        int lsc = lane; asm volatile("" : "+v"(lsc));
        {
            float cg[4][8], tg[4];
#pragma unroll
            for (int g = 0; g < 4; ++g) { const float* sr = S + (size_t)m * 2048 + 512 * g + 8 * lsc; const float4 sa = *(const float4*)sr, sb = *(const float4*)(sr + 4); const int kb = 8 * (lsc & 15);
                cg[g][0] = enc_key(sa.x, kb); cg[g][1] = enc_key(sa.y, kb + 1); cg[g][2] = enc_key(sa.z, kb + 2); cg[g][3] = enc_key(sa.w, kb + 3);
                cg[g][4] = enc_key(sb.x, kb + 4); cg[g][5] = enc_key(sb.y, kb + 5); cg[g][6] = enc_key(sb.z, kb + 6); cg[g][7] = enc_key(sb.w, kb + 7); tg[g] = NEG; }
#pragma unroll 1
            for (int k = 0; k < 16; ++k) {
#pragma unroll
                for (int g = 0; g < 4; ++g) {
                    float mx = fmaxf(fmaxf(fmaxf(cg[g][0], cg[g][1]), fmaxf(cg[g][2], cg[g][3])), fmaxf(fmaxf(cg[g][4], cg[g][5]), fmaxf(cg[g][6], cg[g][7])));
                    mx = fmaxf(mx, dppf<0xB1>(mx)); mx = fmaxf(mx, dppf<0x4E>(mx)); mx = fmaxf(mx, dppf<0x141>(mx)); mx = fmaxf(mx, dppf<0x140>(mx));
#pragma unroll
                    for (int e = 0; e < 8; ++e) if (cg[g][e] == mx) cg[g][e] = NEG;
                    if ((lane & 15) == k) tg[g] = mx;
                }
            }
            const int rowb = lsc & 48, ll = lsc & 15, srcl = 32 * ((lsc >> 4) & 1) + ll; const bool up = (lsc >> 5) != 0;
            float cd2[2][16], bestg[2]; int I1[2], I2[2];
#pragma unroll
            for (int G = 0; G < 2; ++G) {
                const float a0 = __shfl(tg[2 * G], srcl), a1 = __shfl(tg[2 * G + 1], srcl), b0 = __shfl(tg[2 * G], srcl + 16), b1 = __shfl(tg[2 * G + 1], srcl + 16);
                const float v1r = up ? a1 : a0, v2r = up ? b1 : b0;
                I1[G] = (int)(__float_as_uint(v1r) & 0xffu); I2[G] = (int)(__float_as_uint(v2r) & 0xffu);
                const float v1 = __uint_as_float(__float_as_uint(v1r) & 0xffffff00u), v2 = __uint_as_float(__float_as_uint(v2r) & 0xffffff00u);
#pragma unroll
                for (int bq = 0; bq < 16; ++bq) cd2[G][bq] = enc_key(v1 + __shfl(v2, rowb + bq), 16 * ll + bq);
                bestg[G] = NEG;
            }
#pragma unroll 1
            for (int k = 0; k < 16; ++k) {
#pragma unroll
                for (int G = 0; G < 2; ++G) {
                    float mx = fmaxf(fmaxf(fmaxf(fmaxf(cd2[G][0], cd2[G][1]), fmaxf(cd2[G][2], cd2[G][3])), fmaxf(fmaxf(cd2[G][4], cd2[G][5]), fmaxf(cd2[G][6], cd2[G][7]))),
                                     fmaxf(fmaxf(fmaxf(cd2[G][8], cd2[G][9]), fmaxf(cd2[G][10], cd2[G][11])), fmaxf(fmaxf(cd2[G][12], cd2[G][13]), fmaxf(cd2[G][14], cd2[G][15]))));
                    mx = fmaxf(mx, dppf<0xB1>(mx)); mx = fmaxf(mx, dppf<0x4E>(mx)); mx = fmaxf(mx, dppf<0x141>(mx)); mx = fmaxf(mx, dppf<0x140>(mx));
#pragma unroll
                    for (int bq = 0; bq < 16; ++bq) if (cd2[G][bq] == mx) cd2[G][bq] = NEG;
                    if (ll == k) bestg[G] = mx;
                }
            }
#pragma unroll
            for (int G = 0; G < 2; ++G) {
                const int cidx = (int)(__float_as_uint(bestg[G]) & 0xffu);
                const int ea = __shfl(I1[G], rowb + (cidx >> 4)), eb = __shfl(I2[G], rowb + (cidx & 15));
                const float bv = __uint_as_float(__float_as_uint(bestg[G]) & 0xffffff00u);
                float bm = bv; bm = fmaxf(bm, dppf<0xB1>(bm)); bm = fmaxf(bm, dppf<0x4E>(bm)); bm = fmaxf(bm, dppf<0x141>(bm)); bm = fmaxf(bm, dppf<0x140>(bm));
                const float pe = __expf(bv - bm); const float gate = pe / sum16(pe);
                if (G == 0) { gt0 = gate; eid0 = ea * 128 + eb; } else { gt1 = gate; eid1 = ea * 128 + eb; }
            }
        }
        }
        const int l48 = lane * 16; int lsx = lane; asm volatile("" : "+v"(lsx));
#ifndef MK_PEER_SORT
#define MK_PEER_SORT 1
#endif
        if (MK_PEER_SORT && VAR != 2) {
            unsigned k0 = ((unsigned)eid0 << 7) | (unsigned)lsx, k1 = ((unsigned)eid1 << 7) | (unsigned)(64 + lsx);
#pragma unroll
            for (int kk = 2; kk <= 128; kk <<= 1) {
#pragma unroll
                for (int j = kk >> 1; j >= 1; j >>= 1) {
                    if (j == 64) { const unsigned lo = k0 < k1 ? k0 : k1, hi = k0 < k1 ? k1 : k0; k0 = lo; k1 = hi; }
                    else {
                        const unsigned p0 = (unsigned)__shfl_xor((int)k0, j), p1 = (unsigned)__shfl_xor((int)k1, j);
                        const bool lower = (lsx & j) == 0;
                        const bool up0 = kk == 128 ? true : kk == 64 ? true : (lsx & kk) == 0, up1 = kk == 128 ? true : kk == 64 ? false : (lsx & kk) == 0;
                        const unsigned mn0 = k0 < p0 ? k0 : p0, mx0 = k0 < p0 ? p0 : k0, mn1 = k1 < p1 ? k1 : p1, mx1 = k1 < p1 ? p1 : k1;
                        k0 = (up0 == lower) ? mn0 : mx0; k1 = (up1 == lower) ? mn1 : mx1;
                    }
                }
            }
            const int po0 = (int)(k0 & 127u), po1 = (int)(k1 & 127u);
            const float ga0 = __shfl(gt0, po0 & 63), gb0 = __shfl(gt1, po0 & 63), ga1 = __shfl(gt0, po1 & 63), gb1 = __shfl(gt1, po1 & 63);
            gt0 = po0 < 64 ? ga0 : gb0; gt1 = po1 < 64 ? ga1 : gb1; eid0 = (int)(k0 >> 7); eid1 = (int)(k1 >> 7);
        }
        h16x2_t xh[16][2];
        if (VAR == 5) {
#pragma unroll
            for (int j = 0; j < 16; ++j) { xh[j][0] = (h16x2_t){(_Float16)xn[j][0], (_Float16)xn[j][1]}; xh[j][1] = (h16x2_t){(_Float16)xn[j][2], (_Float16)xn[j][3]}; } }
        float cf0 = 0.f, cf1 = 0.f;
        if (VAR == 4) { cf0 = gt0; cf1 = gt1; }
#define PEER_EID(pp) (__builtin_amdgcn_readlane((pp) < 64 ? eid0 : eid1, (pp) & 63) & EMASK)
#define PEER_FETCH(buf, pbase, TAB, F4) do { _Pragma("unroll") for (int q2 = 0; q2 < 4; ++q2) { const int e_ = PEER_EID((pbase) + q2); buf[q2] = ld_row<F4>(TAB, (TAB) == U8 ? USC : VSC, e_, l48, lane); } } while (0)
#define PEER_FETCH8(buf, pbase, TAB, RSC) do { _Pragma("unroll") for (int q2 = 0; q2 < 2; ++q2) { const int e_ = PEER_EID((pbase) + q2); buf[q2] = ld_row<false>(TAB, RSC, e_, l48, lane); } } while (0)
#define PEER_W16(rr) {rr.q0.x, rr.q0.y, rr.q0.z, rr.q0.w, rr.q1.x, rr.q1.y, rr.q1.z, rr.q1.w, rr.q2.x, rr.q2.y, rr.q2.z, rr.q2.w, rr.q3.x, rr.q3.y, rr.q3.z, rr.q3.w}
        if constexpr (U4) { if (VAR != 4) {
            float am = 0.f;
            if constexpr (!XQ) {
#pragma unroll
                for (int j = 0; j < 16; ++j) am = fmaxf(fmaxf(am, fmaxf(fabsf(xn[j][0]), fabsf(xn[j][1]))), fmaxf(fabsf(xn[j][2]), fabsf(xn[j][3])));
                am = wave_max(am); }
            const float xsc = XQ ? ((const float*)(a.ws + WS_SA))[m] : (am > 0.f ? am * (1.f / 119.f) : 1.f), xinv = 1.f / xsc;
            const unsigned* xrow = (const unsigned*)(a.ws + WS_XN2 + (size_t)m * DM) + lsx;
            int XL[2][4], XH[2][4];
#pragma unroll
            for (int p = 0; p < 2; ++p)
#pragma unroll
                for (int d = 0; d < 4; ++d) { unsigned tl[2], th[2];
#pragma unroll
                    for (int hf = 0; hf < 2; ++hf) { const int j = 8 * p + 2 * d + hf; const unsigned W = XQ ? xrow[64 * j] : pk4_i8(xn[j][0] * xinv, xn[j][1] * xinv, xn[j][2] * xinv, xn[j][3] * xinv);
                        const unsigned lo = W & 0x0f0f0f0fu, w8 = ((W & 0x7f7f7f7fu) + 0x08080808u) ^ (W & 0x80808080u), hi = (w8 >> 4) & 0x0f0f0f0fu;
                        tl[hf] = lo | (lo >> 4); th[hf] = hi | (hi >> 4); }
                    XL[p][d] = (int)__builtin_amdgcn_perm(tl[1], tl[0], 0x06040200u); XH[p][d] = (int)__builtin_amdgcn_perm(th[1], th[0], 0x06040200u); }
            Fp6Row r0[2], r1[2], r2[2], r3[2];
#define PEER_FETCH4(buf, pbase) do { _Pragma("unroll") for (int q2 = 0; q2 < 2; ++q2) { const int e_ = PEER_EID((pbase) + q2); buf[q2] = ld_row<true>(U8, USC, e_, l48, lane); } } while (0)
            PEER_FETCH4(r0, 0); PEER_FETCH4(r1, 2); PEER_FETCH4(r2, 4);
#pragma unroll 1
            for (int p0 = 0; p0 < 128; p0 += 8) {
#pragma unroll
                for (int gsel = 0; gsel < 4; ++gsel) {
                    const int pb = p0 + 2 * gsel;
                    {
                        asm volatile("" ::: "memory");
                        if (pb + 6 < 128) { if (gsel == 0) PEER_FETCH4(r3, pb + 6); else if (gsel == 1) PEER_FETCH4(r0, pb + 6); else if (gsel == 2) PEER_FETCH4(r1, pb + 6); else PEER_FETCH4(r2, pb + 6); }
                        float d[2];
#pragma unroll
                        for (int q = 0; q < 2; ++q) { const Fp6Row& rr = gsel == 0 ? r0[q] : gsel == 1 ? r1[q] : gsel == 2 ? r2[q] : r3[q];
                            const unsigned wa[4] = {rr.q0.x, rr.q0.y, rr.q0.z, rr.q0.w}, wb[4] = {rr.q1.x, rr.q1.y, rr.q1.z, rr.q1.w};
                            int la = 0, ha = 0, lb = 0, hb = 0;
#pragma unroll
                            for (int dw = 0; dw < 4; ++dw) { la = __builtin_amdgcn_sdot8((int)wa[dw], XL[0][dw], la, false); ha = __builtin_amdgcn_sdot8((int)wa[dw], XH[0][dw], ha, false);
                                lb = __builtin_amdgcn_sdot8((int)wb[dw], XL[1][dw], lb, false); hb = __builtin_amdgcn_sdot8((int)wb[dw], XH[1][dw], hb, false); }
                            float s0, s1; if (S8) { const f32x2 sd = __builtin_amdgcn_cvt_pk_f32_fp8((int)rr.q2.x, false); s0 = sd.x * rr.rs; s1 = sd.y * rr.rs; } else { s0 = bflo(rr.q2.x); s1 = bfhi(rr.q2.x); }
                            d[q] = (float)(16 * ha + la) * s0 + (float)(16 * hb + lb) * s1; }
#pragma unroll
                        for (int q = 0; q < 2; ++q) {
                            const int p = pb + q;
                            const float dot = wave_sum(d[q]) * xsc;
                            if (lane == (p & 63)) { if (pb < 64) cf0 = dot; else cf1 = dot; }
                        }
                    }
                }
            }
            { const pg8::f32x2 a2 = pg8::gelu_pk((pg8::f32x2){cf0, cf1}); cf0 = gt0 * a2.x; cf1 = gt1 * a2.y; }
        } } else
        if constexpr (I8) { if (VAR != 4) {
            float am = 0.f;
#pragma unroll
            for (int j = 0; j < 16; ++j) am = fmaxf(fmaxf(am, fmaxf(fabsf(xn[j][0]), fabsf(xn[j][1]))), fmaxf(fabsf(xn[j][2]), fabsf(xn[j][3])));
            am = wave_max(am);
            const float xsc = am > 0.f ? am * (1.f / 127.f) : 1.f, xinv = 1.f / xsc;
            int xq[16];
#pragma unroll
            for (int j = 0; j < 16; ++j) xq[j] = (int)pk4_i8(xn[j][0] * xinv, xn[j][1] * xinv, xn[j][2] * xinv, xn[j][3] * xinv);
            Fp6Row r0[2], r1[2], r2[2];
            PEER_FETCH8(r0, 0, U8, USC); PEER_FETCH8(r1, 2, U8, USC);
#pragma unroll 1
            for (int p0 = 0; p0 < 128; p0 += 6) {
#pragma unroll
                for (int gsel = 0; gsel < 3; ++gsel) {
                    const int pb = p0 + 2 * gsel;
                    if (pb < 128) {
                        asm volatile("" ::: "memory");
                        if (pb + 4 < 128) { if (gsel == 0) PEER_FETCH8(r2, pb + 4, U8, USC); else if (gsel == 1) PEER_FETCH8(r0, pb + 4, U8, USC); else PEER_FETCH8(r1, pb + 4, U8, USC); }
                        float d[2];
#pragma unroll
                        for (int q = 0; q < 2; ++q) { const Fp6Row& rr = gsel == 0 ? r0[q] : gsel == 1 ? r1[q] : r2[q]; const unsigned w[16] = PEER_W16(rr);
                            int d0 = 0, d1 = 0, d2 = 0, d3 = 0;
#pragma unroll
                            for (int j = 0; j < 4; ++j) { d0 = __builtin_amdgcn_sdot4((int)w[j], xq[j], d0, false); d1 = __builtin_amdgcn_sdot4((int)w[4 + j], xq[4 + j], d1, false);
                                d2 = __builtin_amdgcn_sdot4((int)w[8 + j], xq[8 + j], d2, false); d3 = __builtin_amdgcn_sdot4((int)w[12 + j], xq[12 + j], d3, false); }
                            d[q] = (float)((d0 + d1) + (d2 + d3)); }
#pragma unroll
                        for (int q = 0; q < 2; ++q) {
                            const int p = pb + q;
                            const float dot = wave_sum(d[q]) * ((gsel == 0 ? r0[q].rs : gsel == 1 ? r1[q].rs : r2[q].rs) * xsc);
                            const float act = pg8::gelu_pk((pg8::f32x2){dot, dot}).x;
                            if (lane == (p & 63)) { if (pb < 64) cf0 = gt0 * act; else cf1 = gt1 * act; }
                        }
                    }
                }
            }
        } } else
        if (VAR != 4) {
            Fp6Row r0[4], r1[4], r2[4];
            PEER_FETCH(r0, 0, U8, UF4); if (URING == 3) PEER_FETCH(r1, 4, U8, UF4);
#pragma unroll 1
            for (int p0 = 0; p0 < 128; p0 += 4 * URING) {
#pragma unroll
                for (int gsel = 0; gsel < URING; ++gsel) {
                    const int pb = p0 + 4 * gsel;
                    if (pb < 128) {
                        asm volatile("" ::: "memory");
                        if (URING == 3) { if (pb + 8 < 128) { if (gsel == 0) PEER_FETCH(r2, pb + 8, U8, UF4); else if (gsel == 1) PEER_FETCH(r0, pb + 8, U8, UF4); else PEER_FETCH(r1, pb + 8, U8, UF4); } }
                        else { if (pb + 4 < 128) { if (gsel == 0) PEER_FETCH(r1, pb + 4, U8, UF4); else PEER_FETCH(r0, pb + 4, U8, UF4); } }
                        float d[4];
#pragma unroll
                        for (int q = 0; q < 4; ++q) {
                            float dd = 0.f;
#pragma unroll
                            for (int p = 0; p < 2; ++p) { const Fp6Row& rr = gsel == 0 ? r0[q] : gsel == 1 ? r1[q] : r2[q];
                                if (UF4) { const uint4 qq = p ? rr.q1 : rr.q0; const unsigned wq[4] = {qq.x, qq.y, qq.z, qq.w}; float dp = 0.f;
#pragma unroll
                                    for (int dw = 0; dw < 4; ++dw) { float one = 1.0f; asm volatile("" : "+v"(one)); float f8[8]; fp4_unpack8(wq[dw], one, f8);
#pragma unroll
                                        for (int t = 0; t < 8; ++t) dp += xn[8 * p + 2 * dw + (t >> 2)][t & 3] * f8[t];
                                        asm volatile("" : "+v"(dp)); }
                                    dd += dp * (p ? bfhi(rr.q2.x) : bflo(rr.q2.x));
                                } else if (VAR == 5) { float one = 1.0f; asm volatile("" : "+v"(one)); const h16x32_t fh = fp6_unpack_h(rr, p, one); float dp = 0.f;
#pragma unroll
                                    for (int t = 0; t < 32; t += 2) dp = __builtin_amdgcn_fdot2((h16x2_t){fh[t], fh[t + 1]}, xh[8 * p + (t >> 2)][(t & 3) >> 1], dp, false);
                                    dd += dp;
                                } else { float one = 1.0f; asm volatile("" : "+v"(one)); float bsc; const f32x32_t f = row_unpack<UF4, VAR>(rr, p, one, bsc);
                                    float dp = 0.f;
#pragma unroll
                                    for (int t = 0; t < 32; ++t) dp += xn[8 * p + (t >> 2)][t & 3] * f[t];
                                    dd += dp * bsc; }
                                asm volatile("" : "+v"(dd)); }
                            d[q] = dd;
                        }
#pragma unroll
                        for (int q = 0; q < 4; ++q) {
                            const int p = pb + q;
                            const float dot = wave_sum(d[q]) * (gsel == 0 ? r0[q].rs : gsel == 1 ? r1[q].rs : r2[q].rs);
                            const float act = pg8::gelu_pk((pg8::f32x2){dot, dot}).x;
                            if (lane == (p & 63)) { if (pb < 64) cf0 = gt0 * act; else cf1 = gt1 * act; }
                        }
                    }
                }
            }
        }
#pragma unroll
        for (int j = 0; j < 16; ++j)
#pragma unroll
            for (int e = 0; e < 4; ++e) acc[j][e] = 0.f;
        if constexpr (V4) { if (VAR != 3) {
            const float c0 = cf0 * VSC[eid0 & EMASK], c1 = cf1 * VSC[eid1 & EMASK];
            const float cm = wave_max(fmaxf(fabsf(c0), fabsf(c1)));
            const float csc = cm > 0.f ? cm * (1.f / 127.f) : 1.f, cinv = 1.f / csc;
            int ai[16][4]; int sca = 0, scb = 0;
#pragma unroll
            for (int j = 0; j < 16; ++j)
#pragma unroll
                for (int e = 0; e < 4; ++e) ai[j][e] = 0;
            Fp6Row r0[4], r1[4];
#define PEER_FETCHV4(buf, pbase) do { _Pragma("unroll") for (int q2 = 0; q2 < 4; ++q2) { const int e_ = PEER_EID((pbase) + q2); buf[q2] = ld_row<true>(V8, nullptr, e_, l48, lane); } } while (0)
            PEER_FETCHV4(r0, 0);
#pragma unroll 1
            for (int p0 = 0; p0 < 128; p0 += 8) {
#pragma unroll
                for (int gsel = 0; gsel < 2; ++gsel) {
                    const int pb = p0 + 4 * gsel;
                    asm volatile("" ::: "memory");
                    if (pb + 4 < 128) { if (gsel == 0) PEER_FETCHV4(r1, pb + 4); else PEER_FETCHV4(r0, pb + 4); }
                    float ce[4];
#pragma unroll
                    for (int q = 0; q < 4; ++q) ce[q] = rlane(S8 ? (pb < 64 ? c0 : c1) : (pb < 64 ? cf0 : cf1), (pb + q) & 63) * cinv;
#pragma unroll
                    for (int p = 0; p < 2; ++p) {
                        unsigned uc[4];
#pragma unroll
                        for (int q = 0; q < 4; ++q) { const Fp6Row& rr = gsel == 0 ? r0[q] : r1[q]; float sq;
                            if (S8) { const f32x2 sd = __builtin_amdgcn_cvt_pk_f32_fp8((int)rr.q2.x, false); sq = p ? sd.y : sd.x; } else sq = p ? bfhi(rr.q2.x) : bflo(rr.q2.x);
                            uc[q] = __float_as_uint(ce[q] * sq + 12582912.f); }
                        const int cpack = (int)((uc[0] & 0xffu) | ((uc[1] & 0xffu) << 8) | ((uc[2] & 0xffu) << 16) | (uc[3] << 24));
                        const int csum = (((int)(uc[0] << 24) >> 24) + ((int)(uc[1] << 24) >> 24)) + (((int)(uc[2] << 24) >> 24) + ((int)(uc[3] << 24) >> 24));
                        if (p) scb += csum; else sca += csum;
#pragma unroll
                        for (int dw = 0; dw < 4; ++dw) {
                            unsigned wr[4];
#pragma unroll
                            for (int q = 0; q < 4; ++q) { const Fp6Row& rr = gsel == 0 ? r0[q] : r1[q]; const uint4 qq = p ? rr.q1 : rr.q0; wr[q] = dw == 0 ? qq.x : dw == 1 ? qq.y : dw == 2 ? qq.z : qq.w; }
                            const unsigned t0 = __builtin_amdgcn_perm(wr[1], wr[0], 0x05010400u), t1 = __builtin_amdgcn_perm(wr[1], wr[0], 0x07030602u), t2 = __builtin_amdgcn_perm(wr[3], wr[2], 0x05010400u), t3 = __builtin_amdgcn_perm(wr[3], wr[2], 0x07030602u);
                            const unsigned o[4] = {__builtin_amdgcn_perm(t2, t0, 0x05040100u), __builtin_amdgcn_perm(t2, t0, 0x07060302u), __builtin_amdgcn_perm(t3, t1, 0x05040100u), __builtin_amdgcn_perm(t3, t1, 0x07060302u)};
                            const int j0 = 8 * p + 2 * dw;
#pragma unroll
                            for (int b = 0; b < 4; ++b) { const int lo = (int)(o[b] & 0x0f0f0f0fu), hi = (int)((o[b] >> 4) & 0x0f0f0f0fu); const int j = j0 + (b >> 1), t = 2 * (b & 1);
                                ai[j][t] = __builtin_amdgcn_sdot4(lo, cpack, ai[j][t], false); ai[j][t + 1] = __builtin_amdgcn_sdot4(hi, cpack, ai[j][t + 1], false); }
                        }
                    }
                }
            }
#pragma unroll
            for (int j = 0; j < 16; ++j)
#pragma unroll
                for (int e = 0; e < 4; ++e) acc[j][e] = (float)(ai[j][e] - 8 * (j < 8 ? sca : scb)) * csc;
        } } else
        if constexpr (I8) { if (VAR != 3) {
            const float c0 = cf0 * VSC[eid0 & EMASK], c1 = cf1 * VSC[eid1 & EMASK];
            const float cm = wave_max(fmaxf(fabsf(c0), fabsf(c1)));
            const float csc = cm > 0.f ? cm * (1.f / 127.f) : 1.f, cinv = 1.f / csc;
            const int ci0 = (int)(__float_as_uint(c0 * cinv + 12582912.f) & 0xffu), ci1 = (int)(__float_as_uint(c1 * cinv + 12582912.f) & 0xffu);
            int ai[16][4];
#pragma unroll
            for (int j = 0; j < 16; ++j)
#pragma unroll
                for (int e = 0; e < 4; ++e) ai[j][e] = 0;
            Fp6Row r0[2], r1[2], r2[2];
            PEER_FETCH8(r0, 0, V8, nullptr); PEER_FETCH8(r1, 2, V8, nullptr);
#pragma unroll 1
            for (int p0 = 0; p0 < 128; p0 += 6) {
#pragma unroll
                for (int gsel = 0; gsel < 3; ++gsel) {
                    const int pb = p0 + 2 * gsel;
                    if (pb < 128) {
                        asm volatile("" ::: "memory");
                        if (pb + 4 < 128) { if (gsel == 0) PEER_FETCH8(r2, pb + 4, V8, nullptr); else if (gsel == 1) PEER_FETCH8(r0, pb + 4, V8, nullptr); else PEER_FETCH8(r1, pb + 4, V8, nullptr); }
#pragma unroll
                        for (int q = 0; q < 2; ++q) { const Fp6Row& rr = gsel == 0 ? r0[q] : gsel == 1 ? r1[q] : r2[q]; const unsigned w[16] = PEER_W16(rr);
                            const int c8 = __builtin_amdgcn_readlane(pb < 64 ? ci0 : ci1, (pb + q) & 63); const int cb1 = c8 << 8, cb2 = c8 << 16, cb3 = c8 << 24;
#pragma unroll
                            for (int j = 0; j < 16; ++j) { ai[j][0] = __builtin_amdgcn_sdot4((int)w[j], c8, ai[j][0], false); ai[j][1] = __builtin_amdgcn_sdot4((int)w[j], cb1, ai[j][1], false);
                                ai[j][2] = __builtin_amdgcn_sdot4((int)w[j], cb2, ai[j][2], false); ai[j][3] = __builtin_amdgcn_sdot4((int)w[j], cb3, ai[j][3], false); } }
                    }
                }
            }
#pragma unroll
            for (int j = 0; j < 16; ++j)
#pragma unroll
                for (int e = 0; e < 4; ++e) acc[j][e] = (float)ai[j][e] * csc;
        } } else
        if (VAR != 3) {
            h16x2_t ah[16][2];
#pragma unroll
            for (int j = 0; j < 16; ++j) { ah[j][0] = (h16x2_t){0, 0}; ah[j][1] = (h16x2_t){0, 0}; }
            f32x2 ap[16][2];
#pragma unroll
            for (int j = 0; j < 16; ++j) { ap[j][0] = (f32x2){0.f, 0.f}; ap[j][1] = (f32x2){0.f, 0.f}; }
            Fp6Row r0[4], r1[4], r2[4];
            PEER_FETCH(r0, 0, V8, VF4); if (VRING == 3) PEER_FETCH(r1, 4, V8, VF4);
#pragma unroll 1
            for (int p0 = 0; p0 < 128; p0 += 4 * VRING) {
#pragma unroll
                for (int gsel = 0; gsel < VRING; ++gsel) {
                    const int pb = p0 + 4 * gsel;
                    if (pb < 128) {
                        asm volatile("" ::: "memory");
                        if (VRING == 3) { if (pb + 8 < 128) { if (gsel == 0) PEER_FETCH(r2, pb + 8, V8, VF4); else if (gsel == 1) PEER_FETCH(r0, pb + 8, V8, VF4); else PEER_FETCH(r1, pb + 8, V8, VF4); } }
                        else { if (pb + 4 < 128) { if (gsel == 0) PEER_FETCH(r1, pb + 4, V8, VF4); else PEER_FETCH(r0, pb + 4, V8, VF4); } }
                        float cfv[4];
#pragma unroll
                        for (int q = 0; q < 4; ++q) cfv[q] = rlane(pb < 64 ? cf0 : cf1, (pb + q) & 63) * (gsel == 0 ? r0[q].rs : gsel == 1 ? r1[q].rs : r2[q].rs);
#pragma unroll
                        for (int q = 0; q < 4; ++q)
#pragma unroll
                            for (int p = 0; p < 2; ++p) { const Fp6Row& rr = gsel == 0 ? r0[q] : gsel == 1 ? r1[q] : r2[q];
                                if (VF4) { const uint4 qq = p ? rr.q1 : rr.q0; const unsigned wq[4] = {qq.x, qq.y, qq.z, qq.w}; const float cfb = cfv[q] * (p ? bfhi(rr.q2.x) : bflo(rr.q2.x));
#pragma unroll
                                    for (int dw = 0; dw < 4; ++dw) { float one = 1.0f; asm volatile("" : "+v"(one)); float f8[8]; fp4_unpack8(wq[dw], one, f8);
#pragma unroll
                                        for (int t = 0; t < 8; ++t) acc[8 * p + 2 * dw + (t >> 2)][t & 3] += cfb * f8[t];
                                        PIN4(acc[8 * p + 2 * dw]); PIN4(acc[8 * p + 2 * dw + 1]); }
                                } else if (VAR == 5) { float one = 1.0f; asm volatile("" : "+v"(one)); const h16x32_t fh = fp6_unpack_h(rr, p, one); const _Float16 ch = (_Float16)cfv[q];
#pragma unroll
                                    for (int t = 0; t < 32; t += 2) ah[8 * p + (t >> 2)][(t & 3) >> 1] = __builtin_elementwise_fma((h16x2_t){fh[t], fh[t + 1]}, (h16x2_t){ch, ch}, ah[8 * p + (t >> 2)][(t & 3) >> 1]);
#pragma unroll
                                    for (int jj = 0; jj < 8; ++jj) asm volatile("" : "+v"(ah[8 * p + jj][0]), "+v"(ah[8 * p + jj][1]));
                                } else { float one = 1.0f; asm volatile("" : "+v"(one)); float bsc; const f32x32_t f = row_unpack<VF4, VAR>(rr, p, one, bsc);
                                    const float cfb = cfv[q] * bsc;
#pragma unroll
                                    for (int t = 0; t < 32; t += 2) ap[8 * p + (t >> 2)][(t & 3) >> 1] = __builtin_elementwise_fma((f32x2){f[t], f[t + 1]}, (f32x2){cfb, cfb}, ap[8 * p + (t >> 2)][(t & 3) >> 1]);
#pragma unroll
                                    for (int jj = 0; jj < 8; ++jj) asm volatile("" : "+v"(ap[8 * p + jj][0]), "+v"(ap[8 * p + jj][1])); } }
                    }
                }
            }
            if (VAR == 5) {
#pragma unroll
                for (int j = 0; j < 16; ++j) { acc[j][0] = (float)ah[j][0].x; acc[j][1] = (float)ah[j][0].y; acc[j][2] = (float)ah[j][1].x; acc[j][3] = (float)ah[j][1].y; } }
            else if (!VF4) {
#pragma unroll
                for (int j = 0; j < 16; ++j) { acc[j][0] = ap[j][0].x; acc[j][1] = ap[j][0].y; acc[j][2] = ap[j][1].x; acc[j][3] = ap[j][1].y; } }
        }
#endif
        { const float* gt2 = mod + (size_t)bb * NMOD + 5 * DM; float ss = 0.f;
          int l4 = lane * 4; asm volatile("" : "+v"(l4));
#pragma unroll
          for (int j = 0; j < 16; ++j) { const int c = 256 * j + l4; const f32x4 gq = *(const LAS f32x4*)(lds + (size_t)(bb * 4096 + c) * 4); const float4 g = make_float4(gq[0], gq[1], gq[2], gq[3]); float4 h4; if (HBF) { const uint2 hq = *(const uint2*)(hbrow + c); h4 = make_float4(bflo(hq.x), bfhi(hq.x), bflo(hq.y), bfhi(hq.y)); } else h4 = *(const float4*)(hrow + c);
              acc[j][0] = h4.x + g.x * acc[j][0]; acc[j][1] = h4.y + g.y * acc[j][1]; acc[j][2] = h4.z + g.z * acc[j][2]; acc[j][3] = h4.w + g.w * acc[j][3];
              ss += (acc[j][0] * acc[j][0] + acc[j][1] * acc[j][1]) + (acc[j][2] * acc[j][2] + acc[j][3] * acc[j][3]);
              if ((j & 3) == 3) { PIN4(acc[j - 3]); PIN4(acc[j - 2]); PIN4(acc[j - 1]); PIN4(acc[j]); asm volatile("" ::: "memory"); } }
          const float rstd = rsqrtf(wave_sum(ss) * (1.f / DM) + RMS_EPS);
#pragma unroll
          for (int j = 0; j < 16; ++j) { const int c = 256 * j + l4; const f32x4 fq = *(const LAS f32x4*)(lds + (size_t)(4 * 4096 + c) * 4); const float4 fg = make_float4(fq[0], fq[1], fq[2], fq[3]);
              *(float4*)(outp + (size_t)m * DM + c) = make_float4(acc[j][0] * rstd * fg.x, acc[j][1] * rstd * fg.y, acc[j][2] * rstd * fg.z, acc[j][3] * rstd * fg.w);
              if ((j & 3) == 3) asm volatile("" ::: "memory"); } }
    }
}

constexpr int N_PHASES = 13;
#ifndef TAB_ROWS
#define TAB_ROWS 12
#endif
constexpr int TAB_EARLY = 116 * 8 * TAB_ROWS;
__global__ void __launch_bounds__(512, 2) hybrid_fwd(Args args) {
    extern __shared__ __attribute__((aligned(16))) unsigned char lds_raw[];
    LAS unsigned char* lds = (LAS unsigned char*)lds_raw;
    volatile LAS unsigned* MISC = (volatile LAS unsigned*)(lds + LDS_MISC);
    for (int u = TID; u < (LDS_BYTES - LDS_CTL) / 4; u += 512) ((LAS unsigned*)(lds + LDS_CTL))[u] = 0u;
    __syncthreads();
    const int lo = args.ph_lo, hi = args.ph_hi;
    XcdBarrier bar; bar.bar = (unsigned*)(args.ws + WS_CTL); bar.x = 0; bar.st = nullptr;
    if (hi - lo > 1) bar = xcd_barrier_post((unsigned*)(args.ws + WS_CTL), MISC + 8);
#define IN(k) (lo <= (k) && (k) < hi && ((MK_PHASE_MASK >> (k)) & 1))
#define SEAM(k) do { if (IN(k) && IN((k) + 1)) xcd_barrier(bar); } while (0)
    const int bid = (int)blockIdx.x, G = (int)gridDim.x;

    if (IN(0)) { ph_mod(args, lds); ph_conv(args, lds, CONVQ); if (CONVQ) { __syncthreads(); ph_convq(args, lds); } }
    SEAM(0);
    if (IN(1)) { ph_norm1(args); if (MK_F8 && !CONVQ) ph_w8(args); }
    SEAM(1);
    if (IN(2)) { pg8::StaticOrder S; S.init(MT, NINP, G, bid);
#if MK_F8 && (MK_QG & 1)
        { int k8 = DM / 2; asm volatile("" : "+s"(k8));
          pg8::Gemm g{(const bf16*)(args.ws + WS_A1), (const bf16*)(args.ws + WS_W8), MT, NINP, k8, DM / 2, DM / 2, 0, 0};
          pg8::EpiBf16S E{(bf16*)(args.ws + WS_P), NINP, (const float*)(args.ws + WS_SA), (const float*)(args.ws + WS_SB), (bf16*)(args.ws + WS_Z), COL_Z, COL_Z + RW, RW, MX}; pg8::gemm_phase<pg8::EpiBf16S, pg8::StaticOrder, false, MK_F8>(lds, g, S, E, nullptr); }
#else
        { pg8::Gemm g{(const bf16*)(args.ws + WS_A1), (const bf16*)(args.ws + WS_WT_IN), MT, NINP, DM, DM, DM, 0, 0};
          pg8::EpiBf16<0> E{(bf16*)(args.ws + WS_P), NINP, nullptr, 0, 0}; pg8::gemm_phase<pg8::EpiBf16<0>, pg8::StaticOrder>(lds, g, S, E, nullptr); }
#endif
        if (G == 256 && bid >= 140) ph_tabconv(args, 0, TAB_EARLY, (bid - 140) * 8 + WAVE, 116 * 8); }
    SEAM(2);
    if (IN(3)) { ph_prep_stage(args, lds); ph_prep_rwkv(args, lds); ph_prep_ssd(args, lds); }
    SEAM(3);
    if (IN(4)) { int kw = KLRW; asm volatile("" : "+s"(kw));
        pg8::Gemm g{(const bf16*)(args.ws + WS_ALR), (const bf16*)(args.ws + WS_WLR), MT, NLR, kw, KLR, KLRW, 4, 256}; pg8::StaticOrder S; S.init(MT, NLR, G, bid);
        EpiLR E{(bf16*)(args.ws + WS_LR), args.in[I_W0], args.in[I_A0]}; pg8::gemm_phase<EpiLR, pg8::StaticOrder>(lds, g, S, E, nullptr); }
    SEAM(4);
    if (IN(5)) ph_rwkv_chunked2(args, lds);
    if (IN(6)) ph_ssd_chunked(args, lds);
    SEAM(6);
    if (IN(7)) ph_finish(args, lds);
    SEAM(7);
    if (IN(8)) { pg8::StaticOrder S; S.init(MX, DM, G, bid);
        if constexpr (QG2) { int k8 = DM / 2; asm volatile("" : "+s"(k8));
            pg8::Gemm g{(const bf16*)(args.ws + WS_A2), (const bf16*)(args.ws + WS_W8O), MX, DM, k8, DM / 2, DM / 2, 0, 0};
            if constexpr (HBF) { EpiResB E{(bf16*)(args.ws + WS_HB), args.in[I_X], (const float*)(args.ws + WS_MOD), (const float*)(args.ws + WS_SA), (const float*)(args.ws + WS_SB2)}; pg8::gemm_phase<EpiResB, pg8::StaticOrder, false, MK_F8>(lds, g, S, E, nullptr); }
            else { EpiRes E{args.out, args.in[I_X], (const float*)(args.ws + WS_MOD), (const float*)(args.ws + WS_SA), (const float*)(args.ws + WS_SB2)}; pg8::gemm_phase<EpiRes, pg8::StaticOrder, false, MK_F8>(lds, g, S, E, nullptr); } }
        else { pg8::Gemm g{(const bf16*)(args.ws + WS_A2), (const bf16*)(args.ws + WS_WT_OUT), MX, DM, DM, DM, DM, 0, 0};
            EpiRes E{args.out, args.in[I_X], (const float*)(args.ws + WS_MOD), nullptr, nullptr}; pg8::gemm_phase<EpiRes, pg8::StaticOrder>(lds, g, S, E, nullptr); } }
    SEAM(8);
    if (IN(9)) { ph_norm2(args); ph_tabconv(args, G == 256 ? TAB_EARLY : 0, 2 * 16384, GW, NGW); }
    SEAM(9);
    if (IN(10)) { pg8::StaticOrder S; S.init(MX, 2048, G, bid);
        if constexpr (QGQ) { int k8 = DM / 2; asm volatile("" : "+s"(k8));
            pg8::Gemm g{(const bf16*)(args.ws + WS_XN2), (const bf16*)(args.ws + WS_W8Q), MX, 2048, k8, DM / 2, DM / 2, 0, 0};
            pg8::EpiBf16S E{(bf16*)(args.ws + WS_Q), 2048, (const float*)(args.ws + WS_SA), (const float*)(args.ws + WS_SBQ), nullptr, 0, 0, 0, 0}; pg8::gemm_phase<pg8::EpiBf16S, pg8::StaticOrder, false, MK_F8>(lds, g, S, E, nullptr); }
        else { pg8::Gemm g{(const bf16*)(args.ws + WS_XN2), (const bf16*)(args.ws + WS_WT_Q), MX, 2048, DM, DM, DM, 0, 0};
            pg8::EpiBf16<0> E{(bf16*)(args.ws + WS_Q), 2048, nullptr, 0, 0}; pg8::gemm_phase<pg8::EpiBf16<0>, pg8::StaticOrder>(lds, g, S, E, nullptr); } }
    SEAM(10);
    if (IN(11)) { int kw = 256; asm volatile("" : "+s"(kw));
        pg8::Gemm g{(const bf16*)(args.ws + WS_Q), (const bf16*)(args.ws + WS_KBD), MX, 2048, kw, 2048, 256, 0, 256}; pg8::StaticOrder S; S.init(MX, 2048, G, bid);
        pg8::EpiF32 E{(float*)(args.ws + WS_S), 2048, nullptr}; pg8::gemm_phase<pg8::EpiF32, pg8::StaticOrder>(lds, g, S, E, nullptr); }
    SEAM(11);
    if (IN(12)) { if (MK_PEER_PROBE == 1) ph_peer(args, (float*)(args.ws + WS_R), lds); if (MK_PEER_PROBE == 2) ph_peer<1023, MK_PEER_VAR>(args, (float*)(args.ws + WS_R), lds); ph_peer(args, args.out, lds); }
#undef IN
#undef SEAM
}

extern "C" void kernel_launch(void* const* d_in, const int* in_sizes, int n_in, void* d_out, int out_size, void* d_ws, size_t ws_size, hipStream_t stream) {
    static int grid = 0;
    if (grid == 0) {
        if (n_in != N_IN || out_size != MX * DM || ws_size < WS_END) { fprintf(stderr, "kernel_launch: unexpected shapes (n_in %d out %d ws %zu)\n", n_in, out_size, ws_size); grid = -1; return; }
        int dev = 0, cus = 0, per_cu = 0;
        if (hipGetDevice(&dev) != hipSuccess || hipDeviceGetAttribute(&cus, hipDeviceAttributeMultiprocessorCount, dev) != hipSuccess) { grid = -1; return; }
        if (hipFuncSetAttribute((const void*)hybrid_fwd, hipFuncAttributeMaxDynamicSharedMemorySize, LDS_BYTES) != hipSuccess) { fprintf(stderr, "kernel_launch: hipFuncSetAttribute failed\n"); grid = -1; return; }
        if (hipOccupancyMaxActiveBlocksPerMultiprocessor(&per_cu, (const void*)hybrid_fwd, 512, LDS_BYTES) != hipSuccess || per_cu < 1) fprintf(stderr, "kernel_launch: occupancy query reports %d\n", per_cu);
        (void)hipGetLastError();
        grid = cus;
    }
    if (grid < 0) return;
    (void)in_sizes;
    if (hipMemsetAsync((char*)d_ws + WS_CTL, 0, CTL_ZERO_BYTES, stream) != hipSuccess) return;
    Args a{};
    for (int i = 0; i < N_IN; ++i) a.in[i] = (const float*)d_in[i];
    a.out = (float*)d_out; a.ws = (unsigned char*)d_ws;
#if MK_N_LAUNCHES == 1
    a.ph_lo = 0; a.ph_hi = N_PHASES;
    hipLaunchKernelGGL(hybrid_fwd, dim3(grid), dim3(512), LDS_BYTES, stream, a);
#else
    for (int ph = 0; ph < N_PHASES; ++ph) { if (!((MK_PHASE_MASK >> ph) & 1)) continue; a.ph_lo = ph; a.ph_hi = ph + 1; hipLaunchKernelGGL(hybrid_fwd, dim3(grid), dim3(512), LDS_BYTES, stream, a); }
#endif
}
```

```cpp
#include <hip/hip_runtime.h>
#include <stdint.h>
#include <stdio.h>
namespace pg8 {
#define PG8_LAS __attribute__((address_space(3)))
typedef unsigned short bf16_t;
typedef short bf16x8 __attribute__((ext_vector_type(8)));
typedef float f32x4 __attribute__((ext_vector_type(4)));
typedef unsigned u32x4 __attribute__((ext_vector_type(4)));
typedef int i32x8 __attribute__((ext_vector_type(8)));
typedef int i32x4 __attribute__((ext_vector_type(4)));
constexpr int BM = 256, BK = 64, HALF = 128, HTB = HALF * BK * 2  , STAGE_BYTES = 8 * HTB, NXCD = 8, WGM = 8;

__host__ __device__ __forceinline__ int lds_byte(int r, int c) { const int st = (r >> 4) * 2 + (c >> 5), rr = r & 15, cc = c & 31, ob = rr * 64 + cc * 2; return st * 1024 + (ob ^ (((ob >> 9) & 1) << 5)); }
__host__ __device__ __forceinline__ void stage_rc(int b, int& R, int& C) { const int st = b / 1024, sb = b % 1024, swz = sb ^ (((sb >> 9) & 1) << 5); R = (st >> 1) * 16 + swz / 64; C = (st & 1) * 32 + (swz % 64) / 2; }
__host__ __device__ __forceinline__ int perm32(int rho) { const int n = rho >> 4, i = rho & 15; return 8 * (i >> 2) + 4 * n + (i & 3); }

struct Unit { int pm, pn; };
struct Gemm { const bf16_t* A; const bf16_t* Bt; int M, N, K; int lda, ldb, kshift, kmul; };

struct StaticOrder {
    int nM, nN, nwg, G, c;
    __host__ __device__ void init(int M, int N, int G_, int c_) { nM = M / BM; nN = N / BM; nwg = nM * nN; G = G_; c = c_; }
    __host__ __device__ bool next(int i, Unit& u) const {
        const long L = (long)i * G + c; if (L >= nwg) return false;
        int wgid = (int)L; { const int q = nwg / NXCD, r = nwg % NXCD, xcd = wgid % NXCD, off = wgid / NXCD; wgid = (xcd < r ? xcd * (q + 1) : r * (q + 1) + (xcd - r) * q) + off; }
        const int nig = WGM * nN, gid = wgid / nig, fm = gid * WGM, gsz = (nM - fm) < WGM ? (nM - fm) : WGM;
        u.pm = fm + ((wgid % nig) % gsz); u.pn = (wgid % nig) / gsz; return true;
    }
    __device__ __forceinline__ void a_ready(const Unit&) const {}
    __device__ __forceinline__ void done(const Unit&) const {}
};
typedef __bf16 bf16pair __attribute__((ext_vector_type(2))); typedef float f32pair __attribute__((ext_vector_type(2)));
__device__ __forceinline__ unsigned cvt_pk_bf16(float lo, float hi) { return __builtin_bit_cast(unsigned, __builtin_convertvector((f32pair){lo, hi}, bf16pair)); }
typedef float f32x2 __attribute__((ext_vector_type(2)));
__device__ __forceinline__ f32x2 gelu_pk(f32x2 v) {
    const f32x2 av = __builtin_elementwise_abs(v), d = av * 0.2316418882f + 1.0f;
    f32x2 t; t.x = __builtin_amdgcn_rcpf(d.x); t.y = __builtin_amdgcn_rcpf(d.y);
    f32x2 q = t * 0.5307027145f + (-0.7265760135f); q = q * t + 0.7107068705f; q = q * t + (-0.142248368f); q = q * t + 0.127414796f; q = q * t;
    const f32x2 s = (v * v) * (-0.72134752044f);
    f32x2 e; e.x = __builtin_amdgcn_exp2f(s.x); e.y = __builtin_amdgcn_exp2f(s.y);
    const f32x2 m = v * (q * e), r = v - m;
    f32x2 o; o.x = v.x < 0.f ? m.x : r.x; o.y = v.y < 0.f ? m.y : r.y; return o;
}

struct EpiF32 {
    static constexpr bool PERM = false, AFTER_DRAIN = false;
    float* C; int ldc; const float* bias;
    __device__ __forceinline__ void operator()(const f32x4 (&acc)[2][2][4][2], const Unit& u, int wr, int wc, int fr, int fq) const {
        const int row0 = u.pm * BM + wr * 64 + fr, col0 = u.pn * BM + wc * 32 + 4 * fq;
        f32x4 bv[2][2];
#pragma unroll
        for (int bj = 0; bj < 2; ++bj)
#pragma unroll
            for (int n = 0; n < 2; ++n) bv[bj][n] = bias ? *(const f32x4*)(bias + col0 + bj * HALF + n * 16) : (f32x4){0.f, 0.f, 0.f, 0.f};
#pragma unroll
        for (int ai = 0; ai < 2; ++ai)
#pragma unroll
            for (int m = 0; m < 4; ++m) { float* rowp = C + (size_t)(row0 + ai * HALF + m * 16) * ldc + col0;
#pragma unroll
                for (int bj = 0; bj < 2; ++bj)
#pragma unroll
                    for (int n = 0; n < 2; ++n) *(f32x4*)(rowp + bj * HALF + n * 16) = acc[ai][bj][m][n] + bv[bj][n]; }
    }
};
template <int ACT  > struct EpiBf16 {
    static constexpr bool PERM = true, AFTER_DRAIN = false;
    bf16_t* O; int ldc; const float* bias; int split_cols; size_t split_stride;
    __device__ __forceinline__ void operator()(const f32x4 (&acc)[2][2][4][2], const Unit& u, int wr, int wc, int fr, int fq) const {
        const int row0 = u.pm * BM + wr * 64 + fr; int colt = u.pn * BM; bf16_t* base = O;
        if (split_cols) { const int t = colt / split_cols; base += (size_t)t * split_stride; colt -= t * split_cols; }
        const int col0 = colt + wc * 32 + 8 * fq, bcol0 = u.pn * BM + wc * 32 + 8 * fq;
        f32x4 bv[2][2];
#pragma unroll
        for (int bj = 0; bj < 2; ++bj)
#pragma unroll
            for (int n = 0; n < 2; ++n) bv[bj][n] = bias ? *(const f32x4*)(bias + bcol0 + bj * HALF + 4 * n) : (f32x4){0.f, 0.f, 0.f, 0.f};
#pragma unroll
        for (int ai = 0; ai < 2; ++ai)
#pragma unroll
            for (int m = 0; m < 4; ++m) { bf16_t* rowp = base + (size_t)(row0 + ai * HALF + m * 16) * ldc + col0;
#pragma unroll
                for (int bj = 0; bj < 2; ++bj) { f32x4 v0 = acc[ai][bj][m][0] + bv[bj][0], v1 = acc[ai][bj][m][1] + bv[bj][1];
                    if (ACT == 1) { f32x2 a = gelu_pk((f32x2){v0[0], v0[1]}), b = gelu_pk((f32x2){v0[2], v0[3]}), c = gelu_pk((f32x2){v1[0], v1[1]}), d = gelu_pk((f32x2){v1[2], v1[3]});
                        v0 = (f32x4){a.x, a.y, b.x, b.y}; v1 = (f32x4){c.x, c.y, d.x, d.y}; }
                    if (ACT == 2) {
#pragma unroll
                        for (int j = 0; j < 4; ++j) { v0[j] = 0.5f * v0[j] * (1.0f + erff(v0[j] * 0.70710678f)); v1[j] = 0.5f * v1[j] * (1.0f + erff(v1[j] * 0.70710678f)); } }
                    u32x4 w; w.x = cvt_pk_bf16(v0[0], v0[1]); w.y = cvt_pk_bf16(v0[2], v0[3]); w.z = cvt_pk_bf16(v1[0], v1[1]); w.w = cvt_pk_bf16(v1[2], v1[3]);
                    *(u32x4*)(rowp + bj * HALF) = w; } }
    }
};
struct EpiBf16S {
    static constexpr bool PERM = true, AFTER_DRAIN = false;
    bf16_t* O; int ldc; const float* sa; const float* sb; bf16_t* O2; int c2lo, c2hi, ld2, m2;
    template <class AT> __device__ __forceinline__ void operator()(const AT (&acc)[2][2][4][2], const Unit& u, int wr, int wc, int fr, int fq) const {
        const int row0 = u.pm * BM + wr * 64 + fr, col0 = u.pn * BM + wc * 32 + 8 * fq;
        asm volatile("" ::: "memory");
        f32x4 cs[2][2];
#pragma unroll
        for (int bj = 0; bj < 2; ++bj)
#pragma unroll
            for (int n = 0; n < 2; ++n) cs[bj][n] = *(const f32x4*)(sb + col0 + bj * HALF + 4 * n);
#pragma unroll
        for (int ai = 0; ai < 2; ++ai)
#pragma unroll
            for (int m = 0; m < 4; ++m) { const int row = row0 + ai * HALF + m * 16; const float rs = sa[row];
#pragma unroll
                for (int bj = 0; bj < 2; ++bj) { const int ch = u.pn * BM + bj * HALF; const bool red = ch >= c2lo && ch < c2hi;
                    bf16_t* rowp = red ? O2 + (size_t)row * ld2 + (col0 - c2lo) : O + (size_t)row * ldc + col0; if (red && row >= m2) continue;
                    const f32x4 v0 = __builtin_convertvector(acc[ai][bj][m][0], f32x4) * cs[bj][0] * rs, v1 = __builtin_convertvector(acc[ai][bj][m][1], f32x4) * cs[bj][1] * rs;
                    u32x4 w; w.x = cvt_pk_bf16(v0[0], v0[1]); w.y = cvt_pk_bf16(v0[2], v0[3]); w.z = cvt_pk_bf16(v1[0], v1[1]); w.w = cvt_pk_bf16(v1[2], v1[3]);
                    *(u32x4*)(rowp + bj * HALF) = w; } }
    }
};
typedef _Float16 f16x2_t __attribute__((ext_vector_type(2)));
__device__ __forceinline__ unsigned cvt_pk_f16(float lo, float hi) { return __builtin_bit_cast(unsigned, __builtin_convertvector((f32pair){lo, hi}, f16x2_t)); }
struct EpiF16 {
    static constexpr bool PERM = true, AFTER_DRAIN = false;
    unsigned short* C; int ldc;
    __device__ __forceinline__ void operator()(const f32x4 (&acc)[2][2][4][2], const Unit& u, int wr, int wc, int fr, int fq) const {
        const int row0 = u.pm * BM + wr * 64 + fr, col0 = u.pn * BM + wc * 32 + 8 * fq;
#pragma unroll
        for (int ai = 0; ai < 2; ++ai)
#pragma unroll
            for (int m = 0; m < 4; ++m) { unsigned short* rowp = C + (size_t)(row0 + ai * HALF + m * 16) * ldc + col0;
#pragma unroll
                for (int bj = 0; bj < 2; ++bj) { const f32x4 v0 = acc[ai][bj][m][0], v1 = acc[ai][bj][m][1];
                    u32x4 w; w.x = cvt_pk_f16(v0[0], v0[1]); w.y = cvt_pk_f16(v0[2], v0[3]); w.z = cvt_pk_f16(v1[0], v1[1]); w.w = cvt_pk_f16(v1[2], v1[3]);
                    *(u32x4*)(rowp + bj * HALF) = w; } }
    }
};
template <int QT> struct AccT { typedef f32x4 type; };
template <> struct AccT<2> { typedef i32x4 type; };
template <class Epi, class Sched, bool STAMP = false, int QT = 0>
__device__ __forceinline__ void gemm_phase(PG8_LAS unsigned char* lds, const Gemm g, const Sched& S, const Epi& E, unsigned long long* stamps) {
    const int tid = threadIdx.x, wid = __builtin_amdgcn_readfirstlane(tid >> 6), lane = tid & 63, wr = wid >> 2, wc = wid & 3, fr = lane & 15, fq = lane >> 4;
    const int K = g.K, nt = K / BK;
    int ts_lo = 0, ts_hi = 0, nts = 0; const unsigned long long rt_entry = STAMP ? (unsigned long long)wall_clock64() : 0ull;
#define PG8_STAMP() do { if (STAMP && wid == 0 && nts < 64) { const unsigned long long _c = (unsigned long long)clock64(); \
        ts_lo = (lane == nts) ? (int)(unsigned)_c : ts_lo; ts_hi = (lane == nts) ? (int)(unsigned)(_c >> 32) : ts_hi; ++nts; } } while (0)
    PG8_STAMP();
    unsigned voffA[2], voffB[2];
#pragma unroll
    for (int i = 0; i < 2; ++i) { int R, C; stage_rc(tid * 16 + i * 8192, R, C); const int Rb = Epi::PERM ? ((R & ~31) + perm32(R & 31)) : R;
        voffA[i] = (unsigned)(R * g.lda + C) * 2u; voffB[i] = (unsigned)(Rb * g.ldb + C) * 2u; }
    const size_t kstep = (size_t)(BK * 2);
    const size_t hstepA = (size_t)HALF * g.lda * 2, hstepB = (size_t)HALF * g.ldb * 2;
    const size_t tstepA = 2 * hstepA, tstepB = 2 * hstepB;
    const unsigned ldsw = (unsigned)wid * 1024u;
    const int aoff = lds_byte(wr * 64 + fr, fq * 8), boff = lds_byte(wc * 32 + fr, fq * 8);
#define PG8_SA(b, h) (((b) * 2 + (h)) * HTB)
#define PG8_SB(b, h) ((4 + (b) * 2 + (h)) * HTB)
#define PG8_STAGE(bufoff, gbase, voff) do { _Pragma("unroll") for (int _i = 0; _i < 2; ++_i) \
        __builtin_amdgcn_global_load_lds((const unsigned*)((const char*)(gbase) + (voff)[_i]), (PG8_LAS unsigned*)(lds + (bufoff) + ldsw + _i * 8192), 16, 0, 0); } while (0)
#define PG8_LDA(dst, b, h) do { _Pragma("unroll") for (int m = 0; m < 4; ++m) _Pragma("unroll") for (int k = 0; k < 2; ++k) dst[m][k] = *(const PG8_LAS bf16x8*)(lds + PG8_SA(b, h) + aoff + m * 2048 + k * 1024); } while (0)
#define PG8_LDB(dst, b, h) do { _Pragma("unroll") for (int n = 0; n < 2; ++n) _Pragma("unroll") for (int k = 0; k < 2; ++k) dst[n][k] = *(const PG8_LAS bf16x8*)(lds + PG8_SB(b, h) + boff + n * 2048 + k * 1024); } while (0)
#define PG8_CAT(x) __builtin_bit_cast(i32x8, __builtin_shufflevector((x)[0], (x)[1], 0, 1, 2, 3, 4, 5, 6, 7, 8, 9, 10, 11, 12, 13, 14, 15))
#define PG8_MMA(ai, bj, At, Bt) do { __builtin_amdgcn_s_setprio(1); _Pragma("unroll") for (int m = 0; m < 4; ++m) _Pragma("unroll") for (int n = 0; n < 2; ++n) { \
        if constexpr (QT == 1) { const i32x8 _b = PG8_CAT(Bt[n]), _a = PG8_CAT(At[m]); asm volatile("v_mfma_f32_16x16x128_f8f6f4 %0, %1, %2, %0" : "+v"(acc[ai][bj][m][n]) : "v"(_b), "v"(_a)); } \
        else if constexpr (QT == 2) { _Pragma("unroll") for (int k = 0; k < 2; ++k) acc[ai][bj][m][n] = __builtin_amdgcn_mfma_i32_16x16x64_i8(__builtin_bit_cast(i32x4, Bt[n][k]), __builtin_bit_cast(i32x4, At[m][k]), acc[ai][bj][m][n], 0, 0, 0); } \
        else { _Pragma("unroll") for (int k = 0; k < 2; ++k) acc[ai][bj][m][n] = __builtin_amdgcn_mfma_f32_16x16x32_bf16(Bt[n][k], At[m][k], acc[ai][bj][m][n], 0, 0, 0); } } \
        __builtin_amdgcn_s_setprio(0); } while (0)
#define PG8_WAIT_V(n) asm volatile("s_waitcnt vmcnt(" #n ")" ::: "memory")
#define PG8_WAIT_L(n) asm volatile("s_waitcnt lgkmcnt(" #n ")" ::: "memory")
#define PG8_BAR __builtin_amdgcn_s_barrier()
#define PG8_SCHED __builtin_amdgcn_sched_barrier(0)
    Unit cur, nxt; int ui = 0;
    if (!S.next(0, cur)) return;
    typedef typename AccT<QT>::type acc_t;
    acc_t acc[2][2][4][2];
#pragma unroll
    for (int a = 0; a < 2; ++a)
#pragma unroll
        for (int b = 0; b < 2; ++b)
#pragma unroll
            for (int m = 0; m < 4; ++m)
#pragma unroll
                for (int n = 0; n < 2; ++n) acc[a][b][m][n] = (acc_t){0, 0, 0, 0};
    bf16x8 At[4][2], B0[2][2], B1[2][2];
    const char* cA = (const char*)g.A + (size_t)cur.pm * tstepA + (size_t)((cur.pn >> g.kshift) * g.kmul) * 2; const char* cB = (const char*)g.Bt + (size_t)cur.pn * tstepB;
    S.a_ready(cur);
    PG8_STAGE(PG8_SB(0, 0), cB, voffB); PG8_STAGE(PG8_SA(0, 0), cA, voffA); PG8_STAGE(PG8_SB(0, 1), cB + hstepB, voffB); PG8_STAGE(PG8_SA(0, 1), cA + hstepA, voffA);
    if (wr == 1) PG8_BAR;
    PG8_WAIT_V(4); PG8_BAR;
    PG8_STAGE(PG8_SB(1, 0), cB + kstep, voffB); PG8_STAGE(PG8_SA(1, 0), cA + kstep, voffA); PG8_STAGE(PG8_SB(1, 1), cB + hstepB + kstep, voffB);
    PG8_WAIT_V(6); PG8_BAR;
    PG8_STAMP();
    for (;;) {
        const bool has_next = S.next(ui + 1, nxt);
        const char* nA = has_next ? (const char*)g.A + (size_t)nxt.pm * tstepA + (size_t)((nxt.pn >> g.kshift) * g.kmul) * 2 : cA; const char* nB = has_next ? (const char*)g.Bt + (size_t)nxt.pn * tstepB : cB;
        for (int t = 0; t < nt; t += 2) {
            const bool last = (t == nt - 2);
            const char* a1 = cA + (size_t)(t + 1) * kstep;
            const char* a2 = last ? nA : cA + (size_t)(t + 2) * kstep; const char* b2 = last ? nB : cB + (size_t)(t + 2) * kstep;
            const char* a3 = a2 + kstep; const char* b3 = b2 + kstep;
            if (last && has_next) S.a_ready(nxt);
            PG8_LDB(B0, 0, 0); PG8_SCHED; PG8_LDA(At, 0, 0); PG8_STAGE(PG8_SA(1, 1), a1 + hstepA, voffA);
            PG8_WAIT_L(8); PG8_BAR; PG8_WAIT_L(0); PG8_MMA(0, 0, At, B0); PG8_BAR; PG8_SCHED;
            PG8_LDB(B1, 0, 1); PG8_STAGE(PG8_SB(0, 0), b2, voffB);
            PG8_BAR; PG8_WAIT_L(0); PG8_MMA(0, 1, At, B1); PG8_BAR;
            PG8_LDA(At, 0, 1); PG8_STAGE(PG8_SA(0, 0), a2, voffA);
            PG8_BAR; PG8_WAIT_L(0); PG8_MMA(1, 0, At, B0); PG8_BAR; PG8_SCHED;
            PG8_STAGE(PG8_SB(0, 1), b2 + hstepB, voffB);
            PG8_WAIT_V(6); PG8_BAR; PG8_MMA(1, 1, At, B1); PG8_BAR;
            PG8_LDB(B0, 1, 0); PG8_SCHED; PG8_LDA(At, 1, 0); PG8_STAGE(PG8_SA(0, 1), a2 + hstepA, voffA);
            PG8_WAIT_L(8); PG8_BAR; PG8_WAIT_L(0); PG8_MMA(0, 0, At, B0); PG8_BAR; PG8_SCHED;
            PG8_LDB(B1, 1, 1); PG8_STAGE(PG8_SB(1, 0), b3, voffB);
            PG8_BAR; PG8_WAIT_L(0); PG8_MMA(0, 1, At, B1); PG8_BAR;
            PG8_LDA(At, 1, 1); PG8_STAGE(PG8_SA(1, 0), a3, voffA);
            PG8_BAR; PG8_WAIT_L(0); PG8_MMA(1, 0, At, B0); PG8_BAR; PG8_SCHED;
            PG8_STAGE(PG8_SB(1, 1), b3 + hstepB, voffB);
            PG8_WAIT_V(6); PG8_BAR; PG8_MMA(1, 1, At, B1); PG8_BAR;
        }
        PG8_STAMP();
        if constexpr (QT == 1) asm volatile("s_nop 15\n\ts_nop 15" ::: "memory");
        if constexpr (!Epi::AFTER_DRAIN) { E(acc, cur, wr, wc, fr, fq); S.done(cur); }
        PG8_STAMP();
        if (!has_next) break;
#pragma unroll
        for (int a = 0; a < 2; ++a)
#pragma unroll
            for (int b = 0; b < 2; ++b)
#pragma unroll
                for (int m = 0; m < 4; ++m)
#pragma unroll
                    for (int n = 0; n < 2; ++n) acc[a][b][m][n] = (acc_t){0, 0, 0, 0};
        cur = nxt; cA = nA; cB = nB; ++ui;
    }
    PG8_WAIT_V(0);
    if (wr == 0) PG8_BAR;
    PG8_BAR;
    if constexpr (Epi::AFTER_DRAIN) { E.fused(acc, cur, wr, wc, fr, fq, lds, wid, lane); S.done(cur); }
    PG8_STAMP();
    if (STAMP && wid == 0) { stamps[lane] = lane < nts ? (((unsigned long long)(unsigned)ts_hi << 32) | (unsigned)ts_lo) : 0ull;
        if (lane == 62) stamps[62] = rt_entry; if (lane == 63) stamps[63] = (unsigned long long)wall_clock64(); }
#undef PG8_STAMP
#undef PG8_SA
#undef PG8_SB
#undef PG8_STAGE
#undef PG8_LDA
#undef PG8_LDB
#undef PG8_MMA
#undef PG8_CAT
#undef PG8_WAIT_V
#undef PG8_WAIT_L
#undef PG8_BAR
#undef PG8_SCHED
}
}

#define LAS __attribute__((address_space(3)))
typedef unsigned short bf16;
typedef float f32x4 __attribute__((ext_vector_type(4)));

#ifndef MK_N_LAUNCHES
#define MK_N_LAUNCHES 1
#endif
#ifndef MK_PHASE_MASK
#define MK_PHASE_MASK 0x1FFF
#endif
#ifndef MK_PEER_FP4
#define MK_PEER_FP4 6
#endif
#ifndef MK_SKIP_MIXER
#define MK_SKIP_MIXER 0
#endif
#ifndef MK_SKIP_PEER
#define MK_SKIP_PEER 0
#endif
#ifndef MK_SKIP_RWKV
#define MK_SKIP_RWKV 0
#endif
#ifndef MK_SKIP_SSD
#define MK_SKIP_SSD 0
#endif

constexpr int DM = 4096, NBATCH = 4, SEQ = 4096, CTXL = 256;
constexpr int MX = NBATCH * SEQ;
constexpr int MC = NBATCH * CTXL;
constexpr int MT = MX + MC;
constexpr int RW = 2048;
constexpr int RCOLS = 6784;
constexpr int NIN = 12992, NINP = 13056;
constexpr int COL_Z = 6784, COL_XBC = 8832, COL_DT = 12928;
constexpr int NLR = 10240, KLR = 768, KLRW = 256;
constexpr int NMOD = 6 * DM;
constexpr float RMS_EPS = 1e-6f, GN_EPS = 64e-5f;
constexpr int NSTEP = CTXL + SEQ;

constexpr size_t MiB = (size_t)1 << 20;
constexpr size_t WS_CTL = 0, CTL_ZERO_BYTES = 1 * MiB;
constexpr size_t WS_MOD = 64 * 1024;
constexpr size_t WS_WT_OUT = 2 * MiB;
constexpr size_t WS_WT_Q = 34 * MiB;
constexpr size_t WS_WLR = 50 * MiB;
constexpr size_t WS_KBD = 63 * MiB;
constexpr size_t WS_DT = 71 * MiB;
constexpr size_t WS_LA = WS_DT + (size_t)MT * 64 * 4;
constexpr size_t WS_ALR = 300 * MiB;
constexpr size_t WS_WT_IN = 102 * MiB;
constexpr size_t WS_A1 = 204 * MiB;
constexpr size_t WS_W8 = 272 * MiB;
constexpr size_t WS_SA = 600 * 1024, WS_SB = 700 * 1024;
constexpr size_t WS_SB2 = 760 * 1024, WS_SBQ = 780 * 1024;
constexpr size_t WS_W8O = 80 * MiB, WS_W8Q = 55 * MiB;
constexpr size_t WS_P = 340 * MiB;
constexpr size_t WS_R = 774 * MiB, WS_K = 842 * MiB, WS_V = 910 * MiB, WS_KK = 978 * MiB;
constexpr size_t WS_XS = 1046 * MiB, WS_BC = 1114 * MiB;
constexpr size_t WS_Z = 102 * MiB;
constexpr size_t WS_LR = 340 * MiB;
constexpr size_t WS_A2 = 166 * MiB;
constexpr size_t WS_XN2 = 340 * MiB;
constexpr size_t WS_Q = 468 * MiB;
constexpr size_t WS_S = 532 * MiB;
constexpr size_t WS_U8 = 1182 * MiB, WS_V8 = (MK_PEER_FP4 == 3 ? 1246 : 1230) * MiB;
constexpr size_t WS_USC = (MK_PEER_FP4 == 3 ? 1310 : 1278) * MiB, WS_VSC = WS_USC + 65536;
constexpr size_t WS_END = WS_USC + MiB;
static_assert(WS_WT_IN + (size_t)NINP * DM * 2 <= WS_A1 && WS_A1 + (size_t)MT * DM * 2 <= WS_P && WS_P + (size_t)MT * NINP * 2 <= WS_R, "ws map 1");
static_assert(WS_LR + (size_t)MT * NLR * 2 <= WS_R && WS_Z + (size_t)MX * RW * 2 <= WS_A2 && WS_A2 + (size_t)MX * DM * 2 <= WS_P, "ws map 2");
static_assert(WS_LA + (size_t)MT * 64 * 4 <= WS_WT_IN && WS_ALR + (size_t)MT * KLR * 2 <= WS_P && WS_ALR >= WS_A2 + (size_t)MX * DM * 2 && WS_WLR + (size_t)NLR * KLRW * 2 <= WS_KBD, "ws map 3");
static_assert(WS_LA + (size_t)MT * 64 * 4 <= WS_W8O && WS_W8O + (size_t)DM * DM <= WS_WT_IN && WS_WLR + (size_t)NLR * KLRW * 2 <= WS_W8Q && WS_W8Q + (size_t)2048 * DM <= WS_KBD && WS_SB + (size_t)NINP * 4 <= WS_SB2 && WS_SB2 + DM * 4 <= WS_SBQ && WS_SBQ + 2048 * 4 <= CTL_ZERO_BYTES, "ws map 6");
static_assert(WS_MOD + (size_t)5 * NMOD * 4 <= WS_SA && WS_SA + (size_t)MT * 4 <= WS_SB && WS_SB + (size_t)NINP * 4 <= CTL_ZERO_BYTES && WS_A1 + (size_t)MT * DM <= WS_W8 && WS_W8 + (size_t)NINP * DM <= WS_P, "ws map 5");
static_assert(WS_S + (size_t)MX * 2048 * 4 <= WS_R && WS_VSC + 65536 <= WS_END && WS_BC + (size_t)MT * RW * 2 <= WS_U8 && WS_U8 + (size_t)16384 * (MK_PEER_FP4 == 3 ? 4096 : 3072) <= WS_V8 && WS_V8 + (size_t)16384 * (MK_PEER_FP4 == 3 ? 4096 : 3072) <= WS_USC, "ws map 4");

constexpr int LDS_BYTES = 147456;
constexpr int LDS_CTL = 143360;
constexpr int LDS_MISC = LDS_CTL + 320;

enum { I_X = 0, I_C, I_CTX, I_CCTX, I_WMOD, I_BMOD, I_N1G, I_N2G, I_WIN, I_WOUT, I_MU, I_W0, I_W2, I_A0, I_A2, I_G2, I_KK, I_KA, I_RK, I_LNW, I_LNB,
       I_CONVW, I_CONVB, I_DTB, I_ALOG, I_SSMD, I_NORMW, I_WQ, I_K1, I_K2, I_PU, I_PV, I_FG, N_IN };

struct Args { const float* in[N_IN]; float* out; unsigned char* ws; int ph_lo, ph_hi; };

__device__ __forceinline__ unsigned f2bf(float f) { unsigned u = __float_as_uint(f); return (u + 0x7fffu + ((u >> 16) & 1u)) >> 16; }
typedef __bf16 bf16pair_t __attribute__((ext_vector_type(2)));
typedef float f32pair_t __attribute__((ext_vector_type(2)));
__device__ __forceinline__ unsigned pk2(float lo, float hi) { return __builtin_bit_cast(unsigned, __builtin_convertvector((f32pair_t){lo, hi}, bf16pair_t)); }
__device__ __forceinline__ float bflo(unsigned u) { return __uint_as_float(u << 16); }
__device__ __forceinline__ float bfhi(unsigned u) { return __uint_as_float(u & 0xffff0000u); }
__device__ __forceinline__ void unpack8(const uint4& u, float (&f)[8]) {
    f[0] = bflo(u.x); f[1] = bfhi(u.x); f[2] = bflo(u.y); f[3] = bfhi(u.y); f[4] = bflo(u.z); f[5] = bfhi(u.z); f[6] = bflo(u.w); f[7] = bfhi(u.w);
}
__device__ __forceinline__ uint4 pack8(const float (&f)[8]) { uint4 u; u.x = pk2(f[0], f[1]); u.y = pk2(f[2], f[3]); u.z = pk2(f[4], f[5]); u.w = pk2(f[6], f[7]); return u; }
__device__ __forceinline__ uint4 ld16(const bf16* p) { return *(const uint4*)p; }
__device__ __forceinline__ void st16(bf16* p, const uint4& v) { *(uint4*)p = v; }
__device__ __forceinline__ void ldf8(const float* p, float (&f)[8]) { const float4 a = *(const float4*)p, b = *(const float4*)(p + 4); f[0] = a.x; f[1] = a.y; f[2] = a.z; f[3] = a.w; f[4] = b.x; f[5] = b.y; f[6] = b.z; f[7] = b.w; }
#define PIN8(a) asm volatile("" : "+v"((a)[0]), "+v"((a)[1]), "+v"((a)[2]), "+v"((a)[3]), "+v"((a)[4]), "+v"((a)[5]), "+v"((a)[6]), "+v"((a)[7]))
template <int CTRL> __device__ __forceinline__ float dppf(float v) { return __uint_as_float((unsigned)__builtin_amdgcn_update_dpp(0, (int)__float_as_uint(v), CTRL, 0xF, 0xF, true)); }
__device__ __forceinline__ float rlane(float v, int l) { return __uint_as_float((unsigned)__builtin_amdgcn_readlane((int)__float_as_uint(v), l)); }
__device__ __forceinline__ float sum8(float v) { v += dppf<0xB1>(v); v += dppf<0x4E>(v); v += dppf<0x141>(v); return v; }
__device__ __forceinline__ float sum16(float v) { v = sum8(v); v += dppf<0x140>(v); return v; }
__device__ __forceinline__ float sum32(float v) { v = sum16(v); v += __shfl_xor(v, 16); return v; }
__device__ __forceinline__ float wave_sum(float v) { v = sum16(v); return (rlane(v, 0) + rlane(v, 16)) + (rlane(v, 32) + rlane(v, 48)); }
__device__ __forceinline__ float wave_max(float v) {
    v = fmaxf(v, dppf<0xB1>(v)); v = fmaxf(v, dppf<0x4E>(v)); v = fmaxf(v, dppf<0x141>(v)); v = fmaxf(v, dppf<0x140>(v));
    return fmaxf(fmaxf(rlane(v, 0), rlane(v, 16)), fmaxf(rlane(v, 32), rlane(v, 48)));
}
__device__ __forceinline__ void lds_barrier() { asm volatile("s_waitcnt lgkmcnt(0)\n\ts_barrier" ::: "memory"); }
__device__ __forceinline__ float sigmoidf_(float x) { return 1.f / (1.f + __expf(-x)); }
__device__ __forceinline__ float siluf_(float x) { return x / (1.f + __expf(-x)); }

struct EpiLR {
    static constexpr bool PERM = true, AFTER_DRAIN = false;
    bf16* O; const float* w0; const float* a0;
    __device__ __forceinline__ void operator()(const pg8::f32x4 (&acc)[2][2][4][2], const pg8::Unit& u, int wr, int wc, int fr, int fq) const {
        const int row0 = u.pm * 256 + wr * 64 + fr; const int colt = u.pn * 256; const int type = colt >> 11;
        const int col0 = colt + wc * 32 + 8 * fq;
        const float* bias = type < 2 ? (w0 + type * 2048) : (a0 + (type - 2) * 2048);
        pg8::f32x4 bv[2][2];
#pragma unroll
        for (int bj = 0; bj < 2; ++bj)
#pragma unroll
            for (int n = 0; n < 2; ++n) bv[bj][n] = type < 4 ? *(const pg8::f32x4*)(bias + ((col0 + bj * 128 + 4 * n) & 2047)) : (pg8::f32x4){0.f, 0.f, 0.f, 0.f};
#pragma unroll
        for (int ai = 0; ai < 2; ++ai)
#pragma unroll
            for (int m = 0; m < 4; ++m) { bf16* rowp = O + (size_t)(row0 + ai * 128 + m * 16) * NLR + col0;
#pragma unroll
                for (int bj = 0; bj < 2; ++bj) { pg8::f32x4 v0 = acc[ai][bj][m][0] + bv[bj][0], v1 = acc[ai][bj][m][1] + bv[bj][1];
                    if (type < 4) {
#pragma unroll
                        for (int j = 0; j < 4; ++j) { float s0 = __builtin_amdgcn_rcpf(1.f + __expf(-v0[j])), s1 = __builtin_amdgcn_rcpf(1.f + __expf(-v1[j]));
                            if (type < 2) { s0 = 1.f - __expf(-0.60653066f * s0); s1 = 1.f - __expf(-0.60653066f * s1); }
                            v0[j] = s0; v1[j] = s1; } }
                    pg8::u32x4 w; w.x = pk2(v0[0], v0[1]); w.y = pk2(v0[2], v0[3]); w.z = pk2(v1[0], v1[1]); w.w = pk2(v1[2], v1[3]);
                    *(pg8::u32x4*)(rowp + bj * 128) = w; } }
    }
};
struct EpiRes {
    static constexpr bool PERM = false, AFTER_DRAIN = false;
    float* C; const float* X; const float* mod; const float* sa; const float* sb;
    template <class AT> __device__ __forceinline__ void operator()(const AT (&acc)[2][2][4][2], const pg8::Unit& u, int wr, int wc, int fr, int fq) const {
        const int row0 = u.pm * 256 + wr * 64 + fr, col0 = u.pn * 256 + wc * 32 + 4 * fq;
        const float* gt = mod + (size_t)((u.pm * 256) / SEQ) * NMOD + 2 * DM;
        asm volatile("" ::: "memory");
        pg8::f32x4 gv[2][2];
#pragma unroll
        for (int bj = 0; bj < 2; ++bj)
#pragma unroll
            for (int n = 0; n < 2; ++n) { gv[bj][n] = *(const pg8::f32x4*)(gt + col0 + bj * 128 + n * 16); if (sb) gv[bj][n] *= *(const pg8::f32x4*)(sb + col0 + bj * 128 + n * 16); }
#pragma unroll
        for (int ai = 0; ai < 2; ++ai)
#pragma unroll
            for (int m = 0; m < 4; ++m) { const size_t off = (size_t)(row0 + ai * 128 + m * 16) * DM + col0; const float rs = sa ? sa[row0 + ai * 128 + m * 16] : 1.f;
#pragma unroll
                for (int bj = 0; bj < 2; ++bj)
#pragma unroll
                    for (int n = 0; n < 2; ++n) { const pg8::f32x4 xv = *(const pg8::f32x4*)(X + off + bj * 128 + n * 16);
#if MK_SKIP_MIXER
                        *(pg8::f32x4*)(C + off + bj * 128 + n * 16) = xv;
#else
                        *(pg8::f32x4*)(C + off + bj * 128 + n * 16) = xv + gv[bj][n] * (__builtin_convertvector(acc[ai][bj][m][n], pg8::f32x4) * rs);
#endif
                    }
                asm volatile("" ::: "memory"); }
    }
};

#define XB_TMO      128
#define XB_XCNT(j)  (256  + 64 * (j))
#define XB_XSUB(j)  (1280 + 64 * (j))
#define XB_XGEN(j)  (2304 + 64 * (j))
#define XB_TOP      3328
#define XB_TOPGEN   3392
#define XCD_BAR_WORDS 3456
#define XB_SPIN_CAP (1u << 18)
__device__ __forceinline__ unsigned xb_ld(unsigned* p)              { return __hip_atomic_load(p, __ATOMIC_RELAXED, __HIP_MEMORY_SCOPE_AGENT); }
__device__ __forceinline__ unsigned xb_add(unsigned* p, unsigned v) { return __hip_atomic_fetch_add(p, v, __ATOMIC_RELAXED, __HIP_MEMORY_SCOPE_AGENT); }
__device__ __forceinline__ unsigned xb_xcc_id() { return (unsigned)__builtin_amdgcn_s_getreg((3 << 11) | 20) & 0xFu; }
#define XB_SPIN(cond, bar) do { unsigned _sp = 0; while (cond) { __builtin_amdgcn_s_sleep(1); \
    if ((++_sp & 255u) == 0u) { if (xb_ld(&(bar)[XB_TMO])) break; if (_sp > XB_SPIN_CAP) { atomicAdd(&(bar)[XB_TMO], 1u); break; } } } } while (0)
struct XcdBarrier { unsigned* bar; unsigned x; volatile LAS unsigned* st; };
__device__ __forceinline__ XcdBarrier xcd_barrier_post(unsigned* bar, volatile LAS unsigned* st) {
    XcdBarrier b; b.bar = bar; b.x = xb_xcc_id(); b.st = st;
    if (threadIdx.x == 0) (void)xb_add(&bar[XB_XCNT(b.x)], 1u);
    return b;
}
__device__ __forceinline__ void xcd_barrier_complete(unsigned* bar, unsigned x, unsigned& nloc, unsigned& nx) {
    const unsigned G = gridDim.x * gridDim.y * gridDim.z;
    unsigned sum, cnt, mine, sp = 0u;
    for (;;) {
        sum = 0u; cnt = 0u; mine = 0u;
#pragma unroll
        for (unsigned j = 0; j < 16; ++j) { const unsigned c = xb_ld(&bar[XB_XCNT(j)]); sum += c; cnt += (c > 0u) ? 1u : 0u; mine = (j == x) ? c : mine; }
        if (sum == G) break;
        __builtin_amdgcn_s_sleep(1);
        if ((++sp & 255u) == 0u) { if (xb_ld(&bar[XB_TMO])) break; if (sp > XB_SPIN_CAP) { atomicAdd(&bar[XB_TMO], 1u); break; } }
    }
    nloc = mine > 0u ? mine : 1u; nx = cnt > 0u ? cnt : 1u;
}
__device__ __forceinline__ void xcd_barrier(const XcdBarrier& b) {
    asm volatile("s_waitcnt vmcnt(0)" ::: "memory");
    __syncthreads();
    if (threadIdx.x == 0) {
        unsigned* bar = b.bar;
        __builtin_amdgcn_s_waitcnt(0);
        unsigned nloc = b.st[0], nx = b.st[1];
        if (nloc == 0u) { xcd_barrier_complete(bar, b.x, nloc, nx); b.st[0] = nloc; b.st[1] = nx; }
        const unsigned old = xb_add(&bar[XB_XSUB(b.x)], 1u);
        const unsigned gen = old / nloc;
        if (old + 1u == (gen + 1u) * nloc) {
            __builtin_amdgcn_fence(__ATOMIC_RELEASE, "agent");
            asm volatile("s_waitcnt vmcnt(0)" ::: "memory");
            const unsigned og = xb_add(&bar[XB_TOP], 1u);
            const unsigned tg = og / nx;
            if (og + 1u == (tg + 1u) * nx) xb_add(&bar[XB_TOPGEN], 1u);
            else XB_SPIN(xb_ld(&bar[XB_TOPGEN]) == tg, bar);
            __builtin_amdgcn_fence(__ATOMIC_ACQUIRE, "agent");
            xb_add(&bar[XB_XGEN(b.x)], 1u);
            asm volatile("s_waitcnt vmcnt(0)" ::: "memory");
        } else {
            XB_SPIN(xb_ld(&bar[XB_XGEN(b.x)]) == gen, bar);
            __builtin_amdgcn_fence(__ATOMIC_ACQUIRE, "agent");
            asm volatile("s_waitcnt vmcnt(0)" ::: "memory");
        }
    }
    __syncthreads();
}

#define TID ((int)threadIdx.x)
#define LANE ((int)(threadIdx.x & 63))
#define WAVE ((int)__builtin_amdgcn_readfirstlane((int)(threadIdx.x >> 6)))
#define GW ((int)blockIdx.x * 8 + WAVE)
#define NGW ((int)gridDim.x * 8)

__device__ __forceinline__ void ph_mod(const Args& a, LAS unsigned char* lds) {
    const float* c = a.in[I_C]; const float* cc = a.in[I_CCTX]; const float* w_mod = a.in[I_WMOD]; const float* b_mod = a.in[I_BMOD];
    float* mod = (float*)(a.ws + WS_MOD);
    LAS float* sS = (LAS float*)lds;
    LAS float* red = (LAS float*)(lds + 81920);
    const int tid = TID, lane = LANE, wave = WAVE;
    for (int i = tid; i < 5 * DM; i += 512) { const int v = i >> 12, k = i & (DM - 1); const float xv = v < 4 ? c[v * DM + k] : cc[k]; sS[i] = xv / (1.f + expf(-xv)); }
    __syncthreads();
    for (int u = blockIdx.x; u < 256; u += gridDim.x) {
        const bool act = lane < 48; const int cl = act ? lane % 24 : 0, kh = act ? lane / 24 : 0;
        float acc[5][4];
#pragma unroll
        for (int v = 0; v < 5; ++v)
#pragma unroll
            for (int e = 0; e < 4; ++e) acc[v][e] = 0.f;
        const float* wp = w_mod + (size_t)(wave * 512 + kh) * NMOD + u * 96 + cl * 4;
        if (act) {
#pragma unroll 8
            for (int i = 0; i < 256; ++i) {
                const float4 w = *(const float4*)(wp + (size_t)(2 * i) * NMOD);
#pragma unroll
                for (int v = 0; v < 5; ++v) { const float s = sS[v * DM + wave * 512 + 2 * i + kh]; acc[v][0] += s * w.x; acc[v][1] += s * w.y; acc[v][2] += s * w.z; acc[v][3] += s * w.w; }
            }
        }
#pragma unroll
        for (int v = 0; v < 5; ++v)
#pragma unroll
            for (int e = 0; e < 4; ++e) acc[v][e] += __shfl_down(acc[v][e], 24);
        if (lane < 24) {
#pragma unroll
            for (int v = 0; v < 5; ++v) *(LAS f32x4*)(red + ((wave * 5 + v) * 96 + cl * 4)) = (f32x4){acc[v][0], acc[v][1], acc[v][2], acc[v][3]};
        }
        __syncthreads();
        for (int i = tid; i < 480; i += 512) { const int v = i / 96, n = i % 96; float s = b_mod[u * 96 + n];
#pragma unroll
            for (int w = 0; w < 8; ++w) s += red[(w * 5 + v) * 96 + n];
            mod[v * NMOD + u * 96 + n] = s; }
        __syncthreads();
    }
    __syncthreads();
}

#ifndef MK_SIM_FP8
#define MK_SIM_FP8 0
#endif
__device__ __forceinline__ float m3r(float x) { unsigned u = __float_as_uint(x); u += 0x7FFFFu + ((u >> 20) & 1u); return __uint_as_float(u & 0xFFF00000u); }
__device__ __forceinline__ unsigned pk4_i8(float a0, float a1, float a2, float a3) { const float M = 12582912.f; const unsigned u0 = __float_as_uint(a0 + M), u1 = __float_as_uint(a1 + M), u2 = __float_as_uint(a2 + M), u3 = __float_as_uint(a3 + M);
    return (u0 & 0xffu) | ((u1 & 0xffu) << 8) | ((u2 & 0xffu) << 16) | (u3 << 24); }
template <bool SIM> __device__ __forceinline__ float simq(float x) { return SIM ? m3r(x) : x; }
template <bool SIM> __device__ __forceinline__ void transpose_item(const float* W, int K, int N, bf16* WT, LAS float* scr, int item, int lane) {
    const int nblk = N / 32, kb = item / nblk, nb = item % nblk, k0 = 64 * kb, n0 = 32 * nb;
#pragma unroll 8
    for (int i = 0; i < 32; ++i) { const int kk = 2 * i + (lane >> 5); scr[kk * 33 + (lane & 31)] = simq<SIM>(W[(size_t)(k0 + kk) * N + n0 + (lane & 31)]); }
    asm volatile("s_waitcnt lgkmcnt(0)" ::: "memory");
    const int c = lane & 7;
#pragma unroll
    for (int j = 0; j < 4; ++j) { const int n = (lane >> 3) + 8 * j; const LAS float* s = scr + (8 * c) * 33 + n;
        uint4 o; o.x = pk2(s[0 * 33], s[1 * 33]); o.y = pk2(s[2 * 33], s[3 * 33]); o.z = pk2(s[4 * 33], s[5 * 33]); o.w = pk2(s[6 * 33], s[7 * 33]);
        *(uint4*)(WT + (size_t)(n0 + n) * K + k0 + 8 * c) = o; }
    asm volatile("s_waitcnt lgkmcnt(0)" ::: "memory");
}
__device__ __forceinline__ void ph_conv(const Args& a, LAS unsigned char* lds, bool skipq) {
    const int lane = LANE, wave = WAVE, gw = GW, ngw = NGW;
    LAS float* scr = (LAS float*)(lds + wave * 16384);
    bf16* wt_in = (bf16*)(a.ws + WS_WT_IN); bf16* wt_out = (bf16*)(a.ws + WS_WT_OUT); bf16* wt_q = (bf16*)(a.ws + WS_WT_Q);
    constexpr int IT_IN = (DM / 64) * (NIN / 32), IT_OUT = (DM / 64) * (DM / 32), IT_Q = (DM / 64) * (2048 / 32);
    for (int it = gw; it < (skipq ? 0 : IT_IN + IT_OUT + IT_Q); it += ngw) {
        int r = it;
        if (r < IT_IN) { transpose_item<(MK_SIM_FP8 & 1) != 0>(a.in[I_WIN], DM, NIN, wt_in, scr, r, lane); continue; } r -= IT_IN;
        if (r < IT_OUT) { transpose_item<(MK_SIM_FP8 & 2) != 0>(a.in[I_WOUT], DM, DM, wt_out, scr, r, lane); continue; } r -= IT_OUT;
        transpose_item<(MK_SIM_FP8 & 4) != 0>(a.in[I_WQ], DM, 2048, wt_q, scr, r, lane);
    }
    const int gt = blockIdx.x * 512 + TID, ngt = gridDim.x * 512;
    for (int i = gt; i < (skipq ? 0 : (NINP - NIN) * DM / 8); i += ngt) *(uint4*)(wt_in + (size_t)NIN * DM + (size_t)i * 8) = make_uint4(0u, 0u, 0u, 0u);
    { bf16* wlr = (bf16*)(a.ws + WS_WLR); const float* w2 = a.in[I_W2]; const float* a2 = a.in[I_A2]; const float* g2 = a.in[I_G2];
      for (int i = gt; i < NLR * (KLRW / 8); i += ngt) { const int n = i / (KLRW / 8), k0 = (i % (KLRW / 8)) * 8; const int type = n >> 11, cch = n & 2047;
          float f[8];
#pragma unroll
          for (int e = 0; e < 8; ++e) { const int k = k0 + e; float v = 0.f;
              if (type == 4) v = g2[(size_t)k * RW + cch];
              else { const int d = type & 1, kk = k - 128 * d; const float* src = type < 2 ? w2 : a2; if (kk >= 0 && kk < 96) v = src[(size_t)(d * 96 + kk) * RW + cch]; }
              f[e] = v; }
          st16(wlr + (size_t)n * KLRW + k0, pack8(f)); } }
    { bf16* kbd = (bf16*)(a.ws + WS_KBD); const float* k1 = a.in[I_K1]; const float* k2 = a.in[I_K2];
      for (int i = gt; i < 2048 * 32; i += ngt) { const int n = i >> 5, k0 = (i & 31) * 8; float f[8];
          const int h = n >> 8, sb = (n >> 7) & 1, key = n & 127;
          if ((k0 >> 7) == sb) { const float* src = (sb ? k2 : k1) + ((size_t)(h * 128 + key) * 128 + (k0 & 127)); ldf8(src, f); }
          else {
#pragma unroll
              for (int e = 0; e < 8; ++e) f[e] = 0.f; }
          st16(kbd + (size_t)n * 256 + k0, pack8(f)); } }
}

template <bool SIM> __device__ __forceinline__ void norm_mod_row(const float* src, const float* g, const float* sh, const float* sc, bf16* dst, int lane) {
    float4 v[16]; float ss = 0.f;
#pragma unroll
    for (int j = 0; j < 16; ++j) { v[j] = *(const float4*)(src + (lane + 64 * j) * 4); ss += (v[j].x * v[j].x + v[j].y * v[j].y) + (v[j].z * v[j].z + v[j].w * v[j].w); }
    const float rstd = rsqrtf(wave_sum(ss) * (1.f / DM) + RMS_EPS);
#pragma unroll
    for (int j = 0; j < 16; ++j) { const int c = (lane + 64 * j) * 4; const float4 gg = *(const float4*)(g + c), s1 = *(const float4*)(sc + c), s0 = *(const float4*)(sh + c);
        const float o0 = v[j].x * rstd * gg.x * (1.f + s1.x) + s0.x, o1 = v[j].y * rstd * gg.y * (1.f + s1.y) + s0.y, o2 = v[j].z * rstd * gg.z * (1.f + s1.z) + s0.z, o3 = v[j].w * rstd * gg.w * (1.f + s1.w) + s0.w;
        uint2 w; w.x = pk2(simq<SIM>(o0), simq<SIM>(o1)); w.y = pk2(simq<SIM>(o2), simq<SIM>(o3)); *(uint2*)(dst + c) = w; }
}
#ifndef MK_F8
#define MK_F8 2
#endif
constexpr float QMAX = MK_F8 == 2 ? 127.f : 440.f;
__device__ __forceinline__ unsigned pk4_fp8(float a0, float a1, float a2, float a3) {
    if (MK_F8 == 2) { const float M = 12582912.f; const unsigned u0 = __float_as_uint(a0 + M), u1 = __float_as_uint(a1 + M), u2 = __float_as_uint(a2 + M), u3 = __float_as_uint(a3 + M);
        return (u0 & 0xffu) | ((u1 & 0xffu) << 8) | ((u2 & 0xffu) << 16) | (u3 << 24); }
    int w = 0; w = __builtin_amdgcn_cvt_pk_fp8_f32(a0, a1, w, false); w = __builtin_amdgcn_cvt_pk_fp8_f32(a2, a3, w, true); return (unsigned)w; }
constexpr float QMAX_XN2 = (MK_F8 == 2 && (MK_PEER_FP4 == 4 || MK_PEER_FP4 == 5 || MK_PEER_FP4 == 6)) ? 119.f : QMAX;
template <bool SRCBF> __device__ __forceinline__ void norm_mod_row_f8_lds(const float* src, const LAS float* A, const LAS float* B, unsigned char* dst, float* sa, int lane, float qmax) {
    float4 v[16]; float ss = 0.f;
#pragma unroll
    for (int j = 0; j < 16; ++j) { if (SRCBF) { const uint2 q = *(const uint2*)((const bf16*)src + (lane + 64 * j) * 4); v[j] = make_float4(bflo(q.x), bfhi(q.x), bflo(q.y), bfhi(q.y)); } else v[j] = *(const float4*)(src + (lane + 64 * j) * 4);
        ss += (v[j].x * v[j].x + v[j].y * v[j].y) + (v[j].z * v[j].z + v[j].w * v[j].w); }
    const float rstd = rsqrtf(wave_sum(ss) * (1.f / DM) + RMS_EPS); float am = 0.f;
#pragma unroll
    for (int j = 0; j < 16; ++j) { const int c = (lane + 64 * j) * 4; const f32x4 aa = *(const LAS f32x4*)(A + c), bb = *(const LAS f32x4*)(B + c);
        v[j].x = v[j].x * rstd * aa[0] + bb[0]; v[j].y = v[j].y * rstd * aa[1] + bb[1]; v[j].z = v[j].z * rstd * aa[2] + bb[2]; v[j].w = v[j].w * rstd * aa[3] + bb[3];
        am = fmaxf(fmaxf(am, fmaxf(fabsf(v[j].x), fabsf(v[j].y))), fmaxf(fabsf(v[j].z), fabsf(v[j].w))); }
    am = wave_max(am);
    const float scale = am > 0.f ? am / qmax : 1.f, inv = 1.f / scale;
#pragma unroll
    for (int j = 0; j < 16; ++j) *(unsigned*)(dst + (lane + 64 * j) * 4) = pk4_fp8(v[j].x * inv, v[j].y * inv, v[j].z * inv, v[j].w * inv);
    if (lane == 0) *sa = scale;
}
__device__ __forceinline__ void stage_norm_vectors(const float* g, const float* sh, const float* sc, LAS unsigned char* lds) {
    __syncthreads();
    for (int i = TID; i < 1024; i += 512) { const float4 gg = *(const float4*)(g + 4 * i), s1 = *(const float4*)(sc + 4 * i), s0 = *(const float4*)(sh + 4 * i);
        *(LAS f32x4*)(lds + 16 * i) = (f32x4){gg.x * (1.f + s1.x), gg.y * (1.f + s1.y), gg.z * (1.f + s1.z), gg.w * (1.f + s1.w)}; *(LAS f32x4*)(lds + 16384 + 16 * i) = (f32x4){s0.x, s0.y, s0.z, s0.w}; }
    __syncthreads();
}
template <bool SRCBF = false> __device__ __forceinline__ void norm_mod_row_f8(const float* src, const float* g, const float* sh, const float* sc, unsigned char* dst, float* sa, int lane, float qmax = QMAX) {
    float4 v[16]; float ss = 0.f;
#pragma unroll
    for (int j = 0; j < 16; ++j) { if (SRCBF) { const uint2 q = *(const uint2*)((const bf16*)src + (lane + 64 * j) * 4); v[j] = make_float4(bflo(q.x), bfhi(q.x), bflo(q.y), bfhi(q.y)); } else v[j] = *(const float4*)(src + (lane + 64 * j) * 4); ss += (v[j].x * v[j].x + v[j].y * v[j].y) + (v[j].z * v[j].z + v[j].w * v[j].w); }
    const float rstd = rsqrtf(wave_sum(ss) * (1.f / DM) + RMS_EPS); float am = 0.f;
#pragma unroll
    for (int j = 0; j < 16; ++j) { const int c = (lane + 64 * j) * 4; const float4 gg = *(const float4*)(g + c), s1 = *(const float4*)(sc + c), s0 = *(const float4*)(sh + c);
        v[j].x = v[j].x * rstd * gg.x * (1.f + s1.x) + s0.x; v[j].y = v[j].y * rstd * gg.y * (1.f + s1.y) + s0.y; v[j].z = v[j].z * rstd * gg.z * (1.f + s1.z) + s0.z; v[j].w = v[j].w * rstd * gg.w * (1.f + s1.w) + s0.w;
        am = fmaxf(fmaxf(am, fmaxf(fabsf(v[j].x), fabsf(v[j].y))), fmaxf(fabsf(v[j].z), fabsf(v[j].w))); }
    am = wave_max(am);
    const float scale = am > 0.f ? am / qmax : 1.f, inv = 1.f / scale;
#pragma unroll
    for (int j = 0; j < 16; ++j) *(unsigned*)(dst + (lane + 64 * j) * 4) = pk4_fp8(v[j].x * inv, v[j].y * inv, v[j].z * inv, v[j].w * inv);
    if (lane == 0) *sa = scale;
}
#ifndef MK_QG
#define MK_QG 7
#endif
constexpr bool QG1 = MK_F8 && (MK_QG & 1), QG2 = MK_F8 && (MK_QG & 2), QGQ = MK_F8 && (MK_QG & 4);
#ifndef MK_HBF
#define MK_HBF 1
#endif
constexpr bool HBF = MK_HBF && QG2 && QGQ;
constexpr size_t WS_HB = WS_R;
static_assert(WS_HB + (size_t)MX * DM * 2 <= WS_V, "ws map hb");
struct EpiResB {
    static constexpr bool PERM = true, AFTER_DRAIN = false;
    bf16* H; const float* X; const float* mod; const float* sa; const float* sb;
    template <class AT> __device__ __forceinline__ void operator()(const AT (&acc)[2][2][4][2], const pg8::Unit& u, int wr, int wc, int fr, int fq) const {
        const int row0 = u.pm * 256 + wr * 64 + fr, col0 = u.pn * 256 + wc * 32 + 8 * fq;
        const float* gt = mod + (size_t)((u.pm * 256) / SEQ) * NMOD + 2 * DM;
        asm volatile("" ::: "memory");
        pg8::f32x4 gv[2][2];
#pragma unroll
        for (int bj = 0; bj < 2; ++bj)
#pragma unroll
            for (int n = 0; n < 2; ++n) gv[bj][n] = *(const pg8::f32x4*)(gt + col0 + bj * 128 + 4 * n) * *(const pg8::f32x4*)(sb + col0 + bj * 128 + 4 * n);
#pragma unroll
        for (int ai = 0; ai < 2; ++ai)
#pragma unroll
            for (int m = 0; m < 4; ++m) { const int row = row0 + ai * 128 + m * 16; const size_t off = (size_t)row * DM + col0; const float rs = sa[row];
#pragma unroll
                for (int bj = 0; bj < 2; ++bj) { const pg8::f32x4 x0 = *(const pg8::f32x4*)(X + off + bj * 128), x1 = *(const pg8::f32x4*)(X + off + bj * 128 + 4);
                    const pg8::f32x4 v0 = x0 + gv[bj][0] * (__builtin_convertvector(acc[ai][bj][m][0], pg8::f32x4) * rs), v1 = x1 + gv[bj][1] * (__builtin_convertvector(acc[ai][bj][m][1], pg8::f32x4) * rs);
                    pg8::u32x4 w; w.x = pk2(v0[0], v0[1]); w.y = pk2(v0[2], v0[3]); w.z = pk2(v1[0], v1[1]); w.w = pk2(v1[2], v1[3]);
                    *(pg8::u32x4*)(H + off + bj * 128) = w; }
                asm volatile("" ::: "memory"); }
    }
};
__device__ __forceinline__ void ph_w8(const Args& a) {
    const int lane = LANE;
    constexpr int N1 = QG1 ? NINP : 0, N2 = QG2 ? DM : 0, N3 = QGQ ? 2048 : 0;
    for (int r = GW; r < N1 + N2 + N3; r += NGW) {
        const bf16* wt; unsigned char* w8; float* sb; int n = r;
        if (n < N1) { wt = (const bf16*)(a.ws + WS_WT_IN); w8 = a.ws + WS_W8; sb = (float*)(a.ws + WS_SB); }
        else if (n < N1 + N2) { n -= N1; wt = (const bf16*)(a.ws + WS_WT_OUT); w8 = a.ws + WS_W8O; sb = (float*)(a.ws + WS_SB2); }
        else { n -= N1 + N2; wt = (const bf16*)(a.ws + WS_WT_Q); w8 = a.ws + WS_W8Q; sb = (float*)(a.ws + WS_SBQ); }
        uint4 q[8]; float am = 0.f;
#pragma unroll
        for (int j = 0; j < 8; ++j) q[j] = ld16(wt + (size_t)n * DM + (lane + 64 * j) * 8);
        float f[8][8];
#pragma unroll
        for (int j = 0; j < 8; ++j) { unpack8(q[j], f[j]);
#pragma unroll
            for (int e = 0; e < 8; ++e) am = fmaxf(am, fabsf(f[j][e])); }
        am = wave_max(am);
        const float scale = am > 0.f ? am * (1.f / QMAX) : 1.f, inv = 1.f / scale;
#pragma unroll
        for (int j = 0; j < 8; ++j) { uint2 w; w.x = pk4_fp8(f[j][0] * inv, f[j][1] * inv, f[j][2] * inv, f[j][3] * inv); w.y = pk4_fp8(f[j][4] * inv, f[j][5] * inv, f[j][6] * inv, f[j][7] * inv);
            *(uint2*)(w8 + (size_t)n * DM + (lane + 64 * j) * 8) = w; }
        if (lane == 0) sb[n] = scale;
    }
}
constexpr bool CONVQ = MK_F8 == 2 && (MK_QG & 7) == 7;
__device__ __forceinline__ void ph_convq(const Args& a, LAS unsigned char* lds) {
    const int lane = LANE, wave = WAVE, tid = TID;
    LAS float* scr = (LAS float*)(lds + wave * 16384); LAS float* cms = (LAS float*)(lds + 12288);
    constexpr int U_IN = NIN / 32, U_OUT = DM / 32, U_Q = 2048 / 32;
    for (int u = blockIdx.x; u < U_IN + U_OUT + U_Q; u += gridDim.x) {
        const float* W; int N; unsigned char* w8; float* sb; int n0;
        if (u < U_IN) { W = a.in[I_WIN]; N = NIN; w8 = a.ws + WS_W8; sb = (float*)(a.ws + WS_SB); n0 = 32 * u; }
        else if (u < U_IN + U_OUT) { W = a.in[I_WOUT]; N = DM; w8 = a.ws + WS_W8O; sb = (float*)(a.ws + WS_SB2); n0 = 32 * (u - U_IN); }
        else { W = a.in[I_WQ]; N = 2048; w8 = a.ws + WS_W8Q; sb = (float*)(a.ws + WS_SBQ); n0 = 32 * (u - U_IN - U_OUT); }
        const int cq = lane & 7, kr = lane >> 3;
        const float* wp = W + (size_t)(512 * wave + kr) * N + n0 + 4 * cq;
        float m0 = 0.f, m1 = 0.f, m2 = 0.f, m3 = 0.f; uint2 keep[4][8];
#pragma unroll
        for (int t = 0; t < 8; ++t) {
            float4 x[8];
#pragma unroll
            for (int i = 0; i < 8; ++i) x[i] = *(const float4*)(wp + (size_t)(64 * t + 8 * i) * N);
#pragma unroll
            for (int i = 0; i < 8; ++i) { m0 = fmaxf(m0, fabsf(x[i].x)); m1 = fmaxf(m1, fabsf(x[i].y)); m2 = fmaxf(m2, fabsf(x[i].z)); m3 = fmaxf(m3, fabsf(x[i].w)); if (t < 4) { keep[t][i].x = pk2(x[i].x, x[i].y); keep[t][i].y = pk2(x[i].z, x[i].w); } }
            asm volatile("" ::: "memory");
        }
#pragma unroll
        for (int d = 8; d < 64; d <<= 1) { m0 = fmaxf(m0, __shfl_xor(m0, d)); m1 = fmaxf(m1, __shfl_xor(m1, d)); m2 = fmaxf(m2, __shfl_xor(m2, d)); m3 = fmaxf(m3, __shfl_xor(m3, d)); }
        if (lane < 8) *(LAS f32x4*)(cms + wave * 32 + 4 * lane) = (f32x4){m0, m1, m2, m3};
        __syncthreads();
        f32x4 cm = *(const LAS f32x4*)(cms + 4 * cq);
#pragma unroll
        for (int w = 1; w < 8; ++w) { const f32x4 o = *(const LAS f32x4*)(cms + w * 32 + 4 * cq); cm[0] = fmaxf(cm[0], o[0]); cm[1] = fmaxf(cm[1], o[1]); cm[2] = fmaxf(cm[2], o[2]); cm[3] = fmaxf(cm[3], o[3]); }
        f32x4 sc4, inv4;
#pragma unroll
        for (int e = 0; e < 4; ++e) { sc4[e] = cm[e] > 0.f ? cm[e] * (1.f / 127.f) : 1.f; inv4[e] = 1.f / sc4[e]; }
        if (tid < 8) *(f32x4*)(sb + n0 + 4 * tid) = sc4;
#pragma unroll
        for (int t = 0; t < 8; ++t) {
            const int k0 = 512 * wave + 64 * t;
#pragma unroll
            for (int i = 0; i < 8; ++i) { LAS float* d = scr + (8 * i + kr) * 33 + 4 * cq;
                if (t < 4) { d[0] = bflo(keep[t][i].x) * inv4[0]; d[1] = bfhi(keep[t][i].x) * inv4[1]; d[2] = bflo(keep[t][i].y) * inv4[2]; d[3] = bfhi(keep[t][i].y) * inv4[3]; }
                else { const float4 x = *(const float4*)(wp + (size_t)(64 * t + 8 * i) * N); d[0] = x.x * inv4[0]; d[1] = x.y * inv4[1]; d[2] = x.z * inv4[2]; d[3] = x.w * inv4[3]; } }
            asm volatile("s_waitcnt lgkmcnt(0)" ::: "memory");
            const int c = lane & 7;
#pragma unroll
            for (int j = 0; j < 4; ++j) { const int n = (lane >> 3) + 8 * j; const LAS float* sp = scr + (8 * c) * 33 + n;
                uint2 o; o.x = pk4_i8(sp[0 * 33], sp[1 * 33], sp[2 * 33], sp[3 * 33]); o.y = pk4_i8(sp[4 * 33], sp[5 * 33], sp[6 * 33], sp[7 * 33]);
                *(uint2*)(w8 + (size_t)(n0 + n) * DM + k0 + 8 * c) = o; }
            asm volatile("s_waitcnt lgkmcnt(0)" ::: "memory");
        }
        __syncthreads();
    }
    const int gt = blockIdx.x * 512 + tid, ngt = gridDim.x * 512;
    for (int i = gt; i < (NINP - NIN) * DM / 16; i += ngt) *(uint4*)(a.ws + WS_W8 + (size_t)NIN * DM + (size_t)i * 16) = make_uint4(0u, 0u, 0u, 0u);
    for (int i = gt; i < NINP - NIN; i += ngt) ((float*)(a.ws + WS_SB))[NIN + i] = 1.f;
}
#ifndef MK_NORM_LDS
#define MK_NORM_LDS 1
#endif
__device__ __forceinline__ void ph_norm1(const Args& a, LAS unsigned char* lds) {
    const int lane = LANE; const float* mod = (const float*)(a.ws + WS_MOD); bf16* A1 = (bf16*)(a.ws + WS_A1);
#if MK_F8 && (MK_QG & 1) && MK_NORM_LDS
    { int vcur = -1;
      for (int m0 = (int)blockIdx.x * 8; m0 < MT; m0 += NGW) { const int m = m0 + WAVE; const int v = m0 < MX ? m0 / SEQ : 4;
          if (v != vcur) { stage_norm_vectors(a.in[I_N1G], mod + (size_t)v * NMOD, mod + (size_t)v * NMOD + DM, lds); vcur = v; }
          if (m < MT) { const float* src = m < MX ? a.in[I_X] + (size_t)m * DM : a.in[I_CTX] + (size_t)(m - MX) * DM;
              norm_mod_row_f8_lds<false>(src, (const LAS float*)lds, (const LAS float*)(lds + 16384), a.ws + WS_A1 + (size_t)m * DM, (float*)(a.ws + WS_SA) + m, lane, QMAX); } }
      return; }
#endif
    for (int m = GW; m < MT; m += NGW) {
        const float* src = m < MX ? a.in[I_X] + (size_t)m * DM : a.in[I_CTX] + (size_t)(m - MX) * DM;
        const int v = m < MX ? m / SEQ : 4;
#if MK_F8 && (MK_QG & 1)
        norm_mod_row_f8(src, a.in[I_N1G], mod + (size_t)v * NMOD, mod + (size_t)v * NMOD + DM, a.ws + WS_A1 + (size_t)m * DM, (float*)(a.ws + WS_SA) + m, lane);
#else
        norm_mod_row<(MK_SIM_FP8 & 1) != 0>(src, a.in[I_N1G], mod + (size_t)v * NMOD, mod + (size_t)v * NMOD + DM, A1 + (size_t)m * DM, lane);
#endif
    }
}
__device__ __forceinline__ void ph_norm2(const Args& a, LAS unsigned char* lds) {
    const int lane = LANE; const float* mod = (const float*)(a.ws + WS_MOD); bf16* XN2 = (bf16*)(a.ws + WS_XN2);
#if MK_F8 && (MK_QG & 4) && MK_NORM_LDS
    { int vcur = -1;
      for (int m0 = (int)blockIdx.x * 8; m0 < MX; m0 += NGW) { const int m = m0 + WAVE; const int v = m0 / SEQ;
          if (v != vcur) { stage_norm_vectors(a.in[I_N2G], mod + (size_t)v * NMOD + 3 * DM, mod + (size_t)v * NMOD + 4 * DM, lds); vcur = v; }
          if (m < MX) norm_mod_row_f8_lds<HBF>(HBF ? (const float*)((const bf16*)(a.ws + WS_HB) + (size_t)m * DM) : a.out + (size_t)m * DM, (const LAS float*)lds, (const LAS float*)(lds + 16384), a.ws + WS_XN2 + (size_t)m * DM, (float*)(a.ws + WS_SA) + m, lane, QMAX_XN2); }
      return; }
#endif
    for (int m = GW; m < MX; m += NGW) {
        const int v = m / SEQ;
#if MK_F8 && (MK_QG & 4)
        norm_mod_row_f8<HBF>(HBF ? (const float*)((const bf16*)(a.ws + WS_HB) + (size_t)m * DM) : a.out + (size_t)m * DM, a.in[I_N2G], mod + (size_t)v * NMOD + 3 * DM, mod + (size_t)v * NMOD + 4 * DM, a.ws + WS_XN2 + (size_t)m * DM, (float*)(a.ws + WS_SA) + m, lane, QMAX_XN2);
#else
        norm_mod_row<(MK_SIM_FP8 & 4) != 0>(a.out + (size_t)m * DM, a.in[I_N2G], mod + (size_t)v * NMOD + 3 * DM, mod + (size_t)v * NMOD + 4 * DM, XN2 + (size_t)m * DM, lane);
#endif
    }
}
__device__ __forceinline__ void ph_tabconv(const Args& a, int row0, int row1, int wv, int nwv) {
    const int lane = LANE;
    unsigned char* U8 = a.ws + WS_U8; unsigned char* V8 = a.ws + WS_V8; float* USC = (float*)(a.ws + WS_USC); float* VSC = (float*)(a.ws + WS_VSC);
    for (int row = row0 + wv; row < row1; row += nwv) {
        const int tb = row >> 14, r = row & 16383;
        const float* src = (tb ? a.in[I_PV] : a.in[I_PU]) + (size_t)r * DM;
        float4 v[16]; float am = 0.f;
#pragma unroll
        for (int j = 0; j < 16; ++j) { v[j] = *(const float4*)(src + (lane + 64 * j) * 4); am = fmaxf(fmaxf(am, fmaxf(fabsf(v[j].x), fabsf(v[j].y))), fmaxf(fabsf(v[j].z), fabsf(v[j].w))); }
        am = wave_max(am);
        if (MK_PEER_FP4 == 3) {
            const float scale = am > 0.f ? am * (1.f / 127.f) : 1.f, inv = 1.f / scale;
            unsigned char* d8 = (tb ? V8 : U8) + (size_t)r * 4096 + lane * 16;
#pragma unroll
            for (int p = 0; p < 4; ++p) { unsigned w4[4];
#pragma unroll
                for (int d = 0; d < 4; ++d) { const float4 q = v[4 * p + d]; w4[d] = pk4_i8(q.x * inv, q.y * inv, q.z * inv, q.w * inv); }
                *(uint4*)(d8 + 1024 * p) = make_uint4(w4[0], w4[1], w4[2], w4[3]); }
            if (lane == 0) (tb ? VSC : USC)[r] = scale;
            continue;
        }
        if (MK_PEER_FP4 == 6) {
            unsigned char* tabp = (tb ? V8 : U8) + (size_t)r * 2176; float bmx[2];
#pragma unroll
            for (int p = 0; p < 2; ++p) { float bm = 0.f;
#pragma unroll
                for (int j = 0; j < 8; ++j) { const float4 q = v[8 * p + j]; bm = fmaxf(fmaxf(bm, fmaxf(fabsf(q.x), fabsf(q.y))), fmaxf(fabsf(q.z), fabsf(q.w))); }
                bmx[p] = bm; }
            const float rs = am * (1.f / 7.f), rinv = rs > 0.f ? 1.f / rs : 0.f;
            unsigned codes = 0u;
#pragma unroll
            for (int p = 0; p < 2; ++p) {
                const float ratio = bmx[p] * (1.f / 7.f) * rinv;
                int code = __builtin_amdgcn_cvt_pk_fp8_f32(ratio, ratio, 0, false) & 0xff; float dec = __builtin_amdgcn_cvt_f32_fp8(code, 0);
                if (dec < ratio) { code += 1; dec = __builtin_amdgcn_cvt_f32_fp8(code, 0); }
                codes |= (unsigned)code << (8 * p);
                const float bsc = dec * rs, binv = bsc > 0.f ? 1.f / bsc : 0.f;
                unsigned w4[4];
#pragma unroll
                for (int d = 0; d < 4; ++d) { const float4 qa = v[8 * p + 2 * d], qb = v[8 * p + 2 * d + 1]; const float M = 12582912.f + (tb ? 8.f : 0.f);
                    w4[d] = (__float_as_uint(qa.x * binv + M) & 15u) | ((__float_as_uint(qa.y * binv + M) & 15u) << 4) | ((__float_as_uint(qa.z * binv + M) & 15u) << 8) | ((__float_as_uint(qa.w * binv + M) & 15u) << 12)
                          | ((__float_as_uint(qb.x * binv + M) & 15u) << 16) | ((__float_as_uint(qb.y * binv + M) & 15u) << 20) | ((__float_as_uint(qb.z * binv + M) & 15u) << 24) | (__float_as_uint(qb.w * binv + M) << 28); }
                *(uint4*)(tabp + 1024 * p + lane * 16) = make_uint4(w4[0], w4[1], w4[2], w4[3]);
            }
            *(unsigned short*)(tabp + 2048 + lane * 2) = (unsigned short)codes;
            if (lane == 0) (tb ? VSC : USC)[r] = rs;
            continue;
        }
        if (MK_PEER_FP4 == 5 && tb == 1) {
            unsigned char* d4 = V8 + (size_t)r * 2304 + lane * 16; unsigned scw = 0u; float smax = 0.f;
#pragma unroll
            for (int p = 0; p < 2; ++p) {
                float bm = 0.f;
#pragma unroll
                for (int j = 0; j < 8; ++j) { const float4 q = v[8 * p + j]; bm = fmaxf(fmaxf(bm, fmaxf(fabsf(q.x), fabsf(q.y))), fmaxf(fabsf(q.z), fabsf(q.w))); }
                const unsigned sb = bm > 0.f ? f2bf(bm * (1.f / 7.f)) : 0x3f80u; const float bsc = __uint_as_float(sb << 16), binv = 1.f / bsc;
                scw |= sb << (16 * p); smax = fmaxf(smax, bsc);
                unsigned w4[4];
#pragma unroll
                for (int d = 0; d < 4; ++d) { const float4 qa = v[8 * p + 2 * d], qb = v[8 * p + 2 * d + 1]; const float M = 12582912.f + 8.f;
                    w4[d] = (__float_as_uint(qa.x * binv + M) & 15u) | ((__float_as_uint(qa.y * binv + M) & 15u) << 4) | ((__float_as_uint(qa.z * binv + M) & 15u) << 8) | ((__float_as_uint(qa.w * binv + M) & 15u) << 12)
                          | ((__float_as_uint(qb.x * binv + M) & 15u) << 16) | ((__float_as_uint(qb.y * binv + M) & 15u) << 20) | ((__float_as_uint(qb.z * binv + M) & 15u) << 24) | (__float_as_uint(qb.w * binv + M) << 28); }
                *(uint4*)(d4 + 1024 * p) = make_uint4(w4[0], w4[1], w4[2], w4[3]);
            }
            *(unsigned*)(V8 + (size_t)r * 2304 + 2048 + lane * 4) = scw;
            smax = wave_max(smax);
            if (lane == 0) VSC[r] = smax;
            continue;
        }
        if ((MK_PEER_FP4 == 4 || MK_PEER_FP4 == 5) && tb == 0) {
            unsigned char* d4 = U8 + (size_t)r * 2304 + lane * 16; unsigned scw = 0u;
#pragma unroll
            for (int p = 0; p < 2; ++p) {
                float bm = 0.f;
#pragma unroll
                for (int j = 0; j < 8; ++j) { const float4 q = v[8 * p + j]; bm = fmaxf(fmaxf(bm, fmaxf(fabsf(q.x), fabsf(q.y))), fmaxf(fabsf(q.z), fabsf(q.w))); }
                const unsigned sb = bm > 0.f ? f2bf(bm * (1.f / 7.f)) : 0x3f80u; const float binv = 1.f / __uint_as_float(sb << 16);
                scw |= sb << (16 * p);
                unsigned w4[4];
#pragma unroll
                for (int d = 0; d < 4; ++d) { const float4 qa = v[8 * p + 2 * d], qb = v[8 * p + 2 * d + 1]; const float M = 12582912.f;
                    w4[d] = (__float_as_uint(qa.x * binv + M) & 15u) | ((__float_as_uint(qa.y * binv + M) & 15u) << 4) | ((__float_as_uint(qa.z * binv + M) & 15u) << 8) | ((__float_as_uint(qa.w * binv + M) & 15u) << 12)
                          | ((__float_as_uint(qb.x * binv + M) & 15u) << 16) | ((__float_as_uint(qb.y * binv + M) & 15u) << 20) | ((__float_as_uint(qb.z * binv + M) & 15u) << 24) | (__float_as_uint(qb.w * binv + M) << 28); }
                *(uint4*)(d4 + 1024 * p) = make_uint4(w4[0], w4[1], w4[2], w4[3]);
            }
            *(unsigned*)(U8 + (size_t)r * 2304 + 2048 + lane * 4) = scw;
            if (lane == 0) USC[r] = 1.f;
            continue;
        }
        if ((tb ? (MK_PEER_FP4 == 1 || MK_PEER_FP4 == 2) : MK_PEER_FP4 == 2)) {
            unsigned char* d4 = (tb ? V8 : U8) + (size_t)r * 2304 + lane * 16; unsigned scw = 0u;
#pragma unroll
            for (int p = 0; p < 2; ++p) {
                float bm = 0.f;
#pragma unroll
                for (int j = 0; j < 8; ++j) { const float4 q = v[8 * p + j]; bm = fmaxf(fmaxf(bm, fmaxf(fabsf(q.x), fabsf(q.y))), fmaxf(fabsf(q.z), fabsf(q.w))); }
                const unsigned sb = bm > 0.f ? f2bf(bm * (1.f / 6.f)) : 0x3f80u; const float binv = 1.f / __uint_as_float(sb << 16);
                scw |= sb << (16 * p);
                unsigned w4[4] = {0u, 0u, 0u, 0u};
#pragma unroll
                for (int d = 0; d < 4; ++d) { const float4 qa4 = v[8 * p + 2 * d], qb4 = v[8 * p + 2 * d + 1];
                    unsigned wv = 0u;
                    wv = __builtin_amdgcn_cvt_scalef32_pk_fp4_f32(wv, qa4.x * binv, qa4.y * binv, 1.0f, 0); wv = __builtin_amdgcn_cvt_scalef32_pk_fp4_f32(wv, qa4.z * binv, qa4.w * binv, 1.0f, 1);
                    wv = __builtin_amdgcn_cvt_scalef32_pk_fp4_f32(wv, qb4.x * binv, qb4.y * binv, 1.0f, 2); wv = __builtin_amdgcn_cvt_scalef32_pk_fp4_f32(wv, qb4.z * binv, qb4.w * binv, 1.0f, 3);
                    w4[d] = wv; }
                *(uint4*)(d4 + 1024 * p) = make_uint4(w4[0], w4[1], w4[2], w4[3]);
            }
            *(unsigned*)((tb ? V8 : U8) + (size_t)r * 2304 + 2048 + lane * 4) = scw;
            if (lane == 0) (tb ? VSC : USC)[r] = 1.f;
            continue;
        }
        const float scale = am > 0.f ? am * (1.f / 7.5f) : 1.f, inv = 1.f / scale;
        unsigned char* dst = (tb ? V8 : U8) + (size_t)r * 3072 + lane * 16;
        unsigned long long pk[6];
#pragma unroll
        for (int p = 0; p < 2; ++p) {
            unsigned long long w0 = 0ull, w1 = 0ull, w2 = 0ull;
#pragma unroll
            for (int k = 0; k < 32; ++k) {
                const float4 q = v[8 * p + (k >> 2)]; const float x = ((k & 3) == 0 ? q.x : (k & 3) == 1 ? q.y : (k & 3) == 2 ? q.z : q.w) * inv; const float ax = fabsf(x);
                float cf = ax < 2.f ? rintf(ax * 8.f) : (ax < 4.f ? rintf(ax * 4.f) + 8.f : rintf(ax * 2.f) + 16.f);
                cf = fminf(cf, 31.f);
                const unsigned long long code = (unsigned long long)((unsigned)cf | (x < 0.f ? 32u : 0u));
                const int pos = 6 * k, wd = pos >> 6, off = pos & 63;
                if (wd == 0) w0 |= code << off; else if (wd == 1) w1 |= code << off; else w2 |= code << off;
                if (off > 58) { if (wd == 0) w1 |= code >> (64 - off); else w2 |= code >> (64 - off); }
            }
            pk[3 * p] = w0; pk[3 * p + 1] = w1; pk[3 * p + 2] = w2;
        }
#pragma unroll
        for (int k = 0; k < 3; ++k) *(uint4*)(dst + 1024 * k) = make_uint4((unsigned)pk[2 * k], (unsigned)(pk[2 * k] >> 32), (unsigned)pk[2 * k + 1], (unsigned)(pk[2 * k + 1] >> 32));
        if (lane == 0) (tb ? VSC : USC)[r] = scale;
    }
}

__device__ __forceinline__ void ldf8s(const LAS float* p, float (&f)[8]) { const f32x4 a = *(const LAS f32x4*)p, b = *(const LAS f32x4*)(p + 4); f[0] = a[0]; f[1] = a[1]; f[2] = a[2]; f[3] = a[3]; f[4] = b[0]; f[5] = b[1]; f[6] = b[2]; f[7] = b[3]; }
constexpr int PL_MU = 0, PL_KK = 27136, PL_CW = 35328, PL_CB = 84480, PL_END = 100864;
__device__ __forceinline__ void ph_prep_stage(const Args& a, LAS unsigned char* lds) {
    const int tid = TID;
    for (int i = tid; i < RCOLS; i += 512) ((LAS float*)(lds + PL_MU))[i] = a.in[I_MU][i];
    for (int i = tid; i < RW; i += 512) ((LAS float*)(lds + PL_KK))[i] = a.in[I_KK][i];
    for (int i = tid; i < 3 * 4096; i += 512) ((LAS float*)(lds + PL_CW))[i] = a.in[I_CONVW][i];
    for (int i = tid; i < 4096; i += 512) ((LAS float*)(lds + PL_CB))[i] = a.in[I_CONVB][i];
    __syncthreads();
}
__device__ __forceinline__ void ph_prep_rwkv(const Args& a, LAS unsigned char* lds) {
    const int lane = LANE;
    const bf16* P = (const bf16*)(a.ws + WS_P);
    bf16* R = (bf16*)(a.ws + WS_R); bf16* K = (bf16*)(a.ws + WS_K); bf16* V = (bf16*)(a.ws + WS_V); bf16* KK = (bf16*)(a.ws + WS_KK); bf16* ALR = (bf16*)(a.ws + WS_ALR);
    const LAS float* mu = (const LAS float*)(lds + PL_MU); const LAS float* k_k = (const LAS float*)(lds + PL_KK);
    for (int m = GW; m < MT; m += NGW) {
        const bool lat = m < MX;
        bool h0, h1, h2 = false, h3 = false; size_t r0, r1, r2 = (size_t)m, r3 = (size_t)m;
        if (lat) { const int t = m & (SEQ - 1), row = t >> 6, col = t & 63; h0 = col > 0; h1 = col < 63; h2 = row > 0; h3 = row < 63; r0 = (size_t)(m - 1); r1 = (size_t)(m + 1); r2 = (size_t)(m - 64); r3 = (size_t)(m + 64); }
        else { const int t = (m - MX) & (CTXL - 1); h0 = t > 0; h1 = t < CTXL - 1; r0 = (size_t)(m - 1); r1 = (size_t)(m + 1); }
        if (!h0) r0 = (size_t)m; if (!h1) r1 = (size_t)m; if (!h2) r2 = (size_t)m; if (!h3) r3 = (size_t)m;
        const bf16* prow = P + (size_t)m * NINP; const bf16* p0 = P + r0 * NINP; const bf16* p1 = P + r1 * NINP; const bf16* p2 = P + r2 * NINP; const bf16* p3 = P + r3 * NINP;
        const float f0 = h0 ? 1.f : 0.f, f1 = h1 ? 1.f : 0.f, f2 = h2 ? 1.f : 0.f, f3 = h3 ? 1.f : 0.f;
        uint4 qo[2][2], q0[2][2], q1[2][2], q2[2][2], q3[2][2];
#define PREP_LOAD(buf, i2v) do { _Pragma("unroll") for (int ii = 0; ii < 2; ++ii) { const int chunk_ = lane + 64 * ((i2v) + ii); const int c0_ = (chunk_ < RCOLS / 8 ? chunk_ : 0) * 8; \
            qo[buf][ii] = ld16(prow + c0_); q0[buf][ii] = ld16(p0 + c0_); q1[buf][ii] = ld16(p1 + c0_); \
            if (lat) { q2[buf][ii] = ld16(p2 + c0_); q3[buf][ii] = ld16(p3 + c0_); } else { q2[buf][ii] = qo[buf][ii]; q3[buf][ii] = qo[buf][ii]; } } } while (0)
        PREP_LOAD(0, 0);
#pragma unroll
        for (int i2 = 0; i2 < 14; i2 += 2) {
            const int cb_ = (i2 >> 1) & 1;
            if (i2 + 2 < 14) { if (cb_) PREP_LOAD(0, i2 + 2); else PREP_LOAD(1, i2 + 2); }
            asm volatile("" ::: "memory");
#pragma unroll
            for (int ii = 0; ii < 2; ++ii) { const int i = i2 + ii; const int chunk = lane + 64 * i;
              if (chunk < RCOLS / 8) {
                const int c0 = chunk * 8;
                float own[8], n0[8], n1[8], sh[8], xm[8], muv[8];
                unpack8(qo[cb_][ii], own); unpack8(q0[cb_][ii], n0); unpack8(q1[cb_][ii], n1);
                if (lat) { float n2[8], n3[8]; unpack8(q2[cb_][ii], n2); unpack8(q3[cb_][ii], n3);
#pragma unroll
                    for (int e = 0; e < 8; ++e) sh[e] = (e & 3) == 0 ? n0[e] * f0 : (e & 3) == 1 ? n1[e] * f1 : (e & 3) == 2 ? n2[e] * f2 : n3[e] * f3;
                } else {
#pragma unroll
                    for (int e = 0; e < 8; ++e) sh[e] = (e & 1) == 0 ? n0[e] * f0 : n1[e] * f1;
                }
                ldf8s(mu + c0, muv);
#pragma unroll
                for (int e = 0; e < 8; ++e) xm[e] = own[e] + muv[e] * (sh[e] - own[e]);
                if (i < 4) st16(R + (size_t)m * RW + c0, pack8(xm));
                else if (i < 8) { const int cc = c0 - 2048; st16(K + (size_t)m * RW + cc, pack8(xm));
                    float kv[8], kkv[8]; ldf8s(k_k + cc, kv); float ss = 0.f;
#pragma unroll
                    for (int e = 0; e < 8; ++e) { kkv[e] = xm[e] * kv[e]; ss += kkv[e] * kkv[e]; }
                    ss = sum8(ss);
                    const float inv = rsqrtf(fmaxf(ss, 1e-24f));
#pragma unroll
                    for (int e = 0; e < 8; ++e) kkv[e] *= inv;
                    st16(KK + (size_t)m * RW + cc, pack8(kkv)); }
                else if (i < 12) st16(V + (size_t)m * RW + (c0 - 4096), pack8(xm));
                else { const int j0 = c0 - 6144; float f[8];
#pragma unroll
                    for (int e = 0; e < 8; ++e) f[e] = j0 < 192 ? 1.f - 2.f * __builtin_amdgcn_rcpf(1.f + __expf(2.f * xm[e])) : (j0 < 384 ? xm[e] : __builtin_amdgcn_rcpf(1.f + __expf(-xm[e])));
                    const int col = j0 < 384 ? (j0 / 96) * 128 + (j0 % 96) : j0 + 128;
                    st16(ALR + (size_t)m * KLR + col, pack8(f)); }
              } else if (i == 13 && lane < 32) {
                const int pc = lane - 16; st16(ALR + (size_t)m * KLR + (pc >> 2) * 128 + 96 + (pc & 3) * 8, make_uint4(0u, 0u, 0u, 0u));
              }
            }
        }
    }
}

constexpr bool ZDIRECT = QG1;
__device__ __forceinline__ void ph_prep_ssd(const Args& a, LAS unsigned char* lds) {
    const int lane = LANE;
    const bf16* P = (const bf16*)(a.ws + WS_P);
    bf16* XS = (bf16*)(a.ws + WS_XS); bf16* BC = (bf16*)(a.ws + WS_BC); bf16* Z = (bf16*)(a.ws + WS_Z); float* DT = (float*)(a.ws + WS_DT); float* LA = (float*)(a.ws + WS_LA);
    const LAS float* cw = (const LAS float*)(lds + PL_CW); const LAS float* cb = (const LAS float*)(lds + PL_CB);
    for (int m = GW; m < MT; m += NGW) {
        const bool lat = m < MX; bool hp, hn;
        if (lat) { const int t = m & (SEQ - 1); hp = t > 0; hn = t < SEQ - 1; } else { const int t = (m - MX) & (CTXL - 1); hp = t > 0; hn = t < CTXL - 1; }
        const bf16* prow = P + (size_t)m * NINP; const bf16* pp = hp ? prow - NINP : prow; const bf16* pn = hn ? prow + NINP : prow;
        const float fp = hp ? 1.f : 0.f, fn = hn ? 1.f : 0.f;
        uint4 zq[4];
        if (lat && !ZDIRECT) {
#pragma unroll
            for (int i = 0; i < 4; ++i) zq[i] = ld16(prow + COL_Z + (lane + 64 * i) * 8);
        }
        const unsigned short dtraw = prow[COL_DT + lane];
        uint4 qc[2][2], qp[2][2], qn[2][2];
#define SSDP_LOAD(buf, i2v) do { _Pragma("unroll") for (int ii = 0; ii < 2; ++ii) { const int c0_ = (lane + 64 * ((i2v) + ii)) * 8; qc[buf][ii] = ld16(prow + COL_XBC + c0_); qp[buf][ii] = ld16(pp + COL_XBC + c0_); qn[buf][ii] = ld16(pn + COL_XBC + c0_); } } while (0)
        SSDP_LOAD(0, 0);
#pragma unroll
        for (int i2 = 0; i2 < 8; i2 += 2) {
            const int cb_ = (i2 >> 1) & 1;
            if (i2 + 2 < 8) { if (cb_) SSDP_LOAD(0, i2 + 2); else SSDP_LOAD(1, i2 + 2); }
            asm volatile("" ::: "memory");
#pragma unroll
            for (int ii = 0; ii < 2; ++ii) { const int i = i2 + ii; const int c0 = (lane + 64 * i) * 8;
                float cur[8], pv[8], nx[8], w0[8], w1[8], w2[8], bb[8], y[8];
                unpack8(qc[cb_][ii], cur); unpack8(qp[cb_][ii], pv); unpack8(qn[cb_][ii], nx);
                ldf8s(cw + c0, w0); ldf8s(cw + 4096 + c0, w1); ldf8s(cw + 8192 + c0, w2); ldf8s(cb + c0, bb);
#pragma unroll
                for (int e = 0; e < 8; ++e) { const float t = w0[e] * (pv[e] * fp) + w1[e] * cur[e] + w2[e] * (nx[e] * fn) + bb[e]; y[e] = t * __builtin_amdgcn_rcpf(1.f + __expf(-t)); }
                if (i < 4) st16(XS + (size_t)m * RW + c0, pack8(y)); else st16(BC + (size_t)m * RW + (c0 - 2048), pack8(y)); }
        }
        { const float raw = __uint_as_float((unsigned)dtraw << 16) + a.in[I_DTB][lane];
          const float dtv = raw > 20.f ? raw : log1pf(expf(raw));
          DT[(size_t)m * 64 + lane] = dtv; LA[(size_t)m * 64 + lane] = -dtv * expf(a.in[I_ALOG][lane]); }
        if (lat && !ZDIRECT) {
#pragma unroll
            for (int i = 0; i < 4; ++i) st16(Z + (size_t)m * RW + (lane + 64 * i) * 8, zq[i]);
        }
    }
}

__device__ __forceinline__ int scan_row(int n, int dir, int b) { return n < CTXL ? MX + b * CTXL + (dir ? CTXL - 1 - n : n) : b * SEQ + (dir ? NSTEP - 1 - n : n - CTXL); }

typedef short bf16x8_t __attribute__((ext_vector_type(8)));
typedef float f32x16 __attribute__((ext_vector_type(16)));
constexpr int SLD = 272;
constexpr int L_C = 0, L_B = 34816, L_BT = 69632, L_XT = 104448, L_S = 121856, L_F = 139264;
static_assert(L_F + 4 * 512 <= LDS_CTL, "ssd lds map");
typedef unsigned u32x4_t __attribute__((ext_vector_type(4)));
__device__ __forceinline__ void lds_st16(LAS unsigned char* p, const uint4& v) { *(LAS u32x4_t*)p = (u32x4_t){v.x, v.y, v.z, v.w}; }
__device__ __forceinline__ uint4 lds_ld16(const LAS unsigned char* p) { const u32x4_t t = *(const LAS u32x4_t*)p; return make_uint4(t[0], t[1], t[2], t[3]); }
__device__ __forceinline__ bf16x8_t lfrag(LAS unsigned char* img, int row, int k) { return *(LAS bf16x8_t*)(img + row * SLD + k * 2); }
__device__ __forceinline__ void ph_ssd_chunked(const Args& a, LAS unsigned char* lds) {
    const int tid = TID, lane = LANE, wave = WAVE, r = lane & 31, hh = lane >> 5;
    typedef unsigned u32x2_t __attribute__((ext_vector_type(2)));
    const bf16* XS = (const bf16*)(a.ws + WS_XS); const bf16* BC = (const bf16*)(a.ws + WS_BC); const float* DT = (const float*)(a.ws + WS_DT); const float* LA = (const float*)(a.ws + WS_LA);
    bf16* YS = (bf16*)a.out + (size_t)2 * MX * RW;
    LAS float* laS = (LAS float*)(lds + L_F); LAS float* dtS = laS + 128; LAS float* cumS = laS + 256;
    for (int u = blockIdx.x; u < 256; u += gridDim.x) {
        const int g = u >> 5, h = u & 31, dir = g >> 2, b = g & 3, gi = h >> 2;
        f32x16 st;
#pragma unroll
        for (int q = 0; q < 16; ++q) st[q] = 0.f;
        __syncthreads();
        for (int i = tid; i < 64 * SLD / 4; i += 512) ((LAS unsigned*)(lds + L_S))[i] = 0u;
        uint4 pB[4], pC[4], pX[2]; float pla = 0.f, pdt = 0.f;
        const int bl0 = 4 * (tid >> 4), bpc = tid & 15, xl0 = 2 * (tid >> 3), xpc = tid & 7;
#define SSD_FETCH2(cc) do { const int n0_ = (cc) * 128; const bool lat_ = (cc) >= CTXL / 128; \
            _Pragma("unroll") for (int k_ = 0; k_ < 4; ++k_) { const size_t m_ = (size_t)scan_row(n0_ + bl0 + k_, dir, b); \
                pB[k_] = ld16(BC + m_ * RW + gi * 128 + bpc * 8); if (lat_) pC[k_] = ld16(BC + m_ * RW + 1024 + gi * 128 + bpc * 8); } \
            _Pragma("unroll") for (int k_ = 0; k_ < 2; ++k_) { const size_t m_ = (size_t)scan_row(n0_ + xl0 + k_, dir, b); pX[k_] = ld16(XS + m_ * RW + h * 64 + xpc * 8); } \
            if (tid < 128) { const size_t m_ = (size_t)scan_row(n0_ + tid, dir, b); pla = LA[m_ * 64 + dir * 32 + h]; pdt = DT[m_ * 64 + dir * 32 + h]; } } while (0)
        SSD_FETCH2(0);
        for (int c = 0; c < NSTEP / 128; ++c) {
            const int n0 = c * 128; const bool lat = c >= CTXL / 128;
#pragma unroll
            for (int k = 0; k < 4; ++k) { lds_st16(lds + L_B + (bl0 + k) * SLD + bpc * 16, pB[k]); if (lat) lds_st16(lds + L_C + (bl0 + k) * SLD + bpc * 16, pC[k]); }
            { const unsigned w0[4] = {pX[0].x, pX[0].y, pX[0].z, pX[0].w}, w1[4] = {pX[1].x, pX[1].y, pX[1].z, pX[1].w};
#pragma unroll
              for (int e = 0; e < 8; ++e) { const unsigned lo = (e & 1) ? (w0[e >> 1] >> 16) : (w0[e >> 1] & 0xffffu), hi = (e & 1) ? (w1[e >> 1] & 0xffff0000u) : (w1[e >> 1] << 16);
                  *(LAS unsigned*)(lds + L_XT + (xpc * 8 + e) * SLD + xl0 * 2) = lo | hi; } }
            if (tid < 128) { laS[tid] = pla; dtS[tid] = pdt; }
            lds_barrier();
            if (wave == 0) { const float a0 = laS[2 * lane], b0 = laS[2 * lane + 1]; float x = a0 + b0;
#pragma unroll
                for (int d = 1; d < 64; d <<= 1) { const float y = __shfl_up(x, d); if (lane >= d) x += y; }
                cumS[2 * lane + 1] = x; cumS[2 * lane] = x - b0; }
            lds_barrier();
            const float ctot = cumS[127];
            { float wl[4]; float fb[4][8];
#pragma unroll
              for (int k = 0; k < 4; ++k) { wl[k] = dtS[bl0 + k] * __expf(ctot - cumS[bl0 + k]); unpack8(pB[k], fb[k]); }
#pragma unroll
              for (int e = 0; e < 8; ++e) *(LAS u32x2_t*)(lds + L_BT + (bpc * 8 + e) * SLD + bl0 * 2) = (u32x2_t){pk2(fb[0][e] * wl[0], fb[1][e] * wl[1]), pk2(fb[2][e] * wl[2], fb[3][e] * wl[3])}; }
            if (c + 1 < NSTEP / 128) SSD_FETCH2(c + 1);
            f32x16 acc0, acc1;
            const int lt = wave >> 1, st0 = 2 * (wave & 1);
            if (lat) {
#pragma unroll
                for (int q = 0; q < 16; ++q) { acc0[q] = 0.f; acc1[q] = 0.f; }
                if (st0 <= lt) {
#pragma unroll
                    for (int ks = 0; ks < 8; ++ks) { const bf16x8_t cf = lfrag(lds + L_C, lt * 32 + r, ks * 16 + 8 * hh);
                        acc0 = __builtin_amdgcn_mfma_f32_32x32x16_bf16(lfrag(lds + L_B, st0 * 32 + r, ks * 16 + 8 * hh), cf, acc0, 0, 0, 0);
                        if (st0 + 1 <= lt) acc1 = __builtin_amdgcn_mfma_f32_32x32x16_bf16(lfrag(lds + L_B, (st0 + 1) * 32 + r, ks * 16 + 8 * hh), cf, acc1, 0, 0, 0); }
                }
            }
            lds_barrier();
            if (lat) {
                const int l = lt * 32 + r; const float cl = cumS[l];
#pragma unroll
                for (int t = 0; t < 2; ++t) { const int stt = st0 + t;
                    if (stt <= lt) {
#pragma unroll
                        for (int gq = 0; gq < 4; ++gq) { const int s0 = stt * 32 + 8 * gq + 4 * hh; const f32x4 cs = *(const LAS f32x4*)(cumS + s0), ds = *(const LAS f32x4*)(dtS + s0); float o[4];
#pragma unroll
                            for (int e = 0; e < 4; ++e) { const float v = t ? acc1[4 * gq + e] : acc0[4 * gq + e]; o[e] = (s0 + e) <= l ? v * __expf(cl - cs[e]) * ds[e] : 0.f; }
                            *(LAS u32x2_t*)(lds + L_B + l * SLD + s0 * 2) = (u32x2_t){pk2(o[0], o[1]), pk2(o[2], o[3])}; } } }
            }
            lds_barrier();
            if (lat) {
                const int pt = wave & 1;
                f32x16 accd, acco;
#pragma unroll
                for (int q = 0; q < 16; ++q) { accd[q] = 0.f; acco[q] = 0.f; }
                for (int ks = 0; ks < 2 * (lt + 1); ++ks)
                    accd = __builtin_amdgcn_mfma_f32_32x32x16_bf16(lfrag(lds + L_XT, pt * 32 + r, ks * 16 + 8 * hh), lfrag(lds + L_B, lt * 32 + r, ks * 16 + 8 * hh), accd, 0, 0, 0);
#pragma unroll
                for (int ks = 0; ks < 8; ++ks)
                    acco = __builtin_amdgcn_mfma_f32_32x32x16_bf16(lfrag(lds + L_S, pt * 32 + r, ks * 16 + 8 * hh), lfrag(lds + L_C, lt * 32 + r, ks * 16 + 8 * hh), acco, 0, 0, 0);
                const int l = lt * 32 + r; const float el = __expf(cumS[l]);
                bf16* yrow = YS + ((size_t)dir * MX + scan_row(n0 + l, dir, b)) * RW + h * 64 + pt * 32;
#pragma unroll
                for (int gq = 0; gq < 4; ++gq) { float y[4];
#pragma unroll
                    for (int e = 0; e < 4; ++e) y[e] = accd[4 * gq + e] + el * acco[4 * gq + e];
                    *(uint2*)(yrow + 8 * gq + 4 * hh) = make_uint2(pk2(y[0], y[1]), pk2(y[2], y[3])); }
            }
            const int nt = wave >> 1, pt2 = wave & 1;
            { const float dc = __expf(ctot);
#pragma unroll
              for (int q = 0; q < 16; ++q) st[q] *= dc;
#pragma unroll
              for (int ks = 0; ks < 8; ++ks)
                  st = __builtin_amdgcn_mfma_f32_32x32x16_bf16(lfrag(lds + L_BT, nt * 32 + r, ks * 16 + 8 * hh), lfrag(lds + L_XT, pt2 * 32 + r, ks * 16 + 8 * hh), st, 0, 0, 0); }
            lds_barrier();
#pragma unroll
            for (int gq = 0; gq < 4; ++gq) *(LAS u32x2_t*)(lds + L_S + (pt2 * 32 + r) * SLD + (nt * 32 + 8 * gq + 4 * hh) * 2) = (u32x2_t){pk2(st[4 * gq], st[4 * gq + 1]), pk2(st[4 * gq + 2], st[4 * gq + 3])};
            lds_barrier();
        }
    }
}

typedef float f32x2_t __attribute__((ext_vector_type(2)));
constexpr int CR_T = 32, CR_PJ = 144, CR_PS = 80, CR_PF = 272;
constexpr int CR_AR = 0, CR_BK = CR_AR + 64 * CR_PJ, CR_BHT = CR_BK + 64 * CR_PJ, CR_KHT = CR_BHT + 64 * CR_PS, CR_VT = CR_KHT + 64 * CR_PS, CR_SB = CR_VT + 64 * CR_PS,
              CR_NAK = CR_SB + 2 * 64 * CR_PJ, CR_PBR = CR_NAK + 32 * CR_PS, CR_PKR = CR_PBR + 32 * CR_PS, CR_NABF = CR_PKR + 32 * CR_PS, CR_RT = CR_NABF + 32 * CR_PJ,
              CR_SA = CR_RT + 32 * CR_PF, CR_GT = CR_SA + 64 * CR_PS, CR_CP = CR_GT + 256, CR_OB = CR_CP + 16 * 256, CR_END = CR_OB + 32 * 128;
static_assert(CR_END <= 131072, "chunked rwkv lds map");
__device__ __forceinline__ f32x16 mfma32(const bf16x8_t& a, const bf16x8_t& b, const f32x16& c) { return __builtin_amdgcn_mfma_f32_32x32x16_bf16(a, b, c, 0, 0, 0); }
__device__ __forceinline__ bf16x8_t cfrag(const LAS unsigned char* img, int pitch, int row, int k) { return *(const LAS bf16x8_t*)(img + row * pitch + k * 2); }
constexpr int P_IMG = 34048, P_GR = 12288, P_SET = P_IMG + P_GR;
constexpr int PO_AR = 0, PO_BK = 9216, PO_BHT = 18432, PO_KHT = 23552, PO_VT = 28672, PO_GT = 33792, PO_NAK = P_IMG, PO_PBR = P_IMG + 2560, PO_PKR = P_IMG + 5120, PO_NABF = P_IMG + 7680;
constexpr int PQ_SB = 2 * P_SET, PQ_RT = PQ_SB + 2 * 64 * CR_PJ, PQ_SA = PQ_RT + 32 * CR_PF, PQ_OB = PQ_SA + 64 * CR_PS, PQ_END = PQ_OB + 32 * 128;
static_assert(PQ_END <= LDS_CTL && (P_SET % 16) == 0, "pipelined rwkv lds map");
struct CRaw4 { unsigned r[4], k[4], kk[4], w[4], al[4], v[4]; };
__device__ __forceinline__ void cr_load4(CRaw4& x, const bf16* R, const bf16* K, const bf16* V, const bf16* KK, const bf16* LR, int n0, int dir, int b, int chn) {
#pragma unroll
    for (int u = 0; u < 4; ++u) { const size_t m = (size_t)scan_row(n0 + u, dir, b);
        x.r[u] = *(const unsigned*)(R + m * RW + chn); x.k[u] = *(const unsigned*)(K + m * RW + chn); x.kk[u] = *(const unsigned*)(KK + m * RW + chn); x.v[u] = *(const unsigned*)(V + m * RW + chn);
        x.w[u] = *(const unsigned*)(LR + m * NLR + dir * 2048 + chn); x.al[u] = *(const unsigned*)(LR + m * NLR + 4096 + dir * 2048 + chn); }
}
__device__ __forceinline__ void cr_stage4(const CRaw4& raw, LAS unsigned char* img, int chl, int sg, int lane, float ka0, float ka1) {
    typedef unsigned u32x2_t __attribute__((ext_vector_type(2)));
    float rv[4][2], kd[4][2], bv[4][2], av[4][2], vv[4][2], cl[4][2], cx[4][2];
    float run0 = 1.f, run1 = 1.f;
#pragma unroll
    for (int u = 0; u < 4; ++u) {
        const float kk0 = bflo(raw.kk[u]), kk1 = bfhi(raw.kk[u]), al0 = bflo(raw.al[u]), al1 = bfhi(raw.al[u]);
        rv[u][0] = bflo(raw.r[u]); rv[u][1] = bfhi(raw.r[u]); vv[u][0] = bflo(raw.v[u]); vv[u][1] = bfhi(raw.v[u]);
        av[u][0] = -kk0; av[u][1] = -kk1; bv[u][0] = kk0 * al0; bv[u][1] = kk1 * al1;
        kd[u][0] = bflo(raw.k[u]) * (1.f + (al0 - 1.f) * ka0); kd[u][1] = bfhi(raw.k[u]) * (1.f + (al1 - 1.f) * ka1);
        cx[u][0] = run0; cx[u][1] = run1; run0 *= 1.f - bflo(raw.w[u]); run1 *= 1.f - bfhi(raw.w[u]); cl[u][0] = run0; cl[u][1] = run1; }
    float inc0 = run0, inc1 = run1;
#pragma unroll
    for (int d = 8; d < 64; d <<= 1) { const float y0 = __shfl_up(inc0, d), y1 = __shfl_up(inc1, d); if (lane >= d) { inc0 *= y0; inc1 *= y1; } }
    float pre0 = __shfl_up(inc0, 8), pre1 = __shfl_up(inc1, 8); if (lane < 8) { pre0 = 1.f; pre1 = 1.f; }
    const float tot0 = __shfl(inc0, 56 + (lane & 7)), tot1 = __shfl(inc1, 56 + (lane & 7));
    if (sg == 0) *(LAS f32x2_t*)(img + PO_GT + chl * 4) = (f32x2_t){tot0, tot1};
    float tb[4][2], tk[4][2];
#pragma unroll
    for (int u = 0; u < 4; ++u) { const int t = 4 * sg + u;
        const float g0 = pre0 * cl[u][0], g1 = pre1 * cl[u][1], gp0 = pre0 * cx[u][0], gp1 = pre1 * cx[u][1];
        const float i0 = __builtin_amdgcn_rcpf(g0), i1 = __builtin_amdgcn_rcpf(g1);
        *(LAS unsigned*)(img + PO_AR + t * CR_PJ + chl * 2) = pk2(av[u][0] * gp0, av[u][1] * gp1);
        *(LAS unsigned*)(img + PO_AR + (32 + t) * CR_PJ + chl * 2) = pk2(rv[u][0] * g0, rv[u][1] * g1);
        *(LAS unsigned*)(img + PO_BK + t * CR_PJ + chl * 2) = pk2(bv[u][0] * i0, bv[u][1] * i1);
        *(LAS unsigned*)(img + PO_BK + (32 + t) * CR_PJ + chl * 2) = pk2(kd[u][0] * i0, kd[u][1] * i1);
        tb[u][0] = bv[u][0] * (tot0 * i0); tb[u][1] = bv[u][1] * (tot1 * i1); tk[u][0] = kd[u][0] * (tot0 * i0); tk[u][1] = kd[u][1] * (tot1 * i1); }
#pragma unroll
    for (int ch = 0; ch < 2; ++ch) {
        *(LAS u32x2_t*)(img + PO_BHT + (chl + ch) * CR_PS + sg * 8) = (u32x2_t){pk2(tb[0][ch], tb[1][ch]), pk2(tb[2][ch], tb[3][ch])};
        *(LAS u32x2_t*)(img + PO_KHT + (chl + ch) * CR_PS + sg * 8) = (u32x2_t){pk2(tk[0][ch], tk[1][ch]), pk2(tk[2][ch], tk[3][ch])};
        *(LAS u32x2_t*)(img + PO_VT + (chl + ch) * CR_PS + sg * 8) = (u32x2_t){pk2(vv[0][ch], vv[1][ch]), pk2(vv[2][ch], vv[3][ch])}; }
}
__device__ __forceinline__ void cr_gram(LAS unsigned char* set, int gtile, int r, int hh) {
    typedef unsigned u32x2_t __attribute__((ext_vector_type(2)));
    f32x16 acc;
#pragma unroll
    for (int q = 0; q < 16; ++q) acc[q] = 0.f;
    const int rb = gtile >> 1, cb = gtile & 1;
#pragma unroll
    for (int ks = 0; ks < 4; ++ks) acc = mfma32(cfrag(set + PO_BK, CR_PJ, 32 * rb + r, 16 * ks + 8 * hh), cfrag(set + PO_AR, CR_PJ, 32 * cb + r, 16 * ks + 8 * hh), acc);
#pragma unroll
    for (int gq = 0; gq < 4; ++gq) { float o[4];
#pragma unroll
        for (int e = 0; e < 4; ++e) { const int sidx = 8 * gq + 4 * hh + e; const bool keep = cb ? (sidx <= r) : (sidx < r); o[e] = keep ? acc[4 * gq + e] : 0.f; }
        if (gtile == 0) {
#pragma unroll
            for (int e = 0; e < 4; ++e) *(LAS float*)(set + PO_NABF + r * CR_PJ + (e * 8 + 2 * gq + hh) * 4) = o[e]; }
        else { LAS unsigned char* dst = set + (gtile == 1 ? PO_PBR : gtile == 2 ? PO_NAK : PO_PKR) + r * CR_PS + (8 * gq + 4 * hh) * 2; *(LAS u32x2_t*)dst = (u32x2_t){pk2(o[0], o[1]), pk2(o[2], o[3])}; } }
}
__device__ __forceinline__ void ph_rwkv_chunked2(const Args& a, LAS unsigned char* lds) {
    const int tid = TID, lane = LANE, wave = WAVE, r = lane & 31, hh = lane >> 5;
    typedef unsigned u32x2_t __attribute__((ext_vector_type(2)));
    const bf16* R = (const bf16*)(a.ws + WS_R); const bf16* K = (const bf16*)(a.ws + WS_K); const bf16* V = (const bf16*)(a.ws + WS_V); const bf16* KK = (const bf16*)(a.ws + WS_KK);
    const bf16* LR = (const bf16*)(a.ws + WS_LR); bf16* OR = (bf16*)a.out;
    constexpr int NCH = NSTEP / CR_T;
    for (int u0 = blockIdx.x; u0 < 256; u0 += gridDim.x) {
        const int g = u0 >> 5, h = u0 & 31, dir = g >> 2, b = g & 3;
        const int sw = wave & 3, cp = lane & 7, sg = lane >> 3, chl = 16 * sw + 2 * cp, chn = h * 64 + chl;
        const float ka0 = a.in[I_KA][chn], ka1 = a.in[I_KA][chn + 1];
        f32x16 st;
#pragma unroll
        for (int q = 0; q < 16; ++q) st[q] = 0.f;
        __syncthreads();
        for (int i = tid; i < 64 * CR_PJ / 4; i += 512) ((LAS unsigned*)(lds + PQ_SB))[i] = 0u;
        CRaw4 raw;
        if (wave >= 4) { cr_load4(raw, R, K, V, KK, LR, 4 * sg, dir, b, chn); cr_stage4(raw, lds, chl, sg, lane, ka0, ka1); cr_load4(raw, R, K, V, KK, LR, CR_T + 4 * sg, dir, b, chn); }
        lds_barrier();
        if (wave >= 4) cr_gram(lds, wave - 4, r, hh);
        lds_barrier();
        for (int c = 0; c < NCH; ++c) {
            const bool lat = c >= CTXL / CR_T;
            LAS unsigned char* setc = lds + (c & 1) * P_SET; LAS unsigned char* setn = lds + ((c + 1) & 1) * P_SET;
            const LAS unsigned char* SBc = lds + PQ_SB + (c & 1) * 64 * CR_PJ; LAS unsigned char* SBn = lds + PQ_SB + ((c + 1) & 1) * 64 * CR_PJ;
            f32x16 acc;
#pragma unroll
            for (int q = 0; q < 16; ++q) acc[q] = 0.f;
            if (wave >= 4 && (wave < 6 || lat)) {
                const int it = wave & 1, cbr = wave >= 6 ? 32 : 0; const LAS unsigned char* NT = setc + (wave < 6 ? PO_NAK : PO_PKR);
#pragma unroll
                for (int ks = 0; ks < 4; ++ks) acc = mfma32(cfrag(SBc, CR_PJ, 32 * it + r, 16 * ks + 8 * hh), cfrag(setc + PO_AR, CR_PJ, cbr + r, 16 * ks + 8 * hh), acc);
#pragma unroll
                for (int ks = 0; ks < 2; ++ks) acc = mfma32(cfrag(setc + PO_VT, CR_PS, 32 * it + r, 16 * ks + 8 * hh), cfrag(NT, CR_PS, r, 16 * ks + 8 * hh), acc);
                if (wave < 6) {
#pragma unroll
                    for (int gq = 0; gq < 4; ++gq) *(LAS f32x4*)(lds + PQ_RT + r * CR_PF + (32 * it + 8 * gq + 4 * hh) * 4) = (f32x4){acc[4 * gq], acc[4 * gq + 1], acc[4 * gq + 2], acc[4 * gq + 3]};
                }
            }
            lds_barrier();
            if (wave < 4) {
                const int q = lane & 3, irow = 16 * wave + (lane >> 2);
                const LAS unsigned char* nrow = setc + PO_NABF + q * 32; const LAS unsigned char* rcol = lds + PQ_RT + irow * 4;
                float mysa[8];
#pragma unroll
                for (int u = 0; u < 8; ++u) mysa[u] = 0.f;
                f32x4 NA[34], NB[34]; float RH[34];
#pragma unroll
                for (int t = 0; t < 2; ++t) { NA[t] = *(const LAS f32x4*)(nrow + t * CR_PJ); NB[t] = NA[t]; RH[t] = *(const LAS float*)(rcol + t * CR_PF); }
#pragma unroll
                for (int t = 0; t < 32; ++t) {
                    if (t + 2 < 32) { NA[t + 2] = *(const LAS f32x4*)(nrow + (t + 2) * CR_PJ); if (t + 2 > 16) NB[t + 2] = *(const LAS f32x4*)(nrow + (t + 2) * CR_PJ + 16); RH[t + 2] = *(const LAS float*)(rcol + (t + 2) * CR_PF); }
                    asm volatile("" ::: "memory");
                    float p0 = 0.f, p1 = 0.f;
#pragma unroll
                    for (int u = 0; u < 4; ++u) if (u < (t + 3) / 4) { if (u & 1) p1 += mysa[u] * NA[t][u]; else p0 += mysa[u] * NA[t][u]; }
#pragma unroll
                    for (int u = 4; u < 8; ++u) if (u < (t + 3) / 4) { if (u & 1) p1 += mysa[u] * NB[t][u - 4]; else p0 += mysa[u] * NB[t][u - 4]; }
                    float part = p0 + p1;
                    part += dppf<0xB1>(part); part += dppf<0x4E>(part);
                    const float x = RH[t] + part;
                    mysa[t >> 2] = (q == (t & 3)) ? x : mysa[t >> 2];
                    asm volatile("" : "+v"(mysa[t >> 2]));
                }
#pragma unroll
                for (int u = 0; u < 8; ++u) *(LAS bf16*)(lds + PQ_SA + irow * CR_PS + (4 * u + q) * 2) = (bf16)f2bf(mysa[u]);
            } else if (c + 1 < NCH) {
                cr_stage4(raw, setn, chl, sg, lane, ka0, ka1);
                if (c + 2 < NCH) cr_load4(raw, R, K, V, KK, LR, (c + 2) * CR_T + 4 * sg, dir, b, chn);
            }
            lds_barrier();
            if (wave < 4) {
                const int jt = wave >> 1, it = wave & 1;
#pragma unroll
                for (int gq = 0; gq < 4; ++gq) { const f32x4 gv = *(LAS f32x4*)(setc + PO_GT + (32 * jt + 8 * gq + 4 * hh) * 4);
#pragma unroll
                    for (int e = 0; e < 4; ++e) st[4 * gq + e] *= gv[e]; }
#pragma unroll
                for (int ks = 0; ks < 2; ++ks) { st = mfma32(cfrag(setc + PO_BHT, CR_PS, 32 * jt + r, 16 * ks + 8 * hh), cfrag(lds + PQ_SA, CR_PS, 32 * it + r, 16 * ks + 8 * hh), st);
                    st = mfma32(cfrag(setc + PO_KHT, CR_PS, 32 * jt + r, 16 * ks + 8 * hh), cfrag(setc + PO_VT, CR_PS, 32 * it + r, 16 * ks + 8 * hh), st); }
#pragma unroll
                for (int gq = 0; gq < 4; ++gq)
                    *(LAS u32x2_t*)(SBn + (32 * it + r) * CR_PJ + (32 * jt + 8 * gq + 4 * hh) * 2) = (u32x2_t){pk2(st[4 * gq], st[4 * gq + 1]), pk2(st[4 * gq + 2], st[4 * gq + 3])};
            } else {
                if (wave >= 6 && lat) {
                    const int it = wave & 1;
#pragma unroll
                    for (int ks = 0; ks < 2; ++ks) acc = mfma32(cfrag(lds + PQ_SA, CR_PS, 32 * it + r, 16 * ks + 8 * hh), cfrag(setc + PO_PBR, CR_PS, r, 16 * ks + 8 * hh), acc);
#pragma unroll
                    for (int gq = 0; gq < 4; ++gq)
                        *(LAS u32x2_t*)(lds + PQ_OB + r * 128 + (32 * it + 8 * gq + 4 * hh) * 2) = (u32x2_t){pk2(acc[4 * gq], acc[4 * gq + 1]), pk2(acc[4 * gq + 2], acc[4 * gq + 3])};
                }
                if (c + 1 < NCH) cr_gram(setn, wave - 4, r, hh);
            }
            lds_barrier();
            if (lat) { const int ss = tid >> 4, cgp = tid & 15;
                const u32x2_t ov = *(const LAS u32x2_t*)(lds + PQ_OB + ss * 128 + cgp * 8);
                *(uint2*)(OR + ((size_t)dir * MX + scan_row(c * CR_T + ss, dir, b)) * RW + h * 64 + cgp * 4) = make_uint2(ov[0], ov[1]); }
        }
    }
}

constexpr int FL_LNW = 0, FL_LNB = 8192, FL_KA = 16384, FL_RK = 24576, FL_NW = 32768, FL_D = 40960;
__device__ __forceinline__ void ph_finish(const Args& a, LAS unsigned char* lds) {
    const int lane = LANE, tid = TID;
    const bf16* R = (const bf16*)(a.ws + WS_R); const bf16* K = (const bf16*)(a.ws + WS_K); const bf16* V = (const bf16*)(a.ws + WS_V);
    const bf16* LR = (const bf16*)(a.ws + WS_LR); const bf16* XS = (const bf16*)(a.ws + WS_XS); const bf16* Z = (const bf16*)(a.ws + WS_Z);
    const bf16* OR = (const bf16*)a.out; const bf16* YS = (const bf16*)a.out + (size_t)2 * MX * RW;
    bf16* A2 = (bf16*)(a.ws + WS_A2);
    __syncthreads();
    for (int i = tid; i < RW; i += 512) { ((LAS float*)(lds + FL_LNW))[i] = a.in[I_LNW][i]; ((LAS float*)(lds + FL_LNB))[i] = a.in[I_LNB][i]; ((LAS float*)(lds + FL_KA))[i] = a.in[I_KA][i];
        ((LAS float*)(lds + FL_RK))[i] = a.in[I_RK][i]; ((LAS float*)(lds + FL_NW))[i] = a.in[I_NORMW][i]; }
    if (tid < 32) ((LAS float*)(lds + FL_D))[tid] = a.in[I_SSMD][tid];
    __syncthreads();
    for (int m = GW; m < MX; m += NGW) {
        uint4 q[2][8]; uint4 keep[8]; float am = 0.f;
#define FIN_LOAD(buf, it) do { const int c0_ = (lane + 64 * ((it) & 3)) * 8; \
            if ((it) < 4) { q[buf][0] = ld16(OR + (size_t)m * RW + c0_); q[buf][1] = ld16(OR + ((size_t)MX + m) * RW + c0_); q[buf][2] = ld16(R + (size_t)m * RW + c0_); q[buf][3] = ld16(K + (size_t)m * RW + c0_); \
                q[buf][4] = ld16(V + (size_t)m * RW + c0_); q[buf][5] = ld16(LR + (size_t)m * NLR + 4096 + c0_); q[buf][6] = ld16(LR + (size_t)m * NLR + 6144 + c0_); q[buf][7] = ld16(LR + (size_t)m * NLR + 8192 + c0_); } \
            else { q[buf][0] = ld16(YS + (size_t)m * RW + c0_); q[buf][1] = ld16(YS + ((size_t)MX + m) * RW + c0_); q[buf][2] = ld16(XS + (size_t)m * RW + c0_); q[buf][3] = ld16(Z + (size_t)m * RW + c0_); } } while (0)
        FIN_LOAD(0, 0);
#pragma unroll
        for (int it = 0; it < 8; ++it) {
            const int cb = it & 1, c0 = (lane + 64 * (it & 3)) * 8;
            if (it + 1 < 8) { if (cb) FIN_LOAD(0, it + 1); else FIN_LOAD(1, it + 1); }
            asm volatile("" ::: "memory");
            if (it < 4) {
                float of[8], ob[8], o[8], res[8];
#if MK_SKIP_RWKV
#pragma unroll
                for (int e = 0; e < 8; ++e) res[e] = 0.f;
#else
                unpack8(q[cb][0], of); unpack8(q[cb][1], ob);
                float sm = 0.f;
#pragma unroll
                for (int e = 0; e < 8; ++e) { o[e] = of[e] + ob[e]; sm += o[e]; }
                sm = sum8(sm);
                const float mean = sm * (1.f / 64.f); float sq = 0.f;
#pragma unroll
                for (int e = 0; e < 8; ++e) { o[e] -= mean; sq += o[e] * o[e]; }
                sq = sum8(sq);
                const float rstd = rsqrtf(sq * (1.f / 64.f) + GN_EPS);
                float lw[8], lb[8], r[8], k[8], v[8], a0[8], a1[8], ka[8], rk[8], gg[8];
                ldf8s((const LAS float*)(lds + FL_LNW) + c0, lw); ldf8s((const LAS float*)(lds + FL_LNB) + c0, lb); ldf8s((const LAS float*)(lds + FL_KA) + c0, ka); ldf8s((const LAS float*)(lds + FL_RK) + c0, rk);
                unpack8(q[cb][2], r); unpack8(q[cb][3], k); unpack8(q[cb][4], v); unpack8(q[cb][5], a0); unpack8(q[cb][6], a1); unpack8(q[cb][7], gg);
                float bs = 0.f;
#pragma unroll
                for (int e = 0; e < 8; ++e) { const float kd = k[e] * (2.f + (a0[e] + a1[e] - 2.f) * ka[e]); bs += r[e] * kd * rk[e]; }
                bs = sum8(bs);
#pragma unroll
                for (int e = 0; e < 8; ++e) res[e] = (o[e] * rstd * lw[e] + lb[e] + bs * v[e]) * gg[e];
#endif
#pragma unroll
                for (int e = 0; e < 8; ++e) res[e] = simq<(MK_SIM_FP8 & 2) != 0>(res[e]);
                if (QG2) { keep[it] = pack8(res);
#pragma unroll
                    for (int e = 0; e < 8; ++e) am = fmaxf(am, fabsf(res[e])); }
                else st16(A2 + (size_t)m * DM + c0, pack8(res));
            } else {
                float yf[8], yb[8], xs[8], z[8], nw[8], y[8];
#if MK_SKIP_SSD
#pragma unroll
                for (int e = 0; e < 8; ++e) y[e] = 0.f;
#else
                unpack8(q[cb][0], yf); unpack8(q[cb][1], yb); unpack8(q[cb][2], xs); unpack8(q[cb][3], z); ldf8s((const LAS float*)(lds + FL_NW) + c0, nw);
                const float dsk = ((const LAS float*)(lds + FL_D))[c0 >> 6]; float ss = 0.f;
#pragma unroll
                for (int e = 0; e < 8; ++e) { y[e] = (yf[e] + yb[e] + dsk * xs[e]) * (z[e] * __builtin_amdgcn_rcpf(1.f + __expf(-z[e]))); ss += y[e] * y[e]; }
                ss = sum32(ss);
                const float rstd = rsqrtf(ss * (1.f / 256.f) + RMS_EPS);
#pragma unroll
                for (int e = 0; e < 8; ++e) y[e] = y[e] * rstd * nw[e];
#endif
#pragma unroll
                for (int e = 0; e < 8; ++e) y[e] = simq<(MK_SIM_FP8 & 2) != 0>(y[e]);
                if (QG2) { keep[it] = pack8(y);
#pragma unroll
                    for (int e = 0; e < 8; ++e) am = fmaxf(am, fabsf(y[e])); }
                else st16(A2 + (size_t)m * DM + 2048 + c0, pack8(y));
            }
        }
        if (QG2) {
            am = wave_max(am);
            const float scale = am > 0.f ? am * (1.f / QMAX) : 1.f, inv = 1.f / scale; unsigned char* dst = a.ws + WS_A2 + (size_t)m * DM;
#pragma unroll
            for (int it = 0; it < 8; ++it) { float f[8]; unpack8(keep[it], f); uint2 w; w.x = pk4_fp8(f[0] * inv, f[1] * inv, f[2] * inv, f[3] * inv); w.y = pk4_fp8(f[4] * inv, f[5] * inv, f[6] * inv, f[7] * inv);
                *(uint2*)(dst + (it >> 2) * 2048 + (lane + 64 * (it & 3)) * 8) = w; }
            if (lane == 0) ((float*)(a.ws + WS_SA))[m] = scale;
        }
    }
}

__device__ __forceinline__ float enc_key(float v, int idx) { return __uint_as_float((__float_as_uint(v) & 0xffffff00u) | (unsigned)idx); }
typedef float f32x32_t __attribute__((ext_vector_type(32)));
typedef unsigned u32x6_t __attribute__((ext_vector_type(6)));
typedef float f32x2 __attribute__((ext_vector_type(2)));
struct Fp6Row { uint4 q0, q1, q2, q3; float rs; };
template <bool FP4> __device__ __forceinline__ Fp6Row ld_row(const unsigned char* tab, const float* rsc, int e, int l16, int lane) {
    Fp6Row r;
    if (MK_PEER_FP4 == 6) { const unsigned char* p = tab + (size_t)e * 2176; r.q0 = *(const uint4*)(p + l16); r.q1 = *(const uint4*)(p + 1024 + l16); r.q2 = make_uint4(*(const unsigned short*)(p + 2048 + 2 * lane), 0u, 0u, 0u);
        r.rs = rsc ? rsc[e] : 1.f; return r; }
    if (MK_PEER_FP4 == 3) { const unsigned char* p = tab + (size_t)e * 4096 + l16; r.q0 = *(const uint4*)p; r.q1 = *(const uint4*)(p + 1024); r.q2 = *(const uint4*)(p + 2048); r.q3 = *(const uint4*)(p + 3072); r.rs = rsc ? rsc[e] : 1.f; return r; }
    r.rs = FP4 ? 1.f : rsc[e];
    if (FP4) { const unsigned char* p = tab + (size_t)e * 2304; r.q0 = *(const uint4*)(p + l16); r.q1 = *(const uint4*)(p + 1024 + l16); r.q2 = make_uint4(*(const unsigned*)(p + 2048 + 4 * lane), 0u, 0u, 0u); }
    else { const unsigned char* p = tab + (size_t)e * 3072 + l16; r.q0 = *(const uint4*)p; r.q1 = *(const uint4*)(p + 1024); r.q2 = *(const uint4*)(p + 2048); }
    return r;
}
__device__ __forceinline__ f32x32_t fp6_unpack(const Fp6Row& r, int p, float one) {
    u32x6_t s; if (p == 0) { s[0] = r.q0.x; s[1] = r.q0.y; s[2] = r.q0.z; s[3] = r.q0.w; s[4] = r.q1.x; s[5] = r.q1.y; } else { s[0] = r.q1.z; s[1] = r.q1.w; s[2] = r.q2.x; s[3] = r.q2.y; s[4] = r.q2.z; s[5] = r.q2.w; }
    return __builtin_amdgcn_cvt_scalef32_pk32_f32_fp6(s, one);
}
typedef _Float16 h16x32_t __attribute__((ext_vector_type(32)));
typedef _Float16 h16x2_t __attribute__((ext_vector_type(2)));
__device__ __forceinline__ h16x32_t fp6_unpack_h(const Fp6Row& r, int p, float one) {
    u32x6_t s; if (p == 0) { s[0] = r.q0.x; s[1] = r.q0.y; s[2] = r.q0.z; s[3] = r.q0.w; s[4] = r.q1.x; s[5] = r.q1.y; } else { s[0] = r.q1.z; s[1] = r.q1.w; s[2] = r.q2.x; s[3] = r.q2.y; s[4] = r.q2.z; s[5] = r.q2.w; }
    return __builtin_amdgcn_cvt_scalef32_pk32_f16_fp6(s, one);
}
template <bool FP4, int VAR = 0> __device__ __forceinline__ f32x32_t row_unpack(const Fp6Row& r, int p, float one, float& sc) {
    if (!FP4 && VAR == 1) { sc = 1.f; const unsigned w[6] = {p ? r.q1.z : r.q0.x, p ? r.q1.w : r.q0.y, p ? r.q2.x : r.q0.z, p ? r.q2.y : r.q0.w, p ? r.q2.z : r.q1.x, p ? r.q2.w : r.q1.y}; f32x32_t f;
#pragma unroll
        for (int t = 0; t < 32; ++t) f[t] = __uint_as_float((w[t % 6] << (t & 7)) & 0x3fffffffu);
        return f; }
    if (!FP4) { sc = 1.f; return fp6_unpack(r, p, one); }
    const uint4 q = p ? r.q1 : r.q0; const unsigned w[4] = {q.x, q.y, q.z, q.w}; f32x32_t f;
#pragma unroll
    for (int d = 0; d < 4; ++d)
        { const f32x2 t0 = __builtin_amdgcn_cvt_scalef32_pk_f32_fp4(w[d], one, 0), t1 = __builtin_amdgcn_cvt_scalef32_pk_f32_fp4(w[d], one, 1), t2 = __builtin_amdgcn_cvt_scalef32_pk_f32_fp4(w[d], one, 2), t3 = __builtin_amdgcn_cvt_scalef32_pk_f32_fp4(w[d], one, 3);
          f[8 * d] = t0.x; f[8 * d + 1] = t0.y; f[8 * d + 2] = t1.x; f[8 * d + 3] = t1.y; f[8 * d + 4] = t2.x; f[8 * d + 5] = t2.y; f[8 * d + 6] = t3.x; f[8 * d + 7] = t3.y; }
    sc = p ? bfhi(r.q2.x) : bflo(r.q2.x);
    return f;
}
__device__ __forceinline__ void fp4_unpack8(unsigned w, float one, float (&f)[8]) {
    const f32x2 t0 = __builtin_amdgcn_cvt_scalef32_pk_f32_fp4(w, one, 0), t1 = __builtin_amdgcn_cvt_scalef32_pk_f32_fp4(w, one, 1), t2 = __builtin_amdgcn_cvt_scalef32_pk_f32_fp4(w, one, 2), t3 = __builtin_amdgcn_cvt_scalef32_pk_f32_fp4(w, one, 3);
    f[0] = t0.x; f[1] = t0.y; f[2] = t1.x; f[3] = t1.y; f[4] = t2.x; f[5] = t2.y; f[6] = t3.x; f[7] = t3.y;
}
#define PIN4(a) asm volatile("" : "+v"((a)[0]), "+v"((a)[1]), "+v"((a)[2]), "+v"((a)[3]))
#ifndef MK_S16
#define MK_S16 1
#endif
#ifndef MK_PEER_PROBE
#define MK_PEER_PROBE 0
#endif
#ifndef MK_PEER_VAR
#define MK_PEER_VAR 0
#endif
template <int EMASK = 0x3fff, int VAR = 0> __device__ __forceinline__ void ph_peer(const Args& a, float* outp, LAS unsigned char* lds) {
    const int lane = LANE; constexpr bool I8 = MK_PEER_FP4 == 3, U4 = MK_PEER_FP4 == 4 || MK_PEER_FP4 == 5 || MK_PEER_FP4 == 6, V4 = MK_PEER_FP4 == 5 || MK_PEER_FP4 == 6, S8 = MK_PEER_FP4 == 6, UF4 = MK_PEER_FP4 == 2, VF4 = MK_PEER_FP4 == 1 || MK_PEER_FP4 == 2; constexpr int URING = UF4 ? 3 : 2, VRING = VF4 ? 3 : 2;
    const float* mod = (const float*)(a.ws + WS_MOD); const float* S = (const float*)(a.ws + WS_S);
    const unsigned char* U8 = (const unsigned char*)(a.ws + WS_U8); const unsigned char* V8 = (const unsigned char*)(a.ws + WS_V8);
    const float* USC = (const float*)(a.ws + WS_USC); const float* VSC = (const float*)(a.ws + WS_VSC);
    constexpr bool XQ = U4 && QGQ && MK_F8 == 2;
    __syncthreads();
    for (int i = TID; i < 5 * 1024; i += 512) { const int v = i >> 10, c = (i & 1023) * 4; const float* src = v < 4 ? mod + (size_t)v * NMOD + 5 * DM : a.in[I_FG];
        const float4 x4 = *(const float4*)(src + c); *(LAS f32x4*)(lds + (size_t)(v * 4096 + c) * 4) = (f32x4){x4.x, x4.y, x4.z, x4.w}; }
    __syncthreads();
    for (int m = GW; m < MX; m += NGW) {
        const int bb = m / SEQ;
        float* hrow = a.out + (size_t)m * DM; const bf16* hbrow = (const bf16*)(a.ws + WS_HB) + (size_t)m * DM;
        int l4 = lane * 4; asm volatile("" : "+v"(l4));
        float acc[16][4];
#if MK_SKIP_PEER
#pragma unroll
        for (int j = 0; j < 16; ++j)
#pragma unroll
            for (int e = 0; e < 4; ++e) acc[j][e] = 0.f;
#else
        float xn[16][4];
        if constexpr (!XQ) { float ss = 0.f;
#pragma unroll
          for (int j = 0; j < 16; ++j) { float4 h4; if (HBF) { const uint2 hq = *(const uint2*)(hbrow + 256 * j + l4); h4 = make_float4(bflo(hq.x), bfhi(hq.x), bflo(hq.y), bfhi(hq.y)); } else h4 = *(const float4*)(hrow + 256 * j + l4); xn[j][0] = h4.x; xn[j][1] = h4.y; xn[j][2] = h4.z; xn[j][3] = h4.w; ss += (h4.x * h4.x + h4.y * h4.y) + (h4.z * h4.z + h4.w * h4.w); }
          const float rstd = rsqrtf(wave_sum(ss) * (1.f / DM) + RMS_EPS);
          const float* sh2 = mod + (size_t)bb * NMOD + 3 * DM; const float* sc2 = mod + (size_t)bb * NMOD + 4 * DM; const float* g2 = a.in[I_N2G];
#pragma unroll
          for (int j = 0; j < 16; ++j) { const int c = 256 * j + l4; const float4 gg = *(const float4*)(g2 + c), s0 = *(const float4*)(sh2 + c), s1 = *(const float4*)(sc2 + c);
              xn[j][0] = xn[j][0] * rstd * gg.x * (1.f + s1.x) + s0.x; xn[j][1] = xn[j][1] * rstd * gg.y * (1.f + s1.y) + s0.y; xn[j][2] = xn[j][2] * rstd * gg.z * (1.f + s1.z) + s0.z; xn[j][3] = xn[j][3] * rstd * gg.w * (1.f + s1.w) + s0.w;
              if ((j & 3) == 3) { PIN4(xn[j - 3]); PIN4(xn[j - 2]); PIN4(xn[j - 1]); PIN4(xn[j]); asm volatile("" ::: "memory"); } } }
        int eid0 = 0, eid1 = 0; float gt0 = 0.f, gt1 = 0.f;
        const float NEG = -3.0e38f;
        if (VAR == 2) { eid0 = (m * 131 + lane * 977) & 16383; eid1 = (m * 197 + lane * 1531 + 7) & 16383; gt0 = 0.0625f; gt1 = 0.0625f; } else {
        float t1[8], t2[8];
        int lsc = lane; asm volatile("" : "+v"(lsc));
        {
            float cg[4][8], tg[4];
#pragma unroll
            for (int g = 0; g < 4; ++g) { float4 sa, sb;
                if (MK_S16) { const uint4 sq = *(const uint4*)((const unsigned short*)S + (size_t)m * 2048 + 512 * g + 8 * lsc); typedef _Float16 h2_t __attribute__((ext_vector_type(2)));
                    const h2_t h0 = __builtin_bit_cast(h2_t, sq.x), h1 = __builtin_bit_cast(h2_t, sq.y), h2 = __builtin_bit_cast(h2_t, sq.z), h3 = __builtin_bit_cast(h2_t, sq.w);
                    sa = make_float4((float)h0[0], (float)h0[1], (float)h1[0], (float)h1[1]); sb = make_float4((float)h2[0], (float)h2[1], (float)h3[0], (float)h3[1]); }
                else { const float* sr = S + (size_t)m * 2048 + 512 * g + 8 * lsc; sa = *(const float4*)sr; sb = *(const float4*)(sr + 4); }
                const int kb = 8 * (lsc & 15);
                cg[g][0] = enc_key(sa.x, kb); cg[g][1] = enc_key(sa.y, kb + 1); cg[g][2] = enc_key(sa.z, kb + 2); cg[g][3] = enc_key(sa.w, kb + 3);
                cg[g][4] = enc_key(sb.x, kb + 4); cg[g][5] = enc_key(sb.y, kb + 5); cg[g][6] = enc_key(sb.z, kb + 6); cg[g][7] = enc_key(sb.w, kb + 7); tg[g] = NEG; }
#pragma unroll 1
            for (int k = 0; k < 16; ++k) {
#pragma unroll
                for (int g = 0; g < 4; ++g) {
                    float mx = fmaxf(fmaxf(fmaxf(cg[g][0], cg[g][1]), fmaxf(cg[g][2], cg[g][3])), fmaxf(fmaxf(cg[g][4], cg[g][5]), fmaxf(cg[g][6], cg[g][7])));
                    mx = fmaxf(mx, dppf<0xB1>(mx)); mx = fmaxf(mx, dppf<0x4E>(mx)); mx = fmaxf(mx, dppf<0x141>(mx)); mx = fmaxf(mx, dppf<0x140>(mx));
#pragma unroll
                    for (int e = 0; e < 8; ++e) if (cg[g][e] == mx) cg[g][e] = NEG;
                    if ((lane & 15) == k) tg[g] = mx;
                }
            }
            const int rowb = lsc & 48, ll = lsc & 15, srcl = 32 * ((lsc >> 4) & 1) + ll; const bool up = (lsc >> 5) != 0;
            constexpr unsigned long long TA[4] = {0x0ull, 0x3332222211111111ull, 0xdcba987766554443ull, 0xfeull}, TB[4] = {0xfedcba9876543210ull, 0x2104321076543210ull, 0x1010102103ull, 0x0ull};
            constexpr unsigned TV[4] = {0xffffu, 0xffffu, 0xffffu, 0x3u};
            float cd2[2][4], bestg[2]; int I1[2], I2[2];
#pragma unroll
            for (int G = 0; G < 2; ++G) {
                const float a0 = __shfl(tg[2 * G], srcl), a1 = __shfl(tg[2 * G + 1], srcl), b0 = __shfl(tg[2 * G], srcl + 16), b1 = __shfl(tg[2 * G + 1], srcl + 16);
                const float v1r = up ? a1 : a0, v2r = up ? b1 : b0;
                I1[G] = (int)(__float_as_uint(v1r) & 0xffu); I2[G] = (int)(__float_as_uint(v2r) & 0xffu);
                const float v1 = __uint_as_float(__float_as_uint(v1r) & 0xffffff00u), v2 = __uint_as_float(__float_as_uint(v2r) & 0xffffff00u);
#pragma unroll
                for (int sl = 0; sl < 4; ++sl) { const int pa = (int)((TA[sl] >> (4 * ll)) & 15ull), pb = (int)((TB[sl] >> (4 * ll)) & 15ull);
                    const float sm = __shfl(v1, rowb + pa) + __shfl(v2, rowb + pb); cd2[G][sl] = ((TV[sl] >> ll) & 1u) ? enc_key(sm, 16 * pa + pb) : NEG; }
                bestg[G] = NEG;
            }
#pragma unroll 1
            for (int k = 0; k < 16; ++k) {
#pragma unroll
                for (int G = 0; G < 2; ++G) {
                    float mx = fmaxf(fmaxf(cd2[G][0], cd2[G][1]), fmaxf(cd2[G][2], cd2[G][3]));
                    mx = fmaxf(mx, dppf<0xB1>(mx)); mx = fmaxf(mx, dppf<0x4E>(mx)); mx = fmaxf(mx, dppf<0x141>(mx)); mx = fmaxf(mx, dppf<0x140>(mx));
#pragma unroll
                    for (int bq = 0; bq < 4; ++bq) if (cd2[G][bq] == mx) cd2[G][bq] = NEG;
                    if (ll == k) bestg[G] = mx;
                }
            }
#pragma unroll
            for (int G = 0; G < 2; ++G) {
                const int cidx = (int)(__float_as_uint(bestg[G]) & 0xffu);
                const int ea = __shfl(I1[G], rowb + (cidx >> 4)), eb = __shfl(I2[G], rowb + (cidx & 15));
                const float bv = __uint_as_float(__float_as_uint(bestg[G]) & 0xffffff00u);
                float bm = bv; bm = fmaxf(bm, dppf<0xB1>(bm)); bm = fmaxf(bm, dppf<0x4E>(bm)); bm = fmaxf(bm, dppf<0x141>(bm)); bm = fmaxf(bm, dppf<0x140>(bm));
                const float pe = __expf(bv - bm); const float gate = pe / sum16(pe);
                if (G == 0) { gt0 = gate; eid0 = ea * 128 + eb; } else { gt1 = gate; eid1 = ea * 128 + eb; }
            }
        }
        }
        const int l48 = lane * 16; int lsx = lane; asm volatile("" : "+v"(lsx));
#ifndef MK_PEER_SORT
#define MK_PEER_SORT 1
#endif
        if (MK_PEER_SORT && VAR != 2) {
            unsigned k0 = ((unsigned)eid0 << 7) | (unsigned)lsx, k1 = ((unsigned)eid1 << 7) | (unsigned)(64 + lsx);
#pragma unroll
            for (int kk = 2; kk <= 128; kk <<= 1) {
#pragma unroll
                for (int j = kk >> 1; j >= 1; j >>= 1) {
                    if (j == 64) { const unsigned lo = k0 < k1 ? k0 : k1, hi = k0 < k1 ? k1 : k0; k0 = lo; k1 = hi; }
                    else {
                        const unsigned p0 = (unsigned)__shfl_xor((int)k0, j), p1 = (unsigned)__shfl_xor((int)k1, j);
                        const bool lower = (lsx & j) == 0;
                        const bool up0 = kk == 128 ? true : kk == 64 ? true : (lsx & kk) == 0, up1 = kk == 128 ? true : kk == 64 ? false : (lsx & kk) == 0;
                        const unsigned mn0 = k0 < p0 ? k0 : p0, mx0 = k0 < p0 ? p0 : k0, mn1 = k1 < p1 ? k1 : p1, mx1 = k1 < p1 ? p1 : k1;
                        k0 = (up0 == lower) ? mn0 : mx0; k1 = (up1 == lower) ? mn1 : mx1;
                    }
                }
            }
            const int po0 = (int)(k0 & 127u), po1 = (int)(k1 & 127u);
            const float ga0 = __shfl(gt0, po0 & 63), gb0 = __shfl(gt1, po0 & 63), ga1 = __shfl(gt0, po1 & 63), gb1 = __shfl(gt1, po1 & 63);
            gt0 = po0 < 64 ? ga0 : gb0; gt1 = po1 < 64 ? ga1 : gb1; eid0 = (int)(k0 >> 7); eid1 = (int)(k1 >> 7);
        }
        h16x2_t xh[16][2];
        if (VAR == 5) {
#pragma unroll
            for (int j = 0; j < 16; ++j) { xh[j][0] = (h16x2_t){(_Float16)xn[j][0], (_Float16)xn[j][1]}; xh[j][1] = (h16x2_t){(_Float16)xn[j][2], (_Float16)xn[j][3]}; } }
        float cf0 = 0.f, cf1 = 0.f;
        if (VAR == 4) { cf0 = gt0; cf1 = gt1; }
#define PEER_EID(pp) (__builtin_amdgcn_readlane((pp) < 64 ? eid0 : eid1, (pp) & 63) & EMASK)
#define PEER_FETCH(buf, pbase, TAB, F4) do { _Pragma("unroll") for (int q2 = 0; q2 < 4; ++q2) { const int e_ = PEER_EID((pbase) + q2); buf[q2] = ld_row<F4>(TAB, (TAB) == U8 ? USC : VSC, e_, l48, lane); } } while (0)
#define PEER_FETCH8(buf, pbase, TAB, RSC) do { _Pragma("unroll") for (int q2 = 0; q2 < 2; ++q2) { const int e_ = PEER_EID((pbase) + q2); buf[q2] = ld_row<false>(TAB, RSC, e_, l48, lane); } } while (0)
#define PEER_W16(rr) {rr.q0.x, rr.q0.y, rr.q0.z, rr.q0.w, rr.q1.x, rr.q1.y, rr.q1.z, rr.q1.w, rr.q2.x, rr.q2.y, rr.q2.z, rr.q2.w, rr.q3.x, rr.q3.y, rr.q3.z, rr.q3.w}
        if constexpr (U4) { if (VAR != 4) {
            float am = 0.f;
            if constexpr (!XQ) {
#pragma unroll
                for (int j = 0; j < 16; ++j) am = fmaxf(fmaxf(am, fmaxf(fabsf(xn[j][0]), fabsf(xn[j][1]))), fmaxf(fabsf(xn[j][2]), fabsf(xn[j][3])));
                am = wave_max(am); }
            const float xsc = XQ ? ((const float*)(a.ws + WS_SA))[m] : (am > 0.f ? am * (1.f / 119.f) : 1.f), xinv = 1.f / xsc;
            const unsigned* xrow = (const unsigned*)(a.ws + WS_XN2 + (size_t)m * DM) + lsx;
            int XL[2][4], XH[2][4];
#pragma unroll
            for (int p = 0; p < 2; ++p)
#pragma unroll
                for (int d = 0; d < 4; ++d) { unsigned tl[2], th[2];
#pragma unroll
                    for (int hf = 0; hf < 2; ++hf) { const int j = 8 * p + 2 * d + hf; const unsigned W = XQ ? xrow[64 * j] : pk4_i8(xn[j][0] * xinv, xn[j][1] * xinv, xn[j][2] * xinv, xn[j][3] * xinv);
                        const unsigned lo = W & 0x0f0f0f0fu, w8 = ((W & 0x7f7f7f7fu) + 0x08080808u) ^ (W & 0x80808080u), hi = (w8 >> 4) & 0x0f0f0f0fu;
                        tl[hf] = lo | (lo >> 4); th[hf] = hi | (hi >> 4); }
                    XL[p][d] = (int)__builtin_amdgcn_perm(tl[1], tl[0], 0x06040200u); XH[p][d] = (int)__builtin_amdgcn_perm(th[1], th[0], 0x06040200u); }
            float usc0 = 1.f, usc1 = 1.f; if (S8) { usc0 = USC[eid0 & EMASK]; usc1 = USC[eid1 & EMASK]; }
            Fp6Row r0[2], r1[2], r2[2], r3[2];
#define PEER_FETCH4(buf, pbase) do { _Pragma("unroll") for (int q2 = 0; q2 < 2; ++q2) { const int e_ = PEER_EID((pbase) + q2); buf[q2] = ld_row<true>(U8, nullptr, e_, l48, lane); } } while (0)
            PEER_FETCH4(r0, 0); PEER_FETCH4(r1, 2); PEER_FETCH4(r2, 4);
            float dk0 = 0.f, dk1 = 0.f;
#pragma unroll 1
            for (int p0 = 0; p0 < 128; p0 += 8) {
#pragma unroll
                for (int gsel = 0; gsel < 4; ++gsel) {
                    const int pb = p0 + 2 * gsel;
                    {
                        asm volatile("" ::: "memory");
                        if (pb + 6 < 128) { if (gsel == 0) PEER_FETCH4(r3, pb + 6); else if (gsel == 1) PEER_FETCH4(r0, pb + 6); else if (gsel == 2) PEER_FETCH4(r1, pb + 6); else PEER_FETCH4(r2, pb + 6); }
                        float d[2];
#pragma unroll
                        for (int q = 0; q < 2; ++q) { const Fp6Row& rr = gsel == 0 ? r0[q] : gsel == 1 ? r1[q] : gsel == 2 ? r2[q] : r3[q];
                            const unsigned wa[4] = {rr.q0.x, rr.q0.y, rr.q0.z, rr.q0.w}, wb[4] = {rr.q1.x, rr.q1.y, rr.q1.z, rr.q1.w};
                            int la = 0, ha = 0, lb = 0, hb = 0;
#pragma unroll
                            for (int dw = 0; dw < 4; ++dw) { la = __builtin_amdgcn_sdot8((int)wa[dw], XL[0][dw], la, false); ha = __builtin_amdgcn_sdot8((int)wa[dw], XH[0][dw], ha, false);
                                lb = __builtin_amdgcn_sdot8((int)wb[dw], XL[1][dw], lb, false); hb = __builtin_amdgcn_sdot8((int)wb[dw], XH[1][dw], hb, false); }
                            float s0, s1; if (S8) { const f32x2 sd = __builtin_amdgcn_cvt_pk_f32_fp8((int)rr.q2.x, false); s0 = sd.x; s1 = sd.y; } else { s0 = bflo(rr.q2.x); s1 = bfhi(rr.q2.x); }
                            d[q] = (float)(16 * ha + la) * s0 + (float)(16 * hb + lb) * s1; }
                        if ((gsel & 1) == 0) { dk0 = d[0]; dk1 = d[1]; }
                        else {
                            const bool b0 = (lsx & 1) != 0, b1 = (lsx & 2) != 0;
                            float x = b0 ? dk1 : dk0, sx = b0 ? dk0 : dk1, y = b0 ? d[1] : d[0], sy = b0 ? d[0] : d[1];
                            x += dppf<0xB1>(sx); y += dppf<0xB1>(sy);
                            float z = b1 ? y : x, sz = b1 ? x : y;
                            z += dppf<0x4E>(sz);
                            z += dppf<0x124>(z); z += dppf<0x128>(z);
                            z += __shfl_xor(z, 16); z += __shfl_xor(z, 32);
                            const int pb0 = pb - 2;
                            if ((lsx >> 2) == ((pb0 & 63) >> 2)) { if (pb0 < 64) cf0 = z * xsc; else cf1 = z * xsc; }
                        }
                    }
                }
            }
            if (S8) { cf0 *= usc0; cf1 *= usc1; }
            { const pg8::f32x2 a2 = pg8::gelu_pk((pg8::f32x2){cf0, cf1}); cf0 = gt0 * a2.x; cf1 = gt1 * a2.y; }
        } } else
        if constexpr (I8) { if (VAR != 4) {
            float am = 0.f;
#pragma unroll
            for (int j = 0; j < 16; ++j) am = fmaxf(fmaxf(am, fmaxf(fabsf(xn[j][0]), fabsf(xn[j][1]))), fmaxf(fabsf(xn[j][2]), fabsf(xn[j][3])));
            am = wave_max(am);
            const float xsc = am > 0.f ? am * (1.f / 127.f) : 1.f, xinv = 1.f / xsc;
            int xq[16];
#pragma unroll
            for (int j = 0; j < 16; ++j) xq[j] = (int)pk4_i8(xn[j][0] * xinv, xn[j][1] * xinv, xn[j][2] * xinv, xn[j][3] * xinv);
            Fp6Row r0[2], r1[2], r2[2];
            PEER_FETCH8(r0, 0, U8, USC); PEER_FETCH8(r1, 2, U8, USC);
#pragma unroll 1
            for (int p0 = 0; p0 < 128; p0 += 6) {
#pragma unroll
                for (int gsel = 0; gsel < 3; ++gsel) {
                    const int pb = p0 + 2 * gsel;
                    if (pb < 128) {
                        asm volatile("" ::: "memory");
                        if (pb + 4 < 128) { if (gsel == 0) PEER_FETCH8(r2, pb + 4, U8, USC); else if (gsel == 1) PEER_FETCH8(r0, pb + 4, U8, USC); else PEER_FETCH8(r1, pb + 4, U8, USC); }
                        float d[2];
#pragma unroll
                        for (int q = 0; q < 2; ++q) { const Fp6Row& rr = gsel == 0 ? r0[q] : gsel == 1 ? r1[q] : r2[q]; const unsigned w[16] = PEER_W16(rr);
                            int d0 = 0, d1 = 0, d2 = 0, d3 = 0;
#pragma unroll
                            for (int j = 0; j < 4; ++j) { d0 = __builtin_amdgcn_sdot4((int)w[j], xq[j], d0, false); d1 = __builtin_amdgcn_sdot4((int)w[4 + j], xq[4 + j], d1, false);
                                d2 = __builtin_amdgcn_sdot4((int)w[8 + j], xq[8 + j], d2, false); d3 = __builtin_amdgcn_sdot4((int)w[12 + j], xq[12 + j], d3, false); }
                            d[q] = (float)((d0 + d1) + (d2 + d3)); }
#pragma unroll
                        for (int q = 0; q < 2; ++q) {
                            const int p = pb + q;
                            const float dot = wave_sum(d[q]) * ((gsel == 0 ? r0[q].rs : gsel == 1 ? r1[q].rs : r2[q].rs) * xsc);
                            const float act = pg8::gelu_pk((pg8::f32x2){dot, dot}).x;
                            if (lane == (p & 63)) { if (pb < 64) cf0 = gt0 * act; else cf1 = gt1 * act; }
                        }
                    }
                }
            }
        } } else
        if (VAR != 4) {
            Fp6Row r0[4], r1[4], r2[4];
            PEER_FETCH(r0, 0, U8, UF4); if (URING == 3) PEER_FETCH(r1, 4, U8, UF4);
#pragma unroll 1
            for (int p0 = 0; p0 < 128; p0 += 4 * URING) {
#pragma unroll
                for (int gsel = 0; gsel < URING; ++gsel) {
                    const int pb = p0 + 4 * gsel;
                    if (pb < 128) {
                        asm volatile("" ::: "memory");
                        if (URING == 3) { if (pb + 8 < 128) { if (gsel == 0) PEER_FETCH(r2, pb + 8, U8, UF4); else if (gsel == 1) PEER_FETCH(r0, pb + 8, U8, UF4); else PEER_FETCH(r1, pb + 8, U8, UF4); } }
                        else { if (pb + 4 < 128) { if (gsel == 0) PEER_FETCH(r1, pb + 4, U8, UF4); else PEER_FETCH(r0, pb + 4, U8, UF4); } }
                        float d[4];
#pragma unroll
                        for (int q = 0; q < 4; ++q) {
                            float dd = 0.f;
#pragma unroll
                            for (int p = 0; p < 2; ++p) { const Fp6Row& rr = gsel == 0 ? r0[q] : gsel == 1 ? r1[q] : r2[q];
                                if (UF4) { const uint4 qq = p ? rr.q1 : rr.q0; const unsigned wq[4] = {qq.x, qq.y, qq.z, qq.w}; float dp = 0.f;
#pragma unroll
                                    for (int dw = 0; dw < 4; ++dw) { float one = 1.0f; asm volatile("" : "+v"(one)); float f8[8]; fp4_unpack8(wq[dw], one, f8);
#pragma unroll
                                        for (int t = 0; t < 8; ++t) dp += xn[8 * p + 2 * dw + (t >> 2)][t & 3] * f8[t];
                                        asm volatile("" : "+v"(dp)); }
                                    dd += dp * (p ? bfhi(rr.q2.x) : bflo(rr.q2.x));
                                } else if (VAR == 5) { float one = 1.0f; asm volatile("" : "+v"(one)); const h16x32_t fh = fp6_unpack_h(rr, p, one); float dp = 0.f;
#pragma unroll
                                    for (int t = 0; t < 32; t += 2) dp = __builtin_amdgcn_fdot2((h16x2_t){fh[t], fh[t + 1]}, xh[8 * p + (t >> 2)][(t & 3) >> 1], dp, false);
                                    dd += dp;
                                } else { float one = 1.0f; asm volatile("" : "+v"(one)); float bsc; const f32x32_t f = row_unpack<UF4, VAR>(rr, p, one, bsc);
                                    float dp = 0.f;
#pragma unroll
                                    for (int t = 0; t < 32; ++t) dp += xn[8 * p + (t >> 2)][t & 3] * f[t];
                                    dd += dp * bsc; }
                                asm volatile("" : "+v"(dd)); }
                            d[q] = dd;
                        }
#pragma unroll
                        for (int q = 0; q < 4; ++q) {
                            const int p = pb + q;
                            const float dot = wave_sum(d[q]) * (gsel == 0 ? r0[q].rs : gsel == 1 ? r1[q].rs : r2[q].rs);
                            const float act = pg8::gelu_pk((pg8::f32x2){dot, dot}).x;
                            if (lane == (p & 63)) { if (pb < 64) cf0 = gt0 * act; else cf1 = gt1 * act; }
                        }
                    }
                }
            }
        }
#pragma unroll
        for (int j = 0; j < 16; ++j)
#pragma unroll
            for (int e = 0; e < 4; ++e) acc[j][e] = 0.f;
        if constexpr (V4) { if (VAR != 3) {
            const float c0 = cf0 * VSC[eid0 & EMASK], c1 = cf1 * VSC[eid1 & EMASK];
            const float cm = wave_max(fmaxf(fabsf(c0), fabsf(c1)));
            const float csc = cm > 0.f ? cm * (1.f / 127.f) : 1.f, cinv = 1.f / csc;
            int ai[16][4]; int sca = 0, scb = 0;
#pragma unroll
            for (int j = 0; j < 16; ++j)
#pragma unroll
                for (int e = 0; e < 4; ++e) ai[j][e] = 0;
            Fp6Row r0[4], r1[4];
#define PEER_FETCHV4(buf, pbase) do { _Pragma("unroll") for (int q2 = 0; q2 < 4; ++q2) { const int e_ = PEER_EID((pbase) + q2); buf[q2] = ld_row<true>(V8, nullptr, e_, l48, lane); } } while (0)
            PEER_FETCHV4(r0, 0);
#pragma unroll 1
            for (int p0 = 0; p0 < 128; p0 += 8) {
#pragma unroll
                for (int gsel = 0; gsel < 2; ++gsel) {
                    const int pb = p0 + 4 * gsel;
                    asm volatile("" ::: "memory");
                    if (pb + 4 < 128) { if (gsel == 0) PEER_FETCHV4(r1, pb + 4); else PEER_FETCHV4(r0, pb + 4); }
                    float ce[4];
#pragma unroll
                    for (int q = 0; q < 4; ++q) ce[q] = rlane(S8 ? (pb < 64 ? c0 : c1) : (pb < 64 ? cf0 : cf1), (pb + q) & 63) * cinv;
#pragma unroll
                    for (int p = 0; p < 2; ++p) {
                        unsigned uc[4];
#pragma unroll
                        for (int q = 0; q < 4; ++q) { const Fp6Row& rr = gsel == 0 ? r0[q] : r1[q]; float sq;
                            if (S8) { const f32x2 sd = __builtin_amdgcn_cvt_pk_f32_fp8((int)rr.q2.x, false); sq = p ? sd.y : sd.x; } else sq = p ? bfhi(rr.q2.x) : bflo(rr.q2.x);
                            uc[q] = __float_as_uint(ce[q] * sq + 12582912.f); }
                        const int cpack = (int)__builtin_amdgcn_perm(__builtin_amdgcn_perm(uc[3], uc[2], 0x0c0c0400u), __builtin_amdgcn_perm(uc[1], uc[0], 0x0c0c0400u), 0x05040100u);
                        const int csum = __builtin_amdgcn_sdot4(cpack, 0x01010101, 0, false);
                        if (p) scb += csum; else sca += csum;
#pragma unroll
                        for (int dw = 0; dw < 4; ++dw) {
                            unsigned wr[4];
#pragma unroll
                            for (int q = 0; q < 4; ++q) { const Fp6Row& rr = gsel == 0 ? r0[q] : r1[q]; const uint4 qq = p ? rr.q1 : rr.q0; wr[q] = dw == 0 ? qq.x : dw == 1 ? qq.y : dw == 2 ? qq.z : qq.w; }
                            const unsigned t0 = __builtin_amdgcn_perm(wr[1], wr[0], 0x05010400u), t1 = __builtin_amdgcn_perm(wr[1], wr[0], 0x07030602u), t2 = __builtin_amdgcn_perm(wr[3], wr[2], 0x05010400u), t3 = __builtin_amdgcn_perm(wr[3], wr[2], 0x07030602u);
                            const unsigned o[4] = {__builtin_amdgcn_perm(t2, t0, 0x05040100u), __builtin_amdgcn_perm(t2, t0, 0x07060302u), __builtin_amdgcn_perm(t3, t1, 0x05040100u), __builtin_amdgcn_perm(t3, t1, 0x07060302u)};
                            const int j0 = 8 * p + 2 * dw;
#pragma unroll
                            for (int b = 0; b < 4; ++b) { const int lo = (int)(o[b] & 0x0f0f0f0fu), hi = (int)((o[b] >> 4) & 0x0f0f0f0fu); const int j = j0 + (b >> 1), t = 2 * (b & 1);
                                ai[j][t] = __builtin_amdgcn_sdot4(lo, cpack, ai[j][t], false); ai[j][t + 1] = __builtin_amdgcn_sdot4(hi, cpack, ai[j][t + 1], false); }
                        }
                    }
                }
            }
#pragma unroll
            for (int j = 0; j < 16; ++j)
#pragma unroll
                for (int e = 0; e < 4; ++e) acc[j][e] = (float)(ai[j][e] - 8 * (j < 8 ? sca : scb)) * csc;
        } } else
        if constexpr (I8) { if (VAR != 3) {
            const float c0 = cf0 * VSC[eid0 & EMASK], c1 = cf1 * VSC[eid1 & EMASK];
            const float cm = wave_max(fmaxf(fabsf(c0), fabsf(c1)));
            const float csc = cm > 0.f ? cm * (1.f / 127.f) : 1.f, cinv = 1.f / csc;
            const int ci0 = (int)(__float_as_uint(c0 * cinv + 12582912.f) & 0xffu), ci1 = (int)(__float_as_uint(c1 * cinv + 12582912.f) & 0xffu);
            int ai[16][4];
#pragma unroll
            for (int j = 0; j < 16; ++j)
#pragma unroll
                for (int e = 0; e < 4; ++e) ai[j][e] = 0;
            Fp6Row r0[2], r1[2], r2[2];
            PEER_FETCH8(r0, 0, V8, nullptr); PEER_FETCH8(r1, 2, V8, nullptr);
#pragma unroll 1
            for (int p0 = 0; p0 < 128; p0 += 6) {
#pragma unroll
                for (int gsel = 0; gsel < 3; ++gsel) {
                    const int pb = p0 + 2 * gsel;
                    if (pb < 128) {
                        asm volatile("" ::: "memory");
                        if (pb + 4 < 128) { if (gsel == 0) PEER_FETCH8(r2, pb + 4, V8, nullptr); else if (gsel == 1) PEER_FETCH8(r0, pb + 4, V8, nullptr); else PEER_FETCH8(r1, pb + 4, V8, nullptr); }
#pragma unroll
                        for (int q = 0; q < 2; ++q) { const Fp6Row& rr = gsel == 0 ? r0[q] : gsel == 1 ? r1[q] : r2[q]; const unsigned w[16] = PEER_W16(rr);
                            const int c8 = __builtin_amdgcn_readlane(pb < 64 ? ci0 : ci1, (pb + q) & 63); const int cb1 = c8 << 8, cb2 = c8 << 16, cb3 = c8 << 24;
#pragma unroll
                            for (int j = 0; j < 16; ++j) { ai[j][0] = __builtin_amdgcn_sdot4((int)w[j], c8, ai[j][0], false); ai[j][1] = __builtin_amdgcn_sdot4((int)w[j], cb1, ai[j][1], false);
                                ai[j][2] = __builtin_amdgcn_sdot4((int)w[j], cb2, ai[j][2], false); ai[j][3] = __builtin_amdgcn_sdot4((int)w[j], cb3, ai[j][3], false); } }
                    }
                }
            }
#pragma unroll
            for (int j = 0; j < 16; ++j)
#pragma unroll
                for (int e = 0; e < 4; ++e) acc[j][e] = (float)ai[j][e] * csc;
        } } else
        if (VAR != 3) {
            h16x2_t ah[16][2];
#pragma unroll
            for (int j = 0; j < 16; ++j) { ah[j][0] = (h16x2_t){0, 0}; ah[j][1] = (h16x2_t){0, 0}; }
            f32x2 ap[16][2];
#pragma unroll
            for (int j = 0; j < 16; ++j) { ap[j][0] = (f32x2){0.f, 0.f}; ap[j][1] = (f32x2){0.f, 0.f}; }
            Fp6Row r0[4], r1[4], r2[4];
            PEER_FETCH(r0, 0, V8, VF4); if (VRING == 3) PEER_FETCH(r1, 4, V8, VF4);
#pragma unroll 1
            for (int p0 = 0; p0 < 128; p0 += 4 * VRING) {
#pragma unroll
                for (int gsel = 0; gsel < VRING; ++gsel) {
                    const int pb = p0 + 4 * gsel;
                    if (pb < 128) {
                        asm volatile("" ::: "memory");
                        if (VRING == 3) { if (pb + 8 < 128) { if (gsel == 0) PEER_FETCH(r2, pb + 8, V8, VF4); else if (gsel == 1) PEER_FETCH(r0, pb + 8, V8, VF4); else PEER_FETCH(r1, pb + 8, V8, VF4); } }
                        else { if (pb + 4 < 128) { if (gsel == 0) PEER_FETCH(r1, pb + 4, V8, VF4); else PEER_FETCH(r0, pb + 4, V8, VF4); } }
                        float cfv[4];
#pragma unroll
                        for (int q = 0; q < 4; ++q) cfv[q] = rlane(pb < 64 ? cf0 : cf1, (pb + q) & 63) * (gsel == 0 ? r0[q].rs : gsel == 1 ? r1[q].rs : r2[q].rs);
#pragma unroll
                        for (int q = 0; q < 4; ++q)
#pragma unroll
                            for (int p = 0; p < 2; ++p) { const Fp6Row& rr = gsel == 0 ? r0[q] : gsel == 1 ? r1[q] : r2[q];
                                if (VF4) { const uint4 qq = p ? rr.q1 : rr.q0; const unsigned wq[4] = {qq.x, qq.y, qq.z, qq.w}; const float cfb = cfv[q] * (p ? bfhi(rr.q2.x) : bflo(rr.q2.x));
#pragma unroll
                                    for (int dw = 0; dw < 4; ++dw) { float one = 1.0f; asm volatile("" : "+v"(one)); float f8[8]; fp4_unpack8(wq[dw], one, f8);
#pragma unroll
                                        for (int t = 0; t < 8; ++t) acc[8 * p + 2 * dw + (t >> 2)][t & 3] += cfb * f8[t];
                                        PIN4(acc[8 * p + 2 * dw]); PIN4(acc[8 * p + 2 * dw + 1]); }
                                } else if (VAR == 5) { float one = 1.0f; asm volatile("" : "+v"(one)); const h16x32_t fh = fp6_unpack_h(rr, p, one); const _Float16 ch = (_Float16)cfv[q];
#pragma unroll
                                    for (int t = 0; t < 32; t += 2) ah[8 * p + (t >> 2)][(t & 3) >> 1] = __builtin_elementwise_fma((h16x2_t){fh[t], fh[t + 1]}, (h16x2_t){ch, ch}, ah[8 * p + (t >> 2)][(t & 3) >> 1]);
#pragma unroll
                                    for (int jj = 0; jj < 8; ++jj) asm volatile("" : "+v"(ah[8 * p + jj][0]), "+v"(ah[8 * p + jj][1]));
                                } else { float one = 1.0f; asm volatile("" : "+v"(one)); float bsc; const f32x32_t f = row_unpack<VF4, VAR>(rr, p, one, bsc);
                                    const float cfb = cfv[q] * bsc;
#pragma unroll
                                    for (int t = 0; t < 32; t += 2) ap[8 * p + (t >> 2)][(t & 3) >> 1] = __builtin_elementwise_fma((f32x2){f[t], f[t + 1]}, (f32x2){cfb, cfb}, ap[8 * p + (t >> 2)][(t & 3) >> 1]);
#pragma unroll
                                    for (int jj = 0; jj < 8; ++jj) asm volatile("" : "+v"(ap[8 * p + jj][0]), "+v"(ap[8 * p + jj][1])); } }
                    }
                }
            }
            if (VAR == 5) {
#pragma unroll
                for (int j = 0; j < 16; ++j) { acc[j][0] = (float)ah[j][0].x; acc[j][1] = (float)ah[j][0].y; acc[j][2] = (float)ah[j][1].x; acc[j][3] = (float)ah[j][1].y; } }
            else if (!VF4) {
#pragma unroll
                for (int j = 0; j < 16; ++j) { acc[j][0] = ap[j][0].x; acc[j][1] = ap[j][0].y; acc[j][2] = ap[j][1].x; acc[j][3] = ap[j][1].y; } }
        }
#endif
        { const float* gt2 = mod + (size_t)bb * NMOD + 5 * DM; float ss = 0.f;
          int l4 = lane * 4; asm volatile("" : "+v"(l4));
#pragma unroll
          for (int j = 0; j < 16; ++j) { const int c = 256 * j + l4; const f32x4 gq = *(const LAS f32x4*)(lds + (size_t)(bb * 4096 + c) * 4); const float4 g = make_float4(gq[0], gq[1], gq[2], gq[3]); float4 h4; if (HBF) { const uint2 hq = *(const uint2*)(hbrow + c); h4 = make_float4(bflo(hq.x), bfhi(hq.x), bflo(hq.y), bfhi(hq.y)); } else h4 = *(const float4*)(hrow + c);
              acc[j][0] = h4.x + g.x * acc[j][0]; acc[j][1] = h4.y + g.y * acc[j][1]; acc[j][2] = h4.z + g.z * acc[j][2]; acc[j][3] = h4.w + g.w * acc[j][3];
              ss += (acc[j][0] * acc[j][0] + acc[j][1] * acc[j][1]) + (acc[j][2] * acc[j][2] + acc[j][3] * acc[j][3]);
              if ((j & 3) == 3) { PIN4(acc[j - 3]); PIN4(acc[j - 2]); PIN4(acc[j - 1]); PIN4(acc[j]); asm volatile("" ::: "memory"); } }
          const float rstd = rsqrtf(wave_sum(ss) * (1.f / DM) + RMS_EPS);
#pragma unroll
          for (int j = 0; j < 16; ++j) { const int c = 256 * j + l4; const f32x4 fq = *(const LAS f32x4*)(lds + (size_t)(4 * 4096 + c) * 4); const float4 fg = make_float4(fq[0], fq[1], fq[2], fq[3]);
              *(float4*)(outp + (size_t)m * DM + c) = make_float4(acc[j][0] * rstd * fg.x, acc[j][1] * rstd * fg.y, acc[j][2] * rstd * fg.z, acc[j][3] * rstd * fg.w);
              if ((j & 3) == 3) asm volatile("" ::: "memory"); } }
    }
}

constexpr int N_PHASES = 13;
#ifndef TAB_ROWS
#define TAB_ROWS 12
#endif
constexpr int TAB_EARLY = 116 * 8 * TAB_ROWS;
__global__ void __launch_bounds__(512, 2) hybrid_fwd(Args args) {
    extern __shared__ __attribute__((aligned(16))) unsigned char lds_raw[];
    LAS unsigned char* lds = (LAS unsigned char*)lds_raw;
    volatile LAS unsigned* MISC = (volatile LAS unsigned*)(lds + LDS_MISC);
    for (int u = TID; u < (LDS_BYTES - LDS_CTL) / 4; u += 512) ((LAS unsigned*)(lds + LDS_CTL))[u] = 0u;
    __syncthreads();
    const int lo = args.ph_lo, hi = args.ph_hi;
    XcdBarrier bar; bar.bar = (unsigned*)(args.ws + WS_CTL); bar.x = 0; bar.st = nullptr;
    if (hi - lo > 1) bar = xcd_barrier_post((unsigned*)(args.ws + WS_CTL), MISC + 8);
#define IN(k) (lo <= (k) && (k) < hi && ((MK_PHASE_MASK >> (k)) & 1))
#define SEAM(k) do { if (IN(k) && IN((k) + 1)) xcd_barrier(bar); } while (0)
    const int bid = (int)blockIdx.x, G = (int)gridDim.x;

    if (IN(0)) { ph_mod(args, lds); ph_conv(args, lds, CONVQ); if (CONVQ) { __syncthreads(); ph_convq(args, lds); } }
    SEAM(0);
    if (IN(1)) { ph_norm1(args, lds); if (MK_F8 && !CONVQ) ph_w8(args); }
    SEAM(1);
    if (IN(2)) { pg8::StaticOrder S; S.init(MT, NINP, G, bid);
#if MK_F8 && (MK_QG & 1)
        { int k8 = DM / 2; asm volatile("" : "+s"(k8));
          pg8::Gemm g{(const bf16*)(args.ws + WS_A1), (const bf16*)(args.ws + WS_W8), MT, NINP, k8, DM / 2, DM / 2, 0, 0};
          pg8::EpiBf16S E{(bf16*)(args.ws + WS_P), NINP, (const float*)(args.ws + WS_SA), (const float*)(args.ws + WS_SB), (bf16*)(args.ws + WS_Z), COL_Z, COL_Z + RW, RW, MX}; pg8::gemm_phase<pg8::EpiBf16S, pg8::StaticOrder, false, MK_F8>(lds, g, S, E, nullptr); }
#else
        { pg8::Gemm g{(const bf16*)(args.ws + WS_A1), (const bf16*)(args.ws + WS_WT_IN), MT, NINP, DM, DM, DM, 0, 0};
          pg8::EpiBf16<0> E{(bf16*)(args.ws + WS_P), NINP, nullptr, 0, 0}; pg8::gemm_phase<pg8::EpiBf16<0>, pg8::StaticOrder>(lds, g, S, E, nullptr); }
#endif
        if (G == 256 && bid >= 140) ph_tabconv(args, 0, TAB_EARLY, (bid - 140) * 8 + WAVE, 116 * 8); }
    SEAM(2);
    if (IN(3)) { ph_prep_stage(args, lds); ph_prep_rwkv(args, lds); ph_prep_ssd(args, lds); }
    SEAM(3);
    if (IN(4)) { int kw = KLRW; asm volatile("" : "+s"(kw));
        pg8::Gemm g{(const bf16*)(args.ws + WS_ALR), (const bf16*)(args.ws + WS_WLR), MT, NLR, kw, KLR, KLRW, 4, 256}; pg8::StaticOrder S; S.init(MT, NLR, G, bid);
        EpiLR E{(bf16*)(args.ws + WS_LR), args.in[I_W0], args.in[I_A0]}; pg8::gemm_phase<EpiLR, pg8::StaticOrder>(lds, g, S, E, nullptr); }
    SEAM(4);
    if (IN(5)) ph_rwkv_chunked2(args, lds);
    if (IN(6)) ph_ssd_chunked(args, lds);
    SEAM(6);
    if (IN(7)) ph_finish(args, lds);
    SEAM(7);
    if (IN(8)) { pg8::StaticOrder S; S.init(MX, DM, G, bid);
        if constexpr (QG2) { int k8 = DM / 2; asm volatile("" : "+s"(k8));
            pg8::Gemm g{(const bf16*)(args.ws + WS_A2), (const bf16*)(args.ws + WS_W8O), MX, DM, k8, DM / 2, DM / 2, 0, 0};
            if constexpr (HBF) { EpiResB E{(bf16*)(args.ws + WS_HB), args.in[I_X], (const float*)(args.ws + WS_MOD), (const float*)(args.ws + WS_SA), (const float*)(args.ws + WS_SB2)}; pg8::gemm_phase<EpiResB, pg8::StaticOrder, false, MK_F8>(lds, g, S, E, nullptr); }
            else { EpiRes E{args.out, args.in[I_X], (const float*)(args.ws + WS_MOD), (const float*)(args.ws + WS_SA), (const float*)(args.ws + WS_SB2)}; pg8::gemm_phase<EpiRes, pg8::StaticOrder, false, MK_F8>(lds, g, S, E, nullptr); } }
        else { pg8::Gemm g{(const bf16*)(args.ws + WS_A2), (const bf16*)(args.ws + WS_WT_OUT), MX, DM, DM, DM, DM, 0, 0};
            EpiRes E{args.out, args.in[I_X], (const float*)(args.ws + WS_MOD), nullptr, nullptr}; pg8::gemm_phase<EpiRes, pg8::StaticOrder>(lds, g, S, E, nullptr); } }
    SEAM(8);
    if (IN(9)) { ph_norm2(args, lds); ph_tabconv(args, G == 256 ? TAB_EARLY : 0, 2 * 16384, GW, NGW); }
    SEAM(9);
    if (IN(10)) { pg8::StaticOrder S; S.init(MX, 2048, G, bid);
        if constexpr (QGQ) { int k8 = DM / 2; asm volatile("" : "+s"(k8));
            pg8::Gemm g{(const bf16*)(args.ws + WS_XN2), (const bf16*)(args.ws + WS_W8Q), MX, 2048, k8, DM / 2, DM / 2, 0, 0};
            pg8::EpiBf16S E{(bf16*)(args.ws + WS_Q), 2048, (const float*)(args.ws + WS_SA), (const float*)(args.ws + WS_SBQ), nullptr, 0, 0, 0, 0}; pg8::gemm_phase<pg8::EpiBf16S, pg8::StaticOrder, false, MK_F8>(lds, g, S, E, nullptr); }
        else { pg8::Gemm g{(const bf16*)(args.ws + WS_XN2), (const bf16*)(args.ws + WS_WT_Q), MX, 2048, DM, DM, DM, 0, 0};
            pg8::EpiBf16<0> E{(bf16*)(args.ws + WS_Q), 2048, nullptr, 0, 0}; pg8::gemm_phase<pg8::EpiBf16<0>, pg8::StaticOrder>(lds, g, S, E, nullptr); } }
    SEAM(10);
    if (IN(11)) { int kw = 256; asm volatile("" : "+s"(kw));
        pg8::Gemm g{(const bf16*)(args.ws + WS_Q), (const bf16*)(args.ws + WS_KBD), MX, 2048, kw, 2048, 256, 0, 256}; pg8::StaticOrder S; S.init(MX, 2048, G, bid);
#ifndef MK_S16
#define MK_S16 1
#endif
        if (MK_S16) { pg8::EpiF16 E{(unsigned short*)(args.ws + WS_S), 2048}; pg8::gemm_phase<pg8::EpiF16, pg8::StaticOrder>(lds, g, S, E, nullptr); }
        else { pg8::EpiF32 E{(float*)(args.ws + WS_S), 2048, nullptr}; pg8::gemm_phase<pg8::EpiF32, pg8::StaticOrder>(lds, g, S, E, nullptr); } }
    SEAM(11);
    if (IN(12)) { if (MK_PEER_PROBE == 1) ph_peer(args, (float*)(args.ws + WS_R), lds); if (MK_PEER_PROBE == 2) ph_peer<1023, MK_PEER_VAR>(args, (float*)(args.ws + WS_R), lds); ph_peer(args, args.out, lds); }
#undef IN
#undef SEAM
}

extern "C" void kernel_launch(void* const* d_in, const int* in_sizes, int n_in, void* d_out, int out_size, void* d_ws, size_t ws_size, hipStream_t stream) {
    static int grid = 0;
    if (grid == 0) {
        if (n_in != N_IN || out_size != MX * DM || ws_size < WS_END) { fprintf(stderr, "kernel_launch: unexpected shapes (n_in %d out %d ws %zu)\n", n_in, out_size, ws_size); grid = -1; return; }
        int dev = 0, cus = 0, per_cu = 0;
        if (hipGetDevice(&dev) != hipSuccess || hipDeviceGetAttribute(&cus, hipDeviceAttributeMultiprocessorCount, dev) != hipSuccess) { grid = -1; return; }
        if (hipFuncSetAttribute((const void*)hybrid_fwd, hipFuncAttributeMaxDynamicSharedMemorySize, LDS_BYTES) != hipSuccess) { fprintf(stderr, "kernel_launch: hipFuncSetAttribute failed\n"); grid = -1; return; }
        if (hipOccupancyMaxActiveBlocksPerMultiprocessor(&per_cu, (const void*)hybrid_fwd, 512, LDS_BYTES) != hipSuccess || per_cu < 1) fprintf(stderr, "kernel_launch: occupancy query reports %d\n", per_cu);
        (void)hipGetLastError();
        grid = cus;
    }
    if (grid < 0) return;
    (void)in_sizes;
    if (hipMemsetAsync((char*)d_ws + WS_CTL, 0, 16384, stream) != hipSuccess) return;
    Args a{};
    for (int i = 0; i < N_IN; ++i) a.in[i] = (const float*)d_in[i];
    a.out = (float*)d_out; a.ws = (unsigned char*)d_ws;
#if MK_N_LAUNCHES == 1
    a.ph_lo = 0; a.ph_hi = N_PHASES;
    hipLaunchKernelGGL(hybrid_fwd, dim3(grid), dim3(512), LDS_BYTES, stream, a);
#else
    for (int ph = 0; ph < N_PHASES; ++ph) { if (!((MK_PHASE_MASK >> ph) & 1)) continue; a.ph_lo = ph; a.ph_hi = ph + 1; hipLaunchKernelGGL(hybrid_fwd, dim3(grid), dim3(512), LDS_BYTES, stream, a); }
#endif
}
```
